# Optimizing an MI355X kernel written in HIP

```python
import math
import jax, jax.numpy as jnp
from jax import lax
import numpy as np

D_MODEL = 1024
BATCH = 1
SEQ = 16384
DEPTH = 1

CHUNK = 64
MIX_WIDTH = D_MODEL
ATTN_WIDTH = MIX_WIDTH // 2
LRU_WIDTH = MIX_WIDTH - ATTN_WIDTH
ATTN_HEAD_DIM = 64
ATTN_HEADS = ATTN_WIDTH // (2 * ATTN_HEAD_DIM)
LRU_BLOCKS = 8
LRU_BLOCK_DIM = LRU_WIDTH // LRU_BLOCKS
CONV_WIDTH = 4
LRU_C = 8.0
Q_BLOCK = 128
IN_COLS = 3 * ATTN_WIDTH + 2 * LRU_WIDTH
PEER_HEADS = 8
PEER_N_KEYS = 128
PEER_N_EXPERTS = PEER_N_KEYS * PEER_N_KEYS
PEER_QUERY_DIM = 256
PEER_HALF = PEER_QUERY_DIM // 2
PEER_TOPK = 16
PEER_BLOCK = 128
EPS = 1e-6

kernel_name = "hybrid_diffattn_rglru_peer"


def rmsnorm(x, g):
    x32 = x.astype(jnp.float32)
    y = x32 * lax.rsqrt(jnp.mean(x32 * x32, axis=-1, keepdims=True) + EPS)
    return (y * g.astype(jnp.float32)).astype(x.dtype)


def diff_attention(q, k, v, lam, subln_g, lambda_init):
    B, S = q.shape[0], q.shape[1]
    nb = S // Q_BLOCK
    scale = ATTN_HEAD_DIM ** -0.5
    k32 = k.astype(jnp.float32)
    v32 = v.astype(jnp.float32)
    k_chunk = jnp.arange(S) // CHUNK
    qb = q.reshape(B, nb, Q_BLOCK, ATTN_HEADS, 2, ATTN_HEAD_DIM).swapaxes(0, 1)

    def block(args):
        qblk, i = args
        q_chunk = (i * Q_BLOCK + jnp.arange(Q_BLOCK)) // CHUNK
        s = jnp.einsum('bqhmd,bkhmd->bhmqk', qblk.astype(jnp.float32), k32) * scale
        mask = q_chunk[:, None] >= k_chunk[None, :]
        s = jnp.where(mask, s, -1e30)
        p = jax.nn.softmax(s, axis=-1)
        p = p[:, :, 0] - lam * p[:, :, 1]
        return jnp.einsum('bhqk,bkhe->bqhe', p, v32)

    o = lax.map(block, (qb, jnp.arange(nb)))
    o = o.swapaxes(0, 1).reshape(B, S, ATTN_HEADS, 2 * ATTN_HEAD_DIM)
    o32 = o * lax.rsqrt(jnp.mean(o * o, axis=-1, keepdims=True) + EPS)
    o32 = o32 * subln_g.astype(jnp.float32) * (1.0 - lambda_init)
    return o32.reshape(B, S, ATTN_WIDTH).astype(q.dtype)


def rglru_branch(xr, gate, conv_w, conv_b, w_a, b_a, w_x, b_x, lru_lambda):
    B, S, W = xr.shape
    xp = jnp.pad(xr, ((0, 0), (CONV_WIDTH - 1, 0), (0, 0)))
    y = conv_b
    for t in range(CONV_WIDTH):
        y = y + xp[:, t:t + S, :] * conv_w[t]
    yb = y.reshape(B, S, LRU_BLOCKS, LRU_BLOCK_DIM)
    r = jax.nn.sigmoid((jnp.einsum('bsnd,nde->bsne', yb, w_a).reshape(B, S, W) + b_a).astype(jnp.float32))
    i = jax.nn.sigmoid((jnp.einsum('bsnd,nde->bsne', yb, w_x).reshape(B, S, W) + b_x).astype(jnp.float32))
    log_a = -LRU_C * r * jax.nn.softplus(-lru_lambda.astype(jnp.float32))
    a = jnp.exp(log_a)
    mult = jnp.sqrt(jnp.maximum(-jnp.expm1(2.0 * log_a), 1e-12))
    b = mult * (i * y.astype(jnp.float32))

    def combine(left, right):
        a1, b1 = left
        a2, b2 = right
        return a1 * a2, a2 * b1 + b2

    _, h = lax.associative_scan(combine, (a, b), axis=1)
    out = h * jax.nn.gelu(gate.astype(jnp.float32))
    return out.astype(xr.dtype)


def peer_ffn(xn, w_query, sub_keys_1, sub_keys_2, expert_down, expert_up):
    B, S, D = xn.shape
    T = B * S
    xt = xn.reshape(T, D)
    q = (xt @ w_query).reshape(T, PEER_HEADS, 2, PEER_HALF).astype(jnp.float32)
    s1 = jnp.einsum('thd,kd->thk', q[:, :, 0], sub_keys_1.astype(jnp.float32))
    s2 = jnp.einsum('thd,kd->thk', q[:, :, 1], sub_keys_2.astype(jnp.float32))
    v1, i1 = lax.top_k(s1, PEER_TOPK)
    v2, i2 = lax.top_k(s2, PEER_TOPK)
    cand = (v1[..., :, None] + v2[..., None, :]).reshape(T, PEER_HEADS, PEER_TOPK * PEER_TOPK)
    sc, ci = lax.top_k(cand, PEER_TOPK)
    eid = (jnp.take_along_axis(i1, ci // PEER_TOPK, axis=-1) * PEER_N_KEYS
           + jnp.take_along_axis(i2, ci % PEER_TOPK, axis=-1))
    g = jax.nn.softmax(sc, axis=-1)
    nbt = T // PEER_BLOCK

    def block(args):
        xb, eb, gb = args
        u = expert_down[eb]
        act = jax.nn.gelu(jnp.einsum('thkd,td->thk', u, xb).astype(jnp.float32))
        w = (gb * act).astype(xb.dtype)
        return jnp.einsum('thk,thkd->td', w, expert_up[eb])

    out = lax.map(block, (xt.reshape(nbt, PEER_BLOCK, D),
                          eid.reshape(nbt, PEER_BLOCK, PEER_HEADS, PEER_TOPK),
                          g.reshape(nbt, PEER_BLOCK, PEER_HEADS, PEER_TOPK)))
    return out.reshape(B, S, D).astype(xn.dtype)


def setup_inputs(seed: int = 0) -> dict:
    key = jax.random.key(seed)
    ks = jax.random.split(key, 24)
    f32 = jnp.float32
    L, D = DEPTH, D_MODEL
    nrm = lambda k, shape, s: jax.random.normal(k, shape, f32) * s
    a8 = jax.random.uniform(ks[14], (L, LRU_WIDTH), f32, 0.9, 0.999)
    a = a8 ** (1.0 / LRU_C)
    return {
        "x": jax.random.normal(ks[0], (BATCH, SEQ, D), f32),
        "norm1_g": 1.0 + nrm(ks[1], (L, D), 0.02),
        "w_in": nrm(ks[2], (L, D, IN_COLS), D ** -0.5),
        "lambda_q1": nrm(ks[3], (L, ATTN_HEAD_DIM), 0.1),
        "lambda_k1": nrm(ks[4], (L, ATTN_HEAD_DIM), 0.1),
        "lambda_q2": nrm(ks[5], (L, ATTN_HEAD_DIM), 0.1),
        "lambda_k2": nrm(ks[6], (L, ATTN_HEAD_DIM), 0.1),
        "subln_g": 1.0 + nrm(ks[7], (L, 2 * ATTN_HEAD_DIM), 0.02),
        "conv_w": nrm(ks[8], (L, CONV_WIDTH, LRU_WIDTH), CONV_WIDTH ** -0.5),
        "conv_b": nrm(ks[9], (L, LRU_WIDTH), 0.01),
        "w_rec_gate": nrm(ks[10], (L, LRU_BLOCKS, LRU_BLOCK_DIM, LRU_BLOCK_DIM), LRU_BLOCK_DIM ** -0.5),
        "b_rec_gate": nrm(ks[11], (L, LRU_WIDTH), 0.01),
        "w_in_gate": nrm(ks[12], (L, LRU_BLOCKS, LRU_BLOCK_DIM, LRU_BLOCK_DIM), LRU_BLOCK_DIM ** -0.5),
        "b_in_gate": nrm(ks[13], (L, LRU_WIDTH), 0.01),
        "lru_lambda": jnp.log(a) - jnp.log1p(-a),
        "w_out": nrm(ks[15], (L, MIX_WIDTH, D), MIX_WIDTH ** -0.5),
        "norm2_g": 1.0 + nrm(ks[16], (L, D), 0.02),
        "w_query": nrm(ks[17], (L, D, PEER_HEADS * PEER_QUERY_DIM), D ** -0.5),
        "sub_keys_1": nrm(ks[18], (L, PEER_N_KEYS, PEER_HALF), PEER_HALF ** -0.5),
        "sub_keys_2": nrm(ks[19], (L, PEER_N_KEYS, PEER_HALF), PEER_HALF ** -0.5),
        "expert_down": nrm(ks[20], (L, PEER_N_EXPERTS, D), D ** -0.5),
        "expert_up": nrm(ks[21], (L, PEER_N_EXPERTS, D), (PEER_HEADS * PEER_TOPK) ** -0.5),
        "norm_f_g": 1.0 + nrm(ks[22], (D,), 0.02),
    }


def reference(x, norm1_g, w_in, lambda_q1, lambda_k1, lambda_q2, lambda_k2, subln_g,
              conv_w, conv_b, w_rec_gate, b_rec_gate, w_in_gate, b_in_gate, lru_lambda,
              w_out, norm2_g, w_query, sub_keys_1, sub_keys_2, expert_down, expert_up,
              norm_f_g):
    B, S, D = x.shape
    h = x
    for l in range(DEPTH):
        lambda_init = 0.8 - 0.6 * math.exp(-0.3 * l)
        n = rmsnorm(h, norm1_g[l])
        p = n @ w_in[l]
        q = p[..., :ATTN_WIDTH].reshape(B, S, ATTN_HEADS, 2, ATTN_HEAD_DIM)
        k = p[..., ATTN_WIDTH:2 * ATTN_WIDTH].reshape(B, S, ATTN_HEADS, 2, ATTN_HEAD_DIM)
        v = p[..., 2 * ATTN_WIDTH:3 * ATTN_WIDTH].reshape(B, S, ATTN_HEADS, 2 * ATTN_HEAD_DIM)
        xr = p[..., 3 * ATTN_WIDTH:3 * ATTN_WIDTH + LRU_WIDTH]
        gate = p[..., 3 * ATTN_WIDTH + LRU_WIDTH:]
        lam = (jnp.exp(jnp.sum(lambda_q1[l].astype(jnp.float32) * lambda_k1[l].astype(jnp.float32)))
               - jnp.exp(jnp.sum(lambda_q2[l].astype(jnp.float32) * lambda_k2[l].astype(jnp.float32)))
               + lambda_init)
        attn_out = diff_attention(q, k, v, lam, subln_g[l], lambda_init)
        lru_out = rglru_branch(xr, gate, conv_w[l], conv_b[l], w_rec_gate[l], b_rec_gate[l],
                               w_in_gate[l], b_in_gate[l], lru_lambda[l])
        mix = jnp.concatenate([attn_out, lru_out], axis=-1)
        h = h + mix @ w_out[l]
        h = h + peer_ffn(rmsnorm(h, norm2_g[l]), w_query[l], sub_keys_1[l], sub_keys_2[l],
                         expert_down[l], expert_up[l])
    return rmsnorm(h, norm_f_g)
```

```cpp
#include <hip/hip_runtime.h>
#include <hip/hip_cooperative_groups.h>
#include <cstdio>
#include <cstdint>
namespace pg8 {
#define PG8_LAS __attribute__((address_space(3)))
typedef unsigned short bf16_t;
typedef short bf16x8 __attribute__((ext_vector_type(8)));
typedef float f32x4 __attribute__((ext_vector_type(4)));
typedef unsigned u32x4 __attribute__((ext_vector_type(4)));
constexpr int BM = 256, BK = 64, HALF = 128, HTB = HALF * BK * 2  , STAGE_BYTES = 8 * HTB, NXCD = 8, WGM = 8;

__host__ __device__ __forceinline__ int lds_byte(int r, int c) { const int st = (r >> 4) * 2 + (c >> 5), rr = r & 15, cc = c & 31, ob = rr * 64 + cc * 2; return st * 1024 + (ob ^ (((ob >> 9) & 1) << 5)); }
__host__ __device__ __forceinline__ void stage_rc(int b, int& R, int& C) { const int st = b / 1024, sb = b % 1024, swz = sb ^ (((sb >> 9) & 1) << 5); R = (st >> 1) * 16 + swz / 64; C = (st & 1) * 32 + (swz % 64) / 2; }
__host__ __device__ __forceinline__ int perm32(int rho) { const int n = rho >> 4, i = rho & 15; return 8 * (i >> 2) + 4 * n + (i & 3); }

struct Unit { int pm, pn; };
struct Gemm { const bf16_t* A; const bf16_t* Bt; int M, N, K; };

struct StaticOrder {
    int nM, nN, nwg, G, c;
    __host__ __device__ void init(int M, int N, int G_, int c_) { nM = M / BM; nN = N / BM; nwg = nM * nN; G = G_; c = c_; }
    __host__ __device__ bool next(int i, Unit& u) const {
        const long L = (long)i * G + c; if (L >= nwg) return false;
        int wgid = (int)L; { const int q = nwg / NXCD, r = nwg % NXCD, xcd = wgid % NXCD, off = wgid / NXCD; wgid = (xcd < r ? xcd * (q + 1) : r * (q + 1) + (xcd - r) * q) + off; }
        const int nig = WGM * nN, gid = wgid / nig, fm = gid * WGM, gsz = (nM - fm) < WGM ? (nM - fm) : WGM;
        u.pm = fm + ((wgid % nig) % gsz); u.pn = (wgid % nig) / gsz; return true;
    }
    __device__ __forceinline__ void a_ready(const Unit&) const {}
    __device__ __forceinline__ void done(const Unit&) const {}
};

__device__ __forceinline__ unsigned cvt_pk_bf16(float lo, float hi) { unsigned r; asm volatile("v_cvt_pk_bf16_f32 %0, %1, %2" : "=v"(r) : "v"(lo), "v"(hi)); return r; }
typedef float f32x2 __attribute__((ext_vector_type(2)));

template <int RSMODE> struct EpiBf16 {
    static constexpr bool PERM = true, AFTER_DRAIN = false;
    bf16_t* O; int ldc; const float* rowscale; int split_cols; size_t split_stride; float scale0;
    __device__ __forceinline__ void operator()(const f32x4 (&acc)[2][2][4][2], const Unit& u, int wr, int wc, int fr, int fq) const {
        const int row0 = u.pm * BM + wr * 64 + fr; int colt = u.pn * BM; bf16_t* base = O;
        float sc = 1.f; if (split_cols) { const int t = colt / split_cols; base += (size_t)t * split_stride; colt -= t * split_cols; if (t == 0) sc = scale0; }
        const int col0 = colt + wc * 32 + 8 * fq;
#pragma unroll
        for (int ai = 0; ai < 2; ++ai)
#pragma unroll
            for (int m = 0; m < 4; ++m) { const int row = row0 + ai * HALF + m * 16; bf16_t* rowp = base + (size_t)row * ldc + col0;
                float rs = sc;
                if (RSMODE == 1) rs *= rowscale[row];
                if (RSMODE == 2) rs *= 1.0f / sqrtf(rowscale[row] * (1.0f / 1024.0f) + 1e-6f);
#pragma unroll
                for (int bj = 0; bj < 2; ++bj) { f32x4 v0 = acc[ai][bj][m][0] * rs, v1 = acc[ai][bj][m][1] * rs;
                    u32x4 w; w.x = cvt_pk_bf16(v0[0], v0[1]); w.y = cvt_pk_bf16(v0[2], v0[3]); w.z = cvt_pk_bf16(v1[0], v1[1]); w.w = cvt_pk_bf16(v1[2], v1[3]);
                    *(u32x4*)(rowp + bj * HALF) = w; } }
    }
};

struct EpiResid {
    static constexpr bool PERM = false, AFTER_DRAIN = false;
    const float* X; float* Hf; bf16_t* Hb; float* rowss; int ldc;
    __device__ __forceinline__ void operator()(const f32x4 (&acc)[2][2][4][2], const Unit& u, int wr, int wc, int fr, int fq) const {
        typedef unsigned u32x2v __attribute__((ext_vector_type(2)));
        const int col0 = u.pn * BM + wc * 32 + 4 * fq;
#pragma unroll
        for (int ai = 0; ai < 2; ++ai)
#pragma unroll
            for (int m = 0; m < 4; ++m) { const int row = u.pm * BM + ai * HALF + wr * 64 + m * 16 + fr; const size_t off = (size_t)row * ldc + col0; float ss = 0.f;
#pragma unroll
                for (int bj = 0; bj < 2; ++bj)
#pragma unroll
                    for (int n = 0; n < 2; ++n) { const f32x4 xv = *(const f32x4*)(X + off + bj * HALF + n * 16); const f32x4 h = xv + acc[ai][bj][m][n];
                        *(f32x4*)(Hf + off + bj * HALF + n * 16) = h; u32x2v w; w.x = cvt_pk_bf16(h[0], h[1]); w.y = cvt_pk_bf16(h[2], h[3]);
                        *(u32x2v*)(Hb + off + bj * HALF + n * 16) = w; ss += (h[0] * h[0] + h[1] * h[1]) + (h[2] * h[2] + h[3] * h[3]); }
                ss += __shfl_xor(ss, 16); ss += __shfl_xor(ss, 32);
                if (fq == 0) atomicAdd(rowss + row, ss); }
    }
};

template <class Epi, class Sched, bool ALIGN_EPI = false, bool SP2 = false>
__device__ __forceinline__ void gemm_phase(PG8_LAS unsigned char* lds, const Gemm g, const Sched& S, const Epi& E) {
    const int tid = threadIdx.x, wid = __builtin_amdgcn_readfirstlane(tid >> 6), lane = tid & 63, wr = wid >> 2, wc = wid & 3, fr = lane & 15, fq = lane >> 4;
    const int K = g.K, nt = K / BK;
    unsigned voffA[2], voffB[2];
#pragma unroll
    for (int i = 0; i < 2; ++i) { int R, C; stage_rc(tid * 16 + i * 8192, R, C); const int Rb = Epi::PERM ? ((R & ~31) + perm32(R & 31)) : R;
        voffA[i] = (unsigned)(R * K + C) * 2u; voffB[i] = (unsigned)(Rb * K + C) * 2u; }
    const size_t kstep = (size_t)(BK * 2);
    const size_t hstep = (size_t)HALF * K * 2;
    const size_t tstep = 2 * hstep;
    const unsigned ldsw = (unsigned)wid * 1024u;
    const int aoff = lds_byte(wr * 64 + fr, fq * 8), boff = lds_byte(wc * 32 + fr, fq * 8);
#define PG8_SA(b, h) (((b) * 2 + (h)) * HTB)
#define PG8_SB(b, h) ((4 + (b) * 2 + (h)) * HTB)
#define PG8_STAGE(bufoff, gbase, voff) do { _Pragma("unroll") for (int _i = 0; _i < 2; ++_i) \
        __builtin_amdgcn_global_load_lds((const unsigned*)((const char*)(gbase) + (voff)[_i]), (PG8_LAS unsigned*)(lds + (bufoff) + ldsw + _i * 8192), 16, 0, 0); } while (0)
#define PG8_LDA(dst, b, h) do { _Pragma("unroll") for (int m = 0; m < 4; ++m) _Pragma("unroll") for (int k = 0; k < 2; ++k) dst[m][k] = *(const PG8_LAS bf16x8*)(lds + PG8_SA(b, h) + aoff + m * 2048 + k * 1024); } while (0)
#define PG8_LDB(dst, b, h) do { _Pragma("unroll") for (int n = 0; n < 2; ++n) _Pragma("unroll") for (int k = 0; k < 2; ++k) dst[n][k] = *(const PG8_LAS bf16x8*)(lds + PG8_SB(b, h) + boff + n * 2048 + k * 1024); } while (0)
#define PG8_MMA(ai, bj, At, Bt) do { __builtin_amdgcn_s_setprio(1); _Pragma("unroll") for (int m = 0; m < 4; ++m) _Pragma("unroll") for (int n = 0; n < 2; ++n) _Pragma("unroll") for (int k = 0; k < 2; ++k) \
        acc[ai][bj][m][n] = __builtin_amdgcn_mfma_f32_16x16x32_bf16(Bt[n][k], At[m][k], acc[ai][bj][m][n], 0, 0, 0); __builtin_amdgcn_s_setprio(0); } while (0)
#define PG8_WAIT_V(n) asm volatile("s_waitcnt vmcnt(" #n ")" ::: "memory")
#define PG8_WAIT_L(n) asm volatile("s_waitcnt lgkmcnt(" #n ")" ::: "memory")
#define PG8_BAR __builtin_amdgcn_s_barrier()
#define PG8_SCHED __builtin_amdgcn_sched_barrier(0)
    Unit cur, nxt; int ui = 0;
    if (!S.next(0, cur)) return;
    f32x4 acc[2][2][4][2];
#pragma unroll
    for (int a = 0; a < 2; ++a)
#pragma unroll
        for (int b = 0; b < 2; ++b)
#pragma unroll
            for (int m = 0; m < 4; ++m)
#pragma unroll
                for (int n = 0; n < 2; ++n) acc[a][b][m][n] = (f32x4){0.f, 0.f, 0.f, 0.f};
    bf16x8 At[4][2], B0[2][2], B1[2][2];
    const char* cA = (const char*)g.A + (size_t)cur.pm * tstep; const char* cB = (const char*)g.Bt + (size_t)cur.pn * tstep;
    S.a_ready(cur);
    if constexpr (SP2) {
        PG8_STAGE(PG8_SB(0, 0), cB, voffB); PG8_STAGE(PG8_SB(0, 1), cB + hstep, voffB); PG8_STAGE(PG8_SA(0, 0), cA, voffA); PG8_STAGE(PG8_SA(0, 1), cA + hstep, voffA);
        if (wr == 1) PG8_BAR;
        PG8_WAIT_V(2); PG8_BAR;
        PG8_STAGE(PG8_SB(1, 0), cB + kstep, voffB); PG8_STAGE(PG8_SA(1, 0), cA + kstep, voffA); PG8_STAGE(PG8_SB(1, 1), cB + hstep + kstep, voffB);
        PG8_WAIT_V(6); PG8_BAR;
    } else {
        PG8_STAGE(PG8_SB(0, 0), cB, voffB); PG8_STAGE(PG8_SA(0, 0), cA, voffA); PG8_STAGE(PG8_SB(0, 1), cB + hstep, voffB); PG8_STAGE(PG8_SA(0, 1), cA + hstep, voffA);
        if (wr == 1) PG8_BAR;
        PG8_WAIT_V(4); PG8_BAR;
        PG8_STAGE(PG8_SB(1, 0), cB + kstep, voffB); PG8_STAGE(PG8_SA(1, 0), cA + kstep, voffA); PG8_STAGE(PG8_SB(1, 1), cB + hstep + kstep, voffB);
        PG8_WAIT_V(6); PG8_BAR;
    }
    for (;;) {
        const bool has_next = S.next(ui + 1, nxt);
        const char* nA = has_next ? (const char*)g.A + (size_t)nxt.pm * tstep : cA; const char* nB = has_next ? (const char*)g.Bt + (size_t)nxt.pn * tstep : cB;
        for (int t = 0; t < nt; t += 2) {
            const bool last = (t == nt - 2);
            const char* a1 = cA + (size_t)(t + 1) * kstep;
            const char* a2 = last ? nA : cA + (size_t)(t + 2) * kstep; const char* b2 = last ? nB : cB + (size_t)(t + 2) * kstep;
            const char* a3 = a2 + kstep; const char* b3 = b2 + kstep;
            if (last && has_next) S.a_ready(nxt);
            if constexpr (SP2) {
            PG8_LDB(B0, 0, 0); PG8_LDB(B1, 0, 1); PG8_SCHED; PG8_LDA(At, 0, 0); PG8_STAGE(PG8_SA(1, 1), a1 + hstep, voffA);
            PG8_WAIT_V(8); PG8_WAIT_L(0); PG8_BAR; PG8_MMA(0, 0, At, B0); PG8_MMA(0, 1, At, B1); PG8_BAR; PG8_SCHED;
            PG8_LDA(At, 0, 1); PG8_STAGE(PG8_SB(0, 0), b2, voffB); PG8_STAGE(PG8_SB(0, 1), b2 + hstep, voffB); PG8_STAGE(PG8_SA(0, 0), a2, voffA);
            PG8_WAIT_V(8); PG8_WAIT_L(0); PG8_BAR; PG8_MMA(1, 0, At, B0); PG8_MMA(1, 1, At, B1); PG8_BAR; PG8_SCHED;
            PG8_LDB(B0, 1, 0); PG8_LDB(B1, 1, 1); PG8_SCHED; PG8_LDA(At, 1, 0); PG8_STAGE(PG8_SA(0, 1), a2 + hstep, voffA);
            PG8_WAIT_V(8); PG8_WAIT_L(0); PG8_BAR; PG8_MMA(0, 0, At, B0); PG8_MMA(0, 1, At, B1); PG8_BAR; PG8_SCHED;
            PG8_LDA(At, 1, 1); PG8_STAGE(PG8_SB(1, 0), b3, voffB); PG8_STAGE(PG8_SB(1, 1), b3 + hstep, voffB); PG8_STAGE(PG8_SA(1, 0), a3, voffA);
            PG8_WAIT_V(8); PG8_WAIT_L(0); PG8_BAR; PG8_MMA(1, 0, At, B0); PG8_MMA(1, 1, At, B1); PG8_BAR; PG8_SCHED;
            } else {
            PG8_LDB(B0, 0, 0); PG8_SCHED; PG8_LDA(At, 0, 0); PG8_STAGE(PG8_SA(1, 1), a1 + hstep, voffA);
            PG8_WAIT_L(8); PG8_BAR; PG8_WAIT_L(0); PG8_MMA(0, 0, At, B0); PG8_BAR; PG8_SCHED;
            PG8_LDB(B1, 0, 1); PG8_STAGE(PG8_SB(0, 0), b2, voffB);
            PG8_BAR; PG8_WAIT_L(0); PG8_MMA(0, 1, At, B1); PG8_BAR;
            PG8_LDA(At, 0, 1); PG8_STAGE(PG8_SA(0, 0), a2, voffA);
            PG8_BAR; PG8_WAIT_L(0); PG8_MMA(1, 0, At, B0); PG8_BAR; PG8_SCHED;
            PG8_STAGE(PG8_SB(0, 1), b2 + hstep, voffB);
            PG8_WAIT_V(6); PG8_BAR; PG8_MMA(1, 1, At, B1); PG8_BAR;
            PG8_LDB(B0, 1, 0); PG8_SCHED; PG8_LDA(At, 1, 0); PG8_STAGE(PG8_SA(0, 1), a2 + hstep, voffA);
            PG8_WAIT_L(8); PG8_BAR; PG8_WAIT_L(0); PG8_MMA(0, 0, At, B0); PG8_BAR; PG8_SCHED;
            PG8_LDB(B1, 1, 1); PG8_STAGE(PG8_SB(1, 0), b3, voffB);
            PG8_BAR; PG8_WAIT_L(0); PG8_MMA(0, 1, At, B1); PG8_BAR;
            PG8_LDA(At, 1, 1); PG8_STAGE(PG8_SA(1, 0), a3, voffA);
            PG8_BAR; PG8_WAIT_L(0); PG8_MMA(1, 0, At, B0); PG8_BAR; PG8_SCHED;
            PG8_STAGE(PG8_SB(1, 1), b3 + hstep, voffB);
            PG8_WAIT_V(6); PG8_BAR; PG8_MMA(1, 1, At, B1); PG8_BAR;
            }
        }
        if constexpr (ALIGN_EPI) { if (wr == 0) PG8_BAR; }
        if constexpr (!Epi::AFTER_DRAIN) { E(acc, cur, wr, wc, fr, fq); S.done(cur); }
        if (!has_next) break;
#pragma unroll
        for (int a = 0; a < 2; ++a)
#pragma unroll
            for (int b = 0; b < 2; ++b)
#pragma unroll
                for (int m = 0; m < 4; ++m)
#pragma unroll
                    for (int n = 0; n < 2; ++n) acc[a][b][m][n] = (f32x4){0.f, 0.f, 0.f, 0.f};
        cur = nxt; cA = nA; cB = nB; ++ui;
        if constexpr (ALIGN_EPI) { if (wr == 1) PG8_BAR; }
    }
    PG8_WAIT_V(0);
    if constexpr (!ALIGN_EPI) { if (wr == 0) PG8_BAR; }
    PG8_BAR;
    if constexpr (Epi::AFTER_DRAIN) { E.fused(acc, cur, wr, wc, fr, fq, lds, wid, lane); S.done(cur); }
#undef PG8_SA
#undef PG8_SB
#undef PG8_STAGE
#undef PG8_LDA
#undef PG8_LDB
#undef PG8_MMA
#undef PG8_WAIT_V
#undef PG8_WAIT_L
#undef PG8_BAR
#undef PG8_SCHED
}
}

#include <hip/hip_bf16.h>
#include <cmath>
namespace attn_body {
using bf16=__hip_bfloat16;
using bf16x8=__attribute__((ext_vector_type(8)))short;
using s16x4=__attribute__((ext_vector_type(4)))short;
using f32x16=__attribute__((ext_vector_type(16)))float;
using u32x4=__attribute__((ext_vector_type(4)))unsigned;
constexpr int SEQ=16384,D=64,DM=512;
constexpr int NW=8,QBLK=32,QB=QBLK*NW,KVBLK=64,NQB=SEQ/QB;
constexpr int ATTN_PITCH=DM, ATTN_UNIT_ROWS=QB;
__device__ __forceinline__ int crow(int r,int hi){return (r&3)+8*(r>>2)+4*hi;}
#define SBAR() __builtin_amdgcn_sched_barrier(0)
__device__ __forceinline__ void cmask(f32x16&p0,f32x16&p1,int jb,int wid){
  const float NEG=-INFINITY;
  if(jb>(wid>>1)){
  #pragma unroll
  for(int r=0;r<16;++r){p0[r]=NEG;p1[r]=NEG;}}
}

constexpr int NSLOT=3, SLOTB=8192;
constexpr int LDS_K=0, LDS_V=NSLOT*SLOTB, LDS_WS=2*NSLOT*SLOTB, LDS_OST=LDS_WS+NW*64*4, LDS_BYTES=LDS_OST+NW*4096;
constexpr float C2=0.125f*1.4426950408889634f;
__device__ __forceinline__ void glds16(const void*gsrc,unsigned lds_dst){unsigned keep;
  asm volatile("s_mov_b32 %0, m0\n\ts_mov_b32 m0, %2\n\ts_nop 0\n\tglobal_load_lds_dwordx4 %1, off\n\ts_mov_b32 m0, %0":"=&s"(keep):"v"(gsrc),"s"(lds_dst):"memory");}
__device__ __forceinline__ float max3f(float a,float b,float c){float r;asm("v_max3_f32 %0, %1, %2, %3":"=v"(r):"v"(a),"v"(b),"v"(c));return r;}
__device__ __forceinline__ float max2f(float a,float b){float r;asm("v_max_f32_e32 %0, %1, %2":"=v"(r):"v"(a),"v"(b));return r;}
__device__ __forceinline__ float fadd_s(float a,float b){float r;asm("v_add_f32_e32 %0, %1, %2":"=v"(r):"v"(a),"v"(b));return r;}
__device__ __forceinline__ float fsub_s(float a,float b){float r;asm("v_sub_f32_e32 %0, %1, %2":"=v"(r):"v"(a),"v"(b));return r;}
typedef float f32x2_t __attribute__((ext_vector_type(2))); typedef __bf16 bf16x2_t __attribute__((ext_vector_type(2)));
__device__ __forceinline__ unsigned cvtpk_s(float lo,float hi){f32x2_t v={lo,hi};bf16x2_t b=__builtin_convertvector(v,bf16x2_t);return __builtin_bit_cast(unsigned,b);}
#define WAIT_BAR(N) asm volatile("s_waitcnt vmcnt(" #N ") lgkmcnt(0)\n\ts_barrier":::"memory")

__device__ __forceinline__ void qkt(f32x16&p0,f32x16&p1,const char*Kslot,const bf16x8*qr,const f32x16&negm,int r32,int hi){
  const char*kb=Kslot+hi*1024+r32*16;
  #pragma unroll
  for(int d0=0;d0<4;++d0){
    const bf16x8 b0=*reinterpret_cast<const bf16x8*>(kb+d0*2048);
    const bf16x8 b1=*reinterpret_cast<const bf16x8*>(kb+d0*2048+512);
    if(d0==0){p0=__builtin_amdgcn_mfma_f32_32x32x16_bf16(b0,qr[0],negm,0,0,0);p1=__builtin_amdgcn_mfma_f32_32x32x16_bf16(b1,qr[0],negm,0,0,0);}
    else{p0=__builtin_amdgcn_mfma_f32_32x32x16_bf16(b0,qr[d0],p0,0,0,0);p1=__builtin_amdgcn_mfma_f32_32x32x16_bf16(b1,qr[d0],p1,0,0,0);}}
}
typedef __attribute__((address_space(3))) const char* lds_cptr;
typedef short v4i16_t __attribute__((ext_vector_type(4)));
__device__ __forceinline__ void kload8(bf16x8*kf,lds_cptr kp){
  kf[0]=*(const __attribute__((address_space(3))) bf16x8*)(kp);      kf[1]=*(const __attribute__((address_space(3))) bf16x8*)(kp+512);
  kf[2]=*(const __attribute__((address_space(3))) bf16x8*)(kp+2048); kf[3]=*(const __attribute__((address_space(3))) bf16x8*)(kp+2560);
  kf[4]=*(const __attribute__((address_space(3))) bf16x8*)(kp+4096); kf[5]=*(const __attribute__((address_space(3))) bf16x8*)(kp+4608);
  kf[6]=*(const __attribute__((address_space(3))) bf16x8*)(kp+6144); kf[7]=*(const __attribute__((address_space(3))) bf16x8*)(kp+6656);
}
__device__ __forceinline__ void kload2(bf16x8*kf,lds_cptr kp,int j){ kf[2*j]=*(const __attribute__((address_space(3))) bf16x8*)(kp+j*2048); kf[2*j+1]=*(const __attribute__((address_space(3))) bf16x8*)(kp+j*2048+512); }
__device__ __forceinline__ s16x4 vtr(lds_cptr p){ return __builtin_bit_cast(s16x4,__builtin_amdgcn_ds_read_tr16_b64_v4i16((__attribute__((address_space(3))) v4i16_t*)p)); }
__device__ __forceinline__ float rowmax(const f32x16&p0,const f32x16&p1){
  float a=max3f(p0[0],p0[1],p1[0]),b=max3f(p0[2],p0[3],p1[1]);a=max3f(a,p1[2],p1[3]);
  #pragma unroll
  for(int r=4;r<16;r+=4){a=max3f(a,p0[r],p0[r+1]);b=max3f(b,p0[r+2],p0[r+3]);a=max3f(a,p1[r],p1[r+1]);b=max3f(b,p1[r+2],p1[r+3]);}
  const float m=max2f(a,b);
  auto rr=__builtin_amdgcn_permlane32_swap(__float_as_uint(m),__float_as_uint(m),false,false);
  return max2f(__uint_as_float(rr[0]),__uint_as_float(rr[1]));
}
__device__ __forceinline__ void pv(f32x16*o,int vb,bf16x8 pa0,bf16x8 pa1,bf16x8 pa2,bf16x8 pa3){
  #pragma unroll
  for(int d0=0;d0<2;++d0){s16x4 lo[4],hi[4];
    #pragma unroll
    for(int ks=0;ks<4;++ks){
      asm volatile("ds_read_b64_tr_b16 %0,%1 offset:%c2":"=&v"(lo[ks]):"v"(vb),"i"(d0*4096+ks*1024):"memory");
      asm volatile("ds_read_b64_tr_b16 %0,%1 offset:%c2":"=&v"(hi[ks]):"v"(vb),"i"(d0*4096+ks*1024+512):"memory");}
    asm volatile("s_waitcnt lgkmcnt(0)":::"memory");SBAR();
    #define PK(k) (bf16x8){lo[k][0],lo[k][1],lo[k][2],lo[k][3],hi[k][0],hi[k][1],hi[k][2],hi[k][3]}
    o[d0]=__builtin_amdgcn_mfma_f32_32x32x16_bf16(pa0,PK(0),o[d0],0,0,0);
    o[d0]=__builtin_amdgcn_mfma_f32_32x32x16_bf16(pa1,PK(1),o[d0],0,0,0);
    o[d0]=__builtin_amdgcn_mfma_f32_32x32x16_bf16(pa2,PK(2),o[d0],0,0,0);
    o[d0]=__builtin_amdgcn_mfma_f32_32x32x16_bf16(pa3,PK(3),o[d0],0,0,0);
    #undef PK
  }
}

#ifndef ATTN_STORE16
#define ATTN_STORE16(p,v) (*(u32x4*)(p)=(v))
#endif
template<int THRL> __device__ __forceinline__ void attn_unit(int qcol,int vcol,int qb,const bf16*Q,const bf16*__restrict__ K,const bf16*__restrict__ V,bf16*O,char*shm){
  const int tid=threadIdx.x,lane=tid&63,r32=lane&31,hi=lane>>5; const int wid=__builtin_amdgcn_readfirstlane(tid>>6);
  const long rowbase=0; const int q0=qb*QB;
  const bf16*Qw=Q+(rowbase+q0+wid*QBLK)*DM+qcol;
  const bf16*Kh=K+rowbase*DM+qcol,*Vh=V+rowbase*DM+vcol;
  const unsigned lds0=(unsigned)(uintptr_t)shm;
  float*wsf=(float*)(shm+LDS_WS)+wid*64;
  const bf16*ksrc=Kh+(long)lane*DM+wid*8;
  const bf16*vsrc=Vh+(long)(16*(wid&3)+(lane>>2))*DM+(wid>>2)*32+(lane&3)*8;
  const unsigned kdst=lds0+LDS_K+wid*1024, vdst=lds0+LDS_V+wid*1024;
  #define DMA_K(t,slot) glds16(ksrc+(long)(t)*KVBLK*DM,(unsigned)__builtin_amdgcn_readfirstlane(kdst+(slot)))
  #define DMA_V(t,slot) glds16(vsrc+(long)(t)*KVBLK*DM,(unsigned)__builtin_amdgcn_readfirstlane(vdst+(slot)))
  const int vb0=(int)(lds0+LDS_V)+((lane>>4)&1)*32+(lane&3)*8+(4*hi+((lane&15)>>2))*64;
  const char*Kbase=shm+LDS_K; bf16x8 kf[8];
  const lds_cptr shm3=(lds_cptr)shm; const lds_cptr kp0=shm3+LDS_K+hi*1024+r32*16; const lds_cptr vp0=shm3+LDS_V+((lane>>4)&1)*32+(lane&3)*8+(4*hi+((lane&15)>>2))*64;
  const int NT=(q0+QB)/KVBLK;
  DMA_K(0,0);DMA_V(0,0);DMA_K(1,SLOTB);
  bf16x8 qr[4];
  #pragma unroll
  for(int d0=0;d0<4;++d0)qr[d0]=*reinterpret_cast<const bf16x8*>(&Qw[(long)r32*DM+d0*16+hi*8]);
  float mhat=0.f,l_reg=0.f;f32x16 o[2];o[0]=f32x16{};o[1]=f32x16{};f32x16 negm=f32x16{};asm volatile("":"+v"(negm));
  const int qrel=wid*QBLK+r32;
  #define CMASK(P0,P1,t) do{int jb_=(t)-(NT-4); if(jb_>=0)cmask(P0,P1,jb_,wid);}while(0)
  bool resc=false;
  #define START(P0,P1) do{ const float rm=rowmax(P0,P1); resc=false; \
    { const float dl=rm; mhat=fadd_s(mhat,dl); \
      _Pragma("unroll") for(int r=0;r<16;++r){P0[r]=fsub_s(P0[r],dl);P1[r]=fsub_s(P1[r],dl);} \
      _Pragma("unroll") for(int r=0;r<16;++r)negm[r]=-mhat; asm volatile("":"+v"(negm)); } \
    _Pragma("unroll") for(int r=0;r<16;++r)P0[r]=__builtin_amdgcn_exp2f(P0[r]); }while(0)
  #define RESC() do{ if(resc){ asm volatile("s_waitcnt lgkmcnt(0)":::"memory"); \
      _Pragma("unroll") for(int d_=0;d_<2;++d_) _Pragma("unroll") for(int r=0;r<16;++r)o[d_][r]*=wsf[crow(r,hi)]; } }while(0)
  f32x16 pA0,pA1,pB0,pB1;
  int sl_prev=0,sl_cur=0,sl_next=SLOTB;
  #define ROT() do{sl_prev=sl_cur;sl_cur=sl_next;sl_next=(sl_next==(NSLOT-1)*SLOTB)?0:sl_next+SLOTB;}while(0)
  DMA_K(2,2*SLOTB);
  WAIT_BAR(3);
  qkt(pA0,pA1,Kbase,qr,negm,r32,hi);asm volatile("s_nop 15\n\ts_nop 7":"+v"(pA0),"+v"(pA1));CMASK(pA0,pA1,0);
  START(pA0,pA1);
  _Pragma("unroll") for(int r=0;r<16;++r)pA1[r]=__builtin_amdgcn_exp2f(pA1[r]);
  WAIT_BAR(0);
  DMA_K(3,0);DMA_V(1,SLOTB);
  ROT();
  kload8(kf,kp0+sl_cur);
  WAIT_BAR(2);
  s16x4 vlo[8],vhi[8]; u32x4 pw0,pw1,pw2,pw3;
  #define PKW(P,B) cvtpk_s(P[B],P[B+1])
  #define PAF(k) __builtin_bit_cast(bf16x8,pw##k)
  #define VFR(i) (bf16x8){vlo[i][0],vlo[i][1],vlo[i][2],vlo[i][3],vhi[i][0],vhi[i][1],vhi[i][2],vhi[i][3]}
  #define PIN(x) asm volatile("":"+v"(x))
  #define MX3(a,b,c) __builtin_fmaxf(__builtin_fmaxf((a),(b)),(c))
  #define GAPA(MF,A0,A1,A2,A3,W0,W1,PW) do{ MF; sacc+=A0; sacc+=A1; sacc+=A2; sacc+=A3; PIN(sacc); W0; W1; PIN(PW); SBAR(); }while(0)
  #define EX(v) __builtin_amdgcn_exp2f(v)
  #define GAPB(MF,X,B) do{ MF; X[B]=EX(X[B]); X[B+1]=EX(X[B+1]); X[B+2]=EX(X[B+2]); X[B+3]=EX(X[B+3]); PIN(X); SBAR(); }while(0)
  #define VRD(i) do{ vlo[i]=vtr(vp_+(((i)>>2)*4096+((i)&3)*1024)); vhi[i]=vtr(vp_+(((i)>>2)*4096+((i)&3)*1024+512)); }while(0)
  #define KRD(G,j) do{ if(G){ kload2(kf,kp0+sl_next,j); SBAR(); } }while(0)
  #define STEP(C0,C1,P0,P1,t,GK,GV,GL) do{ SBAR(); \
    const lds_cptr vp_=vp0+sl_prev; \
    VRD(0); SBAR(); float sacc=(P0[0]+P0[1]); \
    GAPA(C0=__builtin_amdgcn_mfma_f32_32x32x16_bf16(kf[0],qr[0],negm,0,0,0), P0[2],P0[3],P0[4],P0[5],     pw0[0]=PKW(P0,0), pw0[1]=PKW(P0,2), pw0); \
    VRD(4); SBAR(); GAPA(C1=__builtin_amdgcn_mfma_f32_32x32x16_bf16(kf[1],qr[0],negm,0,0,0), P0[6],P0[7],P0[8],P0[9],     pw0[2]=PKW(P0,4), pw0[3]=PKW(P0,6), pw0); \
    VRD(1); SBAR(); GAPA(C0=__builtin_amdgcn_mfma_f32_32x32x16_bf16(kf[2],qr[1],C0,0,0,0),   P0[10],P0[11],P0[12],P0[13], pw1[0]=PKW(P0,8), pw1[1]=PKW(P0,10), pw1); \
    VRD(5); SBAR(); GAPA(C1=__builtin_amdgcn_mfma_f32_32x32x16_bf16(kf[3],qr[1],C1,0,0,0),   P0[14],P0[15],P1[0],P1[1],   pw1[2]=PKW(P0,12),pw1[3]=PKW(P0,14), pw1); \
    VRD(2); SBAR(); GAPA(C0=__builtin_amdgcn_mfma_f32_32x32x16_bf16(kf[4],qr[2],C0,0,0,0),   P1[2],P1[3],P1[4],P1[5],     pw2[0]=PKW(P1,0), pw2[1]=PKW(P1,2), pw2); \
    VRD(6); SBAR(); GAPA(C1=__builtin_amdgcn_mfma_f32_32x32x16_bf16(kf[5],qr[2],C1,0,0,0),   P1[6],P1[7],P1[8],P1[9],     pw2[2]=PKW(P1,4), pw2[3]=PKW(P1,6), pw2); \
    VRD(3); SBAR(); GAPA(C0=__builtin_amdgcn_mfma_f32_32x32x16_bf16(kf[6],qr[3],C0,0,0,0),   P1[10],P1[11],P1[12],P1[13], pw3[0]=PKW(P1,8), pw3[1]=PKW(P1,10), pw3); \
    VRD(7); SBAR(); GAPA(C1=__builtin_amdgcn_mfma_f32_32x32x16_bf16(kf[7],qr[3],C1,0,0,0),   P1[14],P1[15],0.f,0.f,       pw3[2]=PKW(P1,12),pw3[3]=PKW(P1,14), pw3); \
    l_reg+=sacc; \
    if(GK){DMA_K((t)+3,sl_cur);} if(GV){DMA_V((t)+1,sl_next);} \
    CMASK(C0,C1,t); \
    { float a=MX3(C0[0],C0[1],C1[0]),b=MX3(C0[2],C0[3],C1[1]); a=MX3(a,C1[2],C1[3]); \
      _Pragma("unroll") for(int r=4;r<16;r+=4){a=MX3(a,C0[r],C0[r+1]);b=MX3(b,C0[r+2],C0[r+3]);a=MX3(a,C1[r],C1[r+1]);b=MX3(b,C1[r+2],C1[r+3]);} \
      float rm=__builtin_fmaxf(a,b); { auto rr=__builtin_amdgcn_permlane32_swap(__float_as_uint(rm),__float_as_uint(rm),false,false); rm=__builtin_fmaxf(__uint_as_float(rr[0]),__uint_as_float(rr[1])); } \
      resc=false; \
      if(__builtin_expect(__any(rm>(float)THRL),0)){ const float dl=__builtin_fmaxf(rm,0.f); mhat+=dl; \
        _Pragma("unroll") for(int r=0;r<16;++r){C0[r]-=dl;C1[r]-=dl;} \
        _Pragma("unroll") for(int r=0;r<16;++r)negm[r]=-mhat; asm volatile("":"+v"(negm)); \
        const float f=__builtin_amdgcn_exp2f(-dl); l_reg*=f; if(hi==0)wsf[r32]=f; resc=true; } } \
    SBAR(); \
    GAPB(o[0]=__builtin_amdgcn_mfma_f32_32x32x16_bf16(PAF(0),VFR(0),o[0],0,0,0), C0,0); \
    GAPB(o[1]=__builtin_amdgcn_mfma_f32_32x32x16_bf16(PAF(0),VFR(4),o[1],0,0,0), C0,4); \
    KRD(GL,0); GAPB(o[0]=__builtin_amdgcn_mfma_f32_32x32x16_bf16(PAF(1),VFR(1),o[0],0,0,0), C0,8); \
    KRD(GL,1); GAPB(o[1]=__builtin_amdgcn_mfma_f32_32x32x16_bf16(PAF(1),VFR(5),o[1],0,0,0), C0,12); \
    KRD(GL,2); GAPB(o[0]=__builtin_amdgcn_mfma_f32_32x32x16_bf16(PAF(2),VFR(2),o[0],0,0,0), C1,0); \
    KRD(GL,3); GAPB(o[1]=__builtin_amdgcn_mfma_f32_32x32x16_bf16(PAF(2),VFR(6),o[1],0,0,0), C1,4); \
    GAPB(o[0]=__builtin_amdgcn_mfma_f32_32x32x16_bf16(PAF(3),VFR(3),o[0],0,0,0), C1,8); \
    GAPB(o[1]=__builtin_amdgcn_mfma_f32_32x32x16_bf16(PAF(3),VFR(7),o[1],0,0,0), C1,12); \
    }while(0)
  int t=1;
  #undef CMASK
  #define CMASK(P0,P1,t) do{}while(0)
  for(;t+5<NT;t+=2){
    STEP(pB0,pB1,pA0,pA1,t,true,true,true);     WAIT_BAR(2); RESC(); ROT();
    STEP(pA0,pA1,pB0,pB1,t+1,true,true,true);   WAIT_BAR(2); RESC(); ROT();
  }
  #undef CMASK
  #define CMASK(P0,P1,t) do{int jb_=(t)-(NT-4); if(jb_>=0)cmask(P0,P1,jb_,wid);}while(0)
  #define ENDW(tt) do{ if((tt)+3<NT){WAIT_BAR(2);} else if((tt)+2<NT){WAIT_BAR(1);} else {WAIT_BAR(0);} }while(0)
  for(;t+1<NT;t+=2){
    STEP(pB0,pB1,pA0,pA1,t,(t+3<NT),(t+1<NT),(t+1<NT));       ENDW(t);   RESC(); ROT();
    STEP(pA0,pA1,pB0,pB1,t+1,(t+4<NT),(t+2<NT),(t+2<NT));     ENDW(t+1); RESC(); ROT();
  }
  STEP(pB0,pB1,pA0,pA1,NT-1,false,false,false); RESC();
  { float sacc=pB0[0]+pB0[1]; _Pragma("unroll") for(int r=2;r<16;++r)sacc+=pB0[r]; _Pragma("unroll") for(int r=0;r<16;++r)sacc+=pB1[r]; l_reg+=sacc;
    pw0=(u32x4){PKW(pB0,0),PKW(pB0,2),PKW(pB0,4),PKW(pB0,6)};pw1=(u32x4){PKW(pB0,8),PKW(pB0,10),PKW(pB0,12),PKW(pB0,14)};pw2=(u32x4){PKW(pB1,0),PKW(pB1,2),PKW(pB1,4),PKW(pB1,6)};pw3=(u32x4){PKW(pB1,8),PKW(pB1,10),PKW(pB1,12),PKW(pB1,14)};
    SBAR(); pv(o,vb0+sl_cur,PAF(0),PAF(1),PAF(2),PAF(3)); }
  #undef PKW
  #undef PAF
  #undef VFR
  #undef PIN
  #undef MX3
  #undef GAPA
  #undef GAPB
  #undef EX
  #undef VRD
  #undef KRD
  #undef STEP
  #undef ENDW
  {auto rr=__builtin_amdgcn_permlane32_swap(__float_as_uint(l_reg),__float_as_uint(l_reg),false,false);l_reg=__uint_as_float(rr[0])+__uint_as_float(rr[1]);}
  if(hi==0)wsf[32+r32]=l_reg;asm volatile("s_waitcnt lgkmcnt(0)":::"memory");
  float rli[16];
  #pragma unroll
  for(int r=0;r<16;++r)rli[r]=__builtin_amdgcn_rcpf(wsf[32+crow(r,hi)]);
  bf16*Ow=O+(rowbase+q0+wid*QBLK)*DM+vcol;
  { bf16*stg=(bf16*)(shm+LDS_OST)+wid*2048;
    #pragma unroll
    for(int r=0;r<16;++r){const int orow=crow(r,hi);
      #pragma unroll
      for(int d0=0;d0<2;++d0)stg[orow*64+d0*32+r32]=__float2bfloat16(o[d0][r]*rli[r]);}
    asm volatile("s_waitcnt lgkmcnt(0)":::"memory");
    #pragma unroll
    for(int i=0;i<4;++i){const int row=i*8+(lane>>3),ch=lane&7; const u32x4 v=*(const u32x4*)(stg+row*64+ch*8); ATTN_STORE16(Ow+(long)row*DM+ch*8,v);} }
  asm volatile("s_waitcnt lgkmcnt(0)\n\ts_barrier":::"memory");
  #undef DMA_K
  #undef DMA_V
  #undef CMASK
  #undef START
  #undef RESC
  #undef ROT
}
constexpr int ATTN_LDS_BYTES=LDS_BYTES;
struct AttnTensors { const bf16* Q; const bf16* K; const bf16* V; bf16* O; };
struct AttnUnit { int var; int qb; };
struct StaticOrder {
  int vcu;
  __device__ __forceinline__ explicit StaticOrder(int v):vcu(v){}
  __device__ __forceinline__ bool next(int i,AttnUnit&u)const{ if(i>=4)return false; const int s=vcu&15; u.var=vcu>>4; u.qb=(i==0)?s:(i==1)?31-s:(i==2)?32+s:63-s; return true; }
};
template<class Sched,int THRL=8> __device__ __forceinline__ void attn_phase(char*lds,const AttnTensors&T,const Sched&S){
  AttnUnit u;
  for(int i=0;S.next(i,u);++i){ const int h=u.var>>2,mp=(u.var>>1)&1,vh=u.var&1;
    attn_unit<THRL>(h*128+mp*64,h*128+vh*64,u.qb,T.Q,T.K,T.V,T.O+(size_t)mp*SEQ*DM,lds); }
}
#undef SBAR
#undef WAIT_BAR
}

#define GAS __attribute__((address_space(1)))
#define LAS __attribute__((address_space(3)))
typedef unsigned short bf16;
typedef unsigned v4u __attribute__((ext_vector_type(4)));
typedef float f32x4 __attribute__((ext_vector_type(4)));
typedef short bf16x8 __attribute__((ext_vector_type(8)));
typedef GAS unsigned gu32;
typedef GAS unsigned long long gu64;
#define RLX_AGENT __ATOMIC_RELAXED, __HIP_MEMORY_SCOPE_AGENT
#define LDS_WAIT() asm volatile("s_waitcnt lgkmcnt(0)" ::: "memory")
#define VM_WAIT() asm volatile("s_waitcnt vmcnt(0)" ::: "memory")
__device__ __forceinline__ unsigned long long rt() { return __builtin_amdgcn_s_memrealtime(); }
__device__ __forceinline__ unsigned f2bf(float f) { unsigned u = __builtin_bit_cast(unsigned, f); return (u + 0x7fffu + ((u >> 16) & 1u)) >> 16; }
__device__ __forceinline__ unsigned pk2(float lo, float hi) { return f2bf(lo) | (f2bf(hi) << 16); }

#define XB_TMO      128
#define XB_XCNT(j)  (256  + 64 * (j))
#define XB_XSUB(j)  (1280 + 64 * (j))
#define XB_XGEN(j)  (2304 + 64 * (j))
#define XB_TOP      3328
#define XB_TOPGEN   3392
#define XCD_BAR_WORDS 3456
#define XB_SPIN_CAP (1u << 18)

__device__ __forceinline__ unsigned xb_ld(unsigned* p)              { return __hip_atomic_load(p, __ATOMIC_RELAXED, __HIP_MEMORY_SCOPE_AGENT); }
__device__ __forceinline__ unsigned xb_add(unsigned* p, unsigned v) { return __hip_atomic_fetch_add(p, v, __ATOMIC_RELAXED, __HIP_MEMORY_SCOPE_AGENT); }
__device__ __forceinline__ unsigned xb_xcc_id() { return (unsigned)__builtin_amdgcn_s_getreg((3 << 11) | 20) & 0xFu; }
#define XB_SPIN(cond, bar) do { unsigned _sp = 0; while (cond) { __builtin_amdgcn_s_sleep(1); \
    if ((++_sp & 255u) == 0u) { if (xb_ld(&(bar)[XB_TMO])) break; if (_sp > XB_SPIN_CAP) { atomicAdd(&(bar)[XB_TMO], 1u); break; } } } } while (0)

struct XcdBarrier {
    unsigned* bar; unsigned x;
    volatile LAS unsigned* st;
};

__device__ __forceinline__ XcdBarrier xcd_barrier_post(unsigned* bar, volatile LAS unsigned* st) {
    XcdBarrier b; b.bar = bar; b.x = xb_xcc_id(); b.st = st;
    if (threadIdx.x == 0) (void)xb_add(&bar[XB_XCNT(b.x)], 1u);
    return b;
}
__device__ __forceinline__ void xcd_barrier_complete(unsigned* bar, unsigned x, unsigned& nloc, unsigned& nx) {
    const unsigned G = gridDim.x * gridDim.y * gridDim.z;
    unsigned sum, cnt, mine, sp = 0u;
    for (;;) {
        sum = 0u; cnt = 0u; mine = 0u;
#pragma unroll
        for (unsigned j = 0; j < 16; ++j) { const unsigned c = xb_ld(&bar[XB_XCNT(j)]); sum += c; cnt += (c > 0u) ? 1u : 0u; mine = (j == x) ? c : mine; }
        if (sum == G) break;
        __builtin_amdgcn_s_sleep(1);
        if ((++sp & 255u) == 0u) { if (xb_ld(&bar[XB_TMO])) break; if (sp > XB_SPIN_CAP) { atomicAdd(&bar[XB_TMO], 1u); break; } }
    }
    nloc = mine > 0u ? mine : 1u; nx = cnt > 0u ? cnt : 1u;
}

__device__ __forceinline__ void xcd_barrier(const XcdBarrier& b) {
    asm volatile("s_waitcnt vmcnt(0)" ::: "memory");
    __syncthreads();
    if (threadIdx.x == 0) {
        unsigned* bar = b.bar;
        __builtin_amdgcn_s_waitcnt(0);
        unsigned nloc = b.st[0], nx = b.st[1];
        if (nloc == 0u) { xcd_barrier_complete(bar, b.x, nloc, nx); b.st[0] = nloc; b.st[1] = nx; }
        const unsigned old = xb_add(&bar[XB_XSUB(b.x)], 1u);
        const unsigned gen = old / nloc;
        if (old + 1u == (gen + 1u) * nloc) {
            __builtin_amdgcn_fence(__ATOMIC_RELEASE, "agent");
            asm volatile("s_waitcnt vmcnt(0)" ::: "memory");
            const unsigned og = xb_add(&bar[XB_TOP], 1u);
            const unsigned tg = og / nx;
            if (og + 1u == (tg + 1u) * nx) xb_add(&bar[XB_TOPGEN], 1u);
            else XB_SPIN(xb_ld(&bar[XB_TOPGEN]) == tg, bar);
            __builtin_amdgcn_fence(__ATOMIC_ACQUIRE, "agent");
            xb_add(&bar[XB_XGEN(b.x)], 1u);
            asm volatile("s_waitcnt vmcnt(0)" ::: "memory");
        } else {
            XB_SPIN(xb_ld(&bar[XB_XGEN(b.x)]) == gen, bar);
            __builtin_amdgcn_fence(__ATOMIC_ACQUIRE, "agent");
            asm volatile("s_waitcnt vmcnt(0)" ::: "memory");
        }
    }
    __syncthreads();
}

constexpr int NWAVES = 8;
constexpr int M = 16384, D = 1024, INC = 2560, AW = 512, LW = 512, NQ = 2048, NEXP = 16384;
constexpr float EPSN = 1e-6f;
constexpr size_t MiB = 1u << 20;
constexpr size_t WS_CTL = 0, CTL_ZERO_BYTES = 1 * MiB;
constexpr size_t WS_ROWSS2 = 512 * 1024;
constexpr size_t WS_RS1 = 1 * MiB;
constexpr size_t WS_SK1 = 1 * MiB + 128 * 1024, WS_SK2 = WS_SK1 + 32 * 1024;
constexpr size_t WS_WIN = 2 * MiB, WS_WOUT = 8 * MiB, WS_WQ = 10 * MiB;
constexpr size_t WS_ED = 16 * MiB, WS_EU = 48 * MiB;
constexpr size_t WS_XB = 80 * MiB;
constexpr size_t WS_OS = 80 * MiB;
constexpr size_t WS_Q2 = 80 * MiB;
constexpr size_t WS_Q = 112 * MiB, WS_SPLIT = 16 * MiB;
constexpr size_t WS_GATE = WS_Q + 4 * WS_SPLIT;
constexpr size_t WS_EID = 144 * MiB, WS_GW = 152 * MiB;
constexpr size_t WS_MIX = 192 * MiB, WS_HB = 224 * MiB, WS_END = 256 * MiB;
constexpr int CW_BAR = 4096;
constexpr int RING_OFF = 0, RING_BYTES = 131072;
constexpr int LDSCTL_OFF = RING_BYTES, MISC_OFF = LDSCTL_OFF + 320;
constexpr int LDS_BYTES = 147456;

struct Frame {
    LAS unsigned char* lds;
    volatile LAS unsigned* MISC;
    int tid, lane, wave;
    int vcu, G;
};

__device__ __forceinline__ float wave_sum(float v) {
#pragma unroll
    for (int o = 1; o < 64; o <<= 1) v += __shfl_xor(v, o);
    return v;
}
__device__ __forceinline__ float bf2f(unsigned short b) { return __builtin_bit_cast(float, (unsigned)b << 16); }
__device__ __forceinline__ float bflo(unsigned w) { return __builtin_bit_cast(float, w << 16); }
__device__ __forceinline__ float bfhi(unsigned w) { return __builtin_bit_cast(float, w & 0xffff0000u); }
__device__ __forceinline__ float gelu_tanh(float x) { const float u = 0.7978845608028654f * (x + 0.044715f * x * x * x); return 0.5f * x * (1.0f + tanhf(u)); }
__device__ __forceinline__ float sigmoidf_(float x) { return 1.0f / (1.0f + expf(-x)); }

__device__ __forceinline__ void p0_transpose_item(const float* W, int K, int N, bf16* WT, const float* gk, LAS float* scr, int item, int lane) {
    const int nblk = N / 32, kb = item / nblk, nb = item % nblk, k0 = 64 * kb, n0 = 32 * nb;
#pragma unroll 8
    for (int i = 0; i < 32; ++i) { const int kk = 2 * i + (lane >> 5); const float g = gk ? gk[k0 + kk] : 1.0f; scr[kk * 33 + (lane & 31)] = W[(size_t)(k0 + kk) * N + n0 + (lane & 31)] * g; }
    LDS_WAIT(); asm volatile("" ::: "memory");
    const int c = lane & 7;
#pragma unroll
    for (int j = 0; j < 4; ++j) { const int n = (lane >> 3) + 8 * j; const LAS float* s = scr + (8 * c) * 33 + n;
        v4u o; o.x = pk2(s[0 * 33], s[1 * 33]); o.y = pk2(s[2 * 33], s[3 * 33]); o.z = pk2(s[4 * 33], s[5 * 33]); o.w = pk2(s[6 * 33], s[7 * 33]);
        *(GAS v4u*)(WT + (size_t)(n0 + n) * K + k0 + 8 * c) = o; }
    LDS_WAIT(); asm volatile("" ::: "memory");
}
__device__ __forceinline__ void p0_row(const float* xrow, bf16* orow, const float* gk, float* rs, int lane) {
    const GAS f32x4* xr = (const GAS f32x4*)xrow + lane;
    f32x4 v[4]; float s = 0.f;
#pragma unroll
    for (int j = 0; j < 4; ++j) { v[j] = xr[64 * j]; s += (v[j].x * v[j].x + v[j].y * v[j].y) + (v[j].z * v[j].z + v[j].w * v[j].w); }
    if (rs) { const float tot = wave_sum(s); if (lane == 0) rs[0] = 1.0f / sqrtf(tot * (1.0f / 1024.0f) + EPSN); }
    if (gk) {
#pragma unroll
        for (int j = 0; j < 4; ++j) v[j] = v[j] * ((const GAS f32x4*)gk)[lane + 64 * j]; }
    GAS unsigned long long* o8 = (GAS unsigned long long*)orow + lane;
#pragma unroll
    for (int j = 0; j < 4; ++j) o8[64 * j] = (unsigned long long)pk2(v[j].x, v[j].y) | ((unsigned long long)pk2(v[j].z, v[j].w) << 32);
}

struct Args { const float* in[23]; float* out; unsigned char* ws; int ph_lo, ph_hi; };

__device__ __forceinline__ void p0_prologue(Frame& F, const Args& a) {
    LAS float* scr = (LAS float*)(F.lds + RING_OFF + F.wave * 16384);
    unsigned char* ws = a.ws;
    const int gw = F.vcu * NWAVES + F.wave, NGW = F.G * NWAVES;
    constexpr int I_IN = (D / 64) * (INC / 32), I_OUT = (D / 64) * (D / 32), I_Q = (D / 64) * (NQ / 32);
    constexpr int NITEMS = I_IN + I_OUT + I_Q;
    for (int it = gw; it < NITEMS; it += NGW) {
        int r = it;
        if (r < I_IN) { p0_transpose_item(a.in[2], D, INC, (bf16*)(ws + WS_WIN), a.in[1], scr, r, F.lane); continue; } r -= I_IN;
        if (r < I_OUT) { p0_transpose_item(a.in[15], D, D, (bf16*)(ws + WS_WOUT), nullptr, scr, r, F.lane); continue; } r -= I_OUT;
        p0_transpose_item(a.in[17], D, NQ, (bf16*)(ws + WS_WQ), a.in[16], scr, r, F.lane);
    }
    constexpr int NROWS = M + 2 * NEXP + 32;
    for (int m = gw; m < NROWS; m += NGW) {
        int r = m;
        if (r < M) { p0_row(a.in[0] + (size_t)r * D, (bf16*)(ws + WS_XB) + (size_t)r * D, nullptr, (float*)(ws + WS_RS1) + r, F.lane); continue; } r -= M;
        if (r < NEXP) { p0_row(a.in[20] + (size_t)r * D, (bf16*)(ws + WS_ED) + (size_t)r * D, a.in[16], nullptr, F.lane); continue; } r -= NEXP;
        if (r < NEXP) { p0_row(a.in[21] + (size_t)r * D, (bf16*)(ws + WS_EU) + (size_t)r * D, nullptr, nullptr, F.lane); continue; } r -= NEXP;
        if (r < 16) { p0_row(a.in[18] + (size_t)r * 1024, (bf16*)(ws + WS_SK1) + (size_t)r * 1024, nullptr, nullptr, F.lane); continue; } r -= 16;
        p0_row(a.in[19] + (size_t)r * 1024, (bf16*)(ws + WS_SK2) + (size_t)r * 1024, nullptr, nullptr, F.lane);
    }
}

__device__ __forceinline__ void lru_local_unit(Frame& F, const Args& a, int c) {
    LAS float* Y = (LAS float*)(F.lds + RING_OFF);
    const int e = F.tid, r0 = c * 64;
    const bf16* XR = (const bf16*)(a.ws + WS_Q + 3 * WS_SPLIT);
    float* HL = a.out; float* AC = a.out + (size_t)M * 512;
    const float* conv_w = a.in[8]; const float cw0 = conv_w[e], cw1 = conv_w[512 + e], cw2 = conv_w[1024 + e], cw3 = conv_w[1536 + e], cb = a.in[9][e];
    float x0 = 0.f, x1 = 0.f, x2 = 0.f;
    if (c > 0) { x0 = bf2f(XR[(size_t)(r0 - 3) * 512 + e]); x1 = bf2f(XR[(size_t)(r0 - 2) * 512 + e]); x2 = bf2f(XR[(size_t)(r0 - 1) * 512 + e]); }
#pragma unroll 8
    for (int t = 0; t < 64; ++t) { const float x3 = bf2f(XR[(size_t)(r0 + t) * 512 + e]); Y[t * 512 + e] = cb + x0 * cw0 + x1 * cw1 + x2 * cw2 + x3 * cw3; x0 = x1; x1 = x2; x2 = x3; }
    __syncthreads();
    const int n = F.wave, el = F.lane;
    const float lam = a.in[14][e];
    const float sp = (lam > 15.f) ? expf(-lam) : log1pf(expf(-lam));
    {
        float wa[64];
        { const float* w_a = a.in[10] + n * 4096; asm volatile("" : "+s"(w_a));
#pragma unroll
          for (int d = 0; d < 64; ++d) wa[d] = w_a[d * 64 + el]; }
        const float ba = a.in[11][e];
#pragma unroll 1
        for (int t = 0; t < 64; ++t) {
            float ra = ba;
            const LAS f32x4* yr = (const LAS f32x4*)(Y + t * 512 + n * 64);
#pragma unroll
            for (int d4 = 0; d4 < 16; ++d4) { const f32x4 yv = yr[d4]; ra += yv.x * wa[4 * d4]; ra += yv.y * wa[4 * d4 + 1]; ra += yv.z * wa[4 * d4 + 2]; ra += yv.w * wa[4 * d4 + 3]; }
            AC[(size_t)(r0 + t) * 512 + e] = -8.0f * sigmoidf_(ra) * sp;
        }
    }
    {
        float wx[64];
        { const float* w_x = a.in[12] + n * 4096; asm volatile("" : "+s"(w_x));
#pragma unroll
          for (int d = 0; d < 64; ++d) wx[d] = w_x[d * 64 + el]; }
        const float bx = a.in[13][e];
        float h = 0.f, ac = 1.f;
#pragma unroll 1
        for (int t = 0; t < 64; ++t) {
            float ia = bx;
            const LAS f32x4* yr = (const LAS f32x4*)(Y + t * 512 + n * 64);
#pragma unroll
            for (int d4 = 0; d4 < 16; ++d4) { const f32x4 yv = yr[d4]; ia += yv.x * wx[4 * d4]; ia += yv.y * wx[4 * d4 + 1]; ia += yv.z * wx[4 * d4 + 2]; ia += yv.w * wx[4 * d4 + 3]; }
            const float ig = sigmoidf_(ia);
            const float log_a = AC[(size_t)(r0 + t) * 512 + e], av = expf(log_a), mult = sqrtf(fmaxf(-expm1f(2.0f * log_a), 1e-12f));
            const float b = mult * (ig * Y[t * 512 + e]);
            h = av * h + b; ac *= av;
            HL[(size_t)(r0 + t) * 512 + e] = h; AC[(size_t)(r0 + t) * 512 + e] = ac;
        }
    }
    __syncthreads();
}

__device__ __forceinline__ void fix_unit(Frame& F, const Args& a, int c, float lamv) {
    const int e = F.tid, r0 = c * 64;
    const float* HL = a.out; const float* AC = a.out + (size_t)M * 512;
    const bf16* GATE = (const bf16*)(a.ws + WS_GATE);
    bf16* MIX = (bf16*)(a.ws + WS_MIX);
    float hin = 0.f;
    for (int cc = 0; cc < c; ++cc) { const size_t o = (size_t)(cc * 64 + 63) * 512 + e; hin = AC[o] * hin + HL[o]; }
#pragma unroll 4
    for (int t = 0; t < 64; ++t) { const size_t o = (size_t)(r0 + t) * 512 + e; const float h = HL[o] + AC[o] * hin; const float g = bf2f(GATE[o]);
        MIX[(size_t)(r0 + t) * 1024 + 512 + e] = (bf16)f2bf(h * gelu_tanh(g)); }
    const bf16* OS0 = (const bf16*)(a.ws + WS_OS); const bf16* OS1 = OS0 + (size_t)M * 512;
    const float* sg = a.in[7] + (F.lane & 15) * 8;
    float sgv[8];
#pragma unroll
    for (int j = 0; j < 8; ++j) sgv[j] = sg[j] * 0.8f;
#pragma unroll 2
    for (int rr = 0; rr < 8; ++rr) { const size_t row = (size_t)(r0 + 8 * F.wave + rr);
        const v4u p = *(const GAS v4u*)(OS0 + row * 512 + F.lane * 8), q = *(const GAS v4u*)(OS1 + row * 512 + F.lane * 8);
        float d[8];
        d[0] = bflo(p.x) - lamv * bflo(q.x); d[1] = bfhi(p.x) - lamv * bfhi(q.x); d[2] = bflo(p.y) - lamv * bflo(q.y); d[3] = bfhi(p.y) - lamv * bfhi(q.y);
        d[4] = bflo(p.z) - lamv * bflo(q.z); d[5] = bfhi(p.z) - lamv * bfhi(q.z); d[6] = bflo(p.w) - lamv * bflo(q.w); d[7] = bfhi(p.w) - lamv * bfhi(q.w);
        float ss = 0.f;
#pragma unroll
        for (int j = 0; j < 8; ++j) ss += d[j] * d[j];
        ss += __shfl_xor(ss, 1); ss += __shfl_xor(ss, 2); ss += __shfl_xor(ss, 4); ss += __shfl_xor(ss, 8);
        const float ri = 1.0f / sqrtf(ss * (1.0f / 128.0f) + EPSN);
        v4u o; o.x = pk2(d[0] * ri * sgv[0], d[1] * ri * sgv[1]); o.y = pk2(d[2] * ri * sgv[2], d[3] * ri * sgv[3]);
        o.z = pk2(d[4] * ri * sgv[4], d[5] * ri * sgv[5]); o.w = pk2(d[6] * ri * sgv[6], d[7] * ri * sgv[7]);
        *(GAS v4u*)(MIX + row * 1024 + F.lane * 8) = o; }
}

typedef float f32x16 __attribute__((ext_vector_type(16)));
#define CEX(a, b) do { const float _hi = fmaxf(a, b), _lo = fminf(a, b); a = _hi; b = _lo; } while (0)
__device__ __forceinline__ void top16_half(float (&top)[16], const bf16* q, const bf16* sk, int r32, int hi) {
    bf16x8 qf[8];
#pragma unroll
    for (int ks = 0; ks < 8; ++ks) qf[ks] = *(const GAS bf16x8*)(q + 16 * ks + 8 * hi);
#pragma unroll
    for (int i = 0; i < 16; ++i) top[i] = -INFINITY;
#pragma unroll
    for (int kt = 0; kt < 4; ++kt) {
        f32x16 acc = {};
#pragma unroll
        for (int ks = 0; ks < 8; ++ks) { const bf16x8 kf = *(const GAS bf16x8*)(sk + (size_t)(32 * kt + r32) * 128 + 16 * ks + 8 * hi); acc = __builtin_amdgcn_mfma_f32_32x32x16_bf16(kf, qf[ks], acc, 0, 0, 0); }
#pragma unroll
        for (int r = 0; r < 16; ++r) { const unsigned idx = (unsigned)(32 * kt + (r & 3) + 8 * (r >> 2)) + 4u * (unsigned)hi;
            float v = __builtin_bit_cast(float, (__builtin_bit_cast(unsigned, acc[r]) & ~127u) | idx);
#pragma unroll
            for (int i = 0; i < 16; ++i) CEX(top[i], v); }
    }
    float oth[16];
#pragma unroll
    for (int i = 0; i < 16; ++i) oth[i] = __shfl_xor(top[i], 32);
#pragma unroll
    for (int i = 0; i < 16; ++i) top[i] = fmaxf(top[i], oth[15 - i]);
#pragma unroll
    for (int st = 8; st >= 1; st >>= 1)
#pragma unroll
        for (int i = 0; i < 16; ++i) if ((i & st) == 0) CEX(top[i], top[i + st]);
}
__device__ __forceinline__ void route_unit(const Args& a, int g, int hd, int lane, LAS unsigned char* slot) {
    const int r32 = lane & 31, hi = lane >> 5; const int t = g * 32 + r32;
    const bf16* q = (const bf16*)(a.ws + WS_Q2) + (size_t)t * NQ + hd * 256;
    float v1[16], v2[16];
    top16_half(v1, q, (const bf16*)(a.ws + WS_SK1), r32, hi);
    top16_half(v2, q + 128, (const bf16*)(a.ws + WS_SK2), r32, hi);
    { v4u w1, w2;
#define IDX4(v, j) ((__builtin_bit_cast(unsigned, v[4 * (j)]) & 127u) | ((__builtin_bit_cast(unsigned, v[4 * (j) + 1]) & 127u) << 8) | ((__builtin_bit_cast(unsigned, v[4 * (j) + 2]) & 127u) << 16) | ((__builtin_bit_cast(unsigned, v[4 * (j) + 3]) & 127u) << 24))
      w1 = (v4u){IDX4(v1, 0), IDX4(v1, 1), IDX4(v1, 2), IDX4(v1, 3)}; w2 = (v4u){IDX4(v2, 0), IDX4(v2, 1), IDX4(v2, 2), IDX4(v2, 3)};
#undef IDX4
      *(LAS v4u*)(slot) = w1; *(LAS v4u*)(slot + 16) = w2; }
    float K[16];
#pragma unroll
    for (int i = 0; i < 16; ++i) K[i] = -INFINITY;
#pragma unroll
    for (int ia = 0; ia < 16; ++ia)
#pragma unroll
        for (int ib = 0; ib < 16; ++ib) if ((ia + 1) * (ib + 1) <= 16) {
            float k = __builtin_bit_cast(float, (__builtin_bit_cast(unsigned, v1[ia] + v2[ib]) & ~255u) | (unsigned)(ia * 16 + ib));
#pragma unroll
            for (int i = 0; i < 16; ++i) CEX(K[i], k);
        }
    unsigned P[16];
#pragma unroll
    for (int i = 0; i < 16; ++i) { const unsigned ci = __builtin_bit_cast(unsigned, K[i]) & 255u; const unsigned i1 = slot[ci >> 4], i2 = slot[16 + (ci & 15u)]; P[i] = i1 * 128u + i2; }
    float ex[16], sum = 0.f;
#pragma unroll
    for (int i = 0; i < 16; ++i) { ex[i] = expf(K[i] - K[0]); sum += ex[i]; }
    const float inv = 1.0f / sum;
    if (hi == 0) {
        GAS v4u* eo = (GAS v4u*)((int*)(a.ws + WS_EID) + (size_t)t * 128 + hd * 16); GAS f32x4* go = (GAS f32x4*)((float*)(a.ws + WS_GW) + (size_t)t * 128 + hd * 16);
#pragma unroll
        for (int j = 0; j < 4; ++j) { eo[j] = (v4u){P[4 * j], P[4 * j + 1], P[4 * j + 2], P[4 * j + 3]}; go[j] = (f32x4){ex[4 * j] * inv, ex[4 * j + 1] * inv, ex[4 * j + 2] * inv, ex[4 * j + 3] * inv}; }
    }
}


__device__ __forceinline__ float wave_max(float v) {
#pragma unroll
    for (int o = 1; o < 64; o <<= 1) v = fmaxf(v, __shfl_xor(v, o));
    return v;
}
__device__ __forceinline__ void route_unit_ref(const Args& a, int t, int hd, int lane, LAS float* sc) {
    LAS unsigned* sci = (LAS unsigned*)sc;
    const bf16* q = (const bf16*)(a.ws + WS_Q2) + (size_t)t * NQ + hd * 256;
#pragma unroll 1
    for (int half = 0; half < 2; ++half) {
        const float* sk = a.in[18 + half];
        float sa = 0.f, sb = 0.f;
        for (int d = 0; d < 128; ++d) { const float qv = bf2f(q[half * 128 + d]); sa += qv * sk[lane * 128 + d]; sb += qv * sk[(lane + 64) * 128 + d]; }
        for (int r = 0; r < 16; ++r) {
            const float mx = wave_max(fmaxf(sa, sb));
            const unsigned long long ba = __ballot(sa == mx), bb = __ballot(sb == mx);
            int key;
            if (ba) { const int ln = __ffsll((long long)ba) - 1; key = ln; if (lane == ln) sa = -INFINITY; }
            else { const int ln = __ffsll((long long)bb) - 1; key = ln + 64; if (lane == ln) sb = -INFINITY; }
            if (lane == 0) { sc[half * 32 + r] = mx; sci[half * 32 + 16 + r] = (unsigned)key; }
        }
    }
    __builtin_amdgcn_s_waitcnt(0);
    const int ca = lane >> 2, cb0 = (lane & 3) * 4;
    float c[4];
#pragma unroll
    for (int j = 0; j < 4; ++j) c[j] = sc[ca] + sc[32 + cb0 + j];
    for (int r = 0; r < 16; ++r) {
        const float mx = wave_max(fmaxf(fmaxf(c[0], c[1]), fmaxf(c[2], c[3])));
        const bool mine = (c[0] == mx) || (c[1] == mx) || (c[2] == mx) || (c[3] == mx);
        const unsigned long long bm = __ballot(mine); const int ln = __ffsll((long long)bm) - 1;
        if (lane == ln) { int j = (c[0] == mx) ? 0 : (c[1] == mx) ? 1 : (c[2] == mx) ? 2 : 3;
            if (j == 0) c[0] = -INFINITY; else if (j == 1) c[1] = -INFINITY; else if (j == 2) c[2] = -INFINITY; else c[3] = -INFINITY;
            sc[64 + r] = mx; sci[80 + r] = sci[16 + ca] * 128u + sci[48 + cb0 + j]; }
    }
    __builtin_amdgcn_s_waitcnt(0);
    if (lane < 16) {
        const float mx0 = sc[64]; const float ex = expf(sc[64 + lane] - mx0); float sum = ex;
        sum += __shfl_xor(sum, 1); sum += __shfl_xor(sum, 2); sum += __shfl_xor(sum, 4); sum += __shfl_xor(sum, 8);
        ((int*)(a.ws + WS_EID))[(size_t)t * 128 + hd * 16 + lane] = (int)sci[80 + lane];
        ((float*)(a.ws + WS_GW))[(size_t)t * 128 + hd * 16 + lane] = ex / sum;
    }
    __builtin_amdgcn_s_waitcnt(0);
}

__device__ __forceinline__ void unpack8(const v4u w, float* f) { f[0] = bflo(w.x); f[1] = bfhi(w.x); f[2] = bflo(w.y); f[3] = bfhi(w.y); f[4] = bflo(w.z); f[5] = bfhi(w.z); f[6] = bflo(w.w); f[7] = bfhi(w.w); }
__device__ __forceinline__ void gather_token(const Args& a, int t, int lane) {
    const bf16* HB = (const bf16*)(a.ws + WS_HB) + (size_t)t * D; const bf16* ED = (const bf16*)(a.ws + WS_ED); const bf16* EU = (const bf16*)(a.ws + WS_EU);
    float hx[16];
    unpack8(*(const GAS v4u*)(HB + lane * 8), hx); unpack8(*(const GAS v4u*)(HB + 512 + lane * 8), hx + 8);
    const float rs2 = 1.0f / sqrtf(((const float*)(a.ws + WS_ROWSS2))[t] * (1.0f / 1024.0f) + EPSN);
    const int* EID = (const int*)(a.ws + WS_EID) + (size_t)t * 128; const float* GW = (const float*)(a.ws + WS_GW) + (size_t)t * 128;
    const int e0 = EID[lane], e1 = EID[64 + lane]; const float g0 = GW[lane], g1 = GW[64 + lane];
    float acc[16];
#pragma unroll
    for (int i = 0; i < 16; ++i) acc[i] = 0.f;
#pragma unroll 1
    for (int j = 0; j < 128; j += 4) {
        int ee[4]; float gg[4], dt[4];
#pragma unroll
        for (int k = 0; k < 4; ++k) { const int jj = j + k; ee[k] = __shfl(jj < 64 ? e0 : e1, jj & 63); gg[k] = __shfl(jj < 64 ? g0 : g1, jj & 63); }
        v4u da[4], db[4];
#pragma unroll
        for (int k = 0; k < 4; ++k) { const bf16* r = ED + (size_t)ee[k] * D; da[k] = *(const GAS v4u*)(r + lane * 8); db[k] = *(const GAS v4u*)(r + 512 + lane * 8); }
#pragma unroll
        for (int k = 0; k < 4; ++k) { float f[16]; unpack8(da[k], f); unpack8(db[k], f + 8); float s = 0.f;
#pragma unroll
            for (int i = 0; i < 16; ++i) s += f[i] * hx[i];
            dt[k] = s; }
#pragma unroll
        for (int o = 1; o < 64; o <<= 1) {
#pragma unroll
            for (int k = 0; k < 4; ++k) dt[k] += __shfl_xor(dt[k], o); }
#pragma unroll
        for (int k = 0; k < 4; ++k) { const bf16* r = EU + (size_t)ee[k] * D; da[k] = *(const GAS v4u*)(r + lane * 8); db[k] = *(const GAS v4u*)(r + 512 + lane * 8); }
#pragma unroll
        for (int k = 0; k < 4; ++k) { const float w = gg[k] * gelu_tanh(dt[k] * rs2); float f[16]; unpack8(da[k], f); unpack8(db[k], f + 8);
#pragma unroll
            for (int i = 0; i < 16; ++i) acc[i] += w * f[i]; }
    }
    float* orow = a.out + (size_t)t * D; const float* gf = a.in[22];
    f32x4 h0 = *(const GAS f32x4*)(orow + lane * 8), h1 = *(const GAS f32x4*)(orow + lane * 8 + 4), h2 = *(const GAS f32x4*)(orow + 512 + lane * 8), h3 = *(const GAS f32x4*)(orow + 512 + lane * 8 + 4);
    h0 += (f32x4){acc[0], acc[1], acc[2], acc[3]}; h1 += (f32x4){acc[4], acc[5], acc[6], acc[7]}; h2 += (f32x4){acc[8], acc[9], acc[10], acc[11]}; h3 += (f32x4){acc[12], acc[13], acc[14], acc[15]};
    float ss = (h0.x * h0.x + h0.y * h0.y) + (h0.z * h0.z + h0.w * h0.w) + (h1.x * h1.x + h1.y * h1.y) + (h1.z * h1.z + h1.w * h1.w)
             + (h2.x * h2.x + h2.y * h2.y) + (h2.z * h2.z + h2.w * h2.w) + (h3.x * h3.x + h3.y * h3.y) + (h3.z * h3.z + h3.w * h3.w);
    ss = wave_sum(ss);
    const float ri = 1.0f / sqrtf(ss * (1.0f / 1024.0f) + EPSN);
    const f32x4 f0 = *(const GAS f32x4*)(gf + lane * 8), f1 = *(const GAS f32x4*)(gf + lane * 8 + 4), f2 = *(const GAS f32x4*)(gf + 512 + lane * 8), f3 = *(const GAS f32x4*)(gf + 512 + lane * 8 + 4);
    *(GAS f32x4*)(orow + lane * 8) = h0 * ri * f0; *(GAS f32x4*)(orow + lane * 8 + 4) = h1 * ri * f1;
    *(GAS f32x4*)(orow + 512 + lane * 8) = h2 * ri * f2; *(GAS f32x4*)(orow + 512 + lane * 8 + 4) = h3 * ri * f3;
}

__device__ __forceinline__ float a_dot64(const float* p, const float* q, int lane) { return wave_sum(p[lane] * q[lane]); }
constexpr int N_PHASES = 8;
#ifndef ROUTE_REF
#define ROUTE_REF 1
#endif
#ifndef MK_ONE_LAUNCH
#define MK_ONE_LAUNCH 0
#endif
__global__ void __launch_bounds__(NWAVES * 64, 2) fwd_mega(Args args) {
    extern __shared__ __attribute__((aligned(16))) unsigned char lds[];
    Frame F;
    F.lds = (LAS unsigned char*)lds;
    F.MISC = (volatile LAS unsigned*)(F.lds + MISC_OFF);
    F.tid = threadIdx.x; F.lane = F.tid & 63; F.wave = __builtin_amdgcn_readfirstlane(F.tid >> 6);
    F.G = gridDim.x; { const int bx = blockIdx.x; F.vcu = (F.G % 8 == 0) ? (bx % 8) * (F.G / 8) + bx / 8 : bx; }
    unsigned char* ws = args.ws;
    const int lo = args.ph_lo, hi = args.ph_hi;
#ifndef PH_MASK
#define PH_MASK 0xff
#endif
#define IN(k) (((PH_MASK >> (k)) & 1) && lo <= (k) && (k) < hi)
#define BOTH(k) (IN(k) && IN((k) + 1))
#if MK_ONE_LAUNCH
#define GRID_BAR() do { __threadfence(); cooperative_groups::this_grid().sync(); } while (0)
#else
#define GRID_BAR() do { } while (0)
#endif
    if (IN(0)) { p0_prologue(F, args); if (BOTH(0)) GRID_BAR(); }
    if (IN(1)) {
        pg8::Gemm g{(const pg8::bf16_t*)(ws + WS_XB), (const pg8::bf16_t*)(ws + WS_WIN), M, INC, D}; pg8::StaticOrder S; S.init(M, INC, F.G, (int)blockIdx.x);
        pg8::EpiBf16<1> E{(pg8::bf16_t*)(ws + WS_Q), 512, (const float*)(ws + WS_RS1), 512, (size_t)WS_SPLIT / 2, attn_body::C2};
        pg8::gemm_phase<pg8::EpiBf16<1>, pg8::StaticOrder, true, true>(F.lds + RING_OFF, g, S, E);
        if (BOTH(1)) GRID_BAR();
    }
    if (IN(2)) {
        for (int c = F.vcu; c < M / 64; c += F.G) lru_local_unit(F, args, c);
        const attn_body::AttnTensors AT{(const attn_body::bf16*)(ws + WS_Q), (const attn_body::bf16*)(ws + WS_Q + WS_SPLIT), (const attn_body::bf16*)(ws + WS_Q + 2 * WS_SPLIT), (attn_body::bf16*)(ws + WS_OS)};
        const attn_body::StaticOrder S(F.vcu);
        attn_body::attn_phase<attn_body::StaticOrder>((char*)lds + RING_OFF, AT, S);
        if (BOTH(2)) GRID_BAR();
    }
    if (IN(3)) {
        float l1 = a_dot64(args.in[3], args.in[4], F.lane), l2 = a_dot64(args.in[5], args.in[6], F.lane);
        const float lamv = expf(l1) - expf(l2) + 0.2f;
        for (int c = F.vcu; c < M / 64; c += F.G) fix_unit(F, args, c, lamv);
        if (BOTH(3)) GRID_BAR();
    }
    if (IN(4)) {
        pg8::Gemm g{(const pg8::bf16_t*)(ws + WS_MIX), (const pg8::bf16_t*)(ws + WS_WOUT), M, D, D}; pg8::StaticOrder S; S.init(M, D, F.G, (int)blockIdx.x);
        pg8::EpiResid E{args.in[0], args.out, (pg8::bf16_t*)(ws + WS_HB), (float*)(ws + WS_ROWSS2), D};
        pg8::gemm_phase<pg8::EpiResid, pg8::StaticOrder, true, true>(F.lds + RING_OFF, g, S, E);
        if (BOTH(4)) GRID_BAR();
    }
    if (IN(5)) {
        pg8::Gemm g{(const pg8::bf16_t*)(ws + WS_HB), (const pg8::bf16_t*)(ws + WS_WQ), M, NQ, D}; pg8::StaticOrder S; S.init(M, NQ, F.G, (int)blockIdx.x);
        pg8::EpiBf16<2> E{(pg8::bf16_t*)(ws + WS_Q2), NQ, (const float*)(ws + WS_ROWSS2), 0, 0, 1.f};
        pg8::gemm_phase<pg8::EpiBf16<2>, pg8::StaticOrder, true, true>(F.lds + RING_OFF, g, S, E);
        if (BOTH(5)) GRID_BAR();
    }
    if (IN(6)) {
        const int gw = F.vcu * NWAVES + F.wave, NGW = F.G * NWAVES;
#if ROUTE_REF
        for (int u = gw; u < M * 8; u += NGW) route_unit_ref(args, u >> 3, u & 7, F.lane, (LAS float*)(F.lds + RING_OFF) + F.wave * 128);
#else
        for (int u = gw; u < (M / 32) * 8; u += NGW) route_unit(args, u >> 3, u & 7, F.lane, F.lds + RING_OFF + F.tid * 32);
#endif
        if (BOTH(6)) GRID_BAR();
    }
    if (IN(7)) {
        const int gw = F.vcu * NWAVES + F.wave, NGW = F.G * NWAVES;
        for (int t = gw; t < M; t += NGW) gather_token(args, t, F.lane);
    }
#undef IN
#undef BOTH
}

extern "C" void kernel_launch(void* const* d_in, const int* in_sizes, int n_in, void* d_out, int out_size, void* d_ws, size_t ws_size, hipStream_t stream) {
    static int grid = 0;
    if (grid == 0) {
        if (n_in != 23 || out_size != M * D || ws_size < WS_END) { fprintf(stderr, "kernel_launch: unexpected problem: n_in %d out %d ws %zu\n", n_in, out_size, ws_size); grid = -1; return; }
        int dev = 0, cus = 0, per_cu = 0;
        if (hipGetDevice(&dev) != hipSuccess || hipDeviceGetAttribute(&cus, hipDeviceAttributeMultiprocessorCount, dev) != hipSuccess) { grid = -1; return; }
        if (hipFuncSetAttribute((const void*)fwd_mega, hipFuncAttributeMaxDynamicSharedMemorySize, LDS_BYTES) != hipSuccess) { fprintf(stderr, "kernel_launch: hipFuncSetAttribute failed\n"); grid = -1; return; }
        if (hipOccupancyMaxActiveBlocksPerMultiprocessor(&per_cu, (const void*)fwd_mega, NWAVES * 64, LDS_BYTES) != hipSuccess || per_cu < 1) { fprintf(stderr, "kernel_launch: occupancy query reports %d\n", per_cu); per_cu = 1; }
        (void)hipGetLastError();
        grid = cus;
    }
    if (grid < 0) return;
    (void)hipMemsetAsync((char*)d_ws + WS_CTL, 0, CTL_ZERO_BYTES, stream);
    Args a{};
    for (int i = 0; i < 23; ++i) a.in[i] = (const float*)d_in[i];
    a.out = (float*)d_out; a.ws = (unsigned char*)d_ws;
#if MK_ONE_LAUNCH
    a.ph_lo = 0; a.ph_hi = N_PHASES;
    void* kargs[] = {&a};
    hipError_t e = hipLaunchCooperativeKernel((const void*)fwd_mega, dim3(grid), dim3(NWAVES * 64), kargs, LDS_BYTES, stream);
    if (e != hipSuccess) fprintf(stderr, "cooperative launch failed: %s (grid %d)\n", hipGetErrorString(e), grid);
#else
    for (int p = 0; p < N_PHASES; ++p) { a.ph_lo = p; a.ph_hi = p + 1; hipLaunchKernelGGL(fwd_mega, dim3(grid), dim3(NWAVES * 64), LDS_BYTES, stream, a); }
#endif
}
```

```cpp
#include <hip/hip_runtime.h>
#include <hip/hip_cooperative_groups.h>
#include <cstdio>
#include <cstdint>
namespace pg8 {
#define PG8_LAS __attribute__((address_space(3)))
typedef unsigned short bf16_t;
typedef short bf16x8 __attribute__((ext_vector_type(8)));
typedef float f32x4 __attribute__((ext_vector_type(4)));
typedef unsigned u32x4 __attribute__((ext_vector_type(4)));
constexpr int BM = 256, BK = 64, HALF = 128, HTB = HALF * BK * 2  , STAGE_BYTES = 8 * HTB, NXCD = 8, WGM = 8;

__host__ __device__ __forceinline__ int lds_byte(int r, int c) { const int st = (r >> 4) * 2 + (c >> 5), rr = r & 15, cc = c & 31, ob = rr * 64 + cc * 2; return st * 1024 + (ob ^ (((ob >> 9) & 1) << 5)); }
__host__ __device__ __forceinline__ void stage_rc(int b, int& R, int& C) { const int st = b / 1024, sb = b % 1024, swz = sb ^ (((sb >> 9) & 1) << 5); R = (st >> 1) * 16 + swz / 64; C = (st & 1) * 32 + (swz % 64) / 2; }
__host__ __device__ __forceinline__ int perm32(int rho) { const int n = rho >> 4, i = rho & 15; return 8 * (i >> 2) + 4 * n + (i & 3); }

struct Unit { int pm, pn; };
struct Gemm { const bf16_t* A; const bf16_t* Bt; int M, N, K; };

struct StaticOrder {
    int nM, nN, nwg, G, c;
    __host__ __device__ void init(int M, int N, int G_, int c_) { nM = M / BM; nN = N / BM; nwg = nM * nN; G = G_; c = c_; }
    __host__ __device__ bool next(int i, Unit& u) const {
        const long L = (long)i * G + c; if (L >= nwg) return false;
        int wgid = (int)L; { const int q = nwg / NXCD, r = nwg % NXCD, xcd = wgid % NXCD, off = wgid / NXCD; wgid = (xcd < r ? xcd * (q + 1) : r * (q + 1) + (xcd - r) * q) + off; }
        const int nig = WGM * nN, gid = wgid / nig, fm = gid * WGM, gsz = (nM - fm) < WGM ? (nM - fm) : WGM;
        u.pm = fm + ((wgid % nig) % gsz); u.pn = (wgid % nig) / gsz; return true;
    }
    __device__ __forceinline__ void a_ready(const Unit&) const {}
    __device__ __forceinline__ void done(const Unit&) const {}
};

__device__ __forceinline__ unsigned cvt_pk_bf16(float lo, float hi) { unsigned r; asm volatile("v_cvt_pk_bf16_f32 %0, %1, %2" : "=v"(r) : "v"(lo), "v"(hi)); return r; }
typedef float f32x2 __attribute__((ext_vector_type(2)));

template <int RSMODE> struct EpiBf16 {
    static constexpr bool PERM = true, AFTER_DRAIN = false;
    bf16_t* O; int ldc; const float* rowscale; int split_cols; size_t split_stride; float scale0;
    __device__ __forceinline__ void operator()(const f32x4 (&acc)[2][2][4][2], const Unit& u, int wr, int wc, int fr, int fq) const {
        const int row0 = u.pm * BM + wr * 64 + fr; int colt = u.pn * BM; bf16_t* base = O;
        float sc = 1.f; if (split_cols) { const int t = colt / split_cols; base += (size_t)t * split_stride; colt -= t * split_cols; if (t == 0) sc = scale0; }
        const int col0 = colt + wc * 32 + 8 * fq;
#pragma unroll
        for (int ai = 0; ai < 2; ++ai)
#pragma unroll
            for (int m = 0; m < 4; ++m) { const int row = row0 + ai * HALF + m * 16; bf16_t* rowp = base + (size_t)row * ldc + col0;
                float rs = sc;
                if (RSMODE == 1) rs *= rowscale[row];
                if (RSMODE == 2) rs *= 1.0f / sqrtf(rowscale[row] * (1.0f / 1024.0f) + 1e-6f);
#pragma unroll
                for (int bj = 0; bj < 2; ++bj) { f32x4 v0 = acc[ai][bj][m][0] * rs, v1 = acc[ai][bj][m][1] * rs;
                    u32x4 w; w.x = cvt_pk_bf16(v0[0], v0[1]); w.y = cvt_pk_bf16(v0[2], v0[3]); w.z = cvt_pk_bf16(v1[0], v1[1]); w.w = cvt_pk_bf16(v1[2], v1[3]);
                    *(u32x4*)(rowp + bj * HALF) = w; } }
    }
};

struct EpiResid {
    static constexpr bool PERM = false, AFTER_DRAIN = false;
    const float* X; float* Hf; bf16_t* Hb; float* rowss; int ldc;
    __device__ __forceinline__ void operator()(const f32x4 (&acc)[2][2][4][2], const Unit& u, int wr, int wc, int fr, int fq) const {
        typedef unsigned u32x2v __attribute__((ext_vector_type(2)));
        const int col0 = u.pn * BM + wc * 32 + 4 * fq;
#pragma unroll
        for (int ai = 0; ai < 2; ++ai)
#pragma unroll
            for (int m = 0; m < 4; ++m) { const int row = u.pm * BM + ai * HALF + wr * 64 + m * 16 + fr; const size_t off = (size_t)row * ldc + col0; float ss = 0.f;
#pragma unroll
                for (int bj = 0; bj < 2; ++bj)
#pragma unroll
                    for (int n = 0; n < 2; ++n) { const f32x4 xv = *(const f32x4*)(X + off + bj * HALF + n * 16); const f32x4 h = xv + acc[ai][bj][m][n];
                        *(f32x4*)(Hf + off + bj * HALF + n * 16) = h; u32x2v w; w.x = cvt_pk_bf16(h[0], h[1]); w.y = cvt_pk_bf16(h[2], h[3]);
                        *(u32x2v*)(Hb + off + bj * HALF + n * 16) = w; ss += (h[0] * h[0] + h[1] * h[1]) + (h[2] * h[2] + h[3] * h[3]); }
                ss += __shfl_xor(ss, 16); ss += __shfl_xor(ss, 32);
                if (fq == 0) atomicAdd(rowss + row, ss); }
    }
};

template <class Epi, class Sched, bool ALIGN_EPI = false, bool SP2 = false>
__device__ __forceinline__ void gemm_phase(PG8_LAS unsigned char* lds, const Gemm g, const Sched& S, const Epi& E) {
    const int tid = threadIdx.x, wid = __builtin_amdgcn_readfirstlane(tid >> 6), lane = tid & 63, wr = wid >> 2, wc = wid & 3, fr = lane & 15, fq = lane >> 4;
    const int K = g.K, nt = K / BK;
    unsigned voffA[2], voffB[2];
#pragma unroll
    for (int i = 0; i < 2; ++i) { int R, C; stage_rc(tid * 16 + i * 8192, R, C); const int Rb = Epi::PERM ? ((R & ~31) + perm32(R & 31)) : R;
        voffA[i] = (unsigned)(R * K + C) * 2u; voffB[i] = (unsigned)(Rb * K + C) * 2u; }
    const size_t kstep = (size_t)(BK * 2);
    const size_t hstep = (size_t)HALF * K * 2;
    const size_t tstep = 2 * hstep;
    const unsigned ldsw = (unsigned)wid * 1024u;
    const int aoff = lds_byte(wr * 64 + fr, fq * 8), boff = lds_byte(wc * 32 + fr, fq * 8);
#define PG8_SA(b, h) (((b) * 2 + (h)) * HTB)
#define PG8_SB(b, h) ((4 + (b) * 2 + (h)) * HTB)
#define PG8_STAGE(bufoff, gbase, voff) do { _Pragma("unroll") for (int _i = 0; _i < 2; ++_i) \
        __builtin_amdgcn_global_load_lds((const unsigned*)((const char*)(gbase) + (voff)[_i]), (PG8_LAS unsigned*)(lds + (bufoff) + ldsw + _i * 8192), 16, 0, 0); } while (0)
#define PG8_LDA(dst, b, h) do { _Pragma("unroll") for (int m = 0; m < 4; ++m) _Pragma("unroll") for (int k = 0; k < 2; ++k) dst[m][k] = *(const PG8_LAS bf16x8*)(lds + PG8_SA(b, h) + aoff + m * 2048 + k * 1024); } while (0)
#define PG8_LDB(dst, b, h) do { _Pragma("unroll") for (int n = 0; n < 2; ++n) _Pragma("unroll") for (int k = 0; k < 2; ++k) dst[n][k] = *(const PG8_LAS bf16x8*)(lds + PG8_SB(b, h) + boff + n * 2048 + k * 1024); } while (0)
#define PG8_MMA(ai, bj, At, Bt) do { __builtin_amdgcn_s_setprio(1); _Pragma("unroll") for (int m = 0; m < 4; ++m) _Pragma("unroll") for (int n = 0; n < 2; ++n) _Pragma("unroll") for (int k = 0; k < 2; ++k) \
        acc[ai][bj][m][n] = __builtin_amdgcn_mfma_f32_16x16x32_bf16(Bt[n][k], At[m][k], acc[ai][bj][m][n], 0, 0, 0); __builtin_amdgcn_s_setprio(0); } while (0)
#define PG8_WAIT_V(n) asm volatile("s_waitcnt vmcnt(" #n ")" ::: "memory")
#define PG8_WAIT_L(n) asm volatile("s_waitcnt lgkmcnt(" #n ")" ::: "memory")
#define PG8_BAR __builtin_amdgcn_s_barrier()
#define PG8_SCHED __builtin_amdgcn_sched_barrier(0)
    Unit cur, nxt; int ui = 0;
    if (!S.next(0, cur)) return;
    f32x4 acc[2][2][4][2];
#pragma unroll
    for (int a = 0; a < 2; ++a)
#pragma unroll
        for (int b = 0; b < 2; ++b)
#pragma unroll
            for (int m = 0; m < 4; ++m)
#pragma unroll
                for (int n = 0; n < 2; ++n) acc[a][b][m][n] = (f32x4){0.f, 0.f, 0.f, 0.f};
    bf16x8 At[4][2], B0[2][2], B1[2][2];
    const char* cA = (const char*)g.A + (size_t)cur.pm * tstep; const char* cB = (const char*)g.Bt + (size_t)cur.pn * tstep;
    S.a_ready(cur);
    if constexpr (SP2) {
        PG8_STAGE(PG8_SB(0, 0), cB, voffB); PG8_STAGE(PG8_SB(0, 1), cB + hstep, voffB); PG8_STAGE(PG8_SA(0, 0), cA, voffA); PG8_STAGE(PG8_SA(0, 1), cA + hstep, voffA);
        if (wr == 1) PG8_BAR;
        PG8_WAIT_V(2); PG8_BAR;
        PG8_STAGE(PG8_SB(1, 0), cB + kstep, voffB); PG8_STAGE(PG8_SA(1, 0), cA + kstep, voffA); PG8_STAGE(PG8_SB(1, 1), cB + hstep + kstep, voffB);
        PG8_WAIT_V(6); PG8_BAR;
    } else {
        PG8_STAGE(PG8_SB(0, 0), cB, voffB); PG8_STAGE(PG8_SA(0, 0), cA, voffA); PG8_STAGE(PG8_SB(0, 1), cB + hstep, voffB); PG8_STAGE(PG8_SA(0, 1), cA + hstep, voffA);
        if (wr == 1) PG8_BAR;
        PG8_WAIT_V(4); PG8_BAR;
        PG8_STAGE(PG8_SB(1, 0), cB + kstep, voffB); PG8_STAGE(PG8_SA(1, 0), cA + kstep, voffA); PG8_STAGE(PG8_SB(1, 1), cB + hstep + kstep, voffB);
        PG8_WAIT_V(6); PG8_BAR;
    }
    for (;;) {
        const bool has_next = S.next(ui + 1, nxt);
        const char* nA = has_next ? (const char*)g.A + (size_t)nxt.pm * tstep : cA; const char* nB = has_next ? (const char*)g.Bt + (size_t)nxt.pn * tstep : cB;
        for (int t = 0; t < nt; t += 2) {
            const bool last = (t == nt - 2);
            const char* a1 = cA + (size_t)(t + 1) * kstep;
            const char* a2 = last ? nA : cA + (size_t)(t + 2) * kstep; const char* b2 = last ? nB : cB + (size_t)(t + 2) * kstep;
            const char* a3 = a2 + kstep; const char* b3 = b2 + kstep;
            if (last && has_next) S.a_ready(nxt);
            if constexpr (SP2) {
            PG8_LDB(B0, 0, 0); PG8_LDB(B1, 0, 1); PG8_SCHED; PG8_LDA(At, 0, 0); PG8_STAGE(PG8_SA(1, 1), a1 + hstep, voffA);
            PG8_WAIT_V(8); PG8_WAIT_L(0); PG8_BAR; PG8_MMA(0, 0, At, B0); PG8_MMA(0, 1, At, B1); PG8_BAR; PG8_SCHED;
            PG8_LDA(At, 0, 1); PG8_STAGE(PG8_SB(0, 0), b2, voffB); PG8_STAGE(PG8_SB(0, 1), b2 + hstep, voffB); PG8_STAGE(PG8_SA(0, 0), a2, voffA);
            PG8_WAIT_V(8); PG8_WAIT_L(0); PG8_BAR; PG8_MMA(1, 0, At, B0); PG8_MMA(1, 1, At, B1); PG8_BAR; PG8_SCHED;
            PG8_LDB(B0, 1, 0); PG8_LDB(B1, 1, 1); PG8_SCHED; PG8_LDA(At, 1, 0); PG8_STAGE(PG8_SA(0, 1), a2 + hstep, voffA);
            PG8_WAIT_V(8); PG8_WAIT_L(0); PG8_BAR; PG8_MMA(0, 0, At, B0); PG8_MMA(0, 1, At, B1); PG8_BAR; PG8_SCHED;
            PG8_LDA(At, 1, 1); PG8_STAGE(PG8_SB(1, 0), b3, voffB); PG8_STAGE(PG8_SB(1, 1), b3 + hstep, voffB); PG8_STAGE(PG8_SA(1, 0), a3, voffA);
            PG8_WAIT_V(8); PG8_WAIT_L(0); PG8_BAR; PG8_MMA(1, 0, At, B0); PG8_MMA(1, 1, At, B1); PG8_BAR; PG8_SCHED;
            } else {
            PG8_LDB(B0, 0, 0); PG8_SCHED; PG8_LDA(At, 0, 0); PG8_STAGE(PG8_SA(1, 1), a1 + hstep, voffA);
            PG8_WAIT_L(8); PG8_BAR; PG8_WAIT_L(0); PG8_MMA(0, 0, At, B0); PG8_BAR; PG8_SCHED;
            PG8_LDB(B1, 0, 1); PG8_STAGE(PG8_SB(0, 0), b2, voffB);
            PG8_BAR; PG8_WAIT_L(0); PG8_MMA(0, 1, At, B1); PG8_BAR;
            PG8_LDA(At, 0, 1); PG8_STAGE(PG8_SA(0, 0), a2, voffA);
            PG8_BAR; PG8_WAIT_L(0); PG8_MMA(1, 0, At, B0); PG8_BAR; PG8_SCHED;
            PG8_STAGE(PG8_SB(0, 1), b2 + hstep, voffB);
            PG8_WAIT_V(6); PG8_BAR; PG8_MMA(1, 1, At, B1); PG8_BAR;
            PG8_LDB(B0, 1, 0); PG8_SCHED; PG8_LDA(At, 1, 0); PG8_STAGE(PG8_SA(0, 1), a2 + hstep, voffA);
            PG8_WAIT_L(8); PG8_BAR; PG8_WAIT_L(0); PG8_MMA(0, 0, At, B0); PG8_BAR; PG8_SCHED;
            PG8_LDB(B1, 1, 1); PG8_STAGE(PG8_SB(1, 0), b3, voffB);
            PG8_BAR; PG8_WAIT_L(0); PG8_MMA(0, 1, At, B1); PG8_BAR;
            PG8_LDA(At, 1, 1); PG8_STAGE(PG8_SA(1, 0), a3, voffA);
            PG8_BAR; PG8_WAIT_L(0); PG8_MMA(1, 0, At, B0); PG8_BAR; PG8_SCHED;
            PG8_STAGE(PG8_SB(1, 1), b3 + hstep, voffB);
            PG8_WAIT_V(6); PG8_BAR; PG8_MMA(1, 1, At, B1); PG8_BAR;
            }
        }
        if constexpr (ALIGN_EPI) { if (wr == 0) PG8_BAR; }
        if constexpr (!Epi::AFTER_DRAIN) { E(acc, cur, wr, wc, fr, fq); S.done(cur); }
        if (!has_next) break;
#pragma unroll
        for (int a = 0; a < 2; ++a)
#pragma unroll
            for (int b = 0; b < 2; ++b)
#pragma unroll
                for (int m = 0; m < 4; ++m)
#pragma unroll
                    for (int n = 0; n < 2; ++n) acc[a][b][m][n] = (f32x4){0.f, 0.f, 0.f, 0.f};
        cur = nxt; cA = nA; cB = nB; ++ui;
        if constexpr (ALIGN_EPI) { if (wr == 1) PG8_BAR; }
    }
    PG8_WAIT_V(0);
    if constexpr (!ALIGN_EPI) { if (wr == 0) PG8_BAR; }
    PG8_BAR;
    if constexpr (Epi::AFTER_DRAIN) { E.fused(acc, cur, wr, wc, fr, fq, lds, wid, lane); S.done(cur); }
#undef PG8_SA
#undef PG8_SB
#undef PG8_STAGE
#undef PG8_LDA
#undef PG8_LDB
#undef PG8_MMA
#undef PG8_WAIT_V
#undef PG8_WAIT_L
#undef PG8_BAR
#undef PG8_SCHED
}
}

#include <hip/hip_bf16.h>
#include <cmath>
namespace attn_body {
using bf16=__hip_bfloat16;
using bf16x8=__attribute__((ext_vector_type(8)))short;
using s16x4=__attribute__((ext_vector_type(4)))short;
using f32x16=__attribute__((ext_vector_type(16)))float;
using u32x4=__attribute__((ext_vector_type(4)))unsigned;
constexpr int SEQ=16384,D=64,DM=512;
constexpr int NW=8,QBLK=32,QB=QBLK*NW,KVBLK=64,NQB=SEQ/QB;
constexpr int ATTN_PITCH=DM, ATTN_UNIT_ROWS=QB;
__device__ __forceinline__ int crow(int r,int hi){return (r&3)+8*(r>>2)+4*hi;}
#define SBAR() __builtin_amdgcn_sched_barrier(0)
__device__ __forceinline__ void cmask(f32x16&p0,f32x16&p1,int jb,int wid){
  const float NEG=-INFINITY;
  if(jb>(wid>>1)){
  #pragma unroll
  for(int r=0;r<16;++r){p0[r]=NEG;p1[r]=NEG;}}
}

constexpr int NSLOT=3, SLOTB=8192;
constexpr int LDS_K=0, LDS_V=NSLOT*SLOTB, LDS_WS=2*NSLOT*SLOTB, LDS_OST=LDS_WS+NW*64*4, LDS_BYTES=LDS_OST+NW*4096;
constexpr float C2=0.125f*1.4426950408889634f;
__device__ __forceinline__ void glds16(const void*gsrc,unsigned lds_dst){unsigned keep;
  asm volatile("s_mov_b32 %0, m0\n\ts_mov_b32 m0, %2\n\ts_nop 0\n\tglobal_load_lds_dwordx4 %1, off\n\ts_mov_b32 m0, %0":"=&s"(keep):"v"(gsrc),"s"(lds_dst):"memory");}
__device__ __forceinline__ float max3f(float a,float b,float c){float r;asm("v_max3_f32 %0, %1, %2, %3":"=v"(r):"v"(a),"v"(b),"v"(c));return r;}
__device__ __forceinline__ float max2f(float a,float b){float r;asm("v_max_f32_e32 %0, %1, %2":"=v"(r):"v"(a),"v"(b));return r;}
__device__ __forceinline__ float fadd_s(float a,float b){float r;asm("v_add_f32_e32 %0, %1, %2":"=v"(r):"v"(a),"v"(b));return r;}
__device__ __forceinline__ float fsub_s(float a,float b){float r;asm("v_sub_f32_e32 %0, %1, %2":"=v"(r):"v"(a),"v"(b));return r;}
typedef float f32x2_t __attribute__((ext_vector_type(2))); typedef __bf16 bf16x2_t __attribute__((ext_vector_type(2)));
__device__ __forceinline__ unsigned cvtpk_s(float lo,float hi){f32x2_t v={lo,hi};bf16x2_t b=__builtin_convertvector(v,bf16x2_t);return __builtin_bit_cast(unsigned,b);}
#define WAIT_BAR(N) asm volatile("s_waitcnt vmcnt(" #N ") lgkmcnt(0)\n\ts_barrier":::"memory")

__device__ __forceinline__ void qkt(f32x16&p0,f32x16&p1,const char*Kslot,const bf16x8*qr,const f32x16&negm,int r32,int hi){
  const char*kb=Kslot+hi*1024+r32*16;
  #pragma unroll
  for(int d0=0;d0<4;++d0){
    const bf16x8 b0=*reinterpret_cast<const bf16x8*>(kb+d0*2048);
    const bf16x8 b1=*reinterpret_cast<const bf16x8*>(kb+d0*2048+512);
    if(d0==0){p0=__builtin_amdgcn_mfma_f32_32x32x16_bf16(b0,qr[0],negm,0,0,0);p1=__builtin_amdgcn_mfma_f32_32x32x16_bf16(b1,qr[0],negm,0,0,0);}
    else{p0=__builtin_amdgcn_mfma_f32_32x32x16_bf16(b0,qr[d0],p0,0,0,0);p1=__builtin_amdgcn_mfma_f32_32x32x16_bf16(b1,qr[d0],p1,0,0,0);}}
}
typedef __attribute__((address_space(3))) const char* lds_cptr;
typedef short v4i16_t __attribute__((ext_vector_type(4)));
__device__ __forceinline__ void kload8(bf16x8*kf,lds_cptr kp){
  kf[0]=*(const __attribute__((address_space(3))) bf16x8*)(kp);      kf[1]=*(const __attribute__((address_space(3))) bf16x8*)(kp+512);
  kf[2]=*(const __attribute__((address_space(3))) bf16x8*)(kp+2048); kf[3]=*(const __attribute__((address_space(3))) bf16x8*)(kp+2560);
  kf[4]=*(const __attribute__((address_space(3))) bf16x8*)(kp+4096); kf[5]=*(const __attribute__((address_space(3))) bf16x8*)(kp+4608);
  kf[6]=*(const __attribute__((address_space(3))) bf16x8*)(kp+6144); kf[7]=*(const __attribute__((address_space(3))) bf16x8*)(kp+6656);
}
__device__ __forceinline__ void kload2(bf16x8*kf,lds_cptr kp,int j){ kf[2*j]=*(const __attribute__((address_space(3))) bf16x8*)(kp+j*2048); kf[2*j+1]=*(const __attribute__((address_space(3))) bf16x8*)(kp+j*2048+512); }
__device__ __forceinline__ s16x4 vtr(lds_cptr p){ return __builtin_bit_cast(s16x4,__builtin_amdgcn_ds_read_tr16_b64_v4i16((__attribute__((address_space(3))) v4i16_t*)p)); }
__device__ __forceinline__ float rowmax(const f32x16&p0,const f32x16&p1){
  float a=max3f(p0[0],p0[1],p1[0]),b=max3f(p0[2],p0[3],p1[1]);a=max3f(a,p1[2],p1[3]);
  #pragma unroll
  for(int r=4;r<16;r+=4){a=max3f(a,p0[r],p0[r+1]);b=max3f(b,p0[r+2],p0[r+3]);a=max3f(a,p1[r],p1[r+1]);b=max3f(b,p1[r+2],p1[r+3]);}
  const float m=max2f(a,b);
  auto rr=__builtin_amdgcn_permlane32_swap(__float_as_uint(m),__float_as_uint(m),false,false);
  return max2f(__uint_as_float(rr[0]),__uint_as_float(rr[1]));
}
__device__ __forceinline__ void pv(f32x16*o,int vb,bf16x8 pa0,bf16x8 pa1,bf16x8 pa2,bf16x8 pa3){
  #pragma unroll
  for(int d0=0;d0<2;++d0){s16x4 lo[4],hi[4];
    #pragma unroll
    for(int ks=0;ks<4;++ks){
      asm volatile("ds_read_b64_tr_b16 %0,%1 offset:%c2":"=&v"(lo[ks]):"v"(vb),"i"(d0*4096+ks*1024):"memory");
      asm volatile("ds_read_b64_tr_b16 %0,%1 offset:%c2":"=&v"(hi[ks]):"v"(vb),"i"(d0*4096+ks*1024+512):"memory");}
    asm volatile("s_waitcnt lgkmcnt(0)":::"memory");SBAR();
    #define PK(k) (bf16x8){lo[k][0],lo[k][1],lo[k][2],lo[k][3],hi[k][0],hi[k][1],hi[k][2],hi[k][3]}
    o[d0]=__builtin_amdgcn_mfma_f32_32x32x16_bf16(pa0,PK(0),o[d0],0,0,0);
    o[d0]=__builtin_amdgcn_mfma_f32_32x32x16_bf16(pa1,PK(1),o[d0],0,0,0);
    o[d0]=__builtin_amdgcn_mfma_f32_32x32x16_bf16(pa2,PK(2),o[d0],0,0,0);
    o[d0]=__builtin_amdgcn_mfma_f32_32x32x16_bf16(pa3,PK(3),o[d0],0,0,0);
    #undef PK
  }
}

#ifndef ATTN_STORE16
#define ATTN_STORE16(p,v) (*(u32x4*)(p)=(v))
#endif
template<int THRL> __device__ __forceinline__ void attn_unit(int qcol,int vcol,int qb,const bf16*Q,const bf16*__restrict__ K,const bf16*__restrict__ V,bf16*O,char*shm){
  const int tid=threadIdx.x,lane=tid&63,r32=lane&31,hi=lane>>5; const int wid=__builtin_amdgcn_readfirstlane(tid>>6);
  const long rowbase=0; const int q0=qb*QB;
  const bf16*Qw=Q+(rowbase+q0+wid*QBLK)*DM+qcol;
  const bf16*Kh=K+rowbase*DM+qcol,*Vh=V+rowbase*DM+vcol;
  const unsigned lds0=(unsigned)(uintptr_t)shm;
  float*wsf=(float*)(shm+LDS_WS)+wid*64;
  const bf16*ksrc=Kh+(long)lane*DM+wid*8;
  const bf16*vsrc=Vh+(long)(16*(wid&3)+(lane>>2))*DM+(wid>>2)*32+(lane&3)*8;
  const unsigned kdst=lds0+LDS_K+wid*1024, vdst=lds0+LDS_V+wid*1024;
  #define DMA_K(t,slot) glds16(ksrc+(long)(t)*KVBLK*DM,(unsigned)__builtin_amdgcn_readfirstlane(kdst+(slot)))
  #define DMA_V(t,slot) glds16(vsrc+(long)(t)*KVBLK*DM,(unsigned)__builtin_amdgcn_readfirstlane(vdst+(slot)))
  const int vb0=(int)(lds0+LDS_V)+((lane>>4)&1)*32+(lane&3)*8+(4*hi+((lane&15)>>2))*64;
  const char*Kbase=shm+LDS_K; bf16x8 kf[8];
  const lds_cptr shm3=(lds_cptr)shm; const lds_cptr kp0=shm3+LDS_K+hi*1024+r32*16; const lds_cptr vp0=shm3+LDS_V+((lane>>4)&1)*32+(lane&3)*8+(4*hi+((lane&15)>>2))*64;
  const int NT=(q0+QB)/KVBLK;
  DMA_K(0,0);DMA_V(0,0);DMA_K(1,SLOTB);
  bf16x8 qr[4];
  #pragma unroll
  for(int d0=0;d0<4;++d0)qr[d0]=*reinterpret_cast<const bf16x8*>(&Qw[(long)r32*DM+d0*16+hi*8]);
  float mhat=0.f,l_reg=0.f;f32x16 o[2];o[0]=f32x16{};o[1]=f32x16{};f32x16 negm=f32x16{};asm volatile("":"+v"(negm));
  const int qrel=wid*QBLK+r32;
  #define CMASK(P0,P1,t) do{int jb_=(t)-(NT-4); if(jb_>=0)cmask(P0,P1,jb_,wid);}while(0)
  bool resc=false;
  #define START(P0,P1) do{ const float rm=rowmax(P0,P1); resc=false; \
    { const float dl=rm; mhat=fadd_s(mhat,dl); \
      _Pragma("unroll") for(int r=0;r<16;++r){P0[r]=fsub_s(P0[r],dl);P1[r]=fsub_s(P1[r],dl);} \
      _Pragma("unroll") for(int r=0;r<16;++r)negm[r]=-mhat; asm volatile("":"+v"(negm)); } \
    _Pragma("unroll") for(int r=0;r<16;++r)P0[r]=__builtin_amdgcn_exp2f(P0[r]); }while(0)
  #define RESC() do{ if(resc){ asm volatile("s_waitcnt lgkmcnt(0)":::"memory"); \
      _Pragma("unroll") for(int d_=0;d_<2;++d_) _Pragma("unroll") for(int r=0;r<16;++r)o[d_][r]*=wsf[crow(r,hi)]; } }while(0)
  f32x16 pA0,pA1,pB0,pB1;
  int sl_prev=0,sl_cur=0,sl_next=SLOTB;
  #define ROT() do{sl_prev=sl_cur;sl_cur=sl_next;sl_next=(sl_next==(NSLOT-1)*SLOTB)?0:sl_next+SLOTB;}while(0)
  DMA_K(2,2*SLOTB);
  WAIT_BAR(3);
  qkt(pA0,pA1,Kbase,qr,negm,r32,hi);asm volatile("s_nop 15\n\ts_nop 7":"+v"(pA0),"+v"(pA1));CMASK(pA0,pA1,0);
  START(pA0,pA1);
  _Pragma("unroll") for(int r=0;r<16;++r)pA1[r]=__builtin_amdgcn_exp2f(pA1[r]);
  WAIT_BAR(0);
  DMA_K(3,0);DMA_V(1,SLOTB);
  ROT();
  kload8(kf,kp0+sl_cur);
  WAIT_BAR(2);
  s16x4 vlo[8],vhi[8]; u32x4 pw0,pw1,pw2,pw3;
  #define PKW(P,B) cvtpk_s(P[B],P[B+1])
  #define PAF(k) __builtin_bit_cast(bf16x8,pw##k)
  #define VFR(i) (bf16x8){vlo[i][0],vlo[i][1],vlo[i][2],vlo[i][3],vhi[i][0],vhi[i][1],vhi[i][2],vhi[i][3]}
  #define PIN(x) asm volatile("":"+v"(x))
  #define MX3(a,b,c) __builtin_fmaxf(__builtin_fmaxf((a),(b)),(c))
  #define GAPA(MF,A0,A1,A2,A3,W0,W1,PW) do{ MF; sacc+=A0; sacc+=A1; sacc+=A2; sacc+=A3; PIN(sacc); W0; W1; PIN(PW); SBAR(); }while(0)
  #define EX(v) __builtin_amdgcn_exp2f(v)
  #define GAPB(MF,X,B) do{ MF; X[B]=EX(X[B]); X[B+1]=EX(X[B+1]); X[B+2]=EX(X[B+2]); X[B+3]=EX(X[B+3]); PIN(X); SBAR(); }while(0)
  #define VRD(i) do{ vlo[i]=vtr(vp_+(((i)>>2)*4096+((i)&3)*1024)); vhi[i]=vtr(vp_+(((i)>>2)*4096+((i)&3)*1024+512)); }while(0)
  #define KRD(G,j) do{ if(G){ kload2(kf,kp0+sl_next,j); SBAR(); } }while(0)
  #define STEP(C0,C1,P0,P1,t,GK,GV,GL) do{ SBAR(); \
    const lds_cptr vp_=vp0+sl_prev; \
    VRD(0); SBAR(); float sacc=(P0[0]+P0[1]); \
    GAPA(C0=__builtin_amdgcn_mfma_f32_32x32x16_bf16(kf[0],qr[0],negm,0,0,0), P0[2],P0[3],P0[4],P0[5],     pw0[0]=PKW(P0,0), pw0[1]=PKW(P0,2), pw0); \
    VRD(4); SBAR(); GAPA(C1=__builtin_amdgcn_mfma_f32_32x32x16_bf16(kf[1],qr[0],negm,0,0,0), P0[6],P0[7],P0[8],P0[9],     pw0[2]=PKW(P0,4), pw0[3]=PKW(P0,6), pw0); \
    VRD(1); SBAR(); GAPA(C0=__builtin_amdgcn_mfma_f32_32x32x16_bf16(kf[2],qr[1],C0,0,0,0),   P0[10],P0[11],P0[12],P0[13], pw1[0]=PKW(P0,8), pw1[1]=PKW(P0,10), pw1); \
    VRD(5); SBAR(); GAPA(C1=__builtin_amdgcn_mfma_f32_32x32x16_bf16(kf[3],qr[1],C1,0,0,0),   P0[14],P0[15],P1[0],P1[1],   pw1[2]=PKW(P0,12),pw1[3]=PKW(P0,14), pw1); \
    VRD(2); SBAR(); GAPA(C0=__builtin_amdgcn_mfma_f32_32x32x16_bf16(kf[4],qr[2],C0,0,0,0),   P1[2],P1[3],P1[4],P1[5],     pw2[0]=PKW(P1,0), pw2[1]=PKW(P1,2), pw2); \
    VRD(6); SBAR(); GAPA(C1=__builtin_amdgcn_mfma_f32_32x32x16_bf16(kf[5],qr[2],C1,0,0,0),   P1[6],P1[7],P1[8],P1[9],     pw2[2]=PKW(P1,4), pw2[3]=PKW(P1,6), pw2); \
    VRD(3); SBAR(); GAPA(C0=__builtin_amdgcn_mfma_f32_32x32x16_bf16(kf[6],qr[3],C0,0,0,0),   P1[10],P1[11],P1[12],P1[13], pw3[0]=PKW(P1,8), pw3[1]=PKW(P1,10), pw3); \
    VRD(7); SBAR(); GAPA(C1=__builtin_amdgcn_mfma_f32_32x32x16_bf16(kf[7],qr[3],C1,0,0,0),   P1[14],P1[15],0.f,0.f,       pw3[2]=PKW(P1,12),pw3[3]=PKW(P1,14), pw3); \
    l_reg+=sacc; \
    if(GK){DMA_K((t)+3,sl_cur);} if(GV){DMA_V((t)+1,sl_next);} \
    CMASK(C0,C1,t); \
    { float a=MX3(C0[0],C0[1],C1[0]),b=MX3(C0[2],C0[3],C1[1]); a=MX3(a,C1[2],C1[3]); \
      _Pragma("unroll") for(int r=4;r<16;r+=4){a=MX3(a,C0[r],C0[r+1]);b=MX3(b,C0[r+2],C0[r+3]);a=MX3(a,C1[r],C1[r+1]);b=MX3(b,C1[r+2],C1[r+3]);} \
      float rm=__builtin_fmaxf(a,b); { auto rr=__builtin_amdgcn_permlane32_swap(__float_as_uint(rm),__float_as_uint(rm),false,false); rm=__builtin_fmaxf(__uint_as_float(rr[0]),__uint_as_float(rr[1])); } \
      resc=false; \
      if(__builtin_expect(__any(rm>(float)THRL),0)){ const float dl=__builtin_fmaxf(rm,0.f); mhat+=dl; \
        _Pragma("unroll") for(int r=0;r<16;++r){C0[r]-=dl;C1[r]-=dl;} \
        _Pragma("unroll") for(int r=0;r<16;++r)negm[r]=-mhat; asm volatile("":"+v"(negm)); \
        const float f=__builtin_amdgcn_exp2f(-dl); l_reg*=f; if(hi==0)wsf[r32]=f; resc=true; } } \
    SBAR(); \
    GAPB(o[0]=__builtin_amdgcn_mfma_f32_32x32x16_bf16(PAF(0),VFR(0),o[0],0,0,0), C0,0); \
    GAPB(o[1]=__builtin_amdgcn_mfma_f32_32x32x16_bf16(PAF(0),VFR(4),o[1],0,0,0), C0,4); \
    KRD(GL,0); GAPB(o[0]=__builtin_amdgcn_mfma_f32_32x32x16_bf16(PAF(1),VFR(1),o[0],0,0,0), C0,8); \
    KRD(GL,1); GAPB(o[1]=__builtin_amdgcn_mfma_f32_32x32x16_bf16(PAF(1),VFR(5),o[1],0,0,0), C0,12); \
    KRD(GL,2); GAPB(o[0]=__builtin_amdgcn_mfma_f32_32x32x16_bf16(PAF(2),VFR(2),o[0],0,0,0), C1,0); \
    KRD(GL,3); GAPB(o[1]=__builtin_amdgcn_mfma_f32_32x32x16_bf16(PAF(2),VFR(6),o[1],0,0,0), C1,4); \
    GAPB(o[0]=__builtin_amdgcn_mfma_f32_32x32x16_bf16(PAF(3),VFR(3),o[0],0,0,0), C1,8); \
    GAPB(o[1]=__builtin_amdgcn_mfma_f32_32x32x16_bf16(PAF(3),VFR(7),o[1],0,0,0), C1,12); \
    }while(0)
  int t=1;
  #undef CMASK
  #define CMASK(P0,P1,t) do{}while(0)
  for(;t+5<NT;t+=2){
    STEP(pB0,pB1,pA0,pA1,t,true,true,true);     WAIT_BAR(2); RESC(); ROT();
    STEP(pA0,pA1,pB0,pB1,t+1,true,true,true);   WAIT_BAR(2); RESC(); ROT();
  }
  #undef CMASK
  #define CMASK(P0,P1,t) do{int jb_=(t)-(NT-4); if(jb_>=0)cmask(P0,P1,jb_,wid);}while(0)
  #define ENDW(tt) do{ if((tt)+3<NT){WAIT_BAR(2);} else if((tt)+2<NT){WAIT_BAR(1);} else {WAIT_BAR(0);} }while(0)
  for(;t+1<NT;t+=2){
    STEP(pB0,pB1,pA0,pA1,t,(t+3<NT),(t+1<NT),(t+1<NT));       ENDW(t);   RESC(); ROT();
    STEP(pA0,pA1,pB0,pB1,t+1,(t+4<NT),(t+2<NT),(t+2<NT));     ENDW(t+1); RESC(); ROT();
  }
  STEP(pB0,pB1,pA0,pA1,NT-1,false,false,false); RESC();
  { float sacc=pB0[0]+pB0[1]; _Pragma("unroll") for(int r=2;r<16;++r)sacc+=pB0[r]; _Pragma("unroll") for(int r=0;r<16;++r)sacc+=pB1[r]; l_reg+=sacc;
    pw0=(u32x4){PKW(pB0,0),PKW(pB0,2),PKW(pB0,4),PKW(pB0,6)};pw1=(u32x4){PKW(pB0,8),PKW(pB0,10),PKW(pB0,12),PKW(pB0,14)};pw2=(u32x4){PKW(pB1,0),PKW(pB1,2),PKW(pB1,4),PKW(pB1,6)};pw3=(u32x4){PKW(pB1,8),PKW(pB1,10),PKW(pB1,12),PKW(pB1,14)};
    SBAR(); pv(o,vb0+sl_cur,PAF(0),PAF(1),PAF(2),PAF(3)); }
  #undef PKW
  #undef PAF
  #undef VFR
  #undef PIN
  #undef MX3
  #undef GAPA
  #undef GAPB
  #undef EX
  #undef VRD
  #undef KRD
  #undef STEP
  #undef ENDW
  {auto rr=__builtin_amdgcn_permlane32_swap(__float_as_uint(l_reg),__float_as_uint(l_reg),false,false);l_reg=__uint_as_float(rr[0])+__uint_as_float(rr[1]);}
  if(hi==0)wsf[32+r32]=l_reg;asm volatile("s_waitcnt lgkmcnt(0)":::"memory");
  float rli[16];
  #pragma unroll
  for(int r=0;r<16;++r)rli[r]=__builtin_amdgcn_rcpf(wsf[32+crow(r,hi)]);
  bf16*Ow=O+(rowbase+q0+wid*QBLK)*DM+vcol;
  { bf16*stg=(bf16*)(shm+LDS_OST)+wid*2048;
    #pragma unroll
    for(int r=0;r<16;++r){const int orow=crow(r,hi);
      #pragma unroll
      for(int d0=0;d0<2;++d0)stg[orow*64+d0*32+r32]=__float2bfloat16(o[d0][r]*rli[r]);}
    asm volatile("s_waitcnt lgkmcnt(0)":::"memory");
    #pragma unroll
    for(int i=0;i<4;++i){const int row=i*8+(lane>>3),ch=lane&7; const u32x4 v=*(const u32x4*)(stg+row*64+ch*8); ATTN_STORE16(Ow+(long)row*DM+ch*8,v);} }
  asm volatile("s_waitcnt lgkmcnt(0)\n\ts_barrier":::"memory");
  #undef DMA_K
  #undef DMA_V
  #undef CMASK
  #undef START
  #undef RESC
  #undef ROT
}
constexpr int ATTN_LDS_BYTES=LDS_BYTES;
struct AttnTensors { const bf16* Q; const bf16* K; const bf16* V; bf16* O; };
struct AttnUnit { int var; int qb; };
struct StaticOrder {
  int vcu;
  __device__ __forceinline__ explicit StaticOrder(int v):vcu(v){}
  __device__ __forceinline__ bool next(int i,AttnUnit&u)const{ if(i>=4)return false; const int s=vcu&15; u.var=vcu>>4; u.qb=(i==0)?s:(i==1)?31-s:(i==2)?32+s:63-s; return true; }
};
template<class Sched,int THRL=8> __device__ __forceinline__ void attn_phase(char*lds,const AttnTensors&T,const Sched&S){
  AttnUnit u;
  for(int i=0;S.next(i,u);++i){ const int h=u.var>>2,mp=(u.var>>1)&1,vh=u.var&1;
    attn_unit<THRL>(h*128+mp*64,h*128+vh*64,u.qb,T.Q,T.K,T.V,T.O+(size_t)mp*SEQ*DM,lds); }
}
#undef SBAR
#undef WAIT_BAR
}
namespace attn128 {
using bf16=__hip_bfloat16;
using bf16x8=__attribute__((ext_vector_type(8)))short;
using s16x4=__attribute__((ext_vector_type(4)))short;
using f32x16=__attribute__((ext_vector_type(16)))float;
using u32x4=__attribute__((ext_vector_type(4)))unsigned;
constexpr int SEQ=16384,D=64,DM=512;
constexpr int NW=8,QBLK=32,QB=QBLK*NW,KVBLK=64,NQB=SEQ/QB;
constexpr int ATTN_PITCH=DM, ATTN_UNIT_ROWS=QB;
__device__ __forceinline__ int crow(int r,int hi){return (r&3)+8*(r>>2)+4*hi;}
#define SBAR() __builtin_amdgcn_sched_barrier(0)
__device__ __forceinline__ void cmask(f32x16&p0,f32x16&p1,int jb,int wid){
  const float NEG=-INFINITY;
  if(jb>(wid>>1)){
  #pragma unroll
  for(int r=0;r<16;++r){p0[r]=NEG;p1[r]=NEG;}}
}

constexpr int NSLOT=3, SLOTB=8192;
constexpr int LDS_K=0, LDS_V=NSLOT*SLOTB, LDS_WS=3*NSLOT*SLOTB, LDS_OST=LDS_WS+NW*64*4, LDS_BYTES=LDS_OST+NW*4096;
constexpr float C2=0.125f*1.4426950408889634f;
__device__ __forceinline__ void glds16(const void*gsrc,unsigned lds_dst){unsigned keep;
  asm volatile("s_mov_b32 %0, m0\n\ts_mov_b32 m0, %2\n\ts_nop 0\n\tglobal_load_lds_dwordx4 %1, off\n\ts_mov_b32 m0, %0":"=&s"(keep):"v"(gsrc),"s"(lds_dst):"memory");}
__device__ __forceinline__ float max3f(float a,float b,float c){float r;asm("v_max3_f32 %0, %1, %2, %3":"=v"(r):"v"(a),"v"(b),"v"(c));return r;}
__device__ __forceinline__ float max2f(float a,float b){float r;asm("v_max_f32_e32 %0, %1, %2":"=v"(r):"v"(a),"v"(b));return r;}
__device__ __forceinline__ float fadd_s(float a,float b){float r;asm("v_add_f32_e32 %0, %1, %2":"=v"(r):"v"(a),"v"(b));return r;}
__device__ __forceinline__ float fsub_s(float a,float b){float r;asm("v_sub_f32_e32 %0, %1, %2":"=v"(r):"v"(a),"v"(b));return r;}
typedef float f32x2_t __attribute__((ext_vector_type(2))); typedef __bf16 bf16x2_t __attribute__((ext_vector_type(2)));
__device__ __forceinline__ unsigned cvtpk_s(float lo,float hi){f32x2_t v={lo,hi};bf16x2_t b=__builtin_convertvector(v,bf16x2_t);return __builtin_bit_cast(unsigned,b);}
#define WAIT_BAR(N) asm volatile("s_waitcnt vmcnt(" #N ") lgkmcnt(0)\n\ts_barrier":::"memory")

__device__ __forceinline__ void qkt(f32x16&p0,f32x16&p1,const char*Kslot,const bf16x8*qr,const f32x16&negm,int r32,int hi){
  const char*kb=Kslot+hi*1024+r32*16;
  #pragma unroll
  for(int d0=0;d0<4;++d0){
    const bf16x8 b0=*reinterpret_cast<const bf16x8*>(kb+d0*2048);
    const bf16x8 b1=*reinterpret_cast<const bf16x8*>(kb+d0*2048+512);
    if(d0==0){p0=__builtin_amdgcn_mfma_f32_32x32x16_bf16(b0,qr[0],negm,0,0,0);p1=__builtin_amdgcn_mfma_f32_32x32x16_bf16(b1,qr[0],negm,0,0,0);}
    else{p0=__builtin_amdgcn_mfma_f32_32x32x16_bf16(b0,qr[d0],p0,0,0,0);p1=__builtin_amdgcn_mfma_f32_32x32x16_bf16(b1,qr[d0],p1,0,0,0);}}
}
typedef __attribute__((address_space(3))) const char* lds_cptr;
typedef short v4i16_t __attribute__((ext_vector_type(4)));
__device__ __forceinline__ void kload8(bf16x8*kf,lds_cptr kp){
  kf[0]=*(const __attribute__((address_space(3))) bf16x8*)(kp);      kf[1]=*(const __attribute__((address_space(3))) bf16x8*)(kp+512);
  kf[2]=*(const __attribute__((address_space(3))) bf16x8*)(kp+2048); kf[3]=*(const __attribute__((address_space(3))) bf16x8*)(kp+2560);
  kf[4]=*(const __attribute__((address_space(3))) bf16x8*)(kp+4096); kf[5]=*(const __attribute__((address_space(3))) bf16x8*)(kp+4608);
  kf[6]=*(const __attribute__((address_space(3))) bf16x8*)(kp+6144); kf[7]=*(const __attribute__((address_space(3))) bf16x8*)(kp+6656);
}
__device__ __forceinline__ void kload2(bf16x8*kf,lds_cptr kp,int j){ kf[2*j]=*(const __attribute__((address_space(3))) bf16x8*)(kp+j*2048); kf[2*j+1]=*(const __attribute__((address_space(3))) bf16x8*)(kp+j*2048+512); }
__device__ __forceinline__ s16x4 vtr(lds_cptr p){ return __builtin_bit_cast(s16x4,__builtin_amdgcn_ds_read_tr16_b64_v4i16((__attribute__((address_space(3))) v4i16_t*)p)); }
__device__ __forceinline__ float rowmax(const f32x16&p0,const f32x16&p1){
  float a=max3f(p0[0],p0[1],p1[0]),b=max3f(p0[2],p0[3],p1[1]);a=max3f(a,p1[2],p1[3]);
  #pragma unroll
  for(int r=4;r<16;r+=4){a=max3f(a,p0[r],p0[r+1]);b=max3f(b,p0[r+2],p0[r+3]);a=max3f(a,p1[r],p1[r+1]);b=max3f(b,p1[r+2],p1[r+3]);}
  const float m=max2f(a,b);
  auto rr=__builtin_amdgcn_permlane32_swap(__float_as_uint(m),__float_as_uint(m),false,false);
  return max2f(__uint_as_float(rr[0]),__uint_as_float(rr[1]));
}
__device__ __forceinline__ void pv(f32x16*o,int vb,bf16x8 pa0,bf16x8 pa1,bf16x8 pa2,bf16x8 pa3){
  #pragma unroll
  for(int d0=0;d0<4;++d0){s16x4 lo[4],hi[4];
    #pragma unroll
    for(int ks=0;ks<4;++ks){
      asm volatile("ds_read_b64_tr_b16 %0,%1 offset:%c2":"=&v"(lo[ks]):"v"(vb),"i"(d0*4096+ks*1024):"memory");
      asm volatile("ds_read_b64_tr_b16 %0,%1 offset:%c2":"=&v"(hi[ks]):"v"(vb),"i"(d0*4096+ks*1024+512):"memory");}
    asm volatile("s_waitcnt lgkmcnt(0)":::"memory");SBAR();
    #define PK(k) (bf16x8){lo[k][0],lo[k][1],lo[k][2],lo[k][3],hi[k][0],hi[k][1],hi[k][2],hi[k][3]}
    o[d0]=__builtin_amdgcn_mfma_f32_32x32x16_bf16(pa0,PK(0),o[d0],0,0,0);
    o[d0]=__builtin_amdgcn_mfma_f32_32x32x16_bf16(pa1,PK(1),o[d0],0,0,0);
    o[d0]=__builtin_amdgcn_mfma_f32_32x32x16_bf16(pa2,PK(2),o[d0],0,0,0);
    o[d0]=__builtin_amdgcn_mfma_f32_32x32x16_bf16(pa3,PK(3),o[d0],0,0,0);
    #undef PK
  }
}

#ifndef ATTN_STORE16
#define ATTN_STORE16(p,v) (*(u32x4*)(p)=(v))
#endif
template<int THRL> __device__ __forceinline__ void attn_unit(int qcol,int vcol,int qb,const bf16*Q,const bf16*__restrict__ K,const bf16*__restrict__ V,bf16*O,char*shm){
  const int tid=threadIdx.x,lane=tid&63,r32=lane&31,hi=lane>>5; const int wid=__builtin_amdgcn_readfirstlane(tid>>6);
  const long rowbase=0; const int q0=qb*QB;
  const bf16*Qw=Q+(rowbase+q0+wid*QBLK)*DM+qcol;
  const bf16*Kh=K+rowbase*DM+qcol,*Vh=V+rowbase*DM+vcol;
  const unsigned lds0=(unsigned)(uintptr_t)shm;
  float*wsf=(float*)(shm+LDS_WS)+wid*64;
  const bf16*ksrc=Kh+(long)lane*DM+wid*8;
  const bf16*vsrc=Vh+(long)(16*(wid&3)+(lane>>2))*DM+(wid>>2)*32+(lane&3)*8;
  const unsigned kdst=lds0+LDS_K+wid*1024, vdst=lds0+LDS_V+wid*1024;
  #define DMA_K(t,slot) glds16(ksrc+(long)(t)*KVBLK*DM,(unsigned)__builtin_amdgcn_readfirstlane(kdst+(slot)))
  #define DMA_V(t,slot) do{ glds16(vsrc+(long)(t)*KVBLK*DM,(unsigned)__builtin_amdgcn_readfirstlane(vdst+2*(slot))); glds16(vsrc+64+(long)(t)*KVBLK*DM,(unsigned)__builtin_amdgcn_readfirstlane(vdst+2*(slot)+8192)); }while(0)
  const int vb0=(int)(lds0+LDS_V)+((lane>>4)&1)*32+(lane&3)*8+(4*hi+((lane&15)>>2))*64;
  const char*Kbase=shm+LDS_K; bf16x8 kf[8];
  const lds_cptr shm3=(lds_cptr)shm; const lds_cptr kp0=shm3+LDS_K+hi*1024+r32*16; const lds_cptr vp0=shm3+LDS_V+((lane>>4)&1)*32+(lane&3)*8+(4*hi+((lane&15)>>2))*64;
  const int NT=(q0+QB)/KVBLK;
  DMA_K(0,0);DMA_V(0,0);DMA_K(1,SLOTB);
  bf16x8 qr[4];
  #pragma unroll
  for(int d0=0;d0<4;++d0)qr[d0]=*reinterpret_cast<const bf16x8*>(&Qw[(long)r32*DM+d0*16+hi*8]);
  float mhat=0.f,l_reg=0.f;f32x16 o[4];o[0]=f32x16{};o[1]=f32x16{};o[2]=f32x16{};o[3]=f32x16{};const f32x16 negm=f32x16{};
  const int qrel=wid*QBLK+r32;
  #define CMASK(P0,P1,t) do{int jb_=(t)-(NT-4); if(jb_>=0)cmask(P0,P1,jb_,wid);}while(0)
  bool resc=false;
  #define START(P0,P1) do{ const float rm=rowmax(P0,P1); resc=false; \
    { const float dl=rm; mhat=fadd_s(mhat,dl); \
      _Pragma("unroll") for(int r=0;r<16;++r){P0[r]=fsub_s(P0[r],dl);P1[r]=fsub_s(P1[r],dl);} \
      } \
    _Pragma("unroll") for(int r=0;r<16;++r)P0[r]=__builtin_amdgcn_exp2f(P0[r]); }while(0)
  #define RESC() do{ if(resc){ asm volatile("s_waitcnt lgkmcnt(0)":::"memory"); \
      _Pragma("unroll") for(int d_=0;d_<4;++d_) _Pragma("unroll") for(int r=0;r<16;++r)o[d_][r]*=wsf[crow(r,hi)]; } }while(0)
  f32x16 pA0,pA1,pB0,pB1;
  int sl_prev=0,sl_cur=0,sl_next=SLOTB;
  #define ROT() do{sl_prev=sl_cur;sl_cur=sl_next;sl_next=(sl_next==(NSLOT-1)*SLOTB)?0:sl_next+SLOTB;}while(0)
  DMA_K(2,2*SLOTB);
  WAIT_BAR(4);
  qkt(pA0,pA1,Kbase,qr,negm,r32,hi);asm volatile("s_nop 15\n\ts_nop 7":"+v"(pA0),"+v"(pA1));CMASK(pA0,pA1,0);
  START(pA0,pA1);
  float rmx=mhat;
  _Pragma("unroll") for(int r=0;r<16;++r)pA1[r]=__builtin_amdgcn_exp2f(pA1[r]);
  WAIT_BAR(0);
  DMA_K(3,0);DMA_V(1,SLOTB);
  ROT();
  kload8(kf,kp0+sl_cur);
  WAIT_BAR(3);
  s16x4 vlo[8],vhi[8]; u32x4 pw0,pw1,pw2,pw3;
  #define PKW(P,B) cvtpk_s(P[B],P[B+1])
  #define PAF(k) __builtin_bit_cast(bf16x8,pw##k)
  #define VFR(i) (bf16x8){vlo[i][0],vlo[i][1],vlo[i][2],vlo[i][3],vhi[i][0],vhi[i][1],vhi[i][2],vhi[i][3]}
  #define PIN(x) asm volatile("":"+v"(x))
  #define MX3(a,b,c) __builtin_fmaxf(__builtin_fmaxf((a),(b)),(c))
  #define GAPA(MF,A0,A1,A2,A3,W0,W1,PW) do{ MF; sacc+=A0; sacc+=A1; sacc+=A2; sacc+=A3; PIN(sacc); W0; W1; PIN(PW); SBAR(); }while(0)
  #define EX(v) __builtin_amdgcn_exp2f(v)
  #define GAPB(MF,X,B) do{ MF; X[B]=EX(X[B]); X[B+1]=EX(X[B+1]); X[B+2]=EX(X[B+2]); X[B+3]=EX(X[B+3]); PIN(X); SBAR(); }while(0)
  #define VRD(i) do{ vlo[i]=vtr(vp_+(((i)>>2)*4096+((i)&3)*1024)); vhi[i]=vtr(vp_+(((i)>>2)*4096+((i)&3)*1024+512)); }while(0)
  #define VRD2(i) do{ vlo[i]=vtr(vp_+((2+((i)>>2))*4096+((i)&3)*1024)); vhi[i]=vtr(vp_+((2+((i)>>2))*4096+((i)&3)*1024+512)); SBAR(); }while(0)
  #define GAPB2(MF,X,B) do{ MF; asm volatile("v_max3_f32 %0, %0, %1, %2" : "+v"(rmx) : "v"(X[B]), "v"(X[B+1])); X[B]=EX(X[B]-mhat); X[B+1]=EX(X[B+1]-mhat); PIN(X); SBAR(); }while(0)
  #define KRD(G,j) do{ if(G){ kload2(kf,kp0+sl_next,j); SBAR(); } }while(0)
  #define STEP(C0,C1,P0,P1,t,GK,GV,GL) do{ SBAR(); \
    const lds_cptr vp_=vp0+2*sl_prev; \
    VRD(0); SBAR(); float sacc=(P0[0]+P0[1]); \
    GAPA(C0=__builtin_amdgcn_mfma_f32_32x32x16_bf16(kf[0],qr[0],negm,0,0,0), P0[2],P0[3],P0[4],P0[5],     pw0[0]=PKW(P0,0), pw0[1]=PKW(P0,2), pw0); \
    VRD(4); SBAR(); GAPA(C1=__builtin_amdgcn_mfma_f32_32x32x16_bf16(kf[1],qr[0],negm,0,0,0), P0[6],P0[7],P0[8],P0[9],     pw0[2]=PKW(P0,4), pw0[3]=PKW(P0,6), pw0); \
    VRD(1); SBAR(); GAPA(C0=__builtin_amdgcn_mfma_f32_32x32x16_bf16(kf[2],qr[1],C0,0,0,0),   P0[10],P0[11],P0[12],P0[13], pw1[0]=PKW(P0,8), pw1[1]=PKW(P0,10), pw1); \
    VRD(5); SBAR(); GAPA(C1=__builtin_amdgcn_mfma_f32_32x32x16_bf16(kf[3],qr[1],C1,0,0,0),   P0[14],P0[15],P1[0],P1[1],   pw1[2]=PKW(P0,12),pw1[3]=PKW(P0,14), pw1); \
    GAPA(C0=__builtin_amdgcn_mfma_f32_32x32x16_bf16(kf[4],qr[2],C0,0,0,0),   P1[2],P1[3],P1[4],P1[5],     pw2[0]=PKW(P1,0), pw2[1]=PKW(P1,2), pw2); \
    GAPA(C1=__builtin_amdgcn_mfma_f32_32x32x16_bf16(kf[5],qr[2],C1,0,0,0),   P1[6],P1[7],P1[8],P1[9],     pw2[2]=PKW(P1,4), pw2[3]=PKW(P1,6), pw2); \
    GAPA(C0=__builtin_amdgcn_mfma_f32_32x32x16_bf16(kf[6],qr[3],C0,0,0,0),   P1[10],P1[11],P1[12],P1[13], pw3[0]=PKW(P1,8), pw3[1]=PKW(P1,10), pw3); \
    GAPA(C1=__builtin_amdgcn_mfma_f32_32x32x16_bf16(kf[7],qr[3],C1,0,0,0),   P1[14],P1[15],0.f,0.f,       pw3[2]=PKW(P1,12),pw3[3]=PKW(P1,14), pw3); \
    l_reg+=sacc; \
    if(GK){DMA_K((t)+3,sl_cur);} if(GV){DMA_V((t)+1,sl_next);} \
    CMASK(C0,C1,t); \
    {   \
      float rm=rmx; { auto rr=__builtin_amdgcn_permlane32_swap(__float_as_uint(rm),__float_as_uint(rm),false,false); rm=__builtin_fmaxf(__uint_as_float(rr[0]),__uint_as_float(rr[1])); } rmx=-INFINITY; \
      resc=false; const float rmr=rm-mhat; \
      if(__builtin_expect(__any(rmr>(float)THRL),0)){ const float dl=__builtin_fmaxf(rmr,0.f); mhat+=dl; \
        const float f=__builtin_amdgcn_exp2f(-dl); l_reg*=f; if(hi==0)wsf[r32]=f; resc=true; } } \
    SBAR(); \
    VRD(2); SBAR(); GAPB2(o[0]=__builtin_amdgcn_mfma_f32_32x32x16_bf16(PAF(0),VFR(0),o[0],0,0,0), C0,0); \
    VRD(6); SBAR(); GAPB2(o[1]=__builtin_amdgcn_mfma_f32_32x32x16_bf16(PAF(0),VFR(4),o[1],0,0,0), C0,2); \
    VRD(3); SBAR(); GAPB2(o[0]=__builtin_amdgcn_mfma_f32_32x32x16_bf16(PAF(1),VFR(1),o[0],0,0,0), C0,4); \
    VRD(7); SBAR(); GAPB2(o[1]=__builtin_amdgcn_mfma_f32_32x32x16_bf16(PAF(1),VFR(5),o[1],0,0,0), C0,6); \
    VRD2(0); GAPB2(o[0]=__builtin_amdgcn_mfma_f32_32x32x16_bf16(PAF(2),VFR(2),o[0],0,0,0), C0,8); \
    VRD2(4); GAPB2(o[1]=__builtin_amdgcn_mfma_f32_32x32x16_bf16(PAF(2),VFR(6),o[1],0,0,0), C0,10); \
    VRD2(1); GAPB2(o[0]=__builtin_amdgcn_mfma_f32_32x32x16_bf16(PAF(3),VFR(3),o[0],0,0,0), C0,12); \
    VRD2(5); GAPB2(o[1]=__builtin_amdgcn_mfma_f32_32x32x16_bf16(PAF(3),VFR(7),o[1],0,0,0), C0,14); \
    VRD2(2); GAPB2(o[2]=__builtin_amdgcn_mfma_f32_32x32x16_bf16(PAF(0),VFR(0),o[2],0,0,0), C1,0); \
    VRD2(6); GAPB2(o[3]=__builtin_amdgcn_mfma_f32_32x32x16_bf16(PAF(0),VFR(4),o[3],0,0,0), C1,2); \
    VRD2(3); KRD(GL,0); GAPB2(o[2]=__builtin_amdgcn_mfma_f32_32x32x16_bf16(PAF(1),VFR(1),o[2],0,0,0), C1,4); \
    VRD2(7); KRD(GL,1); GAPB2(o[3]=__builtin_amdgcn_mfma_f32_32x32x16_bf16(PAF(1),VFR(5),o[3],0,0,0), C1,6); \
    KRD(GL,2); GAPB2(o[2]=__builtin_amdgcn_mfma_f32_32x32x16_bf16(PAF(2),VFR(2),o[2],0,0,0), C1,8); \
    KRD(GL,3); GAPB2(o[3]=__builtin_amdgcn_mfma_f32_32x32x16_bf16(PAF(2),VFR(6),o[3],0,0,0), C1,10); \
    GAPB2(o[2]=__builtin_amdgcn_mfma_f32_32x32x16_bf16(PAF(3),VFR(3),o[2],0,0,0), C1,12); \
    GAPB2(o[3]=__builtin_amdgcn_mfma_f32_32x32x16_bf16(PAF(3),VFR(7),o[3],0,0,0), C1,14); \
    }while(0)
  int t=1;
  #undef CMASK
  #define CMASK(P0,P1,t) do{}while(0)
  for(;t+5<NT;t+=2){
    STEP(pB0,pB1,pA0,pA1,t,true,true,true);     WAIT_BAR(3); RESC(); ROT();
    STEP(pA0,pA1,pB0,pB1,t+1,true,true,true);   WAIT_BAR(3); RESC(); ROT();
  }
  #undef CMASK
  #define CMASK(P0,P1,t) do{int jb_=(t)-(NT-4); if(jb_>=0)cmask(P0,P1,jb_,wid);}while(0)
  #define ENDW(tt) do{ if((tt)+3<NT){WAIT_BAR(3);} else if((tt)+2<NT){WAIT_BAR(2);} else {WAIT_BAR(0);} }while(0)
  for(;t+1<NT;t+=2){
    STEP(pB0,pB1,pA0,pA1,t,(t+3<NT),(t+1<NT),(t+1<NT));       ENDW(t);   RESC(); ROT();
    STEP(pA0,pA1,pB0,pB1,t+1,(t+4<NT),(t+2<NT),(t+2<NT));     ENDW(t+1); RESC(); ROT();
  }
  STEP(pB0,pB1,pA0,pA1,NT-1,false,false,false); RESC();
  { float sacc=pB0[0]+pB0[1]; _Pragma("unroll") for(int r=2;r<16;++r)sacc+=pB0[r]; _Pragma("unroll") for(int r=0;r<16;++r)sacc+=pB1[r]; l_reg+=sacc;
    pw0=(u32x4){PKW(pB0,0),PKW(pB0,2),PKW(pB0,4),PKW(pB0,6)};pw1=(u32x4){PKW(pB0,8),PKW(pB0,10),PKW(pB0,12),PKW(pB0,14)};pw2=(u32x4){PKW(pB1,0),PKW(pB1,2),PKW(pB1,4),PKW(pB1,6)};pw3=(u32x4){PKW(pB1,8),PKW(pB1,10),PKW(pB1,12),PKW(pB1,14)};
    SBAR(); pv(o,vb0+2*sl_cur,PAF(0),PAF(1),PAF(2),PAF(3)); }
  #undef PKW
  #undef PAF
  #undef VFR
  #undef PIN
  #undef MX3
  #undef GAPA
  #undef GAPB
  #undef GAPB2
  #undef VRD2
  #undef EX
  #undef VRD
  #undef KRD
  #undef STEP
  #undef ENDW
  {auto rr=__builtin_amdgcn_permlane32_swap(__float_as_uint(l_reg),__float_as_uint(l_reg),false,false);l_reg=__uint_as_float(rr[0])+__uint_as_float(rr[1]);}
  if(hi==0)wsf[32+r32]=l_reg;asm volatile("s_waitcnt lgkmcnt(0)":::"memory");
  float rli[16];
  #pragma unroll
  for(int r=0;r<16;++r)rli[r]=__builtin_amdgcn_rcpf(wsf[32+crow(r,hi)]);
  bf16*Ow=O+(rowbase+q0+wid*QBLK)*DM+vcol;
  { bf16*stg=(bf16*)(shm+LDS_OST)+wid*2048;
    #pragma unroll
    for(int hf=0;hf<2;++hf){
    #pragma unroll
    for(int r=0;r<16;++r){const int orow=crow(r,hi);
      #pragma unroll
      for(int d0=0;d0<2;++d0)stg[orow*64+d0*32+r32]=__float2bfloat16(o[2*hf+d0][r]*rli[r]);}
    asm volatile("s_waitcnt lgkmcnt(0)":::"memory");
    #pragma unroll
    for(int i=0;i<4;++i){const int row=i*8+(lane>>3),ch=lane&7; const u32x4 v=*(const u32x4*)(stg+row*64+ch*8); ATTN_STORE16(Ow+(long)row*DM+hf*64+ch*8,v);}
    asm volatile("s_waitcnt lgkmcnt(0)":::"memory"); } }
  asm volatile("s_waitcnt lgkmcnt(0)\n\ts_barrier":::"memory");
  #undef DMA_K
  #undef DMA_V
  #undef CMASK
  #undef START
  #undef RESC
  #undef ROT
}
constexpr int ATTN_LDS_BYTES=LDS_BYTES;
struct AttnTensors { const bf16* Q; const bf16* K; const bf16* V; bf16* O; };
struct AttnUnit { int var; int qb; };
struct StaticOrder {
  int vcu;
  __device__ __forceinline__ explicit StaticOrder(int v):vcu(v){}
  __device__ __forceinline__ bool next(int i,AttnUnit&u)const{ if(i>=2)return false; const int s=vcu&31; u.var=vcu>>5; u.qb=(i==0)?s:63-s; return true; }
};
template<class Sched,int THRL=8> __device__ __forceinline__ void attn_phase(char*lds,const AttnTensors&T,const Sched&S){
  AttnUnit u;
  for(int i=0;S.next(i,u);++i){ const int h=u.var>>1,mp=u.var&1;
    attn_unit<THRL>(h*128+mp*64,h*128,u.qb,T.Q,T.K,T.V,T.O+(size_t)mp*SEQ*DM,lds); }
}
#undef SBAR
#undef WAIT_BAR
}


#define GAS __attribute__((address_space(1)))
#define LAS __attribute__((address_space(3)))
typedef unsigned short bf16;
typedef unsigned v4u __attribute__((ext_vector_type(4)));
typedef float f32x4 __attribute__((ext_vector_type(4)));
typedef short bf16x8 __attribute__((ext_vector_type(8)));
typedef GAS unsigned gu32;
typedef GAS unsigned long long gu64;
#define RLX_AGENT __ATOMIC_RELAXED, __HIP_MEMORY_SCOPE_AGENT
#define LDS_WAIT() asm volatile("s_waitcnt lgkmcnt(0)" ::: "memory")
#define VM_WAIT() asm volatile("s_waitcnt vmcnt(0)" ::: "memory")
__device__ __forceinline__ unsigned long long rt() { return __builtin_amdgcn_s_memrealtime(); }
__device__ __forceinline__ unsigned f2bf(float f) { unsigned u = __builtin_bit_cast(unsigned, f); return (u + 0x7fffu + ((u >> 16) & 1u)) >> 16; }
__device__ __forceinline__ unsigned pk2(float lo, float hi) { return f2bf(lo) | (f2bf(hi) << 16); }

#define XB_TMO      128
#define XB_XCNT(j)  (256  + 64 * (j))
#define XB_XSUB(j)  (1280 + 64 * (j))
#define XB_XGEN(j)  (2304 + 64 * (j))
#define XB_TOP      3328
#define XB_TOPGEN   3392
#define XCD_BAR_WORDS 3456
#define XB_SPIN_CAP (1u << 18)

__device__ __forceinline__ unsigned xb_ld(unsigned* p)              { return __hip_atomic_load(p, __ATOMIC_RELAXED, __HIP_MEMORY_SCOPE_AGENT); }
__device__ __forceinline__ unsigned xb_add(unsigned* p, unsigned v) { return __hip_atomic_fetch_add(p, v, __ATOMIC_RELAXED, __HIP_MEMORY_SCOPE_AGENT); }
__device__ __forceinline__ unsigned xb_xcc_id() { return (unsigned)__builtin_amdgcn_s_getreg((3 << 11) | 20) & 0xFu; }
#define XB_SPIN(cond, bar) do { unsigned _sp = 0; while (cond) { __builtin_amdgcn_s_sleep(1); \
    if ((++_sp & 255u) == 0u) { if (xb_ld(&(bar)[XB_TMO])) break; if (_sp > XB_SPIN_CAP) { atomicAdd(&(bar)[XB_TMO], 1u); break; } } } } while (0)

struct XcdBarrier {
    unsigned* bar; unsigned x;
    volatile LAS unsigned* st;
};

__device__ __forceinline__ XcdBarrier xcd_barrier_post(unsigned* bar, volatile LAS unsigned* st) {
    XcdBarrier b; b.bar = bar; b.x = xb_xcc_id(); b.st = st;
    if (threadIdx.x == 0) (void)xb_add(&bar[XB_XCNT(b.x)], 1u);
    return b;
}
__device__ __forceinline__ void xcd_barrier_complete(unsigned* bar, unsigned x, unsigned& nloc, unsigned& nx) {
    const unsigned G = gridDim.x * gridDim.y * gridDim.z;
    unsigned sum, cnt, mine, sp = 0u;
    for (;;) {
        sum = 0u; cnt = 0u; mine = 0u;
#pragma unroll
        for (unsigned j = 0; j < 16; ++j) { const unsigned c = xb_ld(&bar[XB_XCNT(j)]); sum += c; cnt += (c > 0u) ? 1u : 0u; mine = (j == x) ? c : mine; }
        if (sum == G) break;
        __builtin_amdgcn_s_sleep(1);
        if ((++sp & 255u) == 0u) { if (xb_ld(&bar[XB_TMO])) break; if (sp > XB_SPIN_CAP) { atomicAdd(&bar[XB_TMO], 1u); break; } }
    }
    nloc = mine > 0u ? mine : 1u; nx = cnt > 0u ? cnt : 1u;
}

__device__ __forceinline__ void xcd_barrier(const XcdBarrier& b) {
    asm volatile("s_waitcnt vmcnt(0)" ::: "memory");
    __syncthreads();
    if (threadIdx.x == 0) {
        unsigned* bar = b.bar;
        __builtin_amdgcn_s_waitcnt(0);
        unsigned nloc = b.st[0], nx = b.st[1];
        if (nloc == 0u) { xcd_barrier_complete(bar, b.x, nloc, nx); b.st[0] = nloc; b.st[1] = nx; }
        const unsigned old = xb_add(&bar[XB_XSUB(b.x)], 1u);
        const unsigned gen = old / nloc;
        if (old + 1u == (gen + 1u) * nloc) {
            __builtin_amdgcn_fence(__ATOMIC_RELEASE, "agent");
            asm volatile("s_waitcnt vmcnt(0)" ::: "memory");
            const unsigned og = xb_add(&bar[XB_TOP], 1u);
            const unsigned tg = og / nx;
            if (og + 1u == (tg + 1u) * nx) xb_add(&bar[XB_TOPGEN], 1u);
            else XB_SPIN(xb_ld(&bar[XB_TOPGEN]) == tg, bar);
            __builtin_amdgcn_fence(__ATOMIC_ACQUIRE, "agent");
            xb_add(&bar[XB_XGEN(b.x)], 1u);
            asm volatile("s_waitcnt vmcnt(0)" ::: "memory");
        } else {
            XB_SPIN(xb_ld(&bar[XB_XGEN(b.x)]) == gen, bar);
            __builtin_amdgcn_fence(__ATOMIC_ACQUIRE, "agent");
            asm volatile("s_waitcnt vmcnt(0)" ::: "memory");
        }
    }
    __syncthreads();
}

constexpr int NWAVES = 8;
constexpr int M = 16384, D = 1024, INC = 2560, AW = 512, LW = 512, NQ = 2048, NEXP = 16384;
constexpr float EPSN = 1e-6f;
constexpr size_t MiB = 1u << 20;
constexpr size_t WS_CTL = 0, CTL_ZERO_BYTES = 1 * MiB;
constexpr size_t WS_ROWSS2 = 512 * 1024;
constexpr size_t WS_RS1 = 1 * MiB;
constexpr size_t WS_SK1 = 1 * MiB + 128 * 1024, WS_SK2 = WS_SK1 + 32 * 1024;
constexpr size_t WS_WIN = 2 * MiB, WS_WOUT = 8 * MiB, WS_WQ = 10 * MiB;
constexpr size_t WS_ED = 16 * MiB, WS_EU = 48 * MiB;
constexpr size_t WS_SCD = 32 * MiB, WS_SCU = 33 * MiB;
constexpr size_t WS_WQ8 = 170 * MiB;
constexpr size_t WS_XB = 80 * MiB;
constexpr size_t WS_OS = 80 * MiB;
constexpr size_t WS_Q2 = 80 * MiB;
constexpr size_t WS_Q = 112 * MiB, WS_SPLIT = 16 * MiB;
constexpr size_t WS_GATE = WS_Q + 4 * WS_SPLIT;
constexpr size_t WS_EID = 144 * MiB, WS_GW = 152 * MiB;
constexpr size_t WS_MIX = 192 * MiB, WS_HB = 224 * MiB, WS_END = 256 * MiB;
constexpr size_t WS_ROWSS3 = 576 * 1024;
constexpr size_t WS_DOTP = 80 * MiB;
constexpr size_t WS_REC = 160 * MiB, WS_N0 = 168 * MiB;
constexpr size_t WS_PEER = 176 * MiB;
constexpr size_t WS_REC_OLD_UNUSED = 0;
constexpr int CW_BAR = 4096;
constexpr int RING_OFF = 0, RING_BYTES = 131072;
constexpr int LDSCTL_OFF = RING_BYTES, MISC_OFF = LDSCTL_OFF + 320;
constexpr int LDS_BYTES = 163840;

struct Frame {
    LAS unsigned char* lds;
    volatile LAS unsigned* MISC;
    int tid, lane, wave;
    int vcu, G;
};

__device__ __forceinline__ float wave_sum(float v) {
#pragma unroll
    for (int o = 1; o < 64; o <<= 1) v += __shfl_xor(v, o);
    return v;
}
__device__ __forceinline__ float bf2f(unsigned short b) { return __builtin_bit_cast(float, (unsigned)b << 16); }
__device__ __forceinline__ float bflo(unsigned w) { return __builtin_bit_cast(float, w << 16); }
__device__ __forceinline__ float bfhi(unsigned w) { return __builtin_bit_cast(float, w & 0xffff0000u); }
__device__ __forceinline__ float gelu_tanh(float x) { const float u = 0.7978845608028654f * (x + 0.044715f * x * x * x); return 0.5f * x * (1.0f + tanhf(u)); }
__device__ __forceinline__ float sigmoidf_(float x) { return 1.0f / (1.0f + expf(-x)); }
__device__ __forceinline__ float fsigmoid(float x) { return __builtin_amdgcn_rcpf(1.0f + __builtin_amdgcn_exp2f(-1.4426950408889634f * x)); }
__device__ __forceinline__ float fgelu_tanh(float x) { const float u = 0.7978845608028654f * (x + 0.044715f * x * x * x); const float t = 1.0f - 2.0f * __builtin_amdgcn_rcpf(1.0f + __builtin_amdgcn_exp2f(2.8853900817779268f * u)); return 0.5f * x * (1.0f + t); }

__device__ __forceinline__ void p0_transpose_item(const float* W, int K, int N, bf16* WT, const float* gk, LAS float* scr, int item, int lane) {
    const int nblk = N / 32, kb = item / nblk, nb = item % nblk, k0 = 64 * kb, n0 = 32 * nb;
#pragma unroll 8
    for (int i = 0; i < 32; ++i) { const int kk = 2 * i + (lane >> 5); const float g = gk ? gk[k0 + kk] : 1.0f; scr[kk * 33 + (lane & 31)] = W[(size_t)(k0 + kk) * N + n0 + (lane & 31)] * g; }
    LDS_WAIT(); asm volatile("" ::: "memory");
    const int c = lane & 7;
#pragma unroll
    for (int j = 0; j < 4; ++j) { const int n = (lane >> 3) + 8 * j; const LAS float* s = scr + (8 * c) * 33 + n;
        v4u o; o.x = pk2(s[0 * 33], s[1 * 33]); o.y = pk2(s[2 * 33], s[3 * 33]); o.z = pk2(s[4 * 33], s[5 * 33]); o.w = pk2(s[6 * 33], s[7 * 33]);
        *(GAS v4u*)(WT + (size_t)(n0 + n) * K + k0 + 8 * c) = o; }
    LDS_WAIT(); asm volatile("" ::: "memory");
}
template <int NR> __device__ __forceinline__ void p0_rows(const float* xrow, bf16* orow, const float* gk, float* rs, int lane) {
    f32x4 v[NR][4];
#pragma unroll
    for (int i = 0; i < NR; ++i)
#pragma unroll
        for (int j = 0; j < 4; ++j) v[i][j] = __builtin_nontemporal_load((const GAS f32x4*)(xrow + (size_t)i * 1024) + lane + 64 * j);
#pragma unroll
    for (int i = 0; i < NR; ++i) {
        if (rs) { float s = 0.f;
#pragma unroll
            for (int j = 0; j < 4; ++j) s += (v[i][j].x * v[i][j].x + v[i][j].y * v[i][j].y) + (v[i][j].z * v[i][j].z + v[i][j].w * v[i][j].w);
            const float tot = wave_sum(s); if (lane == 0) rs[i] = 1.0f / sqrtf(tot * (1.0f / 1024.0f) + EPSN); }
        if (gk) {
#pragma unroll
            for (int j = 0; j < 4; ++j) v[i][j] = v[i][j] * ((const GAS f32x4*)gk)[lane + 64 * j]; }
        GAS unsigned long long* o8 = (GAS unsigned long long*)(orow + (size_t)i * 1024) + lane;
#pragma unroll
        for (int j = 0; j < 4; ++j) o8[64 * j] = (unsigned long long)pk2(v[i][j].x, v[i][j].y) | ((unsigned long long)pk2(v[i][j].z, v[i][j].w) << 32);
    }
}

struct Args { const float* in[23]; float* out; unsigned char* ws; int ph_lo, ph_hi; };

__device__ __forceinline__ void p0_prologue(Frame& F, const Args& a) {
    LAS float* scr = (LAS float*)(F.lds + RING_OFF + F.wave * 16384);
    unsigned char* ws = a.ws;
    const int gw = F.vcu * NWAVES + F.wave, NGW = F.G * NWAVES;
    constexpr int I_IN = (D / 64) * (INC / 32), I_OUT = (D / 64) * (D / 32), I_Q = (D / 64) * (NQ / 32);
    constexpr int NITEMS = I_IN + I_OUT + I_Q;
    for (int it = gw; it < NITEMS; it += NGW) {
        int r = it;
        if (r < I_IN) { p0_transpose_item(a.in[2], D, INC, (bf16*)(ws + WS_WIN), a.in[1], scr, r, F.lane); continue; } r -= I_IN;
        if (r < I_OUT) { p0_transpose_item(a.in[15], D, D, (bf16*)(ws + WS_WOUT), nullptr, scr, r, F.lane); continue; } r -= I_OUT;
        p0_transpose_item(a.in[17], D, NQ, (bf16*)(ws + WS_WQ), a.in[16], scr, r, F.lane);
    }
    constexpr int NGRP = (M + 32) / 4;
    for (int m = gw; m < NGRP; m += NGW) {
        int r = 4 * m;
        if (r < M) { p0_rows<4>(a.in[0] + (size_t)r * D, (bf16*)(ws + WS_XB) + (size_t)r * D, nullptr, (float*)(ws + WS_RS1) + r, F.lane); continue; } r -= M;
        if (r < 16) { p0_rows<4>(a.in[18] + (size_t)r * 1024, (bf16*)(ws + WS_SK1) + (size_t)r * 1024, nullptr, nullptr, F.lane); continue; } r -= 16;
        p0_rows<4>(a.in[19] + (size_t)r * 1024, (bf16*)(ws + WS_SK2) + (size_t)r * 1024, nullptr, nullptr, F.lane);
    }
}
template <int NR> __device__ __forceinline__ void q8_rows(const float* xrow, unsigned char* orow, const float* gk, float* scale, int lane) {
    f32x4 v[NR][4];
#pragma unroll
    for (int i = 0; i < NR; ++i)
#pragma unroll
        for (int j = 0; j < 4; ++j) v[i][j] = __builtin_nontemporal_load((const GAS f32x4*)(xrow + (size_t)i * 1024) + lane + 64 * j);
#pragma unroll
    for (int i = 0; i < NR; ++i) {
        float am = 0.f;
#pragma unroll
        for (int j = 0; j < 4; ++j) { if (gk) v[i][j] = v[i][j] * ((const GAS f32x4*)gk)[lane + 64 * j];
            am = fmaxf(fmaxf(am, fmaxf(fabsf(v[i][j].x), fabsf(v[i][j].y))), fmaxf(fabsf(v[i][j].z), fabsf(v[i][j].w))); }
#pragma unroll
        for (int o = 1; o < 64; o <<= 1) am = fmaxf(am, __shfl_xor(am, o));
        const float sc = (am > 0.f) ? am * (1.0f / 127.0f) : 1.0f, inv = 1.0f / sc;
        if (lane == 0) scale[i] = sc;
        GAS unsigned* o4 = (GAS unsigned*)(orow + (size_t)i * 1024) + lane;
#pragma unroll
        for (int j = 0; j < 4; ++j) { const int q0 = (int)__builtin_rintf(v[i][j].x * inv), q1 = (int)__builtin_rintf(v[i][j].y * inv), q2 = (int)__builtin_rintf(v[i][j].z * inv), q3 = (int)__builtin_rintf(v[i][j].w * inv);
            o4[64 * j] = ((unsigned)q0 & 255u) | (((unsigned)q1 & 255u) << 8) | (((unsigned)q2 & 255u) << 16) | ((unsigned)q3 << 24); }
    }
}
__device__ __forceinline__ void convert_experts(const Args& a, int w, int nw, int lane) {
    unsigned char* ws = a.ws;
    for (int m = w; m < (2 * NEXP) / 4; m += nw) {
        int r = 4 * m;
        if (r < NEXP) { q8_rows<4>(a.in[20] + (size_t)r * D, ws + WS_ED + (size_t)r * D, a.in[16], (float*)(ws + WS_SCD) + r, lane); continue; } r -= NEXP;
        q8_rows<4>(a.in[21] + (size_t)r * D, ws + WS_EU + (size_t)r * D, nullptr, (float*)(ws + WS_SCU) + r, lane);
    }
}

typedef float f32x16 __attribute__((ext_vector_type(16)));
__device__ __forceinline__ void lru_local_unit(Frame& F, const Args& a, int c) {
    constexpr int YP = 520;
    LAS unsigned short* Y = (LAS unsigned short*)(F.lds + RING_OFF);
    const int e = F.tid, r0 = c * 64;
    const bf16* XR = (const bf16*)(a.ws + WS_Q + 3 * WS_SPLIT);
    float* HL = a.out; float* AC = a.out + (size_t)M * 512;
    { const float* conv_w = a.in[8]; const float cw0 = conv_w[e], cw1 = conv_w[512 + e], cw2 = conv_w[1024 + e], cw3 = conv_w[1536 + e], cb = a.in[9][e];
      float x0 = 0.f, x1 = 0.f, x2 = 0.f;
      if (c > 0) { x0 = bf2f(XR[(size_t)(r0 - 3) * 512 + e]); x1 = bf2f(XR[(size_t)(r0 - 2) * 512 + e]); x2 = bf2f(XR[(size_t)(r0 - 1) * 512 + e]); }
#pragma unroll 8
      for (int t = 0; t < 64; ++t) { const float x3 = bf2f(XR[(size_t)(r0 + t) * 512 + e]); Y[t * YP + e] = (unsigned short)f2bf(cb + x0 * cw0 + x1 * cw1 + x2 * cw2 + x3 * cw3); x0 = x1; x1 = x2; x2 = x3; } }
    __syncthreads();
    const int n = F.wave, lane = F.lane, r32 = lane & 31, hi = lane >> 5;
#pragma unroll 1
    for (int et = 0; et < 2; ++et) {
        bf16x8 wf[2][4];
#pragma unroll
        for (int gt = 0; gt < 2; ++gt) { const float* w = a.in[gt ? 12 : 10] + n * 4096 + 32 * et; asm volatile("" : "+s"(w));
#pragma unroll
            for (int ks = 0; ks < 4; ++ks) { float f[8];
#pragma unroll
                for (int j = 0; j < 8; ++j) f[j] = w[(16 * ks + 8 * hi + j) * 64 + r32];
                wf[gt][ks] = __builtin_bit_cast(bf16x8, (v4u){pk2(f[0], f[1]), pk2(f[2], f[3]), pk2(f[4], f[5]), pk2(f[6], f[7])}); asm volatile("" ::: "memory"); } }
        const int ch = 64 * n + 32 * et + r32;
        const float ba = a.in[11][ch], bx = a.in[13][ch], lam = a.in[14][ch];
        const float sp = (lam > 15.f) ? expf(-lam) : log1pf(expf(-lam));
        float av[2][16], bv[2][16];
#pragma unroll
        for (int tt = 0; tt < 2; ++tt) {
            f32x16 ra = {}, ia = {};
#pragma unroll
            for (int ks = 0; ks < 4; ++ks) { const bf16x8 af = *(const LAS bf16x8*)(Y + (32 * tt + r32) * YP + 64 * n + 16 * ks + 8 * hi);
                ra = __builtin_amdgcn_mfma_f32_32x32x16_bf16(af, wf[0][ks], ra, 0, 0, 0); ia = __builtin_amdgcn_mfma_f32_32x32x16_bf16(af, wf[1][ks], ia, 0, 0, 0); }
#pragma unroll
            for (int r = 0; r < 16; ++r) { const int t = 32 * tt + (r & 3) + 8 * (r >> 2) + 4 * hi;
                const float rr = fsigmoid(ra[r] + ba), ii = fsigmoid(ia[r] + bx);
                const float log_a = -8.0f * rr * sp, aa = __builtin_amdgcn_exp2f(log_a * 1.4426950408889634f);
                const float u2 = 2.0f * log_a;
                const float ser = -u2 * (1.0f + u2 * (0.5f + u2 * (0.16666667f + u2 * (0.041666668f + u2 * 0.0083333338f))));
                const float om = (u2 > -0.1f) ? ser : (1.0f - aa * aa);
                const float mult = __builtin_amdgcn_sqrtf(fmaxf(om, 1e-12f));
                av[tt][r] = aa; bv[tt][r] = mult * (ii * bf2f(Y[t * YP + ch])); }
        }
#pragma unroll
        for (int tt = 0; tt < 2; ++tt)
#pragma unroll
            for (int rq = 0; rq < 4; ++rq) { float h = 0.f, pa = 1.f;
#pragma unroll
                for (int k = 0; k < 4; ++k) { const int r = 4 * rq + k; h = av[tt][r] * h + bv[tt][r]; pa *= av[tt][r]; bv[tt][r] = h; av[tt][r] = pa; } }
        float hin[8], ain[8]; float hc = 0.f, ac = 1.f;
#pragma unroll
        for (int j = 0; j < 8; ++j) { const int tt = j >> 2, r3 = 4 * (j & 3) + 3;
#pragma unroll
            for (int own = 0; own < 2; ++own) {
                if (hi == own) { hin[j] = hc; ain[j] = ac; }
                const float mh = av[tt][r3] * hc + bv[tt][r3], ma = ac * av[tt][r3];
                const float oh = __shfl_xor(mh, 32), oa = __shfl_xor(ma, 32);
                hc = (hi == own) ? mh : oh; ac = (hi == own) ? ma : oa; } }
#pragma unroll
        for (int tt = 0; tt < 2; ++tt)
            { unsigned ob = (unsigned)((r0 + 32 * tt + 4 * hi) * 512 + ch); asm volatile("" : "+v"(ob));
#pragma unroll
            for (int r = 0; r < 16; ++r) { const int j = 4 * tt + (r >> 2); const unsigned o = ob + (unsigned)(((r & 3) + 8 * (r >> 2)) * 512);
                HL[o] = bv[tt][r] + av[tt][r] * hin[j]; AC[o] = av[tt][r] * ain[j]; } }
    }
    __syncthreads();
}

__device__ __forceinline__ void fix_unit(Frame& F, const Args& a, int c, float lamv) {
    const int r0 = c * 64;
    const float* HL = a.out; const float* AC = a.out + (size_t)M * 512;
    const bf16* GATE = (const bf16*)(a.ws + WS_GATE);
    bf16* MIX = (bf16*)(a.ws + WS_MIX);
    const int g4 = F.tid & 127, sgm = F.tid >> 7;
    LAS f32x4* SA = (LAS f32x4*)(F.lds + RING_OFF); LAS f32x4* SH = SA + 512;
    { const int L = (c + 3) >> 2; const int lo_c = sgm * L; int hi_c = lo_c + L; if (hi_c > c) hi_c = c;
      f32x4 A4 = (f32x4){1.f, 1.f, 1.f, 1.f}, H4 = (f32x4){0.f, 0.f, 0.f, 0.f};
      int cc = lo_c;
      for (; cc + 8 <= hi_c; cc += 8) { f32x4 av[8], hv[8];
#pragma unroll
          for (int k = 0; k < 8; ++k) { const size_t o = (size_t)((cc + k) * 64 + 63) * 512 + 4 * g4; av[k] = *(const GAS f32x4*)(AC + o); hv[k] = *(const GAS f32x4*)(HL + o); }
#pragma unroll
          for (int k = 0; k < 8; ++k) { H4 = av[k] * H4 + hv[k]; A4 = A4 * av[k]; } }
      for (; cc < hi_c; ++cc) { const size_t o = (size_t)(cc * 64 + 63) * 512 + 4 * g4; const f32x4 av = *(const GAS f32x4*)(AC + o), hv = *(const GAS f32x4*)(HL + o); H4 = av * H4 + hv; A4 = A4 * av; }
      SA[sgm * 128 + g4] = A4; SH[sgm * 128 + g4] = H4; }
    __syncthreads();
    f32x4 hin = (f32x4){0.f, 0.f, 0.f, 0.f};
#pragma unroll
    for (int sq = 0; sq < 4; ++sq) hin = SA[sq * 128 + g4] * hin + SH[sq * 128 + g4];
    __syncthreads();
#pragma unroll 4
    for (int t = sgm * 16; t < sgm * 16 + 16; ++t) { const size_t o = (size_t)(r0 + t) * 512 + 4 * g4;
        const f32x4 h = *(const GAS f32x4*)(HL + o) + *(const GAS f32x4*)(AC + o) * hin; const unsigned long long gw = *(const GAS unsigned long long*)(GATE + o);
        const unsigned glo = (unsigned)gw, ghi = (unsigned)(gw >> 32);
        const unsigned long long ov = (unsigned long long)pk2(h.x * fgelu_tanh(bflo(glo)), h.y * fgelu_tanh(bfhi(glo))) | ((unsigned long long)pk2(h.z * fgelu_tanh(bflo(ghi)), h.w * fgelu_tanh(bfhi(ghi))) << 32);
        *(GAS unsigned long long*)(MIX + (size_t)(r0 + t) * 1024 + 512 + 4 * g4) = ov; }
    const bf16* OS0 = (const bf16*)(a.ws + WS_OS); const bf16* OS1 = OS0 + (size_t)M * 512;
    const float* sg = a.in[7] + (F.lane & 15) * 8;
    float sgv[8];
#pragma unroll
    for (int j = 0; j < 8; ++j) sgv[j] = sg[j] * 0.8f;
#pragma unroll 2
    for (int rr = 0; rr < 8; ++rr) { const size_t row = (size_t)(r0 + 8 * F.wave + rr);
        const v4u p = *(const GAS v4u*)(OS0 + row * 512 + F.lane * 8), q = *(const GAS v4u*)(OS1 + row * 512 + F.lane * 8);
        float d[8];
        d[0] = bflo(p.x) - lamv * bflo(q.x); d[1] = bfhi(p.x) - lamv * bfhi(q.x); d[2] = bflo(p.y) - lamv * bflo(q.y); d[3] = bfhi(p.y) - lamv * bfhi(q.y);
        d[4] = bflo(p.z) - lamv * bflo(q.z); d[5] = bfhi(p.z) - lamv * bfhi(q.z); d[6] = bflo(p.w) - lamv * bflo(q.w); d[7] = bfhi(p.w) - lamv * bfhi(q.w);
        float ss = 0.f;
#pragma unroll
        for (int j = 0; j < 8; ++j) ss += d[j] * d[j];
        ss += __shfl_xor(ss, 1); ss += __shfl_xor(ss, 2); ss += __shfl_xor(ss, 4); ss += __shfl_xor(ss, 8);
        const float ri = 1.0f / sqrtf(ss * (1.0f / 128.0f) + EPSN);
        v4u o; o.x = pk2(d[0] * ri * sgv[0], d[1] * ri * sgv[1]); o.y = pk2(d[2] * ri * sgv[2], d[3] * ri * sgv[3]);
        o.z = pk2(d[4] * ri * sgv[4], d[5] * ri * sgv[5]); o.w = pk2(d[6] * ri * sgv[6], d[7] * ri * sgv[7]);
        *(GAS v4u*)(MIX + row * 1024 + F.lane * 8) = o; }
}

typedef float f32x16 __attribute__((ext_vector_type(16)));
#define CEX(a, b) do { const float _hi = fmaxf(a, b), _lo = fminf(a, b); a = _hi; b = _lo; } while (0)
__device__ __forceinline__ int skey(int b) { return b ^ ((b >> 31) & 0x7fffffff); }
#define CEI(a, b) do { const int _hi = max(a, b), _lo = min(a, b); a = _hi; b = _lo; } while (0)
__device__ __forceinline__ void sort16_desc(int (&v)[16]) {
#pragma unroll
    for (int k = 2; k <= 16; k <<= 1)
#pragma unroll
        for (int j = k >> 1; j >= 1; j >>= 1)
#pragma unroll
            for (int i = 0; i < 16; ++i) { const int l = i ^ j; if (l > i) { if ((i & k) == 0) CEI(v[i], v[l]); else CEI(v[l], v[i]); } }
}
__device__ __forceinline__ void merge16_desc(int (&a)[16], const int (&b)[16]) {
#pragma unroll
    for (int i = 0; i < 16; ++i) a[i] = max(a[i], b[15 - i]);
#pragma unroll
    for (int j = 8; j >= 1; j >>= 1)
#pragma unroll
        for (int i = 0; i < 16; ++i) if ((i & j) == 0) CEI(a[i], a[i + j]);
}
__device__ __forceinline__ void top16_half(int (&top)[16], const bf16* q, const LAS unsigned char* sk, int r32, int hi) {
    bf16x8 qf[8];
#pragma unroll
    for (int ks = 0; ks < 8; ++ks) qf[ks] = *(const GAS bf16x8*)(q + 16 * ks + 8 * hi);
#pragma unroll
    for (int i = 0; i < 16; ++i) top[i] = (int)0x80000000;
#pragma unroll 1
    for (int kt = 0; kt < 4; ++kt) {
        f32x16 acc = {};
#pragma unroll
        for (int ks = 0; ks < 8; ++ks) { const bf16x8 kf = *(const LAS bf16x8*)(sk + (32 * kt + r32) * 272 + (16 * ks + 8 * hi) * 2); acc = __builtin_amdgcn_mfma_f32_32x32x16_bf16(kf, qf[ks], acc, 0, 0, 0); }
        int grp[16];
#pragma unroll
        for (int r = 0; r < 16; ++r) { const int idx = 32 * kt + (r & 3) + 8 * (r >> 2) + 4 * hi; const float av = acc[r];
            grp[r] = (skey(__float_as_int(av)) & ~127) | idx; }
        sort16_desc(grp); merge16_desc(top, grp);
    }
    int oth[16];
#pragma unroll
    for (int i = 0; i < 16; ++i) oth[i] = __shfl_xor(top[i], 32);
    merge16_desc(top, oth);
}
__device__ __forceinline__ void route_unit(const Args& a, int g, int hd, int lane, LAS unsigned char* slot, const LAS unsigned char* skl, int* EIDo, float* GWo) {
    const int r32 = lane & 31, hi = lane >> 5; const int t = g * 32 + r32;
    const bf16* q = (const bf16*)(a.ws + WS_Q2) + (size_t)t * NQ + hd * 256;
    int k1[16], k2[16];
    top16_half(k1, q, skl, r32, hi);
    top16_half(k2, q + 128, skl + 128 * 272, r32, hi);
    { v4u w1, w2;
#define IDX4(v, j) (((unsigned)v[4 * (j)] & 127u) | (((unsigned)v[4 * (j) + 1] & 127u) << 8) | (((unsigned)v[4 * (j) + 2] & 127u) << 16) | (((unsigned)v[4 * (j) + 3] & 127u) << 24))
      w1 = (v4u){IDX4(k1, 0), IDX4(k1, 1), IDX4(k1, 2), IDX4(k1, 3)}; w2 = (v4u){IDX4(k2, 0), IDX4(k2, 1), IDX4(k2, 2), IDX4(k2, 3)};
#undef IDX4
      *(LAS v4u*)(slot) = w1; *(LAS v4u*)(slot + 16) = w2; }
    float v1[16], v2[16];
#pragma unroll
    for (int i = 0; i < 16; ++i) { v1[i] = __int_as_float(skey(k1[i])); v2[i] = __int_as_float(skey(k2[i])); }
#define CKEY(ia, ib) ((skey(__float_as_int(v1[ia] + v2[ib])) & ~255) | ((ia) * 16 + (ib)))
    int K[16], G1[16], G2[16];
#pragma unroll
    for (int i = 0; i < 16; ++i) K[i] = CKEY(0, i);
    { int n_ = 0;
#pragma unroll
      for (int ia = 1; ia < 16; ++ia)
#pragma unroll
          for (int ib = 0; ib < 16; ++ib) if ((ia + 1) * (ib + 1) <= 16) { const int kk = CKEY(ia, ib); if (n_ < 16) G1[n_] = kk; else if (n_ < 32) G2[n_ - 16] = kk; ++n_; }
    }
    sort16_desc(G1); merge16_desc(K, G1);
    sort16_desc(G2); merge16_desc(K, G2);
    { int x0 = CKEY(14, 0), x1 = CKEY(15, 0);
#pragma unroll
      for (int i = 0; i < 16; ++i) { CEI(K[i], x0); }
#pragma unroll
      for (int i = 0; i < 16; ++i) { CEI(K[i], x1); }
    }
#undef CKEY
    unsigned P[16]; float sc[16];
#pragma unroll
    for (int i = 0; i < 16; ++i) { const unsigned ci = (unsigned)K[i] & 255u; const unsigned i1 = slot[ci >> 4], i2 = slot[16 + (ci & 15u)]; P[i] = i1 * 128u + i2; sc[i] = __int_as_float(skey(K[i] & ~255)); }
    float ex[16], sum = 0.f;
#pragma unroll
    for (int i = 0; i < 16; ++i) { ex[i] = expf(sc[i] - sc[0]); sum += ex[i]; }
    const float inv = 1.0f / sum;
    if (hi == 0) {
        GAS v4u* eo = (GAS v4u*)(EIDo + (size_t)t * 128 + hd * 16); GAS f32x4* go = (GAS f32x4*)(GWo + (size_t)t * 128 + hd * 16);
#pragma unroll
        for (int j = 0; j < 4; ++j) { eo[j] = (v4u){P[4 * j], P[4 * j + 1], P[4 * j + 2], P[4 * j + 3]}; go[j] = (f32x4){ex[4 * j] * inv, ex[4 * j + 1] * inv, ex[4 * j + 2] * inv, ex[4 * j + 3] * inv}; }
    }
}

__device__ __forceinline__ float wave_max(float v) {
#pragma unroll
    for (int o = 1; o < 64; o <<= 1) v = fmaxf(v, __shfl_xor(v, o));
    return v;
}
__device__ __forceinline__ void route_unit_ref(const Args& a, int t, int hd, int lane, LAS float* sc) {
    LAS unsigned* sci = (LAS unsigned*)sc;
    const bf16* q = (const bf16*)(a.ws + WS_Q2) + (size_t)t * NQ + hd * 256;
#pragma unroll 1
    for (int half = 0; half < 2; ++half) {
        const float* sk = a.in[18 + half];
        float sa = 0.f, sb = 0.f;
        for (int d = 0; d < 128; ++d) { const float qv = bf2f(q[half * 128 + d]); sa += qv * sk[lane * 128 + d]; sb += qv * sk[(lane + 64) * 128 + d]; }
        for (int r = 0; r < 16; ++r) {
            const float mx = wave_max(fmaxf(sa, sb));
            const unsigned long long ba = __ballot(sa == mx), bb = __ballot(sb == mx);
            int key;
            if (ba) { const int ln = __ffsll((long long)ba) - 1; key = ln; if (lane == ln) sa = -INFINITY; }
            else { const int ln = __ffsll((long long)bb) - 1; key = ln + 64; if (lane == ln) sb = -INFINITY; }
            if (lane == 0) { sc[half * 32 + r] = mx; sci[half * 32 + 16 + r] = (unsigned)key; }
        }
    }
    __builtin_amdgcn_s_waitcnt(0);
    const int ca = lane >> 2, cb0 = (lane & 3) * 4;
    float c[4];
#pragma unroll
    for (int j = 0; j < 4; ++j) c[j] = sc[ca] + sc[32 + cb0 + j];
    for (int r = 0; r < 16; ++r) {
        const float mx = wave_max(fmaxf(fmaxf(c[0], c[1]), fmaxf(c[2], c[3])));
        const bool mine = (c[0] == mx) || (c[1] == mx) || (c[2] == mx) || (c[3] == mx);
        const unsigned long long bm = __ballot(mine); const int ln = __ffsll((long long)bm) - 1;
        if (lane == ln) { int j = (c[0] == mx) ? 0 : (c[1] == mx) ? 1 : (c[2] == mx) ? 2 : 3;
            if (j == 0) c[0] = -INFINITY; else if (j == 1) c[1] = -INFINITY; else if (j == 2) c[2] = -INFINITY; else c[3] = -INFINITY;
            sc[64 + r] = mx; sci[80 + r] = sci[16 + ca] * 128u + sci[48 + cb0 + j]; }
    }
    __builtin_amdgcn_s_waitcnt(0);
    if (lane < 16) {
        const float mx0 = sc[64]; const float ex = expf(sc[64 + lane] - mx0); float sum = ex;
        sum += __shfl_xor(sum, 1); sum += __shfl_xor(sum, 2); sum += __shfl_xor(sum, 4); sum += __shfl_xor(sum, 8);
        ((int*)(a.ws + WS_EID))[(size_t)t * 128 + hd * 16 + lane] = (int)sci[80 + lane];
        ((float*)(a.ws + WS_GW))[(size_t)t * 128 + hd * 16 + lane] = ex / sum;
    }
    __builtin_amdgcn_s_waitcnt(0);
}

__device__ __forceinline__ void unpack8(const v4u w, float* f) { f[0] = bflo(w.x); f[1] = bfhi(w.x); f[2] = bflo(w.y); f[3] = bfhi(w.y); f[4] = bflo(w.z); f[5] = bfhi(w.z); f[6] = bflo(w.w); f[7] = bfhi(w.w); }
__device__ __forceinline__ void gather_token(const Args& a, int t, int lane, float* dst) {
    const bf16* HB = (const bf16*)(a.ws + WS_HB) + (size_t)t * D; const bf16* ED = (const bf16*)(a.ws + WS_ED); const bf16* EU = (const bf16*)(a.ws + WS_EU);
    float hx[16];
    unpack8(*(const GAS v4u*)(HB + lane * 8), hx); unpack8(*(const GAS v4u*)(HB + 512 + lane * 8), hx + 8);
    const float rs2 = 1.0f / sqrtf(((const float*)(a.ws + WS_ROWSS2))[t] * (1.0f / 1024.0f) + EPSN);
    const int* EID = (const int*)(a.ws + WS_EID) + (size_t)t * 128; const float* GW = (const float*)(a.ws + WS_GW) + (size_t)t * 128;
    const int e0 = EID[lane], e1 = EID[64 + lane]; const float g0 = GW[lane], g1 = GW[64 + lane];
    float acc[16];
#pragma unroll
    for (int i = 0; i < 16; ++i) acc[i] = 0.f;
#pragma unroll 1
    for (int j = 0; j < 128; j += 4) {
        int ee[4]; float gg[4], dt[4];
#pragma unroll
        for (int k = 0; k < 4; ++k) { const int jj = j + k; ee[k] = __shfl(jj < 64 ? e0 : e1, jj & 63); gg[k] = __shfl(jj < 64 ? g0 : g1, jj & 63); }
        v4u da[4], db[4];
#pragma unroll
        for (int k = 0; k < 4; ++k) { const bf16* r = ED + (size_t)ee[k] * D; da[k] = *(const GAS v4u*)(r + lane * 8); db[k] = *(const GAS v4u*)(r + 512 + lane * 8); }
#pragma unroll
        for (int k = 0; k < 4; ++k) { float f[16]; unpack8(da[k], f); unpack8(db[k], f + 8); float s = 0.f;
#pragma unroll
            for (int i = 0; i < 16; ++i) s += f[i] * hx[i];
            dt[k] = s; }
#pragma unroll
        for (int o = 1; o < 64; o <<= 1) {
#pragma unroll
            for (int k = 0; k < 4; ++k) dt[k] += __shfl_xor(dt[k], o); }
#pragma unroll
        for (int k = 0; k < 4; ++k) { const bf16* r = EU + (size_t)ee[k] * D; da[k] = *(const GAS v4u*)(r + lane * 8); db[k] = *(const GAS v4u*)(r + 512 + lane * 8); }
#pragma unroll
        for (int k = 0; k < 4; ++k) { const float w = gg[k] * gelu_tanh(dt[k] * rs2); float f[16]; unpack8(da[k], f); unpack8(db[k], f + 8);
#pragma unroll
            for (int i = 0; i < 16; ++i) acc[i] += w * f[i]; }
    }
    const float* orow = a.out + (size_t)t * D; float* drow = dst + (size_t)t * D; const float* gf = a.in[22];
    f32x4 h0 = *(const GAS f32x4*)(orow + lane * 8), h1 = *(const GAS f32x4*)(orow + lane * 8 + 4), h2 = *(const GAS f32x4*)(orow + 512 + lane * 8), h3 = *(const GAS f32x4*)(orow + 512 + lane * 8 + 4);
    h0 += (f32x4){acc[0], acc[1], acc[2], acc[3]}; h1 += (f32x4){acc[4], acc[5], acc[6], acc[7]}; h2 += (f32x4){acc[8], acc[9], acc[10], acc[11]}; h3 += (f32x4){acc[12], acc[13], acc[14], acc[15]};
    float ss = (h0.x * h0.x + h0.y * h0.y) + (h0.z * h0.z + h0.w * h0.w) + (h1.x * h1.x + h1.y * h1.y) + (h1.z * h1.z + h1.w * h1.w)
             + (h2.x * h2.x + h2.y * h2.y) + (h2.z * h2.z + h2.w * h2.w) + (h3.x * h3.x + h3.y * h3.y) + (h3.z * h3.z + h3.w * h3.w);
    ss = wave_sum(ss);
    const float ri = 1.0f / sqrtf(ss * (1.0f / 1024.0f) + EPSN);
    const f32x4 f0 = *(const GAS f32x4*)(gf + lane * 8), f1 = *(const GAS f32x4*)(gf + lane * 8 + 4), f2 = *(const GAS f32x4*)(gf + 512 + lane * 8), f3 = *(const GAS f32x4*)(gf + 512 + lane * 8 + 4);
    *(GAS f32x4*)(drow + lane * 8) = h0 * ri * f0; *(GAS f32x4*)(drow + lane * 8 + 4) = h1 * ri * f1;
    *(GAS f32x4*)(drow + 512 + lane * 8) = h2 * ri * f2; *(GAS f32x4*)(drow + 512 + lane * 8 + 4) = h3 * ri * f3;
}


template <int CTRL> __device__ __forceinline__ float dpp_add(float v) { return v + __int_as_float(__builtin_amdgcn_update_dpp(0, __float_as_int(v), CTRL, 0xf, 0xf, false)); }
__device__ __forceinline__ float row16_sum(float v) { v = dpp_add<0x140>(v); v = dpp_add<0x141>(v); v = dpp_add<0x4E>(v); v = dpp_add<0xB1>(v); return v; }
__device__ __forceinline__ unsigned long long lanemask_lt(int lane) { return (1ull << lane) - 1ull; }
__device__ __forceinline__ void glds16g(const void* gsrc, unsigned lds_dst) { unsigned keep;
    asm volatile("s_mov_b32 %0, m0\n\ts_mov_b32 m0, %2\n\ts_nop 0\n\tglobal_load_lds_dwordx4 %1, off\n\ts_mov_b32 m0, %0" : "=&s"(keep) : "v"(gsrc), "s"(lds_dst) : "memory"); }

__device__ __forceinline__ void glds16x4(const void* sbase, unsigned o0, unsigned o1, unsigned o2, unsigned o3, unsigned d0, unsigned d1, unsigned d2, unsigned d3) { unsigned keep;
    asm volatile("s_mov_b32 %0, m0\n\ts_mov_b32 m0, %6\n\ts_nop 0\n\tglobal_load_lds_dwordx4 %1, %5\n\ts_mov_b32 m0, %7\n\ts_nop 0\n\tglobal_load_lds_dwordx4 %2, %5\n\t"
                 "s_mov_b32 m0, %8\n\ts_nop 0\n\tglobal_load_lds_dwordx4 %3, %5\n\ts_mov_b32 m0, %9\n\ts_nop 0\n\tglobal_load_lds_dwordx4 %4, %5\n\ts_mov_b32 m0, %0"
                 : "=&s"(keep) : "v"(o0), "v"(o1), "v"(o2), "v"(o3), "s"(sbase), "s"(d0), "s"(d1), "s"(d2), "s"(d3) : "memory"); }
typedef __bf16 bf2_t __attribute__((ext_vector_type(2)));
__device__ __forceinline__ float dot2bf(unsigned a, unsigned b, float c) { return __builtin_amdgcn_fdot2_f32_bf16(__builtin_bit_cast(bf2_t, a), __builtin_bit_cast(bf2_t, b), c, false); }
__device__ __forceinline__ void compact_token(const Args& a, int t, int lane) {
    const int* EID = (const int*)(a.ws + WS_EID) + (size_t)t * 128; const float* GW = (const float*)(a.ws + WS_GW) + (size_t)t * 128;
    const int e0 = EID[lane], e1 = EID[64 + lane]; const float g0 = GW[lane], g1 = GW[64 + lane];
    const bool p0 = e0 < 8192, p1 = e1 < 8192;
    const unsigned long long m0 = __ballot(p0), m1 = __ballot(p1), lt = lanemask_lt(lane);
    const int c0 = __popcll(m0), n0 = c0 + __popcll(m1);
    const int pos0 = p0 ? __popcll(m0 & lt) : n0 + __popcll(~m0 & lt);
    const int pos1 = p1 ? c0 + __popcll(m1 & lt) : n0 + (64 - c0) + __popcll(~m1 & lt);
    unsigned* R = (unsigned*)(a.ws + WS_REC) + (size_t)t * 128;
    R[pos0] = (unsigned)e0 | (f2bf(g0) << 16); R[pos1] = (unsigned)e1 | (f2bf(g1) << 16);
    if (lane == 0) ((int*)(a.ws + WS_N0))[t] = n0;
}
template <int NT> __device__ __forceinline__ void w_tokens(const Args& a, int t0, int lane) {
    float d0[NT], d1[NT], sd0[NT], sd1[NT], su0[NT], su1[NT]; unsigned r0[NT], r1[NT]; float ss[NT];
#pragma unroll
    for (int i = 0; i < NT; ++i) { const float* DP = (const float*)(a.ws + WS_DOTP) + (size_t)(t0 + i) * 1024; const unsigned* R = (const unsigned*)(a.ws + WS_REC) + (size_t)(t0 + i) * 128;
        float p0[8], p1[8];
#pragma unroll
        for (int x = 0; x < 8; ++x) { p0[x] = DP[x * 128 + lane]; p1[x] = DP[x * 128 + 64 + lane]; }
        r0[i] = R[lane]; r1[i] = R[64 + lane]; ss[i] = ((const float*)(a.ws + WS_ROWSS2))[t0 + i];
        sd0[i] = ((const float*)(a.ws + WS_SCD))[r0[i] & 0x3fffu]; sd1[i] = ((const float*)(a.ws + WS_SCD))[r1[i] & 0x3fffu];
        su0[i] = ((const float*)(a.ws + WS_SCU))[r0[i] & 0x3fffu]; su1[i] = ((const float*)(a.ws + WS_SCU))[r1[i] & 0x3fffu];
        d0[i] = ((p0[0] + p0[1]) + (p0[2] + p0[3])) + ((p0[4] + p0[5]) + (p0[6] + p0[7])); d1[i] = ((p1[0] + p1[1]) + (p1[2] + p1[3])) + ((p1[4] + p1[5]) + (p1[6] + p1[7])); }
#pragma unroll
    for (int i = 0; i < NT; ++i) { const float rs2 = 1.0f / sqrtf(ss[i] * (1.0f / 1024.0f) + EPSN);
        const float w0 = bfhi(r0[i]) * fgelu_tanh(d0[i] * sd0[i] * rs2) * su0[i], w1 = bfhi(r1[i]) * fgelu_tanh(d1[i] * sd1[i] * rs2) * su1[i];
        float m0 = fabsf(w0), m1 = fabsf(w1);
#pragma unroll
        for (int o = 1; o < 64; o <<= 1) { m0 = fmaxf(m0, __shfl_xor(m0, o)); m1 = fmaxf(m1, __shfl_xor(m1, o)); }
        const float s0 = (m0 > 0.f) ? m0 * (1.0f / 127.0f) : 1.0f, s1 = (m1 > 0.f) ? m1 * (1.0f / 127.0f) : 1.0f;
        unsigned char* WQ = a.ws + WS_WQ8 + (size_t)(t0 + i) * 144;
        WQ[lane] = (unsigned char)((int)__builtin_rintf(w0 / s0) & 255); WQ[64 + lane] = (unsigned char)((int)__builtin_rintf(w1 / s1) & 255);
        if (lane == 0) { ((float*)(WQ + 128))[0] = s0; ((float*)(WQ + 128))[1] = s1; } }
}
template <bool IS_UP> __device__ __forceinline__ void sweep_slice(const Args& a, int x, int wv, int lane, unsigned ring, LAS unsigned char* ringp, unsigned aux, LAS unsigned char* auxp) {
    const int g = lane >> 4, li = lane & 15, n16 = li, kg = g;
    const char* TABx = (const char*)(a.ws + (IS_UP ? WS_EU : WS_ED)) + x * 256;
    unsigned jofs[4];
#pragma unroll
    for (int q = 0; q < 4; ++q) jofs[q] = (unsigned)((li ^ ((g << 2) | q)) * 16);
    const unsigned pd = (unsigned)__builtin_amdgcn_readfirstlane(ring);
#pragma unroll 1
    for (int s_ = 0; s_ < 128; ++s_) {
        const int r = s_ >> 6, k = s_ & 63, t = wv * 64 + k, base = 64 * r;
        const LAS unsigned* rec = (const LAS unsigned*)(auxp + (k & 3) * 512) + base;
        const LAS unsigned char* hp = auxp + 2048 + (k & 3) * 256;
        asm volatile("s_waitcnt lgkmcnt(0)" ::: "memory");
        if ((k & 3) == 0) {
            const char* rsrc = (const char*)(a.ws + WS_REC) + (size_t)t * 512 + lane * 16;
            glds16g(rsrc, (unsigned)__builtin_amdgcn_readfirstlane(aux)); glds16g(rsrc + 1024, (unsigned)__builtin_amdgcn_readfirstlane(aux + 1024));
            if (!IS_UP) glds16g((const char*)(a.ws + WS_HB) + (size_t)(t + g) * 2048 + x * 256 + li * 16, (unsigned)__builtin_amdgcn_readfirstlane(aux + 2048));
            asm volatile("s_waitcnt vmcnt(0)" ::: "memory");
        }
        {
            unsigned so[16];
#pragma unroll
            for (int p = 0; p < 16; ++p) so[p] = rec[4 * p + g];
#pragma unroll
            for (int p = 0; p < 16; ++p) so[p] = ((so[p] & 0x3fffu) << 11) + jofs[p & 3];
            glds16x4(TABx, so[0], so[1], so[2], so[3], pd, pd + 1024u, pd + 2048u, pd + 3072u);
            glds16x4(TABx, so[4], so[5], so[6], so[7], pd + 4096u, pd + 5120u, pd + 6144u, pd + 7168u);
            glds16x4(TABx, so[8], so[9], so[10], so[11], pd + 8192u, pd + 9216u, pd + 10240u, pd + 11264u);
            glds16x4(TABx, so[12], so[13], so[14], so[15], pd + 12288u, pd + 13312u, pd + 14336u, pd + 15360u);
        }
        asm volatile("s_waitcnt vmcnt(0)" ::: "memory");
        if (!IS_UP) {
            bf16x8 hb[4];
#pragma unroll
            for (int q = 0; q < 4; ++q) hb[q] = *(const LAS bf16x8*)(hp + (32 * q + 8 * kg) * 2);
            f32x4 res = (f32x4){0.f, 0.f, 0.f, 0.f};
#pragma unroll
            for (int rb = 0; rb < 4; ++rb) {
                f32x4 d = (f32x4){0.f, 0.f, 0.f, 0.f}; const int row = n16 + 16 * rb; const int key = ((row & 3) << 2) | ((row >> 2) & 3);
#pragma unroll
                for (int q = 0; q < 4; ++q) { const bf16x8 af = *(const LAS bf16x8*)(ringp + 256 * row + 16 * ((4 * q + kg) ^ key)); d = __builtin_amdgcn_mfma_f32_16x16x32_bf16(af, hb[q], d, 0, 0, 0); }
                res = (n16 == rb) ? d : res; }
            if (n16 < 4) *(GAS f32x4*)((float*)(a.ws + WS_DOTP) + ((size_t)t * 8 + x) * 128 + base + 16 * n16 + 4 * kg) = res;
        } else {
            f32x4 pacc[8];
#pragma unroll
            for (int i = 0; i < 8; ++i) pacc[i] = (f32x4){0.f, 0.f, 0.f, 0.f};
            const int q4 = n16 >> 2, p4 = lane & 3;
#pragma unroll
            for (int ks = 0; ks < 2; ++ks) {
                const v4u wa = *(const LAS v4u*)(rec + 32 * ks + 8 * kg), wb = *(const LAS v4u*)(rec + 32 * ks + 8 * kg + 4);
                const bf16x8 af = __builtin_bit_cast(bf16x8, (v4u){(wa.x >> 16) | (wa.y & 0xffff0000u), (wa.z >> 16) | (wa.w & 0xffff0000u), (wb.x >> 16) | (wb.y & 0xffff0000u), (wb.z >> 16) | (wb.w & 0xffff0000u)});
#pragma unroll
                for (int c = 0; c < 8; ++c) {
                    const int row0 = 32 * ks + 8 * kg + q4, row1 = row0 + 4; const int ch = 2 * c + (p4 >> 1);
                    const int k0 = ((row0 & 3) << 2) | ((row0 >> 2) & 3), k1 = ((row1 & 3) << 2) | ((row1 >> 2) & 3);
                    const attn_body::s16x4 lo4 = attn_body::vtr((attn_body::lds_cptr)(ringp + 256 * row0 + 16 * (ch ^ k0) + 8 * (p4 & 1)));
                    const attn_body::s16x4 hi4 = attn_body::vtr((attn_body::lds_cptr)(ringp + 256 * row1 + 16 * (ch ^ k1) + 8 * (p4 & 1)));
                    const bf16x8 bfr = (bf16x8){lo4[0], lo4[1], lo4[2], lo4[3], hi4[0], hi4[1], hi4[2], hi4[3]};
                    pacc[c] = __builtin_amdgcn_mfma_f32_16x16x32_bf16(af, bfr, pacc[c], 0, 0, 0); }
            }
            const float v0 = (kg == 0) ? pacc[0][0] : (kg == 1) ? pacc[1][0] : (kg == 2) ? pacc[2][0] : pacc[3][0];
            const float v1 = (kg == 0) ? pacc[4][0] : (kg == 1) ? pacc[5][0] : (kg == 2) ? pacc[6][0] : pacc[7][0];
            bf16* po = (bf16*)(a.ws + WS_PEER) + ((size_t)r * M + t) * D + x * 128;
            po[lane] = (bf16)f2bf(v0); po[64 + lane] = (bf16)f2bf(v1);
        }
    }
}
typedef int i32x4 __attribute__((ext_vector_type(4)));
__device__ __forceinline__ void sweep_down_q8(const Args& a, int x, int wv, int lane, unsigned ring, LAS unsigned char* ringp, unsigned aux, LAS unsigned char* auxp) {
    const int g = lane >> 4, li = lane & 15, n16 = li, kg = g, g8 = lane >> 3, s8 = lane & 7;
    const char* TABx = (const char*)(a.ws + WS_ED) + x * 128;
    unsigned jofs[2];
#pragma unroll
    for (int b = 0; b < 2; ++b) jofs[b] = (unsigned)((s8 ^ (4 * b + (g8 >> 1))) * 16);
    const unsigned pd = (unsigned)__builtin_amdgcn_readfirstlane(ring);
    LAS unsigned char* hq = auxp + 3072; LAS float* hsc = (LAS float*)(auxp + 3072 + 512);
#pragma unroll 1
    for (int s_ = 0; s_ < 128; ++s_) {
        const int r = s_ >> 6, k = s_ & 63, t = wv * 64 + k, base = 64 * r;
        const LAS unsigned* rec = (const LAS unsigned*)(auxp + (k & 3) * 512) + base;
        asm volatile("s_waitcnt lgkmcnt(0)" ::: "memory");
        if ((k & 3) == 0) {
            const char* rsrc = (const char*)(a.ws + WS_REC) + (size_t)t * 512 + lane * 16;
            glds16g(rsrc, (unsigned)__builtin_amdgcn_readfirstlane(aux)); glds16g(rsrc + 1024, (unsigned)__builtin_amdgcn_readfirstlane(aux + 1024));
            glds16g((const char*)(a.ws + WS_HB) + (size_t)(t + g) * 2048 + x * 256 + li * 16, (unsigned)__builtin_amdgcn_readfirstlane(aux + 2048));
            asm volatile("s_waitcnt vmcnt(0)" ::: "memory");
            {
                const v4u hb = *(const LAS v4u*)(auxp + 2048 + lane * 16); float f[8]; unpack8(hb, f);
                float am = fmaxf(fmaxf(fmaxf(fabsf(f[0]), fabsf(f[1])), fmaxf(fabsf(f[2]), fabsf(f[3]))), fmaxf(fmaxf(fabsf(f[4]), fabsf(f[5])), fmaxf(fabsf(f[6]), fabsf(f[7]))));
                am = fmaxf(am, __int_as_float(__builtin_amdgcn_update_dpp(0, __float_as_int(am), 0x140, 0xf, 0xf, false))); am = fmaxf(am, __int_as_float(__builtin_amdgcn_update_dpp(0, __float_as_int(am), 0x141, 0xf, 0xf, false)));
                am = fmaxf(am, __int_as_float(__builtin_amdgcn_update_dpp(0, __float_as_int(am), 0x4E, 0xf, 0xf, false))); am = fmaxf(am, __int_as_float(__builtin_amdgcn_update_dpp(0, __float_as_int(am), 0xB1, 0xf, 0xf, false)));
                const float sc = (am > 0.f) ? am * (1.0f / 127.0f) : 1.0f, inv = 1.0f / sc;
                unsigned qw[2];
#pragma unroll
                for (int h2 = 0; h2 < 2; ++h2) { const int q0 = (int)__builtin_rintf(f[4 * h2] * inv), q1 = (int)__builtin_rintf(f[4 * h2 + 1] * inv), q2 = (int)__builtin_rintf(f[4 * h2 + 2] * inv), q3 = (int)__builtin_rintf(f[4 * h2 + 3] * inv);
                    qw[h2] = ((unsigned)q0 & 255u) | (((unsigned)q1 & 255u) << 8) | (((unsigned)q2 & 255u) << 16) | ((unsigned)q3 << 24); }
                *(LAS unsigned long long*)(hq + lane * 8) = (unsigned long long)qw[0] | ((unsigned long long)qw[1] << 32);
                if (li == 0) hsc[g] = sc; }
        }
        {   unsigned so[8];
#pragma unroll
            for (int i = 0; i < 8; ++i) so[i] = rec[8 * i + g8];
#pragma unroll
            for (int i = 0; i < 8; ++i) so[i] = ((so[i] & 0x3fffu) << 10) + jofs[i & 1];
            glds16x4(TABx, so[0], so[1], so[2], so[3], pd, pd + 1024u, pd + 2048u, pd + 3072u);
            glds16x4(TABx, so[4], so[5], so[6], so[7], pd + 4096u, pd + 5120u, pd + 6144u, pd + 7168u);
        }
        asm volatile("s_waitcnt vmcnt(0)" ::: "memory");
        const i32x4 hb0 = *(const LAS i32x4*)(hq + (k & 3) * 128 + 16 * kg), hb1 = *(const LAS i32x4*)(hq + (k & 3) * 128 + 64 + 16 * kg);
        const float hs = hsc[k & 3];
        i32x4 res = (i32x4){0, 0, 0, 0};
#pragma unroll
        for (int rb = 0; rb < 4; ++rb) {
            const int row = n16 + 16 * rb; const int key = (row >> 1) & 7;
            const i32x4 a0 = *(const LAS i32x4*)(ringp + row * 128 + ((kg ^ key) * 16)), a1 = *(const LAS i32x4*)(ringp + row * 128 + (((4 + kg) ^ key) * 16));
            i32x4 d = __builtin_amdgcn_mfma_i32_16x16x64_i8(a0, hb0, (i32x4){0, 0, 0, 0}, 0, 0, 0); d = __builtin_amdgcn_mfma_i32_16x16x64_i8(a1, hb1, d, 0, 0, 0);
            res = (n16 == rb) ? d : res; }
        if (n16 < 4) *(GAS f32x4*)((float*)(a.ws + WS_DOTP) + ((size_t)t * 8 + x) * 128 + base + 16 * n16 + 4 * kg) = (f32x4){(float)res[0] * hs, (float)res[1] * hs, (float)res[2] * hs, (float)res[3] * hs};
    }
}

__device__ __forceinline__ void sweep_up_q8(const Args& a, int x, int wv, int lane, unsigned ring, LAS unsigned char* ringp, unsigned aux, LAS unsigned char* auxp) {
    const int n16 = lane & 15, kg = lane >> 4, g8 = lane >> 3, s8 = lane & 7;
    const char* TABx = (const char*)(a.ws + WS_EU) + x * 128;
    unsigned jofs[2];
#pragma unroll
    for (int b = 0; b < 2; ++b) jofs[b] = (unsigned)((s8 ^ ((g8 >> 1) | (b << 2))) * 16);
    const unsigned pd = (unsigned)__builtin_amdgcn_readfirstlane(ring);
    typedef int v2i_t __attribute__((ext_vector_type(2)));
#pragma unroll 1
    for (int s_ = 0; s_ < 128; ++s_) {
        const int r = s_ >> 6, k = s_ & 63, t = wv * 64 + k, base = 64 * r;
        const LAS unsigned* rec = (const LAS unsigned*)(auxp + (k & 3) * 512) + base;
        const LAS unsigned char* wq = auxp + 2048 + (k & 3) * 144;
        asm volatile("s_waitcnt lgkmcnt(0)" ::: "memory");
        if ((k & 3) == 0) {
            const char* rsrc = (const char*)(a.ws + WS_REC) + (size_t)t * 512 + lane * 16;
            glds16g(rsrc, (unsigned)__builtin_amdgcn_readfirstlane(aux)); glds16g(rsrc + 1024, (unsigned)__builtin_amdgcn_readfirstlane(aux + 1024));
            if (lane < 36) glds16g((const char*)(a.ws + WS_WQ8) + (size_t)t * 144 + lane * 16, (unsigned)__builtin_amdgcn_readfirstlane(aux + 2048));
            asm volatile("s_waitcnt vmcnt(0)" ::: "memory");
        }
        {   unsigned so[8];
#pragma unroll
            for (int i = 0; i < 8; ++i) so[i] = rec[8 * i + g8];
#pragma unroll
            for (int i = 0; i < 8; ++i) so[i] = ((so[i] & 0x3fffu) << 10) + jofs[(i >> 1) & 1];
            glds16x4(TABx, so[0], so[1], so[2], so[3], pd, pd + 1024u, pd + 2048u, pd + 3072u);
            glds16x4(TABx, so[4], so[5], so[6], so[7], pd + 4096u, pd + 5120u, pd + 6144u, pd + 7168u);
        }
        asm volatile("s_waitcnt vmcnt(0)" ::: "memory");
        const i32x4 aw = *(const LAS i32x4*)(wq + 64 * r + 16 * kg);
        const float wsc = *(const LAS float*)(wq + 128 + 4 * r);
        const int i2 = n16 >> 1, ih = n16 & 1;
        const int row0 = 16 * kg + i2, row1 = row0 + 8;
        const int k0 = ((row0 >> 1) & 3) | (((row0 >> 4) & 1) << 2), k1 = ((row1 >> 1) & 3) | (((row1 >> 4) & 1) << 2);
        const LAS unsigned char* p0 = ringp + row0 * 128 + 8 * ih; const LAS unsigned char* p1 = ringp + row1 * 128 + 8 * ih;
        float outv[8];
#pragma unroll
        for (int c = 0; c < 8; ++c) {
            const v2i_t lo = __builtin_amdgcn_ds_read_tr8_b64_v2i32((LAS v2i_t*)(p0 + ((c ^ k0) * 16)));
            const v2i_t hi = __builtin_amdgcn_ds_read_tr8_b64_v2i32((LAS v2i_t*)(p1 + ((c ^ k1) * 16)));
            const i32x4 d = __builtin_amdgcn_mfma_i32_16x16x64_i8(aw, (i32x4){lo.x, lo.y, hi.x, hi.y}, (i32x4){0, 0, 0, 0}, 0, 0, 0);
            outv[c] = (float)d[0] * wsc; }
        const float v0 = (kg == 0) ? outv[0] : (kg == 1) ? outv[1] : (kg == 2) ? outv[2] : outv[3];
        const float v1 = (kg == 0) ? outv[4] : (kg == 1) ? outv[5] : (kg == 2) ? outv[6] : outv[7];
        bf16* po = (bf16*)(a.ws + WS_PEER) + ((size_t)r * M + t) * D + x * 128;
        po[lane] = (bf16)f2bf(v0); po[64 + lane] = (bf16)f2bf(v1);
    }
}

__device__ __forceinline__ void final_row(const Args& a, int t, int lane) {
    float* orow = a.out + (size_t)t * D; const float* gf = a.in[22];
    const bf16* P0 = (const bf16*)(a.ws + WS_PEER) + (size_t)t * D; const bf16* P1 = P0 + (size_t)M * D;
    f32x4 h[4]; float ss = 0.f;
#pragma unroll
    for (int j = 0; j < 4; ++j) { h[j] = ((const GAS f32x4*)orow)[lane + 64 * j];
        const unsigned long long p = ((const GAS unsigned long long*)P0)[lane + 64 * j], q = ((const GAS unsigned long long*)P1)[lane + 64 * j];
        h[j].x += bflo((unsigned)p) + bflo((unsigned)q); h[j].y += bfhi((unsigned)p) + bfhi((unsigned)q); h[j].z += bflo((unsigned)(p >> 32)) + bflo((unsigned)(q >> 32)); h[j].w += bfhi((unsigned)(p >> 32)) + bfhi((unsigned)(q >> 32));
        ss += (h[j].x * h[j].x + h[j].y * h[j].y) + (h[j].z * h[j].z + h[j].w * h[j].w); }
    ss = wave_sum(ss);
    const float ri = 1.0f / sqrtf(ss * (1.0f / 1024.0f) + EPSN);
#pragma unroll
    for (int j = 0; j < 4; ++j) ((GAS f32x4*)orow)[lane + 64 * j] = h[j] * ri * ((const GAS f32x4*)gf)[lane + 64 * j];
}

__device__ __forceinline__ float a_dot64(const float* p, const float* q, int lane) { return wave_sum(p[lane] * q[lane]); }
constexpr int N_PHASES = 12;
#ifndef ROUTE_REF
#define ROUTE_REF 0
#endif
#ifndef MK_ONE_LAUNCH
#define MK_ONE_LAUNCH 1
#endif
__global__ void __launch_bounds__(NWAVES * 64, 2) fwd_mega(Args args) {
    extern __shared__ __attribute__((aligned(16))) unsigned char lds[];
    Frame F;
    F.lds = (LAS unsigned char*)lds;
    F.MISC = (volatile LAS unsigned*)(F.lds + MISC_OFF);
    F.tid = threadIdx.x; F.lane = F.tid & 63; F.wave = __builtin_amdgcn_readfirstlane(F.tid >> 6);
    F.G = gridDim.x; { const int bx = blockIdx.x; F.vcu = (F.G % 8 == 0) ? (bx % 8) * (F.G / 8) + bx / 8 : bx; }
    unsigned char* ws = args.ws;
    const int lo = args.ph_lo, hi = args.ph_hi;
#ifndef PH_MASK
#define PH_MASK 0xffff
#endif
#define IN(k) (((PH_MASK >> (k)) & 1) && lo <= (k) && (k) < hi)
#define BOTH(k) (IN(k) && IN((k) + 1))
#if MK_ONE_LAUNCH
    for (int u = F.tid; u < (LDS_BYTES - LDSCTL_OFF) / 4; u += NWAVES * 64) ((LAS unsigned*)(F.lds + LDSCTL_OFF))[u] = 0u;
    __syncthreads();
    const XcdBarrier xbar = xcd_barrier_post((unsigned*)(ws + WS_CTL) + CW_BAR, F.MISC + 8);
    bool first_seam = args.ph_lo < 0;
#define GRID_BAR() do { if (first_seam) { __threadfence(); cooperative_groups::this_grid().sync(); first_seam = false; } else xcd_barrier(xbar); } while (0)
#else
#define GRID_BAR() do { } while (0)
#endif
#ifndef REP_PH
#define REP_PH -1
#endif
#define RUN_PHASE(k, ...) do { if (IN(k)) { if ((k) == REP_PH) { { const bool first_of_two = true; (void)first_of_two; __VA_ARGS__ } GRID_BAR(); } { const bool first_of_two = false; (void)first_of_two; __VA_ARGS__ } if (BOTH(k)) GRID_BAR(); } } while (0)
    RUN_PHASE(0, { p0_prologue(F, args); });
    RUN_PHASE(1, {
        pg8::Gemm g{(const pg8::bf16_t*)(ws + WS_XB), (const pg8::bf16_t*)(ws + WS_WIN), M, INC, D}; pg8::StaticOrder S; S.init(M, INC, F.G, (int)blockIdx.x);
        pg8::EpiBf16<1> E{(pg8::bf16_t*)(ws + WS_Q), 512, (const float*)(ws + WS_RS1), 512, (size_t)WS_SPLIT / 2, attn_body::C2};
        pg8::gemm_phase<pg8::EpiBf16<1>, pg8::StaticOrder, true, true>(F.lds + RING_OFF, g, S, E);
        { const int nb = (F.G >= 2) ? (int)F.G / 2 : 1; const int bi = (int)blockIdx.x - ((int)F.G - nb); if (bi >= 0) convert_experts(args, bi * NWAVES + F.wave, nb * NWAVES, F.lane); }
    });
    RUN_PHASE(2, {
        for (int c = F.vcu; c < M / 64; c += F.G) lru_local_unit(F, args, c);
        const attn128::AttnTensors AT{(const attn128::bf16*)(ws + WS_Q), (const attn128::bf16*)(ws + WS_Q + WS_SPLIT), (const attn128::bf16*)(ws + WS_Q + 2 * WS_SPLIT), (attn128::bf16*)(ws + WS_OS)};
        const attn128::StaticOrder S(F.vcu);
        attn128::attn_phase<attn128::StaticOrder>((char*)lds + RING_OFF, AT, S);
    });
    RUN_PHASE(3, {
        float l1 = a_dot64(args.in[3], args.in[4], F.lane); float l2 = a_dot64(args.in[5], args.in[6], F.lane);
        const float lamv = expf(l1) - expf(l2) + 0.2f;
        for (int c = F.vcu; c < M / 64; c += F.G) fix_unit(F, args, c, lamv);
    });
    RUN_PHASE(4, {
        pg8::Gemm g{(const pg8::bf16_t*)(ws + WS_MIX), (const pg8::bf16_t*)(ws + WS_WOUT), M, D, D}; pg8::StaticOrder S; S.init(M, D, F.G, (int)blockIdx.x);
        pg8::EpiResid E{args.in[0], args.out, (pg8::bf16_t*)(ws + WS_HB), (float*)(ws + (first_of_two ? WS_RS1 : WS_ROWSS2)), D};
        pg8::gemm_phase<pg8::EpiResid, pg8::StaticOrder, true, true>(F.lds + RING_OFF, g, S, E);
    });
    RUN_PHASE(5, {
        pg8::Gemm g{(const pg8::bf16_t*)(ws + WS_HB), (const pg8::bf16_t*)(ws + WS_WQ), M, NQ, D}; pg8::StaticOrder S; S.init(M, NQ, F.G, (int)blockIdx.x);
        pg8::EpiBf16<2> E{(pg8::bf16_t*)(ws + WS_Q2), NQ, (const float*)(ws + WS_ROWSS2), 0, 0, 1.f};
        pg8::gemm_phase<pg8::EpiBf16<2>, pg8::StaticOrder, true, true>(F.lds + RING_OFF, g, S, E);
    });
    RUN_PHASE(6, {
        const int gw = F.vcu * NWAVES + F.wave; const int NGW = F.G * NWAVES;
        LAS unsigned char* skl = F.lds + RING_OFF + 16384;
        for (int c = F.tid; c < 4096; c += NWAVES * 64) { const int row = c >> 4; const int ch = c & 15; *(LAS v4u*)(skl + row * 272 + ch * 16) = *(const GAS v4u*)(ws + WS_SK1 + (size_t)row * 256 + ch * 16); }
        __syncthreads();
        for (int u = gw; u < (M / 32) * 8; u += NGW) route_unit(args, u >> 3, u & 7, F.lane, F.lds + RING_OFF + F.tid * 32, skl, (int*)(ws + WS_EID), (float*)(ws + WS_GW));
        __syncthreads();
    });
    RUN_PHASE(7, {
        const int gw = F.vcu * NWAVES + F.wave; const int NGW = F.G * NWAVES;
        for (int t = gw; t < M; t += NGW) compact_token(args, t, F.lane);
    });
    RUN_PHASE(8, {
        if (F.G == 256) sweep_down_q8(args, F.vcu >> 5, (F.vcu & 31) * NWAVES + F.wave, F.lane, (unsigned)(uintptr_t)(lds + RING_OFF) + F.wave * 16384u, F.lds + RING_OFF + F.wave * 16384, (unsigned)(uintptr_t)(lds + LDSCTL_OFF + 1024) + F.wave * 3712u, F.lds + LDSCTL_OFF + 1024 + F.wave * 3712);
    });
    RUN_PHASE(9, {
        const int gw = F.vcu * NWAVES + F.wave; const int NGW = F.G * NWAVES;
        for (int t = 4 * gw; t < M; t += 4 * NGW) w_tokens<4>(args, t, F.lane);
    });
    RUN_PHASE(10, {
        if (F.G == 256) sweep_up_q8(args, F.vcu >> 5, (F.vcu & 31) * NWAVES + F.wave, F.lane, (unsigned)(uintptr_t)(lds + RING_OFF) + F.wave * 16384u, F.lds + RING_OFF + F.wave * 16384, (unsigned)(uintptr_t)(lds + LDSCTL_OFF + 1024) + F.wave * 3712u, F.lds + LDSCTL_OFF + 1024 + F.wave * 3712);
    });
    RUN_PHASE(11, {
        const int gw = F.vcu * NWAVES + F.wave; const int NGW = F.G * NWAVES;
        for (int t = gw; t < M; t += NGW) final_row(args, t, F.lane);
    });
#undef IN
#undef BOTH
}

extern "C" void kernel_launch(void* const* d_in, const int* in_sizes, int n_in, void* d_out, int out_size, void* d_ws, size_t ws_size, hipStream_t stream) {
    static int grid = 0;
    if (grid == 0) {
        if (n_in != 23 || out_size != M * D || ws_size < WS_END) { fprintf(stderr, "kernel_launch: unexpected problem: n_in %d out %d ws %zu\n", n_in, out_size, ws_size); grid = -1; return; }
        int dev = 0, cus = 0, per_cu = 0;
        if (hipGetDevice(&dev) != hipSuccess || hipDeviceGetAttribute(&cus, hipDeviceAttributeMultiprocessorCount, dev) != hipSuccess) { grid = -1; return; }
        if (hipFuncSetAttribute((const void*)fwd_mega, hipFuncAttributeMaxDynamicSharedMemorySize, LDS_BYTES) != hipSuccess) { fprintf(stderr, "kernel_launch: hipFuncSetAttribute failed\n"); grid = -1; return; }
        if (hipOccupancyMaxActiveBlocksPerMultiprocessor(&per_cu, (const void*)fwd_mega, NWAVES * 64, LDS_BYTES) != hipSuccess || per_cu < 1) { fprintf(stderr, "kernel_launch: occupancy query reports %d\n", per_cu); per_cu = 1; }
        (void)hipGetLastError();
        grid = cus;
    }
    if (grid < 0) return;
    (void)hipMemsetAsync((char*)d_ws + WS_CTL, 0, CTL_ZERO_BYTES, stream);
    Args a{};
    for (int i = 0; i < 23; ++i) a.in[i] = (const float*)d_in[i];
    a.out = (float*)d_out; a.ws = (unsigned char*)d_ws;
#if MK_ONE_LAUNCH
    a.ph_lo = 0; a.ph_hi = N_PHASES;
    void* kargs[] = {&a};
    hipError_t e = hipLaunchCooperativeKernel((const void*)fwd_mega, dim3(grid), dim3(NWAVES * 64), kargs, LDS_BYTES, stream);
    if (e != hipSuccess) fprintf(stderr, "cooperative launch failed: %s (grid %d)\n", hipGetErrorString(e), grid);
#else
    for (int p = 0; p < N_PHASES; ++p) { a.ph_lo = p; a.ph_hi = p + 1; hipLaunchKernelGGL(fwd_mega, dim3(grid), dim3(NWAVES * 64), LDS_BYTES, stream, a); }
#endif
}
```

```cpp
#include <hip/hip_runtime.h>
#include <hip/hip_cooperative_groups.h>
#include <cstdio>
#include <cstdint>
namespace pg8 {
#define PG8_LAS __attribute__((address_space(3)))
typedef unsigned short bf16_t;
typedef short bf16x8 __attribute__((ext_vector_type(8)));
typedef float f32x4 __attribute__((ext_vector_type(4)));
typedef unsigned u32x4 __attribute__((ext_vector_type(4)));
constexpr int BM = 256, BK = 64, HALF = 128, HTB = HALF * BK * 2  , STAGE_BYTES = 8 * HTB, NXCD = 8, WGM = 8;

__host__ __device__ __forceinline__ int lds_byte(int r, int c) { const int st = (r >> 4) * 2 + (c >> 5), rr = r & 15, cc = c & 31, ob = rr * 64 + cc * 2; return st * 1024 + (ob ^ (((ob >> 9) & 1) << 5)); }
__host__ __device__ __forceinline__ void stage_rc(int b, int& R, int& C) { const int st = b / 1024, sb = b % 1024, swz = sb ^ (((sb >> 9) & 1) << 5); R = (st >> 1) * 16 + swz / 64; C = (st & 1) * 32 + (swz % 64) / 2; }
__host__ __device__ __forceinline__ int perm32(int rho) { const int n = rho >> 4, i = rho & 15; return 8 * (i >> 2) + 4 * n + (i & 3); }

struct Unit { int pm, pn; };
struct Gemm { const bf16_t* A; const bf16_t* Bt; int M, N, K; };

struct StaticOrder {
    int nM, nN, nwg, G, c;
    __host__ __device__ void init(int M, int N, int G_, int c_) { nM = M / BM; nN = N / BM; nwg = nM * nN; G = G_; c = c_; }
    __host__ __device__ bool next(int i, Unit& u) const {
        const long L = (long)i * G + c; if (L >= nwg) return false;
        int wgid = (int)L; { const int q = nwg / NXCD, r = nwg % NXCD, xcd = wgid % NXCD, off = wgid / NXCD; wgid = (xcd < r ? xcd * (q + 1) : r * (q + 1) + (xcd - r) * q) + off; }
        const int nig = WGM * nN, gid = wgid / nig, fm = gid * WGM, gsz = (nM - fm) < WGM ? (nM - fm) : WGM;
        u.pm = fm + ((wgid % nig) % gsz); u.pn = (wgid % nig) / gsz; return true;
    }
    __device__ __forceinline__ void a_ready(const Unit&) const {}
    __device__ __forceinline__ void done(const Unit&) const {}
};

__device__ __forceinline__ unsigned cvt_pk_bf16(float lo, float hi) { unsigned r; asm volatile("v_cvt_pk_bf16_f32 %0, %1, %2" : "=v"(r) : "v"(lo), "v"(hi)); return r; }
typedef float f32x2 __attribute__((ext_vector_type(2)));

template <int RSMODE> struct EpiBf16 {
    static constexpr bool PERM = true, AFTER_DRAIN = false;
    bf16_t* O; int ldc; const float* rowscale; int split_cols; size_t split_stride; float scale0;
    __device__ __forceinline__ void operator()(const f32x4 (&acc)[2][2][4][2], const Unit& u, int wr, int wc, int fr, int fq) const {
        const int row0 = u.pm * BM + wr * 64 + fr; int colt = u.pn * BM; bf16_t* base = O;
        float sc = 1.f; if (split_cols) { const int t = colt / split_cols; base += (size_t)t * split_stride; colt -= t * split_cols; if (t == 0) sc = scale0; }
        const int col0 = colt + wc * 32 + 8 * fq;
#pragma unroll
        for (int ai = 0; ai < 2; ++ai)
#pragma unroll
            for (int m = 0; m < 4; ++m) { const int row = row0 + ai * HALF + m * 16; bf16_t* rowp = base + (size_t)row * ldc + col0;
                float rs = sc;
                if (RSMODE == 1) rs *= rowscale[row];
                if (RSMODE == 2) rs *= 1.0f / sqrtf(rowscale[row] * (1.0f / 1024.0f) + 1e-6f);
#pragma unroll
                for (int bj = 0; bj < 2; ++bj) { f32x4 v0 = acc[ai][bj][m][0] * rs, v1 = acc[ai][bj][m][1] * rs;
                    u32x4 w; w.x = cvt_pk_bf16(v0[0], v0[1]); w.y = cvt_pk_bf16(v0[2], v0[3]); w.z = cvt_pk_bf16(v1[0], v1[1]); w.w = cvt_pk_bf16(v1[2], v1[3]);
                    *(u32x4*)(rowp + bj * HALF) = w; } }
    }
};

struct EpiResid {
    static constexpr bool PERM = false, AFTER_DRAIN = false;
    const float* X; float* Hf; bf16_t* Hb; float* rowss; int ldc;
    __device__ __forceinline__ void operator()(const f32x4 (&acc)[2][2][4][2], const Unit& u, int wr, int wc, int fr, int fq) const {
        typedef unsigned u32x2v __attribute__((ext_vector_type(2)));
        const int col0 = u.pn * BM + wc * 32 + 4 * fq;
#pragma unroll
        for (int ai = 0; ai < 2; ++ai)
#pragma unroll
            for (int m = 0; m < 4; ++m) { const int row = u.pm * BM + ai * HALF + wr * 64 + m * 16 + fr; const size_t off = (size_t)row * ldc + col0; float ss = 0.f;
#pragma unroll
                for (int bj = 0; bj < 2; ++bj)
#pragma unroll
                    for (int n = 0; n < 2; ++n) { const f32x4 xv = *(const f32x4*)(X + off + bj * HALF + n * 16); const f32x4 h = xv + acc[ai][bj][m][n];
                        u32x2v w; w.x = cvt_pk_bf16(h[0], h[1]); w.y = cvt_pk_bf16(h[2], h[3]);
                        *(u32x2v*)(Hb + off + bj * HALF + n * 16) = w; ss += (h[0] * h[0] + h[1] * h[1]) + (h[2] * h[2] + h[3] * h[3]); }
                ss += __shfl_xor(ss, 16); ss += __shfl_xor(ss, 32);
                if (fq == 0) atomicAdd(rowss + row, ss); }
    }
};

template <class Epi, class Sched, bool ALIGN_EPI = false, bool SP2 = false>
__device__ __forceinline__ void gemm_phase(PG8_LAS unsigned char* lds, const Gemm g, const Sched& S, const Epi& E) {
    const int tid = threadIdx.x, wid = __builtin_amdgcn_readfirstlane(tid >> 6), lane = tid & 63, wr = wid >> 2, wc = wid & 3, fr = lane & 15, fq = lane >> 4;
    const int K = g.K, nt = K / BK;
    unsigned voffA[2], voffB[2];
#pragma unroll
    for (int i = 0; i < 2; ++i) { int R, C; stage_rc(tid * 16 + i * 8192, R, C); const int Rb = Epi::PERM ? ((R & ~31) + perm32(R & 31)) : R;
        voffA[i] = (unsigned)(R * K + C) * 2u; voffB[i] = (unsigned)(Rb * K + C) * 2u; }
    const size_t kstep = (size_t)(BK * 2);
    const size_t hstep = (size_t)HALF * K * 2;
    const size_t tstep = 2 * hstep;
    const unsigned ldsw = (unsigned)wid * 1024u;
    const int aoff = lds_byte(wr * 64 + fr, fq * 8), boff = lds_byte(wc * 32 + fr, fq * 8);
#define PG8_SA(b, h) (((b) * 2 + (h)) * HTB)
#define PG8_SB(b, h) ((4 + (b) * 2 + (h)) * HTB)
#define PG8_STAGE(bufoff, gbase, voff) do { _Pragma("unroll") for (int _i = 0; _i < 2; ++_i) \
        __builtin_amdgcn_global_load_lds((const unsigned*)((const char*)(gbase) + (voff)[_i]), (PG8_LAS unsigned*)(lds + (bufoff) + ldsw + _i * 8192), 16, 0, 0); } while (0)
#define PG8_LDA(dst, b, h) do { _Pragma("unroll") for (int m = 0; m < 4; ++m) _Pragma("unroll") for (int k = 0; k < 2; ++k) dst[m][k] = *(const PG8_LAS bf16x8*)(lds + PG8_SA(b, h) + aoff + m * 2048 + k * 1024); } while (0)
#define PG8_LDB(dst, b, h) do { _Pragma("unroll") for (int n = 0; n < 2; ++n) _Pragma("unroll") for (int k = 0; k < 2; ++k) dst[n][k] = *(const PG8_LAS bf16x8*)(lds + PG8_SB(b, h) + boff + n * 2048 + k * 1024); } while (0)
#define PG8_MMA(ai, bj, At, Bt) do { __builtin_amdgcn_s_setprio(1); _Pragma("unroll") for (int m = 0; m < 4; ++m) _Pragma("unroll") for (int n = 0; n < 2; ++n) _Pragma("unroll") for (int k = 0; k < 2; ++k) \
        acc[ai][bj][m][n] = __builtin_amdgcn_mfma_f32_16x16x32_bf16(Bt[n][k], At[m][k], acc[ai][bj][m][n], 0, 0, 0); __builtin_amdgcn_s_setprio(0); } while (0)
#define PG8_WAIT_V(n) asm volatile("s_waitcnt vmcnt(" #n ")" ::: "memory")
#define PG8_WAIT_L(n) asm volatile("s_waitcnt lgkmcnt(" #n ")" ::: "memory")
#define PG8_BAR __builtin_amdgcn_s_barrier()
#define PG8_SCHED __builtin_amdgcn_sched_barrier(0)
    Unit cur, nxt; int ui = 0;
    if (!S.next(0, cur)) return;
    f32x4 acc[2][2][4][2];
#pragma unroll
    for (int a = 0; a < 2; ++a)
#pragma unroll
        for (int b = 0; b < 2; ++b)
#pragma unroll
            for (int m = 0; m < 4; ++m)
#pragma unroll
                for (int n = 0; n < 2; ++n) acc[a][b][m][n] = (f32x4){0.f, 0.f, 0.f, 0.f};
    bf16x8 At[4][2], B0[2][2], B1[2][2];
    const char* cA = (const char*)g.A + (size_t)cur.pm * tstep; const char* cB = (const char*)g.Bt + (size_t)cur.pn * tstep;
    S.a_ready(cur);
    if constexpr (SP2) {
        PG8_STAGE(PG8_SB(0, 0), cB, voffB); PG8_STAGE(PG8_SB(0, 1), cB + hstep, voffB); PG8_STAGE(PG8_SA(0, 0), cA, voffA); PG8_STAGE(PG8_SA(0, 1), cA + hstep, voffA);
        if (wr == 1) PG8_BAR;
        PG8_WAIT_V(2); PG8_BAR;
        PG8_STAGE(PG8_SB(1, 0), cB + kstep, voffB); PG8_STAGE(PG8_SA(1, 0), cA + kstep, voffA); PG8_STAGE(PG8_SB(1, 1), cB + hstep + kstep, voffB);
        PG8_WAIT_V(6); PG8_BAR;
    } else {
        PG8_STAGE(PG8_SB(0, 0), cB, voffB); PG8_STAGE(PG8_SA(0, 0), cA, voffA); PG8_STAGE(PG8_SB(0, 1), cB + hstep, voffB); PG8_STAGE(PG8_SA(0, 1), cA + hstep, voffA);
        if (wr == 1) PG8_BAR;
        PG8_WAIT_V(4); PG8_BAR;
        PG8_STAGE(PG8_SB(1, 0), cB + kstep, voffB); PG8_STAGE(PG8_SA(1, 0), cA + kstep, voffA); PG8_STAGE(PG8_SB(1, 1), cB + hstep + kstep, voffB);
        PG8_WAIT_V(6); PG8_BAR;
    }
    for (;;) {
        const bool has_next = S.next(ui + 1, nxt);
        const char* nA = has_next ? (const char*)g.A + (size_t)nxt.pm * tstep : cA; const char* nB = has_next ? (const char*)g.Bt + (size_t)nxt.pn * tstep : cB;
        for (int t = 0; t < nt; t += 2) {
            const bool last = (t == nt - 2);
            const char* a1 = cA + (size_t)(t + 1) * kstep;
            const char* a2 = last ? nA : cA + (size_t)(t + 2) * kstep; const char* b2 = last ? nB : cB + (size_t)(t + 2) * kstep;
            const char* a3 = a2 + kstep; const char* b3 = b2 + kstep;
            if (last && has_next) S.a_ready(nxt);
            if constexpr (SP2) {
            PG8_LDB(B0, 0, 0); PG8_LDB(B1, 0, 1); PG8_SCHED; PG8_LDA(At, 0, 0); PG8_STAGE(PG8_SA(1, 1), a1 + hstep, voffA);
            PG8_WAIT_V(8); PG8_WAIT_L(0); PG8_BAR; PG8_MMA(0, 0, At, B0); PG8_MMA(0, 1, At, B1); PG8_BAR; PG8_SCHED;
            PG8_LDA(At, 0, 1); PG8_STAGE(PG8_SB(0, 0), b2, voffB); PG8_STAGE(PG8_SB(0, 1), b2 + hstep, voffB); PG8_STAGE(PG8_SA(0, 0), a2, voffA);
            PG8_WAIT_V(8); PG8_WAIT_L(0); PG8_BAR; PG8_MMA(1, 0, At, B0); PG8_MMA(1, 1, At, B1); PG8_BAR; PG8_SCHED;
            PG8_LDB(B0, 1, 0); PG8_LDB(B1, 1, 1); PG8_SCHED; PG8_LDA(At, 1, 0); PG8_STAGE(PG8_SA(0, 1), a2 + hstep, voffA);
            PG8_WAIT_V(8); PG8_WAIT_L(0); PG8_BAR; PG8_MMA(0, 0, At, B0); PG8_MMA(0, 1, At, B1); PG8_BAR; PG8_SCHED;
            PG8_LDA(At, 1, 1); PG8_STAGE(PG8_SB(1, 0), b3, voffB); PG8_STAGE(PG8_SB(1, 1), b3 + hstep, voffB); PG8_STAGE(PG8_SA(1, 0), a3, voffA);
            PG8_WAIT_V(8); PG8_WAIT_L(0); PG8_BAR; PG8_MMA(1, 0, At, B0); PG8_MMA(1, 1, At, B1); PG8_BAR; PG8_SCHED;
            } else {
            PG8_LDB(B0, 0, 0); PG8_SCHED; PG8_LDA(At, 0, 0); PG8_STAGE(PG8_SA(1, 1), a1 + hstep, voffA);
            PG8_WAIT_L(8); PG8_BAR; PG8_WAIT_L(0); PG8_MMA(0, 0, At, B0); PG8_BAR; PG8_SCHED;
            PG8_LDB(B1, 0, 1); PG8_STAGE(PG8_SB(0, 0), b2, voffB);
            PG8_BAR; PG8_WAIT_L(0); PG8_MMA(0, 1, At, B1); PG8_BAR;
            PG8_LDA(At, 0, 1); PG8_STAGE(PG8_SA(0, 0), a2, voffA);
            PG8_BAR; PG8_WAIT_L(0); PG8_MMA(1, 0, At, B0); PG8_BAR; PG8_SCHED;
            PG8_STAGE(PG8_SB(0, 1), b2 + hstep, voffB);
            PG8_WAIT_V(6); PG8_BAR; PG8_MMA(1, 1, At, B1); PG8_BAR;
            PG8_LDB(B0, 1, 0); PG8_SCHED; PG8_LDA(At, 1, 0); PG8_STAGE(PG8_SA(0, 1), a2 + hstep, voffA);
            PG8_WAIT_L(8); PG8_BAR; PG8_WAIT_L(0); PG8_MMA(0, 0, At, B0); PG8_BAR; PG8_SCHED;
            PG8_LDB(B1, 1, 1); PG8_STAGE(PG8_SB(1, 0), b3, voffB);
            PG8_BAR; PG8_WAIT_L(0); PG8_MMA(0, 1, At, B1); PG8_BAR;
            PG8_LDA(At, 1, 1); PG8_STAGE(PG8_SA(1, 0), a3, voffA);
            PG8_BAR; PG8_WAIT_L(0); PG8_MMA(1, 0, At, B0); PG8_BAR; PG8_SCHED;
            PG8_STAGE(PG8_SB(1, 1), b3 + hstep, voffB);
            PG8_WAIT_V(6); PG8_BAR; PG8_MMA(1, 1, At, B1); PG8_BAR;
            }
        }
        if constexpr (ALIGN_EPI) { if (wr == 0) PG8_BAR; }
        if constexpr (!Epi::AFTER_DRAIN) { E(acc, cur, wr, wc, fr, fq); S.done(cur); }
        if (!has_next) break;
#pragma unroll
        for (int a = 0; a < 2; ++a)
#pragma unroll
            for (int b = 0; b < 2; ++b)
#pragma unroll
                for (int m = 0; m < 4; ++m)
#pragma unroll
                    for (int n = 0; n < 2; ++n) acc[a][b][m][n] = (f32x4){0.f, 0.f, 0.f, 0.f};
        cur = nxt; cA = nA; cB = nB; ++ui;
        if constexpr (ALIGN_EPI) { if (wr == 1) PG8_BAR; }
    }
    PG8_WAIT_V(0);
    if constexpr (!ALIGN_EPI) { if (wr == 0) PG8_BAR; }
    PG8_BAR;
    if constexpr (Epi::AFTER_DRAIN) { E.fused(acc, cur, wr, wc, fr, fq, lds, wid, lane); S.done(cur); }
#undef PG8_SA
#undef PG8_SB
#undef PG8_STAGE
#undef PG8_LDA
#undef PG8_LDB
#undef PG8_MMA
#undef PG8_WAIT_V
#undef PG8_WAIT_L
#undef PG8_BAR
#undef PG8_SCHED
}
}

#include <hip/hip_bf16.h>
#include <cmath>
namespace attn_body {
using bf16=__hip_bfloat16;
using bf16x8=__attribute__((ext_vector_type(8)))short;
using s16x4=__attribute__((ext_vector_type(4)))short;
using f32x16=__attribute__((ext_vector_type(16)))float;
using u32x4=__attribute__((ext_vector_type(4)))unsigned;
constexpr int SEQ=16384,D=64,DM=512;
constexpr int NW=8,QBLK=32,QB=QBLK*NW,KVBLK=64,NQB=SEQ/QB;
constexpr int ATTN_PITCH=DM, ATTN_UNIT_ROWS=QB;
__device__ __forceinline__ int crow(int r,int hi){return (r&3)+8*(r>>2)+4*hi;}
#define SBAR() __builtin_amdgcn_sched_barrier(0)
__device__ __forceinline__ void cmask(f32x16&p0,f32x16&p1,int jb,int wid){
  const float NEG=-INFINITY;
  if(jb>(wid>>1)){
  #pragma unroll
  for(int r=0;r<16;++r){p0[r]=NEG;p1[r]=NEG;}}
}

constexpr int NSLOT=3, SLOTB=8192;
constexpr int LDS_K=0, LDS_V=NSLOT*SLOTB, LDS_WS=2*NSLOT*SLOTB, LDS_OST=LDS_WS+NW*64*4, LDS_BYTES=LDS_OST+NW*4096;
constexpr float C2=0.125f*1.4426950408889634f;
__device__ __forceinline__ void glds16(const void*gsrc,unsigned lds_dst){unsigned keep;
  asm volatile("s_mov_b32 %0, m0\n\ts_mov_b32 m0, %2\n\ts_nop 0\n\tglobal_load_lds_dwordx4 %1, off\n\ts_mov_b32 m0, %0":"=&s"(keep):"v"(gsrc),"s"(lds_dst):"memory");}
__device__ __forceinline__ float max3f(float a,float b,float c){float r;asm("v_max3_f32 %0, %1, %2, %3":"=v"(r):"v"(a),"v"(b),"v"(c));return r;}
__device__ __forceinline__ float max2f(float a,float b){float r;asm("v_max_f32_e32 %0, %1, %2":"=v"(r):"v"(a),"v"(b));return r;}
__device__ __forceinline__ float fadd_s(float a,float b){float r;asm("v_add_f32_e32 %0, %1, %2":"=v"(r):"v"(a),"v"(b));return r;}
__device__ __forceinline__ float fsub_s(float a,float b){float r;asm("v_sub_f32_e32 %0, %1, %2":"=v"(r):"v"(a),"v"(b));return r;}
typedef float f32x2_t __attribute__((ext_vector_type(2))); typedef __bf16 bf16x2_t __attribute__((ext_vector_type(2)));
__device__ __forceinline__ unsigned cvtpk_s(float lo,float hi){f32x2_t v={lo,hi};bf16x2_t b=__builtin_convertvector(v,bf16x2_t);return __builtin_bit_cast(unsigned,b);}
#define WAIT_BAR(N) asm volatile("s_waitcnt vmcnt(" #N ") lgkmcnt(0)\n\ts_barrier":::"memory")

__device__ __forceinline__ void qkt(f32x16&p0,f32x16&p1,const char*Kslot,const bf16x8*qr,const f32x16&negm,int r32,int hi){
  const char*kb=Kslot+hi*1024+r32*16;
  #pragma unroll
  for(int d0=0;d0<4;++d0){
    const bf16x8 b0=*reinterpret_cast<const bf16x8*>(kb+d0*2048);
    const bf16x8 b1=*reinterpret_cast<const bf16x8*>(kb+d0*2048+512);
    if(d0==0){p0=__builtin_amdgcn_mfma_f32_32x32x16_bf16(b0,qr[0],negm,0,0,0);p1=__builtin_amdgcn_mfma_f32_32x32x16_bf16(b1,qr[0],negm,0,0,0);}
    else{p0=__builtin_amdgcn_mfma_f32_32x32x16_bf16(b0,qr[d0],p0,0,0,0);p1=__builtin_amdgcn_mfma_f32_32x32x16_bf16(b1,qr[d0],p1,0,0,0);}}
}
typedef __attribute__((address_space(3))) const char* lds_cptr;
typedef short v4i16_t __attribute__((ext_vector_type(4)));
__device__ __forceinline__ void kload8(bf16x8*kf,lds_cptr kp){
  kf[0]=*(const __attribute__((address_space(3))) bf16x8*)(kp);      kf[1]=*(const __attribute__((address_space(3))) bf16x8*)(kp+512);
  kf[2]=*(const __attribute__((address_space(3))) bf16x8*)(kp+2048); kf[3]=*(const __attribute__((address_space(3))) bf16x8*)(kp+2560);
  kf[4]=*(const __attribute__((address_space(3))) bf16x8*)(kp+4096); kf[5]=*(const __attribute__((address_space(3))) bf16x8*)(kp+4608);
  kf[6]=*(const __attribute__((address_space(3))) bf16x8*)(kp+6144); kf[7]=*(const __attribute__((address_space(3))) bf16x8*)(kp+6656);
}
__device__ __forceinline__ void kload2(bf16x8*kf,lds_cptr kp,int j){ kf[2*j]=*(const __attribute__((address_space(3))) bf16x8*)(kp+j*2048); kf[2*j+1]=*(const __attribute__((address_space(3))) bf16x8*)(kp+j*2048+512); }
__device__ __forceinline__ s16x4 vtr(lds_cptr p){ return __builtin_bit_cast(s16x4,__builtin_amdgcn_ds_read_tr16_b64_v4i16((__attribute__((address_space(3))) v4i16_t*)p)); }
__device__ __forceinline__ float rowmax(const f32x16&p0,const f32x16&p1){
  float a=max3f(p0[0],p0[1],p1[0]),b=max3f(p0[2],p0[3],p1[1]);a=max3f(a,p1[2],p1[3]);
  #pragma unroll
  for(int r=4;r<16;r+=4){a=max3f(a,p0[r],p0[r+1]);b=max3f(b,p0[r+2],p0[r+3]);a=max3f(a,p1[r],p1[r+1]);b=max3f(b,p1[r+2],p1[r+3]);}
  const float m=max2f(a,b);
  auto rr=__builtin_amdgcn_permlane32_swap(__float_as_uint(m),__float_as_uint(m),false,false);
  return max2f(__uint_as_float(rr[0]),__uint_as_float(rr[1]));
}
__device__ __forceinline__ void pv(f32x16*o,int vb,bf16x8 pa0,bf16x8 pa1,bf16x8 pa2,bf16x8 pa3){
  #pragma unroll
  for(int d0=0;d0<2;++d0){s16x4 lo[4],hi[4];
    #pragma unroll
    for(int ks=0;ks<4;++ks){
      asm volatile("ds_read_b64_tr_b16 %0,%1 offset:%c2":"=&v"(lo[ks]):"v"(vb),"i"(d0*4096+ks*1024):"memory");
      asm volatile("ds_read_b64_tr_b16 %0,%1 offset:%c2":"=&v"(hi[ks]):"v"(vb),"i"(d0*4096+ks*1024+512):"memory");}
    asm volatile("s_waitcnt lgkmcnt(0)":::"memory");SBAR();
    #define PK(k) (bf16x8){lo[k][0],lo[k][1],lo[k][2],lo[k][3],hi[k][0],hi[k][1],hi[k][2],hi[k][3]}
    o[d0]=__builtin_amdgcn_mfma_f32_32x32x16_bf16(pa0,PK(0),o[d0],0,0,0);
    o[d0]=__builtin_amdgcn_mfma_f32_32x32x16_bf16(pa1,PK(1),o[d0],0,0,0);
    o[d0]=__builtin_amdgcn_mfma_f32_32x32x16_bf16(pa2,PK(2),o[d0],0,0,0);
    o[d0]=__builtin_amdgcn_mfma_f32_32x32x16_bf16(pa3,PK(3),o[d0],0,0,0);
    #undef PK
  }
}

#ifndef ATTN_STORE16
#define ATTN_STORE16(p,v) (*(u32x4*)(p)=(v))
#endif
template<int THRL> __device__ __forceinline__ void attn_unit(int qcol,int vcol,int qb,const bf16*Q,const bf16*__restrict__ K,const bf16*__restrict__ V,bf16*O,char*shm){
  const int tid=threadIdx.x,lane=tid&63,r32=lane&31,hi=lane>>5; const int wid=__builtin_amdgcn_readfirstlane(tid>>6);
  const long rowbase=0; const int q0=qb*QB;
  const bf16*Qw=Q+(rowbase+q0+wid*QBLK)*DM+qcol;
  const bf16*Kh=K+rowbase*DM+qcol,*Vh=V+rowbase*DM+vcol;
  const unsigned lds0=(unsigned)(uintptr_t)shm;
  float*wsf=(float*)(shm+LDS_WS)+wid*64;
  const bf16*ksrc=Kh+(long)lane*DM+wid*8;
  const bf16*vsrc=Vh+(long)(16*(wid&3)+(lane>>2))*DM+(wid>>2)*32+(lane&3)*8;
  const unsigned kdst=lds0+LDS_K+wid*1024, vdst=lds0+LDS_V+wid*1024;
  #define DMA_K(t,slot) glds16(ksrc+(long)(t)*KVBLK*DM,(unsigned)__builtin_amdgcn_readfirstlane(kdst+(slot)))
  #define DMA_V(t,slot) glds16(vsrc+(long)(t)*KVBLK*DM,(unsigned)__builtin_amdgcn_readfirstlane(vdst+(slot)))
  const int vb0=(int)(lds0+LDS_V)+((lane>>4)&1)*32+(lane&3)*8+(4*hi+((lane&15)>>2))*64;
  const char*Kbase=shm+LDS_K; bf16x8 kf[8];
  const lds_cptr shm3=(lds_cptr)shm; const lds_cptr kp0=shm3+LDS_K+hi*1024+r32*16; const lds_cptr vp0=shm3+LDS_V+((lane>>4)&1)*32+(lane&3)*8+(4*hi+((lane&15)>>2))*64;
  const int NT=(q0+QB)/KVBLK;
  DMA_K(0,0);DMA_V(0,0);DMA_K(1,SLOTB);
  bf16x8 qr[4];
  #pragma unroll
  for(int d0=0;d0<4;++d0)qr[d0]=*reinterpret_cast<const bf16x8*>(&Qw[(long)r32*DM+d0*16+hi*8]);
  float mhat=0.f,l_reg=0.f;f32x16 o[2];o[0]=f32x16{};o[1]=f32x16{};f32x16 negm=f32x16{};asm volatile("":"+v"(negm));
  const int qrel=wid*QBLK+r32;
  #define CMASK(P0,P1,t) do{int jb_=(t)-(NT-4); if(jb_>=0)cmask(P0,P1,jb_,wid);}while(0)
  bool resc=false;
  #define START(P0,P1) do{ const float rm=rowmax(P0,P1); resc=false; \
    { const float dl=rm; mhat=fadd_s(mhat,dl); \
      _Pragma("unroll") for(int r=0;r<16;++r){P0[r]=fsub_s(P0[r],dl);P1[r]=fsub_s(P1[r],dl);} \
      _Pragma("unroll") for(int r=0;r<16;++r)negm[r]=-mhat; asm volatile("":"+v"(negm)); } \
    _Pragma("unroll") for(int r=0;r<16;++r)P0[r]=__builtin_amdgcn_exp2f(P0[r]); }while(0)
  #define RESC() do{ if(resc){ asm volatile("s_waitcnt lgkmcnt(0)":::"memory"); \
      _Pragma("unroll") for(int d_=0;d_<2;++d_) _Pragma("unroll") for(int r=0;r<16;++r)o[d_][r]*=wsf[crow(r,hi)]; } }while(0)
  f32x16 pA0,pA1,pB0,pB1;
  int sl_prev=0,sl_cur=0,sl_next=SLOTB;
  #define ROT() do{sl_prev=sl_cur;sl_cur=sl_next;sl_next=(sl_next==(NSLOT-1)*SLOTB)?0:sl_next+SLOTB;}while(0)
  DMA_K(2,2*SLOTB);
  WAIT_BAR(3);
  qkt(pA0,pA1,Kbase,qr,negm,r32,hi);asm volatile("s_nop 15\n\ts_nop 7":"+v"(pA0),"+v"(pA1));CMASK(pA0,pA1,0);
  START(pA0,pA1);
  _Pragma("unroll") for(int r=0;r<16;++r)pA1[r]=__builtin_amdgcn_exp2f(pA1[r]);
  WAIT_BAR(0);
  DMA_K(3,0);DMA_V(1,SLOTB);
  ROT();
  kload8(kf,kp0+sl_cur);
  WAIT_BAR(2);
  s16x4 vlo[8],vhi[8]; u32x4 pw0,pw1,pw2,pw3;
  #define PKW(P,B) cvtpk_s(P[B],P[B+1])
  #define PAF(k) __builtin_bit_cast(bf16x8,pw##k)
  #define VFR(i) (bf16x8){vlo[i][0],vlo[i][1],vlo[i][2],vlo[i][3],vhi[i][0],vhi[i][1],vhi[i][2],vhi[i][3]}
  #define PIN(x) asm volatile("":"+v"(x))
  #define MX3(a,b,c) __builtin_fmaxf(__builtin_fmaxf((a),(b)),(c))
  #define GAPA(MF,A0,A1,A2,A3,W0,W1,PW) do{ MF; sacc+=A0; sacc+=A1; sacc+=A2; sacc+=A3; PIN(sacc); W0; W1; PIN(PW); SBAR(); }while(0)
  #define EX(v) __builtin_amdgcn_exp2f(v)
  #define GAPB(MF,X,B) do{ MF; X[B]=EX(X[B]); X[B+1]=EX(X[B+1]); X[B+2]=EX(X[B+2]); X[B+3]=EX(X[B+3]); PIN(X); SBAR(); }while(0)
  #define VRD(i) do{ vlo[i]=vtr(vp_+(((i)>>2)*4096+((i)&3)*1024)); vhi[i]=vtr(vp_+(((i)>>2)*4096+((i)&3)*1024+512)); }while(0)
  #define KRD(G,j) do{ if(G){ kload2(kf,kp0+sl_next,j); SBAR(); } }while(0)
  #define STEP(C0,C1,P0,P1,t,GK,GV,GL) do{ SBAR(); \
    const lds_cptr vp_=vp0+sl_prev; \
    VRD(0); SBAR(); float sacc=(P0[0]+P0[1]); \
    GAPA(C0=__builtin_amdgcn_mfma_f32_32x32x16_bf16(kf[0],qr[0],negm,0,0,0), P0[2],P0[3],P0[4],P0[5],     pw0[0]=PKW(P0,0), pw0[1]=PKW(P0,2), pw0); \
    VRD(4); SBAR(); GAPA(C1=__builtin_amdgcn_mfma_f32_32x32x16_bf16(kf[1],qr[0],negm,0,0,0), P0[6],P0[7],P0[8],P0[9],     pw0[2]=PKW(P0,4), pw0[3]=PKW(P0,6), pw0); \
    VRD(1); SBAR(); GAPA(C0=__builtin_amdgcn_mfma_f32_32x32x16_bf16(kf[2],qr[1],C0,0,0,0),   P0[10],P0[11],P0[12],P0[13], pw1[0]=PKW(P0,8), pw1[1]=PKW(P0,10), pw1); \
    VRD(5); SBAR(); GAPA(C1=__builtin_amdgcn_mfma_f32_32x32x16_bf16(kf[3],qr[1],C1,0,0,0),   P0[14],P0[15],P1[0],P1[1],   pw1[2]=PKW(P0,12),pw1[3]=PKW(P0,14), pw1); \
    VRD(2); SBAR(); GAPA(C0=__builtin_amdgcn_mfma_f32_32x32x16_bf16(kf[4],qr[2],C0,0,0,0),   P1[2],P1[3],P1[4],P1[5],     pw2[0]=PKW(P1,0), pw2[1]=PKW(P1,2), pw2); \
    VRD(6); SBAR(); GAPA(C1=__builtin_amdgcn_mfma_f32_32x32x16_bf16(kf[5],qr[2],C1,0,0,0),   P1[6],P1[7],P1[8],P1[9],     pw2[2]=PKW(P1,4), pw2[3]=PKW(P1,6), pw2); \
    VRD(3); SBAR(); GAPA(C0=__builtin_amdgcn_mfma_f32_32x32x16_bf16(kf[6],qr[3],C0,0,0,0),   P1[10],P1[11],P1[12],P1[13], pw3[0]=PKW(P1,8), pw3[1]=PKW(P1,10), pw3); \
    VRD(7); SBAR(); GAPA(C1=__builtin_amdgcn_mfma_f32_32x32x16_bf16(kf[7],qr[3],C1,0,0,0),   P1[14],P1[15],0.f,0.f,       pw3[2]=PKW(P1,12),pw3[3]=PKW(P1,14), pw3); \
    l_reg+=sacc; \
    if(GK){DMA_K((t)+3,sl_cur);} if(GV){DMA_V((t)+1,sl_next);} \
    CMASK(C0,C1,t); \
    { float a=MX3(C0[0],C0[1],C1[0]),b=MX3(C0[2],C0[3],C1[1]); a=MX3(a,C1[2],C1[3]); \
      _Pragma("unroll") for(int r=4;r<16;r+=4){a=MX3(a,C0[r],C0[r+1]);b=MX3(b,C0[r+2],C0[r+3]);a=MX3(a,C1[r],C1[r+1]);b=MX3(b,C1[r+2],C1[r+3]);} \
      float rm=__builtin_fmaxf(a,b); { auto rr=__builtin_amdgcn_permlane32_swap(__float_as_uint(rm),__float_as_uint(rm),false,false); rm=__builtin_fmaxf(__uint_as_float(rr[0]),__uint_as_float(rr[1])); } \
      resc=false; \
      if(__builtin_expect(__any(rm>(float)THRL),0)){ const float dl=__builtin_fmaxf(rm,0.f); mhat+=dl; \
        _Pragma("unroll") for(int r=0;r<16;++r){C0[r]-=dl;C1[r]-=dl;} \
        _Pragma("unroll") for(int r=0;r<16;++r)negm[r]=-mhat; asm volatile("":"+v"(negm)); \
        const float f=__builtin_amdgcn_exp2f(-dl); l_reg*=f; if(hi==0)wsf[r32]=f; resc=true; } } \
    SBAR(); \
    GAPB(o[0]=__builtin_amdgcn_mfma_f32_32x32x16_bf16(PAF(0),VFR(0),o[0],0,0,0), C0,0); \
    GAPB(o[1]=__builtin_amdgcn_mfma_f32_32x32x16_bf16(PAF(0),VFR(4),o[1],0,0,0), C0,4); \
    KRD(GL,0); GAPB(o[0]=__builtin_amdgcn_mfma_f32_32x32x16_bf16(PAF(1),VFR(1),o[0],0,0,0), C0,8); \
    KRD(GL,1); GAPB(o[1]=__builtin_amdgcn_mfma_f32_32x32x16_bf16(PAF(1),VFR(5),o[1],0,0,0), C0,12); \
    KRD(GL,2); GAPB(o[0]=__builtin_amdgcn_mfma_f32_32x32x16_bf16(PAF(2),VFR(2),o[0],0,0,0), C1,0); \
    KRD(GL,3); GAPB(o[1]=__builtin_amdgcn_mfma_f32_32x32x16_bf16(PAF(2),VFR(6),o[1],0,0,0), C1,4); \
    GAPB(o[0]=__builtin_amdgcn_mfma_f32_32x32x16_bf16(PAF(3),VFR(3),o[0],0,0,0), C1,8); \
    GAPB(o[1]=__builtin_amdgcn_mfma_f32_32x32x16_bf16(PAF(3),VFR(7),o[1],0,0,0), C1,12); \
    }while(0)
  int t=1;
  #undef CMASK
  #define CMASK(P0,P1,t) do{}while(0)
  for(;t+5<NT;t+=2){
    STEP(pB0,pB1,pA0,pA1,t,true,true,true);     WAIT_BAR(2); RESC(); ROT();
    STEP(pA0,pA1,pB0,pB1,t+1,true,true,true);   WAIT_BAR(2); RESC(); ROT();
  }
  #undef CMASK
  #define CMASK(P0,P1,t) do{int jb_=(t)-(NT-4); if(jb_>=0)cmask(P0,P1,jb_,wid);}while(0)
  #define ENDW(tt) do{ if((tt)+3<NT){WAIT_BAR(2);} else if((tt)+2<NT){WAIT_BAR(1);} else {WAIT_BAR(0);} }while(0)
  for(;t+1<NT;t+=2){
    STEP(pB0,pB1,pA0,pA1,t,(t+3<NT),(t+1<NT),(t+1<NT));       ENDW(t);   RESC(); ROT();
    STEP(pA0,pA1,pB0,pB1,t+1,(t+4<NT),(t+2<NT),(t+2<NT));     ENDW(t+1); RESC(); ROT();
  }
  STEP(pB0,pB1,pA0,pA1,NT-1,false,false,false); RESC();
  { float sacc=pB0[0]+pB0[1]; _Pragma("unroll") for(int r=2;r<16;++r)sacc+=pB0[r]; _Pragma("unroll") for(int r=0;r<16;++r)sacc+=pB1[r]; l_reg+=sacc;
    pw0=(u32x4){PKW(pB0,0),PKW(pB0,2),PKW(pB0,4),PKW(pB0,6)};pw1=(u32x4){PKW(pB0,8),PKW(pB0,10),PKW(pB0,12),PKW(pB0,14)};pw2=(u32x4){PKW(pB1,0),PKW(pB1,2),PKW(pB1,4),PKW(pB1,6)};pw3=(u32x4){PKW(pB1,8),PKW(pB1,10),PKW(pB1,12),PKW(pB1,14)};
    SBAR(); pv(o,vb0+sl_cur,PAF(0),PAF(1),PAF(2),PAF(3)); }
  #undef PKW
  #undef PAF
  #undef VFR
  #undef PIN
  #undef MX3
  #undef GAPA
  #undef GAPB
  #undef EX
  #undef VRD
  #undef KRD
  #undef STEP
  #undef ENDW
  {auto rr=__builtin_amdgcn_permlane32_swap(__float_as_uint(l_reg),__float_as_uint(l_reg),false,false);l_reg=__uint_as_float(rr[0])+__uint_as_float(rr[1]);}
  if(hi==0)wsf[32+r32]=l_reg;asm volatile("s_waitcnt lgkmcnt(0)":::"memory");
  float rli[16];
  #pragma unroll
  for(int r=0;r<16;++r)rli[r]=__builtin_amdgcn_rcpf(wsf[32+crow(r,hi)]);
  bf16*Ow=O+(rowbase+q0+wid*QBLK)*DM+vcol;
  { bf16*stg=(bf16*)(shm+LDS_OST)+wid*2048;
    #pragma unroll
    for(int r=0;r<16;++r){const int orow=crow(r,hi);
      #pragma unroll
      for(int d0=0;d0<2;++d0)stg[orow*64+d0*32+r32]=__float2bfloat16(o[d0][r]*rli[r]);}
    asm volatile("s_waitcnt lgkmcnt(0)":::"memory");
    #pragma unroll
    for(int i=0;i<4;++i){const int row=i*8+(lane>>3),ch=lane&7; const u32x4 v=*(const u32x4*)(stg+row*64+ch*8); ATTN_STORE16(Ow+(long)row*DM+ch*8,v);} }
  asm volatile("s_waitcnt lgkmcnt(0)\n\ts_barrier":::"memory");
  #undef DMA_K
  #undef DMA_V
  #undef CMASK
  #undef START
  #undef RESC
  #undef ROT
}
constexpr int ATTN_LDS_BYTES=LDS_BYTES;
struct AttnTensors { const bf16* Q; const bf16* K; const bf16* V; bf16* O; };
struct AttnUnit { int var; int qb; };
struct StaticOrder {
  int vcu;
  __device__ __forceinline__ explicit StaticOrder(int v):vcu(v){}
  __device__ __forceinline__ bool next(int i,AttnUnit&u)const{ if(i>=4)return false; const int s=vcu&15; u.var=vcu>>4; u.qb=(i==0)?s:(i==1)?31-s:(i==2)?32+s:63-s; return true; }
};
template<class Sched,int THRL=8> __device__ __forceinline__ void attn_phase(char*lds,const AttnTensors&T,const Sched&S){
  AttnUnit u;
  for(int i=0;S.next(i,u);++i){ const int h=u.var>>2,mp=(u.var>>1)&1,vh=u.var&1;
    attn_unit<THRL>(h*128+mp*64,h*128+vh*64,u.qb,T.Q,T.K,T.V,T.O+(size_t)mp*SEQ*DM,lds); }
}
#undef SBAR
#undef WAIT_BAR
}
namespace attn128 {
using bf16=__hip_bfloat16;
using bf16x8=__attribute__((ext_vector_type(8)))short;
using s16x4=__attribute__((ext_vector_type(4)))short;
using f32x16=__attribute__((ext_vector_type(16)))float;
using u32x4=__attribute__((ext_vector_type(4)))unsigned;
constexpr int SEQ=16384,D=64,DM=512;
constexpr int NW=8,QBLK=32,QB=QBLK*NW,KVBLK=64,NQB=SEQ/QB;
constexpr int ATTN_PITCH=DM, ATTN_UNIT_ROWS=QB;
__device__ __forceinline__ int crow(int r,int hi){return (r&3)+8*(r>>2)+4*hi;}
#define SBAR() __builtin_amdgcn_sched_barrier(0)
__device__ __forceinline__ void cmask(f32x16&p0,f32x16&p1,int jb,int wid){
  const float NEG=-INFINITY;
  if(jb>(wid>>1)){
  #pragma unroll
  for(int r=0;r<16;++r){p0[r]=NEG;p1[r]=NEG;}}
}

constexpr int NSLOT=3, SLOTB=8192;
constexpr int LDS_K=0, LDS_V=NSLOT*SLOTB, LDS_WS=3*NSLOT*SLOTB, LDS_OST=LDS_WS+NW*64*4, LDS_BYTES=LDS_OST+NW*4096;
constexpr float C2=0.125f*1.4426950408889634f;
__device__ __forceinline__ void glds16(const void*gsrc,unsigned lds_dst){unsigned keep;
  asm volatile("s_mov_b32 %0, m0\n\ts_mov_b32 m0, %2\n\ts_nop 0\n\tglobal_load_lds_dwordx4 %1, off\n\ts_mov_b32 m0, %0":"=&s"(keep):"v"(gsrc),"s"(lds_dst):"memory");}
__device__ __forceinline__ float max3f(float a,float b,float c){float r;asm("v_max3_f32 %0, %1, %2, %3":"=v"(r):"v"(a),"v"(b),"v"(c));return r;}
__device__ __forceinline__ float max2f(float a,float b){float r;asm("v_max_f32_e32 %0, %1, %2":"=v"(r):"v"(a),"v"(b));return r;}
__device__ __forceinline__ float fadd_s(float a,float b){float r;asm("v_add_f32_e32 %0, %1, %2":"=v"(r):"v"(a),"v"(b));return r;}
__device__ __forceinline__ float fsub_s(float a,float b){float r;asm("v_sub_f32_e32 %0, %1, %2":"=v"(r):"v"(a),"v"(b));return r;}
typedef float f32x2_t __attribute__((ext_vector_type(2))); typedef __bf16 bf16x2_t __attribute__((ext_vector_type(2)));
__device__ __forceinline__ unsigned cvtpk_s(float lo,float hi){f32x2_t v={lo,hi};bf16x2_t b=__builtin_convertvector(v,bf16x2_t);return __builtin_bit_cast(unsigned,b);}
#define WAIT_BAR(N) asm volatile("s_waitcnt vmcnt(" #N ") lgkmcnt(0)\n\ts_barrier":::"memory")

__device__ __forceinline__ void qkt(f32x16&p0,f32x16&p1,const char*Kslot,const bf16x8*qr,const f32x16&negm,int r32,int hi){
  const char*kb=Kslot+hi*1024+r32*16;
  #pragma unroll
  for(int d0=0;d0<4;++d0){
    const bf16x8 b0=*reinterpret_cast<const bf16x8*>(kb+d0*2048);
    const bf16x8 b1=*reinterpret_cast<const bf16x8*>(kb+d0*2048+512);
    if(d0==0){p0=__builtin_amdgcn_mfma_f32_32x32x16_bf16(b0,qr[0],negm,0,0,0);p1=__builtin_amdgcn_mfma_f32_32x32x16_bf16(b1,qr[0],negm,0,0,0);}
    else{p0=__builtin_amdgcn_mfma_f32_32x32x16_bf16(b0,qr[d0],p0,0,0,0);p1=__builtin_amdgcn_mfma_f32_32x32x16_bf16(b1,qr[d0],p1,0,0,0);}}
}
typedef __attribute__((address_space(3))) const char* lds_cptr;
typedef short v4i16_t __attribute__((ext_vector_type(4)));
__device__ __forceinline__ void kload8(bf16x8*kf,lds_cptr kp){
  kf[0]=*(const __attribute__((address_space(3))) bf16x8*)(kp);      kf[1]=*(const __attribute__((address_space(3))) bf16x8*)(kp+512);
  kf[2]=*(const __attribute__((address_space(3))) bf16x8*)(kp+2048); kf[3]=*(const __attribute__((address_space(3))) bf16x8*)(kp+2560);
  kf[4]=*(const __attribute__((address_space(3))) bf16x8*)(kp+4096); kf[5]=*(const __attribute__((address_space(3))) bf16x8*)(kp+4608);
  kf[6]=*(const __attribute__((address_space(3))) bf16x8*)(kp+6144); kf[7]=*(const __attribute__((address_space(3))) bf16x8*)(kp+6656);
}
__device__ __forceinline__ void kload2(bf16x8*kf,lds_cptr kp,int j){ kf[2*j]=*(const __attribute__((address_space(3))) bf16x8*)(kp+j*2048); kf[2*j+1]=*(const __attribute__((address_space(3))) bf16x8*)(kp+j*2048+512); }
__device__ __forceinline__ s16x4 vtr(lds_cptr p){ return __builtin_bit_cast(s16x4,__builtin_amdgcn_ds_read_tr16_b64_v4i16((__attribute__((address_space(3))) v4i16_t*)p)); }
__device__ __forceinline__ float rowmax(const f32x16&p0,const f32x16&p1){
  float a=max3f(p0[0],p0[1],p1[0]),b=max3f(p0[2],p0[3],p1[1]);a=max3f(a,p1[2],p1[3]);
  #pragma unroll
  for(int r=4;r<16;r+=4){a=max3f(a,p0[r],p0[r+1]);b=max3f(b,p0[r+2],p0[r+3]);a=max3f(a,p1[r],p1[r+1]);b=max3f(b,p1[r+2],p1[r+3]);}
  const float m=max2f(a,b);
  auto rr=__builtin_amdgcn_permlane32_swap(__float_as_uint(m),__float_as_uint(m),false,false);
  return max2f(__uint_as_float(rr[0]),__uint_as_float(rr[1]));
}
__device__ __forceinline__ void pv(f32x16*o,int vb,bf16x8 pa0,bf16x8 pa1,bf16x8 pa2,bf16x8 pa3){
  #pragma unroll
  for(int d0=0;d0<4;++d0){s16x4 lo[4],hi[4];
    #pragma unroll
    for(int ks=0;ks<4;++ks){
      asm volatile("ds_read_b64_tr_b16 %0,%1 offset:%c2":"=&v"(lo[ks]):"v"(vb),"i"(d0*4096+ks*1024):"memory");
      asm volatile("ds_read_b64_tr_b16 %0,%1 offset:%c2":"=&v"(hi[ks]):"v"(vb),"i"(d0*4096+ks*1024+512):"memory");}
    asm volatile("s_waitcnt lgkmcnt(0)":::"memory");SBAR();
    #define PK(k) (bf16x8){lo[k][0],lo[k][1],lo[k][2],lo[k][3],hi[k][0],hi[k][1],hi[k][2],hi[k][3]}
    o[d0]=__builtin_amdgcn_mfma_f32_32x32x16_bf16(pa0,PK(0),o[d0],0,0,0);
    o[d0]=__builtin_amdgcn_mfma_f32_32x32x16_bf16(pa1,PK(1),o[d0],0,0,0);
    o[d0]=__builtin_amdgcn_mfma_f32_32x32x16_bf16(pa2,PK(2),o[d0],0,0,0);
    o[d0]=__builtin_amdgcn_mfma_f32_32x32x16_bf16(pa3,PK(3),o[d0],0,0,0);
    #undef PK
  }
}

#ifndef ATTN_STORE16
#define ATTN_STORE16(p,v) (*(u32x4*)(p)=(v))
#endif
template<int THRL> __device__ __forceinline__ void attn_unit(int qcol,int vcol,int qb,const bf16*Q,const bf16*__restrict__ K,const bf16*__restrict__ V,bf16*O,char*shm){
  const int tid=threadIdx.x,lane=tid&63,r32=lane&31,hi=lane>>5; const int wid=__builtin_amdgcn_readfirstlane(tid>>6);
  const long rowbase=0; const int q0=qb*QB;
  const bf16*Qw=Q+(rowbase+q0+wid*QBLK)*DM+qcol;
  const bf16*Kh=K+rowbase*DM+qcol,*Vh=V+rowbase*DM+vcol;
  const unsigned lds0=(unsigned)(uintptr_t)shm;
  float*wsf=(float*)(shm+LDS_WS)+wid*64;
  const bf16*ksrc=Kh+(long)lane*DM+wid*8;
  const bf16*vsrc=Vh+(long)(16*(wid&3)+(lane>>2))*DM+(wid>>2)*32+(lane&3)*8;
  const unsigned kdst=lds0+LDS_K+wid*1024, vdst=lds0+LDS_V+wid*1024;
  #define DMA_K(t,slot) glds16(ksrc+(long)(t)*KVBLK*DM,(unsigned)__builtin_amdgcn_readfirstlane(kdst+(slot)))
  #define DMA_V(t,slot) do{ glds16(vsrc+(long)(t)*KVBLK*DM,(unsigned)__builtin_amdgcn_readfirstlane(vdst+2*(slot))); glds16(vsrc+64+(long)(t)*KVBLK*DM,(unsigned)__builtin_amdgcn_readfirstlane(vdst+2*(slot)+8192)); }while(0)
  const int vb0=(int)(lds0+LDS_V)+((lane>>4)&1)*32+(lane&3)*8+(4*hi+((lane&15)>>2))*64;
  const char*Kbase=shm+LDS_K; bf16x8 kf[8];
  const lds_cptr shm3=(lds_cptr)shm; const lds_cptr kp0=shm3+LDS_K+hi*1024+r32*16; const lds_cptr vp0=shm3+LDS_V+((lane>>4)&1)*32+(lane&3)*8+(4*hi+((lane&15)>>2))*64;
  const int NT=(q0+QB)/KVBLK;
  DMA_K(0,0);DMA_V(0,0);DMA_K(1,SLOTB);
  bf16x8 qr[4];
  #pragma unroll
  for(int d0=0;d0<4;++d0)qr[d0]=*reinterpret_cast<const bf16x8*>(&Qw[(long)r32*DM+d0*16+hi*8]);
  float mhat=0.f,l_reg=0.f;f32x16 o[4];o[0]=f32x16{};o[1]=f32x16{};o[2]=f32x16{};o[3]=f32x16{};const f32x16 negm=f32x16{};
  const int qrel=wid*QBLK+r32;
  #define CMASK(P0,P1,t) do{int jb_=(t)-(NT-4); if(jb_>=0)cmask(P0,P1,jb_,wid);}while(0)
  bool resc=false;
  #define START(P0,P1) do{ const float rm=rowmax(P0,P1); resc=false; \
    { const float dl=rm; mhat=fadd_s(mhat,dl); \
      _Pragma("unroll") for(int r=0;r<16;++r){P0[r]=fsub_s(P0[r],dl);P1[r]=fsub_s(P1[r],dl);} \
      } \
    _Pragma("unroll") for(int r=0;r<16;++r)P0[r]=__builtin_amdgcn_exp2f(P0[r]); }while(0)
  #define RESC() do{ if(resc){ asm volatile("s_waitcnt lgkmcnt(0)":::"memory"); \
      _Pragma("unroll") for(int d_=0;d_<4;++d_) _Pragma("unroll") for(int r=0;r<16;++r)o[d_][r]*=wsf[crow(r,hi)]; } }while(0)
  f32x16 pA0,pA1,pB0,pB1;
  int sl_prev=0,sl_cur=0,sl_next=SLOTB;
  #define ROT() do{sl_prev=sl_cur;sl_cur=sl_next;sl_next=(sl_next==(NSLOT-1)*SLOTB)?0:sl_next+SLOTB;}while(0)
  DMA_K(2,2*SLOTB);
  WAIT_BAR(4);
  qkt(pA0,pA1,Kbase,qr,negm,r32,hi);asm volatile("s_nop 15\n\ts_nop 7":"+v"(pA0),"+v"(pA1));CMASK(pA0,pA1,0);
  START(pA0,pA1);
  _Pragma("unroll") for(int r=0;r<16;++r)pA1[r]=__builtin_amdgcn_exp2f(pA1[r]);
  WAIT_BAR(0);
  DMA_K(3,0);DMA_V(1,SLOTB);
  ROT();
  kload8(kf,kp0+sl_cur);
  WAIT_BAR(3);
  s16x4 vlo[8],vhi[8]; u32x4 pw0,pw1,pw2,pw3;
  #define PKW(P,B) cvtpk_s(P[B],P[B+1])
  #define PAF(k) __builtin_bit_cast(bf16x8,pw##k)
  #define VFR(i) (bf16x8){vlo[i][0],vlo[i][1],vlo[i][2],vlo[i][3],vhi[i][0],vhi[i][1],vhi[i][2],vhi[i][3]}
  #define PIN(x) asm volatile("":"+v"(x))
  #define MX3(a,b,c) __builtin_fmaxf(__builtin_fmaxf((a),(b)),(c))
  #define GAPA(MF,A0,A1,A2,A3,W0,W1,PW) do{ MF; sacc+=A0; sacc+=A1; sacc+=A2; sacc+=A3; PIN(sacc); W0; W1; PIN(PW); SBAR(); }while(0)
  #define EX(v) __builtin_amdgcn_exp2f(v)
  #define GAPB(MF,X,B) do{ MF; X[B]=EX(X[B]); X[B+1]=EX(X[B+1]); X[B+2]=EX(X[B+2]); X[B+3]=EX(X[B+3]); PIN(X); SBAR(); }while(0)
  #define VRD(i) do{ vlo[i]=vtr(vp_+(((i)>>2)*4096+((i)&3)*1024)); vhi[i]=vtr(vp_+(((i)>>2)*4096+((i)&3)*1024+512)); }while(0)
  #define VRD2(i) do{ vlo[i]=vtr(vp_+((2+((i)>>2))*4096+((i)&3)*1024)); vhi[i]=vtr(vp_+((2+((i)>>2))*4096+((i)&3)*1024+512)); SBAR(); }while(0)
  #define GAPB2(MF,X,B) do{ MF; X[B]=EX(X[B]-mhat); X[B+1]=EX(X[B+1]-mhat); PIN(X); SBAR(); }while(0)
  #define KRD(G,j) do{ if(G){ kload2(kf,kp0+sl_next,j); SBAR(); } }while(0)
  #define STEP(C0,C1,P0,P1,t,GK,GV,GL) do{ SBAR(); \
    const lds_cptr vp_=vp0+2*sl_prev; \
    VRD(0); SBAR(); float sacc=(P0[0]+P0[1]); \
    GAPA(C0=__builtin_amdgcn_mfma_f32_32x32x16_bf16(kf[0],qr[0],negm,0,0,0), P0[2],P0[3],P0[4],P0[5],     pw0[0]=PKW(P0,0), pw0[1]=PKW(P0,2), pw0); \
    VRD(4); SBAR(); GAPA(C1=__builtin_amdgcn_mfma_f32_32x32x16_bf16(kf[1],qr[0],negm,0,0,0), P0[6],P0[7],P0[8],P0[9],     pw0[2]=PKW(P0,4), pw0[3]=PKW(P0,6), pw0); \
    VRD(1); SBAR(); GAPA(C0=__builtin_amdgcn_mfma_f32_32x32x16_bf16(kf[2],qr[1],C0,0,0,0),   P0[10],P0[11],P0[12],P0[13], pw1[0]=PKW(P0,8), pw1[1]=PKW(P0,10), pw1); \
    VRD(5); SBAR(); GAPA(C1=__builtin_amdgcn_mfma_f32_32x32x16_bf16(kf[3],qr[1],C1,0,0,0),   P0[14],P0[15],P1[0],P1[1],   pw1[2]=PKW(P0,12),pw1[3]=PKW(P0,14), pw1); \
    GAPA(C0=__builtin_amdgcn_mfma_f32_32x32x16_bf16(kf[4],qr[2],C0,0,0,0),   P1[2],P1[3],P1[4],P1[5],     pw2[0]=PKW(P1,0), pw2[1]=PKW(P1,2), pw2); \
    GAPA(C1=__builtin_amdgcn_mfma_f32_32x32x16_bf16(kf[5],qr[2],C1,0,0,0),   P1[6],P1[7],P1[8],P1[9],     pw2[2]=PKW(P1,4), pw2[3]=PKW(P1,6), pw2); \
    GAPA(C0=__builtin_amdgcn_mfma_f32_32x32x16_bf16(kf[6],qr[3],C0,0,0,0),   P1[10],P1[11],P1[12],P1[13], pw3[0]=PKW(P1,8), pw3[1]=PKW(P1,10), pw3); \
    GAPA(C1=__builtin_amdgcn_mfma_f32_32x32x16_bf16(kf[7],qr[3],C1,0,0,0),   P1[14],P1[15],0.f,0.f,       pw3[2]=PKW(P1,12),pw3[3]=PKW(P1,14), pw3); \
    l_reg+=sacc; \
    if(GK){DMA_K((t)+3,sl_cur);} if(GV){DMA_V((t)+1,sl_next);} \
    CMASK(C0,C1,t); \
    { float a=MX3(C0[0],C0[1],C1[0]),b=MX3(C0[2],C0[3],C1[1]); a=MX3(a,C1[2],C1[3]); \
      _Pragma("unroll") for(int r=4;r<16;r+=4){a=MX3(a,C0[r],C0[r+1]);b=MX3(b,C0[r+2],C0[r+3]);a=MX3(a,C1[r],C1[r+1]);b=MX3(b,C1[r+2],C1[r+3]);} \
      float rm=__builtin_fmaxf(a,b); { auto rr=__builtin_amdgcn_permlane32_swap(__float_as_uint(rm),__float_as_uint(rm),false,false); rm=__builtin_fmaxf(__uint_as_float(rr[0]),__uint_as_float(rr[1])); } \
      resc=false; const float rmr=rm-mhat; \
      if(__builtin_expect(__any(rmr>(float)THRL),0)){ const float dl=__builtin_fmaxf(rmr,0.f); mhat+=dl; \
        const float f=__builtin_amdgcn_exp2f(-dl); l_reg*=f; if(hi==0)wsf[r32]=f; resc=true; } } \
    SBAR(); \
    VRD(2); SBAR(); GAPB2(o[0]=__builtin_amdgcn_mfma_f32_32x32x16_bf16(PAF(0),VFR(0),o[0],0,0,0), C0,0); \
    VRD(6); SBAR(); GAPB2(o[1]=__builtin_amdgcn_mfma_f32_32x32x16_bf16(PAF(0),VFR(4),o[1],0,0,0), C0,2); \
    VRD(3); SBAR(); GAPB2(o[0]=__builtin_amdgcn_mfma_f32_32x32x16_bf16(PAF(1),VFR(1),o[0],0,0,0), C0,4); \
    VRD(7); SBAR(); GAPB2(o[1]=__builtin_amdgcn_mfma_f32_32x32x16_bf16(PAF(1),VFR(5),o[1],0,0,0), C0,6); \
    VRD2(0); GAPB2(o[0]=__builtin_amdgcn_mfma_f32_32x32x16_bf16(PAF(2),VFR(2),o[0],0,0,0), C0,8); \
    VRD2(4); GAPB2(o[1]=__builtin_amdgcn_mfma_f32_32x32x16_bf16(PAF(2),VFR(6),o[1],0,0,0), C0,10); \
    VRD2(1); GAPB2(o[0]=__builtin_amdgcn_mfma_f32_32x32x16_bf16(PAF(3),VFR(3),o[0],0,0,0), C0,12); \
    VRD2(5); GAPB2(o[1]=__builtin_amdgcn_mfma_f32_32x32x16_bf16(PAF(3),VFR(7),o[1],0,0,0), C0,14); \
    VRD2(2); GAPB2(o[2]=__builtin_amdgcn_mfma_f32_32x32x16_bf16(PAF(0),VFR(0),o[2],0,0,0), C1,0); \
    VRD2(6); GAPB2(o[3]=__builtin_amdgcn_mfma_f32_32x32x16_bf16(PAF(0),VFR(4),o[3],0,0,0), C1,2); \
    VRD2(3); KRD(GL,0); GAPB2(o[2]=__builtin_amdgcn_mfma_f32_32x32x16_bf16(PAF(1),VFR(1),o[2],0,0,0), C1,4); \
    VRD2(7); KRD(GL,1); GAPB2(o[3]=__builtin_amdgcn_mfma_f32_32x32x16_bf16(PAF(1),VFR(5),o[3],0,0,0), C1,6); \
    KRD(GL,2); GAPB2(o[2]=__builtin_amdgcn_mfma_f32_32x32x16_bf16(PAF(2),VFR(2),o[2],0,0,0), C1,8); \
    KRD(GL,3); GAPB2(o[3]=__builtin_amdgcn_mfma_f32_32x32x16_bf16(PAF(2),VFR(6),o[3],0,0,0), C1,10); \
    GAPB2(o[2]=__builtin_amdgcn_mfma_f32_32x32x16_bf16(PAF(3),VFR(3),o[2],0,0,0), C1,12); \
    GAPB2(o[3]=__builtin_amdgcn_mfma_f32_32x32x16_bf16(PAF(3),VFR(7),o[3],0,0,0), C1,14); \
    }while(0)
  int t=1;
  #undef CMASK
  #define CMASK(P0,P1,t) do{}while(0)
  for(;t+5<NT;t+=2){
    STEP(pB0,pB1,pA0,pA1,t,true,true,true);     WAIT_BAR(3); RESC(); ROT();
    STEP(pA0,pA1,pB0,pB1,t+1,true,true,true);   WAIT_BAR(3); RESC(); ROT();
  }
  #undef CMASK
  #define CMASK(P0,P1,t) do{int jb_=(t)-(NT-4); if(jb_>=0)cmask(P0,P1,jb_,wid);}while(0)
  #define ENDW(tt) do{ if((tt)+3<NT){WAIT_BAR(3);} else if((tt)+2<NT){WAIT_BAR(2);} else {WAIT_BAR(0);} }while(0)
  for(;t+1<NT;t+=2){
    STEP(pB0,pB1,pA0,pA1,t,(t+3<NT),(t+1<NT),(t+1<NT));       ENDW(t);   RESC(); ROT();
    STEP(pA0,pA1,pB0,pB1,t+1,(t+4<NT),(t+2<NT),(t+2<NT));     ENDW(t+1); RESC(); ROT();
  }
  STEP(pB0,pB1,pA0,pA1,NT-1,false,false,false); RESC();
  { float sacc=pB0[0]+pB0[1]; _Pragma("unroll") for(int r=2;r<16;++r)sacc+=pB0[r]; _Pragma("unroll") for(int r=0;r<16;++r)sacc+=pB1[r]; l_reg+=sacc;
    pw0=(u32x4){PKW(pB0,0),PKW(pB0,2),PKW(pB0,4),PKW(pB0,6)};pw1=(u32x4){PKW(pB0,8),PKW(pB0,10),PKW(pB0,12),PKW(pB0,14)};pw2=(u32x4){PKW(pB1,0),PKW(pB1,2),PKW(pB1,4),PKW(pB1,6)};pw3=(u32x4){PKW(pB1,8),PKW(pB1,10),PKW(pB1,12),PKW(pB1,14)};
    SBAR(); pv(o,vb0+2*sl_cur,PAF(0),PAF(1),PAF(2),PAF(3)); }
  #undef PKW
  #undef PAF
  #undef VFR
  #undef PIN
  #undef MX3
  #undef GAPA
  #undef GAPB
  #undef GAPB2
  #undef VRD2
  #undef EX
  #undef VRD
  #undef KRD
  #undef STEP
  #undef ENDW
  {auto rr=__builtin_amdgcn_permlane32_swap(__float_as_uint(l_reg),__float_as_uint(l_reg),false,false);l_reg=__uint_as_float(rr[0])+__uint_as_float(rr[1]);}
  if(hi==0)wsf[32+r32]=l_reg;asm volatile("s_waitcnt lgkmcnt(0)":::"memory");
  float rli[16];
  #pragma unroll
  for(int r=0;r<16;++r)rli[r]=__builtin_amdgcn_rcpf(wsf[32+crow(r,hi)]);
  bf16*Ow=O+(rowbase+q0+wid*QBLK)*DM+vcol;
  { bf16*stg=(bf16*)(shm+LDS_OST)+wid*2048;
    #pragma unroll
    for(int hf=0;hf<2;++hf){
    #pragma unroll
    for(int r=0;r<16;++r){const int orow=crow(r,hi);
      #pragma unroll
      for(int d0=0;d0<2;++d0)stg[orow*64+d0*32+r32]=__float2bfloat16(o[2*hf+d0][r]*rli[r]);}
    asm volatile("s_waitcnt lgkmcnt(0)":::"memory");
    #pragma unroll
    for(int i=0;i<4;++i){const int row=i*8+(lane>>3),ch=lane&7; const u32x4 v=*(const u32x4*)(stg+row*64+ch*8); ATTN_STORE16(Ow+(long)row*DM+hf*64+ch*8,v);}
    asm volatile("s_waitcnt lgkmcnt(0)":::"memory"); } }
  asm volatile("s_waitcnt lgkmcnt(0)\n\ts_barrier":::"memory");
  #undef DMA_K
  #undef DMA_V
  #undef CMASK
  #undef START
  #undef RESC
  #undef ROT
}
constexpr int ATTN_LDS_BYTES=LDS_BYTES;
struct AttnTensors { const bf16* Q; const bf16* K; const bf16* V; bf16* O; };
struct AttnUnit { int var; int qb; };
struct StaticOrder {
  int vcu;
  __device__ __forceinline__ explicit StaticOrder(int v):vcu(v){}
  __device__ __forceinline__ bool next(int i,AttnUnit&u)const{ if(i>=2)return false; const int s=vcu&31; u.var=vcu>>5; u.qb=(i==0)?s:63-s; return true; }
};
template<class Sched,int THRL=8> __device__ __forceinline__ void attn_phase(char*lds,const AttnTensors&T,const Sched&S){
  AttnUnit u;
  for(int i=0;S.next(i,u);++i){ const int h=u.var>>1,mp=u.var&1;
    attn_unit<THRL>(h*128+mp*64,h*128,u.qb,T.Q,T.K,T.V,T.O+(size_t)mp*SEQ*DM,lds); }
}
#undef SBAR
#undef WAIT_BAR
}


#define GAS __attribute__((address_space(1)))
#define LAS __attribute__((address_space(3)))
typedef unsigned short bf16;
typedef unsigned v4u __attribute__((ext_vector_type(4)));
typedef float f32x4 __attribute__((ext_vector_type(4)));
typedef short bf16x8 __attribute__((ext_vector_type(8)));
typedef GAS unsigned gu32;
typedef GAS unsigned long long gu64;
#define RLX_AGENT __ATOMIC_RELAXED, __HIP_MEMORY_SCOPE_AGENT
#define LDS_WAIT() asm volatile("s_waitcnt lgkmcnt(0)" ::: "memory")
#define VM_WAIT() asm volatile("s_waitcnt vmcnt(0)" ::: "memory")
__device__ __forceinline__ unsigned long long rt() { return __builtin_amdgcn_s_memrealtime(); }
__device__ __forceinline__ unsigned f2bf(float f) { unsigned u = __builtin_bit_cast(unsigned, f); return (u + 0x7fffu + ((u >> 16) & 1u)) >> 16; }
__device__ __forceinline__ unsigned pk2(float lo, float hi) { return f2bf(lo) | (f2bf(hi) << 16); }

#define XB_TMO      128
#define XB_XCNT(j)  (256  + 64 * (j))
#define XB_XSUB(j)  (1280 + 64 * (j))
#define XB_XGEN(j)  (2304 + 64 * (j))
#define XB_TOP      3328
#define XB_TOPGEN   3392
#define XCD_BAR_WORDS 3456
#define XB_SPIN_CAP (1u << 18)

__device__ __forceinline__ unsigned xb_ld(unsigned* p)              { return __hip_atomic_load(p, __ATOMIC_RELAXED, __HIP_MEMORY_SCOPE_AGENT); }
__device__ __forceinline__ unsigned xb_add(unsigned* p, unsigned v) { return __hip_atomic_fetch_add(p, v, __ATOMIC_RELAXED, __HIP_MEMORY_SCOPE_AGENT); }
__device__ __forceinline__ unsigned xb_xcc_id() { return (unsigned)__builtin_amdgcn_s_getreg((3 << 11) | 20) & 0xFu; }
#define XB_SPIN(cond, bar) do { unsigned _sp = 0; while (cond) { __builtin_amdgcn_s_sleep(1); \
    if ((++_sp & 255u) == 0u) { if (xb_ld(&(bar)[XB_TMO])) break; if (_sp > XB_SPIN_CAP) { atomicAdd(&(bar)[XB_TMO], 1u); break; } } } } while (0)

struct XcdBarrier {
    unsigned* bar; unsigned x;
    volatile LAS unsigned* st;
};

__device__ __forceinline__ XcdBarrier xcd_barrier_post(unsigned* bar, volatile LAS unsigned* st) {
    XcdBarrier b; b.bar = bar; b.x = xb_xcc_id(); b.st = st;
    if (threadIdx.x == 0) (void)xb_add(&bar[XB_XCNT(b.x)], 1u);
    return b;
}
__device__ __forceinline__ void xcd_barrier_complete(unsigned* bar, unsigned x, unsigned& nloc, unsigned& nx) {
    const unsigned G = gridDim.x * gridDim.y * gridDim.z;
    unsigned sum, cnt, mine, sp = 0u;
    for (;;) {
        sum = 0u; cnt = 0u; mine = 0u;
#pragma unroll
        for (unsigned j = 0; j < 16; ++j) { const unsigned c = xb_ld(&bar[XB_XCNT(j)]); sum += c; cnt += (c > 0u) ? 1u : 0u; mine = (j == x) ? c : mine; }
        if (sum == G) break;
        __builtin_amdgcn_s_sleep(1);
        if ((++sp & 255u) == 0u) { if (xb_ld(&bar[XB_TMO])) break; if (sp > XB_SPIN_CAP) { atomicAdd(&bar[XB_TMO], 1u); break; } }
    }
    nloc = mine > 0u ? mine : 1u; nx = cnt > 0u ? cnt : 1u;
}

__device__ __forceinline__ void xcd_barrier(const XcdBarrier& b) {
    asm volatile("s_waitcnt vmcnt(0)" ::: "memory");
    __syncthreads();
    if (threadIdx.x == 0) {
        unsigned* bar = b.bar;
        __builtin_amdgcn_s_waitcnt(0);
        unsigned nloc = b.st[0], nx = b.st[1];
        if (nloc == 0u) { xcd_barrier_complete(bar, b.x, nloc, nx); b.st[0] = nloc; b.st[1] = nx; }
        const unsigned old = xb_add(&bar[XB_XSUB(b.x)], 1u);
        const unsigned gen = old / nloc;
        if (old + 1u == (gen + 1u) * nloc) {
            __builtin_amdgcn_fence(__ATOMIC_RELEASE, "agent");
            asm volatile("s_waitcnt vmcnt(0)" ::: "memory");
            const unsigned og = xb_add(&bar[XB_TOP], 1u);
            const unsigned tg = og / nx;
            if (og + 1u == (tg + 1u) * nx) xb_add(&bar[XB_TOPGEN], 1u);
            else XB_SPIN(xb_ld(&bar[XB_TOPGEN]) == tg, bar);
            __builtin_amdgcn_fence(__ATOMIC_ACQUIRE, "agent");
            xb_add(&bar[XB_XGEN(b.x)], 1u);
            asm volatile("s_waitcnt vmcnt(0)" ::: "memory");
        } else {
            XB_SPIN(xb_ld(&bar[XB_XGEN(b.x)]) == gen, bar);
            __builtin_amdgcn_fence(__ATOMIC_ACQUIRE, "agent");
            asm volatile("s_waitcnt vmcnt(0)" ::: "memory");
        }
    }
    __syncthreads();
}

constexpr int NWAVES = 8;
constexpr int M = 16384, D = 1024, INC = 2560, AW = 512, LW = 512, NQ = 2048, NEXP = 16384;
constexpr float EPSN = 1e-6f;
constexpr size_t MiB = 1u << 20;
constexpr size_t WS_CTL = 0, CTL_ZERO_BYTES = 1 * MiB;
constexpr size_t WS_ROWSS2 = 512 * 1024;
constexpr size_t WS_RS1 = 1 * MiB;
constexpr size_t WS_SK1 = 1 * MiB + 128 * 1024, WS_SK2 = WS_SK1 + 32 * 1024;
constexpr size_t WS_WIN = 2 * MiB, WS_WOUT = 8 * MiB, WS_WQ = 10 * MiB;
constexpr size_t WS_ED = 16 * MiB, WS_EU = 48 * MiB;
constexpr size_t WS_SCD = 32 * MiB, WS_SCU = 33 * MiB;
constexpr size_t WS_WQ8 = 170 * MiB;
constexpr size_t WS_XB = 80 * MiB;
constexpr size_t WS_OS = 80 * MiB;
constexpr size_t WS_Q2 = 80 * MiB;
constexpr size_t WS_Q = 112 * MiB, WS_SPLIT = 16 * MiB;
constexpr size_t WS_GATE = WS_Q + 4 * WS_SPLIT;
constexpr size_t WS_EID = 144 * MiB, WS_GW = 152 * MiB;
constexpr size_t WS_MIX = 192 * MiB, WS_HB = 224 * MiB, WS_END = 256 * MiB;
constexpr size_t WS_ROWSS3 = 576 * 1024;
constexpr size_t WS_DOTP = 80 * MiB;
constexpr size_t WS_REC = 160 * MiB, WS_N0 = 168 * MiB;
constexpr size_t WS_PEER = 80 * MiB;
constexpr size_t WS_REC_OLD_UNUSED = 0;
constexpr int CW_BAR = 4096;
constexpr int RING_OFF = 0, RING_BYTES = 131072;
constexpr int LDSCTL_OFF = RING_BYTES, MISC_OFF = LDSCTL_OFF + 320;
constexpr int LDS_BYTES = 163840;

struct Frame {
    LAS unsigned char* lds;
    volatile LAS unsigned* MISC;
    int tid, lane, wave;
    int vcu, G;
};

__device__ __forceinline__ float wave_sum(float v) {
#pragma unroll
    for (int o = 1; o < 64; o <<= 1) v += __shfl_xor(v, o);
    return v;
}
__device__ __forceinline__ float bf2f(unsigned short b) { return __builtin_bit_cast(float, (unsigned)b << 16); }
__device__ __forceinline__ float bflo(unsigned w) { return __builtin_bit_cast(float, w << 16); }
__device__ __forceinline__ float bfhi(unsigned w) { return __builtin_bit_cast(float, w & 0xffff0000u); }
__device__ __forceinline__ float gelu_tanh(float x) { const float u = 0.7978845608028654f * (x + 0.044715f * x * x * x); return 0.5f * x * (1.0f + tanhf(u)); }
__device__ __forceinline__ float sigmoidf_(float x) { return 1.0f / (1.0f + expf(-x)); }
__device__ __forceinline__ float fsigmoid(float x) { return __builtin_amdgcn_rcpf(1.0f + __builtin_amdgcn_exp2f(-1.4426950408889634f * x)); }
__device__ __forceinline__ float fgelu_tanh(float x) { const float u = 0.7978845608028654f * (x + 0.044715f * x * x * x); const float t = 1.0f - 2.0f * __builtin_amdgcn_rcpf(1.0f + __builtin_amdgcn_exp2f(2.8853900817779268f * u)); return 0.5f * x * (1.0f + t); }

__device__ __forceinline__ void p0_transpose_item(const float* W, int K, int N, bf16* WT, const float* gk, LAS float* scr, int item, int lane) {
    const int nblk = N / 32, kb = item / nblk, nb = item % nblk, k0 = 64 * kb, n0 = 32 * nb;
#pragma unroll 8
    for (int i = 0; i < 32; ++i) { const int kk = 2 * i + (lane >> 5); const float g = gk ? gk[k0 + kk] : 1.0f; scr[kk * 33 + (lane & 31)] = W[(size_t)(k0 + kk) * N + n0 + (lane & 31)] * g; }
    LDS_WAIT(); asm volatile("" ::: "memory");
    const int c = lane & 7;
#pragma unroll
    for (int j = 0; j < 4; ++j) { const int n = (lane >> 3) + 8 * j; const LAS float* s = scr + (8 * c) * 33 + n;
        v4u o; o.x = pk2(s[0 * 33], s[1 * 33]); o.y = pk2(s[2 * 33], s[3 * 33]); o.z = pk2(s[4 * 33], s[5 * 33]); o.w = pk2(s[6 * 33], s[7 * 33]);
        *(GAS v4u*)(WT + (size_t)(n0 + n) * K + k0 + 8 * c) = o; }
    LDS_WAIT(); asm volatile("" ::: "memory");
}
template <int NR> __device__ __forceinline__ void p0_rows(const float* xrow, bf16* orow, const float* gk, float* rs, int lane) {
    f32x4 v[NR][4];
#pragma unroll
    for (int i = 0; i < NR; ++i)
#pragma unroll
        for (int j = 0; j < 4; ++j) v[i][j] = __builtin_nontemporal_load((const GAS f32x4*)(xrow + (size_t)i * 1024) + lane + 64 * j);
#pragma unroll
    for (int i = 0; i < NR; ++i) {
        if (rs) { float s = 0.f;
#pragma unroll
            for (int j = 0; j < 4; ++j) s += (v[i][j].x * v[i][j].x + v[i][j].y * v[i][j].y) + (v[i][j].z * v[i][j].z + v[i][j].w * v[i][j].w);
            const float tot = wave_sum(s); if (lane == 0) rs[i] = 1.0f / sqrtf(tot * (1.0f / 1024.0f) + EPSN); }
        if (gk) {
#pragma unroll
            for (int j = 0; j < 4; ++j) v[i][j] = v[i][j] * ((const GAS f32x4*)gk)[lane + 64 * j]; }
        GAS unsigned long long* o8 = (GAS unsigned long long*)(orow + (size_t)i * 1024) + lane;
#pragma unroll
        for (int j = 0; j < 4; ++j) o8[64 * j] = (unsigned long long)pk2(v[i][j].x, v[i][j].y) | ((unsigned long long)pk2(v[i][j].z, v[i][j].w) << 32);
    }
}

struct Args { const float* in[23]; float* out; unsigned char* ws; int ph_lo, ph_hi; };

__device__ __forceinline__ void p0_prologue(Frame& F, const Args& a) {
    LAS float* scr = (LAS float*)(F.lds + RING_OFF + F.wave * 16384);
    unsigned char* ws = a.ws;
    const int gw = F.vcu * NWAVES + F.wave, NGW = F.G * NWAVES;
    constexpr int I_IN = (D / 64) * (INC / 32), I_OUT = (D / 64) * (D / 32), I_Q = (D / 64) * (NQ / 32);
    constexpr int NITEMS = I_IN + I_OUT + I_Q;
    for (int it = gw; it < NITEMS; it += NGW) {
        int r = it;
        if (r < I_IN) { p0_transpose_item(a.in[2], D, INC, (bf16*)(ws + WS_WIN), a.in[1], scr, r, F.lane); continue; } r -= I_IN;
        if (r < I_OUT) { p0_transpose_item(a.in[15], D, D, (bf16*)(ws + WS_WOUT), nullptr, scr, r, F.lane); continue; } r -= I_OUT;
        p0_transpose_item(a.in[17], D, NQ, (bf16*)(ws + WS_WQ), a.in[16], scr, r, F.lane);
    }
    constexpr int NGRP = (M + 32) / 4;
    for (int m = gw; m < NGRP; m += NGW) {
        int r = 4 * m;
        if (r < M) { p0_rows<4>(a.in[0] + (size_t)r * D, (bf16*)(ws + WS_XB) + (size_t)r * D, nullptr, (float*)(ws + WS_RS1) + r, F.lane); continue; } r -= M;
        if (r < 16) { p0_rows<4>(a.in[18] + (size_t)r * 1024, (bf16*)(ws + WS_SK1) + (size_t)r * 1024, nullptr, nullptr, F.lane); continue; } r -= 16;
        p0_rows<4>(a.in[19] + (size_t)r * 1024, (bf16*)(ws + WS_SK2) + (size_t)r * 1024, nullptr, nullptr, F.lane);
    }
}
template <int NR> __device__ __forceinline__ void q8_rows(const float* xrow, unsigned char* orow, const float* gk, float* scale, int lane) {
    f32x4 v[NR][4];
#pragma unroll
    for (int i = 0; i < NR; ++i)
#pragma unroll
        for (int j = 0; j < 4; ++j) v[i][j] = __builtin_nontemporal_load((const GAS f32x4*)(xrow + (size_t)i * 1024) + lane + 64 * j);
#pragma unroll
    for (int i = 0; i < NR; ++i) {
        float am = 0.f;
#pragma unroll
        for (int j = 0; j < 4; ++j) { if (gk) v[i][j] = v[i][j] * ((const GAS f32x4*)gk)[lane + 64 * j];
            am = fmaxf(fmaxf(am, fmaxf(fabsf(v[i][j].x), fabsf(v[i][j].y))), fmaxf(fabsf(v[i][j].z), fabsf(v[i][j].w))); }
#pragma unroll
        for (int o = 1; o < 64; o <<= 1) am = fmaxf(am, __shfl_xor(am, o));
        const float sc = (am > 0.f) ? am * (1.0f / 127.0f) : 1.0f, inv = 1.0f / sc;
        if (lane == 0) scale[i] = sc;
        GAS unsigned* o4 = (GAS unsigned*)(orow + (size_t)i * 1024) + lane;
#pragma unroll
        for (int j = 0; j < 4; ++j) { const int q0 = (int)__builtin_rintf(v[i][j].x * inv), q1 = (int)__builtin_rintf(v[i][j].y * inv), q2 = (int)__builtin_rintf(v[i][j].z * inv), q3 = (int)__builtin_rintf(v[i][j].w * inv);
            o4[64 * j] = ((unsigned)q0 & 255u) | (((unsigned)q1 & 255u) << 8) | (((unsigned)q2 & 255u) << 16) | ((unsigned)q3 << 24); }
    }
}
__device__ __forceinline__ void convert_experts(const Args& a, int w, int nw, int lane) {
    unsigned char* ws = a.ws;
    for (int m = w; m < (2 * NEXP) / 4; m += nw) {
        int r = 4 * m;
        if (r < NEXP) { q8_rows<4>(a.in[20] + (size_t)r * D, ws + WS_ED + (size_t)r * D, a.in[16], (float*)(ws + WS_SCD) + r, lane); continue; } r -= NEXP;
        q8_rows<4>(a.in[21] + (size_t)r * D, ws + WS_EU + (size_t)r * D, nullptr, (float*)(ws + WS_SCU) + r, lane);
    }
}

typedef float f32x16 __attribute__((ext_vector_type(16)));
__device__ __forceinline__ void lru_local_unit(Frame& F, const Args& a, int c) {
    constexpr int YP = 520;
    LAS unsigned short* Y = (LAS unsigned short*)(F.lds + RING_OFF);
    const int e = F.tid, r0 = c * 64;
    const bf16* XR = (const bf16*)(a.ws + WS_Q + 3 * WS_SPLIT);
    float* HL = a.out; float* AC = a.out + (size_t)M * 512;
    { const float* conv_w = a.in[8]; const float cw0 = conv_w[e], cw1 = conv_w[512 + e], cw2 = conv_w[1024 + e], cw3 = conv_w[1536 + e], cb = a.in[9][e];
      float x0 = 0.f, x1 = 0.f, x2 = 0.f;
      if (c > 0) { x0 = bf2f(XR[(size_t)(r0 - 3) * 512 + e]); x1 = bf2f(XR[(size_t)(r0 - 2) * 512 + e]); x2 = bf2f(XR[(size_t)(r0 - 1) * 512 + e]); }
#pragma unroll 8
      for (int t = 0; t < 64; ++t) { const float x3 = bf2f(XR[(size_t)(r0 + t) * 512 + e]); Y[t * YP + e] = (unsigned short)f2bf(cb + x0 * cw0 + x1 * cw1 + x2 * cw2 + x3 * cw3); x0 = x1; x1 = x2; x2 = x3; } }
    __syncthreads();
    const int n = F.wave, lane = F.lane, r32 = lane & 31, hi = lane >> 5;
#pragma unroll 1
    for (int et = 0; et < 2; ++et) {
        bf16x8 wf[2][4];
#pragma unroll
        for (int gt = 0; gt < 2; ++gt) { const float* w = a.in[gt ? 12 : 10] + n * 4096 + 32 * et; asm volatile("" : "+s"(w));
#pragma unroll
            for (int ks = 0; ks < 4; ++ks) { float f[8];
#pragma unroll
                for (int j = 0; j < 8; ++j) f[j] = w[(16 * ks + 8 * hi + j) * 64 + r32];
                wf[gt][ks] = __builtin_bit_cast(bf16x8, (v4u){pk2(f[0], f[1]), pk2(f[2], f[3]), pk2(f[4], f[5]), pk2(f[6], f[7])}); asm volatile("" ::: "memory"); } }
        const int ch = 64 * n + 32 * et + r32;
        const float ba = a.in[11][ch], bx = a.in[13][ch], lam = a.in[14][ch];
        const float sp = (lam > 15.f) ? expf(-lam) : log1pf(expf(-lam));
        float av[2][16], bv[2][16];
#pragma unroll
        for (int tt = 0; tt < 2; ++tt) {
            f32x16 ra = {}, ia = {};
#pragma unroll
            for (int ks = 0; ks < 4; ++ks) { const bf16x8 af = *(const LAS bf16x8*)(Y + (32 * tt + r32) * YP + 64 * n + 16 * ks + 8 * hi);
                ra = __builtin_amdgcn_mfma_f32_32x32x16_bf16(af, wf[0][ks], ra, 0, 0, 0); ia = __builtin_amdgcn_mfma_f32_32x32x16_bf16(af, wf[1][ks], ia, 0, 0, 0); }
#pragma unroll
            for (int r = 0; r < 16; ++r) { const int t = 32 * tt + (r & 3) + 8 * (r >> 2) + 4 * hi;
                const float rr = fsigmoid(ra[r] + ba), ii = fsigmoid(ia[r] + bx);
                const float log_a = -8.0f * rr * sp, aa = __builtin_amdgcn_exp2f(log_a * 1.4426950408889634f);
                const float u2 = 2.0f * log_a;
                const float ser = -u2 * (1.0f + u2 * (0.5f + u2 * (0.16666667f + u2 * (0.041666668f + u2 * 0.0083333338f))));
                const float om = (u2 > -0.1f) ? ser : (1.0f - aa * aa);
                const float mult = __builtin_amdgcn_sqrtf(fmaxf(om, 1e-12f));
                av[tt][r] = aa; bv[tt][r] = mult * (ii * bf2f(Y[t * YP + ch])); }
        }
#pragma unroll
        for (int tt = 0; tt < 2; ++tt)
#pragma unroll
            for (int rq = 0; rq < 4; ++rq) { float h = 0.f, pa = 1.f;
#pragma unroll
                for (int k = 0; k < 4; ++k) { const int r = 4 * rq + k; h = av[tt][r] * h + bv[tt][r]; pa *= av[tt][r]; bv[tt][r] = h; av[tt][r] = pa; } }
        float hin[8], ain[8]; float hc = 0.f, ac = 1.f;
#pragma unroll
        for (int j = 0; j < 8; ++j) { const int tt = j >> 2, r3 = 4 * (j & 3) + 3;
#pragma unroll
            for (int own = 0; own < 2; ++own) {
                if (hi == own) { hin[j] = hc; ain[j] = ac; }
                const float mh = av[tt][r3] * hc + bv[tt][r3], ma = ac * av[tt][r3];
                const float oh = __shfl_xor(mh, 32), oa = __shfl_xor(ma, 32);
                hc = (hi == own) ? mh : oh; ac = (hi == own) ? ma : oa; } }
#pragma unroll
        for (int tt = 0; tt < 2; ++tt)
            { unsigned ob = (unsigned)((r0 + 32 * tt + 4 * hi) * 512 + ch); asm volatile("" : "+v"(ob));
#pragma unroll
            for (int r = 0; r < 16; ++r) { const int j = 4 * tt + (r >> 2); const unsigned o = ob + (unsigned)(((r & 3) + 8 * (r >> 2)) * 512);
                HL[o] = bv[tt][r] + av[tt][r] * hin[j]; AC[o] = av[tt][r] * ain[j]; } }
    }
    __syncthreads();
}

__device__ __forceinline__ void fix_unit(Frame& F, const Args& a, int c, float lamv) {
    const int r0 = c * 64;
    const float* HL = a.out; const float* AC = a.out + (size_t)M * 512;
    const bf16* GATE = (const bf16*)(a.ws + WS_GATE);
    bf16* MIX = (bf16*)(a.ws + WS_MIX);
    const int g4 = F.tid & 127, sgm = F.tid >> 7;
    LAS f32x4* SA = (LAS f32x4*)(F.lds + RING_OFF); LAS f32x4* SH = SA + 512;
    { const int L = (c + 3) >> 2; const int lo_c = sgm * L; int hi_c = lo_c + L; if (hi_c > c) hi_c = c;
      f32x4 A4 = (f32x4){1.f, 1.f, 1.f, 1.f}, H4 = (f32x4){0.f, 0.f, 0.f, 0.f};
      int cc = lo_c;
      for (; cc + 8 <= hi_c; cc += 8) { f32x4 av[8], hv[8];
#pragma unroll
          for (int k = 0; k < 8; ++k) { const size_t o = (size_t)((cc + k) * 64 + 63) * 512 + 4 * g4; av[k] = *(const GAS f32x4*)(AC + o); hv[k] = *(const GAS f32x4*)(HL + o); }
#pragma unroll
          for (int k = 0; k < 8; ++k) { H4 = av[k] * H4 + hv[k]; A4 = A4 * av[k]; } }
      for (; cc < hi_c; ++cc) { const size_t o = (size_t)(cc * 64 + 63) * 512 + 4 * g4; const f32x4 av = *(const GAS f32x4*)(AC + o), hv = *(const GAS f32x4*)(HL + o); H4 = av * H4 + hv; A4 = A4 * av; }
      SA[sgm * 128 + g4] = A4; SH[sgm * 128 + g4] = H4; }
    __syncthreads();
    f32x4 hin = (f32x4){0.f, 0.f, 0.f, 0.f};
#pragma unroll
    for (int sq = 0; sq < 4; ++sq) hin = SA[sq * 128 + g4] * hin + SH[sq * 128 + g4];
    __syncthreads();
#pragma unroll 4
    for (int t = sgm * 16; t < sgm * 16 + 16; ++t) { const size_t o = (size_t)(r0 + t) * 512 + 4 * g4;
        const f32x4 h = *(const GAS f32x4*)(HL + o) + *(const GAS f32x4*)(AC + o) * hin; const unsigned long long gw = *(const GAS unsigned long long*)(GATE + o);
        const unsigned glo = (unsigned)gw, ghi = (unsigned)(gw >> 32);
        const unsigned long long ov = (unsigned long long)pk2(h.x * fgelu_tanh(bflo(glo)), h.y * fgelu_tanh(bfhi(glo))) | ((unsigned long long)pk2(h.z * fgelu_tanh(bflo(ghi)), h.w * fgelu_tanh(bfhi(ghi))) << 32);
        *(GAS unsigned long long*)(MIX + (size_t)(r0 + t) * 1024 + 512 + 4 * g4) = ov; }
    const bf16* OS0 = (const bf16*)(a.ws + WS_OS); const bf16* OS1 = OS0 + (size_t)M * 512;
    const float* sg = a.in[7] + (F.lane & 15) * 8;
    float sgv[8];
#pragma unroll
    for (int j = 0; j < 8; ++j) sgv[j] = sg[j] * 0.8f;
#pragma unroll 2
    for (int rr = 0; rr < 8; ++rr) { const size_t row = (size_t)(r0 + 8 * F.wave + rr);
        const v4u p = *(const GAS v4u*)(OS0 + row * 512 + F.lane * 8), q = *(const GAS v4u*)(OS1 + row * 512 + F.lane * 8);
        float d[8];
        d[0] = bflo(p.x) - lamv * bflo(q.x); d[1] = bfhi(p.x) - lamv * bfhi(q.x); d[2] = bflo(p.y) - lamv * bflo(q.y); d[3] = bfhi(p.y) - lamv * bfhi(q.y);
        d[4] = bflo(p.z) - lamv * bflo(q.z); d[5] = bfhi(p.z) - lamv * bfhi(q.z); d[6] = bflo(p.w) - lamv * bflo(q.w); d[7] = bfhi(p.w) - lamv * bfhi(q.w);
        float ss = 0.f;
#pragma unroll
        for (int j = 0; j < 8; ++j) ss += d[j] * d[j];
        ss += __shfl_xor(ss, 1); ss += __shfl_xor(ss, 2); ss += __shfl_xor(ss, 4); ss += __shfl_xor(ss, 8);
        const float ri = 1.0f / sqrtf(ss * (1.0f / 128.0f) + EPSN);
        v4u o; o.x = pk2(d[0] * ri * sgv[0], d[1] * ri * sgv[1]); o.y = pk2(d[2] * ri * sgv[2], d[3] * ri * sgv[3]);
        o.z = pk2(d[4] * ri * sgv[4], d[5] * ri * sgv[5]); o.w = pk2(d[6] * ri * sgv[6], d[7] * ri * sgv[7]);
        *(GAS v4u*)(MIX + row * 1024 + F.lane * 8) = o; }
}

typedef float f32x16 __attribute__((ext_vector_type(16)));
#define CEX(a, b) do { const float _hi = fmaxf(a, b), _lo = fminf(a, b); a = _hi; b = _lo; } while (0)
__device__ __forceinline__ int skey(int b) { return b ^ ((b >> 31) & 0x7fffffff); }
#define CEI(a, b) do { const int _hi = max(a, b), _lo = min(a, b); a = _hi; b = _lo; } while (0)
__device__ __forceinline__ void sort16_desc(int (&v)[16]) {
#pragma unroll
    for (int k = 2; k <= 16; k <<= 1)
#pragma unroll
        for (int j = k >> 1; j >= 1; j >>= 1)
#pragma unroll
            for (int i = 0; i < 16; ++i) { const int l = i ^ j; if (l > i) { if ((i & k) == 0) CEI(v[i], v[l]); else CEI(v[l], v[i]); } }
}
__device__ __forceinline__ void merge16_desc(int (&a)[16], const int (&b)[16]) {
#pragma unroll
    for (int i = 0; i < 16; ++i) a[i] = max(a[i], b[15 - i]);
#pragma unroll
    for (int j = 8; j >= 1; j >>= 1)
#pragma unroll
        for (int i = 0; i < 16; ++i) if ((i & j) == 0) CEI(a[i], a[i + j]);
}
__device__ __forceinline__ void top16_half(int (&top)[16], const bf16* q, const LAS unsigned char* sk, int r32, int hi) {
    bf16x8 qf[8];
#pragma unroll
    for (int ks = 0; ks < 8; ++ks) qf[ks] = *(const GAS bf16x8*)(q + 16 * ks + 8 * hi);
#pragma unroll
    for (int i = 0; i < 16; ++i) top[i] = (int)0x80000000;
#pragma unroll 1
    for (int kt = 0; kt < 4; ++kt) {
        f32x16 acc = {};
#pragma unroll
        for (int ks = 0; ks < 8; ++ks) { const bf16x8 kf = *(const LAS bf16x8*)(sk + (32 * kt + r32) * 272 + (16 * ks + 8 * hi) * 2); acc = __builtin_amdgcn_mfma_f32_32x32x16_bf16(kf, qf[ks], acc, 0, 0, 0); }
        int grp[16];
#pragma unroll
        for (int r = 0; r < 16; ++r) { const int idx = 32 * kt + (r & 3) + 8 * (r >> 2) + 4 * hi; const float av = acc[r];
            grp[r] = (skey(__float_as_int(av)) & ~127) | idx; }
        sort16_desc(grp); merge16_desc(top, grp);
    }
    int oth[16];
#pragma unroll
    for (int i = 0; i < 16; ++i) oth[i] = __shfl_xor(top[i], 32);
    merge16_desc(top, oth);
}
__device__ __forceinline__ void route_unit(const Args& a, int g, int hd, int lane, LAS unsigned char* slot, const LAS unsigned char* skl, int* EIDo, float* GWo) {
    const int r32 = lane & 31, hi = lane >> 5; const int t = g * 32 + r32;
    const bf16* q = (const bf16*)(a.ws + WS_Q2) + (size_t)t * NQ + hd * 256;
    int k1[16], k2[16];
    top16_half(k1, q, skl, r32, hi);
    top16_half(k2, q + 128, skl + 128 * 272, r32, hi);
    { v4u w1, w2;
#define IDX4(v, j) (((unsigned)v[4 * (j)] & 127u) | (((unsigned)v[4 * (j) + 1] & 127u) << 8) | (((unsigned)v[4 * (j) + 2] & 127u) << 16) | (((unsigned)v[4 * (j) + 3] & 127u) << 24))
      w1 = (v4u){IDX4(k1, 0), IDX4(k1, 1), IDX4(k1, 2), IDX4(k1, 3)}; w2 = (v4u){IDX4(k2, 0), IDX4(k2, 1), IDX4(k2, 2), IDX4(k2, 3)};
#undef IDX4
      *(LAS v4u*)(slot) = w1; *(LAS v4u*)(slot + 16) = w2; }
    float v1[16], v2[16];
#pragma unroll
    for (int i = 0; i < 16; ++i) { v1[i] = __int_as_float(skey(k1[i])); v2[i] = __int_as_float(skey(k2[i])); }
#define CKEY(ia, ib) ((skey(__float_as_int(v1[ia] + v2[ib])) & ~255) | ((ia) * 16 + (ib)))
    int K[16], G1[16], G2[16];
#pragma unroll
    for (int i = 0; i < 16; ++i) K[i] = CKEY(0, i);
    { int n_ = 0;
#pragma unroll
      for (int ia = 1; ia < 16; ++ia)
#pragma unroll
          for (int ib = 0; ib < 16; ++ib) if ((ia + 1) * (ib + 1) <= 16) { const int kk = CKEY(ia, ib); if (n_ < 16) G1[n_] = kk; else if (n_ < 32) G2[n_ - 16] = kk; ++n_; }
    }
    sort16_desc(G1); merge16_desc(K, G1);
    sort16_desc(G2); merge16_desc(K, G2);
    { int x0 = CKEY(14, 0), x1 = CKEY(15, 0);
#pragma unroll
      for (int i = 0; i < 16; ++i) { CEI(K[i], x0); }
#pragma unroll
      for (int i = 0; i < 16; ++i) { CEI(K[i], x1); }
    }
#undef CKEY
    unsigned P[16]; float sc[16];
#pragma unroll
    for (int i = 0; i < 16; ++i) { const unsigned ci = (unsigned)K[i] & 255u; const unsigned i1 = slot[ci >> 4], i2 = slot[16 + (ci & 15u)]; P[i] = i1 * 128u + i2; sc[i] = __int_as_float(skey(K[i] & ~255)); }
    float ex[16], sum = 0.f;
#pragma unroll
    for (int i = 0; i < 16; ++i) { ex[i] = expf(sc[i] - sc[0]); sum += ex[i]; }
    const float inv = 1.0f / sum;
    if (hi == 0) {
        GAS v4u* eo = (GAS v4u*)(EIDo + (size_t)t * 128 + hd * 16); GAS f32x4* go = (GAS f32x4*)(GWo + (size_t)t * 128 + hd * 16);
#pragma unroll
        for (int j = 0; j < 4; ++j) { eo[j] = (v4u){P[4 * j], P[4 * j + 1], P[4 * j + 2], P[4 * j + 3]}; go[j] = (f32x4){ex[4 * j] * inv, ex[4 * j + 1] * inv, ex[4 * j + 2] * inv, ex[4 * j + 3] * inv}; }
    }
}

__device__ __forceinline__ float wave_max(float v) {
#pragma unroll
    for (int o = 1; o < 64; o <<= 1) v = fmaxf(v, __shfl_xor(v, o));
    return v;
}
__device__ __forceinline__ void route_unit_ref(const Args& a, int t, int hd, int lane, LAS float* sc) {
    LAS unsigned* sci = (LAS unsigned*)sc;
    const bf16* q = (const bf16*)(a.ws + WS_Q2) + (size_t)t * NQ + hd * 256;
#pragma unroll 1
    for (int half = 0; half < 2; ++half) {
        const float* sk = a.in[18 + half];
        float sa = 0.f, sb = 0.f;
        for (int d = 0; d < 128; ++d) { const float qv = bf2f(q[half * 128 + d]); sa += qv * sk[lane * 128 + d]; sb += qv * sk[(lane + 64) * 128 + d]; }
        for (int r = 0; r < 16; ++r) {
            const float mx = wave_max(fmaxf(sa, sb));
            const unsigned long long ba = __ballot(sa == mx), bb = __ballot(sb == mx);
            int key;
            if (ba) { const int ln = __ffsll((long long)ba) - 1; key = ln; if (lane == ln) sa = -INFINITY; }
            else { const int ln = __ffsll((long long)bb) - 1; key = ln + 64; if (lane == ln) sb = -INFINITY; }
            if (lane == 0) { sc[half * 32 + r] = mx; sci[half * 32 + 16 + r] = (unsigned)key; }
        }
    }
    __builtin_amdgcn_s_waitcnt(0);
    const int ca = lane >> 2, cb0 = (lane & 3) * 4;
    float c[4];
#pragma unroll
    for (int j = 0; j < 4; ++j) c[j] = sc[ca] + sc[32 + cb0 + j];
    for (int r = 0; r < 16; ++r) {
        const float mx = wave_max(fmaxf(fmaxf(c[0], c[1]), fmaxf(c[2], c[3])));
        const bool mine = (c[0] == mx) || (c[1] == mx) || (c[2] == mx) || (c[3] == mx);
        const unsigned long long bm = __ballot(mine); const int ln = __ffsll((long long)bm) - 1;
        if (lane == ln) { int j = (c[0] == mx) ? 0 : (c[1] == mx) ? 1 : (c[2] == mx) ? 2 : 3;
            if (j == 0) c[0] = -INFINITY; else if (j == 1) c[1] = -INFINITY; else if (j == 2) c[2] = -INFINITY; else c[3] = -INFINITY;
            sc[64 + r] = mx; sci[80 + r] = sci[16 + ca] * 128u + sci[48 + cb0 + j]; }
    }
    __builtin_amdgcn_s_waitcnt(0);
    if (lane < 16) {
        const float mx0 = sc[64]; const float ex = expf(sc[64 + lane] - mx0); float sum = ex;
        sum += __shfl_xor(sum, 1); sum += __shfl_xor(sum, 2); sum += __shfl_xor(sum, 4); sum += __shfl_xor(sum, 8);
        ((int*)(a.ws + WS_EID))[(size_t)t * 128 + hd * 16 + lane] = (int)sci[80 + lane];
        ((float*)(a.ws + WS_GW))[(size_t)t * 128 + hd * 16 + lane] = ex / sum;
    }
    __builtin_amdgcn_s_waitcnt(0);
}

__device__ __forceinline__ void unpack8(const v4u w, float* f) { f[0] = bflo(w.x); f[1] = bfhi(w.x); f[2] = bflo(w.y); f[3] = bfhi(w.y); f[4] = bflo(w.z); f[5] = bfhi(w.z); f[6] = bflo(w.w); f[7] = bfhi(w.w); }
__device__ __forceinline__ void gather_token(const Args& a, int t, int lane, float* dst) {
    const bf16* HB = (const bf16*)(a.ws + WS_HB) + (size_t)t * D; const bf16* ED = (const bf16*)(a.ws + WS_ED); const bf16* EU = (const bf16*)(a.ws + WS_EU);
    float hx[16];
    unpack8(*(const GAS v4u*)(HB + lane * 8), hx); unpack8(*(const GAS v4u*)(HB + 512 + lane * 8), hx + 8);
    const float rs2 = 1.0f / sqrtf(((const float*)(a.ws + WS_ROWSS2))[t] * (1.0f / 1024.0f) + EPSN);
    const int* EID = (const int*)(a.ws + WS_EID) + (size_t)t * 128; const float* GW = (const float*)(a.ws + WS_GW) + (size_t)t * 128;
    const int e0 = EID[lane], e1 = EID[64 + lane]; const float g0 = GW[lane], g1 = GW[64 + lane];
    float acc[16];
#pragma unroll
    for (int i = 0; i < 16; ++i) acc[i] = 0.f;
#pragma unroll 1
    for (int j = 0; j < 128; j += 4) {
        int ee[4]; float gg[4], dt[4];
#pragma unroll
        for (int k = 0; k < 4; ++k) { const int jj = j + k; ee[k] = __shfl(jj < 64 ? e0 : e1, jj & 63); gg[k] = __shfl(jj < 64 ? g0 : g1, jj & 63); }
        v4u da[4], db[4];
#pragma unroll
        for (int k = 0; k < 4; ++k) { const bf16* r = ED + (size_t)ee[k] * D; da[k] = *(const GAS v4u*)(r + lane * 8); db[k] = *(const GAS v4u*)(r + 512 + lane * 8); }
#pragma unroll
        for (int k = 0; k < 4; ++k) { float f[16]; unpack8(da[k], f); unpack8(db[k], f + 8); float s = 0.f;
#pragma unroll
            for (int i = 0; i < 16; ++i) s += f[i] * hx[i];
            dt[k] = s; }
#pragma unroll
        for (int o = 1; o < 64; o <<= 1) {
#pragma unroll
            for (int k = 0; k < 4; ++k) dt[k] += __shfl_xor(dt[k], o); }
#pragma unroll
        for (int k = 0; k < 4; ++k) { const bf16* r = EU + (size_t)ee[k] * D; da[k] = *(const GAS v4u*)(r + lane * 8); db[k] = *(const GAS v4u*)(r + 512 + lane * 8); }
#pragma unroll
        for (int k = 0; k < 4; ++k) { const float w = gg[k] * gelu_tanh(dt[k] * rs2); float f[16]; unpack8(da[k], f); unpack8(db[k], f + 8);
#pragma unroll
            for (int i = 0; i < 16; ++i) acc[i] += w * f[i]; }
    }
    const float* orow = a.out + (size_t)t * D; float* drow = dst + (size_t)t * D; const float* gf = a.in[22];
    f32x4 h0 = *(const GAS f32x4*)(orow + lane * 8), h1 = *(const GAS f32x4*)(orow + lane * 8 + 4), h2 = *(const GAS f32x4*)(orow + 512 + lane * 8), h3 = *(const GAS f32x4*)(orow + 512 + lane * 8 + 4);
    h0 += (f32x4){acc[0], acc[1], acc[2], acc[3]}; h1 += (f32x4){acc[4], acc[5], acc[6], acc[7]}; h2 += (f32x4){acc[8], acc[9], acc[10], acc[11]}; h3 += (f32x4){acc[12], acc[13], acc[14], acc[15]};
    float ss = (h0.x * h0.x + h0.y * h0.y) + (h0.z * h0.z + h0.w * h0.w) + (h1.x * h1.x + h1.y * h1.y) + (h1.z * h1.z + h1.w * h1.w)
             + (h2.x * h2.x + h2.y * h2.y) + (h2.z * h2.z + h2.w * h2.w) + (h3.x * h3.x + h3.y * h3.y) + (h3.z * h3.z + h3.w * h3.w);
    ss = wave_sum(ss);
    const float ri = 1.0f / sqrtf(ss * (1.0f / 1024.0f) + EPSN);
    const f32x4 f0 = *(const GAS f32x4*)(gf + lane * 8), f1 = *(const GAS f32x4*)(gf + lane * 8 + 4), f2 = *(const GAS f32x4*)(gf + 512 + lane * 8), f3 = *(const GAS f32x4*)(gf + 512 + lane * 8 + 4);
    *(GAS f32x4*)(drow + lane * 8) = h0 * ri * f0; *(GAS f32x4*)(drow + lane * 8 + 4) = h1 * ri * f1;
    *(GAS f32x4*)(drow + 512 + lane * 8) = h2 * ri * f2; *(GAS f32x4*)(drow + 512 + lane * 8 + 4) = h3 * ri * f3;
}


template <int CTRL> __device__ __forceinline__ float dpp_add(float v) { return v + __int_as_float(__builtin_amdgcn_update_dpp(0, __float_as_int(v), CTRL, 0xf, 0xf, false)); }
__device__ __forceinline__ float row16_sum(float v) { v = dpp_add<0x140>(v); v = dpp_add<0x141>(v); v = dpp_add<0x4E>(v); v = dpp_add<0xB1>(v); return v; }
__device__ __forceinline__ unsigned long long lanemask_lt(int lane) { return (1ull << lane) - 1ull; }
__device__ __forceinline__ void glds16g(const void* gsrc, unsigned lds_dst) { unsigned keep;
    asm volatile("s_mov_b32 %0, m0\n\ts_mov_b32 m0, %2\n\ts_nop 0\n\tglobal_load_lds_dwordx4 %1, off\n\ts_mov_b32 m0, %0" : "=&s"(keep) : "v"(gsrc), "s"(lds_dst) : "memory"); }

__device__ __forceinline__ void glds16x4(const void* sbase, unsigned o0, unsigned o1, unsigned o2, unsigned o3, unsigned d0, unsigned d1, unsigned d2, unsigned d3) { unsigned keep;
    asm volatile("s_mov_b32 %0, m0\n\ts_mov_b32 m0, %6\n\ts_nop 0\n\tglobal_load_lds_dwordx4 %1, %5\n\ts_mov_b32 m0, %7\n\ts_nop 0\n\tglobal_load_lds_dwordx4 %2, %5\n\t"
                 "s_mov_b32 m0, %8\n\ts_nop 0\n\tglobal_load_lds_dwordx4 %3, %5\n\ts_mov_b32 m0, %9\n\ts_nop 0\n\tglobal_load_lds_dwordx4 %4, %5\n\ts_mov_b32 m0, %0"
                 : "=&s"(keep) : "v"(o0), "v"(o1), "v"(o2), "v"(o3), "s"(sbase), "s"(d0), "s"(d1), "s"(d2), "s"(d3) : "memory"); }
typedef __bf16 bf2_t __attribute__((ext_vector_type(2)));
__device__ __forceinline__ float dot2bf(unsigned a, unsigned b, float c) { return __builtin_amdgcn_fdot2_f32_bf16(__builtin_bit_cast(bf2_t, a), __builtin_bit_cast(bf2_t, b), c, false); }
__device__ __forceinline__ void compact_token(const Args& a, int t, int lane) {
    const int* EID = (const int*)(a.ws + WS_EID) + (size_t)t * 128; const float* GW = (const float*)(a.ws + WS_GW) + (size_t)t * 128;
    const int e0 = EID[lane], e1 = EID[64 + lane]; const float g0 = GW[lane], g1 = GW[64 + lane];
    const bool p0 = e0 < 8192, p1 = e1 < 8192;
    const unsigned long long m0 = __ballot(p0), m1 = __ballot(p1), lt = lanemask_lt(lane);
    const int c0 = __popcll(m0), n0 = c0 + __popcll(m1);
    const int pos0 = p0 ? __popcll(m0 & lt) : n0 + __popcll(~m0 & lt);
    const int pos1 = p1 ? c0 + __popcll(m1 & lt) : n0 + (64 - c0) + __popcll(~m1 & lt);
    unsigned* R = (unsigned*)(a.ws + WS_REC) + (size_t)t * 128;
    R[pos0] = (unsigned)e0 | (f2bf(g0) << 16); R[pos1] = (unsigned)e1 | (f2bf(g1) << 16);
    if (lane == 0) ((int*)(a.ws + WS_N0))[t] = n0;
}
template <int NT> __device__ __forceinline__ void w_tokens(const Args& a, int t0, int lane) {
    float d0[NT], d1[NT], sd0[NT], sd1[NT], su0[NT], su1[NT]; unsigned r0[NT], r1[NT]; float ss[NT];
#pragma unroll
    for (int i = 0; i < NT; ++i) { const float* DP = (const float*)(a.ws + WS_DOTP) + (size_t)(t0 + i) * 1024; const unsigned* R = (const unsigned*)(a.ws + WS_REC) + (size_t)(t0 + i) * 128;
        float p0[8], p1[8];
#pragma unroll
        for (int x = 0; x < 8; ++x) { p0[x] = DP[x * 128 + lane]; p1[x] = DP[x * 128 + 64 + lane]; }
        r0[i] = R[lane]; r1[i] = R[64 + lane]; ss[i] = ((const float*)(a.ws + WS_ROWSS2))[t0 + i];
        sd0[i] = ((const float*)(a.ws + WS_SCD))[r0[i] & 0x3fffu]; sd1[i] = ((const float*)(a.ws + WS_SCD))[r1[i] & 0x3fffu];
        su0[i] = ((const float*)(a.ws + WS_SCU))[r0[i] & 0x3fffu]; su1[i] = ((const float*)(a.ws + WS_SCU))[r1[i] & 0x3fffu];
        d0[i] = ((p0[0] + p0[1]) + (p0[2] + p0[3])) + ((p0[4] + p0[5]) + (p0[6] + p0[7])); d1[i] = ((p1[0] + p1[1]) + (p1[2] + p1[3])) + ((p1[4] + p1[5]) + (p1[6] + p1[7])); }
#pragma unroll
    for (int i = 0; i < NT; ++i) { const float rs2 = 1.0f / sqrtf(ss[i] * (1.0f / 1024.0f) + EPSN);
        const float w0 = bfhi(r0[i]) * fgelu_tanh(d0[i] * sd0[i] * rs2) * su0[i], w1 = bfhi(r1[i]) * fgelu_tanh(d1[i] * sd1[i] * rs2) * su1[i];
        float m0 = fabsf(w0), m1 = fabsf(w1);
#pragma unroll
        for (int o = 1; o < 64; o <<= 1) { m0 = fmaxf(m0, __shfl_xor(m0, o)); m1 = fmaxf(m1, __shfl_xor(m1, o)); }
        const float s0 = (m0 > 0.f) ? m0 * (1.0f / 127.0f) : 1.0f, s1 = (m1 > 0.f) ? m1 * (1.0f / 127.0f) : 1.0f;
        unsigned char* WQ = a.ws + WS_WQ8 + (size_t)(t0 + i) * 144;
        WQ[lane] = (unsigned char)((int)__builtin_rintf(w0 / s0) & 255); WQ[64 + lane] = (unsigned char)((int)__builtin_rintf(w1 / s1) & 255);
        if (lane == 0) { ((float*)(WQ + 128))[0] = s0; ((float*)(WQ + 128))[1] = s1; } }
}
template <bool IS_UP> __device__ __forceinline__ void sweep_slice(const Args& a, int x, int wv, int lane, unsigned ring, LAS unsigned char* ringp, unsigned aux, LAS unsigned char* auxp) {
    const int g = lane >> 4, li = lane & 15, n16 = li, kg = g;
    const char* TABx = (const char*)(a.ws + (IS_UP ? WS_EU : WS_ED)) + x * 256;
    unsigned jofs[4];
#pragma unroll
    for (int q = 0; q < 4; ++q) jofs[q] = (unsigned)((li ^ ((g << 2) | q)) * 16);
    const unsigned pd = (unsigned)__builtin_amdgcn_readfirstlane(ring);
#pragma unroll 1
    for (int s_ = 0; s_ < 128; ++s_) {
        const int r = s_ >> 6, k = s_ & 63, t = wv * 64 + k, base = 64 * r;
        const LAS unsigned* rec = (const LAS unsigned*)(auxp + (k & 3) * 512) + base;
        const LAS unsigned char* hp = auxp + 2048 + (k & 3) * 256;
        asm volatile("s_waitcnt lgkmcnt(0)" ::: "memory");
        if ((k & 3) == 0) {
            const char* rsrc = (const char*)(a.ws + WS_REC) + (size_t)t * 512 + lane * 16;
            glds16g(rsrc, (unsigned)__builtin_amdgcn_readfirstlane(aux)); glds16g(rsrc + 1024, (unsigned)__builtin_amdgcn_readfirstlane(aux + 1024));
            if (!IS_UP) glds16g((const char*)(a.ws + WS_HB) + (size_t)(t + g) * 2048 + x * 256 + li * 16, (unsigned)__builtin_amdgcn_readfirstlane(aux + 2048));
            asm volatile("s_waitcnt vmcnt(0)" ::: "memory");
        }
        {
            unsigned so[16];
#pragma unroll
            for (int p = 0; p < 16; ++p) so[p] = rec[4 * p + g];
#pragma unroll
            for (int p = 0; p < 16; ++p) so[p] = ((so[p] & 0x3fffu) << 11) + jofs[p & 3];
            glds16x4(TABx, so[0], so[1], so[2], so[3], pd, pd + 1024u, pd + 2048u, pd + 3072u);
            glds16x4(TABx, so[4], so[5], so[6], so[7], pd + 4096u, pd + 5120u, pd + 6144u, pd + 7168u);
            glds16x4(TABx, so[8], so[9], so[10], so[11], pd + 8192u, pd + 9216u, pd + 10240u, pd + 11264u);
            glds16x4(TABx, so[12], so[13], so[14], so[15], pd + 12288u, pd + 13312u, pd + 14336u, pd + 15360u);
        }
        asm volatile("s_waitcnt vmcnt(0)" ::: "memory");
        if (!IS_UP) {
            bf16x8 hb[4];
#pragma unroll
            for (int q = 0; q < 4; ++q) hb[q] = *(const LAS bf16x8*)(hp + (32 * q + 8 * kg) * 2);
            f32x4 res = (f32x4){0.f, 0.f, 0.f, 0.f};
#pragma unroll
            for (int rb = 0; rb < 4; ++rb) {
                f32x4 d = (f32x4){0.f, 0.f, 0.f, 0.f}; const int row = n16 + 16 * rb; const int key = ((row & 3) << 2) | ((row >> 2) & 3);
#pragma unroll
                for (int q = 0; q < 4; ++q) { const bf16x8 af = *(const LAS bf16x8*)(ringp + 256 * row + 16 * ((4 * q + kg) ^ key)); d = __builtin_amdgcn_mfma_f32_16x16x32_bf16(af, hb[q], d, 0, 0, 0); }
                res = (n16 == rb) ? d : res; }
            if (n16 < 4) *(GAS f32x4*)((float*)(a.ws + WS_DOTP) + ((size_t)t * 8 + x) * 128 + base + 16 * n16 + 4 * kg) = res;
        } else {
            f32x4 pacc[8];
#pragma unroll
            for (int i = 0; i < 8; ++i) pacc[i] = (f32x4){0.f, 0.f, 0.f, 0.f};
            const int q4 = n16 >> 2, p4 = lane & 3;
#pragma unroll
            for (int ks = 0; ks < 2; ++ks) {
                const v4u wa = *(const LAS v4u*)(rec + 32 * ks + 8 * kg), wb = *(const LAS v4u*)(rec + 32 * ks + 8 * kg + 4);
                const bf16x8 af = __builtin_bit_cast(bf16x8, (v4u){(wa.x >> 16) | (wa.y & 0xffff0000u), (wa.z >> 16) | (wa.w & 0xffff0000u), (wb.x >> 16) | (wb.y & 0xffff0000u), (wb.z >> 16) | (wb.w & 0xffff0000u)});
#pragma unroll
                for (int c = 0; c < 8; ++c) {
                    const int row0 = 32 * ks + 8 * kg + q4, row1 = row0 + 4; const int ch = 2 * c + (p4 >> 1);
                    const int k0 = ((row0 & 3) << 2) | ((row0 >> 2) & 3), k1 = ((row1 & 3) << 2) | ((row1 >> 2) & 3);
                    const attn_body::s16x4 lo4 = attn_body::vtr((attn_body::lds_cptr)(ringp + 256 * row0 + 16 * (ch ^ k0) + 8 * (p4 & 1)));
                    const attn_body::s16x4 hi4 = attn_body::vtr((attn_body::lds_cptr)(ringp + 256 * row1 + 16 * (ch ^ k1) + 8 * (p4 & 1)));
                    const bf16x8 bfr = (bf16x8){lo4[0], lo4[1], lo4[2], lo4[3], hi4[0], hi4[1], hi4[2], hi4[3]};
                    pacc[c] = __builtin_amdgcn_mfma_f32_16x16x32_bf16(af, bfr, pacc[c], 0, 0, 0); }
            }
            const float v0 = (kg == 0) ? pacc[0][0] : (kg == 1) ? pacc[1][0] : (kg == 2) ? pacc[2][0] : pacc[3][0];
            const float v1 = (kg == 0) ? pacc[4][0] : (kg == 1) ? pacc[5][0] : (kg == 2) ? pacc[6][0] : pacc[7][0];
            bf16* po = (bf16*)(a.ws + WS_PEER) + ((size_t)r * M + t) * D + x * 128;
            po[lane] = (bf16)f2bf(v0); po[64 + lane] = (bf16)f2bf(v1);
        }
    }
}
typedef int i32x4 __attribute__((ext_vector_type(4)));
__device__ __forceinline__ void sweep_down_q8(const Args& a, int x, int wv, int lane, unsigned ring, LAS unsigned char* ringp, unsigned aux, LAS unsigned char* auxp) {
    const int g = lane >> 4, li = lane & 15, n16 = li, kg = g, g8 = lane >> 3, s8 = lane & 7;
    const char* TABx = (const char*)(a.ws + WS_ED) + x * 128;
    unsigned jofs[2];
#pragma unroll
    for (int b = 0; b < 2; ++b) jofs[b] = (unsigned)((s8 ^ (4 * b + (g8 >> 1))) * 16);
    const unsigned pd = (unsigned)__builtin_amdgcn_readfirstlane(ring);
    LAS unsigned char* hq = auxp + 3072; LAS float* hsc = (LAS float*)(auxp + 3072 + 512);
#pragma unroll 1
    for (int s_ = 0; s_ < 128; ++s_) {
        const int r = s_ >> 6, k = s_ & 63, t = wv * 64 + k, base = 64 * r;
        const LAS unsigned* rec = (const LAS unsigned*)(auxp + (k & 3) * 512) + base;
        asm volatile("s_waitcnt lgkmcnt(0)" ::: "memory");
        if ((k & 3) == 0) {
            const char* rsrc = (const char*)(a.ws + WS_REC) + (size_t)t * 512 + lane * 16;
            glds16g(rsrc, (unsigned)__builtin_amdgcn_readfirstlane(aux)); glds16g(rsrc + 1024, (unsigned)__builtin_amdgcn_readfirstlane(aux + 1024));
            glds16g((const char*)(a.ws + WS_HB) + (size_t)(t + g) * 2048 + x * 256 + li * 16, (unsigned)__builtin_amdgcn_readfirstlane(aux + 2048));
            asm volatile("s_waitcnt vmcnt(0)" ::: "memory");
            {
                const v4u hb = *(const LAS v4u*)(auxp + 2048 + lane * 16); float f[8]; unpack8(hb, f);
                float am = fmaxf(fmaxf(fmaxf(fabsf(f[0]), fabsf(f[1])), fmaxf(fabsf(f[2]), fabsf(f[3]))), fmaxf(fmaxf(fabsf(f[4]), fabsf(f[5])), fmaxf(fabsf(f[6]), fabsf(f[7]))));
                am = fmaxf(am, __int_as_float(__builtin_amdgcn_update_dpp(0, __float_as_int(am), 0x140, 0xf, 0xf, false))); am = fmaxf(am, __int_as_float(__builtin_amdgcn_update_dpp(0, __float_as_int(am), 0x141, 0xf, 0xf, false)));
                am = fmaxf(am, __int_as_float(__builtin_amdgcn_update_dpp(0, __float_as_int(am), 0x4E, 0xf, 0xf, false))); am = fmaxf(am, __int_as_float(__builtin_amdgcn_update_dpp(0, __float_as_int(am), 0xB1, 0xf, 0xf, false)));
                const float sc = (am > 0.f) ? am * (1.0f / 127.0f) : 1.0f, inv = 1.0f / sc;
                unsigned qw[2];
#pragma unroll
                for (int h2 = 0; h2 < 2; ++h2) { const int q0 = (int)__builtin_rintf(f[4 * h2] * inv), q1 = (int)__builtin_rintf(f[4 * h2 + 1] * inv), q2 = (int)__builtin_rintf(f[4 * h2 + 2] * inv), q3 = (int)__builtin_rintf(f[4 * h2 + 3] * inv);
                    qw[h2] = ((unsigned)q0 & 255u) | (((unsigned)q1 & 255u) << 8) | (((unsigned)q2 & 255u) << 16) | ((unsigned)q3 << 24); }
                *(LAS unsigned long long*)(hq + lane * 8) = (unsigned long long)qw[0] | ((unsigned long long)qw[1] << 32);
                if (li == 0) hsc[g] = sc; }
        }
        {   unsigned so[8];
#pragma unroll
            for (int i = 0; i < 8; ++i) so[i] = rec[8 * i + g8];
#pragma unroll
            for (int i = 0; i < 8; ++i) so[i] = ((so[i] & 0x3fffu) << 10) + jofs[i & 1];
            glds16x4(TABx, so[0], so[1], so[2], so[3], pd, pd + 1024u, pd + 2048u, pd + 3072u);
            glds16x4(TABx, so[4], so[5], so[6], so[7], pd + 4096u, pd + 5120u, pd + 6144u, pd + 7168u);
        }
        asm volatile("s_waitcnt vmcnt(0)" ::: "memory");
        const i32x4 hb0 = *(const LAS i32x4*)(hq + (k & 3) * 128 + 16 * kg), hb1 = *(const LAS i32x4*)(hq + (k & 3) * 128 + 64 + 16 * kg);
        const float hs = hsc[k & 3];
        i32x4 res = (i32x4){0, 0, 0, 0};
#pragma unroll
        for (int rb = 0; rb < 4; ++rb) {
            const int row = n16 + 16 * rb; const int key = (row >> 1) & 7;
            const i32x4 a0 = *(const LAS i32x4*)(ringp + row * 128 + ((kg ^ key) * 16)), a1 = *(const LAS i32x4*)(ringp + row * 128 + (((4 + kg) ^ key) * 16));
            i32x4 d = __builtin_amdgcn_mfma_i32_16x16x64_i8(a0, hb0, (i32x4){0, 0, 0, 0}, 0, 0, 0); d = __builtin_amdgcn_mfma_i32_16x16x64_i8(a1, hb1, d, 0, 0, 0);
            res = (n16 == rb) ? d : res; }
        if (n16 < 4) *(GAS f32x4*)((float*)(a.ws + WS_DOTP) + ((size_t)t * 8 + x) * 128 + base + 16 * n16 + 4 * kg) = (f32x4){(float)res[0] * hs, (float)res[1] * hs, (float)res[2] * hs, (float)res[3] * hs};
    }
}

__device__ __forceinline__ void sweep_up_q8(const Args& a, int x, int wv, int lane, unsigned ring, LAS unsigned char* ringp, unsigned aux, LAS unsigned char* auxp) {
    const int n16 = lane & 15, kg = lane >> 4, g8 = lane >> 3, s8 = lane & 7;
    const char* TABx = (const char*)(a.ws + WS_EU) + x * 128;
    unsigned jofs[2];
#pragma unroll
    for (int b = 0; b < 2; ++b) jofs[b] = (unsigned)((s8 ^ ((g8 >> 1) | (b << 2))) * 16);
    const unsigned pd = (unsigned)__builtin_amdgcn_readfirstlane(ring);
    typedef int v2i_t __attribute__((ext_vector_type(2)));
#pragma unroll 1
    for (int s_ = 0; s_ < 128; ++s_) {
        const int r = s_ >> 6, k = s_ & 63, t = wv * 64 + k, base = 64 * r;
        const LAS unsigned* rec = (const LAS unsigned*)(auxp + (k & 3) * 512) + base;
        const LAS unsigned char* wq = auxp + 2048 + (k & 3) * 144;
        asm volatile("s_waitcnt lgkmcnt(0)" ::: "memory");
        if ((k & 3) == 0) {
            const char* rsrc = (const char*)(a.ws + WS_REC) + (size_t)t * 512 + lane * 16;
            glds16g(rsrc, (unsigned)__builtin_amdgcn_readfirstlane(aux)); glds16g(rsrc + 1024, (unsigned)__builtin_amdgcn_readfirstlane(aux + 1024));
            if (lane < 36) glds16g((const char*)(a.ws + WS_WQ8) + (size_t)t * 144 + lane * 16, (unsigned)__builtin_amdgcn_readfirstlane(aux + 2048));
            asm volatile("s_waitcnt vmcnt(0)" ::: "memory");
        }
        {   unsigned so[8];
#pragma unroll
            for (int i = 0; i < 8; ++i) so[i] = rec[8 * i + g8];
#pragma unroll
            for (int i = 0; i < 8; ++i) so[i] = ((so[i] & 0x3fffu) << 10) + jofs[(i >> 1) & 1];
            glds16x4(TABx, so[0], so[1], so[2], so[3], pd, pd + 1024u, pd + 2048u, pd + 3072u);
            glds16x4(TABx, so[4], so[5], so[6], so[7], pd + 4096u, pd + 5120u, pd + 6144u, pd + 7168u);
        }
        asm volatile("s_waitcnt vmcnt(0)" ::: "memory");
        const i32x4 aw = *(const LAS i32x4*)(wq + 64 * r + 16 * kg);
        const float wsc = *(const LAS float*)(wq + 128 + 4 * r);
        const int i2 = n16 >> 1, ih = n16 & 1;
        const int row0 = 16 * kg + i2, row1 = row0 + 8;
        const int k0 = ((row0 >> 1) & 3) | (((row0 >> 4) & 1) << 2), k1 = ((row1 >> 1) & 3) | (((row1 >> 4) & 1) << 2);
        const LAS unsigned char* p0 = ringp + row0 * 128 + 8 * ih; const LAS unsigned char* p1 = ringp + row1 * 128 + 8 * ih;
        float outv[8];
#pragma unroll
        for (int c = 0; c < 8; ++c) {
            const v2i_t lo = __builtin_amdgcn_ds_read_tr8_b64_v2i32((LAS v2i_t*)(p0 + ((c ^ k0) * 16)));
            const v2i_t hi = __builtin_amdgcn_ds_read_tr8_b64_v2i32((LAS v2i_t*)(p1 + ((c ^ k1) * 16)));
            const i32x4 d = __builtin_amdgcn_mfma_i32_16x16x64_i8(aw, (i32x4){lo.x, lo.y, hi.x, hi.y}, (i32x4){0, 0, 0, 0}, 0, 0, 0);
            outv[c] = (float)d[0] * wsc; }
        const float v0 = (kg == 0) ? outv[0] : (kg == 1) ? outv[1] : (kg == 2) ? outv[2] : outv[3];
        const float v1 = (kg == 0) ? outv[4] : (kg == 1) ? outv[5] : (kg == 2) ? outv[6] : outv[7];
        bf16* po = (bf16*)(a.ws + WS_PEER) + ((size_t)r * M + t) * D + x * 128;
        po[lane] = (bf16)f2bf(v0); po[64 + lane] = (bf16)f2bf(v1);
    }
}

__device__ __forceinline__ void final_row(const Args& a, int t, int lane) {
    float* orow = a.out + (size_t)t * D; const float* gf = a.in[22];
    const bf16* P0 = (const bf16*)(a.ws + WS_PEER) + (size_t)t * D; const bf16* P1 = P0 + (size_t)M * D;
    const bf16* HBr = (const bf16*)(a.ws + WS_HB) + (size_t)t * D;
    f32x4 h[4]; float ss = 0.f;
#pragma unroll
    for (int j = 0; j < 4; ++j) { { const unsigned long long hb = ((const GAS unsigned long long*)HBr)[lane + 64 * j]; h[j].x = bflo((unsigned)hb); h[j].y = bfhi((unsigned)hb); h[j].z = bflo((unsigned)(hb >> 32)); h[j].w = bfhi((unsigned)(hb >> 32)); }
        const unsigned long long p = ((const GAS unsigned long long*)P0)[lane + 64 * j], q = ((const GAS unsigned long long*)P1)[lane + 64 * j];
        h[j].x += bflo((unsigned)p) + bflo((unsigned)q); h[j].y += bfhi((unsigned)p) + bfhi((unsigned)q); h[j].z += bflo((unsigned)(p >> 32)) + bflo((unsigned)(q >> 32)); h[j].w += bfhi((unsigned)(p >> 32)) + bfhi((unsigned)(q >> 32));
        ss += (h[j].x * h[j].x + h[j].y * h[j].y) + (h[j].z * h[j].z + h[j].w * h[j].w); }
    ss = wave_sum(ss);
    const float ri = 1.0f / sqrtf(ss * (1.0f / 1024.0f) + EPSN);
#pragma unroll
    for (int j = 0; j < 4; ++j) ((GAS f32x4*)orow)[lane + 64 * j] = h[j] * ri * ((const GAS f32x4*)gf)[lane + 64 * j];
}

__device__ __forceinline__ float a_dot64(const float* p, const float* q, int lane) { return wave_sum(p[lane] * q[lane]); }
constexpr int N_PHASES = 12;
#ifndef ROUTE_REF
#define ROUTE_REF 0
#endif
#ifndef MK_ONE_LAUNCH
#define MK_ONE_LAUNCH 1
#endif
__global__ void __launch_bounds__(NWAVES * 64, 2) fwd_mega(Args args) {
    extern __shared__ __attribute__((aligned(16))) unsigned char lds[];
    Frame F;
    F.lds = (LAS unsigned char*)lds;
    F.MISC = (volatile LAS unsigned*)(F.lds + MISC_OFF);
    F.tid = threadIdx.x; F.lane = F.tid & 63; F.wave = __builtin_amdgcn_readfirstlane(F.tid >> 6);
    F.G = gridDim.x; { const int bx = blockIdx.x; F.vcu = (F.G % 8 == 0) ? (bx % 8) * (F.G / 8) + bx / 8 : bx; }
    unsigned char* ws = args.ws;
    const int lo = args.ph_lo, hi = args.ph_hi;
#ifndef PH_MASK
#define PH_MASK 0xffff
#endif
#define IN(k) (((PH_MASK >> (k)) & 1) && lo <= (k) && (k) < hi)
#define BOTH(k) (IN(k) && IN((k) + 1))
#if MK_ONE_LAUNCH
    for (int u = F.tid; u < (LDS_BYTES - LDSCTL_OFF) / 4; u += NWAVES * 64) ((LAS unsigned*)(F.lds + LDSCTL_OFF))[u] = 0u;
    __syncthreads();
    const XcdBarrier xbar = xcd_barrier_post((unsigned*)(ws + WS_CTL) + CW_BAR, F.MISC + 8);
    bool first_seam = args.ph_lo < 0;
#define GRID_BAR() do { if (first_seam) { __threadfence(); cooperative_groups::this_grid().sync(); first_seam = false; } else xcd_barrier(xbar); } while (0)
#else
#define GRID_BAR() do { } while (0)
#endif
#ifndef REP_PH
#define REP_PH -1
#endif
#define RUN_PHASE(k, ...) do { if (IN(k)) { if ((k) == REP_PH) { { const bool first_of_two = true; (void)first_of_two; __VA_ARGS__ } GRID_BAR(); } { const bool first_of_two = false; (void)first_of_two; __VA_ARGS__ } if (BOTH(k)) GRID_BAR(); } } while (0)
    RUN_PHASE(0, { p0_prologue(F, args); });
    RUN_PHASE(1, {
        pg8::Gemm g{(const pg8::bf16_t*)(ws + WS_XB), (const pg8::bf16_t*)(ws + WS_WIN), M, INC, D}; pg8::StaticOrder S; S.init(M, INC, F.G, (int)blockIdx.x);
        pg8::EpiBf16<1> E{(pg8::bf16_t*)(ws + WS_Q), 512, (const float*)(ws + WS_RS1), 512, (size_t)WS_SPLIT / 2, attn_body::C2};
        pg8::gemm_phase<pg8::EpiBf16<1>, pg8::StaticOrder, true, true>(F.lds + RING_OFF, g, S, E);
        { const int nb = (F.G >= 2) ? (int)F.G / 2 : 1; const int bi = (int)blockIdx.x - ((int)F.G - nb); if (bi >= 0) convert_experts(args, bi * NWAVES + F.wave, nb * NWAVES, F.lane); }
    });
    RUN_PHASE(2, {
        for (int c = F.vcu; c < M / 64; c += F.G) lru_local_unit(F, args, c);
        const attn128::AttnTensors AT{(const attn128::bf16*)(ws + WS_Q), (const attn128::bf16*)(ws + WS_Q + WS_SPLIT), (const attn128::bf16*)(ws + WS_Q + 2 * WS_SPLIT), (attn128::bf16*)(ws + WS_OS)};
        const attn128::StaticOrder S(F.vcu);
        attn128::attn_phase<attn128::StaticOrder>((char*)lds + RING_OFF, AT, S);
    });
    RUN_PHASE(3, {
        float l1 = a_dot64(args.in[3], args.in[4], F.lane); float l2 = a_dot64(args.in[5], args.in[6], F.lane);
        const float lamv = expf(l1) - expf(l2) + 0.2f;
        for (int c = F.vcu; c < M / 64; c += F.G) fix_unit(F, args, c, lamv);
    });
    RUN_PHASE(4, {
        pg8::Gemm g{(const pg8::bf16_t*)(ws + WS_MIX), (const pg8::bf16_t*)(ws + WS_WOUT), M, D, D}; pg8::StaticOrder S; S.init(M, D, F.G, (int)blockIdx.x);
        pg8::EpiResid E{args.in[0], args.out, (pg8::bf16_t*)(ws + WS_HB), (float*)(ws + (first_of_two ? WS_RS1 : WS_ROWSS2)), D};
        pg8::gemm_phase<pg8::EpiResid, pg8::StaticOrder, true, true>(F.lds + RING_OFF, g, S, E);
    });
    RUN_PHASE(5, {
        pg8::Gemm g{(const pg8::bf16_t*)(ws + WS_HB), (const pg8::bf16_t*)(ws + WS_WQ), M, NQ, D}; pg8::StaticOrder S; S.init(M, NQ, F.G, (int)blockIdx.x);
        pg8::EpiBf16<2> E{(pg8::bf16_t*)(ws + WS_Q2), NQ, (const float*)(ws + WS_ROWSS2), 0, 0, 1.f};
        pg8::gemm_phase<pg8::EpiBf16<2>, pg8::StaticOrder, true, true>(F.lds + RING_OFF, g, S, E);
    });
    RUN_PHASE(6, {
        const int gw = F.vcu * NWAVES + F.wave; const int NGW = F.G * NWAVES;
        LAS unsigned char* skl = F.lds + RING_OFF + 16384;
        for (int c = F.tid; c < 4096; c += NWAVES * 64) { const int row = c >> 4; const int ch = c & 15; *(LAS v4u*)(skl + row * 272 + ch * 16) = *(const GAS v4u*)(ws + WS_SK1 + (size_t)row * 256 + ch * 16); }
        __syncthreads();
        for (int u = gw; u < (M / 32) * 8; u += NGW) route_unit(args, u >> 3, u & 7, F.lane, F.lds + RING_OFF + F.tid * 32, skl, (int*)(ws + WS_EID), (float*)(ws + WS_GW));
        __syncthreads();
    });
    RUN_PHASE(7, {
        const int gw = F.vcu * NWAVES + F.wave; const int NGW = F.G * NWAVES;
        for (int t = gw; t < M; t += NGW) compact_token(args, t, F.lane);
    });
    RUN_PHASE(8, {
        if (F.G == 256) sweep_down_q8(args, F.vcu >> 5, (F.vcu & 31) * NWAVES + F.wave, F.lane, (unsigned)(uintptr_t)(lds + RING_OFF) + F.wave * 16384u, F.lds + RING_OFF + F.wave * 16384, (unsigned)(uintptr_t)(lds + LDSCTL_OFF + 1024) + F.wave * 3712u, F.lds + LDSCTL_OFF + 1024 + F.wave * 3712);
    });
    RUN_PHASE(9, {
        const int gw = F.vcu * NWAVES + F.wave; const int NGW = F.G * NWAVES;
        for (int t = 4 * gw; t < M; t += 4 * NGW) w_tokens<4>(args, t, F.lane);
    });
    RUN_PHASE(10, {
        if (F.G == 256) sweep_up_q8(args, F.vcu >> 5, (F.vcu & 31) * NWAVES + F.wave, F.lane, (unsigned)(uintptr_t)(lds + RING_OFF) + F.wave * 16384u, F.lds + RING_OFF + F.wave * 16384, (unsigned)(uintptr_t)(lds + LDSCTL_OFF + 1024) + F.wave * 3712u, F.lds + LDSCTL_OFF + 1024 + F.wave * 3712);
    });
    RUN_PHASE(11, {
        const int gw = F.vcu * NWAVES + F.wave; const int NGW = F.G * NWAVES;
        for (int t = gw; t < M; t += NGW) final_row(args, t, F.lane);
    });
#undef IN
#undef BOTH
}

extern "C" void kernel_launch(void* const* d_in, const int* in_sizes, int n_in, void* d_out, int out_size, void* d_ws, size_t ws_size, hipStream_t stream) {
    static int grid = 0;
    if (grid == 0) {
        if (n_in != 23 || out_size != M * D || ws_size < WS_END) { fprintf(stderr, "kernel_launch: unexpected problem: n_in %d out %d ws %zu\n", n_in, out_size, ws_size); grid = -1; return; }
        int dev = 0, cus = 0, per_cu = 0;
        if (hipGetDevice(&dev) != hipSuccess || hipDeviceGetAttribute(&cus, hipDeviceAttributeMultiprocessorCount, dev) != hipSuccess) { grid = -1; return; }
        if (hipFuncSetAttribute((const void*)fwd_mega, hipFuncAttributeMaxDynamicSharedMemorySize, LDS_BYTES) != hipSuccess) { fprintf(stderr, "kernel_launch: hipFuncSetAttribute failed\n"); grid = -1; return; }
        if (hipOccupancyMaxActiveBlocksPerMultiprocessor(&per_cu, (const void*)fwd_mega, NWAVES * 64, LDS_BYTES) != hipSuccess || per_cu < 1) { fprintf(stderr, "kernel_launch: occupancy query reports %d\n", per_cu); per_cu = 1; }
        (void)hipGetLastError();
        grid = cus;
    }
    if (grid < 0) return;
    (void)hipMemsetAsync((char*)d_ws + WS_CTL, 0, CTL_ZERO_BYTES, stream);
    Args a{};
    for (int i = 0; i < 23; ++i) a.in[i] = (const float*)d_in[i];
    a.out = (float*)d_out; a.ws = (unsigned char*)d_ws;
#if MK_ONE_LAUNCH
    a.ph_lo = 0; a.ph_hi = N_PHASES;
    void* kargs[] = {&a};
    hipError_t e = hipLaunchCooperativeKernel((const void*)fwd_mega, dim3(grid), dim3(NWAVES * 64), kargs, LDS_BYTES, stream);
    if (e != hipSuccess) fprintf(stderr, "cooperative launch failed: %s (grid %d)\n", hipGetErrorString(e), grid);
#else
    for (int p = 0; p < N_PHASES; ++p) { a.ph_lo = p; a.ph_hi = p + 1; hipLaunchKernelGGL(fwd_mega, dim3(grid), dim3(NWAVES * 64), LDS_BYTES, stream, a); }
#endif
}
```

```cpp
#include <hip/hip_runtime.h>
#include <hip/hip_cooperative_groups.h>
#include <cstdio>
#include <cstdint>
namespace pg8 {
#define PG8_LAS __attribute__((address_space(3)))
typedef unsigned short bf16_t;
typedef short bf16x8 __attribute__((ext_vector_type(8)));
typedef float f32x4 __attribute__((ext_vector_type(4)));
typedef unsigned u32x4 __attribute__((ext_vector_type(4)));
constexpr int BM = 256, BK = 64, HALF = 128, HTB = HALF * BK * 2  , STAGE_BYTES = 8 * HTB, NXCD = 8, WGM = 8;

__host__ __device__ __forceinline__ int lds_byte(int r, int c) { const int st = (r >> 4) * 2 + (c >> 5), rr = r & 15, cc = c & 31, ob = rr * 64 + cc * 2; return st * 1024 + (ob ^ (((ob >> 9) & 1) << 5)); }
__host__ __device__ __forceinline__ void stage_rc(int b, int& R, int& C) { const int st = b / 1024, sb = b % 1024, swz = sb ^ (((sb >> 9) & 1) << 5); R = (st >> 1) * 16 + swz / 64; C = (st & 1) * 32 + (swz % 64) / 2; }
__host__ __device__ __forceinline__ int perm32(int rho) { const int n = rho >> 4, i = rho & 15; return 8 * (i >> 2) + 4 * n + (i & 3); }

struct Unit { int pm, pn; };
struct Gemm { const bf16_t* A; const bf16_t* Bt; int M, N, K; };

struct StaticOrder {
    int nM, nN, nwg, G, c;
    __host__ __device__ void init(int M, int N, int G_, int c_) { nM = M / BM; nN = N / BM; nwg = nM * nN; G = G_; c = c_; }
    __host__ __device__ bool next(int i, Unit& u) const {
        const long L = (long)i * G + c; if (L >= nwg) return false;
        int wgid = (int)L; { const int q = nwg / NXCD, r = nwg % NXCD, xcd = wgid % NXCD, off = wgid / NXCD; wgid = (xcd < r ? xcd * (q + 1) : r * (q + 1) + (xcd - r) * q) + off; }
        const int nig = WGM * nN, gid = wgid / nig, fm = gid * WGM, gsz = (nM - fm) < WGM ? (nM - fm) : WGM;
        u.pm = fm + ((wgid % nig) % gsz); u.pn = (wgid % nig) / gsz; return true;
    }
    __device__ __forceinline__ void a_ready(const Unit&) const {}
    __device__ __forceinline__ void done(const Unit&) const {}
};

__device__ __forceinline__ unsigned cvt_pk_bf16(float lo, float hi) { unsigned r; asm volatile("v_cvt_pk_bf16_f32 %0, %1, %2" : "=v"(r) : "v"(lo), "v"(hi)); return r; }
typedef float f32x2 __attribute__((ext_vector_type(2)));

template <int RSMODE> struct EpiBf16 {
    static constexpr bool PERM = true, AFTER_DRAIN = false;
    bf16_t* O; int ldc; const float* rowscale; int split_cols; size_t split_stride; float scale0;
    __device__ __forceinline__ void operator()(const f32x4 (&acc)[2][2][4][2], const Unit& u, int wr, int wc, int fr, int fq) const {
        const int row0 = u.pm * BM + wr * 64 + fr; int colt = u.pn * BM; bf16_t* base = O;
        float sc = 1.f; if (split_cols) { const int t = colt / split_cols; base += (size_t)t * split_stride; colt -= t * split_cols; if (t == 0) sc = scale0; }
        const int col0 = colt + wc * 32 + 8 * fq;
#pragma unroll
        for (int ai = 0; ai < 2; ++ai)
#pragma unroll
            for (int m = 0; m < 4; ++m) { const int row = row0 + ai * HALF + m * 16; bf16_t* rowp = base + (size_t)row * ldc + col0;
                float rs = sc;
                if (RSMODE == 1) rs *= rowscale[row];
                if (RSMODE == 2) rs *= 1.0f / sqrtf(rowscale[row] * (1.0f / 1024.0f) + 1e-6f);
#pragma unroll
                for (int bj = 0; bj < 2; ++bj) { f32x4 v0 = acc[ai][bj][m][0] * rs, v1 = acc[ai][bj][m][1] * rs;
                    u32x4 w; w.x = cvt_pk_bf16(v0[0], v0[1]); w.y = cvt_pk_bf16(v0[2], v0[3]); w.z = cvt_pk_bf16(v1[0], v1[1]); w.w = cvt_pk_bf16(v1[2], v1[3]);
                    *(u32x4*)(rowp + bj * HALF) = w; } }
    }
};

struct EpiResid {
    static constexpr bool PERM = false, AFTER_DRAIN = false;
    const float* X; float* Hf; bf16_t* Hb; float* rowss; int ldc;
    __device__ __forceinline__ void operator()(const f32x4 (&acc)[2][2][4][2], const Unit& u, int wr, int wc, int fr, int fq) const {
        typedef unsigned u32x2v __attribute__((ext_vector_type(2)));
        const int col0 = u.pn * BM + wc * 32 + 4 * fq;
#pragma unroll
        for (int ai = 0; ai < 2; ++ai)
#pragma unroll
            for (int m = 0; m < 4; ++m) { const int row = u.pm * BM + ai * HALF + wr * 64 + m * 16 + fr; const size_t off = (size_t)row * ldc + col0; float ss = 0.f;
#pragma unroll
                for (int bj = 0; bj < 2; ++bj)
#pragma unroll
                    for (int n = 0; n < 2; ++n) { const f32x4 xv = *(const f32x4*)(X + off + bj * HALF + n * 16); const f32x4 h = xv + acc[ai][bj][m][n];
                        u32x2v w; w.x = cvt_pk_bf16(h[0], h[1]); w.y = cvt_pk_bf16(h[2], h[3]);
                        *(u32x2v*)(Hb + off + bj * HALF + n * 16) = w; ss += (h[0] * h[0] + h[1] * h[1]) + (h[2] * h[2] + h[3] * h[3]); }
                ss += __shfl_xor(ss, 16); ss += __shfl_xor(ss, 32);
                if (fq == 0) atomicAdd(rowss + row, ss); }
    }
};

template <class Epi, class Sched, bool ALIGN_EPI = false, bool SP2 = false>
__device__ __forceinline__ void gemm_phase(PG8_LAS unsigned char* lds, const Gemm g, const Sched& S, const Epi& E) {
    const int tid = threadIdx.x, wid = __builtin_amdgcn_readfirstlane(tid >> 6), lane = tid & 63, wr = wid >> 2, wc = wid & 3, fr = lane & 15, fq = lane >> 4;
    const int K = g.K, nt = K / BK;
    unsigned voffA[2], voffB[2];
#pragma unroll
    for (int i = 0; i < 2; ++i) { int R, C; stage_rc(tid * 16 + i * 8192, R, C); const int Rb = Epi::PERM ? ((R & ~31) + perm32(R & 31)) : R;
        voffA[i] = (unsigned)(R * K + C) * 2u; voffB[i] = (unsigned)(Rb * K + C) * 2u; }
    const size_t kstep = (size_t)(BK * 2);
    const size_t hstep = (size_t)HALF * K * 2;
    const size_t tstep = 2 * hstep;
    const unsigned ldsw = (unsigned)wid * 1024u;
    const int aoff = lds_byte(wr * 64 + fr, fq * 8), boff = lds_byte(wc * 32 + fr, fq * 8);
#define PG8_SA(b, h) (((b) * 2 + (h)) * HTB)
#define PG8_SB(b, h) ((4 + (b) * 2 + (h)) * HTB)
#define PG8_STAGE(bufoff, gbase, voff) do { _Pragma("unroll") for (int _i = 0; _i < 2; ++_i) \
        __builtin_amdgcn_global_load_lds((const unsigned*)((const char*)(gbase) + (voff)[_i]), (PG8_LAS unsigned*)(lds + (bufoff) + ldsw + _i * 8192), 16, 0, 0); } while (0)
#define PG8_LDA(dst, b, h) do { _Pragma("unroll") for (int m = 0; m < 4; ++m) _Pragma("unroll") for (int k = 0; k < 2; ++k) dst[m][k] = *(const PG8_LAS bf16x8*)(lds + PG8_SA(b, h) + aoff + m * 2048 + k * 1024); } while (0)
#define PG8_LDB(dst, b, h) do { _Pragma("unroll") for (int n = 0; n < 2; ++n) _Pragma("unroll") for (int k = 0; k < 2; ++k) dst[n][k] = *(const PG8_LAS bf16x8*)(lds + PG8_SB(b, h) + boff + n * 2048 + k * 1024); } while (0)
#define PG8_MMA(ai, bj, At, Bt) do { __builtin_amdgcn_s_setprio(1); _Pragma("unroll") for (int m = 0; m < 4; ++m) _Pragma("unroll") for (int n = 0; n < 2; ++n) _Pragma("unroll") for (int k = 0; k < 2; ++k) \
        acc[ai][bj][m][n] = __builtin_amdgcn_mfma_f32_16x16x32_bf16(Bt[n][k], At[m][k], acc[ai][bj][m][n], 0, 0, 0); __builtin_amdgcn_s_setprio(0); } while (0)
#define PG8_WAIT_V(n) asm volatile("s_waitcnt vmcnt(" #n ")" ::: "memory")
#define PG8_WAIT_L(n) asm volatile("s_waitcnt lgkmcnt(" #n ")" ::: "memory")
#define PG8_BAR __builtin_amdgcn_s_barrier()
#define PG8_SCHED __builtin_amdgcn_sched_barrier(0)
    Unit cur, nxt; int ui = 0;
    if (!S.next(0, cur)) return;
    f32x4 acc[2][2][4][2];
#pragma unroll
    for (int a = 0; a < 2; ++a)
#pragma unroll
        for (int b = 0; b < 2; ++b)
#pragma unroll
            for (int m = 0; m < 4; ++m)
#pragma unroll
                for (int n = 0; n < 2; ++n) acc[a][b][m][n] = (f32x4){0.f, 0.f, 0.f, 0.f};
    bf16x8 At[4][2], B0[2][2], B1[2][2];
    const char* cA = (const char*)g.A + (size_t)cur.pm * tstep; const char* cB = (const char*)g.Bt + (size_t)cur.pn * tstep;
    S.a_ready(cur);
    if constexpr (SP2) {
        PG8_STAGE(PG8_SB(0, 0), cB, voffB); PG8_STAGE(PG8_SB(0, 1), cB + hstep, voffB); PG8_STAGE(PG8_SA(0, 0), cA, voffA); PG8_STAGE(PG8_SA(0, 1), cA + hstep, voffA);
        if (wr == 1) PG8_BAR;
        PG8_WAIT_V(2); PG8_BAR;
        PG8_STAGE(PG8_SB(1, 0), cB + kstep, voffB); PG8_STAGE(PG8_SA(1, 0), cA + kstep, voffA); PG8_STAGE(PG8_SB(1, 1), cB + hstep + kstep, voffB);
        PG8_WAIT_V(6); PG8_BAR;
    } else {
        PG8_STAGE(PG8_SB(0, 0), cB, voffB); PG8_STAGE(PG8_SA(0, 0), cA, voffA); PG8_STAGE(PG8_SB(0, 1), cB + hstep, voffB); PG8_STAGE(PG8_SA(0, 1), cA + hstep, voffA);
        if (wr == 1) PG8_BAR;
        PG8_WAIT_V(4); PG8_BAR;
        PG8_STAGE(PG8_SB(1, 0), cB + kstep, voffB); PG8_STAGE(PG8_SA(1, 0), cA + kstep, voffA); PG8_STAGE(PG8_SB(1, 1), cB + hstep + kstep, voffB);
        PG8_WAIT_V(6); PG8_BAR;
    }
    for (;;) {
        const bool has_next = S.next(ui + 1, nxt);
        const char* nA = has_next ? (const char*)g.A + (size_t)nxt.pm * tstep : cA; const char* nB = has_next ? (const char*)g.Bt + (size_t)nxt.pn * tstep : cB;
        for (int t = 0; t < nt; t += 2) {
            const bool last = (t == nt - 2);
            const char* a1 = cA + (size_t)(t + 1) * kstep;
            const char* a2 = last ? nA : cA + (size_t)(t + 2) * kstep; const char* b2 = last ? nB : cB + (size_t)(t + 2) * kstep;
            const char* a3 = a2 + kstep; const char* b3 = b2 + kstep;
            if (last && has_next) S.a_ready(nxt);
            if constexpr (SP2) {
            PG8_LDB(B0, 0, 0); PG8_LDB(B1, 0, 1); PG8_SCHED; PG8_LDA(At, 0, 0); PG8_STAGE(PG8_SA(1, 1), a1 + hstep, voffA);
            PG8_WAIT_V(8); PG8_WAIT_L(0); PG8_BAR; PG8_MMA(0, 0, At, B0); PG8_MMA(0, 1, At, B1); PG8_BAR; PG8_SCHED;
            PG8_LDA(At, 0, 1); PG8_STAGE(PG8_SB(0, 0), b2, voffB); PG8_STAGE(PG8_SB(0, 1), b2 + hstep, voffB); PG8_STAGE(PG8_SA(0, 0), a2, voffA);
            PG8_WAIT_V(8); PG8_WAIT_L(0); PG8_BAR; PG8_MMA(1, 0, At, B0); PG8_MMA(1, 1, At, B1); PG8_BAR; PG8_SCHED;
            PG8_LDB(B0, 1, 0); PG8_LDB(B1, 1, 1); PG8_SCHED; PG8_LDA(At, 1, 0); PG8_STAGE(PG8_SA(0, 1), a2 + hstep, voffA);
            PG8_WAIT_V(8); PG8_WAIT_L(0); PG8_BAR; PG8_MMA(0, 0, At, B0); PG8_MMA(0, 1, At, B1); PG8_BAR; PG8_SCHED;
            PG8_LDA(At, 1, 1); PG8_STAGE(PG8_SB(1, 0), b3, voffB); PG8_STAGE(PG8_SB(1, 1), b3 + hstep, voffB); PG8_STAGE(PG8_SA(1, 0), a3, voffA);
            PG8_WAIT_V(8); PG8_WAIT_L(0); PG8_BAR; PG8_MMA(1, 0, At, B0); PG8_MMA(1, 1, At, B1); PG8_BAR; PG8_SCHED;
            } else {
            PG8_LDB(B0, 0, 0); PG8_SCHED; PG8_LDA(At, 0, 0); PG8_STAGE(PG8_SA(1, 1), a1 + hstep, voffA);
            PG8_WAIT_L(8); PG8_BAR; PG8_WAIT_L(0); PG8_MMA(0, 0, At, B0); PG8_BAR; PG8_SCHED;
            PG8_LDB(B1, 0, 1); PG8_STAGE(PG8_SB(0, 0), b2, voffB);
            PG8_BAR; PG8_WAIT_L(0); PG8_MMA(0, 1, At, B1); PG8_BAR;
            PG8_LDA(At, 0, 1); PG8_STAGE(PG8_SA(0, 0), a2, voffA);
            PG8_BAR; PG8_WAIT_L(0); PG8_MMA(1, 0, At, B0); PG8_BAR; PG8_SCHED;
            PG8_STAGE(PG8_SB(0, 1), b2 + hstep, voffB);
            PG8_WAIT_V(6); PG8_BAR; PG8_MMA(1, 1, At, B1); PG8_BAR;
            PG8_LDB(B0, 1, 0); PG8_SCHED; PG8_LDA(At, 1, 0); PG8_STAGE(PG8_SA(0, 1), a2 + hstep, voffA);
            PG8_WAIT_L(8); PG8_BAR; PG8_WAIT_L(0); PG8_MMA(0, 0, At, B0); PG8_BAR; PG8_SCHED;
            PG8_LDB(B1, 1, 1); PG8_STAGE(PG8_SB(1, 0), b3, voffB);
            PG8_BAR; PG8_WAIT_L(0); PG8_MMA(0, 1, At, B1); PG8_BAR;
            PG8_LDA(At, 1, 1); PG8_STAGE(PG8_SA(1, 0), a3, voffA);
            PG8_BAR; PG8_WAIT_L(0); PG8_MMA(1, 0, At, B0); PG8_BAR; PG8_SCHED;
            PG8_STAGE(PG8_SB(1, 1), b3 + hstep, voffB);
            PG8_WAIT_V(6); PG8_BAR; PG8_MMA(1, 1, At, B1); PG8_BAR;
            }
        }
        if constexpr (ALIGN_EPI) { if (wr == 0) PG8_BAR; }
        if constexpr (!Epi::AFTER_DRAIN) { E(acc, cur, wr, wc, fr, fq); S.done(cur); }
        if (!has_next) break;
#pragma unroll
        for (int a = 0; a < 2; ++a)
#pragma unroll
            for (int b = 0; b < 2; ++b)
#pragma unroll
                for (int m = 0; m < 4; ++m)
#pragma unroll
                    for (int n = 0; n < 2; ++n) acc[a][b][m][n] = (f32x4){0.f, 0.f, 0.f, 0.f};
        cur = nxt; cA = nA; cB = nB; ++ui;
        if constexpr (ALIGN_EPI) { if (wr == 1) PG8_BAR; }
    }
    PG8_WAIT_V(0);
    if constexpr (!ALIGN_EPI) { if (wr == 0) PG8_BAR; }
    PG8_BAR;
    if constexpr (Epi::AFTER_DRAIN) { E.fused(acc, cur, wr, wc, fr, fq, lds, wid, lane); S.done(cur); }
#undef PG8_SA
#undef PG8_SB
#undef PG8_STAGE
#undef PG8_LDA
#undef PG8_LDB
#undef PG8_MMA
#undef PG8_WAIT_V
#undef PG8_WAIT_L
#undef PG8_BAR
#undef PG8_SCHED
}
}

#include <hip/hip_bf16.h>
#include <cmath>
namespace attn_body {
using bf16=__hip_bfloat16;
using bf16x8=__attribute__((ext_vector_type(8)))short;
using s16x4=__attribute__((ext_vector_type(4)))short;
using f32x16=__attribute__((ext_vector_type(16)))float;
using u32x4=__attribute__((ext_vector_type(4)))unsigned;
constexpr int SEQ=16384,D=64,DM=512;
constexpr int NW=8,QBLK=32,QB=QBLK*NW,KVBLK=64,NQB=SEQ/QB;
constexpr int ATTN_PITCH=DM, ATTN_UNIT_ROWS=QB;
__device__ __forceinline__ int crow(int r,int hi){return (r&3)+8*(r>>2)+4*hi;}
#define SBAR() __builtin_amdgcn_sched_barrier(0)
__device__ __forceinline__ void cmask(f32x16&p0,f32x16&p1,int jb,int wid){
  const float NEG=-INFINITY;
  if(jb>(wid>>1)){
  #pragma unroll
  for(int r=0;r<16;++r){p0[r]=NEG;p1[r]=NEG;}}
}

constexpr int NSLOT=3, SLOTB=8192;
constexpr int LDS_K=0, LDS_V=NSLOT*SLOTB, LDS_WS=2*NSLOT*SLOTB, LDS_OST=LDS_WS+NW*64*4, LDS_BYTES=LDS_OST+NW*4096;
constexpr float C2=0.125f*1.4426950408889634f;
__device__ __forceinline__ void glds16(const void*gsrc,unsigned lds_dst){unsigned keep;
  asm volatile("s_mov_b32 %0, m0\n\ts_mov_b32 m0, %2\n\ts_nop 0\n\tglobal_load_lds_dwordx4 %1, off\n\ts_mov_b32 m0, %0":"=&s"(keep):"v"(gsrc),"s"(lds_dst):"memory");}
__device__ __forceinline__ float max3f(float a,float b,float c){float r;asm("v_max3_f32 %0, %1, %2, %3":"=v"(r):"v"(a),"v"(b),"v"(c));return r;}
__device__ __forceinline__ float max2f(float a,float b){float r;asm("v_max_f32_e32 %0, %1, %2":"=v"(r):"v"(a),"v"(b));return r;}
__device__ __forceinline__ float fadd_s(float a,float b){float r;asm("v_add_f32_e32 %0, %1, %2":"=v"(r):"v"(a),"v"(b));return r;}
__device__ __forceinline__ float fsub_s(float a,float b){float r;asm("v_sub_f32_e32 %0, %1, %2":"=v"(r):"v"(a),"v"(b));return r;}
typedef float f32x2_t __attribute__((ext_vector_type(2))); typedef __bf16 bf16x2_t __attribute__((ext_vector_type(2)));
__device__ __forceinline__ unsigned cvtpk_s(float lo,float hi){f32x2_t v={lo,hi};bf16x2_t b=__builtin_convertvector(v,bf16x2_t);return __builtin_bit_cast(unsigned,b);}
#define WAIT_BAR(N) asm volatile("s_waitcnt vmcnt(" #N ") lgkmcnt(0)\n\ts_barrier":::"memory")

__device__ __forceinline__ void qkt(f32x16&p0,f32x16&p1,const char*Kslot,const bf16x8*qr,const f32x16&negm,int r32,int hi){
  const char*kb=Kslot+hi*1024+r32*16;
  #pragma unroll
  for(int d0=0;d0<4;++d0){
    const bf16x8 b0=*reinterpret_cast<const bf16x8*>(kb+d0*2048);
    const bf16x8 b1=*reinterpret_cast<const bf16x8*>(kb+d0*2048+512);
    if(d0==0){p0=__builtin_amdgcn_mfma_f32_32x32x16_bf16(b0,qr[0],negm,0,0,0);p1=__builtin_amdgcn_mfma_f32_32x32x16_bf16(b1,qr[0],negm,0,0,0);}
    else{p0=__builtin_amdgcn_mfma_f32_32x32x16_bf16(b0,qr[d0],p0,0,0,0);p1=__builtin_amdgcn_mfma_f32_32x32x16_bf16(b1,qr[d0],p1,0,0,0);}}
}
typedef __attribute__((address_space(3))) const char* lds_cptr;
typedef short v4i16_t __attribute__((ext_vector_type(4)));
__device__ __forceinline__ void kload8(bf16x8*kf,lds_cptr kp){
  kf[0]=*(const __attribute__((address_space(3))) bf16x8*)(kp);      kf[1]=*(const __attribute__((address_space(3))) bf16x8*)(kp+512);
  kf[2]=*(const __attribute__((address_space(3))) bf16x8*)(kp+2048); kf[3]=*(const __attribute__((address_space(3))) bf16x8*)(kp+2560);
  kf[4]=*(const __attribute__((address_space(3))) bf16x8*)(kp+4096); kf[5]=*(const __attribute__((address_space(3))) bf16x8*)(kp+4608);
  kf[6]=*(const __attribute__((address_space(3))) bf16x8*)(kp+6144); kf[7]=*(const __attribute__((address_space(3))) bf16x8*)(kp+6656);
}
__device__ __forceinline__ void kload2(bf16x8*kf,lds_cptr kp,int j){ kf[2*j]=*(const __attribute__((address_space(3))) bf16x8*)(kp+j*2048); kf[2*j+1]=*(const __attribute__((address_space(3))) bf16x8*)(kp+j*2048+512); }
__device__ __forceinline__ s16x4 vtr(lds_cptr p){ return __builtin_bit_cast(s16x4,__builtin_amdgcn_ds_read_tr16_b64_v4i16((__attribute__((address_space(3))) v4i16_t*)p)); }
__device__ __forceinline__ float rowmax(const f32x16&p0,const f32x16&p1){
  float a=max3f(p0[0],p0[1],p1[0]),b=max3f(p0[2],p0[3],p1[1]);a=max3f(a,p1[2],p1[3]);
  #pragma unroll
  for(int r=4;r<16;r+=4){a=max3f(a,p0[r],p0[r+1]);b=max3f(b,p0[r+2],p0[r+3]);a=max3f(a,p1[r],p1[r+1]);b=max3f(b,p1[r+2],p1[r+3]);}
  const float m=max2f(a,b);
  auto rr=__builtin_amdgcn_permlane32_swap(__float_as_uint(m),__float_as_uint(m),false,false);
  return max2f(__uint_as_float(rr[0]),__uint_as_float(rr[1]));
}
__device__ __forceinline__ void pv(f32x16*o,int vb,bf16x8 pa0,bf16x8 pa1,bf16x8 pa2,bf16x8 pa3){
  #pragma unroll
  for(int d0=0;d0<2;++d0){s16x4 lo[4],hi[4];
    #pragma unroll
    for(int ks=0;ks<4;++ks){
      asm volatile("ds_read_b64_tr_b16 %0,%1 offset:%c2":"=&v"(lo[ks]):"v"(vb),"i"(d0*4096+ks*1024):"memory");
      asm volatile("ds_read_b64_tr_b16 %0,%1 offset:%c2":"=&v"(hi[ks]):"v"(vb),"i"(d0*4096+ks*1024+512):"memory");}
    asm volatile("s_waitcnt lgkmcnt(0)":::"memory");SBAR();
    #define PK(k) (bf16x8){lo[k][0],lo[k][1],lo[k][2],lo[k][3],hi[k][0],hi[k][1],hi[k][2],hi[k][3]}
    o[d0]=__builtin_amdgcn_mfma_f32_32x32x16_bf16(pa0,PK(0),o[d0],0,0,0);
    o[d0]=__builtin_amdgcn_mfma_f32_32x32x16_bf16(pa1,PK(1),o[d0],0,0,0);
    o[d0]=__builtin_amdgcn_mfma_f32_32x32x16_bf16(pa2,PK(2),o[d0],0,0,0);
    o[d0]=__builtin_amdgcn_mfma_f32_32x32x16_bf16(pa3,PK(3),o[d0],0,0,0);
    #undef PK
  }
}

#ifndef ATTN_STORE16
#define ATTN_STORE16(p,v) (*(u32x4*)(p)=(v))
#endif
template<int THRL> __device__ __forceinline__ void attn_unit(int qcol,int vcol,int qb,const bf16*Q,const bf16*__restrict__ K,const bf16*__restrict__ V,bf16*O,char*shm){
  const int tid=threadIdx.x,lane=tid&63,r32=lane&31,hi=lane>>5; const int wid=__builtin_amdgcn_readfirstlane(tid>>6);
  const long rowbase=0; const int q0=qb*QB;
  const bf16*Qw=Q+(rowbase+q0+wid*QBLK)*DM+qcol;
  const bf16*Kh=K+rowbase*DM+qcol,*Vh=V+rowbase*DM+vcol;
  const unsigned lds0=(unsigned)(uintptr_t)shm;
  float*wsf=(float*)(shm+LDS_WS)+wid*64;
  const bf16*ksrc=Kh+(long)lane*DM+wid*8;
  const bf16*vsrc=Vh+(long)(16*(wid&3)+(lane>>2))*DM+(wid>>2)*32+(lane&3)*8;
  const unsigned kdst=lds0+LDS_K+wid*1024, vdst=lds0+LDS_V+wid*1024;
  #define DMA_K(t,slot) glds16(ksrc+(long)(t)*KVBLK*DM,(unsigned)__builtin_amdgcn_readfirstlane(kdst+(slot)))
  #define DMA_V(t,slot) glds16(vsrc+(long)(t)*KVBLK*DM,(unsigned)__builtin_amdgcn_readfirstlane(vdst+(slot)))
  const int vb0=(int)(lds0+LDS_V)+((lane>>4)&1)*32+(lane&3)*8+(4*hi+((lane&15)>>2))*64;
  const char*Kbase=shm+LDS_K; bf16x8 kf[8];
  const lds_cptr shm3=(lds_cptr)shm; const lds_cptr kp0=shm3+LDS_K+hi*1024+r32*16; const lds_cptr vp0=shm3+LDS_V+((lane>>4)&1)*32+(lane&3)*8+(4*hi+((lane&15)>>2))*64;
  const int NT=(q0+QB)/KVBLK;
  DMA_K(0,0);DMA_V(0,0);DMA_K(1,SLOTB);
  bf16x8 qr[4];
  #pragma unroll
  for(int d0=0;d0<4;++d0)qr[d0]=*reinterpret_cast<const bf16x8*>(&Qw[(long)r32*DM+d0*16+hi*8]);
  float mhat=0.f,l_reg=0.f;f32x16 o[2];o[0]=f32x16{};o[1]=f32x16{};f32x16 negm=f32x16{};asm volatile("":"+v"(negm));
  const int qrel=wid*QBLK+r32;
  #define CMASK(P0,P1,t) do{int jb_=(t)-(NT-4); if(jb_>=0)cmask(P0,P1,jb_,wid);}while(0)
  bool resc=false;
  #define START(P0,P1) do{ const float rm=rowmax(P0,P1); resc=false; \
    { const float dl=rm; mhat=fadd_s(mhat,dl); \
      _Pragma("unroll") for(int r=0;r<16;++r){P0[r]=fsub_s(P0[r],dl);P1[r]=fsub_s(P1[r],dl);} \
      _Pragma("unroll") for(int r=0;r<16;++r)negm[r]=-mhat; asm volatile("":"+v"(negm)); } \
    _Pragma("unroll") for(int r=0;r<16;++r)P0[r]=__builtin_amdgcn_exp2f(P0[r]); }while(0)
  #define RESC() do{ if(resc){ asm volatile("s_waitcnt lgkmcnt(0)":::"memory"); \
      _Pragma("unroll") for(int d_=0;d_<2;++d_) _Pragma("unroll") for(int r=0;r<16;++r)o[d_][r]*=wsf[crow(r,hi)]; } }while(0)
  f32x16 pA0,pA1,pB0,pB1;
  int sl_prev=0,sl_cur=0,sl_next=SLOTB;
  #define ROT() do{sl_prev=sl_cur;sl_cur=sl_next;sl_next=(sl_next==(NSLOT-1)*SLOTB)?0:sl_next+SLOTB;}while(0)
  DMA_K(2,2*SLOTB);
  WAIT_BAR(3);
  qkt(pA0,pA1,Kbase,qr,negm,r32,hi);asm volatile("s_nop 15\n\ts_nop 7":"+v"(pA0),"+v"(pA1));CMASK(pA0,pA1,0);
  START(pA0,pA1);
  _Pragma("unroll") for(int r=0;r<16;++r)pA1[r]=__builtin_amdgcn_exp2f(pA1[r]);
  WAIT_BAR(0);
  DMA_K(3,0);DMA_V(1,SLOTB);
  ROT();
  kload8(kf,kp0+sl_cur);
  WAIT_BAR(2);
  s16x4 vlo[8],vhi[8]; u32x4 pw0,pw1,pw2,pw3;
  #define PKW(P,B) cvtpk_s(P[B],P[B+1])
  #define PAF(k) __builtin_bit_cast(bf16x8,pw##k)
  #define VFR(i) (bf16x8){vlo[i][0],vlo[i][1],vlo[i][2],vlo[i][3],vhi[i][0],vhi[i][1],vhi[i][2],vhi[i][3]}
  #define PIN(x) asm volatile("":"+v"(x))
  #define MX3(a,b,c) __builtin_fmaxf(__builtin_fmaxf((a),(b)),(c))
  #define GAPA(MF,A0,A1,A2,A3,W0,W1,PW) do{ MF; sacc+=A0; sacc+=A1; sacc+=A2; sacc+=A3; PIN(sacc); W0; W1; PIN(PW); SBAR(); }while(0)
  #define EX(v) __builtin_amdgcn_exp2f(v)
  #define GAPB(MF,X,B) do{ MF; X[B]=EX(X[B]); X[B+1]=EX(X[B+1]); X[B+2]=EX(X[B+2]); X[B+3]=EX(X[B+3]); PIN(X); SBAR(); }while(0)
  #define VRD(i) do{ vlo[i]=vtr(vp_+(((i)>>2)*4096+((i)&3)*1024)); vhi[i]=vtr(vp_+(((i)>>2)*4096+((i)&3)*1024+512)); }while(0)
  #define KRD(G,j) do{ if(G){ kload2(kf,kp0+sl_next,j); SBAR(); } }while(0)
  #define STEP(C0,C1,P0,P1,t,GK,GV,GL) do{ SBAR(); \
    const lds_cptr vp_=vp0+sl_prev; \
    VRD(0); SBAR(); float sacc=(P0[0]+P0[1]); \
    GAPA(C0=__builtin_amdgcn_mfma_f32_32x32x16_bf16(kf[0],qr[0],negm,0,0,0), P0[2],P0[3],P0[4],P0[5],     pw0[0]=PKW(P0,0), pw0[1]=PKW(P0,2), pw0); \
    VRD(4); SBAR(); GAPA(C1=__builtin_amdgcn_mfma_f32_32x32x16_bf16(kf[1],qr[0],negm,0,0,0), P0[6],P0[7],P0[8],P0[9],     pw0[2]=PKW(P0,4), pw0[3]=PKW(P0,6), pw0); \
    VRD(1); SBAR(); GAPA(C0=__builtin_amdgcn_mfma_f32_32x32x16_bf16(kf[2],qr[1],C0,0,0,0),   P0[10],P0[11],P0[12],P0[13], pw1[0]=PKW(P0,8), pw1[1]=PKW(P0,10), pw1); \
    VRD(5); SBAR(); GAPA(C1=__builtin_amdgcn_mfma_f32_32x32x16_bf16(kf[3],qr[1],C1,0,0,0),   P0[14],P0[15],P1[0],P1[1],   pw1[2]=PKW(P0,12),pw1[3]=PKW(P0,14), pw1); \
    VRD(2); SBAR(); GAPA(C0=__builtin_amdgcn_mfma_f32_32x32x16_bf16(kf[4],qr[2],C0,0,0,0),   P1[2],P1[3],P1[4],P1[5],     pw2[0]=PKW(P1,0), pw2[1]=PKW(P1,2), pw2); \
    VRD(6); SBAR(); GAPA(C1=__builtin_amdgcn_mfma_f32_32x32x16_bf16(kf[5],qr[2],C1,0,0,0),   P1[6],P1[7],P1[8],P1[9],     pw2[2]=PKW(P1,4), pw2[3]=PKW(P1,6), pw2); \
    VRD(3); SBAR(); GAPA(C0=__builtin_amdgcn_mfma_f32_32x32x16_bf16(kf[6],qr[3],C0,0,0,0),   P1[10],P1[11],P1[12],P1[13], pw3[0]=PKW(P1,8), pw3[1]=PKW(P1,10), pw3); \
    VRD(7); SBAR(); GAPA(C1=__builtin_amdgcn_mfma_f32_32x32x16_bf16(kf[7],qr[3],C1,0,0,0),   P1[14],P1[15],0.f,0.f,       pw3[2]=PKW(P1,12),pw3[3]=PKW(P1,14), pw3); \
    l_reg+=sacc; \
    if(GK){DMA_K((t)+3,sl_cur);} if(GV){DMA_V((t)+1,sl_next);} \
    CMASK(C0,C1,t); \
    { float a=MX3(C0[0],C0[1],C1[0]),b=MX3(C0[2],C0[3],C1[1]); a=MX3(a,C1[2],C1[3]); \
      _Pragma("unroll") for(int r=4;r<16;r+=4){a=MX3(a,C0[r],C0[r+1]);b=MX3(b,C0[r+2],C0[r+3]);a=MX3(a,C1[r],C1[r+1]);b=MX3(b,C1[r+2],C1[r+3]);} \
      float rm=__builtin_fmaxf(a,b); { auto rr=__builtin_amdgcn_permlane32_swap(__float_as_uint(rm),__float_as_uint(rm),false,false); rm=__builtin_fmaxf(__uint_as_float(rr[0]),__uint_as_float(rr[1])); } \
      resc=false; \
      if(__builtin_expect(__any(rm>(float)THRL),0)){ const float dl=__builtin_fmaxf(rm,0.f); mhat+=dl; \
        _Pragma("unroll") for(int r=0;r<16;++r){C0[r]-=dl;C1[r]-=dl;} \
        _Pragma("unroll") for(int r=0;r<16;++r)negm[r]=-mhat; asm volatile("":"+v"(negm)); \
        const float f=__builtin_amdgcn_exp2f(-dl); l_reg*=f; if(hi==0)wsf[r32]=f; resc=true; } } \
    SBAR(); \
    GAPB(o[0]=__builtin_amdgcn_mfma_f32_32x32x16_bf16(PAF(0),VFR(0),o[0],0,0,0), C0,0); \
    GAPB(o[1]=__builtin_amdgcn_mfma_f32_32x32x16_bf16(PAF(0),VFR(4),o[1],0,0,0), C0,4); \
    KRD(GL,0); GAPB(o[0]=__builtin_amdgcn_mfma_f32_32x32x16_bf16(PAF(1),VFR(1),o[0],0,0,0), C0,8); \
    KRD(GL,1); GAPB(o[1]=__builtin_amdgcn_mfma_f32_32x32x16_bf16(PAF(1),VFR(5),o[1],0,0,0), C0,12); \
    KRD(GL,2); GAPB(o[0]=__builtin_amdgcn_mfma_f32_32x32x16_bf16(PAF(2),VFR(2),o[0],0,0,0), C1,0); \
    KRD(GL,3); GAPB(o[1]=__builtin_amdgcn_mfma_f32_32x32x16_bf16(PAF(2),VFR(6),o[1],0,0,0), C1,4); \
    GAPB(o[0]=__builtin_amdgcn_mfma_f32_32x32x16_bf16(PAF(3),VFR(3),o[0],0,0,0), C1,8); \
    GAPB(o[1]=__builtin_amdgcn_mfma_f32_32x32x16_bf16(PAF(3),VFR(7),o[1],0,0,0), C1,12); \
    }while(0)
  int t=1;
  #undef CMASK
  #define CMASK(P0,P1,t) do{}while(0)
  for(;t+5<NT;t+=2){
    STEP(pB0,pB1,pA0,pA1,t,true,true,true);     WAIT_BAR(2); RESC(); ROT();
    STEP(pA0,pA1,pB0,pB1,t+1,true,true,true);   WAIT_BAR(2); RESC(); ROT();
  }
  #undef CMASK
  #define CMASK(P0,P1,t) do{int jb_=(t)-(NT-4); if(jb_>=0)cmask(P0,P1,jb_,wid);}while(0)
  #define ENDW(tt) do{ if((tt)+3<NT){WAIT_BAR(2);} else if((tt)+2<NT){WAIT_BAR(1);} else {WAIT_BAR(0);} }while(0)
  for(;t+1<NT;t+=2){
    STEP(pB0,pB1,pA0,pA1,t,(t+3<NT),(t+1<NT),(t+1<NT));       ENDW(t);   RESC(); ROT();
    STEP(pA0,pA1,pB0,pB1,t+1,(t+4<NT),(t+2<NT),(t+2<NT));     ENDW(t+1); RESC(); ROT();
  }
  STEP(pB0,pB1,pA0,pA1,NT-1,false,false,false); RESC();
  { float sacc=pB0[0]+pB0[1]; _Pragma("unroll") for(int r=2;r<16;++r)sacc+=pB0[r]; _Pragma("unroll") for(int r=0;r<16;++r)sacc+=pB1[r]; l_reg+=sacc;
    pw0=(u32x4){PKW(pB0,0),PKW(pB0,2),PKW(pB0,4),PKW(pB0,6)};pw1=(u32x4){PKW(pB0,8),PKW(pB0,10),PKW(pB0,12),PKW(pB0,14)};pw2=(u32x4){PKW(pB1,0),PKW(pB1,2),PKW(pB1,4),PKW(pB1,6)};pw3=(u32x4){PKW(pB1,8),PKW(pB1,10),PKW(pB1,12),PKW(pB1,14)};
    SBAR(); pv(o,vb0+sl_cur,PAF(0),PAF(1),PAF(2),PAF(3)); }
  #undef PKW
  #undef PAF
  #undef VFR
  #undef PIN
  #undef MX3
  #undef GAPA
  #undef GAPB
  #undef EX
  #undef VRD
  #undef KRD
  #undef STEP
  #undef ENDW
  {auto rr=__builtin_amdgcn_permlane32_swap(__float_as_uint(l_reg),__float_as_uint(l_reg),false,false);l_reg=__uint_as_float(rr[0])+__uint_as_float(rr[1]);}
  if(hi==0)wsf[32+r32]=l_reg;asm volatile("s_waitcnt lgkmcnt(0)":::"memory");
  float rli[16];
  #pragma unroll
  for(int r=0;r<16;++r)rli[r]=__builtin_amdgcn_rcpf(wsf[32+crow(r,hi)]);
  bf16*Ow=O+(rowbase+q0+wid*QBLK)*DM+vcol;
  { bf16*stg=(bf16*)(shm+LDS_OST)+wid*2048;
    #pragma unroll
    for(int r=0;r<16;++r){const int orow=crow(r,hi);
      #pragma unroll
      for(int d0=0;d0<2;++d0)stg[orow*64+d0*32+r32]=__float2bfloat16(o[d0][r]*rli[r]);}
    asm volatile("s_waitcnt lgkmcnt(0)":::"memory");
    #pragma unroll
    for(int i=0;i<4;++i){const int row=i*8+(lane>>3),ch=lane&7; const u32x4 v=*(const u32x4*)(stg+row*64+ch*8); ATTN_STORE16(Ow+(long)row*DM+ch*8,v);} }
  asm volatile("s_waitcnt lgkmcnt(0)\n\ts_barrier":::"memory");
  #undef DMA_K
  #undef DMA_V
  #undef CMASK
  #undef START
  #undef RESC
  #undef ROT
}
constexpr int ATTN_LDS_BYTES=LDS_BYTES;
struct AttnTensors { const bf16* Q; const bf16* K; const bf16* V; bf16* O; };
struct AttnUnit { int var; int qb; };
struct StaticOrder {
  int vcu;
  __device__ __forceinline__ explicit StaticOrder(int v):vcu(v){}
  __device__ __forceinline__ bool next(int i,AttnUnit&u)const{ if(i>=4)return false; const int s=vcu&15; u.var=vcu>>4; u.qb=(i==0)?s:(i==1)?31-s:(i==2)?32+s:63-s; return true; }
};
template<class Sched,int THRL=8> __device__ __forceinline__ void attn_phase(char*lds,const AttnTensors&T,const Sched&S){
  AttnUnit u;
  for(int i=0;S.next(i,u);++i){ const int h=u.var>>2,mp=(u.var>>1)&1,vh=u.var&1;
    attn_unit<THRL>(h*128+mp*64,h*128+vh*64,u.qb,T.Q,T.K,T.V,T.O+(size_t)mp*SEQ*DM,lds); }
}
#undef SBAR
#undef WAIT_BAR
}
namespace attn128 {
using bf16=__hip_bfloat16;
using bf16x8=__attribute__((ext_vector_type(8)))short;
using s16x4=__attribute__((ext_vector_type(4)))short;
using f32x16=__attribute__((ext_vector_type(16)))float;
using u32x4=__attribute__((ext_vector_type(4)))unsigned;
constexpr int SEQ=16384,D=64,DM=512;
constexpr int NW=8,QBLK=32,QB=QBLK*NW,KVBLK=64,NQB=SEQ/QB;
constexpr int ATTN_PITCH=DM, ATTN_UNIT_ROWS=QB;
__device__ __forceinline__ int crow(int r,int hi){return (r&3)+8*(r>>2)+4*hi;}
#define SBAR() __builtin_amdgcn_sched_barrier(0)
__device__ __forceinline__ void cmask(f32x16&p0,f32x16&p1,int jb,int wid){
  const float NEG=-INFINITY;
  if(jb>(wid>>1)){
  #pragma unroll
  for(int r=0;r<16;++r){p0[r]=NEG;p1[r]=NEG;}}
}

constexpr int NSLOT=3, SLOTB=8192;
constexpr int LDS_K=0, LDS_V=NSLOT*SLOTB, LDS_WS=3*NSLOT*SLOTB, LDS_OST=LDS_WS+NW*64*4, LDS_BYTES=LDS_OST+NW*4096;
constexpr float C2=0.125f*1.4426950408889634f;
__device__ __forceinline__ void glds16(const void*gsrc,unsigned lds_dst){unsigned keep;
  asm volatile("s_mov_b32 %0, m0\n\ts_mov_b32 m0, %2\n\ts_nop 0\n\tglobal_load_lds_dwordx4 %1, off\n\ts_mov_b32 m0, %0":"=&s"(keep):"v"(gsrc),"s"(lds_dst):"memory");}
__device__ __forceinline__ float max3f(float a,float b,float c){float r;asm("v_max3_f32 %0, %1, %2, %3":"=v"(r):"v"(a),"v"(b),"v"(c));return r;}
__device__ __forceinline__ float max2f(float a,float b){float r;asm("v_max_f32_e32 %0, %1, %2":"=v"(r):"v"(a),"v"(b));return r;}
__device__ __forceinline__ float fadd_s(float a,float b){float r;asm("v_add_f32_e32 %0, %1, %2":"=v"(r):"v"(a),"v"(b));return r;}
__device__ __forceinline__ float fsub_s(float a,float b){float r;asm("v_sub_f32_e32 %0, %1, %2":"=v"(r):"v"(a),"v"(b));return r;}
typedef float f32x2_t __attribute__((ext_vector_type(2))); typedef __bf16 bf16x2_t __attribute__((ext_vector_type(2)));
__device__ __forceinline__ unsigned cvtpk_s(float lo,float hi){f32x2_t v={lo,hi};bf16x2_t b=__builtin_convertvector(v,bf16x2_t);return __builtin_bit_cast(unsigned,b);}
#define WAIT_BAR(N) asm volatile("s_waitcnt vmcnt(" #N ") lgkmcnt(0)\n\ts_barrier":::"memory")

__device__ __forceinline__ void qkt(f32x16&p0,f32x16&p1,const char*Kslot,const bf16x8*qr,const f32x16&negm,int r32,int hi){
  const char*kb=Kslot+hi*1024+r32*16;
  #pragma unroll
  for(int d0=0;d0<4;++d0){
    const bf16x8 b0=*reinterpret_cast<const bf16x8*>(kb+d0*2048);
    const bf16x8 b1=*reinterpret_cast<const bf16x8*>(kb+d0*2048+512);
    if(d0==0){p0=__builtin_amdgcn_mfma_f32_32x32x16_bf16(b0,qr[0],negm,0,0,0);p1=__builtin_amdgcn_mfma_f32_32x32x16_bf16(b1,qr[0],negm,0,0,0);}
    else{p0=__builtin_amdgcn_mfma_f32_32x32x16_bf16(b0,qr[d0],p0,0,0,0);p1=__builtin_amdgcn_mfma_f32_32x32x16_bf16(b1,qr[d0],p1,0,0,0);}}
}
typedef __attribute__((address_space(3))) const char* lds_cptr;
typedef short v4i16_t __attribute__((ext_vector_type(4)));
__device__ __forceinline__ void kload8(bf16x8*kf,lds_cptr kp){
  kf[0]=*(const __attribute__((address_space(3))) bf16x8*)(kp);      kf[1]=*(const __attribute__((address_space(3))) bf16x8*)(kp+512);
  kf[2]=*(const __attribute__((address_space(3))) bf16x8*)(kp+2048); kf[3]=*(const __attribute__((address_space(3))) bf16x8*)(kp+2560);
  kf[4]=*(const __attribute__((address_space(3))) bf16x8*)(kp+4096); kf[5]=*(const __attribute__((address_space(3))) bf16x8*)(kp+4608);
  kf[6]=*(const __attribute__((address_space(3))) bf16x8*)(kp+6144); kf[7]=*(const __attribute__((address_space(3))) bf16x8*)(kp+6656);
}
__device__ __forceinline__ void kload2(bf16x8*kf,lds_cptr kp,int j){ kf[2*j]=*(const __attribute__((address_space(3))) bf16x8*)(kp+j*2048); kf[2*j+1]=*(const __attribute__((address_space(3))) bf16x8*)(kp+j*2048+512); }
__device__ __forceinline__ s16x4 vtr(lds_cptr p){ return __builtin_bit_cast(s16x4,__builtin_amdgcn_ds_read_tr16_b64_v4i16((__attribute__((address_space(3))) v4i16_t*)p)); }
__device__ __forceinline__ float rowmax(const f32x16&p0,const f32x16&p1){
  float a=max3f(p0[0],p0[1],p1[0]),b=max3f(p0[2],p0[3],p1[1]);a=max3f(a,p1[2],p1[3]);
  #pragma unroll
  for(int r=4;r<16;r+=4){a=max3f(a,p0[r],p0[r+1]);b=max3f(b,p0[r+2],p0[r+3]);a=max3f(a,p1[r],p1[r+1]);b=max3f(b,p1[r+2],p1[r+3]);}
  const float m=max2f(a,b);
  auto rr=__builtin_amdgcn_permlane32_swap(__float_as_uint(m),__float_as_uint(m),false,false);
  return max2f(__uint_as_float(rr[0]),__uint_as_float(rr[1]));
}
__device__ __forceinline__ void pv(f32x16*o,int vb,bf16x8 pa0,bf16x8 pa1,bf16x8 pa2,bf16x8 pa3){
  #pragma unroll
  for(int d0=0;d0<4;++d0){s16x4 lo[4],hi[4];
    #pragma unroll
    for(int ks=0;ks<4;++ks){
      asm volatile("ds_read_b64_tr_b16 %0,%1 offset:%c2":"=&v"(lo[ks]):"v"(vb),"i"(d0*4096+ks*1024):"memory");
      asm volatile("ds_read_b64_tr_b16 %0,%1 offset:%c2":"=&v"(hi[ks]):"v"(vb),"i"(d0*4096+ks*1024+512):"memory");}
    asm volatile("s_waitcnt lgkmcnt(0)":::"memory");SBAR();
    #define PK(k) (bf16x8){lo[k][0],lo[k][1],lo[k][2],lo[k][3],hi[k][0],hi[k][1],hi[k][2],hi[k][3]}
    o[d0]=__builtin_amdgcn_mfma_f32_32x32x16_bf16(pa0,PK(0),o[d0],0,0,0);
    o[d0]=__builtin_amdgcn_mfma_f32_32x32x16_bf16(pa1,PK(1),o[d0],0,0,0);
    o[d0]=__builtin_amdgcn_mfma_f32_32x32x16_bf16(pa2,PK(2),o[d0],0,0,0);
    o[d0]=__builtin_amdgcn_mfma_f32_32x32x16_bf16(pa3,PK(3),o[d0],0,0,0);
    #undef PK
  }
}

#ifndef ATTN_STORE16
#define ATTN_STORE16(p,v) (*(u32x4*)(p)=(v))
#endif
template<int THRL> __device__ __forceinline__ void attn_unit(int qcol,int vcol,int qb,const bf16*Q,const bf16*__restrict__ K,const bf16*__restrict__ V,bf16*O,char*shm){
  const int tid=threadIdx.x,lane=tid&63,r32=lane&31,hi=lane>>5; const int wid=__builtin_amdgcn_readfirstlane(tid>>6);
  const long rowbase=0; const int q0=qb*QB;
  const bf16*Qw=Q+(rowbase+q0+wid*QBLK)*DM+qcol;
  const bf16*Kh=K+rowbase*DM+qcol,*Vh=V+rowbase*DM+vcol;
  const unsigned lds0=(unsigned)(uintptr_t)shm;
  float*wsf=(float*)(shm+LDS_WS)+wid*64;
  const bf16*ksrc=Kh+(long)lane*DM+wid*8;
  const bf16*vsrc=Vh+(long)(16*(wid&3)+(lane>>2))*DM+(wid>>2)*32+(lane&3)*8;
  const unsigned kdst=lds0+LDS_K+wid*1024, vdst=lds0+LDS_V+wid*1024;
  #define DMA_K(t,slot) glds16(ksrc+(long)(t)*KVBLK*DM,(unsigned)__builtin_amdgcn_readfirstlane(kdst+(slot)))
  #define DMA_V(t,slot) do{ glds16(vsrc+(long)(t)*KVBLK*DM,(unsigned)__builtin_amdgcn_readfirstlane(vdst+2*(slot))); glds16(vsrc+64+(long)(t)*KVBLK*DM,(unsigned)__builtin_amdgcn_readfirstlane(vdst+2*(slot)+8192)); }while(0)
  const int vb0=(int)(lds0+LDS_V)+((lane>>4)&1)*32+(lane&3)*8+(4*hi+((lane&15)>>2))*64;
  const char*Kbase=shm+LDS_K; bf16x8 kf[8];
  const lds_cptr shm3=(lds_cptr)shm; const lds_cptr kp0=shm3+LDS_K+hi*1024+r32*16; const lds_cptr vp0=shm3+LDS_V+((lane>>4)&1)*32+(lane&3)*8+(4*hi+((lane&15)>>2))*64;
  const int NT=(q0+QB)/KVBLK;
  DMA_K(0,0);DMA_V(0,0);DMA_K(1,SLOTB);
  bf16x8 qr[4];
  #pragma unroll
  for(int d0=0;d0<4;++d0)qr[d0]=*reinterpret_cast<const bf16x8*>(&Qw[(long)r32*DM+d0*16+hi*8]);
  float mhat=0.f,l_reg=0.f;f32x16 o[4];o[0]=f32x16{};o[1]=f32x16{};o[2]=f32x16{};o[3]=f32x16{};const f32x16 negm=f32x16{};
  const int qrel=wid*QBLK+r32;
  #define CMASK(P0,P1,t) do{int jb_=(t)-(NT-4); if(jb_>=0)cmask(P0,P1,jb_,wid);}while(0)
  bool resc=false;
  #define START(P0,P1) do{ const float rm=rowmax(P0,P1); resc=false; \
    { const float dl=rm; mhat=fadd_s(mhat,dl); \
      _Pragma("unroll") for(int r=0;r<16;++r){P0[r]=fsub_s(P0[r],dl);P1[r]=fsub_s(P1[r],dl);} \
      } \
    _Pragma("unroll") for(int r=0;r<16;++r)P0[r]=__builtin_amdgcn_exp2f(P0[r]); }while(0)
  #define RESC() do{ if(resc){ asm volatile("s_waitcnt lgkmcnt(0)":::"memory"); \
      _Pragma("unroll") for(int d_=0;d_<4;++d_) _Pragma("unroll") for(int r=0;r<16;++r)o[d_][r]*=wsf[crow(r,hi)]; } }while(0)
  f32x16 pA0,pA1,pB0,pB1;
  int sl_prev=0,sl_cur=0,sl_next=SLOTB;
  #define ROT() do{sl_prev=sl_cur;sl_cur=sl_next;sl_next=(sl_next==(NSLOT-1)*SLOTB)?0:sl_next+SLOTB;}while(0)
  DMA_K(2,2*SLOTB);
  WAIT_BAR(4);
  qkt(pA0,pA1,Kbase,qr,negm,r32,hi);asm volatile("s_nop 15\n\ts_nop 7":"+v"(pA0),"+v"(pA1));CMASK(pA0,pA1,0);
  START(pA0,pA1);
  _Pragma("unroll") for(int r=0;r<16;++r)pA1[r]=__builtin_amdgcn_exp2f(pA1[r]);
  WAIT_BAR(0);
  DMA_K(3,0);DMA_V(1,SLOTB);
  ROT();
  kload8(kf,kp0+sl_cur);
  WAIT_BAR(3);
  s16x4 vlo[8],vhi[8]; u32x4 pw0,pw1,pw2,pw3;
  #define PKW(P,B) cvtpk_s(P[B],P[B+1])
  #define PAF(k) __builtin_bit_cast(bf16x8,pw##k)
  #define VFR(i) (bf16x8){vlo[i][0],vlo[i][1],vlo[i][2],vlo[i][3],vhi[i][0],vhi[i][1],vhi[i][2],vhi[i][3]}
  #define PIN(x) asm volatile("":"+v"(x))
  #define MX3(a,b,c) __builtin_fmaxf(__builtin_fmaxf((a),(b)),(c))
  #define GAPA(MF,A0,A1,A2,A3,W0,W1,PW) do{ MF; sacc+=A0; sacc+=A1; sacc+=A2; sacc+=A3; PIN(sacc); W0; W1; PIN(PW); SBAR(); }while(0)
  #define EX(v) __builtin_amdgcn_exp2f(v)
  #define GAPB(MF,X,B) do{ MF; X[B]=EX(X[B]); X[B+1]=EX(X[B+1]); X[B+2]=EX(X[B+2]); X[B+3]=EX(X[B+3]); PIN(X); SBAR(); }while(0)
  #define VRD(i) do{ vlo[i]=vtr(vp_+(((i)>>2)*4096+((i)&3)*1024)); vhi[i]=vtr(vp_+(((i)>>2)*4096+((i)&3)*1024+512)); }while(0)
  #define VRD2(i) do{ vlo[i]=vtr(vp_+((2+((i)>>2))*4096+((i)&3)*1024)); vhi[i]=vtr(vp_+((2+((i)>>2))*4096+((i)&3)*1024+512)); SBAR(); }while(0)
  #define GAPB2(MF,X,B) do{ MF; X[B]=EX(X[B]-mhat); X[B+1]=EX(X[B+1]-mhat); PIN(X); SBAR(); }while(0)
  #define KRD(G,j) do{ if(G){ kload2(kf,kp0+sl_next,j); SBAR(); } }while(0)
  #define STEP(C0,C1,P0,P1,t,GK,GV,GL) do{ SBAR(); \
    const lds_cptr vp_=vp0+2*sl_prev; \
    VRD(0); SBAR(); float sacc=(P0[0]+P0[1]); \
    GAPA(C0=__builtin_amdgcn_mfma_f32_32x32x16_bf16(kf[0],qr[0],negm,0,0,0), P0[2],P0[3],P0[4],P0[5],     pw0[0]=PKW(P0,0), pw0[1]=PKW(P0,2), pw0); \
    VRD(4); SBAR(); GAPA(C1=__builtin_amdgcn_mfma_f32_32x32x16_bf16(kf[1],qr[0],negm,0,0,0), P0[6],P0[7],P0[8],P0[9],     pw0[2]=PKW(P0,4), pw0[3]=PKW(P0,6), pw0); \
    VRD(1); SBAR(); GAPA(C0=__builtin_amdgcn_mfma_f32_32x32x16_bf16(kf[2],qr[1],C0,0,0,0),   P0[10],P0[11],P0[12],P0[13], pw1[0]=PKW(P0,8), pw1[1]=PKW(P0,10), pw1); \
    VRD(5); SBAR(); GAPA(C1=__builtin_amdgcn_mfma_f32_32x32x16_bf16(kf[3],qr[1],C1,0,0,0),   P0[14],P0[15],P1[0],P1[1],   pw1[2]=PKW(P0,12),pw1[3]=PKW(P0,14), pw1); \
    GAPA(C0=__builtin_amdgcn_mfma_f32_32x32x16_bf16(kf[4],qr[2],C0,0,0,0),   P1[2],P1[3],P1[4],P1[5],     pw2[0]=PKW(P1,0), pw2[1]=PKW(P1,2), pw2); \
    GAPA(C1=__builtin_amdgcn_mfma_f32_32x32x16_bf16(kf[5],qr[2],C1,0,0,0),   P1[6],P1[7],P1[8],P1[9],     pw2[2]=PKW(P1,4), pw2[3]=PKW(P1,6), pw2); \
    GAPA(C0=__builtin_amdgcn_mfma_f32_32x32x16_bf16(kf[6],qr[3],C0,0,0,0),   P1[10],P1[11],P1[12],P1[13], pw3[0]=PKW(P1,8), pw3[1]=PKW(P1,10), pw3); \
    GAPA(C1=__builtin_amdgcn_mfma_f32_32x32x16_bf16(kf[7],qr[3],C1,0,0,0),   P1[14],P1[15],0.f,0.f,       pw3[2]=PKW(P1,12),pw3[3]=PKW(P1,14), pw3); \
    l_reg+=sacc; \
    if(GK){DMA_K((t)+3,sl_cur);} if(GV){DMA_V((t)+1,sl_next);} \
    CMASK(C0,C1,t); \
    { float a=MX3(C0[0],C0[1],C1[0]),b=MX3(C0[2],C0[3],C1[1]); a=MX3(a,C1[2],C1[3]); \
      _Pragma("unroll") for(int r=4;r<16;r+=4){a=MX3(a,C0[r],C0[r+1]);b=MX3(b,C0[r+2],C0[r+3]);a=MX3(a,C1[r],C1[r+1]);b=MX3(b,C1[r+2],C1[r+3]);} \
      float rm=__builtin_fmaxf(a,b); { auto rr=__builtin_amdgcn_permlane32_swap(__float_as_uint(rm),__float_as_uint(rm),false,false); rm=__builtin_fmaxf(__uint_as_float(rr[0]),__uint_as_float(rr[1])); } \
      resc=false; const float rmr=rm-mhat; \
      if(__builtin_expect(__any(rmr>(float)THRL),0)){ const float dl=__builtin_fmaxf(rmr,0.f); mhat+=dl; \
        const float f=__builtin_amdgcn_exp2f(-dl); l_reg*=f; if(hi==0)wsf[r32]=f; resc=true; } } \
    SBAR(); \
    VRD(2); SBAR(); GAPB2(o[0]=__builtin_amdgcn_mfma_f32_32x32x16_bf16(PAF(0),VFR(0),o[0],0,0,0), C0,0); \
    VRD(6); SBAR(); GAPB2(o[1]=__builtin_amdgcn_mfma_f32_32x32x16_bf16(PAF(0),VFR(4),o[1],0,0,0), C0,2); \
    VRD(3); SBAR(); GAPB2(o[0]=__builtin_amdgcn_mfma_f32_32x32x16_bf16(PAF(1),VFR(1),o[0],0,0,0), C0,4); \
    VRD(7); SBAR(); GAPB2(o[1]=__builtin_amdgcn_mfma_f32_32x32x16_bf16(PAF(1),VFR(5),o[1],0,0,0), C0,6); \
    VRD2(0); GAPB2(o[0]=__builtin_amdgcn_mfma_f32_32x32x16_bf16(PAF(2),VFR(2),o[0],0,0,0), C0,8); \
    VRD2(4); GAPB2(o[1]=__builtin_amdgcn_mfma_f32_32x32x16_bf16(PAF(2),VFR(6),o[1],0,0,0), C0,10); \
    VRD2(1); GAPB2(o[0]=__builtin_amdgcn_mfma_f32_32x32x16_bf16(PAF(3),VFR(3),o[0],0,0,0), C0,12); \
    VRD2(5); GAPB2(o[1]=__builtin_amdgcn_mfma_f32_32x32x16_bf16(PAF(3),VFR(7),o[1],0,0,0), C0,14); \
    VRD2(2); GAPB2(o[2]=__builtin_amdgcn_mfma_f32_32x32x16_bf16(PAF(0),VFR(0),o[2],0,0,0), C1,0); \
    VRD2(6); GAPB2(o[3]=__builtin_amdgcn_mfma_f32_32x32x16_bf16(PAF(0),VFR(4),o[3],0,0,0), C1,2); \
    VRD2(3); KRD(GL,0); GAPB2(o[2]=__builtin_amdgcn_mfma_f32_32x32x16_bf16(PAF(1),VFR(1),o[2],0,0,0), C1,4); \
    VRD2(7); KRD(GL,1); GAPB2(o[3]=__builtin_amdgcn_mfma_f32_32x32x16_bf16(PAF(1),VFR(5),o[3],0,0,0), C1,6); \
    KRD(GL,2); GAPB2(o[2]=__builtin_amdgcn_mfma_f32_32x32x16_bf16(PAF(2),VFR(2),o[2],0,0,0), C1,8); \
    KRD(GL,3); GAPB2(o[3]=__builtin_amdgcn_mfma_f32_32x32x16_bf16(PAF(2),VFR(6),o[3],0,0,0), C1,10); \
    GAPB2(o[2]=__builtin_amdgcn_mfma_f32_32x32x16_bf16(PAF(3),VFR(3),o[2],0,0,0), C1,12); \
    GAPB2(o[3]=__builtin_amdgcn_mfma_f32_32x32x16_bf16(PAF(3),VFR(7),o[3],0,0,0), C1,14); \
    }while(0)
  int t=1;
  #undef CMASK
  #define CMASK(P0,P1,t) do{}while(0)
  for(;t+5<NT;t+=2){
    STEP(pB0,pB1,pA0,pA1,t,true,true,true);     WAIT_BAR(3); RESC(); ROT();
    STEP(pA0,pA1,pB0,pB1,t+1,true,true,true);   WAIT_BAR(3); RESC(); ROT();
  }
  #undef CMASK
  #define CMASK(P0,P1,t) do{int jb_=(t)-(NT-4); if(jb_>=0)cmask(P0,P1,jb_,wid);}while(0)
  #define ENDW(tt) do{ if((tt)+3<NT){WAIT_BAR(3);} else if((tt)+2<NT){WAIT_BAR(2);} else {WAIT_BAR(0);} }while(0)
  for(;t+1<NT;t+=2){
    STEP(pB0,pB1,pA0,pA1,t,(t+3<NT),(t+1<NT),(t+1<NT));       ENDW(t);   RESC(); ROT();
    STEP(pA0,pA1,pB0,pB1,t+1,(t+4<NT),(t+2<NT),(t+2<NT));     ENDW(t+1); RESC(); ROT();
  }
  STEP(pB0,pB1,pA0,pA1,NT-1,false,false,false); RESC();
  { float sacc=pB0[0]+pB0[1]; _Pragma("unroll") for(int r=2;r<16;++r)sacc+=pB0[r]; _Pragma("unroll") for(int r=0;r<16;++r)sacc+=pB1[r]; l_reg+=sacc;
    pw0=(u32x4){PKW(pB0,0),PKW(pB0,2),PKW(pB0,4),PKW(pB0,6)};pw1=(u32x4){PKW(pB0,8),PKW(pB0,10),PKW(pB0,12),PKW(pB0,14)};pw2=(u32x4){PKW(pB1,0),PKW(pB1,2),PKW(pB1,4),PKW(pB1,6)};pw3=(u32x4){PKW(pB1,8),PKW(pB1,10),PKW(pB1,12),PKW(pB1,14)};
    SBAR(); pv(o,vb0+2*sl_cur,PAF(0),PAF(1),PAF(2),PAF(3)); }
  #undef PKW
  #undef PAF
  #undef VFR
  #undef PIN
  #undef MX3
  #undef GAPA
  #undef GAPB
  #undef GAPB2
  #undef VRD2
  #undef EX
  #undef VRD
  #undef KRD
  #undef STEP
  #undef ENDW
  {auto rr=__builtin_amdgcn_permlane32_swap(__float_as_uint(l_reg),__float_as_uint(l_reg),false,false);l_reg=__uint_as_float(rr[0])+__uint_as_float(rr[1]);}
  if(hi==0)wsf[32+r32]=l_reg;asm volatile("s_waitcnt lgkmcnt(0)":::"memory");
  float rli[16];
  #pragma unroll
  for(int r=0;r<16;++r)rli[r]=__builtin_amdgcn_rcpf(wsf[32+crow(r,hi)]);
  bf16*Ow=O+(rowbase+q0+wid*QBLK)*DM+vcol;
  { bf16*stg=(bf16*)(shm+LDS_OST)+wid*2048;
    #pragma unroll
    for(int hf=0;hf<2;++hf){
    #pragma unroll
    for(int r=0;r<16;++r){const int orow=crow(r,hi);
      #pragma unroll
      for(int d0=0;d0<2;++d0)stg[orow*64+d0*32+r32]=__float2bfloat16(o[2*hf+d0][r]*rli[r]);}
    asm volatile("s_waitcnt lgkmcnt(0)":::"memory");
    #pragma unroll
    for(int i=0;i<4;++i){const int row=i*8+(lane>>3),ch=lane&7; const u32x4 v=*(const u32x4*)(stg+row*64+ch*8); ATTN_STORE16(Ow+(long)row*DM+hf*64+ch*8,v);}
    asm volatile("s_waitcnt lgkmcnt(0)":::"memory"); } }
  asm volatile("s_waitcnt lgkmcnt(0)\n\ts_barrier":::"memory");
  #undef DMA_K
  #undef DMA_V
  #undef CMASK
  #undef START
  #undef RESC
  #undef ROT
}
constexpr int ATTN_LDS_BYTES=LDS_BYTES;
struct AttnTensors { const bf16* Q; const bf16* K; const bf16* V; bf16* O; };
struct AttnUnit { int var; int qb; };
struct StaticOrder {
  int vcu;
  __device__ __forceinline__ explicit StaticOrder(int v):vcu(v){}
  __device__ __forceinline__ bool next(int i,AttnUnit&u)const{ if(i>=2)return false; const int s=vcu&31; u.var=vcu>>5; u.qb=(i==0)?s:63-s; return true; }
};
template<class Sched,int THRL=8> __device__ __forceinline__ void attn_phase(char*lds,const AttnTensors&T,const Sched&S){
  AttnUnit u;
  for(int i=0;S.next(i,u);++i){ const int h=u.var>>1,mp=u.var&1;
    attn_unit<THRL>(h*128+mp*64,h*128,u.qb,T.Q,T.K,T.V,T.O+(size_t)mp*SEQ*DM,lds); }
}
#undef SBAR
#undef WAIT_BAR
}


#define GAS __attribute__((address_space(1)))
#define LAS __attribute__((address_space(3)))
typedef unsigned short bf16;
typedef unsigned v4u __attribute__((ext_vector_type(4)));
typedef float f32x4 __attribute__((ext_vector_type(4)));
typedef short bf16x8 __attribute__((ext_vector_type(8)));
typedef GAS unsigned gu32;
typedef GAS unsigned long long gu64;
#define RLX_AGENT __ATOMIC_RELAXED, __HIP_MEMORY_SCOPE_AGENT
#define LDS_WAIT() asm volatile("s_waitcnt lgkmcnt(0)" ::: "memory")
#define VM_WAIT() asm volatile("s_waitcnt vmcnt(0)" ::: "memory")
__device__ __forceinline__ unsigned long long rt() { return __builtin_amdgcn_s_memrealtime(); }
__device__ __forceinline__ unsigned f2bf(float f) { unsigned u = __builtin_bit_cast(unsigned, f); return (u + 0x7fffu + ((u >> 16) & 1u)) >> 16; }
__device__ __forceinline__ unsigned pk2(float lo, float hi) { return f2bf(lo) | (f2bf(hi) << 16); }

#define XB_TMO      128
#define XB_XCNT(j)  (256  + 64 * (j))
#define XB_XSUB(j)  (1280 + 64 * (j))
#define XB_XGEN(j)  (2304 + 64 * (j))
#define XB_TOP      3328
#define XB_TOPGEN   3392
#define XCD_BAR_WORDS 3456
#define XB_SPIN_CAP (1u << 18)

__device__ __forceinline__ unsigned xb_ld(unsigned* p)              { return __hip_atomic_load(p, __ATOMIC_RELAXED, __HIP_MEMORY_SCOPE_AGENT); }
__device__ __forceinline__ unsigned xb_add(unsigned* p, unsigned v) { return __hip_atomic_fetch_add(p, v, __ATOMIC_RELAXED, __HIP_MEMORY_SCOPE_AGENT); }
__device__ __forceinline__ unsigned xb_xcc_id() { return (unsigned)__builtin_amdgcn_s_getreg((3 << 11) | 20) & 0xFu; }
#define XB_SPIN(cond, bar) do { unsigned _sp = 0; while (cond) { __builtin_amdgcn_s_sleep(1); \
    if ((++_sp & 255u) == 0u) { if (xb_ld(&(bar)[XB_TMO])) break; if (_sp > XB_SPIN_CAP) { atomicAdd(&(bar)[XB_TMO], 1u); break; } } } } while (0)

struct XcdBarrier {
    unsigned* bar; unsigned x;
    volatile LAS unsigned* st;
};

__device__ __forceinline__ XcdBarrier xcd_barrier_post(unsigned* bar, volatile LAS unsigned* st) {
    XcdBarrier b; b.bar = bar; b.x = xb_xcc_id(); b.st = st;
    if (threadIdx.x == 0) (void)xb_add(&bar[XB_XCNT(b.x)], 1u);
    return b;
}
__device__ __forceinline__ void xcd_barrier_complete(unsigned* bar, unsigned x, unsigned& nloc, unsigned& nx) {
    const unsigned G = gridDim.x * gridDim.y * gridDim.z;
    unsigned sum, cnt, mine, sp = 0u;
    for (;;) {
        sum = 0u; cnt = 0u; mine = 0u;
#pragma unroll
        for (unsigned j = 0; j < 16; ++j) { const unsigned c = xb_ld(&bar[XB_XCNT(j)]); sum += c; cnt += (c > 0u) ? 1u : 0u; mine = (j == x) ? c : mine; }
        if (sum == G) break;
        __builtin_amdgcn_s_sleep(1);
        if ((++sp & 255u) == 0u) { if (xb_ld(&bar[XB_TMO])) break; if (sp > XB_SPIN_CAP) { atomicAdd(&bar[XB_TMO], 1u); break; } }
    }
    nloc = mine > 0u ? mine : 1u; nx = cnt > 0u ? cnt : 1u;
}

__device__ __forceinline__ void xcd_barrier(const XcdBarrier& b) {
    asm volatile("s_waitcnt vmcnt(0)" ::: "memory");
    __syncthreads();
    if (threadIdx.x == 0) {
        unsigned* bar = b.bar;
        __builtin_amdgcn_s_waitcnt(0);
        unsigned nloc = b.st[0], nx = b.st[1];
        if (nloc == 0u) { xcd_barrier_complete(bar, b.x, nloc, nx); b.st[0] = nloc; b.st[1] = nx; }
        const unsigned old = xb_add(&bar[XB_XSUB(b.x)], 1u);
        const unsigned gen = old / nloc;
        if (old + 1u == (gen + 1u) * nloc) {
            __builtin_amdgcn_fence(__ATOMIC_RELEASE, "agent");
            asm volatile("s_waitcnt vmcnt(0)" ::: "memory");
            const unsigned og = xb_add(&bar[XB_TOP], 1u);
            const unsigned tg = og / nx;
            if (og + 1u == (tg + 1u) * nx) xb_add(&bar[XB_TOPGEN], 1u);
            else XB_SPIN(xb_ld(&bar[XB_TOPGEN]) == tg, bar);
            __builtin_amdgcn_fence(__ATOMIC_ACQUIRE, "agent");
            xb_add(&bar[XB_XGEN(b.x)], 1u);
            asm volatile("s_waitcnt vmcnt(0)" ::: "memory");
        } else {
            XB_SPIN(xb_ld(&bar[XB_XGEN(b.x)]) == gen, bar);
            __builtin_amdgcn_fence(__ATOMIC_ACQUIRE, "agent");
            asm volatile("s_waitcnt vmcnt(0)" ::: "memory");
        }
    }
    __syncthreads();
}

constexpr int NWAVES = 8;
constexpr int M = 16384, D = 1024, INC = 2560, AW = 512, LW = 512, NQ = 2048, NEXP = 16384;
constexpr float EPSN = 1e-6f;
constexpr size_t MiB = 1u << 20;
constexpr size_t WS_CTL = 0, CTL_ZERO_BYTES = 1 * MiB;
constexpr size_t WS_ROWSS2 = 512 * 1024;
constexpr size_t WS_RS1 = 1 * MiB;
constexpr size_t WS_SK1 = 1 * MiB + 128 * 1024, WS_SK2 = WS_SK1 + 32 * 1024;
constexpr size_t WS_WIN = 2 * MiB, WS_WOUT = 8 * MiB, WS_WQ = 10 * MiB;
constexpr size_t WS_ED = 16 * MiB, WS_EU = 48 * MiB;
constexpr size_t WS_SCD = 32 * MiB, WS_SCU = 33 * MiB;
constexpr size_t WS_WQ8 = 170 * MiB;
constexpr size_t WS_XB = 80 * MiB;
constexpr size_t WS_OS = 80 * MiB;
constexpr size_t WS_Q2 = 80 * MiB;
constexpr size_t WS_Q = 112 * MiB, WS_SPLIT = 16 * MiB;
constexpr size_t WS_GATE = WS_Q + 4 * WS_SPLIT;
constexpr size_t WS_EID = 144 * MiB, WS_GW = 152 * MiB;
constexpr size_t WS_MIX = 192 * MiB, WS_HB = 224 * MiB, WS_END = 256 * MiB;
constexpr size_t WS_ROWSS3 = 576 * 1024;
constexpr size_t WS_DOTP = 80 * MiB;
constexpr size_t WS_REC = 160 * MiB, WS_N0 = 168 * MiB;
constexpr size_t WS_PEER = 80 * MiB;
constexpr size_t WS_REC_OLD_UNUSED = 0;
constexpr int CW_BAR = 4096;
constexpr int RING_OFF = 0, RING_BYTES = 131072;
constexpr int LDSCTL_OFF = RING_BYTES, MISC_OFF = LDSCTL_OFF + 320;
constexpr int LDS_BYTES = 163840;

struct Frame {
    LAS unsigned char* lds;
    volatile LAS unsigned* MISC;
    int tid, lane, wave;
    int vcu, G;
};

__device__ __forceinline__ float wave_sum(float v) {
#pragma unroll
    for (int o = 1; o < 64; o <<= 1) v += __shfl_xor(v, o);
    return v;
}
__device__ __forceinline__ float bf2f(unsigned short b) { return __builtin_bit_cast(float, (unsigned)b << 16); }
__device__ __forceinline__ float bflo(unsigned w) { return __builtin_bit_cast(float, w << 16); }
__device__ __forceinline__ float bfhi(unsigned w) { return __builtin_bit_cast(float, w & 0xffff0000u); }
__device__ __forceinline__ float gelu_tanh(float x) { const float u = 0.7978845608028654f * (x + 0.044715f * x * x * x); return 0.5f * x * (1.0f + tanhf(u)); }
__device__ __forceinline__ float sigmoidf_(float x) { return 1.0f / (1.0f + expf(-x)); }
__device__ __forceinline__ float fsigmoid(float x) { return __builtin_amdgcn_rcpf(1.0f + __builtin_amdgcn_exp2f(-1.4426950408889634f * x)); }
__device__ __forceinline__ float fgelu_tanh(float x) { const float u = 0.7978845608028654f * (x + 0.044715f * x * x * x); const float t = 1.0f - 2.0f * __builtin_amdgcn_rcpf(1.0f + __builtin_amdgcn_exp2f(2.8853900817779268f * u)); return 0.5f * x * (1.0f + t); }

__device__ __forceinline__ void p0_transpose_item(const float* W, int K, int N, bf16* WT, const float* gk, LAS float* scr, int item, int lane) {
    const int nblk = N / 32, kb = item / nblk, nb = item % nblk, k0 = 64 * kb, n0 = 32 * nb;
#pragma unroll 8
    for (int i = 0; i < 32; ++i) { const int kk = 2 * i + (lane >> 5); const float g = gk ? gk[k0 + kk] : 1.0f; scr[kk * 33 + (lane & 31)] = W[(size_t)(k0 + kk) * N + n0 + (lane & 31)] * g; }
    LDS_WAIT(); asm volatile("" ::: "memory");
    const int c = lane & 7;
#pragma unroll
    for (int j = 0; j < 4; ++j) { const int n = (lane >> 3) + 8 * j; const LAS float* s = scr + (8 * c) * 33 + n;
        v4u o; o.x = pk2(s[0 * 33], s[1 * 33]); o.y = pk2(s[2 * 33], s[3 * 33]); o.z = pk2(s[4 * 33], s[5 * 33]); o.w = pk2(s[6 * 33], s[7 * 33]);
        *(GAS v4u*)(WT + (size_t)(n0 + n) * K + k0 + 8 * c) = o; }
    LDS_WAIT(); asm volatile("" ::: "memory");
}
template <int NR> __device__ __forceinline__ void p0_rows(const float* xrow, bf16* orow, const float* gk, float* rs, int lane) {
    f32x4 v[NR][4];
#pragma unroll
    for (int i = 0; i < NR; ++i)
#pragma unroll
        for (int j = 0; j < 4; ++j) v[i][j] = __builtin_nontemporal_load((const GAS f32x4*)(xrow + (size_t)i * 1024) + lane + 64 * j);
#pragma unroll
    for (int i = 0; i < NR; ++i) {
        if (rs) { float s = 0.f;
#pragma unroll
            for (int j = 0; j < 4; ++j) s += (v[i][j].x * v[i][j].x + v[i][j].y * v[i][j].y) + (v[i][j].z * v[i][j].z + v[i][j].w * v[i][j].w);
            const float tot = wave_sum(s); if (lane == 0) rs[i] = 1.0f / sqrtf(tot * (1.0f / 1024.0f) + EPSN); }
        if (gk) {
#pragma unroll
            for (int j = 0; j < 4; ++j) v[i][j] = v[i][j] * ((const GAS f32x4*)gk)[lane + 64 * j]; }
        GAS unsigned long long* o8 = (GAS unsigned long long*)(orow + (size_t)i * 1024) + lane;
#pragma unroll
        for (int j = 0; j < 4; ++j) o8[64 * j] = (unsigned long long)pk2(v[i][j].x, v[i][j].y) | ((unsigned long long)pk2(v[i][j].z, v[i][j].w) << 32);
    }
}

struct Args { const float* in[23]; float* out; unsigned char* ws; int ph_lo, ph_hi; };

__device__ __forceinline__ void p0_prologue(Frame& F, const Args& a) {
    LAS float* scr = (LAS float*)(F.lds + RING_OFF + F.wave * 16384);
    unsigned char* ws = a.ws;
    const int gw = F.vcu * NWAVES + F.wave, NGW = F.G * NWAVES;
    constexpr int I_IN = (D / 64) * (INC / 32), I_OUT = (D / 64) * (D / 32), I_Q = (D / 64) * (NQ / 32);
    constexpr int NITEMS = I_IN + I_OUT + I_Q;
    for (int it = gw; it < NITEMS; it += NGW) {
        int r = it;
        if (r < I_IN) { p0_transpose_item(a.in[2], D, INC, (bf16*)(ws + WS_WIN), a.in[1], scr, r, F.lane); continue; } r -= I_IN;
        if (r < I_OUT) { p0_transpose_item(a.in[15], D, D, (bf16*)(ws + WS_WOUT), nullptr, scr, r, F.lane); continue; } r -= I_OUT;
        p0_transpose_item(a.in[17], D, NQ, (bf16*)(ws + WS_WQ), a.in[16], scr, r, F.lane);
    }
    constexpr int NGRP = (M + 32) / 4;
    for (int m = gw; m < NGRP; m += NGW) {
        int r = 4 * m;
        if (r < M) { p0_rows<4>(a.in[0] + (size_t)r * D, (bf16*)(ws + WS_XB) + (size_t)r * D, nullptr, (float*)(ws + WS_RS1) + r, F.lane); continue; } r -= M;
        if (r < 16) { p0_rows<4>(a.in[18] + (size_t)r * 1024, (bf16*)(ws + WS_SK1) + (size_t)r * 1024, nullptr, nullptr, F.lane); continue; } r -= 16;
        p0_rows<4>(a.in[19] + (size_t)r * 1024, (bf16*)(ws + WS_SK2) + (size_t)r * 1024, nullptr, nullptr, F.lane);
    }
}
template <int NR> __device__ __forceinline__ void q8_load(f32x4 (&v)[NR][4], const float* xrow, int lane) {
#pragma unroll
    for (int i = 0; i < NR; ++i)
#pragma unroll
        for (int j = 0; j < 4; ++j) v[i][j] = __builtin_nontemporal_load((const GAS f32x4*)(xrow + (size_t)i * 1024) + lane + 64 * j);
}
template <int NR> __device__ __forceinline__ void q8_finish(f32x4 (&v)[NR][4], unsigned char* orow, const float* gk, float* scale, int lane) {
#pragma unroll
    for (int i = 0; i < NR; ++i) {
        float am = 0.f;
#pragma unroll
        for (int j = 0; j < 4; ++j) { if (gk) v[i][j] = v[i][j] * ((const GAS f32x4*)gk)[lane + 64 * j];
            am = fmaxf(fmaxf(am, fmaxf(fabsf(v[i][j].x), fabsf(v[i][j].y))), fmaxf(fabsf(v[i][j].z), fabsf(v[i][j].w))); }
#pragma unroll
        for (int o = 1; o < 64; o <<= 1) am = fmaxf(am, __shfl_xor(am, o));
        const float sc = (am > 0.f) ? am * (1.0f / 127.0f) : 1.0f, inv = 1.0f / sc;
        if (lane == 0) scale[i] = sc;
        GAS unsigned* o4 = (GAS unsigned*)(orow + (size_t)i * 1024) + lane;
#pragma unroll
        for (int j = 0; j < 4; ++j) { const int q0 = (int)__builtin_rintf(v[i][j].x * inv), q1 = (int)__builtin_rintf(v[i][j].y * inv), q2 = (int)__builtin_rintf(v[i][j].z * inv), q3 = (int)__builtin_rintf(v[i][j].w * inv);
            o4[64 * j] = ((unsigned)q0 & 255u) | (((unsigned)q1 & 255u) << 8) | (((unsigned)q2 & 255u) << 16) | ((unsigned)q3 << 24); }
    }
}
__device__ __forceinline__ const float* cvx_src(const Args& a, int m) { const int r = 4 * m; return (r < NEXP) ? a.in[20] + (size_t)r * D : a.in[21] + (size_t)(r - NEXP) * D; }
__device__ __forceinline__ void cvx_finish(const Args& a, f32x4 (&v)[4][4], int m, int lane) {
    unsigned char* ws = a.ws; const int r = 4 * m;
    if (r < NEXP) q8_finish<4>(v, ws + WS_ED + (size_t)r * D, a.in[16], (float*)(ws + WS_SCD) + r, lane);
    else          q8_finish<4>(v, ws + WS_EU + (size_t)(r - NEXP) * D, nullptr, (float*)(ws + WS_SCU) + (r - NEXP), lane);
}
__device__ __forceinline__ void convert_experts(const Args& a, int w, int nw, int lane) {
    constexpr int TOT = NEXP / 4;
    int m = w; if (m >= TOT) return;
    f32x4 va[4][4], vb[4][4];
    q8_load<4>(va, cvx_src(a, m), lane);
    for (;;) {
        const bool hb = m + nw < TOT; if (hb) q8_load<4>(vb, cvx_src(a, m + nw), lane);
        cvx_finish(a, va, m, lane);
        if (!hb) break;
        const bool ha = m + 2 * nw < TOT; if (ha) q8_load<4>(va, cvx_src(a, m + 2 * nw), lane);
        cvx_finish(a, vb, m + nw, lane);
        if (!ha) break;
        m += 2 * nw;
    }
}

typedef float f32x16 __attribute__((ext_vector_type(16)));
__device__ __forceinline__ void lru_local_unit(Frame& F, const Args& a, int c) {
    constexpr int YP = 520;
    LAS unsigned short* Y = (LAS unsigned short*)(F.lds + RING_OFF);
    const int e = F.tid, r0 = c * 64;
    const bf16* XR = (const bf16*)(a.ws + WS_Q + 3 * WS_SPLIT);
    float* HL = a.out; float* AC = a.out + (size_t)M * 512;
    { const float* conv_w = a.in[8]; const float cw0 = conv_w[e], cw1 = conv_w[512 + e], cw2 = conv_w[1024 + e], cw3 = conv_w[1536 + e], cb = a.in[9][e];
      float x0 = 0.f, x1 = 0.f, x2 = 0.f;
      if (c > 0) { x0 = bf2f(XR[(size_t)(r0 - 3) * 512 + e]); x1 = bf2f(XR[(size_t)(r0 - 2) * 512 + e]); x2 = bf2f(XR[(size_t)(r0 - 1) * 512 + e]); }
#pragma unroll 8
      for (int t = 0; t < 64; ++t) { const float x3 = bf2f(XR[(size_t)(r0 + t) * 512 + e]); Y[t * YP + e] = (unsigned short)f2bf(cb + x0 * cw0 + x1 * cw1 + x2 * cw2 + x3 * cw3); x0 = x1; x1 = x2; x2 = x3; } }
    __syncthreads();
    const int n = F.wave, lane = F.lane, r32 = lane & 31, hi = lane >> 5;
#pragma unroll 1
    for (int et = 0; et < 2; ++et) {
        bf16x8 wf[2][4];
#pragma unroll
        for (int gt = 0; gt < 2; ++gt) { const float* w = a.in[gt ? 12 : 10] + n * 4096 + 32 * et; asm volatile("" : "+s"(w));
#pragma unroll
            for (int ks = 0; ks < 4; ++ks) { float f[8];
#pragma unroll
                for (int j = 0; j < 8; ++j) f[j] = w[(16 * ks + 8 * hi + j) * 64 + r32];
                wf[gt][ks] = __builtin_bit_cast(bf16x8, (v4u){pk2(f[0], f[1]), pk2(f[2], f[3]), pk2(f[4], f[5]), pk2(f[6], f[7])}); asm volatile("" ::: "memory"); } }
        const int ch = 64 * n + 32 * et + r32;
        const float ba = a.in[11][ch], bx = a.in[13][ch], lam = a.in[14][ch];
        const float sp = (lam > 15.f) ? expf(-lam) : log1pf(expf(-lam));
        float av[2][16], bv[2][16];
#pragma unroll
        for (int tt = 0; tt < 2; ++tt) {
            f32x16 ra = {}, ia = {};
#pragma unroll
            for (int ks = 0; ks < 4; ++ks) { const bf16x8 af = *(const LAS bf16x8*)(Y + (32 * tt + r32) * YP + 64 * n + 16 * ks + 8 * hi);
                ra = __builtin_amdgcn_mfma_f32_32x32x16_bf16(af, wf[0][ks], ra, 0, 0, 0); ia = __builtin_amdgcn_mfma_f32_32x32x16_bf16(af, wf[1][ks], ia, 0, 0, 0); }
#pragma unroll
            for (int r = 0; r < 16; ++r) { const int t = 32 * tt + (r & 3) + 8 * (r >> 2) + 4 * hi;
                const float rr = fsigmoid(ra[r] + ba), ii = fsigmoid(ia[r] + bx);
                const float log_a = -8.0f * rr * sp, aa = __builtin_amdgcn_exp2f(log_a * 1.4426950408889634f);
                const float u2 = 2.0f * log_a;
                const float ser = -u2 * (1.0f + u2 * (0.5f + u2 * (0.16666667f + u2 * (0.041666668f + u2 * 0.0083333338f))));
                const float om = (u2 > -0.1f) ? ser : (1.0f - aa * aa);
                const float mult = __builtin_amdgcn_sqrtf(fmaxf(om, 1e-12f));
                av[tt][r] = aa; bv[tt][r] = mult * (ii * bf2f(Y[t * YP + ch])); }
        }
#pragma unroll
        for (int tt = 0; tt < 2; ++tt)
#pragma unroll
            for (int rq = 0; rq < 4; ++rq) { float h = 0.f, pa = 1.f;
#pragma unroll
                for (int k = 0; k < 4; ++k) { const int r = 4 * rq + k; h = av[tt][r] * h + bv[tt][r]; pa *= av[tt][r]; bv[tt][r] = h; av[tt][r] = pa; } }
        float hin[8], ain[8]; float hc = 0.f, ac = 1.f;
#pragma unroll
        for (int j = 0; j < 8; ++j) { const int tt = j >> 2, r3 = 4 * (j & 3) + 3;
#pragma unroll
            for (int own = 0; own < 2; ++own) {
                if (hi == own) { hin[j] = hc; ain[j] = ac; }
                const float mh = av[tt][r3] * hc + bv[tt][r3], ma = ac * av[tt][r3];
                const float oh = __shfl_xor(mh, 32), oa = __shfl_xor(ma, 32);
                hc = (hi == own) ? mh : oh; ac = (hi == own) ? ma : oa; } }
#pragma unroll
        for (int tt = 0; tt < 2; ++tt)
            { unsigned ob = (unsigned)((r0 + 32 * tt + 4 * hi) * 512 + ch); asm volatile("" : "+v"(ob));
#pragma unroll
            for (int r = 0; r < 16; ++r) { const int j = 4 * tt + (r >> 2); const unsigned o = ob + (unsigned)(((r & 3) + 8 * (r >> 2)) * 512);
                HL[o] = bv[tt][r] + av[tt][r] * hin[j]; AC[o] = av[tt][r] * ain[j]; } }
    }
    __syncthreads();
}

__device__ __forceinline__ void fix_unit(Frame& F, const Args& a, int c, float lamv) {
    const int r0 = c * 64;
    const float* HL = a.out; const float* AC = a.out + (size_t)M * 512;
    const bf16* GATE = (const bf16*)(a.ws + WS_GATE);
    bf16* MIX = (bf16*)(a.ws + WS_MIX);
    const int g4 = F.tid & 127, sgm = F.tid >> 7;
    LAS f32x4* SA = (LAS f32x4*)(F.lds + RING_OFF); LAS f32x4* SH = SA + 512;
    { const int L = (c + 3) >> 2; const int lo_c = sgm * L; int hi_c = lo_c + L; if (hi_c > c) hi_c = c;
      f32x4 A4 = (f32x4){1.f, 1.f, 1.f, 1.f}, H4 = (f32x4){0.f, 0.f, 0.f, 0.f};
      int cc = lo_c;
      for (; cc + 8 <= hi_c; cc += 8) { f32x4 av[8], hv[8];
#pragma unroll
          for (int k = 0; k < 8; ++k) { const size_t o = (size_t)((cc + k) * 64 + 63) * 512 + 4 * g4; av[k] = *(const GAS f32x4*)(AC + o); hv[k] = *(const GAS f32x4*)(HL + o); }
#pragma unroll
          for (int k = 0; k < 8; ++k) { H4 = av[k] * H4 + hv[k]; A4 = A4 * av[k]; } }
      for (; cc < hi_c; ++cc) { const size_t o = (size_t)(cc * 64 + 63) * 512 + 4 * g4; const f32x4 av = *(const GAS f32x4*)(AC + o), hv = *(const GAS f32x4*)(HL + o); H4 = av * H4 + hv; A4 = A4 * av; }
      SA[sgm * 128 + g4] = A4; SH[sgm * 128 + g4] = H4; }
    __syncthreads();
    f32x4 hin = (f32x4){0.f, 0.f, 0.f, 0.f};
#pragma unroll
    for (int sq = 0; sq < 4; ++sq) hin = SA[sq * 128 + g4] * hin + SH[sq * 128 + g4];
    __syncthreads();
#pragma unroll 4
    for (int t = sgm * 16; t < sgm * 16 + 16; ++t) { const size_t o = (size_t)(r0 + t) * 512 + 4 * g4;
        const f32x4 h = *(const GAS f32x4*)(HL + o) + *(const GAS f32x4*)(AC + o) * hin; const unsigned long long gw = *(const GAS unsigned long long*)(GATE + o);
        const unsigned glo = (unsigned)gw, ghi = (unsigned)(gw >> 32);
        const unsigned long long ov = (unsigned long long)pk2(h.x * fgelu_tanh(bflo(glo)), h.y * fgelu_tanh(bfhi(glo))) | ((unsigned long long)pk2(h.z * fgelu_tanh(bflo(ghi)), h.w * fgelu_tanh(bfhi(ghi))) << 32);
        *(GAS unsigned long long*)(MIX + (size_t)(r0 + t) * 1024 + 512 + 4 * g4) = ov; }
    const bf16* OS0 = (const bf16*)(a.ws + WS_OS); const bf16* OS1 = OS0 + (size_t)M * 512;
    const float* sg = a.in[7] + (F.lane & 15) * 8;
    float sgv[8];
#pragma unroll
    for (int j = 0; j < 8; ++j) sgv[j] = sg[j] * 0.8f;
#pragma unroll 2
    for (int rr = 0; rr < 8; ++rr) { const size_t row = (size_t)(r0 + 8 * F.wave + rr);
        const v4u p = *(const GAS v4u*)(OS0 + row * 512 + F.lane * 8), q = *(const GAS v4u*)(OS1 + row * 512 + F.lane * 8);
        float d[8];
        d[0] = bflo(p.x) - lamv * bflo(q.x); d[1] = bfhi(p.x) - lamv * bfhi(q.x); d[2] = bflo(p.y) - lamv * bflo(q.y); d[3] = bfhi(p.y) - lamv * bfhi(q.y);
        d[4] = bflo(p.z) - lamv * bflo(q.z); d[5] = bfhi(p.z) - lamv * bfhi(q.z); d[6] = bflo(p.w) - lamv * bflo(q.w); d[7] = bfhi(p.w) - lamv * bfhi(q.w);
        float ss = 0.f;
#pragma unroll
        for (int j = 0; j < 8; ++j) ss += d[j] * d[j];
        ss += __shfl_xor(ss, 1); ss += __shfl_xor(ss, 2); ss += __shfl_xor(ss, 4); ss += __shfl_xor(ss, 8);
        const float ri = 1.0f / sqrtf(ss * (1.0f / 128.0f) + EPSN);
        v4u o; o.x = pk2(d[0] * ri * sgv[0], d[1] * ri * sgv[1]); o.y = pk2(d[2] * ri * sgv[2], d[3] * ri * sgv[3]);
        o.z = pk2(d[4] * ri * sgv[4], d[5] * ri * sgv[5]); o.w = pk2(d[6] * ri * sgv[6], d[7] * ri * sgv[7]);
        *(GAS v4u*)(MIX + row * 1024 + F.lane * 8) = o; }
}

typedef float f32x16 __attribute__((ext_vector_type(16)));
#define CEX(a, b) do { const float _hi = fmaxf(a, b), _lo = fminf(a, b); a = _hi; b = _lo; } while (0)
__device__ __forceinline__ int skey(int b) { return b ^ ((b >> 31) & 0x7fffffff); }
#define CEI(a, b) do { const int _hi = max(a, b), _lo = min(a, b); a = _hi; b = _lo; } while (0)
__device__ __forceinline__ void sort16_desc(int (&v)[16]) {
#pragma unroll
    for (int k = 2; k <= 16; k <<= 1)
#pragma unroll
        for (int j = k >> 1; j >= 1; j >>= 1)
#pragma unroll
            for (int i = 0; i < 16; ++i) { const int l = i ^ j; if (l > i) { if ((i & k) == 0) CEI(v[i], v[l]); else CEI(v[l], v[i]); } }
}
__device__ __forceinline__ void merge16_desc(int (&a)[16], const int (&b)[16]) {
#pragma unroll
    for (int i = 0; i < 16; ++i) a[i] = max(a[i], b[15 - i]);
#pragma unroll
    for (int j = 8; j >= 1; j >>= 1)
#pragma unroll
        for (int i = 0; i < 16; ++i) if ((i & j) == 0) CEI(a[i], a[i + j]);
}
__device__ __forceinline__ void top16_half(int (&top)[16], const bf16* q, const LAS unsigned char* sk, int r32, int hi) {
    bf16x8 qf[8];
#pragma unroll
    for (int ks = 0; ks < 8; ++ks) qf[ks] = *(const GAS bf16x8*)(q + 16 * ks + 8 * hi);
#pragma unroll
    for (int i = 0; i < 16; ++i) top[i] = (int)0x80000000;
#pragma unroll 1
    for (int kt = 0; kt < 4; ++kt) {
        f32x16 acc = {};
#pragma unroll
        for (int ks = 0; ks < 8; ++ks) { const bf16x8 kf = *(const LAS bf16x8*)(sk + (32 * kt + r32) * 272 + (16 * ks + 8 * hi) * 2); acc = __builtin_amdgcn_mfma_f32_32x32x16_bf16(kf, qf[ks], acc, 0, 0, 0); }
        int grp[16];
#pragma unroll
        for (int r = 0; r < 16; ++r) { const int idx = 32 * kt + (r & 3) + 8 * (r >> 2) + 4 * hi; const float av = acc[r];
            grp[r] = (skey(__float_as_int(av)) & ~127) | idx; }
        sort16_desc(grp); merge16_desc(top, grp);
    }
    int oth[16];
#pragma unroll
    for (int i = 0; i < 16; ++i) oth[i] = __shfl_xor(top[i], 32);
    merge16_desc(top, oth);
}
__device__ __forceinline__ void route_unit(const Args& a, int g, int hd, int lane, LAS unsigned char* slot, const LAS unsigned char* skl, int* EIDo, float* GWo) {
    const int r32 = lane & 31, hi = lane >> 5; const int t = g * 32 + r32;
    const bf16* q = (const bf16*)(a.ws + WS_Q2) + (size_t)t * NQ + hd * 256;
    int k1[16], k2[16];
    top16_half(k1, q, skl, r32, hi);
    top16_half(k2, q + 128, skl + 128 * 272, r32, hi);
    { v4u w1, w2;
#define IDX4(v, j) (((unsigned)v[4 * (j)] & 127u) | (((unsigned)v[4 * (j) + 1] & 127u) << 8) | (((unsigned)v[4 * (j) + 2] & 127u) << 16) | (((unsigned)v[4 * (j) + 3] & 127u) << 24))
      w1 = (v4u){IDX4(k1, 0), IDX4(k1, 1), IDX4(k1, 2), IDX4(k1, 3)}; w2 = (v4u){IDX4(k2, 0), IDX4(k2, 1), IDX4(k2, 2), IDX4(k2, 3)};
#undef IDX4
      *(LAS v4u*)(slot) = w1; *(LAS v4u*)(slot + 16) = w2; }
    float v1[16], v2[16];
#pragma unroll
    for (int i = 0; i < 16; ++i) { v1[i] = __int_as_float(skey(k1[i])); v2[i] = __int_as_float(skey(k2[i])); }
#define CKEY(ia, ib) ((skey(__float_as_int(v1[ia] + v2[ib])) & ~255) | ((ia) * 16 + (ib)))
    int K[16], G1[16], G2[16];
#pragma unroll
    for (int i = 0; i < 16; ++i) K[i] = CKEY(0, i);
    { int n_ = 0;
#pragma unroll
      for (int ia = 1; ia < 16; ++ia)
#pragma unroll
          for (int ib = 0; ib < 16; ++ib) if ((ia + 1) * (ib + 1) <= 16) { const int kk = CKEY(ia, ib); if (n_ < 16) G1[n_] = kk; else if (n_ < 32) G2[n_ - 16] = kk; ++n_; }
    }
    sort16_desc(G1); merge16_desc(K, G1);
    sort16_desc(G2); merge16_desc(K, G2);
    { int x0 = CKEY(14, 0), x1 = CKEY(15, 0);
#pragma unroll
      for (int i = 0; i < 16; ++i) { CEI(K[i], x0); }
#pragma unroll
      for (int i = 0; i < 16; ++i) { CEI(K[i], x1); }
    }
#undef CKEY
    unsigned P[16]; float sc[16];
#pragma unroll
    for (int i = 0; i < 16; ++i) { const unsigned ci = (unsigned)K[i] & 255u; const unsigned i1 = slot[ci >> 4], i2 = slot[16 + (ci & 15u)]; P[i] = i1 * 128u + i2; sc[i] = __int_as_float(skey(K[i] & ~255)); }
    float ex[16], sum = 0.f;
#pragma unroll
    for (int i = 0; i < 16; ++i) { ex[i] = expf(sc[i] - sc[0]); sum += ex[i]; }
    const float inv = 1.0f / sum;
    if (hi == 0) {
        GAS v4u* eo = (GAS v4u*)(EIDo + (size_t)t * 128 + hd * 16); GAS f32x4* go = (GAS f32x4*)(GWo + (size_t)t * 128 + hd * 16);
#pragma unroll
        for (int j = 0; j < 4; ++j) { eo[j] = (v4u){P[4 * j], P[4 * j + 1], P[4 * j + 2], P[4 * j + 3]}; go[j] = (f32x4){ex[4 * j] * inv, ex[4 * j + 1] * inv, ex[4 * j + 2] * inv, ex[4 * j + 3] * inv}; }
    }
}

__device__ __forceinline__ float wave_max(float v) {
#pragma unroll
    for (int o = 1; o < 64; o <<= 1) v = fmaxf(v, __shfl_xor(v, o));
    return v;
}
__device__ __forceinline__ void route_unit_ref(const Args& a, int t, int hd, int lane, LAS float* sc) {
    LAS unsigned* sci = (LAS unsigned*)sc;
    const bf16* q = (const bf16*)(a.ws + WS_Q2) + (size_t)t * NQ + hd * 256;
#pragma unroll 1
    for (int half = 0; half < 2; ++half) {
        const float* sk = a.in[18 + half];
        float sa = 0.f, sb = 0.f;
        for (int d = 0; d < 128; ++d) { const float qv = bf2f(q[half * 128 + d]); sa += qv * sk[lane * 128 + d]; sb += qv * sk[(lane + 64) * 128 + d]; }
        for (int r = 0; r < 16; ++r) {
            const float mx = wave_max(fmaxf(sa, sb));
            const unsigned long long ba = __ballot(sa == mx), bb = __ballot(sb == mx);
            int key;
            if (ba) { const int ln = __ffsll((long long)ba) - 1; key = ln; if (lane == ln) sa = -INFINITY; }
            else { const int ln = __ffsll((long long)bb) - 1; key = ln + 64; if (lane == ln) sb = -INFINITY; }
            if (lane == 0) { sc[half * 32 + r] = mx; sci[half * 32 + 16 + r] = (unsigned)key; }
        }
    }
    __builtin_amdgcn_s_waitcnt(0);
    const int ca = lane >> 2, cb0 = (lane & 3) * 4;
    float c[4];
#pragma unroll
    for (int j = 0; j < 4; ++j) c[j] = sc[ca] + sc[32 + cb0 + j];
    for (int r = 0; r < 16; ++r) {
        const float mx = wave_max(fmaxf(fmaxf(c[0], c[1]), fmaxf(c[2], c[3])));
        const bool mine = (c[0] == mx) || (c[1] == mx) || (c[2] == mx) || (c[3] == mx);
        const unsigned long long bm = __ballot(mine); const int ln = __ffsll((long long)bm) - 1;
        if (lane == ln) { int j = (c[0] == mx) ? 0 : (c[1] == mx) ? 1 : (c[2] == mx) ? 2 : 3;
            if (j == 0) c[0] = -INFINITY; else if (j == 1) c[1] = -INFINITY; else if (j == 2) c[2] = -INFINITY; else c[3] = -INFINITY;
            sc[64 + r] = mx; sci[80 + r] = sci[16 + ca] * 128u + sci[48 + cb0 + j]; }
    }
    __builtin_amdgcn_s_waitcnt(0);
    if (lane < 16) {
        const float mx0 = sc[64]; const float ex = expf(sc[64 + lane] - mx0); float sum = ex;
        sum += __shfl_xor(sum, 1); sum += __shfl_xor(sum, 2); sum += __shfl_xor(sum, 4); sum += __shfl_xor(sum, 8);
        ((int*)(a.ws + WS_EID))[(size_t)t * 128 + hd * 16 + lane] = (int)sci[80 + lane];
        ((float*)(a.ws + WS_GW))[(size_t)t * 128 + hd * 16 + lane] = ex / sum;
    }
    __builtin_amdgcn_s_waitcnt(0);
}

__device__ __forceinline__ void unpack8(const v4u w, float* f) { f[0] = bflo(w.x); f[1] = bfhi(w.x); f[2] = bflo(w.y); f[3] = bfhi(w.y); f[4] = bflo(w.z); f[5] = bfhi(w.z); f[6] = bflo(w.w); f[7] = bfhi(w.w); }
__device__ __forceinline__ void gather_token(const Args& a, int t, int lane, float* dst) {
    const bf16* HB = (const bf16*)(a.ws + WS_HB) + (size_t)t * D; const bf16* ED = (const bf16*)(a.ws + WS_ED); const bf16* EU = (const bf16*)(a.ws + WS_EU);
    float hx[16];
    unpack8(*(const GAS v4u*)(HB + lane * 8), hx); unpack8(*(const GAS v4u*)(HB + 512 + lane * 8), hx + 8);
    const float rs2 = 1.0f / sqrtf(((const float*)(a.ws + WS_ROWSS2))[t] * (1.0f / 1024.0f) + EPSN);
    const int* EID = (const int*)(a.ws + WS_EID) + (size_t)t * 128; const float* GW = (const float*)(a.ws + WS_GW) + (size_t)t * 128;
    const int e0 = EID[lane], e1 = EID[64 + lane]; const float g0 = GW[lane], g1 = GW[64 + lane];
    float acc[16];
#pragma unroll
    for (int i = 0; i < 16; ++i) acc[i] = 0.f;
#pragma unroll 1
    for (int j = 0; j < 128; j += 4) {
        int ee[4]; float gg[4], dt[4];
#pragma unroll
        for (int k = 0; k < 4; ++k) { const int jj = j + k; ee[k] = __shfl(jj < 64 ? e0 : e1, jj & 63); gg[k] = __shfl(jj < 64 ? g0 : g1, jj & 63); }
        v4u da[4], db[4];
#pragma unroll
        for (int k = 0; k < 4; ++k) { const bf16* r = ED + (size_t)ee[k] * D; da[k] = *(const GAS v4u*)(r + lane * 8); db[k] = *(const GAS v4u*)(r + 512 + lane * 8); }
#pragma unroll
        for (int k = 0; k < 4; ++k) { float f[16]; unpack8(da[k], f); unpack8(db[k], f + 8); float s = 0.f;
#pragma unroll
            for (int i = 0; i < 16; ++i) s += f[i] * hx[i];
            dt[k] = s; }
#pragma unroll
        for (int o = 1; o < 64; o <<= 1) {
#pragma unroll
            for (int k = 0; k < 4; ++k) dt[k] += __shfl_xor(dt[k], o); }
#pragma unroll
        for (int k = 0; k < 4; ++k) { const bf16* r = EU + (size_t)ee[k] * D; da[k] = *(const GAS v4u*)(r + lane * 8); db[k] = *(const GAS v4u*)(r + 512 + lane * 8); }
#pragma unroll
        for (int k = 0; k < 4; ++k) { const float w = gg[k] * gelu_tanh(dt[k] * rs2); float f[16]; unpack8(da[k], f); unpack8(db[k], f + 8);
#pragma unroll
            for (int i = 0; i < 16; ++i) acc[i] += w * f[i]; }
    }
    const float* orow = a.out + (size_t)t * D; float* drow = dst + (size_t)t * D; const float* gf = a.in[22];
    f32x4 h0 = *(const GAS f32x4*)(orow + lane * 8), h1 = *(const GAS f32x4*)(orow + lane * 8 + 4), h2 = *(const GAS f32x4*)(orow + 512 + lane * 8), h3 = *(const GAS f32x4*)(orow + 512 + lane * 8 + 4);
    h0 += (f32x4){acc[0], acc[1], acc[2], acc[3]}; h1 += (f32x4){acc[4], acc[5], acc[6], acc[7]}; h2 += (f32x4){acc[8], acc[9], acc[10], acc[11]}; h3 += (f32x4){acc[12], acc[13], acc[14], acc[15]};
    float ss = (h0.x * h0.x + h0.y * h0.y) + (h0.z * h0.z + h0.w * h0.w) + (h1.x * h1.x + h1.y * h1.y) + (h1.z * h1.z + h1.w * h1.w)
             + (h2.x * h2.x + h2.y * h2.y) + (h2.z * h2.z + h2.w * h2.w) + (h3.x * h3.x + h3.y * h3.y) + (h3.z * h3.z + h3.w * h3.w);
    ss = wave_sum(ss);
    const float ri = 1.0f / sqrtf(ss * (1.0f / 1024.0f) + EPSN);
    const f32x4 f0 = *(const GAS f32x4*)(gf + lane * 8), f1 = *(const GAS f32x4*)(gf + lane * 8 + 4), f2 = *(const GAS f32x4*)(gf + 512 + lane * 8), f3 = *(const GAS f32x4*)(gf + 512 + lane * 8 + 4);
    *(GAS f32x4*)(drow + lane * 8) = h0 * ri * f0; *(GAS f32x4*)(drow + lane * 8 + 4) = h1 * ri * f1;
    *(GAS f32x4*)(drow + 512 + lane * 8) = h2 * ri * f2; *(GAS f32x4*)(drow + 512 + lane * 8 + 4) = h3 * ri * f3;
}


template <int CTRL> __device__ __forceinline__ float dpp_add(float v) { return v + __int_as_float(__builtin_amdgcn_update_dpp(0, __float_as_int(v), CTRL, 0xf, 0xf, false)); }
__device__ __forceinline__ float row16_sum(float v) { v = dpp_add<0x140>(v); v = dpp_add<0x141>(v); v = dpp_add<0x4E>(v); v = dpp_add<0xB1>(v); return v; }
__device__ __forceinline__ unsigned long long lanemask_lt(int lane) { return (1ull << lane) - 1ull; }
__device__ __forceinline__ void glds16g(const void* gsrc, unsigned lds_dst) { unsigned keep;
    asm volatile("s_mov_b32 %0, m0\n\ts_mov_b32 m0, %2\n\ts_nop 0\n\tglobal_load_lds_dwordx4 %1, off\n\ts_mov_b32 m0, %0" : "=&s"(keep) : "v"(gsrc), "s"(lds_dst) : "memory"); }

__device__ __forceinline__ void glds16x4(const void* sbase, unsigned o0, unsigned o1, unsigned o2, unsigned o3, unsigned d0, unsigned d1, unsigned d2, unsigned d3) { unsigned keep;
    asm volatile("s_mov_b32 %0, m0\n\ts_mov_b32 m0, %6\n\ts_nop 0\n\tglobal_load_lds_dwordx4 %1, %5\n\ts_mov_b32 m0, %7\n\ts_nop 0\n\tglobal_load_lds_dwordx4 %2, %5\n\t"
                 "s_mov_b32 m0, %8\n\ts_nop 0\n\tglobal_load_lds_dwordx4 %3, %5\n\ts_mov_b32 m0, %9\n\ts_nop 0\n\tglobal_load_lds_dwordx4 %4, %5\n\ts_mov_b32 m0, %0"
                 : "=&s"(keep) : "v"(o0), "v"(o1), "v"(o2), "v"(o3), "s"(sbase), "s"(d0), "s"(d1), "s"(d2), "s"(d3) : "memory"); }
typedef __bf16 bf2_t __attribute__((ext_vector_type(2)));
__device__ __forceinline__ float dot2bf(unsigned a, unsigned b, float c) { return __builtin_amdgcn_fdot2_f32_bf16(__builtin_bit_cast(bf2_t, a), __builtin_bit_cast(bf2_t, b), c, false); }
__device__ __forceinline__ void compact_token(const Args& a, int t, int lane) {
    const int* EID = (const int*)(a.ws + WS_EID) + (size_t)t * 128; const float* GW = (const float*)(a.ws + WS_GW) + (size_t)t * 128;
    const int e0 = EID[lane], e1 = EID[64 + lane]; const float g0 = GW[lane], g1 = GW[64 + lane];
    const bool p0 = e0 < 8192, p1 = e1 < 8192;
    const unsigned long long m0 = __ballot(p0), m1 = __ballot(p1), lt = lanemask_lt(lane);
    const int c0 = __popcll(m0), n0 = c0 + __popcll(m1);
    const int pos0 = p0 ? __popcll(m0 & lt) : n0 + __popcll(~m0 & lt);
    const int pos1 = p1 ? c0 + __popcll(m1 & lt) : n0 + (64 - c0) + __popcll(~m1 & lt);
    unsigned* R = (unsigned*)(a.ws + WS_REC) + (size_t)t * 128;
    R[pos0] = (unsigned)e0 | (f2bf(g0) << 16); R[pos1] = (unsigned)e1 | (f2bf(g1) << 16);
    if (lane == 0) ((int*)(a.ws + WS_N0))[t] = n0;
}
template <int NT> __device__ __forceinline__ void w_tokens(const Args& a, int t0, int lane) {
    float d0[NT], d1[NT], sd0[NT], sd1[NT], su0[NT], su1[NT]; unsigned r0[NT], r1[NT]; float ss[NT];
#pragma unroll
    for (int i = 0; i < NT; ++i) { const float* DP = (const float*)(a.ws + WS_DOTP) + (size_t)(t0 + i) * 1024; const unsigned* R = (const unsigned*)(a.ws + WS_REC) + (size_t)(t0 + i) * 128;
        float p0[8], p1[8];
#pragma unroll
        for (int x = 0; x < 8; ++x) { p0[x] = DP[x * 128 + lane]; p1[x] = DP[x * 128 + 64 + lane]; }
        r0[i] = R[lane]; r1[i] = R[64 + lane]; ss[i] = ((const float*)(a.ws + WS_ROWSS2))[t0 + i];
        sd0[i] = ((const float*)(a.ws + WS_SCD))[r0[i] & 0x3fffu]; sd1[i] = ((const float*)(a.ws + WS_SCD))[r1[i] & 0x3fffu];
        su0[i] = ((const float*)(a.ws + WS_SCU))[r0[i] & 0x3fffu]; su1[i] = ((const float*)(a.ws + WS_SCU))[r1[i] & 0x3fffu];
        d0[i] = ((p0[0] + p0[1]) + (p0[2] + p0[3])) + ((p0[4] + p0[5]) + (p0[6] + p0[7])); d1[i] = ((p1[0] + p1[1]) + (p1[2] + p1[3])) + ((p1[4] + p1[5]) + (p1[6] + p1[7])); }
#pragma unroll
    for (int i = 0; i < NT; ++i) { const float rs2 = 1.0f / sqrtf(ss[i] * (1.0f / 1024.0f) + EPSN);
        const float w0 = bfhi(r0[i]) * fgelu_tanh(d0[i] * sd0[i] * rs2) * su0[i], w1 = bfhi(r1[i]) * fgelu_tanh(d1[i] * sd1[i] * rs2) * su1[i];
        float m0 = fabsf(w0), m1 = fabsf(w1);
#pragma unroll
        for (int o = 1; o < 64; o <<= 1) { m0 = fmaxf(m0, __shfl_xor(m0, o)); m1 = fmaxf(m1, __shfl_xor(m1, o)); }
        const float s0 = (m0 > 0.f) ? m0 * (1.0f / 127.0f) : 1.0f, s1 = (m1 > 0.f) ? m1 * (1.0f / 127.0f) : 1.0f;
        unsigned char* WQ = a.ws + WS_WQ8 + (size_t)(t0 + i) * 144;
        WQ[lane] = (unsigned char)((int)__builtin_rintf(w0 / s0) & 255); WQ[64 + lane] = (unsigned char)((int)__builtin_rintf(w1 / s1) & 255);
        if (lane == 0) { ((float*)(WQ + 128))[0] = s0; ((float*)(WQ + 128))[1] = s1; } }
}
template <bool IS_UP> __device__ __forceinline__ void sweep_slice(const Args& a, int x, int wv, int lane, unsigned ring, LAS unsigned char* ringp, unsigned aux, LAS unsigned char* auxp) {
    const int g = lane >> 4, li = lane & 15, n16 = li, kg = g;
    const char* TABx = (const char*)(a.ws + (IS_UP ? WS_EU : WS_ED)) + x * 256;
    unsigned jofs[4];
#pragma unroll
    for (int q = 0; q < 4; ++q) jofs[q] = (unsigned)((li ^ ((g << 2) | q)) * 16);
    const unsigned pd = (unsigned)__builtin_amdgcn_readfirstlane(ring);
#pragma unroll 1
    for (int s_ = 0; s_ < 128; ++s_) {
        const int r = s_ >> 6, k = s_ & 63, t = wv * 64 + k, base = 64 * r;
        const LAS unsigned* rec = (const LAS unsigned*)(auxp + (k & 3) * 512) + base;
        const LAS unsigned char* hp = auxp + 2048 + (k & 3) * 256;
        asm volatile("s_waitcnt lgkmcnt(0)" ::: "memory");
        if ((k & 3) == 0) {
            const char* rsrc = (const char*)(a.ws + WS_REC) + (size_t)t * 512 + lane * 16;
            glds16g(rsrc, (unsigned)__builtin_amdgcn_readfirstlane(aux)); glds16g(rsrc + 1024, (unsigned)__builtin_amdgcn_readfirstlane(aux + 1024));
            if (!IS_UP) glds16g((const char*)(a.ws + WS_HB) + (size_t)(t + g) * 2048 + x * 256 + li * 16, (unsigned)__builtin_amdgcn_readfirstlane(aux + 2048));
            asm volatile("s_waitcnt vmcnt(0)" ::: "memory");
        }
        {
            unsigned so[16];
#pragma unroll
            for (int p = 0; p < 16; ++p) so[p] = rec[4 * p + g];
#pragma unroll
            for (int p = 0; p < 16; ++p) so[p] = ((so[p] & 0x3fffu) << 11) + jofs[p & 3];
            glds16x4(TABx, so[0], so[1], so[2], so[3], pd, pd + 1024u, pd + 2048u, pd + 3072u);
            glds16x4(TABx, so[4], so[5], so[6], so[7], pd + 4096u, pd + 5120u, pd + 6144u, pd + 7168u);
            glds16x4(TABx, so[8], so[9], so[10], so[11], pd + 8192u, pd + 9216u, pd + 10240u, pd + 11264u);
            glds16x4(TABx, so[12], so[13], so[14], so[15], pd + 12288u, pd + 13312u, pd + 14336u, pd + 15360u);
        }
        asm volatile("s_waitcnt vmcnt(0)" ::: "memory");
        if (!IS_UP) {
            bf16x8 hb[4];
#pragma unroll
            for (int q = 0; q < 4; ++q) hb[q] = *(const LAS bf16x8*)(hp + (32 * q + 8 * kg) * 2);
            f32x4 res = (f32x4){0.f, 0.f, 0.f, 0.f};
#pragma unroll
            for (int rb = 0; rb < 4; ++rb) {
                f32x4 d = (f32x4){0.f, 0.f, 0.f, 0.f}; const int row = n16 + 16 * rb; const int key = ((row & 3) << 2) | ((row >> 2) & 3);
#pragma unroll
                for (int q = 0; q < 4; ++q) { const bf16x8 af = *(const LAS bf16x8*)(ringp + 256 * row + 16 * ((4 * q + kg) ^ key)); d = __builtin_amdgcn_mfma_f32_16x16x32_bf16(af, hb[q], d, 0, 0, 0); }
                res = (n16 == rb) ? d : res; }
            if (n16 < 4) *(GAS f32x4*)((float*)(a.ws + WS_DOTP) + ((size_t)t * 8 + x) * 128 + base + 16 * n16 + 4 * kg) = res;
        } else {
            f32x4 pacc[8];
#pragma unroll
            for (int i = 0; i < 8; ++i) pacc[i] = (f32x4){0.f, 0.f, 0.f, 0.f};
            const int q4 = n16 >> 2, p4 = lane & 3;
#pragma unroll
            for (int ks = 0; ks < 2; ++ks) {
                const v4u wa = *(const LAS v4u*)(rec + 32 * ks + 8 * kg), wb = *(const LAS v4u*)(rec + 32 * ks + 8 * kg + 4);
                const bf16x8 af = __builtin_bit_cast(bf16x8, (v4u){(wa.x >> 16) | (wa.y & 0xffff0000u), (wa.z >> 16) | (wa.w & 0xffff0000u), (wb.x >> 16) | (wb.y & 0xffff0000u), (wb.z >> 16) | (wb.w & 0xffff0000u)});
#pragma unroll
                for (int c = 0; c < 8; ++c) {
                    const int row0 = 32 * ks + 8 * kg + q4, row1 = row0 + 4; const int ch = 2 * c + (p4 >> 1);
                    const int k0 = ((row0 & 3) << 2) | ((row0 >> 2) & 3), k1 = ((row1 & 3) << 2) | ((row1 >> 2) & 3);
                    const attn_body::s16x4 lo4 = attn_body::vtr((attn_body::lds_cptr)(ringp + 256 * row0 + 16 * (ch ^ k0) + 8 * (p4 & 1)));
                    const attn_body::s16x4 hi4 = attn_body::vtr((attn_body::lds_cptr)(ringp + 256 * row1 + 16 * (ch ^ k1) + 8 * (p4 & 1)));
                    const bf16x8 bfr = (bf16x8){lo4[0], lo4[1], lo4[2], lo4[3], hi4[0], hi4[1], hi4[2], hi4[3]};
                    pacc[c] = __builtin_amdgcn_mfma_f32_16x16x32_bf16(af, bfr, pacc[c], 0, 0, 0); }
            }
            const float v0 = (kg == 0) ? pacc[0][0] : (kg == 1) ? pacc[1][0] : (kg == 2) ? pacc[2][0] : pacc[3][0];
            const float v1 = (kg == 0) ? pacc[4][0] : (kg == 1) ? pacc[5][0] : (kg == 2) ? pacc[6][0] : pacc[7][0];
            bf16* po = (bf16*)(a.ws + WS_PEER) + ((size_t)r * M + t) * D + x * 128;
            po[lane] = (bf16)f2bf(v0); po[64 + lane] = (bf16)f2bf(v1);
        }
    }
}
typedef int i32x4 __attribute__((ext_vector_type(4)));
__device__ __forceinline__ void sweep_down_q8(const Args& a, int x, int wv, int lane, unsigned ring, LAS unsigned char* ringp, unsigned aux, LAS unsigned char* auxp) {
    const int g = lane >> 4, li = lane & 15, n16 = li, kg = g, g8 = lane >> 3, s8 = lane & 7;
    const char* TABx = (const char*)(a.ws + WS_ED) + x * 128;
    unsigned jofs[2];
#pragma unroll
    for (int b = 0; b < 2; ++b) jofs[b] = (unsigned)((s8 ^ (4 * b + (g8 >> 1))) * 16);
    const unsigned pd = (unsigned)__builtin_amdgcn_readfirstlane(ring);
    LAS unsigned char* hq = auxp + 3072; LAS float* hsc = (LAS float*)(auxp + 3072 + 512);
#pragma unroll 1
    for (int s_ = 0; s_ < 128; ++s_) {
        const int r = s_ >> 6, k = s_ & 63, t = wv * 64 + k, base = 64 * r;
        const LAS unsigned* rec = (const LAS unsigned*)(auxp + (k & 3) * 512) + base;
        asm volatile("s_waitcnt lgkmcnt(0)" ::: "memory");
        if ((k & 3) == 0) {
            const char* rsrc = (const char*)(a.ws + WS_REC) + (size_t)t * 512 + lane * 16;
            glds16g(rsrc, (unsigned)__builtin_amdgcn_readfirstlane(aux)); glds16g(rsrc + 1024, (unsigned)__builtin_amdgcn_readfirstlane(aux + 1024));
            glds16g((const char*)(a.ws + WS_HB) + (size_t)(t + g) * 2048 + x * 256 + li * 16, (unsigned)__builtin_amdgcn_readfirstlane(aux + 2048));
            asm volatile("s_waitcnt vmcnt(0)" ::: "memory");
            {
                const v4u hb = *(const LAS v4u*)(auxp + 2048 + lane * 16); float f[8]; unpack8(hb, f);
                float am = fmaxf(fmaxf(fmaxf(fabsf(f[0]), fabsf(f[1])), fmaxf(fabsf(f[2]), fabsf(f[3]))), fmaxf(fmaxf(fabsf(f[4]), fabsf(f[5])), fmaxf(fabsf(f[6]), fabsf(f[7]))));
                am = fmaxf(am, __int_as_float(__builtin_amdgcn_update_dpp(0, __float_as_int(am), 0x140, 0xf, 0xf, false))); am = fmaxf(am, __int_as_float(__builtin_amdgcn_update_dpp(0, __float_as_int(am), 0x141, 0xf, 0xf, false)));
                am = fmaxf(am, __int_as_float(__builtin_amdgcn_update_dpp(0, __float_as_int(am), 0x4E, 0xf, 0xf, false))); am = fmaxf(am, __int_as_float(__builtin_amdgcn_update_dpp(0, __float_as_int(am), 0xB1, 0xf, 0xf, false)));
                const float sc = (am > 0.f) ? am * (1.0f / 127.0f) : 1.0f, inv = 1.0f / sc;
                unsigned qw[2];
#pragma unroll
                for (int h2 = 0; h2 < 2; ++h2) { const int q0 = (int)__builtin_rintf(f[4 * h2] * inv), q1 = (int)__builtin_rintf(f[4 * h2 + 1] * inv), q2 = (int)__builtin_rintf(f[4 * h2 + 2] * inv), q3 = (int)__builtin_rintf(f[4 * h2 + 3] * inv);
                    qw[h2] = ((unsigned)q0 & 255u) | (((unsigned)q1 & 255u) << 8) | (((unsigned)q2 & 255u) << 16) | ((unsigned)q3 << 24); }
                *(LAS unsigned long long*)(hq + lane * 8) = (unsigned long long)qw[0] | ((unsigned long long)qw[1] << 32);
                if (li == 0) hsc[g] = sc; }
        }
        {   unsigned so[8];
#pragma unroll
            for (int i = 0; i < 8; ++i) so[i] = rec[8 * i + g8];
#pragma unroll
            for (int i = 0; i < 8; ++i) so[i] = ((so[i] & 0x3fffu) << 10) + jofs[i & 1];
            glds16x4(TABx, so[0], so[1], so[2], so[3], pd, pd + 1024u, pd + 2048u, pd + 3072u);
            glds16x4(TABx, so[4], so[5], so[6], so[7], pd + 4096u, pd + 5120u, pd + 6144u, pd + 7168u);
        }
        asm volatile("s_waitcnt vmcnt(0)" ::: "memory");
        const i32x4 hb0 = *(const LAS i32x4*)(hq + (k & 3) * 128 + 16 * kg), hb1 = *(const LAS i32x4*)(hq + (k & 3) * 128 + 64 + 16 * kg);
        const float hs = hsc[k & 3];
        i32x4 res = (i32x4){0, 0, 0, 0};
#pragma unroll
        for (int rb = 0; rb < 4; ++rb) {
            const int row = n16 + 16 * rb; const int key = (row >> 1) & 7;
            const i32x4 a0 = *(const LAS i32x4*)(ringp + row * 128 + ((kg ^ key) * 16)), a1 = *(const LAS i32x4*)(ringp + row * 128 + (((4 + kg) ^ key) * 16));
            i32x4 d = __builtin_amdgcn_mfma_i32_16x16x64_i8(a0, hb0, (i32x4){0, 0, 0, 0}, 0, 0, 0); d = __builtin_amdgcn_mfma_i32_16x16x64_i8(a1, hb1, d, 0, 0, 0);
            res = (n16 == rb) ? d : res; }
        if (n16 < 4) *(GAS f32x4*)((float*)(a.ws + WS_DOTP) + ((size_t)t * 8 + x) * 128 + base + 16 * n16 + 4 * kg) = (f32x4){(float)res[0] * hs, (float)res[1] * hs, (float)res[2] * hs, (float)res[3] * hs};
    }
}

__device__ __forceinline__ void sweep_up_q8(const Args& a, int x, int wv, int lane, unsigned ring, LAS unsigned char* ringp, unsigned aux, LAS unsigned char* auxp) {
    const int n16 = lane & 15, kg = lane >> 4, g8 = lane >> 3, s8 = lane & 7;
    const char* TABx = (const char*)(a.ws + WS_EU) + x * 128;
    unsigned jofs[2];
#pragma unroll
    for (int b = 0; b < 2; ++b) jofs[b] = (unsigned)((s8 ^ ((g8 >> 1) | (b << 2))) * 16);
    const unsigned pd = (unsigned)__builtin_amdgcn_readfirstlane(ring);
    typedef int v2i_t __attribute__((ext_vector_type(2)));
#pragma unroll 1
    for (int s_ = 0; s_ < 128; ++s_) {
        const int r = s_ >> 6, k = s_ & 63, t = wv * 64 + k, base = 64 * r;
        const LAS unsigned* rec = (const LAS unsigned*)(auxp + (k & 3) * 512) + base;
        const LAS unsigned char* wq = auxp + 2048 + (k & 3) * 144;
        asm volatile("s_waitcnt lgkmcnt(0)" ::: "memory");
        if ((k & 3) == 0) {
            const char* rsrc = (const char*)(a.ws + WS_REC) + (size_t)t * 512 + lane * 16;
            glds16g(rsrc, (unsigned)__builtin_amdgcn_readfirstlane(aux)); glds16g(rsrc + 1024, (unsigned)__builtin_amdgcn_readfirstlane(aux + 1024));
            if (lane < 36) glds16g((const char*)(a.ws + WS_WQ8) + (size_t)t * 144 + lane * 16, (unsigned)__builtin_amdgcn_readfirstlane(aux + 2048));
            asm volatile("s_waitcnt vmcnt(0)" ::: "memory");
        }
        {   unsigned so[8];
#pragma unroll
            for (int i = 0; i < 8; ++i) so[i] = rec[8 * i + g8];
#pragma unroll
            for (int i = 0; i < 8; ++i) so[i] = ((so[i] & 0x3fffu) << 10) + jofs[(i >> 1) & 1];
            glds16x4(TABx, so[0], so[1], so[2], so[3], pd, pd + 1024u, pd + 2048u, pd + 3072u);
            glds16x4(TABx, so[4], so[5], so[6], so[7], pd + 4096u, pd + 5120u, pd + 6144u, pd + 7168u);
        }
        asm volatile("s_waitcnt vmcnt(0)" ::: "memory");
        const i32x4 aw = *(const LAS i32x4*)(wq + 64 * r + 16 * kg);
        const float wsc = *(const LAS float*)(wq + 128 + 4 * r);
        const int i2 = n16 >> 1, ih = n16 & 1;
        const int row0 = 16 * kg + i2, row1 = row0 + 8;
        const int k0 = ((row0 >> 1) & 3) | (((row0 >> 4) & 1) << 2), k1 = ((row1 >> 1) & 3) | (((row1 >> 4) & 1) << 2);
        const LAS unsigned char* p0 = ringp + row0 * 128 + 8 * ih; const LAS unsigned char* p1 = ringp + row1 * 128 + 8 * ih;
        float outv[8];
#pragma unroll
        for (int c = 0; c < 8; ++c) {
            const v2i_t lo = __builtin_amdgcn_ds_read_tr8_b64_v2i32((LAS v2i_t*)(p0 + ((c ^ k0) * 16)));
            const v2i_t hi = __builtin_amdgcn_ds_read_tr8_b64_v2i32((LAS v2i_t*)(p1 + ((c ^ k1) * 16)));
            const i32x4 d = __builtin_amdgcn_mfma_i32_16x16x64_i8(aw, (i32x4){lo.x, lo.y, hi.x, hi.y}, (i32x4){0, 0, 0, 0}, 0, 0, 0);
            outv[c] = (float)d[0] * wsc; }
        const float v0 = (kg == 0) ? outv[0] : (kg == 1) ? outv[1] : (kg == 2) ? outv[2] : outv[3];
        const float v1 = (kg == 0) ? outv[4] : (kg == 1) ? outv[5] : (kg == 2) ? outv[6] : outv[7];
        bf16* po = (bf16*)(a.ws + WS_PEER) + ((size_t)r * M + t) * D + x * 128;
        po[lane] = (bf16)f2bf(v0); po[64 + lane] = (bf16)f2bf(v1);
    }
}

__device__ __forceinline__ void final_row(const Args& a, int t, int lane) {
    float* orow = a.out + (size_t)t * D; const float* gf = a.in[22];
    const bf16* P0 = (const bf16*)(a.ws + WS_PEER) + (size_t)t * D; const bf16* P1 = P0 + (size_t)M * D;
    const bf16* HBr = (const bf16*)(a.ws + WS_HB) + (size_t)t * D;
    f32x4 h[4]; float ss = 0.f;
#pragma unroll
    for (int j = 0; j < 4; ++j) { { const unsigned long long hb = ((const GAS unsigned long long*)HBr)[lane + 64 * j]; h[j].x = bflo((unsigned)hb); h[j].y = bfhi((unsigned)hb); h[j].z = bflo((unsigned)(hb >> 32)); h[j].w = bfhi((unsigned)(hb >> 32)); }
        const unsigned long long p = ((const GAS unsigned long long*)P0)[lane + 64 * j], q = ((const GAS unsigned long long*)P1)[lane + 64 * j];
        h[j].x += bflo((unsigned)p) + bflo((unsigned)q); h[j].y += bfhi((unsigned)p) + bfhi((unsigned)q); h[j].z += bflo((unsigned)(p >> 32)) + bflo((unsigned)(q >> 32)); h[j].w += bfhi((unsigned)(p >> 32)) + bfhi((unsigned)(q >> 32));
        ss += (h[j].x * h[j].x + h[j].y * h[j].y) + (h[j].z * h[j].z + h[j].w * h[j].w); }
    ss = wave_sum(ss);
    const float ri = 1.0f / sqrtf(ss * (1.0f / 1024.0f) + EPSN);
#pragma unroll
    for (int j = 0; j < 4; ++j) ((GAS f32x4*)orow)[lane + 64 * j] = h[j] * ri * ((const GAS f32x4*)gf)[lane + 64 * j];
}

__device__ __forceinline__ float a_dot64(const float* p, const float* q, int lane) { return wave_sum(p[lane] * q[lane]); }
constexpr int N_PHASES = 12;
#ifndef ROUTE_REF
#define ROUTE_REF 0
#endif
#ifndef MK_ONE_LAUNCH
#define MK_ONE_LAUNCH 1
#endif
__global__ void __launch_bounds__(NWAVES * 64, 2) fwd_mega(Args args) {
    extern __shared__ __attribute__((aligned(16))) unsigned char lds[];
    Frame F;
    F.lds = (LAS unsigned char*)lds;
    F.MISC = (volatile LAS unsigned*)(F.lds + MISC_OFF);
    F.tid = threadIdx.x; F.lane = F.tid & 63; F.wave = __builtin_amdgcn_readfirstlane(F.tid >> 6);
    F.G = gridDim.x; { const int bx = blockIdx.x; F.vcu = (F.G % 8 == 0) ? (bx % 8) * (F.G / 8) + bx / 8 : bx; }
    unsigned char* ws = args.ws;
    const int lo = args.ph_lo, hi = args.ph_hi;
#ifndef PH_MASK
#define PH_MASK 0xffff
#endif
#define IN(k) (((PH_MASK >> (k)) & 1) && lo <= (k) && (k) < hi)
#define BOTH(k) (IN(k) && IN((k) + 1))
#if MK_ONE_LAUNCH
    for (int u = F.tid; u < (LDS_BYTES - LDSCTL_OFF) / 4; u += NWAVES * 64) ((LAS unsigned*)(F.lds + LDSCTL_OFF))[u] = 0u;
    __syncthreads();
    const XcdBarrier xbar = xcd_barrier_post((unsigned*)(ws + WS_CTL) + CW_BAR, F.MISC + 8);
    bool first_seam = args.ph_lo < 0;
#define GRID_BAR() do { if (first_seam) { __threadfence(); cooperative_groups::this_grid().sync(); first_seam = false; } else xcd_barrier(xbar); } while (0)
#else
#define GRID_BAR() do { } while (0)
#endif
#ifndef REP_PH
#define REP_PH -1
#endif
#define RUN_PHASE(k, ...) do { if (IN(k)) { if ((k) == REP_PH) { { const bool first_of_two = true; (void)first_of_two; __VA_ARGS__ } GRID_BAR(); } { const bool first_of_two = false; (void)first_of_two; __VA_ARGS__ } if (BOTH(k)) GRID_BAR(); } } while (0)
    RUN_PHASE(0, { p0_prologue(F, args); });
    RUN_PHASE(1, {
        pg8::Gemm g{(const pg8::bf16_t*)(ws + WS_XB), (const pg8::bf16_t*)(ws + WS_WIN), M, INC, D}; pg8::StaticOrder S; S.init(M, INC, F.G, (int)blockIdx.x);
        pg8::EpiBf16<1> E{(pg8::bf16_t*)(ws + WS_Q), 512, (const float*)(ws + WS_RS1), 512, (size_t)WS_SPLIT / 2, attn_body::C2};
        pg8::gemm_phase<pg8::EpiBf16<1>, pg8::StaticOrder, true, true>(F.lds + RING_OFF, g, S, E);
        { const int nb = (F.G >= 2) ? (int)F.G / 2 : 1; const int bi = (int)blockIdx.x - ((int)F.G - nb); if (bi >= 0) convert_experts(args, bi * NWAVES + F.wave, nb * NWAVES, F.lane); }
    });
    RUN_PHASE(2, {
        for (int c = F.vcu; c < M / 64; c += F.G) lru_local_unit(F, args, c);
        const attn128::AttnTensors AT{(const attn128::bf16*)(ws + WS_Q), (const attn128::bf16*)(ws + WS_Q + WS_SPLIT), (const attn128::bf16*)(ws + WS_Q + 2 * WS_SPLIT), (attn128::bf16*)(ws + WS_OS)};
        const attn128::StaticOrder S(F.vcu);
        attn128::attn_phase<attn128::StaticOrder>((char*)lds + RING_OFF, AT, S);
    });
    RUN_PHASE(3, {
        float l1 = a_dot64(args.in[3], args.in[4], F.lane); float l2 = a_dot64(args.in[5], args.in[6], F.lane);
        const float lamv = expf(l1) - expf(l2) + 0.2f;
        for (int c = F.vcu; c < M / 64; c += F.G) fix_unit(F, args, c, lamv);
    });
    RUN_PHASE(4, {
        pg8::Gemm g{(const pg8::bf16_t*)(ws + WS_MIX), (const pg8::bf16_t*)(ws + WS_WOUT), M, D, D}; pg8::StaticOrder S; S.init(M, D, F.G, (int)blockIdx.x);
        pg8::EpiResid E{args.in[0], args.out, (pg8::bf16_t*)(ws + WS_HB), (float*)(ws + (first_of_two ? WS_RS1 : WS_ROWSS2)), D};
        pg8::gemm_phase<pg8::EpiResid, pg8::StaticOrder, true, true>(F.lds + RING_OFF, g, S, E);
    });
    RUN_PHASE(5, {
        pg8::Gemm g{(const pg8::bf16_t*)(ws + WS_HB), (const pg8::bf16_t*)(ws + WS_WQ), M, NQ, D}; pg8::StaticOrder S; S.init(M, NQ, F.G, (int)blockIdx.x);
        pg8::EpiBf16<2> E{(pg8::bf16_t*)(ws + WS_Q2), NQ, (const float*)(ws + WS_ROWSS2), 0, 0, 1.f};
        pg8::gemm_phase<pg8::EpiBf16<2>, pg8::StaticOrder, true, true>(F.lds + RING_OFF, g, S, E);
    });
    RUN_PHASE(6, {
        const int gw = F.vcu * NWAVES + F.wave; const int NGW = F.G * NWAVES;
        LAS unsigned char* skl = F.lds + RING_OFF + 16384;
        for (int c = F.tid; c < 4096; c += NWAVES * 64) { const int row = c >> 4; const int ch = c & 15; *(LAS v4u*)(skl + row * 272 + ch * 16) = *(const GAS v4u*)(ws + WS_SK1 + (size_t)row * 256 + ch * 16); }
        __syncthreads();
        static_assert((M / 32) * 8 == NEXP / 4, "one group of 4 expert_up rows beside each routing unit");
        for (int u = gw; u < (M / 32) * 8; u += NGW) { f32x4 ev[4][4]; q8_load<4>(ev, args.in[21] + (size_t)u * 4 * D, F.lane);
            route_unit(args, u >> 3, u & 7, F.lane, F.lds + RING_OFF + F.tid * 32, skl, (int*)(ws + WS_EID), (float*)(ws + WS_GW));
            q8_finish<4>(ev, ws + WS_EU + (size_t)u * 4 * D, nullptr, (float*)(ws + WS_SCU) + 4 * u, F.lane); }
        __syncthreads();
    });
    RUN_PHASE(7, {
        const int gw = F.vcu * NWAVES + F.wave; const int NGW = F.G * NWAVES;
        for (int t = gw; t < M; t += NGW) compact_token(args, t, F.lane);
    });
    RUN_PHASE(8, {
        if (F.G == 256) sweep_down_q8(args, F.vcu >> 5, (F.vcu & 31) * NWAVES + F.wave, F.lane, (unsigned)(uintptr_t)(lds + RING_OFF) + F.wave * 16384u, F.lds + RING_OFF + F.wave * 16384, (unsigned)(uintptr_t)(lds + LDSCTL_OFF + 1024) + F.wave * 3712u, F.lds + LDSCTL_OFF + 1024 + F.wave * 3712);
    });
    RUN_PHASE(9, {
        const int gw = F.vcu * NWAVES + F.wave; const int NGW = F.G * NWAVES;
        for (int t = 4 * gw; t < M; t += 4 * NGW) w_tokens<4>(args, t, F.lane);
    });
    RUN_PHASE(10, {
        if (F.G == 256) sweep_up_q8(args, F.vcu >> 5, (F.vcu & 31) * NWAVES + F.wave, F.lane, (unsigned)(uintptr_t)(lds + RING_OFF) + F.wave * 16384u, F.lds + RING_OFF + F.wave * 16384, (unsigned)(uintptr_t)(lds + LDSCTL_OFF + 1024) + F.wave * 3712u, F.lds + LDSCTL_OFF + 1024 + F.wave * 3712);
    });
    RUN_PHASE(11, {
        const int gw = F.vcu * NWAVES + F.wave; const int NGW = F.G * NWAVES;
        for (int t = gw; t < M; t += NGW) final_row(args, t, F.lane);
    });
#undef IN
#undef BOTH
}

extern "C" void kernel_launch(void* const* d_in, const int* in_sizes, int n_in, void* d_out, int out_size, void* d_ws, size_t ws_size, hipStream_t stream) {
    static int grid = 0;
    if (grid == 0) {
        if (n_in != 23 || out_size != M * D || ws_size < WS_END) { fprintf(stderr, "kernel_launch: unexpected problem: n_in %d out %d ws %zu\n", n_in, out_size, ws_size); grid = -1; return; }
        int dev = 0, cus = 0, per_cu = 0;
        if (hipGetDevice(&dev) != hipSuccess || hipDeviceGetAttribute(&cus, hipDeviceAttributeMultiprocessorCount, dev) != hipSuccess) { grid = -1; return; }
        if (hipFuncSetAttribute((const void*)fwd_mega, hipFuncAttributeMaxDynamicSharedMemorySize, LDS_BYTES) != hipSuccess) { fprintf(stderr, "kernel_launch: hipFuncSetAttribute failed\n"); grid = -1; return; }
        if (hipOccupancyMaxActiveBlocksPerMultiprocessor(&per_cu, (const void*)fwd_mega, NWAVES * 64, LDS_BYTES) != hipSuccess || per_cu < 1) { fprintf(stderr, "kernel_launch: occupancy query reports %d\n", per_cu); per_cu = 1; }
        (void)hipGetLastError();
        grid = cus;
    }
    if (grid < 0) return;
    (void)hipMemsetAsync((char*)d_ws + WS_CTL, 0, CTL_ZERO_BYTES, stream);
    Args a{};
    for (int i = 0; i < 23; ++i) a.in[i] = (const float*)d_in[i];
    a.out = (float*)d_out; a.ws = (unsigned char*)d_ws;
#if MK_ONE_LAUNCH
    a.ph_lo = 0; a.ph_hi = N_PHASES;
    void* kargs[] = {&a};
    hipError_t e = hipLaunchCooperativeKernel((const void*)fwd_mega, dim3(grid), dim3(NWAVES * 64), kargs, LDS_BYTES, stream);
    if (e != hipSuccess) fprintf(stderr, "cooperative launch failed: %s (grid %d)\n", hipGetErrorString(e), grid);
#else
    for (int p = 0; p < N_PHASES; ++p) { a.ph_lo = p; a.ph_hi = p + 1; hipLaunchKernelGGL(fwd_mega, dim3(grid), dim3(NWAVES * 64), LDS_BYTES, stream, a); }
#endif
}
```

```cpp
#include <hip/hip_runtime.h>
#include <hip/hip_cooperative_groups.h>
#include <cstdio>
#include <cstdint>
namespace pg8 {
#define PG8_LAS __attribute__((address_space(3)))
typedef unsigned short bf16_t;
typedef short bf16x8 __attribute__((ext_vector_type(8)));
typedef float f32x4 __attribute__((ext_vector_type(4)));
typedef unsigned u32x4 __attribute__((ext_vector_type(4)));
constexpr int BM = 256, BK = 64, HALF = 128, HTB = HALF * BK * 2  , STAGE_BYTES = 8 * HTB, NXCD = 8, WGM = 8;

__host__ __device__ __forceinline__ int lds_byte(int r, int c) { const int st = (r >> 4) * 2 + (c >> 5), rr = r & 15, cc = c & 31, ob = rr * 64 + cc * 2; return st * 1024 + (ob ^ (((ob >> 9) & 1) << 5)); }
__host__ __device__ __forceinline__ void stage_rc(int b, int& R, int& C) { const int st = b / 1024, sb = b % 1024, swz = sb ^ (((sb >> 9) & 1) << 5); R = (st >> 1) * 16 + swz / 64; C = (st & 1) * 32 + (swz % 64) / 2; }
__host__ __device__ __forceinline__ int perm32(int rho) { const int n = rho >> 4, i = rho & 15; return 8 * (i >> 2) + 4 * n + (i & 3); }

struct Unit { int pm, pn; };
struct Gemm { const bf16_t* A; const bf16_t* Bt; int M, N, K; };

struct StaticOrder {
    int nM, nN, nwg, G, c;
    __host__ __device__ void init(int M, int N, int G_, int c_) { nM = M / BM; nN = N / BM; nwg = nM * nN; G = G_; c = c_; }
    __host__ __device__ bool next(int i, Unit& u) const {
        const long L = (long)i * G + c; if (L >= nwg) return false;
        int wgid = (int)L; { const int q = nwg / NXCD, r = nwg % NXCD, xcd = wgid % NXCD, off = wgid / NXCD; wgid = (xcd < r ? xcd * (q + 1) : r * (q + 1) + (xcd - r) * q) + off; }
        const int nig = WGM * nN, gid = wgid / nig, fm = gid * WGM, gsz = (nM - fm) < WGM ? (nM - fm) : WGM;
        u.pm = fm + ((wgid % nig) % gsz); u.pn = (wgid % nig) / gsz; return true;
    }
    __device__ __forceinline__ void a_ready(const Unit&) const {}
    __device__ __forceinline__ void done(const Unit&) const {}
};

__device__ __forceinline__ unsigned cvt_pk_bf16(float lo, float hi) { unsigned r; asm volatile("v_cvt_pk_bf16_f32 %0, %1, %2" : "=v"(r) : "v"(lo), "v"(hi)); return r; }
typedef float f32x2 __attribute__((ext_vector_type(2)));

template <int RSMODE> struct EpiBf16 {
    static constexpr bool PERM = true, AFTER_DRAIN = false;
    bf16_t* O; int ldc; const float* rowscale; int split_cols; size_t split_stride; float scale0;
    __device__ __forceinline__ void operator()(const f32x4 (&acc)[2][2][4][2], const Unit& u, int wr, int wc, int fr, int fq) const {
        const int row0 = u.pm * BM + wr * 64 + fr; int colt = u.pn * BM; bf16_t* base = O;
        float sc = 1.f; if (split_cols) { const int t = colt / split_cols; base += (size_t)t * split_stride; colt -= t * split_cols; if (t == 0) sc = scale0; }
        const int col0 = colt + wc * 32 + 8 * fq;
#pragma unroll
        for (int ai = 0; ai < 2; ++ai)
#pragma unroll
            for (int m = 0; m < 4; ++m) { const int row = row0 + ai * HALF + m * 16; bf16_t* rowp = base + (size_t)row * ldc + col0;
                float rs = sc;
                if (RSMODE == 1) rs *= rowscale[row];
                if (RSMODE == 2) rs *= 1.0f / sqrtf(rowscale[row] * (1.0f / 1024.0f) + 1e-6f);
#pragma unroll
                for (int bj = 0; bj < 2; ++bj) { f32x4 v0 = acc[ai][bj][m][0] * rs, v1 = acc[ai][bj][m][1] * rs;
                    u32x4 w; w.x = cvt_pk_bf16(v0[0], v0[1]); w.y = cvt_pk_bf16(v0[2], v0[3]); w.z = cvt_pk_bf16(v1[0], v1[1]); w.w = cvt_pk_bf16(v1[2], v1[3]);
                    *(u32x4*)(rowp + bj * HALF) = w; } }
    }
};

struct EpiResid {
    static constexpr bool PERM = false, AFTER_DRAIN = false;
    const float* X; float* Hf; bf16_t* Hb; float* rowss; int ldc;
    __device__ __forceinline__ void operator()(const f32x4 (&acc)[2][2][4][2], const Unit& u, int wr, int wc, int fr, int fq) const {
        typedef unsigned u32x2v __attribute__((ext_vector_type(2)));
        const int col0 = u.pn * BM + wc * 32 + 4 * fq;
#pragma unroll
        for (int ai = 0; ai < 2; ++ai)
#pragma unroll
            for (int m = 0; m < 4; ++m) { const int row = u.pm * BM + ai * HALF + wr * 64 + m * 16 + fr; const size_t off = (size_t)row * ldc + col0; float ss = 0.f;
#pragma unroll
                for (int bj = 0; bj < 2; ++bj)
#pragma unroll
                    for (int n = 0; n < 2; ++n) { const f32x4 xv = *(const f32x4*)(X + off + bj * HALF + n * 16); const f32x4 h = xv + acc[ai][bj][m][n];
                        u32x2v w; w.x = cvt_pk_bf16(h[0], h[1]); w.y = cvt_pk_bf16(h[2], h[3]);
                        *(u32x2v*)(Hb + off + bj * HALF + n * 16) = w; ss += (h[0] * h[0] + h[1] * h[1]) + (h[2] * h[2] + h[3] * h[3]); }
                ss += __shfl_xor(ss, 16); ss += __shfl_xor(ss, 32);
                if (fq == 0) atomicAdd(rowss + row, ss); }
    }
};

template <class Epi, class Sched, bool ALIGN_EPI = false, bool SP2 = false>
__device__ __forceinline__ void gemm_phase(PG8_LAS unsigned char* lds, const Gemm g, const Sched& S, const Epi& E) {
    const int tid = threadIdx.x, wid = __builtin_amdgcn_readfirstlane(tid >> 6), lane = tid & 63, wr = wid >> 2, wc = wid & 3, fr = lane & 15, fq = lane >> 4;
    const int K = g.K, nt = K / BK;
    unsigned voffA[2], voffB[2];
#pragma unroll
    for (int i = 0; i < 2; ++i) { int R, C; stage_rc(tid * 16 + i * 8192, R, C); const int Rb = Epi::PERM ? ((R & ~31) + perm32(R & 31)) : R;
        voffA[i] = (unsigned)(R * K + C) * 2u; voffB[i] = (unsigned)(Rb * K + C) * 2u; }
    const size_t kstep = (size_t)(BK * 2);
    const size_t hstep = (size_t)HALF * K * 2;
    const size_t tstep = 2 * hstep;
    const unsigned ldsw = (unsigned)wid * 1024u;
    const int aoff = lds_byte(wr * 64 + fr, fq * 8), boff = lds_byte(wc * 32 + fr, fq * 8);
#define PG8_SA(b, h) (((b) * 2 + (h)) * HTB)
#define PG8_SB(b, h) ((4 + (b) * 2 + (h)) * HTB)
#define PG8_STAGE(bufoff, gbase, voff) do { _Pragma("unroll") for (int _i = 0; _i < 2; ++_i) \
        __builtin_amdgcn_global_load_lds((const unsigned*)((const char*)(gbase) + (voff)[_i]), (PG8_LAS unsigned*)(lds + (bufoff) + ldsw + _i * 8192), 16, 0, 0); } while (0)
#define PG8_LDA(dst, b, h) do { _Pragma("unroll") for (int m = 0; m < 4; ++m) _Pragma("unroll") for (int k = 0; k < 2; ++k) dst[m][k] = *(const PG8_LAS bf16x8*)(lds + PG8_SA(b, h) + aoff + m * 2048 + k * 1024); } while (0)
#define PG8_LDB(dst, b, h) do { _Pragma("unroll") for (int n = 0; n < 2; ++n) _Pragma("unroll") for (int k = 0; k < 2; ++k) dst[n][k] = *(const PG8_LAS bf16x8*)(lds + PG8_SB(b, h) + boff + n * 2048 + k * 1024); } while (0)
#define PG8_MMA(ai, bj, At, Bt) do { __builtin_amdgcn_s_setprio(1); _Pragma("unroll") for (int m = 0; m < 4; ++m) _Pragma("unroll") for (int n = 0; n < 2; ++n) _Pragma("unroll") for (int k = 0; k < 2; ++k) \
        acc[ai][bj][m][n] = __builtin_amdgcn_mfma_f32_16x16x32_bf16(Bt[n][k], At[m][k], acc[ai][bj][m][n], 0, 0, 0); __builtin_amdgcn_s_setprio(0); } while (0)
#define PG8_WAIT_V(n) asm volatile("s_waitcnt vmcnt(" #n ")" ::: "memory")
#define PG8_WAIT_L(n) asm volatile("s_waitcnt lgkmcnt(" #n ")" ::: "memory")
#define PG8_BAR __builtin_amdgcn_s_barrier()
#define PG8_SCHED __builtin_amdgcn_sched_barrier(0)
    Unit cur, nxt; int ui = 0;
    if (!S.next(0, cur)) return;
    f32x4 acc[2][2][4][2];
#pragma unroll
    for (int a = 0; a < 2; ++a)
#pragma unroll
        for (int b = 0; b < 2; ++b)
#pragma unroll
            for (int m = 0; m < 4; ++m)
#pragma unroll
                for (int n = 0; n < 2; ++n) acc[a][b][m][n] = (f32x4){0.f, 0.f, 0.f, 0.f};
    bf16x8 At[4][2], B0[2][2], B1[2][2];
    const char* cA = (const char*)g.A + (size_t)cur.pm * tstep; const char* cB = (const char*)g.Bt + (size_t)cur.pn * tstep;
    S.a_ready(cur);
    if constexpr (SP2) {
        PG8_STAGE(PG8_SB(0, 0), cB, voffB); PG8_STAGE(PG8_SB(0, 1), cB + hstep, voffB); PG8_STAGE(PG8_SA(0, 0), cA, voffA); PG8_STAGE(PG8_SA(0, 1), cA + hstep, voffA);
        if (wr == 1) PG8_BAR;
        PG8_WAIT_V(2); PG8_BAR;
        PG8_STAGE(PG8_SB(1, 0), cB + kstep, voffB); PG8_STAGE(PG8_SA(1, 0), cA + kstep, voffA); PG8_STAGE(PG8_SB(1, 1), cB + hstep + kstep, voffB);
        PG8_WAIT_V(6); PG8_BAR;
    } else {
        PG8_STAGE(PG8_SB(0, 0), cB, voffB); PG8_STAGE(PG8_SA(0, 0), cA, voffA); PG8_STAGE(PG8_SB(0, 1), cB + hstep, voffB); PG8_STAGE(PG8_SA(0, 1), cA + hstep, voffA);
        if (wr == 1) PG8_BAR;
        PG8_WAIT_V(4); PG8_BAR;
        PG8_STAGE(PG8_SB(1, 0), cB + kstep, voffB); PG8_STAGE(PG8_SA(1, 0), cA + kstep, voffA); PG8_STAGE(PG8_SB(1, 1), cB + hstep + kstep, voffB);
        PG8_WAIT_V(6); PG8_BAR;
    }
    for (;;) {
        const bool has_next = S.next(ui + 1, nxt);
        const char* nA = has_next ? (const char*)g.A + (size_t)nxt.pm * tstep : cA; const char* nB = has_next ? (const char*)g.Bt + (size_t)nxt.pn * tstep : cB;
        for (int t = 0; t < nt; t += 2) {
            const bool last = (t == nt - 2);
            const char* a1 = cA + (size_t)(t + 1) * kstep;
            const char* a2 = last ? nA : cA + (size_t)(t + 2) * kstep; const char* b2 = last ? nB : cB + (size_t)(t + 2) * kstep;
            const char* a3 = a2 + kstep; const char* b3 = b2 + kstep;
            if (last && has_next) S.a_ready(nxt);
            if constexpr (SP2) {
            PG8_LDB(B0, 0, 0); PG8_LDB(B1, 0, 1); PG8_SCHED; PG8_LDA(At, 0, 0); PG8_STAGE(PG8_SA(1, 1), a1 + hstep, voffA);
            PG8_WAIT_V(8); PG8_WAIT_L(0); PG8_BAR; PG8_MMA(0, 0, At, B0); PG8_MMA(0, 1, At, B1); PG8_BAR; PG8_SCHED;
            PG8_LDA(At, 0, 1); PG8_STAGE(PG8_SB(0, 0), b2, voffB); PG8_STAGE(PG8_SB(0, 1), b2 + hstep, voffB); PG8_STAGE(PG8_SA(0, 0), a2, voffA);
            PG8_WAIT_V(8); PG8_WAIT_L(0); PG8_BAR; PG8_MMA(1, 0, At, B0); PG8_MMA(1, 1, At, B1); PG8_BAR; PG8_SCHED;
            PG8_LDB(B0, 1, 0); PG8_LDB(B1, 1, 1); PG8_SCHED; PG8_LDA(At, 1, 0); PG8_STAGE(PG8_SA(0, 1), a2 + hstep, voffA);
            PG8_WAIT_V(8); PG8_WAIT_L(0); PG8_BAR; PG8_MMA(0, 0, At, B0); PG8_MMA(0, 1, At, B1); PG8_BAR; PG8_SCHED;
            PG8_LDA(At, 1, 1); PG8_STAGE(PG8_SB(1, 0), b3, voffB); PG8_STAGE(PG8_SB(1, 1), b3 + hstep, voffB); PG8_STAGE(PG8_SA(1, 0), a3, voffA);
            PG8_WAIT_V(8); PG8_WAIT_L(0); PG8_BAR; PG8_MMA(1, 0, At, B0); PG8_MMA(1, 1, At, B1); PG8_BAR; PG8_SCHED;
            } else {
            PG8_LDB(B0, 0, 0); PG8_SCHED; PG8_LDA(At, 0, 0); PG8_STAGE(PG8_SA(1, 1), a1 + hstep, voffA);
            PG8_WAIT_L(8); PG8_BAR; PG8_WAIT_L(0); PG8_MMA(0, 0, At, B0); PG8_BAR; PG8_SCHED;
            PG8_LDB(B1, 0, 1); PG8_STAGE(PG8_SB(0, 0), b2, voffB);
            PG8_BAR; PG8_WAIT_L(0); PG8_MMA(0, 1, At, B1); PG8_BAR;
            PG8_LDA(At, 0, 1); PG8_STAGE(PG8_SA(0, 0), a2, voffA);
            PG8_BAR; PG8_WAIT_L(0); PG8_MMA(1, 0, At, B0); PG8_BAR; PG8_SCHED;
            PG8_STAGE(PG8_SB(0, 1), b2 + hstep, voffB);
            PG8_WAIT_V(6); PG8_BAR; PG8_MMA(1, 1, At, B1); PG8_BAR;
            PG8_LDB(B0, 1, 0); PG8_SCHED; PG8_LDA(At, 1, 0); PG8_STAGE(PG8_SA(0, 1), a2 + hstep, voffA);
            PG8_WAIT_L(8); PG8_BAR; PG8_WAIT_L(0); PG8_MMA(0, 0, At, B0); PG8_BAR; PG8_SCHED;
            PG8_LDB(B1, 1, 1); PG8_STAGE(PG8_SB(1, 0), b3, voffB);
            PG8_BAR; PG8_WAIT_L(0); PG8_MMA(0, 1, At, B1); PG8_BAR;
            PG8_LDA(At, 1, 1); PG8_STAGE(PG8_SA(1, 0), a3, voffA);
            PG8_BAR; PG8_WAIT_L(0); PG8_MMA(1, 0, At, B0); PG8_BAR; PG8_SCHED;
            PG8_STAGE(PG8_SB(1, 1), b3 + hstep, voffB);
            PG8_WAIT_V(6); PG8_BAR; PG8_MMA(1, 1, At, B1); PG8_BAR;
            }
        }
        if constexpr (ALIGN_EPI) { if (wr == 0) PG8_BAR; }
        if constexpr (!Epi::AFTER_DRAIN) { E(acc, cur, wr, wc, fr, fq); S.done(cur); }
        if (!has_next) break;
#pragma unroll
        for (int a = 0; a < 2; ++a)
#pragma unroll
            for (int b = 0; b < 2; ++b)
#pragma unroll
                for (int m = 0; m < 4; ++m)
#pragma unroll
                    for (int n = 0; n < 2; ++n) acc[a][b][m][n] = (f32x4){0.f, 0.f, 0.f, 0.f};
        cur = nxt; cA = nA; cB = nB; ++ui;
        if constexpr (ALIGN_EPI) { if (wr == 1) PG8_BAR; }
    }
    PG8_WAIT_V(0);
    if constexpr (!ALIGN_EPI) { if (wr == 0) PG8_BAR; }
    PG8_BAR;
    if constexpr (Epi::AFTER_DRAIN) { E.fused(acc, cur, wr, wc, fr, fq, lds, wid, lane); S.done(cur); }
#undef PG8_SA
#undef PG8_SB
#undef PG8_STAGE
#undef PG8_LDA
#undef PG8_LDB
#undef PG8_MMA
#undef PG8_WAIT_V
#undef PG8_WAIT_L
#undef PG8_BAR
#undef PG8_SCHED
}
}

#include <hip/hip_bf16.h>
#include <cmath>
namespace attn_body {
using bf16=__hip_bfloat16;
using bf16x8=__attribute__((ext_vector_type(8)))short;
using s16x4=__attribute__((ext_vector_type(4)))short;
using f32x16=__attribute__((ext_vector_type(16)))float;
using u32x4=__attribute__((ext_vector_type(4)))unsigned;
constexpr int SEQ=16384,D=64,DM=512;
constexpr int NW=8,QBLK=32,QB=QBLK*NW,KVBLK=64,NQB=SEQ/QB;
constexpr int ATTN_PITCH=DM, ATTN_UNIT_ROWS=QB;
__device__ __forceinline__ int crow(int r,int hi){return (r&3)+8*(r>>2)+4*hi;}
#define SBAR() __builtin_amdgcn_sched_barrier(0)
__device__ __forceinline__ void cmask(f32x16&p0,f32x16&p1,int jb,int wid){
  const float NEG=-INFINITY;
  if(jb>(wid>>1)){
  #pragma unroll
  for(int r=0;r<16;++r){p0[r]=NEG;p1[r]=NEG;}}
}

constexpr int NSLOT=3, SLOTB=8192;
constexpr int LDS_K=0, LDS_V=NSLOT*SLOTB, LDS_WS=2*NSLOT*SLOTB, LDS_OST=LDS_WS+NW*64*4, LDS_BYTES=LDS_OST+NW*4096;
constexpr float C2=0.125f*1.4426950408889634f;
__device__ __forceinline__ void glds16(const void*gsrc,unsigned lds_dst){unsigned keep;
  asm volatile("s_mov_b32 %0, m0\n\ts_mov_b32 m0, %2\n\ts_nop 0\n\tglobal_load_lds_dwordx4 %1, off\n\ts_mov_b32 m0, %0":"=&s"(keep):"v"(gsrc),"s"(lds_dst):"memory");}
__device__ __forceinline__ float max3f(float a,float b,float c){float r;asm("v_max3_f32 %0, %1, %2, %3":"=v"(r):"v"(a),"v"(b),"v"(c));return r;}
__device__ __forceinline__ float max2f(float a,float b){float r;asm("v_max_f32_e32 %0, %1, %2":"=v"(r):"v"(a),"v"(b));return r;}
__device__ __forceinline__ float fadd_s(float a,float b){float r;asm("v_add_f32_e32 %0, %1, %2":"=v"(r):"v"(a),"v"(b));return r;}
__device__ __forceinline__ float fsub_s(float a,float b){float r;asm("v_sub_f32_e32 %0, %1, %2":"=v"(r):"v"(a),"v"(b));return r;}
typedef float f32x2_t __attribute__((ext_vector_type(2))); typedef __bf16 bf16x2_t __attribute__((ext_vector_type(2)));
__device__ __forceinline__ unsigned cvtpk_s(float lo,float hi){f32x2_t v={lo,hi};bf16x2_t b=__builtin_convertvector(v,bf16x2_t);return __builtin_bit_cast(unsigned,b);}
#define WAIT_BAR(N) asm volatile("s_waitcnt vmcnt(" #N ") lgkmcnt(0)\n\ts_barrier":::"memory")

__device__ __forceinline__ void qkt(f32x16&p0,f32x16&p1,const char*Kslot,const bf16x8*qr,const f32x16&negm,int r32,int hi){
  const char*kb=Kslot+hi*1024+r32*16;
  #pragma unroll
  for(int d0=0;d0<4;++d0){
    const bf16x8 b0=*reinterpret_cast<const bf16x8*>(kb+d0*2048);
    const bf16x8 b1=*reinterpret_cast<const bf16x8*>(kb+d0*2048+512);
    if(d0==0){p0=__builtin_amdgcn_mfma_f32_32x32x16_bf16(b0,qr[0],negm,0,0,0);p1=__builtin_amdgcn_mfma_f32_32x32x16_bf16(b1,qr[0],negm,0,0,0);}
    else{p0=__builtin_amdgcn_mfma_f32_32x32x16_bf16(b0,qr[d0],p0,0,0,0);p1=__builtin_amdgcn_mfma_f32_32x32x16_bf16(b1,qr[d0],p1,0,0,0);}}
}
typedef __attribute__((address_space(3))) const char* lds_cptr;
typedef short v4i16_t __attribute__((ext_vector_type(4)));
__device__ __forceinline__ void kload8(bf16x8*kf,lds_cptr kp){
  kf[0]=*(const __attribute__((address_space(3))) bf16x8*)(kp);      kf[1]=*(const __attribute__((address_space(3))) bf16x8*)(kp+512);
  kf[2]=*(const __attribute__((address_space(3))) bf16x8*)(kp+2048); kf[3]=*(const __attribute__((address_space(3))) bf16x8*)(kp+2560);
  kf[4]=*(const __attribute__((address_space(3))) bf16x8*)(kp+4096); kf[5]=*(const __attribute__((address_space(3))) bf16x8*)(kp+4608);
  kf[6]=*(const __attribute__((address_space(3))) bf16x8*)(kp+6144); kf[7]=*(const __attribute__((address_space(3))) bf16x8*)(kp+6656);
}
__device__ __forceinline__ void kload2(bf16x8*kf,lds_cptr kp,int j){ kf[2*j]=*(const __attribute__((address_space(3))) bf16x8*)(kp+j*2048); kf[2*j+1]=*(const __attribute__((address_space(3))) bf16x8*)(kp+j*2048+512); }
__device__ __forceinline__ s16x4 vtr(lds_cptr p){ return __builtin_bit_cast(s16x4,__builtin_amdgcn_ds_read_tr16_b64_v4i16((__attribute__((address_space(3))) v4i16_t*)p)); }
__device__ __forceinline__ float rowmax(const f32x16&p0,const f32x16&p1){
  float a=max3f(p0[0],p0[1],p1[0]),b=max3f(p0[2],p0[3],p1[1]);a=max3f(a,p1[2],p1[3]);
  #pragma unroll
  for(int r=4;r<16;r+=4){a=max3f(a,p0[r],p0[r+1]);b=max3f(b,p0[r+2],p0[r+3]);a=max3f(a,p1[r],p1[r+1]);b=max3f(b,p1[r+2],p1[r+3]);}
  const float m=max2f(a,b);
  auto rr=__builtin_amdgcn_permlane32_swap(__float_as_uint(m),__float_as_uint(m),false,false);
  return max2f(__uint_as_float(rr[0]),__uint_as_float(rr[1]));
}
__device__ __forceinline__ void pv(f32x16*o,int vb,bf16x8 pa0,bf16x8 pa1,bf16x8 pa2,bf16x8 pa3){
  #pragma unroll
  for(int d0=0;d0<2;++d0){s16x4 lo[4],hi[4];
    #pragma unroll
    for(int ks=0;ks<4;++ks){
      asm volatile("ds_read_b64_tr_b16 %0,%1 offset:%c2":"=&v"(lo[ks]):"v"(vb),"i"(d0*4096+ks*1024):"memory");
      asm volatile("ds_read_b64_tr_b16 %0,%1 offset:%c2":"=&v"(hi[ks]):"v"(vb),"i"(d0*4096+ks*1024+512):"memory");}
    asm volatile("s_waitcnt lgkmcnt(0)":::"memory");SBAR();
    #define PK(k) (bf16x8){lo[k][0],lo[k][1],lo[k][2],lo[k][3],hi[k][0],hi[k][1],hi[k][2],hi[k][3]}
    o[d0]=__builtin_amdgcn_mfma_f32_32x32x16_bf16(pa0,PK(0),o[d0],0,0,0);
    o[d0]=__builtin_amdgcn_mfma_f32_32x32x16_bf16(pa1,PK(1),o[d0],0,0,0);
    o[d0]=__builtin_amdgcn_mfma_f32_32x32x16_bf16(pa2,PK(2),o[d0],0,0,0);
    o[d0]=__builtin_amdgcn_mfma_f32_32x32x16_bf16(pa3,PK(3),o[d0],0,0,0);
    #undef PK
  }
}

#ifndef ATTN_STORE16
#define ATTN_STORE16(p,v) (*(u32x4*)(p)=(v))
#endif
template<int THRL> __device__ __forceinline__ void attn_unit(int qcol,int vcol,int qb,const bf16*Q,const bf16*__restrict__ K,const bf16*__restrict__ V,bf16*O,char*shm){
  const int tid=threadIdx.x,lane=tid&63,r32=lane&31,hi=lane>>5; const int wid=__builtin_amdgcn_readfirstlane(tid>>6);
  const long rowbase=0; const int q0=qb*QB;
  const bf16*Qw=Q+(rowbase+q0+wid*QBLK)*DM+qcol;
  const bf16*Kh=K+rowbase*DM+qcol,*Vh=V+rowbase*DM+vcol;
  const unsigned lds0=(unsigned)(uintptr_t)shm;
  float*wsf=(float*)(shm+LDS_WS)+wid*64;
  const bf16*ksrc=Kh+(long)lane*DM+wid*8;
  const bf16*vsrc=Vh+(long)(16*(wid&3)+(lane>>2))*DM+(wid>>2)*32+(lane&3)*8;
  const unsigned kdst=lds0+LDS_K+wid*1024, vdst=lds0+LDS_V+wid*1024;
  #define DMA_K(t,slot) glds16(ksrc+(long)(t)*KVBLK*DM,(unsigned)__builtin_amdgcn_readfirstlane(kdst+(slot)))
  #define DMA_V(t,slot) glds16(vsrc+(long)(t)*KVBLK*DM,(unsigned)__builtin_amdgcn_readfirstlane(vdst+(slot)))
  const int vb0=(int)(lds0+LDS_V)+((lane>>4)&1)*32+(lane&3)*8+(4*hi+((lane&15)>>2))*64;
  const char*Kbase=shm+LDS_K; bf16x8 kf[8];
  const lds_cptr shm3=(lds_cptr)shm; const lds_cptr kp0=shm3+LDS_K+hi*1024+r32*16; const lds_cptr vp0=shm3+LDS_V+((lane>>4)&1)*32+(lane&3)*8+(4*hi+((lane&15)>>2))*64;
  const int NT=(q0+QB)/KVBLK;
  DMA_K(0,0);DMA_V(0,0);DMA_K(1,SLOTB);
  bf16x8 qr[4];
  #pragma unroll
  for(int d0=0;d0<4;++d0)qr[d0]=*reinterpret_cast<const bf16x8*>(&Qw[(long)r32*DM+d0*16+hi*8]);
  float mhat=0.f,l_reg=0.f;f32x16 o[2];o[0]=f32x16{};o[1]=f32x16{};f32x16 negm=f32x16{};asm volatile("":"+v"(negm));
  const int qrel=wid*QBLK+r32;
  #define CMASK(P0,P1,t) do{int jb_=(t)-(NT-4); if(jb_>=0)cmask(P0,P1,jb_,wid);}while(0)
  bool resc=false;
  #define START(P0,P1) do{ const float rm=rowmax(P0,P1); resc=false; \
    { const float dl=rm; mhat=fadd_s(mhat,dl); \
      _Pragma("unroll") for(int r=0;r<16;++r){P0[r]=fsub_s(P0[r],dl);P1[r]=fsub_s(P1[r],dl);} \
      _Pragma("unroll") for(int r=0;r<16;++r)negm[r]=-mhat; asm volatile("":"+v"(negm)); } \
    _Pragma("unroll") for(int r=0;r<16;++r)P0[r]=__builtin_amdgcn_exp2f(P0[r]); }while(0)
  #define RESC() do{ if(resc){ asm volatile("s_waitcnt lgkmcnt(0)":::"memory"); \
      _Pragma("unroll") for(int d_=0;d_<2;++d_) _Pragma("unroll") for(int r=0;r<16;++r)o[d_][r]*=wsf[crow(r,hi)]; } }while(0)
  f32x16 pA0,pA1,pB0,pB1;
  int sl_prev=0,sl_cur=0,sl_next=SLOTB;
  #define ROT() do{sl_prev=sl_cur;sl_cur=sl_next;sl_next=(sl_next==(NSLOT-1)*SLOTB)?0:sl_next+SLOTB;}while(0)
  DMA_K(2,2*SLOTB);
  WAIT_BAR(3);
  qkt(pA0,pA1,Kbase,qr,negm,r32,hi);asm volatile("s_nop 15\n\ts_nop 7":"+v"(pA0),"+v"(pA1));CMASK(pA0,pA1,0);
  START(pA0,pA1);
  _Pragma("unroll") for(int r=0;r<16;++r)pA1[r]=__builtin_amdgcn_exp2f(pA1[r]);
  WAIT_BAR(0);
  DMA_K(3,0);DMA_V(1,SLOTB);
  ROT();
  kload8(kf,kp0+sl_cur);
  WAIT_BAR(2);
  s16x4 vlo[8],vhi[8]; u32x4 pw0,pw1,pw2,pw3;
  #define PKW(P,B) cvtpk_s(P[B],P[B+1])
  #define PAF(k) __builtin_bit_cast(bf16x8,pw##k)
  #define VFR(i) (bf16x8){vlo[i][0],vlo[i][1],vlo[i][2],vlo[i][3],vhi[i][0],vhi[i][1],vhi[i][2],vhi[i][3]}
  #define PIN(x) asm volatile("":"+v"(x))
  #define MX3(a,b,c) __builtin_fmaxf(__builtin_fmaxf((a),(b)),(c))
  #define GAPA(MF,A0,A1,A2,A3,W0,W1,PW) do{ MF; sacc+=A0; sacc+=A1; sacc+=A2; sacc+=A3; PIN(sacc); W0; W1; PIN(PW); SBAR(); }while(0)
  #define EX(v) __builtin_amdgcn_exp2f(v)
  #define GAPB(MF,X,B) do{ MF; X[B]=EX(X[B]); X[B+1]=EX(X[B+1]); X[B+2]=EX(X[B+2]); X[B+3]=EX(X[B+3]); PIN(X); SBAR(); }while(0)
  #define VRD(i) do{ vlo[i]=vtr(vp_+(((i)>>2)*4096+((i)&3)*1024)); vhi[i]=vtr(vp_+(((i)>>2)*4096+((i)&3)*1024+512)); }while(0)
  #define KRD(G,j) do{ if(G){ kload2(kf,kp0+sl_next,j); SBAR(); } }while(0)
  #define STEP(C0,C1,P0,P1,t,GK,GV,GL) do{ SBAR(); \
    const lds_cptr vp_=vp0+sl_prev; \
    VRD(0); SBAR(); float sacc=(P0[0]+P0[1]); \
    GAPA(C0=__builtin_amdgcn_mfma_f32_32x32x16_bf16(kf[0],qr[0],negm,0,0,0), P0[2],P0[3],P0[4],P0[5],     pw0[0]=PKW(P0,0), pw0[1]=PKW(P0,2), pw0); \
    VRD(4); SBAR(); GAPA(C1=__builtin_amdgcn_mfma_f32_32x32x16_bf16(kf[1],qr[0],negm,0,0,0), P0[6],P0[7],P0[8],P0[9],     pw0[2]=PKW(P0,4), pw0[3]=PKW(P0,6), pw0); \
    VRD(1); SBAR(); GAPA(C0=__builtin_amdgcn_mfma_f32_32x32x16_bf16(kf[2],qr[1],C0,0,0,0),   P0[10],P0[11],P0[12],P0[13], pw1[0]=PKW(P0,8), pw1[1]=PKW(P0,10), pw1); \
    VRD(5); SBAR(); GAPA(C1=__builtin_amdgcn_mfma_f32_32x32x16_bf16(kf[3],qr[1],C1,0,0,0),   P0[14],P0[15],P1[0],P1[1],   pw1[2]=PKW(P0,12),pw1[3]=PKW(P0,14), pw1); \
    VRD(2); SBAR(); GAPA(C0=__builtin_amdgcn_mfma_f32_32x32x16_bf16(kf[4],qr[2],C0,0,0,0),   P1[2],P1[3],P1[4],P1[5],     pw2[0]=PKW(P1,0), pw2[1]=PKW(P1,2), pw2); \
    VRD(6); SBAR(); GAPA(C1=__builtin_amdgcn_mfma_f32_32x32x16_bf16(kf[5],qr[2],C1,0,0,0),   P1[6],P1[7],P1[8],P1[9],     pw2[2]=PKW(P1,4), pw2[3]=PKW(P1,6), pw2); \
    VRD(3); SBAR(); GAPA(C0=__builtin_amdgcn_mfma_f32_32x32x16_bf16(kf[6],qr[3],C0,0,0,0),   P1[10],P1[11],P1[12],P1[13], pw3[0]=PKW(P1,8), pw3[1]=PKW(P1,10), pw3); \
    VRD(7); SBAR(); GAPA(C1=__builtin_amdgcn_mfma_f32_32x32x16_bf16(kf[7],qr[3],C1,0,0,0),   P1[14],P1[15],0.f,0.f,       pw3[2]=PKW(P1,12),pw3[3]=PKW(P1,14), pw3); \
    l_reg+=sacc; \
    if(GK){DMA_K((t)+3,sl_cur);} if(GV){DMA_V((t)+1,sl_next);} \
    CMASK(C0,C1,t); \
    { float a=MX3(C0[0],C0[1],C1[0]),b=MX3(C0[2],C0[3],C1[1]); a=MX3(a,C1[2],C1[3]); \
      _Pragma("unroll") for(int r=4;r<16;r+=4){a=MX3(a,C0[r],C0[r+1]);b=MX3(b,C0[r+2],C0[r+3]);a=MX3(a,C1[r],C1[r+1]);b=MX3(b,C1[r+2],C1[r+3]);} \
      float rm=__builtin_fmaxf(a,b); { auto rr=__builtin_amdgcn_permlane32_swap(__float_as_uint(rm),__float_as_uint(rm),false,false); rm=__builtin_fmaxf(__uint_as_float(rr[0]),__uint_as_float(rr[1])); } \
      resc=false; \
      if(__builtin_expect(__any(rm>(float)THRL),0)){ const float dl=__builtin_fmaxf(rm,0.f); mhat+=dl; \
        _Pragma("unroll") for(int r=0;r<16;++r){C0[r]-=dl;C1[r]-=dl;} \
        _Pragma("unroll") for(int r=0;r<16;++r)negm[r]=-mhat; asm volatile("":"+v"(negm)); \
        const float f=__builtin_amdgcn_exp2f(-dl); l_reg*=f; if(hi==0)wsf[r32]=f; resc=true; } } \
    SBAR(); \
    GAPB(o[0]=__builtin_amdgcn_mfma_f32_32x32x16_bf16(PAF(0),VFR(0),o[0],0,0,0), C0,0); \
    GAPB(o[1]=__builtin_amdgcn_mfma_f32_32x32x16_bf16(PAF(0),VFR(4),o[1],0,0,0), C0,4); \
    KRD(GL,0); GAPB(o[0]=__builtin_amdgcn_mfma_f32_32x32x16_bf16(PAF(1),VFR(1),o[0],0,0,0), C0,8); \
    KRD(GL,1); GAPB(o[1]=__builtin_amdgcn_mfma_f32_32x32x16_bf16(PAF(1),VFR(5),o[1],0,0,0), C0,12); \
    KRD(GL,2); GAPB(o[0]=__builtin_amdgcn_mfma_f32_32x32x16_bf16(PAF(2),VFR(2),o[0],0,0,0), C1,0); \
    KRD(GL,3); GAPB(o[1]=__builtin_amdgcn_mfma_f32_32x32x16_bf16(PAF(2),VFR(6),o[1],0,0,0), C1,4); \
    GAPB(o[0]=__builtin_amdgcn_mfma_f32_32x32x16_bf16(PAF(3),VFR(3),o[0],0,0,0), C1,8); \
    GAPB(o[1]=__builtin_amdgcn_mfma_f32_32x32x16_bf16(PAF(3),VFR(7),o[1],0,0,0), C1,12); \
    }while(0)
  int t=1;
  #undef CMASK
  #define CMASK(P0,P1,t) do{}while(0)
  for(;t+5<NT;t+=2){
    STEP(pB0,pB1,pA0,pA1,t,true,true,true);     WAIT_BAR(2); RESC(); ROT();
    STEP(pA0,pA1,pB0,pB1,t+1,true,true,true);   WAIT_BAR(2); RESC(); ROT();
  }
  #undef CMASK
  #define CMASK(P0,P1,t) do{int jb_=(t)-(NT-4); if(jb_>=0)cmask(P0,P1,jb_,wid);}while(0)
  #define ENDW(tt) do{ if((tt)+3<NT){WAIT_BAR(2);} else if((tt)+2<NT){WAIT_BAR(1);} else {WAIT_BAR(0);} }while(0)
  for(;t+1<NT;t+=2){
    STEP(pB0,pB1,pA0,pA1,t,(t+3<NT),(t+1<NT),(t+1<NT));       ENDW(t);   RESC(); ROT();
    STEP(pA0,pA1,pB0,pB1,t+1,(t+4<NT),(t+2<NT),(t+2<NT));     ENDW(t+1); RESC(); ROT();
  }
  STEP(pB0,pB1,pA0,pA1,NT-1,false,false,false); RESC();
  { float sacc=pB0[0]+pB0[1]; _Pragma("unroll") for(int r=2;r<16;++r)sacc+=pB0[r]; _Pragma("unroll") for(int r=0;r<16;++r)sacc+=pB1[r]; l_reg+=sacc;
    pw0=(u32x4){PKW(pB0,0),PKW(pB0,2),PKW(pB0,4),PKW(pB0,6)};pw1=(u32x4){PKW(pB0,8),PKW(pB0,10),PKW(pB0,12),PKW(pB0,14)};pw2=(u32x4){PKW(pB1,0),PKW(pB1,2),PKW(pB1,4),PKW(pB1,6)};pw3=(u32x4){PKW(pB1,8),PKW(pB1,10),PKW(pB1,12),PKW(pB1,14)};
    SBAR(); pv(o,vb0+sl_cur,PAF(0),PAF(1),PAF(2),PAF(3)); }
  #undef PKW
  #undef PAF
  #undef VFR
  #undef PIN
  #undef MX3
  #undef GAPA
  #undef GAPB
  #undef EX
  #undef VRD
  #undef KRD
  #undef STEP
  #undef ENDW
  {auto rr=__builtin_amdgcn_permlane32_swap(__float_as_uint(l_reg),__float_as_uint(l_reg),false,false);l_reg=__uint_as_float(rr[0])+__uint_as_float(rr[1]);}
  if(hi==0)wsf[32+r32]=l_reg;asm volatile("s_waitcnt lgkmcnt(0)":::"memory");
  float rli[16];
  #pragma unroll
  for(int r=0;r<16;++r)rli[r]=__builtin_amdgcn_rcpf(wsf[32+crow(r,hi)]);
  bf16*Ow=O+(rowbase+q0+wid*QBLK)*DM+vcol;
  { bf16*stg=(bf16*)(shm+LDS_OST)+wid*2048;
    #pragma unroll
    for(int r=0;r<16;++r){const int orow=crow(r,hi);
      #pragma unroll
      for(int d0=0;d0<2;++d0)stg[orow*64+d0*32+r32]=__float2bfloat16(o[d0][r]*rli[r]);}
    asm volatile("s_waitcnt lgkmcnt(0)":::"memory");
    #pragma unroll
    for(int i=0;i<4;++i){const int row=i*8+(lane>>3),ch=lane&7; const u32x4 v=*(const u32x4*)(stg+row*64+ch*8); ATTN_STORE16(Ow+(long)row*DM+ch*8,v);} }
  asm volatile("s_waitcnt lgkmcnt(0)\n\ts_barrier":::"memory");
  #undef DMA_K
  #undef DMA_V
  #undef CMASK
  #undef START
  #undef RESC
  #undef ROT
}
constexpr int ATTN_LDS_BYTES=LDS_BYTES;
struct AttnTensors { const bf16* Q; const bf16* K; const bf16* V; bf16* O; };
struct AttnUnit { int var; int qb; };
struct StaticOrder {
  int vcu;
  __device__ __forceinline__ explicit StaticOrder(int v):vcu(v){}
  __device__ __forceinline__ bool next(int i,AttnUnit&u)const{ if(i>=4)return false; const int s=vcu&15; u.var=vcu>>4; u.qb=(i==0)?s:(i==1)?31-s:(i==2)?32+s:63-s; return true; }
};
template<class Sched,int THRL=8> __device__ __forceinline__ void attn_phase(char*lds,const AttnTensors&T,const Sched&S){
  AttnUnit u;
  for(int i=0;S.next(i,u);++i){ const int h=u.var>>2,mp=(u.var>>1)&1,vh=u.var&1;
    attn_unit<THRL>(h*128+mp*64,h*128+vh*64,u.qb,T.Q,T.K,T.V,T.O+(size_t)mp*SEQ*DM,lds); }
}
#undef SBAR
#undef WAIT_BAR
}
namespace attn128 {
using bf16=__hip_bfloat16;
using bf16x8=__attribute__((ext_vector_type(8)))short;
using s16x4=__attribute__((ext_vector_type(4)))short;
using f32x16=__attribute__((ext_vector_type(16)))float;
using u32x4=__attribute__((ext_vector_type(4)))unsigned;
constexpr int SEQ=16384,D=64,DM=512;
constexpr int NW=8,QBLK=32,QB=QBLK*NW,KVBLK=64,NQB=SEQ/QB;
constexpr int ATTN_PITCH=DM, ATTN_UNIT_ROWS=QB;
__device__ __forceinline__ int crow(int r,int hi){return (r&3)+8*(r>>2)+4*hi;}
#define SBAR() __builtin_amdgcn_sched_barrier(0)
__device__ __forceinline__ void cmask(f32x16&p0,f32x16&p1,int jb,int wid){
  const float NEG=-INFINITY;
  if(jb>(wid>>1)){
  #pragma unroll
  for(int r=0;r<16;++r){p0[r]=NEG;p1[r]=NEG;}}
}

constexpr int NSLOT=3, SLOTB=8192;
constexpr int LDS_K=0, LDS_V=NSLOT*SLOTB, LDS_WS=3*NSLOT*SLOTB, LDS_OST=LDS_WS+NW*64*4, LDS_BYTES=LDS_OST+NW*4096;
constexpr float C2=0.125f*1.4426950408889634f;
__device__ __forceinline__ void glds16(const void*gsrc,unsigned lds_dst){unsigned keep;
  asm volatile("s_mov_b32 %0, m0\n\ts_mov_b32 m0, %2\n\ts_nop 0\n\tglobal_load_lds_dwordx4 %1, off\n\ts_mov_b32 m0, %0":"=&s"(keep):"v"(gsrc),"s"(lds_dst):"memory");}
__device__ __forceinline__ float max3f(float a,float b,float c){float r;asm("v_max3_f32 %0, %1, %2, %3":"=v"(r):"v"(a),"v"(b),"v"(c));return r;}
__device__ __forceinline__ float max2f(float a,float b){float r;asm("v_max_f32_e32 %0, %1, %2":"=v"(r):"v"(a),"v"(b));return r;}
__device__ __forceinline__ float fadd_s(float a,float b){float r;asm("v_add_f32_e32 %0, %1, %2":"=v"(r):"v"(a),"v"(b));return r;}
__device__ __forceinline__ float fsub_s(float a,float b){float r;asm("v_sub_f32_e32 %0, %1, %2":"=v"(r):"v"(a),"v"(b));return r;}
typedef float f32x2_t __attribute__((ext_vector_type(2))); typedef __bf16 bf16x2_t __attribute__((ext_vector_type(2)));
__device__ __forceinline__ unsigned cvtpk_s(float lo,float hi){f32x2_t v={lo,hi};bf16x2_t b=__builtin_convertvector(v,bf16x2_t);return __builtin_bit_cast(unsigned,b);}
#define WAIT_BAR(N) asm volatile("s_waitcnt vmcnt(" #N ") lgkmcnt(0)\n\ts_barrier":::"memory")

__device__ __forceinline__ void qkt(f32x16&p0,f32x16&p1,const char*Kslot,const bf16x8*qr,const f32x16&negm,int r32,int hi){
  const char*kb=Kslot+hi*1024+r32*16;
  #pragma unroll
  for(int d0=0;d0<4;++d0){
    const bf16x8 b0=*reinterpret_cast<const bf16x8*>(kb+d0*2048);
    const bf16x8 b1=*reinterpret_cast<const bf16x8*>(kb+d0*2048+512);
    if(d0==0){p0=__builtin_amdgcn_mfma_f32_32x32x16_bf16(b0,qr[0],negm,0,0,0);p1=__builtin_amdgcn_mfma_f32_32x32x16_bf16(b1,qr[0],negm,0,0,0);}
    else{p0=__builtin_amdgcn_mfma_f32_32x32x16_bf16(b0,qr[d0],p0,0,0,0);p1=__builtin_amdgcn_mfma_f32_32x32x16_bf16(b1,qr[d0],p1,0,0,0);}}
}
typedef __attribute__((address_space(3))) const char* lds_cptr;
typedef short v4i16_t __attribute__((ext_vector_type(4)));
__device__ __forceinline__ void kload8(bf16x8*kf,lds_cptr kp){
  kf[0]=*(const __attribute__((address_space(3))) bf16x8*)(kp);      kf[1]=*(const __attribute__((address_space(3))) bf16x8*)(kp+512);
  kf[2]=*(const __attribute__((address_space(3))) bf16x8*)(kp+2048); kf[3]=*(const __attribute__((address_space(3))) bf16x8*)(kp+2560);
  kf[4]=*(const __attribute__((address_space(3))) bf16x8*)(kp+4096); kf[5]=*(const __attribute__((address_space(3))) bf16x8*)(kp+4608);
  kf[6]=*(const __attribute__((address_space(3))) bf16x8*)(kp+6144); kf[7]=*(const __attribute__((address_space(3))) bf16x8*)(kp+6656);
}
__device__ __forceinline__ void kload2(bf16x8*kf,lds_cptr kp,int j){ kf[2*j]=*(const __attribute__((address_space(3))) bf16x8*)(kp+j*2048); kf[2*j+1]=*(const __attribute__((address_space(3))) bf16x8*)(kp+j*2048+512); }
__device__ __forceinline__ s16x4 vtr(lds_cptr p){ return __builtin_bit_cast(s16x4,__builtin_amdgcn_ds_read_tr16_b64_v4i16((__attribute__((address_space(3))) v4i16_t*)p)); }
__device__ __forceinline__ float rowmax(const f32x16&p0,const f32x16&p1){
  float a=max3f(p0[0],p0[1],p1[0]),b=max3f(p0[2],p0[3],p1[1]);a=max3f(a,p1[2],p1[3]);
  #pragma unroll
  for(int r=4;r<16;r+=4){a=max3f(a,p0[r],p0[r+1]);b=max3f(b,p0[r+2],p0[r+3]);a=max3f(a,p1[r],p1[r+1]);b=max3f(b,p1[r+2],p1[r+3]);}
  const float m=max2f(a,b);
  auto rr=__builtin_amdgcn_permlane32_swap(__float_as_uint(m),__float_as_uint(m),false,false);
  return max2f(__uint_as_float(rr[0]),__uint_as_float(rr[1]));
}
__device__ __forceinline__ void pv(f32x16*o,int vb,bf16x8 pa0,bf16x8 pa1,bf16x8 pa2,bf16x8 pa3){
  #pragma unroll
  for(int d0=0;d0<4;++d0){s16x4 lo[4],hi[4];
    #pragma unroll
    for(int ks=0;ks<4;++ks){
      asm volatile("ds_read_b64_tr_b16 %0,%1 offset:%c2":"=&v"(lo[ks]):"v"(vb),"i"(d0*4096+ks*1024):"memory");
      asm volatile("ds_read_b64_tr_b16 %0,%1 offset:%c2":"=&v"(hi[ks]):"v"(vb),"i"(d0*4096+ks*1024+512):"memory");}
    asm volatile("s_waitcnt lgkmcnt(0)":::"memory");SBAR();
    #define PK(k) (bf16x8){lo[k][0],lo[k][1],lo[k][2],lo[k][3],hi[k][0],hi[k][1],hi[k][2],hi[k][3]}
    o[d0]=__builtin_amdgcn_mfma_f32_32x32x16_bf16(pa0,PK(0),o[d0],0,0,0);
    o[d0]=__builtin_amdgcn_mfma_f32_32x32x16_bf16(pa1,PK(1),o[d0],0,0,0);
    o[d0]=__builtin_amdgcn_mfma_f32_32x32x16_bf16(pa2,PK(2),o[d0],0,0,0);
    o[d0]=__builtin_amdgcn_mfma_f32_32x32x16_bf16(pa3,PK(3),o[d0],0,0,0);
    #undef PK
  }
}

#ifndef ATTN_STORE16
#define ATTN_STORE16(p,v) (*(u32x4*)(p)=(v))
#endif
template<int THRL> __device__ __forceinline__ void attn_unit(int qcol,int vcol,int qb,const bf16*Q,const bf16*__restrict__ K,const bf16*__restrict__ V,bf16*O,char*shm){
  const int tid=threadIdx.x,lane=tid&63,r32=lane&31,hi=lane>>5; const int wid=__builtin_amdgcn_readfirstlane(tid>>6);
  const long rowbase=0; const int q0=qb*QB;
  const bf16*Qw=Q+(rowbase+q0+wid*QBLK)*DM+qcol;
  const bf16*Kh=K+rowbase*DM+qcol,*Vh=V+rowbase*DM+vcol;
  const unsigned lds0=(unsigned)(uintptr_t)shm;
  float*wsf=(float*)(shm+LDS_WS)+wid*64;
  const bf16*ksrc=Kh+(long)lane*DM+wid*8;
  const bf16*vsrc=Vh+(long)(16*(wid&3)+(lane>>2))*DM+(wid>>2)*32+(lane&3)*8;
  const unsigned kdst=lds0+LDS_K+wid*1024, vdst=lds0+LDS_V+wid*1024;
  #define DMA_K(t,slot) glds16(ksrc+(long)(t)*KVBLK*DM,(unsigned)__builtin_amdgcn_readfirstlane(kdst+(slot)))
  #define DMA_V(t,slot) do{ glds16(vsrc+(long)(t)*KVBLK*DM,(unsigned)__builtin_amdgcn_readfirstlane(vdst+2*(slot))); glds16(vsrc+64+(long)(t)*KVBLK*DM,(unsigned)__builtin_amdgcn_readfirstlane(vdst+2*(slot)+8192)); }while(0)
  const int vb0=(int)(lds0+LDS_V)+((lane>>4)&1)*32+(lane&3)*8+(4*hi+((lane&15)>>2))*64;
  const char*Kbase=shm+LDS_K; bf16x8 kf[8];
  const lds_cptr shm3=(lds_cptr)shm; const lds_cptr kp0=shm3+LDS_K+hi*1024+r32*16; const lds_cptr vp0=shm3+LDS_V+((lane>>4)&1)*32+(lane&3)*8+(4*hi+((lane&15)>>2))*64;
  const int NT=(q0+QB)/KVBLK;
  DMA_K(0,0);DMA_V(0,0);DMA_K(1,SLOTB);
  bf16x8 qr[4];
  #pragma unroll
  for(int d0=0;d0<4;++d0)qr[d0]=*reinterpret_cast<const bf16x8*>(&Qw[(long)r32*DM+d0*16+hi*8]);
  float mhat=0.f,l_reg=0.f;f32x16 o[4];o[0]=f32x16{};o[1]=f32x16{};o[2]=f32x16{};o[3]=f32x16{};const f32x16 negm=f32x16{};
  const int qrel=wid*QBLK+r32;
  #define CMASK(P0,P1,t) do{int jb_=(t)-(NT-4); if(jb_>=0)cmask(P0,P1,jb_,wid);}while(0)
  bool resc=false;
  #define START(P0,P1) do{ const float rm=rowmax(P0,P1); resc=false; \
    { const float dl=rm; mhat=fadd_s(mhat,dl); \
      _Pragma("unroll") for(int r=0;r<16;++r){P0[r]=fsub_s(P0[r],dl);P1[r]=fsub_s(P1[r],dl);} \
      } \
    _Pragma("unroll") for(int r=0;r<16;++r)P0[r]=__builtin_amdgcn_exp2f(P0[r]); }while(0)
  #define RESC() do{ if(resc){ asm volatile("s_waitcnt lgkmcnt(0)":::"memory"); \
      _Pragma("unroll") for(int d_=0;d_<4;++d_) _Pragma("unroll") for(int r=0;r<16;++r)o[d_][r]*=wsf[crow(r,hi)]; } }while(0)
  f32x16 pA0,pA1,pB0,pB1;
  int sl_prev=0,sl_cur=0,sl_next=SLOTB;
  #define ROT() do{sl_prev=sl_cur;sl_cur=sl_next;sl_next=(sl_next==(NSLOT-1)*SLOTB)?0:sl_next+SLOTB;}while(0)
  DMA_K(2,2*SLOTB);
  WAIT_BAR(4);
  qkt(pA0,pA1,Kbase,qr,negm,r32,hi);asm volatile("s_nop 15\n\ts_nop 7":"+v"(pA0),"+v"(pA1));CMASK(pA0,pA1,0);
  START(pA0,pA1);
  _Pragma("unroll") for(int r=0;r<16;++r)pA1[r]=__builtin_amdgcn_exp2f(pA1[r]);
  WAIT_BAR(0);
  DMA_K(3,0);DMA_V(1,SLOTB);
  ROT();
  kload8(kf,kp0+sl_cur);
  WAIT_BAR(3);
  s16x4 vlo[8],vhi[8]; u32x4 pw0,pw1,pw2,pw3;
  #define PKW(P,B) cvtpk_s(P[B],P[B+1])
  #define PAF(k) __builtin_bit_cast(bf16x8,pw##k)
  #define VFR(i) (bf16x8){vlo[i][0],vlo[i][1],vlo[i][2],vlo[i][3],vhi[i][0],vhi[i][1],vhi[i][2],vhi[i][3]}
  #define PIN(x) asm volatile("":"+v"(x))
  #define MX3(a,b,c) __builtin_fmaxf(__builtin_fmaxf((a),(b)),(c))
  #define GAPA(MF,A0,A1,A2,A3,W0,W1,PW) do{ MF; sacc+=A0; sacc+=A1; sacc+=A2; sacc+=A3; PIN(sacc); W0; W1; PIN(PW); SBAR(); }while(0)
  #define EX(v) __builtin_amdgcn_exp2f(v)
  #define GAPB(MF,X,B) do{ MF; X[B]=EX(X[B]); X[B+1]=EX(X[B+1]); X[B+2]=EX(X[B+2]); X[B+3]=EX(X[B+3]); PIN(X); SBAR(); }while(0)
  #define VRD(i) do{ vlo[i]=vtr(vp_+(((i)>>2)*4096+((i)&3)*1024)); vhi[i]=vtr(vp_+(((i)>>2)*4096+((i)&3)*1024+512)); }while(0)
  #define VRD2(i) do{ vlo[i]=vtr(vp_+((2+((i)>>2))*4096+((i)&3)*1024)); vhi[i]=vtr(vp_+((2+((i)>>2))*4096+((i)&3)*1024+512)); SBAR(); }while(0)
  #define GAPB2(MF,X,B) do{ MF; X[B]=EX(X[B]-mhat); X[B+1]=EX(X[B+1]-mhat); PIN(X); SBAR(); }while(0)
  #define KRD(G,j) do{ if(G){ kload2(kf,kp0+sl_next,j); SBAR(); } }while(0)
  #define STEP(C0,C1,P0,P1,t,GK,GV,GL) do{ SBAR(); \
    const lds_cptr vp_=vp0+2*sl_prev; \
    VRD(0); SBAR(); float sacc=(P0[0]+P0[1]); \
    GAPA(C0=__builtin_amdgcn_mfma_f32_32x32x16_bf16(kf[0],qr[0],negm,0,0,0), P0[2],P0[3],P0[4],P0[5],     pw0[0]=PKW(P0,0), pw0[1]=PKW(P0,2), pw0); \
    VRD(4); SBAR(); GAPA(C1=__builtin_amdgcn_mfma_f32_32x32x16_bf16(kf[1],qr[0],negm,0,0,0), P0[6],P0[7],P0[8],P0[9],     pw0[2]=PKW(P0,4), pw0[3]=PKW(P0,6), pw0); \
    VRD(1); SBAR(); GAPA(C0=__builtin_amdgcn_mfma_f32_32x32x16_bf16(kf[2],qr[1],C0,0,0,0),   P0[10],P0[11],P0[12],P0[13], pw1[0]=PKW(P0,8), pw1[1]=PKW(P0,10), pw1); \
    VRD(5); SBAR(); GAPA(C1=__builtin_amdgcn_mfma_f32_32x32x16_bf16(kf[3],qr[1],C1,0,0,0),   P0[14],P0[15],P1[0],P1[1],   pw1[2]=PKW(P0,12),pw1[3]=PKW(P0,14), pw1); \
    GAPA(C0=__builtin_amdgcn_mfma_f32_32x32x16_bf16(kf[4],qr[2],C0,0,0,0),   P1[2],P1[3],P1[4],P1[5],     pw2[0]=PKW(P1,0), pw2[1]=PKW(P1,2), pw2); \
    GAPA(C1=__builtin_amdgcn_mfma_f32_32x32x16_bf16(kf[5],qr[2],C1,0,0,0),   P1[6],P1[7],P1[8],P1[9],     pw2[2]=PKW(P1,4), pw2[3]=PKW(P1,6), pw2); \
    GAPA(C0=__builtin_amdgcn_mfma_f32_32x32x16_bf16(kf[6],qr[3],C0,0,0,0),   P1[10],P1[11],P1[12],P1[13], pw3[0]=PKW(P1,8), pw3[1]=PKW(P1,10), pw3); \
    GAPA(C1=__builtin_amdgcn_mfma_f32_32x32x16_bf16(kf[7],qr[3],C1,0,0,0),   P1[14],P1[15],0.f,0.f,       pw3[2]=PKW(P1,12),pw3[3]=PKW(P1,14), pw3); \
    l_reg+=sacc; \
    if(GK){DMA_K((t)+3,sl_cur);} if(GV){DMA_V((t)+1,sl_next);} \
    CMASK(C0,C1,t); \
    { float a=MX3(C0[0],C0[1],C1[0]),b=MX3(C0[2],C0[3],C1[1]); a=MX3(a,C1[2],C1[3]); \
      _Pragma("unroll") for(int r=4;r<16;r+=4){a=MX3(a,C0[r],C0[r+1]);b=MX3(b,C0[r+2],C0[r+3]);a=MX3(a,C1[r],C1[r+1]);b=MX3(b,C1[r+2],C1[r+3]);} \
      float rm=__builtin_fmaxf(a,b); { auto rr=__builtin_amdgcn_permlane32_swap(__float_as_uint(rm),__float_as_uint(rm),false,false); rm=__builtin_fmaxf(__uint_as_float(rr[0]),__uint_as_float(rr[1])); } \
      resc=false; const float rmr=rm-mhat; \
      if(__builtin_expect(__any(rmr>(float)THRL),0)){ const float dl=__builtin_fmaxf(rmr,0.f); mhat+=dl; \
        const float f=__builtin_amdgcn_exp2f(-dl); l_reg*=f; if(hi==0)wsf[r32]=f; resc=true; } } \
    SBAR(); \
    VRD(2); SBAR(); GAPB2(o[0]=__builtin_amdgcn_mfma_f32_32x32x16_bf16(PAF(0),VFR(0),o[0],0,0,0), C0,0); \
    VRD(6); SBAR(); GAPB2(o[1]=__builtin_amdgcn_mfma_f32_32x32x16_bf16(PAF(0),VFR(4),o[1],0,0,0), C0,2); \
    VRD(3); SBAR(); GAPB2(o[0]=__builtin_amdgcn_mfma_f32_32x32x16_bf16(PAF(1),VFR(1),o[0],0,0,0), C0,4); \
    VRD(7); SBAR(); GAPB2(o[1]=__builtin_amdgcn_mfma_f32_32x32x16_bf16(PAF(1),VFR(5),o[1],0,0,0), C0,6); \
    VRD2(0); GAPB2(o[0]=__builtin_amdgcn_mfma_f32_32x32x16_bf16(PAF(2),VFR(2),o[0],0,0,0), C0,8); \
    VRD2(4); GAPB2(o[1]=__builtin_amdgcn_mfma_f32_32x32x16_bf16(PAF(2),VFR(6),o[1],0,0,0), C0,10); \
    VRD2(1); GAPB2(o[0]=__builtin_amdgcn_mfma_f32_32x32x16_bf16(PAF(3),VFR(3),o[0],0,0,0), C0,12); \
    VRD2(5); GAPB2(o[1]=__builtin_amdgcn_mfma_f32_32x32x16_bf16(PAF(3),VFR(7),o[1],0,0,0), C0,14); \
    VRD2(2); GAPB2(o[2]=__builtin_amdgcn_mfma_f32_32x32x16_bf16(PAF(0),VFR(0),o[2],0,0,0), C1,0); \
    VRD2(6); GAPB2(o[3]=__builtin_amdgcn_mfma_f32_32x32x16_bf16(PAF(0),VFR(4),o[3],0,0,0), C1,2); \
    VRD2(3); KRD(GL,0); GAPB2(o[2]=__builtin_amdgcn_mfma_f32_32x32x16_bf16(PAF(1),VFR(1),o[2],0,0,0), C1,4); \
    VRD2(7); KRD(GL,1); GAPB2(o[3]=__builtin_amdgcn_mfma_f32_32x32x16_bf16(PAF(1),VFR(5),o[3],0,0,0), C1,6); \
    KRD(GL,2); GAPB2(o[2]=__builtin_amdgcn_mfma_f32_32x32x16_bf16(PAF(2),VFR(2),o[2],0,0,0), C1,8); \
    KRD(GL,3); GAPB2(o[3]=__builtin_amdgcn_mfma_f32_32x32x16_bf16(PAF(2),VFR(6),o[3],0,0,0), C1,10); \
    GAPB2(o[2]=__builtin_amdgcn_mfma_f32_32x32x16_bf16(PAF(3),VFR(3),o[2],0,0,0), C1,12); \
    GAPB2(o[3]=__builtin_amdgcn_mfma_f32_32x32x16_bf16(PAF(3),VFR(7),o[3],0,0,0), C1,14); \
    }while(0)
  int t=1;
  #undef CMASK
  #define CMASK(P0,P1,t) do{}while(0)
  for(;t+5<NT;t+=2){
    STEP(pB0,pB1,pA0,pA1,t,true,true,true);     WAIT_BAR(3); RESC(); ROT();
    STEP(pA0,pA1,pB0,pB1,t+1,true,true,true);   WAIT_BAR(3); RESC(); ROT();
  }
  #undef CMASK
  #define CMASK(P0,P1,t) do{int jb_=(t)-(NT-4); if(jb_>=0)cmask(P0,P1,jb_,wid);}while(0)
  #define ENDW(tt) do{ if((tt)+3<NT){WAIT_BAR(3);} else if((tt)+2<NT){WAIT_BAR(2);} else {WAIT_BAR(0);} }while(0)
  for(;t+1<NT;t+=2){
    STEP(pB0,pB1,pA0,pA1,t,(t+3<NT),(t+1<NT),(t+1<NT));       ENDW(t);   RESC(); ROT();
    STEP(pA0,pA1,pB0,pB1,t+1,(t+4<NT),(t+2<NT),(t+2<NT));     ENDW(t+1); RESC(); ROT();
  }
  STEP(pB0,pB1,pA0,pA1,NT-1,false,false,false); RESC();
  { float sacc=pB0[0]+pB0[1]; _Pragma("unroll") for(int r=2;r<16;++r)sacc+=pB0[r]; _Pragma("unroll") for(int r=0;r<16;++r)sacc+=pB1[r]; l_reg+=sacc;
    pw0=(u32x4){PKW(pB0,0),PKW(pB0,2),PKW(pB0,4),PKW(pB0,6)};pw1=(u32x4){PKW(pB0,8),PKW(pB0,10),PKW(pB0,12),PKW(pB0,14)};pw2=(u32x4){PKW(pB1,0),PKW(pB1,2),PKW(pB1,4),PKW(pB1,6)};pw3=(u32x4){PKW(pB1,8),PKW(pB1,10),PKW(pB1,12),PKW(pB1,14)};
    SBAR(); pv(o,vb0+2*sl_cur,PAF(0),PAF(1),PAF(2),PAF(3)); }
  #undef PKW
  #undef PAF
  #undef VFR
  #undef PIN
  #undef MX3
  #undef GAPA
  #undef GAPB
  #undef GAPB2
  #undef VRD2
  #undef EX
  #undef VRD
  #undef KRD
  #undef STEP
  #undef ENDW
  {auto rr=__builtin_amdgcn_permlane32_swap(__float_as_uint(l_reg),__float_as_uint(l_reg),false,false);l_reg=__uint_as_float(rr[0])+__uint_as_float(rr[1]);}
  if(hi==0)wsf[32+r32]=l_reg;asm volatile("s_waitcnt lgkmcnt(0)":::"memory");
  float rli[16];
  #pragma unroll
  for(int r=0;r<16;++r)rli[r]=__builtin_amdgcn_rcpf(wsf[32+crow(r,hi)]);
  bf16*Ow=O+(rowbase+q0+wid*QBLK)*DM+vcol;
  { bf16*stg=(bf16*)(shm+LDS_OST)+wid*2048;
    #pragma unroll
    for(int hf=0;hf<2;++hf){
    #pragma unroll
    for(int r=0;r<16;++r){const int orow=crow(r,hi);
      #pragma unroll
      for(int d0=0;d0<2;++d0)stg[orow*64+d0*32+r32]=__float2bfloat16(o[2*hf+d0][r]*rli[r]);}
    asm volatile("s_waitcnt lgkmcnt(0)":::"memory");
    #pragma unroll
    for(int i=0;i<4;++i){const int row=i*8+(lane>>3),ch=lane&7; const u32x4 v=*(const u32x4*)(stg+row*64+ch*8); ATTN_STORE16(Ow+(long)row*DM+hf*64+ch*8,v);}
    asm volatile("s_waitcnt lgkmcnt(0)":::"memory"); } }
  asm volatile("s_waitcnt lgkmcnt(0)\n\ts_barrier":::"memory");
  #undef DMA_K
  #undef DMA_V
  #undef CMASK
  #undef START
  #undef RESC
  #undef ROT
}
constexpr int ATTN_LDS_BYTES=LDS_BYTES;
struct AttnTensors { const bf16* Q; const bf16* K; const bf16* V; bf16* O; };
struct AttnUnit { int var; int qb; };
struct StaticOrder {
  int vcu;
  __device__ __forceinline__ explicit StaticOrder(int v):vcu(v){}
  __device__ __forceinline__ bool next(int i,AttnUnit&u)const{ if(i>=2)return false; const int s=vcu&31; u.var=vcu>>5; u.qb=(i==0)?s:63-s; return true; }
};
template<class Sched,int THRL=8> __device__ __forceinline__ void attn_phase(char*lds,const AttnTensors&T,const Sched&S){
  AttnUnit u;
  for(int i=0;S.next(i,u);++i){ const int h=u.var>>1,mp=u.var&1;
    attn_unit<THRL>(h*128+mp*64,h*128,u.qb,T.Q,T.K,T.V,T.O+(size_t)mp*SEQ*DM,lds); }
}
#undef SBAR
#undef WAIT_BAR
}


#define GAS __attribute__((address_space(1)))
#define LAS __attribute__((address_space(3)))
typedef unsigned short bf16;
typedef unsigned v4u __attribute__((ext_vector_type(4)));
typedef float f32x4 __attribute__((ext_vector_type(4)));
typedef short bf16x8 __attribute__((ext_vector_type(8)));
typedef GAS unsigned gu32;
typedef GAS unsigned long long gu64;
#define RLX_AGENT __ATOMIC_RELAXED, __HIP_MEMORY_SCOPE_AGENT
#define LDS_WAIT() asm volatile("s_waitcnt lgkmcnt(0)" ::: "memory")
#define VM_WAIT() asm volatile("s_waitcnt vmcnt(0)" ::: "memory")
__device__ __forceinline__ unsigned long long rt() { return __builtin_amdgcn_s_memrealtime(); }
__device__ __forceinline__ unsigned f2bf(float f) { unsigned u = __builtin_bit_cast(unsigned, f); return (u + 0x7fffu + ((u >> 16) & 1u)) >> 16; }
__device__ __forceinline__ unsigned pk2(float lo, float hi) { return f2bf(lo) | (f2bf(hi) << 16); }

#define XB_TMO      128
#define XB_XCNT(j)  (256  + 64 * (j))
#define XB_XSUB(j)  (1280 + 64 * (j))
#define XB_XGEN(j)  (2304 + 64 * (j))
#define XB_TOP      3328
#define XB_TOPGEN   3392
#define XCD_BAR_WORDS 3456
#define XB_SPIN_CAP (1u << 18)

__device__ __forceinline__ unsigned xb_ld(unsigned* p)              { return __hip_atomic_load(p, __ATOMIC_RELAXED, __HIP_MEMORY_SCOPE_AGENT); }
__device__ __forceinline__ unsigned xb_add(unsigned* p, unsigned v) { return __hip_atomic_fetch_add(p, v, __ATOMIC_RELAXED, __HIP_MEMORY_SCOPE_AGENT); }
__device__ __forceinline__ unsigned xb_xcc_id() { return (unsigned)__builtin_amdgcn_s_getreg((3 << 11) | 20) & 0xFu; }
#define XB_SPIN(cond, bar) do { unsigned _sp = 0; while (cond) { __builtin_amdgcn_s_sleep(1); \
    if ((++_sp & 255u) == 0u) { if (xb_ld(&(bar)[XB_TMO])) break; if (_sp > XB_SPIN_CAP) { atomicAdd(&(bar)[XB_TMO], 1u); break; } } } } while (0)

struct XcdBarrier {
    unsigned* bar; unsigned x;
    volatile LAS unsigned* st;
};

__device__ __forceinline__ XcdBarrier xcd_barrier_post(unsigned* bar, volatile LAS unsigned* st) {
    XcdBarrier b; b.bar = bar; b.x = xb_xcc_id(); b.st = st;
    if (threadIdx.x == 0) (void)xb_add(&bar[XB_XCNT(b.x)], 1u);
    return b;
}
__device__ __forceinline__ void xcd_barrier_complete(unsigned* bar, unsigned x, unsigned& nloc, unsigned& nx) {
    const unsigned G = gridDim.x * gridDim.y * gridDim.z;
    unsigned sum, cnt, mine, sp = 0u;
    for (;;) {
        sum = 0u; cnt = 0u; mine = 0u;
#pragma unroll
        for (unsigned j = 0; j < 16; ++j) { const unsigned c = xb_ld(&bar[XB_XCNT(j)]); sum += c; cnt += (c > 0u) ? 1u : 0u; mine = (j == x) ? c : mine; }
        if (sum == G) break;
        __builtin_amdgcn_s_sleep(1);
        if ((++sp & 255u) == 0u) { if (xb_ld(&bar[XB_TMO])) break; if (sp > XB_SPIN_CAP) { atomicAdd(&bar[XB_TMO], 1u); break; } }
    }
    nloc = mine > 0u ? mine : 1u; nx = cnt > 0u ? cnt : 1u;
}

__device__ __forceinline__ void xcd_barrier(const XcdBarrier& b) {
    asm volatile("s_waitcnt vmcnt(0)" ::: "memory");
    __syncthreads();
    if (threadIdx.x == 0) {
        unsigned* bar = b.bar;
        __builtin_amdgcn_s_waitcnt(0);
        unsigned nloc = b.st[0], nx = b.st[1];
        if (nloc == 0u) { xcd_barrier_complete(bar, b.x, nloc, nx); b.st[0] = nloc; b.st[1] = nx; }
        const unsigned old = xb_add(&bar[XB_XSUB(b.x)], 1u);
        const unsigned gen = old / nloc;
        if (old + 1u == (gen + 1u) * nloc) {
            __builtin_amdgcn_fence(__ATOMIC_RELEASE, "agent");
            asm volatile("s_waitcnt vmcnt(0)" ::: "memory");
            const unsigned og = xb_add(&bar[XB_TOP], 1u);
            const unsigned tg = og / nx;
            if (og + 1u == (tg + 1u) * nx) xb_add(&bar[XB_TOPGEN], 1u);
            else XB_SPIN(xb_ld(&bar[XB_TOPGEN]) == tg, bar);
            __builtin_amdgcn_fence(__ATOMIC_ACQUIRE, "agent");
            xb_add(&bar[XB_XGEN(b.x)], 1u);
            asm volatile("s_waitcnt vmcnt(0)" ::: "memory");
        } else {
            XB_SPIN(xb_ld(&bar[XB_XGEN(b.x)]) == gen, bar);
            __builtin_amdgcn_fence(__ATOMIC_ACQUIRE, "agent");
            asm volatile("s_waitcnt vmcnt(0)" ::: "memory");
        }
    }
    __syncthreads();
}

constexpr int NWAVES = 8;
constexpr int M = 16384, D = 1024, INC = 2560, AW = 512, LW = 512, NQ = 2048, NEXP = 16384;
constexpr float EPSN = 1e-6f;
constexpr size_t MiB = 1u << 20;
constexpr size_t WS_CTL = 0, CTL_ZERO_BYTES = 1 * MiB;
constexpr size_t WS_ROWSS2 = 512 * 1024;
constexpr size_t WS_RS1 = 1 * MiB;
constexpr size_t WS_SK1 = 1 * MiB + 128 * 1024, WS_SK2 = WS_SK1 + 32 * 1024;
constexpr size_t WS_WIN = 2 * MiB, WS_WOUT = 8 * MiB, WS_WQ = 10 * MiB;
constexpr size_t WS_ED = 16 * MiB, WS_EU = 48 * MiB;
constexpr size_t WS_SCD = 32 * MiB, WS_SCU = 33 * MiB;
constexpr size_t WS_WQ8 = 170 * MiB;
constexpr size_t WS_XB = 80 * MiB;
constexpr size_t WS_OS = 80 * MiB;
constexpr size_t WS_Q2 = 80 * MiB;
constexpr size_t WS_Q = 112 * MiB, WS_SPLIT = 16 * MiB;
constexpr size_t WS_GATE = WS_Q + 4 * WS_SPLIT;
constexpr size_t WS_EID = 144 * MiB, WS_GW = 152 * MiB;
constexpr size_t WS_MIX = 192 * MiB, WS_HB = 224 * MiB, WS_END = 256 * MiB;
constexpr size_t WS_ROWSS3 = 576 * 1024;
constexpr size_t WS_DOTP = 80 * MiB;
constexpr size_t WS_REC = 160 * MiB, WS_N0 = 168 * MiB;
constexpr size_t WS_PEER = 80 * MiB;
constexpr size_t WS_REC_OLD_UNUSED = 0;
constexpr int CW_BAR = 4096;
constexpr int RING_OFF = 0, RING_BYTES = 131072;
constexpr int LDSCTL_OFF = RING_BYTES, MISC_OFF = LDSCTL_OFF + 320;
constexpr int LDS_BYTES = 163840;

struct Frame {
    LAS unsigned char* lds;
    volatile LAS unsigned* MISC;
    int tid, lane, wave;
    int vcu, G;
};

__device__ __forceinline__ float wave_sum(float v) {
#pragma unroll
    for (int o = 1; o < 64; o <<= 1) v += __shfl_xor(v, o);
    return v;
}
__device__ __forceinline__ float bf2f(unsigned short b) { return __builtin_bit_cast(float, (unsigned)b << 16); }
__device__ __forceinline__ float bflo(unsigned w) { return __builtin_bit_cast(float, w << 16); }
__device__ __forceinline__ float bfhi(unsigned w) { return __builtin_bit_cast(float, w & 0xffff0000u); }
__device__ __forceinline__ float gelu_tanh(float x) { const float u = 0.7978845608028654f * (x + 0.044715f * x * x * x); return 0.5f * x * (1.0f + tanhf(u)); }
__device__ __forceinline__ float sigmoidf_(float x) { return 1.0f / (1.0f + expf(-x)); }
__device__ __forceinline__ float fsigmoid(float x) { return __builtin_amdgcn_rcpf(1.0f + __builtin_amdgcn_exp2f(-1.4426950408889634f * x)); }
__device__ __forceinline__ float fgelu_tanh(float x) { const float u = 0.7978845608028654f * (x + 0.044715f * x * x * x); const float t = 1.0f - 2.0f * __builtin_amdgcn_rcpf(1.0f + __builtin_amdgcn_exp2f(2.8853900817779268f * u)); return 0.5f * x * (1.0f + t); }

__device__ __forceinline__ void p0_transpose_item(const float* W, int K, int N, bf16* WT, const float* gk, LAS float* scr, int item, int lane) {
    const int nblk = N / 32, kb = item / nblk, nb = item % nblk, k0 = 64 * kb, n0 = 32 * nb;
#pragma unroll 8
    for (int i = 0; i < 32; ++i) { const int kk = 2 * i + (lane >> 5); const float g = gk ? gk[k0 + kk] : 1.0f; scr[kk * 33 + (lane & 31)] = W[(size_t)(k0 + kk) * N + n0 + (lane & 31)] * g; }
    LDS_WAIT(); asm volatile("" ::: "memory");
    const int c = lane & 7;
#pragma unroll
    for (int j = 0; j < 4; ++j) { const int n = (lane >> 3) + 8 * j; const LAS float* s = scr + (8 * c) * 33 + n;
        v4u o; o.x = pk2(s[0 * 33], s[1 * 33]); o.y = pk2(s[2 * 33], s[3 * 33]); o.z = pk2(s[4 * 33], s[5 * 33]); o.w = pk2(s[6 * 33], s[7 * 33]);
        *(GAS v4u*)(WT + (size_t)(n0 + n) * K + k0 + 8 * c) = o; }
    LDS_WAIT(); asm volatile("" ::: "memory");
}
template <int NR> __device__ __forceinline__ void p0_rows(const float* xrow, bf16* orow, const float* gk, float* rs, int lane) {
    f32x4 v[NR][4];
#pragma unroll
    for (int i = 0; i < NR; ++i)
#pragma unroll
        for (int j = 0; j < 4; ++j) v[i][j] = __builtin_nontemporal_load((const GAS f32x4*)(xrow + (size_t)i * 1024) + lane + 64 * j);
#pragma unroll
    for (int i = 0; i < NR; ++i) {
        if (rs) { float s = 0.f;
#pragma unroll
            for (int j = 0; j < 4; ++j) s += (v[i][j].x * v[i][j].x + v[i][j].y * v[i][j].y) + (v[i][j].z * v[i][j].z + v[i][j].w * v[i][j].w);
            const float tot = wave_sum(s); if (lane == 0) rs[i] = 1.0f / sqrtf(tot * (1.0f / 1024.0f) + EPSN); }
        if (gk) {
#pragma unroll
            for (int j = 0; j < 4; ++j) v[i][j] = v[i][j] * ((const GAS f32x4*)gk)[lane + 64 * j]; }
        GAS unsigned long long* o8 = (GAS unsigned long long*)(orow + (size_t)i * 1024) + lane;
#pragma unroll
        for (int j = 0; j < 4; ++j) o8[64 * j] = (unsigned long long)pk2(v[i][j].x, v[i][j].y) | ((unsigned long long)pk2(v[i][j].z, v[i][j].w) << 32);
    }
}

struct Args { const float* in[23]; float* out; unsigned char* ws; int ph_lo, ph_hi; };

__device__ __forceinline__ void p0_prologue(Frame& F, const Args& a) {
    LAS float* scr = (LAS float*)(F.lds + RING_OFF + F.wave * 16384);
    unsigned char* ws = a.ws;
    const int gw = F.vcu * NWAVES + F.wave, NGW = F.G * NWAVES;
    constexpr int I_IN = (D / 64) * (INC / 32), I_OUT = (D / 64) * (D / 32), I_Q = (D / 64) * (NQ / 32);
    constexpr int NITEMS = I_IN + I_OUT + I_Q;
    for (int it = gw; it < NITEMS; it += NGW) {
        int r = it;
        if (r < I_IN) { p0_transpose_item(a.in[2], D, INC, (bf16*)(ws + WS_WIN), a.in[1], scr, r, F.lane); continue; } r -= I_IN;
        if (r < I_OUT) { p0_transpose_item(a.in[15], D, D, (bf16*)(ws + WS_WOUT), nullptr, scr, r, F.lane); continue; } r -= I_OUT;
        p0_transpose_item(a.in[17], D, NQ, (bf16*)(ws + WS_WQ), a.in[16], scr, r, F.lane);
    }
    constexpr int NGRP = (M + 32) / 4;
    for (int m = gw; m < NGRP; m += NGW) {
        int r = 4 * m;
        if (r < M) { p0_rows<4>(a.in[0] + (size_t)r * D, (bf16*)(ws + WS_XB) + (size_t)r * D, nullptr, (float*)(ws + WS_RS1) + r, F.lane); continue; } r -= M;
        if (r < 16) { p0_rows<4>(a.in[18] + (size_t)r * 1024, (bf16*)(ws + WS_SK1) + (size_t)r * 1024, nullptr, nullptr, F.lane); continue; } r -= 16;
        p0_rows<4>(a.in[19] + (size_t)r * 1024, (bf16*)(ws + WS_SK2) + (size_t)r * 1024, nullptr, nullptr, F.lane);
    }
}
template <int NR> __device__ __forceinline__ void q8_load(f32x4 (&v)[NR][4], const float* xrow, int lane) {
#pragma unroll
    for (int i = 0; i < NR; ++i)
#pragma unroll
        for (int j = 0; j < 4; ++j) v[i][j] = __builtin_nontemporal_load((const GAS f32x4*)(xrow + (size_t)i * 1024) + lane + 64 * j);
}
template <int NR> __device__ __forceinline__ void q8_finish(f32x4 (&v)[NR][4], unsigned char* orow, const float* gk, float* scale, int lane) {
#pragma unroll
    for (int i = 0; i < NR; ++i) {
        float am = 0.f;
#pragma unroll
        for (int j = 0; j < 4; ++j) { if (gk) v[i][j] = v[i][j] * ((const GAS f32x4*)gk)[lane + 64 * j];
            am = fmaxf(fmaxf(am, fmaxf(fabsf(v[i][j].x), fabsf(v[i][j].y))), fmaxf(fabsf(v[i][j].z), fabsf(v[i][j].w))); }
#pragma unroll
        for (int o = 1; o < 64; o <<= 1) am = fmaxf(am, __shfl_xor(am, o));
        const float sc = (am > 0.f) ? am * (1.0f / 127.0f) : 1.0f, inv = 1.0f / sc;
        if (lane == 0) scale[i] = sc;
        GAS unsigned* o4 = (GAS unsigned*)(orow + (size_t)i * 1024) + lane;
#pragma unroll
        for (int j = 0; j < 4; ++j) { const int q0 = (int)__builtin_rintf(v[i][j].x * inv), q1 = (int)__builtin_rintf(v[i][j].y * inv), q2 = (int)__builtin_rintf(v[i][j].z * inv), q3 = (int)__builtin_rintf(v[i][j].w * inv);
            o4[64 * j] = ((unsigned)q0 & 255u) | (((unsigned)q1 & 255u) << 8) | (((unsigned)q2 & 255u) << 16) | ((unsigned)q3 << 24); }
    }
}
__device__ __forceinline__ const float* cvx_src(const Args& a, int m) { const int r = 4 * m; return (r < NEXP) ? a.in[20] + (size_t)r * D : a.in[21] + (size_t)(r - NEXP) * D; }
__device__ __forceinline__ void cvx_finish(const Args& a, f32x4 (&v)[4][4], int m, int lane) {
    unsigned char* ws = a.ws; const int r = 4 * m;
    if (r < NEXP) q8_finish<4>(v, ws + WS_ED + (size_t)r * D, a.in[16], (float*)(ws + WS_SCD) + r, lane);
    else          q8_finish<4>(v, ws + WS_EU + (size_t)(r - NEXP) * D, nullptr, (float*)(ws + WS_SCU) + (r - NEXP), lane);
}
__device__ __forceinline__ void convert_experts(const Args& a, int w, int nw, int lane) {
    constexpr int TOT = NEXP / 4;
    int m = w; if (m >= TOT) return;
    f32x4 va[4][4], vb[4][4];
    q8_load<4>(va, cvx_src(a, m), lane);
    for (;;) {
        const bool hb = m + nw < TOT; if (hb) q8_load<4>(vb, cvx_src(a, m + nw), lane);
        cvx_finish(a, va, m, lane);
        if (!hb) break;
        const bool ha = m + 2 * nw < TOT; if (ha) q8_load<4>(va, cvx_src(a, m + 2 * nw), lane);
        cvx_finish(a, vb, m + nw, lane);
        if (!ha) break;
        m += 2 * nw;
    }
}

typedef float f32x16 __attribute__((ext_vector_type(16)));
__device__ __forceinline__ void lru_local_unit(Frame& F, const Args& a, int c) {
    constexpr int YP = 520;
    LAS unsigned short* Y = (LAS unsigned short*)(F.lds + RING_OFF);
    const int e = F.tid, r0 = c * 64;
    const bf16* XR = (const bf16*)(a.ws + WS_Q + 3 * WS_SPLIT);
    unsigned* HLAC = (unsigned*)a.out;
    float* CH = a.out + (size_t)M * 512; float* CA = CH + (size_t)(M / 64) * 512;
    { const float* conv_w = a.in[8]; const float cw0 = conv_w[e], cw1 = conv_w[512 + e], cw2 = conv_w[1024 + e], cw3 = conv_w[1536 + e], cb = a.in[9][e];
      float x0 = 0.f, x1 = 0.f, x2 = 0.f;
      if (c > 0) { x0 = bf2f(XR[(size_t)(r0 - 3) * 512 + e]); x1 = bf2f(XR[(size_t)(r0 - 2) * 512 + e]); x2 = bf2f(XR[(size_t)(r0 - 1) * 512 + e]); }
#pragma unroll 8
      for (int t = 0; t < 64; ++t) { const float x3 = bf2f(XR[(size_t)(r0 + t) * 512 + e]); Y[t * YP + e] = (unsigned short)f2bf(cb + x0 * cw0 + x1 * cw1 + x2 * cw2 + x3 * cw3); x0 = x1; x1 = x2; x2 = x3; } }
    __syncthreads();
    const int n = F.wave, lane = F.lane, r32 = lane & 31, hi = lane >> 5;
#pragma unroll 1
    for (int et = 0; et < 2; ++et) {
        bf16x8 wf[2][4];
#pragma unroll
        for (int gt = 0; gt < 2; ++gt) { const float* w = a.in[gt ? 12 : 10] + n * 4096 + 32 * et; asm volatile("" : "+s"(w));
#pragma unroll
            for (int ks = 0; ks < 4; ++ks) { float f[8];
#pragma unroll
                for (int j = 0; j < 8; ++j) f[j] = w[(16 * ks + 8 * hi + j) * 64 + r32];
                wf[gt][ks] = __builtin_bit_cast(bf16x8, (v4u){pk2(f[0], f[1]), pk2(f[2], f[3]), pk2(f[4], f[5]), pk2(f[6], f[7])}); asm volatile("" ::: "memory"); } }
        const int ch = 64 * n + 32 * et + r32;
        const float ba = a.in[11][ch], bx = a.in[13][ch], lam = a.in[14][ch];
        const float sp = (lam > 15.f) ? expf(-lam) : log1pf(expf(-lam));
        float av[2][16], bv[2][16];
#pragma unroll
        for (int tt = 0; tt < 2; ++tt) {
            f32x16 ra = {}, ia = {};
#pragma unroll
            for (int ks = 0; ks < 4; ++ks) { const bf16x8 af = *(const LAS bf16x8*)(Y + (32 * tt + r32) * YP + 64 * n + 16 * ks + 8 * hi);
                ra = __builtin_amdgcn_mfma_f32_32x32x16_bf16(af, wf[0][ks], ra, 0, 0, 0); ia = __builtin_amdgcn_mfma_f32_32x32x16_bf16(af, wf[1][ks], ia, 0, 0, 0); }
#pragma unroll
            for (int r = 0; r < 16; ++r) { const int t = 32 * tt + (r & 3) + 8 * (r >> 2) + 4 * hi;
                const float rr = fsigmoid(ra[r] + ba), ii = fsigmoid(ia[r] + bx);
                const float log_a = -8.0f * rr * sp, aa = __builtin_amdgcn_exp2f(log_a * 1.4426950408889634f);
                const float u2 = 2.0f * log_a;
                const float ser = -u2 * (1.0f + u2 * (0.5f + u2 * (0.16666667f + u2 * (0.041666668f + u2 * 0.0083333338f))));
                const float om = (u2 > -0.1f) ? ser : (1.0f - aa * aa);
                const float mult = __builtin_amdgcn_sqrtf(fmaxf(om, 1e-12f));
                av[tt][r] = aa; bv[tt][r] = mult * (ii * bf2f(Y[t * YP + ch])); }
        }
#pragma unroll
        for (int tt = 0; tt < 2; ++tt)
#pragma unroll
            for (int rq = 0; rq < 4; ++rq) { float h = 0.f, pa = 1.f;
#pragma unroll
                for (int k = 0; k < 4; ++k) { const int r = 4 * rq + k; h = av[tt][r] * h + bv[tt][r]; pa *= av[tt][r]; bv[tt][r] = h; av[tt][r] = pa; } }
        float hin[8], ain[8]; float hc = 0.f, ac = 1.f;
#pragma unroll
        for (int j = 0; j < 8; ++j) { const int tt = j >> 2, r3 = 4 * (j & 3) + 3;
#pragma unroll
            for (int own = 0; own < 2; ++own) {
                if (hi == own) { hin[j] = hc; ain[j] = ac; }
                const float mh = av[tt][r3] * hc + bv[tt][r3], ma = ac * av[tt][r3];
                const float oh = __shfl_xor(mh, 32), oa = __shfl_xor(ma, 32);
                hc = (hi == own) ? mh : oh; ac = (hi == own) ? ma : oa; } }
#pragma unroll
        for (int tt = 0; tt < 2; ++tt)
            { unsigned ob = (unsigned)((r0 + 32 * tt + 4 * hi) * 512 + ch); asm volatile("" : "+v"(ob));
#pragma unroll
            for (int r = 0; r < 16; ++r) { const int j = 4 * tt + (r >> 2); const unsigned o = ob + (unsigned)(((r & 3) + 8 * (r >> 2)) * 512);
                const float hl = bv[tt][r] + av[tt][r] * hin[j], ac = av[tt][r] * ain[j];
                HLAC[o] = pk2(hl, ac);
                if (tt == 1 && r == 15 && hi == 1) { CH[c * 512 + ch] = hl; CA[c * 512 + ch] = ac; } } }
    }
    __syncthreads();
}

__device__ __forceinline__ void fix_unit(Frame& F, const Args& a, int c, float lamv) {
    const int r0 = c * 64;
    const unsigned* HLAC = (const unsigned*)a.out; const float* CH = a.out + (size_t)M * 512; const float* CA = CH + (size_t)(M / 64) * 512;
    const bf16* GATE = (const bf16*)(a.ws + WS_GATE);
    bf16* MIX = (bf16*)(a.ws + WS_MIX);
    const int g4 = F.tid & 127, sgm = F.tid >> 7;
    LAS f32x4* SA = (LAS f32x4*)(F.lds + RING_OFF); LAS f32x4* SH = SA + 512;
    { const int L = (c + 3) >> 2; const int lo_c = sgm * L; int hi_c = lo_c + L; if (hi_c > c) hi_c = c;
      f32x4 A4 = (f32x4){1.f, 1.f, 1.f, 1.f}, H4 = (f32x4){0.f, 0.f, 0.f, 0.f};
      int cc = lo_c;
      for (; cc + 8 <= hi_c; cc += 8) { f32x4 av[8], hv[8];
#pragma unroll
          for (int k = 0; k < 8; ++k) { const size_t o = (size_t)(cc + k) * 512 + 4 * g4; av[k] = *(const GAS f32x4*)(CA + o); hv[k] = *(const GAS f32x4*)(CH + o); }
#pragma unroll
          for (int k = 0; k < 8; ++k) { H4 = av[k] * H4 + hv[k]; A4 = A4 * av[k]; } }
      for (; cc < hi_c; ++cc) { const size_t o = (size_t)cc * 512 + 4 * g4; const f32x4 av = *(const GAS f32x4*)(CA + o), hv = *(const GAS f32x4*)(CH + o); H4 = av * H4 + hv; A4 = A4 * av; }
      SA[sgm * 128 + g4] = A4; SH[sgm * 128 + g4] = H4; }
    __syncthreads();
    f32x4 hin = (f32x4){0.f, 0.f, 0.f, 0.f};
#pragma unroll
    for (int sq = 0; sq < 4; ++sq) hin = SA[sq * 128 + g4] * hin + SH[sq * 128 + g4];
    __syncthreads();
#pragma unroll 4
    for (int t = sgm * 16; t < sgm * 16 + 16; ++t) { const size_t o = (size_t)(r0 + t) * 512 + 4 * g4;
        const v4u ha = *(const GAS v4u*)(HLAC + o);
        const f32x4 h = (f32x4){bflo(ha.x), bflo(ha.y), bflo(ha.z), bflo(ha.w)} + (f32x4){bfhi(ha.x), bfhi(ha.y), bfhi(ha.z), bfhi(ha.w)} * hin; const unsigned long long gw = *(const GAS unsigned long long*)(GATE + o);
        const unsigned glo = (unsigned)gw, ghi = (unsigned)(gw >> 32);
        const unsigned long long ov = (unsigned long long)pk2(h.x * fgelu_tanh(bflo(glo)), h.y * fgelu_tanh(bfhi(glo))) | ((unsigned long long)pk2(h.z * fgelu_tanh(bflo(ghi)), h.w * fgelu_tanh(bfhi(ghi))) << 32);
        *(GAS unsigned long long*)(MIX + (size_t)(r0 + t) * 1024 + 512 + 4 * g4) = ov; }
    const bf16* OS0 = (const bf16*)(a.ws + WS_OS); const bf16* OS1 = OS0 + (size_t)M * 512;
    const float* sg = a.in[7] + (F.lane & 15) * 8;
    float sgv[8];
#pragma unroll
    for (int j = 0; j < 8; ++j) sgv[j] = sg[j] * 0.8f;
#pragma unroll 2
    for (int rr = 0; rr < 8; ++rr) { const size_t row = (size_t)(r0 + 8 * F.wave + rr);
        const v4u p = *(const GAS v4u*)(OS0 + row * 512 + F.lane * 8), q = *(const GAS v4u*)(OS1 + row * 512 + F.lane * 8);
        float d[8];
        d[0] = bflo(p.x) - lamv * bflo(q.x); d[1] = bfhi(p.x) - lamv * bfhi(q.x); d[2] = bflo(p.y) - lamv * bflo(q.y); d[3] = bfhi(p.y) - lamv * bfhi(q.y);
        d[4] = bflo(p.z) - lamv * bflo(q.z); d[5] = bfhi(p.z) - lamv * bfhi(q.z); d[6] = bflo(p.w) - lamv * bflo(q.w); d[7] = bfhi(p.w) - lamv * bfhi(q.w);
        float ss = 0.f;
#pragma unroll
        for (int j = 0; j < 8; ++j) ss += d[j] * d[j];
        ss += __shfl_xor(ss, 1); ss += __shfl_xor(ss, 2); ss += __shfl_xor(ss, 4); ss += __shfl_xor(ss, 8);
        const float ri = 1.0f / sqrtf(ss * (1.0f / 128.0f) + EPSN);
        v4u o; o.x = pk2(d[0] * ri * sgv[0], d[1] * ri * sgv[1]); o.y = pk2(d[2] * ri * sgv[2], d[3] * ri * sgv[3]);
        o.z = pk2(d[4] * ri * sgv[4], d[5] * ri * sgv[5]); o.w = pk2(d[6] * ri * sgv[6], d[7] * ri * sgv[7]);
        *(GAS v4u*)(MIX + row * 1024 + F.lane * 8) = o; }
}

typedef float f32x16 __attribute__((ext_vector_type(16)));
#define CEX(a, b) do { const float _hi = fmaxf(a, b), _lo = fminf(a, b); a = _hi; b = _lo; } while (0)
__device__ __forceinline__ int skey(int b) { return b ^ ((b >> 31) & 0x7fffffff); }
#define CEI(a, b) do { const int _hi = max(a, b), _lo = min(a, b); a = _hi; b = _lo; } while (0)
__device__ __forceinline__ void sort16_desc(int (&v)[16]) {
#pragma unroll
    for (int k = 2; k <= 16; k <<= 1)
#pragma unroll
        for (int j = k >> 1; j >= 1; j >>= 1)
#pragma unroll
            for (int i = 0; i < 16; ++i) { const int l = i ^ j; if (l > i) { if ((i & k) == 0) CEI(v[i], v[l]); else CEI(v[l], v[i]); } }
}
__device__ __forceinline__ void merge16_desc(int (&a)[16], const int (&b)[16]) {
#pragma unroll
    for (int i = 0; i < 16; ++i) a[i] = max(a[i], b[15 - i]);
#pragma unroll
    for (int j = 8; j >= 1; j >>= 1)
#pragma unroll
        for (int i = 0; i < 16; ++i) if ((i & j) == 0) CEI(a[i], a[i + j]);
}
__device__ __forceinline__ void top16_half(int (&top)[16], const bf16* q, const LAS unsigned char* sk, int r32, int hi) {
    bf16x8 qf[8];
#pragma unroll
    for (int ks = 0; ks < 8; ++ks) qf[ks] = *(const GAS bf16x8*)(q + 16 * ks + 8 * hi);
#pragma unroll
    for (int i = 0; i < 16; ++i) top[i] = (int)0x80000000;
#pragma unroll 1
    for (int kt = 0; kt < 4; ++kt) {
        f32x16 acc = {};
#pragma unroll
        for (int ks = 0; ks < 8; ++ks) { const bf16x8 kf = *(const LAS bf16x8*)(sk + (32 * kt + r32) * 272 + (16 * ks + 8 * hi) * 2); acc = __builtin_amdgcn_mfma_f32_32x32x16_bf16(kf, qf[ks], acc, 0, 0, 0); }
        int grp[16];
#pragma unroll
        for (int r = 0; r < 16; ++r) { const int idx = 32 * kt + (r & 3) + 8 * (r >> 2) + 4 * hi; const float av = acc[r];
            grp[r] = (skey(__float_as_int(av)) & ~127) | idx; }
        sort16_desc(grp); merge16_desc(top, grp);
    }
    int oth[16];
#pragma unroll
    for (int i = 0; i < 16; ++i) oth[i] = __shfl_xor(top[i], 32);
    merge16_desc(top, oth);
}
__device__ __forceinline__ void route_unit(const Args& a, int g, int hd, int lane, LAS unsigned char* slot, const LAS unsigned char* skl, int* EIDo, float* GWo) {
    const int r32 = lane & 31, hi = lane >> 5; const int t = g * 32 + r32;
    const bf16* q = (const bf16*)(a.ws + WS_Q2) + (size_t)t * NQ + hd * 256;
    int k1[16], k2[16];
    top16_half(k1, q, skl, r32, hi);
    top16_half(k2, q + 128, skl + 128 * 272, r32, hi);
    { v4u w1, w2;
#define IDX4(v, j) (((unsigned)v[4 * (j)] & 127u) | (((unsigned)v[4 * (j) + 1] & 127u) << 8) | (((unsigned)v[4 * (j) + 2] & 127u) << 16) | (((unsigned)v[4 * (j) + 3] & 127u) << 24))
      w1 = (v4u){IDX4(k1, 0), IDX4(k1, 1), IDX4(k1, 2), IDX4(k1, 3)}; w2 = (v4u){IDX4(k2, 0), IDX4(k2, 1), IDX4(k2, 2), IDX4(k2, 3)};
#undef IDX4
      *(LAS v4u*)(slot) = w1; *(LAS v4u*)(slot + 16) = w2; }
    float v1[16], v2[16];
#pragma unroll
    for (int i = 0; i < 16; ++i) { v1[i] = __int_as_float(skey(k1[i])); v2[i] = __int_as_float(skey(k2[i])); }
#define CKEY(ia, ib) ((skey(__float_as_int(v1[ia] + v2[ib])) & ~255) | ((ia) * 16 + (ib)))
    int K[16], G1[16], G2[16];
#pragma unroll
    for (int i = 0; i < 16; ++i) K[i] = CKEY(0, i);
    { int n_ = 0;
#pragma unroll
      for (int ia = 1; ia < 16; ++ia)
#pragma unroll
          for (int ib = 0; ib < 16; ++ib) if ((ia + 1) * (ib + 1) <= 16) { const int kk = CKEY(ia, ib); if (n_ < 16) G1[n_] = kk; else if (n_ < 32) G2[n_ - 16] = kk; ++n_; }
    }
    sort16_desc(G1); merge16_desc(K, G1);
    sort16_desc(G2); merge16_desc(K, G2);
    { int x0 = CKEY(14, 0), x1 = CKEY(15, 0);
#pragma unroll
      for (int i = 0; i < 16; ++i) { CEI(K[i], x0); }
#pragma unroll
      for (int i = 0; i < 16; ++i) { CEI(K[i], x1); }
    }
#undef CKEY
    unsigned P[16]; float sc[16];
#pragma unroll
    for (int i = 0; i < 16; ++i) { const unsigned ci = (unsigned)K[i] & 255u; const unsigned i1 = slot[ci >> 4], i2 = slot[16 + (ci & 15u)]; P[i] = i1 * 128u + i2; sc[i] = __int_as_float(skey(K[i] & ~255)); }
    float ex[16], sum = 0.f;
#pragma unroll
    for (int i = 0; i < 16; ++i) { ex[i] = expf(sc[i] - sc[0]); sum += ex[i]; }
    const float inv = 1.0f / sum;
    if (hi == 0) {
        GAS v4u* eo = (GAS v4u*)(EIDo + (size_t)t * 128 + hd * 16); GAS f32x4* go = (GAS f32x4*)(GWo + (size_t)t * 128 + hd * 16);
#pragma unroll
        for (int j = 0; j < 4; ++j) { eo[j] = (v4u){P[4 * j], P[4 * j + 1], P[4 * j + 2], P[4 * j + 3]}; go[j] = (f32x4){ex[4 * j] * inv, ex[4 * j + 1] * inv, ex[4 * j + 2] * inv, ex[4 * j + 3] * inv}; }
    }
}

__device__ __forceinline__ float wave_max(float v) {
#pragma unroll
    for (int o = 1; o < 64; o <<= 1) v = fmaxf(v, __shfl_xor(v, o));
    return v;
}
__device__ __forceinline__ void route_unit_ref(const Args& a, int t, int hd, int lane, LAS float* sc) {
    LAS unsigned* sci = (LAS unsigned*)sc;
    const bf16* q = (const bf16*)(a.ws + WS_Q2) + (size_t)t * NQ + hd * 256;
#pragma unroll 1
    for (int half = 0; half < 2; ++half) {
        const float* sk = a.in[18 + half];
        float sa = 0.f, sb = 0.f;
        for (int d = 0; d < 128; ++d) { const float qv = bf2f(q[half * 128 + d]); sa += qv * sk[lane * 128 + d]; sb += qv * sk[(lane + 64) * 128 + d]; }
        for (int r = 0; r < 16; ++r) {
            const float mx = wave_max(fmaxf(sa, sb));
            const unsigned long long ba = __ballot(sa == mx), bb = __ballot(sb == mx);
            int key;
            if (ba) { const int ln = __ffsll((long long)ba) - 1; key = ln; if (lane == ln) sa = -INFINITY; }
            else { const int ln = __ffsll((long long)bb) - 1; key = ln + 64; if (lane == ln) sb = -INFINITY; }
            if (lane == 0) { sc[half * 32 + r] = mx; sci[half * 32 + 16 + r] = (unsigned)key; }
        }
    }
    __builtin_amdgcn_s_waitcnt(0);
    const int ca = lane >> 2, cb0 = (lane & 3) * 4;
    float c[4];
#pragma unroll
    for (int j = 0; j < 4; ++j) c[j] = sc[ca] + sc[32 + cb0 + j];
    for (int r = 0; r < 16; ++r) {
        const float mx = wave_max(fmaxf(fmaxf(c[0], c[1]), fmaxf(c[2], c[3])));
        const bool mine = (c[0] == mx) || (c[1] == mx) || (c[2] == mx) || (c[3] == mx);
        const unsigned long long bm = __ballot(mine); const int ln = __ffsll((long long)bm) - 1;
        if (lane == ln) { int j = (c[0] == mx) ? 0 : (c[1] == mx) ? 1 : (c[2] == mx) ? 2 : 3;
            if (j == 0) c[0] = -INFINITY; else if (j == 1) c[1] = -INFINITY; else if (j == 2) c[2] = -INFINITY; else c[3] = -INFINITY;
            sc[64 + r] = mx; sci[80 + r] = sci[16 + ca] * 128u + sci[48 + cb0 + j]; }
    }
    __builtin_amdgcn_s_waitcnt(0);
    if (lane < 16) {
        const float mx0 = sc[64]; const float ex = expf(sc[64 + lane] - mx0); float sum = ex;
        sum += __shfl_xor(sum, 1); sum += __shfl_xor(sum, 2); sum += __shfl_xor(sum, 4); sum += __shfl_xor(sum, 8);
        ((int*)(a.ws + WS_EID))[(size_t)t * 128 + hd * 16 + lane] = (int)sci[80 + lane];
        ((float*)(a.ws + WS_GW))[(size_t)t * 128 + hd * 16 + lane] = ex / sum;
    }
    __builtin_amdgcn_s_waitcnt(0);
}

__device__ __forceinline__ void unpack8(const v4u w, float* f) { f[0] = bflo(w.x); f[1] = bfhi(w.x); f[2] = bflo(w.y); f[3] = bfhi(w.y); f[4] = bflo(w.z); f[5] = bfhi(w.z); f[6] = bflo(w.w); f[7] = bfhi(w.w); }
__device__ __forceinline__ void gather_token(const Args& a, int t, int lane, float* dst) {
    const bf16* HB = (const bf16*)(a.ws + WS_HB) + (size_t)t * D; const bf16* ED = (const bf16*)(a.ws + WS_ED); const bf16* EU = (const bf16*)(a.ws + WS_EU);
    float hx[16];
    unpack8(*(const GAS v4u*)(HB + lane * 8), hx); unpack8(*(const GAS v4u*)(HB + 512 + lane * 8), hx + 8);
    const float rs2 = 1.0f / sqrtf(((const float*)(a.ws + WS_ROWSS2))[t] * (1.0f / 1024.0f) + EPSN);
    const int* EID = (const int*)(a.ws + WS_EID) + (size_t)t * 128; const float* GW = (const float*)(a.ws + WS_GW) + (size_t)t * 128;
    const int e0 = EID[lane], e1 = EID[64 + lane]; const float g0 = GW[lane], g1 = GW[64 + lane];
    float acc[16];
#pragma unroll
    for (int i = 0; i < 16; ++i) acc[i] = 0.f;
#pragma unroll 1
    for (int j = 0; j < 128; j += 4) {
        int ee[4]; float gg[4], dt[4];
#pragma unroll
        for (int k = 0; k < 4; ++k) { const int jj = j + k; ee[k] = __shfl(jj < 64 ? e0 : e1, jj & 63); gg[k] = __shfl(jj < 64 ? g0 : g1, jj & 63); }
        v4u da[4], db[4];
#pragma unroll
        for (int k = 0; k < 4; ++k) { const bf16* r = ED + (size_t)ee[k] * D; da[k] = *(const GAS v4u*)(r + lane * 8); db[k] = *(const GAS v4u*)(r + 512 + lane * 8); }
#pragma unroll
        for (int k = 0; k < 4; ++k) { float f[16]; unpack8(da[k], f); unpack8(db[k], f + 8); float s = 0.f;
#pragma unroll
            for (int i = 0; i < 16; ++i) s += f[i] * hx[i];
            dt[k] = s; }
#pragma unroll
        for (int o = 1; o < 64; o <<= 1) {
#pragma unroll
            for (int k = 0; k < 4; ++k) dt[k] += __shfl_xor(dt[k], o); }
#pragma unroll
        for (int k = 0; k < 4; ++k) { const bf16* r = EU + (size_t)ee[k] * D; da[k] = *(const GAS v4u*)(r + lane * 8); db[k] = *(const GAS v4u*)(r + 512 + lane * 8); }
#pragma unroll
        for (int k = 0; k < 4; ++k) { const float w = gg[k] * gelu_tanh(dt[k] * rs2); float f[16]; unpack8(da[k], f); unpack8(db[k], f + 8);
#pragma unroll
            for (int i = 0; i < 16; ++i) acc[i] += w * f[i]; }
    }
    const float* orow = a.out + (size_t)t * D; float* drow = dst + (size_t)t * D; const float* gf = a.in[22];
    f32x4 h0 = *(const GAS f32x4*)(orow + lane * 8), h1 = *(const GAS f32x4*)(orow + lane * 8 + 4), h2 = *(const GAS f32x4*)(orow + 512 + lane * 8), h3 = *(const GAS f32x4*)(orow + 512 + lane * 8 + 4);
    h0 += (f32x4){acc[0], acc[1], acc[2], acc[3]}; h1 += (f32x4){acc[4], acc[5], acc[6], acc[7]}; h2 += (f32x4){acc[8], acc[9], acc[10], acc[11]}; h3 += (f32x4){acc[12], acc[13], acc[14], acc[15]};
    float ss = (h0.x * h0.x + h0.y * h0.y) + (h0.z * h0.z + h0.w * h0.w) + (h1.x * h1.x + h1.y * h1.y) + (h1.z * h1.z + h1.w * h1.w)
             + (h2.x * h2.x + h2.y * h2.y) + (h2.z * h2.z + h2.w * h2.w) + (h3.x * h3.x + h3.y * h3.y) + (h3.z * h3.z + h3.w * h3.w);
    ss = wave_sum(ss);
    const float ri = 1.0f / sqrtf(ss * (1.0f / 1024.0f) + EPSN);
    const f32x4 f0 = *(const GAS f32x4*)(gf + lane * 8), f1 = *(const GAS f32x4*)(gf + lane * 8 + 4), f2 = *(const GAS f32x4*)(gf + 512 + lane * 8), f3 = *(const GAS f32x4*)(gf + 512 + lane * 8 + 4);
    *(GAS f32x4*)(drow + lane * 8) = h0 * ri * f0; *(GAS f32x4*)(drow + lane * 8 + 4) = h1 * ri * f1;
    *(GAS f32x4*)(drow + 512 + lane * 8) = h2 * ri * f2; *(GAS f32x4*)(drow + 512 + lane * 8 + 4) = h3 * ri * f3;
}


template <int CTRL> __device__ __forceinline__ float dpp_add(float v) { return v + __int_as_float(__builtin_amdgcn_update_dpp(0, __float_as_int(v), CTRL, 0xf, 0xf, false)); }
__device__ __forceinline__ float row16_sum(float v) { v = dpp_add<0x140>(v); v = dpp_add<0x141>(v); v = dpp_add<0x4E>(v); v = dpp_add<0xB1>(v); return v; }
__device__ __forceinline__ unsigned long long lanemask_lt(int lane) { return (1ull << lane) - 1ull; }
__device__ __forceinline__ void glds16g(const void* gsrc, unsigned lds_dst) { unsigned keep;
    asm volatile("s_mov_b32 %0, m0\n\ts_mov_b32 m0, %2\n\ts_nop 0\n\tglobal_load_lds_dwordx4 %1, off\n\ts_mov_b32 m0, %0" : "=&s"(keep) : "v"(gsrc), "s"(lds_dst) : "memory"); }

__device__ __forceinline__ void glds16x4(const void* sbase, unsigned o0, unsigned o1, unsigned o2, unsigned o3, unsigned d0, unsigned d1, unsigned d2, unsigned d3) { unsigned keep;
    asm volatile("s_mov_b32 %0, m0\n\ts_mov_b32 m0, %6\n\ts_nop 0\n\tglobal_load_lds_dwordx4 %1, %5\n\ts_mov_b32 m0, %7\n\ts_nop 0\n\tglobal_load_lds_dwordx4 %2, %5\n\t"
                 "s_mov_b32 m0, %8\n\ts_nop 0\n\tglobal_load_lds_dwordx4 %3, %5\n\ts_mov_b32 m0, %9\n\ts_nop 0\n\tglobal_load_lds_dwordx4 %4, %5\n\ts_mov_b32 m0, %0"
                 : "=&s"(keep) : "v"(o0), "v"(o1), "v"(o2), "v"(o3), "s"(sbase), "s"(d0), "s"(d1), "s"(d2), "s"(d3) : "memory"); }
typedef __bf16 bf2_t __attribute__((ext_vector_type(2)));
__device__ __forceinline__ float dot2bf(unsigned a, unsigned b, float c) { return __builtin_amdgcn_fdot2_f32_bf16(__builtin_bit_cast(bf2_t, a), __builtin_bit_cast(bf2_t, b), c, false); }
__device__ __forceinline__ void compact_token(const Args& a, int t, int lane) {
    const int* EID = (const int*)(a.ws + WS_EID) + (size_t)t * 128; const float* GW = (const float*)(a.ws + WS_GW) + (size_t)t * 128;
    const int e0 = EID[lane], e1 = EID[64 + lane]; const float g0 = GW[lane], g1 = GW[64 + lane];
    const bool p0 = e0 < 8192, p1 = e1 < 8192;
    const unsigned long long m0 = __ballot(p0), m1 = __ballot(p1), lt = lanemask_lt(lane);
    const int c0 = __popcll(m0), n0 = c0 + __popcll(m1);
    const int pos0 = p0 ? __popcll(m0 & lt) : n0 + __popcll(~m0 & lt);
    const int pos1 = p1 ? c0 + __popcll(m1 & lt) : n0 + (64 - c0) + __popcll(~m1 & lt);
    unsigned* R = (unsigned*)(a.ws + WS_REC) + (size_t)t * 128;
    R[pos0] = (unsigned)e0 | (f2bf(g0) << 16); R[pos1] = (unsigned)e1 | (f2bf(g1) << 16);
    if (lane == 0) ((int*)(a.ws + WS_N0))[t] = n0;
}
template <int NT> __device__ __forceinline__ void w_tokens(const Args& a, int t0, int lane) {
    float d0[NT], d1[NT], sd0[NT], sd1[NT], su0[NT], su1[NT]; unsigned r0[NT], r1[NT]; float ss[NT];
#pragma unroll
    for (int i = 0; i < NT; ++i) { const float* DP = (const float*)(a.ws + WS_DOTP) + (size_t)(t0 + i) * 1024; const unsigned* R = (const unsigned*)(a.ws + WS_REC) + (size_t)(t0 + i) * 128;
        float p0[8], p1[8];
#pragma unroll
        for (int x = 0; x < 8; ++x) { p0[x] = DP[x * 128 + lane]; p1[x] = DP[x * 128 + 64 + lane]; }
        r0[i] = R[lane]; r1[i] = R[64 + lane]; ss[i] = ((const float*)(a.ws + WS_ROWSS2))[t0 + i];
        sd0[i] = ((const float*)(a.ws + WS_SCD))[r0[i] & 0x3fffu]; sd1[i] = ((const float*)(a.ws + WS_SCD))[r1[i] & 0x3fffu];
        su0[i] = ((const float*)(a.ws + WS_SCU))[r0[i] & 0x3fffu]; su1[i] = ((const float*)(a.ws + WS_SCU))[r1[i] & 0x3fffu];
        d0[i] = ((p0[0] + p0[1]) + (p0[2] + p0[3])) + ((p0[4] + p0[5]) + (p0[6] + p0[7])); d1[i] = ((p1[0] + p1[1]) + (p1[2] + p1[3])) + ((p1[4] + p1[5]) + (p1[6] + p1[7])); }
#pragma unroll
    for (int i = 0; i < NT; ++i) { const float rs2 = 1.0f / sqrtf(ss[i] * (1.0f / 1024.0f) + EPSN);
        const float w0 = bfhi(r0[i]) * fgelu_tanh(d0[i] * sd0[i] * rs2) * su0[i], w1 = bfhi(r1[i]) * fgelu_tanh(d1[i] * sd1[i] * rs2) * su1[i];
        float m0 = fabsf(w0), m1 = fabsf(w1);
#pragma unroll
        for (int o = 1; o < 64; o <<= 1) { m0 = fmaxf(m0, __shfl_xor(m0, o)); m1 = fmaxf(m1, __shfl_xor(m1, o)); }
        const float s0 = (m0 > 0.f) ? m0 * (1.0f / 127.0f) : 1.0f, s1 = (m1 > 0.f) ? m1 * (1.0f / 127.0f) : 1.0f;
        unsigned char* WQ = a.ws + WS_WQ8 + (size_t)(t0 + i) * 144;
        WQ[lane] = (unsigned char)((int)__builtin_rintf(w0 / s0) & 255); WQ[64 + lane] = (unsigned char)((int)__builtin_rintf(w1 / s1) & 255);
        if (lane == 0) { ((float*)(WQ + 128))[0] = s0; ((float*)(WQ + 128))[1] = s1; } }
}
template <bool IS_UP> __device__ __forceinline__ void sweep_slice(const Args& a, int x, int wv, int lane, unsigned ring, LAS unsigned char* ringp, unsigned aux, LAS unsigned char* auxp) {
    const int g = lane >> 4, li = lane & 15, n16 = li, kg = g;
    const char* TABx = (const char*)(a.ws + (IS_UP ? WS_EU : WS_ED)) + x * 256;
    unsigned jofs[4];
#pragma unroll
    for (int q = 0; q < 4; ++q) jofs[q] = (unsigned)((li ^ ((g << 2) | q)) * 16);
    const unsigned pd = (unsigned)__builtin_amdgcn_readfirstlane(ring);
#pragma unroll 1
    for (int s_ = 0; s_ < 128; ++s_) {
        const int r = s_ >> 6, k = s_ & 63, t = wv * 64 + k, base = 64 * r;
        const LAS unsigned* rec = (const LAS unsigned*)(auxp + (k & 3) * 512) + base;
        const LAS unsigned char* hp = auxp + 2048 + (k & 3) * 256;
        asm volatile("s_waitcnt lgkmcnt(0)" ::: "memory");
        if ((k & 3) == 0) {
            const char* rsrc = (const char*)(a.ws + WS_REC) + (size_t)t * 512 + lane * 16;
            glds16g(rsrc, (unsigned)__builtin_amdgcn_readfirstlane(aux)); glds16g(rsrc + 1024, (unsigned)__builtin_amdgcn_readfirstlane(aux + 1024));
            if (!IS_UP) glds16g((const char*)(a.ws + WS_HB) + (size_t)(t + g) * 2048 + x * 256 + li * 16, (unsigned)__builtin_amdgcn_readfirstlane(aux + 2048));
            asm volatile("s_waitcnt vmcnt(0)" ::: "memory");
        }
        {
            unsigned so[16];
#pragma unroll
            for (int p = 0; p < 16; ++p) so[p] = rec[4 * p + g];
#pragma unroll
            for (int p = 0; p < 16; ++p) so[p] = ((so[p] & 0x3fffu) << 11) + jofs[p & 3];
            glds16x4(TABx, so[0], so[1], so[2], so[3], pd, pd + 1024u, pd + 2048u, pd + 3072u);
            glds16x4(TABx, so[4], so[5], so[6], so[7], pd + 4096u, pd + 5120u, pd + 6144u, pd + 7168u);
            glds16x4(TABx, so[8], so[9], so[10], so[11], pd + 8192u, pd + 9216u, pd + 10240u, pd + 11264u);
            glds16x4(TABx, so[12], so[13], so[14], so[15], pd + 12288u, pd + 13312u, pd + 14336u, pd + 15360u);
        }
        asm volatile("s_waitcnt vmcnt(0)" ::: "memory");
        if (!IS_UP) {
            bf16x8 hb[4];
#pragma unroll
            for (int q = 0; q < 4; ++q) hb[q] = *(const LAS bf16x8*)(hp + (32 * q + 8 * kg) * 2);
            f32x4 res = (f32x4){0.f, 0.f, 0.f, 0.f};
#pragma unroll
            for (int rb = 0; rb < 4; ++rb) {
                f32x4 d = (f32x4){0.f, 0.f, 0.f, 0.f}; const int row = n16 + 16 * rb; const int key = ((row & 3) << 2) | ((row >> 2) & 3);
#pragma unroll
                for (int q = 0; q < 4; ++q) { const bf16x8 af = *(const LAS bf16x8*)(ringp + 256 * row + 16 * ((4 * q + kg) ^ key)); d = __builtin_amdgcn_mfma_f32_16x16x32_bf16(af, hb[q], d, 0, 0, 0); }
                res = (n16 == rb) ? d : res; }
            if (n16 < 4) *(GAS f32x4*)((float*)(a.ws + WS_DOTP) + ((size_t)t * 8 + x) * 128 + base + 16 * n16 + 4 * kg) = res;
        } else {
            f32x4 pacc[8];
#pragma unroll
            for (int i = 0; i < 8; ++i) pacc[i] = (f32x4){0.f, 0.f, 0.f, 0.f};
            const int q4 = n16 >> 2, p4 = lane & 3;
#pragma unroll
            for (int ks = 0; ks < 2; ++ks) {
                const v4u wa = *(const LAS v4u*)(rec + 32 * ks + 8 * kg), wb = *(const LAS v4u*)(rec + 32 * ks + 8 * kg + 4);
                const bf16x8 af = __builtin_bit_cast(bf16x8, (v4u){(wa.x >> 16) | (wa.y & 0xffff0000u), (wa.z >> 16) | (wa.w & 0xffff0000u), (wb.x >> 16) | (wb.y & 0xffff0000u), (wb.z >> 16) | (wb.w & 0xffff0000u)});
#pragma unroll
                for (int c = 0; c < 8; ++c) {
                    const int row0 = 32 * ks + 8 * kg + q4, row1 = row0 + 4; const int ch = 2 * c + (p4 >> 1);
                    const int k0 = ((row0 & 3) << 2) | ((row0 >> 2) & 3), k1 = ((row1 & 3) << 2) | ((row1 >> 2) & 3);
                    const attn_body::s16x4 lo4 = attn_body::vtr((attn_body::lds_cptr)(ringp + 256 * row0 + 16 * (ch ^ k0) + 8 * (p4 & 1)));
                    const attn_body::s16x4 hi4 = attn_body::vtr((attn_body::lds_cptr)(ringp + 256 * row1 + 16 * (ch ^ k1) + 8 * (p4 & 1)));
                    const bf16x8 bfr = (bf16x8){lo4[0], lo4[1], lo4[2], lo4[3], hi4[0], hi4[1], hi4[2], hi4[3]};
                    pacc[c] = __builtin_amdgcn_mfma_f32_16x16x32_bf16(af, bfr, pacc[c], 0, 0, 0); }
            }
            const float v0 = (kg == 0) ? pacc[0][0] : (kg == 1) ? pacc[1][0] : (kg == 2) ? pacc[2][0] : pacc[3][0];
            const float v1 = (kg == 0) ? pacc[4][0] : (kg == 1) ? pacc[5][0] : (kg == 2) ? pacc[6][0] : pacc[7][0];
            bf16* po = (bf16*)(a.ws + WS_PEER) + ((size_t)r * M + t) * D + x * 128;
            po[lane] = (bf16)f2bf(v0); po[64 + lane] = (bf16)f2bf(v1);
        }
    }
}
typedef int i32x4 __attribute__((ext_vector_type(4)));
__device__ __forceinline__ void sweep_down_q8(const Args& a, int x, int wv, int lane, unsigned ring, LAS unsigned char* ringp, unsigned aux, LAS unsigned char* auxp) {
    const int g = lane >> 4, li = lane & 15, n16 = li, kg = g, g8 = lane >> 3, s8 = lane & 7;
    const char* TABx = (const char*)(a.ws + WS_ED) + x * 128;
    unsigned jofs[2];
#pragma unroll
    for (int b = 0; b < 2; ++b) jofs[b] = (unsigned)((s8 ^ (4 * b + (g8 >> 1))) * 16);
    const unsigned pd = (unsigned)__builtin_amdgcn_readfirstlane(ring);
    LAS unsigned char* hq = auxp + 3072; LAS float* hsc = (LAS float*)(auxp + 3072 + 512);
#pragma unroll 1
    for (int s_ = 0; s_ < 128; ++s_) {
        const int r = s_ >> 6, k = s_ & 63, t = wv * 64 + k, base = 64 * r;
        const LAS unsigned* rec = (const LAS unsigned*)(auxp + (k & 3) * 512) + base;
        asm volatile("s_waitcnt lgkmcnt(0)" ::: "memory");
        if ((k & 3) == 0) {
            const char* rsrc = (const char*)(a.ws + WS_REC) + (size_t)t * 512 + lane * 16;
            glds16g(rsrc, (unsigned)__builtin_amdgcn_readfirstlane(aux)); glds16g(rsrc + 1024, (unsigned)__builtin_amdgcn_readfirstlane(aux + 1024));
            glds16g((const char*)(a.ws + WS_HB) + (size_t)(t + g) * 2048 + x * 256 + li * 16, (unsigned)__builtin_amdgcn_readfirstlane(aux + 2048));
            asm volatile("s_waitcnt vmcnt(0)" ::: "memory");
            {
                const v4u hb = *(const LAS v4u*)(auxp + 2048 + lane * 16); float f[8]; unpack8(hb, f);
                float am = fmaxf(fmaxf(fmaxf(fabsf(f[0]), fabsf(f[1])), fmaxf(fabsf(f[2]), fabsf(f[3]))), fmaxf(fmaxf(fabsf(f[4]), fabsf(f[5])), fmaxf(fabsf(f[6]), fabsf(f[7]))));
                am = fmaxf(am, __int_as_float(__builtin_amdgcn_update_dpp(0, __float_as_int(am), 0x140, 0xf, 0xf, false))); am = fmaxf(am, __int_as_float(__builtin_amdgcn_update_dpp(0, __float_as_int(am), 0x141, 0xf, 0xf, false)));
                am = fmaxf(am, __int_as_float(__builtin_amdgcn_update_dpp(0, __float_as_int(am), 0x4E, 0xf, 0xf, false))); am = fmaxf(am, __int_as_float(__builtin_amdgcn_update_dpp(0, __float_as_int(am), 0xB1, 0xf, 0xf, false)));
                const float sc = (am > 0.f) ? am * (1.0f / 127.0f) : 1.0f, inv = 1.0f / sc;
                unsigned qw[2];
#pragma unroll
                for (int h2 = 0; h2 < 2; ++h2) { const int q0 = (int)__builtin_rintf(f[4 * h2] * inv), q1 = (int)__builtin_rintf(f[4 * h2 + 1] * inv), q2 = (int)__builtin_rintf(f[4 * h2 + 2] * inv), q3 = (int)__builtin_rintf(f[4 * h2 + 3] * inv);
                    qw[h2] = ((unsigned)q0 & 255u) | (((unsigned)q1 & 255u) << 8) | (((unsigned)q2 & 255u) << 16) | ((unsigned)q3 << 24); }
                *(LAS unsigned long long*)(hq + lane * 8) = (unsigned long long)qw[0] | ((unsigned long long)qw[1] << 32);
                if (li == 0) hsc[g] = sc; }
        }
        {   unsigned so[8];
#pragma unroll
            for (int i = 0; i < 8; ++i) so[i] = rec[8 * i + g8];
#pragma unroll
            for (int i = 0; i < 8; ++i) so[i] = ((so[i] & 0x3fffu) << 10) + jofs[i & 1];
            glds16x4(TABx, so[0], so[1], so[2], so[3], pd, pd + 1024u, pd + 2048u, pd + 3072u);
            glds16x4(TABx, so[4], so[5], so[6], so[7], pd + 4096u, pd + 5120u, pd + 6144u, pd + 7168u);
        }
        asm volatile("s_waitcnt vmcnt(0)" ::: "memory");
        const i32x4 hb0 = *(const LAS i32x4*)(hq + (k & 3) * 128 + 16 * kg), hb1 = *(const LAS i32x4*)(hq + (k & 3) * 128 + 64 + 16 * kg);
        const float hs = hsc[k & 3];
        i32x4 res = (i32x4){0, 0, 0, 0};
#pragma unroll
        for (int rb = 0; rb < 4; ++rb) {
            const int row = n16 + 16 * rb; const int key = (row >> 1) & 7;
            const i32x4 a0 = *(const LAS i32x4*)(ringp + row * 128 + ((kg ^ key) * 16)), a1 = *(const LAS i32x4*)(ringp + row * 128 + (((4 + kg) ^ key) * 16));
            i32x4 d = __builtin_amdgcn_mfma_i32_16x16x64_i8(a0, hb0, (i32x4){0, 0, 0, 0}, 0, 0, 0); d = __builtin_amdgcn_mfma_i32_16x16x64_i8(a1, hb1, d, 0, 0, 0);
            res = (n16 == rb) ? d : res; }
        if (n16 < 4) *(GAS f32x4*)((float*)(a.ws + WS_DOTP) + ((size_t)t * 8 + x) * 128 + base + 16 * n16 + 4 * kg) = (f32x4){(float)res[0] * hs, (float)res[1] * hs, (float)res[2] * hs, (float)res[3] * hs};
    }
}

__device__ __forceinline__ void sweep_up_q8(const Args& a, int x, int wv, int lane, unsigned ring, LAS unsigned char* ringp, unsigned aux, LAS unsigned char* auxp) {
    const int n16 = lane & 15, kg = lane >> 4, g8 = lane >> 3, s8 = lane & 7;
    const char* TABx = (const char*)(a.ws + WS_EU) + x * 128;
    unsigned jofs[2];
#pragma unroll
    for (int b = 0; b < 2; ++b) jofs[b] = (unsigned)((s8 ^ ((g8 >> 1) | (b << 2))) * 16);
    const unsigned pd = (unsigned)__builtin_amdgcn_readfirstlane(ring);
    typedef int v2i_t __attribute__((ext_vector_type(2)));
#pragma unroll 1
    for (int s_ = 0; s_ < 128; ++s_) {
        const int r = s_ >> 6, k = s_ & 63, t = wv * 64 + k, base = 64 * r;
        const LAS unsigned* rec = (const LAS unsigned*)(auxp + (k & 3) * 512) + base;
        const LAS unsigned char* wq = auxp + 2048 + (k & 3) * 144;
        asm volatile("s_waitcnt lgkmcnt(0)" ::: "memory");
        if ((k & 3) == 0) {
            const char* rsrc = (const char*)(a.ws + WS_REC) + (size_t)t * 512 + lane * 16;
            glds16g(rsrc, (unsigned)__builtin_amdgcn_readfirstlane(aux)); glds16g(rsrc + 1024, (unsigned)__builtin_amdgcn_readfirstlane(aux + 1024));
            if (lane < 36) glds16g((const char*)(a.ws + WS_WQ8) + (size_t)t * 144 + lane * 16, (unsigned)__builtin_amdgcn_readfirstlane(aux + 2048));
            asm volatile("s_waitcnt vmcnt(0)" ::: "memory");
        }
        {   unsigned so[8];
#pragma unroll
            for (int i = 0; i < 8; ++i) so[i] = rec[8 * i + g8];
#pragma unroll
            for (int i = 0; i < 8; ++i) so[i] = ((so[i] & 0x3fffu) << 10) + jofs[(i >> 1) & 1];
            glds16x4(TABx, so[0], so[1], so[2], so[3], pd, pd + 1024u, pd + 2048u, pd + 3072u);
            glds16x4(TABx, so[4], so[5], so[6], so[7], pd + 4096u, pd + 5120u, pd + 6144u, pd + 7168u);
        }
        asm volatile("s_waitcnt vmcnt(0)" ::: "memory");
        const i32x4 aw = *(const LAS i32x4*)(wq + 64 * r + 16 * kg);
        const float wsc = *(const LAS float*)(wq + 128 + 4 * r);
        const int i2 = n16 >> 1, ih = n16 & 1;
        const int row0 = 16 * kg + i2, row1 = row0 + 8;
        const int k0 = ((row0 >> 1) & 3) | (((row0 >> 4) & 1) << 2), k1 = ((row1 >> 1) & 3) | (((row1 >> 4) & 1) << 2);
        const LAS unsigned char* p0 = ringp + row0 * 128 + 8 * ih; const LAS unsigned char* p1 = ringp + row1 * 128 + 8 * ih;
        float outv[8];
#pragma unroll
        for (int c = 0; c < 8; ++c) {
            const v2i_t lo = __builtin_amdgcn_ds_read_tr8_b64_v2i32((LAS v2i_t*)(p0 + ((c ^ k0) * 16)));
            const v2i_t hi = __builtin_amdgcn_ds_read_tr8_b64_v2i32((LAS v2i_t*)(p1 + ((c ^ k1) * 16)));
            const i32x4 d = __builtin_amdgcn_mfma_i32_16x16x64_i8(aw, (i32x4){lo.x, lo.y, hi.x, hi.y}, (i32x4){0, 0, 0, 0}, 0, 0, 0);
            outv[c] = (float)d[0] * wsc; }
        const float v0 = (kg == 0) ? outv[0] : (kg == 1) ? outv[1] : (kg == 2) ? outv[2] : outv[3];
        const float v1 = (kg == 0) ? outv[4] : (kg == 1) ? outv[5] : (kg == 2) ? outv[6] : outv[7];
        bf16* po = (bf16*)(a.ws + WS_PEER) + ((size_t)r * M + t) * D + x * 128;
        po[lane] = (bf16)f2bf(v0); po[64 + lane] = (bf16)f2bf(v1);
    }
}

__device__ __forceinline__ void final_row(const Args& a, int t, int lane) {
    float* orow = a.out + (size_t)t * D; const float* gf = a.in[22];
    const bf16* P0 = (const bf16*)(a.ws + WS_PEER) + (size_t)t * D; const bf16* P1 = P0 + (size_t)M * D;
    const bf16* HBr = (const bf16*)(a.ws + WS_HB) + (size_t)t * D;
    f32x4 h[4]; float ss = 0.f;
#pragma unroll
    for (int j = 0; j < 4; ++j) { { const unsigned long long hb = ((const GAS unsigned long long*)HBr)[lane + 64 * j]; h[j].x = bflo((unsigned)hb); h[j].y = bfhi((unsigned)hb); h[j].z = bflo((unsigned)(hb >> 32)); h[j].w = bfhi((unsigned)(hb >> 32)); }
        const unsigned long long p = ((const GAS unsigned long long*)P0)[lane + 64 * j], q = ((const GAS unsigned long long*)P1)[lane + 64 * j];
        h[j].x += bflo((unsigned)p) + bflo((unsigned)q); h[j].y += bfhi((unsigned)p) + bfhi((unsigned)q); h[j].z += bflo((unsigned)(p >> 32)) + bflo((unsigned)(q >> 32)); h[j].w += bfhi((unsigned)(p >> 32)) + bfhi((unsigned)(q >> 32));
        ss += (h[j].x * h[j].x + h[j].y * h[j].y) + (h[j].z * h[j].z + h[j].w * h[j].w); }
    ss = wave_sum(ss);
    const float ri = 1.0f / sqrtf(ss * (1.0f / 1024.0f) + EPSN);
#pragma unroll
    for (int j = 0; j < 4; ++j) ((GAS f32x4*)orow)[lane + 64 * j] = h[j] * ri * ((const GAS f32x4*)gf)[lane + 64 * j];
}

__device__ __forceinline__ float a_dot64(const float* p, const float* q, int lane) { return wave_sum(p[lane] * q[lane]); }
constexpr int N_PHASES = 12;
#ifndef ROUTE_REF
#define ROUTE_REF 0
#endif
#ifndef MK_ONE_LAUNCH
#define MK_ONE_LAUNCH 1
#endif
__global__ void __launch_bounds__(NWAVES * 64, 2) fwd_mega(Args args) {
    extern __shared__ __attribute__((aligned(16))) unsigned char lds[];
    Frame F;
    F.lds = (LAS unsigned char*)lds;
    F.MISC = (volatile LAS unsigned*)(F.lds + MISC_OFF);
    F.tid = threadIdx.x; F.lane = F.tid & 63; F.wave = __builtin_amdgcn_readfirstlane(F.tid >> 6);
    F.G = gridDim.x; { const int bx = blockIdx.x; F.vcu = (F.G % 8 == 0) ? (bx % 8) * (F.G / 8) + bx / 8 : bx; }
    unsigned char* ws = args.ws;
    const int lo = args.ph_lo, hi = args.ph_hi;
#ifndef PH_MASK
#define PH_MASK 0xffff
#endif
#define IN(k) (((PH_MASK >> (k)) & 1) && lo <= (k) && (k) < hi)
#define BOTH(k) (IN(k) && IN((k) + 1))
#if MK_ONE_LAUNCH
    for (int u = F.tid; u < (LDS_BYTES - LDSCTL_OFF) / 4; u += NWAVES * 64) ((LAS unsigned*)(F.lds + LDSCTL_OFF))[u] = 0u;
    __syncthreads();
    const XcdBarrier xbar = xcd_barrier_post((unsigned*)(ws + WS_CTL) + CW_BAR, F.MISC + 8);
    bool first_seam = args.ph_lo < 0;
#define GRID_BAR() do { if (first_seam) { __threadfence(); cooperative_groups::this_grid().sync(); first_seam = false; } else xcd_barrier(xbar); } while (0)
#else
#define GRID_BAR() do { } while (0)
#endif
#ifndef REP_PH
#define REP_PH -1
#endif
#define RUN_PHASE(k, ...) do { if (IN(k)) { if ((k) == REP_PH) { { const bool first_of_two = true; (void)first_of_two; __VA_ARGS__ } GRID_BAR(); } { const bool first_of_two = false; (void)first_of_two; __VA_ARGS__ } if (BOTH(k)) GRID_BAR(); } } while (0)
    RUN_PHASE(0, { p0_prologue(F, args); });
    RUN_PHASE(1, {
        pg8::Gemm g{(const pg8::bf16_t*)(ws + WS_XB), (const pg8::bf16_t*)(ws + WS_WIN), M, INC, D}; pg8::StaticOrder S; S.init(M, INC, F.G, (int)blockIdx.x);
        pg8::EpiBf16<1> E{(pg8::bf16_t*)(ws + WS_Q), 512, (const float*)(ws + WS_RS1), 512, (size_t)WS_SPLIT / 2, attn_body::C2};
        pg8::gemm_phase<pg8::EpiBf16<1>, pg8::StaticOrder, true, true>(F.lds + RING_OFF, g, S, E);
        { const int nb = (F.G >= 2) ? (int)F.G / 2 : 1; const int bi = (int)blockIdx.x - ((int)F.G - nb); if (bi >= 0) convert_experts(args, bi * NWAVES + F.wave, nb * NWAVES, F.lane); }
    });
    RUN_PHASE(2, {
        for (int c = F.vcu; c < M / 64; c += F.G) lru_local_unit(F, args, c);
        const attn128::AttnTensors AT{(const attn128::bf16*)(ws + WS_Q), (const attn128::bf16*)(ws + WS_Q + WS_SPLIT), (const attn128::bf16*)(ws + WS_Q + 2 * WS_SPLIT), (attn128::bf16*)(ws + WS_OS)};
        const attn128::StaticOrder S(F.vcu);
        attn128::attn_phase<attn128::StaticOrder>((char*)lds + RING_OFF, AT, S);
    });
    RUN_PHASE(3, {
        float l1 = a_dot64(args.in[3], args.in[4], F.lane); float l2 = a_dot64(args.in[5], args.in[6], F.lane);
        const float lamv = expf(l1) - expf(l2) + 0.2f;
        for (int c = F.vcu; c < M / 64; c += F.G) fix_unit(F, args, c, lamv);
    });
    RUN_PHASE(4, {
        pg8::Gemm g{(const pg8::bf16_t*)(ws + WS_MIX), (const pg8::bf16_t*)(ws + WS_WOUT), M, D, D}; pg8::StaticOrder S; S.init(M, D, F.G, (int)blockIdx.x);
        pg8::EpiResid E{args.in[0], args.out, (pg8::bf16_t*)(ws + WS_HB), (float*)(ws + (first_of_two ? WS_RS1 : WS_ROWSS2)), D};
        pg8::gemm_phase<pg8::EpiResid, pg8::StaticOrder, true, true>(F.lds + RING_OFF, g, S, E);
    });
    RUN_PHASE(5, {
        pg8::Gemm g{(const pg8::bf16_t*)(ws + WS_HB), (const pg8::bf16_t*)(ws + WS_WQ), M, NQ, D}; pg8::StaticOrder S; S.init(M, NQ, F.G, (int)blockIdx.x);
        pg8::EpiBf16<2> E{(pg8::bf16_t*)(ws + WS_Q2), NQ, (const float*)(ws + WS_ROWSS2), 0, 0, 1.f};
        pg8::gemm_phase<pg8::EpiBf16<2>, pg8::StaticOrder, true, true>(F.lds + RING_OFF, g, S, E);
    });
    RUN_PHASE(6, {
        const int gw = F.vcu * NWAVES + F.wave; const int NGW = F.G * NWAVES;
        LAS unsigned char* skl = F.lds + RING_OFF + 16384;
        for (int c = F.tid; c < 4096; c += NWAVES * 64) { const int row = c >> 4; const int ch = c & 15; *(LAS v4u*)(skl + row * 272 + ch * 16) = *(const GAS v4u*)(ws + WS_SK1 + (size_t)row * 256 + ch * 16); }
        __syncthreads();
        static_assert((M / 32) * 8 == NEXP / 4, "one group of 4 expert_up rows beside each routing unit");
        for (int u = gw; u < (M / 32) * 8; u += NGW) { f32x4 ev[4][4]; q8_load<4>(ev, args.in[21] + (size_t)u * 4 * D, F.lane);
            route_unit(args, u >> 3, u & 7, F.lane, F.lds + RING_OFF + F.tid * 32, skl, (int*)(ws + WS_EID), (float*)(ws + WS_GW));
            q8_finish<4>(ev, ws + WS_EU + (size_t)u * 4 * D, nullptr, (float*)(ws + WS_SCU) + 4 * u, F.lane); }
        __syncthreads();
    });
    RUN_PHASE(7, {
        const int gw = F.vcu * NWAVES + F.wave; const int NGW = F.G * NWAVES;
        for (int t = gw; t < M; t += NGW) compact_token(args, t, F.lane);
    });
    RUN_PHASE(8, {
        if (F.G == 256) sweep_down_q8(args, F.vcu >> 5, (F.vcu & 31) * NWAVES + F.wave, F.lane, (unsigned)(uintptr_t)(lds + RING_OFF) + F.wave * 16384u, F.lds + RING_OFF + F.wave * 16384, (unsigned)(uintptr_t)(lds + LDSCTL_OFF + 1024) + F.wave * 3712u, F.lds + LDSCTL_OFF + 1024 + F.wave * 3712);
    });
    RUN_PHASE(9, {
        const int gw = F.vcu * NWAVES + F.wave; const int NGW = F.G * NWAVES;
        for (int t = 4 * gw; t < M; t += 4 * NGW) w_tokens<4>(args, t, F.lane);
    });
    RUN_PHASE(10, {
        if (F.G == 256) sweep_up_q8(args, F.vcu >> 5, (F.vcu & 31) * NWAVES + F.wave, F.lane, (unsigned)(uintptr_t)(lds + RING_OFF) + F.wave * 16384u, F.lds + RING_OFF + F.wave * 16384, (unsigned)(uintptr_t)(lds + LDSCTL_OFF + 1024) + F.wave * 3712u, F.lds + LDSCTL_OFF + 1024 + F.wave * 3712);
    });
    RUN_PHASE(11, {
        const int gw = F.vcu * NWAVES + F.wave; const int NGW = F.G * NWAVES;
        for (int t = gw; t < M; t += NGW) final_row(args, t, F.lane);
    });
#undef IN
#undef BOTH
}

extern "C" void kernel_launch(void* const* d_in, const int* in_sizes, int n_in, void* d_out, int out_size, void* d_ws, size_t ws_size, hipStream_t stream) {
    static int grid = 0;
    if (grid == 0) {
        if (n_in != 23 || out_size != M * D || ws_size < WS_END) { fprintf(stderr, "kernel_launch: unexpected problem: n_in %d out %d ws %zu\n", n_in, out_size, ws_size); grid = -1; return; }
        int dev = 0, cus = 0, per_cu = 0;
        if (hipGetDevice(&dev) != hipSuccess || hipDeviceGetAttribute(&cus, hipDeviceAttributeMultiprocessorCount, dev) != hipSuccess) { grid = -1; return; }
        if (hipFuncSetAttribute((const void*)fwd_mega, hipFuncAttributeMaxDynamicSharedMemorySize, LDS_BYTES) != hipSuccess) { fprintf(stderr, "kernel_launch: hipFuncSetAttribute failed\n"); grid = -1; return; }
        if (hipOccupancyMaxActiveBlocksPerMultiprocessor(&per_cu, (const void*)fwd_mega, NWAVES * 64, LDS_BYTES) != hipSuccess || per_cu < 1) { fprintf(stderr, "kernel_launch: occupancy query reports %d\n", per_cu); per_cu = 1; }
        (void)hipGetLastError();
        grid = cus;
    }
    if (grid < 0) return;
    (void)hipMemsetAsync((char*)d_ws + WS_CTL, 0, CTL_ZERO_BYTES, stream);
    Args a{};
    for (int i = 0; i < 23; ++i) a.in[i] = (const float*)d_in[i];
    a.out = (float*)d_out; a.ws = (unsigned char*)d_ws;
#if MK_ONE_LAUNCH
    a.ph_lo = 0; a.ph_hi = N_PHASES;
    void* kargs[] = {&a};
    hipError_t e = hipLaunchCooperativeKernel((const void*)fwd_mega, dim3(grid), dim3(NWAVES * 64), kargs, LDS_BYTES, stream);
    if (e != hipSuccess) fprintf(stderr, "cooperative launch failed: %s (grid %d)\n", hipGetErrorString(e), grid);
#else
    for (int p = 0; p < N_PHASES; ++p) { a.ph_lo = p; a.ph_hi = p + 1; hipLaunchKernelGGL(fwd_mega, dim3(grid), dim3(NWAVES * 64), LDS_BYTES, stream, a); }
#endif
}
```

```cpp
#include <hip/hip_runtime.h>
#include <hip/hip_cooperative_groups.h>
#include <cstdio>
#include <cstdint>
namespace pg8 {
#define PG8_LAS __attribute__((address_space(3)))
typedef unsigned short bf16_t;
typedef short bf16x8 __attribute__((ext_vector_type(8)));
typedef float f32x4 __attribute__((ext_vector_type(4)));
typedef unsigned u32x4 __attribute__((ext_vector_type(4)));
constexpr int BM = 256, BK = 64, HALF = 128, HTB = HALF * BK * 2  , STAGE_BYTES = 8 * HTB, NXCD = 8, WGM = 8;

__host__ __device__ __forceinline__ int lds_byte(int r, int c) { const int st = (r >> 4) * 2 + (c >> 5), rr = r & 15, cc = c & 31, ob = rr * 64 + cc * 2; return st * 1024 + (ob ^ (((ob >> 9) & 1) << 5)); }
__host__ __device__ __forceinline__ void stage_rc(int b, int& R, int& C) { const int st = b / 1024, sb = b % 1024, swz = sb ^ (((sb >> 9) & 1) << 5); R = (st >> 1) * 16 + swz / 64; C = (st & 1) * 32 + (swz % 64) / 2; }
__host__ __device__ __forceinline__ int perm32(int rho) { const int n = rho >> 4, i = rho & 15; return 8 * (i >> 2) + 4 * n + (i & 3); }

struct Unit { int pm, pn; };
struct Gemm { const bf16_t* A; const bf16_t* Bt; int M, N, K; };

struct StaticOrder {
    int nM, nN, nwg, G, c;
    __host__ __device__ void init(int M, int N, int G_, int c_) { nM = M / BM; nN = N / BM; nwg = nM * nN; G = G_; c = c_; }
    __host__ __device__ bool next(int i, Unit& u) const {
        const long L = (long)i * G + c; if (L >= nwg) return false;
        int wgid = (int)L; { const int q = nwg / NXCD, r = nwg % NXCD, xcd = wgid % NXCD, off = wgid / NXCD; wgid = (xcd < r ? xcd * (q + 1) : r * (q + 1) + (xcd - r) * q) + off; }
        const int nig = WGM * nN, gid = wgid / nig, fm = gid * WGM, gsz = (nM - fm) < WGM ? (nM - fm) : WGM;
        u.pm = fm + ((wgid % nig) % gsz); u.pn = (wgid % nig) / gsz; return true;
    }
    __device__ __forceinline__ void a_ready(const Unit&) const {}
    __device__ __forceinline__ void done(const Unit&) const {}
};

__device__ __forceinline__ unsigned cvt_pk_bf16(float lo, float hi) { unsigned r; asm volatile("v_cvt_pk_bf16_f32 %0, %1, %2" : "=v"(r) : "v"(lo), "v"(hi)); return r; }
typedef float f32x2 __attribute__((ext_vector_type(2)));

template <int RSMODE> struct EpiBf16 {
    static constexpr bool PERM = true, AFTER_DRAIN = false;
    bf16_t* O; int ldc; const float* rowscale; int split_cols; size_t split_stride; float scale0;
    __device__ __forceinline__ void operator()(const f32x4 (&acc)[2][2][4][2], const Unit& u, int wr, int wc, int fr, int fq) const {
        const int row0 = u.pm * BM + wr * 64 + fr; int colt = u.pn * BM; bf16_t* base = O;
        float sc = 1.f; if (split_cols) { const int t = colt / split_cols; base += (size_t)t * split_stride; colt -= t * split_cols; if (t == 0) sc = scale0; }
        const int col0 = colt + wc * 32 + 8 * fq;
#pragma unroll
        for (int ai = 0; ai < 2; ++ai)
#pragma unroll
            for (int m = 0; m < 4; ++m) { const int row = row0 + ai * HALF + m * 16; bf16_t* rowp = base + (size_t)row * ldc + col0;
                float rs = sc;
                if (RSMODE == 1) rs *= rowscale[row];
                if (RSMODE == 2) rs *= 1.0f / sqrtf(rowscale[row] * (1.0f / 1024.0f) + 1e-6f);
#pragma unroll
                for (int bj = 0; bj < 2; ++bj) { f32x4 v0 = acc[ai][bj][m][0] * rs, v1 = acc[ai][bj][m][1] * rs;
                    u32x4 w; w.x = cvt_pk_bf16(v0[0], v0[1]); w.y = cvt_pk_bf16(v0[2], v0[3]); w.z = cvt_pk_bf16(v1[0], v1[1]); w.w = cvt_pk_bf16(v1[2], v1[3]);
                    *(u32x4*)(rowp + bj * HALF) = w; } }
    }
};

struct EpiResid {
    static constexpr bool PERM = false, AFTER_DRAIN = false;
    const float* X; float* Hf; bf16_t* Hb; float* rowss; int ldc;
    __device__ __forceinline__ void operator()(const f32x4 (&acc)[2][2][4][2], const Unit& u, int wr, int wc, int fr, int fq) const {
        typedef unsigned u32x2v __attribute__((ext_vector_type(2)));
        const int col0 = u.pn * BM + wc * 32 + 4 * fq;
#pragma unroll
        for (int ai = 0; ai < 2; ++ai)
#pragma unroll
            for (int m = 0; m < 4; ++m) { const int row = u.pm * BM + ai * HALF + wr * 64 + m * 16 + fr; const size_t off = (size_t)row * ldc + col0; float ss = 0.f;
#pragma unroll
                for (int bj = 0; bj < 2; ++bj)
#pragma unroll
                    for (int n = 0; n < 2; ++n) { const f32x4 xv = *(const f32x4*)(X + off + bj * HALF + n * 16); const f32x4 h = xv + acc[ai][bj][m][n];
                        u32x2v w; w.x = cvt_pk_bf16(h[0], h[1]); w.y = cvt_pk_bf16(h[2], h[3]);
                        *(u32x2v*)(Hb + off + bj * HALF + n * 16) = w; ss += (h[0] * h[0] + h[1] * h[1]) + (h[2] * h[2] + h[3] * h[3]); }
                ss += __shfl_xor(ss, 16); ss += __shfl_xor(ss, 32);
                if (fq == 0) atomicAdd(rowss + row, ss); }
    }
};

template <class Epi, class Sched, bool ALIGN_EPI = false, bool SP2 = false>
__device__ __forceinline__ void gemm_phase(PG8_LAS unsigned char* lds, const Gemm g, const Sched& S, const Epi& E) {
    const int tid = threadIdx.x, wid = __builtin_amdgcn_readfirstlane(tid >> 6), lane = tid & 63, wr = wid >> 2, wc = wid & 3, fr = lane & 15, fq = lane >> 4;
    const int K = g.K, nt = K / BK;
    unsigned voffA[2], voffB[2];
#pragma unroll
    for (int i = 0; i < 2; ++i) { int R, C; stage_rc(tid * 16 + i * 8192, R, C); const int Rb = Epi::PERM ? ((R & ~31) + perm32(R & 31)) : R;
        voffA[i] = (unsigned)(R * K + C) * 2u; voffB[i] = (unsigned)(Rb * K + C) * 2u; }
    const size_t kstep = (size_t)(BK * 2);
    const size_t hstep = (size_t)HALF * K * 2;
    const size_t tstep = 2 * hstep;
    const unsigned ldsw = (unsigned)wid * 1024u;
    const int aoff = lds_byte(wr * 64 + fr, fq * 8), boff = lds_byte(wc * 32 + fr, fq * 8);
#define PG8_SA(b, h) (((b) * 2 + (h)) * HTB)
#define PG8_SB(b, h) ((4 + (b) * 2 + (h)) * HTB)
#define PG8_STAGE(bufoff, gbase, voff) do { _Pragma("unroll") for (int _i = 0; _i < 2; ++_i) \
        __builtin_amdgcn_global_load_lds((const unsigned*)((const char*)(gbase) + (voff)[_i]), (PG8_LAS unsigned*)(lds + (bufoff) + ldsw + _i * 8192), 16, 0, 0); } while (0)
#define PG8_LDA(dst, b, h) do { _Pragma("unroll") for (int m = 0; m < 4; ++m) _Pragma("unroll") for (int k = 0; k < 2; ++k) dst[m][k] = *(const PG8_LAS bf16x8*)(lds + PG8_SA(b, h) + aoff + m * 2048 + k * 1024); } while (0)
#define PG8_LDB(dst, b, h) do { _Pragma("unroll") for (int n = 0; n < 2; ++n) _Pragma("unroll") for (int k = 0; k < 2; ++k) dst[n][k] = *(const PG8_LAS bf16x8*)(lds + PG8_SB(b, h) + boff + n * 2048 + k * 1024); } while (0)
#define PG8_MMA(ai, bj, At, Bt) do { __builtin_amdgcn_s_setprio(1); _Pragma("unroll") for (int m = 0; m < 4; ++m) _Pragma("unroll") for (int n = 0; n < 2; ++n) _Pragma("unroll") for (int k = 0; k < 2; ++k) \
        acc[ai][bj][m][n] = __builtin_amdgcn_mfma_f32_16x16x32_bf16(Bt[n][k], At[m][k], acc[ai][bj][m][n], 0, 0, 0); __builtin_amdgcn_s_setprio(0); } while (0)
#define PG8_WAIT_V(n) asm volatile("s_waitcnt vmcnt(" #n ")" ::: "memory")
#define PG8_WAIT_L(n) asm volatile("s_waitcnt lgkmcnt(" #n ")" ::: "memory")
#define PG8_BAR __builtin_amdgcn_s_barrier()
#define PG8_SCHED __builtin_amdgcn_sched_barrier(0)
    Unit cur, nxt; int ui = 0;
    if (!S.next(0, cur)) return;
    f32x4 acc[2][2][4][2];
#pragma unroll
    for (int a = 0; a < 2; ++a)
#pragma unroll
        for (int b = 0; b < 2; ++b)
#pragma unroll
            for (int m = 0; m < 4; ++m)
#pragma unroll
                for (int n = 0; n < 2; ++n) acc[a][b][m][n] = (f32x4){0.f, 0.f, 0.f, 0.f};
    bf16x8 At[4][2], B0[2][2], B1[2][2];
    const char* cA = (const char*)g.A + (size_t)cur.pm * tstep; const char* cB = (const char*)g.Bt + (size_t)cur.pn * tstep;
    S.a_ready(cur);
    if constexpr (SP2) {
        PG8_STAGE(PG8_SB(0, 0), cB, voffB); PG8_STAGE(PG8_SB(0, 1), cB + hstep, voffB); PG8_STAGE(PG8_SA(0, 0), cA, voffA); PG8_STAGE(PG8_SA(0, 1), cA + hstep, voffA);
        if (wr == 1) PG8_BAR;
        PG8_WAIT_V(2); PG8_BAR;
        PG8_STAGE(PG8_SB(1, 0), cB + kstep, voffB); PG8_STAGE(PG8_SA(1, 0), cA + kstep, voffA); PG8_STAGE(PG8_SB(1, 1), cB + hstep + kstep, voffB);
        PG8_WAIT_V(6); PG8_BAR;
    } else {
        PG8_STAGE(PG8_SB(0, 0), cB, voffB); PG8_STAGE(PG8_SA(0, 0), cA, voffA); PG8_STAGE(PG8_SB(0, 1), cB + hstep, voffB); PG8_STAGE(PG8_SA(0, 1), cA + hstep, voffA);
        if (wr == 1) PG8_BAR;
        PG8_WAIT_V(4); PG8_BAR;
        PG8_STAGE(PG8_SB(1, 0), cB + kstep, voffB); PG8_STAGE(PG8_SA(1, 0), cA + kstep, voffA); PG8_STAGE(PG8_SB(1, 1), cB + hstep + kstep, voffB);
        PG8_WAIT_V(6); PG8_BAR;
    }
    for (;;) {
        const bool has_next = S.next(ui + 1, nxt);
        const char* nA = has_next ? (const char*)g.A + (size_t)nxt.pm * tstep : cA; const char* nB = has_next ? (const char*)g.Bt + (size_t)nxt.pn * tstep : cB;
        for (int t = 0; t < nt; t += 2) {
            const bool last = (t == nt - 2);
            const char* a1 = cA + (size_t)(t + 1) * kstep;
            const char* a2 = last ? nA : cA + (size_t)(t + 2) * kstep; const char* b2 = last ? nB : cB + (size_t)(t + 2) * kstep;
            const char* a3 = a2 + kstep; const char* b3 = b2 + kstep;
            if (last && has_next) S.a_ready(nxt);
            if constexpr (SP2) {
            PG8_LDB(B0, 0, 0); PG8_LDB(B1, 0, 1); PG8_SCHED; PG8_LDA(At, 0, 0); PG8_STAGE(PG8_SA(1, 1), a1 + hstep, voffA);
            PG8_WAIT_V(8); PG8_WAIT_L(0); PG8_BAR; PG8_MMA(0, 0, At, B0); PG8_MMA(0, 1, At, B1); PG8_BAR; PG8_SCHED;
            PG8_LDA(At, 0, 1); PG8_STAGE(PG8_SB(0, 0), b2, voffB); PG8_STAGE(PG8_SB(0, 1), b2 + hstep, voffB); PG8_STAGE(PG8_SA(0, 0), a2, voffA);
            PG8_WAIT_V(8); PG8_WAIT_L(0); PG8_BAR; PG8_MMA(1, 0, At, B0); PG8_MMA(1, 1, At, B1); PG8_BAR; PG8_SCHED;
            PG8_LDB(B0, 1, 0); PG8_LDB(B1, 1, 1); PG8_SCHED; PG8_LDA(At, 1, 0); PG8_STAGE(PG8_SA(0, 1), a2 + hstep, voffA);
            PG8_WAIT_V(8); PG8_WAIT_L(0); PG8_BAR; PG8_MMA(0, 0, At, B0); PG8_MMA(0, 1, At, B1); PG8_BAR; PG8_SCHED;
            PG8_LDA(At, 1, 1); PG8_STAGE(PG8_SB(1, 0), b3, voffB); PG8_STAGE(PG8_SB(1, 1), b3 + hstep, voffB); PG8_STAGE(PG8_SA(1, 0), a3, voffA);
            PG8_WAIT_V(8); PG8_WAIT_L(0); PG8_BAR; PG8_MMA(1, 0, At, B0); PG8_MMA(1, 1, At, B1); PG8_BAR; PG8_SCHED;
            } else {
            PG8_LDB(B0, 0, 0); PG8_SCHED; PG8_LDA(At, 0, 0); PG8_STAGE(PG8_SA(1, 1), a1 + hstep, voffA);
            PG8_WAIT_L(8); PG8_BAR; PG8_WAIT_L(0); PG8_MMA(0, 0, At, B0); PG8_BAR; PG8_SCHED;
            PG8_LDB(B1, 0, 1); PG8_STAGE(PG8_SB(0, 0), b2, voffB);
            PG8_BAR; PG8_WAIT_L(0); PG8_MMA(0, 1, At, B1); PG8_BAR;
            PG8_LDA(At, 0, 1); PG8_STAGE(PG8_SA(0, 0), a2, voffA);
            PG8_BAR; PG8_WAIT_L(0); PG8_MMA(1, 0, At, B0); PG8_BAR; PG8_SCHED;
            PG8_STAGE(PG8_SB(0, 1), b2 + hstep, voffB);
            PG8_WAIT_V(6); PG8_BAR; PG8_MMA(1, 1, At, B1); PG8_BAR;
            PG8_LDB(B0, 1, 0); PG8_SCHED; PG8_LDA(At, 1, 0); PG8_STAGE(PG8_SA(0, 1), a2 + hstep, voffA);
            PG8_WAIT_L(8); PG8_BAR; PG8_WAIT_L(0); PG8_MMA(0, 0, At, B0); PG8_BAR; PG8_SCHED;
            PG8_LDB(B1, 1, 1); PG8_STAGE(PG8_SB(1, 0), b3, voffB);
            PG8_BAR; PG8_WAIT_L(0); PG8_MMA(0, 1, At, B1); PG8_BAR;
            PG8_LDA(At, 1, 1); PG8_STAGE(PG8_SA(1, 0), a3, voffA);
            PG8_BAR; PG8_WAIT_L(0); PG8_MMA(1, 0, At, B0); PG8_BAR; PG8_SCHED;
            PG8_STAGE(PG8_SB(1, 1), b3 + hstep, voffB);
            PG8_WAIT_V(6); PG8_BAR; PG8_MMA(1, 1, At, B1); PG8_BAR;
            }
        }
        if constexpr (ALIGN_EPI) { if (wr == 0) PG8_BAR; }
        if constexpr (!Epi::AFTER_DRAIN) { E(acc, cur, wr, wc, fr, fq); S.done(cur); }
        if (!has_next) break;
#pragma unroll
        for (int a = 0; a < 2; ++a)
#pragma unroll
            for (int b = 0; b < 2; ++b)
#pragma unroll
                for (int m = 0; m < 4; ++m)
#pragma unroll
                    for (int n = 0; n < 2; ++n) acc[a][b][m][n] = (f32x4){0.f, 0.f, 0.f, 0.f};
        cur = nxt; cA = nA; cB = nB; ++ui;
        if constexpr (ALIGN_EPI) { if (wr == 1) PG8_BAR; }
    }
    PG8_WAIT_V(0);
    if constexpr (!ALIGN_EPI) { if (wr == 0) PG8_BAR; }
    PG8_BAR;
    if constexpr (Epi::AFTER_DRAIN) { E.fused(acc, cur, wr, wc, fr, fq, lds, wid, lane); S.done(cur); }
#undef PG8_SA
#undef PG8_SB
#undef PG8_STAGE
#undef PG8_LDA
#undef PG8_LDB
#undef PG8_MMA
#undef PG8_WAIT_V
#undef PG8_WAIT_L
#undef PG8_BAR
#undef PG8_SCHED
}
}

#include <hip/hip_bf16.h>
#include <cmath>
namespace attn_body {
using bf16=__hip_bfloat16;
using bf16x8=__attribute__((ext_vector_type(8)))short;
using s16x4=__attribute__((ext_vector_type(4)))short;
using f32x16=__attribute__((ext_vector_type(16)))float;
using u32x4=__attribute__((ext_vector_type(4)))unsigned;
constexpr int SEQ=16384,D=64,DM=512;
constexpr int NW=8,QBLK=32,QB=QBLK*NW,KVBLK=64,NQB=SEQ/QB;
constexpr int ATTN_PITCH=DM, ATTN_UNIT_ROWS=QB;
__device__ __forceinline__ int crow(int r,int hi){return (r&3)+8*(r>>2)+4*hi;}
#define SBAR() __builtin_amdgcn_sched_barrier(0)
__device__ __forceinline__ void cmask(f32x16&p0,f32x16&p1,int jb,int wid){
  const float NEG=-INFINITY;
  if(jb>(wid>>1)){
  #pragma unroll
  for(int r=0;r<16;++r){p0[r]=NEG;p1[r]=NEG;}}
}

constexpr int NSLOT=3, SLOTB=8192;
constexpr int LDS_K=0, LDS_V=NSLOT*SLOTB, LDS_WS=2*NSLOT*SLOTB, LDS_OST=LDS_WS+NW*64*4, LDS_BYTES=LDS_OST+NW*4096;
constexpr float C2=0.125f*1.4426950408889634f;
__device__ __forceinline__ void glds16(const void*gsrc,unsigned lds_dst){unsigned keep;
  asm volatile("s_mov_b32 %0, m0\n\ts_mov_b32 m0, %2\n\ts_nop 0\n\tglobal_load_lds_dwordx4 %1, off\n\ts_mov_b32 m0, %0":"=&s"(keep):"v"(gsrc),"s"(lds_dst):"memory");}
__device__ __forceinline__ float max3f(float a,float b,float c){float r;asm("v_max3_f32 %0, %1, %2, %3":"=v"(r):"v"(a),"v"(b),"v"(c));return r;}
__device__ __forceinline__ float max2f(float a,float b){float r;asm("v_max_f32_e32 %0, %1, %2":"=v"(r):"v"(a),"v"(b));return r;}
__device__ __forceinline__ float fadd_s(float a,float b){float r;asm("v_add_f32_e32 %0, %1, %2":"=v"(r):"v"(a),"v"(b));return r;}
__device__ __forceinline__ float fsub_s(float a,float b){float r;asm("v_sub_f32_e32 %0, %1, %2":"=v"(r):"v"(a),"v"(b));return r;}
typedef float f32x2_t __attribute__((ext_vector_type(2))); typedef __bf16 bf16x2_t __attribute__((ext_vector_type(2)));
__device__ __forceinline__ unsigned cvtpk_s(float lo,float hi){f32x2_t v={lo,hi};bf16x2_t b=__builtin_convertvector(v,bf16x2_t);return __builtin_bit_cast(unsigned,b);}
#define WAIT_BAR(N) asm volatile("s_waitcnt vmcnt(" #N ") lgkmcnt(0)\n\ts_barrier":::"memory")

__device__ __forceinline__ void qkt(f32x16&p0,f32x16&p1,const char*Kslot,const bf16x8*qr,const f32x16&negm,int r32,int hi){
  const char*kb=Kslot+hi*1024+r32*16;
  #pragma unroll
  for(int d0=0;d0<4;++d0){
    const bf16x8 b0=*reinterpret_cast<const bf16x8*>(kb+d0*2048);
    const bf16x8 b1=*reinterpret_cast<const bf16x8*>(kb+d0*2048+512);
    if(d0==0){p0=__builtin_amdgcn_mfma_f32_32x32x16_bf16(b0,qr[0],negm,0,0,0);p1=__builtin_amdgcn_mfma_f32_32x32x16_bf16(b1,qr[0],negm,0,0,0);}
    else{p0=__builtin_amdgcn_mfma_f32_32x32x16_bf16(b0,qr[d0],p0,0,0,0);p1=__builtin_amdgcn_mfma_f32_32x32x16_bf16(b1,qr[d0],p1,0,0,0);}}
}
typedef __attribute__((address_space(3))) const char* lds_cptr;
typedef short v4i16_t __attribute__((ext_vector_type(4)));
__device__ __forceinline__ void kload8(bf16x8*kf,lds_cptr kp){
  kf[0]=*(const __attribute__((address_space(3))) bf16x8*)(kp);      kf[1]=*(const __attribute__((address_space(3))) bf16x8*)(kp+512);
  kf[2]=*(const __attribute__((address_space(3))) bf16x8*)(kp+2048); kf[3]=*(const __attribute__((address_space(3))) bf16x8*)(kp+2560);
  kf[4]=*(const __attribute__((address_space(3))) bf16x8*)(kp+4096); kf[5]=*(const __attribute__((address_space(3))) bf16x8*)(kp+4608);
  kf[6]=*(const __attribute__((address_space(3))) bf16x8*)(kp+6144); kf[7]=*(const __attribute__((address_space(3))) bf16x8*)(kp+6656);
}
__device__ __forceinline__ void kload2(bf16x8*kf,lds_cptr kp,int j){ kf[2*j]=*(const __attribute__((address_space(3))) bf16x8*)(kp+j*2048); kf[2*j+1]=*(const __attribute__((address_space(3))) bf16x8*)(kp+j*2048+512); }
__device__ __forceinline__ s16x4 vtr(lds_cptr p){ return __builtin_bit_cast(s16x4,__builtin_amdgcn_ds_read_tr16_b64_v4i16((__attribute__((address_space(3))) v4i16_t*)p)); }
__device__ __forceinline__ float rowmax(const f32x16&p0,const f32x16&p1){
  float a=max3f(p0[0],p0[1],p1[0]),b=max3f(p0[2],p0[3],p1[1]);a=max3f(a,p1[2],p1[3]);
  #pragma unroll
  for(int r=4;r<16;r+=4){a=max3f(a,p0[r],p0[r+1]);b=max3f(b,p0[r+2],p0[r+3]);a=max3f(a,p1[r],p1[r+1]);b=max3f(b,p1[r+2],p1[r+3]);}
  const float m=max2f(a,b);
  auto rr=__builtin_amdgcn_permlane32_swap(__float_as_uint(m),__float_as_uint(m),false,false);
  return max2f(__uint_as_float(rr[0]),__uint_as_float(rr[1]));
}
__device__ __forceinline__ void pv(f32x16*o,int vb,bf16x8 pa0,bf16x8 pa1,bf16x8 pa2,bf16x8 pa3){
  #pragma unroll
  for(int d0=0;d0<2;++d0){s16x4 lo[4],hi[4];
    #pragma unroll
    for(int ks=0;ks<4;++ks){
      asm volatile("ds_read_b64_tr_b16 %0,%1 offset:%c2":"=&v"(lo[ks]):"v"(vb),"i"(d0*4096+ks*1024):"memory");
      asm volatile("ds_read_b64_tr_b16 %0,%1 offset:%c2":"=&v"(hi[ks]):"v"(vb),"i"(d0*4096+ks*1024+512):"memory");}
    asm volatile("s_waitcnt lgkmcnt(0)":::"memory");SBAR();
    #define PK(k) (bf16x8){lo[k][0],lo[k][1],lo[k][2],lo[k][3],hi[k][0],hi[k][1],hi[k][2],hi[k][3]}
    o[d0]=__builtin_amdgcn_mfma_f32_32x32x16_bf16(pa0,PK(0),o[d0],0,0,0);
    o[d0]=__builtin_amdgcn_mfma_f32_32x32x16_bf16(pa1,PK(1),o[d0],0,0,0);
    o[d0]=__builtin_amdgcn_mfma_f32_32x32x16_bf16(pa2,PK(2),o[d0],0,0,0);
    o[d0]=__builtin_amdgcn_mfma_f32_32x32x16_bf16(pa3,PK(3),o[d0],0,0,0);
    #undef PK
  }
}

#ifndef ATTN_STORE16
#define ATTN_STORE16(p,v) (*(u32x4*)(p)=(v))
#endif
template<int THRL> __device__ __forceinline__ void attn_unit(int qcol,int vcol,int qb,const bf16*Q,const bf16*__restrict__ K,const bf16*__restrict__ V,bf16*O,char*shm){
  const int tid=threadIdx.x,lane=tid&63,r32=lane&31,hi=lane>>5; const int wid=__builtin_amdgcn_readfirstlane(tid>>6);
  const long rowbase=0; const int q0=qb*QB;
  const bf16*Qw=Q+(rowbase+q0+wid*QBLK)*DM+qcol;
  const bf16*Kh=K+rowbase*DM+qcol,*Vh=V+rowbase*DM+vcol;
  const unsigned lds0=(unsigned)(uintptr_t)shm;
  float*wsf=(float*)(shm+LDS_WS)+wid*64;
  const bf16*ksrc=Kh+(long)lane*DM+wid*8;
  const bf16*vsrc=Vh+(long)(16*(wid&3)+(lane>>2))*DM+(wid>>2)*32+(lane&3)*8;
  const unsigned kdst=lds0+LDS_K+wid*1024, vdst=lds0+LDS_V+wid*1024;
  #define DMA_K(t,slot) glds16(ksrc+(long)(t)*KVBLK*DM,(unsigned)__builtin_amdgcn_readfirstlane(kdst+(slot)))
  #define DMA_V(t,slot) glds16(vsrc+(long)(t)*KVBLK*DM,(unsigned)__builtin_amdgcn_readfirstlane(vdst+(slot)))
  const int vb0=(int)(lds0+LDS_V)+((lane>>4)&1)*32+(lane&3)*8+(4*hi+((lane&15)>>2))*64;
  const char*Kbase=shm+LDS_K; bf16x8 kf[8];
  const lds_cptr shm3=(lds_cptr)shm; const lds_cptr kp0=shm3+LDS_K+hi*1024+r32*16; const lds_cptr vp0=shm3+LDS_V+((lane>>4)&1)*32+(lane&3)*8+(4*hi+((lane&15)>>2))*64;
  const int NT=(q0+QB)/KVBLK;
  DMA_K(0,0);DMA_V(0,0);DMA_K(1,SLOTB);
  bf16x8 qr[4];
  #pragma unroll
  for(int d0=0;d0<4;++d0)qr[d0]=*reinterpret_cast<const bf16x8*>(&Qw[(long)r32*DM+d0*16+hi*8]);
  float mhat=0.f,l_reg=0.f;f32x16 o[2];o[0]=f32x16{};o[1]=f32x16{};f32x16 negm=f32x16{};asm volatile("":"+v"(negm));
  const int qrel=wid*QBLK+r32;
  #define CMASK(P0,P1,t) do{int jb_=(t)-(NT-4); if(jb_>=0)cmask(P0,P1,jb_,wid);}while(0)
  bool resc=false;
  #define START(P0,P1) do{ const float rm=rowmax(P0,P1); resc=false; \
    { const float dl=rm; mhat=fadd_s(mhat,dl); \
      _Pragma("unroll") for(int r=0;r<16;++r){P0[r]=fsub_s(P0[r],dl);P1[r]=fsub_s(P1[r],dl);} \
      _Pragma("unroll") for(int r=0;r<16;++r)negm[r]=-mhat; asm volatile("":"+v"(negm)); } \
    _Pragma("unroll") for(int r=0;r<16;++r)P0[r]=__builtin_amdgcn_exp2f(P0[r]); }while(0)
  #define RESC() do{ if(resc){ asm volatile("s_waitcnt lgkmcnt(0)":::"memory"); \
      _Pragma("unroll") for(int d_=0;d_<2;++d_) _Pragma("unroll") for(int r=0;r<16;++r)o[d_][r]*=wsf[crow(r,hi)]; } }while(0)
  f32x16 pA0,pA1,pB0,pB1;
  int sl_prev=0,sl_cur=0,sl_next=SLOTB;
  #define ROT() do{sl_prev=sl_cur;sl_cur=sl_next;sl_next=(sl_next==(NSLOT-1)*SLOTB)?0:sl_next+SLOTB;}while(0)
  DMA_K(2,2*SLOTB);
  WAIT_BAR(3);
  qkt(pA0,pA1,Kbase,qr,negm,r32,hi);asm volatile("s_nop 15\n\ts_nop 7":"+v"(pA0),"+v"(pA1));CMASK(pA0,pA1,0);
  START(pA0,pA1);
  _Pragma("unroll") for(int r=0;r<16;++r)pA1[r]=__builtin_amdgcn_exp2f(pA1[r]);
  WAIT_BAR(0);
  DMA_K(3,0);DMA_V(1,SLOTB);
  ROT();
  kload8(kf,kp0+sl_cur);
  WAIT_BAR(2);
  s16x4 vlo[8],vhi[8]; u32x4 pw0,pw1,pw2,pw3;
  #define PKW(P,B) cvtpk_s(P[B],P[B+1])
  #define PAF(k) __builtin_bit_cast(bf16x8,pw##k)
  #define VFR(i) (bf16x8){vlo[i][0],vlo[i][1],vlo[i][2],vlo[i][3],vhi[i][0],vhi[i][1],vhi[i][2],vhi[i][3]}
  #define PIN(x) asm volatile("":"+v"(x))
  #define MX3(a,b,c) __builtin_fmaxf(__builtin_fmaxf((a),(b)),(c))
  #define GAPA(MF,A0,A1,A2,A3,W0,W1,PW) do{ MF; sacc+=A0; sacc+=A1; sacc+=A2; sacc+=A3; PIN(sacc); W0; W1; PIN(PW); SBAR(); }while(0)
  #define EX(v) __builtin_amdgcn_exp2f(v)
  #define GAPB(MF,X,B) do{ MF; X[B]=EX(X[B]); X[B+1]=EX(X[B+1]); X[B+2]=EX(X[B+2]); X[B+3]=EX(X[B+3]); PIN(X); SBAR(); }while(0)
  #define VRD(i) do{ vlo[i]=vtr(vp_+(((i)>>2)*4096+((i)&3)*1024)); vhi[i]=vtr(vp_+(((i)>>2)*4096+((i)&3)*1024+512)); }while(0)
  #define KRD(G,j) do{ if(G){ kload2(kf,kp0+sl_next,j); SBAR(); } }while(0)
  #define STEP(C0,C1,P0,P1,t,GK,GV,GL) do{ SBAR(); \
    const lds_cptr vp_=vp0+sl_prev; \
    VRD(0); SBAR(); float sacc=(P0[0]+P0[1]); \
    GAPA(C0=__builtin_amdgcn_mfma_f32_32x32x16_bf16(kf[0],qr[0],negm,0,0,0), P0[2],P0[3],P0[4],P0[5],     pw0[0]=PKW(P0,0), pw0[1]=PKW(P0,2), pw0); \
    VRD(4); SBAR(); GAPA(C1=__builtin_amdgcn_mfma_f32_32x32x16_bf16(kf[1],qr[0],negm,0,0,0), P0[6],P0[7],P0[8],P0[9],     pw0[2]=PKW(P0,4), pw0[3]=PKW(P0,6), pw0); \
    VRD(1); SBAR(); GAPA(C0=__builtin_amdgcn_mfma_f32_32x32x16_bf16(kf[2],qr[1],C0,0,0,0),   P0[10],P0[11],P0[12],P0[13], pw1[0]=PKW(P0,8), pw1[1]=PKW(P0,10), pw1); \
    VRD(5); SBAR(); GAPA(C1=__builtin_amdgcn_mfma_f32_32x32x16_bf16(kf[3],qr[1],C1,0,0,0),   P0[14],P0[15],P1[0],P1[1],   pw1[2]=PKW(P0,12),pw1[3]=PKW(P0,14), pw1); \
    VRD(2); SBAR(); GAPA(C0=__builtin_amdgcn_mfma_f32_32x32x16_bf16(kf[4],qr[2],C0,0,0,0),   P1[2],P1[3],P1[4],P1[5],     pw2[0]=PKW(P1,0), pw2[1]=PKW(P1,2), pw2); \
    VRD(6); SBAR(); GAPA(C1=__builtin_amdgcn_mfma_f32_32x32x16_bf16(kf[5],qr[2],C1,0,0,0),   P1[6],P1[7],P1[8],P1[9],     pw2[2]=PKW(P1,4), pw2[3]=PKW(P1,6), pw2); \
    VRD(3); SBAR(); GAPA(C0=__builtin_amdgcn_mfma_f32_32x32x16_bf16(kf[6],qr[3],C0,0,0,0),   P1[10],P1[11],P1[12],P1[13], pw3[0]=PKW(P1,8), pw3[1]=PKW(P1,10), pw3); \
    VRD(7); SBAR(); GAPA(C1=__builtin_amdgcn_mfma_f32_32x32x16_bf16(kf[7],qr[3],C1,0,0,0),   P1[14],P1[15],0.f,0.f,       pw3[2]=PKW(P1,12),pw3[3]=PKW(P1,14), pw3); \
    l_reg+=sacc; \
    if(GK){DMA_K((t)+3,sl_cur);} if(GV){DMA_V((t)+1,sl_next);} \
    CMASK(C0,C1,t); \
    { float a=MX3(C0[0],C0[1],C1[0]),b=MX3(C0[2],C0[3],C1[1]); a=MX3(a,C1[2],C1[3]); \
      _Pragma("unroll") for(int r=4;r<16;r+=4){a=MX3(a,C0[r],C0[r+1]);b=MX3(b,C0[r+2],C0[r+3]);a=MX3(a,C1[r],C1[r+1]);b=MX3(b,C1[r+2],C1[r+3]);} \
      float rm=__builtin_fmaxf(a,b); { auto rr=__builtin_amdgcn_permlane32_swap(__float_as_uint(rm),__float_as_uint(rm),false,false); rm=__builtin_fmaxf(__uint_as_float(rr[0]),__uint_as_float(rr[1])); } \
      resc=false; \
      if(__builtin_expect(__any(rm>(float)THRL),0)){ const float dl=__builtin_fmaxf(rm,0.f); mhat+=dl; \
        _Pragma("unroll") for(int r=0;r<16;++r){C0[r]-=dl;C1[r]-=dl;} \
        _Pragma("unroll") for(int r=0;r<16;++r)negm[r]=-mhat; asm volatile("":"+v"(negm)); \
        const float f=__builtin_amdgcn_exp2f(-dl); l_reg*=f; if(hi==0)wsf[r32]=f; resc=true; } } \
    SBAR(); \
    GAPB(o[0]=__builtin_amdgcn_mfma_f32_32x32x16_bf16(PAF(0),VFR(0),o[0],0,0,0), C0,0); \
    GAPB(o[1]=__builtin_amdgcn_mfma_f32_32x32x16_bf16(PAF(0),VFR(4),o[1],0,0,0), C0,4); \
    KRD(GL,0); GAPB(o[0]=__builtin_amdgcn_mfma_f32_32x32x16_bf16(PAF(1),VFR(1),o[0],0,0,0), C0,8); \
    KRD(GL,1); GAPB(o[1]=__builtin_amdgcn_mfma_f32_32x32x16_bf16(PAF(1),VFR(5),o[1],0,0,0), C0,12); \
    KRD(GL,2); GAPB(o[0]=__builtin_amdgcn_mfma_f32_32x32x16_bf16(PAF(2),VFR(2),o[0],0,0,0), C1,0); \
    KRD(GL,3); GAPB(o[1]=__builtin_amdgcn_mfma_f32_32x32x16_bf16(PAF(2),VFR(6),o[1],0,0,0), C1,4); \
    GAPB(o[0]=__builtin_amdgcn_mfma_f32_32x32x16_bf16(PAF(3),VFR(3),o[0],0,0,0), C1,8); \
    GAPB(o[1]=__builtin_amdgcn_mfma_f32_32x32x16_bf16(PAF(3),VFR(7),o[1],0,0,0), C1,12); \
    }while(0)
  int t=1;
  #undef CMASK
  #define CMASK(P0,P1,t) do{}while(0)
  for(;t+5<NT;t+=2){
    STEP(pB0,pB1,pA0,pA1,t,true,true,true);     WAIT_BAR(2); RESC(); ROT();
    STEP(pA0,pA1,pB0,pB1,t+1,true,true,true);   WAIT_BAR(2); RESC(); ROT();
  }
  #undef CMASK
  #define CMASK(P0,P1,t) do{int jb_=(t)-(NT-4); if(jb_>=0)cmask(P0,P1,jb_,wid);}while(0)
  #define ENDW(tt) do{ if((tt)+3<NT){WAIT_BAR(2);} else if((tt)+2<NT){WAIT_BAR(1);} else {WAIT_BAR(0);} }while(0)
  for(;t+1<NT;t+=2){
    STEP(pB0,pB1,pA0,pA1,t,(t+3<NT),(t+1<NT),(t+1<NT));       ENDW(t);   RESC(); ROT();
    STEP(pA0,pA1,pB0,pB1,t+1,(t+4<NT),(t+2<NT),(t+2<NT));     ENDW(t+1); RESC(); ROT();
  }
  STEP(pB0,pB1,pA0,pA1,NT-1,false,false,false); RESC();
  { float sacc=pB0[0]+pB0[1]; _Pragma("unroll") for(int r=2;r<16;++r)sacc+=pB0[r]; _Pragma("unroll") for(int r=0;r<16;++r)sacc+=pB1[r]; l_reg+=sacc;
    pw0=(u32x4){PKW(pB0,0),PKW(pB0,2),PKW(pB0,4),PKW(pB0,6)};pw1=(u32x4){PKW(pB0,8),PKW(pB0,10),PKW(pB0,12),PKW(pB0,14)};pw2=(u32x4){PKW(pB1,0),PKW(pB1,2),PKW(pB1,4),PKW(pB1,6)};pw3=(u32x4){PKW(pB1,8),PKW(pB1,10),PKW(pB1,12),PKW(pB1,14)};
    SBAR(); pv(o,vb0+sl_cur,PAF(0),PAF(1),PAF(2),PAF(3)); }
  #undef PKW
  #undef PAF
  #undef VFR
  #undef PIN
  #undef MX3
  #undef GAPA
  #undef GAPB
  #undef EX
  #undef VRD
  #undef KRD
  #undef STEP
  #undef ENDW
  {auto rr=__builtin_amdgcn_permlane32_swap(__float_as_uint(l_reg),__float_as_uint(l_reg),false,false);l_reg=__uint_as_float(rr[0])+__uint_as_float(rr[1]);}
  if(hi==0)wsf[32+r32]=l_reg;asm volatile("s_waitcnt lgkmcnt(0)":::"memory");
  float rli[16];
  #pragma unroll
  for(int r=0;r<16;++r)rli[r]=__builtin_amdgcn_rcpf(wsf[32+crow(r,hi)]);
  bf16*Ow=O+(rowbase+q0+wid*QBLK)*DM+vcol;
  { bf16*stg=(bf16*)(shm+LDS_OST)+wid*2048;
    #pragma unroll
    for(int r=0;r<16;++r){const int orow=crow(r,hi);
      #pragma unroll
      for(int d0=0;d0<2;++d0)stg[orow*64+d0*32+r32]=__float2bfloat16(o[d0][r]*rli[r]);}
    asm volatile("s_waitcnt lgkmcnt(0)":::"memory");
    #pragma unroll
    for(int i=0;i<4;++i){const int row=i*8+(lane>>3),ch=lane&7; const u32x4 v=*(const u32x4*)(stg+row*64+ch*8); ATTN_STORE16(Ow+(long)row*DM+ch*8,v);} }
  asm volatile("s_waitcnt lgkmcnt(0)\n\ts_barrier":::"memory");
  #undef DMA_K
  #undef DMA_V
  #undef CMASK
  #undef START
  #undef RESC
  #undef ROT
}
constexpr int ATTN_LDS_BYTES=LDS_BYTES;
struct AttnTensors { const bf16* Q; const bf16* K; const bf16* V; bf16* O; };
struct AttnUnit { int var; int qb; };
struct StaticOrder {
  int vcu;
  __device__ __forceinline__ explicit StaticOrder(int v):vcu(v){}
  __device__ __forceinline__ bool next(int i,AttnUnit&u)const{ if(i>=4)return false; const int s=vcu&15; u.var=vcu>>4; u.qb=(i==0)?s:(i==1)?31-s:(i==2)?32+s:63-s; return true; }
};
template<class Sched,int THRL=8> __device__ __forceinline__ void attn_phase(char*lds,const AttnTensors&T,const Sched&S){
  AttnUnit u;
  for(int i=0;S.next(i,u);++i){ const int h=u.var>>2,mp=(u.var>>1)&1,vh=u.var&1;
    attn_unit<THRL>(h*128+mp*64,h*128+vh*64,u.qb,T.Q,T.K,T.V,T.O+(size_t)mp*SEQ*DM,lds); }
}
#undef SBAR
#undef WAIT_BAR
}
namespace attn128 {
using bf16=__hip_bfloat16;
using bf16x8=__attribute__((ext_vector_type(8)))short;
using s16x4=__attribute__((ext_vector_type(4)))short;
using f32x16=__attribute__((ext_vector_type(16)))float;
using u32x4=__attribute__((ext_vector_type(4)))unsigned;
constexpr int SEQ=16384,D=64,DM=512;
constexpr int NW=8,QBLK=32,QB=QBLK*NW,KVBLK=64,NQB=SEQ/QB;
constexpr int ATTN_PITCH=DM, ATTN_UNIT_ROWS=QB;
__device__ __forceinline__ int crow(int r,int hi){return (r&3)+8*(r>>2)+4*hi;}
#define SBAR() __builtin_amdgcn_sched_barrier(0)
__device__ __forceinline__ void cmask(f32x16&p0,f32x16&p1,int jb,int wid){
  const float NEG=-INFINITY;
  if(jb>(wid>>1)){
  #pragma unroll
  for(int r=0;r<16;++r){p0[r]=NEG;p1[r]=NEG;}}
}

constexpr int NSLOT=3, SLOTB=8192;
constexpr int LDS_K=0, LDS_V=NSLOT*SLOTB, LDS_WS=3*NSLOT*SLOTB, LDS_OST=LDS_WS+NW*64*4, LDS_BYTES=LDS_OST+NW*4096;
constexpr float C2=0.125f*1.4426950408889634f;
__device__ __forceinline__ void glds16(const void*gsrc,unsigned lds_dst){unsigned keep;
  asm volatile("s_mov_b32 %0, m0\n\ts_mov_b32 m0, %2\n\ts_nop 0\n\tglobal_load_lds_dwordx4 %1, off\n\ts_mov_b32 m0, %0":"=&s"(keep):"v"(gsrc),"s"(lds_dst):"memory");}
__device__ __forceinline__ float max3f(float a,float b,float c){float r;asm("v_max3_f32 %0, %1, %2, %3":"=v"(r):"v"(a),"v"(b),"v"(c));return r;}
__device__ __forceinline__ float max2f(float a,float b){float r;asm("v_max_f32_e32 %0, %1, %2":"=v"(r):"v"(a),"v"(b));return r;}
__device__ __forceinline__ float fadd_s(float a,float b){float r;asm("v_add_f32_e32 %0, %1, %2":"=v"(r):"v"(a),"v"(b));return r;}
__device__ __forceinline__ float fsub_s(float a,float b){float r;asm("v_sub_f32_e32 %0, %1, %2":"=v"(r):"v"(a),"v"(b));return r;}
typedef float f32x2_t __attribute__((ext_vector_type(2))); typedef __bf16 bf16x2_t __attribute__((ext_vector_type(2)));
__device__ __forceinline__ unsigned cvtpk_s(float lo,float hi){f32x2_t v={lo,hi};bf16x2_t b=__builtin_convertvector(v,bf16x2_t);return __builtin_bit_cast(unsigned,b);}
#define WAIT_BAR(N) asm volatile("s_waitcnt vmcnt(" #N ") lgkmcnt(0)\n\ts_barrier":::"memory")

__device__ __forceinline__ void qkt(f32x16&p0,f32x16&p1,const char*Kslot,const bf16x8*qr,const f32x16&negm,int r32,int hi){
  const char*kb=Kslot+hi*1024+r32*16;
  #pragma unroll
  for(int d0=0;d0<4;++d0){
    const bf16x8 b0=*reinterpret_cast<const bf16x8*>(kb+d0*2048);
    const bf16x8 b1=*reinterpret_cast<const bf16x8*>(kb+d0*2048+512);
    if(d0==0){p0=__builtin_amdgcn_mfma_f32_32x32x16_bf16(b0,qr[0],negm,0,0,0);p1=__builtin_amdgcn_mfma_f32_32x32x16_bf16(b1,qr[0],negm,0,0,0);}
    else{p0=__builtin_amdgcn_mfma_f32_32x32x16_bf16(b0,qr[d0],p0,0,0,0);p1=__builtin_amdgcn_mfma_f32_32x32x16_bf16(b1,qr[d0],p1,0,0,0);}}
}
typedef __attribute__((address_space(3))) const char* lds_cptr;
typedef short v4i16_t __attribute__((ext_vector_type(4)));
__device__ __forceinline__ void kload8(bf16x8*kf,lds_cptr kp){
  kf[0]=*(const __attribute__((address_space(3))) bf16x8*)(kp);      kf[1]=*(const __attribute__((address_space(3))) bf16x8*)(kp+512);
  kf[2]=*(const __attribute__((address_space(3))) bf16x8*)(kp+2048); kf[3]=*(const __attribute__((address_space(3))) bf16x8*)(kp+2560);
  kf[4]=*(const __attribute__((address_space(3))) bf16x8*)(kp+4096); kf[5]=*(const __attribute__((address_space(3))) bf16x8*)(kp+4608);
  kf[6]=*(const __attribute__((address_space(3))) bf16x8*)(kp+6144); kf[7]=*(const __attribute__((address_space(3))) bf16x8*)(kp+6656);
}
__device__ __forceinline__ void kload2(bf16x8*kf,lds_cptr kp,int j){ kf[2*j]=*(const __attribute__((address_space(3))) bf16x8*)(kp+j*2048); kf[2*j+1]=*(const __attribute__((address_space(3))) bf16x8*)(kp+j*2048+512); }
__device__ __forceinline__ s16x4 vtr(lds_cptr p){ return __builtin_bit_cast(s16x4,__builtin_amdgcn_ds_read_tr16_b64_v4i16((__attribute__((address_space(3))) v4i16_t*)p)); }
__device__ __forceinline__ float rowmax(const f32x16&p0,const f32x16&p1){
  float a=max3f(p0[0],p0[1],p1[0]),b=max3f(p0[2],p0[3],p1[1]);a=max3f(a,p1[2],p1[3]);
  #pragma unroll
  for(int r=4;r<16;r+=4){a=max3f(a,p0[r],p0[r+1]);b=max3f(b,p0[r+2],p0[r+3]);a=max3f(a,p1[r],p1[r+1]);b=max3f(b,p1[r+2],p1[r+3]);}
  const float m=max2f(a,b);
  auto rr=__builtin_amdgcn_permlane32_swap(__float_as_uint(m),__float_as_uint(m),false,false);
  return max2f(__uint_as_float(rr[0]),__uint_as_float(rr[1]));
}
__device__ __forceinline__ void pv(f32x16*o,int vb,bf16x8 pa0,bf16x8 pa1,bf16x8 pa2,bf16x8 pa3){
  #pragma unroll
  for(int d0=0;d0<4;++d0){s16x4 lo[4],hi[4];
    #pragma unroll
    for(int ks=0;ks<4;++ks){
      asm volatile("ds_read_b64_tr_b16 %0,%1 offset:%c2":"=&v"(lo[ks]):"v"(vb),"i"(d0*4096+ks*1024):"memory");
      asm volatile("ds_read_b64_tr_b16 %0,%1 offset:%c2":"=&v"(hi[ks]):"v"(vb),"i"(d0*4096+ks*1024+512):"memory");}
    asm volatile("s_waitcnt lgkmcnt(0)":::"memory");SBAR();
    #define PK(k) (bf16x8){lo[k][0],lo[k][1],lo[k][2],lo[k][3],hi[k][0],hi[k][1],hi[k][2],hi[k][3]}
    o[d0]=__builtin_amdgcn_mfma_f32_32x32x16_bf16(pa0,PK(0),o[d0],0,0,0);
    o[d0]=__builtin_amdgcn_mfma_f32_32x32x16_bf16(pa1,PK(1),o[d0],0,0,0);
    o[d0]=__builtin_amdgcn_mfma_f32_32x32x16_bf16(pa2,PK(2),o[d0],0,0,0);
    o[d0]=__builtin_amdgcn_mfma_f32_32x32x16_bf16(pa3,PK(3),o[d0],0,0,0);
    #undef PK
  }
}

#ifndef ATTN_STORE16
#define ATTN_STORE16(p,v) (*(u32x4*)(p)=(v))
#endif
template<int THRL> __device__ __forceinline__ void attn_unit(int qcol,int vcol,int qb,const bf16*Q,const bf16*__restrict__ K,const bf16*__restrict__ V,bf16*O,char*shm){
  const int tid=threadIdx.x,lane=tid&63,r32=lane&31,hi=lane>>5; const int wid=__builtin_amdgcn_readfirstlane(tid>>6);
  const long rowbase=0; const int q0=qb*QB;
  const bf16*Qw=Q+(rowbase+q0+wid*QBLK)*DM+qcol;
  const bf16*Kh=K+rowbase*DM+qcol,*Vh=V+rowbase*DM+vcol;
  const unsigned lds0=(unsigned)(uintptr_t)shm;
  float*wsf=(float*)(shm+LDS_WS)+wid*64;
  const bf16*ksrc=Kh+(long)lane*DM+wid*8;
  const bf16*vsrc=Vh+(long)(16*(wid&3)+(lane>>2))*DM+(wid>>2)*32+(lane&3)*8;
  const unsigned kdst=lds0+LDS_K+wid*1024, vdst=lds0+LDS_V+wid*1024;
  #define DMA_K(t,slot) glds16(ksrc+(long)(t)*KVBLK*DM,(unsigned)__builtin_amdgcn_readfirstlane(kdst+(slot)))
  #define DMA_V(t,slot) do{ glds16(vsrc+(long)(t)*KVBLK*DM,(unsigned)__builtin_amdgcn_readfirstlane(vdst+2*(slot))); glds16(vsrc+64+(long)(t)*KVBLK*DM,(unsigned)__builtin_amdgcn_readfirstlane(vdst+2*(slot)+8192)); }while(0)
  const int vb0=(int)(lds0+LDS_V)+((lane>>4)&1)*32+(lane&3)*8+(4*hi+((lane&15)>>2))*64;
  const char*Kbase=shm+LDS_K; bf16x8 kf[8];
  const lds_cptr shm3=(lds_cptr)shm; const lds_cptr kp0=shm3+LDS_K+hi*1024+r32*16; const lds_cptr vp0=shm3+LDS_V+((lane>>4)&1)*32+(lane&3)*8+(4*hi+((lane&15)>>2))*64;
  const int NT=(q0+QB)/KVBLK;
  DMA_K(0,0);DMA_V(0,0);DMA_K(1,SLOTB);
  bf16x8 qr[4];
  #pragma unroll
  for(int d0=0;d0<4;++d0)qr[d0]=*reinterpret_cast<const bf16x8*>(&Qw[(long)r32*DM+d0*16+hi*8]);
  float mhat=0.f,l_reg=0.f;f32x16 o[4];o[0]=f32x16{};o[1]=f32x16{};o[2]=f32x16{};o[3]=f32x16{};const f32x16 negm=f32x16{};
  const int qrel=wid*QBLK+r32;
  #define CMASK(P0,P1,t) do{int jb_=(t)-(NT-4); if(jb_>=0)cmask(P0,P1,jb_,wid);}while(0)
  bool resc=false;
  #define START(P0,P1) do{ const float rm=rowmax(P0,P1); resc=false; \
    { const float dl=rm; mhat=fadd_s(mhat,dl); \
      _Pragma("unroll") for(int r=0;r<16;++r){P0[r]=fsub_s(P0[r],dl);P1[r]=fsub_s(P1[r],dl);} \
      } \
    _Pragma("unroll") for(int r=0;r<16;++r)P0[r]=__builtin_amdgcn_exp2f(P0[r]); }while(0)
  #define RESC() do{ if(resc){ asm volatile("s_waitcnt lgkmcnt(0)":::"memory"); \
      _Pragma("unroll") for(int d_=0;d_<4;++d_) _Pragma("unroll") for(int r=0;r<16;++r)o[d_][r]*=wsf[crow(r,hi)]; } }while(0)
  f32x16 pA0,pA1,pB0,pB1;
  int sl_prev=0,sl_cur=0,sl_next=SLOTB;
  #define ROT() do{sl_prev=sl_cur;sl_cur=sl_next;sl_next=(sl_next==(NSLOT-1)*SLOTB)?0:sl_next+SLOTB;}while(0)
  DMA_K(2,2*SLOTB);
  WAIT_BAR(4);
  qkt(pA0,pA1,Kbase,qr,negm,r32,hi);asm volatile("s_nop 15\n\ts_nop 7":"+v"(pA0),"+v"(pA1));CMASK(pA0,pA1,0);
  START(pA0,pA1);
  _Pragma("unroll") for(int r=0;r<16;++r)pA1[r]=__builtin_amdgcn_exp2f(pA1[r]);
  WAIT_BAR(0);
  DMA_K(3,0);DMA_V(1,SLOTB);
  ROT();
  kload8(kf,kp0+sl_cur);
  WAIT_BAR(3);
  s16x4 vlo[8],vhi[8]; u32x4 pw0,pw1,pw2,pw3;
  #define PKW(P,B) cvtpk_s(P[B],P[B+1])
  #define PAF(k) __builtin_bit_cast(bf16x8,pw##k)
  #define VFR(i) (bf16x8){vlo[i][0],vlo[i][1],vlo[i][2],vlo[i][3],vhi[i][0],vhi[i][1],vhi[i][2],vhi[i][3]}
  #define PIN(x) asm volatile("":"+v"(x))
  #define MX3(a,b,c) __builtin_fmaxf(__builtin_fmaxf((a),(b)),(c))
  #define GAPA(MF,A0,A1,A2,A3,W0,W1,PW) do{ MF; sacc+=A0; sacc+=A1; sacc+=A2; sacc+=A3; PIN(sacc); W0; W1; PIN(PW); SBAR(); }while(0)
  #define EX(v) __builtin_amdgcn_exp2f(v)
  #define GAPB(MF,X,B) do{ MF; X[B]=EX(X[B]); X[B+1]=EX(X[B+1]); X[B+2]=EX(X[B+2]); X[B+3]=EX(X[B+3]); PIN(X); SBAR(); }while(0)
  #define VRD(i) do{ vlo[i]=vtr(vp_+(((i)>>2)*4096+((i)&3)*1024)); vhi[i]=vtr(vp_+(((i)>>2)*4096+((i)&3)*1024+512)); }while(0)
  #define VRD2(i) do{ vlo[i]=vtr(vp_+((2+((i)>>2))*4096+((i)&3)*1024)); vhi[i]=vtr(vp_+((2+((i)>>2))*4096+((i)&3)*1024+512)); SBAR(); }while(0)
  #define GAPB2(MF,X,B) do{ MF; X[B]=EX(X[B]-mhat); X[B+1]=EX(X[B+1]-mhat); PIN(X); SBAR(); }while(0)
  #define KRD(G,j) do{ if(G){ kload2(kf,kp0+sl_next,j); SBAR(); } }while(0)
  #define STEP(C0,C1,P0,P1,t,GK,GV,GL) do{ SBAR(); \
    const lds_cptr vp_=vp0+2*sl_prev; \
    VRD(0); SBAR(); float sacc=(P0[0]+P0[1]); \
    GAPA(C0=__builtin_amdgcn_mfma_f32_32x32x16_bf16(kf[0],qr[0],negm,0,0,0), P0[2],P0[3],P0[4],P0[5],     pw0[0]=PKW(P0,0), pw0[1]=PKW(P0,2), pw0); \
    VRD(4); SBAR(); GAPA(C1=__builtin_amdgcn_mfma_f32_32x32x16_bf16(kf[1],qr[0],negm,0,0,0), P0[6],P0[7],P0[8],P0[9],     pw0[2]=PKW(P0,4), pw0[3]=PKW(P0,6), pw0); \
    VRD(1); SBAR(); GAPA(C0=__builtin_amdgcn_mfma_f32_32x32x16_bf16(kf[2],qr[1],C0,0,0,0),   P0[10],P0[11],P0[12],P0[13], pw1[0]=PKW(P0,8), pw1[1]=PKW(P0,10), pw1); \
    VRD(5); SBAR(); GAPA(C1=__builtin_amdgcn_mfma_f32_32x32x16_bf16(kf[3],qr[1],C1,0,0,0),   P0[14],P0[15],P1[0],P1[1],   pw1[2]=PKW(P0,12),pw1[3]=PKW(P0,14), pw1); \
    GAPA(C0=__builtin_amdgcn_mfma_f32_32x32x16_bf16(kf[4],qr[2],C0,0,0,0),   P1[2],P1[3],P1[4],P1[5],     pw2[0]=PKW(P1,0), pw2[1]=PKW(P1,2), pw2); \
    GAPA(C1=__builtin_amdgcn_mfma_f32_32x32x16_bf16(kf[5],qr[2],C1,0,0,0),   P1[6],P1[7],P1[8],P1[9],     pw2[2]=PKW(P1,4), pw2[3]=PKW(P1,6), pw2); \
    GAPA(C0=__builtin_amdgcn_mfma_f32_32x32x16_bf16(kf[6],qr[3],C0,0,0,0),   P1[10],P1[11],P1[12],P1[13], pw3[0]=PKW(P1,8), pw3[1]=PKW(P1,10), pw3); \
    GAPA(C1=__builtin_amdgcn_mfma_f32_32x32x16_bf16(kf[7],qr[3],C1,0,0,0),   P1[14],P1[15],0.f,0.f,       pw3[2]=PKW(P1,12),pw3[3]=PKW(P1,14), pw3); \
    l_reg+=sacc; \
    if(GK){DMA_K((t)+3,sl_cur);} if(GV){DMA_V((t)+1,sl_next);} \
    CMASK(C0,C1,t); \
    { float a=MX3(C0[0],C0[1],C1[0]),b=MX3(C0[2],C0[3],C1[1]); a=MX3(a,C1[2],C1[3]); \
      _Pragma("unroll") for(int r=4;r<16;r+=4){a=MX3(a,C0[r],C0[r+1]);b=MX3(b,C0[r+2],C0[r+3]);a=MX3(a,C1[r],C1[r+1]);b=MX3(b,C1[r+2],C1[r+3]);} \
      float rm=__builtin_fmaxf(a,b); { auto rr=__builtin_amdgcn_permlane32_swap(__float_as_uint(rm),__float_as_uint(rm),false,false); rm=__builtin_fmaxf(__uint_as_float(rr[0]),__uint_as_float(rr[1])); } \
      resc=false; const float rmr=rm-mhat; \
      if(__builtin_expect(__any(rmr>(float)THRL),0)){ const float dl=__builtin_fmaxf(rmr,0.f); mhat+=dl; \
        const float f=__builtin_amdgcn_exp2f(-dl); l_reg*=f; if(hi==0)wsf[r32]=f; resc=true; } } \
    SBAR(); \
    VRD(2); SBAR(); GAPB2(o[0]=__builtin_amdgcn_mfma_f32_32x32x16_bf16(PAF(0),VFR(0),o[0],0,0,0), C0,0); \
    VRD(6); SBAR(); GAPB2(o[1]=__builtin_amdgcn_mfma_f32_32x32x16_bf16(PAF(0),VFR(4),o[1],0,0,0), C0,2); \
    VRD(3); SBAR(); GAPB2(o[0]=__builtin_amdgcn_mfma_f32_32x32x16_bf16(PAF(1),VFR(1),o[0],0,0,0), C0,4); \
    VRD(7); SBAR(); GAPB2(o[1]=__builtin_amdgcn_mfma_f32_32x32x16_bf16(PAF(1),VFR(5),o[1],0,0,0), C0,6); \
    VRD2(0); GAPB2(o[0]=__builtin_amdgcn_mfma_f32_32x32x16_bf16(PAF(2),VFR(2),o[0],0,0,0), C0,8); \
    VRD2(4); GAPB2(o[1]=__builtin_amdgcn_mfma_f32_32x32x16_bf16(PAF(2),VFR(6),o[1],0,0,0), C0,10); \
    VRD2(1); GAPB2(o[0]=__builtin_amdgcn_mfma_f32_32x32x16_bf16(PAF(3),VFR(3),o[0],0,0,0), C0,12); \
    VRD2(5); GAPB2(o[1]=__builtin_amdgcn_mfma_f32_32x32x16_bf16(PAF(3),VFR(7),o[1],0,0,0), C0,14); \
    VRD2(2); GAPB2(o[2]=__builtin_amdgcn_mfma_f32_32x32x16_bf16(PAF(0),VFR(0),o[2],0,0,0), C1,0); \
    VRD2(6); GAPB2(o[3]=__builtin_amdgcn_mfma_f32_32x32x16_bf16(PAF(0),VFR(4),o[3],0,0,0), C1,2); \
    VRD2(3); KRD(GL,0); GAPB2(o[2]=__builtin_amdgcn_mfma_f32_32x32x16_bf16(PAF(1),VFR(1),o[2],0,0,0), C1,4); \
    VRD2(7); KRD(GL,1); GAPB2(o[3]=__builtin_amdgcn_mfma_f32_32x32x16_bf16(PAF(1),VFR(5),o[3],0,0,0), C1,6); \
    KRD(GL,2); GAPB2(o[2]=__builtin_amdgcn_mfma_f32_32x32x16_bf16(PAF(2),VFR(2),o[2],0,0,0), C1,8); \
    KRD(GL,3); GAPB2(o[3]=__builtin_amdgcn_mfma_f32_32x32x16_bf16(PAF(2),VFR(6),o[3],0,0,0), C1,10); \
    GAPB2(o[2]=__builtin_amdgcn_mfma_f32_32x32x16_bf16(PAF(3),VFR(3),o[2],0,0,0), C1,12); \
    GAPB2(o[3]=__builtin_amdgcn_mfma_f32_32x32x16_bf16(PAF(3),VFR(7),o[3],0,0,0), C1,14); \
    }while(0)
  int t=1;
  #undef CMASK
  #define CMASK(P0,P1,t) do{}while(0)
  for(;t+5<NT;t+=2){
    STEP(pB0,pB1,pA0,pA1,t,true,true,true);     WAIT_BAR(3); RESC(); ROT();
    STEP(pA0,pA1,pB0,pB1,t+1,true,true,true);   WAIT_BAR(3); RESC(); ROT();
  }
  #undef CMASK
  #define CMASK(P0,P1,t) do{int jb_=(t)-(NT-4); if(jb_>=0)cmask(P0,P1,jb_,wid);}while(0)
  #define ENDW(tt) do{ if((tt)+3<NT){WAIT_BAR(3);} else if((tt)+2<NT){WAIT_BAR(2);} else {WAIT_BAR(0);} }while(0)
  for(;t+1<NT;t+=2){
    STEP(pB0,pB1,pA0,pA1,t,(t+3<NT),(t+1<NT),(t+1<NT));       ENDW(t);   RESC(); ROT();
    STEP(pA0,pA1,pB0,pB1,t+1,(t+4<NT),(t+2<NT),(t+2<NT));     ENDW(t+1); RESC(); ROT();
  }
  STEP(pB0,pB1,pA0,pA1,NT-1,false,false,false); RESC();
  { float sacc=pB0[0]+pB0[1]; _Pragma("unroll") for(int r=2;r<16;++r)sacc+=pB0[r]; _Pragma("unroll") for(int r=0;r<16;++r)sacc+=pB1[r]; l_reg+=sacc;
    pw0=(u32x4){PKW(pB0,0),PKW(pB0,2),PKW(pB0,4),PKW(pB0,6)};pw1=(u32x4){PKW(pB0,8),PKW(pB0,10),PKW(pB0,12),PKW(pB0,14)};pw2=(u32x4){PKW(pB1,0),PKW(pB1,2),PKW(pB1,4),PKW(pB1,6)};pw3=(u32x4){PKW(pB1,8),PKW(pB1,10),PKW(pB1,12),PKW(pB1,14)};
    SBAR(); pv(o,vb0+2*sl_cur,PAF(0),PAF(1),PAF(2),PAF(3)); }
  #undef PKW
  #undef PAF
  #undef VFR
  #undef PIN
  #undef MX3
  #undef GAPA
  #undef GAPB
  #undef GAPB2
  #undef VRD2
  #undef EX
  #undef VRD
  #undef KRD
  #undef STEP
  #undef ENDW
  {auto rr=__builtin_amdgcn_permlane32_swap(__float_as_uint(l_reg),__float_as_uint(l_reg),false,false);l_reg=__uint_as_float(rr[0])+__uint_as_float(rr[1]);}
  if(hi==0)wsf[32+r32]=l_reg;asm volatile("s_waitcnt lgkmcnt(0)":::"memory");
  float rli[16];
  #pragma unroll
  for(int r=0;r<16;++r)rli[r]=__builtin_amdgcn_rcpf(wsf[32+crow(r,hi)]);
  bf16*Ow=O+(rowbase+q0+wid*QBLK)*DM+vcol;
  { bf16*stg=(bf16*)(shm+LDS_OST)+wid*2048;
    #pragma unroll
    for(int hf=0;hf<2;++hf){
    #pragma unroll
    for(int r=0;r<16;++r){const int orow=crow(r,hi);
      #pragma unroll
      for(int d0=0;d0<2;++d0)stg[orow*64+d0*32+r32]=__float2bfloat16(o[2*hf+d0][r]*rli[r]);}
    asm volatile("s_waitcnt lgkmcnt(0)":::"memory");
    #pragma unroll
    for(int i=0;i<4;++i){const int row=i*8+(lane>>3),ch=lane&7; const u32x4 v=*(const u32x4*)(stg+row*64+ch*8); ATTN_STORE16(Ow+(long)row*DM+hf*64+ch*8,v);}
    asm volatile("s_waitcnt lgkmcnt(0)":::"memory"); } }
  asm volatile("s_waitcnt lgkmcnt(0)\n\ts_barrier":::"memory");
  #undef DMA_K
  #undef DMA_V
  #undef CMASK
  #undef START
  #undef RESC
  #undef ROT
}
constexpr int ATTN_LDS_BYTES=LDS_BYTES;
struct AttnTensors { const bf16* Q; const bf16* K; const bf16* V; bf16* O; };
struct AttnUnit { int var; int qb; };
struct StaticOrder {
  int vcu;
  __device__ __forceinline__ explicit StaticOrder(int v):vcu(v){}
  __device__ __forceinline__ bool next(int i,AttnUnit&u)const{ if(i>=2)return false; const int s=vcu&31; u.var=vcu>>5; u.qb=(i==0)?s:63-s; return true; }
};
template<class Sched,int THRL=8> __device__ __forceinline__ void attn_phase(char*lds,const AttnTensors&T,const Sched&S){
  AttnUnit u;
  for(int i=0;S.next(i,u);++i){ const int h=u.var>>1,mp=u.var&1;
    attn_unit<THRL>(h*128+mp*64,h*128,u.qb,T.Q,T.K,T.V,T.O+(size_t)mp*SEQ*DM,lds); }
}
#undef SBAR
#undef WAIT_BAR
}


#define GAS __attribute__((address_space(1)))
#define LAS __attribute__((address_space(3)))
typedef unsigned short bf16;
typedef unsigned v4u __attribute__((ext_vector_type(4)));
typedef float f32x4 __attribute__((ext_vector_type(4)));
typedef short bf16x8 __attribute__((ext_vector_type(8)));
typedef GAS unsigned gu32;
typedef GAS unsigned long long gu64;
#define RLX_AGENT __ATOMIC_RELAXED, __HIP_MEMORY_SCOPE_AGENT
#define LDS_WAIT() asm volatile("s_waitcnt lgkmcnt(0)" ::: "memory")
#define VM_WAIT() asm volatile("s_waitcnt vmcnt(0)" ::: "memory")
__device__ __forceinline__ unsigned long long rt() { return __builtin_amdgcn_s_memrealtime(); }
__device__ __forceinline__ unsigned f2bf(float f) { unsigned u = __builtin_bit_cast(unsigned, f); return (u + 0x7fffu + ((u >> 16) & 1u)) >> 16; }
__device__ __forceinline__ unsigned pk2(float lo, float hi) { return f2bf(lo) | (f2bf(hi) << 16); }

#define XB_TMO      128
#define XB_XCNT(j)  (256  + 64 * (j))
#define XB_XSUB(j)  (1280 + 64 * (j))
#define XB_XGEN(j)  (2304 + 64 * (j))
#define XB_TOP      3328
#define XB_TOPGEN   3392
#define XCD_BAR_WORDS 3456
#define XB_SPIN_CAP (1u << 18)

__device__ __forceinline__ unsigned xb_ld(unsigned* p)              { return __hip_atomic_load(p, __ATOMIC_RELAXED, __HIP_MEMORY_SCOPE_AGENT); }
__device__ __forceinline__ unsigned xb_add(unsigned* p, unsigned v) { return __hip_atomic_fetch_add(p, v, __ATOMIC_RELAXED, __HIP_MEMORY_SCOPE_AGENT); }
__device__ __forceinline__ unsigned xb_xcc_id() { return (unsigned)__builtin_amdgcn_s_getreg((3 << 11) | 20) & 0xFu; }
#define XB_SPIN(cond, bar) do { unsigned _sp = 0; while (cond) { __builtin_amdgcn_s_sleep(1); \
    if ((++_sp & 255u) == 0u) { if (xb_ld(&(bar)[XB_TMO])) break; if (_sp > XB_SPIN_CAP) { atomicAdd(&(bar)[XB_TMO], 1u); break; } } } } while (0)

struct XcdBarrier {
    unsigned* bar; unsigned x;
    volatile LAS unsigned* st;
};

__device__ __forceinline__ XcdBarrier xcd_barrier_post(unsigned* bar, volatile LAS unsigned* st) {
    XcdBarrier b; b.bar = bar; b.x = xb_xcc_id(); b.st = st;
    if (threadIdx.x == 0) (void)xb_add(&bar[XB_XCNT(b.x)], 1u);
    return b;
}
__device__ __forceinline__ void xcd_barrier_complete(unsigned* bar, unsigned x, unsigned& nloc, unsigned& nx) {
    const unsigned G = gridDim.x * gridDim.y * gridDim.z;
    unsigned sum, cnt, mine, sp = 0u;
    for (;;) {
        sum = 0u; cnt = 0u; mine = 0u;
#pragma unroll
        for (unsigned j = 0; j < 16; ++j) { const unsigned c = xb_ld(&bar[XB_XCNT(j)]); sum += c; cnt += (c > 0u) ? 1u : 0u; mine = (j == x) ? c : mine; }
        if (sum == G) break;
        __builtin_amdgcn_s_sleep(1);
        if ((++sp & 255u) == 0u) { if (xb_ld(&bar[XB_TMO])) break; if (sp > XB_SPIN_CAP) { atomicAdd(&bar[XB_TMO], 1u); break; } }
    }
    nloc = mine > 0u ? mine : 1u; nx = cnt > 0u ? cnt : 1u;
}

__device__ __forceinline__ void xcd_barrier(const XcdBarrier& b) {
    asm volatile("s_waitcnt vmcnt(0)" ::: "memory");
    __syncthreads();
    if (threadIdx.x == 0) {
        unsigned* bar = b.bar;
        __builtin_amdgcn_s_waitcnt(0);
        unsigned nloc = b.st[0], nx = b.st[1];
        if (nloc == 0u) { xcd_barrier_complete(bar, b.x, nloc, nx); b.st[0] = nloc; b.st[1] = nx; }
        const unsigned old = xb_add(&bar[XB_XSUB(b.x)], 1u);
        const unsigned gen = old / nloc;
        if (old + 1u == (gen + 1u) * nloc) {
            __builtin_amdgcn_fence(__ATOMIC_RELEASE, "agent");
            asm volatile("s_waitcnt vmcnt(0)" ::: "memory");
            const unsigned og = xb_add(&bar[XB_TOP], 1u);
            const unsigned tg = og / nx;
            if (og + 1u == (tg + 1u) * nx) xb_add(&bar[XB_TOPGEN], 1u);
            else XB_SPIN(xb_ld(&bar[XB_TOPGEN]) == tg, bar);
            __builtin_amdgcn_fence(__ATOMIC_ACQUIRE, "agent");
            xb_add(&bar[XB_XGEN(b.x)], 1u);
            asm volatile("s_waitcnt vmcnt(0)" ::: "memory");
        } else {
            XB_SPIN(xb_ld(&bar[XB_XGEN(b.x)]) == gen, bar);
            __builtin_amdgcn_fence(__ATOMIC_ACQUIRE, "agent");
            asm volatile("s_waitcnt vmcnt(0)" ::: "memory");
        }
    }
    __syncthreads();
}

constexpr int NWAVES = 8;
constexpr int M = 16384, D = 1024, INC = 2560, AW = 512, LW = 512, NQ = 2048, NEXP = 16384;
constexpr float EPSN = 1e-6f;
constexpr size_t MiB = 1u << 20;
constexpr size_t WS_CTL = 0, CTL_ZERO_BYTES = 1 * MiB;
constexpr size_t WS_ROWSS2 = 512 * 1024;
constexpr size_t WS_RS1 = 1 * MiB;
constexpr size_t WS_SK1 = 1 * MiB + 128 * 1024, WS_SK2 = WS_SK1 + 32 * 1024;
constexpr size_t WS_WIN = 2 * MiB, WS_WOUT = 8 * MiB, WS_WQ = 10 * MiB;
constexpr size_t WS_ED = 16 * MiB, WS_EU = 48 * MiB;
constexpr size_t WS_SCD = 32 * MiB, WS_SCU = 33 * MiB;
constexpr size_t WS_WQ8 = 170 * MiB;
constexpr size_t WS_XB = 80 * MiB;
constexpr size_t WS_OS = 80 * MiB;
constexpr size_t WS_Q2 = 80 * MiB;
constexpr size_t WS_Q = 112 * MiB, WS_SPLIT = 16 * MiB;
constexpr size_t WS_GATE = WS_Q + 4 * WS_SPLIT;
constexpr size_t WS_EID = 144 * MiB, WS_GW = 152 * MiB;
constexpr size_t WS_MIX = 192 * MiB, WS_HB = 224 * MiB, WS_END = 256 * MiB;
constexpr size_t WS_ROWSS3 = 576 * 1024;
constexpr size_t WS_DOTP = 80 * MiB;
constexpr size_t WS_REC = 160 * MiB, WS_N0 = 168 * MiB;
constexpr size_t WS_PEER = 80 * MiB;
constexpr size_t WS_REC_OLD_UNUSED = 0;
constexpr int CW_BAR = 4096;
constexpr int RING_OFF = 0, RING_BYTES = 131072;
constexpr int LDSCTL_OFF = RING_BYTES, MISC_OFF = LDSCTL_OFF + 320;
constexpr int LDS_BYTES = 163840;

struct Frame {
    LAS unsigned char* lds;
    volatile LAS unsigned* MISC;
    int tid, lane, wave;
    int vcu, G;
};

__device__ __forceinline__ float wave_sum(float v) {
#pragma unroll
    for (int o = 1; o < 64; o <<= 1) v += __shfl_xor(v, o);
    return v;
}
__device__ __forceinline__ float bf2f(unsigned short b) { return __builtin_bit_cast(float, (unsigned)b << 16); }
__device__ __forceinline__ float bflo(unsigned w) { return __builtin_bit_cast(float, w << 16); }
__device__ __forceinline__ float bfhi(unsigned w) { return __builtin_bit_cast(float, w & 0xffff0000u); }
__device__ __forceinline__ float gelu_tanh(float x) { const float u = 0.7978845608028654f * (x + 0.044715f * x * x * x); return 0.5f * x * (1.0f + tanhf(u)); }
__device__ __forceinline__ float sigmoidf_(float x) { return 1.0f / (1.0f + expf(-x)); }
__device__ __forceinline__ float fsigmoid(float x) { return __builtin_amdgcn_rcpf(1.0f + __builtin_amdgcn_exp2f(-1.4426950408889634f * x)); }
__device__ __forceinline__ float fgelu_tanh(float x) { const float u = 0.7978845608028654f * (x + 0.044715f * x * x * x); const float t = 1.0f - 2.0f * __builtin_amdgcn_rcpf(1.0f + __builtin_amdgcn_exp2f(2.8853900817779268f * u)); return 0.5f * x * (1.0f + t); }

__device__ __forceinline__ void p0_transpose_item(const float* W, int K, int N, bf16* WT, const float* gk, LAS float* scr, int item, int lane) {
    const int nblk = N / 32, kb = item / nblk, nb = item % nblk, k0 = 64 * kb, n0 = 32 * nb;
    float wv[32];
#pragma unroll
    for (int i = 0; i < 32; ++i) { const int kk = 2 * i + (lane >> 5); wv[i] = W[(size_t)(k0 + kk) * N + n0 + (lane & 31)]; }
#pragma unroll
    for (int i = 0; i < 32; ++i) { const int kk = 2 * i + (lane >> 5); const float g = gk ? gk[k0 + kk] : 1.0f; scr[kk * 33 + (lane & 31)] = wv[i] * g; }
    LDS_WAIT(); asm volatile("" ::: "memory");
    const int c = lane & 7;
#pragma unroll
    for (int j = 0; j < 4; ++j) { const int n = (lane >> 3) + 8 * j; const LAS float* s = scr + (8 * c) * 33 + n;
        v4u o; o.x = pk2(s[0 * 33], s[1 * 33]); o.y = pk2(s[2 * 33], s[3 * 33]); o.z = pk2(s[4 * 33], s[5 * 33]); o.w = pk2(s[6 * 33], s[7 * 33]);
        *(GAS v4u*)(WT + (size_t)(n0 + n) * K + k0 + 8 * c) = o; }
    LDS_WAIT(); asm volatile("" ::: "memory");
}
template <int NR> __device__ __forceinline__ void p0_rows(const float* xrow, bf16* orow, const float* gk, float* rs, int lane) {
    f32x4 v[NR][4];
#pragma unroll
    for (int i = 0; i < NR; ++i)
#pragma unroll
        for (int j = 0; j < 4; ++j) v[i][j] = __builtin_nontemporal_load((const GAS f32x4*)(xrow + (size_t)i * 1024) + lane + 64 * j);
#pragma unroll
    for (int i = 0; i < NR; ++i) {
        if (rs) { float s = 0.f;
#pragma unroll
            for (int j = 0; j < 4; ++j) s += (v[i][j].x * v[i][j].x + v[i][j].y * v[i][j].y) + (v[i][j].z * v[i][j].z + v[i][j].w * v[i][j].w);
            const float tot = wave_sum(s); if (lane == 0) rs[i] = 1.0f / sqrtf(tot * (1.0f / 1024.0f) + EPSN); }
        if (gk) {
#pragma unroll
            for (int j = 0; j < 4; ++j) v[i][j] = v[i][j] * ((const GAS f32x4*)gk)[lane + 64 * j]; }
        GAS unsigned long long* o8 = (GAS unsigned long long*)(orow + (size_t)i * 1024) + lane;
#pragma unroll
        for (int j = 0; j < 4; ++j) o8[64 * j] = (unsigned long long)pk2(v[i][j].x, v[i][j].y) | ((unsigned long long)pk2(v[i][j].z, v[i][j].w) << 32);
    }
}

struct Args { const float* in[23]; float* out; unsigned char* ws; int ph_lo, ph_hi; };

__device__ __forceinline__ void p0_prologue(Frame& F, const Args& a) {
    LAS float* scr = (LAS float*)(F.lds + RING_OFF + F.wave * 16384);
    unsigned char* ws = a.ws;
    const int gw = F.vcu * NWAVES + F.wave, NGW = F.G * NWAVES;
    constexpr int I_IN = (D / 64) * (INC / 32), I_OUT = (D / 64) * (D / 32), I_Q = (D / 64) * (NQ / 32);
    constexpr int NITEMS = I_IN + I_OUT + I_Q;
    for (int it = F.wave * (int)F.G + F.vcu; it < NITEMS; it += NGW) {
        int r = it;
        if (r < I_IN) { p0_transpose_item(a.in[2], D, INC, (bf16*)(ws + WS_WIN), a.in[1], scr, r, F.lane); continue; } r -= I_IN;
        if (r < I_OUT) { p0_transpose_item(a.in[15], D, D, (bf16*)(ws + WS_WOUT), nullptr, scr, r, F.lane); continue; } r -= I_OUT;
        p0_transpose_item(a.in[17], D, NQ, (bf16*)(ws + WS_WQ), a.in[16], scr, r, F.lane);
    }
    for (int m = gw; m < M / 8; m += NGW) { const int r = 8 * m; p0_rows<8>(a.in[0] + (size_t)r * D, (bf16*)(ws + WS_XB) + (size_t)r * D, nullptr, (float*)(ws + WS_RS1) + r, F.lane); }
    for (int m = F.wave * (int)F.G + F.vcu; m < 8; m += NGW) { const int r = 4 * m;
        if (r < 16) p0_rows<4>(a.in[18] + (size_t)r * 1024, (bf16*)(ws + WS_SK1) + (size_t)r * 1024, nullptr, nullptr, F.lane);
        else        p0_rows<4>(a.in[19] + (size_t)(r - 16) * 1024, (bf16*)(ws + WS_SK2) + (size_t)(r - 16) * 1024, nullptr, nullptr, F.lane); }
}
template <int NR> __device__ __forceinline__ void q8_load(f32x4 (&v)[NR][4], const float* xrow, int lane) {
#pragma unroll
    for (int i = 0; i < NR; ++i)
#pragma unroll
        for (int j = 0; j < 4; ++j) v[i][j] = __builtin_nontemporal_load((const GAS f32x4*)(xrow + (size_t)i * 1024) + lane + 64 * j);
}
template <int NR> __device__ __forceinline__ void q8_finish(f32x4 (&v)[NR][4], unsigned char* orow, const float* gk, float* scale, int lane) {
#pragma unroll
    for (int i = 0; i < NR; ++i) {
        float am = 0.f;
#pragma unroll
        for (int j = 0; j < 4; ++j) { if (gk) v[i][j] = v[i][j] * ((const GAS f32x4*)gk)[lane + 64 * j];
            am = fmaxf(fmaxf(am, fmaxf(fabsf(v[i][j].x), fabsf(v[i][j].y))), fmaxf(fabsf(v[i][j].z), fabsf(v[i][j].w))); }
#pragma unroll
        for (int o = 1; o < 64; o <<= 1) am = fmaxf(am, __shfl_xor(am, o));
        const float sc = (am > 0.f) ? am * (1.0f / 127.0f) : 1.0f, inv = 1.0f / sc;
        if (lane == 0) scale[i] = sc;
        GAS unsigned* o4 = (GAS unsigned*)(orow + (size_t)i * 1024) + lane;
#pragma unroll
        for (int j = 0; j < 4; ++j) { const int q0 = (int)__builtin_rintf(v[i][j].x * inv), q1 = (int)__builtin_rintf(v[i][j].y * inv), q2 = (int)__builtin_rintf(v[i][j].z * inv), q3 = (int)__builtin_rintf(v[i][j].w * inv);
            o4[64 * j] = ((unsigned)q0 & 255u) | (((unsigned)q1 & 255u) << 8) | (((unsigned)q2 & 255u) << 16) | ((unsigned)q3 << 24); }
    }
}
__device__ __forceinline__ const float* cvx_src(const Args& a, int m) { const int r = 4 * m; return (r < NEXP) ? a.in[20] + (size_t)r * D : a.in[21] + (size_t)(r - NEXP) * D; }
__device__ __forceinline__ void cvx_finish(const Args& a, f32x4 (&v)[4][4], int m, int lane) {
    unsigned char* ws = a.ws; const int r = 4 * m;
    if (r < NEXP) q8_finish<4>(v, ws + WS_ED + (size_t)r * D, a.in[16], (float*)(ws + WS_SCD) + r, lane);
    else          q8_finish<4>(v, ws + WS_EU + (size_t)(r - NEXP) * D, nullptr, (float*)(ws + WS_SCU) + (r - NEXP), lane);
}
__device__ __forceinline__ void convert_experts(const Args& a, int w, int nw, int lane) {
    constexpr int TOT = NEXP / 4;
    int m = w; if (m >= TOT) return;
    f32x4 va[4][4], vb[4][4];
    q8_load<4>(va, cvx_src(a, m), lane);
    for (;;) {
        const bool hb = m + nw < TOT; if (hb) q8_load<4>(vb, cvx_src(a, m + nw), lane);
        cvx_finish(a, va, m, lane);
        if (!hb) break;
        const bool ha = m + 2 * nw < TOT; if (ha) q8_load<4>(va, cvx_src(a, m + 2 * nw), lane);
        cvx_finish(a, vb, m + nw, lane);
        if (!ha) break;
        m += 2 * nw;
    }
}

typedef float f32x16 __attribute__((ext_vector_type(16)));
__device__ __forceinline__ void lru_local_unit(Frame& F, const Args& a, int c) {
    constexpr int YP = 520;
    LAS unsigned short* Y = (LAS unsigned short*)(F.lds + RING_OFF);
    const int e = F.tid, r0 = c * 64;
    const bf16* XR = (const bf16*)(a.ws + WS_Q + 3 * WS_SPLIT);
    unsigned* HLAC = (unsigned*)a.out;
    float* CH = a.out + (size_t)M * 512; float* CA = CH + (size_t)(M / 64) * 512;
    { const float* conv_w = a.in[8]; const float cw0 = conv_w[e], cw1 = conv_w[512 + e], cw2 = conv_w[1024 + e], cw3 = conv_w[1536 + e], cb = a.in[9][e];
      float x0 = 0.f, x1 = 0.f, x2 = 0.f;
      if (c > 0) { x0 = bf2f(XR[(size_t)(r0 - 3) * 512 + e]); x1 = bf2f(XR[(size_t)(r0 - 2) * 512 + e]); x2 = bf2f(XR[(size_t)(r0 - 1) * 512 + e]); }
#pragma unroll 8
      for (int t = 0; t < 64; ++t) { const float x3 = bf2f(XR[(size_t)(r0 + t) * 512 + e]); Y[t * YP + e] = (unsigned short)f2bf(cb + x0 * cw0 + x1 * cw1 + x2 * cw2 + x3 * cw3); x0 = x1; x1 = x2; x2 = x3; } }
    __syncthreads();
    const int n = F.wave, lane = F.lane, r32 = lane & 31, hi = lane >> 5;
#pragma unroll 1
    for (int et = 0; et < 2; ++et) {
        bf16x8 wf[2][4];
#pragma unroll
        for (int gt = 0; gt < 2; ++gt) { const float* w = a.in[gt ? 12 : 10] + n * 4096 + 32 * et; asm volatile("" : "+s"(w));
#pragma unroll
            for (int ks = 0; ks < 4; ++ks) { float f[8];
#pragma unroll
                for (int j = 0; j < 8; ++j) f[j] = w[(16 * ks + 8 * hi + j) * 64 + r32];
                wf[gt][ks] = __builtin_bit_cast(bf16x8, (v4u){pk2(f[0], f[1]), pk2(f[2], f[3]), pk2(f[4], f[5]), pk2(f[6], f[7])}); asm volatile("" ::: "memory"); } }
        const int ch = 64 * n + 32 * et + r32;
        const float ba = a.in[11][ch], bx = a.in[13][ch], lam = a.in[14][ch];
        const float sp = (lam > 15.f) ? expf(-lam) : log1pf(expf(-lam));
        float av[2][16], bv[2][16];
#pragma unroll
        for (int tt = 0; tt < 2; ++tt) {
            f32x16 ra = {}, ia = {};
#pragma unroll
            for (int ks = 0; ks < 4; ++ks) { const bf16x8 af = *(const LAS bf16x8*)(Y + (32 * tt + r32) * YP + 64 * n + 16 * ks + 8 * hi);
                ra = __builtin_amdgcn_mfma_f32_32x32x16_bf16(af, wf[0][ks], ra, 0, 0, 0); ia = __builtin_amdgcn_mfma_f32_32x32x16_bf16(af, wf[1][ks], ia, 0, 0, 0); }
#pragma unroll
            for (int r = 0; r < 16; ++r) { const int t = 32 * tt + (r & 3) + 8 * (r >> 2) + 4 * hi;
                const float rr = fsigmoid(ra[r] + ba), ii = fsigmoid(ia[r] + bx);
                const float log_a = -8.0f * rr * sp, aa = __builtin_amdgcn_exp2f(log_a * 1.4426950408889634f);
                const float u2 = 2.0f * log_a;
                const float ser = -u2 * (1.0f + u2 * (0.5f + u2 * (0.16666667f + u2 * (0.041666668f + u2 * 0.0083333338f))));
                const float om = (u2 > -0.1f) ? ser : (1.0f - aa * aa);
                const float mult = __builtin_amdgcn_sqrtf(fmaxf(om, 1e-12f));
                av[tt][r] = aa; bv[tt][r] = mult * (ii * bf2f(Y[t * YP + ch])); }
        }
#pragma unroll
        for (int tt = 0; tt < 2; ++tt)
#pragma unroll
            for (int rq = 0; rq < 4; ++rq) { float h = 0.f, pa = 1.f;
#pragma unroll
                for (int k = 0; k < 4; ++k) { const int r = 4 * rq + k; h = av[tt][r] * h + bv[tt][r]; pa *= av[tt][r]; bv[tt][r] = h; av[tt][r] = pa; } }
        float hin[8], ain[8]; float hc = 0.f, ac = 1.f;
#pragma unroll
        for (int j = 0; j < 8; ++j) { const int tt = j >> 2, r3 = 4 * (j & 3) + 3;
#pragma unroll
            for (int own = 0; own < 2; ++own) {
                if (hi == own) { hin[j] = hc; ain[j] = ac; }
                const float mh = av[tt][r3] * hc + bv[tt][r3], ma = ac * av[tt][r3];
                const float oh = __shfl_xor(mh, 32), oa = __shfl_xor(ma, 32);
                hc = (hi == own) ? mh : oh; ac = (hi == own) ? ma : oa; } }
#pragma unroll
        for (int tt = 0; tt < 2; ++tt)
            { unsigned ob = (unsigned)((r0 + 32 * tt + 4 * hi) * 512 + ch); asm volatile("" : "+v"(ob));
#pragma unroll
            for (int r = 0; r < 16; ++r) { const int j = 4 * tt + (r >> 2); const unsigned o = ob + (unsigned)(((r & 3) + 8 * (r >> 2)) * 512);
                const float hl = bv[tt][r] + av[tt][r] * hin[j], ac = av[tt][r] * ain[j];
                HLAC[o] = pk2(hl, ac);
                if (tt == 1 && r == 15 && hi == 1) { CH[c * 512 + ch] = hl; CA[c * 512 + ch] = ac; } } }
    }
    __syncthreads();
}

__device__ __forceinline__ void fix_unit(Frame& F, const Args& a, int c, float lamv) {
    const int r0 = c * 64;
    const unsigned* HLAC = (const unsigned*)a.out; const float* CH = a.out + (size_t)M * 512; const float* CA = CH + (size_t)(M / 64) * 512;
    const bf16* GATE = (const bf16*)(a.ws + WS_GATE);
    bf16* MIX = (bf16*)(a.ws + WS_MIX);
    const int g4 = F.tid & 127, sgm = F.tid >> 7;
    LAS f32x4* SA = (LAS f32x4*)(F.lds + RING_OFF); LAS f32x4* SH = SA + 512;
    { const int L = (c + 3) >> 2; const int lo_c = sgm * L; int hi_c = lo_c + L; if (hi_c > c) hi_c = c;
      f32x4 A4 = (f32x4){1.f, 1.f, 1.f, 1.f}, H4 = (f32x4){0.f, 0.f, 0.f, 0.f};
      int cc = lo_c;
      for (; cc + 8 <= hi_c; cc += 8) { f32x4 av[8], hv[8];
#pragma unroll
          for (int k = 0; k < 8; ++k) { const size_t o = (size_t)(cc + k) * 512 + 4 * g4; av[k] = *(const GAS f32x4*)(CA + o); hv[k] = *(const GAS f32x4*)(CH + o); }
#pragma unroll
          for (int k = 0; k < 8; ++k) { H4 = av[k] * H4 + hv[k]; A4 = A4 * av[k]; } }
      for (; cc < hi_c; ++cc) { const size_t o = (size_t)cc * 512 + 4 * g4; const f32x4 av = *(const GAS f32x4*)(CA + o), hv = *(const GAS f32x4*)(CH + o); H4 = av * H4 + hv; A4 = A4 * av; }
      SA[sgm * 128 + g4] = A4; SH[sgm * 128 + g4] = H4; }
    __syncthreads();
    f32x4 hin = (f32x4){0.f, 0.f, 0.f, 0.f};
#pragma unroll
    for (int sq = 0; sq < 4; ++sq) hin = SA[sq * 128 + g4] * hin + SH[sq * 128 + g4];
    __syncthreads();
#pragma unroll 4
    for (int t = sgm * 16; t < sgm * 16 + 16; ++t) { const size_t o = (size_t)(r0 + t) * 512 + 4 * g4;
        const v4u ha = *(const GAS v4u*)(HLAC + o);
        const f32x4 h = (f32x4){bflo(ha.x), bflo(ha.y), bflo(ha.z), bflo(ha.w)} + (f32x4){bfhi(ha.x), bfhi(ha.y), bfhi(ha.z), bfhi(ha.w)} * hin; const unsigned long long gw = *(const GAS unsigned long long*)(GATE + o);
        const unsigned glo = (unsigned)gw, ghi = (unsigned)(gw >> 32);
        const unsigned long long ov = (unsigned long long)pk2(h.x * fgelu_tanh(bflo(glo)), h.y * fgelu_tanh(bfhi(glo))) | ((unsigned long long)pk2(h.z * fgelu_tanh(bflo(ghi)), h.w * fgelu_tanh(bfhi(ghi))) << 32);
        *(GAS unsigned long long*)(MIX + (size_t)(r0 + t) * 1024 + 512 + 4 * g4) = ov; }
    const bf16* OS0 = (const bf16*)(a.ws + WS_OS); const bf16* OS1 = OS0 + (size_t)M * 512;
    const float* sg = a.in[7] + (F.lane & 15) * 8;
    float sgv[8];
#pragma unroll
    for (int j = 0; j < 8; ++j) sgv[j] = sg[j] * 0.8f;
#pragma unroll 2
    for (int rr = 0; rr < 8; ++rr) { const size_t row = (size_t)(r0 + 8 * F.wave + rr);
        const v4u p = *(const GAS v4u*)(OS0 + row * 512 + F.lane * 8), q = *(const GAS v4u*)(OS1 + row * 512 + F.lane * 8);
        float d[8];
        d[0] = bflo(p.x) - lamv * bflo(q.x); d[1] = bfhi(p.x) - lamv * bfhi(q.x); d[2] = bflo(p.y) - lamv * bflo(q.y); d[3] = bfhi(p.y) - lamv * bfhi(q.y);
        d[4] = bflo(p.z) - lamv * bflo(q.z); d[5] = bfhi(p.z) - lamv * bfhi(q.z); d[6] = bflo(p.w) - lamv * bflo(q.w); d[7] = bfhi(p.w) - lamv * bfhi(q.w);
        float ss = 0.f;
#pragma unroll
        for (int j = 0; j < 8; ++j) ss += d[j] * d[j];
        ss += __shfl_xor(ss, 1); ss += __shfl_xor(ss, 2); ss += __shfl_xor(ss, 4); ss += __shfl_xor(ss, 8);
        const float ri = 1.0f / sqrtf(ss * (1.0f / 128.0f) + EPSN);
        v4u o; o.x = pk2(d[0] * ri * sgv[0], d[1] * ri * sgv[1]); o.y = pk2(d[2] * ri * sgv[2], d[3] * ri * sgv[3]);
        o.z = pk2(d[4] * ri * sgv[4], d[5] * ri * sgv[5]); o.w = pk2(d[6] * ri * sgv[6], d[7] * ri * sgv[7]);
        *(GAS v4u*)(MIX + row * 1024 + F.lane * 8) = o; }
}

typedef float f32x16 __attribute__((ext_vector_type(16)));
#define CEX(a, b) do { const float _hi = fmaxf(a, b), _lo = fminf(a, b); a = _hi; b = _lo; } while (0)
__device__ __forceinline__ int skey(int b) { return b ^ ((b >> 31) & 0x7fffffff); }
#define CEI(a, b) do { const int _hi = max(a, b), _lo = min(a, b); a = _hi; b = _lo; } while (0)
__device__ __forceinline__ void sort16_desc(int (&v)[16]) {
#pragma unroll
    for (int k = 2; k <= 16; k <<= 1)
#pragma unroll
        for (int j = k >> 1; j >= 1; j >>= 1)
#pragma unroll
            for (int i = 0; i < 16; ++i) { const int l = i ^ j; if (l > i) { if ((i & k) == 0) CEI(v[i], v[l]); else CEI(v[l], v[i]); } }
}
__device__ __forceinline__ void merge16_desc(int (&a)[16], const int (&b)[16]) {
#pragma unroll
    for (int i = 0; i < 16; ++i) a[i] = max(a[i], b[15 - i]);
#pragma unroll
    for (int j = 8; j >= 1; j >>= 1)
#pragma unroll
        for (int i = 0; i < 16; ++i) if ((i & j) == 0) CEI(a[i], a[i + j]);
}
__device__ __forceinline__ void top16_half(int (&top)[16], const bf16* q, const LAS unsigned char* sk, int r32, int hi) {
    bf16x8 qf[8];
#pragma unroll
    for (int ks = 0; ks < 8; ++ks) qf[ks] = *(const GAS bf16x8*)(q + 16 * ks + 8 * hi);
#pragma unroll
    for (int i = 0; i < 16; ++i) top[i] = (int)0x80000000;
#pragma unroll 1
    for (int kt = 0; kt < 4; ++kt) {
        f32x16 acc = {};
#pragma unroll
        for (int ks = 0; ks < 8; ++ks) { const bf16x8 kf = *(const LAS bf16x8*)(sk + (32 * kt + r32) * 272 + (16 * ks + 8 * hi) * 2); acc = __builtin_amdgcn_mfma_f32_32x32x16_bf16(kf, qf[ks], acc, 0, 0, 0); }
        int grp[16];
#pragma unroll
        for (int r = 0; r < 16; ++r) { const int idx = 32 * kt + (r & 3) + 8 * (r >> 2) + 4 * hi; const float av = acc[r];
            grp[r] = (skey(__float_as_int(av)) & ~127) | idx; }
        sort16_desc(grp); merge16_desc(top, grp);
    }
    int oth[16];
#pragma unroll
    for (int i = 0; i < 16; ++i) oth[i] = __shfl_xor(top[i], 32);
    merge16_desc(top, oth);
}
__device__ __forceinline__ void route_unit(const Args& a, int g, int hd, int lane, LAS unsigned char* slot, const LAS unsigned char* skl, int* EIDo, float* GWo) {
    const int r32 = lane & 31, hi = lane >> 5; const int t = g * 32 + r32;
    const bf16* q = (const bf16*)(a.ws + WS_Q2) + (size_t)t * NQ + hd * 256;
    int k1[16], k2[16];
    top16_half(k1, q, skl, r32, hi);
    top16_half(k2, q + 128, skl + 128 * 272, r32, hi);
    { v4u w1, w2;
#define IDX4(v, j) (((unsigned)v[4 * (j)] & 127u) | (((unsigned)v[4 * (j) + 1] & 127u) << 8) | (((unsigned)v[4 * (j) + 2] & 127u) << 16) | (((unsigned)v[4 * (j) + 3] & 127u) << 24))
      w1 = (v4u){IDX4(k1, 0), IDX4(k1, 1), IDX4(k1, 2), IDX4(k1, 3)}; w2 = (v4u){IDX4(k2, 0), IDX4(k2, 1), IDX4(k2, 2), IDX4(k2, 3)};
#undef IDX4
      *(LAS v4u*)(slot) = w1; *(LAS v4u*)(slot + 16) = w2; }
    float v1[16], v2[16];
#pragma unroll
    for (int i = 0; i < 16; ++i) { v1[i] = __int_as_float(skey(k1[i])); v2[i] = __int_as_float(skey(k2[i])); }
#define CKEY(ia, ib) ((skey(__float_as_int(v1[ia] + v2[ib])) & ~255) | ((ia) * 16 + (ib)))
    int K[16], G1[16], G2[16];
#pragma unroll
    for (int i = 0; i < 16; ++i) K[i] = CKEY(0, i);
    { int n_ = 0;
#pragma unroll
      for (int ia = 1; ia < 16; ++ia)
#pragma unroll
          for (int ib = 0; ib < 16; ++ib) if ((ia + 1) * (ib + 1) <= 16) { const int kk = CKEY(ia, ib); if (n_ < 16) G1[n_] = kk; else if (n_ < 32) G2[n_ - 16] = kk; ++n_; }
    }
    sort16_desc(G1); merge16_desc(K, G1);
    sort16_desc(G2); merge16_desc(K, G2);
    { int x0 = CKEY(14, 0), x1 = CKEY(15, 0);
#pragma unroll
      for (int i = 0; i < 16; ++i) { CEI(K[i], x0); }
#pragma unroll
      for (int i = 0; i < 16; ++i) { CEI(K[i], x1); }
    }
#undef CKEY
    unsigned P[16]; float sc[16];
#pragma unroll
    for (int i = 0; i < 16; ++i) { const unsigned ci = (unsigned)K[i] & 255u; const unsigned i1 = slot[ci >> 4], i2 = slot[16 + (ci & 15u)]; P[i] = i1 * 128u + i2; sc[i] = __int_as_float(skey(K[i] & ~255)); }
    float ex[16], sum = 0.f;
#pragma unroll
    for (int i = 0; i < 16; ++i) { ex[i] = expf(sc[i] - sc[0]); sum += ex[i]; }
    const float inv = 1.0f / sum;
    if (hi == 0) {
        GAS v4u* eo = (GAS v4u*)(EIDo + (size_t)t * 128 + hd * 16); GAS f32x4* go = (GAS f32x4*)(GWo + (size_t)t * 128 + hd * 16);
#pragma unroll
        for (int j = 0; j < 4; ++j) { eo[j] = (v4u){P[4 * j], P[4 * j + 1], P[4 * j + 2], P[4 * j + 3]}; go[j] = (f32x4){ex[4 * j] * inv, ex[4 * j + 1] * inv, ex[4 * j + 2] * inv, ex[4 * j + 3] * inv}; }
    }
}

__device__ __forceinline__ float wave_max(float v) {
#pragma unroll
    for (int o = 1; o < 64; o <<= 1) v = fmaxf(v, __shfl_xor(v, o));
    return v;
}
__device__ __forceinline__ void route_unit_ref(const Args& a, int t, int hd, int lane, LAS float* sc) {
    LAS unsigned* sci = (LAS unsigned*)sc;
    const bf16* q = (const bf16*)(a.ws + WS_Q2) + (size_t)t * NQ + hd * 256;
#pragma unroll 1
    for (int half = 0; half < 2; ++half) {
        const float* sk = a.in[18 + half];
        float sa = 0.f, sb = 0.f;
        for (int d = 0; d < 128; ++d) { const float qv = bf2f(q[half * 128 + d]); sa += qv * sk[lane * 128 + d]; sb += qv * sk[(lane + 64) * 128 + d]; }
        for (int r = 0; r < 16; ++r) {
            const float mx = wave_max(fmaxf(sa, sb));
            const unsigned long long ba = __ballot(sa == mx), bb = __ballot(sb == mx);
            int key;
            if (ba) { const int ln = __ffsll((long long)ba) - 1; key = ln; if (lane == ln) sa = -INFINITY; }
            else { const int ln = __ffsll((long long)bb) - 1; key = ln + 64; if (lane == ln) sb = -INFINITY; }
            if (lane == 0) { sc[half * 32 + r] = mx; sci[half * 32 + 16 + r] = (unsigned)key; }
        }
    }
    __builtin_amdgcn_s_waitcnt(0);
    const int ca = lane >> 2, cb0 = (lane & 3) * 4;
    float c[4];
#pragma unroll
    for (int j = 0; j < 4; ++j) c[j] = sc[ca] + sc[32 + cb0 + j];
    for (int r = 0; r < 16; ++r) {
        const float mx = wave_max(fmaxf(fmaxf(c[0], c[1]), fmaxf(c[2], c[3])));
        const bool mine = (c[0] == mx) || (c[1] == mx) || (c[2] == mx) || (c[3] == mx);
        const unsigned long long bm = __ballot(mine); const int ln = __ffsll((long long)bm) - 1;
        if (lane == ln) { int j = (c[0] == mx) ? 0 : (c[1] == mx) ? 1 : (c[2] == mx) ? 2 : 3;
            if (j == 0) c[0] = -INFINITY; else if (j == 1) c[1] = -INFINITY; else if (j == 2) c[2] = -INFINITY; else c[3] = -INFINITY;
            sc[64 + r] = mx; sci[80 + r] = sci[16 + ca] * 128u + sci[48 + cb0 + j]; }
    }
    __builtin_amdgcn_s_waitcnt(0);
    if (lane < 16) {
        const float mx0 = sc[64]; const float ex = expf(sc[64 + lane] - mx0); float sum = ex;
        sum += __shfl_xor(sum, 1); sum += __shfl_xor(sum, 2); sum += __shfl_xor(sum, 4); sum += __shfl_xor(sum, 8);
        ((int*)(a.ws + WS_EID))[(size_t)t * 128 + hd * 16 + lane] = (int)sci[80 + lane];
        ((float*)(a.ws + WS_GW))[(size_t)t * 128 + hd * 16 + lane] = ex / sum;
    }
    __builtin_amdgcn_s_waitcnt(0);
}

__device__ __forceinline__ void unpack8(const v4u w, float* f) { f[0] = bflo(w.x); f[1] = bfhi(w.x); f[2] = bflo(w.y); f[3] = bfhi(w.y); f[4] = bflo(w.z); f[5] = bfhi(w.z); f[6] = bflo(w.w); f[7] = bfhi(w.w); }
__device__ __forceinline__ void gather_token(const Args& a, int t, int lane, float* dst) {
    const bf16* HB = (const bf16*)(a.ws + WS_HB) + (size_t)t * D; const bf16* ED = (const bf16*)(a.ws + WS_ED); const bf16* EU = (const bf16*)(a.ws + WS_EU);
    float hx[16];
    unpack8(*(const GAS v4u*)(HB + lane * 8), hx); unpack8(*(const GAS v4u*)(HB + 512 + lane * 8), hx + 8);
    const float rs2 = 1.0f / sqrtf(((const float*)(a.ws + WS_ROWSS2))[t] * (1.0f / 1024.0f) + EPSN);
    const int* EID = (const int*)(a.ws + WS_EID) + (size_t)t * 128; const float* GW = (const float*)(a.ws + WS_GW) + (size_t)t * 128;
    const int e0 = EID[lane], e1 = EID[64 + lane]; const float g0 = GW[lane], g1 = GW[64 + lane];
    float acc[16];
#pragma unroll
    for (int i = 0; i < 16; ++i) acc[i] = 0.f;
#pragma unroll 1
    for (int j = 0; j < 128; j += 4) {
        int ee[4]; float gg[4], dt[4];
#pragma unroll
        for (int k = 0; k < 4; ++k) { const int jj = j + k; ee[k] = __shfl(jj < 64 ? e0 : e1, jj & 63); gg[k] = __shfl(jj < 64 ? g0 : g1, jj & 63); }
        v4u da[4], db[4];
#pragma unroll
        for (int k = 0; k < 4; ++k) { const bf16* r = ED + (size_t)ee[k] * D; da[k] = *(const GAS v4u*)(r + lane * 8); db[k] = *(const GAS v4u*)(r + 512 + lane * 8); }
#pragma unroll
        for (int k = 0; k < 4; ++k) { float f[16]; unpack8(da[k], f); unpack8(db[k], f + 8); float s = 0.f;
#pragma unroll
            for (int i = 0; i < 16; ++i) s += f[i] * hx[i];
            dt[k] = s; }
#pragma unroll
        for (int o = 1; o < 64; o <<= 1) {
#pragma unroll
            for (int k = 0; k < 4; ++k) dt[k] += __shfl_xor(dt[k], o); }
#pragma unroll
        for (int k = 0; k < 4; ++k) { const bf16* r = EU + (size_t)ee[k] * D; da[k] = *(const GAS v4u*)(r + lane * 8); db[k] = *(const GAS v4u*)(r + 512 + lane * 8); }
#pragma unroll
        for (int k = 0; k < 4; ++k) { const float w = gg[k] * gelu_tanh(dt[k] * rs2); float f[16]; unpack8(da[k], f); unpack8(db[k], f + 8);
#pragma unroll
            for (int i = 0; i < 16; ++i) acc[i] += w * f[i]; }
    }
    const float* orow = a.out + (size_t)t * D; float* drow = dst + (size_t)t * D; const float* gf = a.in[22];
    f32x4 h0 = *(const GAS f32x4*)(orow + lane * 8), h1 = *(const GAS f32x4*)(orow + lane * 8 + 4), h2 = *(const GAS f32x4*)(orow + 512 + lane * 8), h3 = *(const GAS f32x4*)(orow + 512 + lane * 8 + 4);
    h0 += (f32x4){acc[0], acc[1], acc[2], acc[3]}; h1 += (f32x4){acc[4], acc[5], acc[6], acc[7]}; h2 += (f32x4){acc[8], acc[9], acc[10], acc[11]}; h3 += (f32x4){acc[12], acc[13], acc[14], acc[15]};
    float ss = (h0.x * h0.x + h0.y * h0.y) + (h0.z * h0.z + h0.w * h0.w) + (h1.x * h1.x + h1.y * h1.y) + (h1.z * h1.z + h1.w * h1.w)
             + (h2.x * h2.x + h2.y * h2.y) + (h2.z * h2.z + h2.w * h2.w) + (h3.x * h3.x + h3.y * h3.y) + (h3.z * h3.z + h3.w * h3.w);
    ss = wave_sum(ss);
    const float ri = 1.0f / sqrtf(ss * (1.0f / 1024.0f) + EPSN);
    const f32x4 f0 = *(const GAS f32x4*)(gf + lane * 8), f1 = *(const GAS f32x4*)(gf + lane * 8 + 4), f2 = *(const GAS f32x4*)(gf + 512 + lane * 8), f3 = *(const GAS f32x4*)(gf + 512 + lane * 8 + 4);
    *(GAS f32x4*)(drow + lane * 8) = h0 * ri * f0; *(GAS f32x4*)(drow + lane * 8 + 4) = h1 * ri * f1;
    *(GAS f32x4*)(drow + 512 + lane * 8) = h2 * ri * f2; *(GAS f32x4*)(drow + 512 + lane * 8 + 4) = h3 * ri * f3;
}


template <int CTRL> __device__ __forceinline__ float dpp_add(float v) { return v + __int_as_float(__builtin_amdgcn_update_dpp(0, __float_as_int(v), CTRL, 0xf, 0xf, false)); }
__device__ __forceinline__ float row16_sum(float v) { v = dpp_add<0x140>(v); v = dpp_add<0x141>(v); v = dpp_add<0x4E>(v); v = dpp_add<0xB1>(v); return v; }
__device__ __forceinline__ unsigned long long lanemask_lt(int lane) { return (1ull << lane) - 1ull; }
__device__ __forceinline__ void glds16g(const void* gsrc, unsigned lds_dst) { unsigned keep;
    asm volatile("s_mov_b32 %0, m0\n\ts_mov_b32 m0, %2\n\ts_nop 0\n\tglobal_load_lds_dwordx4 %1, off\n\ts_mov_b32 m0, %0" : "=&s"(keep) : "v"(gsrc), "s"(lds_dst) : "memory"); }

__device__ __forceinline__ void glds16x4(const void* sbase, unsigned o0, unsigned o1, unsigned o2, unsigned o3, unsigned d0, unsigned d1, unsigned d2, unsigned d3) { unsigned keep;
    asm volatile("s_mov_b32 %0, m0\n\ts_mov_b32 m0, %6\n\ts_nop 0\n\tglobal_load_lds_dwordx4 %1, %5\n\ts_mov_b32 m0, %7\n\ts_nop 0\n\tglobal_load_lds_dwordx4 %2, %5\n\t"
                 "s_mov_b32 m0, %8\n\ts_nop 0\n\tglobal_load_lds_dwordx4 %3, %5\n\ts_mov_b32 m0, %9\n\ts_nop 0\n\tglobal_load_lds_dwordx4 %4, %5\n\ts_mov_b32 m0, %0"
                 : "=&s"(keep) : "v"(o0), "v"(o1), "v"(o2), "v"(o3), "s"(sbase), "s"(d0), "s"(d1), "s"(d2), "s"(d3) : "memory"); }
typedef __bf16 bf2_t __attribute__((ext_vector_type(2)));
__device__ __forceinline__ float dot2bf(unsigned a, unsigned b, float c) { return __builtin_amdgcn_fdot2_f32_bf16(__builtin_bit_cast(bf2_t, a), __builtin_bit_cast(bf2_t, b), c, false); }
__device__ __forceinline__ void compact_token(const Args& a, int t, int lane) {
    const int* EID = (const int*)(a.ws + WS_EID) + (size_t)t * 128; const float* GW = (const float*)(a.ws + WS_GW) + (size_t)t * 128;
    const int e0 = EID[lane], e1 = EID[64 + lane]; const float g0 = GW[lane], g1 = GW[64 + lane];
    const bool p0 = e0 < 8192, p1 = e1 < 8192;
    const unsigned long long m0 = __ballot(p0), m1 = __ballot(p1), lt = lanemask_lt(lane);
    const int c0 = __popcll(m0), n0 = c0 + __popcll(m1);
    const int pos0 = p0 ? __popcll(m0 & lt) : n0 + __popcll(~m0 & lt);
    const int pos1 = p1 ? c0 + __popcll(m1 & lt) : n0 + (64 - c0) + __popcll(~m1 & lt);
    unsigned* R = (unsigned*)(a.ws + WS_REC) + (size_t)t * 128;
    R[pos0] = (unsigned)e0 | (f2bf(g0) << 16); R[pos1] = (unsigned)e1 | (f2bf(g1) << 16);
    if (lane == 0) ((int*)(a.ws + WS_N0))[t] = n0;
}
template <int NT> __device__ __forceinline__ void w_tokens(const Args& a, int t0, int lane) {
    float d0[NT], d1[NT], sd0[NT], sd1[NT], su0[NT], su1[NT]; unsigned r0[NT], r1[NT]; float ss[NT];
#pragma unroll
    for (int i = 0; i < NT; ++i) { const float* DP = (const float*)(a.ws + WS_DOTP) + (size_t)(t0 + i) * 1024; const unsigned* R = (const unsigned*)(a.ws + WS_REC) + (size_t)(t0 + i) * 128;
        float p0[8], p1[8];
#pragma unroll
        for (int x = 0; x < 8; ++x) { p0[x] = DP[x * 128 + lane]; p1[x] = DP[x * 128 + 64 + lane]; }
        r0[i] = R[lane]; r1[i] = R[64 + lane]; ss[i] = ((const float*)(a.ws + WS_ROWSS2))[t0 + i];
        sd0[i] = ((const float*)(a.ws + WS_SCD))[r0[i] & 0x3fffu]; sd1[i] = ((const float*)(a.ws + WS_SCD))[r1[i] & 0x3fffu];
        su0[i] = ((const float*)(a.ws + WS_SCU))[r0[i] & 0x3fffu]; su1[i] = ((const float*)(a.ws + WS_SCU))[r1[i] & 0x3fffu];
        d0[i] = ((p0[0] + p0[1]) + (p0[2] + p0[3])) + ((p0[4] + p0[5]) + (p0[6] + p0[7])); d1[i] = ((p1[0] + p1[1]) + (p1[2] + p1[3])) + ((p1[4] + p1[5]) + (p1[6] + p1[7])); }
#pragma unroll
    for (int i = 0; i < NT; ++i) { const float rs2 = 1.0f / sqrtf(ss[i] * (1.0f / 1024.0f) + EPSN);
        const float w0 = bfhi(r0[i]) * fgelu_tanh(d0[i] * sd0[i] * rs2) * su0[i], w1 = bfhi(r1[i]) * fgelu_tanh(d1[i] * sd1[i] * rs2) * su1[i];
        float m0 = fabsf(w0), m1 = fabsf(w1);
#pragma unroll
        for (int o = 1; o < 64; o <<= 1) { m0 = fmaxf(m0, __shfl_xor(m0, o)); m1 = fmaxf(m1, __shfl_xor(m1, o)); }
        const float s0 = (m0 > 0.f) ? m0 * (1.0f / 127.0f) : 1.0f, s1 = (m1 > 0.f) ? m1 * (1.0f / 127.0f) : 1.0f;
        unsigned char* WQ = a.ws + WS_WQ8 + (size_t)(t0 + i) * 144;
        WQ[lane] = (unsigned char)((int)__builtin_rintf(w0 / s0) & 255); WQ[64 + lane] = (unsigned char)((int)__builtin_rintf(w1 / s1) & 255);
        if (lane == 0) { ((float*)(WQ + 128))[0] = s0; ((float*)(WQ + 128))[1] = s1; } }
}
template <bool IS_UP> __device__ __forceinline__ void sweep_slice(const Args& a, int x, int wv, int lane, unsigned ring, LAS unsigned char* ringp, unsigned aux, LAS unsigned char* auxp) {
    const int g = lane >> 4, li = lane & 15, n16 = li, kg = g;
    const char* TABx = (const char*)(a.ws + (IS_UP ? WS_EU : WS_ED)) + x * 256;
    unsigned jofs[4];
#pragma unroll
    for (int q = 0; q < 4; ++q) jofs[q] = (unsigned)((li ^ ((g << 2) | q)) * 16);
    const unsigned pd = (unsigned)__builtin_amdgcn_readfirstlane(ring);
#pragma unroll 1
    for (int s_ = 0; s_ < 128; ++s_) {
        const int r = s_ >> 6, k = s_ & 63, t = wv * 64 + k, base = 64 * r;
        const LAS unsigned* rec = (const LAS unsigned*)(auxp + (k & 3) * 512) + base;
        const LAS unsigned char* hp = auxp + 2048 + (k & 3) * 256;
        asm volatile("s_waitcnt lgkmcnt(0)" ::: "memory");
        if ((k & 3) == 0) {
            const char* rsrc = (const char*)(a.ws + WS_REC) + (size_t)t * 512 + lane * 16;
            glds16g(rsrc, (unsigned)__builtin_amdgcn_readfirstlane(aux)); glds16g(rsrc + 1024, (unsigned)__builtin_amdgcn_readfirstlane(aux + 1024));
            if (!IS_UP) glds16g((const char*)(a.ws + WS_HB) + (size_t)(t + g) * 2048 + x * 256 + li * 16, (unsigned)__builtin_amdgcn_readfirstlane(aux + 2048));
            asm volatile("s_waitcnt vmcnt(0)" ::: "memory");
        }
        {
            unsigned so[16];
#pragma unroll
            for (int p = 0; p < 16; ++p) so[p] = rec[4 * p + g];
#pragma unroll
            for (int p = 0; p < 16; ++p) so[p] = ((so[p] & 0x3fffu) << 11) + jofs[p & 3];
            glds16x4(TABx, so[0], so[1], so[2], so[3], pd, pd + 1024u, pd + 2048u, pd + 3072u);
            glds16x4(TABx, so[4], so[5], so[6], so[7], pd + 4096u, pd + 5120u, pd + 6144u, pd + 7168u);
            glds16x4(TABx, so[8], so[9], so[10], so[11], pd + 8192u, pd + 9216u, pd + 10240u, pd + 11264u);
            glds16x4(TABx, so[12], so[13], so[14], so[15], pd + 12288u, pd + 13312u, pd + 14336u, pd + 15360u);
        }
        asm volatile("s_waitcnt vmcnt(0)" ::: "memory");
        if (!IS_UP) {
            bf16x8 hb[4];
#pragma unroll
            for (int q = 0; q < 4; ++q) hb[q] = *(const LAS bf16x8*)(hp + (32 * q + 8 * kg) * 2);
            f32x4 res = (f32x4){0.f, 0.f, 0.f, 0.f};
#pragma unroll
            for (int rb = 0; rb < 4; ++rb) {
                f32x4 d = (f32x4){0.f, 0.f, 0.f, 0.f}; const int row = n16 + 16 * rb; const int key = ((row & 3) << 2) | ((row >> 2) & 3);
#pragma unroll
                for (int q = 0; q < 4; ++q) { const bf16x8 af = *(const LAS bf16x8*)(ringp + 256 * row + 16 * ((4 * q + kg) ^ key)); d = __builtin_amdgcn_mfma_f32_16x16x32_bf16(af, hb[q], d, 0, 0, 0); }
                res = (n16 == rb) ? d : res; }
            if (n16 < 4) *(GAS f32x4*)((float*)(a.ws + WS_DOTP) + ((size_t)t * 8 + x) * 128 + base + 16 * n16 + 4 * kg) = res;
        } else {
            f32x4 pacc[8];
#pragma unroll
            for (int i = 0; i < 8; ++i) pacc[i] = (f32x4){0.f, 0.f, 0.f, 0.f};
            const int q4 = n16 >> 2, p4 = lane & 3;
#pragma unroll
            for (int ks = 0; ks < 2; ++ks) {
                const v4u wa = *(const LAS v4u*)(rec + 32 * ks + 8 * kg), wb = *(const LAS v4u*)(rec + 32 * ks + 8 * kg + 4);
                const bf16x8 af = __builtin_bit_cast(bf16x8, (v4u){(wa.x >> 16) | (wa.y & 0xffff0000u), (wa.z >> 16) | (wa.w & 0xffff0000u), (wb.x >> 16) | (wb.y & 0xffff0000u), (wb.z >> 16) | (wb.w & 0xffff0000u)});
#pragma unroll
                for (int c = 0; c < 8; ++c) {
                    const int row0 = 32 * ks + 8 * kg + q4, row1 = row0 + 4; const int ch = 2 * c + (p4 >> 1);
                    const int k0 = ((row0 & 3) << 2) | ((row0 >> 2) & 3), k1 = ((row1 & 3) << 2) | ((row1 >> 2) & 3);
                    const attn_body::s16x4 lo4 = attn_body::vtr((attn_body::lds_cptr)(ringp + 256 * row0 + 16 * (ch ^ k0) + 8 * (p4 & 1)));
                    const attn_body::s16x4 hi4 = attn_body::vtr((attn_body::lds_cptr)(ringp + 256 * row1 + 16 * (ch ^ k1) + 8 * (p4 & 1)));
                    const bf16x8 bfr = (bf16x8){lo4[0], lo4[1], lo4[2], lo4[3], hi4[0], hi4[1], hi4[2], hi4[3]};
                    pacc[c] = __builtin_amdgcn_mfma_f32_16x16x32_bf16(af, bfr, pacc[c], 0, 0, 0); }
            }
            const float v0 = (kg == 0) ? pacc[0][0] : (kg == 1) ? pacc[1][0] : (kg == 2) ? pacc[2][0] : pacc[3][0];
            const float v1 = (kg == 0) ? pacc[4][0] : (kg == 1) ? pacc[5][0] : (kg == 2) ? pacc[6][0] : pacc[7][0];
            bf16* po = (bf16*)(a.ws + WS_PEER) + ((size_t)r * M + t) * D + x * 128;
            po[lane] = (bf16)f2bf(v0); po[64 + lane] = (bf16)f2bf(v1);
        }
    }
}
typedef int i32x4 __attribute__((ext_vector_type(4)));
__device__ __forceinline__ void sweep_down_q8(const Args& a, int x, int wv, int lane, unsigned ring, LAS unsigned char* ringp, unsigned aux, LAS unsigned char* auxp) {
    const int g = lane >> 4, li = lane & 15, n16 = li, kg = g, g8 = lane >> 3, s8 = lane & 7;
    const char* TABx = (const char*)(a.ws + WS_ED) + x * 128;
    unsigned jofs[2];
#pragma unroll
    for (int b = 0; b < 2; ++b) jofs[b] = (unsigned)((s8 ^ (4 * b + (g8 >> 1))) * 16);
    const unsigned pd = (unsigned)__builtin_amdgcn_readfirstlane(ring);
    LAS unsigned char* hq = auxp + 3072; LAS float* hsc = (LAS float*)(auxp + 3072 + 512);
#pragma unroll 1
    for (int s_ = 0; s_ < 128; ++s_) {
        const int r = s_ >> 6, k = s_ & 63, t = wv * 64 + k, base = 64 * r;
        const LAS unsigned* rec = (const LAS unsigned*)(auxp + (k & 3) * 512) + base;
        asm volatile("s_waitcnt lgkmcnt(0)" ::: "memory");
        if ((k & 3) == 0) {
            const char* rsrc = (const char*)(a.ws + WS_REC) + (size_t)t * 512 + lane * 16;
            glds16g(rsrc, (unsigned)__builtin_amdgcn_readfirstlane(aux)); glds16g(rsrc + 1024, (unsigned)__builtin_amdgcn_readfirstlane(aux + 1024));
            glds16g((const char*)(a.ws + WS_HB) + (size_t)(t + g) * 2048 + x * 256 + li * 16, (unsigned)__builtin_amdgcn_readfirstlane(aux + 2048));
            asm volatile("s_waitcnt vmcnt(0)" ::: "memory");
            {
                const v4u hb = *(const LAS v4u*)(auxp + 2048 + lane * 16); float f[8]; unpack8(hb, f);
                float am = fmaxf(fmaxf(fmaxf(fabsf(f[0]), fabsf(f[1])), fmaxf(fabsf(f[2]), fabsf(f[3]))), fmaxf(fmaxf(fabsf(f[4]), fabsf(f[5])), fmaxf(fabsf(f[6]), fabsf(f[7]))));
                am = fmaxf(am, __int_as_float(__builtin_amdgcn_update_dpp(0, __float_as_int(am), 0x140, 0xf, 0xf, false))); am = fmaxf(am, __int_as_float(__builtin_amdgcn_update_dpp(0, __float_as_int(am), 0x141, 0xf, 0xf, false)));
                am = fmaxf(am, __int_as_float(__builtin_amdgcn_update_dpp(0, __float_as_int(am), 0x4E, 0xf, 0xf, false))); am = fmaxf(am, __int_as_float(__builtin_amdgcn_update_dpp(0, __float_as_int(am), 0xB1, 0xf, 0xf, false)));
                const float sc = (am > 0.f) ? am * (1.0f / 127.0f) : 1.0f, inv = 1.0f / sc;
                unsigned qw[2];
#pragma unroll
                for (int h2 = 0; h2 < 2; ++h2) { const int q0 = (int)__builtin_rintf(f[4 * h2] * inv), q1 = (int)__builtin_rintf(f[4 * h2 + 1] * inv), q2 = (int)__builtin_rintf(f[4 * h2 + 2] * inv), q3 = (int)__builtin_rintf(f[4 * h2 + 3] * inv);
                    qw[h2] = ((unsigned)q0 & 255u) | (((unsigned)q1 & 255u) << 8) | (((unsigned)q2 & 255u) << 16) | ((unsigned)q3 << 24); }
                *(LAS unsigned long long*)(hq + lane * 8) = (unsigned long long)qw[0] | ((unsigned long long)qw[1] << 32);
                if (li == 0) hsc[g] = sc; }
        }
        {   unsigned so[8];
#pragma unroll
            for (int i = 0; i < 8; ++i) so[i] = rec[8 * i + g8];
#pragma unroll
            for (int i = 0; i < 8; ++i) so[i] = ((so[i] & 0x3fffu) << 10) + jofs[i & 1];
            glds16x4(TABx, so[0], so[1], so[2], so[3], pd, pd + 1024u, pd + 2048u, pd + 3072u);
            glds16x4(TABx, so[4], so[5], so[6], so[7], pd + 4096u, pd + 5120u, pd + 6144u, pd + 7168u);
        }
        asm volatile("s_waitcnt vmcnt(0)" ::: "memory");
        const i32x4 hb0 = *(const LAS i32x4*)(hq + (k & 3) * 128 + 16 * kg), hb1 = *(const LAS i32x4*)(hq + (k & 3) * 128 + 64 + 16 * kg);
        const float hs = hsc[k & 3];
        i32x4 res = (i32x4){0, 0, 0, 0};
#pragma unroll
        for (int rb = 0; rb < 4; ++rb) {
            const int row = n16 + 16 * rb; const int key = (row >> 1) & 7;
            const i32x4 a0 = *(const LAS i32x4*)(ringp + row * 128 + ((kg ^ key) * 16)), a1 = *(const LAS i32x4*)(ringp + row * 128 + (((4 + kg) ^ key) * 16));
            i32x4 d = __builtin_amdgcn_mfma_i32_16x16x64_i8(a0, hb0, (i32x4){0, 0, 0, 0}, 0, 0, 0); d = __builtin_amdgcn_mfma_i32_16x16x64_i8(a1, hb1, d, 0, 0, 0);
            res = (n16 == rb) ? d : res; }
        if (n16 < 4) *(GAS f32x4*)((float*)(a.ws + WS_DOTP) + ((size_t)t * 8 + x) * 128 + base + 16 * n16 + 4 * kg) = (f32x4){(float)res[0] * hs, (float)res[1] * hs, (float)res[2] * hs, (float)res[3] * hs};
    }
}

__device__ __forceinline__ void sweep_up_q8(const Args& a, int x, int wv, int lane, unsigned ring, LAS unsigned char* ringp, unsigned aux, LAS unsigned char* auxp) {
    const int n16 = lane & 15, kg = lane >> 4, g8 = lane >> 3, s8 = lane & 7;
    const char* TABx = (const char*)(a.ws + WS_EU) + x * 128;
    unsigned jofs[2];
#pragma unroll
    for (int b = 0; b < 2; ++b) jofs[b] = (unsigned)((s8 ^ ((g8 >> 1) | (b << 2))) * 16);
    const unsigned pd = (unsigned)__builtin_amdgcn_readfirstlane(ring);
    typedef int v2i_t __attribute__((ext_vector_type(2)));
#pragma unroll 1
    for (int s_ = 0; s_ < 128; ++s_) {
        const int r = s_ >> 6, k = s_ & 63, t = wv * 64 + k, base = 64 * r;
        const LAS unsigned* rec = (const LAS unsigned*)(auxp + (k & 3) * 512) + base;
        const LAS unsigned char* wq = auxp + 2048 + (k & 3) * 144;
        asm volatile("s_waitcnt lgkmcnt(0)" ::: "memory");
        if ((k & 3) == 0) {
            const char* rsrc = (const char*)(a.ws + WS_REC) + (size_t)t * 512 + lane * 16;
            glds16g(rsrc, (unsigned)__builtin_amdgcn_readfirstlane(aux)); glds16g(rsrc + 1024, (unsigned)__builtin_amdgcn_readfirstlane(aux + 1024));
            if (lane < 36) glds16g((const char*)(a.ws + WS_WQ8) + (size_t)t * 144 + lane * 16, (unsigned)__builtin_amdgcn_readfirstlane(aux + 2048));
            asm volatile("s_waitcnt vmcnt(0)" ::: "memory");
        }
        {   unsigned so[8];
#pragma unroll
            for (int i = 0; i < 8; ++i) so[i] = rec[8 * i + g8];
#pragma unroll
            for (int i = 0; i < 8; ++i) so[i] = ((so[i] & 0x3fffu) << 10) + jofs[(i >> 1) & 1];
            glds16x4(TABx, so[0], so[1], so[2], so[3], pd, pd + 1024u, pd + 2048u, pd + 3072u);
            glds16x4(TABx, so[4], so[5], so[6], so[7], pd + 4096u, pd + 5120u, pd + 6144u, pd + 7168u);
        }
        asm volatile("s_waitcnt vmcnt(0)" ::: "memory");
        const i32x4 aw = *(const LAS i32x4*)(wq + 64 * r + 16 * kg);
        const float wsc = *(const LAS float*)(wq + 128 + 4 * r);
        const int i2 = n16 >> 1, ih = n16 & 1;
        const int row0 = 16 * kg + i2, row1 = row0 + 8;
        const int k0 = ((row0 >> 1) & 3) | (((row0 >> 4) & 1) << 2), k1 = ((row1 >> 1) & 3) | (((row1 >> 4) & 1) << 2);
        const LAS unsigned char* p0 = ringp + row0 * 128 + 8 * ih; const LAS unsigned char* p1 = ringp + row1 * 128 + 8 * ih;
        float outv[8];
#pragma unroll
        for (int c = 0; c < 8; ++c) {
            const v2i_t lo = __builtin_amdgcn_ds_read_tr8_b64_v2i32((LAS v2i_t*)(p0 + ((c ^ k0) * 16)));
            const v2i_t hi = __builtin_amdgcn_ds_read_tr8_b64_v2i32((LAS v2i_t*)(p1 + ((c ^ k1) * 16)));
            const i32x4 d = __builtin_amdgcn_mfma_i32_16x16x64_i8(aw, (i32x4){lo.x, lo.y, hi.x, hi.y}, (i32x4){0, 0, 0, 0}, 0, 0, 0);
            outv[c] = (float)d[0] * wsc; }
        const float v0 = (kg == 0) ? outv[0] : (kg == 1) ? outv[1] : (kg == 2) ? outv[2] : outv[3];
        const float v1 = (kg == 0) ? outv[4] : (kg == 1) ? outv[5] : (kg == 2) ? outv[6] : outv[7];
        bf16* po = (bf16*)(a.ws + WS_PEER) + ((size_t)r * M + t) * D + x * 128;
        po[lane] = (bf16)f2bf(v0); po[64 + lane] = (bf16)f2bf(v1);
    }
}

__device__ __forceinline__ void final_row(const Args& a, int t, int lane) {
    float* orow = a.out + (size_t)t * D; const float* gf = a.in[22];
    const bf16* P0 = (const bf16*)(a.ws + WS_PEER) + (size_t)t * D; const bf16* P1 = P0 + (size_t)M * D;
    const bf16* HBr = (const bf16*)(a.ws + WS_HB) + (size_t)t * D;
    f32x4 h[4]; float ss = 0.f;
#pragma unroll
    for (int j = 0; j < 4; ++j) { { const unsigned long long hb = ((const GAS unsigned long long*)HBr)[lane + 64 * j]; h[j].x = bflo((unsigned)hb); h[j].y = bfhi((unsigned)hb); h[j].z = bflo((unsigned)(hb >> 32)); h[j].w = bfhi((unsigned)(hb >> 32)); }
        const unsigned long long p = ((const GAS unsigned long long*)P0)[lane + 64 * j], q = ((const GAS unsigned long long*)P1)[lane + 64 * j];
        h[j].x += bflo((unsigned)p) + bflo((unsigned)q); h[j].y += bfhi((unsigned)p) + bfhi((unsigned)q); h[j].z += bflo((unsigned)(p >> 32)) + bflo((unsigned)(q >> 32)); h[j].w += bfhi((unsigned)(p >> 32)) + bfhi((unsigned)(q >> 32));
        ss += (h[j].x * h[j].x + h[j].y * h[j].y) + (h[j].z * h[j].z + h[j].w * h[j].w); }
    ss = wave_sum(ss);
    const float ri = 1.0f / sqrtf(ss * (1.0f / 1024.0f) + EPSN);
#pragma unroll
    for (int j = 0; j < 4; ++j) ((GAS f32x4*)orow)[lane + 64 * j] = h[j] * ri * ((const GAS f32x4*)gf)[lane + 64 * j];
}

__device__ __forceinline__ float a_dot64(const float* p, const float* q, int lane) { return wave_sum(p[lane] * q[lane]); }
constexpr int N_PHASES = 12;
#ifndef ROUTE_REF
#define ROUTE_REF 0
#endif
#ifndef MK_ONE_LAUNCH
#define MK_ONE_LAUNCH 1
#endif
__global__ void __launch_bounds__(NWAVES * 64, 2) fwd_mega(Args args) {
    extern __shared__ __attribute__((aligned(16))) unsigned char lds[];
    Frame F;
    F.lds = (LAS unsigned char*)lds;
    F.MISC = (volatile LAS unsigned*)(F.lds + MISC_OFF);
    F.tid = threadIdx.x; F.lane = F.tid & 63; F.wave = __builtin_amdgcn_readfirstlane(F.tid >> 6);
    F.G = gridDim.x; { const int bx = blockIdx.x; F.vcu = (F.G % 8 == 0) ? (bx % 8) * (F.G / 8) + bx / 8 : bx; }
    unsigned char* ws = args.ws;
    const int lo = args.ph_lo, hi = args.ph_hi;
#ifndef PH_MASK
#define PH_MASK 0xffff
#endif
#define IN(k) (((PH_MASK >> (k)) & 1) && lo <= (k) && (k) < hi)
#define BOTH(k) (IN(k) && IN((k) + 1))
#if MK_ONE_LAUNCH
    for (int u = F.tid; u < (LDS_BYTES - LDSCTL_OFF) / 4; u += NWAVES * 64) ((LAS unsigned*)(F.lds + LDSCTL_OFF))[u] = 0u;
    __syncthreads();
    const XcdBarrier xbar = xcd_barrier_post((unsigned*)(ws + WS_CTL) + CW_BAR, F.MISC + 8);
    bool first_seam = args.ph_lo < 0;
#define GRID_BAR() do { if (first_seam) { __threadfence(); cooperative_groups::this_grid().sync(); first_seam = false; } else xcd_barrier(xbar); } while (0)
#else
#define GRID_BAR() do { } while (0)
#endif
#ifndef REP_PH
#define REP_PH -1
#endif
#define RUN_PHASE(k, ...) do { if (IN(k)) { if ((k) == REP_PH) { { const bool first_of_two = true; (void)first_of_two; __VA_ARGS__ } GRID_BAR(); } { const bool first_of_two = false; (void)first_of_two; __VA_ARGS__ } if (BOTH(k)) GRID_BAR(); } } while (0)
    RUN_PHASE(0, { p0_prologue(F, args); });
    RUN_PHASE(1, {
        pg8::Gemm g{(const pg8::bf16_t*)(ws + WS_XB), (const pg8::bf16_t*)(ws + WS_WIN), M, INC, D}; pg8::StaticOrder S; S.init(M, INC, F.G, (int)blockIdx.x);
        pg8::EpiBf16<1> E{(pg8::bf16_t*)(ws + WS_Q), 512, (const float*)(ws + WS_RS1), 512, (size_t)WS_SPLIT / 2, attn_body::C2};
        pg8::gemm_phase<pg8::EpiBf16<1>, pg8::StaticOrder, true, true>(F.lds + RING_OFF, g, S, E);
        { const int nb = (F.G >= 2) ? (int)F.G / 2 : 1; const int bi = (int)blockIdx.x - ((int)F.G - nb); if (bi >= 0) convert_experts(args, bi * NWAVES + F.wave, nb * NWAVES, F.lane); }
    });
    RUN_PHASE(2, {
        for (int c = F.vcu; c < M / 64; c += F.G) lru_local_unit(F, args, c);
        const attn128::AttnTensors AT{(const attn128::bf16*)(ws + WS_Q), (const attn128::bf16*)(ws + WS_Q + WS_SPLIT), (const attn128::bf16*)(ws + WS_Q + 2 * WS_SPLIT), (attn128::bf16*)(ws + WS_OS)};
        const attn128::StaticOrder S(F.vcu);
        attn128::attn_phase<attn128::StaticOrder>((char*)lds + RING_OFF, AT, S);
    });
    RUN_PHASE(3, {
        float l1 = a_dot64(args.in[3], args.in[4], F.lane); float l2 = a_dot64(args.in[5], args.in[6], F.lane);
        const float lamv = expf(l1) - expf(l2) + 0.2f;
        for (int c = F.vcu; c < M / 64; c += F.G) fix_unit(F, args, c, lamv);
    });
    RUN_PHASE(4, {
        pg8::Gemm g{(const pg8::bf16_t*)(ws + WS_MIX), (const pg8::bf16_t*)(ws + WS_WOUT), M, D, D}; pg8::StaticOrder S; S.init(M, D, F.G, (int)blockIdx.x);
        pg8::EpiResid E{args.in[0], args.out, (pg8::bf16_t*)(ws + WS_HB), (float*)(ws + (first_of_two ? WS_RS1 : WS_ROWSS2)), D};
        pg8::gemm_phase<pg8::EpiResid, pg8::StaticOrder, true, true>(F.lds + RING_OFF, g, S, E);
    });
    RUN_PHASE(5, {
        pg8::Gemm g{(const pg8::bf16_t*)(ws + WS_HB), (const pg8::bf16_t*)(ws + WS_WQ), M, NQ, D}; pg8::StaticOrder S; S.init(M, NQ, F.G, (int)blockIdx.x);
        pg8::EpiBf16<2> E{(pg8::bf16_t*)(ws + WS_Q2), NQ, (const float*)(ws + WS_ROWSS2), 0, 0, 1.f};
        pg8::gemm_phase<pg8::EpiBf16<2>, pg8::StaticOrder, true, true>(F.lds + RING_OFF, g, S, E);
    });
    RUN_PHASE(6, {
        const int gw = F.vcu * NWAVES + F.wave; const int NGW = F.G * NWAVES;
        LAS unsigned char* skl = F.lds + RING_OFF + 16384;
        for (int c = F.tid; c < 4096; c += NWAVES * 64) { const int row = c >> 4; const int ch = c & 15; *(LAS v4u*)(skl + row * 272 + ch * 16) = *(const GAS v4u*)(ws + WS_SK1 + (size_t)row * 256 + ch * 16); }
        __syncthreads();
        static_assert((M / 32) * 8 == NEXP / 4, "one group of 4 expert_up rows beside each routing unit");
        for (int u = gw; u < (M / 32) * 8; u += NGW) { f32x4 ev[4][4]; q8_load<4>(ev, args.in[21] + (size_t)u * 4 * D, F.lane);
            route_unit(args, u >> 3, u & 7, F.lane, F.lds + RING_OFF + F.tid * 32, skl, (int*)(ws + WS_EID), (float*)(ws + WS_GW));
            q8_finish<4>(ev, ws + WS_EU + (size_t)u * 4 * D, nullptr, (float*)(ws + WS_SCU) + 4 * u, F.lane); }
        __syncthreads();
    });
    RUN_PHASE(7, {
        const int gw = F.vcu * NWAVES + F.wave; const int NGW = F.G * NWAVES;
        for (int t = gw; t < M; t += NGW) compact_token(args, t, F.lane);
    });
    RUN_PHASE(8, {
        if (F.G == 256) sweep_down_q8(args, F.vcu >> 5, (F.vcu & 31) * NWAVES + F.wave, F.lane, (unsigned)(uintptr_t)(lds + RING_OFF) + F.wave * 16384u, F.lds + RING_OFF + F.wave * 16384, (unsigned)(uintptr_t)(lds + LDSCTL_OFF + 1024) + F.wave * 3712u, F.lds + LDSCTL_OFF + 1024 + F.wave * 3712);
    });
    RUN_PHASE(9, {
        const int gw = F.vcu * NWAVES + F.wave; const int NGW = F.G * NWAVES;
        for (int t = 4 * gw; t < M; t += 4 * NGW) w_tokens<4>(args, t, F.lane);
    });
    RUN_PHASE(10, {
        if (F.G == 256) sweep_up_q8(args, F.vcu >> 5, (F.vcu & 31) * NWAVES + F.wave, F.lane, (unsigned)(uintptr_t)(lds + RING_OFF) + F.wave * 16384u, F.lds + RING_OFF + F.wave * 16384, (unsigned)(uintptr_t)(lds + LDSCTL_OFF + 1024) + F.wave * 3712u, F.lds + LDSCTL_OFF + 1024 + F.wave * 3712);
    });
    RUN_PHASE(11, {
        const int gw = F.vcu * NWAVES + F.wave; const int NGW = F.G * NWAVES;
        for (int t = gw; t < M; t += NGW) final_row(args, t, F.lane);
    });
#undef IN
#undef BOTH
}

extern "C" void kernel_launch(void* const* d_in, const int* in_sizes, int n_in, void* d_out, int out_size, void* d_ws, size_t ws_size, hipStream_t stream) {
    static int grid = 0;
    if (grid == 0) {
        if (n_in != 23 || out_size != M * D || ws_size < WS_END) { fprintf(stderr, "kernel_launch: unexpected problem: n_in %d out %d ws %zu\n", n_in, out_size, ws_size); grid = -1; return; }
        int dev = 0, cus = 0, per_cu = 0;
        if (hipGetDevice(&dev) != hipSuccess || hipDeviceGetAttribute(&cus, hipDeviceAttributeMultiprocessorCount, dev) != hipSuccess) { grid = -1; return; }
        if (hipFuncSetAttribute((const void*)fwd_mega, hipFuncAttributeMaxDynamicSharedMemorySize, LDS_BYTES) != hipSuccess) { fprintf(stderr, "kernel_launch: hipFuncSetAttribute failed\n"); grid = -1; return; }
        if (hipOccupancyMaxActiveBlocksPerMultiprocessor(&per_cu, (const void*)fwd_mega, NWAVES * 64, LDS_BYTES) != hipSuccess || per_cu < 1) { fprintf(stderr, "kernel_launch: occupancy query reports %d\n", per_cu); per_cu = 1; }
        (void)hipGetLastError();
        grid = cus;
    }
    if (grid < 0) return;
    (void)hipMemsetAsync((char*)d_ws + WS_CTL, 0, CTL_ZERO_BYTES, stream);
    Args a{};
    for (int i = 0; i < 23; ++i) a.in[i] = (const float*)d_in[i];
    a.out = (float*)d_out; a.ws = (unsigned char*)d_ws;
#if MK_ONE_LAUNCH
    a.ph_lo = 0; a.ph_hi = N_PHASES;
    void* kargs[] = {&a};
    hipError_t e = hipLaunchCooperativeKernel((const void*)fwd_mega, dim3(grid), dim3(NWAVES * 64), kargs, LDS_BYTES, stream);
    if (e != hipSuccess) fprintf(stderr, "cooperative launch failed: %s (grid %d)\n", hipGetErrorString(e), grid);
#else
    for (int p = 0; p < N_PHASES; ++p) { a.ph_lo = p; a.ph_hi = p + 1; hipLaunchKernelGGL(fwd_mega, dim3(grid), dim3(NWAVES * 64), LDS_BYTES, stream, a); }
#endif
}
```

```cpp
#include <hip/hip_runtime.h>
#include <hip/hip_cooperative_groups.h>
#include <cstdio>
#include <cstdint>
namespace pg8 {
#define PG8_LAS __attribute__((address_space(3)))
typedef unsigned short bf16_t;
typedef short bf16x8 __attribute__((ext_vector_type(8)));
typedef float f32x4 __attribute__((ext_vector_type(4)));
typedef unsigned u32x4 __attribute__((ext_vector_type(4)));
constexpr int BM = 256, BK = 64, HALF = 128, HTB = HALF * BK * 2  , STAGE_BYTES = 8 * HTB, NXCD = 8, WGM = 8;

__host__ __device__ __forceinline__ int lds_byte(int r, int c) { const int st = (r >> 4) * 2 + (c >> 5), rr = r & 15, cc = c & 31, ob = rr * 64 + cc * 2; return st * 1024 + (ob ^ (((ob >> 9) & 1) << 5)); }
__host__ __device__ __forceinline__ void stage_rc(int b, int& R, int& C) { const int st = b / 1024, sb = b % 1024, swz = sb ^ (((sb >> 9) & 1) << 5); R = (st >> 1) * 16 + swz / 64; C = (st & 1) * 32 + (swz % 64) / 2; }
__host__ __device__ __forceinline__ int perm32(int rho) { const int n = rho >> 4, i = rho & 15; return 8 * (i >> 2) + 4 * n + (i & 3); }

struct Unit { int pm, pn; };
struct Gemm { const bf16_t* A; const bf16_t* Bt; int M, N, K; };

struct StaticOrder {
    int nM, nN, nwg, G, c;
    __host__ __device__ void init(int M, int N, int G_, int c_) { nM = M / BM; nN = N / BM; nwg = nM * nN; G = G_; c = c_; }
    __host__ __device__ bool next(int i, Unit& u) const {
        const long L = (long)i * G + c; if (L >= nwg) return false;
        int wgid = (int)L; { const int q = nwg / NXCD, r = nwg % NXCD, xcd = wgid % NXCD, off = wgid / NXCD; wgid = (xcd < r ? xcd * (q + 1) : r * (q + 1) + (xcd - r) * q) + off; }
        const int nig = WGM * nN, gid = wgid / nig, fm = gid * WGM, gsz = (nM - fm) < WGM ? (nM - fm) : WGM;
        u.pm = fm + ((wgid % nig) % gsz); u.pn = (wgid % nig) / gsz; return true;
    }
    __device__ __forceinline__ void a_ready(const Unit&) const {}
    __device__ __forceinline__ void done(const Unit&) const {}
};

__device__ __forceinline__ unsigned cvt_pk_bf16(float lo, float hi) { unsigned r; asm volatile("v_cvt_pk_bf16_f32 %0, %1, %2" : "=v"(r) : "v"(lo), "v"(hi)); return r; }
typedef float f32x2 __attribute__((ext_vector_type(2)));

template <int RSMODE> struct EpiBf16 {
    static constexpr bool PERM = true, AFTER_DRAIN = false;
    bf16_t* O; int ldc; const float* rowscale; int split_cols; size_t split_stride; float scale0;
    __device__ __forceinline__ void operator()(const f32x4 (&acc)[2][2][4][2], const Unit& u, int wr, int wc, int fr, int fq) const {
        const int row0 = u.pm * BM + wr * 64 + fr; int colt = u.pn * BM; bf16_t* base = O;
        float sc = 1.f; if (split_cols) { const int t = colt / split_cols; base += (size_t)t * split_stride; colt -= t * split_cols; if (t == 0) sc = scale0; }
        const int col0 = colt + wc * 32 + 8 * fq;
#pragma unroll
        for (int ai = 0; ai < 2; ++ai)
#pragma unroll
            for (int m = 0; m < 4; ++m) { const int row = row0 + ai * HALF + m * 16; bf16_t* rowp = base + (size_t)row * ldc + col0;
                float rs = sc;
                if (RSMODE == 1) rs *= rowscale[row];
                if (RSMODE == 2) rs *= 1.0f / sqrtf(rowscale[row] * (1.0f / 1024.0f) + 1e-6f);
#pragma unroll
                for (int bj = 0; bj < 2; ++bj) { f32x4 v0 = acc[ai][bj][m][0] * rs, v1 = acc[ai][bj][m][1] * rs;
                    u32x4 w; w.x = cvt_pk_bf16(v0[0], v0[1]); w.y = cvt_pk_bf16(v0[2], v0[3]); w.z = cvt_pk_bf16(v1[0], v1[1]); w.w = cvt_pk_bf16(v1[2], v1[3]);
                    *(u32x4*)(rowp + bj * HALF) = w; } }
    }
};

struct EpiResid {
    static constexpr bool PERM = false, AFTER_DRAIN = false;
    const float* X; float* Hf; bf16_t* Hb; float* rowss; int ldc;
    __device__ __forceinline__ void operator()(const f32x4 (&acc)[2][2][4][2], const Unit& u, int wr, int wc, int fr, int fq) const {
        typedef unsigned u32x2v __attribute__((ext_vector_type(2)));
        const int col0 = u.pn * BM + wc * 32 + 4 * fq;
#pragma unroll
        for (int ai = 0; ai < 2; ++ai)
#pragma unroll
            for (int m = 0; m < 4; ++m) { const int row = u.pm * BM + ai * HALF + wr * 64 + m * 16 + fr; const size_t off = (size_t)row * ldc + col0; float ss = 0.f;
#pragma unroll
                for (int bj = 0; bj < 2; ++bj)
#pragma unroll
                    for (int n = 0; n < 2; ++n) { const f32x4 xv = *(const f32x4*)(X + off + bj * HALF + n * 16); const f32x4 h = xv + acc[ai][bj][m][n];
                        u32x2v w; w.x = cvt_pk_bf16(h[0], h[1]); w.y = cvt_pk_bf16(h[2], h[3]);
                        *(u32x2v*)(Hb + off + bj * HALF + n * 16) = w; ss += (h[0] * h[0] + h[1] * h[1]) + (h[2] * h[2] + h[3] * h[3]); }
                ss += __shfl_xor(ss, 16); ss += __shfl_xor(ss, 32);
                if (fq == 0) atomicAdd(rowss + row, ss); }
    }
};

template <class Epi, class Sched, bool ALIGN_EPI = false, bool SP2 = false>
__device__ __forceinline__ void gemm_phase(PG8_LAS unsigned char* lds, const Gemm g, const Sched& S, const Epi& E) {
    const int tid = threadIdx.x, wid = __builtin_amdgcn_readfirstlane(tid >> 6), lane = tid & 63, wr = wid >> 2, wc = wid & 3, fr = lane & 15, fq = lane >> 4;
    const int K = g.K, nt = K / BK;
    unsigned voffA[2], voffB[2];
#pragma unroll
    for (int i = 0; i < 2; ++i) { int R, C; stage_rc(tid * 16 + i * 8192, R, C); const int Rb = Epi::PERM ? ((R & ~31) + perm32(R & 31)) : R;
        voffA[i] = (unsigned)(R * K + C) * 2u; voffB[i] = (unsigned)(Rb * K + C) * 2u; }
    const size_t kstep = (size_t)(BK * 2);
    const size_t hstep = (size_t)HALF * K * 2;
    const size_t tstep = 2 * hstep;
    const unsigned ldsw = (unsigned)wid * 1024u;
    const int aoff = lds_byte(wr * 64 + fr, fq * 8), boff = lds_byte(wc * 32 + fr, fq * 8);
#define PG8_SA(b, h) (((b) * 2 + (h)) * HTB)
#define PG8_SB(b, h) ((4 + (b) * 2 + (h)) * HTB)
#define PG8_STAGE(bufoff, gbase, voff) do { _Pragma("unroll") for (int _i = 0; _i < 2; ++_i) \
        __builtin_amdgcn_global_load_lds((const unsigned*)((const char*)(gbase) + (voff)[_i]), (PG8_LAS unsigned*)(lds + (bufoff) + ldsw + _i * 8192), 16, 0, 0); } while (0)
#define PG8_LDA(dst, b, h) do { _Pragma("unroll") for (int m = 0; m < 4; ++m) _Pragma("unroll") for (int k = 0; k < 2; ++k) dst[m][k] = *(const PG8_LAS bf16x8*)(lds + PG8_SA(b, h) + aoff + m * 2048 + k * 1024); } while (0)
#define PG8_LDB(dst, b, h) do { _Pragma("unroll") for (int n = 0; n < 2; ++n) _Pragma("unroll") for (int k = 0; k < 2; ++k) dst[n][k] = *(const PG8_LAS bf16x8*)(lds + PG8_SB(b, h) + boff + n * 2048 + k * 1024); } while (0)
#define PG8_MMA(ai, bj, At, Bt) do { __builtin_amdgcn_s_setprio(1); _Pragma("unroll") for (int m = 0; m < 4; ++m) _Pragma("unroll") for (int n = 0; n < 2; ++n) _Pragma("unroll") for (int k = 0; k < 2; ++k) \
        acc[ai][bj][m][n] = __builtin_amdgcn_mfma_f32_16x16x32_bf16(Bt[n][k], At[m][k], acc[ai][bj][m][n], 0, 0, 0); __builtin_amdgcn_s_setprio(0); } while (0)
#define PG8_WAIT_V(n) asm volatile("s_waitcnt vmcnt(" #n ")" ::: "memory")
#define PG8_WAIT_L(n) asm volatile("s_waitcnt lgkmcnt(" #n ")" ::: "memory")
#define PG8_BAR __builtin_amdgcn_s_barrier()
#define PG8_SCHED __builtin_amdgcn_sched_barrier(0)
    Unit cur, nxt; int ui = 0;
    if (!S.next(0, cur)) return;
    f32x4 acc[2][2][4][2];
#pragma unroll
    for (int a = 0; a < 2; ++a)
#pragma unroll
        for (int b = 0; b < 2; ++b)
#pragma unroll
            for (int m = 0; m < 4; ++m)
#pragma unroll
                for (int n = 0; n < 2; ++n) acc[a][b][m][n] = (f32x4){0.f, 0.f, 0.f, 0.f};
    bf16x8 At[4][2], B0[2][2], B1[2][2];
    const char* cA = (const char*)g.A + (size_t)cur.pm * tstep; const char* cB = (const char*)g.Bt + (size_t)cur.pn * tstep;
    S.a_ready(cur);
    if constexpr (SP2) {
        PG8_STAGE(PG8_SB(0, 0), cB, voffB); PG8_STAGE(PG8_SB(0, 1), cB + hstep, voffB); PG8_STAGE(PG8_SA(0, 0), cA, voffA); PG8_STAGE(PG8_SA(0, 1), cA + hstep, voffA);
        if (wr == 1) PG8_BAR;
        PG8_WAIT_V(2); PG8_BAR;
        PG8_STAGE(PG8_SB(1, 0), cB + kstep, voffB); PG8_STAGE(PG8_SA(1, 0), cA + kstep, voffA); PG8_STAGE(PG8_SB(1, 1), cB + hstep + kstep, voffB);
        PG8_WAIT_V(6); PG8_BAR;
    } else {
        PG8_STAGE(PG8_SB(0, 0), cB, voffB); PG8_STAGE(PG8_SA(0, 0), cA, voffA); PG8_STAGE(PG8_SB(0, 1), cB + hstep, voffB); PG8_STAGE(PG8_SA(0, 1), cA + hstep, voffA);
        if (wr == 1) PG8_BAR;
        PG8_WAIT_V(4); PG8_BAR;
        PG8_STAGE(PG8_SB(1, 0), cB + kstep, voffB); PG8_STAGE(PG8_SA(1, 0), cA + kstep, voffA); PG8_STAGE(PG8_SB(1, 1), cB + hstep + kstep, voffB);
        PG8_WAIT_V(6); PG8_BAR;
    }
    for (;;) {
        const bool has_next = S.next(ui + 1, nxt);
        const char* nA = has_next ? (const char*)g.A + (size_t)nxt.pm * tstep : cA; const char* nB = has_next ? (const char*)g.Bt + (size_t)nxt.pn * tstep : cB;
        for (int t = 0; t < nt; t += 2) {
            const bool last = (t == nt - 2);
            const char* a1 = cA + (size_t)(t + 1) * kstep;
            const char* a2 = last ? nA : cA + (size_t)(t + 2) * kstep; const char* b2 = last ? nB : cB + (size_t)(t + 2) * kstep;
            const char* a3 = a2 + kstep; const char* b3 = b2 + kstep;
            if (last && has_next) S.a_ready(nxt);
            if constexpr (SP2) {
            PG8_LDB(B0, 0, 0); PG8_LDB(B1, 0, 1); PG8_SCHED; PG8_LDA(At, 0, 0); PG8_STAGE(PG8_SA(1, 1), a1 + hstep, voffA);
            PG8_WAIT_V(8); PG8_WAIT_L(0); PG8_BAR; PG8_MMA(0, 0, At, B0); PG8_MMA(0, 1, At, B1); PG8_BAR; PG8_SCHED;
            PG8_LDA(At, 0, 1); PG8_STAGE(PG8_SB(0, 0), b2, voffB); PG8_STAGE(PG8_SB(0, 1), b2 + hstep, voffB); PG8_STAGE(PG8_SA(0, 0), a2, voffA);
            PG8_WAIT_V(8); PG8_WAIT_L(0); PG8_BAR; PG8_MMA(1, 0, At, B0); PG8_MMA(1, 1, At, B1); PG8_BAR; PG8_SCHED;
            PG8_LDB(B0, 1, 0); PG8_LDB(B1, 1, 1); PG8_SCHED; PG8_LDA(At, 1, 0); PG8_STAGE(PG8_SA(0, 1), a2 + hstep, voffA);
            PG8_WAIT_V(8); PG8_WAIT_L(0); PG8_BAR; PG8_MMA(0, 0, At, B0); PG8_MMA(0, 1, At, B1); PG8_BAR; PG8_SCHED;
            PG8_LDA(At, 1, 1); PG8_STAGE(PG8_SB(1, 0), b3, voffB); PG8_STAGE(PG8_SB(1, 1), b3 + hstep, voffB); PG8_STAGE(PG8_SA(1, 0), a3, voffA);
            PG8_WAIT_V(8); PG8_WAIT_L(0); PG8_BAR; PG8_MMA(1, 0, At, B0); PG8_MMA(1, 1, At, B1); PG8_BAR; PG8_SCHED;
            } else {
            PG8_LDB(B0, 0, 0); PG8_SCHED; PG8_LDA(At, 0, 0); PG8_STAGE(PG8_SA(1, 1), a1 + hstep, voffA);
            PG8_WAIT_L(8); PG8_BAR; PG8_WAIT_L(0); PG8_MMA(0, 0, At, B0); PG8_BAR; PG8_SCHED;
            PG8_LDB(B1, 0, 1); PG8_STAGE(PG8_SB(0, 0), b2, voffB);
            PG8_BAR; PG8_WAIT_L(0); PG8_MMA(0, 1, At, B1); PG8_BAR;
            PG8_LDA(At, 0, 1); PG8_STAGE(PG8_SA(0, 0), a2, voffA);
            PG8_BAR; PG8_WAIT_L(0); PG8_MMA(1, 0, At, B0); PG8_BAR; PG8_SCHED;
            PG8_STAGE(PG8_SB(0, 1), b2 + hstep, voffB);
            PG8_WAIT_V(6); PG8_BAR; PG8_MMA(1, 1, At, B1); PG8_BAR;
            PG8_LDB(B0, 1, 0); PG8_SCHED; PG8_LDA(At, 1, 0); PG8_STAGE(PG8_SA(0, 1), a2 + hstep, voffA);
            PG8_WAIT_L(8); PG8_BAR; PG8_WAIT_L(0); PG8_MMA(0, 0, At, B0); PG8_BAR; PG8_SCHED;
            PG8_LDB(B1, 1, 1); PG8_STAGE(PG8_SB(1, 0), b3, voffB);
            PG8_BAR; PG8_WAIT_L(0); PG8_MMA(0, 1, At, B1); PG8_BAR;
            PG8_LDA(At, 1, 1); PG8_STAGE(PG8_SA(1, 0), a3, voffA);
            PG8_BAR; PG8_WAIT_L(0); PG8_MMA(1, 0, At, B0); PG8_BAR; PG8_SCHED;
            PG8_STAGE(PG8_SB(1, 1), b3 + hstep, voffB);
            PG8_WAIT_V(6); PG8_BAR; PG8_MMA(1, 1, At, B1); PG8_BAR;
            }
        }
        if constexpr (ALIGN_EPI) { if (wr == 0) PG8_BAR; }
        if constexpr (!Epi::AFTER_DRAIN) { E(acc, cur, wr, wc, fr, fq); S.done(cur); }
        if (!has_next) break;
#pragma unroll
        for (int a = 0; a < 2; ++a)
#pragma unroll
            for (int b = 0; b < 2; ++b)
#pragma unroll
                for (int m = 0; m < 4; ++m)
#pragma unroll
                    for (int n = 0; n < 2; ++n) acc[a][b][m][n] = (f32x4){0.f, 0.f, 0.f, 0.f};
        cur = nxt; cA = nA; cB = nB; ++ui;
        if constexpr (ALIGN_EPI) { if (wr == 1) PG8_BAR; }
    }
    PG8_WAIT_V(0);
    if constexpr (!ALIGN_EPI) { if (wr == 0) PG8_BAR; }
    PG8_BAR;
    if constexpr (Epi::AFTER_DRAIN) { E.fused(acc, cur, wr, wc, fr, fq, lds, wid, lane); S.done(cur); }
#undef PG8_SA
#undef PG8_SB
#undef PG8_STAGE
#undef PG8_LDA
#undef PG8_LDB
#undef PG8_MMA
#undef PG8_WAIT_V
#undef PG8_WAIT_L
#undef PG8_BAR
#undef PG8_SCHED
}
}

#include <hip/hip_bf16.h>
#include <cmath>
namespace attn_body {
using bf16=__hip_bfloat16;
using bf16x8=__attribute__((ext_vector_type(8)))short;
using s16x4=__attribute__((ext_vector_type(4)))short;
using f32x16=__attribute__((ext_vector_type(16)))float;
using u32x4=__attribute__((ext_vector_type(4)))unsigned;
constexpr int SEQ=16384,D=64,DM=512;
constexpr int NW=8,QBLK=32,QB=QBLK*NW,KVBLK=64,NQB=SEQ/QB;
constexpr int ATTN_PITCH=DM, ATTN_UNIT_ROWS=QB;
__device__ __forceinline__ int crow(int r,int hi){return (r&3)+8*(r>>2)+4*hi;}
#define SBAR() __builtin_amdgcn_sched_barrier(0)
__device__ __forceinline__ void cmask(f32x16&p0,f32x16&p1,int jb,int wid){
  const float NEG=-INFINITY;
  if(jb>(wid>>1)){
  #pragma unroll
  for(int r=0;r<16;++r){p0[r]=NEG;p1[r]=NEG;}}
}

constexpr int NSLOT=3, SLOTB=8192;
constexpr int LDS_K=0, LDS_V=NSLOT*SLOTB, LDS_WS=2*NSLOT*SLOTB, LDS_OST=LDS_WS+NW*64*4, LDS_BYTES=LDS_OST+NW*4096;
constexpr float C2=0.125f*1.4426950408889634f;
__device__ __forceinline__ void glds16(const void*gsrc,unsigned lds_dst){unsigned keep;
  asm volatile("s_mov_b32 %0, m0\n\ts_mov_b32 m0, %2\n\ts_nop 0\n\tglobal_load_lds_dwordx4 %1, off\n\ts_mov_b32 m0, %0":"=&s"(keep):"v"(gsrc),"s"(lds_dst):"memory");}
__device__ __forceinline__ float max3f(float a,float b,float c){float r;asm("v_max3_f32 %0, %1, %2, %3":"=v"(r):"v"(a),"v"(b),"v"(c));return r;}
__device__ __forceinline__ float max2f(float a,float b){float r;asm("v_max_f32_e32 %0, %1, %2":"=v"(r):"v"(a),"v"(b));return r;}
__device__ __forceinline__ float fadd_s(float a,float b){float r;asm("v_add_f32_e32 %0, %1, %2":"=v"(r):"v"(a),"v"(b));return r;}
__device__ __forceinline__ float fsub_s(float a,float b){float r;asm("v_sub_f32_e32 %0, %1, %2":"=v"(r):"v"(a),"v"(b));return r;}
typedef float f32x2_t __attribute__((ext_vector_type(2))); typedef __bf16 bf16x2_t __attribute__((ext_vector_type(2)));
__device__ __forceinline__ unsigned cvtpk_s(float lo,float hi){f32x2_t v={lo,hi};bf16x2_t b=__builtin_convertvector(v,bf16x2_t);return __builtin_bit_cast(unsigned,b);}
#define WAIT_BAR(N) asm volatile("s_waitcnt vmcnt(" #N ") lgkmcnt(0)\n\ts_barrier":::"memory")

__device__ __forceinline__ void qkt(f32x16&p0,f32x16&p1,const char*Kslot,const bf16x8*qr,const f32x16&negm,int r32,int hi){
  const char*kb=Kslot+hi*1024+r32*16;
  #pragma unroll
  for(int d0=0;d0<4;++d0){
    const bf16x8 b0=*reinterpret_cast<const bf16x8*>(kb+d0*2048);
    const bf16x8 b1=*reinterpret_cast<const bf16x8*>(kb+d0*2048+512);
    if(d0==0){p0=__builtin_amdgcn_mfma_f32_32x32x16_bf16(b0,qr[0],negm,0,0,0);p1=__builtin_amdgcn_mfma_f32_32x32x16_bf16(b1,qr[0],negm,0,0,0);}
    else{p0=__builtin_amdgcn_mfma_f32_32x32x16_bf16(b0,qr[d0],p0,0,0,0);p1=__builtin_amdgcn_mfma_f32_32x32x16_bf16(b1,qr[d0],p1,0,0,0);}}
}
typedef __attribute__((address_space(3))) const char* lds_cptr;
typedef short v4i16_t __attribute__((ext_vector_type(4)));
__device__ __forceinline__ void kload8(bf16x8*kf,lds_cptr kp){
  kf[0]=*(const __attribute__((address_space(3))) bf16x8*)(kp);      kf[1]=*(const __attribute__((address_space(3))) bf16x8*)(kp+512);
  kf[2]=*(const __attribute__((address_space(3))) bf16x8*)(kp+2048); kf[3]=*(const __attribute__((address_space(3))) bf16x8*)(kp+2560);
  kf[4]=*(const __attribute__((address_space(3))) bf16x8*)(kp+4096); kf[5]=*(const __attribute__((address_space(3))) bf16x8*)(kp+4608);
  kf[6]=*(const __attribute__((address_space(3))) bf16x8*)(kp+6144); kf[7]=*(const __attribute__((address_space(3))) bf16x8*)(kp+6656);
}
__device__ __forceinline__ void kload2(bf16x8*kf,lds_cptr kp,int j){ kf[2*j]=*(const __attribute__((address_space(3))) bf16x8*)(kp+j*2048); kf[2*j+1]=*(const __attribute__((address_space(3))) bf16x8*)(kp+j*2048+512); }
__device__ __forceinline__ s16x4 vtr(lds_cptr p){ return __builtin_bit_cast(s16x4,__builtin_amdgcn_ds_read_tr16_b64_v4i16((__attribute__((address_space(3))) v4i16_t*)p)); }
__device__ __forceinline__ float rowmax(const f32x16&p0,const f32x16&p1){
  float a=max3f(p0[0],p0[1],p1[0]),b=max3f(p0[2],p0[3],p1[1]);a=max3f(a,p1[2],p1[3]);
  #pragma unroll
  for(int r=4;r<16;r+=4){a=max3f(a,p0[r],p0[r+1]);b=max3f(b,p0[r+2],p0[r+3]);a=max3f(a,p1[r],p1[r+1]);b=max3f(b,p1[r+2],p1[r+3]);}
  const float m=max2f(a,b);
  auto rr=__builtin_amdgcn_permlane32_swap(__float_as_uint(m),__float_as_uint(m),false,false);
  return max2f(__uint_as_float(rr[0]),__uint_as_float(rr[1]));
}
__device__ __forceinline__ void pv(f32x16*o,int vb,bf16x8 pa0,bf16x8 pa1,bf16x8 pa2,bf16x8 pa3){
  #pragma unroll
  for(int d0=0;d0<2;++d0){s16x4 lo[4],hi[4];
    #pragma unroll
    for(int ks=0;ks<4;++ks){
      asm volatile("ds_read_b64_tr_b16 %0,%1 offset:%c2":"=&v"(lo[ks]):"v"(vb),"i"(d0*4096+ks*1024):"memory");
      asm volatile("ds_read_b64_tr_b16 %0,%1 offset:%c2":"=&v"(hi[ks]):"v"(vb),"i"(d0*4096+ks*1024+512):"memory");}
    asm volatile("s_waitcnt lgkmcnt(0)":::"memory");SBAR();
    #define PK(k) (bf16x8){lo[k][0],lo[k][1],lo[k][2],lo[k][3],hi[k][0],hi[k][1],hi[k][2],hi[k][3]}
    o[d0]=__builtin_amdgcn_mfma_f32_32x32x16_bf16(pa0,PK(0),o[d0],0,0,0);
    o[d0]=__builtin_amdgcn_mfma_f32_32x32x16_bf16(pa1,PK(1),o[d0],0,0,0);
    o[d0]=__builtin_amdgcn_mfma_f32_32x32x16_bf16(pa2,PK(2),o[d0],0,0,0);
    o[d0]=__builtin_amdgcn_mfma_f32_32x32x16_bf16(pa3,PK(3),o[d0],0,0,0);
    #undef PK
  }
}

#ifndef ATTN_STORE16
#define ATTN_STORE16(p,v) (*(u32x4*)(p)=(v))
#endif
template<int THRL> __device__ __forceinline__ void attn_unit(int qcol,int vcol,int qb,const bf16*Q,const bf16*__restrict__ K,const bf16*__restrict__ V,bf16*O,char*shm){
  const int tid=threadIdx.x,lane=tid&63,r32=lane&31,hi=lane>>5; const int wid=__builtin_amdgcn_readfirstlane(tid>>6);
  const long rowbase=0; const int q0=qb*QB;
  const bf16*Qw=Q+(rowbase+q0+wid*QBLK)*DM+qcol;
  const bf16*Kh=K+rowbase*DM+qcol,*Vh=V+rowbase*DM+vcol;
  const unsigned lds0=(unsigned)(uintptr_t)shm;
  float*wsf=(float*)(shm+LDS_WS)+wid*64;
  const bf16*ksrc=Kh+(long)lane*DM+wid*8;
  const bf16*vsrc=Vh+(long)(16*(wid&3)+(lane>>2))*DM+(wid>>2)*32+(lane&3)*8;
  const unsigned kdst=lds0+LDS_K+wid*1024, vdst=lds0+LDS_V+wid*1024;
  #define DMA_K(t,slot) glds16(ksrc+(long)(t)*KVBLK*DM,(unsigned)__builtin_amdgcn_readfirstlane(kdst+(slot)))
  #define DMA_V(t,slot) glds16(vsrc+(long)(t)*KVBLK*DM,(unsigned)__builtin_amdgcn_readfirstlane(vdst+(slot)))
  const int vb0=(int)(lds0+LDS_V)+((lane>>4)&1)*32+(lane&3)*8+(4*hi+((lane&15)>>2))*64;
  const char*Kbase=shm+LDS_K; bf16x8 kf[8];
  const lds_cptr shm3=(lds_cptr)shm; const lds_cptr kp0=shm3+LDS_K+hi*1024+r32*16; const lds_cptr vp0=shm3+LDS_V+((lane>>4)&1)*32+(lane&3)*8+(4*hi+((lane&15)>>2))*64;
  const int NT=(q0+QB)/KVBLK;
  DMA_K(0,0);DMA_V(0,0);DMA_K(1,SLOTB);
  bf16x8 qr[4];
  #pragma unroll
  for(int d0=0;d0<4;++d0)qr[d0]=*reinterpret_cast<const bf16x8*>(&Qw[(long)r32*DM+d0*16+hi*8]);
  float mhat=0.f,l_reg=0.f;f32x16 o[2];o[0]=f32x16{};o[1]=f32x16{};f32x16 negm=f32x16{};asm volatile("":"+v"(negm));
  const int qrel=wid*QBLK+r32;
  #define CMASK(P0,P1,t) do{int jb_=(t)-(NT-4); if(jb_>=0)cmask(P0,P1,jb_,wid);}while(0)
  bool resc=false;
  #define START(P0,P1) do{ const float rm=rowmax(P0,P1); resc=false; \
    { const float dl=rm; mhat=fadd_s(mhat,dl); \
      _Pragma("unroll") for(int r=0;r<16;++r){P0[r]=fsub_s(P0[r],dl);P1[r]=fsub_s(P1[r],dl);} \
      _Pragma("unroll") for(int r=0;r<16;++r)negm[r]=-mhat; asm volatile("":"+v"(negm)); } \
    _Pragma("unroll") for(int r=0;r<16;++r)P0[r]=__builtin_amdgcn_exp2f(P0[r]); }while(0)
  #define RESC() do{ if(resc){ asm volatile("s_waitcnt lgkmcnt(0)":::"memory"); \
      _Pragma("unroll") for(int d_=0;d_<2;++d_) _Pragma("unroll") for(int r=0;r<16;++r)o[d_][r]*=wsf[crow(r,hi)]; } }while(0)
  f32x16 pA0,pA1,pB0,pB1;
  int sl_prev=0,sl_cur=0,sl_next=SLOTB;
  #define ROT() do{sl_prev=sl_cur;sl_cur=sl_next;sl_next=(sl_next==(NSLOT-1)*SLOTB)?0:sl_next+SLOTB;}while(0)
  DMA_K(2,2*SLOTB);
  WAIT_BAR(3);
  qkt(pA0,pA1,Kbase,qr,negm,r32,hi);asm volatile("s_nop 15\n\ts_nop 7":"+v"(pA0),"+v"(pA1));CMASK(pA0,pA1,0);
  START(pA0,pA1);
  _Pragma("unroll") for(int r=0;r<16;++r)pA1[r]=__builtin_amdgcn_exp2f(pA1[r]);
  WAIT_BAR(0);
  DMA_K(3,0);DMA_V(1,SLOTB);
  ROT();
  kload8(kf,kp0+sl_cur);
  WAIT_BAR(2);
  s16x4 vlo[8],vhi[8]; u32x4 pw0,pw1,pw2,pw3;
  #define PKW(P,B) cvtpk_s(P[B],P[B+1])
  #define PAF(k) __builtin_bit_cast(bf16x8,pw##k)
  #define VFR(i) (bf16x8){vlo[i][0],vlo[i][1],vlo[i][2],vlo[i][3],vhi[i][0],vhi[i][1],vhi[i][2],vhi[i][3]}
  #define PIN(x) asm volatile("":"+v"(x))
  #define MX3(a,b,c) __builtin_fmaxf(__builtin_fmaxf((a),(b)),(c))
  #define GAPA(MF,A0,A1,A2,A3,W0,W1,PW) do{ MF; sacc+=A0; sacc+=A1; sacc+=A2; sacc+=A3; PIN(sacc); W0; W1; PIN(PW); SBAR(); }while(0)
  #define EX(v) __builtin_amdgcn_exp2f(v)
  #define GAPB(MF,X,B) do{ MF; X[B]=EX(X[B]); X[B+1]=EX(X[B+1]); X[B+2]=EX(X[B+2]); X[B+3]=EX(X[B+3]); PIN(X); SBAR(); }while(0)
  #define VRD(i) do{ vlo[i]=vtr(vp_+(((i)>>2)*4096+((i)&3)*1024)); vhi[i]=vtr(vp_+(((i)>>2)*4096+((i)&3)*1024+512)); }while(0)
  #define KRD(G,j) do{ if(G){ kload2(kf,kp0+sl_next,j); SBAR(); } }while(0)
  #define STEP(C0,C1,P0,P1,t,GK,GV,GL) do{ SBAR(); \
    const lds_cptr vp_=vp0+sl_prev; \
    VRD(0); SBAR(); float sacc=(P0[0]+P0[1]); \
    GAPA(C0=__builtin_amdgcn_mfma_f32_32x32x16_bf16(kf[0],qr[0],negm,0,0,0), P0[2],P0[3],P0[4],P0[5],     pw0[0]=PKW(P0,0), pw0[1]=PKW(P0,2), pw0); \
    VRD(4); SBAR(); GAPA(C1=__builtin_amdgcn_mfma_f32_32x32x16_bf16(kf[1],qr[0],negm,0,0,0), P0[6],P0[7],P0[8],P0[9],     pw0[2]=PKW(P0,4), pw0[3]=PKW(P0,6), pw0); \
    VRD(1); SBAR(); GAPA(C0=__builtin_amdgcn_mfma_f32_32x32x16_bf16(kf[2],qr[1],C0,0,0,0),   P0[10],P0[11],P0[12],P0[13], pw1[0]=PKW(P0,8), pw1[1]=PKW(P0,10), pw1); \
    VRD(5); SBAR(); GAPA(C1=__builtin_amdgcn_mfma_f32_32x32x16_bf16(kf[3],qr[1],C1,0,0,0),   P0[14],P0[15],P1[0],P1[1],   pw1[2]=PKW(P0,12),pw1[3]=PKW(P0,14), pw1); \
    VRD(2); SBAR(); GAPA(C0=__builtin_amdgcn_mfma_f32_32x32x16_bf16(kf[4],qr[2],C0,0,0,0),   P1[2],P1[3],P1[4],P1[5],     pw2[0]=PKW(P1,0), pw2[1]=PKW(P1,2), pw2); \
    VRD(6); SBAR(); GAPA(C1=__builtin_amdgcn_mfma_f32_32x32x16_bf16(kf[5],qr[2],C1,0,0,0),   P1[6],P1[7],P1[8],P1[9],     pw2[2]=PKW(P1,4), pw2[3]=PKW(P1,6), pw2); \
    VRD(3); SBAR(); GAPA(C0=__builtin_amdgcn_mfma_f32_32x32x16_bf16(kf[6],qr[3],C0,0,0,0),   P1[10],P1[11],P1[12],P1[13], pw3[0]=PKW(P1,8), pw3[1]=PKW(P1,10), pw3); \
    VRD(7); SBAR(); GAPA(C1=__builtin_amdgcn_mfma_f32_32x32x16_bf16(kf[7],qr[3],C1,0,0,0),   P1[14],P1[15],0.f,0.f,       pw3[2]=PKW(P1,12),pw3[3]=PKW(P1,14), pw3); \
    l_reg+=sacc; \
    if(GK){DMA_K((t)+3,sl_cur);} if(GV){DMA_V((t)+1,sl_next);} \
    CMASK(C0,C1,t); \
    { float a=MX3(C0[0],C0[1],C1[0]),b=MX3(C0[2],C0[3],C1[1]); a=MX3(a,C1[2],C1[3]); \
      _Pragma("unroll") for(int r=4;r<16;r+=4){a=MX3(a,C0[r],C0[r+1]);b=MX3(b,C0[r+2],C0[r+3]);a=MX3(a,C1[r],C1[r+1]);b=MX3(b,C1[r+2],C1[r+3]);} \
      float rm=__builtin_fmaxf(a,b); { auto rr=__builtin_amdgcn_permlane32_swap(__float_as_uint(rm),__float_as_uint(rm),false,false); rm=__builtin_fmaxf(__uint_as_float(rr[0]),__uint_as_float(rr[1])); } \
      resc=false; \
      if(__builtin_expect(__any(rm>(float)THRL),0)){ const float dl=__builtin_fmaxf(rm,0.f); mhat+=dl; \
        _Pragma("unroll") for(int r=0;r<16;++r){C0[r]-=dl;C1[r]-=dl;} \
        _Pragma("unroll") for(int r=0;r<16;++r)negm[r]=-mhat; asm volatile("":"+v"(negm)); \
        const float f=__builtin_amdgcn_exp2f(-dl); l_reg*=f; if(hi==0)wsf[r32]=f; resc=true; } } \
    SBAR(); \
    GAPB(o[0]=__builtin_amdgcn_mfma_f32_32x32x16_bf16(PAF(0),VFR(0),o[0],0,0,0), C0,0); \
    GAPB(o[1]=__builtin_amdgcn_mfma_f32_32x32x16_bf16(PAF(0),VFR(4),o[1],0,0,0), C0,4); \
    KRD(GL,0); GAPB(o[0]=__builtin_amdgcn_mfma_f32_32x32x16_bf16(PAF(1),VFR(1),o[0],0,0,0), C0,8); \
    KRD(GL,1); GAPB(o[1]=__builtin_amdgcn_mfma_f32_32x32x16_bf16(PAF(1),VFR(5),o[1],0,0,0), C0,12); \
    KRD(GL,2); GAPB(o[0]=__builtin_amdgcn_mfma_f32_32x32x16_bf16(PAF(2),VFR(2),o[0],0,0,0), C1,0); \
    KRD(GL,3); GAPB(o[1]=__builtin_amdgcn_mfma_f32_32x32x16_bf16(PAF(2),VFR(6),o[1],0,0,0), C1,4); \
    GAPB(o[0]=__builtin_amdgcn_mfma_f32_32x32x16_bf16(PAF(3),VFR(3),o[0],0,0,0), C1,8); \
    GAPB(o[1]=__builtin_amdgcn_mfma_f32_32x32x16_bf16(PAF(3),VFR(7),o[1],0,0,0), C1,12); \
    }while(0)
  int t=1;
  #undef CMASK
  #define CMASK(P0,P1,t) do{}while(0)
  for(;t+5<NT;t+=2){
    STEP(pB0,pB1,pA0,pA1,t,true,true,true);     WAIT_BAR(2); RESC(); ROT();
    STEP(pA0,pA1,pB0,pB1,t+1,true,true,true);   WAIT_BAR(2); RESC(); ROT();
  }
  #undef CMASK
  #define CMASK(P0,P1,t) do{int jb_=(t)-(NT-4); if(jb_>=0)cmask(P0,P1,jb_,wid);}while(0)
  #define ENDW(tt) do{ if((tt)+3<NT){WAIT_BAR(2);} else if((tt)+2<NT){WAIT_BAR(1);} else {WAIT_BAR(0);} }while(0)
  for(;t+1<NT;t+=2){
    STEP(pB0,pB1,pA0,pA1,t,(t+3<NT),(t+1<NT),(t+1<NT));       ENDW(t);   RESC(); ROT();
    STEP(pA0,pA1,pB0,pB1,t+1,(t+4<NT),(t+2<NT),(t+2<NT));     ENDW(t+1); RESC(); ROT();
  }
  STEP(pB0,pB1,pA0,pA1,NT-1,false,false,false); RESC();
  { float sacc=pB0[0]+pB0[1]; _Pragma("unroll") for(int r=2;r<16;++r)sacc+=pB0[r]; _Pragma("unroll") for(int r=0;r<16;++r)sacc+=pB1[r]; l_reg+=sacc;
    pw0=(u32x4){PKW(pB0,0),PKW(pB0,2),PKW(pB0,4),PKW(pB0,6)};pw1=(u32x4){PKW(pB0,8),PKW(pB0,10),PKW(pB0,12),PKW(pB0,14)};pw2=(u32x4){PKW(pB1,0),PKW(pB1,2),PKW(pB1,4),PKW(pB1,6)};pw3=(u32x4){PKW(pB1,8),PKW(pB1,10),PKW(pB1,12),PKW(pB1,14)};
    SBAR(); pv(o,vb0+sl_cur,PAF(0),PAF(1),PAF(2),PAF(3)); }
  #undef PKW
  #undef PAF
  #undef VFR
  #undef PIN
  #undef MX3
  #undef GAPA
  #undef GAPB
  #undef EX
  #undef VRD
  #undef KRD
  #undef STEP
  #undef ENDW
  {auto rr=__builtin_amdgcn_permlane32_swap(__float_as_uint(l_reg),__float_as_uint(l_reg),false,false);l_reg=__uint_as_float(rr[0])+__uint_as_float(rr[1]);}
  if(hi==0)wsf[32+r32]=l_reg;asm volatile("s_waitcnt lgkmcnt(0)":::"memory");
  float rli[16];
  #pragma unroll
  for(int r=0;r<16;++r)rli[r]=__builtin_amdgcn_rcpf(wsf[32+crow(r,hi)]);
  bf16*Ow=O+(rowbase+q0+wid*QBLK)*DM+vcol;
  { bf16*stg=(bf16*)(shm+LDS_OST)+wid*2048;
    #pragma unroll
    for(int r=0;r<16;++r){const int orow=crow(r,hi);
      #pragma unroll
      for(int d0=0;d0<2;++d0)stg[orow*64+d0*32+r32]=__float2bfloat16(o[d0][r]*rli[r]);}
    asm volatile("s_waitcnt lgkmcnt(0)":::"memory");
    #pragma unroll
    for(int i=0;i<4;++i){const int row=i*8+(lane>>3),ch=lane&7; const u32x4 v=*(const u32x4*)(stg+row*64+ch*8); ATTN_STORE16(Ow+(long)row*DM+ch*8,v);} }
  asm volatile("s_waitcnt lgkmcnt(0)\n\ts_barrier":::"memory");
  #undef DMA_K
  #undef DMA_V
  #undef CMASK
  #undef START
  #undef RESC
  #undef ROT
}
constexpr int ATTN_LDS_BYTES=LDS_BYTES;
struct AttnTensors { const bf16* Q; const bf16* K; const bf16* V; bf16* O; };
struct AttnUnit { int var; int qb; };
struct StaticOrder {
  int vcu;
  __device__ __forceinline__ explicit StaticOrder(int v):vcu(v){}
  __device__ __forceinline__ bool next(int i,AttnUnit&u)const{ if(i>=4)return false; const int s=vcu&15; u.var=vcu>>4; u.qb=(i==0)?s:(i==1)?31-s:(i==2)?32+s:63-s; return true; }
};
template<class Sched,int THRL=8> __device__ __forceinline__ void attn_phase(char*lds,const AttnTensors&T,const Sched&S){
  AttnUnit u;
  for(int i=0;S.next(i,u);++i){ const int h=u.var>>2,mp=(u.var>>1)&1,vh=u.var&1;
    attn_unit<THRL>(h*128+mp*64,h*128+vh*64,u.qb,T.Q,T.K,T.V,T.O+(size_t)mp*SEQ*DM,lds); }
}
#undef SBAR
#undef WAIT_BAR
}
namespace attn128 {
using bf16=__hip_bfloat16;
using bf16x8=__attribute__((ext_vector_type(8)))short;
using s16x4=__attribute__((ext_vector_type(4)))short;
using f32x16=__attribute__((ext_vector_type(16)))float;
using u32x4=__attribute__((ext_vector_type(4)))unsigned;
constexpr int SEQ=16384,D=64,DM=512;
constexpr int NW=8,QBLK=32,QB=QBLK*NW,KVBLK=64,NQB=SEQ/QB;
constexpr int ATTN_PITCH=DM, ATTN_UNIT_ROWS=QB;
__device__ __forceinline__ int crow(int r,int hi){return (r&3)+8*(r>>2)+4*hi;}
#define SBAR() __builtin_amdgcn_sched_barrier(0)
__device__ __forceinline__ void cmask(f32x16&p0,f32x16&p1,int jb,int wid){
  const float NEG=-INFINITY;
  if(jb>(wid>>1)){
  #pragma unroll
  for(int r=0;r<16;++r){p0[r]=NEG;p1[r]=NEG;}}
}

constexpr int NSLOT=3, SLOTB=8192;
constexpr int LDS_K=0, LDS_V=NSLOT*SLOTB, LDS_WS=3*NSLOT*SLOTB, LDS_OST=LDS_WS+NW*64*4, LDS_BYTES=LDS_OST+NW*4096;
constexpr float C2=0.125f*1.4426950408889634f;
__device__ __forceinline__ void glds16(const void*gsrc,unsigned lds_dst){unsigned keep;
  asm volatile("s_mov_b32 %0, m0\n\ts_mov_b32 m0, %2\n\ts_nop 0\n\tglobal_load_lds_dwordx4 %1, off\n\ts_mov_b32 m0, %0":"=&s"(keep):"v"(gsrc),"s"(lds_dst):"memory");}
__device__ __forceinline__ float max3f(float a,float b,float c){float r;asm("v_max3_f32 %0, %1, %2, %3":"=v"(r):"v"(a),"v"(b),"v"(c));return r;}
__device__ __forceinline__ float max2f(float a,float b){float r;asm("v_max_f32_e32 %0, %1, %2":"=v"(r):"v"(a),"v"(b));return r;}
__device__ __forceinline__ float fadd_s(float a,float b){float r;asm("v_add_f32_e32 %0, %1, %2":"=v"(r):"v"(a),"v"(b));return r;}
__device__ __forceinline__ float fsub_s(float a,float b){float r;asm("v_sub_f32_e32 %0, %1, %2":"=v"(r):"v"(a),"v"(b));return r;}
typedef float f32x2_t __attribute__((ext_vector_type(2))); typedef __bf16 bf16x2_t __attribute__((ext_vector_type(2)));
__device__ __forceinline__ unsigned cvtpk_s(float lo,float hi){f32x2_t v={lo,hi};bf16x2_t b=__builtin_convertvector(v,bf16x2_t);return __builtin_bit_cast(unsigned,b);}
#define WAIT_BAR(N) asm volatile("s_waitcnt vmcnt(" #N ") lgkmcnt(0)\n\ts_barrier":::"memory")

__device__ __forceinline__ void qkt(f32x16&p0,f32x16&p1,const char*Kslot,const bf16x8*qr,const f32x16&negm,int r32,int hi){
  const char*kb=Kslot+hi*1024+r32*16;
  #pragma unroll
  for(int d0=0;d0<4;++d0){
    const bf16x8 b0=*reinterpret_cast<const bf16x8*>(kb+d0*2048);
    const bf16x8 b1=*reinterpret_cast<const bf16x8*>(kb+d0*2048+512);
    if(d0==0){p0=__builtin_amdgcn_mfma_f32_32x32x16_bf16(b0,qr[0],negm,0,0,0);p1=__builtin_amdgcn_mfma_f32_32x32x16_bf16(b1,qr[0],negm,0,0,0);}
    else{p0=__builtin_amdgcn_mfma_f32_32x32x16_bf16(b0,qr[d0],p0,0,0,0);p1=__builtin_amdgcn_mfma_f32_32x32x16_bf16(b1,qr[d0],p1,0,0,0);}}
}
typedef __attribute__((address_space(3))) const char* lds_cptr;
typedef short v4i16_t __attribute__((ext_vector_type(4)));
__device__ __forceinline__ void kload8(bf16x8*kf,lds_cptr kp){
  kf[0]=*(const __attribute__((address_space(3))) bf16x8*)(kp);      kf[1]=*(const __attribute__((address_space(3))) bf16x8*)(kp+512);
  kf[2]=*(const __attribute__((address_space(3))) bf16x8*)(kp+2048); kf[3]=*(const __attribute__((address_space(3))) bf16x8*)(kp+2560);
  kf[4]=*(const __attribute__((address_space(3))) bf16x8*)(kp+4096); kf[5]=*(const __attribute__((address_space(3))) bf16x8*)(kp+4608);
  kf[6]=*(const __attribute__((address_space(3))) bf16x8*)(kp+6144); kf[7]=*(const __attribute__((address_space(3))) bf16x8*)(kp+6656);
}
__device__ __forceinline__ void kload2(bf16x8*kf,lds_cptr kp,int j){ kf[2*j]=*(const __attribute__((address_space(3))) bf16x8*)(kp+j*2048); kf[2*j+1]=*(const __attribute__((address_space(3))) bf16x8*)(kp+j*2048+512); }
__device__ __forceinline__ s16x4 vtr(lds_cptr p){ return __builtin_bit_cast(s16x4,__builtin_amdgcn_ds_read_tr16_b64_v4i16((__attribute__((address_space(3))) v4i16_t*)p)); }
__device__ __forceinline__ float rowmax(const f32x16&p0,const f32x16&p1){
  float a=max3f(p0[0],p0[1],p1[0]),b=max3f(p0[2],p0[3],p1[1]);a=max3f(a,p1[2],p1[3]);
  #pragma unroll
  for(int r=4;r<16;r+=4){a=max3f(a,p0[r],p0[r+1]);b=max3f(b,p0[r+2],p0[r+3]);a=max3f(a,p1[r],p1[r+1]);b=max3f(b,p1[r+2],p1[r+3]);}
  const float m=max2f(a,b);
  auto rr=__builtin_amdgcn_permlane32_swap(__float_as_uint(m),__float_as_uint(m),false,false);
  return max2f(__uint_as_float(rr[0]),__uint_as_float(rr[1]));
}
__device__ __forceinline__ void pv(f32x16*o,int vb,bf16x8 pa0,bf16x8 pa1,bf16x8 pa2,bf16x8 pa3){
  #pragma unroll
  for(int d0=0;d0<4;++d0){s16x4 lo[4],hi[4];
    #pragma unroll
    for(int ks=0;ks<4;++ks){
      asm volatile("ds_read_b64_tr_b16 %0,%1 offset:%c2":"=&v"(lo[ks]):"v"(vb),"i"(d0*4096+ks*1024):"memory");
      asm volatile("ds_read_b64_tr_b16 %0,%1 offset:%c2":"=&v"(hi[ks]):"v"(vb),"i"(d0*4096+ks*1024+512):"memory");}
    asm volatile("s_waitcnt lgkmcnt(0)":::"memory");SBAR();
    #define PK(k) (bf16x8){lo[k][0],lo[k][1],lo[k][2],lo[k][3],hi[k][0],hi[k][1],hi[k][2],hi[k][3]}
    o[d0]=__builtin_amdgcn_mfma_f32_32x32x16_bf16(pa0,PK(0),o[d0],0,0,0);
    o[d0]=__builtin_amdgcn_mfma_f32_32x32x16_bf16(pa1,PK(1),o[d0],0,0,0);
    o[d0]=__builtin_amdgcn_mfma_f32_32x32x16_bf16(pa2,PK(2),o[d0],0,0,0);
    o[d0]=__builtin_amdgcn_mfma_f32_32x32x16_bf16(pa3,PK(3),o[d0],0,0,0);
    #undef PK
  }
}

#ifndef ATTN_STORE16
#define ATTN_STORE16(p,v) (*(u32x4*)(p)=(v))
#endif
template<int THRL> __device__ __forceinline__ void attn_unit(int qcol,int vcol,int qb,const bf16*Q,const bf16*__restrict__ K,const bf16*__restrict__ V,bf16*O,char*shm){
  const int tid=threadIdx.x,lane=tid&63,r32=lane&31,hi=lane>>5; const int wid=__builtin_amdgcn_readfirstlane(tid>>6);
  const long rowbase=0; const int q0=qb*QB;
  const bf16*Qw=Q+(rowbase+q0+wid*QBLK)*DM+qcol;
  const bf16*Kh=K+rowbase*DM+qcol,*Vh=V+rowbase*DM+vcol;
  const unsigned lds0=(unsigned)(uintptr_t)shm;
  float*wsf=(float*)(shm+LDS_WS)+wid*64;
  const bf16*ksrc=Kh+(long)lane*DM+wid*8;
  const bf16*vsrc=Vh+(long)(16*(wid&3)+(lane>>2))*DM+(wid>>2)*32+(lane&3)*8;
  const unsigned kdst=lds0+LDS_K+wid*1024, vdst=lds0+LDS_V+wid*1024;
  #define DMA_K(t,slot) glds16(ksrc+(long)(t)*KVBLK*DM,(unsigned)__builtin_amdgcn_readfirstlane(kdst+(slot)))
  #define DMA_V(t,slot) do{ glds16(vsrc+(long)(t)*KVBLK*DM,(unsigned)__builtin_amdgcn_readfirstlane(vdst+2*(slot))); glds16(vsrc+64+(long)(t)*KVBLK*DM,(unsigned)__builtin_amdgcn_readfirstlane(vdst+2*(slot)+8192)); }while(0)
  const int vb0=(int)(lds0+LDS_V)+((lane>>4)&1)*32+(lane&3)*8+(4*hi+((lane&15)>>2))*64;
  const char*Kbase=shm+LDS_K; bf16x8 kf[8];
  const lds_cptr shm3=(lds_cptr)shm; const lds_cptr kp0=shm3+LDS_K+hi*1024+r32*16; const lds_cptr vp0=shm3+LDS_V+((lane>>4)&1)*32+(lane&3)*8+(4*hi+((lane&15)>>2))*64;
  const int NT=(q0+QB)/KVBLK;
  DMA_K(0,0);DMA_V(0,0);DMA_K(1,SLOTB);
  bf16x8 qr[4];
  #pragma unroll
  for(int d0=0;d0<4;++d0)qr[d0]=*reinterpret_cast<const bf16x8*>(&Qw[(long)r32*DM+d0*16+hi*8]);
  float mhat=0.f,l_reg=0.f;f32x16 o[4];o[0]=f32x16{};o[1]=f32x16{};o[2]=f32x16{};o[3]=f32x16{};const f32x16 negm=f32x16{};
  const int qrel=wid*QBLK+r32;
  #define CMASK(P0,P1,t) do{int jb_=(t)-(NT-4); if(jb_>=0)cmask(P0,P1,jb_,wid);}while(0)
  bool resc=false;
  #define START(P0,P1) do{ const float rm=rowmax(P0,P1); resc=false; \
    { const float dl=rm; mhat=fadd_s(mhat,dl); \
      _Pragma("unroll") for(int r=0;r<16;++r){P0[r]=fsub_s(P0[r],dl);P1[r]=fsub_s(P1[r],dl);} \
      } \
    _Pragma("unroll") for(int r=0;r<16;++r)P0[r]=__builtin_amdgcn_exp2f(P0[r]); }while(0)
  #define RESC() do{ if(resc){ asm volatile("s_waitcnt lgkmcnt(0)":::"memory"); \
      _Pragma("unroll") for(int d_=0;d_<4;++d_) _Pragma("unroll") for(int r=0;r<16;++r)o[d_][r]*=wsf[crow(r,hi)]; } }while(0)
  f32x16 pA0,pA1,pB0,pB1;
  int sl_prev=0,sl_cur=0,sl_next=SLOTB;
  #define ROT() do{sl_prev=sl_cur;sl_cur=sl_next;sl_next=(sl_next==(NSLOT-1)*SLOTB)?0:sl_next+SLOTB;}while(0)
  DMA_K(2,2*SLOTB);
  WAIT_BAR(4);
  qkt(pA0,pA1,Kbase,qr,negm,r32,hi);asm volatile("s_nop 15\n\ts_nop 7":"+v"(pA0),"+v"(pA1));CMASK(pA0,pA1,0);
  START(pA0,pA1);
  _Pragma("unroll") for(int r=0;r<16;++r)pA1[r]=__builtin_amdgcn_exp2f(pA1[r]);
  WAIT_BAR(0);
  DMA_K(3,0);DMA_V(1,SLOTB);
  ROT();
  kload8(kf,kp0+sl_cur);
  WAIT_BAR(3);
  s16x4 vlo[8],vhi[8]; u32x4 pw0,pw1,pw2,pw3;
  #define PKW(P,B) cvtpk_s(P[B],P[B+1])
  #define PAF(k) __builtin_bit_cast(bf16x8,pw##k)
  #define VFR(i) (bf16x8){vlo[i][0],vlo[i][1],vlo[i][2],vlo[i][3],vhi[i][0],vhi[i][1],vhi[i][2],vhi[i][3]}
  #define PIN(x) asm volatile("":"+v"(x))
  #define MX3(a,b,c) __builtin_fmaxf(__builtin_fmaxf((a),(b)),(c))
  #define GAPA(MF,A0,A1,A2,A3,W0,W1,PW) do{ MF; sacc+=A0; sacc+=A1; sacc+=A2; sacc+=A3; PIN(sacc); W0; W1; PIN(PW); SBAR(); }while(0)
  #define EX(v) __builtin_amdgcn_exp2f(v)
  #define GAPB(MF,X,B) do{ MF; X[B]=EX(X[B]); X[B+1]=EX(X[B+1]); X[B+2]=EX(X[B+2]); X[B+3]=EX(X[B+3]); PIN(X); SBAR(); }while(0)
  #define VRD(i) do{ vlo[i]=vtr(vp_+(((i)>>2)*4096+((i)&3)*1024)); vhi[i]=vtr(vp_+(((i)>>2)*4096+((i)&3)*1024+512)); }while(0)
  #define VRD2(i) do{ vlo[i]=vtr(vp_+((2+((i)>>2))*4096+((i)&3)*1024)); vhi[i]=vtr(vp_+((2+((i)>>2))*4096+((i)&3)*1024+512)); SBAR(); }while(0)
  #define GAPB2(MF,X,B) do{ MF; X[B]=EX(X[B]-mhat); X[B+1]=EX(X[B+1]-mhat); PIN(X); SBAR(); }while(0)
  #define KRD(G,j) do{ if(G){ kload2(kf,kp0+sl_next,j); SBAR(); } }while(0)
  #define STEP(C0,C1,P0,P1,t,GK,GV,GL) do{ SBAR(); \
    const lds_cptr vp_=vp0+2*sl_prev; \
    VRD(0); SBAR(); float sacc=(P0[0]+P0[1]); \
    GAPA(C0=__builtin_amdgcn_mfma_f32_32x32x16_bf16(kf[0],qr[0],negm,0,0,0), P0[2],P0[3],P0[4],P0[5],     pw0[0]=PKW(P0,0), pw0[1]=PKW(P0,2), pw0); \
    VRD(4); SBAR(); GAPA(C1=__builtin_amdgcn_mfma_f32_32x32x16_bf16(kf[1],qr[0],negm,0,0,0), P0[6],P0[7],P0[8],P0[9],     pw0[2]=PKW(P0,4), pw0[3]=PKW(P0,6), pw0); \
    VRD(1); SBAR(); GAPA(C0=__builtin_amdgcn_mfma_f32_32x32x16_bf16(kf[2],qr[1],C0,0,0,0),   P0[10],P0[11],P0[12],P0[13], pw1[0]=PKW(P0,8), pw1[1]=PKW(P0,10), pw1); \
    VRD(5); SBAR(); GAPA(C1=__builtin_amdgcn_mfma_f32_32x32x16_bf16(kf[3],qr[1],C1,0,0,0),   P0[14],P0[15],P1[0],P1[1],   pw1[2]=PKW(P0,12),pw1[3]=PKW(P0,14), pw1); \
    GAPA(C0=__builtin_amdgcn_mfma_f32_32x32x16_bf16(kf[4],qr[2],C0,0,0,0),   P1[2],P1[3],P1[4],P1[5],     pw2[0]=PKW(P1,0), pw2[1]=PKW(P1,2), pw2); \
    GAPA(C1=__builtin_amdgcn_mfma_f32_32x32x16_bf16(kf[5],qr[2],C1,0,0,0),   P1[6],P1[7],P1[8],P1[9],     pw2[2]=PKW(P1,4), pw2[3]=PKW(P1,6), pw2); \
    GAPA(C0=__builtin_amdgcn_mfma_f32_32x32x16_bf16(kf[6],qr[3],C0,0,0,0),   P1[10],P1[11],P1[12],P1[13], pw3[0]=PKW(P1,8), pw3[1]=PKW(P1,10), pw3); \
    GAPA(C1=__builtin_amdgcn_mfma_f32_32x32x16_bf16(kf[7],qr[3],C1,0,0,0),   P1[14],P1[15],0.f,0.f,       pw3[2]=PKW(P1,12),pw3[3]=PKW(P1,14), pw3); \
    l_reg+=sacc; \
    if(GK){DMA_K((t)+3,sl_cur);} if(GV){DMA_V((t)+1,sl_next);} \
    CMASK(C0,C1,t); \
    { float a=MX3(C0[0],C0[1],C1[0]),b=MX3(C0[2],C0[3],C1[1]); a=MX3(a,C1[2],C1[3]); \
      _Pragma("unroll") for(int r=4;r<16;r+=4){a=MX3(a,C0[r],C0[r+1]);b=MX3(b,C0[r+2],C0[r+3]);a=MX3(a,C1[r],C1[r+1]);b=MX3(b,C1[r+2],C1[r+3]);} \
      float rm=__builtin_fmaxf(a,b); { auto rr=__builtin_amdgcn_permlane32_swap(__float_as_uint(rm),__float_as_uint(rm),false,false); rm=__builtin_fmaxf(__uint_as_float(rr[0]),__uint_as_float(rr[1])); } \
      resc=false; const float rmr=rm-mhat; \
      if(__builtin_expect(__any(rmr>(float)THRL),0)){ const float dl=__builtin_fmaxf(rmr,0.f); mhat+=dl; \
        const float f=__builtin_amdgcn_exp2f(-dl); l_reg*=f; if(hi==0)wsf[r32]=f; resc=true; } } \
    SBAR(); \
    VRD(2); SBAR(); GAPB2(o[0]=__builtin_amdgcn_mfma_f32_32x32x16_bf16(PAF(0),VFR(0),o[0],0,0,0), C0,0); \
    VRD(6); SBAR(); GAPB2(o[1]=__builtin_amdgcn_mfma_f32_32x32x16_bf16(PAF(0),VFR(4),o[1],0,0,0), C0,2); \
    VRD(3); SBAR(); GAPB2(o[0]=__builtin_amdgcn_mfma_f32_32x32x16_bf16(PAF(1),VFR(1),o[0],0,0,0), C0,4); \
    VRD(7); SBAR(); GAPB2(o[1]=__builtin_amdgcn_mfma_f32_32x32x16_bf16(PAF(1),VFR(5),o[1],0,0,0), C0,6); \
    VRD2(0); GAPB2(o[0]=__builtin_amdgcn_mfma_f32_32x32x16_bf16(PAF(2),VFR(2),o[0],0,0,0), C0,8); \
    VRD2(4); GAPB2(o[1]=__builtin_amdgcn_mfma_f32_32x32x16_bf16(PAF(2),VFR(6),o[1],0,0,0), C0,10); \
    VRD2(1); GAPB2(o[0]=__builtin_amdgcn_mfma_f32_32x32x16_bf16(PAF(3),VFR(3),o[0],0,0,0), C0,12); \
    VRD2(5); GAPB2(o[1]=__builtin_amdgcn_mfma_f32_32x32x16_bf16(PAF(3),VFR(7),o[1],0,0,0), C0,14); \
    VRD2(2); GAPB2(o[2]=__builtin_amdgcn_mfma_f32_32x32x16_bf16(PAF(0),VFR(0),o[2],0,0,0), C1,0); \
    VRD2(6); GAPB2(o[3]=__builtin_amdgcn_mfma_f32_32x32x16_bf16(PAF(0),VFR(4),o[3],0,0,0), C1,2); \
    VRD2(3); KRD(GL,0); GAPB2(o[2]=__builtin_amdgcn_mfma_f32_32x32x16_bf16(PAF(1),VFR(1),o[2],0,0,0), C1,4); \
    VRD2(7); KRD(GL,1); GAPB2(o[3]=__builtin_amdgcn_mfma_f32_32x32x16_bf16(PAF(1),VFR(5),o[3],0,0,0), C1,6); \
    KRD(GL,2); GAPB2(o[2]=__builtin_amdgcn_mfma_f32_32x32x16_bf16(PAF(2),VFR(2),o[2],0,0,0), C1,8); \
    KRD(GL,3); GAPB2(o[3]=__builtin_amdgcn_mfma_f32_32x32x16_bf16(PAF(2),VFR(6),o[3],0,0,0), C1,10); \
    GAPB2(o[2]=__builtin_amdgcn_mfma_f32_32x32x16_bf16(PAF(3),VFR(3),o[2],0,0,0), C1,12); \
    GAPB2(o[3]=__builtin_amdgcn_mfma_f32_32x32x16_bf16(PAF(3),VFR(7),o[3],0,0,0), C1,14); \
    }while(0)
  int t=1;
  #undef CMASK
  #define CMASK(P0,P1,t) do{}while(0)
  for(;t+5<NT;t+=2){
    STEP(pB0,pB1,pA0,pA1,t,true,true,true);     WAIT_BAR(3); RESC(); ROT();
    STEP(pA0,pA1,pB0,pB1,t+1,true,true,true);   WAIT_BAR(3); RESC(); ROT();
  }
  #undef CMASK
  #define CMASK(P0,P1,t) do{int jb_=(t)-(NT-4); if(jb_>=0)cmask(P0,P1,jb_,wid);}while(0)
  #define ENDW(tt) do{ if((tt)+3<NT){WAIT_BAR(3);} else if((tt)+2<NT){WAIT_BAR(2);} else {WAIT_BAR(0);} }while(0)
  for(;t+1<NT;t+=2){
    STEP(pB0,pB1,pA0,pA1,t,(t+3<NT),(t+1<NT),(t+1<NT));       ENDW(t);   RESC(); ROT();
    STEP(pA0,pA1,pB0,pB1,t+1,(t+4<NT),(t+2<NT),(t+2<NT));     ENDW(t+1); RESC(); ROT();
  }
  STEP(pB0,pB1,pA0,pA1,NT-1,false,false,false); RESC();
  { float sacc=pB0[0]+pB0[1]; _Pragma("unroll") for(int r=2;r<16;++r)sacc+=pB0[r]; _Pragma("unroll") for(int r=0;r<16;++r)sacc+=pB1[r]; l_reg+=sacc;
    pw0=(u32x4){PKW(pB0,0),PKW(pB0,2),PKW(pB0,4),PKW(pB0,6)};pw1=(u32x4){PKW(pB0,8),PKW(pB0,10),PKW(pB0,12),PKW(pB0,14)};pw2=(u32x4){PKW(pB1,0),PKW(pB1,2),PKW(pB1,4),PKW(pB1,6)};pw3=(u32x4){PKW(pB1,8),PKW(pB1,10),PKW(pB1,12),PKW(pB1,14)};
    SBAR(); pv(o,vb0+2*sl_cur,PAF(0),PAF(1),PAF(2),PAF(3)); }
  #undef PKW
  #undef PAF
  #undef VFR
  #undef PIN
  #undef MX3
  #undef GAPA
  #undef GAPB
  #undef GAPB2
  #undef VRD2
  #undef EX
  #undef VRD
  #undef KRD
  #undef STEP
  #undef ENDW
  {auto rr=__builtin_amdgcn_permlane32_swap(__float_as_uint(l_reg),__float_as_uint(l_reg),false,false);l_reg=__uint_as_float(rr[0])+__uint_as_float(rr[1]);}
  if(hi==0)wsf[32+r32]=l_reg;asm volatile("s_waitcnt lgkmcnt(0)":::"memory");
  float rli[16];
  #pragma unroll
  for(int r=0;r<16;++r)rli[r]=__builtin_amdgcn_rcpf(wsf[32+crow(r,hi)]);
  bf16*Ow=O+(rowbase+q0+wid*QBLK)*DM+vcol;
  { bf16*stg=(bf16*)(shm+LDS_OST)+wid*2048;
    #pragma unroll
    for(int hf=0;hf<2;++hf){
    #pragma unroll
    for(int r=0;r<16;++r){const int orow=crow(r,hi);
      #pragma unroll
      for(int d0=0;d0<2;++d0)stg[orow*64+d0*32+r32]=__float2bfloat16(o[2*hf+d0][r]*rli[r]);}
    asm volatile("s_waitcnt lgkmcnt(0)":::"memory");
    #pragma unroll
    for(int i=0;i<4;++i){const int row=i*8+(lane>>3),ch=lane&7; const u32x4 v=*(const u32x4*)(stg+row*64+ch*8); ATTN_STORE16(Ow+(long)row*DM+hf*64+ch*8,v);}
    asm volatile("s_waitcnt lgkmcnt(0)":::"memory"); } }
  asm volatile("s_waitcnt lgkmcnt(0)\n\ts_barrier":::"memory");
  #undef DMA_K
  #undef DMA_V
  #undef CMASK
  #undef START
  #undef RESC
  #undef ROT
}
constexpr int ATTN_LDS_BYTES=LDS_BYTES;
struct AttnTensors { const bf16* Q; const bf16* K; const bf16* V; bf16* O; };
struct AttnUnit { int var; int qb; };
struct StaticOrder {
  int vcu;
  __device__ __forceinline__ explicit StaticOrder(int v):vcu(v){}
  __device__ __forceinline__ bool next(int i,AttnUnit&u)const{ if(i>=2)return false; const int s=vcu&31; u.var=vcu>>5; u.qb=(i==0)?s:63-s; return true; }
};
template<class Sched,int THRL=8> __device__ __forceinline__ void attn_phase(char*lds,const AttnTensors&T,const Sched&S){
  AttnUnit u;
  for(int i=0;S.next(i,u);++i){ const int h=u.var>>1,mp=u.var&1;
    attn_unit<THRL>(h*128+mp*64,h*128,u.qb,T.Q,T.K,T.V,T.O+(size_t)mp*SEQ*DM,lds); }
}
#undef SBAR
#undef WAIT_BAR
}


#define GAS __attribute__((address_space(1)))
#define LAS __attribute__((address_space(3)))
typedef unsigned short bf16;
typedef unsigned v4u __attribute__((ext_vector_type(4)));
typedef float f32x4 __attribute__((ext_vector_type(4)));
typedef short bf16x8 __attribute__((ext_vector_type(8)));
typedef GAS unsigned gu32;
typedef GAS unsigned long long gu64;
#define RLX_AGENT __ATOMIC_RELAXED, __HIP_MEMORY_SCOPE_AGENT
#define LDS_WAIT() asm volatile("s_waitcnt lgkmcnt(0)" ::: "memory")
#define VM_WAIT() asm volatile("s_waitcnt vmcnt(0)" ::: "memory")
__device__ __forceinline__ unsigned long long rt() { return __builtin_amdgcn_s_memrealtime(); }
__device__ __forceinline__ unsigned f2bf(float f) { unsigned u = __builtin_bit_cast(unsigned, f); return (u + 0x7fffu + ((u >> 16) & 1u)) >> 16; }
__device__ __forceinline__ unsigned pk2(float lo, float hi) { return f2bf(lo) | (f2bf(hi) << 16); }

#define XB_TMO      128
#define XB_XCNT(j)  (256  + 64 * (j))
#define XB_XSUB(j)  (1280 + 64 * (j))
#define XB_XGEN(j)  (2304 + 64 * (j))
#define XB_TOP      3328
#define XB_TOPGEN   3392
#define XCD_BAR_WORDS 3456
#define XB_SPIN_CAP (1u << 18)

__device__ __forceinline__ unsigned xb_ld(unsigned* p)              { return __hip_atomic_load(p, __ATOMIC_RELAXED, __HIP_MEMORY_SCOPE_AGENT); }
__device__ __forceinline__ unsigned xb_add(unsigned* p, unsigned v) { return __hip_atomic_fetch_add(p, v, __ATOMIC_RELAXED, __HIP_MEMORY_SCOPE_AGENT); }
__device__ __forceinline__ unsigned xb_xcc_id() { return (unsigned)__builtin_amdgcn_s_getreg((3 << 11) | 20) & 0xFu; }
#define XB_SPIN(cond, bar) do { unsigned _sp = 0; while (cond) { __builtin_amdgcn_s_sleep(1); \
    if ((++_sp & 255u) == 0u) { if (xb_ld(&(bar)[XB_TMO])) break; if (_sp > XB_SPIN_CAP) { atomicAdd(&(bar)[XB_TMO], 1u); break; } } } } while (0)

struct XcdBarrier {
    unsigned* bar; unsigned x;
    volatile LAS unsigned* st;
};

__device__ __forceinline__ XcdBarrier xcd_barrier_post(unsigned* bar, volatile LAS unsigned* st) {
    XcdBarrier b; b.bar = bar; b.x = xb_xcc_id(); b.st = st;
    if (threadIdx.x == 0) (void)xb_add(&bar[XB_XCNT(b.x)], 1u);
    return b;
}
__device__ __forceinline__ void xcd_barrier_complete(unsigned* bar, unsigned x, unsigned& nloc, unsigned& nx) {
    const unsigned G = gridDim.x * gridDim.y * gridDim.z;
    unsigned sum, cnt, mine, sp = 0u;
    for (;;) {
        sum = 0u; cnt = 0u; mine = 0u;
#pragma unroll
        for (unsigned j = 0; j < 16; ++j) { const unsigned c = xb_ld(&bar[XB_XCNT(j)]); sum += c; cnt += (c > 0u) ? 1u : 0u; mine = (j == x) ? c : mine; }
        if (sum == G) break;
        __builtin_amdgcn_s_sleep(1);
        if ((++sp & 255u) == 0u) { if (xb_ld(&bar[XB_TMO])) break; if (sp > XB_SPIN_CAP) { atomicAdd(&bar[XB_TMO], 1u); break; } }
    }
    nloc = mine > 0u ? mine : 1u; nx = cnt > 0u ? cnt : 1u;
}

__device__ __forceinline__ void xcd_barrier(const XcdBarrier& b) {
    asm volatile("s_waitcnt vmcnt(0)" ::: "memory");
    __syncthreads();
    if (threadIdx.x == 0) {
        unsigned* bar = b.bar;
        __builtin_amdgcn_s_waitcnt(0);
        unsigned nloc = b.st[0], nx = b.st[1];
        if (nloc == 0u) { xcd_barrier_complete(bar, b.x, nloc, nx); b.st[0] = nloc; b.st[1] = nx; }
        const unsigned old = xb_add(&bar[XB_XSUB(b.x)], 1u);
        const unsigned gen = old / nloc;
        if (old + 1u == (gen + 1u) * nloc) {
            __builtin_amdgcn_fence(__ATOMIC_RELEASE, "agent");
            asm volatile("s_waitcnt vmcnt(0)" ::: "memory");
            const unsigned og = xb_add(&bar[XB_TOP], 1u);
            const unsigned tg = og / nx;
            if (og + 1u == (tg + 1u) * nx) xb_add(&bar[XB_TOPGEN], 1u);
            else XB_SPIN(xb_ld(&bar[XB_TOPGEN]) == tg, bar);
            __builtin_amdgcn_fence(__ATOMIC_ACQUIRE, "agent");
            xb_add(&bar[XB_XGEN(b.x)], 1u);
            asm volatile("s_waitcnt vmcnt(0)" ::: "memory");
        } else {
            XB_SPIN(xb_ld(&bar[XB_XGEN(b.x)]) == gen, bar);
            __builtin_amdgcn_fence(__ATOMIC_ACQUIRE, "agent");
            asm volatile("s_waitcnt vmcnt(0)" ::: "memory");
        }
    }
    __syncthreads();
}

constexpr int NWAVES = 8;
constexpr int M = 16384, D = 1024, INC = 2560, AW = 512, LW = 512, NQ = 2048, NEXP = 16384;
constexpr float EPSN = 1e-6f;
constexpr size_t MiB = 1u << 20;
constexpr size_t WS_CTL = 0, CTL_ZERO_BYTES = 1 * MiB;
constexpr size_t WS_ROWSS2 = 512 * 1024;
constexpr size_t WS_RS1 = 1 * MiB;
constexpr size_t WS_SK1 = 1 * MiB + 128 * 1024, WS_SK2 = WS_SK1 + 32 * 1024;
constexpr size_t WS_WIN = 2 * MiB, WS_WOUT = 8 * MiB, WS_WQ = 10 * MiB;
constexpr size_t WS_ED = 16 * MiB, WS_EU = 48 * MiB;
constexpr size_t WS_SCD = 32 * MiB, WS_SCU = 33 * MiB;
constexpr size_t WS_WQ8 = 170 * MiB;
constexpr size_t WS_XB = 80 * MiB;
constexpr size_t WS_OS = 80 * MiB;
constexpr size_t WS_Q2 = 80 * MiB;
constexpr size_t WS_Q = 112 * MiB, WS_SPLIT = 16 * MiB;
constexpr size_t WS_GATE = WS_Q + 4 * WS_SPLIT;
constexpr size_t WS_EID = 144 * MiB, WS_GW = 152 * MiB;
constexpr size_t WS_MIX = 192 * MiB, WS_HB = 224 * MiB, WS_END = 256 * MiB;
constexpr size_t WS_ROWSS3 = 576 * 1024;
constexpr size_t WS_DOTP = 80 * MiB;
constexpr size_t WS_REC = 160 * MiB, WS_N0 = 168 * MiB;
constexpr size_t WS_PEER = 80 * MiB;
constexpr size_t WS_REC_OLD_UNUSED = 0;
constexpr int CW_BAR = 4096;
constexpr int RING_OFF = 0, RING_BYTES = 131072;
constexpr int LDSCTL_OFF = RING_BYTES, MISC_OFF = LDSCTL_OFF + 320;
constexpr int LDS_BYTES = 163840;

struct Frame {
    LAS unsigned char* lds;
    volatile LAS unsigned* MISC;
    int tid, lane, wave;
    int vcu, G;
};

__device__ __forceinline__ float wave_sum(float v) {
#pragma unroll
    for (int o = 1; o < 64; o <<= 1) v += __shfl_xor(v, o);
    return v;
}
__device__ __forceinline__ float bf2f(unsigned short b) { return __builtin_bit_cast(float, (unsigned)b << 16); }
__device__ __forceinline__ float bflo(unsigned w) { return __builtin_bit_cast(float, w << 16); }
__device__ __forceinline__ float bfhi(unsigned w) { return __builtin_bit_cast(float, w & 0xffff0000u); }
__device__ __forceinline__ float gelu_tanh(float x) { const float u = 0.7978845608028654f * (x + 0.044715f * x * x * x); return 0.5f * x * (1.0f + tanhf(u)); }
__device__ __forceinline__ float sigmoidf_(float x) { return 1.0f / (1.0f + expf(-x)); }
__device__ __forceinline__ float fsigmoid(float x) { return __builtin_amdgcn_rcpf(1.0f + __builtin_amdgcn_exp2f(-1.4426950408889634f * x)); }
__device__ __forceinline__ float fgelu_tanh(float x) { const float u = 0.7978845608028654f * (x + 0.044715f * x * x * x); const float t = 1.0f - 2.0f * __builtin_amdgcn_rcpf(1.0f + __builtin_amdgcn_exp2f(2.8853900817779268f * u)); return 0.5f * x * (1.0f + t); }

__device__ __forceinline__ void p0_transpose_item(const float* W, int K, int N, bf16* WT, const float* gk, LAS float* scr, int item, int lane) {
    const int nblk = N / 32, kb = item / nblk, nb = item % nblk, k0 = 64 * kb, n0 = 32 * nb;
    float wv[32];
#pragma unroll
    for (int i = 0; i < 32; ++i) { const int kk = 2 * i + (lane >> 5); wv[i] = W[(size_t)(k0 + kk) * N + n0 + (lane & 31)]; }
#pragma unroll
    for (int i = 0; i < 32; ++i) { const int kk = 2 * i + (lane >> 5); const float g = gk ? gk[k0 + kk] : 1.0f; scr[kk * 33 + (lane & 31)] = wv[i] * g; }
    LDS_WAIT(); asm volatile("" ::: "memory");
    const int c = lane & 7;
#pragma unroll
    for (int j = 0; j < 4; ++j) { const int n = (lane >> 3) + 8 * j; const LAS float* s = scr + (8 * c) * 33 + n;
        v4u o; o.x = pk2(s[0 * 33], s[1 * 33]); o.y = pk2(s[2 * 33], s[3 * 33]); o.z = pk2(s[4 * 33], s[5 * 33]); o.w = pk2(s[6 * 33], s[7 * 33]);
        *(GAS v4u*)(WT + (size_t)(n0 + n) * K + k0 + 8 * c) = o; }
    LDS_WAIT(); asm volatile("" ::: "memory");
}
template <int NR> __device__ __forceinline__ void p0_rows(const float* xrow, bf16* orow, const float* gk, float* rs, int lane) {
    f32x4 v[NR][4];
#pragma unroll
    for (int i = 0; i < NR; ++i)
#pragma unroll
        for (int j = 0; j < 4; ++j) v[i][j] = __builtin_nontemporal_load((const GAS f32x4*)(xrow + (size_t)i * 1024) + lane + 64 * j);
#pragma unroll
    for (int i = 0; i < NR; ++i) {
        if (rs) { float s = 0.f;
#pragma unroll
            for (int j = 0; j < 4; ++j) s += (v[i][j].x * v[i][j].x + v[i][j].y * v[i][j].y) + (v[i][j].z * v[i][j].z + v[i][j].w * v[i][j].w);
            const float tot = wave_sum(s); if (lane == 0) rs[i] = 1.0f / sqrtf(tot * (1.0f / 1024.0f) + EPSN); }
        if (gk) {
#pragma unroll
            for (int j = 0; j < 4; ++j) v[i][j] = v[i][j] * ((const GAS f32x4*)gk)[lane + 64 * j]; }
        GAS unsigned long long* o8 = (GAS unsigned long long*)(orow + (size_t)i * 1024) + lane;
#pragma unroll
        for (int j = 0; j < 4; ++j) o8[64 * j] = (unsigned long long)pk2(v[i][j].x, v[i][j].y) | ((unsigned long long)pk2(v[i][j].z, v[i][j].w) << 32);
    }
}

struct Args { const float* in[23]; float* out; unsigned char* ws; int ph_lo, ph_hi; };

__device__ __forceinline__ void p0_prologue(Frame& F, const Args& a) {
    LAS float* scr = (LAS float*)(F.lds + RING_OFF + F.wave * 16384);
    unsigned char* ws = a.ws;
    const int gw = F.vcu * NWAVES + F.wave, NGW = F.G * NWAVES;
    constexpr int I_IN = (D / 64) * (INC / 32), I_OUT = (D / 64) * (D / 32), I_Q = (D / 64) * (NQ / 32);
    constexpr int NITEMS = I_IN + I_OUT + I_Q;
    for (int it = F.wave * (int)F.G + F.vcu; it < NITEMS; it += NGW) {
        int r = it;
        if (r < I_IN) { p0_transpose_item(a.in[2], D, INC, (bf16*)(ws + WS_WIN), a.in[1], scr, r, F.lane); continue; } r -= I_IN;
        if (r < I_OUT) { p0_transpose_item(a.in[15], D, D, (bf16*)(ws + WS_WOUT), nullptr, scr, r, F.lane); continue; } r -= I_OUT;
        p0_transpose_item(a.in[17], D, NQ, (bf16*)(ws + WS_WQ), a.in[16], scr, r, F.lane);
    }
    for (int m = gw; m < M / 8; m += NGW) { const int r = 8 * m; p0_rows<8>(a.in[0] + (size_t)r * D, (bf16*)(ws + WS_XB) + (size_t)r * D, nullptr, (float*)(ws + WS_RS1) + r, F.lane); }
    for (int m = F.wave * (int)F.G + F.vcu; m < 8; m += NGW) { const int r = 4 * m;
        if (r < 16) p0_rows<4>(a.in[18] + (size_t)r * 1024, (bf16*)(ws + WS_SK1) + (size_t)r * 1024, nullptr, nullptr, F.lane);
        else        p0_rows<4>(a.in[19] + (size_t)(r - 16) * 1024, (bf16*)(ws + WS_SK2) + (size_t)(r - 16) * 1024, nullptr, nullptr, F.lane); }
}
template <int NR> __device__ __forceinline__ void q8_load(f32x4 (&v)[NR][4], const float* xrow, int lane) {
#pragma unroll
    for (int i = 0; i < NR; ++i)
#pragma unroll
        for (int j = 0; j < 4; ++j) v[i][j] = __builtin_nontemporal_load((const GAS f32x4*)(xrow + (size_t)i * 1024) + lane + 64 * j);
}
template <int NR> __device__ __forceinline__ void q8_finish(f32x4 (&v)[NR][4], unsigned char* orow, const float* gk, float* scale, int lane) {
#pragma unroll
    for (int i = 0; i < NR; ++i) {
        float am = 0.f;
#pragma unroll
        for (int j = 0; j < 4; ++j) { if (gk) v[i][j] = v[i][j] * ((const GAS f32x4*)gk)[lane + 64 * j];
            am = fmaxf(fmaxf(am, fmaxf(fabsf(v[i][j].x), fabsf(v[i][j].y))), fmaxf(fabsf(v[i][j].z), fabsf(v[i][j].w))); }
#pragma unroll
        for (int o = 1; o < 64; o <<= 1) am = fmaxf(am, __shfl_xor(am, o));
        const float sc = (am > 0.f) ? am * (1.0f / 127.0f) : 1.0f, inv = 1.0f / sc;
        if (lane == 0) scale[i] = sc;
        GAS unsigned* o4 = (GAS unsigned*)(orow + (size_t)i * 1024) + lane;
#pragma unroll
        for (int j = 0; j < 4; ++j) { const int q0 = (int)__builtin_rintf(v[i][j].x * inv), q1 = (int)__builtin_rintf(v[i][j].y * inv), q2 = (int)__builtin_rintf(v[i][j].z * inv), q3 = (int)__builtin_rintf(v[i][j].w * inv);
            o4[64 * j] = ((unsigned)q0 & 255u) | (((unsigned)q1 & 255u) << 8) | (((unsigned)q2 & 255u) << 16) | ((unsigned)q3 << 24); }
    }
}
__device__ __forceinline__ const float* cvx_src(const Args& a, int m) { const int r = 4 * m; return (r < NEXP) ? a.in[20] + (size_t)r * D : a.in[21] + (size_t)(r - NEXP) * D; }
__device__ __forceinline__ void cvx_finish(const Args& a, f32x4 (&v)[4][4], int m, int lane) {
    unsigned char* ws = a.ws; const int r = 4 * m;
    if (r < NEXP) q8_finish<4>(v, ws + WS_ED + (size_t)r * D, a.in[16], (float*)(ws + WS_SCD) + r, lane);
    else          q8_finish<4>(v, ws + WS_EU + (size_t)(r - NEXP) * D, nullptr, (float*)(ws + WS_SCU) + (r - NEXP), lane);
}
__device__ __forceinline__ void convert_experts(const Args& a, int w, int nw, int lane) {
    constexpr int TOT = NEXP / 4;
    int m = w; if (m >= TOT) return;
    f32x4 va[4][4], vb[4][4];
    q8_load<4>(va, cvx_src(a, m), lane);
    for (;;) {
        const bool hb = m + nw < TOT; if (hb) q8_load<4>(vb, cvx_src(a, m + nw), lane);
        cvx_finish(a, va, m, lane);
        if (!hb) break;
        const bool ha = m + 2 * nw < TOT; if (ha) q8_load<4>(va, cvx_src(a, m + 2 * nw), lane);
        cvx_finish(a, vb, m + nw, lane);
        if (!ha) break;
        m += 2 * nw;
    }
}

typedef float f32x16 __attribute__((ext_vector_type(16)));
__device__ __forceinline__ void lru_local_unit(Frame& F, const Args& a, int c) {
    constexpr int YP = 520;
    LAS unsigned short* Y = (LAS unsigned short*)(F.lds + RING_OFF);
    const int e = F.tid, r0 = c * 64;
    const bf16* XR = (const bf16*)(a.ws + WS_Q + 3 * WS_SPLIT);
    unsigned* HLAC = (unsigned*)a.out;
    float* CH = a.out + (size_t)M * 512; float* CA = CH + (size_t)(M / 64) * 512;
    { const float* conv_w = a.in[8]; const float cw0 = conv_w[e], cw1 = conv_w[512 + e], cw2 = conv_w[1024 + e], cw3 = conv_w[1536 + e], cb = a.in[9][e];
      float x0 = 0.f, x1 = 0.f, x2 = 0.f;
      if (c > 0) { x0 = bf2f(XR[(size_t)(r0 - 3) * 512 + e]); x1 = bf2f(XR[(size_t)(r0 - 2) * 512 + e]); x2 = bf2f(XR[(size_t)(r0 - 1) * 512 + e]); }
#pragma unroll 8
      for (int t = 0; t < 64; ++t) { const float x3 = bf2f(XR[(size_t)(r0 + t) * 512 + e]); Y[t * YP + e] = (unsigned short)f2bf(cb + x0 * cw0 + x1 * cw1 + x2 * cw2 + x3 * cw3); x0 = x1; x1 = x2; x2 = x3; } }
    __syncthreads();
    const int n = F.wave, lane = F.lane, r32 = lane & 31, hi = lane >> 5;
#pragma unroll 1
    for (int et = 0; et < 2; ++et) {
        bf16x8 wf[2][4];
#pragma unroll
        for (int gt = 0; gt < 2; ++gt) { const float* w = a.in[gt ? 12 : 10] + n * 4096 + 32 * et; asm volatile("" : "+s"(w));
#pragma unroll
            for (int ks = 0; ks < 4; ++ks) { float f[8];
#pragma unroll
                for (int j = 0; j < 8; ++j) f[j] = w[(16 * ks + 8 * hi + j) * 64 + r32];
                wf[gt][ks] = __builtin_bit_cast(bf16x8, (v4u){pk2(f[0], f[1]), pk2(f[2], f[3]), pk2(f[4], f[5]), pk2(f[6], f[7])}); asm volatile("" ::: "memory"); } }
        const int ch = 64 * n + 32 * et + r32;
        const float ba = a.in[11][ch], bx = a.in[13][ch], lam = a.in[14][ch];
        const float sp = (lam > 15.f) ? expf(-lam) : log1pf(expf(-lam));
        float av[2][16], bv[2][16];
#pragma unroll
        for (int tt = 0; tt < 2; ++tt) {
            f32x16 ra = {}, ia = {};
#pragma unroll
            for (int ks = 0; ks < 4; ++ks) { const bf16x8 af = *(const LAS bf16x8*)(Y + (32 * tt + r32) * YP + 64 * n + 16 * ks + 8 * hi);
                ra = __builtin_amdgcn_mfma_f32_32x32x16_bf16(af, wf[0][ks], ra, 0, 0, 0); ia = __builtin_amdgcn_mfma_f32_32x32x16_bf16(af, wf[1][ks], ia, 0, 0, 0); }
#pragma unroll
            for (int r = 0; r < 16; ++r) { const int t = 32 * tt + (r & 3) + 8 * (r >> 2) + 4 * hi;
                const float rr = fsigmoid(ra[r] + ba), ii = fsigmoid(ia[r] + bx);
                const float log_a = -8.0f * rr * sp, aa = __builtin_amdgcn_exp2f(log_a * 1.4426950408889634f);
                const float u2 = 2.0f * log_a;
                const float ser = -u2 * (1.0f + u2 * (0.5f + u2 * (0.16666667f + u2 * (0.041666668f + u2 * 0.0083333338f))));
                const float om = (u2 > -0.1f) ? ser : (1.0f - aa * aa);
                const float mult = __builtin_amdgcn_sqrtf(fmaxf(om, 1e-12f));
                av[tt][r] = aa; bv[tt][r] = mult * (ii * bf2f(Y[t * YP + ch])); }
        }
#pragma unroll
        for (int tt = 0; tt < 2; ++tt)
#pragma unroll
            for (int rq = 0; rq < 4; ++rq) { float h = 0.f, pa = 1.f;
#pragma unroll
                for (int k = 0; k < 4; ++k) { const int r = 4 * rq + k; h = av[tt][r] * h + bv[tt][r]; pa *= av[tt][r]; bv[tt][r] = h; av[tt][r] = pa; } }
        float hin[8], ain[8]; float hc = 0.f, ac = 1.f;
#pragma unroll
        for (int j = 0; j < 8; ++j) { const int tt = j >> 2, r3 = 4 * (j & 3) + 3;
#pragma unroll
            for (int own = 0; own < 2; ++own) {
                if (hi == own) { hin[j] = hc; ain[j] = ac; }
                const float mh = av[tt][r3] * hc + bv[tt][r3], ma = ac * av[tt][r3];
                const float oh = __shfl_xor(mh, 32), oa = __shfl_xor(ma, 32);
                hc = (hi == own) ? mh : oh; ac = (hi == own) ? ma : oa; } }
#pragma unroll
        for (int tt = 0; tt < 2; ++tt)
            { unsigned ob = (unsigned)((r0 + 32 * tt + 4 * hi) * 512 + ch); asm volatile("" : "+v"(ob));
#pragma unroll
            for (int r = 0; r < 16; ++r) { const int j = 4 * tt + (r >> 2); const unsigned o = ob + (unsigned)(((r & 3) + 8 * (r >> 2)) * 512);
                const float hl = bv[tt][r] + av[tt][r] * hin[j], ac = av[tt][r] * ain[j];
                HLAC[o] = pk2(hl, ac);
                if (tt == 1 && r == 15 && hi == 1) { CH[c * 512 + ch] = hl; CA[c * 512 + ch] = ac; } } }
    }
    __syncthreads();
}

__device__ __forceinline__ void fix_unit(Frame& F, const Args& a, int c, float lamv) {
    const int r0 = c * 64;
    const unsigned* HLAC = (const unsigned*)a.out; const float* CH = a.out + (size_t)M * 512; const float* CA = CH + (size_t)(M / 64) * 512;
    const bf16* GATE = (const bf16*)(a.ws + WS_GATE);
    bf16* MIX = (bf16*)(a.ws + WS_MIX);
    const int g4 = F.tid & 127, sgm = F.tid >> 7;
    LAS f32x4* SA = (LAS f32x4*)(F.lds + RING_OFF); LAS f32x4* SH = SA + 512;
    { const int L = (c + 3) >> 2; const int lo_c = sgm * L; int hi_c = lo_c + L; if (hi_c > c) hi_c = c;
      f32x4 A4 = (f32x4){1.f, 1.f, 1.f, 1.f}, H4 = (f32x4){0.f, 0.f, 0.f, 0.f};
      int cc = lo_c;
      for (; cc + 8 <= hi_c; cc += 8) { f32x4 av[8], hv[8];
#pragma unroll
          for (int k = 0; k < 8; ++k) { const size_t o = (size_t)(cc + k) * 512 + 4 * g4; av[k] = *(const GAS f32x4*)(CA + o); hv[k] = *(const GAS f32x4*)(CH + o); }
#pragma unroll
          for (int k = 0; k < 8; ++k) { H4 = av[k] * H4 + hv[k]; A4 = A4 * av[k]; } }
      for (; cc < hi_c; ++cc) { const size_t o = (size_t)cc * 512 + 4 * g4; const f32x4 av = *(const GAS f32x4*)(CA + o), hv = *(const GAS f32x4*)(CH + o); H4 = av * H4 + hv; A4 = A4 * av; }
      SA[sgm * 128 + g4] = A4; SH[sgm * 128 + g4] = H4; }
    __syncthreads();
    f32x4 hin = (f32x4){0.f, 0.f, 0.f, 0.f};
#pragma unroll
    for (int sq = 0; sq < 4; ++sq) hin = SA[sq * 128 + g4] * hin + SH[sq * 128 + g4];
    __syncthreads();
#pragma unroll 4
    for (int t = sgm * 16; t < sgm * 16 + 16; ++t) { const size_t o = (size_t)(r0 + t) * 512 + 4 * g4;
        const v4u ha = *(const GAS v4u*)(HLAC + o);
        const f32x4 h = (f32x4){bflo(ha.x), bflo(ha.y), bflo(ha.z), bflo(ha.w)} + (f32x4){bfhi(ha.x), bfhi(ha.y), bfhi(ha.z), bfhi(ha.w)} * hin; const unsigned long long gw = *(const GAS unsigned long long*)(GATE + o);
        const unsigned glo = (unsigned)gw, ghi = (unsigned)(gw >> 32);
        const unsigned long long ov = (unsigned long long)pk2(h.x * fgelu_tanh(bflo(glo)), h.y * fgelu_tanh(bfhi(glo))) | ((unsigned long long)pk2(h.z * fgelu_tanh(bflo(ghi)), h.w * fgelu_tanh(bfhi(ghi))) << 32);
        *(GAS unsigned long long*)(MIX + (size_t)(r0 + t) * 1024 + 512 + 4 * g4) = ov; }
    const bf16* OS0 = (const bf16*)(a.ws + WS_OS); const bf16* OS1 = OS0 + (size_t)M * 512;
    const float* sg = a.in[7] + (F.lane & 15) * 8;
    float sgv[8];
#pragma unroll
    for (int j = 0; j < 8; ++j) sgv[j] = sg[j] * 0.8f;
#pragma unroll 2
    for (int rr = 0; rr < 8; ++rr) { const size_t row = (size_t)(r0 + 8 * F.wave + rr);
        const v4u p = *(const GAS v4u*)(OS0 + row * 512 + F.lane * 8), q = *(const GAS v4u*)(OS1 + row * 512 + F.lane * 8);
        float d[8];
        d[0] = bflo(p.x) - lamv * bflo(q.x); d[1] = bfhi(p.x) - lamv * bfhi(q.x); d[2] = bflo(p.y) - lamv * bflo(q.y); d[3] = bfhi(p.y) - lamv * bfhi(q.y);
        d[4] = bflo(p.z) - lamv * bflo(q.z); d[5] = bfhi(p.z) - lamv * bfhi(q.z); d[6] = bflo(p.w) - lamv * bflo(q.w); d[7] = bfhi(p.w) - lamv * bfhi(q.w);
        float ss = 0.f;
#pragma unroll
        for (int j = 0; j < 8; ++j) ss += d[j] * d[j];
        ss += __shfl_xor(ss, 1); ss += __shfl_xor(ss, 2); ss += __shfl_xor(ss, 4); ss += __shfl_xor(ss, 8);
        const float ri = 1.0f / sqrtf(ss * (1.0f / 128.0f) + EPSN);
        v4u o; o.x = pk2(d[0] * ri * sgv[0], d[1] * ri * sgv[1]); o.y = pk2(d[2] * ri * sgv[2], d[3] * ri * sgv[3]);
        o.z = pk2(d[4] * ri * sgv[4], d[5] * ri * sgv[5]); o.w = pk2(d[6] * ri * sgv[6], d[7] * ri * sgv[7]);
        *(GAS v4u*)(MIX + row * 1024 + F.lane * 8) = o; }
}

typedef float f32x16 __attribute__((ext_vector_type(16)));
#define CEX(a, b) do { const float _hi = fmaxf(a, b), _lo = fminf(a, b); a = _hi; b = _lo; } while (0)
__device__ __forceinline__ int skey(int b) { return b ^ ((b >> 31) & 0x7fffffff); }
#define CEI(a, b) do { const int _hi = max(a, b), _lo = min(a, b); a = _hi; b = _lo; } while (0)
__device__ __forceinline__ void sort16_desc(int (&v)[16]) {
#pragma unroll
    for (int k = 2; k <= 16; k <<= 1)
#pragma unroll
        for (int j = k >> 1; j >= 1; j >>= 1)
#pragma unroll
            for (int i = 0; i < 16; ++i) { const int l = i ^ j; if (l > i) { if ((i & k) == 0) CEI(v[i], v[l]); else CEI(v[l], v[i]); } }
}
__device__ __forceinline__ void merge16_desc(int (&a)[16], const int (&b)[16]) {
#pragma unroll
    for (int i = 0; i < 16; ++i) a[i] = max(a[i], b[15 - i]);
#pragma unroll
    for (int j = 8; j >= 1; j >>= 1)
#pragma unroll
        for (int i = 0; i < 16; ++i) if ((i & j) == 0) CEI(a[i], a[i + j]);
}
__device__ __forceinline__ void top16_half(int (&top)[16], const bf16* q, const LAS unsigned char* sk, int r32, int hi) {
    bf16x8 qf[8];
#pragma unroll
    for (int ks = 0; ks < 8; ++ks) qf[ks] = *(const GAS bf16x8*)(q + 16 * ks + 8 * hi);
#pragma unroll
    for (int i = 0; i < 16; ++i) top[i] = (int)0x80000000;
#pragma unroll 1
    for (int kt = 0; kt < 4; ++kt) {
        f32x16 acc = {};
#pragma unroll
        for (int ks = 0; ks < 8; ++ks) { const bf16x8 kf = *(const LAS bf16x8*)(sk + (32 * kt + r32) * 272 + (16 * ks + 8 * hi) * 2); acc = __builtin_amdgcn_mfma_f32_32x32x16_bf16(kf, qf[ks], acc, 0, 0, 0); }
        int grp[16];
#pragma unroll
        for (int r = 0; r < 16; ++r) { const int idx = 32 * kt + (r & 3) + 8 * (r >> 2) + 4 * hi; const float av = acc[r];
            grp[r] = (skey(__float_as_int(av)) & ~127) | idx; }
        sort16_desc(grp); merge16_desc(top, grp);
    }
    int oth[16];
#pragma unroll
    for (int i = 0; i < 16; ++i) oth[i] = __shfl_xor(top[i], 32);
    merge16_desc(top, oth);
}
__device__ __forceinline__ void route_unit(const Args& a, int g, int hd, int lane, LAS unsigned char* slot, const LAS unsigned char* skl, int* EIDo, float* GWo) {
    const int r32 = lane & 31, hi = lane >> 5; const int t = g * 32 + r32;
    const bf16* q = (const bf16*)(a.ws + WS_Q2) + (size_t)t * NQ + hd * 256;
    int k1[16], k2[16];
    top16_half(k1, q, skl, r32, hi);
    top16_half(k2, q + 128, skl + 128 * 272, r32, hi);
    { v4u w1, w2;
#define IDX4(v, j) (((unsigned)v[4 * (j)] & 127u) | (((unsigned)v[4 * (j) + 1] & 127u) << 8) | (((unsigned)v[4 * (j) + 2] & 127u) << 16) | (((unsigned)v[4 * (j) + 3] & 127u) << 24))
      w1 = (v4u){IDX4(k1, 0), IDX4(k1, 1), IDX4(k1, 2), IDX4(k1, 3)}; w2 = (v4u){IDX4(k2, 0), IDX4(k2, 1), IDX4(k2, 2), IDX4(k2, 3)};
#undef IDX4
      *(LAS v4u*)(slot) = w1; *(LAS v4u*)(slot + 16) = w2; }
    float v1[16], v2[16];
#pragma unroll
    for (int i = 0; i < 16; ++i) { v1[i] = __int_as_float(skey(k1[i])); v2[i] = __int_as_float(skey(k2[i])); }
#define CKEY(ia, ib) ((skey(__float_as_int(v1[ia] + v2[ib])) & ~255) | ((ia) * 16 + (ib)))
    int K[16], G1[16], G2[16];
#pragma unroll
    for (int i = 0; i < 16; ++i) K[i] = CKEY(0, i);
    { int n_ = 0;
#pragma unroll
      for (int ia = 1; ia < 16; ++ia)
#pragma unroll
          for (int ib = 0; ib < 16; ++ib) if ((ia + 1) * (ib + 1) <= 16) { const int kk = CKEY(ia, ib); if (n_ < 16) G1[n_] = kk; else if (n_ < 32) G2[n_ - 16] = kk; ++n_; }
    }
    sort16_desc(G1); merge16_desc(K, G1);
    sort16_desc(G2); merge16_desc(K, G2);
    { int x0 = CKEY(14, 0), x1 = CKEY(15, 0);
#pragma unroll
      for (int i = 0; i < 16; ++i) { CEI(K[i], x0); }
#pragma unroll
      for (int i = 0; i < 16; ++i) { CEI(K[i], x1); }
    }
#undef CKEY
    unsigned P[16]; float sc[16];
#pragma unroll
    for (int i = 0; i < 16; ++i) { const unsigned ci = (unsigned)K[i] & 255u; const unsigned i1 = slot[ci >> 4], i2 = slot[16 + (ci & 15u)]; P[i] = i1 * 128u + i2; sc[i] = __int_as_float(skey(K[i] & ~255)); }
    float ex[16], sum = 0.f;
#pragma unroll
    for (int i = 0; i < 16; ++i) { ex[i] = expf(sc[i] - sc[0]); sum += ex[i]; }
    const float inv = 1.0f / sum;
    if (hi == 0) {
        GAS v4u* eo = (GAS v4u*)(EIDo + (size_t)t * 128 + hd * 16); GAS f32x4* go = (GAS f32x4*)(GWo + (size_t)t * 128 + hd * 16);
#pragma unroll
        for (int j = 0; j < 4; ++j) { eo[j] = (v4u){P[4 * j], P[4 * j + 1], P[4 * j + 2], P[4 * j + 3]}; go[j] = (f32x4){ex[4 * j] * inv, ex[4 * j + 1] * inv, ex[4 * j + 2] * inv, ex[4 * j + 3] * inv}; }
    }
}

__device__ __forceinline__ float wave_max(float v) {
#pragma unroll
    for (int o = 1; o < 64; o <<= 1) v = fmaxf(v, __shfl_xor(v, o));
    return v;
}
__device__ __forceinline__ void route_unit_ref(const Args& a, int t, int hd, int lane, LAS float* sc) {
    LAS unsigned* sci = (LAS unsigned*)sc;
    const bf16* q = (const bf16*)(a.ws + WS_Q2) + (size_t)t * NQ + hd * 256;
#pragma unroll 1
    for (int half = 0; half < 2; ++half) {
        const float* sk = a.in[18 + half];
        float sa = 0.f, sb = 0.f;
        for (int d = 0; d < 128; ++d) { const float qv = bf2f(q[half * 128 + d]); sa += qv * sk[lane * 128 + d]; sb += qv * sk[(lane + 64) * 128 + d]; }
        for (int r = 0; r < 16; ++r) {
            const float mx = wave_max(fmaxf(sa, sb));
            const unsigned long long ba = __ballot(sa == mx), bb = __ballot(sb == mx);
            int key;
            if (ba) { const int ln = __ffsll((long long)ba) - 1; key = ln; if (lane == ln) sa = -INFINITY; }
            else { const int ln = __ffsll((long long)bb) - 1; key = ln + 64; if (lane == ln) sb = -INFINITY; }
            if (lane == 0) { sc[half * 32 + r] = mx; sci[half * 32 + 16 + r] = (unsigned)key; }
        }
    }
    __builtin_amdgcn_s_waitcnt(0);
    const int ca = lane >> 2, cb0 = (lane & 3) * 4;
    float c[4];
#pragma unroll
    for (int j = 0; j < 4; ++j) c[j] = sc[ca] + sc[32 + cb0 + j];
    for (int r = 0; r < 16; ++r) {
        const float mx = wave_max(fmaxf(fmaxf(c[0], c[1]), fmaxf(c[2], c[3])));
        const bool mine = (c[0] == mx) || (c[1] == mx) || (c[2] == mx) || (c[3] == mx);
        const unsigned long long bm = __ballot(mine); const int ln = __ffsll((long long)bm) - 1;
        if (lane == ln) { int j = (c[0] == mx) ? 0 : (c[1] == mx) ? 1 : (c[2] == mx) ? 2 : 3;
            if (j == 0) c[0] = -INFINITY; else if (j == 1) c[1] = -INFINITY; else if (j == 2) c[2] = -INFINITY; else c[3] = -INFINITY;
            sc[64 + r] = mx; sci[80 + r] = sci[16 + ca] * 128u + sci[48 + cb0 + j]; }
    }
    __builtin_amdgcn_s_waitcnt(0);
    if (lane < 16) {
        const float mx0 = sc[64]; const float ex = expf(sc[64 + lane] - mx0); float sum = ex;
        sum += __shfl_xor(sum, 1); sum += __shfl_xor(sum, 2); sum += __shfl_xor(sum, 4); sum += __shfl_xor(sum, 8);
        ((int*)(a.ws + WS_EID))[(size_t)t * 128 + hd * 16 + lane] = (int)sci[80 + lane];
        ((float*)(a.ws + WS_GW))[(size_t)t * 128 + hd * 16 + lane] = ex / sum;
    }
    __builtin_amdgcn_s_waitcnt(0);
}

__device__ __forceinline__ void unpack8(const v4u w, float* f) { f[0] = bflo(w.x); f[1] = bfhi(w.x); f[2] = bflo(w.y); f[3] = bfhi(w.y); f[4] = bflo(w.z); f[5] = bfhi(w.z); f[6] = bflo(w.w); f[7] = bfhi(w.w); }
__device__ __forceinline__ void gather_token(const Args& a, int t, int lane, float* dst) {
    const bf16* HB = (const bf16*)(a.ws + WS_HB) + (size_t)t * D; const bf16* ED = (const bf16*)(a.ws + WS_ED); const bf16* EU = (const bf16*)(a.ws + WS_EU);
    float hx[16];
    unpack8(*(const GAS v4u*)(HB + lane * 8), hx); unpack8(*(const GAS v4u*)(HB + 512 + lane * 8), hx + 8);
    const float rs2 = 1.0f / sqrtf(((const float*)(a.ws + WS_ROWSS2))[t] * (1.0f / 1024.0f) + EPSN);
    const int* EID = (const int*)(a.ws + WS_EID) + (size_t)t * 128; const float* GW = (const float*)(a.ws + WS_GW) + (size_t)t * 128;
    const int e0 = EID[lane], e1 = EID[64 + lane]; const float g0 = GW[lane], g1 = GW[64 + lane];
    float acc[16];
#pragma unroll
    for (int i = 0; i < 16; ++i) acc[i] = 0.f;
#pragma unroll 1
    for (int j = 0; j < 128; j += 4) {
        int ee[4]; float gg[4], dt[4];
#pragma unroll
        for (int k = 0; k < 4; ++k) { const int jj = j + k; ee[k] = __shfl(jj < 64 ? e0 : e1, jj & 63); gg[k] = __shfl(jj < 64 ? g0 : g1, jj & 63); }
        v4u da[4], db[4];
#pragma unroll
        for (int k = 0; k < 4; ++k) { const bf16* r = ED + (size_t)ee[k] * D; da[k] = *(const GAS v4u*)(r + lane * 8); db[k] = *(const GAS v4u*)(r + 512 + lane * 8); }
#pragma unroll
        for (int k = 0; k < 4; ++k) { float f[16]; unpack8(da[k], f); unpack8(db[k], f + 8); float s = 0.f;
#pragma unroll
            for (int i = 0; i < 16; ++i) s += f[i] * hx[i];
            dt[k] = s; }
#pragma unroll
        for (int o = 1; o < 64; o <<= 1) {
#pragma unroll
            for (int k = 0; k < 4; ++k) dt[k] += __shfl_xor(dt[k], o); }
#pragma unroll
        for (int k = 0; k < 4; ++k) { const bf16* r = EU + (size_t)ee[k] * D; da[k] = *(const GAS v4u*)(r + lane * 8); db[k] = *(const GAS v4u*)(r + 512 + lane * 8); }
#pragma unroll
        for (int k = 0; k < 4; ++k) { const float w = gg[k] * gelu_tanh(dt[k] * rs2); float f[16]; unpack8(da[k], f); unpack8(db[k], f + 8);
#pragma unroll
            for (int i = 0; i < 16; ++i) acc[i] += w * f[i]; }
    }
    const float* orow = a.out + (size_t)t * D; float* drow = dst + (size_t)t * D; const float* gf = a.in[22];
    f32x4 h0 = *(const GAS f32x4*)(orow + lane * 8), h1 = *(const GAS f32x4*)(orow + lane * 8 + 4), h2 = *(const GAS f32x4*)(orow + 512 + lane * 8), h3 = *(const GAS f32x4*)(orow + 512 + lane * 8 + 4);
    h0 += (f32x4){acc[0], acc[1], acc[2], acc[3]}; h1 += (f32x4){acc[4], acc[5], acc[6], acc[7]}; h2 += (f32x4){acc[8], acc[9], acc[10], acc[11]}; h3 += (f32x4){acc[12], acc[13], acc[14], acc[15]};
    float ss = (h0.x * h0.x + h0.y * h0.y) + (h0.z * h0.z + h0.w * h0.w) + (h1.x * h1.x + h1.y * h1.y) + (h1.z * h1.z + h1.w * h1.w)
             + (h2.x * h2.x + h2.y * h2.y) + (h2.z * h2.z + h2.w * h2.w) + (h3.x * h3.x + h3.y * h3.y) + (h3.z * h3.z + h3.w * h3.w);
    ss = wave_sum(ss);
    const float ri = 1.0f / sqrtf(ss * (1.0f / 1024.0f) + EPSN);
    const f32x4 f0 = *(const GAS f32x4*)(gf + lane * 8), f1 = *(const GAS f32x4*)(gf + lane * 8 + 4), f2 = *(const GAS f32x4*)(gf + 512 + lane * 8), f3 = *(const GAS f32x4*)(gf + 512 + lane * 8 + 4);
    *(GAS f32x4*)(drow + lane * 8) = h0 * ri * f0; *(GAS f32x4*)(drow + lane * 8 + 4) = h1 * ri * f1;
    *(GAS f32x4*)(drow + 512 + lane * 8) = h2 * ri * f2; *(GAS f32x4*)(drow + 512 + lane * 8 + 4) = h3 * ri * f3;
}


template <int CTRL> __device__ __forceinline__ float dpp_add(float v) { return v + __int_as_float(__builtin_amdgcn_update_dpp(0, __float_as_int(v), CTRL, 0xf, 0xf, false)); }
__device__ __forceinline__ float row16_sum(float v) { v = dpp_add<0x140>(v); v = dpp_add<0x141>(v); v = dpp_add<0x4E>(v); v = dpp_add<0xB1>(v); return v; }
__device__ __forceinline__ unsigned long long lanemask_lt(int lane) { return (1ull << lane) - 1ull; }
__device__ __forceinline__ void glds16g(const void* gsrc, unsigned lds_dst) { unsigned keep;
    asm volatile("s_mov_b32 %0, m0\n\ts_mov_b32 m0, %2\n\ts_nop 0\n\tglobal_load_lds_dwordx4 %1, off\n\ts_mov_b32 m0, %0" : "=&s"(keep) : "v"(gsrc), "s"(lds_dst) : "memory"); }

__device__ __forceinline__ void glds16x4(const void* sbase, unsigned o0, unsigned o1, unsigned o2, unsigned o3, unsigned d0, unsigned d1, unsigned d2, unsigned d3) { unsigned keep;
    asm volatile("s_mov_b32 %0, m0\n\ts_mov_b32 m0, %6\n\ts_nop 0\n\tglobal_load_lds_dwordx4 %1, %5\n\ts_mov_b32 m0, %7\n\ts_nop 0\n\tglobal_load_lds_dwordx4 %2, %5\n\t"
                 "s_mov_b32 m0, %8\n\ts_nop 0\n\tglobal_load_lds_dwordx4 %3, %5\n\ts_mov_b32 m0, %9\n\ts_nop 0\n\tglobal_load_lds_dwordx4 %4, %5\n\ts_mov_b32 m0, %0"
                 : "=&s"(keep) : "v"(o0), "v"(o1), "v"(o2), "v"(o3), "s"(sbase), "s"(d0), "s"(d1), "s"(d2), "s"(d3) : "memory"); }
typedef __bf16 bf2_t __attribute__((ext_vector_type(2)));
__device__ __forceinline__ float dot2bf(unsigned a, unsigned b, float c) { return __builtin_amdgcn_fdot2_f32_bf16(__builtin_bit_cast(bf2_t, a), __builtin_bit_cast(bf2_t, b), c, false); }
template <int NT> __device__ __forceinline__ void compact_tokens(const Args& a, int t0, int lane) {
    int e0[NT], e1[NT]; float g0[NT], g1[NT];
#pragma unroll
    for (int i = 0; i < NT; ++i) { const int* EID = (const int*)(a.ws + WS_EID) + (size_t)(t0 + i) * 128; const float* GW = (const float*)(a.ws + WS_GW) + (size_t)(t0 + i) * 128;
        e0[i] = EID[lane]; e1[i] = EID[64 + lane]; g0[i] = GW[lane]; g1[i] = GW[64 + lane]; }
#pragma unroll
    for (int i = 0; i < NT; ++i) {
        const bool p0 = e0[i] < 8192, p1 = e1[i] < 8192;
        const unsigned long long m0 = __ballot(p0), m1 = __ballot(p1), lt = lanemask_lt(lane);
        const int c0 = __popcll(m0), n0 = c0 + __popcll(m1);
        const int pos0 = p0 ? __popcll(m0 & lt) : n0 + __popcll(~m0 & lt);
        const int pos1 = p1 ? c0 + __popcll(m1 & lt) : n0 + (64 - c0) + __popcll(~m1 & lt);
        unsigned* R = (unsigned*)(a.ws + WS_REC) + (size_t)(t0 + i) * 128;
        R[pos0] = (unsigned)e0[i] | (f2bf(g0[i]) << 16); R[pos1] = (unsigned)e1[i] | (f2bf(g1[i]) << 16);
        if (lane == 0) ((int*)(a.ws + WS_N0))[t0 + i] = n0; }
}
template <int NT> __device__ __forceinline__ void w_tokens(const Args& a, int t0, int lane, const LAS float* scd, const LAS float* scu) {
    float d0[NT], d1[NT], sd0[NT], sd1[NT], su0[NT], su1[NT]; unsigned r0[NT], r1[NT]; float ss[NT];
#pragma unroll
    for (int i = 0; i < NT; ++i) { const float* DP = (const float*)(a.ws + WS_DOTP) + (size_t)(t0 + i) * 1024; const unsigned* R = (const unsigned*)(a.ws + WS_REC) + (size_t)(t0 + i) * 128;
        float p0[8], p1[8];
#pragma unroll
        for (int x = 0; x < 8; ++x) { p0[x] = DP[x * 128 + lane]; p1[x] = DP[x * 128 + 64 + lane]; }
        r0[i] = R[lane]; r1[i] = R[64 + lane]; ss[i] = ((const float*)(a.ws + WS_ROWSS2))[t0 + i];
        sd0[i] = scd[r0[i] & 0x3fffu]; sd1[i] = scd[r1[i] & 0x3fffu];
        su0[i] = scu[r0[i] & 0x3fffu]; su1[i] = scu[r1[i] & 0x3fffu];
        d0[i] = ((p0[0] + p0[1]) + (p0[2] + p0[3])) + ((p0[4] + p0[5]) + (p0[6] + p0[7])); d1[i] = ((p1[0] + p1[1]) + (p1[2] + p1[3])) + ((p1[4] + p1[5]) + (p1[6] + p1[7])); }
#pragma unroll
    for (int i = 0; i < NT; ++i) { const float rs2 = 1.0f / sqrtf(ss[i] * (1.0f / 1024.0f) + EPSN);
        const float w0 = bfhi(r0[i]) * fgelu_tanh(d0[i] * sd0[i] * rs2) * su0[i], w1 = bfhi(r1[i]) * fgelu_tanh(d1[i] * sd1[i] * rs2) * su1[i];
        float m0 = fabsf(w0), m1 = fabsf(w1);
#pragma unroll
        for (int o = 1; o < 64; o <<= 1) { m0 = fmaxf(m0, __shfl_xor(m0, o)); m1 = fmaxf(m1, __shfl_xor(m1, o)); }
        const float s0 = (m0 > 0.f) ? m0 * (1.0f / 127.0f) : 1.0f, s1 = (m1 > 0.f) ? m1 * (1.0f / 127.0f) : 1.0f;
        unsigned char* WQ = a.ws + WS_WQ8 + (size_t)(t0 + i) * 144;
        WQ[lane] = (unsigned char)((int)__builtin_rintf(w0 / s0) & 255); WQ[64 + lane] = (unsigned char)((int)__builtin_rintf(w1 / s1) & 255);
        if (lane == 0) { ((float*)(WQ + 128))[0] = s0; ((float*)(WQ + 128))[1] = s1; } }
}
template <bool IS_UP> __device__ __forceinline__ void sweep_slice(const Args& a, int x, int wv, int lane, unsigned ring, LAS unsigned char* ringp, unsigned aux, LAS unsigned char* auxp) {
    const int g = lane >> 4, li = lane & 15, n16 = li, kg = g;
    const char* TABx = (const char*)(a.ws + (IS_UP ? WS_EU : WS_ED)) + x * 256;
    unsigned jofs[4];
#pragma unroll
    for (int q = 0; q < 4; ++q) jofs[q] = (unsigned)((li ^ ((g << 2) | q)) * 16);
    const unsigned pd = (unsigned)__builtin_amdgcn_readfirstlane(ring);
#pragma unroll 1
    for (int s_ = 0; s_ < 128; ++s_) {
        const int r = s_ >> 6, k = s_ & 63, t = wv * 64 + k, base = 64 * r;
        const LAS unsigned* rec = (const LAS unsigned*)(auxp + (k & 3) * 512) + base;
        const LAS unsigned char* hp = auxp + 2048 + (k & 3) * 256;
        asm volatile("s_waitcnt lgkmcnt(0)" ::: "memory");
        if ((k & 3) == 0) {
            const char* rsrc = (const char*)(a.ws + WS_REC) + (size_t)t * 512 + lane * 16;
            glds16g(rsrc, (unsigned)__builtin_amdgcn_readfirstlane(aux)); glds16g(rsrc + 1024, (unsigned)__builtin_amdgcn_readfirstlane(aux + 1024));
            if (!IS_UP) glds16g((const char*)(a.ws + WS_HB) + (size_t)(t + g) * 2048 + x * 256 + li * 16, (unsigned)__builtin_amdgcn_readfirstlane(aux + 2048));
            asm volatile("s_waitcnt vmcnt(0)" ::: "memory");
        }
        {
            unsigned so[16];
#pragma unroll
            for (int p = 0; p < 16; ++p) so[p] = rec[4 * p + g];
#pragma unroll
            for (int p = 0; p < 16; ++p) so[p] = ((so[p] & 0x3fffu) << 11) + jofs[p & 3];
            glds16x4(TABx, so[0], so[1], so[2], so[3], pd, pd + 1024u, pd + 2048u, pd + 3072u);
            glds16x4(TABx, so[4], so[5], so[6], so[7], pd + 4096u, pd + 5120u, pd + 6144u, pd + 7168u);
            glds16x4(TABx, so[8], so[9], so[10], so[11], pd + 8192u, pd + 9216u, pd + 10240u, pd + 11264u);
            glds16x4(TABx, so[12], so[13], so[14], so[15], pd + 12288u, pd + 13312u, pd + 14336u, pd + 15360u);
        }
        asm volatile("s_waitcnt vmcnt(0)" ::: "memory");
        if (!IS_UP) {
            bf16x8 hb[4];
#pragma unroll
            for (int q = 0; q < 4; ++q) hb[q] = *(const LAS bf16x8*)(hp + (32 * q + 8 * kg) * 2);
            f32x4 res = (f32x4){0.f, 0.f, 0.f, 0.f};
#pragma unroll
            for (int rb = 0; rb < 4; ++rb) {
                f32x4 d = (f32x4){0.f, 0.f, 0.f, 0.f}; const int row = n16 + 16 * rb; const int key = ((row & 3) << 2) | ((row >> 2) & 3);
#pragma unroll
                for (int q = 0; q < 4; ++q) { const bf16x8 af = *(const LAS bf16x8*)(ringp + 256 * row + 16 * ((4 * q + kg) ^ key)); d = __builtin_amdgcn_mfma_f32_16x16x32_bf16(af, hb[q], d, 0, 0, 0); }
                res = (n16 == rb) ? d : res; }
            if (n16 < 4) *(GAS f32x4*)((float*)(a.ws + WS_DOTP) + ((size_t)t * 8 + x) * 128 + base + 16 * n16 + 4 * kg) = res;
        } else {
            f32x4 pacc[8];
#pragma unroll
            for (int i = 0; i < 8; ++i) pacc[i] = (f32x4){0.f, 0.f, 0.f, 0.f};
            const int q4 = n16 >> 2, p4 = lane & 3;
#pragma unroll
            for (int ks = 0; ks < 2; ++ks) {
                const v4u wa = *(const LAS v4u*)(rec + 32 * ks + 8 * kg), wb = *(const LAS v4u*)(rec + 32 * ks + 8 * kg + 4);
                const bf16x8 af = __builtin_bit_cast(bf16x8, (v4u){(wa.x >> 16) | (wa.y & 0xffff0000u), (wa.z >> 16) | (wa.w & 0xffff0000u), (wb.x >> 16) | (wb.y & 0xffff0000u), (wb.z >> 16) | (wb.w & 0xffff0000u)});
#pragma unroll
                for (int c = 0; c < 8; ++c) {
                    const int row0 = 32 * ks + 8 * kg + q4, row1 = row0 + 4; const int ch = 2 * c + (p4 >> 1);
                    const int k0 = ((row0 & 3) << 2) | ((row0 >> 2) & 3), k1 = ((row1 & 3) << 2) | ((row1 >> 2) & 3);
                    const attn_body::s16x4 lo4 = attn_body::vtr((attn_body::lds_cptr)(ringp + 256 * row0 + 16 * (ch ^ k0) + 8 * (p4 & 1)));
                    const attn_body::s16x4 hi4 = attn_body::vtr((attn_body::lds_cptr)(ringp + 256 * row1 + 16 * (ch ^ k1) + 8 * (p4 & 1)));
                    const bf16x8 bfr = (bf16x8){lo4[0], lo4[1], lo4[2], lo4[3], hi4[0], hi4[1], hi4[2], hi4[3]};
                    pacc[c] = __builtin_amdgcn_mfma_f32_16x16x32_bf16(af, bfr, pacc[c], 0, 0, 0); }
            }
            const float v0 = (kg == 0) ? pacc[0][0] : (kg == 1) ? pacc[1][0] : (kg == 2) ? pacc[2][0] : pacc[3][0];
            const float v1 = (kg == 0) ? pacc[4][0] : (kg == 1) ? pacc[5][0] : (kg == 2) ? pacc[6][0] : pacc[7][0];
            bf16* po = (bf16*)(a.ws + WS_PEER) + ((size_t)r * M + t) * D + x * 128;
            po[lane] = (bf16)f2bf(v0); po[64 + lane] = (bf16)f2bf(v1);
        }
    }
}
typedef int i32x4 __attribute__((ext_vector_type(4)));
__device__ __forceinline__ void sweep_down_q8(const Args& a, int x, int wv, int lane, unsigned ring, LAS unsigned char* ringp, unsigned aux, LAS unsigned char* auxp) {
    const int g = lane >> 4, li = lane & 15, n16 = li, kg = g, g8 = lane >> 3, s8 = lane & 7;
    const char* TABx = (const char*)(a.ws + WS_ED) + x * 128;
    unsigned jofs[2];
#pragma unroll
    for (int b = 0; b < 2; ++b) jofs[b] = (unsigned)((s8 ^ (4 * b + (g8 >> 1))) * 16);
    const unsigned pd = (unsigned)__builtin_amdgcn_readfirstlane(ring);
    LAS unsigned char* hq = auxp + 3072; LAS float* hsc = (LAS float*)(auxp + 3072 + 512);
#pragma unroll 1
    for (int s_ = 0; s_ < 128; ++s_) {
        const int r = s_ & 1, k = s_ >> 1, t = wv * 64 + k, base = 64 * r;
        const LAS unsigned* rec = (const LAS unsigned*)(auxp + (k & 3) * 512) + base;
        asm volatile("s_waitcnt lgkmcnt(0)" ::: "memory");
        if ((k & 3) == 0 && r == 0) {
            const char* rsrc = (const char*)(a.ws + WS_REC) + (size_t)t * 512 + lane * 16;
            glds16g(rsrc, (unsigned)__builtin_amdgcn_readfirstlane(aux)); glds16g(rsrc + 1024, (unsigned)__builtin_amdgcn_readfirstlane(aux + 1024));
            glds16g((const char*)(a.ws + WS_HB) + (size_t)(t + g) * 2048 + x * 256 + li * 16, (unsigned)__builtin_amdgcn_readfirstlane(aux + 2048));
            asm volatile("s_waitcnt vmcnt(0)" ::: "memory");
            {
                const v4u hb = *(const LAS v4u*)(auxp + 2048 + lane * 16); float f[8]; unpack8(hb, f);
                float am = fmaxf(fmaxf(fmaxf(fabsf(f[0]), fabsf(f[1])), fmaxf(fabsf(f[2]), fabsf(f[3]))), fmaxf(fmaxf(fabsf(f[4]), fabsf(f[5])), fmaxf(fabsf(f[6]), fabsf(f[7]))));
                am = fmaxf(am, __int_as_float(__builtin_amdgcn_update_dpp(0, __float_as_int(am), 0x140, 0xf, 0xf, false))); am = fmaxf(am, __int_as_float(__builtin_amdgcn_update_dpp(0, __float_as_int(am), 0x141, 0xf, 0xf, false)));
                am = fmaxf(am, __int_as_float(__builtin_amdgcn_update_dpp(0, __float_as_int(am), 0x4E, 0xf, 0xf, false))); am = fmaxf(am, __int_as_float(__builtin_amdgcn_update_dpp(0, __float_as_int(am), 0xB1, 0xf, 0xf, false)));
                const float sc = (am > 0.f) ? am * (1.0f / 127.0f) : 1.0f, inv = 1.0f / sc;
                unsigned qw[2];
#pragma unroll
                for (int h2 = 0; h2 < 2; ++h2) { const int q0 = (int)__builtin_rintf(f[4 * h2] * inv), q1 = (int)__builtin_rintf(f[4 * h2 + 1] * inv), q2 = (int)__builtin_rintf(f[4 * h2 + 2] * inv), q3 = (int)__builtin_rintf(f[4 * h2 + 3] * inv);
                    qw[h2] = ((unsigned)q0 & 255u) | (((unsigned)q1 & 255u) << 8) | (((unsigned)q2 & 255u) << 16) | ((unsigned)q3 << 24); }
                *(LAS unsigned long long*)(hq + lane * 8) = (unsigned long long)qw[0] | ((unsigned long long)qw[1] << 32);
                if (li == 0) hsc[g] = sc; }
        }
        {   unsigned so[8];
#pragma unroll
            for (int i = 0; i < 8; ++i) so[i] = rec[8 * i + g8];
#pragma unroll
            for (int i = 0; i < 8; ++i) so[i] = ((so[i] & 0x3fffu) << 10) + jofs[i & 1];
            glds16x4(TABx, so[0], so[1], so[2], so[3], pd, pd + 1024u, pd + 2048u, pd + 3072u);
            glds16x4(TABx, so[4], so[5], so[6], so[7], pd + 4096u, pd + 5120u, pd + 6144u, pd + 7168u);
        }
        asm volatile("s_waitcnt vmcnt(0)" ::: "memory");
        const i32x4 hb0 = *(const LAS i32x4*)(hq + (k & 3) * 128 + 16 * kg), hb1 = *(const LAS i32x4*)(hq + (k & 3) * 128 + 64 + 16 * kg);
        const float hs = hsc[k & 3];
        i32x4 res = (i32x4){0, 0, 0, 0};
#pragma unroll
        for (int rb = 0; rb < 4; ++rb) {
            const int row = n16 + 16 * rb; const int key = (row >> 1) & 7;
            const i32x4 a0 = *(const LAS i32x4*)(ringp + row * 128 + ((kg ^ key) * 16)), a1 = *(const LAS i32x4*)(ringp + row * 128 + (((4 + kg) ^ key) * 16));
            i32x4 d = __builtin_amdgcn_mfma_i32_16x16x64_i8(a0, hb0, (i32x4){0, 0, 0, 0}, 0, 0, 0); d = __builtin_amdgcn_mfma_i32_16x16x64_i8(a1, hb1, d, 0, 0, 0);
            res = (n16 == rb) ? d : res; }
        if (n16 < 4) *(GAS f32x4*)((float*)(a.ws + WS_DOTP) + ((size_t)t * 8 + x) * 128 + base + 16 * n16 + 4 * kg) = (f32x4){(float)res[0] * hs, (float)res[1] * hs, (float)res[2] * hs, (float)res[3] * hs};
    }
}

__device__ __forceinline__ void sweep_up_q8(const Args& a, int x, int wv, int lane, unsigned ring, LAS unsigned char* ringp, unsigned aux, LAS unsigned char* auxp) {
    const int n16 = lane & 15, kg = lane >> 4, g8 = lane >> 3, s8 = lane & 7;
    const char* TABx = (const char*)(a.ws + WS_EU) + x * 128;
    unsigned jofs[2];
#pragma unroll
    for (int b = 0; b < 2; ++b) jofs[b] = (unsigned)((s8 ^ ((g8 >> 1) | (b << 2))) * 16);
    const unsigned pd = (unsigned)__builtin_amdgcn_readfirstlane(ring);
    typedef int v2i_t __attribute__((ext_vector_type(2)));
#pragma unroll 1
    for (int s_ = 0; s_ < 128; ++s_) {
        const int r = s_ & 1, k = s_ >> 1, t = wv * 64 + k, base = 64 * r;
        const LAS unsigned* rec = (const LAS unsigned*)(auxp + (k & 3) * 512) + base;
        const LAS unsigned char* wq = auxp + 2048 + (k & 3) * 144;
        asm volatile("s_waitcnt lgkmcnt(0)" ::: "memory");
        if ((k & 3) == 0 && r == 0) {
            const char* rsrc = (const char*)(a.ws + WS_REC) + (size_t)t * 512 + lane * 16;
            glds16g(rsrc, (unsigned)__builtin_amdgcn_readfirstlane(aux)); glds16g(rsrc + 1024, (unsigned)__builtin_amdgcn_readfirstlane(aux + 1024));
            if (lane < 36) glds16g((const char*)(a.ws + WS_WQ8) + (size_t)t * 144 + lane * 16, (unsigned)__builtin_amdgcn_readfirstlane(aux + 2048));
            asm volatile("s_waitcnt vmcnt(0)" ::: "memory");
        }
        {   unsigned so[8];
#pragma unroll
            for (int i = 0; i < 8; ++i) so[i] = rec[8 * i + g8];
#pragma unroll
            for (int i = 0; i < 8; ++i) so[i] = ((so[i] & 0x3fffu) << 10) + jofs[(i >> 1) & 1];
            glds16x4(TABx, so[0], so[1], so[2], so[3], pd, pd + 1024u, pd + 2048u, pd + 3072u);
            glds16x4(TABx, so[4], so[5], so[6], so[7], pd + 4096u, pd + 5120u, pd + 6144u, pd + 7168u);
        }
        asm volatile("s_waitcnt vmcnt(0)" ::: "memory");
        const i32x4 aw = *(const LAS i32x4*)(wq + 64 * r + 16 * kg);
        const float wsc = *(const LAS float*)(wq + 128 + 4 * r);
        const int i2 = n16 >> 1, ih = n16 & 1;
        const int row0 = 16 * kg + i2, row1 = row0 + 8;
        const int k0 = ((row0 >> 1) & 3) | (((row0 >> 4) & 1) << 2), k1 = ((row1 >> 1) & 3) | (((row1 >> 4) & 1) << 2);
        const LAS unsigned char* p0 = ringp + row0 * 128 + 8 * ih; const LAS unsigned char* p1 = ringp + row1 * 128 + 8 * ih;
        float outv[8];
#pragma unroll
        for (int c = 0; c < 8; ++c) {
            const v2i_t lo = __builtin_amdgcn_ds_read_tr8_b64_v2i32((LAS v2i_t*)(p0 + ((c ^ k0) * 16)));
            const v2i_t hi = __builtin_amdgcn_ds_read_tr8_b64_v2i32((LAS v2i_t*)(p1 + ((c ^ k1) * 16)));
            const i32x4 d = __builtin_amdgcn_mfma_i32_16x16x64_i8(aw, (i32x4){lo.x, lo.y, hi.x, hi.y}, (i32x4){0, 0, 0, 0}, 0, 0, 0);
            outv[c] = (float)d[0] * wsc; }
        const float v0 = (kg == 0) ? outv[0] : (kg == 1) ? outv[1] : (kg == 2) ? outv[2] : outv[3];
        const float v1 = (kg == 0) ? outv[4] : (kg == 1) ? outv[5] : (kg == 2) ? outv[6] : outv[7];
        bf16* po = (bf16*)(a.ws + WS_PEER) + ((size_t)r * M + t) * D + x * 128;
        po[lane] = (bf16)f2bf(v0); po[64 + lane] = (bf16)f2bf(v1);
    }
}

__device__ __forceinline__ void final_row(const Args& a, int t, int lane) {
    float* orow = a.out + (size_t)t * D; const float* gf = a.in[22];
    const bf16* P0 = (const bf16*)(a.ws + WS_PEER) + (size_t)t * D; const bf16* P1 = P0 + (size_t)M * D;
    const bf16* HBr = (const bf16*)(a.ws + WS_HB) + (size_t)t * D;
    f32x4 h[4]; float ss = 0.f;
#pragma unroll
    for (int j = 0; j < 4; ++j) { { const unsigned long long hb = ((const GAS unsigned long long*)HBr)[lane + 64 * j]; h[j].x = bflo((unsigned)hb); h[j].y = bfhi((unsigned)hb); h[j].z = bflo((unsigned)(hb >> 32)); h[j].w = bfhi((unsigned)(hb >> 32)); }
        const unsigned long long p = ((const GAS unsigned long long*)P0)[lane + 64 * j], q = ((const GAS unsigned long long*)P1)[lane + 64 * j];
        h[j].x += bflo((unsigned)p) + bflo((unsigned)q); h[j].y += bfhi((unsigned)p) + bfhi((unsigned)q); h[j].z += bflo((unsigned)(p >> 32)) + bflo((unsigned)(q >> 32)); h[j].w += bfhi((unsigned)(p >> 32)) + bfhi((unsigned)(q >> 32));
        ss += (h[j].x * h[j].x + h[j].y * h[j].y) + (h[j].z * h[j].z + h[j].w * h[j].w); }
    ss = wave_sum(ss);
    const float ri = 1.0f / sqrtf(ss * (1.0f / 1024.0f) + EPSN);
#pragma unroll
    for (int j = 0; j < 4; ++j) ((GAS f32x4*)orow)[lane + 64 * j] = h[j] * ri * ((const GAS f32x4*)gf)[lane + 64 * j];
}

__device__ __forceinline__ float a_dot64(const float* p, const float* q, int lane) { return wave_sum(p[lane] * q[lane]); }
constexpr int N_PHASES = 12;
#ifndef ROUTE_REF
#define ROUTE_REF 0
#endif
#ifndef MK_ONE_LAUNCH
#define MK_ONE_LAUNCH 1
#endif
__global__ void __launch_bounds__(NWAVES * 64, 2) fwd_mega(Args args) {
    extern __shared__ __attribute__((aligned(16))) unsigned char lds[];
    Frame F;
    F.lds = (LAS unsigned char*)lds;
    F.MISC = (volatile LAS unsigned*)(F.lds + MISC_OFF);
    F.tid = threadIdx.x; F.lane = F.tid & 63; F.wave = __builtin_amdgcn_readfirstlane(F.tid >> 6);
    F.G = gridDim.x; { const int bx = blockIdx.x; F.vcu = (F.G % 8 == 0) ? (bx % 8) * (F.G / 8) + bx / 8 : bx; }
    unsigned char* ws = args.ws;
    const int lo = args.ph_lo, hi = args.ph_hi;
#ifndef PH_MASK
#define PH_MASK 0xffff
#endif
#define IN(k) (((PH_MASK >> (k)) & 1) && lo <= (k) && (k) < hi)
#define BOTH(k) (IN(k) && IN((k) + 1))
#if MK_ONE_LAUNCH
    for (int u = F.tid; u < (LDS_BYTES - LDSCTL_OFF) / 4; u += NWAVES * 64) ((LAS unsigned*)(F.lds + LDSCTL_OFF))[u] = 0u;
    __syncthreads();
    const XcdBarrier xbar = xcd_barrier_post((unsigned*)(ws + WS_CTL) + CW_BAR, F.MISC + 8);
    bool first_seam = args.ph_lo < 0;
#define GRID_BAR() do { if (first_seam) { __threadfence(); cooperative_groups::this_grid().sync(); first_seam = false; } else xcd_barrier(xbar); } while (0)
#else
#define GRID_BAR() do { } while (0)
#endif
#ifndef REP_PH
#define REP_PH -1
#endif
#define RUN_PHASE(k, ...) do { if (IN(k)) { if ((k) == REP_PH) { { const bool first_of_two = true; (void)first_of_two; __VA_ARGS__ } GRID_BAR(); } { const bool first_of_two = false; (void)first_of_two; __VA_ARGS__ } if (BOTH(k)) GRID_BAR(); } } while (0)
    RUN_PHASE(0, { p0_prologue(F, args); });
    RUN_PHASE(1, {
        pg8::Gemm g{(const pg8::bf16_t*)(ws + WS_XB), (const pg8::bf16_t*)(ws + WS_WIN), M, INC, D}; pg8::StaticOrder S; S.init(M, INC, F.G, (int)blockIdx.x);
        pg8::EpiBf16<1> E{(pg8::bf16_t*)(ws + WS_Q), 512, (const float*)(ws + WS_RS1), 512, (size_t)WS_SPLIT / 2, attn_body::C2};
        pg8::gemm_phase<pg8::EpiBf16<1>, pg8::StaticOrder, true, true>(F.lds + RING_OFF, g, S, E);
        { const int nb = (F.G >= 2) ? (int)F.G / 2 : 1; const int bi = (int)blockIdx.x - ((int)F.G - nb); if (bi >= 0) convert_experts(args, bi * NWAVES + F.wave, nb * NWAVES, F.lane); }
    });
    RUN_PHASE(2, {
        for (int c = F.vcu; c < M / 64; c += F.G) lru_local_unit(F, args, c);
        const attn128::AttnTensors AT{(const attn128::bf16*)(ws + WS_Q), (const attn128::bf16*)(ws + WS_Q + WS_SPLIT), (const attn128::bf16*)(ws + WS_Q + 2 * WS_SPLIT), (attn128::bf16*)(ws + WS_OS)};
        const attn128::StaticOrder S(F.vcu);
        attn128::attn_phase<attn128::StaticOrder>((char*)lds + RING_OFF, AT, S);
    });
    RUN_PHASE(3, {
        float l1 = a_dot64(args.in[3], args.in[4], F.lane); float l2 = a_dot64(args.in[5], args.in[6], F.lane);
        const float lamv = expf(l1) - expf(l2) + 0.2f;
        for (int c = F.vcu; c < M / 64; c += F.G) fix_unit(F, args, c, lamv);
    });
    RUN_PHASE(4, {
        pg8::Gemm g{(const pg8::bf16_t*)(ws + WS_MIX), (const pg8::bf16_t*)(ws + WS_WOUT), M, D, D}; pg8::StaticOrder S; S.init(M, D, F.G, (int)blockIdx.x);
        pg8::EpiResid E{args.in[0], args.out, (pg8::bf16_t*)(ws + WS_HB), (float*)(ws + (first_of_two ? WS_RS1 : WS_ROWSS2)), D};
        pg8::gemm_phase<pg8::EpiResid, pg8::StaticOrder, true, true>(F.lds + RING_OFF, g, S, E);
    });
    RUN_PHASE(5, {
        pg8::Gemm g{(const pg8::bf16_t*)(ws + WS_HB), (const pg8::bf16_t*)(ws + WS_WQ), M, NQ, D}; pg8::StaticOrder S; S.init(M, NQ, F.G, (int)blockIdx.x);
        pg8::EpiBf16<2> E{(pg8::bf16_t*)(ws + WS_Q2), NQ, (const float*)(ws + WS_ROWSS2), 0, 0, 1.f};
        pg8::gemm_phase<pg8::EpiBf16<2>, pg8::StaticOrder, true, true>(F.lds + RING_OFF, g, S, E);
    });
    RUN_PHASE(6, {
        const int gw = F.vcu * NWAVES + F.wave; const int NGW = F.G * NWAVES;
        LAS unsigned char* skl = F.lds + RING_OFF + 16384;
        for (int c = F.tid; c < 4096; c += NWAVES * 64) { const int row = c >> 4; const int ch = c & 15; *(LAS v4u*)(skl + row * 272 + ch * 16) = *(const GAS v4u*)(ws + WS_SK1 + (size_t)row * 256 + ch * 16); }
        __syncthreads();
        static_assert((M / 32) * 8 == NEXP / 4, "one group of 4 expert_up rows beside each routing unit");
        for (int u = gw; u < (M / 32) * 8; u += NGW) { f32x4 ev[4][4]; q8_load<4>(ev, args.in[21] + (size_t)u * 4 * D, F.lane);
            route_unit(args, u >> 3, u & 7, F.lane, F.lds + RING_OFF + F.tid * 32, skl, (int*)(ws + WS_EID), (float*)(ws + WS_GW));
            q8_finish<4>(ev, ws + WS_EU + (size_t)u * 4 * D, nullptr, (float*)(ws + WS_SCU) + 4 * u, F.lane); }
        __syncthreads();
    });
    RUN_PHASE(7, {
        const int gw = F.vcu * NWAVES + F.wave; const int NGW = F.G * NWAVES;
        for (int t = 8 * gw; t < M; t += 8 * NGW) compact_tokens<8>(args, t, F.lane);
    });
    RUN_PHASE(8, {
        if (F.G == 256) sweep_down_q8(args, F.vcu >> 5, (F.vcu & 31) * NWAVES + F.wave, F.lane, (unsigned)(uintptr_t)(lds + RING_OFF) + F.wave * 16384u, F.lds + RING_OFF + F.wave * 16384, (unsigned)(uintptr_t)(lds + LDSCTL_OFF + 1024) + F.wave * 3712u, F.lds + LDSCTL_OFF + 1024 + F.wave * 3712);
    });
    RUN_PHASE(9, {
        const int gw = F.vcu * NWAVES + F.wave; const int NGW = F.G * NWAVES;
        LAS float* scl = (LAS float*)(F.lds + RING_OFF);
        for (int i = F.tid; i < NEXP / 4; i += NWAVES * 64) { ((LAS v4u*)scl)[i] = ((const GAS v4u*)(ws + WS_SCD))[i]; ((LAS v4u*)(scl + NEXP))[i] = ((const GAS v4u*)(ws + WS_SCU))[i]; }
        __syncthreads();
        for (int t = 8 * gw; t < M; t += 8 * NGW) w_tokens<8>(args, t, F.lane, scl, scl + NEXP);
        __syncthreads();
    });
    RUN_PHASE(10, {
        if (F.G == 256) sweep_up_q8(args, F.vcu >> 5, (F.vcu & 31) * NWAVES + F.wave, F.lane, (unsigned)(uintptr_t)(lds + RING_OFF) + F.wave * 16384u, F.lds + RING_OFF + F.wave * 16384, (unsigned)(uintptr_t)(lds + LDSCTL_OFF + 1024) + F.wave * 3712u, F.lds + LDSCTL_OFF + 1024 + F.wave * 3712);
    });
    RUN_PHASE(11, {
        const int gw = F.vcu * NWAVES + F.wave; const int NGW = F.G * NWAVES;
        for (int t = gw; t < M; t += NGW) final_row(args, t, F.lane);
    });
#undef IN
#undef BOTH
}

extern "C" void kernel_launch(void* const* d_in, const int* in_sizes, int n_in, void* d_out, int out_size, void* d_ws, size_t ws_size, hipStream_t stream) {
    static int grid = 0;
    if (grid == 0) {
        if (n_in != 23 || out_size != M * D || ws_size < WS_END) { fprintf(stderr, "kernel_launch: unexpected problem: n_in %d out %d ws %zu\n", n_in, out_size, ws_size); grid = -1; return; }
        int dev = 0, cus = 0, per_cu = 0;
        if (hipGetDevice(&dev) != hipSuccess || hipDeviceGetAttribute(&cus, hipDeviceAttributeMultiprocessorCount, dev) != hipSuccess) { grid = -1; return; }
        if (hipFuncSetAttribute((const void*)fwd_mega, hipFuncAttributeMaxDynamicSharedMemorySize, LDS_BYTES) != hipSuccess) { fprintf(stderr, "kernel_launch: hipFuncSetAttribute failed\n"); grid = -1; return; }
        if (hipOccupancyMaxActiveBlocksPerMultiprocessor(&per_cu, (const void*)fwd_mega, NWAVES * 64, LDS_BYTES) != hipSuccess || per_cu < 1) { fprintf(stderr, "kernel_launch: occupancy query reports %d\n", per_cu); per_cu = 1; }
        (void)hipGetLastError();
        grid = cus;
    }
    if (grid < 0) return;
    (void)hipMemsetAsync((char*)d_ws + WS_CTL, 0, CTL_ZERO_BYTES, stream);
    Args a{};
    for (int i = 0; i < 23; ++i) a.in[i] = (const float*)d_in[i];
    a.out = (float*)d_out; a.ws = (unsigned char*)d_ws;
#if MK_ONE_LAUNCH
    a.ph_lo = 0; a.ph_hi = N_PHASES;
    void* kargs[] = {&a};
    hipError_t e = hipLaunchCooperativeKernel((const void*)fwd_mega, dim3(grid), dim3(NWAVES * 64), kargs, LDS_BYTES, stream);
    if (e != hipSuccess) fprintf(stderr, "cooperative launch failed: %s (grid %d)\n", hipGetErrorString(e), grid);
#else
    for (int p = 0; p < N_PHASES; ++p) { a.ph_lo = p; a.ph_hi = p + 1; hipLaunchKernelGGL(fwd_mega, dim3(grid), dim3(NWAVES * 64), LDS_BYTES, stream, a); }
#endif
}
```

```cpp
#include <hip/hip_runtime.h>
#include <hip/hip_cooperative_groups.h>
#include <cstdio>
#include <cstdint>
namespace pg8 {
#define PG8_LAS __attribute__((address_space(3)))
typedef unsigned short bf16_t;
typedef short bf16x8 __attribute__((ext_vector_type(8)));
typedef float f32x4 __attribute__((ext_vector_type(4)));
typedef unsigned u32x4 __attribute__((ext_vector_type(4)));
constexpr int BM = 256, BK = 64, HALF = 128, HTB = HALF * BK * 2  , STAGE_BYTES = 8 * HTB, NXCD = 8, WGM = 8;

__host__ __device__ __forceinline__ int lds_byte(int r, int c) { const int st = (r >> 4) * 2 + (c >> 5), rr = r & 15, cc = c & 31, ob = rr * 64 + cc * 2; return st * 1024 + (ob ^ (((ob >> 9) & 1) << 5)); }
__host__ __device__ __forceinline__ void stage_rc(int b, int& R, int& C) { const int st = b / 1024, sb = b % 1024, swz = sb ^ (((sb >> 9) & 1) << 5); R = (st >> 1) * 16 + swz / 64; C = (st & 1) * 32 + (swz % 64) / 2; }
__host__ __device__ __forceinline__ int perm32(int rho) { const int n = rho >> 4, i = rho & 15; return 8 * (i >> 2) + 4 * n + (i & 3); }

struct Unit { int pm, pn; };
struct Gemm { const bf16_t* A; const bf16_t* Bt; int M, N, K; };

struct StaticOrder {
    int nM, nN, nwg, G, c;
    __host__ __device__ void init(int M, int N, int G_, int c_) { nM = M / BM; nN = N / BM; nwg = nM * nN; G = G_; c = c_; }
    __host__ __device__ bool next(int i, Unit& u) const {
        const long L = (long)i * G + c; if (L >= nwg) return false;
        int wgid = (int)L; { const int q = nwg / NXCD, r = nwg % NXCD, xcd = wgid % NXCD, off = wgid / NXCD; wgid = (xcd < r ? xcd * (q + 1) : r * (q + 1) + (xcd - r) * q) + off; }
        const int nig = WGM * nN, gid = wgid / nig, fm = gid * WGM, gsz = (nM - fm) < WGM ? (nM - fm) : WGM;
        u.pm = fm + ((wgid % nig) % gsz); u.pn = (wgid % nig) / gsz; return true;
    }
    __device__ __forceinline__ void a_ready(const Unit&) const {}
    __device__ __forceinline__ void done(const Unit&) const {}
};

__device__ __forceinline__ unsigned cvt_pk_bf16(float lo, float hi) { unsigned r; asm volatile("v_cvt_pk_bf16_f32 %0, %1, %2" : "=v"(r) : "v"(lo), "v"(hi)); return r; }
typedef float f32x2 __attribute__((ext_vector_type(2)));

template <int RSMODE> struct EpiBf16 {
    static constexpr bool PERM = true, AFTER_DRAIN = false;
    bf16_t* O; int ldc; const float* rowscale; int split_cols; size_t split_stride; float scale0;
    __device__ __forceinline__ void operator()(const f32x4 (&acc)[2][2][4][2], const Unit& u, int wr, int wc, int fr, int fq) const {
        const int row0 = u.pm * BM + wr * 64 + fr; int colt = u.pn * BM; bf16_t* base = O;
        float sc = 1.f; if (split_cols) { const int t = colt / split_cols; base += (size_t)t * split_stride; colt -= t * split_cols; if (t == 0) sc = scale0; }
        const int col0 = colt + wc * 32 + 8 * fq;
#pragma unroll
        for (int ai = 0; ai < 2; ++ai)
#pragma unroll
            for (int m = 0; m < 4; ++m) { const int row = row0 + ai * HALF + m * 16; bf16_t* rowp = base + (size_t)row * ldc + col0;
                float rs = sc;
                if (RSMODE == 1) rs *= rowscale[row];
                if (RSMODE == 2) rs *= 1.0f / sqrtf(rowscale[row] * (1.0f / 1024.0f) + 1e-6f);
#pragma unroll
                for (int bj = 0; bj < 2; ++bj) { f32x4 v0 = acc[ai][bj][m][0] * rs, v1 = acc[ai][bj][m][1] * rs;
                    u32x4 w; w.x = cvt_pk_bf16(v0[0], v0[1]); w.y = cvt_pk_bf16(v0[2], v0[3]); w.z = cvt_pk_bf16(v1[0], v1[1]); w.w = cvt_pk_bf16(v1[2], v1[3]);
                    *(u32x4*)(rowp + bj * HALF) = w; } }
    }
};

struct EpiResid {
    static constexpr bool PERM = false, AFTER_DRAIN = false;
    const float* X; float* Hf; bf16_t* Hb; float* rowss; int ldc;
    __device__ __forceinline__ void operator()(const f32x4 (&acc)[2][2][4][2], const Unit& u, int wr, int wc, int fr, int fq) const {
        typedef unsigned u32x2v __attribute__((ext_vector_type(2)));
        const int col0 = u.pn * BM + wc * 32 + 4 * fq;
#pragma unroll
        for (int ai = 0; ai < 2; ++ai)
#pragma unroll
            for (int m = 0; m < 4; ++m) { const int row = u.pm * BM + ai * HALF + wr * 64 + m * 16 + fr; const size_t off = (size_t)row * ldc + col0; float ss = 0.f;
#pragma unroll
                for (int bj = 0; bj < 2; ++bj)
#pragma unroll
                    for (int n = 0; n < 2; ++n) { const f32x4 xv = *(const f32x4*)(X + off + bj * HALF + n * 16); const f32x4 h = xv + acc[ai][bj][m][n];
                        u32x2v w; w.x = cvt_pk_bf16(h[0], h[1]); w.y = cvt_pk_bf16(h[2], h[3]);
                        *(u32x2v*)(Hb + off + bj * HALF + n * 16) = w; ss += (h[0] * h[0] + h[1] * h[1]) + (h[2] * h[2] + h[3] * h[3]); }
                ss += __shfl_xor(ss, 16); ss += __shfl_xor(ss, 32);
                if (fq == 0) atomicAdd(rowss + row, ss); }
    }
};

template <class Epi, class Sched, bool ALIGN_EPI = false, bool SP2 = false>
__device__ __forceinline__ void gemm_phase(PG8_LAS unsigned char* lds, const Gemm g, const Sched& S, const Epi& E) {
    const int tid = threadIdx.x, wid = __builtin_amdgcn_readfirstlane(tid >> 6), lane = tid & 63, wr = wid >> 2, wc = wid & 3, fr = lane & 15, fq = lane >> 4;
    const int K = g.K, nt = K / BK;
    unsigned voffA[2], voffB[2];
#pragma unroll
    for (int i = 0; i < 2; ++i) { int R, C; stage_rc(tid * 16 + i * 8192, R, C); const int Rb = Epi::PERM ? ((R & ~31) + perm32(R & 31)) : R;
        voffA[i] = (unsigned)(R * K + C) * 2u; voffB[i] = (unsigned)(Rb * K + C) * 2u; }
    const size_t kstep = (size_t)(BK * 2);
    const size_t hstep = (size_t)HALF * K * 2;
    const size_t tstep = 2 * hstep;
    const unsigned ldsw = (unsigned)wid * 1024u;
    const int aoff = lds_byte(wr * 64 + fr, fq * 8), boff = lds_byte(wc * 32 + fr, fq * 8);
#define PG8_SA(b, h) (((b) * 2 + (h)) * HTB)
#define PG8_SB(b, h) ((4 + (b) * 2 + (h)) * HTB)
#define PG8_STAGE(bufoff, gbase, voff) do { _Pragma("unroll") for (int _i = 0; _i < 2; ++_i) \
        __builtin_amdgcn_global_load_lds((const unsigned*)((const char*)(gbase) + (voff)[_i]), (PG8_LAS unsigned*)(lds + (bufoff) + ldsw + _i * 8192), 16, 0, 0); } while (0)
#define PG8_LDA(dst, b, h) do { _Pragma("unroll") for (int m = 0; m < 4; ++m) _Pragma("unroll") for (int k = 0; k < 2; ++k) dst[m][k] = *(const PG8_LAS bf16x8*)(lds + PG8_SA(b, h) + aoff + m * 2048 + k * 1024); } while (0)
#define PG8_LDB(dst, b, h) do { _Pragma("unroll") for (int n = 0; n < 2; ++n) _Pragma("unroll") for (int k = 0; k < 2; ++k) dst[n][k] = *(const PG8_LAS bf16x8*)(lds + PG8_SB(b, h) + boff + n * 2048 + k * 1024); } while (0)
#define PG8_MMA(ai, bj, At, Bt) do { __builtin_amdgcn_s_setprio(1); _Pragma("unroll") for (int m = 0; m < 4; ++m) _Pragma("unroll") for (int n = 0; n < 2; ++n) _Pragma("unroll") for (int k = 0; k < 2; ++k) \
        acc[ai][bj][m][n] = __builtin_amdgcn_mfma_f32_16x16x32_bf16(Bt[n][k], At[m][k], acc[ai][bj][m][n], 0, 0, 0); __builtin_amdgcn_s_setprio(0); } while (0)
#define PG8_WAIT_V(n) asm volatile("s_waitcnt vmcnt(" #n ")" ::: "memory")
#define PG8_WAIT_L(n) asm volatile("s_waitcnt lgkmcnt(" #n ")" ::: "memory")
#define PG8_BAR __builtin_amdgcn_s_barrier()
#define PG8_SCHED __builtin_amdgcn_sched_barrier(0)
    Unit cur, nxt; int ui = 0;
    if (!S.next(0, cur)) return;
    f32x4 acc[2][2][4][2];
#pragma unroll
    for (int a = 0; a < 2; ++a)
#pragma unroll
        for (int b = 0; b < 2; ++b)
#pragma unroll
            for (int m = 0; m < 4; ++m)
#pragma unroll
                for (int n = 0; n < 2; ++n) acc[a][b][m][n] = (f32x4){0.f, 0.f, 0.f, 0.f};
    bf16x8 At[4][2], B0[2][2], B1[2][2];
    const char* cA = (const char*)g.A + (size_t)cur.pm * tstep; const char* cB = (const char*)g.Bt + (size_t)cur.pn * tstep;
    S.a_ready(cur);
    if constexpr (SP2) {
        PG8_STAGE(PG8_SB(0, 0), cB, voffB); PG8_STAGE(PG8_SB(0, 1), cB + hstep, voffB); PG8_STAGE(PG8_SA(0, 0), cA, voffA); PG8_STAGE(PG8_SA(0, 1), cA + hstep, voffA);
        if (wr == 1) PG8_BAR;
        PG8_WAIT_V(2); PG8_BAR;
        PG8_STAGE(PG8_SB(1, 0), cB + kstep, voffB); PG8_STAGE(PG8_SA(1, 0), cA + kstep, voffA); PG8_STAGE(PG8_SB(1, 1), cB + hstep + kstep, voffB);
        PG8_WAIT_V(6); PG8_BAR;
    } else {
        PG8_STAGE(PG8_SB(0, 0), cB, voffB); PG8_STAGE(PG8_SA(0, 0), cA, voffA); PG8_STAGE(PG8_SB(0, 1), cB + hstep, voffB); PG8_STAGE(PG8_SA(0, 1), cA + hstep, voffA);
        if (wr == 1) PG8_BAR;
        PG8_WAIT_V(4); PG8_BAR;
        PG8_STAGE(PG8_SB(1, 0), cB + kstep, voffB); PG8_STAGE(PG8_SA(1, 0), cA + kstep, voffA); PG8_STAGE(PG8_SB(1, 1), cB + hstep + kstep, voffB);
        PG8_WAIT_V(6); PG8_BAR;
    }
    for (;;) {
        const bool has_next = S.next(ui + 1, nxt);
        const char* nA = has_next ? (const char*)g.A + (size_t)nxt.pm * tstep : cA; const char* nB = has_next ? (const char*)g.Bt + (size_t)nxt.pn * tstep : cB;
        for (int t = 0; t < nt; t += 2) {
            const bool last = (t == nt - 2);
            const char* a1 = cA + (size_t)(t + 1) * kstep;
            const char* a2 = last ? nA : cA + (size_t)(t + 2) * kstep; const char* b2 = last ? nB : cB + (size_t)(t + 2) * kstep;
            const char* a3 = a2 + kstep; const char* b3 = b2 + kstep;
            if (last && has_next) S.a_ready(nxt);
            if constexpr (SP2) {
            PG8_LDB(B0, 0, 0); PG8_LDB(B1, 0, 1); PG8_SCHED; PG8_LDA(At, 0, 0); PG8_STAGE(PG8_SA(1, 1), a1 + hstep, voffA);
            PG8_WAIT_V(8); PG8_WAIT_L(0); PG8_BAR; PG8_MMA(0, 0, At, B0); PG8_MMA(0, 1, At, B1); PG8_BAR; PG8_SCHED;
            PG8_LDA(At, 0, 1); PG8_STAGE(PG8_SB(0, 0), b2, voffB); PG8_STAGE(PG8_SB(0, 1), b2 + hstep, voffB); PG8_STAGE(PG8_SA(0, 0), a2, voffA);
            PG8_WAIT_V(8); PG8_WAIT_L(0); PG8_BAR; PG8_MMA(1, 0, At, B0); PG8_MMA(1, 1, At, B1); PG8_BAR; PG8_SCHED;
            PG8_LDB(B0, 1, 0); PG8_LDB(B1, 1, 1); PG8_SCHED; PG8_LDA(At, 1, 0); PG8_STAGE(PG8_SA(0, 1), a2 + hstep, voffA);
            PG8_WAIT_V(8); PG8_WAIT_L(0); PG8_BAR; PG8_MMA(0, 0, At, B0); PG8_MMA(0, 1, At, B1); PG8_BAR; PG8_SCHED;
            PG8_LDA(At, 1, 1); PG8_STAGE(PG8_SB(1, 0), b3, voffB); PG8_STAGE(PG8_SB(1, 1), b3 + hstep, voffB); PG8_STAGE(PG8_SA(1, 0), a3, voffA);
            PG8_WAIT_V(8); PG8_WAIT_L(0); PG8_BAR; PG8_MMA(1, 0, At, B0); PG8_MMA(1, 1, At, B1); PG8_BAR; PG8_SCHED;
            } else {
            PG8_LDB(B0, 0, 0); PG8_SCHED; PG8_LDA(At, 0, 0); PG8_STAGE(PG8_SA(1, 1), a1 + hstep, voffA);
            PG8_WAIT_L(8); PG8_BAR; PG8_WAIT_L(0); PG8_MMA(0, 0, At, B0); PG8_BAR; PG8_SCHED;
            PG8_LDB(B1, 0, 1); PG8_STAGE(PG8_SB(0, 0), b2, voffB);
            PG8_BAR; PG8_WAIT_L(0); PG8_MMA(0, 1, At, B1); PG8_BAR;
            PG8_LDA(At, 0, 1); PG8_STAGE(PG8_SA(0, 0), a2, voffA);
            PG8_BAR; PG8_WAIT_L(0); PG8_MMA(1, 0, At, B0); PG8_BAR; PG8_SCHED;
            PG8_STAGE(PG8_SB(0, 1), b2 + hstep, voffB);
            PG8_WAIT_V(6); PG8_BAR; PG8_MMA(1, 1, At, B1); PG8_BAR;
            PG8_LDB(B0, 1, 0); PG8_SCHED; PG8_LDA(At, 1, 0); PG8_STAGE(PG8_SA(0, 1), a2 + hstep, voffA);
            PG8_WAIT_L(8); PG8_BAR; PG8_WAIT_L(0); PG8_MMA(0, 0, At, B0); PG8_BAR; PG8_SCHED;
            PG8_LDB(B1, 1, 1); PG8_STAGE(PG8_SB(1, 0), b3, voffB);
            PG8_BAR; PG8_WAIT_L(0); PG8_MMA(0, 1, At, B1); PG8_BAR;
            PG8_LDA(At, 1, 1); PG8_STAGE(PG8_SA(1, 0), a3, voffA);
            PG8_BAR; PG8_WAIT_L(0); PG8_MMA(1, 0, At, B0); PG8_BAR; PG8_SCHED;
            PG8_STAGE(PG8_SB(1, 1), b3 + hstep, voffB);
            PG8_WAIT_V(6); PG8_BAR; PG8_MMA(1, 1, At, B1); PG8_BAR;
            }
        }
        if constexpr (ALIGN_EPI) { if (wr == 0) PG8_BAR; }
        if constexpr (!Epi::AFTER_DRAIN) { E(acc, cur, wr, wc, fr, fq); S.done(cur); }
        if (!has_next) break;
#pragma unroll
        for (int a = 0; a < 2; ++a)
#pragma unroll
            for (int b = 0; b < 2; ++b)
#pragma unroll
                for (int m = 0; m < 4; ++m)
#pragma unroll
                    for (int n = 0; n < 2; ++n) acc[a][b][m][n] = (f32x4){0.f, 0.f, 0.f, 0.f};
        cur = nxt; cA = nA; cB = nB; ++ui;
        if constexpr (ALIGN_EPI) { if (wr == 1) PG8_BAR; }
    }
    PG8_WAIT_V(0);
    if constexpr (!ALIGN_EPI) { if (wr == 0) PG8_BAR; }
    PG8_BAR;
    if constexpr (Epi::AFTER_DRAIN) { E.fused(acc, cur, wr, wc, fr, fq, lds, wid, lane); S.done(cur); }
#undef PG8_SA
#undef PG8_SB
#undef PG8_STAGE
#undef PG8_LDA
#undef PG8_LDB
#undef PG8_MMA
#undef PG8_WAIT_V
#undef PG8_WAIT_L
#undef PG8_BAR
#undef PG8_SCHED
}
}

#include <hip/hip_bf16.h>
#include <cmath>
namespace attn_body {
using bf16=__hip_bfloat16;
using bf16x8=__attribute__((ext_vector_type(8)))short;
using s16x4=__attribute__((ext_vector_type(4)))short;
using f32x16=__attribute__((ext_vector_type(16)))float;
using u32x4=__attribute__((ext_vector_type(4)))unsigned;
constexpr int SEQ=16384,D=64,DM=512;
constexpr int NW=8,QBLK=32,QB=QBLK*NW,KVBLK=64,NQB=SEQ/QB;
constexpr int ATTN_PITCH=DM, ATTN_UNIT_ROWS=QB;
__device__ __forceinline__ int crow(int r,int hi){return (r&3)+8*(r>>2)+4*hi;}
#define SBAR() __builtin_amdgcn_sched_barrier(0)
__device__ __forceinline__ void cmask(f32x16&p0,f32x16&p1,int jb,int wid){
  const float NEG=-INFINITY;
  if(jb>(wid>>1)){
  #pragma unroll
  for(int r=0;r<16;++r){p0[r]=NEG;p1[r]=NEG;}}
}

constexpr int NSLOT=3, SLOTB=8192;
constexpr int LDS_K=0, LDS_V=NSLOT*SLOTB, LDS_WS=2*NSLOT*SLOTB, LDS_OST=LDS_WS+NW*64*4, LDS_BYTES=LDS_OST+NW*4096;
constexpr float C2=0.125f*1.4426950408889634f;
__device__ __forceinline__ void glds16(const void*gsrc,unsigned lds_dst){unsigned keep;
  asm volatile("s_mov_b32 %0, m0\n\ts_mov_b32 m0, %2\n\ts_nop 0\n\tglobal_load_lds_dwordx4 %1, off\n\ts_mov_b32 m0, %0":"=&s"(keep):"v"(gsrc),"s"(lds_dst):"memory");}
__device__ __forceinline__ float max3f(float a,float b,float c){float r;asm("v_max3_f32 %0, %1, %2, %3":"=v"(r):"v"(a),"v"(b),"v"(c));return r;}
__device__ __forceinline__ float max2f(float a,float b){float r;asm("v_max_f32_e32 %0, %1, %2":"=v"(r):"v"(a),"v"(b));return r;}
__device__ __forceinline__ float fadd_s(float a,float b){float r;asm("v_add_f32_e32 %0, %1, %2":"=v"(r):"v"(a),"v"(b));return r;}
__device__ __forceinline__ float fsub_s(float a,float b){float r;asm("v_sub_f32_e32 %0, %1, %2":"=v"(r):"v"(a),"v"(b));return r;}
typedef float f32x2_t __attribute__((ext_vector_type(2))); typedef __bf16 bf16x2_t __attribute__((ext_vector_type(2)));
__device__ __forceinline__ unsigned cvtpk_s(float lo,float hi){f32x2_t v={lo,hi};bf16x2_t b=__builtin_convertvector(v,bf16x2_t);return __builtin_bit_cast(unsigned,b);}
#define WAIT_BAR(N) asm volatile("s_waitcnt vmcnt(" #N ") lgkmcnt(0)\n\ts_barrier":::"memory")

__device__ __forceinline__ void qkt(f32x16&p0,f32x16&p1,const char*Kslot,const bf16x8*qr,const f32x16&negm,int r32,int hi){
  const char*kb=Kslot+hi*1024+r32*16;
  #pragma unroll
  for(int d0=0;d0<4;++d0){
    const bf16x8 b0=*reinterpret_cast<const bf16x8*>(kb+d0*2048);
    const bf16x8 b1=*reinterpret_cast<const bf16x8*>(kb+d0*2048+512);
    if(d0==0){p0=__builtin_amdgcn_mfma_f32_32x32x16_bf16(b0,qr[0],negm,0,0,0);p1=__builtin_amdgcn_mfma_f32_32x32x16_bf16(b1,qr[0],negm,0,0,0);}
    else{p0=__builtin_amdgcn_mfma_f32_32x32x16_bf16(b0,qr[d0],p0,0,0,0);p1=__builtin_amdgcn_mfma_f32_32x32x16_bf16(b1,qr[d0],p1,0,0,0);}}
}
typedef __attribute__((address_space(3))) const char* lds_cptr;
typedef short v4i16_t __attribute__((ext_vector_type(4)));
__device__ __forceinline__ void kload8(bf16x8*kf,lds_cptr kp){
  kf[0]=*(const __attribute__((address_space(3))) bf16x8*)(kp);      kf[1]=*(const __attribute__((address_space(3))) bf16x8*)(kp+512);
  kf[2]=*(const __attribute__((address_space(3))) bf16x8*)(kp+2048); kf[3]=*(const __attribute__((address_space(3))) bf16x8*)(kp+2560);
  kf[4]=*(const __attribute__((address_space(3))) bf16x8*)(kp+4096); kf[5]=*(const __attribute__((address_space(3))) bf16x8*)(kp+4608);
  kf[6]=*(const __attribute__((address_space(3))) bf16x8*)(kp+6144); kf[7]=*(const __attribute__((address_space(3))) bf16x8*)(kp+6656);
}
__device__ __forceinline__ void kload2(bf16x8*kf,lds_cptr kp,int j){ kf[2*j]=*(const __attribute__((address_space(3))) bf16x8*)(kp+j*2048); kf[2*j+1]=*(const __attribute__((address_space(3))) bf16x8*)(kp+j*2048+512); }
__device__ __forceinline__ s16x4 vtr(lds_cptr p){ return __builtin_bit_cast(s16x4,__builtin_amdgcn_ds_read_tr16_b64_v4i16((__attribute__((address_space(3))) v4i16_t*)p)); }
__device__ __forceinline__ float rowmax(const f32x16&p0,const f32x16&p1){
  float a=max3f(p0[0],p0[1],p1[0]),b=max3f(p0[2],p0[3],p1[1]);a=max3f(a,p1[2],p1[3]);
  #pragma unroll
  for(int r=4;r<16;r+=4){a=max3f(a,p0[r],p0[r+1]);b=max3f(b,p0[r+2],p0[r+3]);a=max3f(a,p1[r],p1[r+1]);b=max3f(b,p1[r+2],p1[r+3]);}
  const float m=max2f(a,b);
  auto rr=__builtin_amdgcn_permlane32_swap(__float_as_uint(m),__float_as_uint(m),false,false);
  return max2f(__uint_as_float(rr[0]),__uint_as_float(rr[1]));
}
__device__ __forceinline__ void pv(f32x16*o,int vb,bf16x8 pa0,bf16x8 pa1,bf16x8 pa2,bf16x8 pa3){
  #pragma unroll
  for(int d0=0;d0<2;++d0){s16x4 lo[4],hi[4];
    #pragma unroll
    for(int ks=0;ks<4;++ks){
      asm volatile("ds_read_b64_tr_b16 %0,%1 offset:%c2":"=&v"(lo[ks]):"v"(vb),"i"(d0*4096+ks*1024):"memory");
      asm volatile("ds_read_b64_tr_b16 %0,%1 offset:%c2":"=&v"(hi[ks]):"v"(vb),"i"(d0*4096+ks*1024+512):"memory");}
    asm volatile("s_waitcnt lgkmcnt(0)":::"memory");SBAR();
    #define PK(k) (bf16x8){lo[k][0],lo[k][1],lo[k][2],lo[k][3],hi[k][0],hi[k][1],hi[k][2],hi[k][3]}
    o[d0]=__builtin_amdgcn_mfma_f32_32x32x16_bf16(pa0,PK(0),o[d0],0,0,0);
    o[d0]=__builtin_amdgcn_mfma_f32_32x32x16_bf16(pa1,PK(1),o[d0],0,0,0);
    o[d0]=__builtin_amdgcn_mfma_f32_32x32x16_bf16(pa2,PK(2),o[d0],0,0,0);
    o[d0]=__builtin_amdgcn_mfma_f32_32x32x16_bf16(pa3,PK(3),o[d0],0,0,0);
    #undef PK
  }
}

#ifndef ATTN_STORE16
#define ATTN_STORE16(p,v) (*(u32x4*)(p)=(v))
#endif
template<int THRL> __device__ __forceinline__ void attn_unit(int qcol,int vcol,int qb,const bf16*Q,const bf16*__restrict__ K,const bf16*__restrict__ V,bf16*O,char*shm){
  const int tid=threadIdx.x,lane=tid&63,r32=lane&31,hi=lane>>5; const int wid=__builtin_amdgcn_readfirstlane(tid>>6);
  const long rowbase=0; const int q0=qb*QB;
  const bf16*Qw=Q+(rowbase+q0+wid*QBLK)*DM+qcol;
  const bf16*Kh=K+rowbase*DM+qcol,*Vh=V+rowbase*DM+vcol;
  const unsigned lds0=(unsigned)(uintptr_t)shm;
  float*wsf=(float*)(shm+LDS_WS)+wid*64;
  const bf16*ksrc=Kh+(long)lane*DM+wid*8;
  const bf16*vsrc=Vh+(long)(16*(wid&3)+(lane>>2))*DM+(wid>>2)*32+(lane&3)*8;
  const unsigned kdst=lds0+LDS_K+wid*1024, vdst=lds0+LDS_V+wid*1024;
  #define DMA_K(t,slot) glds16(ksrc+(long)(t)*KVBLK*DM,(unsigned)__builtin_amdgcn_readfirstlane(kdst+(slot)))
  #define DMA_V(t,slot) glds16(vsrc+(long)(t)*KVBLK*DM,(unsigned)__builtin_amdgcn_readfirstlane(vdst+(slot)))
  const int vb0=(int)(lds0+LDS_V)+((lane>>4)&1)*32+(lane&3)*8+(4*hi+((lane&15)>>2))*64;
  const char*Kbase=shm+LDS_K; bf16x8 kf[8];
  const lds_cptr shm3=(lds_cptr)shm; const lds_cptr kp0=shm3+LDS_K+hi*1024+r32*16; const lds_cptr vp0=shm3+LDS_V+((lane>>4)&1)*32+(lane&3)*8+(4*hi+((lane&15)>>2))*64;
  const int NT=(q0+QB)/KVBLK;
  DMA_K(0,0);DMA_V(0,0);DMA_K(1,SLOTB);
  bf16x8 qr[4];
  #pragma unroll
  for(int d0=0;d0<4;++d0)qr[d0]=*reinterpret_cast<const bf16x8*>(&Qw[(long)r32*DM+d0*16+hi*8]);
  float mhat=0.f,l_reg=0.f;f32x16 o[2];o[0]=f32x16{};o[1]=f32x16{};f32x16 negm=f32x16{};asm volatile("":"+v"(negm));
  const int qrel=wid*QBLK+r32;
  #define CMASK(P0,P1,t) do{int jb_=(t)-(NT-4); if(jb_>=0)cmask(P0,P1,jb_,wid);}while(0)
  bool resc=false;
  #define START(P0,P1) do{ const float rm=rowmax(P0,P1); resc=false; \
    { const float dl=rm; mhat=fadd_s(mhat,dl); \
      _Pragma("unroll") for(int r=0;r<16;++r){P0[r]=fsub_s(P0[r],dl);P1[r]=fsub_s(P1[r],dl);} \
      _Pragma("unroll") for(int r=0;r<16;++r)negm[r]=-mhat; asm volatile("":"+v"(negm)); } \
    _Pragma("unroll") for(int r=0;r<16;++r)P0[r]=__builtin_amdgcn_exp2f(P0[r]); }while(0)
  #define RESC() do{ if(resc){ asm volatile("s_waitcnt lgkmcnt(0)":::"memory"); \
      _Pragma("unroll") for(int d_=0;d_<2;++d_) _Pragma("unroll") for(int r=0;r<16;++r)o[d_][r]*=wsf[crow(r,hi)]; } }while(0)
  f32x16 pA0,pA1,pB0,pB1;
  int sl_prev=0,sl_cur=0,sl_next=SLOTB;
  #define ROT() do{sl_prev=sl_cur;sl_cur=sl_next;sl_next=(sl_next==(NSLOT-1)*SLOTB)?0:sl_next+SLOTB;}while(0)
  DMA_K(2,2*SLOTB);
  WAIT_BAR(3);
  qkt(pA0,pA1,Kbase,qr,negm,r32,hi);asm volatile("s_nop 15\n\ts_nop 7":"+v"(pA0),"+v"(pA1));CMASK(pA0,pA1,0);
  START(pA0,pA1);
  _Pragma("unroll") for(int r=0;r<16;++r)pA1[r]=__builtin_amdgcn_exp2f(pA1[r]);
  WAIT_BAR(0);
  DMA_K(3,0);DMA_V(1,SLOTB);
  ROT();
  kload8(kf,kp0+sl_cur);
  WAIT_BAR(2);
  s16x4 vlo[8],vhi[8]; u32x4 pw0,pw1,pw2,pw3;
  #define PKW(P,B) cvtpk_s(P[B],P[B+1])
  #define PAF(k) __builtin_bit_cast(bf16x8,pw##k)
  #define VFR(i) (bf16x8){vlo[i][0],vlo[i][1],vlo[i][2],vlo[i][3],vhi[i][0],vhi[i][1],vhi[i][2],vhi[i][3]}
  #define PIN(x) asm volatile("":"+v"(x))
  #define MX3(a,b,c) __builtin_fmaxf(__builtin_fmaxf((a),(b)),(c))
  #define GAPA(MF,A0,A1,A2,A3,W0,W1,PW) do{ MF; sacc+=A0; sacc+=A1; sacc+=A2; sacc+=A3; PIN(sacc); W0; W1; PIN(PW); SBAR(); }while(0)
  #define EX(v) __builtin_amdgcn_exp2f(v)
  #define GAPB(MF,X,B) do{ MF; X[B]=EX(X[B]); X[B+1]=EX(X[B+1]); X[B+2]=EX(X[B+2]); X[B+3]=EX(X[B+3]); PIN(X); SBAR(); }while(0)
  #define VRD(i) do{ vlo[i]=vtr(vp_+(((i)>>2)*4096+((i)&3)*1024)); vhi[i]=vtr(vp_+(((i)>>2)*4096+((i)&3)*1024+512)); }while(0)
  #define KRD(G,j) do{ if(G){ kload2(kf,kp0+sl_next,j); SBAR(); } }while(0)
  #define STEP(C0,C1,P0,P1,t,GK,GV,GL) do{ SBAR(); \
    const lds_cptr vp_=vp0+sl_prev; \
    VRD(0); SBAR(); float sacc=(P0[0]+P0[1]); \
    GAPA(C0=__builtin_amdgcn_mfma_f32_32x32x16_bf16(kf[0],qr[0],negm,0,0,0), P0[2],P0[3],P0[4],P0[5],     pw0[0]=PKW(P0,0), pw0[1]=PKW(P0,2), pw0); \
    VRD(4); SBAR(); GAPA(C1=__builtin_amdgcn_mfma_f32_32x32x16_bf16(kf[1],qr[0],negm,0,0,0), P0[6],P0[7],P0[8],P0[9],     pw0[2]=PKW(P0,4), pw0[3]=PKW(P0,6), pw0); \
    VRD(1); SBAR(); GAPA(C0=__builtin_amdgcn_mfma_f32_32x32x16_bf16(kf[2],qr[1],C0,0,0,0),   P0[10],P0[11],P0[12],P0[13], pw1[0]=PKW(P0,8), pw1[1]=PKW(P0,10), pw1); \
    VRD(5); SBAR(); GAPA(C1=__builtin_amdgcn_mfma_f32_32x32x16_bf16(kf[3],qr[1],C1,0,0,0),   P0[14],P0[15],P1[0],P1[1],   pw1[2]=PKW(P0,12),pw1[3]=PKW(P0,14), pw1); \
    VRD(2); SBAR(); GAPA(C0=__builtin_amdgcn_mfma_f32_32x32x16_bf16(kf[4],qr[2],C0,0,0,0),   P1[2],P1[3],P1[4],P1[5],     pw2[0]=PKW(P1,0), pw2[1]=PKW(P1,2), pw2); \
    VRD(6); SBAR(); GAPA(C1=__builtin_amdgcn_mfma_f32_32x32x16_bf16(kf[5],qr[2],C1,0,0,0),   P1[6],P1[7],P1[8],P1[9],     pw2[2]=PKW(P1,4), pw2[3]=PKW(P1,6), pw2); \
    VRD(3); SBAR(); GAPA(C0=__builtin_amdgcn_mfma_f32_32x32x16_bf16(kf[6],qr[3],C0,0,0,0),   P1[10],P1[11],P1[12],P1[13], pw3[0]=PKW(P1,8), pw3[1]=PKW(P1,10), pw3); \
    VRD(7); SBAR(); GAPA(C1=__builtin_amdgcn_mfma_f32_32x32x16_bf16(kf[7],qr[3],C1,0,0,0),   P1[14],P1[15],0.f,0.f,       pw3[2]=PKW(P1,12),pw3[3]=PKW(P1,14), pw3); \
    l_reg+=sacc; \
    if(GK){DMA_K((t)+3,sl_cur);} if(GV){DMA_V((t)+1,sl_next);} \
    CMASK(C0,C1,t); \
    { float a=MX3(C0[0],C0[1],C1[0]),b=MX3(C0[2],C0[3],C1[1]); a=MX3(a,C1[2],C1[3]); \
      _Pragma("unroll") for(int r=4;r<16;r+=4){a=MX3(a,C0[r],C0[r+1]);b=MX3(b,C0[r+2],C0[r+3]);a=MX3(a,C1[r],C1[r+1]);b=MX3(b,C1[r+2],C1[r+3]);} \
      float rm=__builtin_fmaxf(a,b); { auto rr=__builtin_amdgcn_permlane32_swap(__float_as_uint(rm),__float_as_uint(rm),false,false); rm=__builtin_fmaxf(__uint_as_float(rr[0]),__uint_as_float(rr[1])); } \
      resc=false; \
      if(__builtin_expect(__any(rm>(float)THRL),0)){ const float dl=__builtin_fmaxf(rm,0.f); mhat+=dl; \
        _Pragma("unroll") for(int r=0;r<16;++r){C0[r]-=dl;C1[r]-=dl;} \
        _Pragma("unroll") for(int r=0;r<16;++r)negm[r]=-mhat; asm volatile("":"+v"(negm)); \
        const float f=__builtin_amdgcn_exp2f(-dl); l_reg*=f; if(hi==0)wsf[r32]=f; resc=true; } } \
    SBAR(); \
    GAPB(o[0]=__builtin_amdgcn_mfma_f32_32x32x16_bf16(PAF(0),VFR(0),o[0],0,0,0), C0,0); \
    GAPB(o[1]=__builtin_amdgcn_mfma_f32_32x32x16_bf16(PAF(0),VFR(4),o[1],0,0,0), C0,4); \
    KRD(GL,0); GAPB(o[0]=__builtin_amdgcn_mfma_f32_32x32x16_bf16(PAF(1),VFR(1),o[0],0,0,0), C0,8); \
    KRD(GL,1); GAPB(o[1]=__builtin_amdgcn_mfma_f32_32x32x16_bf16(PAF(1),VFR(5),o[1],0,0,0), C0,12); \
    KRD(GL,2); GAPB(o[0]=__builtin_amdgcn_mfma_f32_32x32x16_bf16(PAF(2),VFR(2),o[0],0,0,0), C1,0); \
    KRD(GL,3); GAPB(o[1]=__builtin_amdgcn_mfma_f32_32x32x16_bf16(PAF(2),VFR(6),o[1],0,0,0), C1,4); \
    GAPB(o[0]=__builtin_amdgcn_mfma_f32_32x32x16_bf16(PAF(3),VFR(3),o[0],0,0,0), C1,8); \
    GAPB(o[1]=__builtin_amdgcn_mfma_f32_32x32x16_bf16(PAF(3),VFR(7),o[1],0,0,0), C1,12); \
    }while(0)
  int t=1;
  #undef CMASK
  #define CMASK(P0,P1,t) do{}while(0)
  for(;t+5<NT;t+=2){
    STEP(pB0,pB1,pA0,pA1,t,true,true,true);     WAIT_BAR(2); RESC(); ROT();
    STEP(pA0,pA1,pB0,pB1,t+1,true,true,true);   WAIT_BAR(2); RESC(); ROT();
  }
  #undef CMASK
  #define CMASK(P0,P1,t) do{int jb_=(t)-(NT-4); if(jb_>=0)cmask(P0,P1,jb_,wid);}while(0)
  #define ENDW(tt) do{ if((tt)+3<NT){WAIT_BAR(2);} else if((tt)+2<NT){WAIT_BAR(1);} else {WAIT_BAR(0);} }while(0)
  for(;t+1<NT;t+=2){
    STEP(pB0,pB1,pA0,pA1,t,(t+3<NT),(t+1<NT),(t+1<NT));       ENDW(t);   RESC(); ROT();
    STEP(pA0,pA1,pB0,pB1,t+1,(t+4<NT),(t+2<NT),(t+2<NT));     ENDW(t+1); RESC(); ROT();
  }
  STEP(pB0,pB1,pA0,pA1,NT-1,false,false,false); RESC();
  { float sacc=pB0[0]+pB0[1]; _Pragma("unroll") for(int r=2;r<16;++r)sacc+=pB0[r]; _Pragma("unroll") for(int r=0;r<16;++r)sacc+=pB1[r]; l_reg+=sacc;
    pw0=(u32x4){PKW(pB0,0),PKW(pB0,2),PKW(pB0,4),PKW(pB0,6)};pw1=(u32x4){PKW(pB0,8),PKW(pB0,10),PKW(pB0,12),PKW(pB0,14)};pw2=(u32x4){PKW(pB1,0),PKW(pB1,2),PKW(pB1,4),PKW(pB1,6)};pw3=(u32x4){PKW(pB1,8),PKW(pB1,10),PKW(pB1,12),PKW(pB1,14)};
    SBAR(); pv(o,vb0+sl_cur,PAF(0),PAF(1),PAF(2),PAF(3)); }
  #undef PKW
  #undef PAF
  #undef VFR
  #undef PIN
  #undef MX3
  #undef GAPA
  #undef GAPB
  #undef EX
  #undef VRD
  #undef KRD
  #undef STEP
  #undef ENDW
  {auto rr=__builtin_amdgcn_permlane32_swap(__float_as_uint(l_reg),__float_as_uint(l_reg),false,false);l_reg=__uint_as_float(rr[0])+__uint_as_float(rr[1]);}
  if(hi==0)wsf[32+r32]=l_reg;asm volatile("s_waitcnt lgkmcnt(0)":::"memory");
  float rli[16];
  #pragma unroll
  for(int r=0;r<16;++r)rli[r]=__builtin_amdgcn_rcpf(wsf[32+crow(r,hi)]);
  bf16*Ow=O+(rowbase+q0+wid*QBLK)*DM+vcol;
  { bf16*stg=(bf16*)(shm+LDS_OST)+wid*2048;
    #pragma unroll
    for(int r=0;r<16;++r){const int orow=crow(r,hi);
      #pragma unroll
      for(int d0=0;d0<2;++d0)stg[orow*64+d0*32+r32]=__float2bfloat16(o[d0][r]*rli[r]);}
    asm volatile("s_waitcnt lgkmcnt(0)":::"memory");
    #pragma unroll
    for(int i=0;i<4;++i){const int row=i*8+(lane>>3),ch=lane&7; const u32x4 v=*(const u32x4*)(stg+row*64+ch*8); ATTN_STORE16(Ow+(long)row*DM+ch*8,v);} }
  asm volatile("s_waitcnt lgkmcnt(0)\n\ts_barrier":::"memory");
  #undef DMA_K
  #undef DMA_V
  #undef CMASK
  #undef START
  #undef RESC
  #undef ROT
}
constexpr int ATTN_LDS_BYTES=LDS_BYTES;
struct AttnTensors { const bf16* Q; const bf16* K; const bf16* V; bf16* O; };
struct AttnUnit { int var; int qb; };
struct StaticOrder {
  int vcu;
  __device__ __forceinline__ explicit StaticOrder(int v):vcu(v){}
  __device__ __forceinline__ bool next(int i,AttnUnit&u)const{ if(i>=4)return false; const int s=vcu&15; u.var=vcu>>4; u.qb=(i==0)?s:(i==1)?31-s:(i==2)?32+s:63-s; return true; }
};
template<class Sched,int THRL=8> __device__ __forceinline__ void attn_phase(char*lds,const AttnTensors&T,const Sched&S){
  AttnUnit u;
  for(int i=0;S.next(i,u);++i){ const int h=u.var>>2,mp=(u.var>>1)&1,vh=u.var&1;
    attn_unit<THRL>(h*128+mp*64,h*128+vh*64,u.qb,T.Q,T.K,T.V,T.O+(size_t)mp*SEQ*DM,lds); }
}
#undef SBAR
#undef WAIT_BAR
}
namespace attn128 {
using bf16=__hip_bfloat16;
using bf16x8=__attribute__((ext_vector_type(8)))short;
using s16x4=__attribute__((ext_vector_type(4)))short;
using f32x16=__attribute__((ext_vector_type(16)))float;
using u32x4=__attribute__((ext_vector_type(4)))unsigned;
constexpr int SEQ=16384,D=64,DM=512;
constexpr int NW=8,QBLK=32,QB=QBLK*NW,KVBLK=64,NQB=SEQ/QB;
constexpr int ATTN_PITCH=DM, ATTN_UNIT_ROWS=QB;
__device__ __forceinline__ int crow(int r,int hi){return (r&3)+8*(r>>2)+4*hi;}
#define SBAR() __builtin_amdgcn_sched_barrier(0)
__device__ __forceinline__ void cmask(f32x16&p0,f32x16&p1,int jb,int wid){
  const float NEG=-INFINITY;
  if(jb>(wid>>1)){
  #pragma unroll
  for(int r=0;r<16;++r){p0[r]=NEG;p1[r]=NEG;}}
}

constexpr int NSLOT=3, SLOTB=8192;
constexpr int LDS_K=0, LDS_V=NSLOT*SLOTB, LDS_WS=3*NSLOT*SLOTB, LDS_OST=LDS_WS+NW*64*4, LDS_BYTES=LDS_OST+NW*4096;
constexpr float C2=0.125f*1.4426950408889634f;
__device__ __forceinline__ void glds16(const void*gsrc,unsigned lds_dst){unsigned keep;
  asm volatile("s_mov_b32 %0, m0\n\ts_mov_b32 m0, %2\n\ts_nop 0\n\tglobal_load_lds_dwordx4 %1, off\n\ts_mov_b32 m0, %0":"=&s"(keep):"v"(gsrc),"s"(lds_dst):"memory");}
__device__ __forceinline__ float max3f(float a,float b,float c){float r;asm("v_max3_f32 %0, %1, %2, %3":"=v"(r):"v"(a),"v"(b),"v"(c));return r;}
__device__ __forceinline__ float max2f(float a,float b){float r;asm("v_max_f32_e32 %0, %1, %2":"=v"(r):"v"(a),"v"(b));return r;}
__device__ __forceinline__ float fadd_s(float a,float b){float r;asm("v_add_f32_e32 %0, %1, %2":"=v"(r):"v"(a),"v"(b));return r;}
__device__ __forceinline__ float fsub_s(float a,float b){float r;asm("v_sub_f32_e32 %0, %1, %2":"=v"(r):"v"(a),"v"(b));return r;}
typedef float f32x2_t __attribute__((ext_vector_type(2))); typedef __bf16 bf16x2_t __attribute__((ext_vector_type(2)));
__device__ __forceinline__ unsigned cvtpk_s(float lo,float hi){f32x2_t v={lo,hi};bf16x2_t b=__builtin_convertvector(v,bf16x2_t);return __builtin_bit_cast(unsigned,b);}
#define WAIT_BAR(N) asm volatile("s_waitcnt vmcnt(" #N ") lgkmcnt(0)\n\ts_barrier":::"memory")

__device__ __forceinline__ void qkt(f32x16&p0,f32x16&p1,const char*Kslot,const bf16x8*qr,const f32x16&negm,int r32,int hi){
  const char*kb=Kslot+hi*1024+r32*16;
  #pragma unroll
  for(int d0=0;d0<4;++d0){
    const bf16x8 b0=*reinterpret_cast<const bf16x8*>(kb+d0*2048);
    const bf16x8 b1=*reinterpret_cast<const bf16x8*>(kb+d0*2048+512);
    if(d0==0){p0=__builtin_amdgcn_mfma_f32_32x32x16_bf16(b0,qr[0],negm,0,0,0);p1=__builtin_amdgcn_mfma_f32_32x32x16_bf16(b1,qr[0],negm,0,0,0);}
    else{p0=__builtin_amdgcn_mfma_f32_32x32x16_bf16(b0,qr[d0],p0,0,0,0);p1=__builtin_amdgcn_mfma_f32_32x32x16_bf16(b1,qr[d0],p1,0,0,0);}}
}
typedef __attribute__((address_space(3))) const char* lds_cptr;
typedef short v4i16_t __attribute__((ext_vector_type(4)));
__device__ __forceinline__ void kload8(bf16x8*kf,lds_cptr kp){
  kf[0]=*(const __attribute__((address_space(3))) bf16x8*)(kp);      kf[1]=*(const __attribute__((address_space(3))) bf16x8*)(kp+512);
  kf[2]=*(const __attribute__((address_space(3))) bf16x8*)(kp+2048); kf[3]=*(const __attribute__((address_space(3))) bf16x8*)(kp+2560);
  kf[4]=*(const __attribute__((address_space(3))) bf16x8*)(kp+4096); kf[5]=*(const __attribute__((address_space(3))) bf16x8*)(kp+4608);
  kf[6]=*(const __attribute__((address_space(3))) bf16x8*)(kp+6144); kf[7]=*(const __attribute__((address_space(3))) bf16x8*)(kp+6656);
}
__device__ __forceinline__ void kload2(bf16x8*kf,lds_cptr kp,int j){ kf[2*j]=*(const __attribute__((address_space(3))) bf16x8*)(kp+j*2048); kf[2*j+1]=*(const __attribute__((address_space(3))) bf16x8*)(kp+j*2048+512); }
__device__ __forceinline__ s16x4 vtr(lds_cptr p){ return __builtin_bit_cast(s16x4,__builtin_amdgcn_ds_read_tr16_b64_v4i16((__attribute__((address_space(3))) v4i16_t*)p)); }
__device__ __forceinline__ float rowmax(const f32x16&p0,const f32x16&p1){
  float a=max3f(p0[0],p0[1],p1[0]),b=max3f(p0[2],p0[3],p1[1]);a=max3f(a,p1[2],p1[3]);
  #pragma unroll
  for(int r=4;r<16;r+=4){a=max3f(a,p0[r],p0[r+1]);b=max3f(b,p0[r+2],p0[r+3]);a=max3f(a,p1[r],p1[r+1]);b=max3f(b,p1[r+2],p1[r+3]);}
  const float m=max2f(a,b);
  auto rr=__builtin_amdgcn_permlane32_swap(__float_as_uint(m),__float_as_uint(m),false,false);
  return max2f(__uint_as_float(rr[0]),__uint_as_float(rr[1]));
}
__device__ __forceinline__ void pv(f32x16*o,int vb,bf16x8 pa0,bf16x8 pa1,bf16x8 pa2,bf16x8 pa3){
  #pragma unroll
  for(int d0=0;d0<4;++d0){s16x4 lo[4],hi[4];
    #pragma unroll
    for(int ks=0;ks<4;++ks){
      asm volatile("ds_read_b64_tr_b16 %0,%1 offset:%c2":"=&v"(lo[ks]):"v"(vb),"i"(d0*4096+ks*1024):"memory");
      asm volatile("ds_read_b64_tr_b16 %0,%1 offset:%c2":"=&v"(hi[ks]):"v"(vb),"i"(d0*4096+ks*1024+512):"memory");}
    asm volatile("s_waitcnt lgkmcnt(0)":::"memory");SBAR();
    #define PK(k) (bf16x8){lo[k][0],lo[k][1],lo[k][2],lo[k][3],hi[k][0],hi[k][1],hi[k][2],hi[k][3]}
    o[d0]=__builtin_amdgcn_mfma_f32_32x32x16_bf16(pa0,PK(0),o[d0],0,0,0);
    o[d0]=__builtin_amdgcn_mfma_f32_32x32x16_bf16(pa1,PK(1),o[d0],0,0,0);
    o[d0]=__builtin_amdgcn_mfma_f32_32x32x16_bf16(pa2,PK(2),o[d0],0,0,0);
    o[d0]=__builtin_amdgcn_mfma_f32_32x32x16_bf16(pa3,PK(3),o[d0],0,0,0);
    #undef PK
  }
}

#ifndef ATTN_STORE16
#define ATTN_STORE16(p,v) (*(u32x4*)(p)=(v))
#endif
template<int THRL> __device__ __forceinline__ void attn_unit(int qcol,int vcol,int qb,const bf16*Q,const bf16*__restrict__ K,const bf16*__restrict__ V,bf16*O,char*shm){
  const int tid=threadIdx.x,lane=tid&63,r32=lane&31,hi=lane>>5; const int wid=__builtin_amdgcn_readfirstlane(tid>>6);
  const long rowbase=0; const int q0=qb*QB;
  const bf16*Qw=Q+(rowbase+q0+wid*QBLK)*DM+qcol;
  const bf16*Kh=K+rowbase*DM+qcol,*Vh=V+rowbase*DM+vcol;
  const unsigned lds0=(unsigned)(uintptr_t)shm;
  float*wsf=(float*)(shm+LDS_WS)+wid*64;
  const bf16*ksrc=Kh+(long)lane*DM+wid*8;
  const bf16*vsrc=Vh+(long)(16*(wid&3)+(lane>>2))*DM+(wid>>2)*32+(lane&3)*8;
  const unsigned kdst=lds0+LDS_K+wid*1024, vdst=lds0+LDS_V+wid*1024;
  #define DMA_K(t,slot) glds16(ksrc+(long)(t)*KVBLK*DM,(unsigned)__builtin_amdgcn_readfirstlane(kdst+(slot)))
  #define DMA_V(t,slot) do{ glds16(vsrc+(long)(t)*KVBLK*DM,(unsigned)__builtin_amdgcn_readfirstlane(vdst+2*(slot))); glds16(vsrc+64+(long)(t)*KVBLK*DM,(unsigned)__builtin_amdgcn_readfirstlane(vdst+2*(slot)+8192)); }while(0)
  const int vb0=(int)(lds0+LDS_V)+((lane>>4)&1)*32+(lane&3)*8+(4*hi+((lane&15)>>2))*64;
  const char*Kbase=shm+LDS_K; bf16x8 kf[8];
  const lds_cptr shm3=(lds_cptr)shm; const lds_cptr kp0=shm3+LDS_K+hi*1024+r32*16; const lds_cptr vp0=shm3+LDS_V+((lane>>4)&1)*32+(lane&3)*8+(4*hi+((lane&15)>>2))*64;
  const int NT=(q0+QB)/KVBLK;
  DMA_K(0,0);DMA_V(0,0);DMA_K(1,SLOTB);
  bf16x8 qr[4];
  #pragma unroll
  for(int d0=0;d0<4;++d0)qr[d0]=*reinterpret_cast<const bf16x8*>(&Qw[(long)r32*DM+d0*16+hi*8]);
  float mhat=0.f,l_reg=0.f;f32x16 o[4];o[0]=f32x16{};o[1]=f32x16{};o[2]=f32x16{};o[3]=f32x16{};const f32x16 negm=f32x16{};
  const int qrel=wid*QBLK+r32;
  #define CMASK(P0,P1,t) do{int jb_=(t)-(NT-4); if(jb_>=0)cmask(P0,P1,jb_,wid);}while(0)
  bool resc=false;
  #define START(P0,P1) do{ const float rm=rowmax(P0,P1); resc=false; \
    { const float dl=rm; mhat=fadd_s(mhat,dl); \
      _Pragma("unroll") for(int r=0;r<16;++r){P0[r]=fsub_s(P0[r],dl);P1[r]=fsub_s(P1[r],dl);} \
      } \
    _Pragma("unroll") for(int r=0;r<16;++r)P0[r]=__builtin_amdgcn_exp2f(P0[r]); }while(0)
  #define RESC() do{ if(resc){ asm volatile("s_waitcnt lgkmcnt(0)":::"memory"); \
      _Pragma("unroll") for(int d_=0;d_<4;++d_) _Pragma("unroll") for(int r=0;r<16;++r)o[d_][r]*=wsf[crow(r,hi)]; } }while(0)
  f32x16 pA0,pA1,pB0,pB1;
  int sl_prev=0,sl_cur=0,sl_next=SLOTB;
  #define ROT() do{sl_prev=sl_cur;sl_cur=sl_next;sl_next=(sl_next==(NSLOT-1)*SLOTB)?0:sl_next+SLOTB;}while(0)
  DMA_K(2,2*SLOTB);
  WAIT_BAR(4);
  qkt(pA0,pA1,Kbase,qr,negm,r32,hi);asm volatile("s_nop 15\n\ts_nop 7":"+v"(pA0),"+v"(pA1));CMASK(pA0,pA1,0);
  START(pA0,pA1);
  _Pragma("unroll") for(int r=0;r<16;++r)pA1[r]=__builtin_amdgcn_exp2f(pA1[r]);
  WAIT_BAR(0);
  DMA_K(3,0);DMA_V(1,SLOTB);
  ROT();
  kload8(kf,kp0+sl_cur);
  WAIT_BAR(3);
  s16x4 vlo[8],vhi[8]; u32x4 pw0,pw1,pw2,pw3;
  #define PKW(P,B) cvtpk_s(P[B],P[B+1])
  #define PAF(k) __builtin_bit_cast(bf16x8,pw##k)
  #define VFR(i) (bf16x8){vlo[i][0],vlo[i][1],vlo[i][2],vlo[i][3],vhi[i][0],vhi[i][1],vhi[i][2],vhi[i][3]}
  #define PIN(x) asm volatile("":"+v"(x))
  #define MX3(a,b,c) __builtin_fmaxf(__builtin_fmaxf((a),(b)),(c))
  #define GAPA(MF,A0,A1,A2,A3,W0,W1,PW) do{ MF; sacc+=A0; sacc+=A1; sacc+=A2; sacc+=A3; PIN(sacc); W0; W1; PIN(PW); SBAR(); }while(0)
  #define EX(v) __builtin_amdgcn_exp2f(v)
  #define GAPB(MF,X,B) do{ MF; X[B]=EX(X[B]); X[B+1]=EX(X[B+1]); X[B+2]=EX(X[B+2]); X[B+3]=EX(X[B+3]); PIN(X); SBAR(); }while(0)
  #define VRD(i) do{ vlo[i]=vtr(vp_+(((i)>>2)*4096+((i)&3)*1024)); vhi[i]=vtr(vp_+(((i)>>2)*4096+((i)&3)*1024+512)); }while(0)
  #define VRD2(i) do{ vlo[i]=vtr(vp_+((2+((i)>>2))*4096+((i)&3)*1024)); vhi[i]=vtr(vp_+((2+((i)>>2))*4096+((i)&3)*1024+512)); SBAR(); }while(0)
  #define GAPB2(MF,X,B) do{ MF; X[B]=EX(X[B]-mhat); X[B+1]=EX(X[B+1]-mhat); PIN(X); SBAR(); }while(0)
  #define KRD(G,j) do{ if(G){ kload2(kf,kp0+sl_next,j); SBAR(); } }while(0)
  #define STEP(C0,C1,P0,P1,t,GK,GV,GL) do{ SBAR(); \
    const lds_cptr vp_=vp0+2*sl_prev; \
    VRD(0); SBAR(); float sacc=(P0[0]+P0[1]); \
    GAPA(C0=__builtin_amdgcn_mfma_f32_32x32x16_bf16(kf[0],qr[0],negm,0,0,0), P0[2],P0[3],P0[4],P0[5],     pw0[0]=PKW(P0,0), pw0[1]=PKW(P0,2), pw0); \
    VRD(4); SBAR(); GAPA(C1=__builtin_amdgcn_mfma_f32_32x32x16_bf16(kf[1],qr[0],negm,0,0,0), P0[6],P0[7],P0[8],P0[9],     pw0[2]=PKW(P0,4), pw0[3]=PKW(P0,6), pw0); \
    VRD(1); SBAR(); GAPA(C0=__builtin_amdgcn_mfma_f32_32x32x16_bf16(kf[2],qr[1],C0,0,0,0),   P0[10],P0[11],P0[12],P0[13], pw1[0]=PKW(P0,8), pw1[1]=PKW(P0,10), pw1); \
    VRD(5); SBAR(); GAPA(C1=__builtin_amdgcn_mfma_f32_32x32x16_bf16(kf[3],qr[1],C1,0,0,0),   P0[14],P0[15],P1[0],P1[1],   pw1[2]=PKW(P0,12),pw1[3]=PKW(P0,14), pw1); \
    GAPA(C0=__builtin_amdgcn_mfma_f32_32x32x16_bf16(kf[4],qr[2],C0,0,0,0),   P1[2],P1[3],P1[4],P1[5],     pw2[0]=PKW(P1,0), pw2[1]=PKW(P1,2), pw2); \
    GAPA(C1=__builtin_amdgcn_mfma_f32_32x32x16_bf16(kf[5],qr[2],C1,0,0,0),   P1[6],P1[7],P1[8],P1[9],     pw2[2]=PKW(P1,4), pw2[3]=PKW(P1,6), pw2); \
    GAPA(C0=__builtin_amdgcn_mfma_f32_32x32x16_bf16(kf[6],qr[3],C0,0,0,0),   P1[10],P1[11],P1[12],P1[13], pw3[0]=PKW(P1,8), pw3[1]=PKW(P1,10), pw3); \
    GAPA(C1=__builtin_amdgcn_mfma_f32_32x32x16_bf16(kf[7],qr[3],C1,0,0,0),   P1[14],P1[15],0.f,0.f,       pw3[2]=PKW(P1,12),pw3[3]=PKW(P1,14), pw3); \
    l_reg+=sacc; \
    if(GK){DMA_K((t)+3,sl_cur);} if(GV){DMA_V((t)+1,sl_next);} \
    CMASK(C0,C1,t); \
    { float a=MX3(C0[0],C0[1],C1[0]),b=MX3(C0[2],C0[3],C1[1]); a=MX3(a,C1[2],C1[3]); \
      _Pragma("unroll") for(int r=4;r<16;r+=4){a=MX3(a,C0[r],C0[r+1]);b=MX3(b,C0[r+2],C0[r+3]);a=MX3(a,C1[r],C1[r+1]);b=MX3(b,C1[r+2],C1[r+3]);} \
      float rm=__builtin_fmaxf(a,b); { auto rr=__builtin_amdgcn_permlane32_swap(__float_as_uint(rm),__float_as_uint(rm),false,false); rm=__builtin_fmaxf(__uint_as_float(rr[0]),__uint_as_float(rr[1])); } \
      resc=false; const float rmr=rm-mhat; \
      if(__builtin_expect(__any(rmr>(float)THRL),0)){ const float dl=__builtin_fmaxf(rmr,0.f); mhat+=dl; \
        const float f=__builtin_amdgcn_exp2f(-dl); l_reg*=f; if(hi==0)wsf[r32]=f; resc=true; } } \
    SBAR(); \
    VRD(2); SBAR(); GAPB2(o[0]=__builtin_amdgcn_mfma_f32_32x32x16_bf16(PAF(0),VFR(0),o[0],0,0,0), C0,0); \
    VRD(6); SBAR(); GAPB2(o[1]=__builtin_amdgcn_mfma_f32_32x32x16_bf16(PAF(0),VFR(4),o[1],0,0,0), C0,2); \
    VRD(3); SBAR(); GAPB2(o[0]=__builtin_amdgcn_mfma_f32_32x32x16_bf16(PAF(1),VFR(1),o[0],0,0,0), C0,4); \
    VRD(7); SBAR(); GAPB2(o[1]=__builtin_amdgcn_mfma_f32_32x32x16_bf16(PAF(1),VFR(5),o[1],0,0,0), C0,6); \
    VRD2(0); GAPB2(o[0]=__builtin_amdgcn_mfma_f32_32x32x16_bf16(PAF(2),VFR(2),o[0],0,0,0), C0,8); \
    VRD2(4); GAPB2(o[1]=__builtin_amdgcn_mfma_f32_32x32x16_bf16(PAF(2),VFR(6),o[1],0,0,0), C0,10); \
    VRD2(1); GAPB2(o[0]=__builtin_amdgcn_mfma_f32_32x32x16_bf16(PAF(3),VFR(3),o[0],0,0,0), C0,12); \
    VRD2(5); GAPB2(o[1]=__builtin_amdgcn_mfma_f32_32x32x16_bf16(PAF(3),VFR(7),o[1],0,0,0), C0,14); \
    VRD2(2); GAPB2(o[2]=__builtin_amdgcn_mfma_f32_32x32x16_bf16(PAF(0),VFR(0),o[2],0,0,0), C1,0); \
    VRD2(6); GAPB2(o[3]=__builtin_amdgcn_mfma_f32_32x32x16_bf16(PAF(0),VFR(4),o[3],0,0,0), C1,2); \
    VRD2(3); KRD(GL,0); GAPB2(o[2]=__builtin_amdgcn_mfma_f32_32x32x16_bf16(PAF(1),VFR(1),o[2],0,0,0), C1,4); \
    VRD2(7); KRD(GL,1); GAPB2(o[3]=__builtin_amdgcn_mfma_f32_32x32x16_bf16(PAF(1),VFR(5),o[3],0,0,0), C1,6); \
    KRD(GL,2); GAPB2(o[2]=__builtin_amdgcn_mfma_f32_32x32x16_bf16(PAF(2),VFR(2),o[2],0,0,0), C1,8); \
    KRD(GL,3); GAPB2(o[3]=__builtin_amdgcn_mfma_f32_32x32x16_bf16(PAF(2),VFR(6),o[3],0,0,0), C1,10); \
    GAPB2(o[2]=__builtin_amdgcn_mfma_f32_32x32x16_bf16(PAF(3),VFR(3),o[2],0,0,0), C1,12); \
    GAPB2(o[3]=__builtin_amdgcn_mfma_f32_32x32x16_bf16(PAF(3),VFR(7),o[3],0,0,0), C1,14); \
    }while(0)
  int t=1;
  #undef CMASK
  #define CMASK(P0,P1,t) do{}while(0)
  for(;t+5<NT;t+=2){
    STEP(pB0,pB1,pA0,pA1,t,true,true,true);     WAIT_BAR(3); RESC(); ROT();
    STEP(pA0,pA1,pB0,pB1,t+1,true,true,true);   WAIT_BAR(3); RESC(); ROT();
  }
  #undef CMASK
  #define CMASK(P0,P1,t) do{int jb_=(t)-(NT-4); if(jb_>=0)cmask(P0,P1,jb_,wid);}while(0)
  #define ENDW(tt) do{ if((tt)+3<NT){WAIT_BAR(3);} else if((tt)+2<NT){WAIT_BAR(2);} else {WAIT_BAR(0);} }while(0)
  for(;t+1<NT;t+=2){
    STEP(pB0,pB1,pA0,pA1,t,(t+3<NT),(t+1<NT),(t+1<NT));       ENDW(t);   RESC(); ROT();
    STEP(pA0,pA1,pB0,pB1,t+1,(t+4<NT),(t+2<NT),(t+2<NT));     ENDW(t+1); RESC(); ROT();
  }
  STEP(pB0,pB1,pA0,pA1,NT-1,false,false,false); RESC();
  { float sacc=pB0[0]+pB0[1]; _Pragma("unroll") for(int r=2;r<16;++r)sacc+=pB0[r]; _Pragma("unroll") for(int r=0;r<16;++r)sacc+=pB1[r]; l_reg+=sacc;
    pw0=(u32x4){PKW(pB0,0),PKW(pB0,2),PKW(pB0,4),PKW(pB0,6)};pw1=(u32x4){PKW(pB0,8),PKW(pB0,10),PKW(pB0,12),PKW(pB0,14)};pw2=(u32x4){PKW(pB1,0),PKW(pB1,2),PKW(pB1,4),PKW(pB1,6)};pw3=(u32x4){PKW(pB1,8),PKW(pB1,10),PKW(pB1,12),PKW(pB1,14)};
    SBAR(); pv(o,vb0+2*sl_cur,PAF(0),PAF(1),PAF(2),PAF(3)); }
  #undef PKW
  #undef PAF
  #undef VFR
  #undef PIN
  #undef MX3
  #undef GAPA
  #undef GAPB
  #undef GAPB2
  #undef VRD2
  #undef EX
  #undef VRD
  #undef KRD
  #undef STEP
  #undef ENDW
  {auto rr=__builtin_amdgcn_permlane32_swap(__float_as_uint(l_reg),__float_as_uint(l_reg),false,false);l_reg=__uint_as_float(rr[0])+__uint_as_float(rr[1]);}
  if(hi==0)wsf[32+r32]=l_reg;asm volatile("s_waitcnt lgkmcnt(0)":::"memory");
  float rli[16];
  #pragma unroll
  for(int r=0;r<16;++r)rli[r]=__builtin_amdgcn_rcpf(wsf[32+crow(r,hi)]);
  bf16*Ow=O+(rowbase+q0+wid*QBLK)*DM+vcol;
  { bf16*stg=(bf16*)(shm+LDS_OST)+wid*2048;
    #pragma unroll
    for(int hf=0;hf<2;++hf){
    #pragma unroll
    for(int r=0;r<16;++r){const int orow=crow(r,hi);
      #pragma unroll
      for(int d0=0;d0<2;++d0)stg[orow*64+d0*32+r32]=__float2bfloat16(o[2*hf+d0][r]*rli[r]);}
    asm volatile("s_waitcnt lgkmcnt(0)":::"memory");
    #pragma unroll
    for(int i=0;i<4;++i){const int row=i*8+(lane>>3),ch=lane&7; const u32x4 v=*(const u32x4*)(stg+row*64+ch*8); ATTN_STORE16(Ow+(long)row*DM+hf*64+ch*8,v);}
    asm volatile("s_waitcnt lgkmcnt(0)":::"memory"); } }
  asm volatile("s_waitcnt lgkmcnt(0)\n\ts_barrier":::"memory");
  #undef DMA_K
  #undef DMA_V
  #undef CMASK
  #undef START
  #undef RESC
  #undef ROT
}
constexpr int ATTN_LDS_BYTES=LDS_BYTES;
struct AttnTensors { const bf16* Q; const bf16* K; const bf16* V; bf16* O; };
struct AttnUnit { int var; int qb; };
struct StaticOrder {
  int vcu;
  __device__ __forceinline__ explicit StaticOrder(int v):vcu(v){}
  __device__ __forceinline__ bool next(int i,AttnUnit&u)const{ if(i>=2)return false; const int s=vcu&31; u.var=vcu>>5; u.qb=(i==0)?s:63-s; return true; }
};
template<class Sched,int THRL=8> __device__ __forceinline__ void attn_phase(char*lds,const AttnTensors&T,const Sched&S){
  AttnUnit u;
  for(int i=0;S.next(i,u);++i){ const int h=u.var>>1,mp=u.var&1;
    attn_unit<THRL>(h*128+mp*64,h*128,u.qb,T.Q,T.K,T.V,T.O+(size_t)mp*SEQ*DM,lds); }
}
#undef SBAR
#undef WAIT_BAR
}


#define GAS __attribute__((address_space(1)))
#define LAS __attribute__((address_space(3)))
typedef unsigned short bf16;
typedef unsigned v4u __attribute__((ext_vector_type(4)));
typedef float f32x4 __attribute__((ext_vector_type(4)));
typedef short bf16x8 __attribute__((ext_vector_type(8)));
typedef GAS unsigned gu32;
typedef GAS unsigned long long gu64;
#define RLX_AGENT __ATOMIC_RELAXED, __HIP_MEMORY_SCOPE_AGENT
#define LDS_WAIT() asm volatile("s_waitcnt lgkmcnt(0)" ::: "memory")
#define VM_WAIT() asm volatile("s_waitcnt vmcnt(0)" ::: "memory")
__device__ __forceinline__ unsigned long long rt() { return __builtin_amdgcn_s_memrealtime(); }
__device__ __forceinline__ unsigned f2bf(float f) { unsigned u = __builtin_bit_cast(unsigned, f); return (u + 0x7fffu + ((u >> 16) & 1u)) >> 16; }
__device__ __forceinline__ unsigned pk2(float lo, float hi) { return f2bf(lo) | (f2bf(hi) << 16); }

#define XB_TMO      128
#define XB_XCNT(j)  (256  + 64 * (j))
#define XB_XSUB(j)  (1280 + 64 * (j))
#define XB_XGEN(j)  (2304 + 64 * (j))
#define XB_TOP      3328
#define XB_TOPGEN   3392
#define XCD_BAR_WORDS 3456
#define XB_SPIN_CAP (1u << 18)

__device__ __forceinline__ unsigned xb_ld(unsigned* p)              { return __hip_atomic_load(p, __ATOMIC_RELAXED, __HIP_MEMORY_SCOPE_AGENT); }
__device__ __forceinline__ unsigned xb_add(unsigned* p, unsigned v) { return __hip_atomic_fetch_add(p, v, __ATOMIC_RELAXED, __HIP_MEMORY_SCOPE_AGENT); }
__device__ __forceinline__ unsigned xb_xcc_id() { return (unsigned)__builtin_amdgcn_s_getreg((3 << 11) | 20) & 0xFu; }
#define XB_SPIN(cond, bar) do { unsigned _sp = 0; while (cond) { __builtin_amdgcn_s_sleep(1); \
    if ((++_sp & 255u) == 0u) { if (xb_ld(&(bar)[XB_TMO])) break; if (_sp > XB_SPIN_CAP) { atomicAdd(&(bar)[XB_TMO], 1u); break; } } } } while (0)

struct XcdBarrier {
    unsigned* bar; unsigned x;
    volatile LAS unsigned* st;
};

__device__ __forceinline__ XcdBarrier xcd_barrier_post(unsigned* bar, volatile LAS unsigned* st) {
    XcdBarrier b; b.bar = bar; b.x = xb_xcc_id(); b.st = st;
    if (threadIdx.x == 0) (void)xb_add(&bar[XB_XCNT(b.x)], 1u);
    return b;
}
__device__ __forceinline__ void xcd_barrier_complete(unsigned* bar, unsigned x, unsigned& nloc, unsigned& nx) {
    const unsigned G = gridDim.x * gridDim.y * gridDim.z;
    unsigned sum, cnt, mine, sp = 0u;
    for (;;) {
        sum = 0u; cnt = 0u; mine = 0u;
#pragma unroll
        for (unsigned j = 0; j < 16; ++j) { const unsigned c = xb_ld(&bar[XB_XCNT(j)]); sum += c; cnt += (c > 0u) ? 1u : 0u; mine = (j == x) ? c : mine; }
        if (sum == G) break;
        __builtin_amdgcn_s_sleep(1);
        if ((++sp & 255u) == 0u) { if (xb_ld(&bar[XB_TMO])) break; if (sp > XB_SPIN_CAP) { atomicAdd(&bar[XB_TMO], 1u); break; } }
    }
    nloc = mine > 0u ? mine : 1u; nx = cnt > 0u ? cnt : 1u;
}

__device__ __forceinline__ void xcd_barrier(const XcdBarrier& b) {
    asm volatile("s_waitcnt vmcnt(0)" ::: "memory");
    __syncthreads();
    if (threadIdx.x == 0) {
        unsigned* bar = b.bar;
        __builtin_amdgcn_s_waitcnt(0);
        unsigned nloc = b.st[0], nx = b.st[1];
        if (nloc == 0u) { xcd_barrier_complete(bar, b.x, nloc, nx); b.st[0] = nloc; b.st[1] = nx; }
        const unsigned old = xb_add(&bar[XB_XSUB(b.x)], 1u);
        const unsigned gen = old / nloc;
        if (old + 1u == (gen + 1u) * nloc) {
            __builtin_amdgcn_fence(__ATOMIC_RELEASE, "agent");
            asm volatile("s_waitcnt vmcnt(0)" ::: "memory");
            const unsigned og = xb_add(&bar[XB_TOP], 1u);
            const unsigned tg = og / nx;
            if (og + 1u == (tg + 1u) * nx) xb_add(&bar[XB_TOPGEN], 1u);
            else XB_SPIN(xb_ld(&bar[XB_TOPGEN]) == tg, bar);
            __builtin_amdgcn_fence(__ATOMIC_ACQUIRE, "agent");
            xb_add(&bar[XB_XGEN(b.x)], 1u);
            asm volatile("s_waitcnt vmcnt(0)" ::: "memory");
        } else {
            XB_SPIN(xb_ld(&bar[XB_XGEN(b.x)]) == gen, bar);
            __builtin_amdgcn_fence(__ATOMIC_ACQUIRE, "agent");
            asm volatile("s_waitcnt vmcnt(0)" ::: "memory");
        }
    }
    __syncthreads();
}

constexpr int NWAVES = 8;
constexpr int M = 16384, D = 1024, INC = 2560, AW = 512, LW = 512, NQ = 2048, NEXP = 16384;
constexpr float EPSN = 1e-6f;
constexpr size_t MiB = 1u << 20;
constexpr size_t WS_CTL = 0, CTL_ZERO_BYTES = 1 * MiB;
constexpr size_t WS_ROWSS2 = 512 * 1024;
constexpr size_t WS_RS1 = 1 * MiB;
constexpr size_t WS_SK1 = 1 * MiB + 128 * 1024, WS_SK2 = WS_SK1 + 32 * 1024;
constexpr size_t WS_WIN = 2 * MiB, WS_WOUT = 8 * MiB, WS_WQ = 10 * MiB;
constexpr size_t WS_ED = 16 * MiB, WS_EU = 48 * MiB;
constexpr size_t WS_SCD = 32 * MiB, WS_SCU = 33 * MiB;
constexpr size_t WS_WQ8 = 170 * MiB;
constexpr size_t WS_XB = 80 * MiB;
constexpr size_t WS_OS = 80 * MiB;
constexpr size_t WS_Q2 = 80 * MiB;
constexpr size_t WS_Q = 112 * MiB, WS_SPLIT = 16 * MiB;
constexpr size_t WS_GATE = WS_Q + 4 * WS_SPLIT;
constexpr size_t WS_EID = 144 * MiB, WS_GW = 152 * MiB;
constexpr size_t WS_MIX = 192 * MiB, WS_HB = 224 * MiB, WS_END = 256 * MiB;
constexpr size_t WS_ROWSS3 = 576 * 1024;
constexpr size_t WS_DOTP = 80 * MiB;
constexpr size_t WS_REC = 160 * MiB, WS_N0 = 168 * MiB;
constexpr size_t WS_PEER = 80 * MiB;
constexpr size_t WS_REC_OLD_UNUSED = 0;
constexpr int CW_BAR = 4096;
constexpr int RING_OFF = 0, RING_BYTES = 131072;
constexpr int LDSCTL_OFF = RING_BYTES, MISC_OFF = LDSCTL_OFF + 320;
constexpr int LDS_BYTES = 163840;

struct Frame {
    LAS unsigned char* lds;
    volatile LAS unsigned* MISC;
    int tid, lane, wave;
    int vcu, G;
};

__device__ __forceinline__ float wave_sum(float v) {
#pragma unroll
    for (int o = 1; o < 64; o <<= 1) v += __shfl_xor(v, o);
    return v;
}
__device__ __forceinline__ float bf2f(unsigned short b) { return __builtin_bit_cast(float, (unsigned)b << 16); }
__device__ __forceinline__ float bflo(unsigned w) { return __builtin_bit_cast(float, w << 16); }
__device__ __forceinline__ float bfhi(unsigned w) { return __builtin_bit_cast(float, w & 0xffff0000u); }
__device__ __forceinline__ float gelu_tanh(float x) { const float u = 0.7978845608028654f * (x + 0.044715f * x * x * x); return 0.5f * x * (1.0f + tanhf(u)); }
__device__ __forceinline__ float sigmoidf_(float x) { return 1.0f / (1.0f + expf(-x)); }
__device__ __forceinline__ float fsigmoid(float x) { return __builtin_amdgcn_rcpf(1.0f + __builtin_amdgcn_exp2f(-1.4426950408889634f * x)); }
__device__ __forceinline__ float fgelu_tanh(float x) { const float u = 0.7978845608028654f * (x + 0.044715f * x * x * x); const float t = 1.0f - 2.0f * __builtin_amdgcn_rcpf(1.0f + __builtin_amdgcn_exp2f(2.8853900817779268f * u)); return 0.5f * x * (1.0f + t); }

__device__ __forceinline__ void p0_transpose_item(const float* W, int K, int N, bf16* WT, const float* gk, LAS float* scr, int item, int lane) {
    const int nblk = N / 32, kb = item / nblk, nb = item % nblk, k0 = 64 * kb, n0 = 32 * nb;
    float wv[32];
#pragma unroll
    for (int i = 0; i < 32; ++i) { const int kk = 2 * i + (lane >> 5); wv[i] = W[(size_t)(k0 + kk) * N + n0 + (lane & 31)]; }
#pragma unroll
    for (int i = 0; i < 32; ++i) { const int kk = 2 * i + (lane >> 5); const float g = gk ? gk[k0 + kk] : 1.0f; scr[kk * 33 + (lane & 31)] = wv[i] * g; }
    LDS_WAIT(); asm volatile("" ::: "memory");
    const int c = lane & 7;
#pragma unroll
    for (int j = 0; j < 4; ++j) { const int n = (lane >> 3) + 8 * j; const LAS float* s = scr + (8 * c) * 33 + n;
        v4u o; o.x = pk2(s[0 * 33], s[1 * 33]); o.y = pk2(s[2 * 33], s[3 * 33]); o.z = pk2(s[4 * 33], s[5 * 33]); o.w = pk2(s[6 * 33], s[7 * 33]);
        *(GAS v4u*)(WT + (size_t)(n0 + n) * K + k0 + 8 * c) = o; }
    LDS_WAIT(); asm volatile("" ::: "memory");
}
template <int NR> __device__ __forceinline__ void p0_rows(const float* xrow, bf16* orow, const float* gk, float* rs, int lane) {
    f32x4 v[NR][4];
#pragma unroll
    for (int i = 0; i < NR; ++i)
#pragma unroll
        for (int j = 0; j < 4; ++j) v[i][j] = __builtin_nontemporal_load((const GAS f32x4*)(xrow + (size_t)i * 1024) + lane + 64 * j);
#pragma unroll
    for (int i = 0; i < NR; ++i) {
        if (rs) { float s = 0.f;
#pragma unroll
            for (int j = 0; j < 4; ++j) s += (v[i][j].x * v[i][j].x + v[i][j].y * v[i][j].y) + (v[i][j].z * v[i][j].z + v[i][j].w * v[i][j].w);
            const float tot = wave_sum(s); if (lane == 0) rs[i] = 1.0f / sqrtf(tot * (1.0f / 1024.0f) + EPSN); }
        if (gk) {
#pragma unroll
            for (int j = 0; j < 4; ++j) v[i][j] = v[i][j] * ((const GAS f32x4*)gk)[lane + 64 * j]; }
        GAS unsigned long long* o8 = (GAS unsigned long long*)(orow + (size_t)i * 1024) + lane;
#pragma unroll
        for (int j = 0; j < 4; ++j) o8[64 * j] = (unsigned long long)pk2(v[i][j].x, v[i][j].y) | ((unsigned long long)pk2(v[i][j].z, v[i][j].w) << 32);
    }
}

struct Args { const float* in[23]; float* out; unsigned char* ws; int ph_lo, ph_hi; };

__device__ __forceinline__ void p0_prologue(Frame& F, const Args& a) {
    LAS float* scr = (LAS float*)(F.lds + RING_OFF + F.wave * 16384);
    unsigned char* ws = a.ws;
    const int gw = F.vcu * NWAVES + F.wave, NGW = F.G * NWAVES;
    constexpr int I_IN = (D / 64) * (INC / 32), I_OUT = (D / 64) * (D / 32), I_Q = (D / 64) * (NQ / 32);
    constexpr int NITEMS = I_IN + I_OUT + I_Q;
    for (int it = F.wave * (int)F.G + F.vcu; it < NITEMS; it += NGW) {
        int r = it;
        if (r < I_IN) { p0_transpose_item(a.in[2], D, INC, (bf16*)(ws + WS_WIN), a.in[1], scr, r, F.lane); continue; } r -= I_IN;
        if (r < I_OUT) { p0_transpose_item(a.in[15], D, D, (bf16*)(ws + WS_WOUT), nullptr, scr, r, F.lane); continue; } r -= I_OUT;
        p0_transpose_item(a.in[17], D, NQ, (bf16*)(ws + WS_WQ), a.in[16], scr, r, F.lane);
    }
    for (int m = gw; m < M / 8; m += NGW) { const int r = 8 * m; p0_rows<8>(a.in[0] + (size_t)r * D, (bf16*)(ws + WS_XB) + (size_t)r * D, nullptr, (float*)(ws + WS_RS1) + r, F.lane); }
    for (int m = F.wave * (int)F.G + F.vcu; m < 8; m += NGW) { const int r = 4 * m;
        if (r < 16) p0_rows<4>(a.in[18] + (size_t)r * 1024, (bf16*)(ws + WS_SK1) + (size_t)r * 1024, nullptr, nullptr, F.lane);
        else        p0_rows<4>(a.in[19] + (size_t)(r - 16) * 1024, (bf16*)(ws + WS_SK2) + (size_t)(r - 16) * 1024, nullptr, nullptr, F.lane); }
}
template <int NR> __device__ __forceinline__ void q8_load(f32x4 (&v)[NR][4], const float* xrow, int lane) {
#pragma unroll
    for (int i = 0; i < NR; ++i)
#pragma unroll
        for (int j = 0; j < 4; ++j) v[i][j] = __builtin_nontemporal_load((const GAS f32x4*)(xrow + (size_t)i * 1024) + lane + 64 * j);
}
template <int NR> __device__ __forceinline__ void q8_finish(f32x4 (&v)[NR][4], unsigned char* orow, const float* gk, float* scale, int lane) {
#pragma unroll
    for (int i = 0; i < NR; ++i) {
        float am = 0.f;
#pragma unroll
        for (int j = 0; j < 4; ++j) { if (gk) v[i][j] = v[i][j] * ((const GAS f32x4*)gk)[lane + 64 * j];
            am = fmaxf(fmaxf(am, fmaxf(fabsf(v[i][j].x), fabsf(v[i][j].y))), fmaxf(fabsf(v[i][j].z), fabsf(v[i][j].w))); }
#pragma unroll
        for (int o = 1; o < 64; o <<= 1) am = fmaxf(am, __shfl_xor(am, o));
        const float sc = (am > 0.f) ? am * (1.0f / 127.0f) : 1.0f, inv = 1.0f / sc;
        if (lane == 0) scale[i] = sc;
        GAS unsigned* o4 = (GAS unsigned*)(orow + (size_t)i * 128 + (size_t)(lane >> 5) * ((size_t)NEXP * 128)) + (lane & 31);
#pragma unroll
        for (int j = 0; j < 4; ++j) { const int q0 = (int)__builtin_rintf(v[i][j].x * inv), q1 = (int)__builtin_rintf(v[i][j].y * inv), q2 = (int)__builtin_rintf(v[i][j].z * inv), q3 = (int)__builtin_rintf(v[i][j].w * inv);
            o4[(size_t)j * (2 * (size_t)NEXP * 128 / 4)] = ((unsigned)q0 & 255u) | (((unsigned)q1 & 255u) << 8) | (((unsigned)q2 & 255u) << 16) | ((unsigned)q3 << 24); }
    }
}
__device__ __forceinline__ const float* cvx_src(const Args& a, int m) { const int r = 4 * m; return (r < NEXP) ? a.in[20] + (size_t)r * D : a.in[21] + (size_t)(r - NEXP) * D; }
__device__ __forceinline__ void cvx_finish(const Args& a, f32x4 (&v)[4][4], int m, int lane) {
    unsigned char* ws = a.ws; const int r = 4 * m;
    if (r < NEXP) q8_finish<4>(v, ws + WS_ED + (size_t)r * 128, a.in[16], (float*)(ws + WS_SCD) + r, lane);
    else          q8_finish<4>(v, ws + WS_EU + (size_t)(r - NEXP) * 128, nullptr, (float*)(ws + WS_SCU) + (r - NEXP), lane);
}
__device__ __forceinline__ void convert_experts(const Args& a, int w, int nw, int lane) {
    constexpr int TOT = NEXP / 4;
    int m = w; if (m >= TOT) return;
    f32x4 va[4][4], vb[4][4];
    q8_load<4>(va, cvx_src(a, m), lane);
    for (;;) {
        const bool hb = m + nw < TOT; if (hb) q8_load<4>(vb, cvx_src(a, m + nw), lane);
        cvx_finish(a, va, m, lane);
        if (!hb) break;
        const bool ha = m + 2 * nw < TOT; if (ha) q8_load<4>(va, cvx_src(a, m + 2 * nw), lane);
        cvx_finish(a, vb, m + nw, lane);
        if (!ha) break;
        m += 2 * nw;
    }
}

typedef float f32x16 __attribute__((ext_vector_type(16)));
__device__ __forceinline__ void lru_local_unit(Frame& F, const Args& a, int c) {
    constexpr int YP = 520;
    LAS unsigned short* Y = (LAS unsigned short*)(F.lds + RING_OFF);
    const int e = F.tid, r0 = c * 64;
    const bf16* XR = (const bf16*)(a.ws + WS_Q + 3 * WS_SPLIT);
    unsigned* HLAC = (unsigned*)a.out;
    float* CH = a.out + (size_t)M * 512; float* CA = CH + (size_t)(M / 64) * 512;
    { const float* conv_w = a.in[8]; const float cw0 = conv_w[e], cw1 = conv_w[512 + e], cw2 = conv_w[1024 + e], cw3 = conv_w[1536 + e], cb = a.in[9][e];
      float x0 = 0.f, x1 = 0.f, x2 = 0.f;
      if (c > 0) { x0 = bf2f(XR[(size_t)(r0 - 3) * 512 + e]); x1 = bf2f(XR[(size_t)(r0 - 2) * 512 + e]); x2 = bf2f(XR[(size_t)(r0 - 1) * 512 + e]); }
#pragma unroll 8
      for (int t = 0; t < 64; ++t) { const float x3 = bf2f(XR[(size_t)(r0 + t) * 512 + e]); Y[t * YP + e] = (unsigned short)f2bf(cb + x0 * cw0 + x1 * cw1 + x2 * cw2 + x3 * cw3); x0 = x1; x1 = x2; x2 = x3; } }
    __syncthreads();
    const int n = F.wave, lane = F.lane, r32 = lane & 31, hi = lane >> 5;
#pragma unroll 1
    for (int et = 0; et < 2; ++et) {
        bf16x8 wf[2][4];
#pragma unroll
        for (int gt = 0; gt < 2; ++gt) { const float* w = a.in[gt ? 12 : 10] + n * 4096 + 32 * et; asm volatile("" : "+s"(w));
#pragma unroll
            for (int ks = 0; ks < 4; ++ks) { float f[8];
#pragma unroll
                for (int j = 0; j < 8; ++j) f[j] = w[(16 * ks + 8 * hi + j) * 64 + r32];
                wf[gt][ks] = __builtin_bit_cast(bf16x8, (v4u){pk2(f[0], f[1]), pk2(f[2], f[3]), pk2(f[4], f[5]), pk2(f[6], f[7])}); asm volatile("" ::: "memory"); } }
        const int ch = 64 * n + 32 * et + r32;
        const float ba = a.in[11][ch], bx = a.in[13][ch], lam = a.in[14][ch];
        const float sp = (lam > 15.f) ? expf(-lam) : log1pf(expf(-lam));
        float av[2][16], bv[2][16];
#pragma unroll
        for (int tt = 0; tt < 2; ++tt) {
            f32x16 ra = {}, ia = {};
#pragma unroll
            for (int ks = 0; ks < 4; ++ks) { const bf16x8 af = *(const LAS bf16x8*)(Y + (32 * tt + r32) * YP + 64 * n + 16 * ks + 8 * hi);
                ra = __builtin_amdgcn_mfma_f32_32x32x16_bf16(af, wf[0][ks], ra, 0, 0, 0); ia = __builtin_amdgcn_mfma_f32_32x32x16_bf16(af, wf[1][ks], ia, 0, 0, 0); }
#pragma unroll
            for (int r = 0; r < 16; ++r) { const int t = 32 * tt + (r & 3) + 8 * (r >> 2) + 4 * hi;
                const float rr = fsigmoid(ra[r] + ba), ii = fsigmoid(ia[r] + bx);
                const float log_a = -8.0f * rr * sp, aa = __builtin_amdgcn_exp2f(log_a * 1.4426950408889634f);
                const float u2 = 2.0f * log_a;
                const float ser = -u2 * (1.0f + u2 * (0.5f + u2 * (0.16666667f + u2 * (0.041666668f + u2 * 0.0083333338f))));
                const float om = (u2 > -0.1f) ? ser : (1.0f - aa * aa);
                const float mult = __builtin_amdgcn_sqrtf(fmaxf(om, 1e-12f));
                av[tt][r] = aa; bv[tt][r] = mult * (ii * bf2f(Y[t * YP + ch])); }
        }
#pragma unroll
        for (int tt = 0; tt < 2; ++tt)
#pragma unroll
            for (int rq = 0; rq < 4; ++rq) { float h = 0.f, pa = 1.f;
#pragma unroll
                for (int k = 0; k < 4; ++k) { const int r = 4 * rq + k; h = av[tt][r] * h + bv[tt][r]; pa *= av[tt][r]; bv[tt][r] = h; av[tt][r] = pa; } }
        float hin[8], ain[8]; float hc = 0.f, ac = 1.f;
#pragma unroll
        for (int j = 0; j < 8; ++j) { const int tt = j >> 2, r3 = 4 * (j & 3) + 3;
#pragma unroll
            for (int own = 0; own < 2; ++own) {
                if (hi == own) { hin[j] = hc; ain[j] = ac; }
                const float mh = av[tt][r3] * hc + bv[tt][r3], ma = ac * av[tt][r3];
                const float oh = __shfl_xor(mh, 32), oa = __shfl_xor(ma, 32);
                hc = (hi == own) ? mh : oh; ac = (hi == own) ? ma : oa; } }
#pragma unroll
        for (int tt = 0; tt < 2; ++tt)
            { unsigned ob = (unsigned)((r0 + 32 * tt + 4 * hi) * 512 + ch); asm volatile("" : "+v"(ob));
#pragma unroll
            for (int r = 0; r < 16; ++r) { const int j = 4 * tt + (r >> 2); const unsigned o = ob + (unsigned)(((r & 3) + 8 * (r >> 2)) * 512);
                const float hl = bv[tt][r] + av[tt][r] * hin[j], ac = av[tt][r] * ain[j];
                HLAC[o] = pk2(hl, ac);
                if (tt == 1 && r == 15 && hi == 1) { CH[c * 512 + ch] = hl; CA[c * 512 + ch] = ac; } } }
    }
    __syncthreads();
}

__device__ __forceinline__ void fix_unit(Frame& F, const Args& a, int c, float lamv) {
    const int r0 = c * 64;
    const unsigned* HLAC = (const unsigned*)a.out; const float* CH = a.out + (size_t)M * 512; const float* CA = CH + (size_t)(M / 64) * 512;
    const bf16* GATE = (const bf16*)(a.ws + WS_GATE);
    bf16* MIX = (bf16*)(a.ws + WS_MIX);
    const int g4 = F.tid & 127, sgm = F.tid >> 7;
    LAS f32x4* SA = (LAS f32x4*)(F.lds + RING_OFF); LAS f32x4* SH = SA + 512;
    { const int L = (c + 3) >> 2; const int lo_c = sgm * L; int hi_c = lo_c + L; if (hi_c > c) hi_c = c;
      f32x4 A4 = (f32x4){1.f, 1.f, 1.f, 1.f}, H4 = (f32x4){0.f, 0.f, 0.f, 0.f};
      int cc = lo_c;
      for (; cc + 8 <= hi_c; cc += 8) { f32x4 av[8], hv[8];
#pragma unroll
          for (int k = 0; k < 8; ++k) { const size_t o = (size_t)(cc + k) * 512 + 4 * g4; av[k] = *(const GAS f32x4*)(CA + o); hv[k] = *(const GAS f32x4*)(CH + o); }
#pragma unroll
          for (int k = 0; k < 8; ++k) { H4 = av[k] * H4 + hv[k]; A4 = A4 * av[k]; } }
      for (; cc < hi_c; ++cc) { const size_t o = (size_t)cc * 512 + 4 * g4; const f32x4 av = *(const GAS f32x4*)(CA + o), hv = *(const GAS f32x4*)(CH + o); H4 = av * H4 + hv; A4 = A4 * av; }
      SA[sgm * 128 + g4] = A4; SH[sgm * 128 + g4] = H4; }
    __syncthreads();
    f32x4 hin = (f32x4){0.f, 0.f, 0.f, 0.f};
#pragma unroll
    for (int sq = 0; sq < 4; ++sq) hin = SA[sq * 128 + g4] * hin + SH[sq * 128 + g4];
    __syncthreads();
#pragma unroll 4
    for (int t = sgm * 16; t < sgm * 16 + 16; ++t) { const size_t o = (size_t)(r0 + t) * 512 + 4 * g4;
        const v4u ha = *(const GAS v4u*)(HLAC + o);
        const f32x4 h = (f32x4){bflo(ha.x), bflo(ha.y), bflo(ha.z), bflo(ha.w)} + (f32x4){bfhi(ha.x), bfhi(ha.y), bfhi(ha.z), bfhi(ha.w)} * hin; const unsigned long long gw = *(const GAS unsigned long long*)(GATE + o);
        const unsigned glo = (unsigned)gw, ghi = (unsigned)(gw >> 32);
        const unsigned long long ov = (unsigned long long)pk2(h.x * fgelu_tanh(bflo(glo)), h.y * fgelu_tanh(bfhi(glo))) | ((unsigned long long)pk2(h.z * fgelu_tanh(bflo(ghi)), h.w * fgelu_tanh(bfhi(ghi))) << 32);
        *(GAS unsigned long long*)(MIX + (size_t)(r0 + t) * 1024 + 512 + 4 * g4) = ov; }
    const bf16* OS0 = (const bf16*)(a.ws + WS_OS); const bf16* OS1 = OS0 + (size_t)M * 512;
    const float* sg = a.in[7] + (F.lane & 15) * 8;
    float sgv[8];
#pragma unroll
    for (int j = 0; j < 8; ++j) sgv[j] = sg[j] * 0.8f;
#pragma unroll 2
    for (int rr = 0; rr < 8; ++rr) { const size_t row = (size_t)(r0 + 8 * F.wave + rr);
        const v4u p = *(const GAS v4u*)(OS0 + row * 512 + F.lane * 8), q = *(const GAS v4u*)(OS1 + row * 512 + F.lane * 8);
        float d[8];
        d[0] = bflo(p.x) - lamv * bflo(q.x); d[1] = bfhi(p.x) - lamv * bfhi(q.x); d[2] = bflo(p.y) - lamv * bflo(q.y); d[3] = bfhi(p.y) - lamv * bfhi(q.y);
        d[4] = bflo(p.z) - lamv * bflo(q.z); d[5] = bfhi(p.z) - lamv * bfhi(q.z); d[6] = bflo(p.w) - lamv * bflo(q.w); d[7] = bfhi(p.w) - lamv * bfhi(q.w);
        float ss = 0.f;
#pragma unroll
        for (int j = 0; j < 8; ++j) ss += d[j] * d[j];
        ss += __shfl_xor(ss, 1); ss += __shfl_xor(ss, 2); ss += __shfl_xor(ss, 4); ss += __shfl_xor(ss, 8);
        const float ri = 1.0f / sqrtf(ss * (1.0f / 128.0f) + EPSN);
        v4u o; o.x = pk2(d[0] * ri * sgv[0], d[1] * ri * sgv[1]); o.y = pk2(d[2] * ri * sgv[2], d[3] * ri * sgv[3]);
        o.z = pk2(d[4] * ri * sgv[4], d[5] * ri * sgv[5]); o.w = pk2(d[6] * ri * sgv[6], d[7] * ri * sgv[7]);
        *(GAS v4u*)(MIX + row * 1024 + F.lane * 8) = o; }
}

typedef float f32x16 __attribute__((ext_vector_type(16)));
#define CEX(a, b) do { const float _hi = fmaxf(a, b), _lo = fminf(a, b); a = _hi; b = _lo; } while (0)
__device__ __forceinline__ int skey(int b) { return b ^ ((b >> 31) & 0x7fffffff); }
#define CEI(a, b) do { const int _hi = max(a, b), _lo = min(a, b); a = _hi; b = _lo; } while (0)
__device__ __forceinline__ void sort16_desc(int (&v)[16]) {
#pragma unroll
    for (int k = 2; k <= 16; k <<= 1)
#pragma unroll
        for (int j = k >> 1; j >= 1; j >>= 1)
#pragma unroll
            for (int i = 0; i < 16; ++i) { const int l = i ^ j; if (l > i) { if ((i & k) == 0) CEI(v[i], v[l]); else CEI(v[l], v[i]); } }
}
__device__ __forceinline__ void merge16_desc(int (&a)[16], const int (&b)[16]) {
#pragma unroll
    for (int i = 0; i < 16; ++i) a[i] = max(a[i], b[15 - i]);
#pragma unroll
    for (int j = 8; j >= 1; j >>= 1)
#pragma unroll
        for (int i = 0; i < 16; ++i) if ((i & j) == 0) CEI(a[i], a[i + j]);
}
__device__ __forceinline__ void top16_half(int (&top)[16], const bf16* q, const LAS unsigned char* sk, int r32, int hi) {
    bf16x8 qf[8];
#pragma unroll
    for (int ks = 0; ks < 8; ++ks) qf[ks] = *(const GAS bf16x8*)(q + 16 * ks + 8 * hi);
#pragma unroll
    for (int i = 0; i < 16; ++i) top[i] = (int)0x80000000;
#pragma unroll 1
    for (int kt = 0; kt < 4; ++kt) {
        f32x16 acc = {};
#pragma unroll
        for (int ks = 0; ks < 8; ++ks) { const bf16x8 kf = *(const LAS bf16x8*)(sk + (32 * kt + r32) * 272 + (16 * ks + 8 * hi) * 2); acc = __builtin_amdgcn_mfma_f32_32x32x16_bf16(kf, qf[ks], acc, 0, 0, 0); }
        int grp[16];
#pragma unroll
        for (int r = 0; r < 16; ++r) { const int idx = 32 * kt + (r & 3) + 8 * (r >> 2) + 4 * hi; const float av = acc[r];
            grp[r] = (skey(__float_as_int(av)) & ~127) | idx; }
        sort16_desc(grp); merge16_desc(top, grp);
    }
    int oth[16];
#pragma unroll
    for (int i = 0; i < 16; ++i) oth[i] = __shfl_xor(top[i], 32);
    merge16_desc(top, oth);
}
__device__ __forceinline__ void route_unit(const Args& a, int g, int hd, int lane, LAS unsigned char* slot, const LAS unsigned char* skl, int* EIDo, float* GWo) {
    const int r32 = lane & 31, hi = lane >> 5; const int t = g * 32 + r32;
    const bf16* q = (const bf16*)(a.ws + WS_Q2) + (size_t)t * NQ + hd * 256;
    int k1[16], k2[16];
    top16_half(k1, q, skl, r32, hi);
    top16_half(k2, q + 128, skl + 128 * 272, r32, hi);
    { v4u w1, w2;
#define IDX4(v, j) (((unsigned)v[4 * (j)] & 127u) | (((unsigned)v[4 * (j) + 1] & 127u) << 8) | (((unsigned)v[4 * (j) + 2] & 127u) << 16) | (((unsigned)v[4 * (j) + 3] & 127u) << 24))
      w1 = (v4u){IDX4(k1, 0), IDX4(k1, 1), IDX4(k1, 2), IDX4(k1, 3)}; w2 = (v4u){IDX4(k2, 0), IDX4(k2, 1), IDX4(k2, 2), IDX4(k2, 3)};
#undef IDX4
      *(LAS v4u*)(slot) = w1; *(LAS v4u*)(slot + 16) = w2; }
    float v1[16], v2[16];
#pragma unroll
    for (int i = 0; i < 16; ++i) { v1[i] = __int_as_float(skey(k1[i])); v2[i] = __int_as_float(skey(k2[i])); }
#define CKEY(ia, ib) ((skey(__float_as_int(v1[ia] + v2[ib])) & ~255) | ((ia) * 16 + (ib)))
    int K[16], G1[16], G2[16];
#pragma unroll
    for (int i = 0; i < 16; ++i) K[i] = CKEY(0, i);
    { int n_ = 0;
#pragma unroll
      for (int ia = 1; ia < 16; ++ia)
#pragma unroll
          for (int ib = 0; ib < 16; ++ib) if ((ia + 1) * (ib + 1) <= 16) { const int kk = CKEY(ia, ib); if (n_ < 16) G1[n_] = kk; else if (n_ < 32) G2[n_ - 16] = kk; ++n_; }
    }
    sort16_desc(G1); merge16_desc(K, G1);
    sort16_desc(G2); merge16_desc(K, G2);
    { int x0 = CKEY(14, 0), x1 = CKEY(15, 0);
#pragma unroll
      for (int i = 0; i < 16; ++i) { CEI(K[i], x0); }
#pragma unroll
      for (int i = 0; i < 16; ++i) { CEI(K[i], x1); }
    }
#undef CKEY
    unsigned P[16]; float sc[16];
#pragma unroll
    for (int i = 0; i < 16; ++i) { const unsigned ci = (unsigned)K[i] & 255u; const unsigned i1 = slot[ci >> 4], i2 = slot[16 + (ci & 15u)]; P[i] = i1 * 128u + i2; sc[i] = __int_as_float(skey(K[i] & ~255)); }
    float ex[16], sum = 0.f;
#pragma unroll
    for (int i = 0; i < 16; ++i) { ex[i] = expf(sc[i] - sc[0]); sum += ex[i]; }
    const float inv = 1.0f / sum;
    if (hi == 0) {
        GAS v4u* ro = (GAS v4u*)((unsigned*)(a.ws + WS_REC) + (size_t)t * 128 + hd * 16);
#pragma unroll
        for (int j = 0; j < 4; ++j) ro[j] = (v4u){P[4 * j] | (f2bf(ex[4 * j] * inv) << 16), P[4 * j + 1] | (f2bf(ex[4 * j + 1] * inv) << 16), P[4 * j + 2] | (f2bf(ex[4 * j + 2] * inv) << 16), P[4 * j + 3] | (f2bf(ex[4 * j + 3] * inv) << 16)};
    }
}

__device__ __forceinline__ float wave_max(float v) {
#pragma unroll
    for (int o = 1; o < 64; o <<= 1) v = fmaxf(v, __shfl_xor(v, o));
    return v;
}
__device__ __forceinline__ void route_unit_ref(const Args& a, int t, int hd, int lane, LAS float* sc) {
    LAS unsigned* sci = (LAS unsigned*)sc;
    const bf16* q = (const bf16*)(a.ws + WS_Q2) + (size_t)t * NQ + hd * 256;
#pragma unroll 1
    for (int half = 0; half < 2; ++half) {
        const float* sk = a.in[18 + half];
        float sa = 0.f, sb = 0.f;
        for (int d = 0; d < 128; ++d) { const float qv = bf2f(q[half * 128 + d]); sa += qv * sk[lane * 128 + d]; sb += qv * sk[(lane + 64) * 128 + d]; }
        for (int r = 0; r < 16; ++r) {
            const float mx = wave_max(fmaxf(sa, sb));
            const unsigned long long ba = __ballot(sa == mx), bb = __ballot(sb == mx);
            int key;
            if (ba) { const int ln = __ffsll((long long)ba) - 1; key = ln; if (lane == ln) sa = -INFINITY; }
            else { const int ln = __ffsll((long long)bb) - 1; key = ln + 64; if (lane == ln) sb = -INFINITY; }
            if (lane == 0) { sc[half * 32 + r] = mx; sci[half * 32 + 16 + r] = (unsigned)key; }
        }
    }
    __builtin_amdgcn_s_waitcnt(0);
    const int ca = lane >> 2, cb0 = (lane & 3) * 4;
    float c[4];
#pragma unroll
    for (int j = 0; j < 4; ++j) c[j] = sc[ca] + sc[32 + cb0 + j];
    for (int r = 0; r < 16; ++r) {
        const float mx = wave_max(fmaxf(fmaxf(c[0], c[1]), fmaxf(c[2], c[3])));
        const bool mine = (c[0] == mx) || (c[1] == mx) || (c[2] == mx) || (c[3] == mx);
        const unsigned long long bm = __ballot(mine); const int ln = __ffsll((long long)bm) - 1;
        if (lane == ln) { int j = (c[0] == mx) ? 0 : (c[1] == mx) ? 1 : (c[2] == mx) ? 2 : 3;
            if (j == 0) c[0] = -INFINITY; else if (j == 1) c[1] = -INFINITY; else if (j == 2) c[2] = -INFINITY; else c[3] = -INFINITY;
            sc[64 + r] = mx; sci[80 + r] = sci[16 + ca] * 128u + sci[48 + cb0 + j]; }
    }
    __builtin_amdgcn_s_waitcnt(0);
    if (lane < 16) {
        const float mx0 = sc[64]; const float ex = expf(sc[64 + lane] - mx0); float sum = ex;
        sum += __shfl_xor(sum, 1); sum += __shfl_xor(sum, 2); sum += __shfl_xor(sum, 4); sum += __shfl_xor(sum, 8);
        ((int*)(a.ws + WS_EID))[(size_t)t * 128 + hd * 16 + lane] = (int)sci[80 + lane];
        ((float*)(a.ws + WS_GW))[(size_t)t * 128 + hd * 16 + lane] = ex / sum;
    }
    __builtin_amdgcn_s_waitcnt(0);
}

__device__ __forceinline__ void unpack8(const v4u w, float* f) { f[0] = bflo(w.x); f[1] = bfhi(w.x); f[2] = bflo(w.y); f[3] = bfhi(w.y); f[4] = bflo(w.z); f[5] = bfhi(w.z); f[6] = bflo(w.w); f[7] = bfhi(w.w); }
__device__ __forceinline__ void gather_token(const Args& a, int t, int lane, float* dst) {
    const bf16* HB = (const bf16*)(a.ws + WS_HB) + (size_t)t * D; const bf16* ED = (const bf16*)(a.ws + WS_ED); const bf16* EU = (const bf16*)(a.ws + WS_EU);
    float hx[16];
    unpack8(*(const GAS v4u*)(HB + lane * 8), hx); unpack8(*(const GAS v4u*)(HB + 512 + lane * 8), hx + 8);
    const float rs2 = 1.0f / sqrtf(((const float*)(a.ws + WS_ROWSS2))[t] * (1.0f / 1024.0f) + EPSN);
    const int* EID = (const int*)(a.ws + WS_EID) + (size_t)t * 128; const float* GW = (const float*)(a.ws + WS_GW) + (size_t)t * 128;
    const int e0 = EID[lane], e1 = EID[64 + lane]; const float g0 = GW[lane], g1 = GW[64 + lane];
    float acc[16];
#pragma unroll
    for (int i = 0; i < 16; ++i) acc[i] = 0.f;
#pragma unroll 1
    for (int j = 0; j < 128; j += 4) {
        int ee[4]; float gg[4], dt[4];
#pragma unroll
        for (int k = 0; k < 4; ++k) { const int jj = j + k; ee[k] = __shfl(jj < 64 ? e0 : e1, jj & 63); gg[k] = __shfl(jj < 64 ? g0 : g1, jj & 63); }
        v4u da[4], db[4];
#pragma unroll
        for (int k = 0; k < 4; ++k) { const bf16* r = ED + (size_t)ee[k] * D; da[k] = *(const GAS v4u*)(r + lane * 8); db[k] = *(const GAS v4u*)(r + 512 + lane * 8); }
#pragma unroll
        for (int k = 0; k < 4; ++k) { float f[16]; unpack8(da[k], f); unpack8(db[k], f + 8); float s = 0.f;
#pragma unroll
            for (int i = 0; i < 16; ++i) s += f[i] * hx[i];
            dt[k] = s; }
#pragma unroll
        for (int o = 1; o < 64; o <<= 1) {
#pragma unroll
            for (int k = 0; k < 4; ++k) dt[k] += __shfl_xor(dt[k], o); }
#pragma unroll
        for (int k = 0; k < 4; ++k) { const bf16* r = EU + (size_t)ee[k] * D; da[k] = *(const GAS v4u*)(r + lane * 8); db[k] = *(const GAS v4u*)(r + 512 + lane * 8); }
#pragma unroll
        for (int k = 0; k < 4; ++k) { const float w = gg[k] * gelu_tanh(dt[k] * rs2); float f[16]; unpack8(da[k], f); unpack8(db[k], f + 8);
#pragma unroll
            for (int i = 0; i < 16; ++i) acc[i] += w * f[i]; }
    }
    const float* orow = a.out + (size_t)t * D; float* drow = dst + (size_t)t * D; const float* gf = a.in[22];
    f32x4 h0 = *(const GAS f32x4*)(orow + lane * 8), h1 = *(const GAS f32x4*)(orow + lane * 8 + 4), h2 = *(const GAS f32x4*)(orow + 512 + lane * 8), h3 = *(const GAS f32x4*)(orow + 512 + lane * 8 + 4);
    h0 += (f32x4){acc[0], acc[1], acc[2], acc[3]}; h1 += (f32x4){acc[4], acc[5], acc[6], acc[7]}; h2 += (f32x4){acc[8], acc[9], acc[10], acc[11]}; h3 += (f32x4){acc[12], acc[13], acc[14], acc[15]};
    float ss = (h0.x * h0.x + h0.y * h0.y) + (h0.z * h0.z + h0.w * h0.w) + (h1.x * h1.x + h1.y * h1.y) + (h1.z * h1.z + h1.w * h1.w)
             + (h2.x * h2.x + h2.y * h2.y) + (h2.z * h2.z + h2.w * h2.w) + (h3.x * h3.x + h3.y * h3.y) + (h3.z * h3.z + h3.w * h3.w);
    ss = wave_sum(ss);
    const float ri = 1.0f / sqrtf(ss * (1.0f / 1024.0f) + EPSN);
    const f32x4 f0 = *(const GAS f32x4*)(gf + lane * 8), f1 = *(const GAS f32x4*)(gf + lane * 8 + 4), f2 = *(const GAS f32x4*)(gf + 512 + lane * 8), f3 = *(const GAS f32x4*)(gf + 512 + lane * 8 + 4);
    *(GAS f32x4*)(drow + lane * 8) = h0 * ri * f0; *(GAS f32x4*)(drow + lane * 8 + 4) = h1 * ri * f1;
    *(GAS f32x4*)(drow + 512 + lane * 8) = h2 * ri * f2; *(GAS f32x4*)(drow + 512 + lane * 8 + 4) = h3 * ri * f3;
}


template <int CTRL> __device__ __forceinline__ float dpp_add(float v) { return v + __int_as_float(__builtin_amdgcn_update_dpp(0, __float_as_int(v), CTRL, 0xf, 0xf, false)); }
__device__ __forceinline__ float row16_sum(float v) { v = dpp_add<0x140>(v); v = dpp_add<0x141>(v); v = dpp_add<0x4E>(v); v = dpp_add<0xB1>(v); return v; }
__device__ __forceinline__ unsigned long long lanemask_lt(int lane) { return (1ull << lane) - 1ull; }
__device__ __forceinline__ void glds16g(const void* gsrc, unsigned lds_dst) { unsigned keep;
    asm volatile("s_mov_b32 %0, m0\n\ts_mov_b32 m0, %2\n\ts_nop 0\n\tglobal_load_lds_dwordx4 %1, off\n\ts_mov_b32 m0, %0" : "=&s"(keep) : "v"(gsrc), "s"(lds_dst) : "memory"); }

__device__ __forceinline__ void glds16x4(const void* sbase, unsigned o0, unsigned o1, unsigned o2, unsigned o3, unsigned d0, unsigned d1, unsigned d2, unsigned d3) { unsigned keep;
    asm volatile("s_mov_b32 %0, m0\n\ts_mov_b32 m0, %6\n\ts_nop 0\n\tglobal_load_lds_dwordx4 %1, %5\n\ts_mov_b32 m0, %7\n\ts_nop 0\n\tglobal_load_lds_dwordx4 %2, %5\n\t"
                 "s_mov_b32 m0, %8\n\ts_nop 0\n\tglobal_load_lds_dwordx4 %3, %5\n\ts_mov_b32 m0, %9\n\ts_nop 0\n\tglobal_load_lds_dwordx4 %4, %5\n\ts_mov_b32 m0, %0"
                 : "=&s"(keep) : "v"(o0), "v"(o1), "v"(o2), "v"(o3), "s"(sbase), "s"(d0), "s"(d1), "s"(d2), "s"(d3) : "memory"); }
typedef __bf16 bf2_t __attribute__((ext_vector_type(2)));
__device__ __forceinline__ float dot2bf(unsigned a, unsigned b, float c) { return __builtin_amdgcn_fdot2_f32_bf16(__builtin_bit_cast(bf2_t, a), __builtin_bit_cast(bf2_t, b), c, false); }
template <int NT> __device__ __forceinline__ void compact_tokens(const Args& a, int t0, int lane) {
    int e0[NT], e1[NT]; float g0[NT], g1[NT];
#pragma unroll
    for (int i = 0; i < NT; ++i) { const int* EID = (const int*)(a.ws + WS_EID) + (size_t)(t0 + i) * 128; const float* GW = (const float*)(a.ws + WS_GW) + (size_t)(t0 + i) * 128;
        e0[i] = EID[lane]; e1[i] = EID[64 + lane]; g0[i] = GW[lane]; g1[i] = GW[64 + lane]; }
#pragma unroll
    for (int i = 0; i < NT; ++i) {
        const bool p0 = e0[i] < 8192, p1 = e1[i] < 8192;
        const unsigned long long m0 = __ballot(p0), m1 = __ballot(p1), lt = lanemask_lt(lane);
        const int c0 = __popcll(m0), n0 = c0 + __popcll(m1);
        const int pos0 = p0 ? __popcll(m0 & lt) : n0 + __popcll(~m0 & lt);
        const int pos1 = p1 ? c0 + __popcll(m1 & lt) : n0 + (64 - c0) + __popcll(~m1 & lt);
        unsigned* R = (unsigned*)(a.ws + WS_REC) + (size_t)(t0 + i) * 128;
        R[pos0] = (unsigned)e0[i] | (f2bf(g0[i]) << 16); R[pos1] = (unsigned)e1[i] | (f2bf(g1[i]) << 16);
        if (lane == 0) ((int*)(a.ws + WS_N0))[t0 + i] = n0; }
}
template <int NT> __device__ __forceinline__ void w_tokens(const Args& a, int t0, int lane, const LAS float* scd, const LAS float* scu) {
    float d0[NT], d1[NT], sd0[NT], sd1[NT], su0[NT], su1[NT]; unsigned r0[NT], r1[NT]; float ss[NT];
#pragma unroll
    for (int i = 0; i < NT; ++i) { const float* DP = (const float*)(a.ws + WS_DOTP) + (size_t)(t0 + i) * 1024; const unsigned* R = (const unsigned*)(a.ws + WS_REC) + (size_t)(t0 + i) * 128;
        float p0[8], p1[8];
#pragma unroll
        for (int x = 0; x < 8; ++x) { p0[x] = DP[x * 128 + lane]; p1[x] = DP[x * 128 + 64 + lane]; }
        r0[i] = R[lane]; r1[i] = R[64 + lane]; ss[i] = ((const float*)(a.ws + WS_ROWSS2))[t0 + i];
        sd0[i] = scd[r0[i] & 0x3fffu]; sd1[i] = scd[r1[i] & 0x3fffu];
        su0[i] = scu[r0[i] & 0x3fffu]; su1[i] = scu[r1[i] & 0x3fffu];
        d0[i] = ((p0[0] + p0[1]) + (p0[2] + p0[3])) + ((p0[4] + p0[5]) + (p0[6] + p0[7])); d1[i] = ((p1[0] + p1[1]) + (p1[2] + p1[3])) + ((p1[4] + p1[5]) + (p1[6] + p1[7])); }
#pragma unroll
    for (int i = 0; i < NT; ++i) { const float rs2 = 1.0f / sqrtf(ss[i] * (1.0f / 1024.0f) + EPSN);
        const float w0 = bfhi(r0[i]) * fgelu_tanh(d0[i] * sd0[i] * rs2) * su0[i], w1 = bfhi(r1[i]) * fgelu_tanh(d1[i] * sd1[i] * rs2) * su1[i];
        float m0 = fabsf(w0), m1 = fabsf(w1);
#pragma unroll
        for (int o = 1; o < 64; o <<= 1) { m0 = fmaxf(m0, __shfl_xor(m0, o)); m1 = fmaxf(m1, __shfl_xor(m1, o)); }
        const float s0 = (m0 > 0.f) ? m0 * (1.0f / 127.0f) : 1.0f, s1 = (m1 > 0.f) ? m1 * (1.0f / 127.0f) : 1.0f;
        unsigned char* WQ = a.ws + WS_WQ8 + (size_t)(t0 + i) * 144;
        WQ[lane] = (unsigned char)((int)__builtin_rintf(w0 / s0) & 255); WQ[64 + lane] = (unsigned char)((int)__builtin_rintf(w1 / s1) & 255);
        if (lane == 0) { ((float*)(WQ + 128))[0] = s0; ((float*)(WQ + 128))[1] = s1; } }
}
template <bool IS_UP> __device__ __forceinline__ void sweep_slice(const Args& a, int x, int wv, int lane, unsigned ring, LAS unsigned char* ringp, unsigned aux, LAS unsigned char* auxp) {
    const int g = lane >> 4, li = lane & 15, n16 = li, kg = g;
    const char* TABx = (const char*)(a.ws + (IS_UP ? WS_EU : WS_ED)) + x * 256;
    unsigned jofs[4];
#pragma unroll
    for (int q = 0; q < 4; ++q) jofs[q] = (unsigned)((li ^ ((g << 2) | q)) * 16);
    const unsigned pd = (unsigned)__builtin_amdgcn_readfirstlane(ring);
#pragma unroll 1
    for (int s_ = 0; s_ < 128; ++s_) {
        const int r = s_ >> 6, k = s_ & 63, t = wv * 64 + k, base = 64 * r;
        const LAS unsigned* rec = (const LAS unsigned*)(auxp + (k & 3) * 512) + base;
        const LAS unsigned char* hp = auxp + 2048 + (k & 3) * 256;
        asm volatile("s_waitcnt lgkmcnt(0)" ::: "memory");
        if ((k & 3) == 0) {
            const char* rsrc = (const char*)(a.ws + WS_REC) + (size_t)t * 512 + lane * 16;
            glds16g(rsrc, (unsigned)__builtin_amdgcn_readfirstlane(aux)); glds16g(rsrc + 1024, (unsigned)__builtin_amdgcn_readfirstlane(aux + 1024));
            if (!IS_UP) glds16g((const char*)(a.ws + WS_HB) + (size_t)(t + g) * 2048 + x * 256 + li * 16, (unsigned)__builtin_amdgcn_readfirstlane(aux + 2048));
            asm volatile("s_waitcnt vmcnt(0)" ::: "memory");
        }
        {
            unsigned so[16];
#pragma unroll
            for (int p = 0; p < 16; ++p) so[p] = rec[4 * p + g];
#pragma unroll
            for (int p = 0; p < 16; ++p) so[p] = ((so[p] & 0x3fffu) << 11) + jofs[p & 3];
            glds16x4(TABx, so[0], so[1], so[2], so[3], pd, pd + 1024u, pd + 2048u, pd + 3072u);
            glds16x4(TABx, so[4], so[5], so[6], so[7], pd + 4096u, pd + 5120u, pd + 6144u, pd + 7168u);
            glds16x4(TABx, so[8], so[9], so[10], so[11], pd + 8192u, pd + 9216u, pd + 10240u, pd + 11264u);
            glds16x4(TABx, so[12], so[13], so[14], so[15], pd + 12288u, pd + 13312u, pd + 14336u, pd + 15360u);
        }
        asm volatile("s_waitcnt vmcnt(0)" ::: "memory");
        if (!IS_UP) {
            bf16x8 hb[4];
#pragma unroll
            for (int q = 0; q < 4; ++q) hb[q] = *(const LAS bf16x8*)(hp + (32 * q + 8 * kg) * 2);
            f32x4 res = (f32x4){0.f, 0.f, 0.f, 0.f};
#pragma unroll
            for (int rb = 0; rb < 4; ++rb) {
                f32x4 d = (f32x4){0.f, 0.f, 0.f, 0.f}; const int row = n16 + 16 * rb; const int key = ((row & 3) << 2) | ((row >> 2) & 3);
#pragma unroll
                for (int q = 0; q < 4; ++q) { const bf16x8 af = *(const LAS bf16x8*)(ringp + 256 * row + 16 * ((4 * q + kg) ^ key)); d = __builtin_amdgcn_mfma_f32_16x16x32_bf16(af, hb[q], d, 0, 0, 0); }
                res = (n16 == rb) ? d : res; }
            if (n16 < 4) *(GAS f32x4*)((float*)(a.ws + WS_DOTP) + ((size_t)t * 8 + x) * 128 + base + 16 * n16 + 4 * kg) = res;
        } else {
            f32x4 pacc[8];
#pragma unroll
            for (int i = 0; i < 8; ++i) pacc[i] = (f32x4){0.f, 0.f, 0.f, 0.f};
            const int q4 = n16 >> 2, p4 = lane & 3;
#pragma unroll
            for (int ks = 0; ks < 2; ++ks) {
                const v4u wa = *(const LAS v4u*)(rec + 32 * ks + 8 * kg), wb = *(const LAS v4u*)(rec + 32 * ks + 8 * kg + 4);
                const bf16x8 af = __builtin_bit_cast(bf16x8, (v4u){(wa.x >> 16) | (wa.y & 0xffff0000u), (wa.z >> 16) | (wa.w & 0xffff0000u), (wb.x >> 16) | (wb.y & 0xffff0000u), (wb.z >> 16) | (wb.w & 0xffff0000u)});
#pragma unroll
                for (int c = 0; c < 8; ++c) {
                    const int row0 = 32 * ks + 8 * kg + q4, row1 = row0 + 4; const int ch = 2 * c + (p4 >> 1);
                    const int k0 = ((row0 & 3) << 2) | ((row0 >> 2) & 3), k1 = ((row1 & 3) << 2) | ((row1 >> 2) & 3);
                    const attn_body::s16x4 lo4 = attn_body::vtr((attn_body::lds_cptr)(ringp + 256 * row0 + 16 * (ch ^ k0) + 8 * (p4 & 1)));
                    const attn_body::s16x4 hi4 = attn_body::vtr((attn_body::lds_cptr)(ringp + 256 * row1 + 16 * (ch ^ k1) + 8 * (p4 & 1)));
                    const bf16x8 bfr = (bf16x8){lo4[0], lo4[1], lo4[2], lo4[3], hi4[0], hi4[1], hi4[2], hi4[3]};
                    pacc[c] = __builtin_amdgcn_mfma_f32_16x16x32_bf16(af, bfr, pacc[c], 0, 0, 0); }
            }
            const float v0 = (kg == 0) ? pacc[0][0] : (kg == 1) ? pacc[1][0] : (kg == 2) ? pacc[2][0] : pacc[3][0];
            const float v1 = (kg == 0) ? pacc[4][0] : (kg == 1) ? pacc[5][0] : (kg == 2) ? pacc[6][0] : pacc[7][0];
            bf16* po = (bf16*)(a.ws + WS_PEER) + ((size_t)r * M + t) * D + x * 128;
            po[lane] = (bf16)f2bf(v0); po[64 + lane] = (bf16)f2bf(v1);
        }
    }
}
typedef int i32x4 __attribute__((ext_vector_type(4)));
__device__ __forceinline__ void sweep_down_q8(const Args& a, int x, int wv, int lane, unsigned ring, LAS unsigned char* ringp, unsigned aux, LAS unsigned char* auxp) {
    const int g = lane >> 4, li = lane & 15, n16 = li, kg = g, g8 = lane >> 3, s8 = lane & 7;
    const char* TABx = (const char*)(a.ws + WS_ED) + (size_t)x * ((size_t)NEXP * 128);
    unsigned jofs[2];
#pragma unroll
    for (int b = 0; b < 2; ++b) jofs[b] = (unsigned)((s8 ^ (4 * b + (g8 >> 1))) * 16);
    const unsigned pd = (unsigned)__builtin_amdgcn_readfirstlane(ring);
#define DN_FETCH(tw, dst) do { const char* rsrc_ = (const char*)(a.ws + WS_REC) + (size_t)(tw) * 512 + lane * 16; const unsigned d_ = (unsigned)__builtin_amdgcn_readfirstlane(dst); \
        glds16g(rsrc_, d_); glds16g(rsrc_ + 1024, d_ + 1024u); \
        glds16g((const char*)(a.ws + WS_HB) + (size_t)((tw) + g) * 2048 + x * 256 + li * 16, d_ + 2048u); } while (0)
    DN_FETCH(wv * 64, pd + 8192u);
    asm volatile("s_waitcnt vmcnt(0)" ::: "memory");
#pragma unroll 1
    for (int s_ = 0; s_ < 128; ++s_) {
        const int r = s_ & 1, k = s_ >> 1, t = wv * 64 + k, base = 64 * r;
        LAS unsigned char* wp = ringp + 8192 + 4096 * ((k >> 2) & 1);
        LAS unsigned char* hq = wp + 3072; LAS float* hsc = (LAS float*)(wp + 3072 + 512);
        const LAS unsigned* rec = (const LAS unsigned*)(wp + (k & 3) * 512) + base;
        asm volatile("s_waitcnt lgkmcnt(0)" ::: "memory");
        if ((k & 3) == 0 && r == 0) {
            {
                const v4u hb = *(const LAS v4u*)(wp + 2048 + lane * 16); float f[8]; unpack8(hb, f);
                float am = fmaxf(fmaxf(fmaxf(fabsf(f[0]), fabsf(f[1])), fmaxf(fabsf(f[2]), fabsf(f[3]))), fmaxf(fmaxf(fabsf(f[4]), fabsf(f[5])), fmaxf(fabsf(f[6]), fabsf(f[7]))));
                am = fmaxf(am, __int_as_float(__builtin_amdgcn_update_dpp(0, __float_as_int(am), 0x140, 0xf, 0xf, false))); am = fmaxf(am, __int_as_float(__builtin_amdgcn_update_dpp(0, __float_as_int(am), 0x141, 0xf, 0xf, false)));
                am = fmaxf(am, __int_as_float(__builtin_amdgcn_update_dpp(0, __float_as_int(am), 0x4E, 0xf, 0xf, false))); am = fmaxf(am, __int_as_float(__builtin_amdgcn_update_dpp(0, __float_as_int(am), 0xB1, 0xf, 0xf, false)));
                const float sc = (am > 0.f) ? am * (1.0f / 127.0f) : 1.0f, inv = 1.0f / sc;
                unsigned qw[2];
#pragma unroll
                for (int h2 = 0; h2 < 2; ++h2) { const int q0 = (int)__builtin_rintf(f[4 * h2] * inv), q1 = (int)__builtin_rintf(f[4 * h2 + 1] * inv), q2 = (int)__builtin_rintf(f[4 * h2 + 2] * inv), q3 = (int)__builtin_rintf(f[4 * h2 + 3] * inv);
                    qw[h2] = ((unsigned)q0 & 255u) | (((unsigned)q1 & 255u) << 8) | (((unsigned)q2 & 255u) << 16) | ((unsigned)q3 << 24); }
                *(LAS unsigned long long*)(hq + lane * 8) = (unsigned long long)qw[0] | ((unsigned long long)qw[1] << 32);
                if (li == 0) hsc[g] = sc; }
        }
        {   unsigned so[8];
#pragma unroll
            for (int i = 0; i < 8; ++i) so[i] = rec[8 * i + g8];
#pragma unroll
            for (int i = 0; i < 8; ++i) so[i] = ((so[i] & 0x3fffu) << 7) + jofs[i & 1];
            glds16x4(TABx, so[0], so[1], so[2], so[3], pd, pd + 1024u, pd + 2048u, pd + 3072u);
            glds16x4(TABx, so[4], so[5], so[6], so[7], pd + 4096u, pd + 5120u, pd + 6144u, pd + 7168u);
        }
        if ((k & 3) == 0 && r == 0 && k + 4 < 64) { DN_FETCH(t + 4, pd + 8192u + 4096u * (unsigned)(((k >> 2) + 1) & 1)); asm volatile("s_waitcnt vmcnt(3)" ::: "memory"); }
        else asm volatile("s_waitcnt vmcnt(0)" ::: "memory");
        const i32x4 hb0 = *(const LAS i32x4*)(hq + (k & 3) * 128 + 16 * kg), hb1 = *(const LAS i32x4*)(hq + (k & 3) * 128 + 64 + 16 * kg);
        const float hs = hsc[k & 3];
        i32x4 res = (i32x4){0, 0, 0, 0};
#pragma unroll
        for (int rb = 0; rb < 4; ++rb) {
            const int row = n16 + 16 * rb; const int key = (row >> 1) & 7;
            const i32x4 a0 = *(const LAS i32x4*)(ringp + row * 128 + ((kg ^ key) * 16)), a1 = *(const LAS i32x4*)(ringp + row * 128 + (((4 + kg) ^ key) * 16));
            i32x4 d = __builtin_amdgcn_mfma_i32_16x16x64_i8(a0, hb0, (i32x4){0, 0, 0, 0}, 0, 0, 0); d = __builtin_amdgcn_mfma_i32_16x16x64_i8(a1, hb1, d, 0, 0, 0);
            res = (n16 == rb) ? d : res; }
        if (n16 < 4) *(GAS f32x4*)((float*)(a.ws + WS_DOTP) + ((size_t)t * 8 + x) * 128 + base + 16 * n16 + 4 * kg) = (f32x4){(float)res[0] * hs, (float)res[1] * hs, (float)res[2] * hs, (float)res[3] * hs};
    }
}
#undef DN_FETCH

__device__ __forceinline__ void sweep_up_q8(const Args& a, int x, int wv, int lane, unsigned ring, LAS unsigned char* ringp, unsigned aux, LAS unsigned char* auxp) {
    const int n16 = lane & 15, kg = lane >> 4, g8 = lane >> 3, s8 = lane & 7;
    const char* TABx = (const char*)(a.ws + WS_EU) + (size_t)x * ((size_t)NEXP * 128);
    unsigned jofs[2];
#pragma unroll
    for (int b = 0; b < 2; ++b) jofs[b] = (unsigned)((s8 ^ ((g8 >> 1) | (b << 2))) * 16);
    const unsigned pd = (unsigned)__builtin_amdgcn_readfirstlane(ring);
    typedef int v2i_t __attribute__((ext_vector_type(2)));
    float acc0 = 0.f, acc1 = 0.f;
#define UP_FETCH(tw, dst) do { const char* rsrc_ = (const char*)(a.ws + WS_REC) + (size_t)(tw) * 512 + lane * 16; const unsigned d_ = (unsigned)__builtin_amdgcn_readfirstlane(dst); \
        glds16g(rsrc_, d_); glds16g(rsrc_ + 1024, d_ + 1024u); \
        if (lane < 36) glds16g((const char*)(a.ws + WS_WQ8) + (size_t)(tw) * 144 + lane * 16, d_ + 2048u); \
        glds16g((const char*)(a.ws + WS_HB) + (size_t)((tw) + (lane >> 4)) * 2048 + x * 256 + (lane & 15) * 16, d_ + 2688u); } while (0)
    UP_FETCH(wv * 64, pd + 8192u);
    asm volatile("s_waitcnt vmcnt(0)" ::: "memory");
#pragma unroll 1
    for (int s_ = 0; s_ < 128; ++s_) {
        const int r = s_ & 1, k = s_ >> 1, t = wv * 64 + k, base = 64 * r;
        const LAS unsigned char* wp = ringp + 8192 + 4096 * ((k >> 2) & 1);
        const LAS unsigned* rec = (const LAS unsigned*)(wp + (k & 3) * 512) + base;
        const LAS unsigned char* wq = wp + 2048 + (k & 3) * 144;
        asm volatile("s_waitcnt lgkmcnt(0)" ::: "memory");
        {   unsigned so[8];
#pragma unroll
            for (int i = 0; i < 8; ++i) so[i] = rec[8 * i + g8];
#pragma unroll
            for (int i = 0; i < 8; ++i) so[i] = ((so[i] & 0x3fffu) << 7) + jofs[(i >> 1) & 1];
            glds16x4(TABx, so[0], so[1], so[2], so[3], pd, pd + 1024u, pd + 2048u, pd + 3072u);
            glds16x4(TABx, so[4], so[5], so[6], so[7], pd + 4096u, pd + 5120u, pd + 6144u, pd + 7168u);
        }
        if ((k & 3) == 0 && r == 0 && k + 4 < 64) { UP_FETCH(t + 4, pd + 8192u + 4096u * (unsigned)(((k >> 2) + 1) & 1)); asm volatile("s_waitcnt vmcnt(4)" ::: "memory"); }
        else asm volatile("s_waitcnt vmcnt(0)" ::: "memory");
        const i32x4 aw = *(const LAS i32x4*)(wq + 64 * r + 16 * kg);
        const float wsc = *(const LAS float*)(wq + 128 + 4 * r);
        const int i2 = n16 >> 1, ih = n16 & 1;
        const int row0 = 16 * kg + i2, row1 = row0 + 8;
        const int k0 = ((row0 >> 1) & 3) | (((row0 >> 4) & 1) << 2), k1 = ((row1 >> 1) & 3) | (((row1 >> 4) & 1) << 2);
        const LAS unsigned char* p0 = ringp + row0 * 128 + 8 * ih; const LAS unsigned char* p1 = ringp + row1 * 128 + 8 * ih;
        float outv[8];
#pragma unroll
        for (int c = 0; c < 8; ++c) {
            const v2i_t lo = __builtin_amdgcn_ds_read_tr8_b64_v2i32((LAS v2i_t*)(p0 + ((c ^ k0) * 16)));
            const v2i_t hi = __builtin_amdgcn_ds_read_tr8_b64_v2i32((LAS v2i_t*)(p1 + ((c ^ k1) * 16)));
            const i32x4 d = __builtin_amdgcn_mfma_i32_16x16x64_i8(aw, (i32x4){lo.x, lo.y, hi.x, hi.y}, (i32x4){0, 0, 0, 0}, 0, 0, 0);
            outv[c] = (float)d[0] * wsc; }
        const float v0 = (kg == 0) ? outv[0] : (kg == 1) ? outv[1] : (kg == 2) ? outv[2] : outv[3];
        const float v1 = (kg == 0) ? outv[4] : (kg == 1) ? outv[5] : (kg == 2) ? outv[6] : outv[7];
        if (r == 0) { acc0 = v0; acc1 = v1; }
        else { const LAS unsigned short* hs = (const LAS unsigned short*)(wp + 2688 + (k & 3) * 256);
            const float y0 = bf2f(hs[lane]) + (acc0 + v0), y1 = bf2f(hs[64 + lane]) + (acc1 + v1);
            bf16* po = (bf16*)(a.ws + WS_PEER) + (size_t)t * D + x * 128;
            po[lane] = (bf16)f2bf(y0); po[64 + lane] = (bf16)f2bf(y1); }
    }
}
#undef UP_FETCH

__device__ __forceinline__ void final_row(const Args& a, int t, int lane) {
    float* orow = a.out + (size_t)t * D; const float* gf = a.in[22];
    const bf16* Y = (const bf16*)(a.ws + WS_PEER) + (size_t)t * D;
    f32x4 y[4]; float ss = 0.f;
#pragma unroll
    for (int j = 0; j < 4; ++j) { const unsigned long long yb = ((const GAS unsigned long long*)Y)[lane + 64 * j];
        y[j] = (f32x4){bflo((unsigned)yb), bfhi((unsigned)yb), bflo((unsigned)(yb >> 32)), bfhi((unsigned)(yb >> 32))};
        ss += (y[j].x * y[j].x + y[j].y * y[j].y) + (y[j].z * y[j].z + y[j].w * y[j].w); }
    ss = wave_sum(ss);
    const float ri = 1.0f / sqrtf(ss * (1.0f / 1024.0f) + EPSN);
#pragma unroll
    for (int j = 0; j < 4; ++j) ((GAS f32x4*)orow)[lane + 64 * j] = y[j] * ri * ((const GAS f32x4*)gf)[lane + 64 * j];
}

__device__ __forceinline__ float a_dot64(const float* p, const float* q, int lane) { return wave_sum(p[lane] * q[lane]); }
constexpr int N_PHASES = 12;
#ifndef ROUTE_REF
#define ROUTE_REF 0
#endif
#ifndef MK_ONE_LAUNCH
#define MK_ONE_LAUNCH 1
#endif
__global__ void __launch_bounds__(NWAVES * 64, 2) fwd_mega(Args args) {
    extern __shared__ __attribute__((aligned(16))) unsigned char lds[];
    Frame F;
    F.lds = (LAS unsigned char*)lds;
    F.MISC = (volatile LAS unsigned*)(F.lds + MISC_OFF);
    F.tid = threadIdx.x; F.lane = F.tid & 63; F.wave = __builtin_amdgcn_readfirstlane(F.tid >> 6);
    F.G = gridDim.x; { const int bx = blockIdx.x; F.vcu = (F.G % 8 == 0) ? (bx % 8) * (F.G / 8) + bx / 8 : bx; }
    unsigned char* ws = args.ws;
    const int lo = args.ph_lo, hi = args.ph_hi;
#ifndef PH_MASK
#define PH_MASK 0xffff
#endif
#define IN(k) (((PH_MASK >> (k)) & 1) && lo <= (k) && (k) < hi)
#define BOTH(k) (IN(k) && IN((k) + 1))
#if MK_ONE_LAUNCH
    for (int u = F.tid; u < (LDS_BYTES - LDSCTL_OFF) / 4; u += NWAVES * 64) ((LAS unsigned*)(F.lds + LDSCTL_OFF))[u] = 0u;
    __syncthreads();
    const XcdBarrier xbar = xcd_barrier_post((unsigned*)(ws + WS_CTL) + CW_BAR, F.MISC + 8);
    bool first_seam = args.ph_lo < 0;
#define GRID_BAR() do { if (first_seam) { __threadfence(); cooperative_groups::this_grid().sync(); first_seam = false; } else xcd_barrier(xbar); } while (0)
#else
#define GRID_BAR() do { } while (0)
#endif
#ifndef REP_PH
#define REP_PH -1
#endif
#define RUN_PHASE(k, ...) do { if (IN(k)) { if ((k) == REP_PH) { { const bool first_of_two = true; (void)first_of_two; __VA_ARGS__ } GRID_BAR(); } { const bool first_of_two = false; (void)first_of_two; __VA_ARGS__ } if (BOTH(k)) GRID_BAR(); } } while (0)
    RUN_PHASE(0, { p0_prologue(F, args); });
    RUN_PHASE(1, {
        pg8::Gemm g{(const pg8::bf16_t*)(ws + WS_XB), (const pg8::bf16_t*)(ws + WS_WIN), M, INC, D}; pg8::StaticOrder S; S.init(M, INC, F.G, (int)blockIdx.x);
        pg8::EpiBf16<1> E{(pg8::bf16_t*)(ws + WS_Q), 512, (const float*)(ws + WS_RS1), 512, (size_t)WS_SPLIT / 2, attn_body::C2};
        pg8::gemm_phase<pg8::EpiBf16<1>, pg8::StaticOrder, true, true>(F.lds + RING_OFF, g, S, E);
        { const int nb = (F.G >= 2) ? (int)F.G / 2 : 1; const int bi = (int)blockIdx.x - ((int)F.G - nb); if (bi >= 0) convert_experts(args, bi * NWAVES + F.wave, nb * NWAVES, F.lane); }
    });
    RUN_PHASE(2, {
        for (int c = F.vcu; c < M / 64; c += F.G) lru_local_unit(F, args, c);
        const attn128::AttnTensors AT{(const attn128::bf16*)(ws + WS_Q), (const attn128::bf16*)(ws + WS_Q + WS_SPLIT), (const attn128::bf16*)(ws + WS_Q + 2 * WS_SPLIT), (attn128::bf16*)(ws + WS_OS)};
        const attn128::StaticOrder S(F.vcu);
        attn128::attn_phase<attn128::StaticOrder>((char*)lds + RING_OFF, AT, S);
    });
    RUN_PHASE(3, {
        float l1 = a_dot64(args.in[3], args.in[4], F.lane); float l2 = a_dot64(args.in[5], args.in[6], F.lane);
        const float lamv = expf(l1) - expf(l2) + 0.2f;
        for (int c = F.vcu; c < M / 64; c += F.G) fix_unit(F, args, c, lamv);
    });
    RUN_PHASE(4, {
        pg8::Gemm g{(const pg8::bf16_t*)(ws + WS_MIX), (const pg8::bf16_t*)(ws + WS_WOUT), M, D, D}; pg8::StaticOrder S; S.init(M, D, F.G, (int)blockIdx.x);
        pg8::EpiResid E{args.in[0], args.out, (pg8::bf16_t*)(ws + WS_HB), (float*)(ws + (first_of_two ? WS_RS1 : WS_ROWSS2)), D};
        pg8::gemm_phase<pg8::EpiResid, pg8::StaticOrder, true, true>(F.lds + RING_OFF, g, S, E);
    });
    RUN_PHASE(5, {
        pg8::Gemm g{(const pg8::bf16_t*)(ws + WS_HB), (const pg8::bf16_t*)(ws + WS_WQ), M, NQ, D}; pg8::StaticOrder S; S.init(M, NQ, F.G, (int)blockIdx.x);
        pg8::EpiBf16<2> E{(pg8::bf16_t*)(ws + WS_Q2), NQ, (const float*)(ws + WS_ROWSS2), 0, 0, 1.f};
        pg8::gemm_phase<pg8::EpiBf16<2>, pg8::StaticOrder, true, true>(F.lds + RING_OFF, g, S, E);
    });
    RUN_PHASE(6, {
        const int gw = F.vcu * NWAVES + F.wave; const int NGW = F.G * NWAVES;
        LAS unsigned char* skl = F.lds + RING_OFF + 16384;
        for (int c = F.tid; c < 4096; c += NWAVES * 64) { const int row = c >> 4; const int ch = c & 15; *(LAS v4u*)(skl + row * 272 + ch * 16) = *(const GAS v4u*)(ws + WS_SK1 + (size_t)row * 256 + ch * 16); }
        __syncthreads();
        static_assert((M / 32) * 8 == NEXP / 4, "one group of 4 expert_up rows beside each routing unit");
        for (int u = gw; u < (M / 32) * 8; u += NGW) { f32x4 ev[4][4]; q8_load<4>(ev, args.in[21] + (size_t)u * 4 * D, F.lane);
            route_unit(args, u >> 3, u & 7, F.lane, F.lds + RING_OFF + F.tid * 32, skl, (int*)(ws + WS_EID), (float*)(ws + WS_GW));
            q8_finish<4>(ev, ws + WS_EU + (size_t)u * 4 * 128, nullptr, (float*)(ws + WS_SCU) + 4 * u, F.lane); }
        __syncthreads();
    });
    RUN_PHASE(8, {
        if (F.G == 256) sweep_down_q8(args, F.vcu >> 5, (F.vcu & 31) * NWAVES + F.wave, F.lane, (unsigned)(uintptr_t)(lds + RING_OFF) + F.wave * 16384u, F.lds + RING_OFF + F.wave * 16384, (unsigned)(uintptr_t)(lds + LDSCTL_OFF + 1024) + F.wave * 3712u, F.lds + LDSCTL_OFF + 1024 + F.wave * 3712);
    });
    RUN_PHASE(9, {
        const int gw = F.vcu * NWAVES + F.wave; const int NGW = F.G * NWAVES;
        LAS float* scl = (LAS float*)(F.lds + RING_OFF);
        for (int i = F.tid; i < NEXP / 4; i += NWAVES * 64) { ((LAS v4u*)scl)[i] = ((const GAS v4u*)(ws + WS_SCD))[i]; ((LAS v4u*)(scl + NEXP))[i] = ((const GAS v4u*)(ws + WS_SCU))[i]; }
        __syncthreads();
        for (int t = 8 * gw; t < M; t += 8 * NGW) w_tokens<8>(args, t, F.lane, scl, scl + NEXP);
        __syncthreads();
    });
    RUN_PHASE(10, {
        if (F.G == 256) sweep_up_q8(args, F.vcu >> 5, (F.vcu & 31) * NWAVES + F.wave, F.lane, (unsigned)(uintptr_t)(lds + RING_OFF) + F.wave * 16384u, F.lds + RING_OFF + F.wave * 16384, (unsigned)(uintptr_t)(lds + LDSCTL_OFF + 1024) + F.wave * 3712u, F.lds + LDSCTL_OFF + 1024 + F.wave * 3712);
    });
    RUN_PHASE(11, {
        const int gw = F.vcu * NWAVES + F.wave; const int NGW = F.G * NWAVES;
        for (int t = gw; t < M; t += NGW) final_row(args, t, F.lane);
    });
#undef IN
#undef BOTH
}

extern "C" void kernel_launch(void* const* d_in, const int* in_sizes, int n_in, void* d_out, int out_size, void* d_ws, size_t ws_size, hipStream_t stream) {
    static int grid = 0;
    if (grid == 0) {
        if (n_in != 23 || out_size != M * D || ws_size < WS_END) { fprintf(stderr, "kernel_launch: unexpected problem: n_in %d out %d ws %zu\n", n_in, out_size, ws_size); grid = -1; return; }
        int dev = 0, cus = 0, per_cu = 0;
        if (hipGetDevice(&dev) != hipSuccess || hipDeviceGetAttribute(&cus, hipDeviceAttributeMultiprocessorCount, dev) != hipSuccess) { grid = -1; return; }
        if (hipFuncSetAttribute((const void*)fwd_mega, hipFuncAttributeMaxDynamicSharedMemorySize, LDS_BYTES) != hipSuccess) { fprintf(stderr, "kernel_launch: hipFuncSetAttribute failed\n"); grid = -1; return; }
        if (hipOccupancyMaxActiveBlocksPerMultiprocessor(&per_cu, (const void*)fwd_mega, NWAVES * 64, LDS_BYTES) != hipSuccess || per_cu < 1) { fprintf(stderr, "kernel_launch: occupancy query reports %d\n", per_cu); per_cu = 1; }
        (void)hipGetLastError();
        grid = cus;
    }
    if (grid < 0) return;
    (void)hipMemsetAsync((char*)d_ws + WS_CTL, 0, CTL_ZERO_BYTES, stream);
    Args a{};
    for (int i = 0; i < 23; ++i) a.in[i] = (const float*)d_in[i];
    a.out = (float*)d_out; a.ws = (unsigned char*)d_ws;
#if MK_ONE_LAUNCH
    a.ph_lo = 0; a.ph_hi = N_PHASES;
    void* kargs[] = {&a};
    hipError_t e = hipLaunchCooperativeKernel((const void*)fwd_mega, dim3(grid), dim3(NWAVES * 64), kargs, LDS_BYTES, stream);
    if (e != hipSuccess) fprintf(stderr, "cooperative launch failed: %s (grid %d)\n", hipGetErrorString(e), grid);
#else
    for (int p = 0; p < N_PHASES; ++p) { a.ph_lo = p; a.ph_hi = p + 1; hipLaunchKernelGGL(fwd_mega, dim3(grid), dim3(NWAVES * 64), LDS_BYTES, stream, a); }
#endif
}
```

```cpp
#include <hip/hip_runtime.h>
#include <hip/hip_cooperative_groups.h>
#include <cstdio>
#include <cstdint>
namespace pg8 {
#define PG8_LAS __attribute__((address_space(3)))
typedef unsigned short bf16_t;
typedef short bf16x8 __attribute__((ext_vector_type(8)));
typedef float f32x4 __attribute__((ext_vector_type(4)));
typedef unsigned u32x4 __attribute__((ext_vector_type(4)));
constexpr int BM = 256, BK = 64, HALF = 128, HTB = HALF * BK * 2  , STAGE_BYTES = 8 * HTB, NXCD = 8, WGM = 8;

__host__ __device__ __forceinline__ int lds_byte(int r, int c) { const int st = (r >> 4) * 2 + (c >> 5), rr = r & 15, cc = c & 31, ob = rr * 64 + cc * 2; return st * 1024 + (ob ^ (((ob >> 9) & 1) << 5)); }
__host__ __device__ __forceinline__ void stage_rc(int b, int& R, int& C) { const int st = b / 1024, sb = b % 1024, swz = sb ^ (((sb >> 9) & 1) << 5); R = (st >> 1) * 16 + swz / 64; C = (st & 1) * 32 + (swz % 64) / 2; }
__host__ __device__ __forceinline__ int perm32(int rho) { const int n = rho >> 4, i = rho & 15; return 8 * (i >> 2) + 4 * n + (i & 3); }

struct Unit { int pm, pn; };
struct Gemm { const bf16_t* A; const bf16_t* Bt; int M, N, K; };

struct StaticOrder {
    int nM, nN, nwg, G, c;
    __host__ __device__ void init(int M, int N, int G_, int c_) { nM = M / BM; nN = N / BM; nwg = nM * nN; G = G_; c = c_; }
    __host__ __device__ bool next(int i, Unit& u) const {
        const long L = (long)i * G + c; if (L >= nwg) return false;
        int wgid = (int)L; { const int q = nwg / NXCD, r = nwg % NXCD, xcd = wgid % NXCD, off = wgid / NXCD; wgid = (xcd < r ? xcd * (q + 1) : r * (q + 1) + (xcd - r) * q) + off; }
        const int nig = WGM * nN, gid = wgid / nig, fm = gid * WGM, gsz = (nM - fm) < WGM ? (nM - fm) : WGM;
        u.pm = fm + ((wgid % nig) % gsz); u.pn = (wgid % nig) / gsz; return true;
    }
    __device__ __forceinline__ void a_ready(const Unit&) const {}
    __device__ __forceinline__ void done(const Unit&) const {}
};

__device__ __forceinline__ unsigned cvt_pk_bf16(float lo, float hi) { unsigned r; asm volatile("v_cvt_pk_bf16_f32 %0, %1, %2" : "=v"(r) : "v"(lo), "v"(hi)); return r; }
typedef float f32x2 __attribute__((ext_vector_type(2)));

template <int RSMODE> struct EpiBf16 {
    static constexpr bool PERM = true, AFTER_DRAIN = false;
    bf16_t* O; int ldc; const float* rowscale; int split_cols; size_t split_stride; float scale0;
    __device__ __forceinline__ void operator()(const f32x4 (&acc)[2][2][4][2], const Unit& u, int wr, int wc, int fr, int fq) const {
        const int row0 = u.pm * BM + wr * 64 + fr; int colt = u.pn * BM; bf16_t* base = O;
        float sc = 1.f; if (split_cols) { const int t = colt / split_cols; base += (size_t)t * split_stride; colt -= t * split_cols; if (t == 0) sc = scale0; }
        const int col0 = colt + wc * 32 + 8 * fq;
#pragma unroll
        for (int ai = 0; ai < 2; ++ai)
#pragma unroll
            for (int m = 0; m < 4; ++m) { const int row = row0 + ai * HALF + m * 16; bf16_t* rowp = base + (size_t)row * ldc + col0;
                float rs = sc;
                if (RSMODE == 1) rs *= rowscale[row];
                if (RSMODE == 2) rs *= 1.0f / sqrtf(rowscale[row] * (1.0f / 1024.0f) + 1e-6f);
#pragma unroll
                for (int bj = 0; bj < 2; ++bj) { f32x4 v0 = acc[ai][bj][m][0] * rs, v1 = acc[ai][bj][m][1] * rs;
                    u32x4 w; w.x = cvt_pk_bf16(v0[0], v0[1]); w.y = cvt_pk_bf16(v0[2], v0[3]); w.z = cvt_pk_bf16(v1[0], v1[1]); w.w = cvt_pk_bf16(v1[2], v1[3]);
                    *(u32x4*)(rowp + bj * HALF) = w; } }
    }
};

struct EpiResid {
    static constexpr bool PERM = false, AFTER_DRAIN = false;
    const bf16_t* X; float* Hf; bf16_t* Hb; float* rowss; int ldc;
    __device__ __forceinline__ void operator()(const f32x4 (&acc)[2][2][4][2], const Unit& u, int wr, int wc, int fr, int fq) const {
        typedef unsigned u32x2v __attribute__((ext_vector_type(2)));
        const int col0 = u.pn * BM + wc * 32 + 4 * fq;
#pragma unroll
        for (int ai = 0; ai < 2; ++ai)
#pragma unroll
            for (int m = 0; m < 4; ++m) { const int row = u.pm * BM + ai * HALF + wr * 64 + m * 16 + fr; const size_t off = (size_t)row * ldc + col0; float ss = 0.f;
#pragma unroll
                for (int bj = 0; bj < 2; ++bj)
#pragma unroll
                    for (int n = 0; n < 2; ++n) { const u32x2v xb = *(const u32x2v*)(X + off + bj * HALF + n * 16);
                        const f32x4 xv = (f32x4){__builtin_bit_cast(float, xb.x << 16), __builtin_bit_cast(float, xb.x & 0xffff0000u), __builtin_bit_cast(float, xb.y << 16), __builtin_bit_cast(float, xb.y & 0xffff0000u)}; const f32x4 h = xv + acc[ai][bj][m][n];
                        u32x2v w; w.x = cvt_pk_bf16(h[0], h[1]); w.y = cvt_pk_bf16(h[2], h[3]);
                        *(u32x2v*)(Hb + off + bj * HALF + n * 16) = w; ss += (h[0] * h[0] + h[1] * h[1]) + (h[2] * h[2] + h[3] * h[3]); }
                ss += __shfl_xor(ss, 16); ss += __shfl_xor(ss, 32);
                if (fq == 0) atomicAdd(rowss + row, ss); }
    }
};

template <class Epi, class Sched, bool ALIGN_EPI = false, bool SP2 = false>
__device__ __forceinline__ void gemm_phase(PG8_LAS unsigned char* lds, const Gemm g, const Sched& S, const Epi& E) {
    const int tid = threadIdx.x, wid = __builtin_amdgcn_readfirstlane(tid >> 6), lane = tid & 63, wr = wid >> 2, wc = wid & 3, fr = lane & 15, fq = lane >> 4;
    const int K = g.K, nt = K / BK;
    unsigned voffA[2], voffB[2];
#pragma unroll
    for (int i = 0; i < 2; ++i) { int R, C; stage_rc(tid * 16 + i * 8192, R, C); const int Rb = Epi::PERM ? ((R & ~31) + perm32(R & 31)) : R;
        voffA[i] = (unsigned)(R * K + C) * 2u; voffB[i] = (unsigned)(Rb * K + C) * 2u; }
    const size_t kstep = (size_t)(BK * 2);
    const size_t hstep = (size_t)HALF * K * 2;
    const size_t tstep = 2 * hstep;
    const unsigned ldsw = (unsigned)wid * 1024u;
    const int aoff = lds_byte(wr * 64 + fr, fq * 8), boff = lds_byte(wc * 32 + fr, fq * 8);
#define PG8_SA(b, h) (((b) * 2 + (h)) * HTB)
#define PG8_SB(b, h) ((4 + (b) * 2 + (h)) * HTB)
#define PG8_STAGE(bufoff, gbase, voff) do { _Pragma("unroll") for (int _i = 0; _i < 2; ++_i) \
        __builtin_amdgcn_global_load_lds((const unsigned*)((const char*)(gbase) + (voff)[_i]), (PG8_LAS unsigned*)(lds + (bufoff) + ldsw + _i * 8192), 16, 0, 0); } while (0)
#define PG8_LDA(dst, b, h) do { _Pragma("unroll") for (int m = 0; m < 4; ++m) _Pragma("unroll") for (int k = 0; k < 2; ++k) dst[m][k] = *(const PG8_LAS bf16x8*)(lds + PG8_SA(b, h) + aoff + m * 2048 + k * 1024); } while (0)
#define PG8_LDB(dst, b, h) do { _Pragma("unroll") for (int n = 0; n < 2; ++n) _Pragma("unroll") for (int k = 0; k < 2; ++k) dst[n][k] = *(const PG8_LAS bf16x8*)(lds + PG8_SB(b, h) + boff + n * 2048 + k * 1024); } while (0)
#define PG8_MMA(ai, bj, At, Bt) do { __builtin_amdgcn_s_setprio(1); _Pragma("unroll") for (int m = 0; m < 4; ++m) _Pragma("unroll") for (int n = 0; n < 2; ++n) _Pragma("unroll") for (int k = 0; k < 2; ++k) \
        acc[ai][bj][m][n] = __builtin_amdgcn_mfma_f32_16x16x32_bf16(Bt[n][k], At[m][k], acc[ai][bj][m][n], 0, 0, 0); __builtin_amdgcn_s_setprio(0); } while (0)
#define PG8_WAIT_V(n) asm volatile("s_waitcnt vmcnt(" #n ")" ::: "memory")
#define PG8_WAIT_L(n) asm volatile("s_waitcnt lgkmcnt(" #n ")" ::: "memory")
#define PG8_BAR __builtin_amdgcn_s_barrier()
#define PG8_SCHED __builtin_amdgcn_sched_barrier(0)
    Unit cur, nxt; int ui = 0;
    if (!S.next(0, cur)) return;
    f32x4 acc[2][2][4][2];
#pragma unroll
    for (int a = 0; a < 2; ++a)
#pragma unroll
        for (int b = 0; b < 2; ++b)
#pragma unroll
            for (int m = 0; m < 4; ++m)
#pragma unroll
                for (int n = 0; n < 2; ++n) acc[a][b][m][n] = (f32x4){0.f, 0.f, 0.f, 0.f};
    bf16x8 At[4][2], B0[2][2], B1[2][2];
    const char* cA = (const char*)g.A + (size_t)cur.pm * tstep; const char* cB = (const char*)g.Bt + (size_t)cur.pn * tstep;
    S.a_ready(cur);
    if constexpr (SP2) {
        PG8_STAGE(PG8_SB(0, 0), cB, voffB); PG8_STAGE(PG8_SB(0, 1), cB + hstep, voffB); PG8_STAGE(PG8_SA(0, 0), cA, voffA); PG8_STAGE(PG8_SA(0, 1), cA + hstep, voffA);
        if (wr == 1) PG8_BAR;
        PG8_WAIT_V(2); PG8_BAR;
        PG8_STAGE(PG8_SB(1, 0), cB + kstep, voffB); PG8_STAGE(PG8_SA(1, 0), cA + kstep, voffA); PG8_STAGE(PG8_SB(1, 1), cB + hstep + kstep, voffB);
        PG8_WAIT_V(6); PG8_BAR;
    } else {
        PG8_STAGE(PG8_SB(0, 0), cB, voffB); PG8_STAGE(PG8_SA(0, 0), cA, voffA); PG8_STAGE(PG8_SB(0, 1), cB + hstep, voffB); PG8_STAGE(PG8_SA(0, 1), cA + hstep, voffA);
        if (wr == 1) PG8_BAR;
        PG8_WAIT_V(4); PG8_BAR;
        PG8_STAGE(PG8_SB(1, 0), cB + kstep, voffB); PG8_STAGE(PG8_SA(1, 0), cA + kstep, voffA); PG8_STAGE(PG8_SB(1, 1), cB + hstep + kstep, voffB);
        PG8_WAIT_V(6); PG8_BAR;
    }
    for (;;) {
        const bool has_next = S.next(ui + 1, nxt);
        const char* nA = has_next ? (const char*)g.A + (size_t)nxt.pm * tstep : cA; const char* nB = has_next ? (const char*)g.Bt + (size_t)nxt.pn * tstep : cB;
        for (int t = 0; t < nt; t += 2) {
            const bool last = (t == nt - 2);
            const char* a1 = cA + (size_t)(t + 1) * kstep;
            const char* a2 = last ? nA : cA + (size_t)(t + 2) * kstep; const char* b2 = last ? nB : cB + (size_t)(t + 2) * kstep;
            const char* a3 = a2 + kstep; const char* b3 = b2 + kstep;
            if (last && has_next) S.a_ready(nxt);
            if constexpr (SP2) {
            PG8_LDB(B0, 0, 0); PG8_LDB(B1, 0, 1); PG8_SCHED; PG8_LDA(At, 0, 0); PG8_STAGE(PG8_SA(1, 1), a1 + hstep, voffA);
            PG8_WAIT_V(8); PG8_WAIT_L(0); PG8_BAR; PG8_MMA(0, 0, At, B0); PG8_MMA(0, 1, At, B1); PG8_BAR; PG8_SCHED;
            PG8_LDA(At, 0, 1); PG8_STAGE(PG8_SB(0, 0), b2, voffB); PG8_STAGE(PG8_SB(0, 1), b2 + hstep, voffB); PG8_STAGE(PG8_SA(0, 0), a2, voffA);
            PG8_WAIT_V(8); PG8_WAIT_L(0); PG8_BAR; PG8_MMA(1, 0, At, B0); PG8_MMA(1, 1, At, B1); PG8_BAR; PG8_SCHED;
            PG8_LDB(B0, 1, 0); PG8_LDB(B1, 1, 1); PG8_SCHED; PG8_LDA(At, 1, 0); PG8_STAGE(PG8_SA(0, 1), a2 + hstep, voffA);
            PG8_WAIT_V(8); PG8_WAIT_L(0); PG8_BAR; PG8_MMA(0, 0, At, B0); PG8_MMA(0, 1, At, B1); PG8_BAR; PG8_SCHED;
            PG8_LDA(At, 1, 1); PG8_STAGE(PG8_SB(1, 0), b3, voffB); PG8_STAGE(PG8_SB(1, 1), b3 + hstep, voffB); PG8_STAGE(PG8_SA(1, 0), a3, voffA);
            PG8_WAIT_V(8); PG8_WAIT_L(0); PG8_BAR; PG8_MMA(1, 0, At, B0); PG8_MMA(1, 1, At, B1); PG8_BAR; PG8_SCHED;
            } else {
            PG8_LDB(B0, 0, 0); PG8_SCHED; PG8_LDA(At, 0, 0); PG8_STAGE(PG8_SA(1, 1), a1 + hstep, voffA);
            PG8_WAIT_L(8); PG8_BAR; PG8_WAIT_L(0); PG8_MMA(0, 0, At, B0); PG8_BAR; PG8_SCHED;
            PG8_LDB(B1, 0, 1); PG8_STAGE(PG8_SB(0, 0), b2, voffB);
            PG8_BAR; PG8_WAIT_L(0); PG8_MMA(0, 1, At, B1); PG8_BAR;
            PG8_LDA(At, 0, 1); PG8_STAGE(PG8_SA(0, 0), a2, voffA);
            PG8_BAR; PG8_WAIT_L(0); PG8_MMA(1, 0, At, B0); PG8_BAR; PG8_SCHED;
            PG8_STAGE(PG8_SB(0, 1), b2 + hstep, voffB);
            PG8_WAIT_V(6); PG8_BAR; PG8_MMA(1, 1, At, B1); PG8_BAR;
            PG8_LDB(B0, 1, 0); PG8_SCHED; PG8_LDA(At, 1, 0); PG8_STAGE(PG8_SA(0, 1), a2 + hstep, voffA);
            PG8_WAIT_L(8); PG8_BAR; PG8_WAIT_L(0); PG8_MMA(0, 0, At, B0); PG8_BAR; PG8_SCHED;
            PG8_LDB(B1, 1, 1); PG8_STAGE(PG8_SB(1, 0), b3, voffB);
            PG8_BAR; PG8_WAIT_L(0); PG8_MMA(0, 1, At, B1); PG8_BAR;
            PG8_LDA(At, 1, 1); PG8_STAGE(PG8_SA(1, 0), a3, voffA);
            PG8_BAR; PG8_WAIT_L(0); PG8_MMA(1, 0, At, B0); PG8_BAR; PG8_SCHED;
            PG8_STAGE(PG8_SB(1, 1), b3 + hstep, voffB);
            PG8_WAIT_V(6); PG8_BAR; PG8_MMA(1, 1, At, B1); PG8_BAR;
            }
        }
        if constexpr (ALIGN_EPI) { if (wr == 0) PG8_BAR; }
        if constexpr (!Epi::AFTER_DRAIN) { E(acc, cur, wr, wc, fr, fq); S.done(cur); }
        if (!has_next) break;
#pragma unroll
        for (int a = 0; a < 2; ++a)
#pragma unroll
            for (int b = 0; b < 2; ++b)
#pragma unroll
                for (int m = 0; m < 4; ++m)
#pragma unroll
                    for (int n = 0; n < 2; ++n) acc[a][b][m][n] = (f32x4){0.f, 0.f, 0.f, 0.f};
        cur = nxt; cA = nA; cB = nB; ++ui;
        if constexpr (ALIGN_EPI) { if (wr == 1) PG8_BAR; }
    }
    PG8_WAIT_V(0);
    if constexpr (!ALIGN_EPI) { if (wr == 0) PG8_BAR; }
    PG8_BAR;
    if constexpr (Epi::AFTER_DRAIN) { E.fused(acc, cur, wr, wc, fr, fq, lds, wid, lane); S.done(cur); }
#undef PG8_SA
#undef PG8_SB
#undef PG8_STAGE
#undef PG8_LDA
#undef PG8_LDB
#undef PG8_MMA
#undef PG8_WAIT_V
#undef PG8_WAIT_L
#undef PG8_BAR
#undef PG8_SCHED
}
}

#include <hip/hip_bf16.h>
#include <cmath>
namespace attn_body {
using bf16=__hip_bfloat16;
using bf16x8=__attribute__((ext_vector_type(8)))short;
using s16x4=__attribute__((ext_vector_type(4)))short;
using f32x16=__attribute__((ext_vector_type(16)))float;
using u32x4=__attribute__((ext_vector_type(4)))unsigned;
constexpr int SEQ=16384,D=64,DM=512;
constexpr int NW=8,QBLK=32,QB=QBLK*NW,KVBLK=64,NQB=SEQ/QB;
constexpr int ATTN_PITCH=DM, ATTN_UNIT_ROWS=QB;
__device__ __forceinline__ int crow(int r,int hi){return (r&3)+8*(r>>2)+4*hi;}
#define SBAR() __builtin_amdgcn_sched_barrier(0)
__device__ __forceinline__ void cmask(f32x16&p0,f32x16&p1,int jb,int wid){
  const float NEG=-INFINITY;
  if(jb>(wid>>1)){
  #pragma unroll
  for(int r=0;r<16;++r){p0[r]=NEG;p1[r]=NEG;}}
}

constexpr int NSLOT=3, SLOTB=8192;
constexpr int LDS_K=0, LDS_V=NSLOT*SLOTB, LDS_WS=2*NSLOT*SLOTB, LDS_OST=LDS_WS+NW*64*4, LDS_BYTES=LDS_OST+NW*4096;
constexpr float C2=0.125f*1.4426950408889634f;
__device__ __forceinline__ void glds16(const void*gsrc,unsigned lds_dst){unsigned keep;
  asm volatile("s_mov_b32 %0, m0\n\ts_mov_b32 m0, %2\n\ts_nop 0\n\tglobal_load_lds_dwordx4 %1, off\n\ts_mov_b32 m0, %0":"=&s"(keep):"v"(gsrc),"s"(lds_dst):"memory");}
__device__ __forceinline__ float max3f(float a,float b,float c){float r;asm("v_max3_f32 %0, %1, %2, %3":"=v"(r):"v"(a),"v"(b),"v"(c));return r;}
__device__ __forceinline__ float max2f(float a,float b){float r;asm("v_max_f32_e32 %0, %1, %2":"=v"(r):"v"(a),"v"(b));return r;}
__device__ __forceinline__ float fadd_s(float a,float b){float r;asm("v_add_f32_e32 %0, %1, %2":"=v"(r):"v"(a),"v"(b));return r;}
__device__ __forceinline__ float fsub_s(float a,float b){float r;asm("v_sub_f32_e32 %0, %1, %2":"=v"(r):"v"(a),"v"(b));return r;}
typedef float f32x2_t __attribute__((ext_vector_type(2))); typedef __bf16 bf16x2_t __attribute__((ext_vector_type(2)));
__device__ __forceinline__ unsigned cvtpk_s(float lo,float hi){f32x2_t v={lo,hi};bf16x2_t b=__builtin_convertvector(v,bf16x2_t);return __builtin_bit_cast(unsigned,b);}
#define WAIT_BAR(N) asm volatile("s_waitcnt vmcnt(" #N ") lgkmcnt(0)\n\ts_barrier":::"memory")

__device__ __forceinline__ void qkt(f32x16&p0,f32x16&p1,const char*Kslot,const bf16x8*qr,const f32x16&negm,int r32,int hi){
  const char*kb=Kslot+hi*1024+r32*16;
  #pragma unroll
  for(int d0=0;d0<4;++d0){
    const bf16x8 b0=*reinterpret_cast<const bf16x8*>(kb+d0*2048);
    const bf16x8 b1=*reinterpret_cast<const bf16x8*>(kb+d0*2048+512);
    if(d0==0){p0=__builtin_amdgcn_mfma_f32_32x32x16_bf16(b0,qr[0],negm,0,0,0);p1=__builtin_amdgcn_mfma_f32_32x32x16_bf16(b1,qr[0],negm,0,0,0);}
    else{p0=__builtin_amdgcn_mfma_f32_32x32x16_bf16(b0,qr[d0],p0,0,0,0);p1=__builtin_amdgcn_mfma_f32_32x32x16_bf16(b1,qr[d0],p1,0,0,0);}}
}
typedef __attribute__((address_space(3))) const char* lds_cptr;
typedef short v4i16_t __attribute__((ext_vector_type(4)));
__device__ __forceinline__ void kload8(bf16x8*kf,lds_cptr kp){
  kf[0]=*(const __attribute__((address_space(3))) bf16x8*)(kp);      kf[1]=*(const __attribute__((address_space(3))) bf16x8*)(kp+512);
  kf[2]=*(const __attribute__((address_space(3))) bf16x8*)(kp+2048); kf[3]=*(const __attribute__((address_space(3))) bf16x8*)(kp+2560);
  kf[4]=*(const __attribute__((address_space(3))) bf16x8*)(kp+4096); kf[5]=*(const __attribute__((address_space(3))) bf16x8*)(kp+4608);
  kf[6]=*(const __attribute__((address_space(3))) bf16x8*)(kp+6144); kf[7]=*(const __attribute__((address_space(3))) bf16x8*)(kp+6656);
}
__device__ __forceinline__ void kload2(bf16x8*kf,lds_cptr kp,int j){ kf[2*j]=*(const __attribute__((address_space(3))) bf16x8*)(kp+j*2048); kf[2*j+1]=*(const __attribute__((address_space(3))) bf16x8*)(kp+j*2048+512); }
__device__ __forceinline__ s16x4 vtr(lds_cptr p){ return __builtin_bit_cast(s16x4,__builtin_amdgcn_ds_read_tr16_b64_v4i16((__attribute__((address_space(3))) v4i16_t*)p)); }
__device__ __forceinline__ float rowmax(const f32x16&p0,const f32x16&p1){
  float a=max3f(p0[0],p0[1],p1[0]),b=max3f(p0[2],p0[3],p1[1]);a=max3f(a,p1[2],p1[3]);
  #pragma unroll
  for(int r=4;r<16;r+=4){a=max3f(a,p0[r],p0[r+1]);b=max3f(b,p0[r+2],p0[r+3]);a=max3f(a,p1[r],p1[r+1]);b=max3f(b,p1[r+2],p1[r+3]);}
  const float m=max2f(a,b);
  auto rr=__builtin_amdgcn_permlane32_swap(__float_as_uint(m),__float_as_uint(m),false,false);
  return max2f(__uint_as_float(rr[0]),__uint_as_float(rr[1]));
}
__device__ __forceinline__ void pv(f32x16*o,int vb,bf16x8 pa0,bf16x8 pa1,bf16x8 pa2,bf16x8 pa3){
  #pragma unroll
  for(int d0=0;d0<2;++d0){s16x4 lo[4],hi[4];
    #pragma unroll
    for(int ks=0;ks<4;++ks){
      asm volatile("ds_read_b64_tr_b16 %0,%1 offset:%c2":"=&v"(lo[ks]):"v"(vb),"i"(d0*4096+ks*1024):"memory");
      asm volatile("ds_read_b64_tr_b16 %0,%1 offset:%c2":"=&v"(hi[ks]):"v"(vb),"i"(d0*4096+ks*1024+512):"memory");}
    asm volatile("s_waitcnt lgkmcnt(0)":::"memory");SBAR();
    #define PK(k) (bf16x8){lo[k][0],lo[k][1],lo[k][2],lo[k][3],hi[k][0],hi[k][1],hi[k][2],hi[k][3]}
    o[d0]=__builtin_amdgcn_mfma_f32_32x32x16_bf16(pa0,PK(0),o[d0],0,0,0);
    o[d0]=__builtin_amdgcn_mfma_f32_32x32x16_bf16(pa1,PK(1),o[d0],0,0,0);
    o[d0]=__builtin_amdgcn_mfma_f32_32x32x16_bf16(pa2,PK(2),o[d0],0,0,0);
    o[d0]=__builtin_amdgcn_mfma_f32_32x32x16_bf16(pa3,PK(3),o[d0],0,0,0);
    #undef PK
  }
}

#ifndef ATTN_STORE16
#define ATTN_STORE16(p,v) (*(u32x4*)(p)=(v))
#endif
template<int THRL> __device__ __forceinline__ void attn_unit(int qcol,int vcol,int qb,const bf16*Q,const bf16*__restrict__ K,const bf16*__restrict__ V,bf16*O,char*shm){
  const int tid=threadIdx.x,lane=tid&63,r32=lane&31,hi=lane>>5; const int wid=__builtin_amdgcn_readfirstlane(tid>>6);
  const long rowbase=0; const int q0=qb*QB;
  const bf16*Qw=Q+(rowbase+q0+wid*QBLK)*DM+qcol;
  const bf16*Kh=K+rowbase*DM+qcol,*Vh=V+rowbase*DM+vcol;
  const unsigned lds0=(unsigned)(uintptr_t)shm;
  float*wsf=(float*)(shm+LDS_WS)+wid*64;
  const bf16*ksrc=Kh+(long)lane*DM+wid*8;
  const bf16*vsrc=Vh+(long)(16*(wid&3)+(lane>>2))*DM+(wid>>2)*32+(lane&3)*8;
  const unsigned kdst=lds0+LDS_K+wid*1024, vdst=lds0+LDS_V+wid*1024;
  #define DMA_K(t,slot) glds16(ksrc+(long)(t)*KVBLK*DM,(unsigned)__builtin_amdgcn_readfirstlane(kdst+(slot)))
  #define DMA_V(t,slot) glds16(vsrc+(long)(t)*KVBLK*DM,(unsigned)__builtin_amdgcn_readfirstlane(vdst+(slot)))
  const int vb0=(int)(lds0+LDS_V)+((lane>>4)&1)*32+(lane&3)*8+(4*hi+((lane&15)>>2))*64;
  const char*Kbase=shm+LDS_K; bf16x8 kf[8];
  const lds_cptr shm3=(lds_cptr)shm; const lds_cptr kp0=shm3+LDS_K+hi*1024+r32*16; const lds_cptr vp0=shm3+LDS_V+((lane>>4)&1)*32+(lane&3)*8+(4*hi+((lane&15)>>2))*64;
  const int NT=(q0+QB)/KVBLK;
  DMA_K(0,0);DMA_V(0,0);DMA_K(1,SLOTB);
  bf16x8 qr[4];
  #pragma unroll
  for(int d0=0;d0<4;++d0)qr[d0]=*reinterpret_cast<const bf16x8*>(&Qw[(long)r32*DM+d0*16+hi*8]);
  float mhat=0.f,l_reg=0.f;f32x16 o[2];o[0]=f32x16{};o[1]=f32x16{};f32x16 negm=f32x16{};asm volatile("":"+v"(negm));
  const int qrel=wid*QBLK+r32;
  #define CMASK(P0,P1,t) do{int jb_=(t)-(NT-4); if(jb_>=0)cmask(P0,P1,jb_,wid);}while(0)
  bool resc=false;
  #define START(P0,P1) do{ const float rm=rowmax(P0,P1); resc=false; \
    { const float dl=rm; mhat=fadd_s(mhat,dl); \
      _Pragma("unroll") for(int r=0;r<16;++r){P0[r]=fsub_s(P0[r],dl);P1[r]=fsub_s(P1[r],dl);} \
      _Pragma("unroll") for(int r=0;r<16;++r)negm[r]=-mhat; asm volatile("":"+v"(negm)); } \
    _Pragma("unroll") for(int r=0;r<16;++r)P0[r]=__builtin_amdgcn_exp2f(P0[r]); }while(0)
  #define RESC() do{ if(resc){ asm volatile("s_waitcnt lgkmcnt(0)":::"memory"); \
      _Pragma("unroll") for(int d_=0;d_<2;++d_) _Pragma("unroll") for(int r=0;r<16;++r)o[d_][r]*=wsf[crow(r,hi)]; } }while(0)
  f32x16 pA0,pA1,pB0,pB1;
  int sl_prev=0,sl_cur=0,sl_next=SLOTB;
  #define ROT() do{sl_prev=sl_cur;sl_cur=sl_next;sl_next=(sl_next==(NSLOT-1)*SLOTB)?0:sl_next+SLOTB;}while(0)
  DMA_K(2,2*SLOTB);
  WAIT_BAR(3);
  qkt(pA0,pA1,Kbase,qr,negm,r32,hi);asm volatile("s_nop 15\n\ts_nop 7":"+v"(pA0),"+v"(pA1));CMASK(pA0,pA1,0);
  START(pA0,pA1);
  _Pragma("unroll") for(int r=0;r<16;++r)pA1[r]=__builtin_amdgcn_exp2f(pA1[r]);
  WAIT_BAR(0);
  DMA_K(3,0);DMA_V(1,SLOTB);
  ROT();
  kload8(kf,kp0+sl_cur);
  WAIT_BAR(2);
  s16x4 vlo[8],vhi[8]; u32x4 pw0,pw1,pw2,pw3;
  #define PKW(P,B) cvtpk_s(P[B],P[B+1])
  #define PAF(k) __builtin_bit_cast(bf16x8,pw##k)
  #define VFR(i) (bf16x8){vlo[i][0],vlo[i][1],vlo[i][2],vlo[i][3],vhi[i][0],vhi[i][1],vhi[i][2],vhi[i][3]}
  #define PIN(x) asm volatile("":"+v"(x))
  #define MX3(a,b,c) __builtin_fmaxf(__builtin_fmaxf((a),(b)),(c))
  #define GAPA(MF,A0,A1,A2,A3,W0,W1,PW) do{ MF; sacc+=A0; sacc+=A1; sacc+=A2; sacc+=A3; PIN(sacc); W0; W1; PIN(PW); SBAR(); }while(0)
  #define EX(v) __builtin_amdgcn_exp2f(v)
  #define GAPB(MF,X,B) do{ MF; X[B]=EX(X[B]); X[B+1]=EX(X[B+1]); X[B+2]=EX(X[B+2]); X[B+3]=EX(X[B+3]); PIN(X); SBAR(); }while(0)
  #define VRD(i) do{ vlo[i]=vtr(vp_+(((i)>>2)*4096+((i)&3)*1024)); vhi[i]=vtr(vp_+(((i)>>2)*4096+((i)&3)*1024+512)); }while(0)
  #define KRD(G,j) do{ if(G){ kload2(kf,kp0+sl_next,j); SBAR(); } }while(0)
  #define STEP(C0,C1,P0,P1,t,GK,GV,GL) do{ SBAR(); \
    const lds_cptr vp_=vp0+sl_prev; \
    VRD(0); SBAR(); float sacc=(P0[0]+P0[1]); \
    GAPA(C0=__builtin_amdgcn_mfma_f32_32x32x16_bf16(kf[0],qr[0],negm,0,0,0), P0[2],P0[3],P0[4],P0[5],     pw0[0]=PKW(P0,0), pw0[1]=PKW(P0,2), pw0); \
    VRD(4); SBAR(); GAPA(C1=__builtin_amdgcn_mfma_f32_32x32x16_bf16(kf[1],qr[0],negm,0,0,0), P0[6],P0[7],P0[8],P0[9],     pw0[2]=PKW(P0,4), pw0[3]=PKW(P0,6), pw0); \
    VRD(1); SBAR(); GAPA(C0=__builtin_amdgcn_mfma_f32_32x32x16_bf16(kf[2],qr[1],C0,0,0,0),   P0[10],P0[11],P0[12],P0[13], pw1[0]=PKW(P0,8), pw1[1]=PKW(P0,10), pw1); \
    VRD(5); SBAR(); GAPA(C1=__builtin_amdgcn_mfma_f32_32x32x16_bf16(kf[3],qr[1],C1,0,0,0),   P0[14],P0[15],P1[0],P1[1],   pw1[2]=PKW(P0,12),pw1[3]=PKW(P0,14), pw1); \
    VRD(2); SBAR(); GAPA(C0=__builtin_amdgcn_mfma_f32_32x32x16_bf16(kf[4],qr[2],C0,0,0,0),   P1[2],P1[3],P1[4],P1[5],     pw2[0]=PKW(P1,0), pw2[1]=PKW(P1,2), pw2); \
    VRD(6); SBAR(); GAPA(C1=__builtin_amdgcn_mfma_f32_32x32x16_bf16(kf[5],qr[2],C1,0,0,0),   P1[6],P1[7],P1[8],P1[9],     pw2[2]=PKW(P1,4), pw2[3]=PKW(P1,6), pw2); \
    VRD(3); SBAR(); GAPA(C0=__builtin_amdgcn_mfma_f32_32x32x16_bf16(kf[6],qr[3],C0,0,0,0),   P1[10],P1[11],P1[12],P1[13], pw3[0]=PKW(P1,8), pw3[1]=PKW(P1,10), pw3); \
    VRD(7); SBAR(); GAPA(C1=__builtin_amdgcn_mfma_f32_32x32x16_bf16(kf[7],qr[3],C1,0,0,0),   P1[14],P1[15],0.f,0.f,       pw3[2]=PKW(P1,12),pw3[3]=PKW(P1,14), pw3); \
    l_reg+=sacc; \
    if(GK){DMA_K((t)+3,sl_cur);} if(GV){DMA_V((t)+1,sl_next);} \
    CMASK(C0,C1,t); \
    { float a=MX3(C0[0],C0[1],C1[0]),b=MX3(C0[2],C0[3],C1[1]); a=MX3(a,C1[2],C1[3]); \
      _Pragma("unroll") for(int r=4;r<16;r+=4){a=MX3(a,C0[r],C0[r+1]);b=MX3(b,C0[r+2],C0[r+3]);a=MX3(a,C1[r],C1[r+1]);b=MX3(b,C1[r+2],C1[r+3]);} \
      float rm=__builtin_fmaxf(a,b); { auto rr=__builtin_amdgcn_permlane32_swap(__float_as_uint(rm),__float_as_uint(rm),false,false); rm=__builtin_fmaxf(__uint_as_float(rr[0]),__uint_as_float(rr[1])); } \
      resc=false; \
      if(__builtin_expect(__any(rm>(float)THRL),0)){ const float dl=__builtin_fmaxf(rm,0.f); mhat+=dl; \
        _Pragma("unroll") for(int r=0;r<16;++r){C0[r]-=dl;C1[r]-=dl;} \
        _Pragma("unroll") for(int r=0;r<16;++r)negm[r]=-mhat; asm volatile("":"+v"(negm)); \
        const float f=__builtin_amdgcn_exp2f(-dl); l_reg*=f; if(hi==0)wsf[r32]=f; resc=true; } } \
    SBAR(); \
    GAPB(o[0]=__builtin_amdgcn_mfma_f32_32x32x16_bf16(PAF(0),VFR(0),o[0],0,0,0), C0,0); \
    GAPB(o[1]=__builtin_amdgcn_mfma_f32_32x32x16_bf16(PAF(0),VFR(4),o[1],0,0,0), C0,4); \
    KRD(GL,0); GAPB(o[0]=__builtin_amdgcn_mfma_f32_32x32x16_bf16(PAF(1),VFR(1),o[0],0,0,0), C0,8); \
    KRD(GL,1); GAPB(o[1]=__builtin_amdgcn_mfma_f32_32x32x16_bf16(PAF(1),VFR(5),o[1],0,0,0), C0,12); \
    KRD(GL,2); GAPB(o[0]=__builtin_amdgcn_mfma_f32_32x32x16_bf16(PAF(2),VFR(2),o[0],0,0,0), C1,0); \
    KRD(GL,3); GAPB(o[1]=__builtin_amdgcn_mfma_f32_32x32x16_bf16(PAF(2),VFR(6),o[1],0,0,0), C1,4); \
    GAPB(o[0]=__builtin_amdgcn_mfma_f32_32x32x16_bf16(PAF(3),VFR(3),o[0],0,0,0), C1,8); \
    GAPB(o[1]=__builtin_amdgcn_mfma_f32_32x32x16_bf16(PAF(3),VFR(7),o[1],0,0,0), C1,12); \
    }while(0)
  int t=1;
  #undef CMASK
  #define CMASK(P0,P1,t) do{}while(0)
  for(;t+5<NT;t+=2){
    STEP(pB0,pB1,pA0,pA1,t,true,true,true);     WAIT_BAR(2); RESC(); ROT();
    STEP(pA0,pA1,pB0,pB1,t+1,true,true,true);   WAIT_BAR(2); RESC(); ROT();
  }
  #undef CMASK
  #define CMASK(P0,P1,t) do{int jb_=(t)-(NT-4); if(jb_>=0)cmask(P0,P1,jb_,wid);}while(0)
  #define ENDW(tt) do{ if((tt)+3<NT){WAIT_BAR(2);} else if((tt)+2<NT){WAIT_BAR(1);} else {WAIT_BAR(0);} }while(0)
  for(;t+1<NT;t+=2){
    STEP(pB0,pB1,pA0,pA1,t,(t+3<NT),(t+1<NT),(t+1<NT));       ENDW(t);   RESC(); ROT();
    STEP(pA0,pA1,pB0,pB1,t+1,(t+4<NT),(t+2<NT),(t+2<NT));     ENDW(t+1); RESC(); ROT();
  }
  STEP(pB0,pB1,pA0,pA1,NT-1,false,false,false); RESC();
  { float sacc=pB0[0]+pB0[1]; _Pragma("unroll") for(int r=2;r<16;++r)sacc+=pB0[r]; _Pragma("unroll") for(int r=0;r<16;++r)sacc+=pB1[r]; l_reg+=sacc;
    pw0=(u32x4){PKW(pB0,0),PKW(pB0,2),PKW(pB0,4),PKW(pB0,6)};pw1=(u32x4){PKW(pB0,8),PKW(pB0,10),PKW(pB0,12),PKW(pB0,14)};pw2=(u32x4){PKW(pB1,0),PKW(pB1,2),PKW(pB1,4),PKW(pB1,6)};pw3=(u32x4){PKW(pB1,8),PKW(pB1,10),PKW(pB1,12),PKW(pB1,14)};
    SBAR(); pv(o,vb0+sl_cur,PAF(0),PAF(1),PAF(2),PAF(3)); }
  #undef PKW
  #undef PAF
  #undef VFR
  #undef PIN
  #undef MX3
  #undef GAPA
  #undef GAPB
  #undef EX
  #undef VRD
  #undef KRD
  #undef STEP
  #undef ENDW
  {auto rr=__builtin_amdgcn_permlane32_swap(__float_as_uint(l_reg),__float_as_uint(l_reg),false,false);l_reg=__uint_as_float(rr[0])+__uint_as_float(rr[1]);}
  if(hi==0)wsf[32+r32]=l_reg;asm volatile("s_waitcnt lgkmcnt(0)":::"memory");
  float rli[16];
  #pragma unroll
  for(int r=0;r<16;++r)rli[r]=__builtin_amdgcn_rcpf(wsf[32+crow(r,hi)]);
  bf16*Ow=O+(rowbase+q0+wid*QBLK)*DM+vcol;
  { bf16*stg=(bf16*)(shm+LDS_OST)+wid*2048;
    #pragma unroll
    for(int r=0;r<16;++r){const int orow=crow(r,hi);
      #pragma unroll
      for(int d0=0;d0<2;++d0)stg[orow*64+d0*32+r32]=__float2bfloat16(o[d0][r]*rli[r]);}
    asm volatile("s_waitcnt lgkmcnt(0)":::"memory");
    #pragma unroll
    for(int i=0;i<4;++i){const int row=i*8+(lane>>3),ch=lane&7; const u32x4 v=*(const u32x4*)(stg+row*64+ch*8); ATTN_STORE16(Ow+(long)row*DM+ch*8,v);} }
  asm volatile("s_waitcnt lgkmcnt(0)\n\ts_barrier":::"memory");
  #undef DMA_K
  #undef DMA_V
  #undef CMASK
  #undef START
  #undef RESC
  #undef ROT
}
constexpr int ATTN_LDS_BYTES=LDS_BYTES;
struct AttnTensors { const bf16* Q; const bf16* K; const bf16* V; bf16* O; };
struct AttnUnit { int var; int qb; };
struct StaticOrder {
  int vcu;
  __device__ __forceinline__ explicit StaticOrder(int v):vcu(v){}
  __device__ __forceinline__ bool next(int i,AttnUnit&u)const{ if(i>=4)return false; const int s=vcu&15; u.var=vcu>>4; u.qb=(i==0)?s:(i==1)?31-s:(i==2)?32+s:63-s; return true; }
};
template<class Sched,int THRL=8> __device__ __forceinline__ void attn_phase(char*lds,const AttnTensors&T,const Sched&S){
  AttnUnit u;
  for(int i=0;S.next(i,u);++i){ const int h=u.var>>2,mp=(u.var>>1)&1,vh=u.var&1;
    attn_unit<THRL>(h*128+mp*64,h*128+vh*64,u.qb,T.Q,T.K,T.V,T.O+(size_t)mp*SEQ*DM,lds); }
}
#undef SBAR
#undef WAIT_BAR
}
namespace attn128 {
using bf16=__hip_bfloat16;
using bf16x8=__attribute__((ext_vector_type(8)))short;
using s16x4=__attribute__((ext_vector_type(4)))short;
using f32x16=__attribute__((ext_vector_type(16)))float;
using u32x4=__attribute__((ext_vector_type(4)))unsigned;
constexpr int SEQ=16384,D=64,DM=512;
constexpr int NW=8,QBLK=32,QB=QBLK*NW,KVBLK=64,NQB=SEQ/QB;
constexpr int ATTN_PITCH=DM, ATTN_UNIT_ROWS=QB;
__device__ __forceinline__ int crow(int r,int hi){return (r&3)+8*(r>>2)+4*hi;}
#define SBAR() __builtin_amdgcn_sched_barrier(0)
__device__ __forceinline__ void cmask(f32x16&p0,f32x16&p1,int jb,int wid){
  const float NEG=-INFINITY;
  if(jb>(wid>>1)){
  #pragma unroll
  for(int r=0;r<16;++r){p0[r]=NEG;p1[r]=NEG;}}
}

constexpr int NSLOT=3, SLOTB=8192;
constexpr int LDS_K=0, LDS_V=NSLOT*SLOTB, LDS_WS=3*NSLOT*SLOTB, LDS_OST=LDS_WS+NW*64*4, LDS_BYTES=LDS_OST+NW*4096;
constexpr float C2=0.125f*1.4426950408889634f;
__device__ __forceinline__ void glds16(const void*gsrc,unsigned lds_dst){unsigned keep;
  asm volatile("s_mov_b32 %0, m0\n\ts_mov_b32 m0, %2\n\ts_nop 0\n\tglobal_load_lds_dwordx4 %1, off\n\ts_mov_b32 m0, %0":"=&s"(keep):"v"(gsrc),"s"(lds_dst):"memory");}
__device__ __forceinline__ float max3f(float a,float b,float c){float r;asm("v_max3_f32 %0, %1, %2, %3":"=v"(r):"v"(a),"v"(b),"v"(c));return r;}
__device__ __forceinline__ float max2f(float a,float b){float r;asm("v_max_f32_e32 %0, %1, %2":"=v"(r):"v"(a),"v"(b));return r;}
__device__ __forceinline__ float fadd_s(float a,float b){float r;asm("v_add_f32_e32 %0, %1, %2":"=v"(r):"v"(a),"v"(b));return r;}
__device__ __forceinline__ float fsub_s(float a,float b){float r;asm("v_sub_f32_e32 %0, %1, %2":"=v"(r):"v"(a),"v"(b));return r;}
typedef float f32x2_t __attribute__((ext_vector_type(2))); typedef __bf16 bf16x2_t __attribute__((ext_vector_type(2)));
__device__ __forceinline__ unsigned cvtpk_s(float lo,float hi){f32x2_t v={lo,hi};bf16x2_t b=__builtin_convertvector(v,bf16x2_t);return __builtin_bit_cast(unsigned,b);}
#define WAIT_BAR(N) asm volatile("s_waitcnt vmcnt(" #N ") lgkmcnt(0)\n\ts_barrier":::"memory")

__device__ __forceinline__ void qkt(f32x16&p0,f32x16&p1,const char*Kslot,const bf16x8*qr,const f32x16&negm,int r32,int hi){
  const char*kb=Kslot+hi*1024+r32*16;
  #pragma unroll
  for(int d0=0;d0<4;++d0){
    const bf16x8 b0=*reinterpret_cast<const bf16x8*>(kb+d0*2048);
    const bf16x8 b1=*reinterpret_cast<const bf16x8*>(kb+d0*2048+512);
    if(d0==0){p0=__builtin_amdgcn_mfma_f32_32x32x16_bf16(b0,qr[0],negm,0,0,0);p1=__builtin_amdgcn_mfma_f32_32x32x16_bf16(b1,qr[0],negm,0,0,0);}
    else{p0=__builtin_amdgcn_mfma_f32_32x32x16_bf16(b0,qr[d0],p0,0,0,0);p1=__builtin_amdgcn_mfma_f32_32x32x16_bf16(b1,qr[d0],p1,0,0,0);}}
}
typedef __attribute__((address_space(3))) const char* lds_cptr;
typedef short v4i16_t __attribute__((ext_vector_type(4)));
__device__ __forceinline__ void kload8(bf16x8*kf,lds_cptr kp){
  kf[0]=*(const __attribute__((address_space(3))) bf16x8*)(kp);      kf[1]=*(const __attribute__((address_space(3))) bf16x8*)(kp+512);
  kf[2]=*(const __attribute__((address_space(3))) bf16x8*)(kp+2048); kf[3]=*(const __attribute__((address_space(3))) bf16x8*)(kp+2560);
  kf[4]=*(const __attribute__((address_space(3))) bf16x8*)(kp+4096); kf[5]=*(const __attribute__((address_space(3))) bf16x8*)(kp+4608);
  kf[6]=*(const __attribute__((address_space(3))) bf16x8*)(kp+6144); kf[7]=*(const __attribute__((address_space(3))) bf16x8*)(kp+6656);
}
__device__ __forceinline__ void kload2(bf16x8*kf,lds_cptr kp,int j){ kf[2*j]=*(const __attribute__((address_space(3))) bf16x8*)(kp+j*2048); kf[2*j+1]=*(const __attribute__((address_space(3))) bf16x8*)(kp+j*2048+512); }
__device__ __forceinline__ s16x4 vtr(lds_cptr p){ return __builtin_bit_cast(s16x4,__builtin_amdgcn_ds_read_tr16_b64_v4i16((__attribute__((address_space(3))) v4i16_t*)p)); }
__device__ __forceinline__ float rowmax(const f32x16&p0,const f32x16&p1){
  float a=max3f(p0[0],p0[1],p1[0]),b=max3f(p0[2],p0[3],p1[1]);a=max3f(a,p1[2],p1[3]);
  #pragma unroll
  for(int r=4;r<16;r+=4){a=max3f(a,p0[r],p0[r+1]);b=max3f(b,p0[r+2],p0[r+3]);a=max3f(a,p1[r],p1[r+1]);b=max3f(b,p1[r+2],p1[r+3]);}
  const float m=max2f(a,b);
  auto rr=__builtin_amdgcn_permlane32_swap(__float_as_uint(m),__float_as_uint(m),false,false);
  return max2f(__uint_as_float(rr[0]),__uint_as_float(rr[1]));
}
__device__ __forceinline__ void pv(f32x16*o,int vb,bf16x8 pa0,bf16x8 pa1,bf16x8 pa2,bf16x8 pa3){
  #pragma unroll
  for(int d0=0;d0<4;++d0){s16x4 lo[4],hi[4];
    #pragma unroll
    for(int ks=0;ks<4;++ks){
      asm volatile("ds_read_b64_tr_b16 %0,%1 offset:%c2":"=&v"(lo[ks]):"v"(vb),"i"(d0*4096+ks*1024):"memory");
      asm volatile("ds_read_b64_tr_b16 %0,%1 offset:%c2":"=&v"(hi[ks]):"v"(vb),"i"(d0*4096+ks*1024+512):"memory");}
    asm volatile("s_waitcnt lgkmcnt(0)":::"memory");SBAR();
    #define PK(k) (bf16x8){lo[k][0],lo[k][1],lo[k][2],lo[k][3],hi[k][0],hi[k][1],hi[k][2],hi[k][3]}
    o[d0]=__builtin_amdgcn_mfma_f32_32x32x16_bf16(pa0,PK(0),o[d0],0,0,0);
    o[d0]=__builtin_amdgcn_mfma_f32_32x32x16_bf16(pa1,PK(1),o[d0],0,0,0);
    o[d0]=__builtin_amdgcn_mfma_f32_32x32x16_bf16(pa2,PK(2),o[d0],0,0,0);
    o[d0]=__builtin_amdgcn_mfma_f32_32x32x16_bf16(pa3,PK(3),o[d0],0,0,0);
    #undef PK
  }
}

#ifndef ATTN_STORE16
#define ATTN_STORE16(p,v) (*(u32x4*)(p)=(v))
#endif
template<int THRL> __device__ __forceinline__ void attn_unit(int qcol,int vcol,int qb,const bf16*Q,const bf16*__restrict__ K,const bf16*__restrict__ V,bf16*O,char*shm){
  const int tid=threadIdx.x,lane=tid&63,r32=lane&31,hi=lane>>5; const int wid=__builtin_amdgcn_readfirstlane(tid>>6);
  const long rowbase=0; const int q0=qb*QB;
  const bf16*Qw=Q+(rowbase+q0+wid*QBLK)*DM+qcol;
  const bf16*Kh=K+rowbase*DM+qcol,*Vh=V+rowbase*DM+vcol;
  const unsigned lds0=(unsigned)(uintptr_t)shm;
  float*wsf=(float*)(shm+LDS_WS)+wid*64;
  const bf16*ksrc=Kh+(long)lane*DM+wid*8;
  const bf16*vsrc=Vh+(long)(16*(wid&3)+(lane>>2))*DM+(wid>>2)*32+(lane&3)*8;
  const unsigned kdst=lds0+LDS_K+wid*1024, vdst=lds0+LDS_V+wid*1024;
  #define DMA_K(t,slot) glds16(ksrc+(long)(t)*KVBLK*DM,(unsigned)__builtin_amdgcn_readfirstlane(kdst+(slot)))
  #define DMA_V(t,slot) do{ glds16(vsrc+(long)(t)*KVBLK*DM,(unsigned)__builtin_amdgcn_readfirstlane(vdst+2*(slot))); glds16(vsrc+64+(long)(t)*KVBLK*DM,(unsigned)__builtin_amdgcn_readfirstlane(vdst+2*(slot)+8192)); }while(0)
  const int vb0=(int)(lds0+LDS_V)+((lane>>4)&1)*32+(lane&3)*8+(4*hi+((lane&15)>>2))*64;
  const char*Kbase=shm+LDS_K; bf16x8 kf[8];
  const lds_cptr shm3=(lds_cptr)shm; const lds_cptr kp0=shm3+LDS_K+hi*1024+r32*16; const lds_cptr vp0=shm3+LDS_V+((lane>>4)&1)*32+(lane&3)*8+(4*hi+((lane&15)>>2))*64;
  const int NT=(q0+QB)/KVBLK;
  DMA_K(0,0);DMA_V(0,0);DMA_K(1,SLOTB);
  bf16x8 qr[4];
  #pragma unroll
  for(int d0=0;d0<4;++d0)qr[d0]=*reinterpret_cast<const bf16x8*>(&Qw[(long)r32*DM+d0*16+hi*8]);
  float mhat=0.f,l_reg=0.f;f32x16 o[4];o[0]=f32x16{};o[1]=f32x16{};o[2]=f32x16{};o[3]=f32x16{};const f32x16 negm=f32x16{};
  const int qrel=wid*QBLK+r32;
  #define CMASK(P0,P1,t) do{int jb_=(t)-(NT-4); if(jb_>=0)cmask(P0,P1,jb_,wid);}while(0)
  bool resc=false;
  #define START(P0,P1) do{ const float rm=rowmax(P0,P1); resc=false; \
    { const float dl=rm; mhat=fadd_s(mhat,dl); \
      _Pragma("unroll") for(int r=0;r<16;++r){P0[r]=fsub_s(P0[r],dl);P1[r]=fsub_s(P1[r],dl);} \
      } \
    _Pragma("unroll") for(int r=0;r<16;++r)P0[r]=__builtin_amdgcn_exp2f(P0[r]); }while(0)
  #define RESC() do{ if(resc){ asm volatile("s_waitcnt lgkmcnt(0)":::"memory"); \
      _Pragma("unroll") for(int d_=0;d_<4;++d_) _Pragma("unroll") for(int r=0;r<16;++r)o[d_][r]*=wsf[crow(r,hi)]; } }while(0)
  f32x16 pA0,pA1,pB0,pB1;
  int sl_prev=0,sl_cur=0,sl_next=SLOTB;
  #define ROT() do{sl_prev=sl_cur;sl_cur=sl_next;sl_next=(sl_next==(NSLOT-1)*SLOTB)?0:sl_next+SLOTB;}while(0)
  DMA_K(2,2*SLOTB);
  WAIT_BAR(4);
  qkt(pA0,pA1,Kbase,qr,negm,r32,hi);asm volatile("s_nop 15\n\ts_nop 7":"+v"(pA0),"+v"(pA1));CMASK(pA0,pA1,0);
  START(pA0,pA1);
  _Pragma("unroll") for(int r=0;r<16;++r)pA1[r]=__builtin_amdgcn_exp2f(pA1[r]);
  WAIT_BAR(0);
  DMA_K(3,0);DMA_V(1,SLOTB);
  ROT();
  kload8(kf,kp0+sl_cur);
  WAIT_BAR(3);
  s16x4 vlo[8],vhi[8]; u32x4 pw0,pw1,pw2,pw3;
  #define PKW(P,B) cvtpk_s(P[B],P[B+1])
  #define PAF(k) __builtin_bit_cast(bf16x8,pw##k)
  #define VFR(i) (bf16x8){vlo[i][0],vlo[i][1],vlo[i][2],vlo[i][3],vhi[i][0],vhi[i][1],vhi[i][2],vhi[i][3]}
  #define PIN(x) asm volatile("":"+v"(x))
  #define MX3(a,b,c) __builtin_fmaxf(__builtin_fmaxf((a),(b)),(c))
  #define GAPA(MF,A0,A1,A2,A3,W0,W1,PW) do{ MF; sacc+=A0; sacc+=A1; sacc+=A2; sacc+=A3; PIN(sacc); W0; W1; PIN(PW); SBAR(); }while(0)
  #define EX(v) __builtin_amdgcn_exp2f(v)
  #define GAPB(MF,X,B) do{ MF; X[B]=EX(X[B]); X[B+1]=EX(X[B+1]); X[B+2]=EX(X[B+2]); X[B+3]=EX(X[B+3]); PIN(X); SBAR(); }while(0)
  #define VRD(i) do{ vlo[i]=vtr(vp_+(((i)>>2)*4096+((i)&3)*1024)); vhi[i]=vtr(vp_+(((i)>>2)*4096+((i)&3)*1024+512)); }while(0)
  #define VRD2(i) do{ vlo[i]=vtr(vp_+((2+((i)>>2))*4096+((i)&3)*1024)); vhi[i]=vtr(vp_+((2+((i)>>2))*4096+((i)&3)*1024+512)); SBAR(); }while(0)
  #define GAPB2(MF,X,B) do{ MF; X[B]=EX(X[B]-mhat); X[B+1]=EX(X[B+1]-mhat); PIN(X); SBAR(); }while(0)
  #define KRD(G,j) do{ if(G){ kload2(kf,kp0+sl_next,j); SBAR(); } }while(0)
  #define STEP(C0,C1,P0,P1,t,GK,GV,GL) do{ SBAR(); \
    const lds_cptr vp_=vp0+2*sl_prev; \
    VRD(0); SBAR(); float sacc=(P0[0]+P0[1]); \
    GAPA(C0=__builtin_amdgcn_mfma_f32_32x32x16_bf16(kf[0],qr[0],negm,0,0,0), P0[2],P0[3],P0[4],P0[5],     pw0[0]=PKW(P0,0), pw0[1]=PKW(P0,2), pw0); \
    VRD(4); SBAR(); GAPA(C1=__builtin_amdgcn_mfma_f32_32x32x16_bf16(kf[1],qr[0],negm,0,0,0), P0[6],P0[7],P0[8],P0[9],     pw0[2]=PKW(P0,4), pw0[3]=PKW(P0,6), pw0); \
    VRD(1); SBAR(); GAPA(C0=__builtin_amdgcn_mfma_f32_32x32x16_bf16(kf[2],qr[1],C0,0,0,0),   P0[10],P0[11],P0[12],P0[13], pw1[0]=PKW(P0,8), pw1[1]=PKW(P0,10), pw1); \
    VRD(5); SBAR(); GAPA(C1=__builtin_amdgcn_mfma_f32_32x32x16_bf16(kf[3],qr[1],C1,0,0,0),   P0[14],P0[15],P1[0],P1[1],   pw1[2]=PKW(P0,12),pw1[3]=PKW(P0,14), pw1); \
    GAPA(C0=__builtin_amdgcn_mfma_f32_32x32x16_bf16(kf[4],qr[2],C0,0,0,0),   P1[2],P1[3],P1[4],P1[5],     pw2[0]=PKW(P1,0), pw2[1]=PKW(P1,2), pw2); \
    GAPA(C1=__builtin_amdgcn_mfma_f32_32x32x16_bf16(kf[5],qr[2],C1,0,0,0),   P1[6],P1[7],P1[8],P1[9],     pw2[2]=PKW(P1,4), pw2[3]=PKW(P1,6), pw2); \
    GAPA(C0=__builtin_amdgcn_mfma_f32_32x32x16_bf16(kf[6],qr[3],C0,0,0,0),   P1[10],P1[11],P1[12],P1[13], pw3[0]=PKW(P1,8), pw3[1]=PKW(P1,10), pw3); \
    GAPA(C1=__builtin_amdgcn_mfma_f32_32x32x16_bf16(kf[7],qr[3],C1,0,0,0),   P1[14],P1[15],0.f,0.f,       pw3[2]=PKW(P1,12),pw3[3]=PKW(P1,14), pw3); \
    l_reg+=sacc; \
    if(GK){DMA_K((t)+3,sl_cur);} if(GV){DMA_V((t)+1,sl_next);} \
    CMASK(C0,C1,t); \
    { float a=MX3(C0[0],C0[1],C1[0]),b=MX3(C0[2],C0[3],C1[1]); a=MX3(a,C1[2],C1[3]); \
      _Pragma("unroll") for(int r=4;r<16;r+=4){a=MX3(a,C0[r],C0[r+1]);b=MX3(b,C0[r+2],C0[r+3]);a=MX3(a,C1[r],C1[r+1]);b=MX3(b,C1[r+2],C1[r+3]);} \
      float rm=__builtin_fmaxf(a,b); { auto rr=__builtin_amdgcn_permlane32_swap(__float_as_uint(rm),__float_as_uint(rm),false,false); rm=__builtin_fmaxf(__uint_as_float(rr[0]),__uint_as_float(rr[1])); } \
      resc=false; const float rmr=rm-mhat; \
      if(__builtin_expect(__any(rmr>(float)THRL),0)){ const float dl=__builtin_fmaxf(rmr,0.f); mhat+=dl; \
        const float f=__builtin_amdgcn_exp2f(-dl); l_reg*=f; if(hi==0)wsf[r32]=f; resc=true; } } \
    SBAR(); \
    VRD(2); SBAR(); GAPB2(o[0]=__builtin_amdgcn_mfma_f32_32x32x16_bf16(PAF(0),VFR(0),o[0],0,0,0), C0,0); \
    VRD(6); SBAR(); GAPB2(o[1]=__builtin_amdgcn_mfma_f32_32x32x16_bf16(PAF(0),VFR(4),o[1],0,0,0), C0,2); \
    VRD(3); SBAR(); GAPB2(o[0]=__builtin_amdgcn_mfma_f32_32x32x16_bf16(PAF(1),VFR(1),o[0],0,0,0), C0,4); \
    VRD(7); SBAR(); GAPB2(o[1]=__builtin_amdgcn_mfma_f32_32x32x16_bf16(PAF(1),VFR(5),o[1],0,0,0), C0,6); \
    VRD2(0); GAPB2(o[0]=__builtin_amdgcn_mfma_f32_32x32x16_bf16(PAF(2),VFR(2),o[0],0,0,0), C0,8); \
    VRD2(4); GAPB2(o[1]=__builtin_amdgcn_mfma_f32_32x32x16_bf16(PAF(2),VFR(6),o[1],0,0,0), C0,10); \
    VRD2(1); GAPB2(o[0]=__builtin_amdgcn_mfma_f32_32x32x16_bf16(PAF(3),VFR(3),o[0],0,0,0), C0,12); \
    VRD2(5); GAPB2(o[1]=__builtin_amdgcn_mfma_f32_32x32x16_bf16(PAF(3),VFR(7),o[1],0,0,0), C0,14); \
    VRD2(2); GAPB2(o[2]=__builtin_amdgcn_mfma_f32_32x32x16_bf16(PAF(0),VFR(0),o[2],0,0,0), C1,0); \
    VRD2(6); GAPB2(o[3]=__builtin_amdgcn_mfma_f32_32x32x16_bf16(PAF(0),VFR(4),o[3],0,0,0), C1,2); \
    VRD2(3); KRD(GL,0); GAPB2(o[2]=__builtin_amdgcn_mfma_f32_32x32x16_bf16(PAF(1),VFR(1),o[2],0,0,0), C1,4); \
    VRD2(7); KRD(GL,1); GAPB2(o[3]=__builtin_amdgcn_mfma_f32_32x32x16_bf16(PAF(1),VFR(5),o[3],0,0,0), C1,6); \
    KRD(GL,2); GAPB2(o[2]=__builtin_amdgcn_mfma_f32_32x32x16_bf16(PAF(2),VFR(2),o[2],0,0,0), C1,8); \
    KRD(GL,3); GAPB2(o[3]=__builtin_amdgcn_mfma_f32_32x32x16_bf16(PAF(2),VFR(6),o[3],0,0,0), C1,10); \
    GAPB2(o[2]=__builtin_amdgcn_mfma_f32_32x32x16_bf16(PAF(3),VFR(3),o[2],0,0,0), C1,12); \
    GAPB2(o[3]=__builtin_amdgcn_mfma_f32_32x32x16_bf16(PAF(3),VFR(7),o[3],0,0,0), C1,14); \
    }while(0)
  int t=1;
  #undef CMASK
  #define CMASK(P0,P1,t) do{}while(0)
  for(;t+5<NT;t+=2){
    STEP(pB0,pB1,pA0,pA1,t,true,true,true);     WAIT_BAR(3); RESC(); ROT();
    STEP(pA0,pA1,pB0,pB1,t+1,true,true,true);   WAIT_BAR(3); RESC(); ROT();
  }
  #undef CMASK
  #define CMASK(P0,P1,t) do{int jb_=(t)-(NT-4); if(jb_>=0)cmask(P0,P1,jb_,wid);}while(0)
  #define ENDW(tt) do{ if((tt)+3<NT){WAIT_BAR(3);} else if((tt)+2<NT){WAIT_BAR(2);} else {WAIT_BAR(0);} }while(0)
  for(;t+1<NT;t+=2){
    STEP(pB0,pB1,pA0,pA1,t,(t+3<NT),(t+1<NT),(t+1<NT));       ENDW(t);   RESC(); ROT();
    STEP(pA0,pA1,pB0,pB1,t+1,(t+4<NT),(t+2<NT),(t+2<NT));     ENDW(t+1); RESC(); ROT();
  }
  STEP(pB0,pB1,pA0,pA1,NT-1,false,false,false); RESC();
  { float sacc=pB0[0]+pB0[1]; _Pragma("unroll") for(int r=2;r<16;++r)sacc+=pB0[r]; _Pragma("unroll") for(int r=0;r<16;++r)sacc+=pB1[r]; l_reg+=sacc;
    pw0=(u32x4){PKW(pB0,0),PKW(pB0,2),PKW(pB0,4),PKW(pB0,6)};pw1=(u32x4){PKW(pB0,8),PKW(pB0,10),PKW(pB0,12),PKW(pB0,14)};pw2=(u32x4){PKW(pB1,0),PKW(pB1,2),PKW(pB1,4),PKW(pB1,6)};pw3=(u32x4){PKW(pB1,8),PKW(pB1,10),PKW(pB1,12),PKW(pB1,14)};
    SBAR(); pv(o,vb0+2*sl_cur,PAF(0),PAF(1),PAF(2),PAF(3)); }
  #undef PKW
  #undef PAF
  #undef VFR
  #undef PIN
  #undef MX3
  #undef GAPA
  #undef GAPB
  #undef GAPB2
  #undef VRD2
  #undef EX
  #undef VRD
  #undef KRD
  #undef STEP
  #undef ENDW
  {auto rr=__builtin_amdgcn_permlane32_swap(__float_as_uint(l_reg),__float_as_uint(l_reg),false,false);l_reg=__uint_as_float(rr[0])+__uint_as_float(rr[1]);}
  if(hi==0)wsf[32+r32]=l_reg;asm volatile("s_waitcnt lgkmcnt(0)":::"memory");
  float rli[16];
  #pragma unroll
  for(int r=0;r<16;++r)rli[r]=__builtin_amdgcn_rcpf(wsf[32+crow(r,hi)]);
  bf16*Ow=O+(rowbase+q0+wid*QBLK)*DM+vcol;
  { bf16*stg=(bf16*)(shm+LDS_OST)+wid*2048;
    #pragma unroll
    for(int hf=0;hf<2;++hf){
    #pragma unroll
    for(int r=0;r<16;++r){const int orow=crow(r,hi);
      #pragma unroll
      for(int d0=0;d0<2;++d0)stg[orow*64+d0*32+r32]=__float2bfloat16(o[2*hf+d0][r]*rli[r]);}
    asm volatile("s_waitcnt lgkmcnt(0)":::"memory");
    #pragma unroll
    for(int i=0;i<4;++i){const int row=i*8+(lane>>3),ch=lane&7; const u32x4 v=*(const u32x4*)(stg+row*64+ch*8); ATTN_STORE16(Ow+(long)row*DM+hf*64+ch*8,v);}
    asm volatile("s_waitcnt lgkmcnt(0)":::"memory"); } }
  asm volatile("s_waitcnt lgkmcnt(0)\n\ts_barrier":::"memory");
  #undef DMA_K
  #undef DMA_V
  #undef CMASK
  #undef START
  #undef RESC
  #undef ROT
}
constexpr int ATTN_LDS_BYTES=LDS_BYTES;
struct AttnTensors { const bf16* Q; const bf16* K; const bf16* V; bf16* O; };
struct AttnUnit { int var; int qb; };
struct StaticOrder {
  int vcu;
  __device__ __forceinline__ explicit StaticOrder(int v):vcu(v){}
  __device__ __forceinline__ bool next(int i,AttnUnit&u)const{ if(i>=2)return false; const int s=vcu&31; u.var=vcu>>5; u.qb=(i==0)?s:63-s; return true; }
};
template<class Sched,int THRL=8> __device__ __forceinline__ void attn_phase(char*lds,const AttnTensors&T,const Sched&S){
  AttnUnit u;
  for(int i=0;S.next(i,u);++i){ const int h=u.var>>1,mp=u.var&1;
    attn_unit<THRL>(h*128+mp*64,h*128,u.qb,T.Q,T.K,T.V,T.O+(size_t)mp*SEQ*DM,lds); }
}
#undef SBAR
#undef WAIT_BAR
}


#define GAS __attribute__((address_space(1)))
#define LAS __attribute__((address_space(3)))
typedef unsigned short bf16;
typedef unsigned v4u __attribute__((ext_vector_type(4)));
typedef float f32x4 __attribute__((ext_vector_type(4)));
typedef short bf16x8 __attribute__((ext_vector_type(8)));
typedef GAS unsigned gu32;
typedef GAS unsigned long long gu64;
#define RLX_AGENT __ATOMIC_RELAXED, __HIP_MEMORY_SCOPE_AGENT
#define LDS_WAIT() asm volatile("s_waitcnt lgkmcnt(0)" ::: "memory")
#define VM_WAIT() asm volatile("s_waitcnt vmcnt(0)" ::: "memory")
__device__ __forceinline__ unsigned long long rt() { return __builtin_amdgcn_s_memrealtime(); }
__device__ __forceinline__ unsigned f2bf(float f) { unsigned u = __builtin_bit_cast(unsigned, f); return (u + 0x7fffu + ((u >> 16) & 1u)) >> 16; }
__device__ __forceinline__ unsigned pk2(float lo, float hi) { return f2bf(lo) | (f2bf(hi) << 16); }

#define XB_TMO      128
#define XB_XCNT(j)  (256  + 64 * (j))
#define XB_XSUB(j)  (1280 + 64 * (j))
#define XB_XGEN(j)  (2304 + 64 * (j))
#define XB_TOP      3328
#define XB_TOPGEN   3392
#define XCD_BAR_WORDS 3456
#define XB_SPIN_CAP (1u << 18)

__device__ __forceinline__ unsigned xb_ld(unsigned* p)              { return __hip_atomic_load(p, __ATOMIC_RELAXED, __HIP_MEMORY_SCOPE_AGENT); }
__device__ __forceinline__ unsigned xb_add(unsigned* p, unsigned v) { return __hip_atomic_fetch_add(p, v, __ATOMIC_RELAXED, __HIP_MEMORY_SCOPE_AGENT); }
__device__ __forceinline__ unsigned xb_xcc_id() { return (unsigned)__builtin_amdgcn_s_getreg((3 << 11) | 20) & 0xFu; }
#define XB_SPIN(cond, bar) do { unsigned _sp = 0; while (cond) { __builtin_amdgcn_s_sleep(1); \
    if ((++_sp & 255u) == 0u) { if (xb_ld(&(bar)[XB_TMO])) break; if (_sp > XB_SPIN_CAP) { atomicAdd(&(bar)[XB_TMO], 1u); break; } } } } while (0)

struct XcdBarrier {
    unsigned* bar; unsigned x;
    volatile LAS unsigned* st;
};

__device__ __forceinline__ XcdBarrier xcd_barrier_post(unsigned* bar, volatile LAS unsigned* st) {
    XcdBarrier b; b.bar = bar; b.x = xb_xcc_id(); b.st = st;
    if (threadIdx.x == 0) (void)xb_add(&bar[XB_XCNT(b.x)], 1u);
    return b;
}
__device__ __forceinline__ void xcd_barrier_complete(unsigned* bar, unsigned x, unsigned& nloc, unsigned& nx) {
    const unsigned G = gridDim.x * gridDim.y * gridDim.z;
    unsigned sum, cnt, mine, sp = 0u;
    for (;;) {
        sum = 0u; cnt = 0u; mine = 0u;
#pragma unroll
        for (unsigned j = 0; j < 16; ++j) { const unsigned c = xb_ld(&bar[XB_XCNT(j)]); sum += c; cnt += (c > 0u) ? 1u : 0u; mine = (j == x) ? c : mine; }
        if (sum == G) break;
        __builtin_amdgcn_s_sleep(1);
        if ((++sp & 255u) == 0u) { if (xb_ld(&bar[XB_TMO])) break; if (sp > XB_SPIN_CAP) { atomicAdd(&bar[XB_TMO], 1u); break; } }
    }
    nloc = mine > 0u ? mine : 1u; nx = cnt > 0u ? cnt : 1u;
}

__device__ __forceinline__ void xcd_barrier(const XcdBarrier& b) {
    asm volatile("s_waitcnt vmcnt(0)" ::: "memory");
    __syncthreads();
    if (threadIdx.x == 0) {
        unsigned* bar = b.bar;
        __builtin_amdgcn_s_waitcnt(0);
        unsigned nloc = b.st[0], nx = b.st[1];
        if (nloc == 0u) { xcd_barrier_complete(bar, b.x, nloc, nx); b.st[0] = nloc; b.st[1] = nx; }
        const unsigned old = xb_add(&bar[XB_XSUB(b.x)], 1u);
        const unsigned gen = old / nloc;
        if (old + 1u == (gen + 1u) * nloc) {
            __builtin_amdgcn_fence(__ATOMIC_RELEASE, "agent");
            asm volatile("s_waitcnt vmcnt(0)" ::: "memory");
            const unsigned og = xb_add(&bar[XB_TOP], 1u);
            const unsigned tg = og / nx;
            if (og + 1u == (tg + 1u) * nx) xb_add(&bar[XB_TOPGEN], 1u);
            else XB_SPIN(xb_ld(&bar[XB_TOPGEN]) == tg, bar);
            __builtin_amdgcn_fence(__ATOMIC_ACQUIRE, "agent");
            xb_add(&bar[XB_XGEN(b.x)], 1u);
            asm volatile("s_waitcnt vmcnt(0)" ::: "memory");
        } else {
            XB_SPIN(xb_ld(&bar[XB_XGEN(b.x)]) == gen, bar);
            __builtin_amdgcn_fence(__ATOMIC_ACQUIRE, "agent");
            asm volatile("s_waitcnt vmcnt(0)" ::: "memory");
        }
    }
    __syncthreads();
}

constexpr int NWAVES = 8;
constexpr int M = 16384, D = 1024, INC = 2560, AW = 512, LW = 512, NQ = 2048, NEXP = 16384;
constexpr float EPSN = 1e-6f;
constexpr size_t MiB = 1u << 20;
constexpr size_t WS_CTL = 0, CTL_ZERO_BYTES = 1 * MiB;
constexpr size_t WS_ROWSS2 = 512 * 1024;
constexpr size_t WS_RS1 = 1 * MiB;
constexpr size_t WS_SK1 = 1 * MiB + 128 * 1024, WS_SK2 = WS_SK1 + 32 * 1024;
constexpr size_t WS_WGF = 1 * MiB + 256 * 1024;
constexpr size_t WS_WIN = 2 * MiB, WS_WOUT = 8 * MiB, WS_WQ = 10 * MiB;
constexpr size_t WS_ED = 16 * MiB, WS_EU = 48 * MiB;
constexpr size_t WS_SCD = 32 * MiB, WS_SCU = 33 * MiB;
constexpr size_t WS_WQ8 = 170 * MiB;
constexpr size_t WS_XB = 80 * MiB;
constexpr size_t WS_CARRY = 34 * MiB;
constexpr size_t WS_Q2 = 80 * MiB;
constexpr size_t WS_Q = 112 * MiB, WS_SPLIT = 16 * MiB;
constexpr size_t WS_GATE = WS_Q + 4 * WS_SPLIT;
constexpr size_t WS_EID = 144 * MiB, WS_GW = 152 * MiB;
constexpr size_t WS_MIX = 192 * MiB, WS_HB = 224 * MiB, WS_END = 256 * MiB;
constexpr size_t WS_ROWSS3 = 576 * 1024;
constexpr size_t WS_DOTP = 80 * MiB;
constexpr size_t WS_REC = 160 * MiB, WS_N0 = 168 * MiB;
constexpr size_t WS_PEER = 80 * MiB;
constexpr size_t WS_REC_OLD_UNUSED = 0;
constexpr int CW_BAR = 4096;
constexpr int RING_OFF = 0, RING_BYTES = 131072;
constexpr int LDSCTL_OFF = RING_BYTES, MISC_OFF = LDSCTL_OFF + 320;
constexpr int LDS_BYTES = 163840;

struct Frame {
    LAS unsigned char* lds;
    volatile LAS unsigned* MISC;
    int tid, lane, wave;
    int vcu, G;
};

__device__ __forceinline__ float wave_sum(float v) {
#pragma unroll
    for (int o = 1; o < 64; o <<= 1) v += __shfl_xor(v, o);
    return v;
}
__device__ __forceinline__ float bf2f(unsigned short b) { return __builtin_bit_cast(float, (unsigned)b << 16); }
__device__ __forceinline__ float bflo(unsigned w) { return __builtin_bit_cast(float, w << 16); }
__device__ __forceinline__ float bfhi(unsigned w) { return __builtin_bit_cast(float, w & 0xffff0000u); }
__device__ __forceinline__ float gelu_tanh(float x) { const float u = 0.7978845608028654f * (x + 0.044715f * x * x * x); return 0.5f * x * (1.0f + tanhf(u)); }
__device__ __forceinline__ float sigmoidf_(float x) { return 1.0f / (1.0f + expf(-x)); }
__device__ __forceinline__ float fsigmoid(float x) { return __builtin_amdgcn_rcpf(1.0f + __builtin_amdgcn_exp2f(-1.4426950408889634f * x)); }
__device__ __forceinline__ float fgelu_tanh(float x) { const float u = 0.7978845608028654f * (x + 0.044715f * x * x * x); const float t = 1.0f - 2.0f * __builtin_amdgcn_rcpf(1.0f + __builtin_amdgcn_exp2f(2.8853900817779268f * u)); return 0.5f * x * (1.0f + t); }

__device__ __forceinline__ void p0_transpose_item(const float* W, int K, int N, bf16* WT, const float* gk, LAS float* scr, int item, int lane) {
    const int nblk = N / 32, kb = item / nblk, nb = item % nblk, k0 = 64 * kb, n0 = 32 * nb;
    float wv[32];
#pragma unroll
    for (int i = 0; i < 32; ++i) { const int kk = 2 * i + (lane >> 5); wv[i] = W[(size_t)(k0 + kk) * N + n0 + (lane & 31)]; }
#pragma unroll
    for (int i = 0; i < 32; ++i) { const int kk = 2 * i + (lane >> 5); const float g = gk ? gk[k0 + kk] : 1.0f; scr[kk * 33 + (lane & 31)] = wv[i] * g; }
    LDS_WAIT(); asm volatile("" ::: "memory");
    const int c = lane & 7;
#pragma unroll
    for (int j = 0; j < 4; ++j) { const int n = (lane >> 3) + 8 * j; const LAS float* s = scr + (8 * c) * 33 + n;
        v4u o; o.x = pk2(s[0 * 33], s[1 * 33]); o.y = pk2(s[2 * 33], s[3 * 33]); o.z = pk2(s[4 * 33], s[5 * 33]); o.w = pk2(s[6 * 33], s[7 * 33]);
        *(GAS v4u*)(WT + (size_t)(n0 + n) * K + k0 + 8 * c) = o; }
    LDS_WAIT(); asm volatile("" ::: "memory");
}
template <int NR> __device__ __forceinline__ void p0_rows(const float* xrow, bf16* orow, const float* gk, float* rs, int lane) {
    f32x4 v[NR][4];
#pragma unroll
    for (int i = 0; i < NR; ++i)
#pragma unroll
        for (int j = 0; j < 4; ++j) v[i][j] = __builtin_nontemporal_load((const GAS f32x4*)(xrow + (size_t)i * 1024) + lane + 64 * j);
#pragma unroll
    for (int i = 0; i < NR; ++i) {
        if (rs) { float s = 0.f;
#pragma unroll
            for (int j = 0; j < 4; ++j) s += (v[i][j].x * v[i][j].x + v[i][j].y * v[i][j].y) + (v[i][j].z * v[i][j].z + v[i][j].w * v[i][j].w);
            const float tot = wave_sum(s); if (lane == 0) rs[i] = 1.0f / sqrtf(tot * (1.0f / 1024.0f) + EPSN); }
        if (gk) {
#pragma unroll
            for (int j = 0; j < 4; ++j) v[i][j] = v[i][j] * ((const GAS f32x4*)gk)[lane + 64 * j]; }
        GAS unsigned long long* o8 = (GAS unsigned long long*)(orow + (size_t)i * 1024) + lane;
#pragma unroll
        for (int j = 0; j < 4; ++j) o8[64 * j] = (unsigned long long)pk2(v[i][j].x, v[i][j].y) | ((unsigned long long)pk2(v[i][j].z, v[i][j].w) << 32);
    }
}

struct Args { const float* in[23]; float* out; unsigned char* ws; int ph_lo, ph_hi; };

__device__ __forceinline__ void p0_prologue(Frame& F, const Args& a) {
    LAS float* scr = (LAS float*)(F.lds + RING_OFF + F.wave * 16384);
    unsigned char* ws = a.ws;
    const int gw = F.vcu * NWAVES + F.wave, NGW = F.G * NWAVES;
    constexpr int I_IN = (D / 64) * (INC / 32), I_OUT = (D / 64) * (D / 32), I_Q = (D / 64) * (NQ / 32);
    constexpr int NITEMS = I_IN + I_OUT + I_Q;
    for (int it = F.wave * (int)F.G + F.vcu; it < NITEMS; it += NGW) {
        int r = it;
        if (r < I_IN) { p0_transpose_item(a.in[2], D, INC, (bf16*)(ws + WS_WIN), a.in[1], scr, r, F.lane); continue; } r -= I_IN;
        if (r < I_OUT) { p0_transpose_item(a.in[15], D, D, (bf16*)(ws + WS_WOUT), nullptr, scr, r, F.lane); continue; } r -= I_OUT;
        p0_transpose_item(a.in[17], D, NQ, (bf16*)(ws + WS_WQ), a.in[16], scr, r, F.lane);
    }
    for (int i = (F.wave * (int)F.G + F.vcu) * 64 + F.lane; i < 8192; i += NGW * 64) {
        const int ln = i & 63, ks = (i >> 6) & 3, et = (i >> 8) & 1, n = (i >> 9) & 7, gt = i >> 12, r32 = ln & 31, hi = ln >> 5;
        const float* w = a.in[gt ? 12 : 10] + n * 4096 + 32 * et + (16 * ks + 8 * hi) * 64 + r32;
        *(GAS v4u*)(ws + WS_WGF + (size_t)i * 16) = (v4u){pk2(w[0], w[64]), pk2(w[128], w[192]), pk2(w[256], w[320]), pk2(w[384], w[448])}; }
    for (int m = gw; m < M / 8; m += NGW) { const int r = 8 * m; p0_rows<8>(a.in[0] + (size_t)r * D, (bf16*)(ws + WS_XB) + (size_t)r * D, nullptr, (float*)(ws + WS_RS1) + r, F.lane); }
    for (int m = F.wave * (int)F.G + F.vcu; m < 8; m += NGW) { const int r = 4 * m;
        if (r < 16) p0_rows<4>(a.in[18] + (size_t)r * 1024, (bf16*)(ws + WS_SK1) + (size_t)r * 1024, nullptr, nullptr, F.lane);
        else        p0_rows<4>(a.in[19] + (size_t)(r - 16) * 1024, (bf16*)(ws + WS_SK2) + (size_t)(r - 16) * 1024, nullptr, nullptr, F.lane); }
}
template <int NR> __device__ __forceinline__ void q8_load(f32x4 (&v)[NR][4], const float* xrow, int lane) {
#pragma unroll
    for (int i = 0; i < NR; ++i)
#pragma unroll
        for (int j = 0; j < 4; ++j) v[i][j] = __builtin_nontemporal_load((const GAS f32x4*)(xrow + (size_t)i * 1024) + lane + 64 * j);
}
template <int NR> __device__ __forceinline__ void q8_finish(f32x4 (&v)[NR][4], unsigned char* orow, const float* gk, float* scale, int lane) {
#pragma unroll
    for (int i = 0; i < NR; ++i) {
        float am = 0.f;
#pragma unroll
        for (int j = 0; j < 4; ++j) { if (gk) v[i][j] = v[i][j] * ((const GAS f32x4*)gk)[lane + 64 * j];
            am = fmaxf(fmaxf(am, fmaxf(fabsf(v[i][j].x), fabsf(v[i][j].y))), fmaxf(fabsf(v[i][j].z), fabsf(v[i][j].w))); }
#pragma unroll
        for (int o = 1; o < 64; o <<= 1) am = fmaxf(am, __shfl_xor(am, o));
        const float sc = (am > 0.f) ? am * (1.0f / 127.0f) : 1.0f, inv = 1.0f / sc;
        if (lane == 0) scale[i] = sc;
        GAS unsigned* o4 = (GAS unsigned*)(orow + (size_t)i * 128 + (size_t)(lane >> 5) * ((size_t)NEXP * 128)) + (lane & 31);
#pragma unroll
        for (int j = 0; j < 4; ++j) { const int q0 = (int)__builtin_rintf(v[i][j].x * inv), q1 = (int)__builtin_rintf(v[i][j].y * inv), q2 = (int)__builtin_rintf(v[i][j].z * inv), q3 = (int)__builtin_rintf(v[i][j].w * inv);
            o4[(size_t)j * (2 * (size_t)NEXP * 128 / 4)] = ((unsigned)q0 & 255u) | (((unsigned)q1 & 255u) << 8) | (((unsigned)q2 & 255u) << 16) | ((unsigned)q3 << 24); }
    }
}
__device__ __forceinline__ const float* cvx_src(const Args& a, int m) { const int r = 4 * m; return (r < NEXP) ? a.in[20] + (size_t)r * D : a.in[21] + (size_t)(r - NEXP) * D; }
__device__ __forceinline__ void cvx_finish(const Args& a, f32x4 (&v)[4][4], int m, int lane) {
    unsigned char* ws = a.ws; const int r = 4 * m;
    if (r < NEXP) q8_finish<4>(v, ws + WS_ED + (size_t)r * 128, a.in[16], (float*)(ws + WS_SCD) + r, lane);
    else          q8_finish<4>(v, ws + WS_EU + (size_t)(r - NEXP) * 128, nullptr, (float*)(ws + WS_SCU) + (r - NEXP), lane);
}
__device__ __forceinline__ void convert_experts(const Args& a, int w, int nw, int lane) {
    constexpr int TOT = NEXP / 4;
    int m = w; if (m >= TOT) return;
    f32x4 va[4][4], vb[4][4];
    q8_load<4>(va, cvx_src(a, m), lane);
    for (;;) {
        const bool hb = m + nw < TOT; if (hb) q8_load<4>(vb, cvx_src(a, m + nw), lane);
        cvx_finish(a, va, m, lane);
        if (!hb) break;
        const bool ha = m + 2 * nw < TOT; if (ha) q8_load<4>(va, cvx_src(a, m + 2 * nw), lane);
        cvx_finish(a, vb, m + nw, lane);
        if (!ha) break;
        m += 2 * nw;
    }
}

typedef float f32x16 __attribute__((ext_vector_type(16)));
typedef float f32x2 __attribute__((ext_vector_type(2)));
__device__ __forceinline__ void lru_local_unit(Frame& F, const Args& a, int c) {
    constexpr int YP = 520;
    LAS unsigned short* Y = (LAS unsigned short*)(F.lds + RING_OFF);
    const int e = F.tid, r0 = c * 64;
    const bf16* XR = (const bf16*)(a.ws + WS_Q + 3 * WS_SPLIT);
    unsigned* HLAC = (unsigned*)a.out;
    float* CH = (float*)(a.ws + WS_CARRY); float* CA = CH + (size_t)(M / 64) * 512;
    {
        const int p = F.tid & 255, hh = F.tid >> 8; const float* conv_w = a.in[8];
        const f32x2 c0 = *(const GAS f32x2*)(conv_w + 2 * p), c1 = *(const GAS f32x2*)(conv_w + 512 + 2 * p), c2 = *(const GAS f32x2*)(conv_w + 1024 + 2 * p), c3 = *(const GAS f32x2*)(conv_w + 1536 + 2 * p), cb = *(const GAS f32x2*)(a.in[9] + 2 * p);
        unsigned xv[35];
        const int rb = r0 + 32 * hh - 3;
#pragma unroll
        for (int i = 0; i < 35; ++i) xv[i] = (rb + i >= 0) ? *(const GAS unsigned*)(XR + (size_t)(rb + i) * 512 + 2 * p) : 0u;
#pragma unroll
        for (int i = 0; i < 32; ++i) {
            const float lo = cb.x + bflo(xv[i]) * c0.x + bflo(xv[i + 1]) * c1.x + bflo(xv[i + 2]) * c2.x + bflo(xv[i + 3]) * c3.x;
            const float hi2 = cb.y + bfhi(xv[i]) * c0.y + bfhi(xv[i + 1]) * c1.y + bfhi(xv[i + 2]) * c2.y + bfhi(xv[i + 3]) * c3.y;
            *(LAS unsigned*)(Y + (32 * hh + i) * YP + 2 * p) = pk2(lo, hi2); } }
    __syncthreads();
    const int n = F.wave, lane = F.lane, r32 = lane & 31, hi = lane >> 5;
#pragma unroll 1
    for (int et = 0; et < 2; ++et) {
        bf16x8 wf[2][4];
#pragma unroll
        for (int gt = 0; gt < 2; ++gt)
#pragma unroll
            for (int ks = 0; ks < 4; ++ks) wf[gt][ks] = *(const GAS bf16x8*)(a.ws + WS_WGF + (size_t)(((((gt * 8 + n) * 2 + et) * 4 + ks) * 64 + lane) * 16));
        const int ch = 64 * n + 32 * et + r32;
        const float ba = a.in[11][ch], bx = a.in[13][ch], lam = a.in[14][ch];
        const float sp = (lam > 15.f) ? expf(-lam) : log1pf(expf(-lam));
        float av[2][16], bv[2][16];
#pragma unroll
        for (int tt = 0; tt < 2; ++tt) {
            f32x16 ra = {}, ia = {};
#pragma unroll
            for (int ks = 0; ks < 4; ++ks) { const bf16x8 af = *(const LAS bf16x8*)(Y + (32 * tt + r32) * YP + 64 * n + 16 * ks + 8 * hi);
                ra = __builtin_amdgcn_mfma_f32_32x32x16_bf16(af, wf[0][ks], ra, 0, 0, 0); ia = __builtin_amdgcn_mfma_f32_32x32x16_bf16(af, wf[1][ks], ia, 0, 0, 0); }
#pragma unroll
            for (int r = 0; r < 16; ++r) { const int t = 32 * tt + (r & 3) + 8 * (r >> 2) + 4 * hi;
                const float rr = fsigmoid(ra[r] + ba), ii = fsigmoid(ia[r] + bx);
                const float log_a = -8.0f * rr * sp, aa = __builtin_amdgcn_exp2f(log_a * 1.4426950408889634f);
                const float u2 = 2.0f * log_a;
                const float ser = -u2 * (1.0f + u2 * (0.5f + u2 * (0.16666667f + u2 * (0.041666668f + u2 * 0.0083333338f))));
                const float om = (u2 > -0.1f) ? ser : (1.0f - aa * aa);
                const float mult = __builtin_amdgcn_sqrtf(fmaxf(om, 1e-12f));
                av[tt][r] = aa; bv[tt][r] = mult * (ii * bf2f(Y[t * YP + ch])); }
        }
#pragma unroll
        for (int tt = 0; tt < 2; ++tt)
#pragma unroll
            for (int rq = 0; rq < 4; ++rq) { float h = 0.f, pa = 1.f;
#pragma unroll
                for (int k = 0; k < 4; ++k) { const int r = 4 * rq + k; h = av[tt][r] * h + bv[tt][r]; pa *= av[tt][r]; bv[tt][r] = h; av[tt][r] = pa; } }
        float hin[8], ain[8]; float hc = 0.f, ac = 1.f;
#pragma unroll
        for (int j = 0; j < 8; ++j) { const int tt = j >> 2, r3 = 4 * (j & 3) + 3;
#pragma unroll
            for (int own = 0; own < 2; ++own) {
                if (hi == own) { hin[j] = hc; ain[j] = ac; }
                const float mh = av[tt][r3] * hc + bv[tt][r3], ma = ac * av[tt][r3];
                const float oh = __shfl_xor(mh, 32), oa = __shfl_xor(ma, 32);
                hc = (hi == own) ? mh : oh; ac = (hi == own) ? ma : oa; } }
#pragma unroll
        for (int tt = 0; tt < 2; ++tt)
            { unsigned ob = (unsigned)((r0 + 32 * tt + 4 * hi) * 512 + ch); asm volatile("" : "+v"(ob));
#pragma unroll
            for (int r = 0; r < 16; ++r) { const int j = 4 * tt + (r >> 2); const unsigned o = ob + (unsigned)(((r & 3) + 8 * (r >> 2)) * 512);
                const float hl = bv[tt][r] + av[tt][r] * hin[j], ac = av[tt][r] * ain[j];
                HLAC[o] = pk2(hl, ac);
                if (tt == 1 && r == 15 && hi == 1) { CH[c * 512 + ch] = hl; CA[c * 512 + ch] = ac; } } }
    }
    __syncthreads();
}

__device__ __forceinline__ void fix_unit(Frame& F, const Args& a, int c, float lamv) {
    const int r0 = c * 64;
    const unsigned* HLAC = (const unsigned*)a.out; const float* CH = (const float*)(a.ws + WS_CARRY); const float* CA = CH + (size_t)(M / 64) * 512;
    const bf16* GATE = (const bf16*)(a.ws + WS_GATE);
    bf16* MIX = (bf16*)(a.ws + WS_MIX);
    const int g4 = F.tid & 127, sgm = F.tid >> 7;
    LAS f32x4* SA = (LAS f32x4*)(F.lds + RING_OFF); LAS f32x4* SH = SA + 512;
    { const int L = (c + 3) >> 2; const int lo_c = sgm * L; int hi_c = lo_c + L; if (hi_c > c) hi_c = c;
      f32x4 A4 = (f32x4){1.f, 1.f, 1.f, 1.f}, H4 = (f32x4){0.f, 0.f, 0.f, 0.f};
      int cc = lo_c;
      for (; cc + 8 <= hi_c; cc += 8) { f32x4 av[8], hv[8];
#pragma unroll
          for (int k = 0; k < 8; ++k) { const size_t o = (size_t)(cc + k) * 512 + 4 * g4; av[k] = *(const GAS f32x4*)(CA + o); hv[k] = *(const GAS f32x4*)(CH + o); }
#pragma unroll
          for (int k = 0; k < 8; ++k) { H4 = av[k] * H4 + hv[k]; A4 = A4 * av[k]; } }
      for (; cc < hi_c; ++cc) { const size_t o = (size_t)cc * 512 + 4 * g4; const f32x4 av = *(const GAS f32x4*)(CA + o), hv = *(const GAS f32x4*)(CH + o); H4 = av * H4 + hv; A4 = A4 * av; }
      SA[sgm * 128 + g4] = A4; SH[sgm * 128 + g4] = H4; }
    __syncthreads();
    f32x4 hin = (f32x4){0.f, 0.f, 0.f, 0.f};
#pragma unroll
    for (int sq = 0; sq < 4; ++sq) hin = SA[sq * 128 + g4] * hin + SH[sq * 128 + g4];
    __syncthreads();
#pragma unroll 4
    for (int t = sgm * 16; t < sgm * 16 + 16; ++t) { const size_t o = (size_t)(r0 + t) * 512 + 4 * g4;
        const v4u ha = *(const GAS v4u*)(HLAC + o);
        const f32x4 h = (f32x4){bflo(ha.x), bflo(ha.y), bflo(ha.z), bflo(ha.w)} + (f32x4){bfhi(ha.x), bfhi(ha.y), bfhi(ha.z), bfhi(ha.w)} * hin; const unsigned long long gw = *(const GAS unsigned long long*)(GATE + o);
        const unsigned glo = (unsigned)gw, ghi = (unsigned)(gw >> 32);
        const unsigned long long ov = (unsigned long long)pk2(h.x * fgelu_tanh(bflo(glo)), h.y * fgelu_tanh(bfhi(glo))) | ((unsigned long long)pk2(h.z * fgelu_tanh(bflo(ghi)), h.w * fgelu_tanh(bfhi(ghi))) << 32);
        *(GAS unsigned long long*)(MIX + (size_t)(r0 + t) * 1024 + 512 + 4 * g4) = ov; }
    const bf16* OS0 = (const bf16*)(a.out + (size_t)M * 512); const bf16* OS1 = OS0 + (size_t)M * 512;
    const float* sg = a.in[7] + (F.lane & 15) * 8;
    float sgv[8];
#pragma unroll
    for (int j = 0; j < 8; ++j) sgv[j] = sg[j] * 0.8f;
#pragma unroll 2
    for (int rr = 0; rr < 8; ++rr) { const size_t row = (size_t)(r0 + 8 * F.wave + rr);
        const v4u p = *(const GAS v4u*)(OS0 + row * 512 + F.lane * 8), q = *(const GAS v4u*)(OS1 + row * 512 + F.lane * 8);
        float d[8];
        d[0] = bflo(p.x) - lamv * bflo(q.x); d[1] = bfhi(p.x) - lamv * bfhi(q.x); d[2] = bflo(p.y) - lamv * bflo(q.y); d[3] = bfhi(p.y) - lamv * bfhi(q.y);
        d[4] = bflo(p.z) - lamv * bflo(q.z); d[5] = bfhi(p.z) - lamv * bfhi(q.z); d[6] = bflo(p.w) - lamv * bflo(q.w); d[7] = bfhi(p.w) - lamv * bfhi(q.w);
        float ss = 0.f;
#pragma unroll
        for (int j = 0; j < 8; ++j) ss += d[j] * d[j];
        ss += __shfl_xor(ss, 1); ss += __shfl_xor(ss, 2); ss += __shfl_xor(ss, 4); ss += __shfl_xor(ss, 8);
        const float ri = 1.0f / sqrtf(ss * (1.0f / 128.0f) + EPSN);
        v4u o; o.x = pk2(d[0] * ri * sgv[0], d[1] * ri * sgv[1]); o.y = pk2(d[2] * ri * sgv[2], d[3] * ri * sgv[3]);
        o.z = pk2(d[4] * ri * sgv[4], d[5] * ri * sgv[5]); o.w = pk2(d[6] * ri * sgv[6], d[7] * ri * sgv[7]);
        *(GAS v4u*)(MIX + row * 1024 + F.lane * 8) = o; }
}

typedef float f32x16 __attribute__((ext_vector_type(16)));
#define CEX(a, b) do { const float _hi = fmaxf(a, b), _lo = fminf(a, b); a = _hi; b = _lo; } while (0)
__device__ __forceinline__ int skey(int b) { return b ^ ((b >> 31) & 0x7fffffff); }
#define CEI(a, b) do { const int _hi = max(a, b), _lo = min(a, b); a = _hi; b = _lo; } while (0)
__device__ __forceinline__ void sort16_desc(int (&v)[16]) {
#pragma unroll
    for (int k = 2; k <= 16; k <<= 1)
#pragma unroll
        for (int j = k >> 1; j >= 1; j >>= 1)
#pragma unroll
            for (int i = 0; i < 16; ++i) { const int l = i ^ j; if (l > i) { if ((i & k) == 0) CEI(v[i], v[l]); else CEI(v[l], v[i]); } }
}
__device__ __forceinline__ void merge16_desc(int (&a)[16], const int (&b)[16]) {
#pragma unroll
    for (int i = 0; i < 16; ++i) a[i] = max(a[i], b[15 - i]);
#pragma unroll
    for (int j = 8; j >= 1; j >>= 1)
#pragma unroll
        for (int i = 0; i < 16; ++i) if ((i & j) == 0) CEI(a[i], a[i + j]);
}
__device__ __forceinline__ void top16_half(int (&top)[16], const bf16* q, const LAS unsigned char* sk, int r32, int hi) {
    bf16x8 qf[8];
#pragma unroll
    for (int ks = 0; ks < 8; ++ks) qf[ks] = *(const GAS bf16x8*)(q + 16 * ks + 8 * hi);
#pragma unroll
    for (int i = 0; i < 16; ++i) top[i] = (int)0x80000000;
#pragma unroll 1
    for (int kt = 0; kt < 4; ++kt) {
        f32x16 acc = {};
#pragma unroll
        for (int ks = 0; ks < 8; ++ks) { const bf16x8 kf = *(const LAS bf16x8*)(sk + (32 * kt + r32) * 272 + (16 * ks + 8 * hi) * 2); acc = __builtin_amdgcn_mfma_f32_32x32x16_bf16(kf, qf[ks], acc, 0, 0, 0); }
        int grp[16];
#pragma unroll
        for (int r = 0; r < 16; ++r) { const int idx = 32 * kt + (r & 3) + 8 * (r >> 2) + 4 * hi; const float av = acc[r];
            grp[r] = (skey(__float_as_int(av)) & ~127) | idx; }
        sort16_desc(grp); merge16_desc(top, grp);
    }
    int oth[16];
#pragma unroll
    for (int i = 0; i < 16; ++i) oth[i] = __shfl_xor(top[i], 32);
    merge16_desc(top, oth);
}
__device__ __forceinline__ void route_unit(const Args& a, int g, int hd, int lane, LAS unsigned char* slot, const LAS unsigned char* skl, int* EIDo, float* GWo) {
    const int r32 = lane & 31, hi = lane >> 5; const int t = g * 32 + r32;
    const bf16* q = (const bf16*)(a.ws + WS_Q2) + (size_t)t * NQ + hd * 256;
    int k1[16], k2[16];
    top16_half(k1, q, skl, r32, hi);
    top16_half(k2, q + 128, skl + 128 * 272, r32, hi);
    { v4u w1, w2;
#define IDX4(v, j) (((unsigned)v[4 * (j)] & 127u) | (((unsigned)v[4 * (j) + 1] & 127u) << 8) | (((unsigned)v[4 * (j) + 2] & 127u) << 16) | (((unsigned)v[4 * (j) + 3] & 127u) << 24))
      w1 = (v4u){IDX4(k1, 0), IDX4(k1, 1), IDX4(k1, 2), IDX4(k1, 3)}; w2 = (v4u){IDX4(k2, 0), IDX4(k2, 1), IDX4(k2, 2), IDX4(k2, 3)};
#undef IDX4
      *(LAS v4u*)(slot) = w1; *(LAS v4u*)(slot + 16) = w2; }
    float v1[16], v2[16];
#pragma unroll
    for (int i = 0; i < 16; ++i) { v1[i] = __int_as_float(skey(k1[i])); v2[i] = __int_as_float(skey(k2[i])); }
#define CKEY(ia, ib) ((skey(__float_as_int(v1[ia] + v2[ib])) & ~255) | ((ia) * 16 + (ib)))
    int K[16], G1[16], G2[16];
#pragma unroll
    for (int i = 0; i < 16; ++i) K[i] = CKEY(0, i);
    { int n_ = 0;
#pragma unroll
      for (int ia = 1; ia < 16; ++ia)
#pragma unroll
          for (int ib = 0; ib < 16; ++ib) if ((ia + 1) * (ib + 1) <= 16) { const int kk = CKEY(ia, ib); if (n_ < 16) G1[n_] = kk; else if (n_ < 32) G2[n_ - 16] = kk; ++n_; }
    }
    sort16_desc(G1); merge16_desc(K, G1);
    sort16_desc(G2); merge16_desc(K, G2);
    { int x0 = CKEY(14, 0), x1 = CKEY(15, 0);
#pragma unroll
      for (int i = 0; i < 16; ++i) { CEI(K[i], x0); }
#pragma unroll
      for (int i = 0; i < 16; ++i) { CEI(K[i], x1); }
    }
#undef CKEY
    unsigned P[16]; float sc[16];
#pragma unroll
    for (int i = 0; i < 16; ++i) { const unsigned ci = (unsigned)K[i] & 255u; const unsigned i1 = slot[ci >> 4], i2 = slot[16 + (ci & 15u)]; P[i] = i1 * 128u + i2; sc[i] = __int_as_float(skey(K[i] & ~255)); }
    float ex[16], sum = 0.f;
#pragma unroll
    for (int i = 0; i < 16; ++i) { ex[i] = expf(sc[i] - sc[0]); sum += ex[i]; }
    const float inv = 1.0f / sum;
    if (hi == 0) {
        GAS v4u* ro = (GAS v4u*)((unsigned*)(a.ws + WS_REC) + (size_t)t * 128 + hd * 16);
#pragma unroll
        for (int j = 0; j < 4; ++j) ro[j] = (v4u){P[4 * j] | (f2bf(ex[4 * j] * inv) << 16), P[4 * j + 1] | (f2bf(ex[4 * j + 1] * inv) << 16), P[4 * j + 2] | (f2bf(ex[4 * j + 2] * inv) << 16), P[4 * j + 3] | (f2bf(ex[4 * j + 3] * inv) << 16)};
    }
}

__device__ __forceinline__ float wave_max(float v) {
#pragma unroll
    for (int o = 1; o < 64; o <<= 1) v = fmaxf(v, __shfl_xor(v, o));
    return v;
}
__device__ __forceinline__ void route_unit_ref(const Args& a, int t, int hd, int lane, LAS float* sc) {
    LAS unsigned* sci = (LAS unsigned*)sc;
    const bf16* q = (const bf16*)(a.ws + WS_Q2) + (size_t)t * NQ + hd * 256;
#pragma unroll 1
    for (int half = 0; half < 2; ++half) {
        const float* sk = a.in[18 + half];
        float sa = 0.f, sb = 0.f;
        for (int d = 0; d < 128; ++d) { const float qv = bf2f(q[half * 128 + d]); sa += qv * sk[lane * 128 + d]; sb += qv * sk[(lane + 64) * 128 + d]; }
        for (int r = 0; r < 16; ++r) {
            const float mx = wave_max(fmaxf(sa, sb));
            const unsigned long long ba = __ballot(sa == mx), bb = __ballot(sb == mx);
            int key;
            if (ba) { const int ln = __ffsll((long long)ba) - 1; key = ln; if (lane == ln) sa = -INFINITY; }
            else { const int ln = __ffsll((long long)bb) - 1; key = ln + 64; if (lane == ln) sb = -INFINITY; }
            if (lane == 0) { sc[half * 32 + r] = mx; sci[half * 32 + 16 + r] = (unsigned)key; }
        }
    }
    __builtin_amdgcn_s_waitcnt(0);
    const int ca = lane >> 2, cb0 = (lane & 3) * 4;
    float c[4];
#pragma unroll
    for (int j = 0; j < 4; ++j) c[j] = sc[ca] + sc[32 + cb0 + j];
    for (int r = 0; r < 16; ++r) {
        const float mx = wave_max(fmaxf(fmaxf(c[0], c[1]), fmaxf(c[2], c[3])));
        const bool mine = (c[0] == mx) || (c[1] == mx) || (c[2] == mx) || (c[3] == mx);
        const unsigned long long bm = __ballot(mine); const int ln = __ffsll((long long)bm) - 1;
        if (lane == ln) { int j = (c[0] == mx) ? 0 : (c[1] == mx) ? 1 : (c[2] == mx) ? 2 : 3;
            if (j == 0) c[0] = -INFINITY; else if (j == 1) c[1] = -INFINITY; else if (j == 2) c[2] = -INFINITY; else c[3] = -INFINITY;
            sc[64 + r] = mx; sci[80 + r] = sci[16 + ca] * 128u + sci[48 + cb0 + j]; }
    }
    __builtin_amdgcn_s_waitcnt(0);
    if (lane < 16) {
        const float mx0 = sc[64]; const float ex = expf(sc[64 + lane] - mx0); float sum = ex;
        sum += __shfl_xor(sum, 1); sum += __shfl_xor(sum, 2); sum += __shfl_xor(sum, 4); sum += __shfl_xor(sum, 8);
        ((int*)(a.ws + WS_EID))[(size_t)t * 128 + hd * 16 + lane] = (int)sci[80 + lane];
        ((float*)(a.ws + WS_GW))[(size_t)t * 128 + hd * 16 + lane] = ex / sum;
    }
    __builtin_amdgcn_s_waitcnt(0);
}

__device__ __forceinline__ void unpack8(const v4u w, float* f) { f[0] = bflo(w.x); f[1] = bfhi(w.x); f[2] = bflo(w.y); f[3] = bfhi(w.y); f[4] = bflo(w.z); f[5] = bfhi(w.z); f[6] = bflo(w.w); f[7] = bfhi(w.w); }
__device__ __forceinline__ void gather_token(const Args& a, int t, int lane, float* dst) {
    const bf16* HB = (const bf16*)(a.ws + WS_HB) + (size_t)t * D; const bf16* ED = (const bf16*)(a.ws + WS_ED); const bf16* EU = (const bf16*)(a.ws + WS_EU);
    float hx[16];
    unpack8(*(const GAS v4u*)(HB + lane * 8), hx); unpack8(*(const GAS v4u*)(HB + 512 + lane * 8), hx + 8);
    const float rs2 = 1.0f / sqrtf(((const float*)(a.ws + WS_ROWSS2))[t] * (1.0f / 1024.0f) + EPSN);
    const int* EID = (const int*)(a.ws + WS_EID) + (size_t)t * 128; const float* GW = (const float*)(a.ws + WS_GW) + (size_t)t * 128;
    const int e0 = EID[lane], e1 = EID[64 + lane]; const float g0 = GW[lane], g1 = GW[64 + lane];
    float acc[16];
#pragma unroll
    for (int i = 0; i < 16; ++i) acc[i] = 0.f;
#pragma unroll 1
    for (int j = 0; j < 128; j += 4) {
        int ee[4]; float gg[4], dt[4];
#pragma unroll
        for (int k = 0; k < 4; ++k) { const int jj = j + k; ee[k] = __shfl(jj < 64 ? e0 : e1, jj & 63); gg[k] = __shfl(jj < 64 ? g0 : g1, jj & 63); }
        v4u da[4], db[4];
#pragma unroll
        for (int k = 0; k < 4; ++k) { const bf16* r = ED + (size_t)ee[k] * D; da[k] = *(const GAS v4u*)(r + lane * 8); db[k] = *(const GAS v4u*)(r + 512 + lane * 8); }
#pragma unroll
        for (int k = 0; k < 4; ++k) { float f[16]; unpack8(da[k], f); unpack8(db[k], f + 8); float s = 0.f;
#pragma unroll
            for (int i = 0; i < 16; ++i) s += f[i] * hx[i];
            dt[k] = s; }
#pragma unroll
        for (int o = 1; o < 64; o <<= 1) {
#pragma unroll
            for (int k = 0; k < 4; ++k) dt[k] += __shfl_xor(dt[k], o); }
#pragma unroll
        for (int k = 0; k < 4; ++k) { const bf16* r = EU + (size_t)ee[k] * D; da[k] = *(const GAS v4u*)(r + lane * 8); db[k] = *(const GAS v4u*)(r + 512 + lane * 8); }
#pragma unroll
        for (int k = 0; k < 4; ++k) { const float w = gg[k] * gelu_tanh(dt[k] * rs2); float f[16]; unpack8(da[k], f); unpack8(db[k], f + 8);
#pragma unroll
            for (int i = 0; i < 16; ++i) acc[i] += w * f[i]; }
    }
    const float* orow = a.out + (size_t)t * D; float* drow = dst + (size_t)t * D; const float* gf = a.in[22];
    f32x4 h0 = *(const GAS f32x4*)(orow + lane * 8), h1 = *(const GAS f32x4*)(orow + lane * 8 + 4), h2 = *(const GAS f32x4*)(orow + 512 + lane * 8), h3 = *(const GAS f32x4*)(orow + 512 + lane * 8 + 4);
    h0 += (f32x4){acc[0], acc[1], acc[2], acc[3]}; h1 += (f32x4){acc[4], acc[5], acc[6], acc[7]}; h2 += (f32x4){acc[8], acc[9], acc[10], acc[11]}; h3 += (f32x4){acc[12], acc[13], acc[14], acc[15]};
    float ss = (h0.x * h0.x + h0.y * h0.y) + (h0.z * h0.z + h0.w * h0.w) + (h1.x * h1.x + h1.y * h1.y) + (h1.z * h1.z + h1.w * h1.w)
             + (h2.x * h2.x + h2.y * h2.y) + (h2.z * h2.z + h2.w * h2.w) + (h3.x * h3.x + h3.y * h3.y) + (h3.z * h3.z + h3.w * h3.w);
    ss = wave_sum(ss);
    const float ri = 1.0f / sqrtf(ss * (1.0f / 1024.0f) + EPSN);
    const f32x4 f0 = *(const GAS f32x4*)(gf + lane * 8), f1 = *(const GAS f32x4*)(gf + lane * 8 + 4), f2 = *(const GAS f32x4*)(gf + 512 + lane * 8), f3 = *(const GAS f32x4*)(gf + 512 + lane * 8 + 4);
    *(GAS f32x4*)(drow + lane * 8) = h0 * ri * f0; *(GAS f32x4*)(drow + lane * 8 + 4) = h1 * ri * f1;
    *(GAS f32x4*)(drow + 512 + lane * 8) = h2 * ri * f2; *(GAS f32x4*)(drow + 512 + lane * 8 + 4) = h3 * ri * f3;
}


template <int CTRL> __device__ __forceinline__ float dpp_add(float v) { return v + __int_as_float(__builtin_amdgcn_update_dpp(0, __float_as_int(v), CTRL, 0xf, 0xf, false)); }
__device__ __forceinline__ float row16_sum(float v) { v = dpp_add<0x140>(v); v = dpp_add<0x141>(v); v = dpp_add<0x4E>(v); v = dpp_add<0xB1>(v); return v; }
__device__ __forceinline__ unsigned long long lanemask_lt(int lane) { return (1ull << lane) - 1ull; }
__device__ __forceinline__ void glds16g(const void* gsrc, unsigned lds_dst) { unsigned keep;
    asm volatile("s_mov_b32 %0, m0\n\ts_mov_b32 m0, %2\n\ts_nop 0\n\tglobal_load_lds_dwordx4 %1, off\n\ts_mov_b32 m0, %0" : "=&s"(keep) : "v"(gsrc), "s"(lds_dst) : "memory"); }

__device__ __forceinline__ void glds16x4(const void* sbase, unsigned o0, unsigned o1, unsigned o2, unsigned o3, unsigned d0, unsigned d1, unsigned d2, unsigned d3) { unsigned keep;
    asm volatile("s_mov_b32 %0, m0\n\ts_mov_b32 m0, %6\n\ts_nop 0\n\tglobal_load_lds_dwordx4 %1, %5\n\ts_mov_b32 m0, %7\n\ts_nop 0\n\tglobal_load_lds_dwordx4 %2, %5\n\t"
                 "s_mov_b32 m0, %8\n\ts_nop 0\n\tglobal_load_lds_dwordx4 %3, %5\n\ts_mov_b32 m0, %9\n\ts_nop 0\n\tglobal_load_lds_dwordx4 %4, %5\n\ts_mov_b32 m0, %0"
                 : "=&s"(keep) : "v"(o0), "v"(o1), "v"(o2), "v"(o3), "s"(sbase), "s"(d0), "s"(d1), "s"(d2), "s"(d3) : "memory"); }
typedef __bf16 bf2_t __attribute__((ext_vector_type(2)));
__device__ __forceinline__ float dot2bf(unsigned a, unsigned b, float c) { return __builtin_amdgcn_fdot2_f32_bf16(__builtin_bit_cast(bf2_t, a), __builtin_bit_cast(bf2_t, b), c, false); }
template <int NT> __device__ __forceinline__ void compact_tokens(const Args& a, int t0, int lane) {
    int e0[NT], e1[NT]; float g0[NT], g1[NT];
#pragma unroll
    for (int i = 0; i < NT; ++i) { const int* EID = (const int*)(a.ws + WS_EID) + (size_t)(t0 + i) * 128; const float* GW = (const float*)(a.ws + WS_GW) + (size_t)(t0 + i) * 128;
        e0[i] = EID[lane]; e1[i] = EID[64 + lane]; g0[i] = GW[lane]; g1[i] = GW[64 + lane]; }
#pragma unroll
    for (int i = 0; i < NT; ++i) {
        const bool p0 = e0[i] < 8192, p1 = e1[i] < 8192;
        const unsigned long long m0 = __ballot(p0), m1 = __ballot(p1), lt = lanemask_lt(lane);
        const int c0 = __popcll(m0), n0 = c0 + __popcll(m1);
        const int pos0 = p0 ? __popcll(m0 & lt) : n0 + __popcll(~m0 & lt);
        const int pos1 = p1 ? c0 + __popcll(m1 & lt) : n0 + (64 - c0) + __popcll(~m1 & lt);
        unsigned* R = (unsigned*)(a.ws + WS_REC) + (size_t)(t0 + i) * 128;
        R[pos0] = (unsigned)e0[i] | (f2bf(g0[i]) << 16); R[pos1] = (unsigned)e1[i] | (f2bf(g1[i]) << 16);
        if (lane == 0) ((int*)(a.ws + WS_N0))[t0 + i] = n0; }
}
template <int NT> __device__ __forceinline__ void w_tokens(const Args& a, int t0, int lane, const LAS float* scd, const LAS float* scu) {
    float d0[NT], d1[NT], sd0[NT], sd1[NT], su0[NT], su1[NT]; unsigned r0[NT], r1[NT]; float ss[NT];
#pragma unroll
    for (int i = 0; i < NT; ++i) { const unsigned short* DP = (const unsigned short*)(a.ws + WS_DOTP) + (size_t)(t0 + i) * 1024; const unsigned* R = (const unsigned*)(a.ws + WS_REC) + (size_t)(t0 + i) * 128;
        float p0[8], p1[8];
#pragma unroll
        for (int x = 0; x < 8; ++x) { p0[x] = bf2f(DP[x * 128 + lane]); p1[x] = bf2f(DP[x * 128 + 64 + lane]); }
        r0[i] = R[lane]; r1[i] = R[64 + lane]; ss[i] = ((const float*)(a.ws + WS_ROWSS2))[t0 + i];
        sd0[i] = scd[r0[i] & 0x3fffu]; sd1[i] = scd[r1[i] & 0x3fffu];
        su0[i] = scu[r0[i] & 0x3fffu]; su1[i] = scu[r1[i] & 0x3fffu];
        d0[i] = ((p0[0] + p0[1]) + (p0[2] + p0[3])) + ((p0[4] + p0[5]) + (p0[6] + p0[7])); d1[i] = ((p1[0] + p1[1]) + (p1[2] + p1[3])) + ((p1[4] + p1[5]) + (p1[6] + p1[7])); }
#pragma unroll
    for (int i = 0; i < NT; ++i) { const float rs2 = 1.0f / sqrtf(ss[i] * (1.0f / 1024.0f) + EPSN);
        const float w0 = bfhi(r0[i]) * fgelu_tanh(d0[i] * sd0[i] * rs2) * su0[i], w1 = bfhi(r1[i]) * fgelu_tanh(d1[i] * sd1[i] * rs2) * su1[i];
        float m0 = fabsf(w0), m1 = fabsf(w1);
#pragma unroll
        for (int o = 1; o < 64; o <<= 1) { m0 = fmaxf(m0, __shfl_xor(m0, o)); m1 = fmaxf(m1, __shfl_xor(m1, o)); }
        const float s0 = (m0 > 0.f) ? m0 * (1.0f / 127.0f) : 1.0f, s1 = (m1 > 0.f) ? m1 * (1.0f / 127.0f) : 1.0f;
        unsigned char* WQ = a.ws + WS_WQ8 + (size_t)(t0 + i) * 144;
        WQ[lane] = (unsigned char)((int)__builtin_rintf(w0 / s0) & 255); WQ[64 + lane] = (unsigned char)((int)__builtin_rintf(w1 / s1) & 255);
        if (lane == 0) { ((float*)(WQ + 128))[0] = s0; ((float*)(WQ + 128))[1] = s1; } }
}
template <bool IS_UP> __device__ __forceinline__ void sweep_slice(const Args& a, int x, int wv, int lane, unsigned ring, LAS unsigned char* ringp, unsigned aux, LAS unsigned char* auxp) {
    const int g = lane >> 4, li = lane & 15, n16 = li, kg = g;
    const char* TABx = (const char*)(a.ws + (IS_UP ? WS_EU : WS_ED)) + x * 256;
    unsigned jofs[4];
#pragma unroll
    for (int q = 0; q < 4; ++q) jofs[q] = (unsigned)((li ^ ((g << 2) | q)) * 16);
    const unsigned pd = (unsigned)__builtin_amdgcn_readfirstlane(ring);
#pragma unroll 1
    for (int s_ = 0; s_ < 128; ++s_) {
        const int r = s_ >> 6, k = s_ & 63, t = wv * 64 + k, base = 64 * r;
        const LAS unsigned* rec = (const LAS unsigned*)(auxp + (k & 3) * 512) + base;
        const LAS unsigned char* hp = auxp + 2048 + (k & 3) * 256;
        asm volatile("s_waitcnt lgkmcnt(0)" ::: "memory");
        if ((k & 3) == 0) {
            const char* rsrc = (const char*)(a.ws + WS_REC) + (size_t)t * 512 + lane * 16;
            glds16g(rsrc, (unsigned)__builtin_amdgcn_readfirstlane(aux)); glds16g(rsrc + 1024, (unsigned)__builtin_amdgcn_readfirstlane(aux + 1024));
            if (!IS_UP) glds16g((const char*)(a.ws + WS_HB) + (size_t)(t + g) * 2048 + x * 256 + li * 16, (unsigned)__builtin_amdgcn_readfirstlane(aux + 2048));
            asm volatile("s_waitcnt vmcnt(0)" ::: "memory");
        }
        {
            unsigned so[16];
#pragma unroll
            for (int p = 0; p < 16; ++p) so[p] = rec[4 * p + g];
#pragma unroll
            for (int p = 0; p < 16; ++p) so[p] = ((so[p] & 0x3fffu) << 11) + jofs[p & 3];
            glds16x4(TABx, so[0], so[1], so[2], so[3], pd, pd + 1024u, pd + 2048u, pd + 3072u);
            glds16x4(TABx, so[4], so[5], so[6], so[7], pd + 4096u, pd + 5120u, pd + 6144u, pd + 7168u);
            glds16x4(TABx, so[8], so[9], so[10], so[11], pd + 8192u, pd + 9216u, pd + 10240u, pd + 11264u);
            glds16x4(TABx, so[12], so[13], so[14], so[15], pd + 12288u, pd + 13312u, pd + 14336u, pd + 15360u);
        }
        asm volatile("s_waitcnt vmcnt(0)" ::: "memory");
        if (!IS_UP) {
            bf16x8 hb[4];
#pragma unroll
            for (int q = 0; q < 4; ++q) hb[q] = *(const LAS bf16x8*)(hp + (32 * q + 8 * kg) * 2);
            f32x4 res = (f32x4){0.f, 0.f, 0.f, 0.f};
#pragma unroll
            for (int rb = 0; rb < 4; ++rb) {
                f32x4 d = (f32x4){0.f, 0.f, 0.f, 0.f}; const int row = n16 + 16 * rb; const int key = ((row & 3) << 2) | ((row >> 2) & 3);
#pragma unroll
                for (int q = 0; q < 4; ++q) { const bf16x8 af = *(const LAS bf16x8*)(ringp + 256 * row + 16 * ((4 * q + kg) ^ key)); d = __builtin_amdgcn_mfma_f32_16x16x32_bf16(af, hb[q], d, 0, 0, 0); }
                res = (n16 == rb) ? d : res; }
            if (n16 < 4) *(GAS f32x4*)((float*)(a.ws + WS_DOTP) + ((size_t)t * 8 + x) * 128 + base + 16 * n16 + 4 * kg) = res;
        } else {
            f32x4 pacc[8];
#pragma unroll
            for (int i = 0; i < 8; ++i) pacc[i] = (f32x4){0.f, 0.f, 0.f, 0.f};
            const int q4 = n16 >> 2, p4 = lane & 3;
#pragma unroll
            for (int ks = 0; ks < 2; ++ks) {
                const v4u wa = *(const LAS v4u*)(rec + 32 * ks + 8 * kg), wb = *(const LAS v4u*)(rec + 32 * ks + 8 * kg + 4);
                const bf16x8 af = __builtin_bit_cast(bf16x8, (v4u){(wa.x >> 16) | (wa.y & 0xffff0000u), (wa.z >> 16) | (wa.w & 0xffff0000u), (wb.x >> 16) | (wb.y & 0xffff0000u), (wb.z >> 16) | (wb.w & 0xffff0000u)});
#pragma unroll
                for (int c = 0; c < 8; ++c) {
                    const int row0 = 32 * ks + 8 * kg + q4, row1 = row0 + 4; const int ch = 2 * c + (p4 >> 1);
                    const int k0 = ((row0 & 3) << 2) | ((row0 >> 2) & 3), k1 = ((row1 & 3) << 2) | ((row1 >> 2) & 3);
                    const attn_body::s16x4 lo4 = attn_body::vtr((attn_body::lds_cptr)(ringp + 256 * row0 + 16 * (ch ^ k0) + 8 * (p4 & 1)));
                    const attn_body::s16x4 hi4 = attn_body::vtr((attn_body::lds_cptr)(ringp + 256 * row1 + 16 * (ch ^ k1) + 8 * (p4 & 1)));
                    const bf16x8 bfr = (bf16x8){lo4[0], lo4[1], lo4[2], lo4[3], hi4[0], hi4[1], hi4[2], hi4[3]};
                    pacc[c] = __builtin_amdgcn_mfma_f32_16x16x32_bf16(af, bfr, pacc[c], 0, 0, 0); }
            }
            const float v0 = (kg == 0) ? pacc[0][0] : (kg == 1) ? pacc[1][0] : (kg == 2) ? pacc[2][0] : pacc[3][0];
            const float v1 = (kg == 0) ? pacc[4][0] : (kg == 1) ? pacc[5][0] : (kg == 2) ? pacc[6][0] : pacc[7][0];
            bf16* po = (bf16*)(a.ws + WS_PEER) + ((size_t)r * M + t) * D + x * 128;
            po[lane] = (bf16)f2bf(v0); po[64 + lane] = (bf16)f2bf(v1);
        }
    }
}
typedef int i32x4 __attribute__((ext_vector_type(4)));
__device__ __forceinline__ void sweep_down_q8(const Args& a, int x, int wv, int lane, unsigned ring, LAS unsigned char* ringp, unsigned aux, LAS unsigned char* auxp) {
    const int g = lane >> 4, li = lane & 15, n16 = li, kg = g, g8 = lane >> 3, s8 = lane & 7;
    const char* TABx = (const char*)(a.ws + WS_ED) + (size_t)x * ((size_t)NEXP * 128);
    unsigned jofs[2];
#pragma unroll
    for (int b = 0; b < 2; ++b) jofs[b] = (unsigned)((s8 ^ (4 * b + (g8 >> 1))) * 16);
    const unsigned pd = (unsigned)__builtin_amdgcn_readfirstlane(ring);
#define DN_FETCH(tw, dst) do { const char* rsrc_ = (const char*)(a.ws + WS_REC) + (size_t)(tw) * 512 + lane * 16; const unsigned d_ = (unsigned)__builtin_amdgcn_readfirstlane(dst); \
        glds16g(rsrc_, d_); glds16g(rsrc_ + 1024, d_ + 1024u); \
        glds16g((const char*)(a.ws + WS_HB) + (size_t)((tw) + g) * 2048 + x * 256 + li * 16, d_ + 2048u); } while (0)
    DN_FETCH(wv * 64, pd + 8192u);
    asm volatile("s_waitcnt vmcnt(0)" ::: "memory");
#pragma unroll 1
    for (int s_ = 0; s_ < 128; ++s_) {
        const int r = s_ & 1, k = s_ >> 1, t = wv * 64 + k, base = 64 * r;
        LAS unsigned char* wp = ringp + 8192 + 4096 * ((k >> 2) & 1);
        LAS unsigned char* hq = wp + 3072; LAS float* hsc = (LAS float*)(wp + 3072 + 512);
        const LAS unsigned* rec = (const LAS unsigned*)(wp + (k & 3) * 512) + base;
        asm volatile("s_waitcnt lgkmcnt(0)" ::: "memory");
        if ((k & 3) == 0 && r == 0) {
            {
                const v4u hb = *(const LAS v4u*)(wp + 2048 + lane * 16); float f[8]; unpack8(hb, f);
                float am = fmaxf(fmaxf(fmaxf(fabsf(f[0]), fabsf(f[1])), fmaxf(fabsf(f[2]), fabsf(f[3]))), fmaxf(fmaxf(fabsf(f[4]), fabsf(f[5])), fmaxf(fabsf(f[6]), fabsf(f[7]))));
                am = fmaxf(am, __int_as_float(__builtin_amdgcn_update_dpp(0, __float_as_int(am), 0x140, 0xf, 0xf, false))); am = fmaxf(am, __int_as_float(__builtin_amdgcn_update_dpp(0, __float_as_int(am), 0x141, 0xf, 0xf, false)));
                am = fmaxf(am, __int_as_float(__builtin_amdgcn_update_dpp(0, __float_as_int(am), 0x4E, 0xf, 0xf, false))); am = fmaxf(am, __int_as_float(__builtin_amdgcn_update_dpp(0, __float_as_int(am), 0xB1, 0xf, 0xf, false)));
                const float sc = (am > 0.f) ? am * (1.0f / 127.0f) : 1.0f, inv = 1.0f / sc;
                unsigned qw[2];
#pragma unroll
                for (int h2 = 0; h2 < 2; ++h2) { const int q0 = (int)__builtin_rintf(f[4 * h2] * inv), q1 = (int)__builtin_rintf(f[4 * h2 + 1] * inv), q2 = (int)__builtin_rintf(f[4 * h2 + 2] * inv), q3 = (int)__builtin_rintf(f[4 * h2 + 3] * inv);
                    qw[h2] = ((unsigned)q0 & 255u) | (((unsigned)q1 & 255u) << 8) | (((unsigned)q2 & 255u) << 16) | ((unsigned)q3 << 24); }
                *(LAS unsigned long long*)(hq + lane * 8) = (unsigned long long)qw[0] | ((unsigned long long)qw[1] << 32);
                if (li == 0) hsc[g] = sc; }
        }
        {   unsigned so[8];
#pragma unroll
            for (int i = 0; i < 8; ++i) so[i] = rec[8 * i + g8];
#pragma unroll
            for (int i = 0; i < 8; ++i) so[i] = ((so[i] & 0x3fffu) << 7) + jofs[i & 1];
            glds16x4(TABx, so[0], so[1], so[2], so[3], pd, pd + 1024u, pd + 2048u, pd + 3072u);
            glds16x4(TABx, so[4], so[5], so[6], so[7], pd + 4096u, pd + 5120u, pd + 6144u, pd + 7168u);
        }
        if ((k & 3) == 0 && r == 0 && k + 4 < 64) { DN_FETCH(t + 4, pd + 8192u + 4096u * (unsigned)(((k >> 2) + 1) & 1)); asm volatile("s_waitcnt vmcnt(3)" ::: "memory"); }
        else asm volatile("s_waitcnt vmcnt(0)" ::: "memory");
        const i32x4 hb0 = *(const LAS i32x4*)(hq + (k & 3) * 128 + 16 * kg), hb1 = *(const LAS i32x4*)(hq + (k & 3) * 128 + 64 + 16 * kg);
        const float hs = hsc[k & 3];
        i32x4 res = (i32x4){0, 0, 0, 0};
#pragma unroll
        for (int rb = 0; rb < 4; ++rb) {
            const int row = n16 + 16 * rb; const int key = (row >> 1) & 7;
            const i32x4 a0 = *(const LAS i32x4*)(ringp + row * 128 + ((kg ^ key) * 16)), a1 = *(const LAS i32x4*)(ringp + row * 128 + (((4 + kg) ^ key) * 16));
            i32x4 d = __builtin_amdgcn_mfma_i32_16x16x64_i8(a0, hb0, (i32x4){0, 0, 0, 0}, 0, 0, 0); d = __builtin_amdgcn_mfma_i32_16x16x64_i8(a1, hb1, d, 0, 0, 0);
            res = (n16 == rb) ? d : res; }
        if (n16 < 4) *(GAS unsigned long long*)((bf16*)(a.ws + WS_DOTP) + ((size_t)t * 8 + x) * 128 + base + 16 * n16 + 4 * kg) = (unsigned long long)pk2((float)res[0] * hs, (float)res[1] * hs) | ((unsigned long long)pk2((float)res[2] * hs, (float)res[3] * hs) << 32);
    }
}
#undef DN_FETCH

__device__ __forceinline__ void sweep_up_q8(const Args& a, int x, int wv, int lane, unsigned ring, LAS unsigned char* ringp, unsigned aux, LAS unsigned char* auxp) {
    const int n16 = lane & 15, kg = lane >> 4, g8 = lane >> 3, s8 = lane & 7;
    const char* TABx = (const char*)(a.ws + WS_EU) + (size_t)x * ((size_t)NEXP * 128);
    unsigned jofs[2];
#pragma unroll
    for (int b = 0; b < 2; ++b) jofs[b] = (unsigned)((s8 ^ ((g8 >> 1) | (b << 2))) * 16);
    const unsigned pd = (unsigned)__builtin_amdgcn_readfirstlane(ring);
    typedef int v2i_t __attribute__((ext_vector_type(2)));
    float acc0 = 0.f, acc1 = 0.f;
#define UP_FETCH(tw, dst) do { const char* rsrc_ = (const char*)(a.ws + WS_REC) + (size_t)(tw) * 512 + lane * 16; const unsigned d_ = (unsigned)__builtin_amdgcn_readfirstlane(dst); \
        glds16g(rsrc_, d_); glds16g(rsrc_ + 1024, d_ + 1024u); \
        if (lane < 36) glds16g((const char*)(a.ws + WS_WQ8) + (size_t)(tw) * 144 + lane * 16, d_ + 2048u); \
        glds16g((const char*)(a.ws + WS_HB) + (size_t)((tw) + (lane >> 4)) * 2048 + x * 256 + (lane & 15) * 16, d_ + 2688u); } while (0)
    UP_FETCH(wv * 64, pd + 8192u);
    asm volatile("s_waitcnt vmcnt(0)" ::: "memory");
#pragma unroll 1
    for (int s_ = 0; s_ < 128; ++s_) {
        const int r = s_ & 1, k = s_ >> 1, t = wv * 64 + k, base = 64 * r;
        const LAS unsigned char* wp = ringp + 8192 + 4096 * ((k >> 2) & 1);
        const LAS unsigned* rec = (const LAS unsigned*)(wp + (k & 3) * 512) + base;
        const LAS unsigned char* wq = wp + 2048 + (k & 3) * 144;
        asm volatile("s_waitcnt lgkmcnt(0)" ::: "memory");
        {   unsigned so[8];
#pragma unroll
            for (int i = 0; i < 8; ++i) so[i] = rec[8 * i + g8];
#pragma unroll
            for (int i = 0; i < 8; ++i) so[i] = ((so[i] & 0x3fffu) << 7) + jofs[(i >> 1) & 1];
            glds16x4(TABx, so[0], so[1], so[2], so[3], pd, pd + 1024u, pd + 2048u, pd + 3072u);
            glds16x4(TABx, so[4], so[5], so[6], so[7], pd + 4096u, pd + 5120u, pd + 6144u, pd + 7168u);
        }
        if ((k & 3) == 0 && r == 0 && k + 4 < 64) { UP_FETCH(t + 4, pd + 8192u + 4096u * (unsigned)(((k >> 2) + 1) & 1)); asm volatile("s_waitcnt vmcnt(4)" ::: "memory"); }
        else asm volatile("s_waitcnt vmcnt(0)" ::: "memory");
        const i32x4 aw = *(const LAS i32x4*)(wq + 64 * r + 16 * kg);
        const float wsc = *(const LAS float*)(wq + 128 + 4 * r);
        const int i2 = n16 >> 1, ih = n16 & 1;
        const int row0 = 16 * kg + i2, row1 = row0 + 8;
        const int k0 = ((row0 >> 1) & 3) | (((row0 >> 4) & 1) << 2), k1 = ((row1 >> 1) & 3) | (((row1 >> 4) & 1) << 2);
        const LAS unsigned char* p0 = ringp + row0 * 128 + 8 * ih; const LAS unsigned char* p1 = ringp + row1 * 128 + 8 * ih;
        float outv[8];
#pragma unroll
        for (int c = 0; c < 8; ++c) {
            const v2i_t lo = __builtin_amdgcn_ds_read_tr8_b64_v2i32((LAS v2i_t*)(p0 + ((c ^ k0) * 16)));
            const v2i_t hi = __builtin_amdgcn_ds_read_tr8_b64_v2i32((LAS v2i_t*)(p1 + ((c ^ k1) * 16)));
            const i32x4 d = __builtin_amdgcn_mfma_i32_16x16x64_i8(aw, (i32x4){lo.x, lo.y, hi.x, hi.y}, (i32x4){0, 0, 0, 0}, 0, 0, 0);
            outv[c] = (float)d[0] * wsc; }
        const float v0 = (kg == 0) ? outv[0] : (kg == 1) ? outv[1] : (kg == 2) ? outv[2] : outv[3];
        const float v1 = (kg == 0) ? outv[4] : (kg == 1) ? outv[5] : (kg == 2) ? outv[6] : outv[7];
        if (r == 0) { acc0 = v0; acc1 = v1; }
        else { const LAS unsigned short* hs = (const LAS unsigned short*)(wp + 2688 + (k & 3) * 256);
            const float y0 = bf2f(hs[lane]) + (acc0 + v0), y1 = bf2f(hs[64 + lane]) + (acc1 + v1);
            bf16* po = (bf16*)(a.ws + WS_PEER) + (size_t)t * D + x * 128;
            po[lane] = (bf16)f2bf(y0); po[64 + lane] = (bf16)f2bf(y1); }
    }
}
#undef UP_FETCH

__device__ __forceinline__ void final_row(const Args& a, int t, int lane) {
    float* orow = a.out + (size_t)t * D; const float* gf = a.in[22];
    const bf16* Y = (const bf16*)(a.ws + WS_PEER) + (size_t)t * D;
    f32x4 y[4]; float ss = 0.f;
#pragma unroll
    for (int j = 0; j < 4; ++j) { const unsigned long long yb = ((const GAS unsigned long long*)Y)[lane + 64 * j];
        y[j] = (f32x4){bflo((unsigned)yb), bfhi((unsigned)yb), bflo((unsigned)(yb >> 32)), bfhi((unsigned)(yb >> 32))};
        ss += (y[j].x * y[j].x + y[j].y * y[j].y) + (y[j].z * y[j].z + y[j].w * y[j].w); }
    ss = wave_sum(ss);
    const float ri = 1.0f / sqrtf(ss * (1.0f / 1024.0f) + EPSN);
#pragma unroll
    for (int j = 0; j < 4; ++j) ((GAS f32x4*)orow)[lane + 64 * j] = y[j] * ri * ((const GAS f32x4*)gf)[lane + 64 * j];
}

__device__ __forceinline__ float a_dot64(const float* p, const float* q, int lane) { return wave_sum(p[lane] * q[lane]); }
constexpr int N_PHASES = 12;
#ifndef ROUTE_REF
#define ROUTE_REF 0
#endif
#ifndef MK_ONE_LAUNCH
#define MK_ONE_LAUNCH 1
#endif
__global__ void __launch_bounds__(NWAVES * 64, 2) fwd_mega(Args args) {
    extern __shared__ __attribute__((aligned(16))) unsigned char lds[];
    Frame F;
    F.lds = (LAS unsigned char*)lds;
    F.MISC = (volatile LAS unsigned*)(F.lds + MISC_OFF);
    F.tid = threadIdx.x; F.lane = F.tid & 63; F.wave = __builtin_amdgcn_readfirstlane(F.tid >> 6);
    F.G = gridDim.x; { const int bx = blockIdx.x; F.vcu = (F.G % 8 == 0) ? (bx % 8) * (F.G / 8) + bx / 8 : bx; }
    unsigned char* ws = args.ws;
    const int lo = args.ph_lo, hi = args.ph_hi;
#ifndef PH_MASK
#define PH_MASK 0xffff
#endif
#define IN(k) (((PH_MASK >> (k)) & 1) && lo <= (k) && (k) < hi)
#define BOTH(k) (IN(k) && IN((k) + 1))
#if MK_ONE_LAUNCH
    for (int u = F.tid; u < (LDS_BYTES - LDSCTL_OFF) / 4; u += NWAVES * 64) ((LAS unsigned*)(F.lds + LDSCTL_OFF))[u] = 0u;
    __syncthreads();
    const XcdBarrier xbar = xcd_barrier_post((unsigned*)(ws + WS_CTL) + CW_BAR, F.MISC + 8);
    bool first_seam = args.ph_lo < 0;
#define GRID_BAR() do { if (first_seam) { __threadfence(); cooperative_groups::this_grid().sync(); first_seam = false; } else xcd_barrier(xbar); } while (0)
#else
#define GRID_BAR() do { } while (0)
#endif
#ifndef REP_PH
#define REP_PH -1
#endif
#define RUN_PHASE(k, ...) do { if (IN(k)) { if ((k) == REP_PH) { { const bool first_of_two = true; (void)first_of_two; __VA_ARGS__ } GRID_BAR(); } { const bool first_of_two = false; (void)first_of_two; __VA_ARGS__ } if (BOTH(k)) GRID_BAR(); } } while (0)
    RUN_PHASE(0, { p0_prologue(F, args); });
    RUN_PHASE(1, {
        pg8::Gemm g{(const pg8::bf16_t*)(ws + WS_XB), (const pg8::bf16_t*)(ws + WS_WIN), M, INC, D}; pg8::StaticOrder S; S.init(M, INC, F.G, (int)blockIdx.x);
        pg8::EpiBf16<1> E{(pg8::bf16_t*)(ws + WS_Q), 512, (const float*)(ws + WS_RS1), 512, (size_t)WS_SPLIT / 2, attn_body::C2};
        pg8::gemm_phase<pg8::EpiBf16<1>, pg8::StaticOrder, true, true>(F.lds + RING_OFF, g, S, E);
        { const int nb = (F.G >= 2) ? (int)F.G / 2 : 1; const int bi = (int)blockIdx.x - ((int)F.G - nb); if (bi >= 0) convert_experts(args, bi * NWAVES + F.wave, nb * NWAVES, F.lane); }
    });
    RUN_PHASE(2, {
        for (int c = F.vcu; c < M / 64; c += F.G) lru_local_unit(F, args, c);
        const attn128::AttnTensors AT{(const attn128::bf16*)(ws + WS_Q), (const attn128::bf16*)(ws + WS_Q + WS_SPLIT), (const attn128::bf16*)(ws + WS_Q + 2 * WS_SPLIT), (attn128::bf16*)(args.out + (size_t)M * 512)};
        const attn128::StaticOrder S(F.vcu);
        attn128::attn_phase<attn128::StaticOrder>((char*)lds + RING_OFF, AT, S);
    });
    RUN_PHASE(3, {
        float l1 = a_dot64(args.in[3], args.in[4], F.lane); float l2 = a_dot64(args.in[5], args.in[6], F.lane);
        const float lamv = expf(l1) - expf(l2) + 0.2f;
        for (int c = F.vcu; c < M / 64; c += F.G) fix_unit(F, args, c, lamv);
    });
    RUN_PHASE(4, {
        pg8::Gemm g{(const pg8::bf16_t*)(ws + WS_MIX), (const pg8::bf16_t*)(ws + WS_WOUT), M, D, D}; pg8::StaticOrder S; S.init(M, D, F.G, (int)blockIdx.x);
        pg8::EpiResid E{(const pg8::bf16_t*)(ws + WS_XB), args.out, (pg8::bf16_t*)(ws + WS_HB), (float*)(ws + (first_of_two ? WS_RS1 : WS_ROWSS2)), D};
        pg8::gemm_phase<pg8::EpiResid, pg8::StaticOrder, true, true>(F.lds + RING_OFF, g, S, E);
    });
    RUN_PHASE(5, {
        pg8::Gemm g{(const pg8::bf16_t*)(ws + WS_HB), (const pg8::bf16_t*)(ws + WS_WQ), M, NQ, D}; pg8::StaticOrder S; S.init(M, NQ, F.G, (int)blockIdx.x);
        pg8::EpiBf16<2> E{(pg8::bf16_t*)(ws + WS_Q2), NQ, (const float*)(ws + WS_ROWSS2), 0, 0, 1.f};
        pg8::gemm_phase<pg8::EpiBf16<2>, pg8::StaticOrder, true, true>(F.lds + RING_OFF, g, S, E);
    });
    RUN_PHASE(6, {
        const int gw = F.vcu * NWAVES + F.wave; const int NGW = F.G * NWAVES;
        LAS unsigned char* skl = F.lds + RING_OFF + 16384;
        for (int c = F.tid; c < 4096; c += NWAVES * 64) { const int row = c >> 4; const int ch = c & 15; *(LAS v4u*)(skl + row * 272 + ch * 16) = *(const GAS v4u*)(ws + WS_SK1 + (size_t)row * 256 + ch * 16); }
        __syncthreads();
        static_assert((M / 32) * 8 == NEXP / 4, "one group of 4 expert_up rows beside each routing unit");
        for (int u = gw; u < (M / 32) * 8; u += NGW) { f32x4 ev[4][4]; q8_load<4>(ev, args.in[21] + (size_t)u * 4 * D, F.lane);
            route_unit(args, u >> 3, u & 7, F.lane, F.lds + RING_OFF + F.tid * 32, skl, (int*)(ws + WS_EID), (float*)(ws + WS_GW));
            q8_finish<4>(ev, ws + WS_EU + (size_t)u * 4 * 128, nullptr, (float*)(ws + WS_SCU) + 4 * u, F.lane); }
        __syncthreads();
    });
    RUN_PHASE(8, {
        if (F.G == 256) sweep_down_q8(args, F.vcu >> 5, (F.vcu & 31) * NWAVES + F.wave, F.lane, (unsigned)(uintptr_t)(lds + RING_OFF) + F.wave * 16384u, F.lds + RING_OFF + F.wave * 16384, (unsigned)(uintptr_t)(lds + LDSCTL_OFF + 1024) + F.wave * 3712u, F.lds + LDSCTL_OFF + 1024 + F.wave * 3712);
    });
    RUN_PHASE(9, {
        const int gw = F.vcu * NWAVES + F.wave; const int NGW = F.G * NWAVES;
        LAS float* scl = (LAS float*)(F.lds + RING_OFF);
        for (int i = F.tid; i < NEXP / 4; i += NWAVES * 64) { ((LAS v4u*)scl)[i] = ((const GAS v4u*)(ws + WS_SCD))[i]; ((LAS v4u*)(scl + NEXP))[i] = ((const GAS v4u*)(ws + WS_SCU))[i]; }
        __syncthreads();
        for (int t = 8 * gw; t < M; t += 8 * NGW) w_tokens<8>(args, t, F.lane, scl, scl + NEXP);
        __syncthreads();
    });
    RUN_PHASE(10, {
        if (F.G == 256) sweep_up_q8(args, F.vcu >> 5, (F.vcu & 31) * NWAVES + F.wave, F.lane, (unsigned)(uintptr_t)(lds + RING_OFF) + F.wave * 16384u, F.lds + RING_OFF + F.wave * 16384, (unsigned)(uintptr_t)(lds + LDSCTL_OFF + 1024) + F.wave * 3712u, F.lds + LDSCTL_OFF + 1024 + F.wave * 3712);
    });
    RUN_PHASE(11, {
        const int gw = F.vcu * NWAVES + F.wave; const int NGW = F.G * NWAVES;
        for (int t = gw; t < M; t += NGW) final_row(args, t, F.lane);
    });
#undef IN
#undef BOTH
}

extern "C" void kernel_launch(void* const* d_in, const int* in_sizes, int n_in, void* d_out, int out_size, void* d_ws, size_t ws_size, hipStream_t stream) {
    static int grid = 0;
    if (grid == 0) {
        if (n_in != 23 || out_size != M * D || ws_size < WS_END) { fprintf(stderr, "kernel_launch: unexpected problem: n_in %d out %d ws %zu\n", n_in, out_size, ws_size); grid = -1; return; }
        int dev = 0, cus = 0, per_cu = 0;
        if (hipGetDevice(&dev) != hipSuccess || hipDeviceGetAttribute(&cus, hipDeviceAttributeMultiprocessorCount, dev) != hipSuccess) { grid = -1; return; }
        if (hipFuncSetAttribute((const void*)fwd_mega, hipFuncAttributeMaxDynamicSharedMemorySize, LDS_BYTES) != hipSuccess) { fprintf(stderr, "kernel_launch: hipFuncSetAttribute failed\n"); grid = -1; return; }
        if (hipOccupancyMaxActiveBlocksPerMultiprocessor(&per_cu, (const void*)fwd_mega, NWAVES * 64, LDS_BYTES) != hipSuccess || per_cu < 1) { fprintf(stderr, "kernel_launch: occupancy query reports %d\n", per_cu); per_cu = 1; }
        (void)hipGetLastError();
        grid = cus;
    }
    if (grid < 0) return;
    (void)hipMemsetAsync((char*)d_ws + WS_CTL, 0, CTL_ZERO_BYTES, stream);
    Args a{};
    for (int i = 0; i < 23; ++i) a.in[i] = (const float*)d_in[i];
    a.out = (float*)d_out; a.ws = (unsigned char*)d_ws;
#if MK_ONE_LAUNCH
    a.ph_lo = 0; a.ph_hi = N_PHASES;
    void* kargs[] = {&a};
    hipError_t e = hipLaunchCooperativeKernel((const void*)fwd_mega, dim3(grid), dim3(NWAVES * 64), kargs, LDS_BYTES, stream);
    if (e != hipSuccess) fprintf(stderr, "cooperative launch failed: %s (grid %d)\n", hipGetErrorString(e), grid);
#else
    for (int p = 0; p < N_PHASES; ++p) { a.ph_lo = p; a.ph_hi = p + 1; hipLaunchKernelGGL(fwd_mega, dim3(grid), dim3(NWAVES * 64), LDS_BYTES, stream, a); }
#endif
}
```

```cpp
#include <hip/hip_runtime.h>
#include <hip/hip_cooperative_groups.h>
#include <cstdio>
#include <cstdint>
namespace pg8 {
#define PG8_LAS __attribute__((address_space(3)))
typedef unsigned short bf16_t;
typedef short bf16x8 __attribute__((ext_vector_type(8)));
typedef float f32x4 __attribute__((ext_vector_type(4)));
typedef unsigned u32x4 __attribute__((ext_vector_type(4)));
constexpr int BM = 256, BK = 64, HALF = 128, HTB = HALF * BK * 2  , STAGE_BYTES = 8 * HTB, NXCD = 8, WGM = 8;

__host__ __device__ __forceinline__ int lds_byte(int r, int c) { const int st = (r >> 4) * 2 + (c >> 5), rr = r & 15, cc = c & 31, ob = rr * 64 + cc * 2; return st * 1024 + (ob ^ (((ob >> 9) & 1) << 5)); }
__host__ __device__ __forceinline__ void stage_rc(int b, int& R, int& C) { const int st = b / 1024, sb = b % 1024, swz = sb ^ (((sb >> 9) & 1) << 5); R = (st >> 1) * 16 + swz / 64; C = (st & 1) * 32 + (swz % 64) / 2; }
__host__ __device__ __forceinline__ int perm32(int rho) { const int n = rho >> 4, i = rho & 15; return 8 * (i >> 2) + 4 * n + (i & 3); }

struct Unit { int pm, pn; };
struct Gemm { const bf16_t* A; const bf16_t* Bt; int M, N, K; };

struct StaticOrder {
    int nM, nN, nwg, G, c;
    __host__ __device__ void init(int M, int N, int G_, int c_) { nM = M / BM; nN = N / BM; nwg = nM * nN; G = G_; c = c_; }
    __host__ __device__ bool next(int i, Unit& u) const {
        const long L = (long)i * G + c; if (L >= nwg) return false;
        int wgid = (int)L; { const int q = nwg / NXCD, r = nwg % NXCD, xcd = wgid % NXCD, off = wgid / NXCD; wgid = (xcd < r ? xcd * (q + 1) : r * (q + 1) + (xcd - r) * q) + off; }
        const int nig = WGM * nN, gid = wgid / nig, fm = gid * WGM, gsz = (nM - fm) < WGM ? (nM - fm) : WGM;
        u.pm = fm + ((wgid % nig) % gsz); u.pn = (wgid % nig) / gsz; return true;
    }
    __device__ __forceinline__ void a_ready(const Unit&) const {}
    __device__ __forceinline__ void done(const Unit&) const {}
};

__device__ __forceinline__ unsigned cvt_pk_bf16(float lo, float hi) { unsigned r; asm volatile("v_cvt_pk_bf16_f32 %0, %1, %2" : "=v"(r) : "v"(lo), "v"(hi)); return r; }
typedef float f32x2 __attribute__((ext_vector_type(2)));

template <int RSMODE> struct EpiBf16 {
    static constexpr bool PERM = true, AFTER_DRAIN = false;
    bf16_t* O; int ldc; const float* rowscale; int split_cols; size_t split_stride; float scale0;
    __device__ __forceinline__ void operator()(const f32x4 (&acc)[2][2][4][2], const Unit& u, int wr, int wc, int fr, int fq) const {
        const int row0 = u.pm * BM + wr * 64 + fr; int colt = u.pn * BM; bf16_t* base = O;
        float sc = 1.f; if (split_cols) { const int t = colt / split_cols; base += (size_t)t * split_stride; colt -= t * split_cols; if (t == 0) sc = scale0; }
        const int col0 = colt + wc * 32 + 8 * fq;
#pragma unroll
        for (int ai = 0; ai < 2; ++ai)
#pragma unroll
            for (int m = 0; m < 4; ++m) { const int row = row0 + ai * HALF + m * 16; bf16_t* rowp = base + (size_t)row * ldc + col0;
                float rs = sc;
                if (RSMODE == 1) rs *= rowscale[row];
                if (RSMODE == 2) rs *= 1.0f / sqrtf(rowscale[row] * (1.0f / 1024.0f) + 1e-6f);
#pragma unroll
                for (int bj = 0; bj < 2; ++bj) { f32x4 v0 = acc[ai][bj][m][0] * rs, v1 = acc[ai][bj][m][1] * rs;
                    u32x4 w; w.x = cvt_pk_bf16(v0[0], v0[1]); w.y = cvt_pk_bf16(v0[2], v0[3]); w.z = cvt_pk_bf16(v1[0], v1[1]); w.w = cvt_pk_bf16(v1[2], v1[3]);
                    *(u32x4*)(rowp + bj * HALF) = w; } }
    }
};

struct EpiResid {
    static constexpr bool PERM = false, AFTER_DRAIN = false;
    const bf16_t* X; float* Hf; bf16_t* Hb; float* rowss; int ldc;
    __device__ __forceinline__ void operator()(const f32x4 (&acc)[2][2][4][2], const Unit& u, int wr, int wc, int fr, int fq) const {
        typedef unsigned u32x2v __attribute__((ext_vector_type(2)));
        const int col0 = u.pn * BM + wc * 32 + 4 * fq;
#pragma unroll
        for (int ai = 0; ai < 2; ++ai)
#pragma unroll
            for (int m = 0; m < 4; ++m) { const int row = u.pm * BM + ai * HALF + wr * 64 + m * 16 + fr; const size_t off = (size_t)row * ldc + col0; float ss = 0.f;
#pragma unroll
                for (int bj = 0; bj < 2; ++bj)
#pragma unroll
                    for (int n = 0; n < 2; ++n) { const u32x2v xb = *(const u32x2v*)(X + off + bj * HALF + n * 16);
                        const f32x4 xv = (f32x4){__builtin_bit_cast(float, xb.x << 16), __builtin_bit_cast(float, xb.x & 0xffff0000u), __builtin_bit_cast(float, xb.y << 16), __builtin_bit_cast(float, xb.y & 0xffff0000u)}; const f32x4 h = xv + acc[ai][bj][m][n];
                        u32x2v w; w.x = cvt_pk_bf16(h[0], h[1]); w.y = cvt_pk_bf16(h[2], h[3]);
                        *(u32x2v*)(Hb + off + bj * HALF + n * 16) = w; ss += (h[0] * h[0] + h[1] * h[1]) + (h[2] * h[2] + h[3] * h[3]); }
                ss += __shfl_xor(ss, 16); ss += __shfl_xor(ss, 32);
                if (fq == 0) atomicAdd(rowss + row, ss); }
    }
};

template <class Epi, class Sched, bool ALIGN_EPI = false, bool SP2 = false>
__device__ __forceinline__ void gemm_phase(PG8_LAS unsigned char* lds, const Gemm g, const Sched& S, const Epi& E) {
    const int tid = threadIdx.x, wid = __builtin_amdgcn_readfirstlane(tid >> 6), lane = tid & 63, wr = wid >> 2, wc = wid & 3, fr = lane & 15, fq = lane >> 4;
    const int K = g.K, nt = K / BK;
    unsigned voffA[2], voffB[2];
#pragma unroll
    for (int i = 0; i < 2; ++i) { int R, C; stage_rc(tid * 16 + i * 8192, R, C); const int Rb = Epi::PERM ? ((R & ~31) + perm32(R & 31)) : R;
        voffA[i] = (unsigned)(R * K + C) * 2u; voffB[i] = (unsigned)(Rb * K + C) * 2u; }
    const size_t kstep = (size_t)(BK * 2);
    const size_t hstep = (size_t)HALF * K * 2;
    const size_t tstep = 2 * hstep;
    const unsigned ldsw = (unsigned)wid * 1024u;
    const int aoff = lds_byte(wr * 64 + fr, fq * 8), boff = lds_byte(wc * 32 + fr, fq * 8);
#define PG8_SA(b, h) (((b) * 2 + (h)) * HTB)
#define PG8_SB(b, h) ((4 + (b) * 2 + (h)) * HTB)
#define PG8_STAGE(bufoff, gbase, voff) do { _Pragma("unroll") for (int _i = 0; _i < 2; ++_i) \
        __builtin_amdgcn_global_load_lds((const unsigned*)((const char*)(gbase) + (voff)[_i]), (PG8_LAS unsigned*)(lds + (bufoff) + ldsw + _i * 8192), 16, 0, 0); } while (0)
#define PG8_LDA(dst, b, h) do { _Pragma("unroll") for (int m = 0; m < 4; ++m) _Pragma("unroll") for (int k = 0; k < 2; ++k) dst[m][k] = *(const PG8_LAS bf16x8*)(lds + PG8_SA(b, h) + aoff + m * 2048 + k * 1024); } while (0)
#define PG8_LDB(dst, b, h) do { _Pragma("unroll") for (int n = 0; n < 2; ++n) _Pragma("unroll") for (int k = 0; k < 2; ++k) dst[n][k] = *(const PG8_LAS bf16x8*)(lds + PG8_SB(b, h) + boff + n * 2048 + k * 1024); } while (0)
#define PG8_MMA(ai, bj, At, Bt) do { __builtin_amdgcn_s_setprio(1); _Pragma("unroll") for (int m = 0; m < 4; ++m) _Pragma("unroll") for (int n = 0; n < 2; ++n) _Pragma("unroll") for (int k = 0; k < 2; ++k) \
        acc[ai][bj][m][n] = __builtin_amdgcn_mfma_f32_16x16x32_bf16(Bt[n][k], At[m][k], acc[ai][bj][m][n], 0, 0, 0); __builtin_amdgcn_s_setprio(0); } while (0)
#define PG8_WAIT_V(n) asm volatile("s_waitcnt vmcnt(" #n ")" ::: "memory")
#define PG8_WAIT_L(n) asm volatile("s_waitcnt lgkmcnt(" #n ")" ::: "memory")
#define PG8_BAR __builtin_amdgcn_s_barrier()
#define PG8_SCHED __builtin_amdgcn_sched_barrier(0)
    Unit cur, nxt; int ui = 0;
    if (!S.next(0, cur)) return;
    f32x4 acc[2][2][4][2];
#pragma unroll
    for (int a = 0; a < 2; ++a)
#pragma unroll
        for (int b = 0; b < 2; ++b)
#pragma unroll
            for (int m = 0; m < 4; ++m)
#pragma unroll
                for (int n = 0; n < 2; ++n) acc[a][b][m][n] = (f32x4){0.f, 0.f, 0.f, 0.f};
    bf16x8 At[4][2], B0[2][2], B1[2][2];
    const char* cA = (const char*)g.A + (size_t)cur.pm * tstep; const char* cB = (const char*)g.Bt + (size_t)cur.pn * tstep;
    S.a_ready(cur);
    if constexpr (SP2) {
        PG8_STAGE(PG8_SB(0, 0), cB, voffB); PG8_STAGE(PG8_SB(0, 1), cB + hstep, voffB); PG8_STAGE(PG8_SA(0, 0), cA, voffA); PG8_STAGE(PG8_SA(0, 1), cA + hstep, voffA);
        if (wr == 1) PG8_BAR;
        PG8_WAIT_V(2); PG8_BAR;
        PG8_STAGE(PG8_SB(1, 0), cB + kstep, voffB); PG8_STAGE(PG8_SA(1, 0), cA + kstep, voffA); PG8_STAGE(PG8_SB(1, 1), cB + hstep + kstep, voffB);
        PG8_WAIT_V(6); PG8_BAR;
    } else {
        PG8_STAGE(PG8_SB(0, 0), cB, voffB); PG8_STAGE(PG8_SA(0, 0), cA, voffA); PG8_STAGE(PG8_SB(0, 1), cB + hstep, voffB); PG8_STAGE(PG8_SA(0, 1), cA + hstep, voffA);
        if (wr == 1) PG8_BAR;
        PG8_WAIT_V(4); PG8_BAR;
        PG8_STAGE(PG8_SB(1, 0), cB + kstep, voffB); PG8_STAGE(PG8_SA(1, 0), cA + kstep, voffA); PG8_STAGE(PG8_SB(1, 1), cB + hstep + kstep, voffB);
        PG8_WAIT_V(6); PG8_BAR;
    }
    for (;;) {
        const bool has_next = S.next(ui + 1, nxt);
        const char* nA = has_next ? (const char*)g.A + (size_t)nxt.pm * tstep : cA; const char* nB = has_next ? (const char*)g.Bt + (size_t)nxt.pn * tstep : cB;
        for (int t = 0; t < nt; t += 2) {
            const bool last = (t == nt - 2);
            const char* a1 = cA + (size_t)(t + 1) * kstep;
            const char* a2 = last ? nA : cA + (size_t)(t + 2) * kstep; const char* b2 = last ? nB : cB + (size_t)(t + 2) * kstep;
            const char* a3 = a2 + kstep; const char* b3 = b2 + kstep;
            if (last && has_next) S.a_ready(nxt);
            if constexpr (SP2) {
            PG8_LDB(B0, 0, 0); PG8_LDB(B1, 0, 1); PG8_SCHED; PG8_LDA(At, 0, 0); PG8_STAGE(PG8_SA(1, 1), a1 + hstep, voffA);
            PG8_WAIT_V(8); PG8_WAIT_L(0); PG8_BAR; PG8_MMA(0, 0, At, B0); PG8_MMA(0, 1, At, B1); PG8_BAR; PG8_SCHED;
            PG8_LDA(At, 0, 1); PG8_STAGE(PG8_SB(0, 0), b2, voffB); PG8_STAGE(PG8_SB(0, 1), b2 + hstep, voffB); PG8_STAGE(PG8_SA(0, 0), a2, voffA);
            PG8_WAIT_V(8); PG8_WAIT_L(0); PG8_BAR; PG8_MMA(1, 0, At, B0); PG8_MMA(1, 1, At, B1); PG8_BAR; PG8_SCHED;
            PG8_LDB(B0, 1, 0); PG8_LDB(B1, 1, 1); PG8_SCHED; PG8_LDA(At, 1, 0); PG8_STAGE(PG8_SA(0, 1), a2 + hstep, voffA);
            PG8_WAIT_V(8); PG8_WAIT_L(0); PG8_BAR; PG8_MMA(0, 0, At, B0); PG8_MMA(0, 1, At, B1); PG8_BAR; PG8_SCHED;
            PG8_LDA(At, 1, 1); PG8_STAGE(PG8_SB(1, 0), b3, voffB); PG8_STAGE(PG8_SB(1, 1), b3 + hstep, voffB); PG8_STAGE(PG8_SA(1, 0), a3, voffA);
            PG8_WAIT_V(8); PG8_WAIT_L(0); PG8_BAR; PG8_MMA(1, 0, At, B0); PG8_MMA(1, 1, At, B1); PG8_BAR; PG8_SCHED;
            } else {
            PG8_LDB(B0, 0, 0); PG8_SCHED; PG8_LDA(At, 0, 0); PG8_STAGE(PG8_SA(1, 1), a1 + hstep, voffA);
            PG8_WAIT_L(8); PG8_BAR; PG8_WAIT_L(0); PG8_MMA(0, 0, At, B0); PG8_BAR; PG8_SCHED;
            PG8_LDB(B1, 0, 1); PG8_STAGE(PG8_SB(0, 0), b2, voffB);
            PG8_BAR; PG8_WAIT_L(0); PG8_MMA(0, 1, At, B1); PG8_BAR;
            PG8_LDA(At, 0, 1); PG8_STAGE(PG8_SA(0, 0), a2, voffA);
            PG8_BAR; PG8_WAIT_L(0); PG8_MMA(1, 0, At, B0); PG8_BAR; PG8_SCHED;
            PG8_STAGE(PG8_SB(0, 1), b2 + hstep, voffB);
            PG8_WAIT_V(6); PG8_BAR; PG8_MMA(1, 1, At, B1); PG8_BAR;
            PG8_LDB(B0, 1, 0); PG8_SCHED; PG8_LDA(At, 1, 0); PG8_STAGE(PG8_SA(0, 1), a2 + hstep, voffA);
            PG8_WAIT_L(8); PG8_BAR; PG8_WAIT_L(0); PG8_MMA(0, 0, At, B0); PG8_BAR; PG8_SCHED;
            PG8_LDB(B1, 1, 1); PG8_STAGE(PG8_SB(1, 0), b3, voffB);
            PG8_BAR; PG8_WAIT_L(0); PG8_MMA(0, 1, At, B1); PG8_BAR;
            PG8_LDA(At, 1, 1); PG8_STAGE(PG8_SA(1, 0), a3, voffA);
            PG8_BAR; PG8_WAIT_L(0); PG8_MMA(1, 0, At, B0); PG8_BAR; PG8_SCHED;
            PG8_STAGE(PG8_SB(1, 1), b3 + hstep, voffB);
            PG8_WAIT_V(6); PG8_BAR; PG8_MMA(1, 1, At, B1); PG8_BAR;
            }
        }
        if constexpr (ALIGN_EPI) { if (wr == 0) PG8_BAR; }
        if constexpr (!Epi::AFTER_DRAIN) { E(acc, cur, wr, wc, fr, fq); S.done(cur); }
        if (!has_next) break;
#pragma unroll
        for (int a = 0; a < 2; ++a)
#pragma unroll
            for (int b = 0; b < 2; ++b)
#pragma unroll
                for (int m = 0; m < 4; ++m)
#pragma unroll
                    for (int n = 0; n < 2; ++n) acc[a][b][m][n] = (f32x4){0.f, 0.f, 0.f, 0.f};
        cur = nxt; cA = nA; cB = nB; ++ui;
        if constexpr (ALIGN_EPI) { if (wr == 1) PG8_BAR; }
    }
    PG8_WAIT_V(0);
    if constexpr (!ALIGN_EPI) { if (wr == 0) PG8_BAR; }
    PG8_BAR;
    if constexpr (Epi::AFTER_DRAIN) { E.fused(acc, cur, wr, wc, fr, fq, lds, wid, lane); S.done(cur); }
#undef PG8_SA
#undef PG8_SB
#undef PG8_STAGE
#undef PG8_LDA
#undef PG8_LDB
#undef PG8_MMA
#undef PG8_WAIT_V
#undef PG8_WAIT_L
#undef PG8_BAR
#undef PG8_SCHED
}
}

#include <hip/hip_bf16.h>
#include <cmath>
namespace attn_body {
using bf16=__hip_bfloat16;
using bf16x8=__attribute__((ext_vector_type(8)))short;
using s16x4=__attribute__((ext_vector_type(4)))short;
using f32x16=__attribute__((ext_vector_type(16)))float;
using u32x4=__attribute__((ext_vector_type(4)))unsigned;
constexpr int SEQ=16384,D=64,DM=512;
constexpr int NW=8,QBLK=32,QB=QBLK*NW,KVBLK=64,NQB=SEQ/QB;
constexpr int ATTN_PITCH=DM, ATTN_UNIT_ROWS=QB;
__device__ __forceinline__ int crow(int r,int hi){return (r&3)+8*(r>>2)+4*hi;}
#define SBAR() __builtin_amdgcn_sched_barrier(0)
__device__ __forceinline__ void cmask(f32x16&p0,f32x16&p1,int jb,int wid){
  const float NEG=-INFINITY;
  if(jb>(wid>>1)){
  #pragma unroll
  for(int r=0;r<16;++r){p0[r]=NEG;p1[r]=NEG;}}
}

constexpr int NSLOT=3, SLOTB=8192;
constexpr int LDS_K=0, LDS_V=NSLOT*SLOTB, LDS_WS=2*NSLOT*SLOTB, LDS_OST=LDS_WS+NW*64*4, LDS_BYTES=LDS_OST+NW*4096;
constexpr float C2=0.125f*1.4426950408889634f;
__device__ __forceinline__ void glds16(const void*gsrc,unsigned lds_dst){unsigned keep;
  asm volatile("s_mov_b32 %0, m0\n\ts_mov_b32 m0, %2\n\ts_nop 0\n\tglobal_load_lds_dwordx4 %1, off\n\ts_mov_b32 m0, %0":"=&s"(keep):"v"(gsrc),"s"(lds_dst):"memory");}
__device__ __forceinline__ float max3f(float a,float b,float c){float r;asm("v_max3_f32 %0, %1, %2, %3":"=v"(r):"v"(a),"v"(b),"v"(c));return r;}
__device__ __forceinline__ float max2f(float a,float b){float r;asm("v_max_f32_e32 %0, %1, %2":"=v"(r):"v"(a),"v"(b));return r;}
__device__ __forceinline__ float fadd_s(float a,float b){float r;asm("v_add_f32_e32 %0, %1, %2":"=v"(r):"v"(a),"v"(b));return r;}
__device__ __forceinline__ float fsub_s(float a,float b){float r;asm("v_sub_f32_e32 %0, %1, %2":"=v"(r):"v"(a),"v"(b));return r;}
typedef float f32x2_t __attribute__((ext_vector_type(2))); typedef __bf16 bf16x2_t __attribute__((ext_vector_type(2)));
__device__ __forceinline__ unsigned cvtpk_s(float lo,float hi){f32x2_t v={lo,hi};bf16x2_t b=__builtin_convertvector(v,bf16x2_t);return __builtin_bit_cast(unsigned,b);}
#define WAIT_BAR(N) asm volatile("s_waitcnt vmcnt(" #N ") lgkmcnt(0)\n\ts_barrier":::"memory")

__device__ __forceinline__ void qkt(f32x16&p0,f32x16&p1,const char*Kslot,const bf16x8*qr,const f32x16&negm,int r32,int hi){
  const char*kb=Kslot+hi*1024+r32*16;
  #pragma unroll
  for(int d0=0;d0<4;++d0){
    const bf16x8 b0=*reinterpret_cast<const bf16x8*>(kb+d0*2048);
    const bf16x8 b1=*reinterpret_cast<const bf16x8*>(kb+d0*2048+512);
    if(d0==0){p0=__builtin_amdgcn_mfma_f32_32x32x16_bf16(b0,qr[0],negm,0,0,0);p1=__builtin_amdgcn_mfma_f32_32x32x16_bf16(b1,qr[0],negm,0,0,0);}
    else{p0=__builtin_amdgcn_mfma_f32_32x32x16_bf16(b0,qr[d0],p0,0,0,0);p1=__builtin_amdgcn_mfma_f32_32x32x16_bf16(b1,qr[d0],p1,0,0,0);}}
}
typedef __attribute__((address_space(3))) const char* lds_cptr;
typedef short v4i16_t __attribute__((ext_vector_type(4)));
__device__ __forceinline__ void kload8(bf16x8*kf,lds_cptr kp){
  kf[0]=*(const __attribute__((address_space(3))) bf16x8*)(kp);      kf[1]=*(const __attribute__((address_space(3))) bf16x8*)(kp+512);
  kf[2]=*(const __attribute__((address_space(3))) bf16x8*)(kp+2048); kf[3]=*(const __attribute__((address_space(3))) bf16x8*)(kp+2560);
  kf[4]=*(const __attribute__((address_space(3))) bf16x8*)(kp+4096); kf[5]=*(const __attribute__((address_space(3))) bf16x8*)(kp+4608);
  kf[6]=*(const __attribute__((address_space(3))) bf16x8*)(kp+6144); kf[7]=*(const __attribute__((address_space(3))) bf16x8*)(kp+6656);
}
__device__ __forceinline__ void kload2(bf16x8*kf,lds_cptr kp,int j){ kf[2*j]=*(const __attribute__((address_space(3))) bf16x8*)(kp+j*2048); kf[2*j+1]=*(const __attribute__((address_space(3))) bf16x8*)(kp+j*2048+512); }
__device__ __forceinline__ s16x4 vtr(lds_cptr p){ return __builtin_bit_cast(s16x4,__builtin_amdgcn_ds_read_tr16_b64_v4i16((__attribute__((address_space(3))) v4i16_t*)p)); }
__device__ __forceinline__ float rowmax(const f32x16&p0,const f32x16&p1){
  float a=max3f(p0[0],p0[1],p1[0]),b=max3f(p0[2],p0[3],p1[1]);a=max3f(a,p1[2],p1[3]);
  #pragma unroll
  for(int r=4;r<16;r+=4){a=max3f(a,p0[r],p0[r+1]);b=max3f(b,p0[r+2],p0[r+3]);a=max3f(a,p1[r],p1[r+1]);b=max3f(b,p1[r+2],p1[r+3]);}
  const float m=max2f(a,b);
  auto rr=__builtin_amdgcn_permlane32_swap(__float_as_uint(m),__float_as_uint(m),false,false);
  return max2f(__uint_as_float(rr[0]),__uint_as_float(rr[1]));
}
__device__ __forceinline__ void pv(f32x16*o,int vb,bf16x8 pa0,bf16x8 pa1,bf16x8 pa2,bf16x8 pa3){
  #pragma unroll
  for(int d0=0;d0<2;++d0){s16x4 lo[4],hi[4];
    #pragma unroll
    for(int ks=0;ks<4;++ks){
      asm volatile("ds_read_b64_tr_b16 %0,%1 offset:%c2":"=&v"(lo[ks]):"v"(vb),"i"(d0*4096+ks*1024):"memory");
      asm volatile("ds_read_b64_tr_b16 %0,%1 offset:%c2":"=&v"(hi[ks]):"v"(vb),"i"(d0*4096+ks*1024+512):"memory");}
    asm volatile("s_waitcnt lgkmcnt(0)":::"memory");SBAR();
    #define PK(k) (bf16x8){lo[k][0],lo[k][1],lo[k][2],lo[k][3],hi[k][0],hi[k][1],hi[k][2],hi[k][3]}
    o[d0]=__builtin_amdgcn_mfma_f32_32x32x16_bf16(pa0,PK(0),o[d0],0,0,0);
    o[d0]=__builtin_amdgcn_mfma_f32_32x32x16_bf16(pa1,PK(1),o[d0],0,0,0);
    o[d0]=__builtin_amdgcn_mfma_f32_32x32x16_bf16(pa2,PK(2),o[d0],0,0,0);
    o[d0]=__builtin_amdgcn_mfma_f32_32x32x16_bf16(pa3,PK(3),o[d0],0,0,0);
    #undef PK
  }
}

#ifndef ATTN_STORE16
#define ATTN_STORE16(p,v) (*(u32x4*)(p)=(v))
#endif
template<int THRL> __device__ __forceinline__ void attn_unit(int qcol,int vcol,int qb,const bf16*Q,const bf16*__restrict__ K,const bf16*__restrict__ V,bf16*O,char*shm){
  const int tid=threadIdx.x,lane=tid&63,r32=lane&31,hi=lane>>5; const int wid=__builtin_amdgcn_readfirstlane(tid>>6);
  const long rowbase=0; const int q0=qb*QB;
  const bf16*Qw=Q+(rowbase+q0+wid*QBLK)*DM+qcol;
  const bf16*Kh=K+rowbase*DM+qcol,*Vh=V+rowbase*DM+vcol;
  const unsigned lds0=(unsigned)(uintptr_t)shm;
  float*wsf=(float*)(shm+LDS_WS)+wid*64;
  const bf16*ksrc=Kh+(long)lane*DM+wid*8;
  const bf16*vsrc=Vh+(long)(16*(wid&3)+(lane>>2))*DM+(wid>>2)*32+(lane&3)*8;
  const unsigned kdst=lds0+LDS_K+wid*1024, vdst=lds0+LDS_V+wid*1024;
  #define DMA_K(t,slot) glds16(ksrc+(long)(t)*KVBLK*DM,(unsigned)__builtin_amdgcn_readfirstlane(kdst+(slot)))
  #define DMA_V(t,slot) glds16(vsrc+(long)(t)*KVBLK*DM,(unsigned)__builtin_amdgcn_readfirstlane(vdst+(slot)))
  const int vb0=(int)(lds0+LDS_V)+((lane>>4)&1)*32+(lane&3)*8+(4*hi+((lane&15)>>2))*64;
  const char*Kbase=shm+LDS_K; bf16x8 kf[8];
  const lds_cptr shm3=(lds_cptr)shm; const lds_cptr kp0=shm3+LDS_K+hi*1024+r32*16; const lds_cptr vp0=shm3+LDS_V+((lane>>4)&1)*32+(lane&3)*8+(4*hi+((lane&15)>>2))*64;
  const int NT=(q0+QB)/KVBLK;
  DMA_K(0,0);DMA_V(0,0);DMA_K(1,SLOTB);
  bf16x8 qr[4];
  #pragma unroll
  for(int d0=0;d0<4;++d0)qr[d0]=*reinterpret_cast<const bf16x8*>(&Qw[(long)r32*DM+d0*16+hi*8]);
  float mhat=0.f,l_reg=0.f;f32x16 o[2];o[0]=f32x16{};o[1]=f32x16{};f32x16 negm=f32x16{};asm volatile("":"+v"(negm));
  const int qrel=wid*QBLK+r32;
  #define CMASK(P0,P1,t) do{int jb_=(t)-(NT-4); if(jb_>=0)cmask(P0,P1,jb_,wid);}while(0)
  bool resc=false;
  #define START(P0,P1) do{ const float rm=rowmax(P0,P1); resc=false; \
    { const float dl=rm; mhat=fadd_s(mhat,dl); \
      _Pragma("unroll") for(int r=0;r<16;++r){P0[r]=fsub_s(P0[r],dl);P1[r]=fsub_s(P1[r],dl);} \
      _Pragma("unroll") for(int r=0;r<16;++r)negm[r]=-mhat; asm volatile("":"+v"(negm)); } \
    _Pragma("unroll") for(int r=0;r<16;++r)P0[r]=__builtin_amdgcn_exp2f(P0[r]); }while(0)
  #define RESC() do{ if(resc){ asm volatile("s_waitcnt lgkmcnt(0)":::"memory"); \
      _Pragma("unroll") for(int d_=0;d_<2;++d_) _Pragma("unroll") for(int r=0;r<16;++r)o[d_][r]*=wsf[crow(r,hi)]; } }while(0)
  f32x16 pA0,pA1,pB0,pB1;
  int sl_prev=0,sl_cur=0,sl_next=SLOTB;
  #define ROT() do{sl_prev=sl_cur;sl_cur=sl_next;sl_next=(sl_next==(NSLOT-1)*SLOTB)?0:sl_next+SLOTB;}while(0)
  DMA_K(2,2*SLOTB);
  WAIT_BAR(3);
  qkt(pA0,pA1,Kbase,qr,negm,r32,hi);asm volatile("s_nop 15\n\ts_nop 7":"+v"(pA0),"+v"(pA1));CMASK(pA0,pA1,0);
  START(pA0,pA1);
  _Pragma("unroll") for(int r=0;r<16;++r)pA1[r]=__builtin_amdgcn_exp2f(pA1[r]);
  WAIT_BAR(0);
  DMA_K(3,0);DMA_V(1,SLOTB);
  ROT();
  kload8(kf,kp0+sl_cur);
  WAIT_BAR(2);
  s16x4 vlo[8],vhi[8]; u32x4 pw0,pw1,pw2,pw3;
  #define PKW(P,B) cvtpk_s(P[B],P[B+1])
  #define PAF(k) __builtin_bit_cast(bf16x8,pw##k)
  #define VFR(i) (bf16x8){vlo[i][0],vlo[i][1],vlo[i][2],vlo[i][3],vhi[i][0],vhi[i][1],vhi[i][2],vhi[i][3]}
  #define PIN(x) asm volatile("":"+v"(x))
  #define MX3(a,b,c) __builtin_fmaxf(__builtin_fmaxf((a),(b)),(c))
  #define GAPA(MF,A0,A1,A2,A3,W0,W1,PW) do{ MF; sacc+=A0; sacc+=A1; sacc+=A2; sacc+=A3; PIN(sacc); W0; W1; PIN(PW); SBAR(); }while(0)
  #define EX(v) __builtin_amdgcn_exp2f(v)
  #define GAPB(MF,X,B) do{ MF; X[B]=EX(X[B]); X[B+1]=EX(X[B+1]); X[B+2]=EX(X[B+2]); X[B+3]=EX(X[B+3]); PIN(X); SBAR(); }while(0)
  #define VRD(i) do{ vlo[i]=vtr(vp_+(((i)>>2)*4096+((i)&3)*1024)); vhi[i]=vtr(vp_+(((i)>>2)*4096+((i)&3)*1024+512)); }while(0)
  #define KRD(G,j) do{ if(G){ kload2(kf,kp0+sl_next,j); SBAR(); } }while(0)
  #define STEP(C0,C1,P0,P1,t,GK,GV,GL) do{ SBAR(); \
    const lds_cptr vp_=vp0+sl_prev; \
    VRD(0); SBAR(); float sacc=(P0[0]+P0[1]); \
    GAPA(C0=__builtin_amdgcn_mfma_f32_32x32x16_bf16(kf[0],qr[0],negm,0,0,0), P0[2],P0[3],P0[4],P0[5],     pw0[0]=PKW(P0,0), pw0[1]=PKW(P0,2), pw0); \
    VRD(4); SBAR(); GAPA(C1=__builtin_amdgcn_mfma_f32_32x32x16_bf16(kf[1],qr[0],negm,0,0,0), P0[6],P0[7],P0[8],P0[9],     pw0[2]=PKW(P0,4), pw0[3]=PKW(P0,6), pw0); \
    VRD(1); SBAR(); GAPA(C0=__builtin_amdgcn_mfma_f32_32x32x16_bf16(kf[2],qr[1],C0,0,0,0),   P0[10],P0[11],P0[12],P0[13], pw1[0]=PKW(P0,8), pw1[1]=PKW(P0,10), pw1); \
    VRD(5); SBAR(); GAPA(C1=__builtin_amdgcn_mfma_f32_32x32x16_bf16(kf[3],qr[1],C1,0,0,0),   P0[14],P0[15],P1[0],P1[1],   pw1[2]=PKW(P0,12),pw1[3]=PKW(P0,14), pw1); \
    VRD(2); SBAR(); GAPA(C0=__builtin_amdgcn_mfma_f32_32x32x16_bf16(kf[4],qr[2],C0,0,0,0),   P1[2],P1[3],P1[4],P1[5],     pw2[0]=PKW(P1,0), pw2[1]=PKW(P1,2), pw2); \
    VRD(6); SBAR(); GAPA(C1=__builtin_amdgcn_mfma_f32_32x32x16_bf16(kf[5],qr[2],C1,0,0,0),   P1[6],P1[7],P1[8],P1[9],     pw2[2]=PKW(P1,4), pw2[3]=PKW(P1,6), pw2); \
    VRD(3); SBAR(); GAPA(C0=__builtin_amdgcn_mfma_f32_32x32x16_bf16(kf[6],qr[3],C0,0,0,0),   P1[10],P1[11],P1[12],P1[13], pw3[0]=PKW(P1,8), pw3[1]=PKW(P1,10), pw3); \
    VRD(7); SBAR(); GAPA(C1=__builtin_amdgcn_mfma_f32_32x32x16_bf16(kf[7],qr[3],C1,0,0,0),   P1[14],P1[15],0.f,0.f,       pw3[2]=PKW(P1,12),pw3[3]=PKW(P1,14), pw3); \
    l_reg+=sacc; \
    if(GK){DMA_K((t)+3,sl_cur);} if(GV){DMA_V((t)+1,sl_next);} \
    CMASK(C0,C1,t); \
    { float a=MX3(C0[0],C0[1],C1[0]),b=MX3(C0[2],C0[3],C1[1]); a=MX3(a,C1[2],C1[3]); \
      _Pragma("unroll") for(int r=4;r<16;r+=4){a=MX3(a,C0[r],C0[r+1]);b=MX3(b,C0[r+2],C0[r+3]);a=MX3(a,C1[r],C1[r+1]);b=MX3(b,C1[r+2],C1[r+3]);} \
      float rm=__builtin_fmaxf(a,b); { auto rr=__builtin_amdgcn_permlane32_swap(__float_as_uint(rm),__float_as_uint(rm),false,false); rm=__builtin_fmaxf(__uint_as_float(rr[0]),__uint_as_float(rr[1])); } \
      resc=false; \
      if(__builtin_expect(__any(rm>(float)THRL),0)){ const float dl=__builtin_fmaxf(rm,0.f); mhat+=dl; \
        _Pragma("unroll") for(int r=0;r<16;++r){C0[r]-=dl;C1[r]-=dl;} \
        _Pragma("unroll") for(int r=0;r<16;++r)negm[r]=-mhat; asm volatile("":"+v"(negm)); \
        const float f=__builtin_amdgcn_exp2f(-dl); l_reg*=f; if(hi==0)wsf[r32]=f; resc=true; } } \
    SBAR(); \
    GAPB(o[0]=__builtin_amdgcn_mfma_f32_32x32x16_bf16(PAF(0),VFR(0),o[0],0,0,0), C0,0); \
    GAPB(o[1]=__builtin_amdgcn_mfma_f32_32x32x16_bf16(PAF(0),VFR(4),o[1],0,0,0), C0,4); \
    KRD(GL,0); GAPB(o[0]=__builtin_amdgcn_mfma_f32_32x32x16_bf16(PAF(1),VFR(1),o[0],0,0,0), C0,8); \
    KRD(GL,1); GAPB(o[1]=__builtin_amdgcn_mfma_f32_32x32x16_bf16(PAF(1),VFR(5),o[1],0,0,0), C0,12); \
    KRD(GL,2); GAPB(o[0]=__builtin_amdgcn_mfma_f32_32x32x16_bf16(PAF(2),VFR(2),o[0],0,0,0), C1,0); \
    KRD(GL,3); GAPB(o[1]=__builtin_amdgcn_mfma_f32_32x32x16_bf16(PAF(2),VFR(6),o[1],0,0,0), C1,4); \
    GAPB(o[0]=__builtin_amdgcn_mfma_f32_32x32x16_bf16(PAF(3),VFR(3),o[0],0,0,0), C1,8); \
    GAPB(o[1]=__builtin_amdgcn_mfma_f32_32x32x16_bf16(PAF(3),VFR(7),o[1],0,0,0), C1,12); \
    }while(0)
  int t=1;
  #undef CMASK
  #define CMASK(P0,P1,t) do{}while(0)
  for(;t+5<NT;t+=2){
    STEP(pB0,pB1,pA0,pA1,t,true,true,true);     WAIT_BAR(2); RESC(); ROT();
    STEP(pA0,pA1,pB0,pB1,t+1,true,true,true);   WAIT_BAR(2); RESC(); ROT();
  }
  #undef CMASK
  #define CMASK(P0,P1,t) do{int jb_=(t)-(NT-4); if(jb_>=0)cmask(P0,P1,jb_,wid);}while(0)
  #define ENDW(tt) do{ if((tt)+3<NT){WAIT_BAR(2);} else if((tt)+2<NT){WAIT_BAR(1);} else {WAIT_BAR(0);} }while(0)
  for(;t+1<NT;t+=2){
    STEP(pB0,pB1,pA0,pA1,t,(t+3<NT),(t+1<NT),(t+1<NT));       ENDW(t);   RESC(); ROT();
    STEP(pA0,pA1,pB0,pB1,t+1,(t+4<NT),(t+2<NT),(t+2<NT));     ENDW(t+1); RESC(); ROT();
  }
  STEP(pB0,pB1,pA0,pA1,NT-1,false,false,false); RESC();
  { float sacc=pB0[0]+pB0[1]; _Pragma("unroll") for(int r=2;r<16;++r)sacc+=pB0[r]; _Pragma("unroll") for(int r=0;r<16;++r)sacc+=pB1[r]; l_reg+=sacc;
    pw0=(u32x4){PKW(pB0,0),PKW(pB0,2),PKW(pB0,4),PKW(pB0,6)};pw1=(u32x4){PKW(pB0,8),PKW(pB0,10),PKW(pB0,12),PKW(pB0,14)};pw2=(u32x4){PKW(pB1,0),PKW(pB1,2),PKW(pB1,4),PKW(pB1,6)};pw3=(u32x4){PKW(pB1,8),PKW(pB1,10),PKW(pB1,12),PKW(pB1,14)};
    SBAR(); pv(o,vb0+sl_cur,PAF(0),PAF(1),PAF(2),PAF(3)); }
  #undef PKW
  #undef PAF
  #undef VFR
  #undef PIN
  #undef MX3
  #undef GAPA
  #undef GAPB
  #undef EX
  #undef VRD
  #undef KRD
  #undef STEP
  #undef ENDW
  {auto rr=__builtin_amdgcn_permlane32_swap(__float_as_uint(l_reg),__float_as_uint(l_reg),false,false);l_reg=__uint_as_float(rr[0])+__uint_as_float(rr[1]);}
  if(hi==0)wsf[32+r32]=l_reg;asm volatile("s_waitcnt lgkmcnt(0)":::"memory");
  float rli[16];
  #pragma unroll
  for(int r=0;r<16;++r)rli[r]=__builtin_amdgcn_rcpf(wsf[32+crow(r,hi)]);
  bf16*Ow=O+(rowbase+q0+wid*QBLK)*DM+vcol;
  { bf16*stg=(bf16*)(shm+LDS_OST)+wid*2048;
    #pragma unroll
    for(int r=0;r<16;++r){const int orow=crow(r,hi);
      #pragma unroll
      for(int d0=0;d0<2;++d0)stg[orow*64+d0*32+r32]=__float2bfloat16(o[d0][r]*rli[r]);}
    asm volatile("s_waitcnt lgkmcnt(0)":::"memory");
    #pragma unroll
    for(int i=0;i<4;++i){const int row=i*8+(lane>>3),ch=lane&7; const u32x4 v=*(const u32x4*)(stg+row*64+ch*8); ATTN_STORE16(Ow+(long)row*DM+ch*8,v);} }
  asm volatile("s_waitcnt lgkmcnt(0)\n\ts_barrier":::"memory");
  #undef DMA_K
  #undef DMA_V
  #undef CMASK
  #undef START
  #undef RESC
  #undef ROT
}
constexpr int ATTN_LDS_BYTES=LDS_BYTES;
struct AttnTensors { const bf16* Q; const bf16* K; const bf16* V; bf16* O; };
struct AttnUnit { int var; int qb; };
struct StaticOrder {
  int vcu;
  __device__ __forceinline__ explicit StaticOrder(int v):vcu(v){}
  __device__ __forceinline__ bool next(int i,AttnUnit&u)const{ if(i>=4)return false; const int s=vcu&15; u.var=vcu>>4; u.qb=(i==0)?s:(i==1)?31-s:(i==2)?32+s:63-s; return true; }
};
template<class Sched,int THRL=8> __device__ __forceinline__ void attn_phase(char*lds,const AttnTensors&T,const Sched&S){
  AttnUnit u;
  for(int i=0;S.next(i,u);++i){ const int h=u.var>>2,mp=(u.var>>1)&1,vh=u.var&1;
    attn_unit<THRL>(h*128+mp*64,h*128+vh*64,u.qb,T.Q,T.K,T.V,T.O+(size_t)mp*SEQ*DM,lds); }
}
#undef SBAR
#undef WAIT_BAR
}
namespace attn128 {
using bf16=__hip_bfloat16;
using bf16x8=__attribute__((ext_vector_type(8)))short;
using s16x4=__attribute__((ext_vector_type(4)))short;
using f32x16=__attribute__((ext_vector_type(16)))float;
using u32x4=__attribute__((ext_vector_type(4)))unsigned;
constexpr int SEQ=16384,D=64,DM=512;
constexpr int NW=8,QBLK=32,QB=QBLK*NW,KVBLK=64,NQB=SEQ/QB;
constexpr int ATTN_PITCH=DM, ATTN_UNIT_ROWS=QB;
__device__ __forceinline__ int crow(int r,int hi){return (r&3)+8*(r>>2)+4*hi;}
#define SBAR() __builtin_amdgcn_sched_barrier(0)
__device__ __forceinline__ void cmask(f32x16&p0,f32x16&p1,int jb,int wid){
  const float NEG=-INFINITY;
  if(jb>(wid>>1)){
  #pragma unroll
  for(int r=0;r<16;++r){p0[r]=NEG;p1[r]=NEG;}}
}

constexpr int NSLOT=3, SLOTB=8192;
constexpr int LDS_K=0, LDS_V=NSLOT*SLOTB, LDS_WS=3*NSLOT*SLOTB, LDS_OST=LDS_WS+NW*64*4, LDS_BYTES=LDS_OST+NW*4096;
constexpr float C2=0.125f*1.4426950408889634f;
__device__ __forceinline__ void glds16(const void*gsrc,unsigned lds_dst){unsigned keep;
  asm volatile("s_mov_b32 %0, m0\n\ts_mov_b32 m0, %2\n\ts_nop 0\n\tglobal_load_lds_dwordx4 %1, off\n\ts_mov_b32 m0, %0":"=&s"(keep):"v"(gsrc),"s"(lds_dst):"memory");}
__device__ __forceinline__ float max3f(float a,float b,float c){float r;asm("v_max3_f32 %0, %1, %2, %3":"=v"(r):"v"(a),"v"(b),"v"(c));return r;}
__device__ __forceinline__ float max2f(float a,float b){float r;asm("v_max_f32_e32 %0, %1, %2":"=v"(r):"v"(a),"v"(b));return r;}
__device__ __forceinline__ float fadd_s(float a,float b){float r;asm("v_add_f32_e32 %0, %1, %2":"=v"(r):"v"(a),"v"(b));return r;}
__device__ __forceinline__ float fsub_s(float a,float b){float r;asm("v_sub_f32_e32 %0, %1, %2":"=v"(r):"v"(a),"v"(b));return r;}
typedef float f32x2_t __attribute__((ext_vector_type(2))); typedef __bf16 bf16x2_t __attribute__((ext_vector_type(2)));
__device__ __forceinline__ unsigned cvtpk_s(float lo,float hi){f32x2_t v={lo,hi};bf16x2_t b=__builtin_convertvector(v,bf16x2_t);return __builtin_bit_cast(unsigned,b);}
#define WAIT_BAR(N) asm volatile("s_waitcnt vmcnt(" #N ") lgkmcnt(0)\n\ts_barrier":::"memory")

__device__ __forceinline__ void qkt(f32x16&p0,f32x16&p1,const char*Kslot,const bf16x8*qr,const f32x16&negm,int r32,int hi){
  const char*kb=Kslot+hi*1024+r32*16;
  #pragma unroll
  for(int d0=0;d0<4;++d0){
    const bf16x8 b0=*reinterpret_cast<const bf16x8*>(kb+d0*2048);
    const bf16x8 b1=*reinterpret_cast<const bf16x8*>(kb+d0*2048+512);
    if(d0==0){p0=__builtin_amdgcn_mfma_f32_32x32x16_bf16(b0,qr[0],negm,0,0,0);p1=__builtin_amdgcn_mfma_f32_32x32x16_bf16(b1,qr[0],negm,0,0,0);}
    else{p0=__builtin_amdgcn_mfma_f32_32x32x16_bf16(b0,qr[d0],p0,0,0,0);p1=__builtin_amdgcn_mfma_f32_32x32x16_bf16(b1,qr[d0],p1,0,0,0);}}
}
typedef __attribute__((address_space(3))) const char* lds_cptr;
typedef short v4i16_t __attribute__((ext_vector_type(4)));
__device__ __forceinline__ void kload8(bf16x8*kf,lds_cptr kp){
  kf[0]=*(const __attribute__((address_space(3))) bf16x8*)(kp);      kf[1]=*(const __attribute__((address_space(3))) bf16x8*)(kp+512);
  kf[2]=*(const __attribute__((address_space(3))) bf16x8*)(kp+2048); kf[3]=*(const __attribute__((address_space(3))) bf16x8*)(kp+2560);
  kf[4]=*(const __attribute__((address_space(3))) bf16x8*)(kp+4096); kf[5]=*(const __attribute__((address_space(3))) bf16x8*)(kp+4608);
  kf[6]=*(const __attribute__((address_space(3))) bf16x8*)(kp+6144); kf[7]=*(const __attribute__((address_space(3))) bf16x8*)(kp+6656);
}
__device__ __forceinline__ void kload2(bf16x8*kf,lds_cptr kp,int j){ kf[2*j]=*(const __attribute__((address_space(3))) bf16x8*)(kp+j*2048); kf[2*j+1]=*(const __attribute__((address_space(3))) bf16x8*)(kp+j*2048+512); }
__device__ __forceinline__ s16x4 vtr(lds_cptr p){ return __builtin_bit_cast(s16x4,__builtin_amdgcn_ds_read_tr16_b64_v4i16((__attribute__((address_space(3))) v4i16_t*)p)); }
__device__ __forceinline__ float rowmax(const f32x16&p0,const f32x16&p1){
  float a=max3f(p0[0],p0[1],p1[0]),b=max3f(p0[2],p0[3],p1[1]);a=max3f(a,p1[2],p1[3]);
  #pragma unroll
  for(int r=4;r<16;r+=4){a=max3f(a,p0[r],p0[r+1]);b=max3f(b,p0[r+2],p0[r+3]);a=max3f(a,p1[r],p1[r+1]);b=max3f(b,p1[r+2],p1[r+3]);}
  const float m=max2f(a,b);
  auto rr=__builtin_amdgcn_permlane32_swap(__float_as_uint(m),__float_as_uint(m),false,false);
  return max2f(__uint_as_float(rr[0]),__uint_as_float(rr[1]));
}
__device__ __forceinline__ void pv(f32x16*o,int vb,bf16x8 pa0,bf16x8 pa1,bf16x8 pa2,bf16x8 pa3){
  #pragma unroll
  for(int d0=0;d0<4;++d0){s16x4 lo[4],hi[4];
    #pragma unroll
    for(int ks=0;ks<4;++ks){
      asm volatile("ds_read_b64_tr_b16 %0,%1 offset:%c2":"=&v"(lo[ks]):"v"(vb),"i"(d0*4096+ks*1024):"memory");
      asm volatile("ds_read_b64_tr_b16 %0,%1 offset:%c2":"=&v"(hi[ks]):"v"(vb),"i"(d0*4096+ks*1024+512):"memory");}
    asm volatile("s_waitcnt lgkmcnt(0)":::"memory");SBAR();
    #define PK(k) (bf16x8){lo[k][0],lo[k][1],lo[k][2],lo[k][3],hi[k][0],hi[k][1],hi[k][2],hi[k][3]}
    o[d0]=__builtin_amdgcn_mfma_f32_32x32x16_bf16(pa0,PK(0),o[d0],0,0,0);
    o[d0]=__builtin_amdgcn_mfma_f32_32x32x16_bf16(pa1,PK(1),o[d0],0,0,0);
    o[d0]=__builtin_amdgcn_mfma_f32_32x32x16_bf16(pa2,PK(2),o[d0],0,0,0);
    o[d0]=__builtin_amdgcn_mfma_f32_32x32x16_bf16(pa3,PK(3),o[d0],0,0,0);
    #undef PK
  }
}

#ifndef ATTN_STORE16
#define ATTN_STORE16(p,v) (*(u32x4*)(p)=(v))
#endif
template<int THRL> __device__ __forceinline__ void attn_unit(int qcol,int vcol,int qb,const bf16*Q,const bf16*__restrict__ K,const bf16*__restrict__ V,bf16*O,char*shm){
  const int tid=threadIdx.x,lane=tid&63,r32=lane&31,hi=lane>>5; const int wid=__builtin_amdgcn_readfirstlane(tid>>6);
  const long rowbase=0; const int q0=qb*QB;
  const bf16*Qw=Q+(rowbase+q0+wid*QBLK)*DM+qcol;
  const bf16*Kh=K+rowbase*DM+qcol,*Vh=V+rowbase*DM+vcol;
  const unsigned lds0=(unsigned)(uintptr_t)shm;
  float*wsf=(float*)(shm+LDS_WS)+wid*64;
  const bf16*ksrc=Kh+(long)lane*DM+wid*8;
  const bf16*vsrc=Vh+(long)(16*(wid&3)+(lane>>2))*DM+(wid>>2)*32+(lane&3)*8;
  const unsigned kdst=lds0+LDS_K+wid*1024, vdst=lds0+LDS_V+wid*1024;
  #define DMA_K(t,slot) glds16(ksrc+(long)(t)*KVBLK*DM,(unsigned)__builtin_amdgcn_readfirstlane(kdst+(slot)))
  #define DMA_V(t,slot) do{ glds16(vsrc+(long)(t)*KVBLK*DM,(unsigned)__builtin_amdgcn_readfirstlane(vdst+2*(slot))); glds16(vsrc+64+(long)(t)*KVBLK*DM,(unsigned)__builtin_amdgcn_readfirstlane(vdst+2*(slot)+8192)); }while(0)
  const int vb0=(int)(lds0+LDS_V)+((lane>>4)&1)*32+(lane&3)*8+(4*hi+((lane&15)>>2))*64;
  const char*Kbase=shm+LDS_K; bf16x8 kf[8];
  const lds_cptr shm3=(lds_cptr)shm; const lds_cptr kp0=shm3+LDS_K+hi*1024+r32*16; const lds_cptr vp0=shm3+LDS_V+((lane>>4)&1)*32+(lane&3)*8+(4*hi+((lane&15)>>2))*64;
  const int NT=(q0+QB)/KVBLK;
  DMA_K(0,0);DMA_V(0,0);DMA_K(1,SLOTB);
  bf16x8 qr[4];
  #pragma unroll
  for(int d0=0;d0<4;++d0)qr[d0]=*reinterpret_cast<const bf16x8*>(&Qw[(long)r32*DM+d0*16+hi*8]);
  float mhat=0.f,l_reg=0.f;f32x16 o[4];o[0]=f32x16{};o[1]=f32x16{};o[2]=f32x16{};o[3]=f32x16{};const f32x16 negm=f32x16{};
  const int qrel=wid*QBLK+r32;
  #define CMASK(P0,P1,t) do{int jb_=(t)-(NT-4); if(jb_>=0)cmask(P0,P1,jb_,wid);}while(0)
  bool resc=false;
  #define START(P0,P1) do{ const float rm=rowmax(P0,P1); resc=false; \
    { const float dl=rm; mhat=fadd_s(mhat,dl); \
      _Pragma("unroll") for(int r=0;r<16;++r){P0[r]=fsub_s(P0[r],dl);P1[r]=fsub_s(P1[r],dl);} \
      } \
    _Pragma("unroll") for(int r=0;r<16;++r)P0[r]=__builtin_amdgcn_exp2f(P0[r]); }while(0)
  #define RESC() do{ if(resc){ asm volatile("s_waitcnt lgkmcnt(0)":::"memory"); \
      _Pragma("unroll") for(int d_=0;d_<4;++d_) _Pragma("unroll") for(int r=0;r<16;++r)o[d_][r]*=wsf[crow(r,hi)]; } }while(0)
  f32x16 pA0,pA1,pB0,pB1;
  int sl_prev=0,sl_cur=0,sl_next=SLOTB;
  #define ROT() do{sl_prev=sl_cur;sl_cur=sl_next;sl_next=(sl_next==(NSLOT-1)*SLOTB)?0:sl_next+SLOTB;}while(0)
  DMA_K(2,2*SLOTB);
  WAIT_BAR(4);
  qkt(pA0,pA1,Kbase,qr,negm,r32,hi);asm volatile("s_nop 15\n\ts_nop 7":"+v"(pA0),"+v"(pA1));CMASK(pA0,pA1,0);
  START(pA0,pA1);
  _Pragma("unroll") for(int r=0;r<16;++r)pA1[r]=__builtin_amdgcn_exp2f(pA1[r]);
  WAIT_BAR(0);
  DMA_K(3,0);DMA_V(1,SLOTB);
  ROT();
  kload8(kf,kp0+sl_cur);
  WAIT_BAR(3);
  s16x4 vlo[8],vhi[8]; u32x4 pw0,pw1,pw2,pw3;
  #define PKW(P,B) cvtpk_s(P[B],P[B+1])
  #define PAF(k) __builtin_bit_cast(bf16x8,pw##k)
  #define VFR(i) (bf16x8){vlo[i][0],vlo[i][1],vlo[i][2],vlo[i][3],vhi[i][0],vhi[i][1],vhi[i][2],vhi[i][3]}
  #define PIN(x) asm volatile("":"+v"(x))
  #define MX3(a,b,c) __builtin_fmaxf(__builtin_fmaxf((a),(b)),(c))
  #define GAPA(MF,A0,A1,A2,A3,W0,W1,PW) do{ MF; sacc+=A0; sacc+=A1; sacc+=A2; sacc+=A3; PIN(sacc); W0; W1; PIN(PW); SBAR(); }while(0)
  #define EX(v) __builtin_amdgcn_exp2f(v)
  #define GAPB(MF,X,B) do{ MF; X[B]=EX(X[B]); X[B+1]=EX(X[B+1]); X[B+2]=EX(X[B+2]); X[B+3]=EX(X[B+3]); PIN(X); SBAR(); }while(0)
  #define VRD(i) do{ vlo[i]=vtr(vp_+(((i)>>2)*4096+((i)&3)*1024)); vhi[i]=vtr(vp_+(((i)>>2)*4096+((i)&3)*1024+512)); }while(0)
  #define VRD2(i) do{ vlo[i]=vtr(vp_+((2+((i)>>2))*4096+((i)&3)*1024)); vhi[i]=vtr(vp_+((2+((i)>>2))*4096+((i)&3)*1024+512)); SBAR(); }while(0)
  #define GAPB2(MF,X,B) do{ MF; X[B]=EX(X[B]-mhat); X[B+1]=EX(X[B+1]-mhat); PIN(X); SBAR(); }while(0)
  #define KRD(G,j) do{ if(G){ kload2(kf,kp0+sl_next,j); SBAR(); } }while(0)
  #define STEP(C0,C1,P0,P1,t,GK,GV,GL) do{ SBAR(); \
    const lds_cptr vp_=vp0+2*sl_prev; \
    VRD(0); SBAR(); float sacc=(P0[0]+P0[1]); \
    GAPA(C0=__builtin_amdgcn_mfma_f32_32x32x16_bf16(kf[0],qr[0],negm,0,0,0), P0[2],P0[3],P0[4],P0[5],     pw0[0]=PKW(P0,0), pw0[1]=PKW(P0,2), pw0); \
    VRD(4); SBAR(); GAPA(C1=__builtin_amdgcn_mfma_f32_32x32x16_bf16(kf[1],qr[0],negm,0,0,0), P0[6],P0[7],P0[8],P0[9],     pw0[2]=PKW(P0,4), pw0[3]=PKW(P0,6), pw0); \
    VRD(1); SBAR(); GAPA(C0=__builtin_amdgcn_mfma_f32_32x32x16_bf16(kf[2],qr[1],C0,0,0,0),   P0[10],P0[11],P0[12],P0[13], pw1[0]=PKW(P0,8), pw1[1]=PKW(P0,10), pw1); \
    VRD(5); SBAR(); GAPA(C1=__builtin_amdgcn_mfma_f32_32x32x16_bf16(kf[3],qr[1],C1,0,0,0),   P0[14],P0[15],P1[0],P1[1],   pw1[2]=PKW(P0,12),pw1[3]=PKW(P0,14), pw1); \
    GAPA(C0=__builtin_amdgcn_mfma_f32_32x32x16_bf16(kf[4],qr[2],C0,0,0,0),   P1[2],P1[3],P1[4],P1[5],     pw2[0]=PKW(P1,0), pw2[1]=PKW(P1,2), pw2); \
    GAPA(C1=__builtin_amdgcn_mfma_f32_32x32x16_bf16(kf[5],qr[2],C1,0,0,0),   P1[6],P1[7],P1[8],P1[9],     pw2[2]=PKW(P1,4), pw2[3]=PKW(P1,6), pw2); \
    GAPA(C0=__builtin_amdgcn_mfma_f32_32x32x16_bf16(kf[6],qr[3],C0,0,0,0),   P1[10],P1[11],P1[12],P1[13], pw3[0]=PKW(P1,8), pw3[1]=PKW(P1,10), pw3); \
    GAPA(C1=__builtin_amdgcn_mfma_f32_32x32x16_bf16(kf[7],qr[3],C1,0,0,0),   P1[14],P1[15],0.f,0.f,       pw3[2]=PKW(P1,12),pw3[3]=PKW(P1,14), pw3); \
    l_reg+=sacc; \
    if(GK){DMA_K((t)+3,sl_cur);} if(GV){DMA_V((t)+1,sl_next);} \
    CMASK(C0,C1,t); \
    { float a=MX3(C0[0],C0[1],C1[0]),b=MX3(C0[2],C0[3],C1[1]); a=MX3(a,C1[2],C1[3]); \
      _Pragma("unroll") for(int r=4;r<16;r+=4){a=MX3(a,C0[r],C0[r+1]);b=MX3(b,C0[r+2],C0[r+3]);a=MX3(a,C1[r],C1[r+1]);b=MX3(b,C1[r+2],C1[r+3]);} \
      float rm=__builtin_fmaxf(a,b); { auto rr=__builtin_amdgcn_permlane32_swap(__float_as_uint(rm),__float_as_uint(rm),false,false); rm=__builtin_fmaxf(__uint_as_float(rr[0]),__uint_as_float(rr[1])); } \
      resc=false; const float rmr=rm-mhat; \
      if(__builtin_expect(__any(rmr>(float)THRL),0)){ const float dl=__builtin_fmaxf(rmr,0.f); mhat+=dl; \
        const float f=__builtin_amdgcn_exp2f(-dl); l_reg*=f; if(hi==0)wsf[r32]=f; resc=true; } } \
    SBAR(); \
    VRD(2); SBAR(); GAPB2(o[0]=__builtin_amdgcn_mfma_f32_32x32x16_bf16(PAF(0),VFR(0),o[0],0,0,0), C0,0); \
    VRD(6); SBAR(); GAPB2(o[1]=__builtin_amdgcn_mfma_f32_32x32x16_bf16(PAF(0),VFR(4),o[1],0,0,0), C0,2); \
    VRD(3); SBAR(); GAPB2(o[0]=__builtin_amdgcn_mfma_f32_32x32x16_bf16(PAF(1),VFR(1),o[0],0,0,0), C0,4); \
    VRD(7); SBAR(); GAPB2(o[1]=__builtin_amdgcn_mfma_f32_32x32x16_bf16(PAF(1),VFR(5),o[1],0,0,0), C0,6); \
    VRD2(0); GAPB2(o[0]=__builtin_amdgcn_mfma_f32_32x32x16_bf16(PAF(2),VFR(2),o[0],0,0,0), C0,8); \
    VRD2(4); GAPB2(o[1]=__builtin_amdgcn_mfma_f32_32x32x16_bf16(PAF(2),VFR(6),o[1],0,0,0), C0,10); \
    VRD2(1); GAPB2(o[0]=__builtin_amdgcn_mfma_f32_32x32x16_bf16(PAF(3),VFR(3),o[0],0,0,0), C0,12); \
    VRD2(5); GAPB2(o[1]=__builtin_amdgcn_mfma_f32_32x32x16_bf16(PAF(3),VFR(7),o[1],0,0,0), C0,14); \
    VRD2(2); GAPB2(o[2]=__builtin_amdgcn_mfma_f32_32x32x16_bf16(PAF(0),VFR(0),o[2],0,0,0), C1,0); \
    VRD2(6); GAPB2(o[3]=__builtin_amdgcn_mfma_f32_32x32x16_bf16(PAF(0),VFR(4),o[3],0,0,0), C1,2); \
    VRD2(3); KRD(GL,0); GAPB2(o[2]=__builtin_amdgcn_mfma_f32_32x32x16_bf16(PAF(1),VFR(1),o[2],0,0,0), C1,4); \
    VRD2(7); KRD(GL,1); GAPB2(o[3]=__builtin_amdgcn_mfma_f32_32x32x16_bf16(PAF(1),VFR(5),o[3],0,0,0), C1,6); \
    KRD(GL,2); GAPB2(o[2]=__builtin_amdgcn_mfma_f32_32x32x16_bf16(PAF(2),VFR(2),o[2],0,0,0), C1,8); \
    KRD(GL,3); GAPB2(o[3]=__builtin_amdgcn_mfma_f32_32x32x16_bf16(PAF(2),VFR(6),o[3],0,0,0), C1,10); \
    GAPB2(o[2]=__builtin_amdgcn_mfma_f32_32x32x16_bf16(PAF(3),VFR(3),o[2],0,0,0), C1,12); \
    GAPB2(o[3]=__builtin_amdgcn_mfma_f32_32x32x16_bf16(PAF(3),VFR(7),o[3],0,0,0), C1,14); \
    }while(0)
  int t=1;
  #undef CMASK
  #define CMASK(P0,P1,t) do{}while(0)
  for(;t+5<NT;t+=2){
    STEP(pB0,pB1,pA0,pA1,t,true,true,true);     WAIT_BAR(3); RESC(); ROT();
    STEP(pA0,pA1,pB0,pB1,t+1,true,true,true);   WAIT_BAR(3); RESC(); ROT();
  }
  #undef CMASK
  #define CMASK(P0,P1,t) do{int jb_=(t)-(NT-4); if(jb_>=0)cmask(P0,P1,jb_,wid);}while(0)
  #define ENDW(tt) do{ if((tt)+3<NT){WAIT_BAR(3);} else if((tt)+2<NT){WAIT_BAR(2);} else {WAIT_BAR(0);} }while(0)
  for(;t+1<NT;t+=2){
    STEP(pB0,pB1,pA0,pA1,t,(t+3<NT),(t+1<NT),(t+1<NT));       ENDW(t);   RESC(); ROT();
    STEP(pA0,pA1,pB0,pB1,t+1,(t+4<NT),(t+2<NT),(t+2<NT));     ENDW(t+1); RESC(); ROT();
  }
  STEP(pB0,pB1,pA0,pA1,NT-1,false,false,false); RESC();
  { float sacc=pB0[0]+pB0[1]; _Pragma("unroll") for(int r=2;r<16;++r)sacc+=pB0[r]; _Pragma("unroll") for(int r=0;r<16;++r)sacc+=pB1[r]; l_reg+=sacc;
    pw0=(u32x4){PKW(pB0,0),PKW(pB0,2),PKW(pB0,4),PKW(pB0,6)};pw1=(u32x4){PKW(pB0,8),PKW(pB0,10),PKW(pB0,12),PKW(pB0,14)};pw2=(u32x4){PKW(pB1,0),PKW(pB1,2),PKW(pB1,4),PKW(pB1,6)};pw3=(u32x4){PKW(pB1,8),PKW(pB1,10),PKW(pB1,12),PKW(pB1,14)};
    SBAR(); pv(o,vb0+2*sl_cur,PAF(0),PAF(1),PAF(2),PAF(3)); }
  #undef PKW
  #undef PAF
  #undef VFR
  #undef PIN
  #undef MX3
  #undef GAPA
  #undef GAPB
  #undef GAPB2
  #undef VRD2
  #undef EX
  #undef VRD
  #undef KRD
  #undef STEP
  #undef ENDW
  {auto rr=__builtin_amdgcn_permlane32_swap(__float_as_uint(l_reg),__float_as_uint(l_reg),false,false);l_reg=__uint_as_float(rr[0])+__uint_as_float(rr[1]);}
  if(hi==0)wsf[32+r32]=l_reg;asm volatile("s_waitcnt lgkmcnt(0)":::"memory");
  float rli[16];
  #pragma unroll
  for(int r=0;r<16;++r)rli[r]=__builtin_amdgcn_rcpf(wsf[32+crow(r,hi)]);
  bf16*Ow=O+(rowbase+q0+wid*QBLK)*DM+vcol;
  { bf16*stg=(bf16*)(shm+LDS_OST)+wid*2048;
    #pragma unroll
    for(int hf=0;hf<2;++hf){
    #pragma unroll
    for(int r=0;r<16;++r){const int orow=crow(r,hi);
      #pragma unroll
      for(int d0=0;d0<2;++d0)stg[orow*64+d0*32+r32]=__float2bfloat16(o[2*hf+d0][r]*rli[r]);}
    asm volatile("s_waitcnt lgkmcnt(0)":::"memory");
    #pragma unroll
    for(int i=0;i<4;++i){const int row=i*8+(lane>>3),ch=lane&7; const u32x4 v=*(const u32x4*)(stg+row*64+ch*8); ATTN_STORE16(Ow+(long)row*DM+hf*64+ch*8,v);}
    asm volatile("s_waitcnt lgkmcnt(0)":::"memory"); } }
  asm volatile("s_waitcnt lgkmcnt(0)\n\ts_barrier":::"memory");
  #undef DMA_K
  #undef DMA_V
  #undef CMASK
  #undef START
  #undef RESC
  #undef ROT
}
constexpr int ATTN_LDS_BYTES=LDS_BYTES;
struct AttnTensors { const bf16* Q; const bf16* K; const bf16* V; bf16* O; };
struct AttnUnit { int var; int qb; };
struct StaticOrder {
  int vcu;
  __device__ __forceinline__ explicit StaticOrder(int v):vcu(v){}
  __device__ __forceinline__ bool next(int i,AttnUnit&u)const{ if(i>=2)return false; const int s=vcu&31; u.var=vcu>>5; u.qb=(i==0)?s:63-s; return true; }
};
template<class Sched,int THRL=8> __device__ __forceinline__ void attn_phase(char*lds,const AttnTensors&T,const Sched&S){
  AttnUnit u;
  for(int i=0;S.next(i,u);++i){ const int h=u.var>>1,mp=u.var&1;
    attn_unit<THRL>(h*128+mp*64,h*128,u.qb,T.Q,T.K,T.V,T.O+(size_t)mp*SEQ*DM,lds); }
}
#undef SBAR
#undef WAIT_BAR
}


#define GAS __attribute__((address_space(1)))
#define LAS __attribute__((address_space(3)))
typedef unsigned short bf16;
typedef unsigned v4u __attribute__((ext_vector_type(4)));
typedef float f32x4 __attribute__((ext_vector_type(4)));
typedef short bf16x8 __attribute__((ext_vector_type(8)));
typedef GAS unsigned gu32;
typedef GAS unsigned long long gu64;
#define RLX_AGENT __ATOMIC_RELAXED, __HIP_MEMORY_SCOPE_AGENT
#define LDS_WAIT() asm volatile("s_waitcnt lgkmcnt(0)" ::: "memory")
#define VM_WAIT() asm volatile("s_waitcnt vmcnt(0)" ::: "memory")
__device__ __forceinline__ unsigned long long rt() { return __builtin_amdgcn_s_memrealtime(); }
__device__ __forceinline__ unsigned f2bf(float f) { unsigned u = __builtin_bit_cast(unsigned, f); return (u + 0x7fffu + ((u >> 16) & 1u)) >> 16; }
__device__ __forceinline__ unsigned pk2(float lo, float hi) { return f2bf(lo) | (f2bf(hi) << 16); }

#define XB_TMO      128
#define XB_XCNT(j)  (256  + 64 * (j))
#define XB_XSUB(j)  (1280 + 64 * (j))
#define XB_XGEN(j)  (2304 + 64 * (j))
#define XB_TOP      3328
#define XB_TOPGEN   3392
#define XCD_BAR_WORDS 3456
#define XB_SPIN_CAP (1u << 18)

__device__ __forceinline__ unsigned xb_ld(unsigned* p)              { return __hip_atomic_load(p, __ATOMIC_RELAXED, __HIP_MEMORY_SCOPE_AGENT); }
__device__ __forceinline__ unsigned xb_add(unsigned* p, unsigned v) { return __hip_atomic_fetch_add(p, v, __ATOMIC_RELAXED, __HIP_MEMORY_SCOPE_AGENT); }
__device__ __forceinline__ unsigned xb_xcc_id() { return (unsigned)__builtin_amdgcn_s_getreg((3 << 11) | 20) & 0xFu; }
#define XB_SPIN(cond, bar) do { unsigned _sp = 0; while (cond) { __builtin_amdgcn_s_sleep(1); \
    if ((++_sp & 255u) == 0u) { if (xb_ld(&(bar)[XB_TMO])) break; if (_sp > XB_SPIN_CAP) { atomicAdd(&(bar)[XB_TMO], 1u); break; } } } } while (0)

struct XcdBarrier {
    unsigned* bar; unsigned x;
    volatile LAS unsigned* st;
};

__device__ __forceinline__ XcdBarrier xcd_barrier_post(unsigned* bar, volatile LAS unsigned* st) {
    XcdBarrier b; b.bar = bar; b.x = xb_xcc_id(); b.st = st;
    if (threadIdx.x == 0) (void)xb_add(&bar[XB_XCNT(b.x)], 1u);
    return b;
}
__device__ __forceinline__ void xcd_barrier_complete(unsigned* bar, unsigned x, unsigned& nloc, unsigned& nx) {
    const unsigned G = gridDim.x * gridDim.y * gridDim.z;
    unsigned sum, cnt, mine, sp = 0u;
    for (;;) {
        sum = 0u; cnt = 0u; mine = 0u;
#pragma unroll
        for (unsigned j = 0; j < 16; ++j) { const unsigned c = xb_ld(&bar[XB_XCNT(j)]); sum += c; cnt += (c > 0u) ? 1u : 0u; mine = (j == x) ? c : mine; }
        if (sum == G) break;
        __builtin_amdgcn_s_sleep(1);
        if ((++sp & 255u) == 0u) { if (xb_ld(&bar[XB_TMO])) break; if (sp > XB_SPIN_CAP) { atomicAdd(&bar[XB_TMO], 1u); break; } }
    }
    nloc = mine > 0u ? mine : 1u; nx = cnt > 0u ? cnt : 1u;
}

__device__ __forceinline__ void xcd_barrier(const XcdBarrier& b) {
    asm volatile("s_waitcnt vmcnt(0)" ::: "memory");
    __syncthreads();
    if (threadIdx.x == 0) {
        unsigned* bar = b.bar;
        __builtin_amdgcn_s_waitcnt(0);
        unsigned nloc = b.st[0], nx = b.st[1];
        if (nloc == 0u) { xcd_barrier_complete(bar, b.x, nloc, nx); b.st[0] = nloc; b.st[1] = nx; }
        const unsigned old = xb_add(&bar[XB_XSUB(b.x)], 1u);
        const unsigned gen = old / nloc;
        if (old + 1u == (gen + 1u) * nloc) {
            __builtin_amdgcn_fence(__ATOMIC_RELEASE, "agent");
            asm volatile("s_waitcnt vmcnt(0)" ::: "memory");
            const unsigned og = xb_add(&bar[XB_TOP], 1u);
            const unsigned tg = og / nx;
            if (og + 1u == (tg + 1u) * nx) xb_add(&bar[XB_TOPGEN], 1u);
            else XB_SPIN(xb_ld(&bar[XB_TOPGEN]) == tg, bar);
            __builtin_amdgcn_fence(__ATOMIC_ACQUIRE, "agent");
            xb_add(&bar[XB_XGEN(b.x)], 1u);
            asm volatile("s_waitcnt vmcnt(0)" ::: "memory");
        } else {
            XB_SPIN(xb_ld(&bar[XB_XGEN(b.x)]) == gen, bar);
            __builtin_amdgcn_fence(__ATOMIC_ACQUIRE, "agent");
            asm volatile("s_waitcnt vmcnt(0)" ::: "memory");
        }
    }
    __syncthreads();
}

constexpr int NWAVES = 8;
constexpr int M = 16384, D = 1024, INC = 2560, AW = 512, LW = 512, NQ = 2048, NEXP = 16384;
constexpr float EPSN = 1e-6f;
constexpr size_t MiB = 1u << 20;
constexpr size_t WS_CTL = 0, CTL_ZERO_BYTES = 1 * MiB;
constexpr size_t WS_ROWSS2 = 512 * 1024;
constexpr size_t WS_RS1 = 1 * MiB;
constexpr size_t WS_SK1 = 1 * MiB + 128 * 1024, WS_SK2 = WS_SK1 + 32 * 1024;
constexpr size_t WS_WGF = 1 * MiB + 256 * 1024;
constexpr size_t WS_WIN = 2 * MiB, WS_WOUT = 8 * MiB, WS_WQ = 10 * MiB;
constexpr size_t WS_ED = 16 * MiB, WS_EU = 48 * MiB;
constexpr size_t WS_SCD = 32 * MiB, WS_SCU = 33 * MiB;
constexpr size_t WS_WQ8 = 170 * MiB;
constexpr size_t WS_XB = 80 * MiB;
constexpr size_t WS_CARRY = 34 * MiB;
constexpr size_t WS_Q2 = 80 * MiB;
constexpr size_t WS_Q = 112 * MiB, WS_SPLIT = 16 * MiB;
constexpr size_t WS_GATE = WS_Q + 4 * WS_SPLIT;
constexpr size_t WS_EID = 144 * MiB, WS_GW = 152 * MiB;
constexpr size_t WS_MIX = 192 * MiB, WS_HB = 224 * MiB, WS_END = 256 * MiB;
constexpr size_t WS_ROWSS3 = 576 * 1024;
constexpr size_t WS_DOTP = 80 * MiB;
constexpr size_t WS_REC = 160 * MiB, WS_N0 = 168 * MiB;
constexpr size_t WS_PEER = 80 * MiB;
constexpr size_t WS_REC_OLD_UNUSED = 0;
constexpr int CW_BAR = 4096;
constexpr int RING_OFF = 0, RING_BYTES = 131072;
constexpr int LDSCTL_OFF = RING_BYTES, MISC_OFF = LDSCTL_OFF + 320;
constexpr int LDS_BYTES = 163840;

struct Frame {
    LAS unsigned char* lds;
    volatile LAS unsigned* MISC;
    int tid, lane, wave;
    int vcu, G;
};

__device__ __forceinline__ float wave_sum(float v) {
#pragma unroll
    for (int o = 1; o < 64; o <<= 1) v += __shfl_xor(v, o);
    return v;
}
__device__ __forceinline__ float bf2f(unsigned short b) { return __builtin_bit_cast(float, (unsigned)b << 16); }
__device__ __forceinline__ float bflo(unsigned w) { return __builtin_bit_cast(float, w << 16); }
__device__ __forceinline__ float bfhi(unsigned w) { return __builtin_bit_cast(float, w & 0xffff0000u); }
__device__ __forceinline__ float gelu_tanh(float x) { const float u = 0.7978845608028654f * (x + 0.044715f * x * x * x); return 0.5f * x * (1.0f + tanhf(u)); }
__device__ __forceinline__ float sigmoidf_(float x) { return 1.0f / (1.0f + expf(-x)); }
__device__ __forceinline__ float fsigmoid(float x) { return __builtin_amdgcn_rcpf(1.0f + __builtin_amdgcn_exp2f(-1.4426950408889634f * x)); }
__device__ __forceinline__ float fgelu_tanh(float x) { const float u = 0.7978845608028654f * (x + 0.044715f * x * x * x); const float t = 1.0f - 2.0f * __builtin_amdgcn_rcpf(1.0f + __builtin_amdgcn_exp2f(2.8853900817779268f * u)); return 0.5f * x * (1.0f + t); }

__device__ __forceinline__ void p0_transpose_item(const float* W, int K, int N, bf16* WT, const float* gk, LAS float* scr, int item, int lane) {
    const int nblk = N / 32, kb = item / nblk, nb = item % nblk, k0 = 64 * kb, n0 = 32 * nb;
    float wv[32];
#pragma unroll
    for (int i = 0; i < 32; ++i) { const int kk = 2 * i + (lane >> 5); wv[i] = W[(size_t)(k0 + kk) * N + n0 + (lane & 31)]; }
#pragma unroll
    for (int i = 0; i < 32; ++i) { const int kk = 2 * i + (lane >> 5); const float g = gk ? gk[k0 + kk] : 1.0f; scr[kk * 33 + (lane & 31)] = wv[i] * g; }
    LDS_WAIT(); asm volatile("" ::: "memory");
    const int c = lane & 7;
#pragma unroll
    for (int j = 0; j < 4; ++j) { const int n = (lane >> 3) + 8 * j; const LAS float* s = scr + (8 * c) * 33 + n;
        v4u o; o.x = pk2(s[0 * 33], s[1 * 33]); o.y = pk2(s[2 * 33], s[3 * 33]); o.z = pk2(s[4 * 33], s[5 * 33]); o.w = pk2(s[6 * 33], s[7 * 33]);
        *(GAS v4u*)(WT + (size_t)(n0 + n) * K + k0 + 8 * c) = o; }
    LDS_WAIT(); asm volatile("" ::: "memory");
}
template <int NR> __device__ __forceinline__ void p0_rows(const float* xrow, bf16* orow, const float* gk, float* rs, int lane) {
    f32x4 v[NR][4];
#pragma unroll
    for (int i = 0; i < NR; ++i)
#pragma unroll
        for (int j = 0; j < 4; ++j) v[i][j] = __builtin_nontemporal_load((const GAS f32x4*)(xrow + (size_t)i * 1024) + lane + 64 * j);
#pragma unroll
    for (int i = 0; i < NR; ++i) {
        if (rs) { float s = 0.f;
#pragma unroll
            for (int j = 0; j < 4; ++j) s += (v[i][j].x * v[i][j].x + v[i][j].y * v[i][j].y) + (v[i][j].z * v[i][j].z + v[i][j].w * v[i][j].w);
            const float tot = wave_sum(s); if (lane == 0) rs[i] = 1.0f / sqrtf(tot * (1.0f / 1024.0f) + EPSN); }
        if (gk) {
#pragma unroll
            for (int j = 0; j < 4; ++j) v[i][j] = v[i][j] * ((const GAS f32x4*)gk)[lane + 64 * j]; }
        GAS unsigned long long* o8 = (GAS unsigned long long*)(orow + (size_t)i * 1024) + lane;
#pragma unroll
        for (int j = 0; j < 4; ++j) o8[64 * j] = (unsigned long long)pk2(v[i][j].x, v[i][j].y) | ((unsigned long long)pk2(v[i][j].z, v[i][j].w) << 32);
    }
}

struct Args { const float* in[23]; float* out; unsigned char* ws; int ph_lo, ph_hi; };

__device__ __forceinline__ void p0_prologue(Frame& F, const Args& a) {
    LAS float* scr = (LAS float*)(F.lds + RING_OFF + F.wave * 16384);
    unsigned char* ws = a.ws;
    const int gw = F.vcu * NWAVES + F.wave, NGW = F.G * NWAVES;
    constexpr int I_IN = (D / 64) * (INC / 32), I_OUT = (D / 64) * (D / 32), I_Q = (D / 64) * (NQ / 32);
    constexpr int NITEMS = I_IN + I_OUT + I_Q;
    for (int it = F.wave * (int)F.G + F.vcu; it < NITEMS; it += NGW) {
        int r = it;
        if (r < I_IN) { p0_transpose_item(a.in[2], D, INC, (bf16*)(ws + WS_WIN), a.in[1], scr, r, F.lane); continue; } r -= I_IN;
        if (r < I_OUT) { p0_transpose_item(a.in[15], D, D, (bf16*)(ws + WS_WOUT), nullptr, scr, r, F.lane); continue; } r -= I_OUT;
        p0_transpose_item(a.in[17], D, NQ, (bf16*)(ws + WS_WQ), a.in[16], scr, r, F.lane);
    }
    for (int i = (F.wave * (int)F.G + F.vcu) * 64 + F.lane; i < 8192; i += NGW * 64) {
        const int ln = i & 63, ks = (i >> 6) & 3, et = (i >> 8) & 1, n = (i >> 9) & 7, gt = i >> 12, r32 = ln & 31, hi = ln >> 5;
        const float* w = a.in[gt ? 12 : 10] + n * 4096 + 32 * et + (16 * ks + 8 * hi) * 64 + r32;
        *(GAS v4u*)(ws + WS_WGF + (size_t)i * 16) = (v4u){pk2(w[0], w[64]), pk2(w[128], w[192]), pk2(w[256], w[320]), pk2(w[384], w[448])}; }
    for (int m = gw; m < M / 8; m += NGW) { const int r = 8 * m; p0_rows<8>(a.in[0] + (size_t)r * D, (bf16*)(ws + WS_XB) + (size_t)r * D, nullptr, (float*)(ws + WS_RS1) + r, F.lane); }
    for (int m = F.wave * (int)F.G + F.vcu; m < 8; m += NGW) { const int r = 4 * m;
        if (r < 16) p0_rows<4>(a.in[18] + (size_t)r * 1024, (bf16*)(ws + WS_SK1) + (size_t)r * 1024, nullptr, nullptr, F.lane);
        else        p0_rows<4>(a.in[19] + (size_t)(r - 16) * 1024, (bf16*)(ws + WS_SK2) + (size_t)(r - 16) * 1024, nullptr, nullptr, F.lane); }
}
template <int NR> __device__ __forceinline__ void q8_load(f32x4 (&v)[NR][4], const float* xrow, int lane) {
#pragma unroll
    for (int i = 0; i < NR; ++i)
#pragma unroll
        for (int j = 0; j < 4; ++j) v[i][j] = __builtin_nontemporal_load((const GAS f32x4*)(xrow + (size_t)i * 1024) + lane + 64 * j);
}
template <int NR> __device__ __forceinline__ void q8_finish(f32x4 (&v)[NR][4], unsigned char* orow, const float* gk, float* scale, int lane) {
#pragma unroll
    for (int i = 0; i < NR; ++i) {
        float am = 0.f;
#pragma unroll
        for (int j = 0; j < 4; ++j) { if (gk) v[i][j] = v[i][j] * ((const GAS f32x4*)gk)[lane + 64 * j];
            am = fmaxf(fmaxf(am, fmaxf(fabsf(v[i][j].x), fabsf(v[i][j].y))), fmaxf(fabsf(v[i][j].z), fabsf(v[i][j].w))); }
#pragma unroll
        for (int o = 1; o < 64; o <<= 1) am = fmaxf(am, __shfl_xor(am, o));
        const float sc = (am > 0.f) ? am * (1.0f / 127.0f) : 1.0f, inv = 1.0f / sc;
        if (lane == 0) scale[i] = sc;
        GAS unsigned* o4 = (GAS unsigned*)(orow + (size_t)i * 128 + (size_t)(lane >> 5) * ((size_t)NEXP * 128)) + (lane & 31);
#pragma unroll
        for (int j = 0; j < 4; ++j) { const int q0 = (int)__builtin_rintf(v[i][j].x * inv), q1 = (int)__builtin_rintf(v[i][j].y * inv), q2 = (int)__builtin_rintf(v[i][j].z * inv), q3 = (int)__builtin_rintf(v[i][j].w * inv);
            o4[(size_t)j * (2 * (size_t)NEXP * 128 / 4)] = ((unsigned)q0 & 255u) | (((unsigned)q1 & 255u) << 8) | (((unsigned)q2 & 255u) << 16) | ((unsigned)q3 << 24); }
    }
}
__device__ __forceinline__ const float* cvx_src(const Args& a, int m) { const int r = 4 * m; return (r < NEXP) ? a.in[20] + (size_t)r * D : a.in[21] + (size_t)(r - NEXP) * D; }
__device__ __forceinline__ void cvx_finish(const Args& a, f32x4 (&v)[4][4], int m, int lane) {
    unsigned char* ws = a.ws; const int r = 4 * m;
    if (r < NEXP) q8_finish<4>(v, ws + WS_ED + (size_t)r * 128, a.in[16], (float*)(ws + WS_SCD) + r, lane);
    else          q8_finish<4>(v, ws + WS_EU + (size_t)(r - NEXP) * 128, nullptr, (float*)(ws + WS_SCU) + (r - NEXP), lane);
}
__device__ __forceinline__ void convert_experts(const Args& a, int w, int nw, int lane) {
    constexpr int TOT = NEXP / 4;
    int m = w; if (m >= TOT) return;
    f32x4 va[4][4], vb[4][4];
    q8_load<4>(va, cvx_src(a, m), lane);
    for (;;) {
        const bool hb = m + nw < TOT; if (hb) q8_load<4>(vb, cvx_src(a, m + nw), lane);
        cvx_finish(a, va, m, lane);
        if (!hb) break;
        const bool ha = m + 2 * nw < TOT; if (ha) q8_load<4>(va, cvx_src(a, m + 2 * nw), lane);
        cvx_finish(a, vb, m + nw, lane);
        if (!ha) break;
        m += 2 * nw;
    }
}

typedef float f32x16 __attribute__((ext_vector_type(16)));
typedef float f32x2 __attribute__((ext_vector_type(2)));
__device__ __forceinline__ void lru_local_unit(Frame& F, const Args& a, int c) {
    constexpr int YP = 520;
    LAS unsigned short* Y = (LAS unsigned short*)(F.lds + RING_OFF);
    const int e = F.tid, r0 = c * 64;
    const bf16* XR = (const bf16*)(a.ws + WS_Q + 3 * WS_SPLIT);
    unsigned* HLAC = (unsigned*)a.out;
    float* CH = (float*)(a.ws + WS_CARRY); float* CA = CH + (size_t)(M / 64) * 512;
    {
        const int p = F.tid & 255, hh = F.tid >> 8; const float* conv_w = a.in[8];
        const f32x2 c0 = *(const GAS f32x2*)(conv_w + 2 * p), c1 = *(const GAS f32x2*)(conv_w + 512 + 2 * p), c2 = *(const GAS f32x2*)(conv_w + 1024 + 2 * p), c3 = *(const GAS f32x2*)(conv_w + 1536 + 2 * p), cb = *(const GAS f32x2*)(a.in[9] + 2 * p);
        unsigned xv[35];
        const int rb = r0 + 32 * hh - 3;
#pragma unroll
        for (int i = 0; i < 35; ++i) xv[i] = (rb + i >= 0) ? *(const GAS unsigned*)(XR + (size_t)(rb + i) * 512 + 2 * p) : 0u;
#pragma unroll
        for (int i = 0; i < 32; ++i) {
            const float lo = cb.x + bflo(xv[i]) * c0.x + bflo(xv[i + 1]) * c1.x + bflo(xv[i + 2]) * c2.x + bflo(xv[i + 3]) * c3.x;
            const float hi2 = cb.y + bfhi(xv[i]) * c0.y + bfhi(xv[i + 1]) * c1.y + bfhi(xv[i + 2]) * c2.y + bfhi(xv[i + 3]) * c3.y;
            *(LAS unsigned*)(Y + (32 * hh + i) * YP + 2 * p) = pk2(lo, hi2); } }
    __syncthreads();
    const int n = F.wave, lane = F.lane, r32 = lane & 31, hi = lane >> 5;
#pragma unroll 1
    for (int et = 0; et < 2; ++et) {
        bf16x8 wf[2][4];
#pragma unroll
        for (int gt = 0; gt < 2; ++gt)
#pragma unroll
            for (int ks = 0; ks < 4; ++ks) wf[gt][ks] = *(const GAS bf16x8*)(a.ws + WS_WGF + (size_t)(((((gt * 8 + n) * 2 + et) * 4 + ks) * 64 + lane) * 16));
        const int ch = 64 * n + 32 * et + r32;
        const float ba = a.in[11][ch], bx = a.in[13][ch], lam = a.in[14][ch];
        const float sp = (lam > 15.f) ? expf(-lam) : log1pf(expf(-lam));
        float av[2][16], bv[2][16];
#pragma unroll
        for (int tt = 0; tt < 2; ++tt) {
            f32x16 ra = {}, ia = {};
#pragma unroll
            for (int ks = 0; ks < 4; ++ks) { const bf16x8 af = *(const LAS bf16x8*)(Y + (32 * tt + r32) * YP + 64 * n + 16 * ks + 8 * hi);
                ra = __builtin_amdgcn_mfma_f32_32x32x16_bf16(af, wf[0][ks], ra, 0, 0, 0); ia = __builtin_amdgcn_mfma_f32_32x32x16_bf16(af, wf[1][ks], ia, 0, 0, 0); }
#pragma unroll
            for (int r = 0; r < 16; ++r) { const int t = 32 * tt + (r & 3) + 8 * (r >> 2) + 4 * hi;
                const float rr = fsigmoid(ra[r] + ba), ii = fsigmoid(ia[r] + bx);
                const float log_a = -8.0f * rr * sp, aa = __builtin_amdgcn_exp2f(log_a * 1.4426950408889634f);
                const float u2 = 2.0f * log_a;
                const float ser = -u2 * (1.0f + u2 * (0.5f + u2 * (0.16666667f + u2 * (0.041666668f + u2 * 0.0083333338f))));
                const float om = (u2 > -0.1f) ? ser : (1.0f - aa * aa);
                const float mult = __builtin_amdgcn_sqrtf(fmaxf(om, 1e-12f));
                av[tt][r] = aa; bv[tt][r] = mult * (ii * bf2f(Y[t * YP + ch])); }
        }
#pragma unroll
        for (int tt = 0; tt < 2; ++tt)
#pragma unroll
            for (int rq = 0; rq < 4; ++rq) { float h = 0.f, pa = 1.f;
#pragma unroll
                for (int k = 0; k < 4; ++k) { const int r = 4 * rq + k; h = av[tt][r] * h + bv[tt][r]; pa *= av[tt][r]; bv[tt][r] = h; av[tt][r] = pa; } }
        float hin[8], ain[8]; float hc = 0.f, ac = 1.f;
#pragma unroll
        for (int j = 0; j < 8; ++j) { const int tt = j >> 2, r3 = 4 * (j & 3) + 3;
#pragma unroll
            for (int own = 0; own < 2; ++own) {
                if (hi == own) { hin[j] = hc; ain[j] = ac; }
                const float mh = av[tt][r3] * hc + bv[tt][r3], ma = ac * av[tt][r3];
                const float oh = __shfl_xor(mh, 32), oa = __shfl_xor(ma, 32);
                hc = (hi == own) ? mh : oh; ac = (hi == own) ? ma : oa; } }
#pragma unroll
        for (int tt = 0; tt < 2; ++tt)
            { unsigned ob = (unsigned)((r0 + 32 * tt + 4 * hi) * 512 + ch); asm volatile("" : "+v"(ob));
#pragma unroll
            for (int r = 0; r < 16; ++r) { const int j = 4 * tt + (r >> 2); const unsigned o = ob + (unsigned)(((r & 3) + 8 * (r >> 2)) * 512);
                const float hl = bv[tt][r] + av[tt][r] * hin[j], ac = av[tt][r] * ain[j];
                HLAC[o] = pk2(hl, ac);
                if (tt == 1 && r == 15 && hi == 1) { CH[c * 512 + ch] = hl; CA[c * 512 + ch] = ac; } } }
    }
    __syncthreads();
}

__device__ __forceinline__ void fix_unit(Frame& F, const Args& a, int c, float lamv) {
    const int r0 = c * 64;
    const unsigned* HLAC = (const unsigned*)a.out; const float* CH = (const float*)(a.ws + WS_CARRY); const float* CA = CH + (size_t)(M / 64) * 512;
    const bf16* GATE = (const bf16*)(a.ws + WS_GATE);
    bf16* MIX = (bf16*)(a.ws + WS_MIX);
    const int g4 = F.tid & 127, sgm = F.tid >> 7;
    LAS f32x4* SA = (LAS f32x4*)(F.lds + RING_OFF); LAS f32x4* SH = SA + 512;
    { const int L = (c + 3) >> 2; const int lo_c = sgm * L; int hi_c = lo_c + L; if (hi_c > c) hi_c = c;
      f32x4 A4 = (f32x4){1.f, 1.f, 1.f, 1.f}, H4 = (f32x4){0.f, 0.f, 0.f, 0.f};
      int cc = lo_c;
      for (; cc + 8 <= hi_c; cc += 8) { f32x4 av[8], hv[8];
#pragma unroll
          for (int k = 0; k < 8; ++k) { const size_t o = (size_t)(cc + k) * 512 + 4 * g4; av[k] = *(const GAS f32x4*)(CA + o); hv[k] = *(const GAS f32x4*)(CH + o); }
#pragma unroll
          for (int k = 0; k < 8; ++k) { H4 = av[k] * H4 + hv[k]; A4 = A4 * av[k]; } }
      for (; cc < hi_c; ++cc) { const size_t o = (size_t)cc * 512 + 4 * g4; const f32x4 av = *(const GAS f32x4*)(CA + o), hv = *(const GAS f32x4*)(CH + o); H4 = av * H4 + hv; A4 = A4 * av; }
      SA[sgm * 128 + g4] = A4; SH[sgm * 128 + g4] = H4; }
    __syncthreads();
    f32x4 hin = (f32x4){0.f, 0.f, 0.f, 0.f};
#pragma unroll
    for (int sq = 0; sq < 4; ++sq) hin = SA[sq * 128 + g4] * hin + SH[sq * 128 + g4];
    __syncthreads();
#pragma unroll 4
    for (int t = sgm * 16; t < sgm * 16 + 16; ++t) { const size_t o = (size_t)(r0 + t) * 512 + 4 * g4;
        const v4u ha = *(const GAS v4u*)(HLAC + o);
        const f32x4 h = (f32x4){bflo(ha.x), bflo(ha.y), bflo(ha.z), bflo(ha.w)} + (f32x4){bfhi(ha.x), bfhi(ha.y), bfhi(ha.z), bfhi(ha.w)} * hin; const unsigned long long gw = *(const GAS unsigned long long*)(GATE + o);
        const unsigned glo = (unsigned)gw, ghi = (unsigned)(gw >> 32);
        const unsigned long long ov = (unsigned long long)pk2(h.x * fgelu_tanh(bflo(glo)), h.y * fgelu_tanh(bfhi(glo))) | ((unsigned long long)pk2(h.z * fgelu_tanh(bflo(ghi)), h.w * fgelu_tanh(bfhi(ghi))) << 32);
        *(GAS unsigned long long*)(MIX + (size_t)(r0 + t) * 1024 + 512 + 4 * g4) = ov; }
    const bf16* OS0 = (const bf16*)(a.out + (size_t)M * 512); const bf16* OS1 = OS0 + (size_t)M * 512;
    const float* sg = a.in[7] + (F.lane & 15) * 8;
    float sgv[8];
#pragma unroll
    for (int j = 0; j < 8; ++j) sgv[j] = sg[j] * 0.8f;
#pragma unroll 2
    for (int rr = 0; rr < 8; ++rr) { const size_t row = (size_t)(r0 + 8 * F.wave + rr);
        const v4u p = *(const GAS v4u*)(OS0 + row * 512 + F.lane * 8), q = *(const GAS v4u*)(OS1 + row * 512 + F.lane * 8);
        float d[8];
        d[0] = bflo(p.x) - lamv * bflo(q.x); d[1] = bfhi(p.x) - lamv * bfhi(q.x); d[2] = bflo(p.y) - lamv * bflo(q.y); d[3] = bfhi(p.y) - lamv * bfhi(q.y);
        d[4] = bflo(p.z) - lamv * bflo(q.z); d[5] = bfhi(p.z) - lamv * bfhi(q.z); d[6] = bflo(p.w) - lamv * bflo(q.w); d[7] = bfhi(p.w) - lamv * bfhi(q.w);
        float ss = 0.f;
#pragma unroll
        for (int j = 0; j < 8; ++j) ss += d[j] * d[j];
        ss += __shfl_xor(ss, 1); ss += __shfl_xor(ss, 2); ss += __shfl_xor(ss, 4); ss += __shfl_xor(ss, 8);
        const float ri = 1.0f / sqrtf(ss * (1.0f / 128.0f) + EPSN);
        v4u o; o.x = pk2(d[0] * ri * sgv[0], d[1] * ri * sgv[1]); o.y = pk2(d[2] * ri * sgv[2], d[3] * ri * sgv[3]);
        o.z = pk2(d[4] * ri * sgv[4], d[5] * ri * sgv[5]); o.w = pk2(d[6] * ri * sgv[6], d[7] * ri * sgv[7]);
        *(GAS v4u*)(MIX + row * 1024 + F.lane * 8) = o; }
}

typedef float f32x16 __attribute__((ext_vector_type(16)));
#define CEX(a, b) do { const float _hi = fmaxf(a, b), _lo = fminf(a, b); a = _hi; b = _lo; } while (0)
__device__ __forceinline__ int skey(int b) { return b ^ ((b >> 31) & 0x7fffffff); }
#define CEI(a, b) do { const int _hi = max(a, b), _lo = min(a, b); a = _hi; b = _lo; } while (0)
__device__ __forceinline__ void sort16_desc(int (&v)[16]) {
#pragma unroll
    for (int p = 1; p < 16; p <<= 1)
#pragma unroll
        for (int k = p; k >= 1; k >>= 1)
#pragma unroll
            for (int j = k % p; j + k < 16; j += 2 * k)
#pragma unroll
                for (int i = 0; i < k; ++i) if (i + j + k < 16 && (i + j) / (2 * p) == (i + j + k) / (2 * p)) CEI(v[i + j], v[i + j + k]);
}
__device__ __forceinline__ void merge16_desc(int (&a)[16], const int (&b)[16]) {
#pragma unroll
    for (int i = 0; i < 16; ++i) a[i] = max(a[i], b[15 - i]);
#pragma unroll
    for (int j = 8; j >= 1; j >>= 1)
#pragma unroll
        for (int i = 0; i < 16; ++i) if ((i & j) == 0) CEI(a[i], a[i + j]);
}
__device__ __forceinline__ void top16_half(int (&top)[16], const bf16* q, const LAS unsigned char* sk, int r32, int hi) {
    bf16x8 qf[8];
#pragma unroll
    for (int ks = 0; ks < 8; ++ks) qf[ks] = *(const GAS bf16x8*)(q + 16 * ks + 8 * hi);
#pragma unroll
    for (int i = 0; i < 16; ++i) top[i] = (int)0x80000000;
#pragma unroll 1
    for (int kt = 0; kt < 4; ++kt) {
        f32x16 acc = {};
#pragma unroll
        for (int ks = 0; ks < 8; ++ks) { const bf16x8 kf = *(const LAS bf16x8*)(sk + (32 * kt + r32) * 272 + (16 * ks + 8 * hi) * 2); acc = __builtin_amdgcn_mfma_f32_32x32x16_bf16(kf, qf[ks], acc, 0, 0, 0); }
        int grp[16];
#pragma unroll
        for (int r = 0; r < 16; ++r) { const int idx = 32 * kt + (r & 3) + 8 * (r >> 2) + 4 * hi; const float av = acc[r];
            grp[r] = (skey(__float_as_int(av)) & ~127) | idx; }
        sort16_desc(grp); merge16_desc(top, grp);
    }
    int oth[16];
#pragma unroll
    for (int i = 0; i < 16; ++i) oth[i] = __shfl_xor(top[i], 32);
    merge16_desc(top, oth);
}
__device__ __forceinline__ void route_tops(const Args& a, int g, int hd, int lane, const LAS unsigned char* skl, int (&k1)[16], int (&k2)[16]) {
    const int r32 = lane & 31, hi = lane >> 5; const int t = g * 32 + r32;
    const bf16* q = (const bf16*)(a.ws + WS_Q2) + (size_t)t * NQ + hd * 256;
    top16_half(k1, q, skl, r32, hi);
    top16_half(k2, q + 128, skl + 128 * 272, r32, hi);
}
__device__ __forceinline__ void route_finish(const Args& a, int t, int hd, LAS unsigned char* slot, const int (&k1)[16], const int (&k2)[16]) {
    { v4u w1, w2;
#define IDX4(v, j) (((unsigned)v[4 * (j)] & 127u) | (((unsigned)v[4 * (j) + 1] & 127u) << 8) | (((unsigned)v[4 * (j) + 2] & 127u) << 16) | (((unsigned)v[4 * (j) + 3] & 127u) << 24))
      w1 = (v4u){IDX4(k1, 0), IDX4(k1, 1), IDX4(k1, 2), IDX4(k1, 3)}; w2 = (v4u){IDX4(k2, 0), IDX4(k2, 1), IDX4(k2, 2), IDX4(k2, 3)};
#undef IDX4
      *(LAS v4u*)(slot) = w1; *(LAS v4u*)(slot + 16) = w2; }
    float v1[16], v2[16];
#pragma unroll
    for (int i = 0; i < 16; ++i) { v1[i] = __int_as_float(skey(k1[i])); v2[i] = __int_as_float(skey(k2[i])); }
#define CKEY(ia, ib) ((skey(__float_as_int(v1[ia] + v2[ib])) & ~255) | ((ia) * 16 + (ib)))
    int K[16], G1[16], G2[16];
#pragma unroll
    for (int i = 0; i < 16; ++i) K[i] = CKEY(0, i);
    { int n_ = 0;
#pragma unroll
      for (int ia = 1; ia < 16; ++ia)
#pragma unroll
          for (int ib = 0; ib < 16; ++ib) if ((ia + 1) * (ib + 1) <= 16) { const int kk = CKEY(ia, ib); if (n_ < 16) G1[n_] = kk; else if (n_ < 32) G2[n_ - 16] = kk; ++n_; }
    }
    sort16_desc(G1); merge16_desc(K, G1);
    sort16_desc(G2); merge16_desc(K, G2);
    { int x0 = CKEY(14, 0), x1 = CKEY(15, 0);
#pragma unroll
      for (int i = 0; i < 16; ++i) { CEI(K[i], x0); }
#pragma unroll
      for (int i = 0; i < 16; ++i) { CEI(K[i], x1); }
    }
#undef CKEY
    unsigned P[16]; float sc[16];
#pragma unroll
    for (int i = 0; i < 16; ++i) { const unsigned ci = (unsigned)K[i] & 255u; const unsigned i1 = slot[ci >> 4], i2 = slot[16 + (ci & 15u)]; P[i] = i1 * 128u + i2; sc[i] = __int_as_float(skey(K[i] & ~255)); }
    float ex[16], sum = 0.f;
#pragma unroll
    for (int i = 0; i < 16; ++i) { ex[i] = __builtin_amdgcn_exp2f((sc[i] - sc[0]) * 1.4426950408889634f); sum += ex[i]; }
    const float inv = 1.0f / sum;
    {
        GAS v4u* ro = (GAS v4u*)((unsigned*)(a.ws + WS_REC) + (size_t)t * 128 + hd * 16);
#pragma unroll
        for (int j = 0; j < 4; ++j) ro[j] = (v4u){P[4 * j] | (f2bf(ex[4 * j] * inv) << 16), P[4 * j + 1] | (f2bf(ex[4 * j + 1] * inv) << 16), P[4 * j + 2] | (f2bf(ex[4 * j + 2] * inv) << 16), P[4 * j + 3] | (f2bf(ex[4 * j + 3] * inv) << 16)};
    }
}

__device__ __forceinline__ float wave_max(float v) {
#pragma unroll
    for (int o = 1; o < 64; o <<= 1) v = fmaxf(v, __shfl_xor(v, o));
    return v;
}
__device__ __forceinline__ void route_unit_ref(const Args& a, int t, int hd, int lane, LAS float* sc) {
    LAS unsigned* sci = (LAS unsigned*)sc;
    const bf16* q = (const bf16*)(a.ws + WS_Q2) + (size_t)t * NQ + hd * 256;
#pragma unroll 1
    for (int half = 0; half < 2; ++half) {
        const float* sk = a.in[18 + half];
        float sa = 0.f, sb = 0.f;
        for (int d = 0; d < 128; ++d) { const float qv = bf2f(q[half * 128 + d]); sa += qv * sk[lane * 128 + d]; sb += qv * sk[(lane + 64) * 128 + d]; }
        for (int r = 0; r < 16; ++r) {
            const float mx = wave_max(fmaxf(sa, sb));
            const unsigned long long ba = __ballot(sa == mx), bb = __ballot(sb == mx);
            int key;
            if (ba) { const int ln = __ffsll((long long)ba) - 1; key = ln; if (lane == ln) sa = -INFINITY; }
            else { const int ln = __ffsll((long long)bb) - 1; key = ln + 64; if (lane == ln) sb = -INFINITY; }
            if (lane == 0) { sc[half * 32 + r] = mx; sci[half * 32 + 16 + r] = (unsigned)key; }
        }
    }
    __builtin_amdgcn_s_waitcnt(0);
    const int ca = lane >> 2, cb0 = (lane & 3) * 4;
    float c[4];
#pragma unroll
    for (int j = 0; j < 4; ++j) c[j] = sc[ca] + sc[32 + cb0 + j];
    for (int r = 0; r < 16; ++r) {
        const float mx = wave_max(fmaxf(fmaxf(c[0], c[1]), fmaxf(c[2], c[3])));
        const bool mine = (c[0] == mx) || (c[1] == mx) || (c[2] == mx) || (c[3] == mx);
        const unsigned long long bm = __ballot(mine); const int ln = __ffsll((long long)bm) - 1;
        if (lane == ln) { int j = (c[0] == mx) ? 0 : (c[1] == mx) ? 1 : (c[2] == mx) ? 2 : 3;
            if (j == 0) c[0] = -INFINITY; else if (j == 1) c[1] = -INFINITY; else if (j == 2) c[2] = -INFINITY; else c[3] = -INFINITY;
            sc[64 + r] = mx; sci[80 + r] = sci[16 + ca] * 128u + sci[48 + cb0 + j]; }
    }
    __builtin_amdgcn_s_waitcnt(0);
    if (lane < 16) {
        const float mx0 = sc[64]; const float ex = expf(sc[64 + lane] - mx0); float sum = ex;
        sum += __shfl_xor(sum, 1); sum += __shfl_xor(sum, 2); sum += __shfl_xor(sum, 4); sum += __shfl_xor(sum, 8);
        ((int*)(a.ws + WS_EID))[(size_t)t * 128 + hd * 16 + lane] = (int)sci[80 + lane];
        ((float*)(a.ws + WS_GW))[(size_t)t * 128 + hd * 16 + lane] = ex / sum;
    }
    __builtin_amdgcn_s_waitcnt(0);
}

__device__ __forceinline__ void unpack8(const v4u w, float* f) { f[0] = bflo(w.x); f[1] = bfhi(w.x); f[2] = bflo(w.y); f[3] = bfhi(w.y); f[4] = bflo(w.z); f[5] = bfhi(w.z); f[6] = bflo(w.w); f[7] = bfhi(w.w); }
__device__ __forceinline__ void gather_token(const Args& a, int t, int lane, float* dst) {
    const bf16* HB = (const bf16*)(a.ws + WS_HB) + (size_t)t * D; const bf16* ED = (const bf16*)(a.ws + WS_ED); const bf16* EU = (const bf16*)(a.ws + WS_EU);
    float hx[16];
    unpack8(*(const GAS v4u*)(HB + lane * 8), hx); unpack8(*(const GAS v4u*)(HB + 512 + lane * 8), hx + 8);
    const float rs2 = 1.0f / sqrtf(((const float*)(a.ws + WS_ROWSS2))[t] * (1.0f / 1024.0f) + EPSN);
    const int* EID = (const int*)(a.ws + WS_EID) + (size_t)t * 128; const float* GW = (const float*)(a.ws + WS_GW) + (size_t)t * 128;
    const int e0 = EID[lane], e1 = EID[64 + lane]; const float g0 = GW[lane], g1 = GW[64 + lane];
    float acc[16];
#pragma unroll
    for (int i = 0; i < 16; ++i) acc[i] = 0.f;
#pragma unroll 1
    for (int j = 0; j < 128; j += 4) {
        int ee[4]; float gg[4], dt[4];
#pragma unroll
        for (int k = 0; k < 4; ++k) { const int jj = j + k; ee[k] = __shfl(jj < 64 ? e0 : e1, jj & 63); gg[k] = __shfl(jj < 64 ? g0 : g1, jj & 63); }
        v4u da[4], db[4];
#pragma unroll
        for (int k = 0; k < 4; ++k) { const bf16* r = ED + (size_t)ee[k] * D; da[k] = *(const GAS v4u*)(r + lane * 8); db[k] = *(const GAS v4u*)(r + 512 + lane * 8); }
#pragma unroll
        for (int k = 0; k < 4; ++k) { float f[16]; unpack8(da[k], f); unpack8(db[k], f + 8); float s = 0.f;
#pragma unroll
            for (int i = 0; i < 16; ++i) s += f[i] * hx[i];
            dt[k] = s; }
#pragma unroll
        for (int o = 1; o < 64; o <<= 1) {
#pragma unroll
            for (int k = 0; k < 4; ++k) dt[k] += __shfl_xor(dt[k], o); }
#pragma unroll
        for (int k = 0; k < 4; ++k) { const bf16* r = EU + (size_t)ee[k] * D; da[k] = *(const GAS v4u*)(r + lane * 8); db[k] = *(const GAS v4u*)(r + 512 + lane * 8); }
#pragma unroll
        for (int k = 0; k < 4; ++k) { const float w = gg[k] * gelu_tanh(dt[k] * rs2); float f[16]; unpack8(da[k], f); unpack8(db[k], f + 8);
#pragma unroll
            for (int i = 0; i < 16; ++i) acc[i] += w * f[i]; }
    }
    const float* orow = a.out + (size_t)t * D; float* drow = dst + (size_t)t * D; const float* gf = a.in[22];
    f32x4 h0 = *(const GAS f32x4*)(orow + lane * 8), h1 = *(const GAS f32x4*)(orow + lane * 8 + 4), h2 = *(const GAS f32x4*)(orow + 512 + lane * 8), h3 = *(const GAS f32x4*)(orow + 512 + lane * 8 + 4);
    h0 += (f32x4){acc[0], acc[1], acc[2], acc[3]}; h1 += (f32x4){acc[4], acc[5], acc[6], acc[7]}; h2 += (f32x4){acc[8], acc[9], acc[10], acc[11]}; h3 += (f32x4){acc[12], acc[13], acc[14], acc[15]};
    float ss = (h0.x * h0.x + h0.y * h0.y) + (h0.z * h0.z + h0.w * h0.w) + (h1.x * h1.x + h1.y * h1.y) + (h1.z * h1.z + h1.w * h1.w)
             + (h2.x * h2.x + h2.y * h2.y) + (h2.z * h2.z + h2.w * h2.w) + (h3.x * h3.x + h3.y * h3.y) + (h3.z * h3.z + h3.w * h3.w);
    ss = wave_sum(ss);
    const float ri = 1.0f / sqrtf(ss * (1.0f / 1024.0f) + EPSN);
    const f32x4 f0 = *(const GAS f32x4*)(gf + lane * 8), f1 = *(const GAS f32x4*)(gf + lane * 8 + 4), f2 = *(const GAS f32x4*)(gf + 512 + lane * 8), f3 = *(const GAS f32x4*)(gf + 512 + lane * 8 + 4);
    *(GAS f32x4*)(drow + lane * 8) = h0 * ri * f0; *(GAS f32x4*)(drow + lane * 8 + 4) = h1 * ri * f1;
    *(GAS f32x4*)(drow + 512 + lane * 8) = h2 * ri * f2; *(GAS f32x4*)(drow + 512 + lane * 8 + 4) = h3 * ri * f3;
}


template <int CTRL> __device__ __forceinline__ float dpp_add(float v) { return v + __int_as_float(__builtin_amdgcn_update_dpp(0, __float_as_int(v), CTRL, 0xf, 0xf, false)); }
__device__ __forceinline__ float row16_sum(float v) { v = dpp_add<0x140>(v); v = dpp_add<0x141>(v); v = dpp_add<0x4E>(v); v = dpp_add<0xB1>(v); return v; }
__device__ __forceinline__ unsigned long long lanemask_lt(int lane) { return (1ull << lane) - 1ull; }
__device__ __forceinline__ void glds16g(const void* gsrc, unsigned lds_dst) { unsigned keep;
    asm volatile("s_mov_b32 %0, m0\n\ts_mov_b32 m0, %2\n\ts_nop 0\n\tglobal_load_lds_dwordx4 %1, off\n\ts_mov_b32 m0, %0" : "=&s"(keep) : "v"(gsrc), "s"(lds_dst) : "memory"); }

__device__ __forceinline__ void glds16x4(const void* sbase, unsigned o0, unsigned o1, unsigned o2, unsigned o3, unsigned d0, unsigned d1, unsigned d2, unsigned d3) { unsigned keep;
    asm volatile("s_mov_b32 %0, m0\n\ts_mov_b32 m0, %6\n\ts_nop 0\n\tglobal_load_lds_dwordx4 %1, %5\n\ts_mov_b32 m0, %7\n\ts_nop 0\n\tglobal_load_lds_dwordx4 %2, %5\n\t"
                 "s_mov_b32 m0, %8\n\ts_nop 0\n\tglobal_load_lds_dwordx4 %3, %5\n\ts_mov_b32 m0, %9\n\ts_nop 0\n\tglobal_load_lds_dwordx4 %4, %5\n\ts_mov_b32 m0, %0"
                 : "=&s"(keep) : "v"(o0), "v"(o1), "v"(o2), "v"(o3), "s"(sbase), "s"(d0), "s"(d1), "s"(d2), "s"(d3) : "memory"); }
typedef __bf16 bf2_t __attribute__((ext_vector_type(2)));
__device__ __forceinline__ float dot2bf(unsigned a, unsigned b, float c) { return __builtin_amdgcn_fdot2_f32_bf16(__builtin_bit_cast(bf2_t, a), __builtin_bit_cast(bf2_t, b), c, false); }
template <int NT> __device__ __forceinline__ void compact_tokens(const Args& a, int t0, int lane) {
    int e0[NT], e1[NT]; float g0[NT], g1[NT];
#pragma unroll
    for (int i = 0; i < NT; ++i) { const int* EID = (const int*)(a.ws + WS_EID) + (size_t)(t0 + i) * 128; const float* GW = (const float*)(a.ws + WS_GW) + (size_t)(t0 + i) * 128;
        e0[i] = EID[lane]; e1[i] = EID[64 + lane]; g0[i] = GW[lane]; g1[i] = GW[64 + lane]; }
#pragma unroll
    for (int i = 0; i < NT; ++i) {
        const bool p0 = e0[i] < 8192, p1 = e1[i] < 8192;
        const unsigned long long m0 = __ballot(p0), m1 = __ballot(p1), lt = lanemask_lt(lane);
        const int c0 = __popcll(m0), n0 = c0 + __popcll(m1);
        const int pos0 = p0 ? __popcll(m0 & lt) : n0 + __popcll(~m0 & lt);
        const int pos1 = p1 ? c0 + __popcll(m1 & lt) : n0 + (64 - c0) + __popcll(~m1 & lt);
        unsigned* R = (unsigned*)(a.ws + WS_REC) + (size_t)(t0 + i) * 128;
        R[pos0] = (unsigned)e0[i] | (f2bf(g0[i]) << 16); R[pos1] = (unsigned)e1[i] | (f2bf(g1[i]) << 16);
        if (lane == 0) ((int*)(a.ws + WS_N0))[t0 + i] = n0; }
}
template <int NT> __device__ __forceinline__ void w_tokens(const Args& a, int t0, int lane, const LAS float* scd, const LAS float* scu) {
    float d0[NT], d1[NT], sd0[NT], sd1[NT], su0[NT], su1[NT]; unsigned r0[NT], r1[NT]; float ss[NT];
#pragma unroll
    for (int i = 0; i < NT; ++i) { const unsigned short* DP = (const unsigned short*)(a.ws + WS_DOTP) + (size_t)(t0 + i) * 1024; const unsigned* R = (const unsigned*)(a.ws + WS_REC) + (size_t)(t0 + i) * 128;
        float p0[8], p1[8];
#pragma unroll
        for (int x = 0; x < 8; ++x) { p0[x] = bf2f(DP[x * 128 + lane]); p1[x] = bf2f(DP[x * 128 + 64 + lane]); }
        r0[i] = R[lane]; r1[i] = R[64 + lane]; ss[i] = ((const float*)(a.ws + WS_ROWSS2))[t0 + i];
        sd0[i] = scd[r0[i] & 0x3fffu]; sd1[i] = scd[r1[i] & 0x3fffu];
        su0[i] = scu[r0[i] & 0x3fffu]; su1[i] = scu[r1[i] & 0x3fffu];
        d0[i] = ((p0[0] + p0[1]) + (p0[2] + p0[3])) + ((p0[4] + p0[5]) + (p0[6] + p0[7])); d1[i] = ((p1[0] + p1[1]) + (p1[2] + p1[3])) + ((p1[4] + p1[5]) + (p1[6] + p1[7])); }
#pragma unroll
    for (int i = 0; i < NT; ++i) { const float rs2 = 1.0f / sqrtf(ss[i] * (1.0f / 1024.0f) + EPSN);
        const float w0 = bfhi(r0[i]) * fgelu_tanh(d0[i] * sd0[i] * rs2) * su0[i], w1 = bfhi(r1[i]) * fgelu_tanh(d1[i] * sd1[i] * rs2) * su1[i];
        float m0 = fabsf(w0), m1 = fabsf(w1);
#pragma unroll
        for (int o = 1; o < 64; o <<= 1) { m0 = fmaxf(m0, __shfl_xor(m0, o)); m1 = fmaxf(m1, __shfl_xor(m1, o)); }
        const float s0 = (m0 > 0.f) ? m0 * (1.0f / 127.0f) : 1.0f, s1 = (m1 > 0.f) ? m1 * (1.0f / 127.0f) : 1.0f;
        unsigned char* WQ = a.ws + WS_WQ8 + (size_t)(t0 + i) * 144;
        WQ[lane] = (unsigned char)((int)__builtin_rintf(w0 / s0) & 255); WQ[64 + lane] = (unsigned char)((int)__builtin_rintf(w1 / s1) & 255);
        if (lane == 0) { ((float*)(WQ + 128))[0] = s0; ((float*)(WQ + 128))[1] = s1; } }
}
template <bool IS_UP> __device__ __forceinline__ void sweep_slice(const Args& a, int x, int wv, int lane, unsigned ring, LAS unsigned char* ringp, unsigned aux, LAS unsigned char* auxp) {
    const int g = lane >> 4, li = lane & 15, n16 = li, kg = g;
    const char* TABx = (const char*)(a.ws + (IS_UP ? WS_EU : WS_ED)) + x * 256;
    unsigned jofs[4];
#pragma unroll
    for (int q = 0; q < 4; ++q) jofs[q] = (unsigned)((li ^ ((g << 2) | q)) * 16);
    const unsigned pd = (unsigned)__builtin_amdgcn_readfirstlane(ring);
#pragma unroll 1
    for (int s_ = 0; s_ < 128; ++s_) {
        const int r = s_ >> 6, k = s_ & 63, t = wv * 64 + k, base = 64 * r;
        const LAS unsigned* rec = (const LAS unsigned*)(auxp + (k & 3) * 512) + base;
        const LAS unsigned char* hp = auxp + 2048 + (k & 3) * 256;
        asm volatile("s_waitcnt lgkmcnt(0)" ::: "memory");
        if ((k & 3) == 0) {
            const char* rsrc = (const char*)(a.ws + WS_REC) + (size_t)t * 512 + lane * 16;
            glds16g(rsrc, (unsigned)__builtin_amdgcn_readfirstlane(aux)); glds16g(rsrc + 1024, (unsigned)__builtin_amdgcn_readfirstlane(aux + 1024));
            if (!IS_UP) glds16g((const char*)(a.ws + WS_HB) + (size_t)(t + g) * 2048 + x * 256 + li * 16, (unsigned)__builtin_amdgcn_readfirstlane(aux + 2048));
            asm volatile("s_waitcnt vmcnt(0)" ::: "memory");
        }
        {
            unsigned so[16];
#pragma unroll
            for (int p = 0; p < 16; ++p) so[p] = rec[4 * p + g];
#pragma unroll
            for (int p = 0; p < 16; ++p) so[p] = ((so[p] & 0x3fffu) << 11) + jofs[p & 3];
            glds16x4(TABx, so[0], so[1], so[2], so[3], pd, pd + 1024u, pd + 2048u, pd + 3072u);
            glds16x4(TABx, so[4], so[5], so[6], so[7], pd + 4096u, pd + 5120u, pd + 6144u, pd + 7168u);
            glds16x4(TABx, so[8], so[9], so[10], so[11], pd + 8192u, pd + 9216u, pd + 10240u, pd + 11264u);
            glds16x4(TABx, so[12], so[13], so[14], so[15], pd + 12288u, pd + 13312u, pd + 14336u, pd + 15360u);
        }
        asm volatile("s_waitcnt vmcnt(0)" ::: "memory");
        if (!IS_UP) {
            bf16x8 hb[4];
#pragma unroll
            for (int q = 0; q < 4; ++q) hb[q] = *(const LAS bf16x8*)(hp + (32 * q + 8 * kg) * 2);
            f32x4 res = (f32x4){0.f, 0.f, 0.f, 0.f};
#pragma unroll
            for (int rb = 0; rb < 4; ++rb) {
                f32x4 d = (f32x4){0.f, 0.f, 0.f, 0.f}; const int row = n16 + 16 * rb; const int key = ((row & 3) << 2) | ((row >> 2) & 3);
#pragma unroll
                for (int q = 0; q < 4; ++q) { const bf16x8 af = *(const LAS bf16x8*)(ringp + 256 * row + 16 * ((4 * q + kg) ^ key)); d = __builtin_amdgcn_mfma_f32_16x16x32_bf16(af, hb[q], d, 0, 0, 0); }
                res = (n16 == rb) ? d : res; }
            if (n16 < 4) *(GAS f32x4*)((float*)(a.ws + WS_DOTP) + ((size_t)t * 8 + x) * 128 + base + 16 * n16 + 4 * kg) = res;
        } else {
            f32x4 pacc[8];
#pragma unroll
            for (int i = 0; i < 8; ++i) pacc[i] = (f32x4){0.f, 0.f, 0.f, 0.f};
            const int q4 = n16 >> 2, p4 = lane & 3;
#pragma unroll
            for (int ks = 0; ks < 2; ++ks) {
                const v4u wa = *(const LAS v4u*)(rec + 32 * ks + 8 * kg), wb = *(const LAS v4u*)(rec + 32 * ks + 8 * kg + 4);
                const bf16x8 af = __builtin_bit_cast(bf16x8, (v4u){(wa.x >> 16) | (wa.y & 0xffff0000u), (wa.z >> 16) | (wa.w & 0xffff0000u), (wb.x >> 16) | (wb.y & 0xffff0000u), (wb.z >> 16) | (wb.w & 0xffff0000u)});
#pragma unroll
                for (int c = 0; c < 8; ++c) {
                    const int row0 = 32 * ks + 8 * kg + q4, row1 = row0 + 4; const int ch = 2 * c + (p4 >> 1);
                    const int k0 = ((row0 & 3) << 2) | ((row0 >> 2) & 3), k1 = ((row1 & 3) << 2) | ((row1 >> 2) & 3);
                    const attn_body::s16x4 lo4 = attn_body::vtr((attn_body::lds_cptr)(ringp + 256 * row0 + 16 * (ch ^ k0) + 8 * (p4 & 1)));
                    const attn_body::s16x4 hi4 = attn_body::vtr((attn_body::lds_cptr)(ringp + 256 * row1 + 16 * (ch ^ k1) + 8 * (p4 & 1)));
                    const bf16x8 bfr = (bf16x8){lo4[0], lo4[1], lo4[2], lo4[3], hi4[0], hi4[1], hi4[2], hi4[3]};
                    pacc[c] = __builtin_amdgcn_mfma_f32_16x16x32_bf16(af, bfr, pacc[c], 0, 0, 0); }
            }
            const float v0 = (kg == 0) ? pacc[0][0] : (kg == 1) ? pacc[1][0] : (kg == 2) ? pacc[2][0] : pacc[3][0];
            const float v1 = (kg == 0) ? pacc[4][0] : (kg == 1) ? pacc[5][0] : (kg == 2) ? pacc[6][0] : pacc[7][0];
            bf16* po = (bf16*)(a.ws + WS_PEER) + ((size_t)r * M + t) * D + x * 128;
            po[lane] = (bf16)f2bf(v0); po[64 + lane] = (bf16)f2bf(v1);
        }
    }
}
typedef int i32x4 __attribute__((ext_vector_type(4)));
__device__ __forceinline__ void sweep_down_q8(const Args& a, int x, int wv, int lane, unsigned ring, LAS unsigned char* ringp, unsigned aux, LAS unsigned char* auxp) {
    const int g = lane >> 4, li = lane & 15, n16 = li, kg = g, g8 = lane >> 3, s8 = lane & 7;
    const char* TABx = (const char*)(a.ws + WS_ED) + (size_t)x * ((size_t)NEXP * 128);
    unsigned jofs[2];
#pragma unroll
    for (int b = 0; b < 2; ++b) jofs[b] = (unsigned)((s8 ^ (4 * b + (g8 >> 1))) * 16);
    const unsigned pd = (unsigned)__builtin_amdgcn_readfirstlane(ring);
#define DN_FETCH(tw, dst) do { const char* rsrc_ = (const char*)(a.ws + WS_REC) + (size_t)(tw) * 512 + lane * 16; const unsigned d_ = (unsigned)__builtin_amdgcn_readfirstlane(dst); \
        glds16g(rsrc_, d_); glds16g(rsrc_ + 1024, d_ + 1024u); \
        glds16g((const char*)(a.ws + WS_HB) + (size_t)((tw) + g) * 2048 + x * 256 + li * 16, d_ + 2048u); } while (0)
    DN_FETCH(wv * 64, pd + 8192u);
    asm volatile("s_waitcnt vmcnt(0)" ::: "memory");
#pragma unroll 1
    for (int s_ = 0; s_ < 128; ++s_) {
        const int r = s_ & 1, k = s_ >> 1, t = wv * 64 + k, base = 64 * r;
        LAS unsigned char* wp = ringp + 8192 + 4096 * ((k >> 2) & 1);
        LAS unsigned char* hq = wp + 3072; LAS float* hsc = (LAS float*)(wp + 3072 + 512);
        const LAS unsigned* rec = (const LAS unsigned*)(wp + (k & 3) * 512) + base;
        asm volatile("s_waitcnt lgkmcnt(0)" ::: "memory");
        if ((k & 3) == 0 && r == 0) {
            {
                const v4u hb = *(const LAS v4u*)(wp + 2048 + lane * 16); float f[8]; unpack8(hb, f);
                float am = fmaxf(fmaxf(fmaxf(fabsf(f[0]), fabsf(f[1])), fmaxf(fabsf(f[2]), fabsf(f[3]))), fmaxf(fmaxf(fabsf(f[4]), fabsf(f[5])), fmaxf(fabsf(f[6]), fabsf(f[7]))));
                am = fmaxf(am, __int_as_float(__builtin_amdgcn_update_dpp(0, __float_as_int(am), 0x140, 0xf, 0xf, false))); am = fmaxf(am, __int_as_float(__builtin_amdgcn_update_dpp(0, __float_as_int(am), 0x141, 0xf, 0xf, false)));
                am = fmaxf(am, __int_as_float(__builtin_amdgcn_update_dpp(0, __float_as_int(am), 0x4E, 0xf, 0xf, false))); am = fmaxf(am, __int_as_float(__builtin_amdgcn_update_dpp(0, __float_as_int(am), 0xB1, 0xf, 0xf, false)));
                const float sc = (am > 0.f) ? am * (1.0f / 127.0f) : 1.0f, inv = 1.0f / sc;
                unsigned qw[2];
#pragma unroll
                for (int h2 = 0; h2 < 2; ++h2) { const int q0 = (int)__builtin_rintf(f[4 * h2] * inv), q1 = (int)__builtin_rintf(f[4 * h2 + 1] * inv), q2 = (int)__builtin_rintf(f[4 * h2 + 2] * inv), q3 = (int)__builtin_rintf(f[4 * h2 + 3] * inv);
                    qw[h2] = ((unsigned)q0 & 255u) | (((unsigned)q1 & 255u) << 8) | (((unsigned)q2 & 255u) << 16) | ((unsigned)q3 << 24); }
                *(LAS unsigned long long*)(hq + lane * 8) = (unsigned long long)qw[0] | ((unsigned long long)qw[1] << 32);
                if (li == 0) hsc[g] = sc; }
        }
        {   unsigned so[8];
#pragma unroll
            for (int i = 0; i < 8; ++i) so[i] = rec[8 * i + g8];
#pragma unroll
            for (int i = 0; i < 8; ++i) so[i] = ((so[i] & 0x3fffu) << 7) + jofs[i & 1];
            glds16x4(TABx, so[0], so[1], so[2], so[3], pd, pd + 1024u, pd + 2048u, pd + 3072u);
            glds16x4(TABx, so[4], so[5], so[6], so[7], pd + 4096u, pd + 5120u, pd + 6144u, pd + 7168u);
        }
        if ((k & 3) == 0 && r == 0 && k + 4 < 64) { DN_FETCH(t + 4, pd + 8192u + 4096u * (unsigned)(((k >> 2) + 1) & 1)); asm volatile("s_waitcnt vmcnt(3)" ::: "memory"); }
        else asm volatile("s_waitcnt vmcnt(0)" ::: "memory");
        const i32x4 hb0 = *(const LAS i32x4*)(hq + (k & 3) * 128 + 16 * kg), hb1 = *(const LAS i32x4*)(hq + (k & 3) * 128 + 64 + 16 * kg);
        const float hs = hsc[k & 3];
        i32x4 res = (i32x4){0, 0, 0, 0};
#pragma unroll
        for (int rb = 0; rb < 4; ++rb) {
            const int row = n16 + 16 * rb; const int key = (row >> 1) & 7;
            const i32x4 a0 = *(const LAS i32x4*)(ringp + row * 128 + ((kg ^ key) * 16)), a1 = *(const LAS i32x4*)(ringp + row * 128 + (((4 + kg) ^ key) * 16));
            i32x4 d = __builtin_amdgcn_mfma_i32_16x16x64_i8(a0, hb0, (i32x4){0, 0, 0, 0}, 0, 0, 0); d = __builtin_amdgcn_mfma_i32_16x16x64_i8(a1, hb1, d, 0, 0, 0);
            res = (n16 == rb) ? d : res; }
        if (n16 < 4) *(GAS unsigned long long*)((bf16*)(a.ws + WS_DOTP) + ((size_t)t * 8 + x) * 128 + base + 16 * n16 + 4 * kg) = (unsigned long long)pk2((float)res[0] * hs, (float)res[1] * hs) | ((unsigned long long)pk2((float)res[2] * hs, (float)res[3] * hs) << 32);
    }
}
#undef DN_FETCH

__device__ __forceinline__ void sweep_up_q8(const Args& a, int x, int wv, int lane, unsigned ring, LAS unsigned char* ringp, unsigned aux, LAS unsigned char* auxp) {
    const int n16 = lane & 15, kg = lane >> 4, g8 = lane >> 3, s8 = lane & 7;
    const char* TABx = (const char*)(a.ws + WS_EU) + (size_t)x * ((size_t)NEXP * 128);
    unsigned jofs[2];
#pragma unroll
    for (int b = 0; b < 2; ++b) jofs[b] = (unsigned)((s8 ^ ((g8 >> 1) | (b << 2))) * 16);
    const unsigned pd = (unsigned)__builtin_amdgcn_readfirstlane(ring);
    typedef int v2i_t __attribute__((ext_vector_type(2)));
    float acc0 = 0.f, acc1 = 0.f;
#define UP_FETCH(tw, dst) do { const char* rsrc_ = (const char*)(a.ws + WS_REC) + (size_t)(tw) * 512 + lane * 16; const unsigned d_ = (unsigned)__builtin_amdgcn_readfirstlane(dst); \
        glds16g(rsrc_, d_); glds16g(rsrc_ + 1024, d_ + 1024u); \
        if (lane < 36) glds16g((const char*)(a.ws + WS_WQ8) + (size_t)(tw) * 144 + lane * 16, d_ + 2048u); \
        glds16g((const char*)(a.ws + WS_HB) + (size_t)((tw) + (lane >> 4)) * 2048 + x * 256 + (lane & 15) * 16, d_ + 2688u); } while (0)
    UP_FETCH(wv * 64, pd + 8192u);
    asm volatile("s_waitcnt vmcnt(0)" ::: "memory");
#pragma unroll 1
    for (int s_ = 0; s_ < 128; ++s_) {
        const int r = s_ & 1, k = s_ >> 1, t = wv * 64 + k, base = 64 * r;
        const LAS unsigned char* wp = ringp + 8192 + 4096 * ((k >> 2) & 1);
        const LAS unsigned* rec = (const LAS unsigned*)(wp + (k & 3) * 512) + base;
        const LAS unsigned char* wq = wp + 2048 + (k & 3) * 144;
        asm volatile("s_waitcnt lgkmcnt(0)" ::: "memory");
        {   unsigned so[8];
#pragma unroll
            for (int i = 0; i < 8; ++i) so[i] = rec[8 * i + g8];
#pragma unroll
            for (int i = 0; i < 8; ++i) so[i] = ((so[i] & 0x3fffu) << 7) + jofs[(i >> 1) & 1];
            glds16x4(TABx, so[0], so[1], so[2], so[3], pd, pd + 1024u, pd + 2048u, pd + 3072u);
            glds16x4(TABx, so[4], so[5], so[6], so[7], pd + 4096u, pd + 5120u, pd + 6144u, pd + 7168u);
        }
        if ((k & 3) == 0 && r == 0 && k + 4 < 64) { UP_FETCH(t + 4, pd + 8192u + 4096u * (unsigned)(((k >> 2) + 1) & 1)); asm volatile("s_waitcnt vmcnt(4)" ::: "memory"); }
        else asm volatile("s_waitcnt vmcnt(0)" ::: "memory");
        const i32x4 aw = *(const LAS i32x4*)(wq + 64 * r + 16 * kg);
        const float wsc = *(const LAS float*)(wq + 128 + 4 * r);
        const int i2 = n16 >> 1, ih = n16 & 1;
        const int row0 = 16 * kg + i2, row1 = row0 + 8;
        const int k0 = ((row0 >> 1) & 3) | (((row0 >> 4) & 1) << 2), k1 = ((row1 >> 1) & 3) | (((row1 >> 4) & 1) << 2);
        const LAS unsigned char* p0 = ringp + row0 * 128 + 8 * ih; const LAS unsigned char* p1 = ringp + row1 * 128 + 8 * ih;
        float outv[8];
#pragma unroll
        for (int c = 0; c < 8; ++c) {
            const v2i_t lo = __builtin_amdgcn_ds_read_tr8_b64_v2i32((LAS v2i_t*)(p0 + ((c ^ k0) * 16)));
            const v2i_t hi = __builtin_amdgcn_ds_read_tr8_b64_v2i32((LAS v2i_t*)(p1 + ((c ^ k1) * 16)));
            const i32x4 d = __builtin_amdgcn_mfma_i32_16x16x64_i8(aw, (i32x4){lo.x, lo.y, hi.x, hi.y}, (i32x4){0, 0, 0, 0}, 0, 0, 0);
            outv[c] = (float)d[0] * wsc; }
        const float v0 = (kg == 0) ? outv[0] : (kg == 1) ? outv[1] : (kg == 2) ? outv[2] : outv[3];
        const float v1 = (kg == 0) ? outv[4] : (kg == 1) ? outv[5] : (kg == 2) ? outv[6] : outv[7];
        if (r == 0) { acc0 = v0; acc1 = v1; }
        else { const LAS unsigned short* hs = (const LAS unsigned short*)(wp + 2688 + (k & 3) * 256);
            const float y0 = bf2f(hs[lane]) + (acc0 + v0), y1 = bf2f(hs[64 + lane]) + (acc1 + v1);
            bf16* po = (bf16*)(a.ws + WS_PEER) + (size_t)t * D + x * 128;
            po[lane] = (bf16)f2bf(y0); po[64 + lane] = (bf16)f2bf(y1); }
    }
}
#undef UP_FETCH

__device__ __forceinline__ void final_row(const Args& a, int t, int lane) {
    float* orow = a.out + (size_t)t * D; const float* gf = a.in[22];
    const bf16* Y = (const bf16*)(a.ws + WS_PEER) + (size_t)t * D;
    f32x4 y[4]; float ss = 0.f;
#pragma unroll
    for (int j = 0; j < 4; ++j) { const unsigned long long yb = ((const GAS unsigned long long*)Y)[lane + 64 * j];
        y[j] = (f32x4){bflo((unsigned)yb), bfhi((unsigned)yb), bflo((unsigned)(yb >> 32)), bfhi((unsigned)(yb >> 32))};
        ss += (y[j].x * y[j].x + y[j].y * y[j].y) + (y[j].z * y[j].z + y[j].w * y[j].w); }
    ss = wave_sum(ss);
    const float ri = 1.0f / sqrtf(ss * (1.0f / 1024.0f) + EPSN);
#pragma unroll
    for (int j = 0; j < 4; ++j) ((GAS f32x4*)orow)[lane + 64 * j] = y[j] * ri * ((const GAS f32x4*)gf)[lane + 64 * j];
}

__device__ __forceinline__ float a_dot64(const float* p, const float* q, int lane) { return wave_sum(p[lane] * q[lane]); }
constexpr int N_PHASES = 12;
#ifndef ROUTE_REF
#define ROUTE_REF 0
#endif
#ifndef MK_ONE_LAUNCH
#define MK_ONE_LAUNCH 1
#endif
__global__ void __launch_bounds__(NWAVES * 64, 2) fwd_mega(Args args) {
    extern __shared__ __attribute__((aligned(16))) unsigned char lds[];
    Frame F;
    F.lds = (LAS unsigned char*)lds;
    F.MISC = (volatile LAS unsigned*)(F.lds + MISC_OFF);
    F.tid = threadIdx.x; F.lane = F.tid & 63; F.wave = __builtin_amdgcn_readfirstlane(F.tid >> 6);
    F.G = gridDim.x; { const int bx = blockIdx.x; F.vcu = (F.G % 8 == 0) ? (bx % 8) * (F.G / 8) + bx / 8 : bx; }
    unsigned char* ws = args.ws;
    const int lo = args.ph_lo, hi = args.ph_hi;
#ifndef PH_MASK
#define PH_MASK 0xffff
#endif
#define IN(k) (((PH_MASK >> (k)) & 1) && lo <= (k) && (k) < hi)
#define BOTH(k) (IN(k) && IN((k) + 1))
#if MK_ONE_LAUNCH
    for (int u = F.tid; u < (LDS_BYTES - LDSCTL_OFF) / 4; u += NWAVES * 64) ((LAS unsigned*)(F.lds + LDSCTL_OFF))[u] = 0u;
    __syncthreads();
    const XcdBarrier xbar = xcd_barrier_post((unsigned*)(ws + WS_CTL) + CW_BAR, F.MISC + 8);
    bool first_seam = args.ph_lo < 0;
#define GRID_BAR() do { if (first_seam) { __threadfence(); cooperative_groups::this_grid().sync(); first_seam = false; } else xcd_barrier(xbar); } while (0)
#else
#define GRID_BAR() do { } while (0)
#endif
#ifndef REP_PH
#define REP_PH -1
#endif
#define RUN_PHASE(k, ...) do { if (IN(k)) { if ((k) == REP_PH) { { const bool first_of_two = true; (void)first_of_two; __VA_ARGS__ } GRID_BAR(); } { const bool first_of_two = false; (void)first_of_two; __VA_ARGS__ } if (BOTH(k)) GRID_BAR(); } } while (0)
    RUN_PHASE(0, { p0_prologue(F, args); });
    RUN_PHASE(1, {
        pg8::Gemm g{(const pg8::bf16_t*)(ws + WS_XB), (const pg8::bf16_t*)(ws + WS_WIN), M, INC, D}; pg8::StaticOrder S; S.init(M, INC, F.G, (int)blockIdx.x);
        pg8::EpiBf16<1> E{(pg8::bf16_t*)(ws + WS_Q), 512, (const float*)(ws + WS_RS1), 512, (size_t)WS_SPLIT / 2, attn_body::C2};
        pg8::gemm_phase<pg8::EpiBf16<1>, pg8::StaticOrder, true, true>(F.lds + RING_OFF, g, S, E);
        { const int nb = (F.G >= 2) ? (int)F.G / 2 : 1; const int bi = (int)blockIdx.x - ((int)F.G - nb); if (bi >= 0) convert_experts(args, bi * NWAVES + F.wave, nb * NWAVES, F.lane); }
    });
    RUN_PHASE(2, {
        for (int c = F.vcu; c < M / 64; c += F.G) lru_local_unit(F, args, c);
        const attn128::AttnTensors AT{(const attn128::bf16*)(ws + WS_Q), (const attn128::bf16*)(ws + WS_Q + WS_SPLIT), (const attn128::bf16*)(ws + WS_Q + 2 * WS_SPLIT), (attn128::bf16*)(args.out + (size_t)M * 512)};
        const attn128::StaticOrder S(F.vcu);
        attn128::attn_phase<attn128::StaticOrder>((char*)lds + RING_OFF, AT, S);
    });
    RUN_PHASE(3, {
        float l1 = a_dot64(args.in[3], args.in[4], F.lane); float l2 = a_dot64(args.in[5], args.in[6], F.lane);
        const float lamv = expf(l1) - expf(l2) + 0.2f;
        for (int c = F.vcu; c < M / 64; c += F.G) fix_unit(F, args, c, lamv);
    });
    RUN_PHASE(4, {
        pg8::Gemm g{(const pg8::bf16_t*)(ws + WS_MIX), (const pg8::bf16_t*)(ws + WS_WOUT), M, D, D}; pg8::StaticOrder S; S.init(M, D, F.G, (int)blockIdx.x);
        pg8::EpiResid E{(const pg8::bf16_t*)(ws + WS_XB), args.out, (pg8::bf16_t*)(ws + WS_HB), (float*)(ws + (first_of_two ? WS_RS1 : WS_ROWSS2)), D};
        pg8::gemm_phase<pg8::EpiResid, pg8::StaticOrder, true, true>(F.lds + RING_OFF, g, S, E);
    });
    RUN_PHASE(5, {
        pg8::Gemm g{(const pg8::bf16_t*)(ws + WS_HB), (const pg8::bf16_t*)(ws + WS_WQ), M, NQ, D}; pg8::StaticOrder S; S.init(M, NQ, F.G, (int)blockIdx.x);
        pg8::EpiBf16<2> E{(pg8::bf16_t*)(ws + WS_Q2), NQ, (const float*)(ws + WS_ROWSS2), 0, 0, 1.f};
        pg8::gemm_phase<pg8::EpiBf16<2>, pg8::StaticOrder, true, true>(F.lds + RING_OFF, g, S, E);
    });
    RUN_PHASE(6, {
        const int gw = F.vcu * NWAVES + F.wave; const int NGW = F.G * NWAVES;
        LAS unsigned char* skl = F.lds + RING_OFF + 16384;
        for (int c = F.tid; c < 4096; c += NWAVES * 64) { const int row = c >> 4; const int ch = c & 15; *(LAS v4u*)(skl + row * 272 + ch * 16) = *(const GAS v4u*)(ws + WS_SK1 + (size_t)row * 256 + ch * 16); }
        __syncthreads();
        static_assert((M / 32) * 8 == NEXP / 4, "one group of 4 expert_up rows beside each 32-token routing group");
        for (int u = gw; u < (M / 64) * 8; u += NGW) { const int g2 = u >> 3, hd = u & 7; f32x4 ev[4][4]; int k1[16], k2[16];
            { int k1a[16], k2a[16];
              q8_load<4>(ev, args.in[21] + (size_t)(2 * u) * 4 * D, F.lane);
              route_tops(args, 2 * g2, hd, F.lane, skl, k1a, k2a);
              q8_finish<4>(ev, ws + WS_EU + (size_t)(2 * u) * 4 * 128, nullptr, (float*)(ws + WS_SCU) + 8 * u, F.lane);
              q8_load<4>(ev, args.in[21] + (size_t)(2 * u + 1) * 4 * D, F.lane);
              route_tops(args, 2 * g2 + 1, hd, F.lane, skl, k1, k2);
              q8_finish<4>(ev, ws + WS_EU + (size_t)(2 * u + 1) * 4 * 128, nullptr, (float*)(ws + WS_SCU) + 8 * u + 4, F.lane);
              if (F.lane < 32) { _Pragma("unroll") for (int i = 0; i < 16; ++i) { k1[i] = k1a[i]; k2[i] = k2a[i]; } } }
            route_finish(args, (2 * g2 + (F.lane >> 5)) * 32 + (F.lane & 31), hd, F.lds + RING_OFF + F.tid * 32, k1, k2); }
        __syncthreads();
    });
    RUN_PHASE(8, {
        if (F.G == 256) sweep_down_q8(args, F.vcu >> 5, (F.vcu & 31) * NWAVES + F.wave, F.lane, (unsigned)(uintptr_t)(lds + RING_OFF) + F.wave * 16384u, F.lds + RING_OFF + F.wave * 16384, (unsigned)(uintptr_t)(lds + LDSCTL_OFF + 1024) + F.wave * 3712u, F.lds + LDSCTL_OFF + 1024 + F.wave * 3712);
    });
    RUN_PHASE(9, {
        const int gw = F.vcu * NWAVES + F.wave; const int NGW = F.G * NWAVES;
        LAS float* scl = (LAS float*)(F.lds + RING_OFF);
        for (int i = F.tid; i < NEXP / 4; i += NWAVES * 64) { ((LAS v4u*)scl)[i] = ((const GAS v4u*)(ws + WS_SCD))[i]; ((LAS v4u*)(scl + NEXP))[i] = ((const GAS v4u*)(ws + WS_SCU))[i]; }
        __syncthreads();
        for (int t = 8 * gw; t < M; t += 8 * NGW) w_tokens<8>(args, t, F.lane, scl, scl + NEXP);
        __syncthreads();
    });
    RUN_PHASE(10, {
        if (F.G == 256) sweep_up_q8(args, F.vcu >> 5, (F.vcu & 31) * NWAVES + F.wave, F.lane, (unsigned)(uintptr_t)(lds + RING_OFF) + F.wave * 16384u, F.lds + RING_OFF + F.wave * 16384, (unsigned)(uintptr_t)(lds + LDSCTL_OFF + 1024) + F.wave * 3712u, F.lds + LDSCTL_OFF + 1024 + F.wave * 3712);
    });
    RUN_PHASE(11, {
        const int gw = F.vcu * NWAVES + F.wave; const int NGW = F.G * NWAVES;
        for (int t = gw; t < M; t += NGW) final_row(args, t, F.lane);
    });
#undef IN
#undef BOTH
}

extern "C" void kernel_launch(void* const* d_in, const int* in_sizes, int n_in, void* d_out, int out_size, void* d_ws, size_t ws_size, hipStream_t stream) {
    static int grid = 0;
    if (grid == 0) {
        if (n_in != 23 || out_size != M * D || ws_size < WS_END) { fprintf(stderr, "kernel_launch: unexpected problem: n_in %d out %d ws %zu\n", n_in, out_size, ws_size); grid = -1; return; }
        int dev = 0, cus = 0, per_cu = 0;
        if (hipGetDevice(&dev) != hipSuccess || hipDeviceGetAttribute(&cus, hipDeviceAttributeMultiprocessorCount, dev) != hipSuccess) { grid = -1; return; }
        if (hipFuncSetAttribute((const void*)fwd_mega, hipFuncAttributeMaxDynamicSharedMemorySize, LDS_BYTES) != hipSuccess) { fprintf(stderr, "kernel_launch: hipFuncSetAttribute failed\n"); grid = -1; return; }
        if (hipOccupancyMaxActiveBlocksPerMultiprocessor(&per_cu, (const void*)fwd_mega, NWAVES * 64, LDS_BYTES) != hipSuccess || per_cu < 1) { fprintf(stderr, "kernel_launch: occupancy query reports %d\n", per_cu); per_cu = 1; }
        (void)hipGetLastError();
        grid = cus;
    }
    if (grid < 0) return;
    (void)hipMemsetAsync((char*)d_ws + WS_CTL, 0, CTL_ZERO_BYTES, stream);
    Args a{};
    for (int i = 0; i < 23; ++i) a.in[i] = (const float*)d_in[i];
    a.out = (float*)d_out; a.ws = (unsigned char*)d_ws;
#if MK_ONE_LAUNCH
    a.ph_lo = 0; a.ph_hi = N_PHASES;
    void* kargs[] = {&a};
    hipError_t e = hipLaunchCooperativeKernel((const void*)fwd_mega, dim3(grid), dim3(NWAVES * 64), kargs, LDS_BYTES, stream);
    if (e != hipSuccess) fprintf(stderr, "cooperative launch failed: %s (grid %d)\n", hipGetErrorString(e), grid);
#else
    for (int p = 0; p < N_PHASES; ++p) { a.ph_lo = p; a.ph_hi = p + 1; hipLaunchKernelGGL(fwd_mega, dim3(grid), dim3(NWAVES * 64), LDS_BYTES, stream, a); }
#endif
}
```

```cpp
#include <hip/hip_runtime.h>
#include <hip/hip_cooperative_groups.h>
#include <cstdio>
#include <cstdint>
namespace pg8 {
#define PG8_LAS __attribute__((address_space(3)))
typedef unsigned short bf16_t;
typedef short bf16x8 __attribute__((ext_vector_type(8)));
typedef float f32x4 __attribute__((ext_vector_type(4)));
typedef unsigned u32x4 __attribute__((ext_vector_type(4)));
constexpr int BM = 256, BK = 64, HALF = 128, HTB = HALF * BK * 2  , STAGE_BYTES = 8 * HTB, NXCD = 8, WGM = 8;

__host__ __device__ __forceinline__ int lds_byte(int r, int c) { const int st = (r >> 4) * 2 + (c >> 5), rr = r & 15, cc = c & 31, ob = rr * 64 + cc * 2; return st * 1024 + (ob ^ (((ob >> 9) & 1) << 5)); }
__host__ __device__ __forceinline__ void stage_rc(int b, int& R, int& C) { const int st = b / 1024, sb = b % 1024, swz = sb ^ (((sb >> 9) & 1) << 5); R = (st >> 1) * 16 + swz / 64; C = (st & 1) * 32 + (swz % 64) / 2; }
__host__ __device__ __forceinline__ int perm32(int rho) { const int n = rho >> 4, i = rho & 15; return 8 * (i >> 2) + 4 * n + (i & 3); }

struct Unit { int pm, pn; };
struct Gemm { const bf16_t* A; const bf16_t* Bt; int M, N, K; };

struct StaticOrder {
    int nM, nN, nwg, G, c;
    __host__ __device__ void init(int M, int N, int G_, int c_) { nM = M / BM; nN = N / BM; nwg = nM * nN; G = G_; c = c_; }
    __host__ __device__ bool next(int i, Unit& u) const {
        const long L = (long)i * G + c; if (L >= nwg) return false;
        int wgid = (int)L; { const int q = nwg / NXCD, r = nwg % NXCD, xcd = wgid % NXCD, off = wgid / NXCD; wgid = (xcd < r ? xcd * (q + 1) : r * (q + 1) + (xcd - r) * q) + off; }
        const int nig = WGM * nN, gid = wgid / nig, fm = gid * WGM, gsz = (nM - fm) < WGM ? (nM - fm) : WGM;
        u.pm = fm + ((wgid % nig) % gsz); u.pn = (wgid % nig) / gsz; return true;
    }
    __device__ __forceinline__ void a_ready(const Unit&) const {}
    __device__ __forceinline__ void done(const Unit&) const {}
};

__device__ __forceinline__ unsigned cvt_pk_bf16(float lo, float hi) { unsigned r; asm volatile("v_cvt_pk_bf16_f32 %0, %1, %2" : "=v"(r) : "v"(lo), "v"(hi)); return r; }
typedef float f32x2 __attribute__((ext_vector_type(2)));

template <int RSMODE> struct EpiBf16 {
    static constexpr bool PERM = true, AFTER_DRAIN = false;
    bf16_t* O; int ldc; const float* rowscale; int split_cols; size_t split_stride; float scale0;
    __device__ __forceinline__ void operator()(const f32x4 (&acc)[2][2][4][2], const Unit& u, int wr, int wc, int fr, int fq) const {
        const int row0 = u.pm * BM + wr * 64 + fr; int colt = u.pn * BM; bf16_t* base = O;
        float sc = 1.f; if (split_cols) { const int t = colt / split_cols; base += (size_t)t * split_stride; colt -= t * split_cols; if (t == 0) sc = scale0; }
        const int col0 = colt + wc * 32 + 8 * fq;
#pragma unroll
        for (int ai = 0; ai < 2; ++ai)
#pragma unroll
            for (int m = 0; m < 4; ++m) { const int row = row0 + ai * HALF + m * 16; bf16_t* rowp = base + (size_t)row * ldc + col0;
                float rs = sc;
                if (RSMODE == 1) rs *= rowscale[row];
                if (RSMODE == 2) rs *= 1.0f / sqrtf(rowscale[row] * (1.0f / 1024.0f) + 1e-6f);
#pragma unroll
                for (int bj = 0; bj < 2; ++bj) { f32x4 v0 = acc[ai][bj][m][0] * rs, v1 = acc[ai][bj][m][1] * rs;
                    u32x4 w; w.x = cvt_pk_bf16(v0[0], v0[1]); w.y = cvt_pk_bf16(v0[2], v0[3]); w.z = cvt_pk_bf16(v1[0], v1[1]); w.w = cvt_pk_bf16(v1[2], v1[3]);
                    *(u32x4*)(rowp + bj * HALF) = w; } }
    }
};

struct EpiResid {
    static constexpr bool PERM = false, AFTER_DRAIN = false;
    const bf16_t* X; float* Hf; bf16_t* Hb; float* rowss; int ldc;
    __device__ __forceinline__ void operator()(const f32x4 (&acc)[2][2][4][2], const Unit& u, int wr, int wc, int fr, int fq) const {
        typedef unsigned u32x2v __attribute__((ext_vector_type(2)));
        const int col0 = u.pn * BM + wc * 32 + 4 * fq;
#pragma unroll
        for (int ai = 0; ai < 2; ++ai)
#pragma unroll
            for (int m = 0; m < 4; ++m) { const int row = u.pm * BM + ai * HALF + wr * 64 + m * 16 + fr; const size_t off = (size_t)row * ldc + col0; float ss = 0.f;
#pragma unroll
                for (int bj = 0; bj < 2; ++bj)
#pragma unroll
                    for (int n = 0; n < 2; ++n) { const u32x2v xb = *(const u32x2v*)(X + off + bj * HALF + n * 16);
                        const f32x4 xv = (f32x4){__builtin_bit_cast(float, xb.x << 16), __builtin_bit_cast(float, xb.x & 0xffff0000u), __builtin_bit_cast(float, xb.y << 16), __builtin_bit_cast(float, xb.y & 0xffff0000u)}; const f32x4 h = xv + acc[ai][bj][m][n];
                        u32x2v w; w.x = cvt_pk_bf16(h[0], h[1]); w.y = cvt_pk_bf16(h[2], h[3]);
                        *(u32x2v*)(Hb + off + bj * HALF + n * 16) = w; ss += (h[0] * h[0] + h[1] * h[1]) + (h[2] * h[2] + h[3] * h[3]); }
                ss += __shfl_xor(ss, 16); ss += __shfl_xor(ss, 32);
                if (fq == 0) atomicAdd(rowss + row, ss); }
    }
};

template <class Epi, class Sched, bool ALIGN_EPI = false, bool SP2 = false>
__device__ __forceinline__ void gemm_phase(PG8_LAS unsigned char* lds, const Gemm g, const Sched& S, const Epi& E) {
    const int tid = threadIdx.x, wid = __builtin_amdgcn_readfirstlane(tid >> 6), lane = tid & 63, wr = wid >> 2, wc = wid & 3, fr = lane & 15, fq = lane >> 4;
    const int K = g.K, nt = K / BK;
    unsigned voffA[2], voffB[2];
#pragma unroll
    for (int i = 0; i < 2; ++i) { int R, C; stage_rc(tid * 16 + i * 8192, R, C); const int Rb = Epi::PERM ? ((R & ~31) + perm32(R & 31)) : R;
        voffA[i] = (unsigned)(R * K + C) * 2u; voffB[i] = (unsigned)(Rb * K + C) * 2u; }
    const size_t kstep = (size_t)(BK * 2);
    const size_t hstep = (size_t)HALF * K * 2;
    const size_t tstep = 2 * hstep;
    const unsigned ldsw = (unsigned)wid * 1024u;
    const int aoff = lds_byte(wr * 64 + fr, fq * 8), boff = lds_byte(wc * 32 + fr, fq * 8);
#define PG8_SA(b, h) (((b) * 2 + (h)) * HTB)
#define PG8_SB(b, h) ((4 + (b) * 2 + (h)) * HTB)
#define PG8_STAGE(bufoff, gbase, voff) do { _Pragma("unroll") for (int _i = 0; _i < 2; ++_i) \
        __builtin_amdgcn_global_load_lds((const unsigned*)((const char*)(gbase) + (voff)[_i]), (PG8_LAS unsigned*)(lds + (bufoff) + ldsw + _i * 8192), 16, 0, 0); } while (0)
#define PG8_LDA(dst, b, h) do { _Pragma("unroll") for (int m = 0; m < 4; ++m) _Pragma("unroll") for (int k = 0; k < 2; ++k) dst[m][k] = *(const PG8_LAS bf16x8*)(lds + PG8_SA(b, h) + aoff + m * 2048 + k * 1024); } while (0)
#define PG8_LDB(dst, b, h) do { _Pragma("unroll") for (int n = 0; n < 2; ++n) _Pragma("unroll") for (int k = 0; k < 2; ++k) dst[n][k] = *(const PG8_LAS bf16x8*)(lds + PG8_SB(b, h) + boff + n * 2048 + k * 1024); } while (0)
#define PG8_MMA(ai, bj, At, Bt) do { __builtin_amdgcn_s_setprio(1); _Pragma("unroll") for (int m = 0; m < 4; ++m) _Pragma("unroll") for (int n = 0; n < 2; ++n) _Pragma("unroll") for (int k = 0; k < 2; ++k) \
        acc[ai][bj][m][n] = __builtin_amdgcn_mfma_f32_16x16x32_bf16(Bt[n][k], At[m][k], acc[ai][bj][m][n], 0, 0, 0); __builtin_amdgcn_s_setprio(0); } while (0)
#define PG8_WAIT_V(n) asm volatile("s_waitcnt vmcnt(" #n ")" ::: "memory")
#define PG8_WAIT_L(n) asm volatile("s_waitcnt lgkmcnt(" #n ")" ::: "memory")
#define PG8_BAR __builtin_amdgcn_s_barrier()
#define PG8_SCHED __builtin_amdgcn_sched_barrier(0)
    Unit cur, nxt; int ui = 0;
    if (!S.next(0, cur)) return;
    f32x4 acc[2][2][4][2];
#pragma unroll
    for (int a = 0; a < 2; ++a)
#pragma unroll
        for (int b = 0; b < 2; ++b)
#pragma unroll
            for (int m = 0; m < 4; ++m)
#pragma unroll
                for (int n = 0; n < 2; ++n) acc[a][b][m][n] = (f32x4){0.f, 0.f, 0.f, 0.f};
    bf16x8 At[4][2], B0[2][2], B1[2][2];
    const char* cA = (const char*)g.A + (size_t)cur.pm * tstep; const char* cB = (const char*)g.Bt + (size_t)cur.pn * tstep;
    S.a_ready(cur);
    if constexpr (SP2) {
        PG8_STAGE(PG8_SB(0, 0), cB, voffB); PG8_STAGE(PG8_SB(0, 1), cB + hstep, voffB); PG8_STAGE(PG8_SA(0, 0), cA, voffA); PG8_STAGE(PG8_SA(0, 1), cA + hstep, voffA);
        if (wr == 1) PG8_BAR;
        PG8_WAIT_V(2); PG8_BAR;
        PG8_STAGE(PG8_SB(1, 0), cB + kstep, voffB); PG8_STAGE(PG8_SA(1, 0), cA + kstep, voffA); PG8_STAGE(PG8_SB(1, 1), cB + hstep + kstep, voffB);
        PG8_WAIT_V(6); PG8_BAR;
    } else {
        PG8_STAGE(PG8_SB(0, 0), cB, voffB); PG8_STAGE(PG8_SA(0, 0), cA, voffA); PG8_STAGE(PG8_SB(0, 1), cB + hstep, voffB); PG8_STAGE(PG8_SA(0, 1), cA + hstep, voffA);
        if (wr == 1) PG8_BAR;
        PG8_WAIT_V(4); PG8_BAR;
        PG8_STAGE(PG8_SB(1, 0), cB + kstep, voffB); PG8_STAGE(PG8_SA(1, 0), cA + kstep, voffA); PG8_STAGE(PG8_SB(1, 1), cB + hstep + kstep, voffB);
        PG8_WAIT_V(6); PG8_BAR;
    }
    for (;;) {
        const bool has_next = S.next(ui + 1, nxt);
        const char* nA = has_next ? (const char*)g.A + (size_t)nxt.pm * tstep : cA; const char* nB = has_next ? (const char*)g.Bt + (size_t)nxt.pn * tstep : cB;
        for (int t = 0; t < nt; t += 2) {
            const bool last = (t == nt - 2);
            const char* a1 = cA + (size_t)(t + 1) * kstep;
            const char* a2 = last ? nA : cA + (size_t)(t + 2) * kstep; const char* b2 = last ? nB : cB + (size_t)(t + 2) * kstep;
            const char* a3 = a2 + kstep; const char* b3 = b2 + kstep;
            if (last && has_next) S.a_ready(nxt);
            if constexpr (SP2) {
            PG8_LDB(B0, 0, 0); PG8_LDB(B1, 0, 1); PG8_SCHED; PG8_LDA(At, 0, 0); PG8_STAGE(PG8_SA(1, 1), a1 + hstep, voffA);
            PG8_WAIT_V(8); PG8_WAIT_L(0); PG8_BAR; PG8_MMA(0, 0, At, B0); PG8_MMA(0, 1, At, B1); PG8_BAR; PG8_SCHED;
            PG8_LDA(At, 0, 1); PG8_STAGE(PG8_SB(0, 0), b2, voffB); PG8_STAGE(PG8_SB(0, 1), b2 + hstep, voffB); PG8_STAGE(PG8_SA(0, 0), a2, voffA);
            PG8_WAIT_V(8); PG8_WAIT_L(0); PG8_BAR; PG8_MMA(1, 0, At, B0); PG8_MMA(1, 1, At, B1); PG8_BAR; PG8_SCHED;
            PG8_LDB(B0, 1, 0); PG8_LDB(B1, 1, 1); PG8_SCHED; PG8_LDA(At, 1, 0); PG8_STAGE(PG8_SA(0, 1), a2 + hstep, voffA);
            PG8_WAIT_V(8); PG8_WAIT_L(0); PG8_BAR; PG8_MMA(0, 0, At, B0); PG8_MMA(0, 1, At, B1); PG8_BAR; PG8_SCHED;
            PG8_LDA(At, 1, 1); PG8_STAGE(PG8_SB(1, 0), b3, voffB); PG8_STAGE(PG8_SB(1, 1), b3 + hstep, voffB); PG8_STAGE(PG8_SA(1, 0), a3, voffA);
            PG8_WAIT_V(8); PG8_WAIT_L(0); PG8_BAR; PG8_MMA(1, 0, At, B0); PG8_MMA(1, 1, At, B1); PG8_BAR; PG8_SCHED;
            } else {
            PG8_LDB(B0, 0, 0); PG8_SCHED; PG8_LDA(At, 0, 0); PG8_STAGE(PG8_SA(1, 1), a1 + hstep, voffA);
            PG8_WAIT_L(8); PG8_BAR; PG8_WAIT_L(0); PG8_MMA(0, 0, At, B0); PG8_BAR; PG8_SCHED;
            PG8_LDB(B1, 0, 1); PG8_STAGE(PG8_SB(0, 0), b2, voffB);
            PG8_BAR; PG8_WAIT_L(0); PG8_MMA(0, 1, At, B1); PG8_BAR;
            PG8_LDA(At, 0, 1); PG8_STAGE(PG8_SA(0, 0), a2, voffA);
            PG8_BAR; PG8_WAIT_L(0); PG8_MMA(1, 0, At, B0); PG8_BAR; PG8_SCHED;
            PG8_STAGE(PG8_SB(0, 1), b2 + hstep, voffB);
            PG8_WAIT_V(6); PG8_BAR; PG8_MMA(1, 1, At, B1); PG8_BAR;
            PG8_LDB(B0, 1, 0); PG8_SCHED; PG8_LDA(At, 1, 0); PG8_STAGE(PG8_SA(0, 1), a2 + hstep, voffA);
            PG8_WAIT_L(8); PG8_BAR; PG8_WAIT_L(0); PG8_MMA(0, 0, At, B0); PG8_BAR; PG8_SCHED;
            PG8_LDB(B1, 1, 1); PG8_STAGE(PG8_SB(1, 0), b3, voffB);
            PG8_BAR; PG8_WAIT_L(0); PG8_MMA(0, 1, At, B1); PG8_BAR;
            PG8_LDA(At, 1, 1); PG8_STAGE(PG8_SA(1, 0), a3, voffA);
            PG8_BAR; PG8_WAIT_L(0); PG8_MMA(1, 0, At, B0); PG8_BAR; PG8_SCHED;
            PG8_STAGE(PG8_SB(1, 1), b3 + hstep, voffB);
            PG8_WAIT_V(6); PG8_BAR; PG8_MMA(1, 1, At, B1); PG8_BAR;
            }
        }
        if constexpr (ALIGN_EPI) { if (wr == 0) PG8_BAR; }
        if constexpr (!Epi::AFTER_DRAIN) { E(acc, cur, wr, wc, fr, fq); S.done(cur); }
        if (!has_next) break;
#pragma unroll
        for (int a = 0; a < 2; ++a)
#pragma unroll
            for (int b = 0; b < 2; ++b)
#pragma unroll
                for (int m = 0; m < 4; ++m)
#pragma unroll
                    for (int n = 0; n < 2; ++n) acc[a][b][m][n] = (f32x4){0.f, 0.f, 0.f, 0.f};
        cur = nxt; cA = nA; cB = nB; ++ui;
        if constexpr (ALIGN_EPI) { if (wr == 1) PG8_BAR; }
    }
    PG8_WAIT_V(0);
    if constexpr (!ALIGN_EPI) { if (wr == 0) PG8_BAR; }
    PG8_BAR;
    if constexpr (Epi::AFTER_DRAIN) { E.fused(acc, cur, wr, wc, fr, fq, lds, wid, lane); S.done(cur); }
#undef PG8_SA
#undef PG8_SB
#undef PG8_STAGE
#undef PG8_LDA
#undef PG8_LDB
#undef PG8_MMA
#undef PG8_WAIT_V
#undef PG8_WAIT_L
#undef PG8_BAR
#undef PG8_SCHED
}
}

#include <hip/hip_bf16.h>
#include <cmath>
namespace attn_body {
using bf16=__hip_bfloat16;
using bf16x8=__attribute__((ext_vector_type(8)))short;
using s16x4=__attribute__((ext_vector_type(4)))short;
using f32x16=__attribute__((ext_vector_type(16)))float;
using u32x4=__attribute__((ext_vector_type(4)))unsigned;
constexpr int SEQ=16384,D=64,DM=512;
constexpr int NW=8,QBLK=32,QB=QBLK*NW,KVBLK=64,NQB=SEQ/QB;
constexpr int ATTN_PITCH=DM, ATTN_UNIT_ROWS=QB;
__device__ __forceinline__ int crow(int r,int hi){return (r&3)+8*(r>>2)+4*hi;}
#define SBAR() __builtin_amdgcn_sched_barrier(0)
__device__ __forceinline__ void cmask(f32x16&p0,f32x16&p1,int jb,int wid){
  const float NEG=-INFINITY;
  if(jb>(wid>>1)){
  #pragma unroll
  for(int r=0;r<16;++r){p0[r]=NEG;p1[r]=NEG;}}
}

constexpr int NSLOT=3, SLOTB=8192;
constexpr int LDS_K=0, LDS_V=NSLOT*SLOTB, LDS_WS=2*NSLOT*SLOTB, LDS_OST=LDS_WS+NW*64*4, LDS_BYTES=LDS_OST+NW*4096;
constexpr float C2=0.125f*1.4426950408889634f;
__device__ __forceinline__ void glds16(const void*gsrc,unsigned lds_dst){unsigned keep;
  asm volatile("s_mov_b32 %0, m0\n\ts_mov_b32 m0, %2\n\ts_nop 0\n\tglobal_load_lds_dwordx4 %1, off\n\ts_mov_b32 m0, %0":"=&s"(keep):"v"(gsrc),"s"(lds_dst):"memory");}
__device__ __forceinline__ float max3f(float a,float b,float c){float r;asm("v_max3_f32 %0, %1, %2, %3":"=v"(r):"v"(a),"v"(b),"v"(c));return r;}
__device__ __forceinline__ float max2f(float a,float b){float r;asm("v_max_f32_e32 %0, %1, %2":"=v"(r):"v"(a),"v"(b));return r;}
__device__ __forceinline__ float fadd_s(float a,float b){float r;asm("v_add_f32_e32 %0, %1, %2":"=v"(r):"v"(a),"v"(b));return r;}
__device__ __forceinline__ float fsub_s(float a,float b){float r;asm("v_sub_f32_e32 %0, %1, %2":"=v"(r):"v"(a),"v"(b));return r;}
typedef float f32x2_t __attribute__((ext_vector_type(2))); typedef __bf16 bf16x2_t __attribute__((ext_vector_type(2)));
__device__ __forceinline__ unsigned cvtpk_s(float lo,float hi){f32x2_t v={lo,hi};bf16x2_t b=__builtin_convertvector(v,bf16x2_t);return __builtin_bit_cast(unsigned,b);}
#define WAIT_BAR(N) asm volatile("s_waitcnt vmcnt(" #N ") lgkmcnt(0)\n\ts_barrier":::"memory")

__device__ __forceinline__ void qkt(f32x16&p0,f32x16&p1,const char*Kslot,const bf16x8*qr,const f32x16&negm,int r32,int hi){
  const char*kb=Kslot+hi*1024+r32*16;
  #pragma unroll
  for(int d0=0;d0<4;++d0){
    const bf16x8 b0=*reinterpret_cast<const bf16x8*>(kb+d0*2048);
    const bf16x8 b1=*reinterpret_cast<const bf16x8*>(kb+d0*2048+512);
    if(d0==0){p0=__builtin_amdgcn_mfma_f32_32x32x16_bf16(b0,qr[0],negm,0,0,0);p1=__builtin_amdgcn_mfma_f32_32x32x16_bf16(b1,qr[0],negm,0,0,0);}
    else{p0=__builtin_amdgcn_mfma_f32_32x32x16_bf16(b0,qr[d0],p0,0,0,0);p1=__builtin_amdgcn_mfma_f32_32x32x16_bf16(b1,qr[d0],p1,0,0,0);}}
}
typedef __attribute__((address_space(3))) const char* lds_cptr;
typedef short v4i16_t __attribute__((ext_vector_type(4)));
__device__ __forceinline__ void kload8(bf16x8*kf,lds_cptr kp){
  kf[0]=*(const __attribute__((address_space(3))) bf16x8*)(kp);      kf[1]=*(const __attribute__((address_space(3))) bf16x8*)(kp+512);
  kf[2]=*(const __attribute__((address_space(3))) bf16x8*)(kp+2048); kf[3]=*(const __attribute__((address_space(3))) bf16x8*)(kp+2560);
  kf[4]=*(const __attribute__((address_space(3))) bf16x8*)(kp+4096); kf[5]=*(const __attribute__((address_space(3))) bf16x8*)(kp+4608);
  kf[6]=*(const __attribute__((address_space(3))) bf16x8*)(kp+6144); kf[7]=*(const __attribute__((address_space(3))) bf16x8*)(kp+6656);
}
__device__ __forceinline__ void kload2(bf16x8*kf,lds_cptr kp,int j){ kf[2*j]=*(const __attribute__((address_space(3))) bf16x8*)(kp+j*2048); kf[2*j+1]=*(const __attribute__((address_space(3))) bf16x8*)(kp+j*2048+512); }
__device__ __forceinline__ s16x4 vtr(lds_cptr p){ return __builtin_bit_cast(s16x4,__builtin_amdgcn_ds_read_tr16_b64_v4i16((__attribute__((address_space(3))) v4i16_t*)p)); }
__device__ __forceinline__ float rowmax(const f32x16&p0,const f32x16&p1){
  float a=max3f(p0[0],p0[1],p1[0]),b=max3f(p0[2],p0[3],p1[1]);a=max3f(a,p1[2],p1[3]);
  #pragma unroll
  for(int r=4;r<16;r+=4){a=max3f(a,p0[r],p0[r+1]);b=max3f(b,p0[r+2],p0[r+3]);a=max3f(a,p1[r],p1[r+1]);b=max3f(b,p1[r+2],p1[r+3]);}
  const float m=max2f(a,b);
  auto rr=__builtin_amdgcn_permlane32_swap(__float_as_uint(m),__float_as_uint(m),false,false);
  return max2f(__uint_as_float(rr[0]),__uint_as_float(rr[1]));
}
__device__ __forceinline__ void pv(f32x16*o,int vb,bf16x8 pa0,bf16x8 pa1,bf16x8 pa2,bf16x8 pa3){
  #pragma unroll
  for(int d0=0;d0<2;++d0){s16x4 lo[4],hi[4];
    #pragma unroll
    for(int ks=0;ks<4;++ks){
      asm volatile("ds_read_b64_tr_b16 %0,%1 offset:%c2":"=&v"(lo[ks]):"v"(vb),"i"(d0*4096+ks*1024):"memory");
      asm volatile("ds_read_b64_tr_b16 %0,%1 offset:%c2":"=&v"(hi[ks]):"v"(vb),"i"(d0*4096+ks*1024+512):"memory");}
    asm volatile("s_waitcnt lgkmcnt(0)":::"memory");SBAR();
    #define PK(k) (bf16x8){lo[k][0],lo[k][1],lo[k][2],lo[k][3],hi[k][0],hi[k][1],hi[k][2],hi[k][3]}
    o[d0]=__builtin_amdgcn_mfma_f32_32x32x16_bf16(pa0,PK(0),o[d0],0,0,0);
    o[d0]=__builtin_amdgcn_mfma_f32_32x32x16_bf16(pa1,PK(1),o[d0],0,0,0);
    o[d0]=__builtin_amdgcn_mfma_f32_32x32x16_bf16(pa2,PK(2),o[d0],0,0,0);
    o[d0]=__builtin_amdgcn_mfma_f32_32x32x16_bf16(pa3,PK(3),o[d0],0,0,0);
    #undef PK
  }
}

#ifndef ATTN_STORE16
#define ATTN_STORE16(p,v) (*(u32x4*)(p)=(v))
#endif
template<int THRL> __device__ __forceinline__ void attn_unit(int qcol,int vcol,int qb,const bf16*Q,const bf16*__restrict__ K,const bf16*__restrict__ V,bf16*O,char*shm){
  const int tid=threadIdx.x,lane=tid&63,r32=lane&31,hi=lane>>5; const int wid=__builtin_amdgcn_readfirstlane(tid>>6);
  const long rowbase=0; const int q0=qb*QB;
  const bf16*Qw=Q+(rowbase+q0+wid*QBLK)*DM+qcol;
  const bf16*Kh=K+rowbase*DM+qcol,*Vh=V+rowbase*DM+vcol;
  const unsigned lds0=(unsigned)(uintptr_t)shm;
  float*wsf=(float*)(shm+LDS_WS)+wid*64;
  const bf16*ksrc=Kh+(long)lane*DM+wid*8;
  const bf16*vsrc=Vh+(long)(16*(wid&3)+(lane>>2))*DM+(wid>>2)*32+(lane&3)*8;
  const unsigned kdst=lds0+LDS_K+wid*1024, vdst=lds0+LDS_V+wid*1024;
  #define DMA_K(t,slot) glds16(ksrc+(long)(t)*KVBLK*DM,(unsigned)__builtin_amdgcn_readfirstlane(kdst+(slot)))
  #define DMA_V(t,slot) glds16(vsrc+(long)(t)*KVBLK*DM,(unsigned)__builtin_amdgcn_readfirstlane(vdst+(slot)))
  const int vb0=(int)(lds0+LDS_V)+((lane>>4)&1)*32+(lane&3)*8+(4*hi+((lane&15)>>2))*64;
  const char*Kbase=shm+LDS_K; bf16x8 kf[8];
  const lds_cptr shm3=(lds_cptr)shm; const lds_cptr kp0=shm3+LDS_K+hi*1024+r32*16; const lds_cptr vp0=shm3+LDS_V+((lane>>4)&1)*32+(lane&3)*8+(4*hi+((lane&15)>>2))*64;
  const int NT=(q0+QB)/KVBLK;
  DMA_K(0,0);DMA_V(0,0);DMA_K(1,SLOTB);
  bf16x8 qr[4];
  #pragma unroll
  for(int d0=0;d0<4;++d0)qr[d0]=*reinterpret_cast<const bf16x8*>(&Qw[(long)r32*DM+d0*16+hi*8]);
  float mhat=0.f,l_reg=0.f;f32x16 o[2];o[0]=f32x16{};o[1]=f32x16{};f32x16 negm=f32x16{};asm volatile("":"+v"(negm));
  const int qrel=wid*QBLK+r32;
  #define CMASK(P0,P1,t) do{int jb_=(t)-(NT-4); if(jb_>=0)cmask(P0,P1,jb_,wid);}while(0)
  bool resc=false;
  #define START(P0,P1) do{ const float rm=rowmax(P0,P1); resc=false; \
    { const float dl=rm; mhat=fadd_s(mhat,dl); \
      _Pragma("unroll") for(int r=0;r<16;++r){P0[r]=fsub_s(P0[r],dl);P1[r]=fsub_s(P1[r],dl);} \
      _Pragma("unroll") for(int r=0;r<16;++r)negm[r]=-mhat; asm volatile("":"+v"(negm)); } \
    _Pragma("unroll") for(int r=0;r<16;++r)P0[r]=__builtin_amdgcn_exp2f(P0[r]); }while(0)
  #define RESC() do{ if(resc){ asm volatile("s_waitcnt lgkmcnt(0)":::"memory"); \
      _Pragma("unroll") for(int d_=0;d_<2;++d_) _Pragma("unroll") for(int r=0;r<16;++r)o[d_][r]*=wsf[crow(r,hi)]; } }while(0)
  f32x16 pA0,pA1,pB0,pB1;
  int sl_prev=0,sl_cur=0,sl_next=SLOTB;
  #define ROT() do{sl_prev=sl_cur;sl_cur=sl_next;sl_next=(sl_next==(NSLOT-1)*SLOTB)?0:sl_next+SLOTB;}while(0)
  DMA_K(2,2*SLOTB);
  WAIT_BAR(3);
  qkt(pA0,pA1,Kbase,qr,negm,r32,hi);asm volatile("s_nop 15\n\ts_nop 7":"+v"(pA0),"+v"(pA1));CMASK(pA0,pA1,0);
  START(pA0,pA1);
  _Pragma("unroll") for(int r=0;r<16;++r)pA1[r]=__builtin_amdgcn_exp2f(pA1[r]);
  WAIT_BAR(0);
  DMA_K(3,0);DMA_V(1,SLOTB);
  ROT();
  kload8(kf,kp0+sl_cur);
  WAIT_BAR(2);
  s16x4 vlo[8],vhi[8]; u32x4 pw0,pw1,pw2,pw3;
  #define PKW(P,B) cvtpk_s(P[B],P[B+1])
  #define PAF(k) __builtin_bit_cast(bf16x8,pw##k)
  #define VFR(i) (bf16x8){vlo[i][0],vlo[i][1],vlo[i][2],vlo[i][3],vhi[i][0],vhi[i][1],vhi[i][2],vhi[i][3]}
  #define PIN(x) asm volatile("":"+v"(x))
  #define MX3(a,b,c) __builtin_fmaxf(__builtin_fmaxf((a),(b)),(c))
  #define GAPA(MF,A0,A1,A2,A3,W0,W1,PW) do{ MF; sacc+=A0; sacc+=A1; sacc+=A2; sacc+=A3; PIN(sacc); W0; W1; PIN(PW); SBAR(); }while(0)
  #define EX(v) __builtin_amdgcn_exp2f(v)
  #define GAPB(MF,X,B) do{ MF; X[B]=EX(X[B]); X[B+1]=EX(X[B+1]); X[B+2]=EX(X[B+2]); X[B+3]=EX(X[B+3]); PIN(X); SBAR(); }while(0)
  #define VRD(i) do{ vlo[i]=vtr(vp_+(((i)>>2)*4096+((i)&3)*1024)); vhi[i]=vtr(vp_+(((i)>>2)*4096+((i)&3)*1024+512)); }while(0)
  #define KRD(G,j) do{ if(G){ kload2(kf,kp0+sl_next,j); SBAR(); } }while(0)
  #define STEP(C0,C1,P0,P1,t,GK,GV,GL) do{ SBAR(); \
    const lds_cptr vp_=vp0+sl_prev; \
    VRD(0); SBAR(); float sacc=(P0[0]+P0[1]); \
    GAPA(C0=__builtin_amdgcn_mfma_f32_32x32x16_bf16(kf[0],qr[0],negm,0,0,0), P0[2],P0[3],P0[4],P0[5],     pw0[0]=PKW(P0,0), pw0[1]=PKW(P0,2), pw0); \
    VRD(4); SBAR(); GAPA(C1=__builtin_amdgcn_mfma_f32_32x32x16_bf16(kf[1],qr[0],negm,0,0,0), P0[6],P0[7],P0[8],P0[9],     pw0[2]=PKW(P0,4), pw0[3]=PKW(P0,6), pw0); \
    VRD(1); SBAR(); GAPA(C0=__builtin_amdgcn_mfma_f32_32x32x16_bf16(kf[2],qr[1],C0,0,0,0),   P0[10],P0[11],P0[12],P0[13], pw1[0]=PKW(P0,8), pw1[1]=PKW(P0,10), pw1); \
    VRD(5); SBAR(); GAPA(C1=__builtin_amdgcn_mfma_f32_32x32x16_bf16(kf[3],qr[1],C1,0,0,0),   P0[14],P0[15],P1[0],P1[1],   pw1[2]=PKW(P0,12),pw1[3]=PKW(P0,14), pw1); \
    VRD(2); SBAR(); GAPA(C0=__builtin_amdgcn_mfma_f32_32x32x16_bf16(kf[4],qr[2],C0,0,0,0),   P1[2],P1[3],P1[4],P1[5],     pw2[0]=PKW(P1,0), pw2[1]=PKW(P1,2), pw2); \
    VRD(6); SBAR(); GAPA(C1=__builtin_amdgcn_mfma_f32_32x32x16_bf16(kf[5],qr[2],C1,0,0,0),   P1[6],P1[7],P1[8],P1[9],     pw2[2]=PKW(P1,4), pw2[3]=PKW(P1,6), pw2); \
    VRD(3); SBAR(); GAPA(C0=__builtin_amdgcn_mfma_f32_32x32x16_bf16(kf[6],qr[3],C0,0,0,0),   P1[10],P1[11],P1[12],P1[13], pw3[0]=PKW(P1,8), pw3[1]=PKW(P1,10), pw3); \
    VRD(7); SBAR(); GAPA(C1=__builtin_amdgcn_mfma_f32_32x32x16_bf16(kf[7],qr[3],C1,0,0,0),   P1[14],P1[15],0.f,0.f,       pw3[2]=PKW(P1,12),pw3[3]=PKW(P1,14), pw3); \
    l_reg+=sacc; \
    if(GK){DMA_K((t)+3,sl_cur);} if(GV){DMA_V((t)+1,sl_next);} \
    CMASK(C0,C1,t); \
    { float a=MX3(C0[0],C0[1],C1[0]),b=MX3(C0[2],C0[3],C1[1]); a=MX3(a,C1[2],C1[3]); \
      _Pragma("unroll") for(int r=4;r<16;r+=4){a=MX3(a,C0[r],C0[r+1]);b=MX3(b,C0[r+2],C0[r+3]);a=MX3(a,C1[r],C1[r+1]);b=MX3(b,C1[r+2],C1[r+3]);} \
      float rm=__builtin_fmaxf(a,b); { auto rr=__builtin_amdgcn_permlane32_swap(__float_as_uint(rm),__float_as_uint(rm),false,false); rm=__builtin_fmaxf(__uint_as_float(rr[0]),__uint_as_float(rr[1])); } \
      resc=false; \
      if(__builtin_expect(__any(rm>(float)THRL),0)){ const float dl=__builtin_fmaxf(rm,0.f); mhat+=dl; \
        _Pragma("unroll") for(int r=0;r<16;++r){C0[r]-=dl;C1[r]-=dl;} \
        _Pragma("unroll") for(int r=0;r<16;++r)negm[r]=-mhat; asm volatile("":"+v"(negm)); \
        const float f=__builtin_amdgcn_exp2f(-dl); l_reg*=f; if(hi==0)wsf[r32]=f; resc=true; } } \
    SBAR(); \
    GAPB(o[0]=__builtin_amdgcn_mfma_f32_32x32x16_bf16(PAF(0),VFR(0),o[0],0,0,0), C0,0); \
    GAPB(o[1]=__builtin_amdgcn_mfma_f32_32x32x16_bf16(PAF(0),VFR(4),o[1],0,0,0), C0,4); \
    KRD(GL,0); GAPB(o[0]=__builtin_amdgcn_mfma_f32_32x32x16_bf16(PAF(1),VFR(1),o[0],0,0,0), C0,8); \
    KRD(GL,1); GAPB(o[1]=__builtin_amdgcn_mfma_f32_32x32x16_bf16(PAF(1),VFR(5),o[1],0,0,0), C0,12); \
    KRD(GL,2); GAPB(o[0]=__builtin_amdgcn_mfma_f32_32x32x16_bf16(PAF(2),VFR(2),o[0],0,0,0), C1,0); \
    KRD(GL,3); GAPB(o[1]=__builtin_amdgcn_mfma_f32_32x32x16_bf16(PAF(2),VFR(6),o[1],0,0,0), C1,4); \
    GAPB(o[0]=__builtin_amdgcn_mfma_f32_32x32x16_bf16(PAF(3),VFR(3),o[0],0,0,0), C1,8); \
    GAPB(o[1]=__builtin_amdgcn_mfma_f32_32x32x16_bf16(PAF(3),VFR(7),o[1],0,0,0), C1,12); \
    }while(0)
  int t=1;
  #undef CMASK
  #define CMASK(P0,P1,t) do{}while(0)
  for(;t+5<NT;t+=2){
    STEP(pB0,pB1,pA0,pA1,t,true,true,true);     WAIT_BAR(2); RESC(); ROT();
    STEP(pA0,pA1,pB0,pB1,t+1,true,true,true);   WAIT_BAR(2); RESC(); ROT();
  }
  #undef CMASK
  #define CMASK(P0,P1,t) do{int jb_=(t)-(NT-4); if(jb_>=0)cmask(P0,P1,jb_,wid);}while(0)
  #define ENDW(tt) do{ if((tt)+3<NT){WAIT_BAR(2);} else if((tt)+2<NT){WAIT_BAR(1);} else {WAIT_BAR(0);} }while(0)
  for(;t+1<NT;t+=2){
    STEP(pB0,pB1,pA0,pA1,t,(t+3<NT),(t+1<NT),(t+1<NT));       ENDW(t);   RESC(); ROT();
    STEP(pA0,pA1,pB0,pB1,t+1,(t+4<NT),(t+2<NT),(t+2<NT));     ENDW(t+1); RESC(); ROT();
  }
  STEP(pB0,pB1,pA0,pA1,NT-1,false,false,false); RESC();
  { float sacc=pB0[0]+pB0[1]; _Pragma("unroll") for(int r=2;r<16;++r)sacc+=pB0[r]; _Pragma("unroll") for(int r=0;r<16;++r)sacc+=pB1[r]; l_reg+=sacc;
    pw0=(u32x4){PKW(pB0,0),PKW(pB0,2),PKW(pB0,4),PKW(pB0,6)};pw1=(u32x4){PKW(pB0,8),PKW(pB0,10),PKW(pB0,12),PKW(pB0,14)};pw2=(u32x4){PKW(pB1,0),PKW(pB1,2),PKW(pB1,4),PKW(pB1,6)};pw3=(u32x4){PKW(pB1,8),PKW(pB1,10),PKW(pB1,12),PKW(pB1,14)};
    SBAR(); pv(o,vb0+sl_cur,PAF(0),PAF(1),PAF(2),PAF(3)); }
  #undef PKW
  #undef PAF
  #undef VFR
  #undef PIN
  #undef MX3
  #undef GAPA
  #undef GAPB
  #undef EX
  #undef VRD
  #undef KRD
  #undef STEP
  #undef ENDW
  {auto rr=__builtin_amdgcn_permlane32_swap(__float_as_uint(l_reg),__float_as_uint(l_reg),false,false);l_reg=__uint_as_float(rr[0])+__uint_as_float(rr[1]);}
  if(hi==0)wsf[32+r32]=l_reg;asm volatile("s_waitcnt lgkmcnt(0)":::"memory");
  float rli[16];
  #pragma unroll
  for(int r=0;r<16;++r)rli[r]=__builtin_amdgcn_rcpf(wsf[32+crow(r,hi)]);
  bf16*Ow=O+(rowbase+q0+wid*QBLK)*DM+vcol;
  { bf16*stg=(bf16*)(shm+LDS_OST)+wid*2048;
    #pragma unroll
    for(int r=0;r<16;++r){const int orow=crow(r,hi);
      #pragma unroll
      for(int d0=0;d0<2;++d0)stg[orow*64+d0*32+r32]=__float2bfloat16(o[d0][r]*rli[r]);}
    asm volatile("s_waitcnt lgkmcnt(0)":::"memory");
    #pragma unroll
    for(int i=0;i<4;++i){const int row=i*8+(lane>>3),ch=lane&7; const u32x4 v=*(const u32x4*)(stg+row*64+ch*8); ATTN_STORE16(Ow+(long)row*DM+ch*8,v);} }
  asm volatile("s_waitcnt lgkmcnt(0)\n\ts_barrier":::"memory");
  #undef DMA_K
  #undef DMA_V
  #undef CMASK
  #undef START
  #undef RESC
  #undef ROT
}
constexpr int ATTN_LDS_BYTES=LDS_BYTES;
struct AttnTensors { const bf16* Q; const bf16* K; const bf16* V; bf16* O; };
struct AttnUnit { int var; int qb; };
struct StaticOrder {
  int vcu;
  __device__ __forceinline__ explicit StaticOrder(int v):vcu(v){}
  __device__ __forceinline__ bool next(int i,AttnUnit&u)const{ if(i>=4)return false; const int s=vcu&15; u.var=vcu>>4; u.qb=(i==0)?s:(i==1)?31-s:(i==2)?32+s:63-s; return true; }
};
template<class Sched,int THRL=8> __device__ __forceinline__ void attn_phase(char*lds,const AttnTensors&T,const Sched&S){
  AttnUnit u;
  for(int i=0;S.next(i,u);++i){ const int h=u.var>>2,mp=(u.var>>1)&1,vh=u.var&1;
    attn_unit<THRL>(h*128+mp*64,h*128+vh*64,u.qb,T.Q,T.K,T.V,T.O+(size_t)mp*SEQ*DM,lds); }
}
#undef SBAR
#undef WAIT_BAR
}
namespace attn128 {
using bf16=__hip_bfloat16;
using bf16x8=__attribute__((ext_vector_type(8)))short;
using s16x4=__attribute__((ext_vector_type(4)))short;
using f32x16=__attribute__((ext_vector_type(16)))float;
using u32x4=__attribute__((ext_vector_type(4)))unsigned;
constexpr int SEQ=16384,D=64,DM=512;
constexpr int NW=8,QBLK=32,QB=QBLK*NW,KVBLK=64,NQB=SEQ/QB;
constexpr int ATTN_PITCH=DM, ATTN_UNIT_ROWS=QB;
__device__ __forceinline__ int crow(int r,int hi){return (r&3)+8*(r>>2)+4*hi;}
#define SBAR() __builtin_amdgcn_sched_barrier(0)
__device__ __forceinline__ void cmask(f32x16&p0,f32x16&p1,int jb,int wid){
  const float NEG=-INFINITY;
  if(jb>(wid>>1)){
  #pragma unroll
  for(int r=0;r<16;++r){p0[r]=NEG;p1[r]=NEG;}}
}

constexpr int NSLOT=4, SLOTB=8192;
constexpr int LDS_K=0, LDS_V=NSLOT*SLOTB, LDS_WS=3*NSLOT*SLOTB, LDS_OST=0  , LDS_BYTES=LDS_WS+NW*64*4;
constexpr float C2=0.125f*1.4426950408889634f;
__device__ __forceinline__ void glds16(const void*gsrc,unsigned lds_dst){unsigned keep;
  asm volatile("s_mov_b32 %0, m0\n\ts_mov_b32 m0, %2\n\ts_nop 0\n\tglobal_load_lds_dwordx4 %1, off\n\ts_mov_b32 m0, %0":"=&s"(keep):"v"(gsrc),"s"(lds_dst):"memory");}
__device__ __forceinline__ float max3f(float a,float b,float c){float r;asm("v_max3_f32 %0, %1, %2, %3":"=v"(r):"v"(a),"v"(b),"v"(c));return r;}
__device__ __forceinline__ float max2f(float a,float b){float r;asm("v_max_f32_e32 %0, %1, %2":"=v"(r):"v"(a),"v"(b));return r;}
__device__ __forceinline__ float fadd_s(float a,float b){float r;asm("v_add_f32_e32 %0, %1, %2":"=v"(r):"v"(a),"v"(b));return r;}
__device__ __forceinline__ float fsub_s(float a,float b){float r;asm("v_sub_f32_e32 %0, %1, %2":"=v"(r):"v"(a),"v"(b));return r;}
typedef float f32x2_t __attribute__((ext_vector_type(2))); typedef __bf16 bf16x2_t __attribute__((ext_vector_type(2)));
__device__ __forceinline__ unsigned cvtpk_s(float lo,float hi){f32x2_t v={lo,hi};bf16x2_t b=__builtin_convertvector(v,bf16x2_t);return __builtin_bit_cast(unsigned,b);}
#define WAIT_BAR(N) asm volatile("s_waitcnt vmcnt(" #N ") lgkmcnt(0)\n\ts_barrier":::"memory")

__device__ __forceinline__ void qkt(f32x16&p0,f32x16&p1,const char*Kslot,const bf16x8*qr,const f32x16&negm,int r32,int hi){
  const char*kb=Kslot+hi*1024+r32*16;
  #pragma unroll
  for(int d0=0;d0<4;++d0){
    const bf16x8 b0=*reinterpret_cast<const bf16x8*>(kb+d0*2048);
    const bf16x8 b1=*reinterpret_cast<const bf16x8*>(kb+d0*2048+512);
    if(d0==0){p0=__builtin_amdgcn_mfma_f32_32x32x16_bf16(b0,qr[0],negm,0,0,0);p1=__builtin_amdgcn_mfma_f32_32x32x16_bf16(b1,qr[0],negm,0,0,0);}
    else{p0=__builtin_amdgcn_mfma_f32_32x32x16_bf16(b0,qr[d0],p0,0,0,0);p1=__builtin_amdgcn_mfma_f32_32x32x16_bf16(b1,qr[d0],p1,0,0,0);}}
}
typedef __attribute__((address_space(3))) const char* lds_cptr;
typedef short v4i16_t __attribute__((ext_vector_type(4)));
__device__ __forceinline__ void kload8(bf16x8*kf,lds_cptr kp){
  kf[0]=*(const __attribute__((address_space(3))) bf16x8*)(kp);      kf[1]=*(const __attribute__((address_space(3))) bf16x8*)(kp+512);
  kf[2]=*(const __attribute__((address_space(3))) bf16x8*)(kp+2048); kf[3]=*(const __attribute__((address_space(3))) bf16x8*)(kp+2560);
  kf[4]=*(const __attribute__((address_space(3))) bf16x8*)(kp+4096); kf[5]=*(const __attribute__((address_space(3))) bf16x8*)(kp+4608);
  kf[6]=*(const __attribute__((address_space(3))) bf16x8*)(kp+6144); kf[7]=*(const __attribute__((address_space(3))) bf16x8*)(kp+6656);
}
__device__ __forceinline__ void kload2(bf16x8*kf,lds_cptr kp,int j){ kf[2*j]=*(const __attribute__((address_space(3))) bf16x8*)(kp+j*2048); kf[2*j+1]=*(const __attribute__((address_space(3))) bf16x8*)(kp+j*2048+512); }
__device__ __forceinline__ s16x4 vtr(lds_cptr p){ return __builtin_bit_cast(s16x4,__builtin_amdgcn_ds_read_tr16_b64_v4i16((__attribute__((address_space(3))) v4i16_t*)p)); }
__device__ __forceinline__ float rowmax(const f32x16&p0,const f32x16&p1){
  float a=max3f(p0[0],p0[1],p1[0]),b=max3f(p0[2],p0[3],p1[1]);a=max3f(a,p1[2],p1[3]);
  #pragma unroll
  for(int r=4;r<16;r+=4){a=max3f(a,p0[r],p0[r+1]);b=max3f(b,p0[r+2],p0[r+3]);a=max3f(a,p1[r],p1[r+1]);b=max3f(b,p1[r+2],p1[r+3]);}
  const float m=max2f(a,b);
  auto rr=__builtin_amdgcn_permlane32_swap(__float_as_uint(m),__float_as_uint(m),false,false);
  return max2f(__uint_as_float(rr[0]),__uint_as_float(rr[1]));
}
__device__ __forceinline__ void pv(f32x16*o,int vb,bf16x8 pa0,bf16x8 pa1,bf16x8 pa2,bf16x8 pa3){
  #pragma unroll
  for(int d0=0;d0<4;++d0){s16x4 lo[4],hi[4];
    #pragma unroll
    for(int ks=0;ks<4;++ks){
      asm volatile("ds_read_b64_tr_b16 %0,%1 offset:%c2":"=&v"(lo[ks]):"v"(vb),"i"(d0*4096+ks*1024):"memory");
      asm volatile("ds_read_b64_tr_b16 %0,%1 offset:%c2":"=&v"(hi[ks]):"v"(vb),"i"(d0*4096+ks*1024+512):"memory");}
    asm volatile("s_waitcnt lgkmcnt(0)":::"memory");SBAR();
    #define PK(k) (bf16x8){lo[k][0],lo[k][1],lo[k][2],lo[k][3],hi[k][0],hi[k][1],hi[k][2],hi[k][3]}
    o[d0]=__builtin_amdgcn_mfma_f32_32x32x16_bf16(pa0,PK(0),o[d0],0,0,0);
    o[d0]=__builtin_amdgcn_mfma_f32_32x32x16_bf16(pa1,PK(1),o[d0],0,0,0);
    o[d0]=__builtin_amdgcn_mfma_f32_32x32x16_bf16(pa2,PK(2),o[d0],0,0,0);
    o[d0]=__builtin_amdgcn_mfma_f32_32x32x16_bf16(pa3,PK(3),o[d0],0,0,0);
    #undef PK
  }
}

#ifndef ATTN_STORE16
#define ATTN_STORE16(p,v) (*(u32x4*)(p)=(v))
#endif
template<int THRL,bool LATE> __device__ __forceinline__ void attn_unit(int qcol,int vcol,int qb,const bf16*Q,const bf16*__restrict__ K,const bf16*__restrict__ V,bf16*O,char*shm){
  const int tid=threadIdx.x,lane=tid&63,r32=lane&31,hi=lane>>5; const int wid=__builtin_amdgcn_readfirstlane(tid>>6);
  const long rowbase=0; const int q0=qb*QB;
  const bf16*Qw=Q+(rowbase+q0+wid*QBLK)*DM+qcol;
  const bf16*Kh=K+rowbase*DM+qcol,*Vh=V+rowbase*DM+vcol;
  const unsigned lds0=(unsigned)(uintptr_t)shm;
  float*wsf=(float*)(shm+LDS_WS)+wid*64;
  const bf16*ksrc=Kh+(long)lane*DM+wid*8;
  const bf16*vsrc=Vh+(long)(16*(wid&3)+(lane>>2))*DM+(wid>>2)*32+(lane&3)*8;
  const unsigned kdst=lds0+LDS_K+wid*1024, vdst=lds0+LDS_V+wid*1024;
  #define DMA_K(t,slot) glds16(ksrc+(long)(t)*KVBLK*DM,(unsigned)__builtin_amdgcn_readfirstlane(kdst+(slot)))
  #define DMA_V(t,slot) do{ glds16(vsrc+(long)(t)*KVBLK*DM,(unsigned)__builtin_amdgcn_readfirstlane(vdst+2*(slot))); glds16(vsrc+64+(long)(t)*KVBLK*DM,(unsigned)__builtin_amdgcn_readfirstlane(vdst+2*(slot)+8192)); }while(0)
  const int vb0=(int)(lds0+LDS_V)+((lane>>4)&1)*32+(lane&3)*8+(4*hi+((lane&15)>>2))*64;
  const char*Kbase=shm+LDS_K; bf16x8 kf[8];
  const lds_cptr shm3=(lds_cptr)shm; const lds_cptr kp0=shm3+LDS_K+hi*1024+r32*16; const lds_cptr vp0=shm3+LDS_V+((lane>>4)&1)*32+(lane&3)*8+(4*hi+((lane&15)>>2))*64;
  const int NT=(q0+QB)/KVBLK;
  DMA_K(0,0);DMA_V(0,0);DMA_K(1,SLOTB);
  bf16x8 qr[4];
  #pragma unroll
  for(int d0=0;d0<4;++d0)qr[d0]=*reinterpret_cast<const bf16x8*>(&Qw[(long)r32*DM+d0*16+hi*8]);
  float mhat=0.f,l_reg=0.f;f32x16 o[4];o[0]=f32x16{};o[1]=f32x16{};o[2]=f32x16{};o[3]=f32x16{};const f32x16 negm=f32x16{};
  const int qrel=wid*QBLK+r32;
  #define CMASK(P0,P1,t) do{int jb_=(t)-(NT-4); if(jb_>=0)cmask(P0,P1,jb_,wid);}while(0)
  bool resc=false;
  #define START(P0,P1) do{ const float rm=rowmax(P0,P1); resc=false; \
    { const float dl=rm; mhat=fadd_s(mhat,dl); \
      _Pragma("unroll") for(int r=0;r<16;++r){P0[r]=fsub_s(P0[r],dl);P1[r]=fsub_s(P1[r],dl);} \
      } \
    _Pragma("unroll") for(int r=0;r<16;++r)P0[r]=__builtin_amdgcn_exp2f(P0[r]); }while(0)
  #define RESC() do{ if(resc){ asm volatile("s_waitcnt lgkmcnt(0)":::"memory"); \
      _Pragma("unroll") for(int d_=0;d_<4;++d_) _Pragma("unroll") for(int r=0;r<16;++r)o[d_][r]*=wsf[crow(r,hi)]; } }while(0)
  f32x16 pA0,pA1,pB0,pB1;
  int sl_prev=0,sl_cur=0,sl_next=SLOTB;
  #define ROT() do{sl_prev=sl_cur;sl_cur=sl_next;sl_next=(sl_next==(NSLOT-1)*SLOTB)?0:sl_next+SLOTB;}while(0)
  DMA_K(2,2*SLOTB);
  WAIT_BAR(4);
  qkt(pA0,pA1,Kbase,qr,negm,r32,hi);asm volatile("s_nop 15\n\ts_nop 7":"+v"(pA0),"+v"(pA1));CMASK(pA0,pA1,0);
  START(pA0,pA1);
  _Pragma("unroll") for(int r=0;r<16;++r)pA1[r]=__builtin_amdgcn_exp2f(pA1[r]);
  WAIT_BAR(0);
  DMA_K(3,3*SLOTB);DMA_V(1,SLOTB);
  ROT();
  kload8(kf,kp0+sl_cur);
  WAIT_BAR(3);
  s16x4 vlo[8],vhi[8]; u32x4 pw0,pw1,pw2,pw3;
  #define PKW(P,B) cvtpk_s(P[B],P[B+1])
  #define PAF(k) __builtin_bit_cast(bf16x8,pw##k)
  #define VFR(i) (bf16x8){vlo[i][0],vlo[i][1],vlo[i][2],vlo[i][3],vhi[i][0],vhi[i][1],vhi[i][2],vhi[i][3]}
  #define PIN(x) asm volatile("":"+v"(x))
  #define MX3(a,b,c) __builtin_fmaxf(__builtin_fmaxf((a),(b)),(c))
  #define GAPA(MF,A0,A1,A2,A3,W0,W1,PW) do{ MF; sacc+=A0; sacc+=A1; sacc+=A2; sacc+=A3; PIN(sacc); W0; W1; PIN(PW); SBAR(); }while(0)
  #define EX(v) __builtin_amdgcn_exp2f(v)
  #define GAPB(MF,X,B) do{ MF; X[B]=EX(X[B]); X[B+1]=EX(X[B+1]); X[B+2]=EX(X[B+2]); X[B+3]=EX(X[B+3]); PIN(X); SBAR(); }while(0)
  #define VRD(i) do{ vlo[i]=vtr(vp_+(((i)>>2)*4096+((i)&3)*1024)); vhi[i]=vtr(vp_+(((i)>>2)*4096+((i)&3)*1024+512)); }while(0)
  #define VRD2(i) do{ vlo[i]=vtr(vp_+((2+((i)>>2))*4096+((i)&3)*1024)); vhi[i]=vtr(vp_+((2+((i)>>2))*4096+((i)&3)*1024+512)); SBAR(); }while(0)
  #define GAPB2(MF,X,B) do{ MF; X[B]=EX(X[B]-mhat); X[B+1]=EX(X[B+1]-mhat); PIN(X); SBAR(); }while(0)
  #define KRD(G,j) do{ if(G){ kload2(kf,kp0+sl_next,j); SBAR(); } }while(0)
  #define PART_A(C0,C1,P0,P1) do{ SBAR(); const lds_cptr vp_=vp0+2*sl_prev; \
    VRD(0); SBAR(); float sacc=(P0[0]+P0[1]); \
    GAPA(C0=__builtin_amdgcn_mfma_f32_32x32x16_bf16(kf[0],qr[0],negm,0,0,0), P0[2],P0[3],P0[4],P0[5],     pw0[0]=PKW(P0,0), pw0[1]=PKW(P0,2), pw0); \
    VRD(4); SBAR(); GAPA(C1=__builtin_amdgcn_mfma_f32_32x32x16_bf16(kf[1],qr[0],negm,0,0,0), P0[6],P0[7],P0[8],P0[9],     pw0[2]=PKW(P0,4), pw0[3]=PKW(P0,6), pw0); \
    VRD(1); SBAR(); GAPA(C0=__builtin_amdgcn_mfma_f32_32x32x16_bf16(kf[2],qr[1],C0,0,0,0),   P0[10],P0[11],P0[12],P0[13], pw1[0]=PKW(P0,8), pw1[1]=PKW(P0,10), pw1); \
    VRD(5); SBAR(); GAPA(C1=__builtin_amdgcn_mfma_f32_32x32x16_bf16(kf[3],qr[1],C1,0,0,0),   P0[14],P0[15],P1[0],P1[1],   pw1[2]=PKW(P0,12),pw1[3]=PKW(P0,14), pw1); \
    GAPA(C0=__builtin_amdgcn_mfma_f32_32x32x16_bf16(kf[4],qr[2],C0,0,0,0),   P1[2],P1[3],P1[4],P1[5],     pw2[0]=PKW(P1,0), pw2[1]=PKW(P1,2), pw2); \
    GAPA(C1=__builtin_amdgcn_mfma_f32_32x32x16_bf16(kf[5],qr[2],C1,0,0,0),   P1[6],P1[7],P1[8],P1[9],     pw2[2]=PKW(P1,4), pw2[3]=PKW(P1,6), pw2); \
    GAPA(C0=__builtin_amdgcn_mfma_f32_32x32x16_bf16(kf[6],qr[3],C0,0,0,0),   P1[10],P1[11],P1[12],P1[13], pw3[0]=PKW(P1,8), pw3[1]=PKW(P1,10), pw3); \
    GAPA(C1=__builtin_amdgcn_mfma_f32_32x32x16_bf16(kf[7],qr[3],C1,0,0,0),   P1[14],P1[15],0.f,0.f,       pw3[2]=PKW(P1,12),pw3[3]=PKW(P1,14), pw3); \
    l_reg+=sacc; \
    }while(0)
  #define MID(C0,C1,t,GK,GV) do{ \
    if(GK){DMA_K((t)+3,sl_prev);} if(GV){DMA_V((t)+1,sl_next);} \
    CMASK(C0,C1,t); \
    { float a=MX3(C0[0],C0[1],C1[0]),b=MX3(C0[2],C0[3],C1[1]); a=MX3(a,C1[2],C1[3]); \
      _Pragma("unroll") for(int r=4;r<16;r+=4){a=MX3(a,C0[r],C0[r+1]);b=MX3(b,C0[r+2],C0[r+3]);a=MX3(a,C1[r],C1[r+1]);b=MX3(b,C1[r+2],C1[r+3]);} \
      float rm=__builtin_fmaxf(a,b); { auto rr=__builtin_amdgcn_permlane32_swap(__float_as_uint(rm),__float_as_uint(rm),false,false); rm=__builtin_fmaxf(__uint_as_float(rr[0]),__uint_as_float(rr[1])); } \
      resc=false; const float rmr=rm-mhat; \
      if(__builtin_expect(__any(rmr>(float)THRL),0)){ const float dl=__builtin_fmaxf(rmr,0.f); mhat+=dl; \
        const float f=__builtin_amdgcn_exp2f(-dl); l_reg*=f; if(hi==0)wsf[r32]=f; resc=true; } } \
    }while(0)
  #define PART_B(X0,X1,VS,KSLOT,GL) do{ const lds_cptr vp_=vp0+2*(VS); const int KS_=(KSLOT); \
    SBAR(); \
    VRD(2); SBAR(); GAPB2(o[0]=__builtin_amdgcn_mfma_f32_32x32x16_bf16(PAF(0),VFR(0),o[0],0,0,0), X0,0); \
    VRD(6); SBAR(); GAPB2(o[1]=__builtin_amdgcn_mfma_f32_32x32x16_bf16(PAF(0),VFR(4),o[1],0,0,0), X0,2); \
    VRD(3); SBAR(); GAPB2(o[0]=__builtin_amdgcn_mfma_f32_32x32x16_bf16(PAF(1),VFR(1),o[0],0,0,0), X0,4); \
    VRD(7); SBAR(); GAPB2(o[1]=__builtin_amdgcn_mfma_f32_32x32x16_bf16(PAF(1),VFR(5),o[1],0,0,0), X0,6); \
    VRD2(0); GAPB2(o[0]=__builtin_amdgcn_mfma_f32_32x32x16_bf16(PAF(2),VFR(2),o[0],0,0,0), X0,8); \
    VRD2(4); GAPB2(o[1]=__builtin_amdgcn_mfma_f32_32x32x16_bf16(PAF(2),VFR(6),o[1],0,0,0), X0,10); \
    VRD2(1); GAPB2(o[0]=__builtin_amdgcn_mfma_f32_32x32x16_bf16(PAF(3),VFR(3),o[0],0,0,0), X0,12); \
    VRD2(5); GAPB2(o[1]=__builtin_amdgcn_mfma_f32_32x32x16_bf16(PAF(3),VFR(7),o[1],0,0,0), X0,14); \
    VRD2(2); GAPB2(o[2]=__builtin_amdgcn_mfma_f32_32x32x16_bf16(PAF(0),VFR(0),o[2],0,0,0), X1,0); \
    VRD2(6); GAPB2(o[3]=__builtin_amdgcn_mfma_f32_32x32x16_bf16(PAF(0),VFR(4),o[3],0,0,0), X1,2); \
    VRD2(3); KRD(GL,0); GAPB2(o[2]=__builtin_amdgcn_mfma_f32_32x32x16_bf16(PAF(1),VFR(1),o[2],0,0,0), X1,4); \
    VRD2(7); KRD(GL,1); GAPB2(o[3]=__builtin_amdgcn_mfma_f32_32x32x16_bf16(PAF(1),VFR(5),o[3],0,0,0), X1,6); \
    KRD(GL,2); GAPB2(o[2]=__builtin_amdgcn_mfma_f32_32x32x16_bf16(PAF(2),VFR(2),o[2],0,0,0), X1,8); \
    KRD(GL,3); GAPB2(o[3]=__builtin_amdgcn_mfma_f32_32x32x16_bf16(PAF(2),VFR(6),o[3],0,0,0), X1,10); \
    GAPB2(o[2]=__builtin_amdgcn_mfma_f32_32x32x16_bf16(PAF(3),VFR(3),o[2],0,0,0), X1,12); \
    GAPB2(o[3]=__builtin_amdgcn_mfma_f32_32x32x16_bf16(PAF(3),VFR(7),o[3],0,0,0), X1,14); \
    }while(0)
  #undef KRD
  #define KRD(G,j) do{ if(G){ kload2(kf,kp0+KS_,j); SBAR(); } }while(0)
  #define STEP_E(C0,C1,P0,P1,t,GK,GV,GL) do{ PART_A(C0,C1,P0,P1); MID(C0,C1,t,GK,GV); PART_B(C0,C1,sl_prev,sl_next,GL); }while(0)
  #define SL_PP ((sl_prev==0)?(NSLOT-1)*SLOTB:sl_prev-SLOTB)
  #define STEP_L(C0,C1,P0,P1,t,GK,GV,GB) do{ if(GB){ PART_B(P0,P1,SL_PP,sl_cur,true); RESC(); } PART_A(C0,C1,P0,P1); MID(C0,C1,t,GK,GV); }while(0)
  int t=1;
  if constexpr(!LATE){
  #undef CMASK
  #define CMASK(P0,P1,t) do{}while(0)
  for(;t+5<NT;t+=2){
    STEP_E(pB0,pB1,pA0,pA1,t,true,true,true);     WAIT_BAR(3); RESC(); ROT();
    STEP_E(pA0,pA1,pB0,pB1,t+1,true,true,true);   WAIT_BAR(3); RESC(); ROT();
  }
  #undef CMASK
  #define CMASK(P0,P1,t) do{int jb_=(t)-(NT-4); if(jb_>=0)cmask(P0,P1,jb_,wid);}while(0)
  #define ENDW(tt) do{ if((tt)+3<NT){WAIT_BAR(3);} else if((tt)+2<NT){WAIT_BAR(2);} else {WAIT_BAR(0);} }while(0)
  for(;t+1<NT;t+=2){
    STEP_E(pB0,pB1,pA0,pA1,t,(t+3<NT),(t+1<NT),(t+1<NT));       ENDW(t);   RESC(); ROT();
    STEP_E(pA0,pA1,pB0,pB1,t+1,(t+4<NT),(t+2<NT),(t+2<NT));     ENDW(t+1); RESC(); ROT();
  }
  STEP_E(pB0,pB1,pA0,pA1,NT-1,false,false,false); RESC();
  } else {
  #undef CMASK
  #define CMASK(P0,P1,t) do{}while(0)
  for(;t+5<NT;t+=2){
    STEP_L(pB0,pB1,pA0,pA1,t,true,true,(t>1));    WAIT_BAR(3); ROT();
    STEP_L(pA0,pA1,pB0,pB1,t+1,true,true,true);   WAIT_BAR(3); ROT();
  }
  #undef CMASK
  #define CMASK(P0,P1,t) do{int jb_=(t)-(NT-4); if(jb_>=0)cmask(P0,P1,jb_,wid);}while(0)
  for(;t+1<NT;t+=2){
    STEP_L(pB0,pB1,pA0,pA1,t,(t+3<NT),(t+1<NT),(t>1));          ENDW(t);   ROT();
    STEP_L(pA0,pA1,pB0,pB1,t+1,(t+4<NT),(t+2<NT),true);         ENDW(t+1); ROT();
  }
  STEP_L(pB0,pB1,pA0,pA1,NT-1,false,false,true);
  PART_B(pB0,pB1,sl_prev,sl_cur,false); RESC();
  }
  { float sacc=pB0[0]+pB0[1]; _Pragma("unroll") for(int r=2;r<16;++r)sacc+=pB0[r]; _Pragma("unroll") for(int r=0;r<16;++r)sacc+=pB1[r]; l_reg+=sacc;
    pw0=(u32x4){PKW(pB0,0),PKW(pB0,2),PKW(pB0,4),PKW(pB0,6)};pw1=(u32x4){PKW(pB0,8),PKW(pB0,10),PKW(pB0,12),PKW(pB0,14)};pw2=(u32x4){PKW(pB1,0),PKW(pB1,2),PKW(pB1,4),PKW(pB1,6)};pw3=(u32x4){PKW(pB1,8),PKW(pB1,10),PKW(pB1,12),PKW(pB1,14)};
    SBAR(); pv(o,vb0+2*sl_cur,PAF(0),PAF(1),PAF(2),PAF(3)); }
  #undef PKW
  #undef PAF
  #undef VFR
  #undef PIN
  #undef MX3
  #undef GAPA
  #undef GAPB
  #undef GAPB2
  #undef VRD2
  #undef EX
  #undef VRD
  #undef KRD
  #undef STEP_E
  #undef STEP_L
  #undef PART_A
  #undef PART_B
  #undef MID
  #undef SL_PP
  #undef ENDW
  {auto rr=__builtin_amdgcn_permlane32_swap(__float_as_uint(l_reg),__float_as_uint(l_reg),false,false);l_reg=__uint_as_float(rr[0])+__uint_as_float(rr[1]);}
  if(hi==0)wsf[32+r32]=l_reg;asm volatile("s_waitcnt lgkmcnt(0)":::"memory");
  float rli[16];
  #pragma unroll
  for(int r=0;r<16;++r)rli[r]=__builtin_amdgcn_rcpf(wsf[32+crow(r,hi)]);
  bf16*Ow=O+(rowbase+q0+wid*QBLK)*DM+vcol;
  asm volatile("s_waitcnt lgkmcnt(0)\n\ts_barrier":::"memory");
  { bf16*stg=(bf16*)(shm+LDS_OST)+wid*2048;
    #pragma unroll
    for(int hf=0;hf<2;++hf){
    #pragma unroll
    for(int r=0;r<16;++r){const int orow=crow(r,hi);
      #pragma unroll
      for(int d0=0;d0<2;++d0)stg[orow*64+d0*32+r32]=__float2bfloat16(o[2*hf+d0][r]*rli[r]);}
    asm volatile("s_waitcnt lgkmcnt(0)":::"memory");
    #pragma unroll
    for(int i=0;i<4;++i){const int row=i*8+(lane>>3),ch=lane&7; const u32x4 v=*(const u32x4*)(stg+row*64+ch*8); ATTN_STORE16(Ow+(long)row*DM+hf*64+ch*8,v);}
    asm volatile("s_waitcnt lgkmcnt(0)":::"memory"); } }
  asm volatile("s_waitcnt lgkmcnt(0)\n\ts_barrier":::"memory");
  #undef DMA_K
  #undef DMA_V
  #undef CMASK
  #undef START
  #undef RESC
  #undef ROT
}
constexpr int ATTN_LDS_BYTES=LDS_BYTES;
struct AttnTensors { const bf16* Q; const bf16* K; const bf16* V; bf16* O; };
struct AttnUnit { int var; int qb; };
struct StaticOrder {
  int vcu;
  __device__ __forceinline__ explicit StaticOrder(int v):vcu(v){}
  __device__ __forceinline__ bool next(int i,AttnUnit&u)const{ if(i>=2)return false; const int s=vcu&31; u.var=vcu>>5; u.qb=(i==0)?s:63-s; return true; }
};
template<class Sched,int THRL=8> __device__ __forceinline__ void attn_phase(char*lds,const AttnTensors&T,const Sched&S){
  AttnUnit u;
  for(int i=0;S.next(i,u);++i){ const int h=u.var>>1,mp=u.var&1;
    if((__builtin_amdgcn_readfirstlane(threadIdx.x>>6)&1)==0) attn_unit<THRL,false>(h*128+mp*64,h*128,u.qb,T.Q,T.K,T.V,T.O+(size_t)mp*SEQ*DM,lds);
    else                                                 attn_unit<THRL,true >(h*128+mp*64,h*128,u.qb,T.Q,T.K,T.V,T.O+(size_t)mp*SEQ*DM,lds); }
}
#undef SBAR
#undef WAIT_BAR
}


#define GAS __attribute__((address_space(1)))
#define LAS __attribute__((address_space(3)))
typedef unsigned short bf16;
typedef unsigned v4u __attribute__((ext_vector_type(4)));
typedef float f32x4 __attribute__((ext_vector_type(4)));
typedef short bf16x8 __attribute__((ext_vector_type(8)));
typedef GAS unsigned gu32;
typedef GAS unsigned long long gu64;
#define RLX_AGENT __ATOMIC_RELAXED, __HIP_MEMORY_SCOPE_AGENT
#define LDS_WAIT() asm volatile("s_waitcnt lgkmcnt(0)" ::: "memory")
#define VM_WAIT() asm volatile("s_waitcnt vmcnt(0)" ::: "memory")
__device__ __forceinline__ unsigned long long rt() { return __builtin_amdgcn_s_memrealtime(); }
__device__ __forceinline__ unsigned f2bf(float f) { unsigned u = __builtin_bit_cast(unsigned, f); return (u + 0x7fffu + ((u >> 16) & 1u)) >> 16; }
__device__ __forceinline__ unsigned pk2(float lo, float hi) { return f2bf(lo) | (f2bf(hi) << 16); }

#define XB_TMO      128
#define XB_XCNT(j)  (256  + 64 * (j))
#define XB_XSUB(j)  (1280 + 64 * (j))
#define XB_XGEN(j)  (2304 + 64 * (j))
#define XB_TOP      3328
#define XB_TOPGEN   3392
#define XCD_BAR_WORDS 3456
#define XB_SPIN_CAP (1u << 18)

__device__ __forceinline__ unsigned xb_ld(unsigned* p)              { return __hip_atomic_load(p, __ATOMIC_RELAXED, __HIP_MEMORY_SCOPE_AGENT); }
__device__ __forceinline__ unsigned xb_add(unsigned* p, unsigned v) { return __hip_atomic_fetch_add(p, v, __ATOMIC_RELAXED, __HIP_MEMORY_SCOPE_AGENT); }
__device__ __forceinline__ unsigned xb_xcc_id() { return (unsigned)__builtin_amdgcn_s_getreg((3 << 11) | 20) & 0xFu; }
#define XB_SPIN(cond, bar) do { unsigned _sp = 0; while (cond) { __builtin_amdgcn_s_sleep(1); \
    if ((++_sp & 255u) == 0u) { if (xb_ld(&(bar)[XB_TMO])) break; if (_sp > XB_SPIN_CAP) { atomicAdd(&(bar)[XB_TMO], 1u); break; } } } } while (0)

struct XcdBarrier {
    unsigned* bar; unsigned x;
    volatile LAS unsigned* st;
};

__device__ __forceinline__ XcdBarrier xcd_barrier_post(unsigned* bar, volatile LAS unsigned* st) {
    XcdBarrier b; b.bar = bar; b.x = xb_xcc_id(); b.st = st;
    if (threadIdx.x == 0) (void)xb_add(&bar[XB_XCNT(b.x)], 1u);
    return b;
}
__device__ __forceinline__ void xcd_barrier_complete(unsigned* bar, unsigned x, unsigned& nloc, unsigned& nx) {
    const unsigned G = gridDim.x * gridDim.y * gridDim.z;
    unsigned sum, cnt, mine, sp = 0u;
    for (;;) {
        sum = 0u; cnt = 0u; mine = 0u;
#pragma unroll
        for (unsigned j = 0; j < 16; ++j) { const unsigned c = xb_ld(&bar[XB_XCNT(j)]); sum += c; cnt += (c > 0u) ? 1u : 0u; mine = (j == x) ? c : mine; }
        if (sum == G) break;
        __builtin_amdgcn_s_sleep(1);
        if ((++sp & 255u) == 0u) { if (xb_ld(&bar[XB_TMO])) break; if (sp > XB_SPIN_CAP) { atomicAdd(&bar[XB_TMO], 1u); break; } }
    }
    nloc = mine > 0u ? mine : 1u; nx = cnt > 0u ? cnt : 1u;
}

__device__ __forceinline__ void xcd_barrier(const XcdBarrier& b) {
    asm volatile("s_waitcnt vmcnt(0)" ::: "memory");
    __syncthreads();
    if (threadIdx.x == 0) {
        unsigned* bar = b.bar;
        __builtin_amdgcn_s_waitcnt(0);
        unsigned nloc = b.st[0], nx = b.st[1];
        if (nloc == 0u) { xcd_barrier_complete(bar, b.x, nloc, nx); b.st[0] = nloc; b.st[1] = nx; }
        const unsigned old = xb_add(&bar[XB_XSUB(b.x)], 1u);
        const unsigned gen = old / nloc;
        if (old + 1u == (gen + 1u) * nloc) {
            __builtin_amdgcn_fence(__ATOMIC_RELEASE, "agent");
            asm volatile("s_waitcnt vmcnt(0)" ::: "memory");
            const unsigned og = xb_add(&bar[XB_TOP], 1u);
            const unsigned tg = og / nx;
            if (og + 1u == (tg + 1u) * nx) xb_add(&bar[XB_TOPGEN], 1u);
            else XB_SPIN(xb_ld(&bar[XB_TOPGEN]) == tg, bar);
            __builtin_amdgcn_fence(__ATOMIC_ACQUIRE, "agent");
            xb_add(&bar[XB_XGEN(b.x)], 1u);
            asm volatile("s_waitcnt vmcnt(0)" ::: "memory");
        } else {
            XB_SPIN(xb_ld(&bar[XB_XGEN(b.x)]) == gen, bar);
            __builtin_amdgcn_fence(__ATOMIC_ACQUIRE, "agent");
            asm volatile("s_waitcnt vmcnt(0)" ::: "memory");
        }
    }
    __syncthreads();
}

constexpr int NWAVES = 8;
constexpr int M = 16384, D = 1024, INC = 2560, AW = 512, LW = 512, NQ = 2048, NEXP = 16384;
constexpr float EPSN = 1e-6f;
constexpr size_t MiB = 1u << 20;
constexpr size_t WS_CTL = 0, CTL_ZERO_BYTES = 1 * MiB;
constexpr size_t WS_ROWSS2 = 512 * 1024;
constexpr size_t WS_RS1 = 1 * MiB;
constexpr size_t WS_SK1 = 1 * MiB + 128 * 1024, WS_SK2 = WS_SK1 + 32 * 1024;
constexpr size_t WS_WGF = 1 * MiB + 256 * 1024;
constexpr size_t WS_WIN = 2 * MiB, WS_WOUT = 8 * MiB, WS_WQ = 10 * MiB;
constexpr size_t WS_ED = 16 * MiB, WS_EU = 48 * MiB;
constexpr size_t WS_SCD = 32 * MiB, WS_SCU = 33 * MiB;
constexpr size_t WS_WQ8 = 170 * MiB;
constexpr size_t WS_XB = 80 * MiB;
constexpr size_t WS_CARRY = 34 * MiB;
constexpr size_t WS_Q2 = 80 * MiB;
constexpr size_t WS_Q = 112 * MiB, WS_SPLIT = 16 * MiB;
constexpr size_t WS_GATE = WS_Q + 4 * WS_SPLIT;
constexpr size_t WS_EID = 144 * MiB, WS_GW = 152 * MiB;
constexpr size_t WS_MIX = 192 * MiB, WS_HB = 224 * MiB, WS_END = 256 * MiB;
constexpr size_t WS_ROWSS3 = 576 * 1024;
constexpr size_t WS_DOTP = 80 * MiB;
constexpr size_t WS_REC = 160 * MiB, WS_N0 = 168 * MiB;
constexpr size_t WS_PEER = 80 * MiB;
constexpr size_t WS_REC_OLD_UNUSED = 0;
constexpr int CW_BAR = 4096;
constexpr int RING_OFF = 0, RING_BYTES = 131072;
constexpr int LDSCTL_OFF = RING_BYTES, MISC_OFF = LDSCTL_OFF + 320;
constexpr int LDS_BYTES = 163840;

struct Frame {
    LAS unsigned char* lds;
    volatile LAS unsigned* MISC;
    int tid, lane, wave;
    int vcu, G;
};

__device__ __forceinline__ float wave_sum(float v) {
#pragma unroll
    for (int o = 1; o < 64; o <<= 1) v += __shfl_xor(v, o);
    return v;
}
__device__ __forceinline__ float bf2f(unsigned short b) { return __builtin_bit_cast(float, (unsigned)b << 16); }
__device__ __forceinline__ float bflo(unsigned w) { return __builtin_bit_cast(float, w << 16); }
__device__ __forceinline__ float bfhi(unsigned w) { return __builtin_bit_cast(float, w & 0xffff0000u); }
__device__ __forceinline__ float gelu_tanh(float x) { const float u = 0.7978845608028654f * (x + 0.044715f * x * x * x); return 0.5f * x * (1.0f + tanhf(u)); }
__device__ __forceinline__ float sigmoidf_(float x) { return 1.0f / (1.0f + expf(-x)); }
__device__ __forceinline__ float fsigmoid(float x) { return __builtin_amdgcn_rcpf(1.0f + __builtin_amdgcn_exp2f(-1.4426950408889634f * x)); }
__device__ __forceinline__ float fgelu_tanh(float x) { const float u = 0.7978845608028654f * (x + 0.044715f * x * x * x); const float t = 1.0f - 2.0f * __builtin_amdgcn_rcpf(1.0f + __builtin_amdgcn_exp2f(2.8853900817779268f * u)); return 0.5f * x * (1.0f + t); }

__device__ __forceinline__ void p0_transpose_item(const float* W, int K, int N, bf16* WT, const float* gk, LAS float* scr, int item, int lane) {
    const int nblk = N / 32, kb = item / nblk, nb = item % nblk, k0 = 64 * kb, n0 = 32 * nb;
    float wv[32];
#pragma unroll
    for (int i = 0; i < 32; ++i) { const int kk = 2 * i + (lane >> 5); wv[i] = W[(size_t)(k0 + kk) * N + n0 + (lane & 31)]; }
#pragma unroll
    for (int i = 0; i < 32; ++i) { const int kk = 2 * i + (lane >> 5); const float g = gk ? gk[k0 + kk] : 1.0f; scr[kk * 33 + (lane & 31)] = wv[i] * g; }
    LDS_WAIT(); asm volatile("" ::: "memory");
    const int c = lane & 7;
#pragma unroll
    for (int j = 0; j < 4; ++j) { const int n = (lane >> 3) + 8 * j; const LAS float* s = scr + (8 * c) * 33 + n;
        v4u o; o.x = pk2(s[0 * 33], s[1 * 33]); o.y = pk2(s[2 * 33], s[3 * 33]); o.z = pk2(s[4 * 33], s[5 * 33]); o.w = pk2(s[6 * 33], s[7 * 33]);
        *(GAS v4u*)(WT + (size_t)(n0 + n) * K + k0 + 8 * c) = o; }
    LDS_WAIT(); asm volatile("" ::: "memory");
}
template <int NR> __device__ __forceinline__ void p0_rows(const float* xrow, bf16* orow, const float* gk, float* rs, int lane) {
    f32x4 v[NR][4];
#pragma unroll
    for (int i = 0; i < NR; ++i)
#pragma unroll
        for (int j = 0; j < 4; ++j) v[i][j] = __builtin_nontemporal_load((const GAS f32x4*)(xrow + (size_t)i * 1024) + lane + 64 * j);
#pragma unroll
    for (int i = 0; i < NR; ++i) {
        if (rs) { float s = 0.f;
#pragma unroll
            for (int j = 0; j < 4; ++j) s += (v[i][j].x * v[i][j].x + v[i][j].y * v[i][j].y) + (v[i][j].z * v[i][j].z + v[i][j].w * v[i][j].w);
            const float tot = wave_sum(s); if (lane == 0) rs[i] = 1.0f / sqrtf(tot * (1.0f / 1024.0f) + EPSN); }
        if (gk) {
#pragma unroll
            for (int j = 0; j < 4; ++j) v[i][j] = v[i][j] * ((const GAS f32x4*)gk)[lane + 64 * j]; }
        GAS unsigned long long* o8 = (GAS unsigned long long*)(orow + (size_t)i * 1024) + lane;
#pragma unroll
        for (int j = 0; j < 4; ++j) o8[64 * j] = (unsigned long long)pk2(v[i][j].x, v[i][j].y) | ((unsigned long long)pk2(v[i][j].z, v[i][j].w) << 32);
    }
}

struct Args { const float* in[23]; float* out; unsigned char* ws; int ph_lo, ph_hi; };

__device__ __forceinline__ void p0_prologue(Frame& F, const Args& a) {
    LAS float* scr = (LAS float*)(F.lds + RING_OFF + F.wave * 16384);
    unsigned char* ws = a.ws;
    const int gw = F.vcu * NWAVES + F.wave, NGW = F.G * NWAVES;
    constexpr int I_IN = (D / 64) * (INC / 32), I_OUT = (D / 64) * (D / 32), I_Q = (D / 64) * (NQ / 32);
    constexpr int NITEMS = I_IN + I_OUT + I_Q;
    for (int it = F.wave * (int)F.G + F.vcu; it < NITEMS; it += NGW) {
        int r = it;
        if (r < I_IN) { p0_transpose_item(a.in[2], D, INC, (bf16*)(ws + WS_WIN), a.in[1], scr, r, F.lane); continue; } r -= I_IN;
        if (r < I_OUT) { p0_transpose_item(a.in[15], D, D, (bf16*)(ws + WS_WOUT), nullptr, scr, r, F.lane); continue; } r -= I_OUT;
        p0_transpose_item(a.in[17], D, NQ, (bf16*)(ws + WS_WQ), a.in[16], scr, r, F.lane);
    }
    for (int i = (F.wave * (int)F.G + F.vcu) * 64 + F.lane; i < 8192; i += NGW * 64) {
        const int ln = i & 63, ks = (i >> 6) & 3, et = (i >> 8) & 1, n = (i >> 9) & 7, gt = i >> 12, r32 = ln & 31, hi = ln >> 5;
        const float* w = a.in[gt ? 12 : 10] + n * 4096 + 32 * et + (16 * ks + 8 * hi) * 64 + r32;
        *(GAS v4u*)(ws + WS_WGF + (size_t)i * 16) = (v4u){pk2(w[0], w[64]), pk2(w[128], w[192]), pk2(w[256], w[320]), pk2(w[384], w[448])}; }
    for (int m = gw; m < M / 8; m += NGW) { const int r = 8 * m; p0_rows<8>(a.in[0] + (size_t)r * D, (bf16*)(ws + WS_XB) + (size_t)r * D, nullptr, (float*)(ws + WS_RS1) + r, F.lane); }
    for (int m = F.wave * (int)F.G + F.vcu; m < 8; m += NGW) { const int r = 4 * m;
        if (r < 16) p0_rows<4>(a.in[18] + (size_t)r * 1024, (bf16*)(ws + WS_SK1) + (size_t)r * 1024, nullptr, nullptr, F.lane);
        else        p0_rows<4>(a.in[19] + (size_t)(r - 16) * 1024, (bf16*)(ws + WS_SK2) + (size_t)(r - 16) * 1024, nullptr, nullptr, F.lane); }
}
template <int NR> __device__ __forceinline__ void q8_load(f32x4 (&v)[NR][4], const float* xrow, int lane) {
#pragma unroll
    for (int i = 0; i < NR; ++i)
#pragma unroll
        for (int j = 0; j < 4; ++j) v[i][j] = __builtin_nontemporal_load((const GAS f32x4*)(xrow + (size_t)i * 1024) + lane + 64 * j);
}
template <int NR> __device__ __forceinline__ void q8_finish(f32x4 (&v)[NR][4], unsigned char* orow, const float* gk, float* scale, int lane) {
#pragma unroll
    for (int i = 0; i < NR; ++i) {
        float am = 0.f;
#pragma unroll
        for (int j = 0; j < 4; ++j) { if (gk) v[i][j] = v[i][j] * ((const GAS f32x4*)gk)[lane + 64 * j];
            am = fmaxf(fmaxf(am, fmaxf(fabsf(v[i][j].x), fabsf(v[i][j].y))), fmaxf(fabsf(v[i][j].z), fabsf(v[i][j].w))); }
#pragma unroll
        for (int o = 1; o < 64; o <<= 1) am = fmaxf(am, __shfl_xor(am, o));
        const float sc = (am > 0.f) ? am * (1.0f / 127.0f) : 1.0f, inv = 1.0f / sc;
        if (lane == 0) scale[i] = sc;
        GAS unsigned* o4 = (GAS unsigned*)(orow + (size_t)i * 128 + (size_t)(lane >> 5) * ((size_t)NEXP * 128)) + (lane & 31);
#pragma unroll
        for (int j = 0; j < 4; ++j) { const int q0 = (int)__builtin_rintf(v[i][j].x * inv), q1 = (int)__builtin_rintf(v[i][j].y * inv), q2 = (int)__builtin_rintf(v[i][j].z * inv), q3 = (int)__builtin_rintf(v[i][j].w * inv);
            o4[(size_t)j * (2 * (size_t)NEXP * 128 / 4)] = ((unsigned)q0 & 255u) | (((unsigned)q1 & 255u) << 8) | (((unsigned)q2 & 255u) << 16) | ((unsigned)q3 << 24); }
    }
}
__device__ __forceinline__ const float* cvx_src(const Args& a, int m) { const int r = 4 * m; return (r < NEXP) ? a.in[20] + (size_t)r * D : a.in[21] + (size_t)(r - NEXP) * D; }
__device__ __forceinline__ void cvx_finish(const Args& a, f32x4 (&v)[4][4], int m, int lane) {
    unsigned char* ws = a.ws; const int r = 4 * m;
    if (r < NEXP) q8_finish<4>(v, ws + WS_ED + (size_t)r * 128, a.in[16], (float*)(ws + WS_SCD) + r, lane);
    else          q8_finish<4>(v, ws + WS_EU + (size_t)(r - NEXP) * 128, nullptr, (float*)(ws + WS_SCU) + (r - NEXP), lane);
}
__device__ __forceinline__ void convert_experts(const Args& a, int w, int nw, int lane) {
    constexpr int TOT = NEXP / 4;
    int m = w; if (m >= TOT) return;
    f32x4 va[4][4], vb[4][4];
    q8_load<4>(va, cvx_src(a, m), lane);
    for (;;) {
        const bool hb = m + nw < TOT; if (hb) q8_load<4>(vb, cvx_src(a, m + nw), lane);
        cvx_finish(a, va, m, lane);
        if (!hb) break;
        const bool ha = m + 2 * nw < TOT; if (ha) q8_load<4>(va, cvx_src(a, m + 2 * nw), lane);
        cvx_finish(a, vb, m + nw, lane);
        if (!ha) break;
        m += 2 * nw;
    }
}

typedef float f32x16 __attribute__((ext_vector_type(16)));
typedef float f32x2 __attribute__((ext_vector_type(2)));
__device__ __forceinline__ void lru_local_unit(Frame& F, const Args& a, int c) {
    constexpr int YP = 520;
    LAS unsigned short* Y = (LAS unsigned short*)(F.lds + RING_OFF);
    const int e = F.tid, r0 = c * 64;
    const bf16* XR = (const bf16*)(a.ws + WS_Q + 3 * WS_SPLIT);
    unsigned* HLAC = (unsigned*)a.out;
    float* CH = (float*)(a.ws + WS_CARRY); float* CA = CH + (size_t)(M / 64) * 512;
    {
        const int p = F.tid & 255, hh = F.tid >> 8; const float* conv_w = a.in[8];
        const f32x2 c0 = *(const GAS f32x2*)(conv_w + 2 * p), c1 = *(const GAS f32x2*)(conv_w + 512 + 2 * p), c2 = *(const GAS f32x2*)(conv_w + 1024 + 2 * p), c3 = *(const GAS f32x2*)(conv_w + 1536 + 2 * p), cb = *(const GAS f32x2*)(a.in[9] + 2 * p);
        unsigned xv[35];
        const int rb = r0 + 32 * hh - 3;
#pragma unroll
        for (int i = 0; i < 35; ++i) xv[i] = (rb + i >= 0) ? *(const GAS unsigned*)(XR + (size_t)(rb + i) * 512 + 2 * p) : 0u;
#pragma unroll
        for (int i = 0; i < 32; ++i) {
            const float lo = cb.x + bflo(xv[i]) * c0.x + bflo(xv[i + 1]) * c1.x + bflo(xv[i + 2]) * c2.x + bflo(xv[i + 3]) * c3.x;
            const float hi2 = cb.y + bfhi(xv[i]) * c0.y + bfhi(xv[i + 1]) * c1.y + bfhi(xv[i + 2]) * c2.y + bfhi(xv[i + 3]) * c3.y;
            *(LAS unsigned*)(Y + (32 * hh + i) * YP + 2 * p) = pk2(lo, hi2); } }
    __syncthreads();
    const int n = F.wave, lane = F.lane, r32 = lane & 31, hi = lane >> 5;
#pragma unroll 1
    for (int et = 0; et < 2; ++et) {
        bf16x8 wf[2][4];
#pragma unroll
        for (int gt = 0; gt < 2; ++gt)
#pragma unroll
            for (int ks = 0; ks < 4; ++ks) wf[gt][ks] = *(const GAS bf16x8*)(a.ws + WS_WGF + (size_t)(((((gt * 8 + n) * 2 + et) * 4 + ks) * 64 + lane) * 16));
        const int ch = 64 * n + 32 * et + r32;
        const float ba = a.in[11][ch], bx = a.in[13][ch], lam = a.in[14][ch];
        const float sp = (lam > 15.f) ? expf(-lam) : log1pf(expf(-lam));
        float av[2][16], bv[2][16];
#pragma unroll
        for (int tt = 0; tt < 2; ++tt) {
            f32x16 ra = {}, ia = {};
#pragma unroll
            for (int ks = 0; ks < 4; ++ks) { const bf16x8 af = *(const LAS bf16x8*)(Y + (32 * tt + r32) * YP + 64 * n + 16 * ks + 8 * hi);
                ra = __builtin_amdgcn_mfma_f32_32x32x16_bf16(af, wf[0][ks], ra, 0, 0, 0); ia = __builtin_amdgcn_mfma_f32_32x32x16_bf16(af, wf[1][ks], ia, 0, 0, 0); }
#pragma unroll
            for (int r = 0; r < 16; ++r) { const int t = 32 * tt + (r & 3) + 8 * (r >> 2) + 4 * hi;
                const float rr = fsigmoid(ra[r] + ba), ii = fsigmoid(ia[r] + bx);
                const float log_a = -8.0f * rr * sp, aa = __builtin_amdgcn_exp2f(log_a * 1.4426950408889634f);
                const float u2 = 2.0f * log_a;
                const float ser = -u2 * (1.0f + u2 * (0.5f + u2 * (0.16666667f + u2 * (0.041666668f + u2 * 0.0083333338f))));
                const float om = (u2 > -0.1f) ? ser : (1.0f - aa * aa);
                const float mult = __builtin_amdgcn_sqrtf(fmaxf(om, 1e-12f));
                av[tt][r] = aa; bv[tt][r] = mult * (ii * bf2f(Y[t * YP + ch])); }
        }
#pragma unroll
        for (int tt = 0; tt < 2; ++tt)
#pragma unroll
            for (int rq = 0; rq < 4; ++rq) { float h = 0.f, pa = 1.f;
#pragma unroll
                for (int k = 0; k < 4; ++k) { const int r = 4 * rq + k; h = av[tt][r] * h + bv[tt][r]; pa *= av[tt][r]; bv[tt][r] = h; av[tt][r] = pa; } }
        float hin[8], ain[8]; float hc = 0.f, ac = 1.f;
#pragma unroll
        for (int j = 0; j < 8; ++j) { const int tt = j >> 2, r3 = 4 * (j & 3) + 3;
#pragma unroll
            for (int own = 0; own < 2; ++own) {
                if (hi == own) { hin[j] = hc; ain[j] = ac; }
                const float mh = av[tt][r3] * hc + bv[tt][r3], ma = ac * av[tt][r3];
                const float oh = __shfl_xor(mh, 32), oa = __shfl_xor(ma, 32);
                hc = (hi == own) ? mh : oh; ac = (hi == own) ? ma : oa; } }
#pragma unroll
        for (int tt = 0; tt < 2; ++tt)
            { unsigned ob = (unsigned)((r0 + 32 * tt + 4 * hi) * 512 + ch); asm volatile("" : "+v"(ob));
#pragma unroll
            for (int r = 0; r < 16; ++r) { const int j = 4 * tt + (r >> 2); const unsigned o = ob + (unsigned)(((r & 3) + 8 * (r >> 2)) * 512);
                const float hl = bv[tt][r] + av[tt][r] * hin[j], ac = av[tt][r] * ain[j];
                HLAC[o] = pk2(hl, ac);
                if (tt == 1 && r == 15 && hi == 1) { CH[c * 512 + ch] = hl; CA[c * 512 + ch] = ac; } } }
    }
    __syncthreads();
}

__device__ __forceinline__ void fix_unit(Frame& F, const Args& a, int c, float lamv) {
    const int r0 = c * 64;
    const unsigned* HLAC = (const unsigned*)a.out; const float* CH = (const float*)(a.ws + WS_CARRY); const float* CA = CH + (size_t)(M / 64) * 512;
    const bf16* GATE = (const bf16*)(a.ws + WS_GATE);
    bf16* MIX = (bf16*)(a.ws + WS_MIX);
    const int g4 = F.tid & 127, sgm = F.tid >> 7;
    LAS f32x4* SA = (LAS f32x4*)(F.lds + RING_OFF); LAS f32x4* SH = SA + 512;
    { const int L = (c + 3) >> 2; const int lo_c = sgm * L; int hi_c = lo_c + L; if (hi_c > c) hi_c = c;
      f32x4 A4 = (f32x4){1.f, 1.f, 1.f, 1.f}, H4 = (f32x4){0.f, 0.f, 0.f, 0.f};
      int cc = lo_c;
      for (; cc + 8 <= hi_c; cc += 8) { f32x4 av[8], hv[8];
#pragma unroll
          for (int k = 0; k < 8; ++k) { const size_t o = (size_t)(cc + k) * 512 + 4 * g4; av[k] = *(const GAS f32x4*)(CA + o); hv[k] = *(const GAS f32x4*)(CH + o); }
#pragma unroll
          for (int k = 0; k < 8; ++k) { H4 = av[k] * H4 + hv[k]; A4 = A4 * av[k]; } }
      for (; cc < hi_c; ++cc) { const size_t o = (size_t)cc * 512 + 4 * g4; const f32x4 av = *(const GAS f32x4*)(CA + o), hv = *(const GAS f32x4*)(CH + o); H4 = av * H4 + hv; A4 = A4 * av; }
      SA[sgm * 128 + g4] = A4; SH[sgm * 128 + g4] = H4; }
    __syncthreads();
    f32x4 hin = (f32x4){0.f, 0.f, 0.f, 0.f};
#pragma unroll
    for (int sq = 0; sq < 4; ++sq) hin = SA[sq * 128 + g4] * hin + SH[sq * 128 + g4];
    __syncthreads();
#pragma unroll 4
    for (int t = sgm * 16; t < sgm * 16 + 16; ++t) { const size_t o = (size_t)(r0 + t) * 512 + 4 * g4;
        const v4u ha = *(const GAS v4u*)(HLAC + o);
        const f32x4 h = (f32x4){bflo(ha.x), bflo(ha.y), bflo(ha.z), bflo(ha.w)} + (f32x4){bfhi(ha.x), bfhi(ha.y), bfhi(ha.z), bfhi(ha.w)} * hin; const unsigned long long gw = *(const GAS unsigned long long*)(GATE + o);
        const unsigned glo = (unsigned)gw, ghi = (unsigned)(gw >> 32);
        const unsigned long long ov = (unsigned long long)pk2(h.x * fgelu_tanh(bflo(glo)), h.y * fgelu_tanh(bfhi(glo))) | ((unsigned long long)pk2(h.z * fgelu_tanh(bflo(ghi)), h.w * fgelu_tanh(bfhi(ghi))) << 32);
        *(GAS unsigned long long*)(MIX + (size_t)(r0 + t) * 1024 + 512 + 4 * g4) = ov; }
    const bf16* OS0 = (const bf16*)(a.out + (size_t)M * 512); const bf16* OS1 = OS0 + (size_t)M * 512;
    const float* sg = a.in[7] + (F.lane & 15) * 8;
    float sgv[8];
#pragma unroll
    for (int j = 0; j < 8; ++j) sgv[j] = sg[j] * 0.8f;
#pragma unroll 2
    for (int rr = 0; rr < 8; ++rr) { const size_t row = (size_t)(r0 + 8 * F.wave + rr);
        const v4u p = *(const GAS v4u*)(OS0 + row * 512 + F.lane * 8), q = *(const GAS v4u*)(OS1 + row * 512 + F.lane * 8);
        float d[8];
        d[0] = bflo(p.x) - lamv * bflo(q.x); d[1] = bfhi(p.x) - lamv * bfhi(q.x); d[2] = bflo(p.y) - lamv * bflo(q.y); d[3] = bfhi(p.y) - lamv * bfhi(q.y);
        d[4] = bflo(p.z) - lamv * bflo(q.z); d[5] = bfhi(p.z) - lamv * bfhi(q.z); d[6] = bflo(p.w) - lamv * bflo(q.w); d[7] = bfhi(p.w) - lamv * bfhi(q.w);
        float ss = 0.f;
#pragma unroll
        for (int j = 0; j < 8; ++j) ss += d[j] * d[j];
        ss += __shfl_xor(ss, 1); ss += __shfl_xor(ss, 2); ss += __shfl_xor(ss, 4); ss += __shfl_xor(ss, 8);
        const float ri = 1.0f / sqrtf(ss * (1.0f / 128.0f) + EPSN);
        v4u o; o.x = pk2(d[0] * ri * sgv[0], d[1] * ri * sgv[1]); o.y = pk2(d[2] * ri * sgv[2], d[3] * ri * sgv[3]);
        o.z = pk2(d[4] * ri * sgv[4], d[5] * ri * sgv[5]); o.w = pk2(d[6] * ri * sgv[6], d[7] * ri * sgv[7]);
        *(GAS v4u*)(MIX + row * 1024 + F.lane * 8) = o; }
}

typedef float f32x16 __attribute__((ext_vector_type(16)));
#define CEX(a, b) do { const float _hi = fmaxf(a, b), _lo = fminf(a, b); a = _hi; b = _lo; } while (0)
__device__ __forceinline__ int skey(int b) { return b ^ ((b >> 31) & 0x7fffffff); }
#define CEI(a, b) do { const int _hi = max(a, b), _lo = min(a, b); a = _hi; b = _lo; } while (0)
__device__ __forceinline__ void sort16_desc(int (&v)[16]) {
#pragma unroll
    for (int p = 1; p < 16; p <<= 1)
#pragma unroll
        for (int k = p; k >= 1; k >>= 1)
#pragma unroll
            for (int j = k % p; j + k < 16; j += 2 * k)
#pragma unroll
                for (int i = 0; i < k; ++i) if (i + j + k < 16 && (i + j) / (2 * p) == (i + j + k) / (2 * p)) CEI(v[i + j], v[i + j + k]);
}
__device__ __forceinline__ void merge16_desc(int (&a)[16], const int (&b)[16]) {
#pragma unroll
    for (int i = 0; i < 16; ++i) a[i] = max(a[i], b[15 - i]);
#pragma unroll
    for (int j = 8; j >= 1; j >>= 1)
#pragma unroll
        for (int i = 0; i < 16; ++i) if ((i & j) == 0) CEI(a[i], a[i + j]);
}
__device__ __forceinline__ void top16_half(int (&top)[16], const bf16* q, const LAS unsigned char* sk, int r32, int hi) {
    bf16x8 qf[8];
#pragma unroll
    for (int ks = 0; ks < 8; ++ks) qf[ks] = *(const GAS bf16x8*)(q + 16 * ks + 8 * hi);
#pragma unroll
    for (int i = 0; i < 16; ++i) top[i] = (int)0x80000000;
#pragma unroll 1
    for (int kt = 0; kt < 4; ++kt) {
        f32x16 acc = {};
#pragma unroll
        for (int ks = 0; ks < 8; ++ks) { const bf16x8 kf = *(const LAS bf16x8*)(sk + (32 * kt + r32) * 272 + (16 * ks + 8 * hi) * 2); acc = __builtin_amdgcn_mfma_f32_32x32x16_bf16(kf, qf[ks], acc, 0, 0, 0); }
        int grp[16];
#pragma unroll
        for (int r = 0; r < 16; ++r) { const int idx = 32 * kt + (r & 3) + 8 * (r >> 2) + 4 * hi; const float av = acc[r];
            grp[r] = (skey(__float_as_int(av)) & ~127) | idx; }
        sort16_desc(grp); merge16_desc(top, grp);
    }
    int oth[16];
#pragma unroll
    for (int i = 0; i < 16; ++i) oth[i] = __shfl_xor(top[i], 32);
    merge16_desc(top, oth);
}
__device__ __forceinline__ void route_tops(const Args& a, int g, int hd, int lane, const LAS unsigned char* skl, int (&k1)[16], int (&k2)[16]) {
    const int r32 = lane & 31, hi = lane >> 5; const int t = g * 32 + r32;
    const bf16* q = (const bf16*)(a.ws + WS_Q2) + (size_t)t * NQ + hd * 256;
    top16_half(k1, q, skl, r32, hi);
    top16_half(k2, q + 128, skl + 128 * 272, r32, hi);
}
__device__ __forceinline__ void route_finish(const Args& a, int t, int hd, LAS unsigned char* slot, const int (&k1)[16], const int (&k2)[16]) {
    { v4u w1, w2;
#define IDX4(v, j) (((unsigned)v[4 * (j)] & 127u) | (((unsigned)v[4 * (j) + 1] & 127u) << 8) | (((unsigned)v[4 * (j) + 2] & 127u) << 16) | (((unsigned)v[4 * (j) + 3] & 127u) << 24))
      w1 = (v4u){IDX4(k1, 0), IDX4(k1, 1), IDX4(k1, 2), IDX4(k1, 3)}; w2 = (v4u){IDX4(k2, 0), IDX4(k2, 1), IDX4(k2, 2), IDX4(k2, 3)};
#undef IDX4
      *(LAS v4u*)(slot) = w1; *(LAS v4u*)(slot + 16) = w2; }
    float v1[16], v2[16];
#pragma unroll
    for (int i = 0; i < 16; ++i) { v1[i] = __int_as_float(skey(k1[i])); v2[i] = __int_as_float(skey(k2[i])); }
#define CKEY(ia, ib) ((skey(__float_as_int(v1[ia] + v2[ib])) & ~255) | ((ia) * 16 + (ib)))
    int K[16], G1[16], G2[16];
#pragma unroll
    for (int i = 0; i < 16; ++i) K[i] = CKEY(0, i);
    { int n_ = 0;
#pragma unroll
      for (int ia = 1; ia < 16; ++ia)
#pragma unroll
          for (int ib = 0; ib < 16; ++ib) if ((ia + 1) * (ib + 1) <= 16) { const int kk = CKEY(ia, ib); if (n_ < 16) G1[n_] = kk; else if (n_ < 32) G2[n_ - 16] = kk; ++n_; }
    }
    sort16_desc(G1); merge16_desc(K, G1);
    sort16_desc(G2); merge16_desc(K, G2);
    { int x0 = CKEY(14, 0), x1 = CKEY(15, 0);
#pragma unroll
      for (int i = 0; i < 16; ++i) { CEI(K[i], x0); }
#pragma unroll
      for (int i = 0; i < 16; ++i) { CEI(K[i], x1); }
    }
#undef CKEY
    unsigned P[16]; float sc[16];
#pragma unroll
    for (int i = 0; i < 16; ++i) { const unsigned ci = (unsigned)K[i] & 255u; const unsigned i1 = slot[ci >> 4], i2 = slot[16 + (ci & 15u)]; P[i] = i1 * 128u + i2; sc[i] = __int_as_float(skey(K[i] & ~255)); }
    float ex[16], sum = 0.f;
#pragma unroll
    for (int i = 0; i < 16; ++i) { ex[i] = __builtin_amdgcn_exp2f((sc[i] - sc[0]) * 1.4426950408889634f); sum += ex[i]; }
    const float inv = 1.0f / sum;
    {
        GAS v4u* ro = (GAS v4u*)((unsigned*)(a.ws + WS_REC) + (size_t)t * 128 + hd * 16);
#pragma unroll
        for (int j = 0; j < 4; ++j) ro[j] = (v4u){P[4 * j] | (f2bf(ex[4 * j] * inv) << 16), P[4 * j + 1] | (f2bf(ex[4 * j + 1] * inv) << 16), P[4 * j + 2] | (f2bf(ex[4 * j + 2] * inv) << 16), P[4 * j + 3] | (f2bf(ex[4 * j + 3] * inv) << 16)};
    }
}

__device__ __forceinline__ float wave_max(float v) {
#pragma unroll
    for (int o = 1; o < 64; o <<= 1) v = fmaxf(v, __shfl_xor(v, o));
    return v;
}
__device__ __forceinline__ void route_unit_ref(const Args& a, int t, int hd, int lane, LAS float* sc) {
    LAS unsigned* sci = (LAS unsigned*)sc;
    const bf16* q = (const bf16*)(a.ws + WS_Q2) + (size_t)t * NQ + hd * 256;
#pragma unroll 1
    for (int half = 0; half < 2; ++half) {
        const float* sk = a.in[18 + half];
        float sa = 0.f, sb = 0.f;
        for (int d = 0; d < 128; ++d) { const float qv = bf2f(q[half * 128 + d]); sa += qv * sk[lane * 128 + d]; sb += qv * sk[(lane + 64) * 128 + d]; }
        for (int r = 0; r < 16; ++r) {
            const float mx = wave_max(fmaxf(sa, sb));
            const unsigned long long ba = __ballot(sa == mx), bb = __ballot(sb == mx);
            int key;
            if (ba) { const int ln = __ffsll((long long)ba) - 1; key = ln; if (lane == ln) sa = -INFINITY; }
            else { const int ln = __ffsll((long long)bb) - 1; key = ln + 64; if (lane == ln) sb = -INFINITY; }
            if (lane == 0) { sc[half * 32 + r] = mx; sci[half * 32 + 16 + r] = (unsigned)key; }
        }
    }
    __builtin_amdgcn_s_waitcnt(0);
    const int ca = lane >> 2, cb0 = (lane & 3) * 4;
    float c[4];
#pragma unroll
    for (int j = 0; j < 4; ++j) c[j] = sc[ca] + sc[32 + cb0 + j];
    for (int r = 0; r < 16; ++r) {
        const float mx = wave_max(fmaxf(fmaxf(c[0], c[1]), fmaxf(c[2], c[3])));
        const bool mine = (c[0] == mx) || (c[1] == mx) || (c[2] == mx) || (c[3] == mx);
        const unsigned long long bm = __ballot(mine); const int ln = __ffsll((long long)bm) - 1;
        if (lane == ln) { int j = (c[0] == mx) ? 0 : (c[1] == mx) ? 1 : (c[2] == mx) ? 2 : 3;
            if (j == 0) c[0] = -INFINITY; else if (j == 1) c[1] = -INFINITY; else if (j == 2) c[2] = -INFINITY; else c[3] = -INFINITY;
            sc[64 + r] = mx; sci[80 + r] = sci[16 + ca] * 128u + sci[48 + cb0 + j]; }
    }
    __builtin_amdgcn_s_waitcnt(0);
    if (lane < 16) {
        const float mx0 = sc[64]; const float ex = expf(sc[64 + lane] - mx0); float sum = ex;
        sum += __shfl_xor(sum, 1); sum += __shfl_xor(sum, 2); sum += __shfl_xor(sum, 4); sum += __shfl_xor(sum, 8);
        ((int*)(a.ws + WS_EID))[(size_t)t * 128 + hd * 16 + lane] = (int)sci[80 + lane];
        ((float*)(a.ws + WS_GW))[(size_t)t * 128 + hd * 16 + lane] = ex / sum;
    }
    __builtin_amdgcn_s_waitcnt(0);
}

__device__ __forceinline__ void unpack8(const v4u w, float* f) { f[0] = bflo(w.x); f[1] = bfhi(w.x); f[2] = bflo(w.y); f[3] = bfhi(w.y); f[4] = bflo(w.z); f[5] = bfhi(w.z); f[6] = bflo(w.w); f[7] = bfhi(w.w); }
__device__ __forceinline__ void gather_token(const Args& a, int t, int lane, float* dst) {
    const bf16* HB = (const bf16*)(a.ws + WS_HB) + (size_t)t * D; const bf16* ED = (const bf16*)(a.ws + WS_ED); const bf16* EU = (const bf16*)(a.ws + WS_EU);
    float hx[16];
    unpack8(*(const GAS v4u*)(HB + lane * 8), hx); unpack8(*(const GAS v4u*)(HB + 512 + lane * 8), hx + 8);
    const float rs2 = 1.0f / sqrtf(((const float*)(a.ws + WS_ROWSS2))[t] * (1.0f / 1024.0f) + EPSN);
    const int* EID = (const int*)(a.ws + WS_EID) + (size_t)t * 128; const float* GW = (const float*)(a.ws + WS_GW) + (size_t)t * 128;
    const int e0 = EID[lane], e1 = EID[64 + lane]; const float g0 = GW[lane], g1 = GW[64 + lane];
    float acc[16];
#pragma unroll
    for (int i = 0; i < 16; ++i) acc[i] = 0.f;
#pragma unroll 1
    for (int j = 0; j < 128; j += 4) {
        int ee[4]; float gg[4], dt[4];
#pragma unroll
        for (int k = 0; k < 4; ++k) { const int jj = j + k; ee[k] = __shfl(jj < 64 ? e0 : e1, jj & 63); gg[k] = __shfl(jj < 64 ? g0 : g1, jj & 63); }
        v4u da[4], db[4];
#pragma unroll
        for (int k = 0; k < 4; ++k) { const bf16* r = ED + (size_t)ee[k] * D; da[k] = *(const GAS v4u*)(r + lane * 8); db[k] = *(const GAS v4u*)(r + 512 + lane * 8); }
#pragma unroll
        for (int k = 0; k < 4; ++k) { float f[16]; unpack8(da[k], f); unpack8(db[k], f + 8); float s = 0.f;
#pragma unroll
            for (int i = 0; i < 16; ++i) s += f[i] * hx[i];
            dt[k] = s; }
#pragma unroll
        for (int o = 1; o < 64; o <<= 1) {
#pragma unroll
            for (int k = 0; k < 4; ++k) dt[k] += __shfl_xor(dt[k], o); }
#pragma unroll
        for (int k = 0; k < 4; ++k) { const bf16* r = EU + (size_t)ee[k] * D; da[k] = *(const GAS v4u*)(r + lane * 8); db[k] = *(const GAS v4u*)(r + 512 + lane * 8); }
#pragma unroll
        for (int k = 0; k < 4; ++k) { const float w = gg[k] * gelu_tanh(dt[k] * rs2); float f[16]; unpack8(da[k], f); unpack8(db[k], f + 8);
#pragma unroll
            for (int i = 0; i < 16; ++i) acc[i] += w * f[i]; }
    }
    const float* orow = a.out + (size_t)t * D; float* drow = dst + (size_t)t * D; const float* gf = a.in[22];
    f32x4 h0 = *(const GAS f32x4*)(orow + lane * 8), h1 = *(const GAS f32x4*)(orow + lane * 8 + 4), h2 = *(const GAS f32x4*)(orow + 512 + lane * 8), h3 = *(const GAS f32x4*)(orow + 512 + lane * 8 + 4);
    h0 += (f32x4){acc[0], acc[1], acc[2], acc[3]}; h1 += (f32x4){acc[4], acc[5], acc[6], acc[7]}; h2 += (f32x4){acc[8], acc[9], acc[10], acc[11]}; h3 += (f32x4){acc[12], acc[13], acc[14], acc[15]};
    float ss = (h0.x * h0.x + h0.y * h0.y) + (h0.z * h0.z + h0.w * h0.w) + (h1.x * h1.x + h1.y * h1.y) + (h1.z * h1.z + h1.w * h1.w)
             + (h2.x * h2.x + h2.y * h2.y) + (h2.z * h2.z + h2.w * h2.w) + (h3.x * h3.x + h3.y * h3.y) + (h3.z * h3.z + h3.w * h3.w);
    ss = wave_sum(ss);
    const float ri = 1.0f / sqrtf(ss * (1.0f / 1024.0f) + EPSN);
    const f32x4 f0 = *(const GAS f32x4*)(gf + lane * 8), f1 = *(const GAS f32x4*)(gf + lane * 8 + 4), f2 = *(const GAS f32x4*)(gf + 512 + lane * 8), f3 = *(const GAS f32x4*)(gf + 512 + lane * 8 + 4);
    *(GAS f32x4*)(drow + lane * 8) = h0 * ri * f0; *(GAS f32x4*)(drow + lane * 8 + 4) = h1 * ri * f1;
    *(GAS f32x4*)(drow + 512 + lane * 8) = h2 * ri * f2; *(GAS f32x4*)(drow + 512 + lane * 8 + 4) = h3 * ri * f3;
}


template <int CTRL> __device__ __forceinline__ float dpp_add(float v) { return v + __int_as_float(__builtin_amdgcn_update_dpp(0, __float_as_int(v), CTRL, 0xf, 0xf, false)); }
__device__ __forceinline__ float row16_sum(float v) { v = dpp_add<0x140>(v); v = dpp_add<0x141>(v); v = dpp_add<0x4E>(v); v = dpp_add<0xB1>(v); return v; }
__device__ __forceinline__ unsigned long long lanemask_lt(int lane) { return (1ull << lane) - 1ull; }
__device__ __forceinline__ void glds16g(const void* gsrc, unsigned lds_dst) { unsigned keep;
    asm volatile("s_mov_b32 %0, m0\n\ts_mov_b32 m0, %2\n\ts_nop 0\n\tglobal_load_lds_dwordx4 %1, off\n\ts_mov_b32 m0, %0" : "=&s"(keep) : "v"(gsrc), "s"(lds_dst) : "memory"); }

__device__ __forceinline__ void glds16x4(const void* sbase, unsigned o0, unsigned o1, unsigned o2, unsigned o3, unsigned d0, unsigned d1, unsigned d2, unsigned d3) { unsigned keep;
    asm volatile("s_mov_b32 %0, m0\n\ts_mov_b32 m0, %6\n\ts_nop 0\n\tglobal_load_lds_dwordx4 %1, %5\n\ts_mov_b32 m0, %7\n\ts_nop 0\n\tglobal_load_lds_dwordx4 %2, %5\n\t"
                 "s_mov_b32 m0, %8\n\ts_nop 0\n\tglobal_load_lds_dwordx4 %3, %5\n\ts_mov_b32 m0, %9\n\ts_nop 0\n\tglobal_load_lds_dwordx4 %4, %5\n\ts_mov_b32 m0, %0"
                 : "=&s"(keep) : "v"(o0), "v"(o1), "v"(o2), "v"(o3), "s"(sbase), "s"(d0), "s"(d1), "s"(d2), "s"(d3) : "memory"); }
typedef __bf16 bf2_t __attribute__((ext_vector_type(2)));
__device__ __forceinline__ float dot2bf(unsigned a, unsigned b, float c) { return __builtin_amdgcn_fdot2_f32_bf16(__builtin_bit_cast(bf2_t, a), __builtin_bit_cast(bf2_t, b), c, false); }
template <int NT> __device__ __forceinline__ void compact_tokens(const Args& a, int t0, int lane) {
    int e0[NT], e1[NT]; float g0[NT], g1[NT];
#pragma unroll
    for (int i = 0; i < NT; ++i) { const int* EID = (const int*)(a.ws + WS_EID) + (size_t)(t0 + i) * 128; const float* GW = (const float*)(a.ws + WS_GW) + (size_t)(t0 + i) * 128;
        e0[i] = EID[lane]; e1[i] = EID[64 + lane]; g0[i] = GW[lane]; g1[i] = GW[64 + lane]; }
#pragma unroll
    for (int i = 0; i < NT; ++i) {
        const bool p0 = e0[i] < 8192, p1 = e1[i] < 8192;
        const unsigned long long m0 = __ballot(p0), m1 = __ballot(p1), lt = lanemask_lt(lane);
        const int c0 = __popcll(m0), n0 = c0 + __popcll(m1);
        const int pos0 = p0 ? __popcll(m0 & lt) : n0 + __popcll(~m0 & lt);
        const int pos1 = p1 ? c0 + __popcll(m1 & lt) : n0 + (64 - c0) + __popcll(~m1 & lt);
        unsigned* R = (unsigned*)(a.ws + WS_REC) + (size_t)(t0 + i) * 128;
        R[pos0] = (unsigned)e0[i] | (f2bf(g0[i]) << 16); R[pos1] = (unsigned)e1[i] | (f2bf(g1[i]) << 16);
        if (lane == 0) ((int*)(a.ws + WS_N0))[t0 + i] = n0; }
}
template <int NT> __device__ __forceinline__ void w_tokens(const Args& a, int t0, int lane, const LAS float* scd, const LAS float* scu) {
    float d0[NT], d1[NT], sd0[NT], sd1[NT], su0[NT], su1[NT]; unsigned r0[NT], r1[NT]; float ss[NT];
#pragma unroll
    for (int i = 0; i < NT; ++i) { const unsigned short* DP = (const unsigned short*)(a.ws + WS_DOTP) + (size_t)(t0 + i) * 1024; const unsigned* R = (const unsigned*)(a.ws + WS_REC) + (size_t)(t0 + i) * 128;
        float p0[8], p1[8];
#pragma unroll
        for (int x = 0; x < 8; ++x) { p0[x] = bf2f(DP[x * 128 + lane]); p1[x] = bf2f(DP[x * 128 + 64 + lane]); }
        r0[i] = R[lane]; r1[i] = R[64 + lane]; ss[i] = ((const float*)(a.ws + WS_ROWSS2))[t0 + i];
        sd0[i] = scd[r0[i] & 0x3fffu]; sd1[i] = scd[r1[i] & 0x3fffu];
        su0[i] = scu[r0[i] & 0x3fffu]; su1[i] = scu[r1[i] & 0x3fffu];
        d0[i] = ((p0[0] + p0[1]) + (p0[2] + p0[3])) + ((p0[4] + p0[5]) + (p0[6] + p0[7])); d1[i] = ((p1[0] + p1[1]) + (p1[2] + p1[3])) + ((p1[4] + p1[5]) + (p1[6] + p1[7])); }
#pragma unroll
    for (int i = 0; i < NT; ++i) { const float rs2 = 1.0f / sqrtf(ss[i] * (1.0f / 1024.0f) + EPSN);
        const float w0 = bfhi(r0[i]) * fgelu_tanh(d0[i] * sd0[i] * rs2) * su0[i], w1 = bfhi(r1[i]) * fgelu_tanh(d1[i] * sd1[i] * rs2) * su1[i];
        float m0 = fabsf(w0), m1 = fabsf(w1);
#pragma unroll
        for (int o = 1; o < 64; o <<= 1) { m0 = fmaxf(m0, __shfl_xor(m0, o)); m1 = fmaxf(m1, __shfl_xor(m1, o)); }
        const float s0 = (m0 > 0.f) ? m0 * (1.0f / 127.0f) : 1.0f, s1 = (m1 > 0.f) ? m1 * (1.0f / 127.0f) : 1.0f;
        unsigned char* WQ = a.ws + WS_WQ8 + (size_t)(t0 + i) * 144;
        WQ[lane] = (unsigned char)((int)__builtin_rintf(w0 / s0) & 255); WQ[64 + lane] = (unsigned char)((int)__builtin_rintf(w1 / s1) & 255);
        if (lane == 0) { ((float*)(WQ + 128))[0] = s0; ((float*)(WQ + 128))[1] = s1; } }
}
template <bool IS_UP> __device__ __forceinline__ void sweep_slice(const Args& a, int x, int wv, int lane, unsigned ring, LAS unsigned char* ringp, unsigned aux, LAS unsigned char* auxp) {
    const int g = lane >> 4, li = lane & 15, n16 = li, kg = g;
    const char* TABx = (const char*)(a.ws + (IS_UP ? WS_EU : WS_ED)) + x * 256;
    unsigned jofs[4];
#pragma unroll
    for (int q = 0; q < 4; ++q) jofs[q] = (unsigned)((li ^ ((g << 2) | q)) * 16);
    const unsigned pd = (unsigned)__builtin_amdgcn_readfirstlane(ring);
#pragma unroll 1
    for (int s_ = 0; s_ < 128; ++s_) {
        const int r = s_ >> 6, k = s_ & 63, t = wv * 64 + k, base = 64 * r;
        const LAS unsigned* rec = (const LAS unsigned*)(auxp + (k & 3) * 512) + base;
        const LAS unsigned char* hp = auxp + 2048 + (k & 3) * 256;
        asm volatile("s_waitcnt lgkmcnt(0)" ::: "memory");
        if ((k & 3) == 0) {
            const char* rsrc = (const char*)(a.ws + WS_REC) + (size_t)t * 512 + lane * 16;
            glds16g(rsrc, (unsigned)__builtin_amdgcn_readfirstlane(aux)); glds16g(rsrc + 1024, (unsigned)__builtin_amdgcn_readfirstlane(aux + 1024));
            if (!IS_UP) glds16g((const char*)(a.ws + WS_HB) + (size_t)(t + g) * 2048 + x * 256 + li * 16, (unsigned)__builtin_amdgcn_readfirstlane(aux + 2048));
            asm volatile("s_waitcnt vmcnt(0)" ::: "memory");
        }
        {
            unsigned so[16];
#pragma unroll
            for (int p = 0; p < 16; ++p) so[p] = rec[4 * p + g];
#pragma unroll
            for (int p = 0; p < 16; ++p) so[p] = ((so[p] & 0x3fffu) << 11) + jofs[p & 3];
            glds16x4(TABx, so[0], so[1], so[2], so[3], pd, pd + 1024u, pd + 2048u, pd + 3072u);
            glds16x4(TABx, so[4], so[5], so[6], so[7], pd + 4096u, pd + 5120u, pd + 6144u, pd + 7168u);
            glds16x4(TABx, so[8], so[9], so[10], so[11], pd + 8192u, pd + 9216u, pd + 10240u, pd + 11264u);
            glds16x4(TABx, so[12], so[13], so[14], so[15], pd + 12288u, pd + 13312u, pd + 14336u, pd + 15360u);
        }
        asm volatile("s_waitcnt vmcnt(0)" ::: "memory");
        if (!IS_UP) {
            bf16x8 hb[4];
#pragma unroll
            for (int q = 0; q < 4; ++q) hb[q] = *(const LAS bf16x8*)(hp + (32 * q + 8 * kg) * 2);
            f32x4 res = (f32x4){0.f, 0.f, 0.f, 0.f};
#pragma unroll
            for (int rb = 0; rb < 4; ++rb) {
                f32x4 d = (f32x4){0.f, 0.f, 0.f, 0.f}; const int row = n16 + 16 * rb; const int key = ((row & 3) << 2) | ((row >> 2) & 3);
#pragma unroll
                for (int q = 0; q < 4; ++q) { const bf16x8 af = *(const LAS bf16x8*)(ringp + 256 * row + 16 * ((4 * q + kg) ^ key)); d = __builtin_amdgcn_mfma_f32_16x16x32_bf16(af, hb[q], d, 0, 0, 0); }
                res = (n16 == rb) ? d : res; }
            if (n16 < 4) *(GAS f32x4*)((float*)(a.ws + WS_DOTP) + ((size_t)t * 8 + x) * 128 + base + 16 * n16 + 4 * kg) = res;
        } else {
            f32x4 pacc[8];
#pragma unroll
            for (int i = 0; i < 8; ++i) pacc[i] = (f32x4){0.f, 0.f, 0.f, 0.f};
            const int q4 = n16 >> 2, p4 = lane & 3;
#pragma unroll
            for (int ks = 0; ks < 2; ++ks) {
                const v4u wa = *(const LAS v4u*)(rec + 32 * ks + 8 * kg), wb = *(const LAS v4u*)(rec + 32 * ks + 8 * kg + 4);
                const bf16x8 af = __builtin_bit_cast(bf16x8, (v4u){(wa.x >> 16) | (wa.y & 0xffff0000u), (wa.z >> 16) | (wa.w & 0xffff0000u), (wb.x >> 16) | (wb.y & 0xffff0000u), (wb.z >> 16) | (wb.w & 0xffff0000u)});
#pragma unroll
                for (int c = 0; c < 8; ++c) {
                    const int row0 = 32 * ks + 8 * kg + q4, row1 = row0 + 4; const int ch = 2 * c + (p4 >> 1);
                    const int k0 = ((row0 & 3) << 2) | ((row0 >> 2) & 3), k1 = ((row1 & 3) << 2) | ((row1 >> 2) & 3);
                    const attn_body::s16x4 lo4 = attn_body::vtr((attn_body::lds_cptr)(ringp + 256 * row0 + 16 * (ch ^ k0) + 8 * (p4 & 1)));
                    const attn_body::s16x4 hi4 = attn_body::vtr((attn_body::lds_cptr)(ringp + 256 * row1 + 16 * (ch ^ k1) + 8 * (p4 & 1)));
                    const bf16x8 bfr = (bf16x8){lo4[0], lo4[1], lo4[2], lo4[3], hi4[0], hi4[1], hi4[2], hi4[3]};
                    pacc[c] = __builtin_amdgcn_mfma_f32_16x16x32_bf16(af, bfr, pacc[c], 0, 0, 0); }
            }
            const float v0 = (kg == 0) ? pacc[0][0] : (kg == 1) ? pacc[1][0] : (kg == 2) ? pacc[2][0] : pacc[3][0];
            const float v1 = (kg == 0) ? pacc[4][0] : (kg == 1) ? pacc[5][0] : (kg == 2) ? pacc[6][0] : pacc[7][0];
            bf16* po = (bf16*)(a.ws + WS_PEER) + ((size_t)r * M + t) * D + x * 128;
            po[lane] = (bf16)f2bf(v0); po[64 + lane] = (bf16)f2bf(v1);
        }
    }
}
typedef int i32x4 __attribute__((ext_vector_type(4)));
__device__ __forceinline__ void sweep_down_q8(const Args& a, int x, int wv, int lane, unsigned ring, LAS unsigned char* ringp, unsigned aux, LAS unsigned char* auxp) {
    const int g = lane >> 4, li = lane & 15, n16 = li, kg = g, g8 = lane >> 3, s8 = lane & 7;
    const char* TABx = (const char*)(a.ws + WS_ED) + (size_t)x * ((size_t)NEXP * 128);
    unsigned jofs[2];
#pragma unroll
    for (int b = 0; b < 2; ++b) jofs[b] = (unsigned)((s8 ^ (4 * b + (g8 >> 1))) * 16);
    const unsigned pd = (unsigned)__builtin_amdgcn_readfirstlane(ring);
#define DN_FETCH(tw, dst) do { const char* rsrc_ = (const char*)(a.ws + WS_REC) + (size_t)(tw) * 512 + lane * 16; const unsigned d_ = (unsigned)__builtin_amdgcn_readfirstlane(dst); \
        glds16g(rsrc_, d_); glds16g(rsrc_ + 1024, d_ + 1024u); \
        glds16g((const char*)(a.ws + WS_HB) + (size_t)((tw) + g) * 2048 + x * 256 + li * 16, d_ + 2048u); } while (0)
    DN_FETCH(wv * 64, pd + 8192u);
    asm volatile("s_waitcnt vmcnt(0)" ::: "memory");
#pragma unroll 1
    for (int s_ = 0; s_ < 128; ++s_) {
        const int r = s_ & 1, k = s_ >> 1, t = wv * 64 + k, base = 64 * r;
        LAS unsigned char* wp = ringp + 8192 + 4096 * ((k >> 2) & 1);
        LAS unsigned char* hq = wp + 3072; LAS float* hsc = (LAS float*)(wp + 3072 + 512);
        const LAS unsigned* rec = (const LAS unsigned*)(wp + (k & 3) * 512) + base;
        asm volatile("s_waitcnt lgkmcnt(0)" ::: "memory");
        if ((k & 3) == 0 && r == 0) {
            {
                const v4u hb = *(const LAS v4u*)(wp + 2048 + lane * 16); float f[8]; unpack8(hb, f);
                float am = fmaxf(fmaxf(fmaxf(fabsf(f[0]), fabsf(f[1])), fmaxf(fabsf(f[2]), fabsf(f[3]))), fmaxf(fmaxf(fabsf(f[4]), fabsf(f[5])), fmaxf(fabsf(f[6]), fabsf(f[7]))));
                am = fmaxf(am, __int_as_float(__builtin_amdgcn_update_dpp(0, __float_as_int(am), 0x140, 0xf, 0xf, false))); am = fmaxf(am, __int_as_float(__builtin_amdgcn_update_dpp(0, __float_as_int(am), 0x141, 0xf, 0xf, false)));
                am = fmaxf(am, __int_as_float(__builtin_amdgcn_update_dpp(0, __float_as_int(am), 0x4E, 0xf, 0xf, false))); am = fmaxf(am, __int_as_float(__builtin_amdgcn_update_dpp(0, __float_as_int(am), 0xB1, 0xf, 0xf, false)));
                const float sc = (am > 0.f) ? am * (1.0f / 127.0f) : 1.0f, inv = 1.0f / sc;
                unsigned qw[2];
#pragma unroll
                for (int h2 = 0; h2 < 2; ++h2) { const int q0 = (int)__builtin_rintf(f[4 * h2] * inv), q1 = (int)__builtin_rintf(f[4 * h2 + 1] * inv), q2 = (int)__builtin_rintf(f[4 * h2 + 2] * inv), q3 = (int)__builtin_rintf(f[4 * h2 + 3] * inv);
                    qw[h2] = ((unsigned)q0 & 255u) | (((unsigned)q1 & 255u) << 8) | (((unsigned)q2 & 255u) << 16) | ((unsigned)q3 << 24); }
                *(LAS unsigned long long*)(hq + lane * 8) = (unsigned long long)qw[0] | ((unsigned long long)qw[1] << 32);
                if (li == 0) hsc[g] = sc; }
        }
        {   unsigned so[8];
#pragma unroll
            for (int i = 0; i < 8; ++i) so[i] = rec[8 * i + g8];
#pragma unroll
            for (int i = 0; i < 8; ++i) so[i] = ((so[i] & 0x3fffu) << 7) + jofs[i & 1];
            glds16x4(TABx, so[0], so[1], so[2], so[3], pd, pd + 1024u, pd + 2048u, pd + 3072u);
            glds16x4(TABx, so[4], so[5], so[6], so[7], pd + 4096u, pd + 5120u, pd + 6144u, pd + 7168u);
        }
        if ((k & 3) == 0 && r == 0 && k + 4 < 64) { DN_FETCH(t + 4, pd + 8192u + 4096u * (unsigned)(((k >> 2) + 1) & 1)); asm volatile("s_waitcnt vmcnt(3)" ::: "memory"); }
        else asm volatile("s_waitcnt vmcnt(0)" ::: "memory");
        const i32x4 hb0 = *(const LAS i32x4*)(hq + (k & 3) * 128 + 16 * kg), hb1 = *(const LAS i32x4*)(hq + (k & 3) * 128 + 64 + 16 * kg);
        const float hs = hsc[k & 3];
        i32x4 res = (i32x4){0, 0, 0, 0};
#pragma unroll
        for (int rb = 0; rb < 4; ++rb) {
            const int row = n16 + 16 * rb; const int key = (row >> 1) & 7;
            const i32x4 a0 = *(const LAS i32x4*)(ringp + row * 128 + ((kg ^ key) * 16)), a1 = *(const LAS i32x4*)(ringp + row * 128 + (((4 + kg) ^ key) * 16));
            i32x4 d = __builtin_amdgcn_mfma_i32_16x16x64_i8(a0, hb0, (i32x4){0, 0, 0, 0}, 0, 0, 0); d = __builtin_amdgcn_mfma_i32_16x16x64_i8(a1, hb1, d, 0, 0, 0);
            res = (n16 == rb) ? d : res; }
        if (n16 < 4) *(GAS unsigned long long*)((bf16*)(a.ws + WS_DOTP) + ((size_t)t * 8 + x) * 128 + base + 16 * n16 + 4 * kg) = (unsigned long long)pk2((float)res[0] * hs, (float)res[1] * hs) | ((unsigned long long)pk2((float)res[2] * hs, (float)res[3] * hs) << 32);
    }
}
#undef DN_FETCH

__device__ __forceinline__ void sweep_up_q8(const Args& a, int x, int wv, int lane, unsigned ring, LAS unsigned char* ringp, unsigned aux, LAS unsigned char* auxp) {
    const int n16 = lane & 15, kg = lane >> 4, g8 = lane >> 3, s8 = lane & 7;
    const char* TABx = (const char*)(a.ws + WS_EU) + (size_t)x * ((size_t)NEXP * 128);
    unsigned jofs[2];
#pragma unroll
    for (int b = 0; b < 2; ++b) jofs[b] = (unsigned)((s8 ^ ((g8 >> 1) | (b << 2))) * 16);
    const unsigned pd = (unsigned)__builtin_amdgcn_readfirstlane(ring);
    typedef int v2i_t __attribute__((ext_vector_type(2)));
    float acc0 = 0.f, acc1 = 0.f;
#define UP_FETCH(tw, dst) do { const char* rsrc_ = (const char*)(a.ws + WS_REC) + (size_t)(tw) * 512 + lane * 16; const unsigned d_ = (unsigned)__builtin_amdgcn_readfirstlane(dst); \
        glds16g(rsrc_, d_); glds16g(rsrc_ + 1024, d_ + 1024u); \
        if (lane < 36) glds16g((const char*)(a.ws + WS_WQ8) + (size_t)(tw) * 144 + lane * 16, d_ + 2048u); \
        glds16g((const char*)(a.ws + WS_HB) + (size_t)((tw) + (lane >> 4)) * 2048 + x * 256 + (lane & 15) * 16, d_ + 2688u); } while (0)
    UP_FETCH(wv * 64, pd + 8192u);
    asm volatile("s_waitcnt vmcnt(0)" ::: "memory");
#pragma unroll 1
    for (int s_ = 0; s_ < 128; ++s_) {
        const int r = s_ & 1, k = s_ >> 1, t = wv * 64 + k, base = 64 * r;
        const LAS unsigned char* wp = ringp + 8192 + 4096 * ((k >> 2) & 1);
        const LAS unsigned* rec = (const LAS unsigned*)(wp + (k & 3) * 512) + base;
        const LAS unsigned char* wq = wp + 2048 + (k & 3) * 144;
        asm volatile("s_waitcnt lgkmcnt(0)" ::: "memory");
        {   unsigned so[8];
#pragma unroll
            for (int i = 0; i < 8; ++i) so[i] = rec[8 * i + g8];
#pragma unroll
            for (int i = 0; i < 8; ++i) so[i] = ((so[i] & 0x3fffu) << 7) + jofs[(i >> 1) & 1];
            glds16x4(TABx, so[0], so[1], so[2], so[3], pd, pd + 1024u, pd + 2048u, pd + 3072u);
            glds16x4(TABx, so[4], so[5], so[6], so[7], pd + 4096u, pd + 5120u, pd + 6144u, pd + 7168u);
        }
        if ((k & 3) == 0 && r == 0 && k + 4 < 64) { UP_FETCH(t + 4, pd + 8192u + 4096u * (unsigned)(((k >> 2) + 1) & 1)); asm volatile("s_waitcnt vmcnt(4)" ::: "memory"); }
        else asm volatile("s_waitcnt vmcnt(0)" ::: "memory");
        const i32x4 aw = *(const LAS i32x4*)(wq + 64 * r + 16 * kg);
        const float wsc = *(const LAS float*)(wq + 128 + 4 * r);
        const int i2 = n16 >> 1, ih = n16 & 1;
        const int row0 = 16 * kg + i2, row1 = row0 + 8;
        const int k0 = ((row0 >> 1) & 3) | (((row0 >> 4) & 1) << 2), k1 = ((row1 >> 1) & 3) | (((row1 >> 4) & 1) << 2);
        const LAS unsigned char* p0 = ringp + row0 * 128 + 8 * ih; const LAS unsigned char* p1 = ringp + row1 * 128 + 8 * ih;
        float outv[8];
#pragma unroll
        for (int c = 0; c < 8; ++c) {
            const v2i_t lo = __builtin_amdgcn_ds_read_tr8_b64_v2i32((LAS v2i_t*)(p0 + ((c ^ k0) * 16)));
            const v2i_t hi = __builtin_amdgcn_ds_read_tr8_b64_v2i32((LAS v2i_t*)(p1 + ((c ^ k1) * 16)));
            const i32x4 d = __builtin_amdgcn_mfma_i32_16x16x64_i8(aw, (i32x4){lo.x, lo.y, hi.x, hi.y}, (i32x4){0, 0, 0, 0}, 0, 0, 0);
            outv[c] = (float)d[0] * wsc; }
        const float v0 = (kg == 0) ? outv[0] : (kg == 1) ? outv[1] : (kg == 2) ? outv[2] : outv[3];
        const float v1 = (kg == 0) ? outv[4] : (kg == 1) ? outv[5] : (kg == 2) ? outv[6] : outv[7];
        if (r == 0) { acc0 = v0; acc1 = v1; }
        else { const LAS unsigned short* hs = (const LAS unsigned short*)(wp + 2688 + (k & 3) * 256);
            const float y0 = bf2f(hs[lane]) + (acc0 + v0), y1 = bf2f(hs[64 + lane]) + (acc1 + v1);
            bf16* po = (bf16*)(a.ws + WS_PEER) + (size_t)t * D + x * 128;
            po[lane] = (bf16)f2bf(y0); po[64 + lane] = (bf16)f2bf(y1); }
    }
}
#undef UP_FETCH

__device__ __forceinline__ void final_row(const Args& a, int t, int lane) {
    float* orow = a.out + (size_t)t * D; const float* gf = a.in[22];
    const bf16* Y = (const bf16*)(a.ws + WS_PEER) + (size_t)t * D;
    f32x4 y[4]; float ss = 0.f;
#pragma unroll
    for (int j = 0; j < 4; ++j) { const unsigned long long yb = ((const GAS unsigned long long*)Y)[lane + 64 * j];
        y[j] = (f32x4){bflo((unsigned)yb), bfhi((unsigned)yb), bflo((unsigned)(yb >> 32)), bfhi((unsigned)(yb >> 32))};
        ss += (y[j].x * y[j].x + y[j].y * y[j].y) + (y[j].z * y[j].z + y[j].w * y[j].w); }
    ss = wave_sum(ss);
    const float ri = 1.0f / sqrtf(ss * (1.0f / 1024.0f) + EPSN);
#pragma unroll
    for (int j = 0; j < 4; ++j) ((GAS f32x4*)orow)[lane + 64 * j] = y[j] * ri * ((const GAS f32x4*)gf)[lane + 64 * j];
}

__device__ __forceinline__ float a_dot64(const float* p, const float* q, int lane) { return wave_sum(p[lane] * q[lane]); }
constexpr int N_PHASES = 12;
#ifndef ROUTE_REF
#define ROUTE_REF 0
#endif
#ifndef MK_ONE_LAUNCH
#define MK_ONE_LAUNCH 1
#endif
__global__ void __launch_bounds__(NWAVES * 64, 2) fwd_mega(Args args) {
    extern __shared__ __attribute__((aligned(16))) unsigned char lds[];
    Frame F;
    F.lds = (LAS unsigned char*)lds;
    F.MISC = (volatile LAS unsigned*)(F.lds + MISC_OFF);
    F.tid = threadIdx.x; F.lane = F.tid & 63; F.wave = __builtin_amdgcn_readfirstlane(F.tid >> 6);
    F.G = gridDim.x; { const int bx = blockIdx.x; F.vcu = (F.G % 8 == 0) ? (bx % 8) * (F.G / 8) + bx / 8 : bx; }
    unsigned char* ws = args.ws;
    const int lo = args.ph_lo, hi = args.ph_hi;
#ifndef PH_MASK
#define PH_MASK 0xffff
#endif
#define IN(k) (((PH_MASK >> (k)) & 1) && lo <= (k) && (k) < hi)
#define BOTH(k) (IN(k) && IN((k) + 1))
#if MK_ONE_LAUNCH
    for (int u = F.tid; u < (LDS_BYTES - LDSCTL_OFF) / 4; u += NWAVES * 64) ((LAS unsigned*)(F.lds + LDSCTL_OFF))[u] = 0u;
    __syncthreads();
    const XcdBarrier xbar = xcd_barrier_post((unsigned*)(ws + WS_CTL) + CW_BAR, F.MISC + 8);
    bool first_seam = args.ph_lo < 0;
#define GRID_BAR() do { if (first_seam) { __threadfence(); cooperative_groups::this_grid().sync(); first_seam = false; } else xcd_barrier(xbar); } while (0)
#else
#define GRID_BAR() do { } while (0)
#endif
#ifndef REP_PH
#define REP_PH -1
#endif
#define RUN_PHASE(k, ...) do { if (IN(k)) { if ((k) == REP_PH) { { const bool first_of_two = true; (void)first_of_two; __VA_ARGS__ } GRID_BAR(); } { const bool first_of_two = false; (void)first_of_two; __VA_ARGS__ } if (BOTH(k)) GRID_BAR(); } } while (0)
    RUN_PHASE(0, { p0_prologue(F, args); });
    RUN_PHASE(1, {
        pg8::Gemm g{(const pg8::bf16_t*)(ws + WS_XB), (const pg8::bf16_t*)(ws + WS_WIN), M, INC, D}; pg8::StaticOrder S; S.init(M, INC, F.G, (int)blockIdx.x);
        pg8::EpiBf16<1> E{(pg8::bf16_t*)(ws + WS_Q), 512, (const float*)(ws + WS_RS1), 512, (size_t)WS_SPLIT / 2, attn_body::C2};
        pg8::gemm_phase<pg8::EpiBf16<1>, pg8::StaticOrder, true, true>(F.lds + RING_OFF, g, S, E);
        { const int nb = (F.G >= 2) ? (int)F.G / 2 : 1; const int bi = (int)blockIdx.x - ((int)F.G - nb); if (bi >= 0) convert_experts(args, bi * NWAVES + F.wave, nb * NWAVES, F.lane); }
    });
    RUN_PHASE(2, {
        for (int c = F.vcu; c < M / 64; c += F.G) lru_local_unit(F, args, c);
        const attn128::AttnTensors AT{(const attn128::bf16*)(ws + WS_Q), (const attn128::bf16*)(ws + WS_Q + WS_SPLIT), (const attn128::bf16*)(ws + WS_Q + 2 * WS_SPLIT), (attn128::bf16*)(args.out + (size_t)M * 512)};
        const attn128::StaticOrder S(F.vcu);
        attn128::attn_phase<attn128::StaticOrder>((char*)lds + RING_OFF, AT, S);
    });
    RUN_PHASE(3, {
        float l1 = a_dot64(args.in[3], args.in[4], F.lane); float l2 = a_dot64(args.in[5], args.in[6], F.lane);
        const float lamv = expf(l1) - expf(l2) + 0.2f;
        for (int c = F.vcu; c < M / 64; c += F.G) fix_unit(F, args, c, lamv);
    });
    RUN_PHASE(4, {
        pg8::Gemm g{(const pg8::bf16_t*)(ws + WS_MIX), (const pg8::bf16_t*)(ws + WS_WOUT), M, D, D}; pg8::StaticOrder S; S.init(M, D, F.G, (int)blockIdx.x);
        pg8::EpiResid E{(const pg8::bf16_t*)(ws + WS_XB), args.out, (pg8::bf16_t*)(ws + WS_HB), (float*)(ws + (first_of_two ? WS_RS1 : WS_ROWSS2)), D};
        pg8::gemm_phase<pg8::EpiResid, pg8::StaticOrder, true, true>(F.lds + RING_OFF, g, S, E);
    });
    RUN_PHASE(5, {
        pg8::Gemm g{(const pg8::bf16_t*)(ws + WS_HB), (const pg8::bf16_t*)(ws + WS_WQ), M, NQ, D}; pg8::StaticOrder S; S.init(M, NQ, F.G, (int)blockIdx.x);
        pg8::EpiBf16<2> E{(pg8::bf16_t*)(ws + WS_Q2), NQ, (const float*)(ws + WS_ROWSS2), 0, 0, 1.f};
        pg8::gemm_phase<pg8::EpiBf16<2>, pg8::StaticOrder, true, true>(F.lds + RING_OFF, g, S, E);
    });
    RUN_PHASE(6, {
        const int gw = F.vcu * NWAVES + F.wave; const int NGW = F.G * NWAVES;
        LAS unsigned char* skl = F.lds + RING_OFF + 16384;
        for (int c = F.tid; c < 4096; c += NWAVES * 64) { const int row = c >> 4; const int ch = c & 15; *(LAS v4u*)(skl + row * 272 + ch * 16) = *(const GAS v4u*)(ws + WS_SK1 + (size_t)row * 256 + ch * 16); }
        __syncthreads();
        static_assert((M / 32) * 8 == NEXP / 4, "one group of 4 expert_up rows beside each 32-token routing group");
        for (int u = gw; u < (M / 64) * 8; u += NGW) { const int g2 = u >> 3, hd = u & 7; f32x4 ev[4][4]; int k1[16], k2[16];
            { int k1a[16], k2a[16];
              q8_load<4>(ev, args.in[21] + (size_t)(2 * u) * 4 * D, F.lane);
              route_tops(args, 2 * g2, hd, F.lane, skl, k1a, k2a);
              q8_finish<4>(ev, ws + WS_EU + (size_t)(2 * u) * 4 * 128, nullptr, (float*)(ws + WS_SCU) + 8 * u, F.lane);
              q8_load<4>(ev, args.in[21] + (size_t)(2 * u + 1) * 4 * D, F.lane);
              route_tops(args, 2 * g2 + 1, hd, F.lane, skl, k1, k2);
              q8_finish<4>(ev, ws + WS_EU + (size_t)(2 * u + 1) * 4 * 128, nullptr, (float*)(ws + WS_SCU) + 8 * u + 4, F.lane);
              if (F.lane < 32) { _Pragma("unroll") for (int i = 0; i < 16; ++i) { k1[i] = k1a[i]; k2[i] = k2a[i]; } } }
            route_finish(args, (2 * g2 + (F.lane >> 5)) * 32 + (F.lane & 31), hd, F.lds + RING_OFF + F.tid * 32, k1, k2); }
        __syncthreads();
    });
    RUN_PHASE(8, {
        if (F.G == 256) sweep_down_q8(args, F.vcu >> 5, (F.vcu & 31) * NWAVES + F.wave, F.lane, (unsigned)(uintptr_t)(lds + RING_OFF) + F.wave * 16384u, F.lds + RING_OFF + F.wave * 16384, (unsigned)(uintptr_t)(lds + LDSCTL_OFF + 1024) + F.wave * 3712u, F.lds + LDSCTL_OFF + 1024 + F.wave * 3712);
    });
    RUN_PHASE(9, {
        const int gw = F.vcu * NWAVES + F.wave; const int NGW = F.G * NWAVES;
        LAS float* scl = (LAS float*)(F.lds + RING_OFF);
        for (int i = F.tid; i < NEXP / 4; i += NWAVES * 64) { ((LAS v4u*)scl)[i] = ((const GAS v4u*)(ws + WS_SCD))[i]; ((LAS v4u*)(scl + NEXP))[i] = ((const GAS v4u*)(ws + WS_SCU))[i]; }
        __syncthreads();
        for (int t = 8 * gw; t < M; t += 8 * NGW) w_tokens<8>(args, t, F.lane, scl, scl + NEXP);
        __syncthreads();
    });
    RUN_PHASE(10, {
        if (F.G == 256) sweep_up_q8(args, F.vcu >> 5, (F.vcu & 31) * NWAVES + F.wave, F.lane, (unsigned)(uintptr_t)(lds + RING_OFF) + F.wave * 16384u, F.lds + RING_OFF + F.wave * 16384, (unsigned)(uintptr_t)(lds + LDSCTL_OFF + 1024) + F.wave * 3712u, F.lds + LDSCTL_OFF + 1024 + F.wave * 3712);
    });
    RUN_PHASE(11, {
        const int gw = F.vcu * NWAVES + F.wave; const int NGW = F.G * NWAVES;
        for (int t = gw; t < M; t += NGW) final_row(args, t, F.lane);
    });
#undef IN
#undef BOTH
}

extern "C" void kernel_launch(void* const* d_in, const int* in_sizes, int n_in, void* d_out, int out_size, void* d_ws, size_t ws_size, hipStream_t stream) {
    static int grid = 0;
    if (grid == 0) {
        if (n_in != 23 || out_size != M * D || ws_size < WS_END) { fprintf(stderr, "kernel_launch: unexpected problem: n_in %d out %d ws %zu\n", n_in, out_size, ws_size); grid = -1; return; }
        int dev = 0, cus = 0, per_cu = 0;
        if (hipGetDevice(&dev) != hipSuccess || hipDeviceGetAttribute(&cus, hipDeviceAttributeMultiprocessorCount, dev) != hipSuccess) { grid = -1; return; }
        if (hipFuncSetAttribute((const void*)fwd_mega, hipFuncAttributeMaxDynamicSharedMemorySize, LDS_BYTES) != hipSuccess) { fprintf(stderr, "kernel_launch: hipFuncSetAttribute failed\n"); grid = -1; return; }
        if (hipOccupancyMaxActiveBlocksPerMultiprocessor(&per_cu, (const void*)fwd_mega, NWAVES * 64, LDS_BYTES) != hipSuccess || per_cu < 1) { fprintf(stderr, "kernel_launch: occupancy query reports %d\n", per_cu); per_cu = 1; }
        (void)hipGetLastError();
        grid = cus;
    }
    if (grid < 0) return;
    (void)hipMemsetAsync((char*)d_ws + WS_CTL, 0, CTL_ZERO_BYTES, stream);
    Args a{};
    for (int i = 0; i < 23; ++i) a.in[i] = (const float*)d_in[i];
    a.out = (float*)d_out; a.ws = (unsigned char*)d_ws;
#if MK_ONE_LAUNCH
    a.ph_lo = 0; a.ph_hi = N_PHASES;
    void* kargs[] = {&a};
    hipError_t e = hipLaunchCooperativeKernel((const void*)fwd_mega, dim3(grid), dim3(NWAVES * 64), kargs, LDS_BYTES, stream);
    if (e != hipSuccess) fprintf(stderr, "cooperative launch failed: %s (grid %d)\n", hipGetErrorString(e), grid);
#else
    for (int p = 0; p < N_PHASES; ++p) { a.ph_lo = p; a.ph_hi = p + 1; hipLaunchKernelGGL(fwd_mega, dim3(grid), dim3(NWAVES * 64), LDS_BYTES, stream, a); }
#endif
}
```

```cpp
#include <hip/hip_runtime.h>
#include <hip/hip_cooperative_groups.h>
#include <cstdio>
#include <cstdint>
namespace pg8 {
#define PG8_LAS __attribute__((address_space(3)))
typedef unsigned short bf16_t;
typedef short bf16x8 __attribute__((ext_vector_type(8)));
typedef float f32x4 __attribute__((ext_vector_type(4)));
typedef unsigned u32x4 __attribute__((ext_vector_type(4)));
constexpr int BM = 256, BK = 64, HALF = 128, HTB = HALF * BK * 2  , STAGE_BYTES = 8 * HTB, NXCD = 8, WGM = 8;

__host__ __device__ __forceinline__ int lds_byte(int r, int c) { const int st = (r >> 4) * 2 + (c >> 5), rr = r & 15, cc = c & 31, ob = rr * 64 + cc * 2; return st * 1024 + (ob ^ (((ob >> 9) & 1) << 5)); }
__host__ __device__ __forceinline__ void stage_rc(int b, int& R, int& C) { const int st = b / 1024, sb = b % 1024, swz = sb ^ (((sb >> 9) & 1) << 5); R = (st >> 1) * 16 + swz / 64; C = (st & 1) * 32 + (swz % 64) / 2; }
__host__ __device__ __forceinline__ int perm32(int rho) { const int n = rho >> 4, i = rho & 15; return 8 * (i >> 2) + 4 * n + (i & 3); }

struct Unit { int pm, pn; };
struct Gemm { const bf16_t* A; const bf16_t* Bt; int M, N, K; };

struct StaticOrder {
    int nM, nN, nwg, G, c;
    __host__ __device__ void init(int M, int N, int G_, int c_) { nM = M / BM; nN = N / BM; nwg = nM * nN; G = G_; c = c_; }
    __host__ __device__ bool next(int i, Unit& u) const {
        const long L = (long)i * G + c; if (L >= nwg) return false;
        int wgid = (int)L; { const int q = nwg / NXCD, r = nwg % NXCD, xcd = wgid % NXCD, off = wgid / NXCD; wgid = (xcd < r ? xcd * (q + 1) : r * (q + 1) + (xcd - r) * q) + off; }
        const int nig = WGM * nN, gid = wgid / nig, fm = gid * WGM, gsz = (nM - fm) < WGM ? (nM - fm) : WGM;
        u.pm = fm + ((wgid % nig) % gsz); u.pn = (wgid % nig) / gsz; return true;
    }
    __device__ __forceinline__ void a_ready(const Unit&) const {}
    __device__ __forceinline__ void done(const Unit&) const {}
};

__device__ __forceinline__ unsigned cvt_pk_bf16(float lo, float hi) { unsigned r; asm volatile("v_cvt_pk_bf16_f32 %0, %1, %2" : "=v"(r) : "v"(lo), "v"(hi)); return r; }
typedef float f32x2 __attribute__((ext_vector_type(2)));

template <int RSMODE> struct EpiBf16 {
    static constexpr bool PERM = true, AFTER_DRAIN = false;
    bf16_t* O; int ldc; const float* rowscale; int split_cols; size_t split_stride; float scale0;
    __device__ __forceinline__ void operator()(const f32x4 (&acc)[2][2][4][2], const Unit& u, int wr, int wc, int fr, int fq) const {
        const int row0 = u.pm * BM + wr * 64 + fr; int colt = u.pn * BM; bf16_t* base = O;
        float sc = 1.f; if (split_cols) { const int t = colt / split_cols; base += (size_t)t * split_stride; colt -= t * split_cols; if (t == 0) sc = scale0; }
        const int col0 = colt + wc * 32 + 8 * fq;
#pragma unroll
        for (int ai = 0; ai < 2; ++ai)
#pragma unroll
            for (int m = 0; m < 4; ++m) { const int row = row0 + ai * HALF + m * 16; bf16_t* rowp = base + (size_t)row * ldc + col0;
                float rs = sc;
                if (RSMODE == 1) rs *= rowscale[row];
                if (RSMODE == 2) rs *= 1.0f / sqrtf(rowscale[row] * (1.0f / 1024.0f) + 1e-6f);
#pragma unroll
                for (int bj = 0; bj < 2; ++bj) { f32x4 v0 = acc[ai][bj][m][0] * rs, v1 = acc[ai][bj][m][1] * rs;
                    u32x4 w; w.x = cvt_pk_bf16(v0[0], v0[1]); w.y = cvt_pk_bf16(v0[2], v0[3]); w.z = cvt_pk_bf16(v1[0], v1[1]); w.w = cvt_pk_bf16(v1[2], v1[3]);
                    *(u32x4*)(rowp + bj * HALF) = w; } }
    }
};

struct EpiResid {
    static constexpr bool PERM = false, AFTER_DRAIN = false;
    const bf16_t* X; float* Hf; bf16_t* Hb; float* rowss; int ldc;
    __device__ __forceinline__ void operator()(const f32x4 (&acc)[2][2][4][2], const Unit& u, int wr, int wc, int fr, int fq) const {
        typedef unsigned u32x2v __attribute__((ext_vector_type(2)));
        const int col0 = u.pn * BM + wc * 32 + 4 * fq;
#pragma unroll
        for (int ai = 0; ai < 2; ++ai)
#pragma unroll
            for (int m = 0; m < 4; ++m) { const int row = u.pm * BM + ai * HALF + wr * 64 + m * 16 + fr; const size_t off = (size_t)row * ldc + col0; float ss = 0.f;
#pragma unroll
                for (int bj = 0; bj < 2; ++bj)
#pragma unroll
                    for (int n = 0; n < 2; ++n) { const u32x2v xb = *(const u32x2v*)(X + off + bj * HALF + n * 16);
                        const f32x4 xv = (f32x4){__builtin_bit_cast(float, xb.x << 16), __builtin_bit_cast(float, xb.x & 0xffff0000u), __builtin_bit_cast(float, xb.y << 16), __builtin_bit_cast(float, xb.y & 0xffff0000u)}; const f32x4 h = xv + acc[ai][bj][m][n];
                        u32x2v w; w.x = cvt_pk_bf16(h[0], h[1]); w.y = cvt_pk_bf16(h[2], h[3]);
                        *(u32x2v*)(Hb + off + bj * HALF + n * 16) = w; ss += (h[0] * h[0] + h[1] * h[1]) + (h[2] * h[2] + h[3] * h[3]); }
                ss += __shfl_xor(ss, 16); ss += __shfl_xor(ss, 32);
                if (fq == 0) atomicAdd(rowss + row, ss); }
    }
};

template <class Epi, class Sched, bool ALIGN_EPI = false, bool SP2 = false>
__device__ __forceinline__ void gemm_phase(PG8_LAS unsigned char* lds, const Gemm g, const Sched& S, const Epi& E) {
    const int tid = threadIdx.x, wid = __builtin_amdgcn_readfirstlane(tid >> 6), lane = tid & 63, wr = wid >> 2, wc = wid & 3, fr = lane & 15, fq = lane >> 4;
    const int K = g.K, nt = K / BK;
    unsigned voffA[2], voffB[2];
#pragma unroll
    for (int i = 0; i < 2; ++i) { int R, C; stage_rc(tid * 16 + i * 8192, R, C); const int Rb = Epi::PERM ? ((R & ~31) + perm32(R & 31)) : R;
        voffA[i] = (unsigned)(R * K + C) * 2u; voffB[i] = (unsigned)(Rb * K + C) * 2u; }
    const size_t kstep = (size_t)(BK * 2);
    const size_t hstep = (size_t)HALF * K * 2;
    const size_t tstep = 2 * hstep;
    const unsigned ldsw = (unsigned)wid * 1024u;
    const int aoff = lds_byte(wr * 64 + fr, fq * 8), boff = lds_byte(wc * 32 + fr, fq * 8);
#define PG8_SA(b, h) (((b) * 2 + (h)) * HTB)
#define PG8_SB(b, h) ((4 + (b) * 2 + (h)) * HTB)
#define PG8_STAGE(bufoff, gbase, voff) do { _Pragma("unroll") for (int _i = 0; _i < 2; ++_i) \
        __builtin_amdgcn_global_load_lds((const unsigned*)((const char*)(gbase) + (voff)[_i]), (PG8_LAS unsigned*)(lds + (bufoff) + ldsw + _i * 8192), 16, 0, 0); } while (0)
#define PG8_LDA(dst, b, h) do { _Pragma("unroll") for (int m = 0; m < 4; ++m) _Pragma("unroll") for (int k = 0; k < 2; ++k) dst[m][k] = *(const PG8_LAS bf16x8*)(lds + PG8_SA(b, h) + aoff + m * 2048 + k * 1024); } while (0)
#define PG8_LDB(dst, b, h) do { _Pragma("unroll") for (int n = 0; n < 2; ++n) _Pragma("unroll") for (int k = 0; k < 2; ++k) dst[n][k] = *(const PG8_LAS bf16x8*)(lds + PG8_SB(b, h) + boff + n * 2048 + k * 1024); } while (0)
#define PG8_MMA(ai, bj, At, Bt) do { __builtin_amdgcn_s_setprio(1); _Pragma("unroll") for (int m = 0; m < 4; ++m) _Pragma("unroll") for (int n = 0; n < 2; ++n) _Pragma("unroll") for (int k = 0; k < 2; ++k) \
        acc[ai][bj][m][n] = __builtin_amdgcn_mfma_f32_16x16x32_bf16(Bt[n][k], At[m][k], acc[ai][bj][m][n], 0, 0, 0); __builtin_amdgcn_s_setprio(0); } while (0)
#define PG8_WAIT_V(n) asm volatile("s_waitcnt vmcnt(" #n ")" ::: "memory")
#define PG8_WAIT_L(n) asm volatile("s_waitcnt lgkmcnt(" #n ")" ::: "memory")
#define PG8_BAR __builtin_amdgcn_s_barrier()
#define PG8_SCHED __builtin_amdgcn_sched_barrier(0)
    Unit cur, nxt; int ui = 0;
    if (!S.next(0, cur)) return;
    f32x4 acc[2][2][4][2];
#pragma unroll
    for (int a = 0; a < 2; ++a)
#pragma unroll
        for (int b = 0; b < 2; ++b)
#pragma unroll
            for (int m = 0; m < 4; ++m)
#pragma unroll
                for (int n = 0; n < 2; ++n) acc[a][b][m][n] = (f32x4){0.f, 0.f, 0.f, 0.f};
    bf16x8 At[4][2], B0[2][2], B1[2][2];
    const char* cA = (const char*)g.A + (size_t)cur.pm * tstep; const char* cB = (const char*)g.Bt + (size_t)cur.pn * tstep;
    S.a_ready(cur);
    if constexpr (SP2) {
        PG8_STAGE(PG8_SB(0, 0), cB, voffB); PG8_STAGE(PG8_SB(0, 1), cB + hstep, voffB); PG8_STAGE(PG8_SA(0, 0), cA, voffA); PG8_STAGE(PG8_SA(0, 1), cA + hstep, voffA);
        if (wr == 1) PG8_BAR;
        PG8_WAIT_V(2); PG8_BAR;
        PG8_STAGE(PG8_SB(1, 0), cB + kstep, voffB); PG8_STAGE(PG8_SA(1, 0), cA + kstep, voffA); PG8_STAGE(PG8_SB(1, 1), cB + hstep + kstep, voffB);
        PG8_WAIT_V(6); PG8_BAR;
    } else {
        PG8_STAGE(PG8_SB(0, 0), cB, voffB); PG8_STAGE(PG8_SA(0, 0), cA, voffA); PG8_STAGE(PG8_SB(0, 1), cB + hstep, voffB); PG8_STAGE(PG8_SA(0, 1), cA + hstep, voffA);
        if (wr == 1) PG8_BAR;
        PG8_WAIT_V(4); PG8_BAR;
        PG8_STAGE(PG8_SB(1, 0), cB + kstep, voffB); PG8_STAGE(PG8_SA(1, 0), cA + kstep, voffA); PG8_STAGE(PG8_SB(1, 1), cB + hstep + kstep, voffB);
        PG8_WAIT_V(6); PG8_BAR;
    }
    for (;;) {
        const bool has_next = S.next(ui + 1, nxt);
        const char* nA = has_next ? (const char*)g.A + (size_t)nxt.pm * tstep : cA; const char* nB = has_next ? (const char*)g.Bt + (size_t)nxt.pn * tstep : cB;
        for (int t = 0; t < nt; t += 2) {
            const bool last = (t == nt - 2);
            const char* a1 = cA + (size_t)(t + 1) * kstep;
            const char* a2 = last ? nA : cA + (size_t)(t + 2) * kstep; const char* b2 = last ? nB : cB + (size_t)(t + 2) * kstep;
            const char* a3 = a2 + kstep; const char* b3 = b2 + kstep;
            if (last && has_next) S.a_ready(nxt);
            if constexpr (SP2) {
            PG8_LDB(B0, 0, 0); PG8_LDB(B1, 0, 1); PG8_SCHED; PG8_LDA(At, 0, 0); PG8_STAGE(PG8_SA(1, 1), a1 + hstep, voffA);
            PG8_WAIT_V(8); PG8_WAIT_L(0); PG8_BAR; PG8_MMA(0, 0, At, B0); PG8_MMA(0, 1, At, B1); PG8_BAR; PG8_SCHED;
            PG8_LDA(At, 0, 1); PG8_STAGE(PG8_SB(0, 0), b2, voffB); PG8_STAGE(PG8_SB(0, 1), b2 + hstep, voffB); PG8_STAGE(PG8_SA(0, 0), a2, voffA);
            PG8_WAIT_V(8); PG8_WAIT_L(0); PG8_BAR; PG8_MMA(1, 0, At, B0); PG8_MMA(1, 1, At, B1); PG8_BAR; PG8_SCHED;
            PG8_LDB(B0, 1, 0); PG8_LDB(B1, 1, 1); PG8_SCHED; PG8_LDA(At, 1, 0); PG8_STAGE(PG8_SA(0, 1), a2 + hstep, voffA);
            PG8_WAIT_V(8); PG8_WAIT_L(0); PG8_BAR; PG8_MMA(0, 0, At, B0); PG8_MMA(0, 1, At, B1); PG8_BAR; PG8_SCHED;
            PG8_LDA(At, 1, 1); PG8_STAGE(PG8_SB(1, 0), b3, voffB); PG8_STAGE(PG8_SB(1, 1), b3 + hstep, voffB); PG8_STAGE(PG8_SA(1, 0), a3, voffA);
            PG8_WAIT_V(8); PG8_WAIT_L(0); PG8_BAR; PG8_MMA(1, 0, At, B0); PG8_MMA(1, 1, At, B1); PG8_BAR; PG8_SCHED;
            } else {
            PG8_LDB(B0, 0, 0); PG8_SCHED; PG8_LDA(At, 0, 0); PG8_STAGE(PG8_SA(1, 1), a1 + hstep, voffA);
            PG8_WAIT_L(8); PG8_BAR; PG8_WAIT_L(0); PG8_MMA(0, 0, At, B0); PG8_BAR; PG8_SCHED;
            PG8_LDB(B1, 0, 1); PG8_STAGE(PG8_SB(0, 0), b2, voffB);
            PG8_BAR; PG8_WAIT_L(0); PG8_MMA(0, 1, At, B1); PG8_BAR;
            PG8_LDA(At, 0, 1); PG8_STAGE(PG8_SA(0, 0), a2, voffA);
            PG8_BAR; PG8_WAIT_L(0); PG8_MMA(1, 0, At, B0); PG8_BAR; PG8_SCHED;
            PG8_STAGE(PG8_SB(0, 1), b2 + hstep, voffB);
            PG8_WAIT_V(6); PG8_BAR; PG8_MMA(1, 1, At, B1); PG8_BAR;
            PG8_LDB(B0, 1, 0); PG8_SCHED; PG8_LDA(At, 1, 0); PG8_STAGE(PG8_SA(0, 1), a2 + hstep, voffA);
            PG8_WAIT_L(8); PG8_BAR; PG8_WAIT_L(0); PG8_MMA(0, 0, At, B0); PG8_BAR; PG8_SCHED;
            PG8_LDB(B1, 1, 1); PG8_STAGE(PG8_SB(1, 0), b3, voffB);
            PG8_BAR; PG8_WAIT_L(0); PG8_MMA(0, 1, At, B1); PG8_BAR;
            PG8_LDA(At, 1, 1); PG8_STAGE(PG8_SA(1, 0), a3, voffA);
            PG8_BAR; PG8_WAIT_L(0); PG8_MMA(1, 0, At, B0); PG8_BAR; PG8_SCHED;
            PG8_STAGE(PG8_SB(1, 1), b3 + hstep, voffB);
            PG8_WAIT_V(6); PG8_BAR; PG8_MMA(1, 1, At, B1); PG8_BAR;
            }
        }
        if constexpr (ALIGN_EPI) { if (wr == 0) PG8_BAR; }
        if constexpr (!Epi::AFTER_DRAIN) { E(acc, cur, wr, wc, fr, fq); S.done(cur); }
        if (!has_next) break;
#pragma unroll
        for (int a = 0; a < 2; ++a)
#pragma unroll
            for (int b = 0; b < 2; ++b)
#pragma unroll
                for (int m = 0; m < 4; ++m)
#pragma unroll
                    for (int n = 0; n < 2; ++n) acc[a][b][m][n] = (f32x4){0.f, 0.f, 0.f, 0.f};
        cur = nxt; cA = nA; cB = nB; ++ui;
        if constexpr (ALIGN_EPI) { if (wr == 1) PG8_BAR; }
    }
    PG8_WAIT_V(0);
    if constexpr (!ALIGN_EPI) { if (wr == 0) PG8_BAR; }
    PG8_BAR;
    if constexpr (Epi::AFTER_DRAIN) { E.fused(acc, cur, wr, wc, fr, fq, lds, wid, lane); S.done(cur); }
#undef PG8_SA
#undef PG8_SB
#undef PG8_STAGE
#undef PG8_LDA
#undef PG8_LDB
#undef PG8_MMA
#undef PG8_WAIT_V
#undef PG8_WAIT_L
#undef PG8_BAR
#undef PG8_SCHED
}
}

#include <hip/hip_bf16.h>
#include <cmath>
namespace attn_body {
using bf16=__hip_bfloat16;
using bf16x8=__attribute__((ext_vector_type(8)))short;
using s16x4=__attribute__((ext_vector_type(4)))short;
using f32x16=__attribute__((ext_vector_type(16)))float;
using u32x4=__attribute__((ext_vector_type(4)))unsigned;
constexpr int SEQ=16384,D=64,DM=512;
constexpr int NW=8,QBLK=32,QB=QBLK*NW,KVBLK=64,NQB=SEQ/QB;
constexpr int ATTN_PITCH=DM, ATTN_UNIT_ROWS=QB;
__device__ __forceinline__ int crow(int r,int hi){return (r&3)+8*(r>>2)+4*hi;}
#define SBAR() __builtin_amdgcn_sched_barrier(0)
__device__ __forceinline__ void cmask(f32x16&p0,f32x16&p1,int jb,int wid){
  const float NEG=-INFINITY;
  if(jb>(wid>>1)){
  #pragma unroll
  for(int r=0;r<16;++r){p0[r]=NEG;p1[r]=NEG;}}
}

constexpr int NSLOT=3, SLOTB=8192;
constexpr int LDS_K=0, LDS_V=NSLOT*SLOTB, LDS_WS=2*NSLOT*SLOTB, LDS_OST=LDS_WS+NW*64*4, LDS_BYTES=LDS_OST+NW*4096;
constexpr float C2=0.125f*1.4426950408889634f;
__device__ __forceinline__ void glds16(const void*gsrc,unsigned lds_dst){unsigned keep;
  asm volatile("s_mov_b32 %0, m0\n\ts_mov_b32 m0, %2\n\ts_nop 0\n\tglobal_load_lds_dwordx4 %1, off\n\ts_mov_b32 m0, %0":"=&s"(keep):"v"(gsrc),"s"(lds_dst):"memory");}
__device__ __forceinline__ float max3f(float a,float b,float c){float r;asm("v_max3_f32 %0, %1, %2, %3":"=v"(r):"v"(a),"v"(b),"v"(c));return r;}
__device__ __forceinline__ float max2f(float a,float b){float r;asm("v_max_f32_e32 %0, %1, %2":"=v"(r):"v"(a),"v"(b));return r;}
__device__ __forceinline__ float fadd_s(float a,float b){float r;asm("v_add_f32_e32 %0, %1, %2":"=v"(r):"v"(a),"v"(b));return r;}
__device__ __forceinline__ float fsub_s(float a,float b){float r;asm("v_sub_f32_e32 %0, %1, %2":"=v"(r):"v"(a),"v"(b));return r;}
typedef float f32x2_t __attribute__((ext_vector_type(2))); typedef __bf16 bf16x2_t __attribute__((ext_vector_type(2)));
__device__ __forceinline__ unsigned cvtpk_s(float lo,float hi){f32x2_t v={lo,hi};bf16x2_t b=__builtin_convertvector(v,bf16x2_t);return __builtin_bit_cast(unsigned,b);}
#define WAIT_BAR(N) asm volatile("s_waitcnt vmcnt(" #N ") lgkmcnt(0)\n\ts_barrier":::"memory")

__device__ __forceinline__ void qkt(f32x16&p0,f32x16&p1,const char*Kslot,const bf16x8*qr,const f32x16&negm,int r32,int hi){
  const char*kb=Kslot+hi*1024+r32*16;
  #pragma unroll
  for(int d0=0;d0<4;++d0){
    const bf16x8 b0=*reinterpret_cast<const bf16x8*>(kb+d0*2048);
    const bf16x8 b1=*reinterpret_cast<const bf16x8*>(kb+d0*2048+512);
    if(d0==0){p0=__builtin_amdgcn_mfma_f32_32x32x16_bf16(b0,qr[0],negm,0,0,0);p1=__builtin_amdgcn_mfma_f32_32x32x16_bf16(b1,qr[0],negm,0,0,0);}
    else{p0=__builtin_amdgcn_mfma_f32_32x32x16_bf16(b0,qr[d0],p0,0,0,0);p1=__builtin_amdgcn_mfma_f32_32x32x16_bf16(b1,qr[d0],p1,0,0,0);}}
}
typedef __attribute__((address_space(3))) const char* lds_cptr;
typedef short v4i16_t __attribute__((ext_vector_type(4)));
__device__ __forceinline__ void kload8(bf16x8*kf,lds_cptr kp){
  kf[0]=*(const __attribute__((address_space(3))) bf16x8*)(kp);      kf[1]=*(const __attribute__((address_space(3))) bf16x8*)(kp+512);
  kf[2]=*(const __attribute__((address_space(3))) bf16x8*)(kp+2048); kf[3]=*(const __attribute__((address_space(3))) bf16x8*)(kp+2560);
  kf[4]=*(const __attribute__((address_space(3))) bf16x8*)(kp+4096); kf[5]=*(const __attribute__((address_space(3))) bf16x8*)(kp+4608);
  kf[6]=*(const __attribute__((address_space(3))) bf16x8*)(kp+6144); kf[7]=*(const __attribute__((address_space(3))) bf16x8*)(kp+6656);
}
__device__ __forceinline__ void kload2(bf16x8*kf,lds_cptr kp,int j){ kf[2*j]=*(const __attribute__((address_space(3))) bf16x8*)(kp+j*2048); kf[2*j+1]=*(const __attribute__((address_space(3))) bf16x8*)(kp+j*2048+512); }
__device__ __forceinline__ s16x4 vtr(lds_cptr p){ return __builtin_bit_cast(s16x4,__builtin_amdgcn_ds_read_tr16_b64_v4i16((__attribute__((address_space(3))) v4i16_t*)p)); }
__device__ __forceinline__ float rowmax(const f32x16&p0,const f32x16&p1){
  float a=max3f(p0[0],p0[1],p1[0]),b=max3f(p0[2],p0[3],p1[1]);a=max3f(a,p1[2],p1[3]);
  #pragma unroll
  for(int r=4;r<16;r+=4){a=max3f(a,p0[r],p0[r+1]);b=max3f(b,p0[r+2],p0[r+3]);a=max3f(a,p1[r],p1[r+1]);b=max3f(b,p1[r+2],p1[r+3]);}
  const float m=max2f(a,b);
  auto rr=__builtin_amdgcn_permlane32_swap(__float_as_uint(m),__float_as_uint(m),false,false);
  return max2f(__uint_as_float(rr[0]),__uint_as_float(rr[1]));
}
__device__ __forceinline__ void pv(f32x16*o,int vb,bf16x8 pa0,bf16x8 pa1,bf16x8 pa2,bf16x8 pa3){
  #pragma unroll
  for(int d0=0;d0<2;++d0){s16x4 lo[4],hi[4];
    #pragma unroll
    for(int ks=0;ks<4;++ks){
      asm volatile("ds_read_b64_tr_b16 %0,%1 offset:%c2":"=&v"(lo[ks]):"v"(vb),"i"(d0*4096+ks*1024):"memory");
      asm volatile("ds_read_b64_tr_b16 %0,%1 offset:%c2":"=&v"(hi[ks]):"v"(vb),"i"(d0*4096+ks*1024+512):"memory");}
    asm volatile("s_waitcnt lgkmcnt(0)":::"memory");SBAR();
    #define PK(k) (bf16x8){lo[k][0],lo[k][1],lo[k][2],lo[k][3],hi[k][0],hi[k][1],hi[k][2],hi[k][3]}
    o[d0]=__builtin_amdgcn_mfma_f32_32x32x16_bf16(pa0,PK(0),o[d0],0,0,0);
    o[d0]=__builtin_amdgcn_mfma_f32_32x32x16_bf16(pa1,PK(1),o[d0],0,0,0);
    o[d0]=__builtin_amdgcn_mfma_f32_32x32x16_bf16(pa2,PK(2),o[d0],0,0,0);
    o[d0]=__builtin_amdgcn_mfma_f32_32x32x16_bf16(pa3,PK(3),o[d0],0,0,0);
    #undef PK
  }
}

#ifndef ATTN_STORE16
#define ATTN_STORE16(p,v) (*(u32x4*)(p)=(v))
#endif
template<int THRL> __device__ __forceinline__ void attn_unit(int qcol,int vcol,int qb,const bf16*Q,const bf16*__restrict__ K,const bf16*__restrict__ V,bf16*O,char*shm){
  const int tid=threadIdx.x,lane=tid&63,r32=lane&31,hi=lane>>5; const int wid=__builtin_amdgcn_readfirstlane(tid>>6);
  const long rowbase=0; const int q0=qb*QB;
  const bf16*Qw=Q+(rowbase+q0+wid*QBLK)*DM+qcol;
  const bf16*Kh=K+rowbase*DM+qcol,*Vh=V+rowbase*DM+vcol;
  const unsigned lds0=(unsigned)(uintptr_t)shm;
  float*wsf=(float*)(shm+LDS_WS)+wid*64;
  const bf16*ksrc=Kh+(long)lane*DM+wid*8;
  const bf16*vsrc=Vh+(long)(16*(wid&3)+(lane>>2))*DM+(wid>>2)*32+(lane&3)*8;
  const unsigned kdst=lds0+LDS_K+wid*1024, vdst=lds0+LDS_V+wid*1024;
  #define DMA_K(t,slot) glds16(ksrc+(long)(t)*KVBLK*DM,(unsigned)__builtin_amdgcn_readfirstlane(kdst+(slot)))
  #define DMA_V(t,slot) glds16(vsrc+(long)(t)*KVBLK*DM,(unsigned)__builtin_amdgcn_readfirstlane(vdst+(slot)))
  const int vb0=(int)(lds0+LDS_V)+((lane>>4)&1)*32+(lane&3)*8+(4*hi+((lane&15)>>2))*64;
  const char*Kbase=shm+LDS_K; bf16x8 kf[8];
  const lds_cptr shm3=(lds_cptr)shm; const lds_cptr kp0=shm3+LDS_K+hi*1024+r32*16; const lds_cptr vp0=shm3+LDS_V+((lane>>4)&1)*32+(lane&3)*8+(4*hi+((lane&15)>>2))*64;
  const int NT=(q0+QB)/KVBLK;
  DMA_K(0,0);DMA_V(0,0);DMA_K(1,SLOTB);
  bf16x8 qr[4];
  #pragma unroll
  for(int d0=0;d0<4;++d0)qr[d0]=*reinterpret_cast<const bf16x8*>(&Qw[(long)r32*DM+d0*16+hi*8]);
  float mhat=0.f,l_reg=0.f;f32x16 o[2];o[0]=f32x16{};o[1]=f32x16{};f32x16 negm=f32x16{};asm volatile("":"+v"(negm));
  const int qrel=wid*QBLK+r32;
  #define CMASK(P0,P1,t) do{int jb_=(t)-(NT-4); if(jb_>=0)cmask(P0,P1,jb_,wid);}while(0)
  bool resc=false;
  #define START(P0,P1) do{ const float rm=rowmax(P0,P1); resc=false; \
    { const float dl=rm; mhat=fadd_s(mhat,dl); \
      _Pragma("unroll") for(int r=0;r<16;++r){P0[r]=fsub_s(P0[r],dl);P1[r]=fsub_s(P1[r],dl);} \
      _Pragma("unroll") for(int r=0;r<16;++r)negm[r]=-mhat; asm volatile("":"+v"(negm)); } \
    _Pragma("unroll") for(int r=0;r<16;++r)P0[r]=__builtin_amdgcn_exp2f(P0[r]); }while(0)
  #define RESC() do{ if(resc){ asm volatile("s_waitcnt lgkmcnt(0)":::"memory"); \
      _Pragma("unroll") for(int d_=0;d_<2;++d_) _Pragma("unroll") for(int r=0;r<16;++r)o[d_][r]*=wsf[crow(r,hi)]; } }while(0)
  f32x16 pA0,pA1,pB0,pB1;
  int sl_prev=0,sl_cur=0,sl_next=SLOTB;
  #define ROT() do{sl_prev=sl_cur;sl_cur=sl_next;sl_next=(sl_next==(NSLOT-1)*SLOTB)?0:sl_next+SLOTB;}while(0)
  DMA_K(2,2*SLOTB);
  WAIT_BAR(3);
  qkt(pA0,pA1,Kbase,qr,negm,r32,hi);asm volatile("s_nop 15\n\ts_nop 7":"+v"(pA0),"+v"(pA1));CMASK(pA0,pA1,0);
  START(pA0,pA1);
  _Pragma("unroll") for(int r=0;r<16;++r)pA1[r]=__builtin_amdgcn_exp2f(pA1[r]);
  WAIT_BAR(0);
  DMA_K(3,0);DMA_V(1,SLOTB);
  ROT();
  kload8(kf,kp0+sl_cur);
  WAIT_BAR(2);
  s16x4 vlo[8],vhi[8]; u32x4 pw0,pw1,pw2,pw3;
  #define PKW(P,B) cvtpk_s(P[B],P[B+1])
  #define PAF(k) __builtin_bit_cast(bf16x8,pw##k)
  #define VFR(i) (bf16x8){vlo[i][0],vlo[i][1],vlo[i][2],vlo[i][3],vhi[i][0],vhi[i][1],vhi[i][2],vhi[i][3]}
  #define PIN(x) asm volatile("":"+v"(x))
  #define MX3(a,b,c) __builtin_fmaxf(__builtin_fmaxf((a),(b)),(c))
  #define GAPA(MF,A0,A1,A2,A3,W0,W1,PW) do{ MF; sacc+=A0; sacc+=A1; sacc+=A2; sacc+=A3; PIN(sacc); W0; W1; PIN(PW); SBAR(); }while(0)
  #define EX(v) __builtin_amdgcn_exp2f(v)
  #define GAPB(MF,X,B) do{ MF; X[B]=EX(X[B]); X[B+1]=EX(X[B+1]); X[B+2]=EX(X[B+2]); X[B+3]=EX(X[B+3]); PIN(X); SBAR(); }while(0)
  #define VRD(i) do{ vlo[i]=vtr(vp_+(((i)>>2)*4096+((i)&3)*1024)); vhi[i]=vtr(vp_+(((i)>>2)*4096+((i)&3)*1024+512)); }while(0)
  #define KRD(G,j) do{ if(G){ kload2(kf,kp0+sl_next,j); SBAR(); } }while(0)
  #define STEP(C0,C1,P0,P1,t,GK,GV,GL) do{ SBAR(); \
    const lds_cptr vp_=vp0+sl_prev; \
    VRD(0); SBAR(); float sacc=(P0[0]+P0[1]); \
    GAPA(C0=__builtin_amdgcn_mfma_f32_32x32x16_bf16(kf[0],qr[0],negm,0,0,0), P0[2],P0[3],P0[4],P0[5],     pw0[0]=PKW(P0,0), pw0[1]=PKW(P0,2), pw0); \
    VRD(4); SBAR(); GAPA(C1=__builtin_amdgcn_mfma_f32_32x32x16_bf16(kf[1],qr[0],negm,0,0,0), P0[6],P0[7],P0[8],P0[9],     pw0[2]=PKW(P0,4), pw0[3]=PKW(P0,6), pw0); \
    VRD(1); SBAR(); GAPA(C0=__builtin_amdgcn_mfma_f32_32x32x16_bf16(kf[2],qr[1],C0,0,0,0),   P0[10],P0[11],P0[12],P0[13], pw1[0]=PKW(P0,8), pw1[1]=PKW(P0,10), pw1); \
    VRD(5); SBAR(); GAPA(C1=__builtin_amdgcn_mfma_f32_32x32x16_bf16(kf[3],qr[1],C1,0,0,0),   P0[14],P0[15],P1[0],P1[1],   pw1[2]=PKW(P0,12),pw1[3]=PKW(P0,14), pw1); \
    VRD(2); SBAR(); GAPA(C0=__builtin_amdgcn_mfma_f32_32x32x16_bf16(kf[4],qr[2],C0,0,0,0),   P1[2],P1[3],P1[4],P1[5],     pw2[0]=PKW(P1,0), pw2[1]=PKW(P1,2), pw2); \
    VRD(6); SBAR(); GAPA(C1=__builtin_amdgcn_mfma_f32_32x32x16_bf16(kf[5],qr[2],C1,0,0,0),   P1[6],P1[7],P1[8],P1[9],     pw2[2]=PKW(P1,4), pw2[3]=PKW(P1,6), pw2); \
    VRD(3); SBAR(); GAPA(C0=__builtin_amdgcn_mfma_f32_32x32x16_bf16(kf[6],qr[3],C0,0,0,0),   P1[10],P1[11],P1[12],P1[13], pw3[0]=PKW(P1,8), pw3[1]=PKW(P1,10), pw3); \
    VRD(7); SBAR(); GAPA(C1=__builtin_amdgcn_mfma_f32_32x32x16_bf16(kf[7],qr[3],C1,0,0,0),   P1[14],P1[15],0.f,0.f,       pw3[2]=PKW(P1,12),pw3[3]=PKW(P1,14), pw3); \
    l_reg+=sacc; \
    if(GK){DMA_K((t)+3,sl_cur);} if(GV){DMA_V((t)+1,sl_next);} \
    CMASK(C0,C1,t); \
    { float a=MX3(C0[0],C0[1],C1[0]),b=MX3(C0[2],C0[3],C1[1]); a=MX3(a,C1[2],C1[3]); \
      _Pragma("unroll") for(int r=4;r<16;r+=4){a=MX3(a,C0[r],C0[r+1]);b=MX3(b,C0[r+2],C0[r+3]);a=MX3(a,C1[r],C1[r+1]);b=MX3(b,C1[r+2],C1[r+3]);} \
      float rm=__builtin_fmaxf(a,b); { auto rr=__builtin_amdgcn_permlane32_swap(__float_as_uint(rm),__float_as_uint(rm),false,false); rm=__builtin_fmaxf(__uint_as_float(rr[0]),__uint_as_float(rr[1])); } \
      resc=false; \
      if(__builtin_expect(__any(rm>(float)THRL),0)){ const float dl=__builtin_fmaxf(rm,0.f); mhat+=dl; \
        _Pragma("unroll") for(int r=0;r<16;++r){C0[r]-=dl;C1[r]-=dl;} \
        _Pragma("unroll") for(int r=0;r<16;++r)negm[r]=-mhat; asm volatile("":"+v"(negm)); \
        const float f=__builtin_amdgcn_exp2f(-dl); l_reg*=f; if(hi==0)wsf[r32]=f; resc=true; } } \
    SBAR(); \
    GAPB(o[0]=__builtin_amdgcn_mfma_f32_32x32x16_bf16(PAF(0),VFR(0),o[0],0,0,0), C0,0); \
    GAPB(o[1]=__builtin_amdgcn_mfma_f32_32x32x16_bf16(PAF(0),VFR(4),o[1],0,0,0), C0,4); \
    KRD(GL,0); GAPB(o[0]=__builtin_amdgcn_mfma_f32_32x32x16_bf16(PAF(1),VFR(1),o[0],0,0,0), C0,8); \
    KRD(GL,1); GAPB(o[1]=__builtin_amdgcn_mfma_f32_32x32x16_bf16(PAF(1),VFR(5),o[1],0,0,0), C0,12); \
    KRD(GL,2); GAPB(o[0]=__builtin_amdgcn_mfma_f32_32x32x16_bf16(PAF(2),VFR(2),o[0],0,0,0), C1,0); \
    KRD(GL,3); GAPB(o[1]=__builtin_amdgcn_mfma_f32_32x32x16_bf16(PAF(2),VFR(6),o[1],0,0,0), C1,4); \
    GAPB(o[0]=__builtin_amdgcn_mfma_f32_32x32x16_bf16(PAF(3),VFR(3),o[0],0,0,0), C1,8); \
    GAPB(o[1]=__builtin_amdgcn_mfma_f32_32x32x16_bf16(PAF(3),VFR(7),o[1],0,0,0), C1,12); \
    }while(0)
  int t=1;
  #undef CMASK
  #define CMASK(P0,P1,t) do{}while(0)
  for(;t+5<NT;t+=2){
    STEP(pB0,pB1,pA0,pA1,t,true,true,true);     WAIT_BAR(2); RESC(); ROT();
    STEP(pA0,pA1,pB0,pB1,t+1,true,true,true);   WAIT_BAR(2); RESC(); ROT();
  }
  #undef CMASK
  #define CMASK(P0,P1,t) do{int jb_=(t)-(NT-4); if(jb_>=0)cmask(P0,P1,jb_,wid);}while(0)
  #define ENDW(tt) do{ if((tt)+3<NT){WAIT_BAR(2);} else if((tt)+2<NT){WAIT_BAR(1);} else {WAIT_BAR(0);} }while(0)
  for(;t+1<NT;t+=2){
    STEP(pB0,pB1,pA0,pA1,t,(t+3<NT),(t+1<NT),(t+1<NT));       ENDW(t);   RESC(); ROT();
    STEP(pA0,pA1,pB0,pB1,t+1,(t+4<NT),(t+2<NT),(t+2<NT));     ENDW(t+1); RESC(); ROT();
  }
  STEP(pB0,pB1,pA0,pA1,NT-1,false,false,false); RESC();
  { float sacc=pB0[0]+pB0[1]; _Pragma("unroll") for(int r=2;r<16;++r)sacc+=pB0[r]; _Pragma("unroll") for(int r=0;r<16;++r)sacc+=pB1[r]; l_reg+=sacc;
    pw0=(u32x4){PKW(pB0,0),PKW(pB0,2),PKW(pB0,4),PKW(pB0,6)};pw1=(u32x4){PKW(pB0,8),PKW(pB0,10),PKW(pB0,12),PKW(pB0,14)};pw2=(u32x4){PKW(pB1,0),PKW(pB1,2),PKW(pB1,4),PKW(pB1,6)};pw3=(u32x4){PKW(pB1,8),PKW(pB1,10),PKW(pB1,12),PKW(pB1,14)};
    SBAR(); pv(o,vb0+sl_cur,PAF(0),PAF(1),PAF(2),PAF(3)); }
  #undef PKW
  #undef PAF
  #undef VFR
  #undef PIN
  #undef MX3
  #undef GAPA
  #undef GAPB
  #undef EX
  #undef VRD
  #undef KRD
  #undef STEP
  #undef ENDW
  {auto rr=__builtin_amdgcn_permlane32_swap(__float_as_uint(l_reg),__float_as_uint(l_reg),false,false);l_reg=__uint_as_float(rr[0])+__uint_as_float(rr[1]);}
  if(hi==0)wsf[32+r32]=l_reg;asm volatile("s_waitcnt lgkmcnt(0)":::"memory");
  float rli[16];
  #pragma unroll
  for(int r=0;r<16;++r)rli[r]=__builtin_amdgcn_rcpf(wsf[32+crow(r,hi)]);
  bf16*Ow=O+(rowbase+q0+wid*QBLK)*DM+vcol;
  { bf16*stg=(bf16*)(shm+LDS_OST)+wid*2048;
    #pragma unroll
    for(int r=0;r<16;++r){const int orow=crow(r,hi);
      #pragma unroll
      for(int d0=0;d0<2;++d0)stg[orow*64+d0*32+r32]=__float2bfloat16(o[d0][r]*rli[r]);}
    asm volatile("s_waitcnt lgkmcnt(0)":::"memory");
    #pragma unroll
    for(int i=0;i<4;++i){const int row=i*8+(lane>>3),ch=lane&7; const u32x4 v=*(const u32x4*)(stg+row*64+ch*8); ATTN_STORE16(Ow+(long)row*DM+ch*8,v);} }
  asm volatile("s_waitcnt lgkmcnt(0)\n\ts_barrier":::"memory");
  #undef DMA_K
  #undef DMA_V
  #undef CMASK
  #undef START
  #undef RESC
  #undef ROT
}
constexpr int ATTN_LDS_BYTES=LDS_BYTES;
struct AttnTensors { const bf16* Q; const bf16* K; const bf16* V; bf16* O; };
struct AttnUnit { int var; int qb; };
struct StaticOrder {
  int vcu;
  __device__ __forceinline__ explicit StaticOrder(int v):vcu(v){}
  __device__ __forceinline__ bool next(int i,AttnUnit&u)const{ if(i>=4)return false; const int s=vcu&15; u.var=vcu>>4; u.qb=(i==0)?s:(i==1)?31-s:(i==2)?32+s:63-s; return true; }
};
template<class Sched,int THRL=8> __device__ __forceinline__ void attn_phase(char*lds,const AttnTensors&T,const Sched&S){
  AttnUnit u;
  for(int i=0;S.next(i,u);++i){ const int h=u.var>>2,mp=(u.var>>1)&1,vh=u.var&1;
    attn_unit<THRL>(h*128+mp*64,h*128+vh*64,u.qb,T.Q,T.K,T.V,T.O+(size_t)mp*SEQ*DM,lds); }
}
#undef SBAR
#undef WAIT_BAR
}
namespace attn128 {
using bf16=__hip_bfloat16;
using bf16x8=__attribute__((ext_vector_type(8)))short;
using s16x4=__attribute__((ext_vector_type(4)))short;
using f32x16=__attribute__((ext_vector_type(16)))float;
using u32x4=__attribute__((ext_vector_type(4)))unsigned;
constexpr int SEQ=16384,D=64,DM=512;
constexpr int NW=8,QBLK=32,QB=QBLK*NW,KVBLK=64,NQB=SEQ/QB;
constexpr int ATTN_PITCH=DM, ATTN_UNIT_ROWS=QB;
__device__ __forceinline__ int crow(int r,int hi){return (r&3)+8*(r>>2)+4*hi;}
#define SBAR() __builtin_amdgcn_sched_barrier(0)
__device__ __forceinline__ void cmask(f32x16&p0,f32x16&p1,int jb,int wid){
  const float NEG=-INFINITY;
  if(jb>(wid>>1)){
  #pragma unroll
  for(int r=0;r<16;++r){p0[r]=NEG;p1[r]=NEG;}}
}

constexpr int NSLOT=3, SLOTB=8192;
constexpr int LDS_K=0, LDS_V=NSLOT*SLOTB, LDS_WS=3*NSLOT*SLOTB, LDS_OST=LDS_WS+NW*64*4, LDS_BYTES=LDS_OST+NW*4096;
constexpr float C2=0.125f*1.4426950408889634f;
__device__ __forceinline__ void glds16(const void*gsrc,unsigned lds_dst){unsigned keep;
  asm volatile("s_mov_b32 %0, m0\n\ts_mov_b32 m0, %2\n\ts_nop 0\n\tglobal_load_lds_dwordx4 %1, off\n\ts_mov_b32 m0, %0":"=&s"(keep):"v"(gsrc),"s"(lds_dst):"memory");}
__device__ __forceinline__ float max3f(float a,float b,float c){float r;asm("v_max3_f32 %0, %1, %2, %3":"=v"(r):"v"(a),"v"(b),"v"(c));return r;}
__device__ __forceinline__ float max2f(float a,float b){float r;asm("v_max_f32_e32 %0, %1, %2":"=v"(r):"v"(a),"v"(b));return r;}
__device__ __forceinline__ float fadd_s(float a,float b){float r;asm("v_add_f32_e32 %0, %1, %2":"=v"(r):"v"(a),"v"(b));return r;}
__device__ __forceinline__ float fsub_s(float a,float b){float r;asm("v_sub_f32_e32 %0, %1, %2":"=v"(r):"v"(a),"v"(b));return r;}
typedef float f32x2_t __attribute__((ext_vector_type(2))); typedef __bf16 bf16x2_t __attribute__((ext_vector_type(2)));
__device__ __forceinline__ unsigned cvtpk_s(float lo,float hi){f32x2_t v={lo,hi};bf16x2_t b=__builtin_convertvector(v,bf16x2_t);return __builtin_bit_cast(unsigned,b);}
#define WAIT_BAR(N) asm volatile("s_waitcnt vmcnt(" #N ") lgkmcnt(0)\n\ts_barrier":::"memory")

__device__ __forceinline__ void qkt(f32x16&p0,f32x16&p1,const char*Kslot,const bf16x8*qr,const f32x16&negm,int r32,int hi){
  const char*kb=Kslot+hi*1024+r32*16;
  #pragma unroll
  for(int d0=0;d0<4;++d0){
    const bf16x8 b0=*reinterpret_cast<const bf16x8*>(kb+d0*2048);
    const bf16x8 b1=*reinterpret_cast<const bf16x8*>(kb+d0*2048+512);
    if(d0==0){p0=__builtin_amdgcn_mfma_f32_32x32x16_bf16(b0,qr[0],negm,0,0,0);p1=__builtin_amdgcn_mfma_f32_32x32x16_bf16(b1,qr[0],negm,0,0,0);}
    else{p0=__builtin_amdgcn_mfma_f32_32x32x16_bf16(b0,qr[d0],p0,0,0,0);p1=__builtin_amdgcn_mfma_f32_32x32x16_bf16(b1,qr[d0],p1,0,0,0);}}
}
typedef __attribute__((address_space(3))) const char* lds_cptr;
typedef short v4i16_t __attribute__((ext_vector_type(4)));
__device__ __forceinline__ void kload8(bf16x8*kf,lds_cptr kp){
  kf[0]=*(const __attribute__((address_space(3))) bf16x8*)(kp);      kf[1]=*(const __attribute__((address_space(3))) bf16x8*)(kp+512);
  kf[2]=*(const __attribute__((address_space(3))) bf16x8*)(kp+2048); kf[3]=*(const __attribute__((address_space(3))) bf16x8*)(kp+2560);
  kf[4]=*(const __attribute__((address_space(3))) bf16x8*)(kp+4096); kf[5]=*(const __attribute__((address_space(3))) bf16x8*)(kp+4608);
  kf[6]=*(const __attribute__((address_space(3))) bf16x8*)(kp+6144); kf[7]=*(const __attribute__((address_space(3))) bf16x8*)(kp+6656);
}
__device__ __forceinline__ void kload2(bf16x8*kf,lds_cptr kp,int j){ kf[2*j]=*(const __attribute__((address_space(3))) bf16x8*)(kp+j*2048); kf[2*j+1]=*(const __attribute__((address_space(3))) bf16x8*)(kp+j*2048+512); }
__device__ __forceinline__ s16x4 vtr(lds_cptr p){ return __builtin_bit_cast(s16x4,__builtin_amdgcn_ds_read_tr16_b64_v4i16((__attribute__((address_space(3))) v4i16_t*)p)); }
__device__ __forceinline__ float rowmax(const f32x16&p0,const f32x16&p1){
  float a=max3f(p0[0],p0[1],p1[0]),b=max3f(p0[2],p0[3],p1[1]);a=max3f(a,p1[2],p1[3]);
  #pragma unroll
  for(int r=4;r<16;r+=4){a=max3f(a,p0[r],p0[r+1]);b=max3f(b,p0[r+2],p0[r+3]);a=max3f(a,p1[r],p1[r+1]);b=max3f(b,p1[r+2],p1[r+3]);}
  const float m=max2f(a,b);
  auto rr=__builtin_amdgcn_permlane32_swap(__float_as_uint(m),__float_as_uint(m),false,false);
  return max2f(__uint_as_float(rr[0]),__uint_as_float(rr[1]));
}
__device__ __forceinline__ void pv(f32x16*o,int vb,bf16x8 pa0,bf16x8 pa1,bf16x8 pa2,bf16x8 pa3){
  #pragma unroll
  for(int d0=0;d0<4;++d0){s16x4 lo[4],hi[4];
    #pragma unroll
    for(int ks=0;ks<4;++ks){
      asm volatile("ds_read_b64_tr_b16 %0,%1 offset:%c2":"=&v"(lo[ks]):"v"(vb),"i"(d0*4096+ks*1024):"memory");
      asm volatile("ds_read_b64_tr_b16 %0,%1 offset:%c2":"=&v"(hi[ks]):"v"(vb),"i"(d0*4096+ks*1024+512):"memory");}
    asm volatile("s_waitcnt lgkmcnt(0)":::"memory");SBAR();
    #define PK(k) (bf16x8){lo[k][0],lo[k][1],lo[k][2],lo[k][3],hi[k][0],hi[k][1],hi[k][2],hi[k][3]}
    o[d0]=__builtin_amdgcn_mfma_f32_32x32x16_bf16(pa0,PK(0),o[d0],0,0,0);
    o[d0]=__builtin_amdgcn_mfma_f32_32x32x16_bf16(pa1,PK(1),o[d0],0,0,0);
    o[d0]=__builtin_amdgcn_mfma_f32_32x32x16_bf16(pa2,PK(2),o[d0],0,0,0);
    o[d0]=__builtin_amdgcn_mfma_f32_32x32x16_bf16(pa3,PK(3),o[d0],0,0,0);
    #undef PK
  }
}

#ifndef ATTN_STORE16
#define ATTN_STORE16(p,v) (*(u32x4*)(p)=(v))
#endif
template<int THRL> __device__ __forceinline__ void attn_unit(int qcol,int vcol,int qb,const bf16*Q,const bf16*__restrict__ K,const bf16*__restrict__ V,bf16*O,char*shm){
  const int tid=threadIdx.x,lane=tid&63,r32=lane&31,hi=lane>>5; const int wid=__builtin_amdgcn_readfirstlane(tid>>6);
  const long rowbase=0; const int q0=qb*QB;
  const bf16*Qw=Q+(rowbase+q0+wid*QBLK)*DM+qcol;
  const bf16*Kh=K+rowbase*DM+qcol,*Vh=V+rowbase*DM+vcol;
  const unsigned lds0=(unsigned)(uintptr_t)shm;
  float*wsf=(float*)(shm+LDS_WS)+wid*64;
  const bf16*ksrc=Kh+(long)lane*DM+wid*8;
  const bf16*vsrc=Vh+(long)(16*(wid&3)+(lane>>2))*DM+(wid>>2)*32+(lane&3)*8;
  const unsigned kdst=lds0+LDS_K+wid*1024, vdst=lds0+LDS_V+wid*1024;
  #define DMA_K(t,slot) glds16(ksrc+(long)(t)*KVBLK*DM,(unsigned)__builtin_amdgcn_readfirstlane(kdst+(slot)))
  #define DMA_V(t,slot) do{ glds16(vsrc+(long)(t)*KVBLK*DM,(unsigned)__builtin_amdgcn_readfirstlane(vdst+2*(slot))); glds16(vsrc+64+(long)(t)*KVBLK*DM,(unsigned)__builtin_amdgcn_readfirstlane(vdst+2*(slot)+8192)); }while(0)
  const int vb0=(int)(lds0+LDS_V)+((lane>>4)&1)*32+(lane&3)*8+(4*hi+((lane&15)>>2))*64;
  const char*Kbase=shm+LDS_K; bf16x8 kf[8];
  const lds_cptr shm3=(lds_cptr)shm; const lds_cptr kp0=shm3+LDS_K+hi*1024+r32*16; const lds_cptr vp0=shm3+LDS_V+((lane>>4)&1)*32+(lane&3)*8+(4*hi+((lane&15)>>2))*64;
  const int NT=(q0+QB)/KVBLK;
  DMA_K(0,0);DMA_V(0,0);DMA_K(1,SLOTB);
  bf16x8 qr[4];
  #pragma unroll
  for(int d0=0;d0<4;++d0)qr[d0]=*reinterpret_cast<const bf16x8*>(&Qw[(long)r32*DM+d0*16+hi*8]);
  float mhat=0.f,l_reg=0.f;f32x16 o[4];o[0]=f32x16{};o[1]=f32x16{};o[2]=f32x16{};o[3]=f32x16{};const f32x16 negm=f32x16{};
  const int qrel=wid*QBLK+r32;
  #define CMASK(P0,P1,t) do{int jb_=(t)-(NT-4); if(jb_>=0)cmask(P0,P1,jb_,wid);}while(0)
  bool resc=false;
  #define START(P0,P1) do{ const float rm=rowmax(P0,P1); resc=false; \
    { const float dl=rm; mhat=fadd_s(mhat,dl); \
      _Pragma("unroll") for(int r=0;r<16;++r){P0[r]=fsub_s(P0[r],dl);P1[r]=fsub_s(P1[r],dl);} \
      } \
    _Pragma("unroll") for(int r=0;r<16;++r)P0[r]=__builtin_amdgcn_exp2f(P0[r]); }while(0)
  #define RESC() do{ if(resc){ asm volatile("s_waitcnt lgkmcnt(0)":::"memory"); \
      _Pragma("unroll") for(int d_=0;d_<4;++d_) _Pragma("unroll") for(int r=0;r<16;++r)o[d_][r]*=wsf[crow(r,hi)]; } }while(0)
  f32x16 pA0,pA1,pB0,pB1;
  int sl_prev=0,sl_cur=0,sl_next=SLOTB;
  #define ROT() do{sl_prev=sl_cur;sl_cur=sl_next;sl_next=(sl_next==(NSLOT-1)*SLOTB)?0:sl_next+SLOTB;}while(0)
  DMA_K(2,2*SLOTB);
  WAIT_BAR(4);
  qkt(pA0,pA1,Kbase,qr,negm,r32,hi);asm volatile("s_nop 15\n\ts_nop 7":"+v"(pA0),"+v"(pA1));CMASK(pA0,pA1,0);
  START(pA0,pA1);
  _Pragma("unroll") for(int r=0;r<16;++r)pA1[r]=__builtin_amdgcn_exp2f(pA1[r]);
  WAIT_BAR(0);
  DMA_K(3,0);DMA_V(1,SLOTB);
  ROT();
  kload8(kf,kp0+sl_cur);
  WAIT_BAR(3);
  s16x4 vlo[8],vhi[8]; u32x4 pw0,pw1,pw2,pw3;
  #define PKW(P,B) cvtpk_s(P[B],P[B+1])
  #define PAF(k) __builtin_bit_cast(bf16x8,pw##k)
  #define VFR(i) (bf16x8){vlo[i][0],vlo[i][1],vlo[i][2],vlo[i][3],vhi[i][0],vhi[i][1],vhi[i][2],vhi[i][3]}
  #define PIN(x) asm volatile("":"+v"(x))
  #define MX3(a,b,c) __builtin_fmaxf(__builtin_fmaxf((a),(b)),(c))
  #define GAPA(MF,A0,A1,A2,A3,W0,W1,PW) do{ MF; sacc+=A0; sacc+=A1; sacc+=A2; sacc+=A3; PIN(sacc); W0; W1; PIN(PW); SBAR(); }while(0)
  #define EX(v) __builtin_amdgcn_exp2f(v)
  #define GAPB(MF,X,B) do{ MF; X[B]=EX(X[B]); X[B+1]=EX(X[B+1]); X[B+2]=EX(X[B+2]); X[B+3]=EX(X[B+3]); PIN(X); SBAR(); }while(0)
  #define VRD(i) do{ vlo[i]=vtr(vp_+(((i)>>2)*4096+((i)&3)*1024)); vhi[i]=vtr(vp_+(((i)>>2)*4096+((i)&3)*1024+512)); }while(0)
  #define VRD2(i) do{ vlo[i]=vtr(vp_+((2+((i)>>2))*4096+((i)&3)*1024)); vhi[i]=vtr(vp_+((2+((i)>>2))*4096+((i)&3)*1024+512)); SBAR(); }while(0)
  #define GAPB2(MF,X,B) do{ MF; X[B]=EX(X[B]-mhat); X[B+1]=EX(X[B+1]-mhat); PIN(X); SBAR(); }while(0)
  #define KRD(G,j) do{ if(G){ kload2(kf,kp0+sl_next,j); SBAR(); } }while(0)
  #define STEP(C0,C1,P0,P1,t,GK,GV,GL) do{ SBAR(); \
    const lds_cptr vp_=vp0+2*sl_prev; \
    VRD(0); SBAR(); float sacc=(P0[0]+P0[1]); \
    GAPA(C0=__builtin_amdgcn_mfma_f32_32x32x16_bf16(kf[0],qr[0],negm,0,0,0), P0[2],P0[3],P0[4],P0[5],     pw0[0]=PKW(P0,0), pw0[1]=PKW(P0,2), pw0); \
    VRD(4); SBAR(); GAPA(C1=__builtin_amdgcn_mfma_f32_32x32x16_bf16(kf[1],qr[0],negm,0,0,0), P0[6],P0[7],P0[8],P0[9],     pw0[2]=PKW(P0,4), pw0[3]=PKW(P0,6), pw0); \
    VRD(1); SBAR(); GAPA(C0=__builtin_amdgcn_mfma_f32_32x32x16_bf16(kf[2],qr[1],C0,0,0,0),   P0[10],P0[11],P0[12],P0[13], pw1[0]=PKW(P0,8), pw1[1]=PKW(P0,10), pw1); \
    VRD(5); SBAR(); GAPA(C1=__builtin_amdgcn_mfma_f32_32x32x16_bf16(kf[3],qr[1],C1,0,0,0),   P0[14],P0[15],P1[0],P1[1],   pw1[2]=PKW(P0,12),pw1[3]=PKW(P0,14), pw1); \
    GAPA(C0=__builtin_amdgcn_mfma_f32_32x32x16_bf16(kf[4],qr[2],C0,0,0,0),   P1[2],P1[3],P1[4],P1[5],     pw2[0]=PKW(P1,0), pw2[1]=PKW(P1,2), pw2); \
    GAPA(C1=__builtin_amdgcn_mfma_f32_32x32x16_bf16(kf[5],qr[2],C1,0,0,0),   P1[6],P1[7],P1[8],P1[9],     pw2[2]=PKW(P1,4), pw2[3]=PKW(P1,6), pw2); \
    GAPA(C0=__builtin_amdgcn_mfma_f32_32x32x16_bf16(kf[6],qr[3],C0,0,0,0),   P1[10],P1[11],P1[12],P1[13], pw3[0]=PKW(P1,8), pw3[1]=PKW(P1,10), pw3); \
    GAPA(C1=__builtin_amdgcn_mfma_f32_32x32x16_bf16(kf[7],qr[3],C1,0,0,0),   P1[14],P1[15],0.f,0.f,       pw3[2]=PKW(P1,12),pw3[3]=PKW(P1,14), pw3); \
    l_reg+=sacc; \
    if(GK){DMA_K((t)+3,sl_cur);} if(GV){DMA_V((t)+1,sl_next);} \
    CMASK(C0,C1,t); \
    { float a=MX3(C0[0],C0[1],C1[0]),b=MX3(C0[2],C0[3],C1[1]); a=MX3(a,C1[2],C1[3]); \
      _Pragma("unroll") for(int r=4;r<16;r+=4){a=MX3(a,C0[r],C0[r+1]);b=MX3(b,C0[r+2],C0[r+3]);a=MX3(a,C1[r],C1[r+1]);b=MX3(b,C1[r+2],C1[r+3]);} \
      float rm=__builtin_fmaxf(a,b); { auto rr=__builtin_amdgcn_permlane32_swap(__float_as_uint(rm),__float_as_uint(rm),false,false); rm=__builtin_fmaxf(__uint_as_float(rr[0]),__uint_as_float(rr[1])); } \
      resc=false; const float rmr=rm-mhat; \
      if(__builtin_expect(__any(rmr>(float)THRL),0)){ const float dl=__builtin_fmaxf(rmr,0.f); mhat+=dl; \
        const float f=__builtin_amdgcn_exp2f(-dl); l_reg*=f; if(hi==0)wsf[r32]=f; resc=true; } } \
    SBAR(); \
    VRD(2); SBAR(); GAPB2(o[0]=__builtin_amdgcn_mfma_f32_32x32x16_bf16(PAF(0),VFR(0),o[0],0,0,0), C0,0); \
    VRD(6); SBAR(); GAPB2(o[1]=__builtin_amdgcn_mfma_f32_32x32x16_bf16(PAF(0),VFR(4),o[1],0,0,0), C0,2); \
    VRD(3); SBAR(); GAPB2(o[0]=__builtin_amdgcn_mfma_f32_32x32x16_bf16(PAF(1),VFR(1),o[0],0,0,0), C0,4); \
    VRD(7); SBAR(); GAPB2(o[1]=__builtin_amdgcn_mfma_f32_32x32x16_bf16(PAF(1),VFR(5),o[1],0,0,0), C0,6); \
    VRD2(0); GAPB2(o[0]=__builtin_amdgcn_mfma_f32_32x32x16_bf16(PAF(2),VFR(2),o[0],0,0,0), C0,8); \
    VRD2(4); GAPB2(o[1]=__builtin_amdgcn_mfma_f32_32x32x16_bf16(PAF(2),VFR(6),o[1],0,0,0), C0,10); \
    VRD2(1); GAPB2(o[0]=__builtin_amdgcn_mfma_f32_32x32x16_bf16(PAF(3),VFR(3),o[0],0,0,0), C0,12); \
    VRD2(5); GAPB2(o[1]=__builtin_amdgcn_mfma_f32_32x32x16_bf16(PAF(3),VFR(7),o[1],0,0,0), C0,14); \
    VRD2(2); GAPB2(o[2]=__builtin_amdgcn_mfma_f32_32x32x16_bf16(PAF(0),VFR(0),o[2],0,0,0), C1,0); \
    VRD2(6); GAPB2(o[3]=__builtin_amdgcn_mfma_f32_32x32x16_bf16(PAF(0),VFR(4),o[3],0,0,0), C1,2); \
    VRD2(3); KRD(GL,0); GAPB2(o[2]=__builtin_amdgcn_mfma_f32_32x32x16_bf16(PAF(1),VFR(1),o[2],0,0,0), C1,4); \
    VRD2(7); KRD(GL,1); GAPB2(o[3]=__builtin_amdgcn_mfma_f32_32x32x16_bf16(PAF(1),VFR(5),o[3],0,0,0), C1,6); \
    KRD(GL,2); GAPB2(o[2]=__builtin_amdgcn_mfma_f32_32x32x16_bf16(PAF(2),VFR(2),o[2],0,0,0), C1,8); \
    KRD(GL,3); GAPB2(o[3]=__builtin_amdgcn_mfma_f32_32x32x16_bf16(PAF(2),VFR(6),o[3],0,0,0), C1,10); \
    GAPB2(o[2]=__builtin_amdgcn_mfma_f32_32x32x16_bf16(PAF(3),VFR(3),o[2],0,0,0), C1,12); \
    GAPB2(o[3]=__builtin_amdgcn_mfma_f32_32x32x16_bf16(PAF(3),VFR(7),o[3],0,0,0), C1,14); \
    }while(0)
  int t=1;
  #undef CMASK
  #define CMASK(P0,P1,t) do{}while(0)
  for(;t+5<NT;t+=2){
    STEP(pB0,pB1,pA0,pA1,t,true,true,true);     WAIT_BAR(3); RESC(); ROT();
    STEP(pA0,pA1,pB0,pB1,t+1,true,true,true);   WAIT_BAR(3); RESC(); ROT();
  }
  #undef CMASK
  #define CMASK(P0,P1,t) do{int jb_=(t)-(NT-4); if(jb_>=0)cmask(P0,P1,jb_,wid);}while(0)
  #define ENDW(tt) do{ if((tt)+3<NT){WAIT_BAR(3);} else if((tt)+2<NT){WAIT_BAR(2);} else {WAIT_BAR(0);} }while(0)
  for(;t+1<NT;t+=2){
    STEP(pB0,pB1,pA0,pA1,t,(t+3<NT),(t+1<NT),(t+1<NT));       ENDW(t);   RESC(); ROT();
    STEP(pA0,pA1,pB0,pB1,t+1,(t+4<NT),(t+2<NT),(t+2<NT));     ENDW(t+1); RESC(); ROT();
  }
  STEP(pB0,pB1,pA0,pA1,NT-1,false,false,false); RESC();
  { float sacc=pB0[0]+pB0[1]; _Pragma("unroll") for(int r=2;r<16;++r)sacc+=pB0[r]; _Pragma("unroll") for(int r=0;r<16;++r)sacc+=pB1[r]; l_reg+=sacc;
    pw0=(u32x4){PKW(pB0,0),PKW(pB0,2),PKW(pB0,4),PKW(pB0,6)};pw1=(u32x4){PKW(pB0,8),PKW(pB0,10),PKW(pB0,12),PKW(pB0,14)};pw2=(u32x4){PKW(pB1,0),PKW(pB1,2),PKW(pB1,4),PKW(pB1,6)};pw3=(u32x4){PKW(pB1,8),PKW(pB1,10),PKW(pB1,12),PKW(pB1,14)};
    SBAR(); pv(o,vb0+2*sl_cur,PAF(0),PAF(1),PAF(2),PAF(3)); }
  #undef PKW
  #undef PAF
  #undef VFR
  #undef PIN
  #undef MX3
  #undef GAPA
  #undef GAPB
  #undef GAPB2
  #undef VRD2
  #undef EX
  #undef VRD
  #undef KRD
  #undef STEP
  #undef ENDW
  {auto rr=__builtin_amdgcn_permlane32_swap(__float_as_uint(l_reg),__float_as_uint(l_reg),false,false);l_reg=__uint_as_float(rr[0])+__uint_as_float(rr[1]);}
  if(hi==0)wsf[32+r32]=l_reg;asm volatile("s_waitcnt lgkmcnt(0)":::"memory");
  float rli[16];
  #pragma unroll
  for(int r=0;r<16;++r)rli[r]=__builtin_amdgcn_rcpf(wsf[32+crow(r,hi)]);
  bf16*Ow=O+(rowbase+q0+wid*QBLK)*DM+vcol;
  { bf16*stg=(bf16*)(shm+LDS_OST)+wid*2048;
    #pragma unroll
    for(int hf=0;hf<2;++hf){
    #pragma unroll
    for(int r=0;r<16;++r){const int orow=crow(r,hi);
      #pragma unroll
      for(int d0=0;d0<2;++d0)stg[orow*64+d0*32+r32]=__float2bfloat16(o[2*hf+d0][r]*rli[r]);}
    asm volatile("s_waitcnt lgkmcnt(0)":::"memory");
    #pragma unroll
    for(int i=0;i<4;++i){const int row=i*8+(lane>>3),ch=lane&7; const u32x4 v=*(const u32x4*)(stg+row*64+ch*8); ATTN_STORE16(Ow+(long)row*DM+hf*64+ch*8,v);}
    asm volatile("s_waitcnt lgkmcnt(0)":::"memory"); } }
  asm volatile("s_waitcnt lgkmcnt(0)\n\ts_barrier":::"memory");
  #undef DMA_K
  #undef DMA_V
  #undef CMASK
  #undef START
  #undef RESC
  #undef ROT
}
constexpr int ATTN_LDS_BYTES=LDS_BYTES;
struct AttnTensors { const bf16* Q; const bf16* K; const bf16* V; bf16* O; };
struct AttnUnit { int var; int qb; };
struct StaticOrder {
  int vcu;
  __device__ __forceinline__ explicit StaticOrder(int v):vcu(v){}
  __device__ __forceinline__ bool next(int i,AttnUnit&u)const{ if(i>=2)return false; const int s=vcu&31; u.var=vcu>>5; u.qb=(i==0)?s:63-s; return true; }
};
template<class Sched,int THRL=8> __device__ __forceinline__ void attn_phase(char*lds,const AttnTensors&T,const Sched&S){
  AttnUnit u;
  for(int i=0;S.next(i,u);++i){ const int h=u.var>>1,mp=u.var&1;
    attn_unit<THRL>(h*128+mp*64,h*128,u.qb,T.Q,T.K,T.V,T.O+(size_t)mp*SEQ*DM,lds); }
}
#undef SBAR
#undef WAIT_BAR
}


#define GAS __attribute__((address_space(1)))
#define LAS __attribute__((address_space(3)))
typedef unsigned short bf16;
typedef unsigned v4u __attribute__((ext_vector_type(4)));
typedef float f32x4 __attribute__((ext_vector_type(4)));
typedef short bf16x8 __attribute__((ext_vector_type(8)));
typedef GAS unsigned gu32;
typedef GAS unsigned long long gu64;
#define RLX_AGENT __ATOMIC_RELAXED, __HIP_MEMORY_SCOPE_AGENT
#define LDS_WAIT() asm volatile("s_waitcnt lgkmcnt(0)" ::: "memory")
#define VM_WAIT() asm volatile("s_waitcnt vmcnt(0)" ::: "memory")
__device__ __forceinline__ unsigned long long rt() { return __builtin_amdgcn_s_memrealtime(); }
__device__ __forceinline__ unsigned f2bf(float f) { unsigned u = __builtin_bit_cast(unsigned, f); return (u + 0x7fffu + ((u >> 16) & 1u)) >> 16; }
__device__ __forceinline__ unsigned pk2(float lo, float hi) { return f2bf(lo) | (f2bf(hi) << 16); }

#define XB_TMO      128
#define XB_XCNT(j)  (256  + 64 * (j))
#define XB_XSUB(j)  (1280 + 64 * (j))
#define XB_XGEN(j)  (2304 + 64 * (j))
#define XB_TOP      3328
#define XB_TOPGEN   3392
#define XCD_BAR_WORDS 3456
#define XB_SPIN_CAP (1u << 18)

__device__ __forceinline__ unsigned xb_ld(unsigned* p)              { return __hip_atomic_load(p, __ATOMIC_RELAXED, __HIP_MEMORY_SCOPE_AGENT); }
__device__ __forceinline__ unsigned xb_add(unsigned* p, unsigned v) { return __hip_atomic_fetch_add(p, v, __ATOMIC_RELAXED, __HIP_MEMORY_SCOPE_AGENT); }
__device__ __forceinline__ unsigned xb_xcc_id() { return (unsigned)__builtin_amdgcn_s_getreg((3 << 11) | 20) & 0xFu; }
#define XB_SPIN(cond, bar) do { unsigned _sp = 0; while (cond) { __builtin_amdgcn_s_sleep(1); \
    if ((++_sp & 255u) == 0u) { if (xb_ld(&(bar)[XB_TMO])) break; if (_sp > XB_SPIN_CAP) { atomicAdd(&(bar)[XB_TMO], 1u); break; } } } } while (0)

struct XcdBarrier {
    unsigned* bar; unsigned x;
    volatile LAS unsigned* st;
};

__device__ __forceinline__ XcdBarrier xcd_barrier_post(unsigned* bar, volatile LAS unsigned* st) {
    XcdBarrier b; b.bar = bar; b.x = xb_xcc_id(); b.st = st;
    if (threadIdx.x == 0) (void)xb_add(&bar[XB_XCNT(b.x)], 1u);
    return b;
}
__device__ __forceinline__ void xcd_barrier_complete(unsigned* bar, unsigned x, unsigned& nloc, unsigned& nx) {
    const unsigned G = gridDim.x * gridDim.y * gridDim.z;
    unsigned sum, cnt, mine, sp = 0u;
    for (;;) {
        sum = 0u; cnt = 0u; mine = 0u;
#pragma unroll
        for (unsigned j = 0; j < 16; ++j) { const unsigned c = xb_ld(&bar[XB_XCNT(j)]); sum += c; cnt += (c > 0u) ? 1u : 0u; mine = (j == x) ? c : mine; }
        if (sum == G) break;
        __builtin_amdgcn_s_sleep(1);
        if ((++sp & 255u) == 0u) { if (xb_ld(&bar[XB_TMO])) break; if (sp > XB_SPIN_CAP) { atomicAdd(&bar[XB_TMO], 1u); break; } }
    }
    nloc = mine > 0u ? mine : 1u; nx = cnt > 0u ? cnt : 1u;
}

__device__ __forceinline__ void xcd_barrier(const XcdBarrier& b) {
    asm volatile("s_waitcnt vmcnt(0)" ::: "memory");
    __syncthreads();
    if (threadIdx.x == 0) {
        unsigned* bar = b.bar;
        __builtin_amdgcn_s_waitcnt(0);
        unsigned nloc = b.st[0], nx = b.st[1];
        if (nloc == 0u) { xcd_barrier_complete(bar, b.x, nloc, nx); b.st[0] = nloc; b.st[1] = nx; }
        const unsigned old = xb_add(&bar[XB_XSUB(b.x)], 1u);
        const unsigned gen = old / nloc;
        if (old + 1u == (gen + 1u) * nloc) {
            __builtin_amdgcn_fence(__ATOMIC_RELEASE, "agent");
            asm volatile("s_waitcnt vmcnt(0)" ::: "memory");
            const unsigned og = xb_add(&bar[XB_TOP], 1u);
            const unsigned tg = og / nx;
            if (og + 1u == (tg + 1u) * nx) xb_add(&bar[XB_TOPGEN], 1u);
            else XB_SPIN(xb_ld(&bar[XB_TOPGEN]) == tg, bar);
            __builtin_amdgcn_fence(__ATOMIC_ACQUIRE, "agent");
            xb_add(&bar[XB_XGEN(b.x)], 1u);
            asm volatile("s_waitcnt vmcnt(0)" ::: "memory");
        } else {
            XB_SPIN(xb_ld(&bar[XB_XGEN(b.x)]) == gen, bar);
            __builtin_amdgcn_fence(__ATOMIC_ACQUIRE, "agent");
            asm volatile("s_waitcnt vmcnt(0)" ::: "memory");
        }
    }
    __syncthreads();
}

constexpr int NWAVES = 8;
constexpr int M = 16384, D = 1024, INC = 2560, AW = 512, LW = 512, NQ = 2048, NEXP = 16384;
constexpr float EPSN = 1e-6f;
constexpr size_t MiB = 1u << 20;
constexpr size_t WS_CTL = 0, CTL_ZERO_BYTES = 1 * MiB;
constexpr size_t WS_ROWSS2 = 512 * 1024;
constexpr size_t WS_RS1 = 1 * MiB;
constexpr size_t WS_SK1 = 1 * MiB + 128 * 1024, WS_SK2 = WS_SK1 + 32 * 1024;
constexpr size_t WS_WGF = 1 * MiB + 256 * 1024;
constexpr size_t WS_WIN = 2 * MiB, WS_WOUT = 8 * MiB, WS_WQ = 10 * MiB;
constexpr size_t WS_ED = 16 * MiB, WS_EU = 48 * MiB;
constexpr size_t WS_SCD = 32 * MiB, WS_SCU = 33 * MiB;
constexpr size_t WS_WQ8 = 170 * MiB;
constexpr size_t WS_XB = 80 * MiB;
constexpr size_t WS_CARRY = 34 * MiB;
constexpr size_t WS_Q2 = 80 * MiB;
constexpr size_t WS_Q = 112 * MiB, WS_SPLIT = 16 * MiB;
constexpr size_t WS_GATE = WS_Q + 4 * WS_SPLIT;
constexpr size_t WS_EID = 144 * MiB, WS_GW = 152 * MiB;
constexpr size_t WS_MIX = 192 * MiB, WS_HB = 224 * MiB, WS_END = 256 * MiB;
constexpr size_t WS_ROWSS3 = 576 * 1024;
constexpr size_t WS_DOTP = 80 * MiB;
constexpr size_t WS_REC = 160 * MiB, WS_N0 = 168 * MiB;
constexpr size_t WS_PEER = 80 * MiB;
constexpr size_t WS_REC_OLD_UNUSED = 0;
constexpr int CW_BAR = 4096;
constexpr int RING_OFF = 0, RING_BYTES = 131072;
constexpr int LDSCTL_OFF = RING_BYTES, MISC_OFF = LDSCTL_OFF + 320;
constexpr int LDS_BYTES = 163840;

struct Frame {
    LAS unsigned char* lds;
    volatile LAS unsigned* MISC;
    int tid, lane, wave;
    int vcu, G;
};

__device__ __forceinline__ float wave_sum(float v) {
#pragma unroll
    for (int o = 1; o < 64; o <<= 1) v += __shfl_xor(v, o);
    return v;
}
__device__ __forceinline__ float bf2f(unsigned short b) { return __builtin_bit_cast(float, (unsigned)b << 16); }
__device__ __forceinline__ float bflo(unsigned w) { return __builtin_bit_cast(float, w << 16); }
__device__ __forceinline__ float bfhi(unsigned w) { return __builtin_bit_cast(float, w & 0xffff0000u); }
__device__ __forceinline__ float gelu_tanh(float x) { const float u = 0.7978845608028654f * (x + 0.044715f * x * x * x); return 0.5f * x * (1.0f + tanhf(u)); }
__device__ __forceinline__ float sigmoidf_(float x) { return 1.0f / (1.0f + expf(-x)); }
__device__ __forceinline__ float fsigmoid(float x) { return __builtin_amdgcn_rcpf(1.0f + __builtin_amdgcn_exp2f(-1.4426950408889634f * x)); }
__device__ __forceinline__ float fgelu_tanh(float x) { const float u = 0.7978845608028654f * (x + 0.044715f * x * x * x); const float t = 1.0f - 2.0f * __builtin_amdgcn_rcpf(1.0f + __builtin_amdgcn_exp2f(2.8853900817779268f * u)); return 0.5f * x * (1.0f + t); }

__device__ __forceinline__ void p0_transpose_item(const float* W, int K, int N, bf16* WT, const float* gk, LAS float* scr, int item, int lane) {
    const int nblk = N / 32, kb = item / nblk, nb = item % nblk, k0 = 64 * kb, n0 = 32 * nb;
    float wv[32];
#pragma unroll
    for (int i = 0; i < 32; ++i) { const int kk = 2 * i + (lane >> 5); wv[i] = W[(size_t)(k0 + kk) * N + n0 + (lane & 31)]; }
#pragma unroll
    for (int i = 0; i < 32; ++i) { const int kk = 2 * i + (lane >> 5); const float g = gk ? gk[k0 + kk] : 1.0f; scr[kk * 33 + (lane & 31)] = wv[i] * g; }
    LDS_WAIT(); asm volatile("" ::: "memory");
    const int c = lane & 7;
#pragma unroll
    for (int j = 0; j < 4; ++j) { const int n = (lane >> 3) + 8 * j; const LAS float* s = scr + (8 * c) * 33 + n;
        v4u o; o.x = pk2(s[0 * 33], s[1 * 33]); o.y = pk2(s[2 * 33], s[3 * 33]); o.z = pk2(s[4 * 33], s[5 * 33]); o.w = pk2(s[6 * 33], s[7 * 33]);
        *(GAS v4u*)(WT + (size_t)(n0 + n) * K + k0 + 8 * c) = o; }
    LDS_WAIT(); asm volatile("" ::: "memory");
}
template <int NR> __device__ __forceinline__ void p0_rows(const float* xrow, bf16* orow, const float* gk, float* rs, int lane) {
    f32x4 v[NR][4];
#pragma unroll
    for (int i = 0; i < NR; ++i)
#pragma unroll
        for (int j = 0; j < 4; ++j) v[i][j] = __builtin_nontemporal_load((const GAS f32x4*)(xrow + (size_t)i * 1024) + lane + 64 * j);
#pragma unroll
    for (int i = 0; i < NR; ++i) {
        if (rs) { float s = 0.f;
#pragma unroll
            for (int j = 0; j < 4; ++j) s += (v[i][j].x * v[i][j].x + v[i][j].y * v[i][j].y) + (v[i][j].z * v[i][j].z + v[i][j].w * v[i][j].w);
            const float tot = wave_sum(s); if (lane == 0) rs[i] = 1.0f / sqrtf(tot * (1.0f / 1024.0f) + EPSN); }
        if (gk) {
#pragma unroll
            for (int j = 0; j < 4; ++j) v[i][j] = v[i][j] * ((const GAS f32x4*)gk)[lane + 64 * j]; }
        GAS unsigned long long* o8 = (GAS unsigned long long*)(orow + (size_t)i * 1024) + lane;
#pragma unroll
        for (int j = 0; j < 4; ++j) o8[64 * j] = (unsigned long long)pk2(v[i][j].x, v[i][j].y) | ((unsigned long long)pk2(v[i][j].z, v[i][j].w) << 32);
    }
}

struct Args { const float* in[23]; float* out; unsigned char* ws; int ph_lo, ph_hi; };

__device__ __forceinline__ void p0_prologue(Frame& F, const Args& a) {
    LAS float* scr = (LAS float*)(F.lds + RING_OFF + F.wave * 16384);
    unsigned char* ws = a.ws;
    const int gw = F.vcu * NWAVES + F.wave, NGW = F.G * NWAVES;
    constexpr int I_IN = (D / 64) * (INC / 32), I_OUT = (D / 64) * (D / 32), I_Q = (D / 64) * (NQ / 32);
    constexpr int NITEMS = I_IN + I_OUT + I_Q;
    for (int it = F.wave * (int)F.G + F.vcu; it < NITEMS; it += NGW) {
        int r = it;
        if (r < I_IN) { p0_transpose_item(a.in[2], D, INC, (bf16*)(ws + WS_WIN), a.in[1], scr, r, F.lane); continue; } r -= I_IN;
        if (r < I_OUT) { p0_transpose_item(a.in[15], D, D, (bf16*)(ws + WS_WOUT), nullptr, scr, r, F.lane); continue; } r -= I_OUT;
        p0_transpose_item(a.in[17], D, NQ, (bf16*)(ws + WS_WQ), a.in[16], scr, r, F.lane);
    }
    for (int i = (F.wave * (int)F.G + F.vcu) * 64 + F.lane; i < 8192; i += NGW * 64) {
        const int ln = i & 63, ks = (i >> 6) & 3, et = (i >> 8) & 1, n = (i >> 9) & 7, gt = i >> 12, r32 = ln & 31, hi = ln >> 5;
        const float* w = a.in[gt ? 12 : 10] + n * 4096 + 32 * et + (16 * ks + 8 * hi) * 64 + r32;
        *(GAS v4u*)(ws + WS_WGF + (size_t)i * 16) = (v4u){pk2(w[0], w[64]), pk2(w[128], w[192]), pk2(w[256], w[320]), pk2(w[384], w[448])}; }
    for (int m = gw; m < M / 8; m += NGW) { const int r = 8 * m; p0_rows<8>(a.in[0] + (size_t)r * D, (bf16*)(ws + WS_XB) + (size_t)r * D, nullptr, (float*)(ws + WS_RS1) + r, F.lane); }
    for (int m = F.wave * (int)F.G + F.vcu; m < 8; m += NGW) { const int r = 4 * m;
        if (r < 16) p0_rows<4>(a.in[18] + (size_t)r * 1024, (bf16*)(ws + WS_SK1) + (size_t)r * 1024, nullptr, nullptr, F.lane);
        else        p0_rows<4>(a.in[19] + (size_t)(r - 16) * 1024, (bf16*)(ws + WS_SK2) + (size_t)(r - 16) * 1024, nullptr, nullptr, F.lane); }
}
template <int NR> __device__ __forceinline__ void q8_load(f32x4 (&v)[NR][4], const float* xrow, int lane) {
#pragma unroll
    for (int i = 0; i < NR; ++i)
#pragma unroll
        for (int j = 0; j < 4; ++j) v[i][j] = __builtin_nontemporal_load((const GAS f32x4*)(xrow + (size_t)i * 1024) + lane + 64 * j);
}
template <int NR> __device__ __forceinline__ void q8_finish(f32x4 (&v)[NR][4], unsigned char* orow, const float* gk, float* scale, int lane) {
#pragma unroll
    for (int i = 0; i < NR; ++i) {
        float am = 0.f;
#pragma unroll
        for (int j = 0; j < 4; ++j) { if (gk) v[i][j] = v[i][j] * ((const GAS f32x4*)gk)[lane + 64 * j];
            am = fmaxf(fmaxf(am, fmaxf(fabsf(v[i][j].x), fabsf(v[i][j].y))), fmaxf(fabsf(v[i][j].z), fabsf(v[i][j].w))); }
#pragma unroll
        for (int o = 1; o < 64; o <<= 1) am = fmaxf(am, __shfl_xor(am, o));
        const float sc = (am > 0.f) ? am * (1.0f / 127.0f) : 1.0f, inv = 1.0f / sc;
        if (lane == 0) scale[i] = sc;
        GAS unsigned* o4 = (GAS unsigned*)(orow + (size_t)i * 128 + (size_t)(lane >> 5) * ((size_t)NEXP * 128)) + (lane & 31);
#pragma unroll
        for (int j = 0; j < 4; ++j) { const int q0 = (int)__builtin_rintf(v[i][j].x * inv), q1 = (int)__builtin_rintf(v[i][j].y * inv), q2 = (int)__builtin_rintf(v[i][j].z * inv), q3 = (int)__builtin_rintf(v[i][j].w * inv);
            o4[(size_t)j * (2 * (size_t)NEXP * 128 / 4)] = ((unsigned)q0 & 255u) | (((unsigned)q1 & 255u) << 8) | (((unsigned)q2 & 255u) << 16) | ((unsigned)q3 << 24); }
    }
}
__device__ __forceinline__ const float* cvx_src(const Args& a, int m) { const int r = 4 * m; return (r < NEXP) ? a.in[20] + (size_t)r * D : a.in[21] + (size_t)(r - NEXP) * D; }
__device__ __forceinline__ void cvx_finish(const Args& a, f32x4 (&v)[4][4], int m, int lane) {
    unsigned char* ws = a.ws; const int r = 4 * m;
    if (r < NEXP) q8_finish<4>(v, ws + WS_ED + (size_t)r * 128, a.in[16], (float*)(ws + WS_SCD) + r, lane);
    else          q8_finish<4>(v, ws + WS_EU + (size_t)(r - NEXP) * 128, nullptr, (float*)(ws + WS_SCU) + (r - NEXP), lane);
}
__device__ __forceinline__ void convert_experts(const Args& a, int w, int nw, int lane) {
    constexpr int TOT = NEXP / 4;
    int m = w; if (m >= TOT) return;
    f32x4 va[4][4], vb[4][4];
    q8_load<4>(va, cvx_src(a, m), lane);
    for (;;) {
        const bool hb = m + nw < TOT; if (hb) q8_load<4>(vb, cvx_src(a, m + nw), lane);
        cvx_finish(a, va, m, lane);
        if (!hb) break;
        const bool ha = m + 2 * nw < TOT; if (ha) q8_load<4>(va, cvx_src(a, m + 2 * nw), lane);
        cvx_finish(a, vb, m + nw, lane);
        if (!ha) break;
        m += 2 * nw;
    }
}

typedef float f32x16 __attribute__((ext_vector_type(16)));
typedef float f32x2 __attribute__((ext_vector_type(2)));
__device__ __forceinline__ void lru_local_unit(Frame& F, const Args& a, int c) {
    constexpr int YP = 520;
    LAS unsigned short* Y = (LAS unsigned short*)(F.lds + RING_OFF);
    const int e = F.tid, r0 = c * 64;
    const bf16* XR = (const bf16*)(a.ws + WS_Q + 3 * WS_SPLIT);
    unsigned* HLAC = (unsigned*)a.out;
    float* CH = (float*)(a.ws + WS_CARRY); float* CA = CH + (size_t)(M / 64) * 512;
    {
        const int p = F.tid & 255, hh = F.tid >> 8; const float* conv_w = a.in[8];
        const f32x2 c0 = *(const GAS f32x2*)(conv_w + 2 * p), c1 = *(const GAS f32x2*)(conv_w + 512 + 2 * p), c2 = *(const GAS f32x2*)(conv_w + 1024 + 2 * p), c3 = *(const GAS f32x2*)(conv_w + 1536 + 2 * p), cb = *(const GAS f32x2*)(a.in[9] + 2 * p);
        unsigned xv[35];
        const int rb = r0 + 32 * hh - 3;
#pragma unroll
        for (int i = 0; i < 35; ++i) xv[i] = (rb + i >= 0) ? *(const GAS unsigned*)(XR + (size_t)(rb + i) * 512 + 2 * p) : 0u;
#pragma unroll
        for (int i = 0; i < 32; ++i) {
            const float lo = cb.x + bflo(xv[i]) * c0.x + bflo(xv[i + 1]) * c1.x + bflo(xv[i + 2]) * c2.x + bflo(xv[i + 3]) * c3.x;
            const float hi2 = cb.y + bfhi(xv[i]) * c0.y + bfhi(xv[i + 1]) * c1.y + bfhi(xv[i + 2]) * c2.y + bfhi(xv[i + 3]) * c3.y;
            *(LAS unsigned*)(Y + (32 * hh + i) * YP + 2 * p) = pk2(lo, hi2); } }
    __syncthreads();
    const int n = F.wave, lane = F.lane, r32 = lane & 31, hi = lane >> 5;
#pragma unroll 1
    for (int et = 0; et < 2; ++et) {
        bf16x8 wf[2][4];
#pragma unroll
        for (int gt = 0; gt < 2; ++gt)
#pragma unroll
            for (int ks = 0; ks < 4; ++ks) wf[gt][ks] = *(const GAS bf16x8*)(a.ws + WS_WGF + (size_t)(((((gt * 8 + n) * 2 + et) * 4 + ks) * 64 + lane) * 16));
        const int ch = 64 * n + 32 * et + r32;
        const float ba = a.in[11][ch], bx = a.in[13][ch], lam = a.in[14][ch];
        const float sp = (lam > 15.f) ? expf(-lam) : log1pf(expf(-lam));
        float av[2][16], bv[2][16];
#pragma unroll
        for (int tt = 0; tt < 2; ++tt) {
            f32x16 ra = {}, ia = {};
#pragma unroll
            for (int ks = 0; ks < 4; ++ks) { const bf16x8 af = *(const LAS bf16x8*)(Y + (32 * tt + r32) * YP + 64 * n + 16 * ks + 8 * hi);
                ra = __builtin_amdgcn_mfma_f32_32x32x16_bf16(af, wf[0][ks], ra, 0, 0, 0); ia = __builtin_amdgcn_mfma_f32_32x32x16_bf16(af, wf[1][ks], ia, 0, 0, 0); }
#pragma unroll
            for (int r = 0; r < 16; ++r) { const int t = 32 * tt + (r & 3) + 8 * (r >> 2) + 4 * hi;
                const float rr = fsigmoid(ra[r] + ba), ii = fsigmoid(ia[r] + bx);
                const float log_a = -8.0f * rr * sp, aa = __builtin_amdgcn_exp2f(log_a * 1.4426950408889634f);
                const float u2 = 2.0f * log_a;
                const float ser = -u2 * (1.0f + u2 * (0.5f + u2 * (0.16666667f + u2 * (0.041666668f + u2 * 0.0083333338f))));
                const float om = (u2 > -0.1f) ? ser : (1.0f - aa * aa);
                const float mult = __builtin_amdgcn_sqrtf(fmaxf(om, 1e-12f));
                av[tt][r] = aa; bv[tt][r] = mult * (ii * bf2f(Y[t * YP + ch])); }
        }
#pragma unroll
        for (int tt = 0; tt < 2; ++tt)
#pragma unroll
            for (int rq = 0; rq < 4; ++rq) { float h = 0.f, pa = 1.f;
#pragma unroll
                for (int k = 0; k < 4; ++k) { const int r = 4 * rq + k; h = av[tt][r] * h + bv[tt][r]; pa *= av[tt][r]; bv[tt][r] = h; av[tt][r] = pa; } }
        float hin[8], ain[8]; float hc = 0.f, ac = 1.f;
#pragma unroll
        for (int j = 0; j < 8; ++j) { const int tt = j >> 2, r3 = 4 * (j & 3) + 3;
#pragma unroll
            for (int own = 0; own < 2; ++own) {
                if (hi == own) { hin[j] = hc; ain[j] = ac; }
                const float mh = av[tt][r3] * hc + bv[tt][r3], ma = ac * av[tt][r3];
                const float oh = __shfl_xor(mh, 32), oa = __shfl_xor(ma, 32);
                hc = (hi == own) ? mh : oh; ac = (hi == own) ? ma : oa; } }
#pragma unroll
        for (int tt = 0; tt < 2; ++tt)
            { unsigned ob = (unsigned)((r0 + 32 * tt + 4 * hi) * 512 + ch); asm volatile("" : "+v"(ob));
#pragma unroll
            for (int r = 0; r < 16; ++r) { const int j = 4 * tt + (r >> 2); const unsigned o = ob + (unsigned)(((r & 3) + 8 * (r >> 2)) * 512);
                const float hl = bv[tt][r] + av[tt][r] * hin[j], ac = av[tt][r] * ain[j];
                HLAC[o] = pk2(hl, ac);
                if (tt == 1 && r == 15 && hi == 1) { CH[c * 512 + ch] = hl; CA[c * 512 + ch] = ac; } } }
    }
    __syncthreads();
}

__device__ __forceinline__ void fix_unit(Frame& F, const Args& a, int c, float lamv) {
    const int r0 = c * 64;
    const unsigned* HLAC = (const unsigned*)a.out; const float* CH = (const float*)(a.ws + WS_CARRY); const float* CA = CH + (size_t)(M / 64) * 512;
    const bf16* GATE = (const bf16*)(a.ws + WS_GATE);
    bf16* MIX = (bf16*)(a.ws + WS_MIX);
    const int g4 = F.tid & 127, sgm = F.tid >> 7;
    LAS f32x4* SA = (LAS f32x4*)(F.lds + RING_OFF); LAS f32x4* SH = SA + 512;
    { const int L = (c + 3) >> 2; const int lo_c = sgm * L; int hi_c = lo_c + L; if (hi_c > c) hi_c = c;
      f32x4 A4 = (f32x4){1.f, 1.f, 1.f, 1.f}, H4 = (f32x4){0.f, 0.f, 0.f, 0.f};
      int cc = lo_c;
      for (; cc + 8 <= hi_c; cc += 8) { f32x4 av[8], hv[8];
#pragma unroll
          for (int k = 0; k < 8; ++k) { const size_t o = (size_t)(cc + k) * 512 + 4 * g4; av[k] = *(const GAS f32x4*)(CA + o); hv[k] = *(const GAS f32x4*)(CH + o); }
#pragma unroll
          for (int k = 0; k < 8; ++k) { H4 = av[k] * H4 + hv[k]; A4 = A4 * av[k]; } }
      for (; cc < hi_c; ++cc) { const size_t o = (size_t)cc * 512 + 4 * g4; const f32x4 av = *(const GAS f32x4*)(CA + o), hv = *(const GAS f32x4*)(CH + o); H4 = av * H4 + hv; A4 = A4 * av; }
      SA[sgm * 128 + g4] = A4; SH[sgm * 128 + g4] = H4; }
    __syncthreads();
    f32x4 hin = (f32x4){0.f, 0.f, 0.f, 0.f};
#pragma unroll
    for (int sq = 0; sq < 4; ++sq) hin = SA[sq * 128 + g4] * hin + SH[sq * 128 + g4];
    __syncthreads();
#pragma unroll 4
    for (int t = sgm * 16; t < sgm * 16 + 16; ++t) { const size_t o = (size_t)(r0 + t) * 512 + 4 * g4;
        const v4u ha = *(const GAS v4u*)(HLAC + o);
        const f32x4 h = (f32x4){bflo(ha.x), bflo(ha.y), bflo(ha.z), bflo(ha.w)} + (f32x4){bfhi(ha.x), bfhi(ha.y), bfhi(ha.z), bfhi(ha.w)} * hin; const unsigned long long gw = *(const GAS unsigned long long*)(GATE + o);
        const unsigned glo = (unsigned)gw, ghi = (unsigned)(gw >> 32);
        const unsigned long long ov = (unsigned long long)pk2(h.x * fgelu_tanh(bflo(glo)), h.y * fgelu_tanh(bfhi(glo))) | ((unsigned long long)pk2(h.z * fgelu_tanh(bflo(ghi)), h.w * fgelu_tanh(bfhi(ghi))) << 32);
        *(GAS unsigned long long*)(MIX + (size_t)(r0 + t) * 1024 + 512 + 4 * g4) = ov; }
    const bf16* OS0 = (const bf16*)(a.out + (size_t)M * 512); const bf16* OS1 = OS0 + (size_t)M * 512;
    const float* sg = a.in[7] + (F.lane & 15) * 8;
    float sgv[8];
#pragma unroll
    for (int j = 0; j < 8; ++j) sgv[j] = sg[j] * 0.8f;
#pragma unroll 2
    for (int rr = 0; rr < 8; ++rr) { const size_t row = (size_t)(r0 + 8 * F.wave + rr);
        const v4u p = *(const GAS v4u*)(OS0 + row * 512 + F.lane * 8), q = *(const GAS v4u*)(OS1 + row * 512 + F.lane * 8);
        float d[8];
        d[0] = bflo(p.x) - lamv * bflo(q.x); d[1] = bfhi(p.x) - lamv * bfhi(q.x); d[2] = bflo(p.y) - lamv * bflo(q.y); d[3] = bfhi(p.y) - lamv * bfhi(q.y);
        d[4] = bflo(p.z) - lamv * bflo(q.z); d[5] = bfhi(p.z) - lamv * bfhi(q.z); d[6] = bflo(p.w) - lamv * bflo(q.w); d[7] = bfhi(p.w) - lamv * bfhi(q.w);
        float ss = 0.f;
#pragma unroll
        for (int j = 0; j < 8; ++j) ss += d[j] * d[j];
        ss += __shfl_xor(ss, 1); ss += __shfl_xor(ss, 2); ss += __shfl_xor(ss, 4); ss += __shfl_xor(ss, 8);
        const float ri = 1.0f / sqrtf(ss * (1.0f / 128.0f) + EPSN);
        v4u o; o.x = pk2(d[0] * ri * sgv[0], d[1] * ri * sgv[1]); o.y = pk2(d[2] * ri * sgv[2], d[3] * ri * sgv[3]);
        o.z = pk2(d[4] * ri * sgv[4], d[5] * ri * sgv[5]); o.w = pk2(d[6] * ri * sgv[6], d[7] * ri * sgv[7]);
        *(GAS v4u*)(MIX + row * 1024 + F.lane * 8) = o; }
}

typedef float f32x16 __attribute__((ext_vector_type(16)));
#define CEX(a, b) do { const float _hi = fmaxf(a, b), _lo = fminf(a, b); a = _hi; b = _lo; } while (0)
__device__ __forceinline__ int skey(int b) { return b ^ ((b >> 31) & 0x7fffffff); }
#define CEI(a, b) do { const int _hi = max(a, b), _lo = min(a, b); a = _hi; b = _lo; } while (0)
__device__ __forceinline__ void sort16_desc(int (&v)[16]) {
#pragma unroll
    for (int p = 1; p < 16; p <<= 1)
#pragma unroll
        for (int k = p; k >= 1; k >>= 1)
#pragma unroll
            for (int j = k % p; j + k < 16; j += 2 * k)
#pragma unroll
                for (int i = 0; i < k; ++i) if (i + j + k < 16 && (i + j) / (2 * p) == (i + j + k) / (2 * p)) CEI(v[i + j], v[i + j + k]);
}
__device__ __forceinline__ void merge16_desc(int (&a)[16], const int (&b)[16]) {
#pragma unroll
    for (int i = 0; i < 16; ++i) a[i] = max(a[i], b[15 - i]);
#pragma unroll
    for (int j = 8; j >= 1; j >>= 1)
#pragma unroll
        for (int i = 0; i < 16; ++i) if ((i & j) == 0) CEI(a[i], a[i + j]);
}
__device__ __forceinline__ void top16_half(int (&top)[16], const bf16* q, const LAS unsigned char* sk, int r32, int hi) {
    bf16x8 qf[8];
#pragma unroll
    for (int ks = 0; ks < 8; ++ks) qf[ks] = *(const GAS bf16x8*)(q + 16 * ks + 8 * hi);
#pragma unroll
    for (int i = 0; i < 16; ++i) top[i] = (int)0x80000000;
#pragma unroll 1
    for (int kt = 0; kt < 4; ++kt) {
        f32x16 acc = {};
#pragma unroll
        for (int ks = 0; ks < 8; ++ks) { const bf16x8 kf = *(const LAS bf16x8*)(sk + (32 * kt + r32) * 272 + (16 * ks + 8 * hi) * 2); acc = __builtin_amdgcn_mfma_f32_32x32x16_bf16(kf, qf[ks], acc, 0, 0, 0); }
        int grp[16];
#pragma unroll
        for (int r = 0; r < 16; ++r) { const int idx = 32 * kt + (r & 3) + 8 * (r >> 2) + 4 * hi; const float av = acc[r];
            grp[r] = (skey(__float_as_int(av)) & ~127) | idx; }
        sort16_desc(grp); merge16_desc(top, grp);
    }
    int oth[16];
#pragma unroll
    for (int i = 0; i < 16; ++i) oth[i] = __shfl_xor(top[i], 32);
    merge16_desc(top, oth);
}
__device__ __forceinline__ void route_tops(const Args& a, int g, int hd, int lane, const LAS unsigned char* skl, int (&k1)[16], int (&k2)[16]) {
    const int r32 = lane & 31, hi = lane >> 5; const int t = g * 32 + r32;
    const bf16* q = (const bf16*)(a.ws + WS_Q2) + (size_t)t * NQ + hd * 256;
    top16_half(k1, q, skl, r32, hi);
    top16_half(k2, q + 128, skl + 128 * 272, r32, hi);
}
__device__ __forceinline__ void route_finish(const Args& a, int t, int hd, LAS unsigned char* slot, const int (&k1)[16], const int (&k2)[16]) {
    { v4u w1, w2;
#define IDX4(v, j) (((unsigned)v[4 * (j)] & 127u) | (((unsigned)v[4 * (j) + 1] & 127u) << 8) | (((unsigned)v[4 * (j) + 2] & 127u) << 16) | (((unsigned)v[4 * (j) + 3] & 127u) << 24))
      w1 = (v4u){IDX4(k1, 0), IDX4(k1, 1), IDX4(k1, 2), IDX4(k1, 3)}; w2 = (v4u){IDX4(k2, 0), IDX4(k2, 1), IDX4(k2, 2), IDX4(k2, 3)};
#undef IDX4
      *(LAS v4u*)(slot) = w1; *(LAS v4u*)(slot + 16) = w2; }
    float v1[16], v2[16];
#pragma unroll
    for (int i = 0; i < 16; ++i) { v1[i] = __int_as_float(skey(k1[i])); v2[i] = __int_as_float(skey(k2[i])); }
#define CKEY(ia, ib) ((skey(__float_as_int(v1[ia] + v2[ib])) & ~255) | ((ia) * 16 + (ib)))
    int K[16], G1[16], G2[16];
#pragma unroll
    for (int i = 0; i < 16; ++i) K[i] = CKEY(0, i);
    { int n_ = 0;
#pragma unroll
      for (int ia = 1; ia < 16; ++ia)
#pragma unroll
          for (int ib = 0; ib < 16; ++ib) if ((ia + 1) * (ib + 1) <= 16) { const int kk = CKEY(ia, ib); if (n_ < 16) G1[n_] = kk; else if (n_ < 32) G2[n_ - 16] = kk; ++n_; }
    }
    sort16_desc(G1); merge16_desc(K, G1);
    sort16_desc(G2); merge16_desc(K, G2);
    { int x0 = CKEY(14, 0), x1 = CKEY(15, 0);
#pragma unroll
      for (int i = 0; i < 16; ++i) { CEI(K[i], x0); }
#pragma unroll
      for (int i = 0; i < 16; ++i) { CEI(K[i], x1); }
    }
#undef CKEY
    unsigned P[16]; float sc[16];
#pragma unroll
    for (int i = 0; i < 16; ++i) { const unsigned ci = (unsigned)K[i] & 255u; const unsigned i1 = slot[ci >> 4], i2 = slot[16 + (ci & 15u)]; P[i] = i1 * 128u + i2; sc[i] = __int_as_float(skey(K[i] & ~255)); }
    float ex[16], sum = 0.f;
#pragma unroll
    for (int i = 0; i < 16; ++i) { ex[i] = __builtin_amdgcn_exp2f((sc[i] - sc[0]) * 1.4426950408889634f); sum += ex[i]; }
    const float inv = 1.0f / sum;
    {
        GAS v4u* ro = (GAS v4u*)((unsigned*)(a.ws + WS_REC) + (size_t)t * 128 + hd * 16);
#pragma unroll
        for (int j = 0; j < 4; ++j) ro[j] = (v4u){P[4 * j] | (f2bf(ex[4 * j] * inv) << 16), P[4 * j + 1] | (f2bf(ex[4 * j + 1] * inv) << 16), P[4 * j + 2] | (f2bf(ex[4 * j + 2] * inv) << 16), P[4 * j + 3] | (f2bf(ex[4 * j + 3] * inv) << 16)};
    }
}

__device__ __forceinline__ float wave_max(float v) {
#pragma unroll
    for (int o = 1; o < 64; o <<= 1) v = fmaxf(v, __shfl_xor(v, o));
    return v;
}
__device__ __forceinline__ void route_unit_ref(const Args& a, int t, int hd, int lane, LAS float* sc) {
    LAS unsigned* sci = (LAS unsigned*)sc;
    const bf16* q = (const bf16*)(a.ws + WS_Q2) + (size_t)t * NQ + hd * 256;
#pragma unroll 1
    for (int half = 0; half < 2; ++half) {
        const float* sk = a.in[18 + half];
        float sa = 0.f, sb = 0.f;
        for (int d = 0; d < 128; ++d) { const float qv = bf2f(q[half * 128 + d]); sa += qv * sk[lane * 128 + d]; sb += qv * sk[(lane + 64) * 128 + d]; }
        for (int r = 0; r < 16; ++r) {
            const float mx = wave_max(fmaxf(sa, sb));
            const unsigned long long ba = __ballot(sa == mx), bb = __ballot(sb == mx);
            int key;
            if (ba) { const int ln = __ffsll((long long)ba) - 1; key = ln; if (lane == ln) sa = -INFINITY; }
            else { const int ln = __ffsll((long long)bb) - 1; key = ln + 64; if (lane == ln) sb = -INFINITY; }
            if (lane == 0) { sc[half * 32 + r] = mx; sci[half * 32 + 16 + r] = (unsigned)key; }
        }
    }
    __builtin_amdgcn_s_waitcnt(0);
    const int ca = lane >> 2, cb0 = (lane & 3) * 4;
    float c[4];
#pragma unroll
    for (int j = 0; j < 4; ++j) c[j] = sc[ca] + sc[32 + cb0 + j];
    for (int r = 0; r < 16; ++r) {
        const float mx = wave_max(fmaxf(fmaxf(c[0], c[1]), fmaxf(c[2], c[3])));
        const bool mine = (c[0] == mx) || (c[1] == mx) || (c[2] == mx) || (c[3] == mx);
        const unsigned long long bm = __ballot(mine); const int ln = __ffsll((long long)bm) - 1;
        if (lane == ln) { int j = (c[0] == mx) ? 0 : (c[1] == mx) ? 1 : (c[2] == mx) ? 2 : 3;
            if (j == 0) c[0] = -INFINITY; else if (j == 1) c[1] = -INFINITY; else if (j == 2) c[2] = -INFINITY; else c[3] = -INFINITY;
            sc[64 + r] = mx; sci[80 + r] = sci[16 + ca] * 128u + sci[48 + cb0 + j]; }
    }
    __builtin_amdgcn_s_waitcnt(0);
    if (lane < 16) {
        const float mx0 = sc[64]; const float ex = expf(sc[64 + lane] - mx0); float sum = ex;
        sum += __shfl_xor(sum, 1); sum += __shfl_xor(sum, 2); sum += __shfl_xor(sum, 4); sum += __shfl_xor(sum, 8);
        ((int*)(a.ws + WS_EID))[(size_t)t * 128 + hd * 16 + lane] = (int)sci[80 + lane];
        ((float*)(a.ws + WS_GW))[(size_t)t * 128 + hd * 16 + lane] = ex / sum;
    }
    __builtin_amdgcn_s_waitcnt(0);
}

__device__ __forceinline__ void unpack8(const v4u w, float* f) { f[0] = bflo(w.x); f[1] = bfhi(w.x); f[2] = bflo(w.y); f[3] = bfhi(w.y); f[4] = bflo(w.z); f[5] = bfhi(w.z); f[6] = bflo(w.w); f[7] = bfhi(w.w); }
__device__ __forceinline__ void gather_token(const Args& a, int t, int lane, float* dst) {
    const bf16* HB = (const bf16*)(a.ws + WS_HB) + (size_t)t * D; const bf16* ED = (const bf16*)(a.ws + WS_ED); const bf16* EU = (const bf16*)(a.ws + WS_EU);
    float hx[16];
    unpack8(*(const GAS v4u*)(HB + lane * 8), hx); unpack8(*(const GAS v4u*)(HB + 512 + lane * 8), hx + 8);
    const float rs2 = 1.0f / sqrtf(((const float*)(a.ws + WS_ROWSS2))[t] * (1.0f / 1024.0f) + EPSN);
    const int* EID = (const int*)(a.ws + WS_EID) + (size_t)t * 128; const float* GW = (const float*)(a.ws + WS_GW) + (size_t)t * 128;
    const int e0 = EID[lane], e1 = EID[64 + lane]; const float g0 = GW[lane], g1 = GW[64 + lane];
    float acc[16];
#pragma unroll
    for (int i = 0; i < 16; ++i) acc[i] = 0.f;
#pragma unroll 1
    for (int j = 0; j < 128; j += 4) {
        int ee[4]; float gg[4], dt[4];
#pragma unroll
        for (int k = 0; k < 4; ++k) { const int jj = j + k; ee[k] = __shfl(jj < 64 ? e0 : e1, jj & 63); gg[k] = __shfl(jj < 64 ? g0 : g1, jj & 63); }
        v4u da[4], db[4];
#pragma unroll
        for (int k = 0; k < 4; ++k) { const bf16* r = ED + (size_t)ee[k] * D; da[k] = *(const GAS v4u*)(r + lane * 8); db[k] = *(const GAS v4u*)(r + 512 + lane * 8); }
#pragma unroll
        for (int k = 0; k < 4; ++k) { float f[16]; unpack8(da[k], f); unpack8(db[k], f + 8); float s = 0.f;
#pragma unroll
            for (int i = 0; i < 16; ++i) s += f[i] * hx[i];
            dt[k] = s; }
#pragma unroll
        for (int o = 1; o < 64; o <<= 1) {
#pragma unroll
            for (int k = 0; k < 4; ++k) dt[k] += __shfl_xor(dt[k], o); }
#pragma unroll
        for (int k = 0; k < 4; ++k) { const bf16* r = EU + (size_t)ee[k] * D; da[k] = *(const GAS v4u*)(r + lane * 8); db[k] = *(const GAS v4u*)(r + 512 + lane * 8); }
#pragma unroll
        for (int k = 0; k < 4; ++k) { const float w = gg[k] * gelu_tanh(dt[k] * rs2); float f[16]; unpack8(da[k], f); unpack8(db[k], f + 8);
#pragma unroll
            for (int i = 0; i < 16; ++i) acc[i] += w * f[i]; }
    }
    const float* orow = a.out + (size_t)t * D; float* drow = dst + (size_t)t * D; const float* gf = a.in[22];
    f32x4 h0 = *(const GAS f32x4*)(orow + lane * 8), h1 = *(const GAS f32x4*)(orow + lane * 8 + 4), h2 = *(const GAS f32x4*)(orow + 512 + lane * 8), h3 = *(const GAS f32x4*)(orow + 512 + lane * 8 + 4);
    h0 += (f32x4){acc[0], acc[1], acc[2], acc[3]}; h1 += (f32x4){acc[4], acc[5], acc[6], acc[7]}; h2 += (f32x4){acc[8], acc[9], acc[10], acc[11]}; h3 += (f32x4){acc[12], acc[13], acc[14], acc[15]};
    float ss = (h0.x * h0.x + h0.y * h0.y) + (h0.z * h0.z + h0.w * h0.w) + (h1.x * h1.x + h1.y * h1.y) + (h1.z * h1.z + h1.w * h1.w)
             + (h2.x * h2.x + h2.y * h2.y) + (h2.z * h2.z + h2.w * h2.w) + (h3.x * h3.x + h3.y * h3.y) + (h3.z * h3.z + h3.w * h3.w);
    ss = wave_sum(ss);
    const float ri = 1.0f / sqrtf(ss * (1.0f / 1024.0f) + EPSN);
    const f32x4 f0 = *(const GAS f32x4*)(gf + lane * 8), f1 = *(const GAS f32x4*)(gf + lane * 8 + 4), f2 = *(const GAS f32x4*)(gf + 512 + lane * 8), f3 = *(const GAS f32x4*)(gf + 512 + lane * 8 + 4);
    *(GAS f32x4*)(drow + lane * 8) = h0 * ri * f0; *(GAS f32x4*)(drow + lane * 8 + 4) = h1 * ri * f1;
    *(GAS f32x4*)(drow + 512 + lane * 8) = h2 * ri * f2; *(GAS f32x4*)(drow + 512 + lane * 8 + 4) = h3 * ri * f3;
}


template <int CTRL> __device__ __forceinline__ float dpp_add(float v) { return v + __int_as_float(__builtin_amdgcn_update_dpp(0, __float_as_int(v), CTRL, 0xf, 0xf, false)); }
__device__ __forceinline__ float row16_sum(float v) { v = dpp_add<0x140>(v); v = dpp_add<0x141>(v); v = dpp_add<0x4E>(v); v = dpp_add<0xB1>(v); return v; }
__device__ __forceinline__ unsigned long long lanemask_lt(int lane) { return (1ull << lane) - 1ull; }
__device__ __forceinline__ void glds16g(const void* gsrc, unsigned lds_dst) { unsigned keep;
    asm volatile("s_mov_b32 %0, m0\n\ts_mov_b32 m0, %2\n\ts_nop 0\n\tglobal_load_lds_dwordx4 %1, off\n\ts_mov_b32 m0, %0" : "=&s"(keep) : "v"(gsrc), "s"(lds_dst) : "memory"); }

__device__ __forceinline__ void glds16x4(const void* sbase, unsigned o0, unsigned o1, unsigned o2, unsigned o3, unsigned d0, unsigned d1, unsigned d2, unsigned d3) { unsigned keep;
    asm volatile("s_mov_b32 %0, m0\n\ts_mov_b32 m0, %6\n\ts_nop 0\n\tglobal_load_lds_dwordx4 %1, %5\n\ts_mov_b32 m0, %7\n\ts_nop 0\n\tglobal_load_lds_dwordx4 %2, %5\n\t"
                 "s_mov_b32 m0, %8\n\ts_nop 0\n\tglobal_load_lds_dwordx4 %3, %5\n\ts_mov_b32 m0, %9\n\ts_nop 0\n\tglobal_load_lds_dwordx4 %4, %5\n\ts_mov_b32 m0, %0"
                 : "=&s"(keep) : "v"(o0), "v"(o1), "v"(o2), "v"(o3), "s"(sbase), "s"(d0), "s"(d1), "s"(d2), "s"(d3) : "memory"); }
typedef __bf16 bf2_t __attribute__((ext_vector_type(2)));
__device__ __forceinline__ float dot2bf(unsigned a, unsigned b, float c) { return __builtin_amdgcn_fdot2_f32_bf16(__builtin_bit_cast(bf2_t, a), __builtin_bit_cast(bf2_t, b), c, false); }
template <int NT> __device__ __forceinline__ void compact_tokens(const Args& a, int t0, int lane) {
    int e0[NT], e1[NT]; float g0[NT], g1[NT];
#pragma unroll
    for (int i = 0; i < NT; ++i) { const int* EID = (const int*)(a.ws + WS_EID) + (size_t)(t0 + i) * 128; const float* GW = (const float*)(a.ws + WS_GW) + (size_t)(t0 + i) * 128;
        e0[i] = EID[lane]; e1[i] = EID[64 + lane]; g0[i] = GW[lane]; g1[i] = GW[64 + lane]; }
#pragma unroll
    for (int i = 0; i < NT; ++i) {
        const bool p0 = e0[i] < 8192, p1 = e1[i] < 8192;
        const unsigned long long m0 = __ballot(p0), m1 = __ballot(p1), lt = lanemask_lt(lane);
        const int c0 = __popcll(m0), n0 = c0 + __popcll(m1);
        const int pos0 = p0 ? __popcll(m0 & lt) : n0 + __popcll(~m0 & lt);
        const int pos1 = p1 ? c0 + __popcll(m1 & lt) : n0 + (64 - c0) + __popcll(~m1 & lt);
        unsigned* R = (unsigned*)(a.ws + WS_REC) + (size_t)(t0 + i) * 128;
        R[pos0] = (unsigned)e0[i] | (f2bf(g0[i]) << 16); R[pos1] = (unsigned)e1[i] | (f2bf(g1[i]) << 16);
        if (lane == 0) ((int*)(a.ws + WS_N0))[t0 + i] = n0; }
}
template <int NT> __device__ __forceinline__ void w_tokens(const Args& a, int t0, int lane, const LAS float* scd, const LAS float* scu) {
    float d0[NT], d1[NT], sd0[NT], sd1[NT], su0[NT], su1[NT]; unsigned r0[NT], r1[NT]; float ss[NT];
#pragma unroll
    for (int i = 0; i < NT; ++i) { const unsigned short* DP = (const unsigned short*)(a.ws + WS_DOTP) + (size_t)(t0 + i) * 1024; const unsigned* R = (const unsigned*)(a.ws + WS_REC) + (size_t)(t0 + i) * 128;
        float p0[8], p1[8];
#pragma unroll
        for (int x = 0; x < 8; ++x) { p0[x] = bf2f(DP[x * 128 + lane]); p1[x] = bf2f(DP[x * 128 + 64 + lane]); }
        r0[i] = R[lane]; r1[i] = R[64 + lane]; ss[i] = ((const float*)(a.ws + WS_ROWSS2))[t0 + i];
        sd0[i] = scd[r0[i] & 0x3fffu]; sd1[i] = scd[r1[i] & 0x3fffu];
        su0[i] = scu[r0[i] & 0x3fffu]; su1[i] = scu[r1[i] & 0x3fffu];
        d0[i] = ((p0[0] + p0[1]) + (p0[2] + p0[3])) + ((p0[4] + p0[5]) + (p0[6] + p0[7])); d1[i] = ((p1[0] + p1[1]) + (p1[2] + p1[3])) + ((p1[4] + p1[5]) + (p1[6] + p1[7])); }
#pragma unroll
    for (int i = 0; i < NT; ++i) { const float rs2 = 1.0f / sqrtf(ss[i] * (1.0f / 1024.0f) + EPSN);
        const float w0 = bfhi(r0[i]) * fgelu_tanh(d0[i] * sd0[i] * rs2) * su0[i], w1 = bfhi(r1[i]) * fgelu_tanh(d1[i] * sd1[i] * rs2) * su1[i];
        float m0 = fabsf(w0), m1 = fabsf(w1);
#pragma unroll
        for (int o = 1; o < 64; o <<= 1) { m0 = fmaxf(m0, __shfl_xor(m0, o)); m1 = fmaxf(m1, __shfl_xor(m1, o)); }
        const float s0 = (m0 > 0.f) ? m0 * (1.0f / 127.0f) : 1.0f, s1 = (m1 > 0.f) ? m1 * (1.0f / 127.0f) : 1.0f;
        unsigned char* WQ = a.ws + WS_WQ8 + (size_t)(t0 + i) * 144;
        WQ[lane] = (unsigned char)((int)__builtin_rintf(w0 / s0) & 255); WQ[64 + lane] = (unsigned char)((int)__builtin_rintf(w1 / s1) & 255);
        if (lane == 0) { ((float*)(WQ + 128))[0] = s0; ((float*)(WQ + 128))[1] = s1; } }
}
template <bool IS_UP> __device__ __forceinline__ void sweep_slice(const Args& a, int x, int wv, int lane, unsigned ring, LAS unsigned char* ringp, unsigned aux, LAS unsigned char* auxp) {
    const int g = lane >> 4, li = lane & 15, n16 = li, kg = g;
    const char* TABx = (const char*)(a.ws + (IS_UP ? WS_EU : WS_ED)) + x * 256;
    unsigned jofs[4];
#pragma unroll
    for (int q = 0; q < 4; ++q) jofs[q] = (unsigned)((li ^ ((g << 2) | q)) * 16);
    const unsigned pd = (unsigned)__builtin_amdgcn_readfirstlane(ring);
#pragma unroll 1
    for (int s_ = 0; s_ < 128; ++s_) {
        const int r = s_ >> 6, k = s_ & 63, t = wv * 64 + k, base = 64 * r;
        const LAS unsigned* rec = (const LAS unsigned*)(auxp + (k & 3) * 512) + base;
        const LAS unsigned char* hp = auxp + 2048 + (k & 3) * 256;
        asm volatile("s_waitcnt lgkmcnt(0)" ::: "memory");
        if ((k & 3) == 0) {
            const char* rsrc = (const char*)(a.ws + WS_REC) + (size_t)t * 512 + lane * 16;
            glds16g(rsrc, (unsigned)__builtin_amdgcn_readfirstlane(aux)); glds16g(rsrc + 1024, (unsigned)__builtin_amdgcn_readfirstlane(aux + 1024));
            if (!IS_UP) glds16g((const char*)(a.ws + WS_HB) + (size_t)(t + g) * 2048 + x * 256 + li * 16, (unsigned)__builtin_amdgcn_readfirstlane(aux + 2048));
            asm volatile("s_waitcnt vmcnt(0)" ::: "memory");
        }
        {
            unsigned so[16];
#pragma unroll
            for (int p = 0; p < 16; ++p) so[p] = rec[4 * p + g];
#pragma unroll
            for (int p = 0; p < 16; ++p) so[p] = ((so[p] & 0x3fffu) << 11) + jofs[p & 3];
            glds16x4(TABx, so[0], so[1], so[2], so[3], pd, pd + 1024u, pd + 2048u, pd + 3072u);
            glds16x4(TABx, so[4], so[5], so[6], so[7], pd + 4096u, pd + 5120u, pd + 6144u, pd + 7168u);
            glds16x4(TABx, so[8], so[9], so[10], so[11], pd + 8192u, pd + 9216u, pd + 10240u, pd + 11264u);
            glds16x4(TABx, so[12], so[13], so[14], so[15], pd + 12288u, pd + 13312u, pd + 14336u, pd + 15360u);
        }
        asm volatile("s_waitcnt vmcnt(0)" ::: "memory");
        if (!IS_UP) {
            bf16x8 hb[4];
#pragma unroll
            for (int q = 0; q < 4; ++q) hb[q] = *(const LAS bf16x8*)(hp + (32 * q + 8 * kg) * 2);
            f32x4 res = (f32x4){0.f, 0.f, 0.f, 0.f};
#pragma unroll
            for (int rb = 0; rb < 4; ++rb) {
                f32x4 d = (f32x4){0.f, 0.f, 0.f, 0.f}; const int row = n16 + 16 * rb; const int key = ((row & 3) << 2) | ((row >> 2) & 3);
#pragma unroll
                for (int q = 0; q < 4; ++q) { const bf16x8 af = *(const LAS bf16x8*)(ringp + 256 * row + 16 * ((4 * q + kg) ^ key)); d = __builtin_amdgcn_mfma_f32_16x16x32_bf16(af, hb[q], d, 0, 0, 0); }
                res = (n16 == rb) ? d : res; }
            if (n16 < 4) *(GAS f32x4*)((float*)(a.ws + WS_DOTP) + ((size_t)t * 8 + x) * 128 + base + 16 * n16 + 4 * kg) = res;
        } else {
            f32x4 pacc[8];
#pragma unroll
            for (int i = 0; i < 8; ++i) pacc[i] = (f32x4){0.f, 0.f, 0.f, 0.f};
            const int q4 = n16 >> 2, p4 = lane & 3;
#pragma unroll
            for (int ks = 0; ks < 2; ++ks) {
                const v4u wa = *(const LAS v4u*)(rec + 32 * ks + 8 * kg), wb = *(const LAS v4u*)(rec + 32 * ks + 8 * kg + 4);
                const bf16x8 af = __builtin_bit_cast(bf16x8, (v4u){(wa.x >> 16) | (wa.y & 0xffff0000u), (wa.z >> 16) | (wa.w & 0xffff0000u), (wb.x >> 16) | (wb.y & 0xffff0000u), (wb.z >> 16) | (wb.w & 0xffff0000u)});
#pragma unroll
                for (int c = 0; c < 8; ++c) {
                    const int row0 = 32 * ks + 8 * kg + q4, row1 = row0 + 4; const int ch = 2 * c + (p4 >> 1);
                    const int k0 = ((row0 & 3) << 2) | ((row0 >> 2) & 3), k1 = ((row1 & 3) << 2) | ((row1 >> 2) & 3);
                    const attn_body::s16x4 lo4 = attn_body::vtr((attn_body::lds_cptr)(ringp + 256 * row0 + 16 * (ch ^ k0) + 8 * (p4 & 1)));
                    const attn_body::s16x4 hi4 = attn_body::vtr((attn_body::lds_cptr)(ringp + 256 * row1 + 16 * (ch ^ k1) + 8 * (p4 & 1)));
                    const bf16x8 bfr = (bf16x8){lo4[0], lo4[1], lo4[2], lo4[3], hi4[0], hi4[1], hi4[2], hi4[3]};
                    pacc[c] = __builtin_amdgcn_mfma_f32_16x16x32_bf16(af, bfr, pacc[c], 0, 0, 0); }
            }
            const float v0 = (kg == 0) ? pacc[0][0] : (kg == 1) ? pacc[1][0] : (kg == 2) ? pacc[2][0] : pacc[3][0];
            const float v1 = (kg == 0) ? pacc[4][0] : (kg == 1) ? pacc[5][0] : (kg == 2) ? pacc[6][0] : pacc[7][0];
            bf16* po = (bf16*)(a.ws + WS_PEER) + ((size_t)r * M + t) * D + x * 128;
            po[lane] = (bf16)f2bf(v0); po[64 + lane] = (bf16)f2bf(v1);
        }
    }
}
typedef int i32x4 __attribute__((ext_vector_type(4)));
__device__ __forceinline__ void sweep_down_q8(const Args& a, int x, int wv, int lane, unsigned ring, LAS unsigned char* ringp, unsigned aux, LAS unsigned char* auxp) {
    const int g = lane >> 4, li = lane & 15, n16 = li, kg = g, g8 = lane >> 3, s8 = lane & 7;
    const char* TABx = (const char*)(a.ws + WS_ED) + (size_t)x * ((size_t)NEXP * 128);
    unsigned jofs[2];
#pragma unroll
    for (int b = 0; b < 2; ++b) jofs[b] = (unsigned)((s8 ^ (4 * b + (g8 >> 1))) * 16);
    const unsigned pd = (unsigned)__builtin_amdgcn_readfirstlane(ring);
#define DN_FETCH(tw, dst) do { const char* rsrc_ = (const char*)(a.ws + WS_REC) + (size_t)(tw) * 512 + lane * 16; const unsigned d_ = (unsigned)__builtin_amdgcn_readfirstlane(dst); \
        glds16g(rsrc_, d_); glds16g(rsrc_ + 1024, d_ + 1024u); \
        glds16g((const char*)(a.ws + WS_HB) + (size_t)((tw) + g) * 2048 + x * 256 + li * 16, d_ + 2048u); } while (0)
    const unsigned auxu = (unsigned)__builtin_amdgcn_readfirstlane(aux);
    LAS unsigned char* hq = auxp + 3072; LAS float* hsc = (LAS float*)(auxp + 3072 + 512);
#define DN_WINDOW(tw) do { DN_FETCH(tw, auxu); asm volatile("s_waitcnt vmcnt(0)" ::: "memory"); \
        {     \
            const v4u hb = *(const LAS v4u*)(auxp + 2048 + lane * 16); float f[8]; unpack8(hb, f); \
            float am = fmaxf(fmaxf(fmaxf(fabsf(f[0]), fabsf(f[1])), fmaxf(fabsf(f[2]), fabsf(f[3]))), fmaxf(fmaxf(fabsf(f[4]), fabsf(f[5])), fmaxf(fabsf(f[6]), fabsf(f[7])))); \
            am = fmaxf(am, __int_as_float(__builtin_amdgcn_update_dpp(0, __float_as_int(am), 0x140, 0xf, 0xf, false))); am = fmaxf(am, __int_as_float(__builtin_amdgcn_update_dpp(0, __float_as_int(am), 0x141, 0xf, 0xf, false))); \
            am = fmaxf(am, __int_as_float(__builtin_amdgcn_update_dpp(0, __float_as_int(am), 0x4E, 0xf, 0xf, false))); am = fmaxf(am, __int_as_float(__builtin_amdgcn_update_dpp(0, __float_as_int(am), 0xB1, 0xf, 0xf, false))); \
            const float sc = (am > 0.f) ? am * (1.0f / 127.0f) : 1.0f, inv = 1.0f / sc; \
            unsigned qw[2]; \
            _Pragma("unroll") for (int h2 = 0; h2 < 2; ++h2) { const int q0 = (int)__builtin_rintf(f[4 * h2] * inv), q1 = (int)__builtin_rintf(f[4 * h2 + 1] * inv), q2 = (int)__builtin_rintf(f[4 * h2 + 2] * inv), q3 = (int)__builtin_rintf(f[4 * h2 + 3] * inv); \
                qw[h2] = ((unsigned)q0 & 255u) | (((unsigned)q1 & 255u) << 8) | (((unsigned)q2 & 255u) << 16) | ((unsigned)q3 << 24); } \
            *(LAS unsigned long long*)(hq + lane * 8) = (unsigned long long)qw[0] | ((unsigned long long)qw[1] << 32); \
            if (li == 0) hsc[g] = sc; } } while (0)
#define DN_PIECES(sn) do { const int kn_ = (sn) >> 1; const LAS unsigned* rec_ = (const LAS unsigned*)(auxp + (kn_ & 3) * 512) + 64 * ((sn) & 1); const unsigned pb_ = pd + 8192u * (unsigned)((sn) & 1); unsigned so[8]; \
        _Pragma("unroll") for (int i = 0; i < 8; ++i) so[i] = rec_[8 * i + g8]; \
        _Pragma("unroll") for (int i = 0; i < 8; ++i) so[i] = ((so[i] & 0x3fffu) << 7) + jofs[i & 1]; \
        glds16x4(TABx, so[0], so[1], so[2], so[3], pb_, pb_ + 1024u, pb_ + 2048u, pb_ + 3072u); \
        glds16x4(TABx, so[4], so[5], so[6], so[7], pb_ + 4096u, pb_ + 5120u, pb_ + 6144u, pb_ + 7168u); } while (0)
    DN_WINDOW(wv * 64);
    DN_PIECES(0);
#pragma unroll 1
    for (int s_ = 0; s_ < 128; ++s_) {
        const int r = s_ & 1, k = s_ >> 1, t = wv * 64 + k, base = 64 * r;
        const LAS unsigned char* ringb = ringp + 8192 * (s_ & 1);
        const bool more = s_ + 1 < 128, nb = (r == 1) && ((k & 3) == 3);
        asm volatile("s_waitcnt lgkmcnt(0)" ::: "memory");
        if (more && !nb) { DN_PIECES(s_ + 1); asm volatile("s_waitcnt vmcnt(8)" ::: "memory"); }
        else asm volatile("s_waitcnt vmcnt(0)" ::: "memory");
        const i32x4 hb0 = *(const LAS i32x4*)(hq + (k & 3) * 128 + 16 * kg), hb1 = *(const LAS i32x4*)(hq + (k & 3) * 128 + 64 + 16 * kg);
        const float hs = hsc[k & 3];
        i32x4 res = (i32x4){0, 0, 0, 0};
#pragma unroll
        for (int rb = 0; rb < 4; ++rb) {
            const int row = n16 + 16 * rb; const int key = (row >> 1) & 7;
            const i32x4 a0 = *(const LAS i32x4*)(ringb + row * 128 + ((kg ^ key) * 16)), a1 = *(const LAS i32x4*)(ringb + row * 128 + (((4 + kg) ^ key) * 16));
            i32x4 d = __builtin_amdgcn_mfma_i32_16x16x64_i8(a0, hb0, (i32x4){0, 0, 0, 0}, 0, 0, 0); d = __builtin_amdgcn_mfma_i32_16x16x64_i8(a1, hb1, d, 0, 0, 0);
            res = (n16 == rb) ? d : res; }
        if (n16 < 4) *(GAS unsigned long long*)((bf16*)(a.ws + WS_DOTP) + ((size_t)t * 8 + x) * 128 + base + 16 * n16 + 4 * kg) = (unsigned long long)pk2((float)res[0] * hs, (float)res[1] * hs) | ((unsigned long long)pk2((float)res[2] * hs, (float)res[3] * hs) << 32);
        if (more && nb) { asm volatile("s_waitcnt lgkmcnt(0)" ::: "memory"); DN_WINDOW(t + 1); DN_PIECES(s_ + 1); }
    }
}
#undef DN_FETCH
#undef DN_WINDOW
#undef DN_PIECES

__device__ __forceinline__ void sweep_up_q8(const Args& a, int x, int wv, int lane, unsigned ring, LAS unsigned char* ringp, unsigned aux, LAS unsigned char* auxp) {
    const int n16 = lane & 15, kg = lane >> 4, g8 = lane >> 3, s8 = lane & 7;
    const char* TABx = (const char*)(a.ws + WS_EU) + (size_t)x * ((size_t)NEXP * 128);
    unsigned jofs[2];
#pragma unroll
    for (int b = 0; b < 2; ++b) jofs[b] = (unsigned)((s8 ^ ((g8 >> 1) | (b << 2))) * 16);
    const unsigned pd = (unsigned)__builtin_amdgcn_readfirstlane(ring);
    typedef int v2i_t __attribute__((ext_vector_type(2)));
    float acc0 = 0.f, acc1 = 0.f;
#define UP_FETCH(tw, dst) do { const char* rsrc_ = (const char*)(a.ws + WS_REC) + (size_t)(tw) * 512 + lane * 16; const unsigned d_ = (unsigned)__builtin_amdgcn_readfirstlane(dst); \
        glds16g(rsrc_, d_); glds16g(rsrc_ + 1024, d_ + 1024u); \
        if (lane < 36) glds16g((const char*)(a.ws + WS_WQ8) + (size_t)(tw) * 144 + lane * 16, d_ + 2048u); \
        glds16g((const char*)(a.ws + WS_HB) + (size_t)((tw) + (lane >> 4)) * 2048 + x * 256 + (lane & 15) * 16, d_ + 2688u); } while (0)
    const unsigned auxu = (unsigned)__builtin_amdgcn_readfirstlane(aux);
#define UP_WINDOW(tw) do { UP_FETCH(tw, auxu); asm volatile("s_waitcnt vmcnt(0)" ::: "memory"); } while (0)
#define UP_PIECES(sn) do { const int kn_ = (sn) >> 1; const LAS unsigned* rec_ = (const LAS unsigned*)(auxp + (kn_ & 3) * 512) + 64 * ((sn) & 1); const unsigned pb_ = pd + 8192u * (unsigned)((sn) & 1); unsigned so[8]; \
        _Pragma("unroll") for (int i = 0; i < 8; ++i) so[i] = rec_[8 * i + g8]; \
        _Pragma("unroll") for (int i = 0; i < 8; ++i) so[i] = ((so[i] & 0x3fffu) << 7) + jofs[(i >> 1) & 1]; \
        glds16x4(TABx, so[0], so[1], so[2], so[3], pb_, pb_ + 1024u, pb_ + 2048u, pb_ + 3072u); \
        glds16x4(TABx, so[4], so[5], so[6], so[7], pb_ + 4096u, pb_ + 5120u, pb_ + 6144u, pb_ + 7168u); } while (0)
    UP_WINDOW(wv * 64);
    UP_PIECES(0);
#pragma unroll 1
    for (int s_ = 0; s_ < 128; ++s_) {
        const int r = s_ & 1, k = s_ >> 1, t = wv * 64 + k;
        const LAS unsigned char* ringb = ringp + 8192 * (s_ & 1);
        const LAS unsigned char* wq = auxp + 2048 + (k & 3) * 144;
        const bool more = s_ + 1 < 128, nb = (r == 1) && ((k & 3) == 3);
        asm volatile("s_waitcnt lgkmcnt(0)" ::: "memory");
        if (more && !nb) { UP_PIECES(s_ + 1); asm volatile("s_waitcnt vmcnt(8)" ::: "memory"); }
        else asm volatile("s_waitcnt vmcnt(0)" ::: "memory");
        const i32x4 aw = *(const LAS i32x4*)(wq + 64 * r + 16 * kg);
        const float wsc = *(const LAS float*)(wq + 128 + 4 * r);
        const int i2 = n16 >> 1, ih = n16 & 1;
        const int row0 = 16 * kg + i2, row1 = row0 + 8;
        const int k0 = ((row0 >> 1) & 3) | (((row0 >> 4) & 1) << 2), k1 = ((row1 >> 1) & 3) | (((row1 >> 4) & 1) << 2);
        const LAS unsigned char* p0 = ringb + row0 * 128 + 8 * ih; const LAS unsigned char* p1 = ringb + row1 * 128 + 8 * ih;
        float outv[8];
#pragma unroll
        for (int c = 0; c < 8; ++c) {
            const v2i_t lo = __builtin_amdgcn_ds_read_tr8_b64_v2i32((LAS v2i_t*)(p0 + ((c ^ k0) * 16)));
            const v2i_t hi = __builtin_amdgcn_ds_read_tr8_b64_v2i32((LAS v2i_t*)(p1 + ((c ^ k1) * 16)));
            const i32x4 d = __builtin_amdgcn_mfma_i32_16x16x64_i8(aw, (i32x4){lo.x, lo.y, hi.x, hi.y}, (i32x4){0, 0, 0, 0}, 0, 0, 0);
            outv[c] = (float)d[0] * wsc; }
        const float v0 = (kg == 0) ? outv[0] : (kg == 1) ? outv[1] : (kg == 2) ? outv[2] : outv[3];
        const float v1 = (kg == 0) ? outv[4] : (kg == 1) ? outv[5] : (kg == 2) ? outv[6] : outv[7];
        if (r == 0) { acc0 = v0; acc1 = v1; }
        else { const LAS unsigned short* hs = (const LAS unsigned short*)(auxp + 2688 + (k & 3) * 256);
            const float y0 = bf2f(hs[lane]) + (acc0 + v0), y1 = bf2f(hs[64 + lane]) + (acc1 + v1);
            bf16* po = (bf16*)(a.ws + WS_PEER) + (size_t)t * D + x * 128;
            po[lane] = (bf16)f2bf(y0); po[64 + lane] = (bf16)f2bf(y1); }
        if (more && nb) { asm volatile("s_waitcnt lgkmcnt(0)" ::: "memory"); UP_WINDOW(t + 1); UP_PIECES(s_ + 1); }
    }
}
#undef UP_FETCH
#undef UP_WINDOW
#undef UP_PIECES

__device__ __forceinline__ void final_row(const Args& a, int t, int lane) {
    float* orow = a.out + (size_t)t * D; const float* gf = a.in[22];
    const bf16* Y = (const bf16*)(a.ws + WS_PEER) + (size_t)t * D;
    f32x4 y[4]; float ss = 0.f;
#pragma unroll
    for (int j = 0; j < 4; ++j) { const unsigned long long yb = ((const GAS unsigned long long*)Y)[lane + 64 * j];
        y[j] = (f32x4){bflo((unsigned)yb), bfhi((unsigned)yb), bflo((unsigned)(yb >> 32)), bfhi((unsigned)(yb >> 32))};
        ss += (y[j].x * y[j].x + y[j].y * y[j].y) + (y[j].z * y[j].z + y[j].w * y[j].w); }
    ss = wave_sum(ss);
    const float ri = 1.0f / sqrtf(ss * (1.0f / 1024.0f) + EPSN);
#pragma unroll
    for (int j = 0; j < 4; ++j) ((GAS f32x4*)orow)[lane + 64 * j] = y[j] * ri * ((const GAS f32x4*)gf)[lane + 64 * j];
}

__device__ __forceinline__ float a_dot64(const float* p, const float* q, int lane) { return wave_sum(p[lane] * q[lane]); }
constexpr int N_PHASES = 12;
#ifndef ROUTE_REF
#define ROUTE_REF 0
#endif
#ifndef MK_ONE_LAUNCH
#define MK_ONE_LAUNCH 1
#endif
__global__ void __launch_bounds__(NWAVES * 64, 2) fwd_mega(Args args) {
    extern __shared__ __attribute__((aligned(16))) unsigned char lds[];
    Frame F;
    F.lds = (LAS unsigned char*)lds;
    F.MISC = (volatile LAS unsigned*)(F.lds + MISC_OFF);
    F.tid = threadIdx.x; F.lane = F.tid & 63; F.wave = __builtin_amdgcn_readfirstlane(F.tid >> 6);
    F.G = gridDim.x; { const int bx = blockIdx.x; F.vcu = (F.G % 8 == 0) ? (bx % 8) * (F.G / 8) + bx / 8 : bx; }
    unsigned char* ws = args.ws;
    const int lo = args.ph_lo, hi = args.ph_hi;
#ifndef PH_MASK
#define PH_MASK 0xffff
#endif
#define IN(k) (((PH_MASK >> (k)) & 1) && lo <= (k) && (k) < hi)
#define BOTH(k) (IN(k) && IN((k) + 1))
#if MK_ONE_LAUNCH
    for (int u = F.tid; u < (LDS_BYTES - LDSCTL_OFF) / 4; u += NWAVES * 64) ((LAS unsigned*)(F.lds + LDSCTL_OFF))[u] = 0u;
    __syncthreads();
    const XcdBarrier xbar = xcd_barrier_post((unsigned*)(ws + WS_CTL) + CW_BAR, F.MISC + 8);
    bool first_seam = args.ph_lo < 0;
#define GRID_BAR() do { if (first_seam) { __threadfence(); cooperative_groups::this_grid().sync(); first_seam = false; } else xcd_barrier(xbar); } while (0)
#else
#define GRID_BAR() do { } while (0)
#endif
#ifndef REP_PH
#define REP_PH -1
#endif
#define RUN_PHASE(k, ...) do { if (IN(k)) { if ((k) == REP_PH) { { const bool first_of_two = true; (void)first_of_two; __VA_ARGS__ } GRID_BAR(); } { const bool first_of_two = false; (void)first_of_two; __VA_ARGS__ } if (BOTH(k)) GRID_BAR(); } } while (0)
    RUN_PHASE(0, { p0_prologue(F, args); });
    RUN_PHASE(1, {
        pg8::Gemm g{(const pg8::bf16_t*)(ws + WS_XB), (const pg8::bf16_t*)(ws + WS_WIN), M, INC, D}; pg8::StaticOrder S; S.init(M, INC, F.G, (int)blockIdx.x);
        pg8::EpiBf16<1> E{(pg8::bf16_t*)(ws + WS_Q), 512, (const float*)(ws + WS_RS1), 512, (size_t)WS_SPLIT / 2, attn_body::C2};
        pg8::gemm_phase<pg8::EpiBf16<1>, pg8::StaticOrder, true, true>(F.lds + RING_OFF, g, S, E);
        { const int nb = (F.G >= 2) ? (int)F.G / 2 : 1; const int bi = (int)blockIdx.x - ((int)F.G - nb); if (bi >= 0) convert_experts(args, bi * NWAVES + F.wave, nb * NWAVES, F.lane); }
    });
    RUN_PHASE(2, {
        for (int c = F.vcu; c < M / 64; c += F.G) lru_local_unit(F, args, c);
        const attn128::AttnTensors AT{(const attn128::bf16*)(ws + WS_Q), (const attn128::bf16*)(ws + WS_Q + WS_SPLIT), (const attn128::bf16*)(ws + WS_Q + 2 * WS_SPLIT), (attn128::bf16*)(args.out + (size_t)M * 512)};
        const attn128::StaticOrder S(F.vcu);
        attn128::attn_phase<attn128::StaticOrder>((char*)lds + RING_OFF, AT, S);
    });
    RUN_PHASE(3, {
        float l1 = a_dot64(args.in[3], args.in[4], F.lane); float l2 = a_dot64(args.in[5], args.in[6], F.lane);
        const float lamv = expf(l1) - expf(l2) + 0.2f;
        for (int c = F.vcu; c < M / 64; c += F.G) fix_unit(F, args, c, lamv);
    });
    RUN_PHASE(4, {
        pg8::Gemm g{(const pg8::bf16_t*)(ws + WS_MIX), (const pg8::bf16_t*)(ws + WS_WOUT), M, D, D}; pg8::StaticOrder S; S.init(M, D, F.G, (int)blockIdx.x);
        pg8::EpiResid E{(const pg8::bf16_t*)(ws + WS_XB), args.out, (pg8::bf16_t*)(ws + WS_HB), (float*)(ws + (first_of_two ? WS_RS1 : WS_ROWSS2)), D};
        pg8::gemm_phase<pg8::EpiResid, pg8::StaticOrder, true, true>(F.lds + RING_OFF, g, S, E);
    });
    RUN_PHASE(5, {
        pg8::Gemm g{(const pg8::bf16_t*)(ws + WS_HB), (const pg8::bf16_t*)(ws + WS_WQ), M, NQ, D}; pg8::StaticOrder S; S.init(M, NQ, F.G, (int)blockIdx.x);
        pg8::EpiBf16<2> E{(pg8::bf16_t*)(ws + WS_Q2), NQ, (const float*)(ws + WS_ROWSS2), 0, 0, 1.f};
        pg8::gemm_phase<pg8::EpiBf16<2>, pg8::StaticOrder, true, true>(F.lds + RING_OFF, g, S, E);
    });
    RUN_PHASE(6, {
        const int gw = F.vcu * NWAVES + F.wave; const int NGW = F.G * NWAVES;
        LAS unsigned char* skl = F.lds + RING_OFF + 16384;
        for (int c = F.tid; c < 4096; c += NWAVES * 64) { const int row = c >> 4; const int ch = c & 15; *(LAS v4u*)(skl + row * 272 + ch * 16) = *(const GAS v4u*)(ws + WS_SK1 + (size_t)row * 256 + ch * 16); }
        __syncthreads();
        static_assert((M / 32) * 8 == NEXP / 4, "one group of 4 expert_up rows beside each 32-token routing group");
        for (int u = gw; u < (M / 64) * 8; u += NGW) { const int g2 = u >> 3, hd = u & 7; f32x4 ev[4][4]; int k1[16], k2[16];
            { int k1a[16], k2a[16];
              q8_load<4>(ev, args.in[21] + (size_t)(2 * u) * 4 * D, F.lane);
              route_tops(args, 2 * g2, hd, F.lane, skl, k1a, k2a);
              q8_finish<4>(ev, ws + WS_EU + (size_t)(2 * u) * 4 * 128, nullptr, (float*)(ws + WS_SCU) + 8 * u, F.lane);
              q8_load<4>(ev, args.in[21] + (size_t)(2 * u + 1) * 4 * D, F.lane);
              route_tops(args, 2 * g2 + 1, hd, F.lane, skl, k1, k2);
              q8_finish<4>(ev, ws + WS_EU + (size_t)(2 * u + 1) * 4 * 128, nullptr, (float*)(ws + WS_SCU) + 8 * u + 4, F.lane);
              if (F.lane < 32) { _Pragma("unroll") for (int i = 0; i < 16; ++i) { k1[i] = k1a[i]; k2[i] = k2a[i]; } } }
            route_finish(args, (2 * g2 + (F.lane >> 5)) * 32 + (F.lane & 31), hd, F.lds + RING_OFF + F.tid * 32, k1, k2); }
        __syncthreads();
    });
    RUN_PHASE(8, {
        if (F.G == 256) sweep_down_q8(args, F.vcu >> 5, (F.vcu & 31) * NWAVES + F.wave, F.lane, (unsigned)(uintptr_t)(lds + RING_OFF) + F.wave * 16384u, F.lds + RING_OFF + F.wave * 16384, (unsigned)(uintptr_t)(lds + LDSCTL_OFF + 1024) + F.wave * 3712u, F.lds + LDSCTL_OFF + 1024 + F.wave * 3712);
    });
    RUN_PHASE(9, {
        const int gw = F.vcu * NWAVES + F.wave; const int NGW = F.G * NWAVES;
        LAS float* scl = (LAS float*)(F.lds + RING_OFF);
        for (int i = F.tid; i < NEXP / 4; i += NWAVES * 64) { ((LAS v4u*)scl)[i] = ((const GAS v4u*)(ws + WS_SCD))[i]; ((LAS v4u*)(scl + NEXP))[i] = ((const GAS v4u*)(ws + WS_SCU))[i]; }
        __syncthreads();
        for (int t = 8 * gw; t < M; t += 8 * NGW) w_tokens<8>(args, t, F.lane, scl, scl + NEXP);
        __syncthreads();
    });
    RUN_PHASE(10, {
        if (F.G == 256) sweep_up_q8(args, F.vcu >> 5, (F.vcu & 31) * NWAVES + F.wave, F.lane, (unsigned)(uintptr_t)(lds + RING_OFF) + F.wave * 16384u, F.lds + RING_OFF + F.wave * 16384, (unsigned)(uintptr_t)(lds + LDSCTL_OFF + 1024) + F.wave * 3712u, F.lds + LDSCTL_OFF + 1024 + F.wave * 3712);
    });
    RUN_PHASE(11, {
        const int gw = F.vcu * NWAVES + F.wave; const int NGW = F.G * NWAVES;
        for (int t = gw; t < M; t += NGW) final_row(args, t, F.lane);
    });
#undef IN
#undef BOTH
}

extern "C" void kernel_launch(void* const* d_in, const int* in_sizes, int n_in, void* d_out, int out_size, void* d_ws, size_t ws_size, hipStream_t stream) {
    static int grid = 0;
    if (grid == 0) {
        if (n_in != 23 || out_size != M * D || ws_size < WS_END) { fprintf(stderr, "kernel_launch: unexpected problem: n_in %d out %d ws %zu\n", n_in, out_size, ws_size); grid = -1; return; }
        int dev = 0, cus = 0, per_cu = 0;
        if (hipGetDevice(&dev) != hipSuccess || hipDeviceGetAttribute(&cus, hipDeviceAttributeMultiprocessorCount, dev) != hipSuccess) { grid = -1; return; }
        if (hipFuncSetAttribute((const void*)fwd_mega, hipFuncAttributeMaxDynamicSharedMemorySize, LDS_BYTES) != hipSuccess) { fprintf(stderr, "kernel_launch: hipFuncSetAttribute failed\n"); grid = -1; return; }
        if (hipOccupancyMaxActiveBlocksPerMultiprocessor(&per_cu, (const void*)fwd_mega, NWAVES * 64, LDS_BYTES) != hipSuccess || per_cu < 1) { fprintf(stderr, "kernel_launch: occupancy query reports %d\n", per_cu); per_cu = 1; }
        (void)hipGetLastError();
        grid = cus;
    }
    if (grid < 0) return;
    (void)hipMemsetAsync((char*)d_ws + WS_CTL, 0, CTL_ZERO_BYTES, stream);
    Args a{};
    for (int i = 0; i < 23; ++i) a.in[i] = (const float*)d_in[i];
    a.out = (float*)d_out; a.ws = (unsigned char*)d_ws;
#if MK_ONE_LAUNCH
    a.ph_lo = 0; a.ph_hi = N_PHASES;
    void* kargs[] = {&a};
    hipError_t e = hipLaunchCooperativeKernel((const void*)fwd_mega, dim3(grid), dim3(NWAVES * 64), kargs, LDS_BYTES, stream);
    if (e != hipSuccess) fprintf(stderr, "cooperative launch failed: %s (grid %d)\n", hipGetErrorString(e), grid);
#else
    for (int p = 0; p < N_PHASES; ++p) { a.ph_lo = p; a.ph_hi = p + 1; hipLaunchKernelGGL(fwd_mega, dim3(grid), dim3(NWAVES * 64), LDS_BYTES, stream, a); }
#endif
}
```
